# Optimizing an MI355X kernel written in HIP

```python
import math
import jax, jax.numpy as jnp
from jax import lax
import numpy as np

D_MODEL = 1024
BATCH = 8
SEQ = 2048
DEPTH = 2

N_A = DEPTH // 2
N_B = DEPTH - N_A
N_DENSE = (DEPTH + 1) // 2
N_MOE = DEPTH // 2

CONV_WIDTH = 3
HEAD_DIM = 64
N_HEADS = D_MODEL // (2 * HEAD_DIM)
V_DIM = 2 * HEAD_DIM
D_FF = 256 * ((8 * D_MODEL // 3 + 255) // 256)
N_EXPERTS = 8
TOP_K = 2
D_FF_EXPERT = 7 * D_MODEL // 2
Q_BLOCK = 128
EPS = 1e-6

kernel_name = "yoco_shortconv_diffattn_moe"


def rmsnorm(x, g):
    xf = x.astype(jnp.float32)
    y = xf * lax.rsqrt(jnp.mean(xf * xf, axis=-1, keepdims=True) + EPS)
    return (y * g.astype(jnp.float32)).astype(x.dtype)


def lambda_init(layer_idx_1based):
    return 0.8 - 0.6 * math.exp(-0.3 * (layer_idx_1based - 1))


def swiglu(h, w_gu, w_down):
    gu = h @ w_gu
    g, u = jnp.split(gu, 2, axis=-1)
    return (jax.nn.silu(g) * u) @ w_down


def short_conv_mixer(h, w_in, conv_w, w_out):
    S = h.shape[1]
    bcv = h @ w_in
    b, c, v = jnp.split(bcv, 3, axis=-1)
    u = c * v
    up = jnp.pad(u, ((0, 0), (CONV_WIDTH - 1, 0), (0, 0)))
    z = up[:, 0:S] * conv_w[0]
    for j in range(1, CONV_WIDTH):
        z = z + up[:, j:j + S] * conv_w[j]
    return (b * z) @ w_out


def shared_kv(stream, ln_kv, w_kv, k_norm):
    Bsz, S, _ = stream.shape
    h = rmsnorm(stream, ln_kv)
    kv = h @ w_kv
    k = kv[..., :2 * N_HEADS * HEAD_DIM].reshape(Bsz, S, N_HEADS, 2, HEAD_DIM)
    k = rmsnorm(k, k_norm)
    v = kv[..., 2 * N_HEADS * HEAD_DIM:].reshape(Bsz, S, N_HEADS, V_DIM)
    return k, v


def diff_attention(h, k, v, w_q, q_norm, lam_params, sub_norm, w_o, lam_init):
    Bsz, S, _ = h.shape
    scale = HEAD_DIM ** -0.5
    q = (h @ w_q).reshape(Bsz, S, N_HEADS, 2, HEAD_DIM)
    q = rmsnorm(q, q_norm) * scale
    lp = lam_params.astype(jnp.float32)
    lam = (jnp.exp(jnp.sum(lp[0] * lp[1])) - jnp.exp(jnp.sum(lp[2] * lp[3])) + lam_init)
    n_blk = S // Q_BLOCK
    qb = q.reshape(Bsz, n_blk, Q_BLOCK, N_HEADS, 2, HEAD_DIM).transpose(1, 0, 2, 3, 4, 5)
    kpos = jnp.arange(S)

    def block(args):
        qi, bi = args
        s = jnp.einsum('bqhcd,bkhcd->bhcqk', qi, k).astype(jnp.float32)
        qpos = bi * Q_BLOCK + jnp.arange(Q_BLOCK)
        mask = kpos[None, :] <= qpos[:, None]
        s = jnp.where(mask, s, -jnp.inf)
        p = jax.nn.softmax(s, axis=-1)
        a = p[:, :, 0] - lam * p[:, :, 1]
        return jnp.einsum('bhqk,bkhe->bqhe', a.astype(v.dtype), v)

    o = lax.map(block, (qb, jnp.arange(n_blk)))
    o = o.transpose(1, 0, 2, 3, 4).reshape(Bsz, S, N_HEADS, V_DIM)
    o = rmsnorm(o, sub_norm) * (1.0 - lam_init)
    return o.reshape(Bsz, S, N_HEADS * V_DIM) @ w_o


def moe_swiglu(h, w_router, w_gu_e, w_down_e):
    logits = (h @ w_router).astype(jnp.float32)
    top_v, top_i = lax.top_k(logits, TOP_K)
    gates = jax.nn.softmax(top_v, axis=-1)
    combine = jnp.sum(jax.nn.one_hot(top_i, N_EXPERTS, dtype=jnp.float32) * gates[..., None], axis=-2)
    combine = combine.astype(h.dtype)
    out = jnp.zeros_like(h)
    for e in range(N_EXPERTS):
        out = out + combine[..., e:e + 1] * swiglu(h, w_gu_e[e], w_down_e[e])
    return out


def setup_inputs(seed: int = 0) -> dict:
    key = jax.random.key(seed)
    ks = jax.random.split(key, 24)
    D = D_MODEL
    f32 = jnp.float32

    def nrm(k, shape, scale):
        return jax.random.normal(k, shape, f32) * scale

    def gain(k, shape):
        return 1.0 + 0.02 * jax.random.normal(k, shape, f32)

    kv_width = 2 * N_HEADS * HEAD_DIM + N_HEADS * V_DIM
    return {
        "x": jax.random.normal(ks[0], (BATCH, SEQ, D), f32),
        "ln_mix": gain(ks[1], (DEPTH, D)),
        "ln_ffn": gain(ks[2], (DEPTH, D)),
        "conv_w_in": nrm(ks[3], (N_A, D, 3 * D), D ** -0.5),
        "conv_w": nrm(ks[4], (N_A, CONV_WIDTH, D), CONV_WIDTH ** -0.5),
        "conv_w_out": nrm(ks[5], (N_A, D, D), D ** -0.5),
        "ln_kv": gain(ks[6], (D,)),
        "w_kv": nrm(ks[7], (D, kv_width), D ** -0.5),
        "k_norm": gain(ks[8], (HEAD_DIM,)),
        "attn_w_q": nrm(ks[9], (N_B, D, 2 * N_HEADS * HEAD_DIM), D ** -0.5),
        "q_norm": gain(ks[10], (N_B, HEAD_DIM)),
        "lam_params": nrm(ks[11], (N_B, 4, HEAD_DIM), 0.1),
        "sub_norm": gain(ks[12], (N_B, V_DIM)),
        "attn_w_o": nrm(ks[13], (N_B, N_HEADS * V_DIM, D), (N_HEADS * V_DIM) ** -0.5),
        "ffn_w_gu": nrm(ks[14], (N_DENSE, D, 2 * D_FF), D ** -0.5),
        "ffn_w_down": nrm(ks[15], (N_DENSE, D_FF, D), D_FF ** -0.5),
        "router_w": nrm(ks[16], (N_MOE, D, N_EXPERTS), D ** -0.5),
        "moe_w_gu": nrm(ks[17], (N_MOE, N_EXPERTS, D, 2 * D_FF_EXPERT), D ** -0.5),
        "moe_w_down": nrm(ks[18], (N_MOE, N_EXPERTS, D_FF_EXPERT, D), D_FF_EXPERT ** -0.5),
    }


def reference(x, ln_mix, ln_ffn, conv_w_in, conv_w, conv_w_out, ln_kv, w_kv, k_norm,
              attn_w_q, q_norm, lam_params, sub_norm, attn_w_o, ffn_w_gu, ffn_w_down,
              router_w, moe_w_gu, moe_w_down):
    k_sh = None
    v_sh = None
    for i in range(DEPTH):
        h = rmsnorm(x, ln_mix[i])
        if i < N_A:
            x = x + short_conv_mixer(h, conv_w_in[i], conv_w[i], conv_w_out[i])
        else:
            j = i - N_A
            x = x + diff_attention(h, k_sh, v_sh, attn_w_q[j], q_norm[j], lam_params[j],
                                   sub_norm[j], attn_w_o[j], lambda_init(i + 1))
        h = rmsnorm(x, ln_ffn[i])
        if i % 2 == 0:
            x = x + swiglu(h, ffn_w_gu[i // 2], ffn_w_down[i // 2])
        else:
            x = x + moe_swiglu(h, router_w[i // 2], moe_w_gu[i // 2], moe_w_down[i // 2])
        if i == N_A - 1:
            k_sh, v_sh = shared_kv(x, ln_kv, w_kv, k_norm)
    return x
```

```cpp
#include <hip/hip_runtime.h>
#include <stdint.h>
#include <stdio.h>

typedef unsigned short bf16_t;
typedef short bf16x8 __attribute__((ext_vector_type(8)));
typedef float f32x4 __attribute__((ext_vector_type(4)));

constexpr int D = 1024, BATCH = 8, SEQ = 2048, M = BATCH * SEQ;
constexpr int NH = 8, HD = 64, VD = 128;
constexpr int DFF = 2816, NE = 8, DFE = 3584;
constexpr float EPS = 1e-6f;
constexpr float LAM_INIT = 0.35550907f;
constexpr int SLOTS = 2 * M + NE * 256;

__device__ __forceinline__ unsigned f2bf(float f) { unsigned u = __builtin_bit_cast(unsigned, f); return (u + 0x7fffu + ((u >> 16) & 1u)) >> 16; }
__device__ __forceinline__ float bf2f(unsigned short b) { return __builtin_bit_cast(float, (unsigned)b << 16); }
__device__ __forceinline__ float wave_sum(float v) {
#pragma unroll
    for (int o = 1; o < 64; o <<= 1) v += __shfl_xor(v, o);
    return v;
}

__global__ __launch_bounds__(256) void k_wt(const float* __restrict__ W, bf16_t* __restrict__ Bt, int K, int N) {
    __shared__ float t[32][33];
    const float* w = W + (size_t)blockIdx.z * K * N; bf16_t* o = Bt + (size_t)blockIdx.z * K * N;
    const int n0 = blockIdx.x * 32, k0 = blockIdx.y * 32, tx = threadIdx.x & 31, ty = threadIdx.x >> 5;
#pragma unroll
    for (int i = 0; i < 4; ++i) t[ty + 8 * i][tx] = w[(size_t)(k0 + ty + 8 * i) * N + n0 + tx];
    __syncthreads();
#pragma unroll
    for (int i = 0; i < 4; ++i) o[(size_t)(n0 + ty + 8 * i) * K + k0 + tx] = (bf16_t)f2bf(t[tx][ty + 8 * i]);
}

__global__ __launch_bounds__(256) void k_rmsnorm(const float* __restrict__ x, const float* __restrict__ g, bf16_t* __restrict__ out) {
    const int row = blockIdx.x * 4 + (threadIdx.x >> 6), lane = threadIdx.x & 63;
    const f32x4* xr = (const f32x4*)(x + (size_t)row * D) + lane; const f32x4* gr = (const f32x4*)g + lane;
    f32x4 v[4]; float s = 0.f;
#pragma unroll
    for (int j = 0; j < 4; ++j) { v[j] = xr[64 * j]; s += v[j].x * v[j].x + v[j].y * v[j].y + v[j].z * v[j].z + v[j].w * v[j].w; }
    const float rstd = rsqrtf(wave_sum(s) * (1.f / D) + EPS);
    unsigned long long* o8 = (unsigned long long*)(out + (size_t)row * D) + lane;
#pragma unroll
    for (int j = 0; j < 4; ++j) { const f32x4 gg = gr[64 * j];
        const unsigned a = f2bf(v[j].x * rstd * gg.x), b = f2bf(v[j].y * rstd * gg.y), c = f2bf(v[j].z * rstd * gg.z), d = f2bf(v[j].w * rstd * gg.w);
        o8[64 * j] = (unsigned long long)(a | (b << 16)) | ((unsigned long long)(c | (d << 16)) << 32); }
}

__global__ __launch_bounds__(256) void k_resid_norm(const float* __restrict__ xold, const float* __restrict__ y, float* __restrict__ xnew,
                                                    const float* __restrict__ g1, bf16_t* __restrict__ o1, const float* __restrict__ g2, bf16_t* __restrict__ o2) {
    const int row = blockIdx.x * 4 + (threadIdx.x >> 6), lane = threadIdx.x & 63;
    const f32x4* xr = (const f32x4*)(xold + (size_t)row * D) + lane; const f32x4* yr = (const f32x4*)(y + (size_t)row * D) + lane;
    f32x4* xo = (f32x4*)(xnew + (size_t)row * D) + lane;
    f32x4 v[4]; float s = 0.f;
#pragma unroll
    for (int j = 0; j < 4; ++j) { v[j] = xr[64 * j] + yr[64 * j]; xo[64 * j] = v[j]; s += v[j].x * v[j].x + v[j].y * v[j].y + v[j].z * v[j].z + v[j].w * v[j].w; }
    const float rstd = rsqrtf(wave_sum(s) * (1.f / D) + EPS);
#pragma unroll
    for (int p = 0; p < 2; ++p) { const float* g = p ? g2 : g1; bf16_t* o = p ? o2 : o1; if (!o) continue;
        const f32x4* gr = (const f32x4*)g + lane; unsigned long long* o8 = (unsigned long long*)(o + (size_t)row * D) + lane;
#pragma unroll
        for (int j = 0; j < 4; ++j) { const f32x4 gg = gr[64 * j];
            const unsigned a = f2bf(v[j].x * rstd * gg.x), b = f2bf(v[j].y * rstd * gg.y), c = f2bf(v[j].z * rstd * gg.z), d = f2bf(v[j].w * rstd * gg.w);
            o8[64 * j] = (unsigned long long)(a | (b << 16)) | ((unsigned long long)(c | (d << 16)) << 32); } }
}

template <int MODE>
__global__ __launch_bounds__(256) void k_gemm(const bf16_t* __restrict__ A, int lda, const bf16_t* __restrict__ Bt, int ldb, void* __restrict__ Cv, int ldc,
                                               int Mtot, int K, int dualOff, const int* __restrict__ arow, const int* __restrict__ gbase, const int* __restrict__ gcount, size_t bstride) {
    const int z = blockIdx.z; int start = 0, count = Mtot;
    if (gbase) { start = gbase[z]; count = gcount[z]; Bt += (size_t)z * bstride; }
    const int mt0 = blockIdx.y * 64; if (mt0 >= count) return;
    const int n0 = blockIdx.x * 64, w = threadIdx.x >> 6, lane = threadIdx.x & 63, r = lane & 15, q = lane >> 4;
    int ml = mt0 + 16 * w + r; if (ml >= count) ml = count - 1;
    const int mrow = start + ml; const int ar = arow ? arow[mrow] : mrow;
    const bf16_t* ap = A + (size_t)ar * lda + 8 * q;
    const bf16_t* bp = Bt + (size_t)(n0 + r) * ldb + 8 * q;
    f32x4 acc[4], acc2[4];
#pragma unroll
    for (int j = 0; j < 4; ++j) { acc[j] = (f32x4){0.f, 0.f, 0.f, 0.f}; acc2[j] = (f32x4){0.f, 0.f, 0.f, 0.f}; }
    for (int k0 = 0; k0 < K; k0 += 32) {
        const bf16x8 a = *(const bf16x8*)(ap + k0);
#pragma unroll
        for (int j = 0; j < 4; ++j) { const bf16x8 b = *(const bf16x8*)(bp + (size_t)(16 * j) * ldb + k0);
            acc[j] = __builtin_amdgcn_mfma_f32_16x16x32_bf16(a, b, acc[j], 0, 0, 0);
            if (MODE == 1) { const bf16x8 b2 = *(const bf16x8*)(bp + (size_t)(16 * j + dualOff) * ldb + k0);
                acc2[j] = __builtin_amdgcn_mfma_f32_16x16x32_bf16(a, b2, acc2[j], 0, 0, 0); } }
    }
#pragma unroll
    for (int j = 0; j < 4; ++j)
#pragma unroll
        for (int i = 0; i < 4; ++i) { const int mo = mt0 + 16 * w + 4 * q + i; if (mo >= count) continue;
            const size_t off = (size_t)(start + mo) * ldc + n0 + 16 * j + r;
            if (MODE == 0) ((float*)Cv)[off] = acc[j][i];
            else { const float g = acc[j][i], u = acc2[j][i]; ((bf16_t*)Cv)[off] = (bf16_t)f2bf(g / (1.f + expf(-g)) * u); } }
}

__global__ __launch_bounds__(256) void k_conv(const float* __restrict__ bcv, const float* __restrict__ cw, bf16_t* __restrict__ G) {
    const int idx = blockIdx.x * 256 + threadIdx.x; const int row = idx >> 10, c = idx & 1023, t = row & (SEQ - 1);
    const float* p = bcv + (size_t)row * 3072;
    float z = cw[2 * D + c] * (p[D + c] * p[2 * D + c]);
    if (t >= 1) z += cw[D + c] * (p[D + c - 3072] * p[2 * D + c - 3072]);
    if (t >= 2) z += cw[c] * (p[D + c - 6144] * p[2 * D + c - 6144]);
    G[idx] = (bf16_t)f2bf(p[c] * z);
}

__global__ __launch_bounds__(256) void k_headnorm(const float* __restrict__ in, int ldin, int c0, const float* __restrict__ gain, float scale, float* __restrict__ out) {
    const int row = blockIdx.x * 4 + (threadIdx.x >> 6), lane = threadIdx.x & 63;
    const f32x4* p = (const f32x4*)(in + (size_t)row * ldin + c0 + 16 * lane);
    f32x4 v[4]; float s = 0.f;
#pragma unroll
    for (int j = 0; j < 4; ++j) { v[j] = p[j]; s += v[j].x * v[j].x + v[j].y * v[j].y + v[j].z * v[j].z + v[j].w * v[j].w; }
    f32x4* o = (f32x4*)(out + (size_t)row * D + 16 * lane);
    if (gain) { s += __shfl_xor(s, 1); s += __shfl_xor(s, 2); const float rstd = rsqrtf(s * (1.f / HD) + EPS) * scale;
        const f32x4* g = (const f32x4*)(gain + 16 * (lane & 3));
#pragma unroll
        for (int j = 0; j < 4; ++j) o[j] = v[j] * rstd * g[j];
    } else {
#pragma unroll
        for (int j = 0; j < 4; ++j) o[j] = v[j]; }
}

__global__ __launch_bounds__(256) void k_attn(const float* __restrict__ Q, const float* __restrict__ Kn, const float* __restrict__ V, float* __restrict__ O0, float* __restrict__ O1) {
    __shared__ __attribute__((aligned(16))) float Ks[32][64];
    __shared__ __attribute__((aligned(16))) float Vs[32][128];
    const int qb = blockIdx.x, hc = blockIdx.y, b = blockIdx.z, h = hc >> 1, c = hc & 1, tid = threadIdx.x;
    const int qi = qb * 256 + tid; const size_t rowbase = (size_t)b * SEQ;
    float q[64], o[128];
    { const f32x4* qp = (const f32x4*)(Q + (rowbase + qi) * D + h * 128 + c * 64);
#pragma unroll
      for (int j = 0; j < 16; ++j) { const f32x4 t = qp[j]; q[4 * j] = t.x; q[4 * j + 1] = t.y; q[4 * j + 2] = t.z; q[4 * j + 3] = t.w; } }
#pragma unroll
    for (int e = 0; e < 128; ++e) o[e] = 0.f;
    float mx = -INFINITY, l = 0.f;
    const int nkt = (qb * 256 + 256) / 32;
    for (int kt = 0; kt < nkt; ++kt) {
        __syncthreads();
#pragma unroll
        for (int i = 0; i < 2; ++i) { const int f = tid + 256 * i, kr = f >> 4, kc = f & 15;
            ((f32x4*)&Ks[0][0])[f] = *(const f32x4*)(Kn + (rowbase + kt * 32 + kr) * D + h * 128 + c * 64 + 4 * kc); }
#pragma unroll
        for (int i = 0; i < 4; ++i) { const int f = tid + 256 * i, kr = f >> 5, kc = f & 31;
            ((f32x4*)&Vs[0][0])[f] = *(const f32x4*)(V + (rowbase + kt * 32 + kr) * D + h * 128 + 4 * kc); }
        __syncthreads();
        for (int kk = 0; kk < 32; ++kk) {
            const int key = kt * 32 + kk; if (key > qi) break;
            float s = 0.f;
#pragma unroll
            for (int d = 0; d < 64; ++d) s += q[d] * Ks[kk][d];
            if (s > mx) { const float al = expf(mx - s); l *= al;
#pragma unroll
                for (int e = 0; e < 128; ++e) o[e] *= al;
                mx = s; }
            const float p = expf(s - mx); l += p;
#pragma unroll
            for (int e = 0; e < 128; ++e) o[e] += p * Vs[kk][e];
        }
    }
    const float il = 1.f / l; float* op = (c ? O1 : O0) + (rowbase + qi) * D + h * 128;
#pragma unroll
    for (int e = 0; e < 128; e += 4) *(f32x4*)(op + e) = (f32x4){o[e] * il, o[e + 1] * il, o[e + 2] * il, o[e + 3] * il};
}

__global__ __launch_bounds__(256) void k_diff(const float* __restrict__ O0, const float* __restrict__ O1, const float* __restrict__ lp, const float* __restrict__ sn, bf16_t* __restrict__ out) {
    const int row = blockIdx.x * 4 + (threadIdx.x >> 6), lane = threadIdx.x & 63;
    const float s01 = wave_sum(lp[lane] * lp[64 + lane]), s23 = wave_sum(lp[128 + lane] * lp[192 + lane]);
    const float lam = expf(s01) - expf(s23) + LAM_INIT;
    const f32x4* a = (const f32x4*)(O0 + (size_t)row * D + 16 * lane); const f32x4* b = (const f32x4*)(O1 + (size_t)row * D + 16 * lane);
    f32x4 v[4]; float s = 0.f;
#pragma unroll
    for (int j = 0; j < 4; ++j) { v[j] = a[j] - b[j] * lam; s += v[j].x * v[j].x + v[j].y * v[j].y + v[j].z * v[j].z + v[j].w * v[j].w; }
    s += __shfl_xor(s, 1); s += __shfl_xor(s, 2); s += __shfl_xor(s, 4);
    const float rstd = rsqrtf(s * (1.f / VD) + EPS) * (1.f - LAM_INIT);
    const f32x4* g = (const f32x4*)(sn + 16 * (lane & 7));
    unsigned long long* o8 = (unsigned long long*)(out + (size_t)row * D + 16 * lane);
#pragma unroll
    for (int j = 0; j < 4; ++j) { const f32x4 gg = g[j];
        const unsigned x0 = f2bf(v[j].x * rstd * gg.x), x1 = f2bf(v[j].y * rstd * gg.y), x2 = f2bf(v[j].z * rstd * gg.z), x3 = f2bf(v[j].w * rstd * gg.w);
        o8[j] = (unsigned long long)(x0 | (x1 << 16)) | ((unsigned long long)(x2 | (x3 << 16)) << 32); }
}

__global__ __launch_bounds__(256) void k_router(const float* __restrict__ x, const float* __restrict__ g, const float* __restrict__ Wr, int* __restrict__ sel, float* __restrict__ gate) {
    const int row = blockIdx.x * 4 + (threadIdx.x >> 6), lane = threadIdx.x & 63;
    const f32x4* xr = (const f32x4*)(x + (size_t)row * D) + lane; const f32x4* gr = (const f32x4*)g + lane;
    f32x4 v[4]; float s = 0.f;
#pragma unroll
    for (int j = 0; j < 4; ++j) { v[j] = xr[64 * j]; s += v[j].x * v[j].x + v[j].y * v[j].y + v[j].z * v[j].z + v[j].w * v[j].w; }
    const float rstd = rsqrtf(wave_sum(s) * (1.f / D) + EPS);
    float lg[8];
#pragma unroll
    for (int e = 0; e < 8; ++e) lg[e] = 0.f;
#pragma unroll
    for (int j = 0; j < 4; ++j) { const f32x4 gg = gr[64 * j]; const float hv[4] = {v[j].x * rstd * gg.x, v[j].y * rstd * gg.y, v[j].z * rstd * gg.z, v[j].w * rstd * gg.w};
#pragma unroll
        for (int i = 0; i < 4; ++i) { const int k = 4 * (lane + 64 * j) + i; const f32x4 w0 = *(const f32x4*)(Wr + (size_t)k * 8), w1 = *(const f32x4*)(Wr + (size_t)k * 8 + 4);
            lg[0] += hv[i] * w0.x; lg[1] += hv[i] * w0.y; lg[2] += hv[i] * w0.z; lg[3] += hv[i] * w0.w; lg[4] += hv[i] * w1.x; lg[5] += hv[i] * w1.y; lg[6] += hv[i] * w1.z; lg[7] += hv[i] * w1.w; } }
#pragma unroll
    for (int e = 0; e < 8; ++e) lg[e] = wave_sum(lg[e]);
    if (lane == 0) {
        int i0 = 0; float v0 = lg[0];
#pragma unroll
        for (int e = 1; e < 8; ++e) if (lg[e] > v0) { v0 = lg[e]; i0 = e; }
        int i1 = -1; float v1 = -INFINITY;
#pragma unroll
        for (int e = 0; e < 8; ++e) if (e != i0 && lg[e] > v1) { v1 = lg[e]; i1 = e; }
        const float g1 = 1.f / (1.f + expf(v0 - v1));
        sel[2 * row] = i0; sel[2 * row + 1] = i1; gate[2 * row] = 1.f - g1; gate[2 * row + 1] = g1;
    }
}

__global__ __launch_bounds__(1024) void k_bin(const int* __restrict__ sel, int* __restrict__ slot_tok, int* __restrict__ tok_slot, int* __restrict__ gbase, int* __restrict__ gcount) {
    __shared__ int cnt[NE][1024];
    __shared__ int base[NE], tot[NE];
    const int tid = threadIdx.x;
#pragma unroll
    for (int e = 0; e < NE; ++e) cnt[e][tid] = 0;
    for (int i = 0; i < 32; ++i) { const int e = sel[tid * 32 + i]; cnt[e][tid] += 1; }
    __syncthreads();
    if (tid < NE) { int run = 0; for (int i = 0; i < 1024; ++i) { const int c = cnt[tid][i]; cnt[tid][i] = run; run += c; } tot[tid] = run; }
    __syncthreads();
    if (tid == 0) { int b = 0; for (int e = 0; e < NE; ++e) { base[e] = b; gbase[e] = b; gcount[e] = tot[e]; b += (tot[e] + 255) & ~255; } }
    __syncthreads();
    for (int i = 0; i < 32; ++i) { const int e = sel[tid * 32 + i]; const int s = base[e] + cnt[e][tid]; cnt[e][tid] += 1; slot_tok[s] = (tid * 32 + i) >> 1; tok_slot[tid * 32 + i] = s; }
    for (int e = 0; e < NE; ++e) { const int padn = ((tot[e] + 255) & ~255) - tot[e]; if (tid < padn) slot_tok[base[e] + tot[e] + tid] = 0; }
}

__global__ __launch_bounds__(256) void k_final(const float* __restrict__ x3, const float* __restrict__ Y, const int* __restrict__ tok_slot, const float* __restrict__ gate, float* __restrict__ out) {
    const int idx = blockIdx.x * 256 + threadIdx.x; const int row = idx >> 8, c4 = idx & 255;
    const int s0 = tok_slot[2 * row], s1 = tok_slot[2 * row + 1]; const float g0 = gate[2 * row], g1 = gate[2 * row + 1];
    const f32x4 a = ((const f32x4*)x3)[idx], y0 = ((const f32x4*)(Y + (size_t)s0 * D))[c4], y1 = ((const f32x4*)(Y + (size_t)s1 * D))[c4];
    ((f32x4*)out)[idx] = a + y0 * g0 + y1 * g1;
}

extern "C" void kernel_launch(void* const* d_in, const int* in_sizes, int n_in, void* d_out, int out_size, void* d_ws, size_t ws_size, hipStream_t stream) {
    const float* x = (const float*)d_in[0]; const float* ln_mix = (const float*)d_in[1]; const float* ln_ffn = (const float*)d_in[2];
    const float* conv_w_in = (const float*)d_in[3]; const float* conv_w = (const float*)d_in[4]; const float* conv_w_out = (const float*)d_in[5];
    const float* ln_kv = (const float*)d_in[6]; const float* w_kv = (const float*)d_in[7]; const float* k_norm = (const float*)d_in[8];
    const float* attn_w_q = (const float*)d_in[9]; const float* q_norm = (const float*)d_in[10]; const float* lam_params = (const float*)d_in[11];
    const float* sub_norm = (const float*)d_in[12]; const float* attn_w_o = (const float*)d_in[13]; const float* ffn_w_gu = (const float*)d_in[14];
    const float* ffn_w_down = (const float*)d_in[15]; const float* router_w = (const float*)d_in[16]; const float* moe_w_gu = (const float*)d_in[17];
    const float* moe_w_down = (const float*)d_in[18];
    float* out = (float*)d_out;
    unsigned char* ws = (unsigned char*)d_ws; size_t off = 0;
    auto alloc = [&](size_t bytes) { void* p = ws + off; off += (bytes + 255) & ~(size_t)255; return p; };
    bf16_t* Wt_in = (bf16_t*)alloc((size_t)3072 * D * 2); bf16_t* Wt_out = (bf16_t*)alloc((size_t)D * D * 2); bf16_t* Wt_kv = (bf16_t*)alloc((size_t)2048 * D * 2);
    bf16_t* Wt_q = (bf16_t*)alloc((size_t)D * D * 2); bf16_t* Wt_o = (bf16_t*)alloc((size_t)D * D * 2); bf16_t* Wt_gu = (bf16_t*)alloc((size_t)2 * DFF * D * 2);
    bf16_t* Wt_dn = (bf16_t*)alloc((size_t)D * DFF * 2); bf16_t* Wt_mgu = (bf16_t*)alloc((size_t)NE * 2 * DFE * D * 2); bf16_t* Wt_mdn = (bf16_t*)alloc((size_t)NE * D * DFE * 2);
    bf16_t* HB = (bf16_t*)alloc((size_t)M * D * 2); bf16_t* HB2 = (bf16_t*)alloc((size_t)M * D * 2);
    unsigned char* U = (unsigned char*)alloc((size_t)SLOTS * DFE * 2);
    unsigned char* Vr = (unsigned char*)alloc((size_t)3 * M * D * 4);
    float* F1 = (float*)U; bf16_t* Hact = (bf16_t*)U; float* O0 = (float*)U; float* O1 = O0 + (size_t)M * D;
    float* Qn = (float*)Vr; float* Kn = Qn + (size_t)M * D; float* Vn = Kn + (size_t)M * D; float* Ymoe = (float*)Vr;
    float* Yf = (float*)alloc((size_t)M * D * 4);
    float* X1 = (float*)alloc((size_t)M * D * 4); float* X2 = (float*)alloc((size_t)M * D * 4); float* X3 = X1;
    int* sel = (int*)alloc((size_t)M * 2 * 4); float* gate = (float*)alloc((size_t)M * 2 * 4); int* slot_tok = (int*)alloc((size_t)SLOTS * 4); int* tok_slot = (int*)alloc((size_t)M * 2 * 4);
    int* gbase = (int*)alloc(64); int* gcount = (int*)alloc(64);
    if (off > ws_size) { fprintf(stderr, "kernel_launch: workspace too small: need %zu, have %zu\n", off, ws_size); return; }

    k_wt<<<dim3(3072 / 32, D / 32, 1), 256, 0, stream>>>(conv_w_in, Wt_in, D, 3072);
    k_wt<<<dim3(D / 32, D / 32, 1), 256, 0, stream>>>(conv_w_out, Wt_out, D, D);
    k_wt<<<dim3(2048 / 32, D / 32, 1), 256, 0, stream>>>(w_kv, Wt_kv, D, 2048);
    k_wt<<<dim3(D / 32, D / 32, 1), 256, 0, stream>>>(attn_w_q, Wt_q, D, D);
    k_wt<<<dim3(D / 32, D / 32, 1), 256, 0, stream>>>(attn_w_o, Wt_o, D, D);
    k_wt<<<dim3(2 * DFF / 32, D / 32, 1), 256, 0, stream>>>(ffn_w_gu, Wt_gu, D, 2 * DFF);
    k_wt<<<dim3(D / 32, DFF / 32, 1), 256, 0, stream>>>(ffn_w_down, Wt_dn, DFF, D);
    k_wt<<<dim3(2 * DFE / 32, D / 32, NE), 256, 0, stream>>>(moe_w_gu, Wt_mgu, D, 2 * DFE);
    k_wt<<<dim3(D / 32, DFE / 32, NE), 256, 0, stream>>>(moe_w_down, Wt_mdn, DFE, D);

    k_rmsnorm<<<M / 4, 256, 0, stream>>>(x, ln_mix, HB);
    k_gemm<0><<<dim3(3072 / 64, M / 64, 1), 256, 0, stream>>>(HB, D, Wt_in, D, F1, 3072, M, D, 0, nullptr, nullptr, nullptr, 0);
    k_conv<<<M * D / 256, 256, 0, stream>>>(F1, conv_w, HB2);
    k_gemm<0><<<dim3(D / 64, M / 64, 1), 256, 0, stream>>>(HB2, D, Wt_out, D, Yf, D, M, D, 0, nullptr, nullptr, nullptr, 0);
    k_resid_norm<<<M / 4, 256, 0, stream>>>(x, Yf, X1, ln_ffn, HB, nullptr, nullptr);
    k_gemm<1><<<dim3(DFF / 64, M / 64, 1), 256, 0, stream>>>(HB, D, Wt_gu, D, Hact, DFF, M, D, DFF, nullptr, nullptr, nullptr, 0);
    k_gemm<0><<<dim3(D / 64, M / 64, 1), 256, 0, stream>>>(Hact, DFF, Wt_dn, DFF, Yf, D, M, DFF, 0, nullptr, nullptr, nullptr, 0);
    k_resid_norm<<<M / 4, 256, 0, stream>>>(X1, Yf, X2, ln_kv, HB, ln_mix + D, HB2);
    k_gemm<0><<<dim3(2048 / 64, M / 64, 1), 256, 0, stream>>>(HB, D, Wt_kv, D, F1, 2048, M, D, 0, nullptr, nullptr, nullptr, 0);
    k_headnorm<<<M / 4, 256, 0, stream>>>(F1, 2048, 0, k_norm, 1.f, Kn);
    k_headnorm<<<M / 4, 256, 0, stream>>>(F1, 2048, 1024, nullptr, 1.f, Vn);
    k_gemm<0><<<dim3(D / 64, M / 64, 1), 256, 0, stream>>>(HB2, D, Wt_q, D, Yf, D, M, D, 0, nullptr, nullptr, nullptr, 0);
    k_headnorm<<<M / 4, 256, 0, stream>>>(Yf, D, 0, q_norm, 0.125f, Qn);
    k_attn<<<dim3(SEQ / 256, 2 * NH, BATCH), 256, 0, stream>>>(Qn, Kn, Vn, O0, O1);
    k_diff<<<M / 4, 256, 0, stream>>>(O0, O1, lam_params, sub_norm, HB);
    k_gemm<0><<<dim3(D / 64, M / 64, 1), 256, 0, stream>>>(HB, D, Wt_o, D, Yf, D, M, D, 0, nullptr, nullptr, nullptr, 0);
    k_resid_norm<<<M / 4, 256, 0, stream>>>(X2, Yf, X3, ln_ffn + D, HB, nullptr, nullptr);
    k_router<<<M / 4, 256, 0, stream>>>(X3, ln_ffn + D, router_w, sel, gate);
    k_bin<<<1, 1024, 0, stream>>>(sel, slot_tok, tok_slot, gbase, gcount);
    k_gemm<1><<<dim3(DFE / 64, M / 64, NE), 256, 0, stream>>>(HB, D, Wt_mgu, D, Hact, DFE, 0, D, DFE, slot_tok, gbase, gcount, (size_t)2 * DFE * D);
    k_gemm<0><<<dim3(D / 64, M / 64, NE), 256, 0, stream>>>(Hact, DFE, Wt_mdn, DFE, Ymoe, D, 0, DFE, 0, nullptr, gbase, gcount, (size_t)D * DFE);
    k_final<<<M * D / 4 / 256, 256, 0, stream>>>(X3, Ymoe, tok_slot, gate, out);
}
```

```cpp
#include <hip/hip_runtime.h>
#include <hip/hip_bf16.h>
#include <stdint.h>
#include <stdio.h>
#include <cmath>
#define MEGA_UPTO 15
#define MEGA_ONE 1
typedef unsigned short bf16_t;
typedef short bf16x8 __attribute__((ext_vector_type(8)));
typedef float f32x4 __attribute__((ext_vector_type(4)));
constexpr int D = 1024, BATCH = 8, SEQ = 2048, M = BATCH * SEQ;
constexpr int NH = 8, HD = 64, VD = 128;
constexpr int DFF = 2816, NE = 8, DFE = 3584;
constexpr float EPS = 1e-6f;
constexpr float LAM_INIT = 0.35550907f;
constexpr int SLOTS = 2 * M + NE * 256;

__device__ __forceinline__ unsigned f2bf(float f) { unsigned u = __builtin_bit_cast(unsigned, f); return (u + 0x7fffu + ((u >> 16) & 1u)) >> 16; }
__device__ __forceinline__ float bf2f(unsigned short b) { return __builtin_bit_cast(float, (unsigned)b << 16); }
__device__ __forceinline__ float wave_sum(float v) {
#pragma unroll
    for (int o = 1; o < 64; o <<= 1) v += __shfl_xor(v, o);
    return v;
}

__global__ __launch_bounds__(256) void k_wt(const float* __restrict__ W, bf16_t* __restrict__ Bt, int K, int N) {
    __shared__ float t[32][33];
    const float* w = W + (size_t)blockIdx.z * K * N; bf16_t* o = Bt + (size_t)blockIdx.z * K * N;
    const int n0 = blockIdx.x * 32, k0 = blockIdx.y * 32, tx = threadIdx.x & 31, ty = threadIdx.x >> 5;
#pragma unroll
    for (int i = 0; i < 4; ++i) t[ty + 8 * i][tx] = w[(size_t)(k0 + ty + 8 * i) * N + n0 + tx];
    __syncthreads();
#pragma unroll
    for (int i = 0; i < 4; ++i) o[(size_t)(n0 + ty + 8 * i) * K + k0 + tx] = (bf16_t)f2bf(t[tx][ty + 8 * i]);
}

__global__ __launch_bounds__(256) void k_rmsnorm(const float* __restrict__ x, const float* __restrict__ g, bf16_t* __restrict__ out) {
    const int row = blockIdx.x * 4 + (threadIdx.x >> 6), lane = threadIdx.x & 63;
    const f32x4* xr = (const f32x4*)(x + (size_t)row * D) + lane; const f32x4* gr = (const f32x4*)g + lane;
    f32x4 v[4]; float s = 0.f;
#pragma unroll
    for (int j = 0; j < 4; ++j) { v[j] = xr[64 * j]; s += v[j].x * v[j].x + v[j].y * v[j].y + v[j].z * v[j].z + v[j].w * v[j].w; }
    const float rstd = rsqrtf(wave_sum(s) * (1.f / D) + EPS);
    unsigned long long* o8 = (unsigned long long*)(out + (size_t)row * D) + lane;
#pragma unroll
    for (int j = 0; j < 4; ++j) { const f32x4 gg = gr[64 * j];
        const unsigned a = f2bf(v[j].x * rstd * gg.x), b = f2bf(v[j].y * rstd * gg.y), c = f2bf(v[j].z * rstd * gg.z), d = f2bf(v[j].w * rstd * gg.w);
        o8[64 * j] = (unsigned long long)(a | (b << 16)) | ((unsigned long long)(c | (d << 16)) << 32); }
}

__global__ __launch_bounds__(256) void k_resid_norm(const float* __restrict__ xold, const float* __restrict__ y, float* __restrict__ xnew,
                                                    const float* __restrict__ g1, bf16_t* __restrict__ o1, const float* __restrict__ g2, bf16_t* __restrict__ o2) {
    const int row = blockIdx.x * 4 + (threadIdx.x >> 6), lane = threadIdx.x & 63;
    const f32x4* xr = (const f32x4*)(xold + (size_t)row * D) + lane; const f32x4* yr = (const f32x4*)(y + (size_t)row * D) + lane;
    f32x4* xo = (f32x4*)(xnew + (size_t)row * D) + lane;
    f32x4 v[4]; float s = 0.f;
#pragma unroll
    for (int j = 0; j < 4; ++j) { v[j] = xr[64 * j] + yr[64 * j]; xo[64 * j] = v[j]; s += v[j].x * v[j].x + v[j].y * v[j].y + v[j].z * v[j].z + v[j].w * v[j].w; }
    const float rstd = rsqrtf(wave_sum(s) * (1.f / D) + EPS);
#pragma unroll
    for (int p = 0; p < 2; ++p) { const float* g = p ? g2 : g1; bf16_t* o = p ? o2 : o1; if (!o) continue;
        const f32x4* gr = (const f32x4*)g + lane; unsigned long long* o8 = (unsigned long long*)(o + (size_t)row * D) + lane;
#pragma unroll
        for (int j = 0; j < 4; ++j) { const f32x4 gg = gr[64 * j];
            const unsigned a = f2bf(v[j].x * rstd * gg.x), b = f2bf(v[j].y * rstd * gg.y), c = f2bf(v[j].z * rstd * gg.z), d = f2bf(v[j].w * rstd * gg.w);
            o8[64 * j] = (unsigned long long)(a | (b << 16)) | ((unsigned long long)(c | (d << 16)) << 32); } }
}

template <int MODE>
__global__ __launch_bounds__(256) void k_gemm(const bf16_t* __restrict__ A, int lda, const bf16_t* __restrict__ Bt, int ldb, void* __restrict__ Cv, int ldc,
                                               int Mtot, int K, int dualOff, const int* __restrict__ arow, const int* __restrict__ gbase, const int* __restrict__ gcount, size_t bstride) {
    const int z = blockIdx.z; int start = 0, count = Mtot;
    if (gbase) { start = gbase[z]; count = gcount[z]; Bt += (size_t)z * bstride; }
    const int mt0 = blockIdx.y * 64; if (mt0 >= count) return;
    const int n0 = blockIdx.x * 64, w = threadIdx.x >> 6, lane = threadIdx.x & 63, r = lane & 15, q = lane >> 4;
    int ml = mt0 + 16 * w + r; if (ml >= count) ml = count - 1;
    const int mrow = start + ml; const int ar = arow ? arow[mrow] : mrow;
    const bf16_t* ap = A + (size_t)ar * lda + 8 * q;
    const bf16_t* bp = Bt + (size_t)(n0 + r) * ldb + 8 * q;
    f32x4 acc[4], acc2[4];
#pragma unroll
    for (int j = 0; j < 4; ++j) { acc[j] = (f32x4){0.f, 0.f, 0.f, 0.f}; acc2[j] = (f32x4){0.f, 0.f, 0.f, 0.f}; }
    for (int k0 = 0; k0 < K; k0 += 32) {
        const bf16x8 a = *(const bf16x8*)(ap + k0);
#pragma unroll
        for (int j = 0; j < 4; ++j) { const bf16x8 b = *(const bf16x8*)(bp + (size_t)(16 * j) * ldb + k0);
            acc[j] = __builtin_amdgcn_mfma_f32_16x16x32_bf16(a, b, acc[j], 0, 0, 0);
            if (MODE == 1) { const bf16x8 b2 = *(const bf16x8*)(bp + (size_t)(16 * j + dualOff) * ldb + k0);
                acc2[j] = __builtin_amdgcn_mfma_f32_16x16x32_bf16(a, b2, acc2[j], 0, 0, 0); } }
    }
#pragma unroll
    for (int j = 0; j < 4; ++j)
#pragma unroll
        for (int i = 0; i < 4; ++i) { const int mo = mt0 + 16 * w + 4 * q + i; if (mo >= count) continue;
            const size_t off = (size_t)(start + mo) * ldc + n0 + 16 * j + r;
            if (MODE == 0) ((float*)Cv)[off] = acc[j][i];
            else { const float g = acc[j][i], u = acc2[j][i]; ((bf16_t*)Cv)[off] = (bf16_t)f2bf(g / (1.f + expf(-g)) * u); } }
}

__global__ __launch_bounds__(256) void k_conv(const float* __restrict__ bcv, const float* __restrict__ cw, bf16_t* __restrict__ G) {
    const int idx = blockIdx.x * 256 + threadIdx.x; const int row = idx >> 10, c = idx & 1023, t = row & (SEQ - 1);
    const float* p = bcv + (size_t)row * 3072;
    float z = cw[2 * D + c] * (p[D + c] * p[2 * D + c]);
    if (t >= 1) z += cw[D + c] * (p[D + c - 3072] * p[2 * D + c - 3072]);
    if (t >= 2) z += cw[c] * (p[D + c - 6144] * p[2 * D + c - 6144]);
    G[idx] = (bf16_t)f2bf(p[c] * z);
}

__global__ __launch_bounds__(256) void k_headnorm(const float* __restrict__ in, int ldin, int c0, const float* __restrict__ gain, float scale, float* __restrict__ out) {
    const int row = blockIdx.x * 4 + (threadIdx.x >> 6), lane = threadIdx.x & 63;
    const f32x4* p = (const f32x4*)(in + (size_t)row * ldin + c0 + 16 * lane);
    f32x4 v[4]; float s = 0.f;
#pragma unroll
    for (int j = 0; j < 4; ++j) { v[j] = p[j]; s += v[j].x * v[j].x + v[j].y * v[j].y + v[j].z * v[j].z + v[j].w * v[j].w; }
    f32x4* o = (f32x4*)(out + (size_t)row * D + 16 * lane);
    if (gain) { s += __shfl_xor(s, 1); s += __shfl_xor(s, 2); const float rstd = rsqrtf(s * (1.f / HD) + EPS) * scale;
        const f32x4* g = (const f32x4*)(gain + 16 * (lane & 3));
#pragma unroll
        for (int j = 0; j < 4; ++j) o[j] = v[j] * rstd * g[j];
    } else {
#pragma unroll
        for (int j = 0; j < 4; ++j) o[j] = v[j]; }
}

__device__ __forceinline__ f32x4 ld4(const float* p) { return *(const f32x4*)p; }
__device__ __forceinline__ f32x4 ld4(const bf16_t* p) { const unsigned long long w = *(const unsigned long long*)p; return (f32x4){bf2f((unsigned short)w), bf2f((unsigned short)(w >> 16)), bf2f((unsigned short)(w >> 32)), bf2f((unsigned short)(w >> 48))}; }
template <typename T>
__global__ __launch_bounds__(256) void k_attn(const T* __restrict__ Q, const T* __restrict__ Kn, const T* __restrict__ V, float* __restrict__ O0, float* __restrict__ O1, float qmul) {
    __shared__ __attribute__((aligned(16))) float Ks[32][64];
    __shared__ __attribute__((aligned(16))) float Vs[32][128];
    const int qb = blockIdx.x, hc = blockIdx.y, b = blockIdx.z, h = hc >> 1, c = hc & 1, tid = threadIdx.x;
    const int qi = qb * 256 + tid; const size_t rowbase = (size_t)b * SEQ;
    float q[64], o[128];
    { const T* qp = Q + (rowbase + qi) * D + h * 128 + c * 64;
#pragma unroll
      for (int j = 0; j < 16; ++j) { const f32x4 t = ld4(qp + 4 * j); q[4 * j] = t.x * qmul; q[4 * j + 1] = t.y * qmul; q[4 * j + 2] = t.z * qmul; q[4 * j + 3] = t.w * qmul; } }
#pragma unroll
    for (int e = 0; e < 128; ++e) o[e] = 0.f;
    float mx = -INFINITY, l = 0.f;
    const int nkt = (qb * 256 + 256) / 32;
    for (int kt = 0; kt < nkt; ++kt) {
        __syncthreads();
#pragma unroll
        for (int i = 0; i < 2; ++i) { const int f = tid + 256 * i, kr = f >> 4, kc = f & 15;
            ((f32x4*)&Ks[0][0])[f] = ld4(Kn + (rowbase + kt * 32 + kr) * D + h * 128 + c * 64 + 4 * kc); }
#pragma unroll
        for (int i = 0; i < 4; ++i) { const int f = tid + 256 * i, kr = f >> 5, kc = f & 31;
            ((f32x4*)&Vs[0][0])[f] = ld4(V + (rowbase + kt * 32 + kr) * D + h * 128 + 4 * kc); }
        __syncthreads();
        for (int kk = 0; kk < 32; ++kk) {
            const int key = kt * 32 + kk; if (key > qi) break;
            float s = 0.f;
#pragma unroll
            for (int d = 0; d < 64; ++d) s += q[d] * Ks[kk][d];
            if (s > mx) { const float al = expf(mx - s); l *= al;
#pragma unroll
                for (int e = 0; e < 128; ++e) o[e] *= al;
                mx = s; }
            const float p = expf(s - mx); l += p;
#pragma unroll
            for (int e = 0; e < 128; ++e) o[e] += p * Vs[kk][e];
        }
    }
    const float il = 1.f / l; float* op = (c ? O1 : O0) + (rowbase + qi) * D + h * 128;
#pragma unroll
    for (int e = 0; e < 128; e += 4) *(f32x4*)(op + e) = (f32x4){o[e] * il, o[e + 1] * il, o[e + 2] * il, o[e + 3] * il};
}

__global__ __launch_bounds__(256) void k_diff(const float* __restrict__ O0, const float* __restrict__ O1, const float* __restrict__ lp, const float* __restrict__ sn, bf16_t* __restrict__ out) {
    const int row = blockIdx.x * 4 + (threadIdx.x >> 6), lane = threadIdx.x & 63;
    const float s01 = wave_sum(lp[lane] * lp[64 + lane]), s23 = wave_sum(lp[128 + lane] * lp[192 + lane]);
    const float lam = expf(s01) - expf(s23) + LAM_INIT;
    const f32x4* a = (const f32x4*)(O0 + (size_t)row * D + 16 * lane); const f32x4* b = (const f32x4*)(O1 + (size_t)row * D + 16 * lane);
    f32x4 v[4]; float s = 0.f;
#pragma unroll
    for (int j = 0; j < 4; ++j) { v[j] = a[j] - b[j] * lam; s += v[j].x * v[j].x + v[j].y * v[j].y + v[j].z * v[j].z + v[j].w * v[j].w; }
    s += __shfl_xor(s, 1); s += __shfl_xor(s, 2); s += __shfl_xor(s, 4);
    const float rstd = rsqrtf(s * (1.f / VD) + EPS) * (1.f - LAM_INIT);
    const f32x4* g = (const f32x4*)(sn + 16 * (lane & 7));
    unsigned long long* o8 = (unsigned long long*)(out + (size_t)row * D + 16 * lane);
#pragma unroll
    for (int j = 0; j < 4; ++j) { const f32x4 gg = g[j];
        const unsigned x0 = f2bf(v[j].x * rstd * gg.x), x1 = f2bf(v[j].y * rstd * gg.y), x2 = f2bf(v[j].z * rstd * gg.z), x3 = f2bf(v[j].w * rstd * gg.w);
        o8[j] = (unsigned long long)(x0 | (x1 << 16)) | ((unsigned long long)(x2 | (x3 << 16)) << 32); }
}

__global__ __launch_bounds__(256) void k_router(const float* __restrict__ x, const float* __restrict__ g, const float* __restrict__ Wr, int* __restrict__ sel, float* __restrict__ gate) {
    const int row = blockIdx.x * 4 + (threadIdx.x >> 6), lane = threadIdx.x & 63;
    const f32x4* xr = (const f32x4*)(x + (size_t)row * D) + lane; const f32x4* gr = (const f32x4*)g + lane;
    f32x4 v[4]; float s = 0.f;
#pragma unroll
    for (int j = 0; j < 4; ++j) { v[j] = xr[64 * j]; s += v[j].x * v[j].x + v[j].y * v[j].y + v[j].z * v[j].z + v[j].w * v[j].w; }
    const float rstd = rsqrtf(wave_sum(s) * (1.f / D) + EPS);
    float lg[8];
#pragma unroll
    for (int e = 0; e < 8; ++e) lg[e] = 0.f;
#pragma unroll
    for (int j = 0; j < 4; ++j) { const f32x4 gg = gr[64 * j]; const float hv[4] = {v[j].x * rstd * gg.x, v[j].y * rstd * gg.y, v[j].z * rstd * gg.z, v[j].w * rstd * gg.w};
#pragma unroll
        for (int i = 0; i < 4; ++i) { const int k = 4 * (lane + 64 * j) + i; const f32x4 w0 = *(const f32x4*)(Wr + (size_t)k * 8), w1 = *(const f32x4*)(Wr + (size_t)k * 8 + 4);
            lg[0] += hv[i] * w0.x; lg[1] += hv[i] * w0.y; lg[2] += hv[i] * w0.z; lg[3] += hv[i] * w0.w; lg[4] += hv[i] * w1.x; lg[5] += hv[i] * w1.y; lg[6] += hv[i] * w1.z; lg[7] += hv[i] * w1.w; } }
#pragma unroll
    for (int e = 0; e < 8; ++e) lg[e] = wave_sum(lg[e]);
    if (lane == 0) {
        int i0 = 0; float v0 = lg[0];
#pragma unroll
        for (int e = 1; e < 8; ++e) if (lg[e] > v0) { v0 = lg[e]; i0 = e; }
        int i1 = -1; float v1 = -INFINITY;
#pragma unroll
        for (int e = 0; e < 8; ++e) if (e != i0 && lg[e] > v1) { v1 = lg[e]; i1 = e; }
        const float g1 = 1.f / (1.f + expf(v0 - v1));
        sel[2 * row] = i0; sel[2 * row + 1] = i1; gate[2 * row] = 1.f - g1; gate[2 * row + 1] = g1;
    }
}

__global__ __launch_bounds__(1024) void k_bin(const int* __restrict__ sel, int* __restrict__ slot_tok, int* __restrict__ tok_slot, int* __restrict__ gbase, int* __restrict__ gcount) {
    __shared__ int cnt[NE][1024];
    __shared__ int base[NE], tot[NE];
    const int tid = threadIdx.x;
#pragma unroll
    for (int e = 0; e < NE; ++e) cnt[e][tid] = 0;
    for (int i = 0; i < 32; ++i) { const int e = sel[tid * 32 + i]; cnt[e][tid] += 1; }
    __syncthreads();
    if (tid < NE) { int run = 0; for (int i = 0; i < 1024; ++i) { const int c = cnt[tid][i]; cnt[tid][i] = run; run += c; } tot[tid] = run; }
    __syncthreads();
    if (tid == 0) { int b = 0; for (int e = 0; e < NE; ++e) { base[e] = b; gbase[e] = b; gcount[e] = tot[e]; b += (tot[e] + 255) & ~255; } }
    __syncthreads();
    for (int i = 0; i < 32; ++i) { const int e = sel[tid * 32 + i]; const int s = base[e] + cnt[e][tid]; cnt[e][tid] += 1; slot_tok[s] = (tid * 32 + i) >> 1; tok_slot[tid * 32 + i] = s; }
    for (int e = 0; e < NE; ++e) { const int padn = ((tot[e] + 255) & ~255) - tot[e]; if (tid < padn) slot_tok[base[e] + tot[e] + tid] = 0; }
}

__global__ __launch_bounds__(256) void k_final(const float* __restrict__ x3, const float* __restrict__ Y, const int* __restrict__ tok_slot, const float* __restrict__ gate, float* __restrict__ out) {
    const int idx = blockIdx.x * 256 + threadIdx.x; const int row = idx >> 8, c4 = idx & 255;
    const int s0 = tok_slot[2 * row], s1 = tok_slot[2 * row + 1]; const float g0 = gate[2 * row], g1 = gate[2 * row + 1];
    const f32x4 a = ((const f32x4*)x3)[idx], y0 = ((const f32x4*)(Y + (size_t)s0 * D))[c4], y1 = ((const f32x4*)(Y + (size_t)s1 * D))[c4];
    ((f32x4*)out)[idx] = a + y0 * g0 + y1 * g1;
}

namespace pg8 {
#define PG8_LAS __attribute__((address_space(3)))
typedef unsigned short bf16_t;
typedef short bf16x8 __attribute__((ext_vector_type(8)));
typedef float f32x4 __attribute__((ext_vector_type(4)));
typedef unsigned u32x4 __attribute__((ext_vector_type(4)));
constexpr int BM = 256, BK = 64, HALF = 128, HTB = HALF * BK * 2  , STAGE_BYTES = 8 * HTB, NXCD = 8, WGM = 8;

__host__ __device__ __forceinline__ int lds_byte(int r, int c) { const int st = (r >> 4) * 2 + (c >> 5), rr = r & 15, cc = c & 31, ob = rr * 64 + cc * 2; return st * 1024 + (ob ^ (((ob >> 9) & 1) << 5)); }
__host__ __device__ __forceinline__ void stage_rc(int b, int& R, int& C) { const int st = b / 1024, sb = b % 1024, swz = sb ^ (((sb >> 9) & 1) << 5); R = (st >> 1) * 16 + swz / 64; C = (st & 1) * 32 + (swz % 64) / 2; }
__host__ __device__ __forceinline__ int perm32(int rho) { const int n = rho >> 4, i = rho & 15; return 8 * (i >> 2) + 4 * n + (i & 3); }

struct Unit { int pm, pn; };
struct Gemm { const bf16_t* A; const bf16_t* Bt; int M, N, K; };

struct StaticOrder {
    int nM, nN, nwg, G, c;
    __host__ __device__ void init(int M, int N, int G_, int c_) { nM = M / BM; nN = N / BM; nwg = nM * nN; G = G_; c = c_; }
    __host__ __device__ bool next(int i, Unit& u) const {
        const long L = (long)i * G + c; if (L >= nwg) return false;
        int wgid = (int)L; { const int q = nwg / NXCD, r = nwg % NXCD, xcd = wgid % NXCD, off = wgid / NXCD; wgid = (xcd < r ? xcd * (q + 1) : r * (q + 1) + (xcd - r) * q) + off; }
        const int nig = WGM * nN, gid = wgid / nig, fm = gid * WGM, gsz = (nM - fm) < WGM ? (nM - fm) : WGM;
        u.pm = fm + ((wgid % nig) % gsz); u.pn = (wgid % nig) / gsz; return true;
    }
    __device__ __forceinline__ void a_ready(const Unit&) const {}
    __device__ __forceinline__ void done(const Unit&) const {}
};

__device__ __forceinline__ unsigned cvt_pk_bf16(float lo, float hi) { unsigned r; asm volatile("v_cvt_pk_bf16_f32 %0, %1, %2" : "=v"(r) : "v"(lo), "v"(hi)); return r; }
typedef float f32x2 __attribute__((ext_vector_type(2)));
typedef unsigned u32x2 __attribute__((ext_vector_type(2)));
constexpr float RMS_EPS = 1e-6f, LOG2E = 1.4426950408889634f;
constexpr int DM_ = 1024;
__device__ __forceinline__ u32x4 pack8(const f32x4 a, const f32x4 b) { u32x4 w; w.x = cvt_pk_bf16(a[0], a[1]); w.y = cvt_pk_bf16(a[2], a[3]); w.z = cvt_pk_bf16(b[0], b[1]); w.w = cvt_pk_bf16(b[2], b[3]); return w; }
__device__ __forceinline__ float rstd_of(const float* ssq, int row) { const f32x4 p = *(const f32x4*)(ssq + (size_t)row * 4); return __builtin_amdgcn_rsqf(((p[0] + p[1]) + (p[2] + p[3])) * (1.0f / 1024.0f) + RMS_EPS); }
__device__ __forceinline__ float silu_mul(float g, float u) { return g * u * __builtin_amdgcn_rcpf(1.0f + __builtin_amdgcn_exp2f(-g * LOG2E)); }

struct EpiInProj {
    static constexpr bool PERM = true, AFTER_DRAIN = false;
    bf16_t* Bb; bf16_t* Ub;
    __device__ __forceinline__ void operator()(const f32x4 (&acc)[2][2][4][2], const Unit& u, int wr, int wc, int fr, int fq) const {
        const int row0 = u.pm * BM + wr * 64 + fr;
        if (u.pn < 4) {
            const int col0 = u.pn * BM + wc * 32 + 8 * fq;
#pragma unroll
            for (int ai = 0; ai < 2; ++ai)
#pragma unroll
                for (int m = 0; m < 4; ++m) { bf16_t* rowp = Bb + (size_t)(row0 + ai * HALF + m * 16) * DM_ + col0;
#pragma unroll
                    for (int bj = 0; bj < 2; ++bj) *(u32x4*)(rowp + bj * HALF) = pack8(acc[ai][bj][m][0], acc[ai][bj][m][1]); }
        } else {
            const int col0 = (u.pn - 4) * 128 + wc * 32 + 8 * fq;
#pragma unroll
            for (int ai = 0; ai < 2; ++ai)
#pragma unroll
                for (int m = 0; m < 4; ++m) { bf16_t* rowp = Ub + (size_t)(row0 + ai * HALF + m * 16) * DM_ + col0;
                    *(u32x4*)rowp = pack8(acc[ai][0][m][0] * acc[ai][1][m][0], acc[ai][0][m][1] * acc[ai][1][m][1]); }
        }
    }
};

struct EpiResidSsq {
    static constexpr bool PERM = false, AFTER_DRAIN = true;
    const float* xold; float* xnew; bf16_t* xb; float* ssq;
    __device__ __forceinline__ void fused(f32x4 (&acc)[2][2][4][2], const Unit& u, int wr, int wc, int fr, int fq, PG8_LAS unsigned char* lds, int wid, int lane) const {
        PG8_LAS float* P = (PG8_LAS float*)lds;
        const int col0 = u.pn * BM + wc * 32 + 4 * fq;
#pragma unroll
        for (int ai = 0; ai < 2; ++ai)
#pragma unroll
            for (int m = 0; m < 4; ++m) { const int r = ai * HALF + wr * 64 + m * 16 + fr; const size_t off = (size_t)(u.pm * BM + r) * DM_ + col0; float s = 0.f;
#pragma unroll
                for (int bj = 0; bj < 2; ++bj)
#pragma unroll
                    for (int n = 0; n < 2; ++n) { const f32x4 v = *(const f32x4*)(xold + off + bj * HALF + n * 16) + acc[ai][bj][m][n];
                        *(f32x4*)(xnew + off + bj * HALF + n * 16) = v;
                        u32x2 w; w.x = cvt_pk_bf16(v[0], v[1]); w.y = cvt_pk_bf16(v[2], v[3]); *(u32x2*)(xb + off + bj * HALF + n * 16) = w;
                        s += (v[0] * v[0] + v[1] * v[1]) + (v[2] * v[2] + v[3] * v[3]); }
                s += __shfl_xor(s, 16); s += __shfl_xor(s, 32);
                if (fq == 0) P[r * 4 + wc] = s;
                if (m & 1) asm volatile("" ::: "memory"); }
        asm volatile("s_waitcnt lgkmcnt(0)" ::: "memory"); __builtin_amdgcn_s_barrier(); asm volatile("" ::: "memory");
        const int t = wid * 64 + lane;
        if (t < 256) { const PG8_LAS f32x4* Pr = (const PG8_LAS f32x4*)lds; const f32x4 p = Pr[t]; ssq[(size_t)(u.pm * BM + t) * 4 + u.pn] = (p[0] + p[1]) + (p[2] + p[3]); }
        asm volatile("s_waitcnt lgkmcnt(0)" ::: "memory"); __builtin_amdgcn_s_barrier(); asm volatile("" ::: "memory");
    }
};

struct EpiSwiGLU {
    static constexpr bool PERM = true, AFTER_DRAIN = false;
    bf16_t* H; int ldh; const float* ssq; const float* rstd; int ncol;
    __device__ __forceinline__ void operator()(const f32x4 (&acc)[2][2][4][2], const Unit& u, int wr, int wc, int fr, int fq) const {
        const int row0 = u.pm * BM + wr * 64 + fr, col0 = (u.pn % ncol) * 128 + wc * 32 + 8 * fq;
#pragma unroll
        for (int ai = 0; ai < 2; ++ai)
#pragma unroll
            for (int m = 0; m < 4; ++m) { const int row = row0 + ai * HALF + m * 16; const float rs = ssq ? rstd_of(ssq, row) : rstd[row];
                f32x4 h[2];
#pragma unroll
                for (int n = 0; n < 2; ++n) { const f32x4 g = acc[ai][0][m][n] * rs, uu = acc[ai][1][m][n] * rs;
#pragma unroll
                    for (int j = 0; j < 4; ++j) h[n][j] = silu_mul(g[j], uu[j]); }
                *(u32x4*)(H + (size_t)row * ldh + col0) = pack8(h[0], h[1]); }
    }
};

struct EpiQKV {
    static constexpr bool PERM = true, AFTER_DRAIN = false;
    bf16_t *Q, *K, *V; const float* ssq; const float* qg; const float* kg; float qscale;
    __device__ __forceinline__ void operator()(const f32x4 (&acc)[2][2][4][2], const Unit& u, int wr, int wc, int fr, int fq) const {
        const int row0 = u.pm * BM + wr * 64 + fr;
        if (u.pn < 8) {
            const bool isq = u.pn < 4; bf16_t* base = isq ? Q : K; const float* gn = isq ? qg : kg; const float sc = isq ? qscale : 1.0f;
            const int col0 = (4 * (u.pn & 3) + wc) * 64 + 8 * fq;
            f32x4 gv[2][2];
#pragma unroll
            for (int bj = 0; bj < 2; ++bj)
#pragma unroll
                for (int n = 0; n < 2; ++n) gv[bj][n] = *(const f32x4*)(gn + 32 * bj + 8 * fq + 4 * n);
#pragma unroll
            for (int ai = 0; ai < 2; ++ai)
#pragma unroll
                for (int m = 0; m < 4; ++m) { const int row = row0 + ai * HALF + m * 16; const float rs = rstd_of(ssq, row);
                    f32x4 v[2][2]; float ss = 0.f;
#pragma unroll
                    for (int bj = 0; bj < 2; ++bj)
#pragma unroll
                        for (int n = 0; n < 2; ++n) { v[bj][n] = acc[ai][bj][m][n] * rs; ss += (v[bj][n][0] * v[bj][n][0] + v[bj][n][1] * v[bj][n][1]) + (v[bj][n][2] * v[bj][n][2] + v[bj][n][3] * v[bj][n][3]); }
                    ss += __shfl_xor(ss, 16); ss += __shfl_xor(ss, 32);
                    const float r2 = __builtin_amdgcn_rsqf(ss * (1.0f / 64.0f) + RMS_EPS) * sc;
#pragma unroll
                    for (int bj = 0; bj < 2; ++bj) *(u32x4*)(base + (size_t)row * DM_ + col0 + 32 * bj) = pack8(v[bj][0] * r2 * gv[bj][0], v[bj][1] * r2 * gv[bj][1]); }
        } else {
            const int col0 = (u.pn - 8) * BM + wc * 32 + 8 * fq;
#pragma unroll
            for (int ai = 0; ai < 2; ++ai)
#pragma unroll
                for (int m = 0; m < 4; ++m) { const int row = row0 + ai * HALF + m * 16; const float rs = rstd_of(ssq, row);
#pragma unroll
                    for (int bj = 0; bj < 2; ++bj) *(u32x4*)(V + (size_t)row * DM_ + col0 + bj * HALF) = pack8(acc[ai][bj][m][0] * rs, acc[ai][bj][m][1] * rs); }
        }
    }
};

struct EpiMoeDown {
    static constexpr bool PERM = true, AFTER_DRAIN = false;
    bf16_t* Y; const float* gate;
    __device__ __forceinline__ void operator()(const f32x4 (&acc)[2][2][4][2], const Unit& u, int wr, int wc, int fr, int fq) const {
        const int row0 = u.pm * BM + wr * 64 + fr, col0 = (u.pn & 3) * BM + wc * 32 + 8 * fq;
#pragma unroll
        for (int ai = 0; ai < 2; ++ai)
#pragma unroll
            for (int m = 0; m < 4; ++m) { const int row = row0 + ai * HALF + m * 16; const float gt = gate[row];
#pragma unroll
                for (int bj = 0; bj < 2; ++bj) *(u32x4*)(Y + (size_t)row * DM_ + col0 + bj * HALF) = pack8(acc[ai][bj][m][0] * gt, acc[ai][bj][m][1] * gt); }
    }
};

struct MoeOrder {
    int nM, nN, nwg, G, c; int t1, t2, t3, t4, t5, t6, t7;
    __device__ __forceinline__ void init(const int* meta, int nN_, int G_, int c_) {
        nM = meta[8]; nN = nN_; nwg = nM * nN; G = G_; c = c_; t1 = meta[1]; t2 = meta[2]; t3 = meta[3]; t4 = meta[4]; t5 = meta[5]; t6 = meta[6]; t7 = meta[7]; }
    __device__ __forceinline__ bool next(int i, Unit& u) const {
        const long L = (long)i * G + c; if (L >= nwg) return false;
        int wgid = (int)L; { const int q = nwg / NXCD, r = nwg % NXCD, xcd = wgid % NXCD, off = wgid / NXCD; wgid = (xcd < r ? xcd * (q + 1) : r * (q + 1) + (xcd - r) * q) + off; }
        const int nig = WGM * nN, gid = wgid / nig, fm = gid * WGM, gsz = (nM - fm) < WGM ? (nM - fm) : WGM;
        const int pm = fm + ((wgid % nig) % gsz), pnl = (wgid % nig) / gsz;
        const int e = (pm >= t1) + (pm >= t2) + (pm >= t3) + (pm >= t4) + (pm >= t5) + (pm >= t6) + (pm >= t7);
        u.pm = pm; u.pn = e * nN + pnl; return true;
    }
    __device__ __forceinline__ void a_ready(const Unit&) const {}
    __device__ __forceinline__ void done(const Unit&) const {}
};
template <class Epi, class Sched, bool ALIGN_EPI = false, bool SP2 = false>
__device__ __forceinline__ void gemm_phase(PG8_LAS unsigned char* lds, const Gemm g, const Sched& S, const Epi& E) {
    const int tid = threadIdx.x, wid = __builtin_amdgcn_readfirstlane(tid >> 6), lane = tid & 63, wr = wid >> 2, wc = wid & 3, fr = lane & 15, fq = lane >> 4;
    const int K = g.K, nt = K / BK;
    unsigned voffA[2], voffB[2];
#pragma unroll
    for (int i = 0; i < 2; ++i) { int R, C; stage_rc(tid * 16 + i * 8192, R, C); const int Rb = Epi::PERM ? ((R & ~31) + perm32(R & 31)) : R;
        voffA[i] = (unsigned)(R * K + C) * 2u; voffB[i] = (unsigned)(Rb * K + C) * 2u; }
    const size_t kstep = (size_t)(BK * 2);
    const size_t hstep = (size_t)HALF * K * 2;
    const size_t tstep = 2 * hstep;
    const unsigned ldsw = (unsigned)wid * 1024u;
    const int aoff = lds_byte(wr * 64 + fr, fq * 8), boff = lds_byte(wc * 32 + fr, fq * 8);
#define PG8_SA(b, h) (((b) * 2 + (h)) * HTB)
#define PG8_SB(b, h) ((4 + (b) * 2 + (h)) * HTB)
#define PG8_STAGE(bufoff, gbase, voff) do { _Pragma("unroll") for (int _i = 0; _i < 2; ++_i) \
        __builtin_amdgcn_global_load_lds((const unsigned*)((const char*)(gbase) + (voff)[_i]), (PG8_LAS unsigned*)(lds + (bufoff) + ldsw + _i * 8192), 16, 0, 0); } while (0)
#define PG8_LDA(dst, b, h) do { _Pragma("unroll") for (int m = 0; m < 4; ++m) _Pragma("unroll") for (int k = 0; k < 2; ++k) dst[m][k] = *(const PG8_LAS bf16x8*)(lds + PG8_SA(b, h) + aoff + m * 2048 + k * 1024); } while (0)
#define PG8_LDB(dst, b, h) do { _Pragma("unroll") for (int n = 0; n < 2; ++n) _Pragma("unroll") for (int k = 0; k < 2; ++k) dst[n][k] = *(const PG8_LAS bf16x8*)(lds + PG8_SB(b, h) + boff + n * 2048 + k * 1024); } while (0)
#define PG8_MMA(ai, bj, At, Bt) do { __builtin_amdgcn_s_setprio(1); _Pragma("unroll") for (int m = 0; m < 4; ++m) _Pragma("unroll") for (int n = 0; n < 2; ++n) _Pragma("unroll") for (int k = 0; k < 2; ++k) \
        acc[ai][bj][m][n] = __builtin_amdgcn_mfma_f32_16x16x32_bf16(Bt[n][k], At[m][k], acc[ai][bj][m][n], 0, 0, 0); __builtin_amdgcn_s_setprio(0); } while (0)
#define PG8_WAIT_V(n) asm volatile("s_waitcnt vmcnt(" #n ")" ::: "memory")
#define PG8_WAIT_L(n) asm volatile("s_waitcnt lgkmcnt(" #n ")" ::: "memory")
#define PG8_BAR __builtin_amdgcn_s_barrier()
#define PG8_SCHED __builtin_amdgcn_sched_barrier(0)
    Unit cur, nxt; int ui = 0;
    if (!S.next(0, cur)) return;
    f32x4 acc[2][2][4][2];
#pragma unroll
    for (int a = 0; a < 2; ++a)
#pragma unroll
        for (int b = 0; b < 2; ++b)
#pragma unroll
            for (int m = 0; m < 4; ++m)
#pragma unroll
                for (int n = 0; n < 2; ++n) acc[a][b][m][n] = (f32x4){0.f, 0.f, 0.f, 0.f};
    bf16x8 At[4][2], B0[2][2], B1[2][2];
    const char* cA = (const char*)g.A + (size_t)cur.pm * tstep; const char* cB = (const char*)g.Bt + (size_t)cur.pn * tstep;
    S.a_ready(cur);
    if constexpr (SP2) {
        PG8_STAGE(PG8_SB(0, 0), cB, voffB); PG8_STAGE(PG8_SB(0, 1), cB + hstep, voffB); PG8_STAGE(PG8_SA(0, 0), cA, voffA); PG8_STAGE(PG8_SA(0, 1), cA + hstep, voffA);
        if (wr == 1) PG8_BAR;
        PG8_WAIT_V(2); PG8_BAR;
        PG8_STAGE(PG8_SB(1, 0), cB + kstep, voffB); PG8_STAGE(PG8_SA(1, 0), cA + kstep, voffA); PG8_STAGE(PG8_SB(1, 1), cB + hstep + kstep, voffB);
        PG8_WAIT_V(6); PG8_BAR;
    } else {
        PG8_STAGE(PG8_SB(0, 0), cB, voffB); PG8_STAGE(PG8_SA(0, 0), cA, voffA); PG8_STAGE(PG8_SB(0, 1), cB + hstep, voffB); PG8_STAGE(PG8_SA(0, 1), cA + hstep, voffA);
        if (wr == 1) PG8_BAR;
        PG8_WAIT_V(4); PG8_BAR;
        PG8_STAGE(PG8_SB(1, 0), cB + kstep, voffB); PG8_STAGE(PG8_SA(1, 0), cA + kstep, voffA); PG8_STAGE(PG8_SB(1, 1), cB + hstep + kstep, voffB);
        PG8_WAIT_V(6); PG8_BAR;
    }
    for (;;) {
        const bool has_next = S.next(ui + 1, nxt);
        const char* nA = has_next ? (const char*)g.A + (size_t)nxt.pm * tstep : cA; const char* nB = has_next ? (const char*)g.Bt + (size_t)nxt.pn * tstep : cB;
        for (int t = 0; t < nt; t += 2) {
            const bool last = (t == nt - 2);
            const char* a1 = cA + (size_t)(t + 1) * kstep;
            const char* a2 = last ? nA : cA + (size_t)(t + 2) * kstep; const char* b2 = last ? nB : cB + (size_t)(t + 2) * kstep;
            const char* a3 = a2 + kstep; const char* b3 = b2 + kstep;
            if (last && has_next) S.a_ready(nxt);
            if constexpr (SP2) {
            PG8_LDB(B0, 0, 0); PG8_LDB(B1, 0, 1); PG8_SCHED; PG8_LDA(At, 0, 0); PG8_STAGE(PG8_SA(1, 1), a1 + hstep, voffA);
            PG8_WAIT_V(8); PG8_WAIT_L(0); PG8_BAR; PG8_MMA(0, 0, At, B0); PG8_MMA(0, 1, At, B1); PG8_BAR; PG8_SCHED;
            PG8_LDA(At, 0, 1); PG8_STAGE(PG8_SB(0, 0), b2, voffB); PG8_STAGE(PG8_SB(0, 1), b2 + hstep, voffB); PG8_STAGE(PG8_SA(0, 0), a2, voffA);
            PG8_WAIT_V(8); PG8_WAIT_L(0); PG8_BAR; PG8_MMA(1, 0, At, B0); PG8_MMA(1, 1, At, B1); PG8_BAR; PG8_SCHED;
            PG8_LDB(B0, 1, 0); PG8_LDB(B1, 1, 1); PG8_SCHED; PG8_LDA(At, 1, 0); PG8_STAGE(PG8_SA(0, 1), a2 + hstep, voffA);
            PG8_WAIT_V(8); PG8_WAIT_L(0); PG8_BAR; PG8_MMA(0, 0, At, B0); PG8_MMA(0, 1, At, B1); PG8_BAR; PG8_SCHED;
            PG8_LDA(At, 1, 1); PG8_STAGE(PG8_SB(1, 0), b3, voffB); PG8_STAGE(PG8_SB(1, 1), b3 + hstep, voffB); PG8_STAGE(PG8_SA(1, 0), a3, voffA);
            PG8_WAIT_V(8); PG8_WAIT_L(0); PG8_BAR; PG8_MMA(1, 0, At, B0); PG8_MMA(1, 1, At, B1); PG8_BAR; PG8_SCHED;
            } else {
            PG8_LDB(B0, 0, 0); PG8_SCHED; PG8_LDA(At, 0, 0); PG8_STAGE(PG8_SA(1, 1), a1 + hstep, voffA);
            PG8_WAIT_L(8); PG8_BAR; PG8_WAIT_L(0); PG8_MMA(0, 0, At, B0); PG8_BAR; PG8_SCHED;
            PG8_LDB(B1, 0, 1); PG8_STAGE(PG8_SB(0, 0), b2, voffB);
            PG8_BAR; PG8_WAIT_L(0); PG8_MMA(0, 1, At, B1); PG8_BAR;
            PG8_LDA(At, 0, 1); PG8_STAGE(PG8_SA(0, 0), a2, voffA);
            PG8_BAR; PG8_WAIT_L(0); PG8_MMA(1, 0, At, B0); PG8_BAR; PG8_SCHED;
            PG8_STAGE(PG8_SB(0, 1), b2 + hstep, voffB);
            PG8_WAIT_V(6); PG8_BAR; PG8_MMA(1, 1, At, B1); PG8_BAR;
            PG8_LDB(B0, 1, 0); PG8_SCHED; PG8_LDA(At, 1, 0); PG8_STAGE(PG8_SA(0, 1), a2 + hstep, voffA);
            PG8_WAIT_L(8); PG8_BAR; PG8_WAIT_L(0); PG8_MMA(0, 0, At, B0); PG8_BAR; PG8_SCHED;
            PG8_LDB(B1, 1, 1); PG8_STAGE(PG8_SB(1, 0), b3, voffB);
            PG8_BAR; PG8_WAIT_L(0); PG8_MMA(0, 1, At, B1); PG8_BAR;
            PG8_LDA(At, 1, 1); PG8_STAGE(PG8_SA(1, 0), a3, voffA);
            PG8_BAR; PG8_WAIT_L(0); PG8_MMA(1, 0, At, B0); PG8_BAR; PG8_SCHED;
            PG8_STAGE(PG8_SB(1, 1), b3 + hstep, voffB);
            PG8_WAIT_V(6); PG8_BAR; PG8_MMA(1, 1, At, B1); PG8_BAR;
            }
        }
        if constexpr (ALIGN_EPI) { if (wr == 0) PG8_BAR; }
        if constexpr (!Epi::AFTER_DRAIN) { E(acc, cur, wr, wc, fr, fq); S.done(cur); }
        if (!has_next) break;
#pragma unroll
        for (int a = 0; a < 2; ++a)
#pragma unroll
            for (int b = 0; b < 2; ++b)
#pragma unroll
                for (int m = 0; m < 4; ++m)
#pragma unroll
                    for (int n = 0; n < 2; ++n) acc[a][b][m][n] = (f32x4){0.f, 0.f, 0.f, 0.f};
        cur = nxt; cA = nA; cB = nB; ++ui;
        if constexpr (ALIGN_EPI) { if (wr == 1) PG8_BAR; }
    }
    PG8_WAIT_V(0);
    if constexpr (!ALIGN_EPI) { if (wr == 0) PG8_BAR; }
    PG8_BAR;
    if constexpr (Epi::AFTER_DRAIN) { E.fused(acc, cur, wr, wc, fr, fq, lds, wid, lane); S.done(cur); }
#undef PG8_SA
#undef PG8_SB
#undef PG8_STAGE
#undef PG8_LDA
#undef PG8_LDB
#undef PG8_MMA
#undef PG8_WAIT_V
#undef PG8_WAIT_L
#undef PG8_BAR
#undef PG8_SCHED
}
}
#include <hip/hip_bf16.h>
#include <cmath>
namespace attn_body {
using bf16=__hip_bfloat16;
using bf16x8=__attribute__((ext_vector_type(8)))short;
using s16x4=__attribute__((ext_vector_type(4)))short;
using f32x16=__attribute__((ext_vector_type(16)))float;
using u32x4=__attribute__((ext_vector_type(4)))unsigned;
constexpr int BATCH=8,NHEAD=16,SEQ=2048,D=64,DM=NHEAD*D;
constexpr int NW=8,QBLK=32,QB=QBLK*NW,KVBLK=64,NQB=SEQ/QB;
constexpr int ATTN_PITCH=DM, ATTN_UNIT_ROWS=QB;
__device__ __forceinline__ int crow(int r,int hi){return (r&3)+8*(r>>2)+4*hi;}
#define SBAR() __builtin_amdgcn_sched_barrier(0)
__device__ __forceinline__ void cmask(f32x16&p0,f32x16&p1,int jb,int qrel,int hi){
  const float NEG=-INFINITY; int kb=64*jb+4*hi;
  #pragma unroll
  for(int r=0;r<16;++r){int kv=kb+(r&3)+8*(r>>2); if(kv>qrel)p0[r]=NEG; if(kv+32>qrel)p1[r]=NEG;}
}

constexpr int NSLOT=3, SLOTB=8192;
constexpr int LDS_K=0, LDS_V=NSLOT*SLOTB, LDS_WS=2*NSLOT*SLOTB, LDS_OST=LDS_WS+NW*64*4, LDS_BYTES=LDS_OST+NW*4096;
constexpr float C2=0.125f*1.4426950408889634f;
__device__ __forceinline__ void glds16(const void*gsrc,unsigned lds_dst){unsigned keep;
  asm volatile("s_mov_b32 %0, m0\n\ts_mov_b32 m0, %2\n\ts_nop 0\n\tglobal_load_lds_dwordx4 %1, off\n\ts_mov_b32 m0, %0":"=&s"(keep):"v"(gsrc),"s"(lds_dst):"memory");}
__device__ __forceinline__ float max3f(float a,float b,float c){float r;asm("v_max3_f32 %0, %1, %2, %3":"=v"(r):"v"(a),"v"(b),"v"(c));return r;}
__device__ __forceinline__ float max2f(float a,float b){float r;asm("v_max_f32_e32 %0, %1, %2":"=v"(r):"v"(a),"v"(b));return r;}
__device__ __forceinline__ float fadd_s(float a,float b){float r;asm("v_add_f32_e32 %0, %1, %2":"=v"(r):"v"(a),"v"(b));return r;}
__device__ __forceinline__ float fsub_s(float a,float b){float r;asm("v_sub_f32_e32 %0, %1, %2":"=v"(r):"v"(a),"v"(b));return r;}
typedef float f32x2_t __attribute__((ext_vector_type(2))); typedef __bf16 bf16x2_t __attribute__((ext_vector_type(2)));
__device__ __forceinline__ unsigned cvtpk_s(float lo,float hi){f32x2_t v={lo,hi};bf16x2_t b=__builtin_convertvector(v,bf16x2_t);return __builtin_bit_cast(unsigned,b);}
#define WAIT_BAR(N) asm volatile("s_waitcnt vmcnt(" #N ") lgkmcnt(0)\n\ts_barrier":::"memory")

__device__ __forceinline__ void qkt(f32x16&p0,f32x16&p1,const char*Kslot,const bf16x8*qr,const f32x16&negm,int r32,int hi){
  const char*kb=Kslot+hi*1024+r32*16;
  #pragma unroll
  for(int d0=0;d0<4;++d0){
    const bf16x8 b0=*reinterpret_cast<const bf16x8*>(kb+d0*2048);
    const bf16x8 b1=*reinterpret_cast<const bf16x8*>(kb+d0*2048+512);
    if(d0==0){p0=__builtin_amdgcn_mfma_f32_32x32x16_bf16(b0,qr[0],negm,0,0,0);p1=__builtin_amdgcn_mfma_f32_32x32x16_bf16(b1,qr[0],negm,0,0,0);}
    else{p0=__builtin_amdgcn_mfma_f32_32x32x16_bf16(b0,qr[d0],p0,0,0,0);p1=__builtin_amdgcn_mfma_f32_32x32x16_bf16(b1,qr[d0],p1,0,0,0);}}
}
typedef __attribute__((address_space(3))) const char* lds_cptr;
typedef short v4i16_t __attribute__((ext_vector_type(4)));
__device__ __forceinline__ void kload8(bf16x8*kf,lds_cptr kp){
  kf[0]=*(const __attribute__((address_space(3))) bf16x8*)(kp);      kf[1]=*(const __attribute__((address_space(3))) bf16x8*)(kp+512);
  kf[2]=*(const __attribute__((address_space(3))) bf16x8*)(kp+2048); kf[3]=*(const __attribute__((address_space(3))) bf16x8*)(kp+2560);
  kf[4]=*(const __attribute__((address_space(3))) bf16x8*)(kp+4096); kf[5]=*(const __attribute__((address_space(3))) bf16x8*)(kp+4608);
  kf[6]=*(const __attribute__((address_space(3))) bf16x8*)(kp+6144); kf[7]=*(const __attribute__((address_space(3))) bf16x8*)(kp+6656);
}
__device__ __forceinline__ void kload2(bf16x8*kf,lds_cptr kp,int j){ kf[2*j]=*(const __attribute__((address_space(3))) bf16x8*)(kp+j*2048); kf[2*j+1]=*(const __attribute__((address_space(3))) bf16x8*)(kp+j*2048+512); }
__device__ __forceinline__ s16x4 vtr(lds_cptr p){ return __builtin_bit_cast(s16x4,__builtin_amdgcn_ds_read_tr16_b64_v4i16((__attribute__((address_space(3))) v4i16_t*)p)); }
__device__ __forceinline__ float rowmax(const f32x16&p0,const f32x16&p1){
  float a=max3f(p0[0],p0[1],p1[0]),b=max3f(p0[2],p0[3],p1[1]);a=max3f(a,p1[2],p1[3]);
  #pragma unroll
  for(int r=4;r<16;r+=4){a=max3f(a,p0[r],p0[r+1]);b=max3f(b,p0[r+2],p0[r+3]);a=max3f(a,p1[r],p1[r+1]);b=max3f(b,p1[r+2],p1[r+3]);}
  const float m=max2f(a,b);
  auto rr=__builtin_amdgcn_permlane32_swap(__float_as_uint(m),__float_as_uint(m),false,false);
  return max2f(__uint_as_float(rr[0]),__uint_as_float(rr[1]));
}
__device__ __forceinline__ void pv(f32x16*o,int vb,bf16x8 pa0,bf16x8 pa1,bf16x8 pa2,bf16x8 pa3){
  #pragma unroll
  for(int d0=0;d0<2;++d0){s16x4 lo[4],hi[4];
    #pragma unroll
    for(int ks=0;ks<4;++ks){
      asm volatile("ds_read_b64_tr_b16 %0,%1 offset:%c2":"=&v"(lo[ks]):"v"(vb),"i"(d0*4096+ks*1024):"memory");
      asm volatile("ds_read_b64_tr_b16 %0,%1 offset:%c2":"=&v"(hi[ks]):"v"(vb),"i"(d0*4096+ks*1024+512):"memory");}
    asm volatile("s_waitcnt lgkmcnt(0)":::"memory");SBAR();
    #define PK(k) (bf16x8){lo[k][0],lo[k][1],lo[k][2],lo[k][3],hi[k][0],hi[k][1],hi[k][2],hi[k][3]}
    o[d0]=__builtin_amdgcn_mfma_f32_32x32x16_bf16(pa0,PK(0),o[d0],0,0,0);
    o[d0]=__builtin_amdgcn_mfma_f32_32x32x16_bf16(pa1,PK(1),o[d0],0,0,0);
    o[d0]=__builtin_amdgcn_mfma_f32_32x32x16_bf16(pa2,PK(2),o[d0],0,0,0);
    o[d0]=__builtin_amdgcn_mfma_f32_32x32x16_bf16(pa3,PK(3),o[d0],0,0,0);
    #undef PK
  }
}

#ifndef ATTN_STORE16
#define ATTN_STORE16(p,v) (*(u32x4*)(p)=(v))
#endif
template<int THRL> __device__ __forceinline__ void attn_unit(int b,int qcol,int vcol,int qb,const bf16*Q,const bf16*__restrict__ K,const bf16*__restrict__ V,bf16*O,char*shm){
  int tid_=threadIdx.x; asm volatile("":"+v"(tid_));
  const int tid=tid_,lane=tid&63,r32=lane&31,hi=lane>>5; const int wid=__builtin_amdgcn_readfirstlane(tid>>6);
  const long rowbase=(long)b*SEQ; const int q0=qb*QB;
  const bf16*Qw=Q+(rowbase+q0+wid*QBLK)*DM+qcol;
  const bf16*Kh=K+rowbase*DM+qcol,*Vh=V+rowbase*DM+vcol;
  const unsigned lds0=(unsigned)(uintptr_t)shm;
  float*wsf=(float*)(shm+LDS_WS)+wid*64;
  const bf16*ksrc=Kh+(long)lane*DM+wid*8;
  const bf16*vsrc=Vh+(long)(16*(wid&3)+(lane>>2))*DM+(wid>>2)*32+(lane&3)*8;
  const unsigned kdst=lds0+LDS_K+wid*1024, vdst=lds0+LDS_V+wid*1024;
  #define DMA_K(t,slot) glds16(ksrc+(long)(t)*KVBLK*DM,(unsigned)__builtin_amdgcn_readfirstlane(kdst+(slot)))
  #define DMA_V(t,slot) glds16(vsrc+(long)(t)*KVBLK*DM,(unsigned)__builtin_amdgcn_readfirstlane(vdst+(slot)))
  const int vb0=(int)(lds0+LDS_V)+((lane>>4)&1)*32+(lane&3)*8+(4*hi+((lane&15)>>2))*64;
  const char*Kbase=shm+LDS_K; bf16x8 kf[8];
  const lds_cptr shm3=(lds_cptr)shm; const lds_cptr kp0=shm3+LDS_K+hi*1024+r32*16; const lds_cptr vp0=shm3+LDS_V+((lane>>4)&1)*32+(lane&3)*8+(4*hi+((lane&15)>>2))*64;
  const int NT=(q0+QB)/KVBLK;
  DMA_K(0,0);DMA_V(0,0);DMA_K(1,SLOTB);
  bf16x8 qr[4];
  #pragma unroll
  for(int d0=0;d0<4;++d0)qr[d0]=*reinterpret_cast<const bf16x8*>(&Qw[(long)r32*DM+d0*16+hi*8]);
  float mhat=0.f,l_reg=0.f;f32x16 o[2];o[0]=f32x16{};o[1]=f32x16{};f32x16 negm=f32x16{};asm volatile("":"+v"(negm));
  const int qrel=wid*QBLK+r32;
  #define CMASK(P0,P1,t) do{int jb_=(t)-(NT-4); if(jb_>=0)cmask(P0,P1,jb_,qrel,hi);}while(0)
  bool resc=false;
  #define START(P0,P1) do{ const float rm=rowmax(P0,P1); resc=false; \
    { const float dl=rm; mhat=fadd_s(mhat,dl); \
      _Pragma("unroll") for(int r=0;r<16;++r){P0[r]=fsub_s(P0[r],dl);P1[r]=fsub_s(P1[r],dl);} \
      _Pragma("unroll") for(int r=0;r<16;++r)negm[r]=-mhat; asm volatile("":"+v"(negm)); } \
    _Pragma("unroll") for(int r=0;r<16;++r)P0[r]=__builtin_amdgcn_exp2f(P0[r]); }while(0)
  #define RESC() do{ if(resc){ asm volatile("s_waitcnt lgkmcnt(0)":::"memory"); \
      _Pragma("unroll") for(int d_=0;d_<2;++d_) _Pragma("unroll") for(int r=0;r<16;++r)o[d_][r]*=wsf[crow(r,hi)]; } }while(0)
  f32x16 pA0,pA1,pB0,pB1;
  int sl_prev=0,sl_cur=0,sl_next=SLOTB;
  #define ROT() do{sl_prev=sl_cur;sl_cur=sl_next;sl_next=(sl_next==(NSLOT-1)*SLOTB)?0:sl_next+SLOTB;}while(0)
  DMA_K(2,2*SLOTB);
  WAIT_BAR(3);
  qkt(pA0,pA1,Kbase,qr,negm,r32,hi);asm volatile("s_nop 15\n\ts_nop 7":"+v"(pA0),"+v"(pA1));CMASK(pA0,pA1,0);
  START(pA0,pA1);
  _Pragma("unroll") for(int r=0;r<16;++r)pA1[r]=__builtin_amdgcn_exp2f(pA1[r]);
  WAIT_BAR(0);
  DMA_K(3,0);DMA_V(1,SLOTB);
  ROT();
  kload8(kf,kp0+sl_cur);
  WAIT_BAR(2);
  s16x4 vlo[8],vhi[8]; u32x4 pw0,pw1,pw2,pw3;
  #define PKW(P,B) cvtpk_s(P[B],P[B+1])
  #define PAF(k) __builtin_bit_cast(bf16x8,pw##k)
  #define VFR(i) (bf16x8){vlo[i][0],vlo[i][1],vlo[i][2],vlo[i][3],vhi[i][0],vhi[i][1],vhi[i][2],vhi[i][3]}
  #define PIN(x) asm volatile("":"+v"(x))
  #define MX3(a,b,c) __builtin_fmaxf(__builtin_fmaxf((a),(b)),(c))
  #define GAPA(MF,A0,A1,A2,A3,W0,W1,PW) do{ MF; sacc+=A0; sacc+=A1; sacc+=A2; sacc+=A3; PIN(sacc); W0; W1; PIN(PW); SBAR(); }while(0)
  #define EX(v) __builtin_amdgcn_exp2f(v)
  #define GAPB(MF,X,B) do{ MF; X[B]=EX(X[B]); X[B+1]=EX(X[B+1]); X[B+2]=EX(X[B+2]); X[B+3]=EX(X[B+3]); PIN(X); SBAR(); }while(0)
  #define VRD(i) do{ vlo[i]=vtr(vp_+(((i)>>2)*4096+((i)&3)*1024)); vhi[i]=vtr(vp_+(((i)>>2)*4096+((i)&3)*1024+512)); }while(0)
  #define KRD(G,j) do{ if(G){ kload2(kf,kp0+sl_next,j); SBAR(); } }while(0)
  #define STEP(C0,C1,P0,P1,t,GK,GV,GL) do{ SBAR(); \
    const lds_cptr vp_=vp0+sl_prev; \
    VRD(0); SBAR(); float sacc=(P0[0]+P0[1]); \
    GAPA(C0=__builtin_amdgcn_mfma_f32_32x32x16_bf16(kf[0],qr[0],negm,0,0,0), P0[2],P0[3],P0[4],P0[5],     pw0[0]=PKW(P0,0), pw0[1]=PKW(P0,2), pw0); \
    VRD(4); SBAR(); GAPA(C1=__builtin_amdgcn_mfma_f32_32x32x16_bf16(kf[1],qr[0],negm,0,0,0), P0[6],P0[7],P0[8],P0[9],     pw0[2]=PKW(P0,4), pw0[3]=PKW(P0,6), pw0); \
    VRD(1); SBAR(); GAPA(C0=__builtin_amdgcn_mfma_f32_32x32x16_bf16(kf[2],qr[1],C0,0,0,0),   P0[10],P0[11],P0[12],P0[13], pw1[0]=PKW(P0,8), pw1[1]=PKW(P0,10), pw1); \
    VRD(5); SBAR(); GAPA(C1=__builtin_amdgcn_mfma_f32_32x32x16_bf16(kf[3],qr[1],C1,0,0,0),   P0[14],P0[15],P1[0],P1[1],   pw1[2]=PKW(P0,12),pw1[3]=PKW(P0,14), pw1); \
    VRD(2); SBAR(); GAPA(C0=__builtin_amdgcn_mfma_f32_32x32x16_bf16(kf[4],qr[2],C0,0,0,0),   P1[2],P1[3],P1[4],P1[5],     pw2[0]=PKW(P1,0), pw2[1]=PKW(P1,2), pw2); \
    VRD(6); SBAR(); GAPA(C1=__builtin_amdgcn_mfma_f32_32x32x16_bf16(kf[5],qr[2],C1,0,0,0),   P1[6],P1[7],P1[8],P1[9],     pw2[2]=PKW(P1,4), pw2[3]=PKW(P1,6), pw2); \
    VRD(3); SBAR(); GAPA(C0=__builtin_amdgcn_mfma_f32_32x32x16_bf16(kf[6],qr[3],C0,0,0,0),   P1[10],P1[11],P1[12],P1[13], pw3[0]=PKW(P1,8), pw3[1]=PKW(P1,10), pw3); \
    VRD(7); SBAR(); GAPA(C1=__builtin_amdgcn_mfma_f32_32x32x16_bf16(kf[7],qr[3],C1,0,0,0),   P1[14],P1[15],0.f,0.f,       pw3[2]=PKW(P1,12),pw3[3]=PKW(P1,14), pw3); \
    l_reg+=sacc; \
    if(GK){DMA_K((t)+3,sl_cur);} if(GV){DMA_V((t)+1,sl_next);} \
    CMASK(C0,C1,t); \
    { float a=MX3(C0[0],C0[1],C1[0]),b=MX3(C0[2],C0[3],C1[1]); a=MX3(a,C1[2],C1[3]); \
      _Pragma("unroll") for(int r=4;r<16;r+=4){a=MX3(a,C0[r],C0[r+1]);b=MX3(b,C0[r+2],C0[r+3]);a=MX3(a,C1[r],C1[r+1]);b=MX3(b,C1[r+2],C1[r+3]);} \
      float rm=__builtin_fmaxf(a,b); { auto rr=__builtin_amdgcn_permlane32_swap(__float_as_uint(rm),__float_as_uint(rm),false,false); rm=__builtin_fmaxf(__uint_as_float(rr[0]),__uint_as_float(rr[1])); } \
      resc=false; \
      if(__builtin_expect(__any(rm>(float)THRL),0)){ const float dl=__builtin_fmaxf(rm,0.f); mhat+=dl; \
        _Pragma("unroll") for(int r=0;r<16;++r){C0[r]-=dl;C1[r]-=dl;} \
        _Pragma("unroll") for(int r=0;r<16;++r)negm[r]=-mhat; asm volatile("":"+v"(negm)); \
        const float f=__builtin_amdgcn_exp2f(-dl); l_reg*=f; if(hi==0)wsf[r32]=f; resc=true; } } \
    SBAR(); \
    GAPB(o[0]=__builtin_amdgcn_mfma_f32_32x32x16_bf16(PAF(0),VFR(0),o[0],0,0,0), C0,0); \
    GAPB(o[1]=__builtin_amdgcn_mfma_f32_32x32x16_bf16(PAF(0),VFR(4),o[1],0,0,0), C0,4); \
    KRD(GL,0); GAPB(o[0]=__builtin_amdgcn_mfma_f32_32x32x16_bf16(PAF(1),VFR(1),o[0],0,0,0), C0,8); \
    KRD(GL,1); GAPB(o[1]=__builtin_amdgcn_mfma_f32_32x32x16_bf16(PAF(1),VFR(5),o[1],0,0,0), C0,12); \
    KRD(GL,2); GAPB(o[0]=__builtin_amdgcn_mfma_f32_32x32x16_bf16(PAF(2),VFR(2),o[0],0,0,0), C1,0); \
    KRD(GL,3); GAPB(o[1]=__builtin_amdgcn_mfma_f32_32x32x16_bf16(PAF(2),VFR(6),o[1],0,0,0), C1,4); \
    GAPB(o[0]=__builtin_amdgcn_mfma_f32_32x32x16_bf16(PAF(3),VFR(3),o[0],0,0,0), C1,8); \
    GAPB(o[1]=__builtin_amdgcn_mfma_f32_32x32x16_bf16(PAF(3),VFR(7),o[1],0,0,0), C1,12); \
    }while(0)
  int t=1;
  #undef CMASK
  #define CMASK(P0,P1,t) do{}while(0)
  for(;t+5<NT;t+=2){
    STEP(pB0,pB1,pA0,pA1,t,true,true,true);     WAIT_BAR(2); RESC(); ROT();
    STEP(pA0,pA1,pB0,pB1,t+1,true,true,true);   WAIT_BAR(2); RESC(); ROT();
  }
  #undef CMASK
  #define CMASK(P0,P1,t) do{int jb_=(t)-(NT-4); if(jb_>=0)cmask(P0,P1,jb_,qrel,hi);}while(0)
  #define ENDW(tt) do{ if((tt)+3<NT){WAIT_BAR(2);} else if((tt)+2<NT){WAIT_BAR(1);} else {WAIT_BAR(0);} }while(0)
  for(;t+1<NT;t+=2){
    STEP(pB0,pB1,pA0,pA1,t,(t+3<NT),(t+1<NT),(t+1<NT));       ENDW(t);   RESC(); ROT();
    STEP(pA0,pA1,pB0,pB1,t+1,(t+4<NT),(t+2<NT),(t+2<NT));     ENDW(t+1); RESC(); ROT();
  }
  STEP(pB0,pB1,pA0,pA1,NT-1,false,false,false); RESC();
  { float sacc=pB0[0]+pB0[1]; _Pragma("unroll") for(int r=2;r<16;++r)sacc+=pB0[r]; _Pragma("unroll") for(int r=0;r<16;++r)sacc+=pB1[r]; l_reg+=sacc;
    pw0=(u32x4){PKW(pB0,0),PKW(pB0,2),PKW(pB0,4),PKW(pB0,6)};pw1=(u32x4){PKW(pB0,8),PKW(pB0,10),PKW(pB0,12),PKW(pB0,14)};pw2=(u32x4){PKW(pB1,0),PKW(pB1,2),PKW(pB1,4),PKW(pB1,6)};pw3=(u32x4){PKW(pB1,8),PKW(pB1,10),PKW(pB1,12),PKW(pB1,14)};
    SBAR(); pv(o,vb0+sl_cur,PAF(0),PAF(1),PAF(2),PAF(3)); }
  #undef PKW
  #undef PAF
  #undef VFR
  #undef PIN
  #undef MX3
  #undef GAPA
  #undef GAPB
  #undef EX
  #undef VRD
  #undef KRD
  #undef STEP
  #undef ENDW
  {auto rr=__builtin_amdgcn_permlane32_swap(__float_as_uint(l_reg),__float_as_uint(l_reg),false,false);l_reg=__uint_as_float(rr[0])+__uint_as_float(rr[1]);}
  if(hi==0)wsf[32+r32]=l_reg;asm volatile("s_waitcnt lgkmcnt(0)":::"memory");
  float rli[16];
  #pragma unroll
  for(int r=0;r<16;++r)rli[r]=__builtin_amdgcn_rcpf(wsf[32+crow(r,hi)]);
  bf16*Ow=O+(rowbase+q0+wid*QBLK)*DM+vcol;
  { bf16*stg=(bf16*)(shm+LDS_OST)+wid*2048;
    #pragma unroll
    for(int r=0;r<16;++r){const int orow=crow(r,hi);
      #pragma unroll
      for(int d0=0;d0<2;++d0)stg[orow*64+d0*32+r32]=__float2bfloat16(o[d0][r]*rli[r]);}
    asm volatile("s_waitcnt lgkmcnt(0)":::"memory");
    #pragma unroll
    for(int i=0;i<4;++i){const int row=i*8+(lane>>3),ch=lane&7; const u32x4 v=*(const u32x4*)(stg+row*64+ch*8); ATTN_STORE16(Ow+(long)row*DM+ch*8,v);} }
  asm volatile("s_waitcnt lgkmcnt(0)\n\ts_barrier":::"memory");
  #undef DMA_K
  #undef DMA_V
  #undef CMASK
  #undef START
  #undef RESC
  #undef ROT
}
constexpr int ATTN_LDS_BYTES=LDS_BYTES;
#undef SBAR
#undef WAIT_BAR
}
constexpr int NWAVES = 8;
constexpr int NPH = 15;
constexpr size_t MiB = 1u << 20;
constexpr size_t WS_CTL = 0, CTL_ZERO_BYTES = 1 * MiB;
constexpr size_t WS_W_IN = 1 * MiB;
constexpr size_t WS_W_OUT = WS_W_IN + (size_t)3072 * 1024 * 2;
constexpr size_t WS_W_GU = WS_W_OUT + (size_t)1024 * 1024 * 2;
constexpr size_t WS_W_DN = WS_W_GU + (size_t)5632 * 1024 * 2;
constexpr size_t WS_W_QKV = WS_W_DN + (size_t)1024 * 2816 * 2;
constexpr size_t WS_W_O = WS_W_QKV + (size_t)3072 * 1024 * 2;
constexpr size_t WS_W_MGU = WS_W_O + (size_t)1024 * 1024 * 2;
constexpr size_t WS_W_MDN = WS_W_MGU + (size_t)8 * 7168 * 1024 * 2;
constexpr size_t WS_W_END = WS_W_MDN + (size_t)8 * 1024 * 3584 * 2;
constexpr size_t WS_R = 202 * MiB;
constexpr size_t ACT = (size_t)M * D * 2;
constexpr size_t WS_XN0 = WS_R, WS_BB = WS_R + ACT, WS_UB = WS_R + 2 * ACT, WS_G = WS_R + 3 * ACT;
constexpr size_t WS_HACT = WS_R;
constexpr size_t WS_Q = WS_R + 4 * ACT, WS_K = WS_R + 5 * ACT, WS_V = WS_R + 6 * ACT;
constexpr size_t WS_O0 = WS_R, WS_O1 = WS_R + ACT, WS_ON = WS_R + 2 * ACT;
constexpr size_t WS_HM = WS_R;
constexpr size_t WS_S = 440 * MiB;
constexpr size_t WS_XG = WS_S, WS_Y = WS_S + 68 * MiB;
constexpr size_t WS_XB = 632 * MiB;
constexpr size_t WS_HB = 664 * MiB, WS_HB2 = 696 * MiB, WS_YF = 728 * MiB;
constexpr size_t WS_SMALL = 792 * MiB;
constexpr size_t WS_SSQ = WS_SMALL;
constexpr size_t WS_SEL = WS_SMALL + 256 * 1024, WS_GATE = WS_SEL + 128 * 1024, WS_TOKSLOT = WS_GATE + 128 * 1024;
constexpr size_t WS_RSTDS = WS_TOKSLOT + 128 * 1024, WS_GATES = WS_RSTDS + 256 * 1024;
constexpr size_t WS_HIST = WS_GATES + 256 * 1024, WS_META = WS_HIST + 16 * 1024;
constexpr size_t WS_NAIVE_SMALL = WS_SMALL + 2 * MiB;
constexpr size_t WS_END = 796 * MiB;
static_assert(WS_W_END <= WS_R && WS_R + (size_t)SLOTS * DFE * 2 <= WS_S && WS_Y + (size_t)SLOTS * D * 2 <= WS_XB && WS_V + ACT <= WS_S, "d_ws map");
constexpr int CW_TMO = 0, CW_CODE = 1, CW_BAR = 4096;
constexpr int MISC_OFF = 0, RING_OFF = 1024, RING_BYTES = 131072, LDS_BYTES = 147456;
constexpr int P0_SCR = 16640;

#define GAS __attribute__((address_space(1)))
#define LAS __attribute__((address_space(3)))
typedef unsigned v4u __attribute__((ext_vector_type(4)));
typedef unsigned v2u __attribute__((ext_vector_type(2)));
typedef GAS unsigned gu32;
#define RLX_AGENT __ATOMIC_RELAXED, __HIP_MEMORY_SCOPE_AGENT
#define LDS_WAIT() asm volatile("s_waitcnt lgkmcnt(0)" ::: "memory")
#define VM_WAIT() asm volatile("s_waitcnt vmcnt(0)" ::: "memory")
__device__ __forceinline__ unsigned pk2(float lo, float hi) { return f2bf(lo) | (f2bf(hi) << 16); }
__device__ __forceinline__ float bflo(unsigned w) { return __builtin_bit_cast(float, w << 16); }
__device__ __forceinline__ float bfhi(unsigned w) { return __builtin_bit_cast(float, w & 0xffff0000u); }

#define XB_TMO      128
#define XB_XCNT(j)  (256  + 64 * (j))
#define XB_XSUB(j)  (1280 + 64 * (j))
#define XB_XGEN(j)  (2304 + 64 * (j))
#define XB_TOP      3328
#define XB_TOPGEN   3392
#define XCD_BAR_WORDS 3456
#define XB_SPIN_CAP (1u << 18)

__device__ __forceinline__ unsigned xb_ld(unsigned* p)              { return __hip_atomic_load(p, __ATOMIC_RELAXED, __HIP_MEMORY_SCOPE_AGENT); }
__device__ __forceinline__ unsigned xb_add(unsigned* p, unsigned v) { return __hip_atomic_fetch_add(p, v, __ATOMIC_RELAXED, __HIP_MEMORY_SCOPE_AGENT); }
__device__ __forceinline__ unsigned xb_xcc_id() { return (unsigned)__builtin_amdgcn_s_getreg((3 << 11) | 20) & 0xFu; }
#define XB_SPIN(cond, bar) do { unsigned _sp = 0; while (cond) { __builtin_amdgcn_s_sleep(1); \
    if ((++_sp & 255u) == 0u) { if (xb_ld(&(bar)[XB_TMO])) break; if (_sp > XB_SPIN_CAP) { atomicAdd(&(bar)[XB_TMO], 1u); break; } } } } while (0)

struct XcdBarrier {
    unsigned* bar; unsigned x;
    volatile LAS unsigned* st;
};

__device__ __forceinline__ XcdBarrier xcd_barrier_post(unsigned* bar, volatile LAS unsigned* st) {
    XcdBarrier b; b.bar = bar; b.x = xb_xcc_id(); b.st = st;
    if (threadIdx.x == 0) (void)xb_add(&bar[XB_XCNT(b.x)], 1u);
    return b;
}
__device__ __forceinline__ void xcd_barrier_complete(unsigned* bar, unsigned x, unsigned& nloc, unsigned& nx) {
    const unsigned G = gridDim.x * gridDim.y * gridDim.z;
    unsigned sum, cnt, mine, sp = 0u;
    for (;;) {
        sum = 0u; cnt = 0u; mine = 0u;
#pragma unroll
        for (unsigned j = 0; j < 16; ++j) { const unsigned c = xb_ld(&bar[XB_XCNT(j)]); sum += c; cnt += (c > 0u) ? 1u : 0u; mine = (j == x) ? c : mine; }
        if (sum == G) break;
        __builtin_amdgcn_s_sleep(1);
        if ((++sp & 255u) == 0u) { if (xb_ld(&bar[XB_TMO])) break; if (sp > XB_SPIN_CAP) { atomicAdd(&bar[XB_TMO], 1u); break; } }
    }
    nloc = mine > 0u ? mine : 1u; nx = cnt > 0u ? cnt : 1u;
}

__device__ __forceinline__ void xcd_barrier(const XcdBarrier& b) {
    asm volatile("s_waitcnt vmcnt(0)" ::: "memory");
    __syncthreads();
    if (threadIdx.x == 0) {
        unsigned* bar = b.bar;
        __builtin_amdgcn_s_waitcnt(0);
        unsigned nloc = b.st[0], nx = b.st[1];
        if (nloc == 0u) { xcd_barrier_complete(bar, b.x, nloc, nx); b.st[0] = nloc; b.st[1] = nx; }
        const unsigned old = xb_add(&bar[XB_XSUB(b.x)], 1u);
        const unsigned gen = old / nloc;
        if (old + 1u == (gen + 1u) * nloc) {
            __builtin_amdgcn_fence(__ATOMIC_RELEASE, "agent");
            asm volatile("s_waitcnt vmcnt(0)" ::: "memory");
            const unsigned og = xb_add(&bar[XB_TOP], 1u);
            const unsigned tg = og / nx;
            if (og + 1u == (tg + 1u) * nx) xb_add(&bar[XB_TOPGEN], 1u);
            else XB_SPIN(xb_ld(&bar[XB_TOPGEN]) == tg, bar);
            __builtin_amdgcn_fence(__ATOMIC_ACQUIRE, "agent");
            xb_add(&bar[XB_XGEN(b.x)], 1u);
            asm volatile("s_waitcnt vmcnt(0)" ::: "memory");
        } else {
            XB_SPIN(xb_ld(&bar[XB_XGEN(b.x)]) == gen, bar);
            __builtin_amdgcn_fence(__ATOMIC_ACQUIRE, "agent");
            asm volatile("s_waitcnt vmcnt(0)" ::: "memory");
        }
    }
    __syncthreads();
}


struct Args { const float* in[19]; float* out; unsigned char* wsp; int ph_lo, ph_hi, li, jobmask; };
struct Frame { LAS unsigned char* lds; int tid, lane, wave, vcu, G; };
#define KA ((const Args*)__builtin_amdgcn_kernarg_segment_ptr())
#define INP(i) (KA->in[i])
#define A_WS (KA->wsp)
#define A_OUT (KA->out)

__device__ __forceinline__ void p0_item(const float* src, int ldw, const float* gain, bf16_t* dst, int K, int k0, int n0, int d0, int d1, LAS float* scr, int lane) {
    const int lr = lane >> 4, lc = lane & 15;
    f32x4 v[16];
#pragma unroll
    for (int i = 0; i < 16; ++i) v[i] = *(const GAS f32x4*)(src + (size_t)(k0 + 4 * i + lr) * ldw + n0 + 4 * lc);
    if (gain) {
#pragma unroll
        for (int i = 0; i < 16; ++i) v[i] = v[i] * gain[k0 + 4 * i + lr];
    }
#pragma unroll
    for (int i = 0; i < 16; ++i) { LAS float* p = scr + (4 * i + lr) * 65 + 4 * lc; p[0] = v[i][0]; p[1] = v[i][1]; p[2] = v[i][2]; p[3] = v[i][3]; }
    LDS_WAIT(); asm volatile("" ::: "memory");
    const int c = lane & 7;
#pragma unroll
    for (int jj = 0; jj < 8; ++jj) { const int nl = 8 * jj + (lane >> 3); const LAS float* s = scr + (8 * c) * 65 + nl;
        v4u o; o.x = pk2(s[0], s[65]); o.y = pk2(s[130], s[195]); o.z = pk2(s[260], s[325]); o.w = pk2(s[390], s[455]);
        const int drow = (jj < 4 ? d0 : d1 - 32) + nl;
        *(GAS v4u*)(dst + (size_t)drow * K + k0 + 8 * c) = o; }
    LDS_WAIT(); asm volatile("" ::: "memory");
}
__device__ __forceinline__ int p0_dstrow(int mode, int aux, int col) {
    if (mode == 1) { if (col < 1024) return col; const int v = col >= 2048, cc = col - (v ? 2048 : 1024); return 1024 + 256 * (cc >> 7) + 128 * v + (cc & 127); }
    if (mode == 2) { const int up = col >= aux, cc = col - (up ? aux : 0); return 256 * (cc >> 7) + 128 * up + (cc & 127); }
    if (mode == 3) { const int g = col >> 6, bj = (col >> 5) & 1; return 256 * (g >> 2) + 32 * (4 * bj + (g & 3)) + (col & 31); }
    return col;
}
__device__ __forceinline__ void p0_job(Frame& F, int& base, const float* src, int ldw, int K, int c0, int ncols, const float* gain, bf16_t* dst, int drow0, int dstrows, int mode, int aux, int nmat) {
    LAS float* scr = (LAS float*)(F.lds + RING_OFF + F.wave * P0_SCR);
    const int gw = F.vcu * NWAVES + F.wave, NGW = F.G * NWAVES, nk = K / 64, nn = ncols / 64, per = nk * nn, total = per * nmat;
    int it = (gw - base) % NGW; if (it < 0) it += NGW;
    for (; it < total; it += NGW) { const int mat = it / per, r = it % per, kb = r / nn, nb = r % nn; const int col = 64 * nb;
        p0_item(src + (size_t)mat * K * ldw + c0, ldw, gain, dst + (size_t)mat * dstrows * K, K, 64 * kb, col, drow0 + p0_dstrow(mode, aux, col), drow0 + p0_dstrow(mode, aux, col + 32), scr, F.lane); }
    base = (base + total) % NGW;
}
__device__ __forceinline__ void rms_row_bf16(const float* xrow, const float* g, bf16_t* orow, int lane) {
    const GAS f32x4* xr = (const GAS f32x4*)xrow + lane; const GAS f32x4* gr = (const GAS f32x4*)g + lane;
    f32x4 v[4]; float s = 0.f;
#pragma unroll
    for (int j = 0; j < 4; ++j) { v[j] = xr[64 * j]; s += (v[j][0] * v[j][0] + v[j][1] * v[j][1]) + (v[j][2] * v[j][2] + v[j][3] * v[j][3]); }
    const float rstd = __builtin_amdgcn_rsqf(wave_sum(s) * (1.f / D) + EPS);
    GAS v2u* o8 = (GAS v2u*)orow + lane;
#pragma unroll
    for (int j = 0; j < 4; ++j) { const f32x4 gg = gr[64 * j]; v2u o; o.x = pk2(v[j][0] * rstd * gg[0], v[j][1] * rstd * gg[1]); o.y = pk2(v[j][2] * rstd * gg[2], v[j][3] * rstd * gg[3]); o8[64 * j] = o; }
}
__device__ __forceinline__ void p0_prologue(Frame& F, int jobmask) {
    unsigned char* ws = A_WS; int base = 0;
    if (jobmask & 1)   p0_job(F, base, INP(3), 3072, 1024, 0, 3072, nullptr, (bf16_t*)(ws + WS_W_IN), 0, 3072, 1, 0, 1);
    if (jobmask & 2)   p0_job(F, base, INP(5), 1024, 1024, 0, 1024, nullptr, (bf16_t*)(ws + WS_W_OUT), 0, 1024, 0, 0, 1);
    if (jobmask & 4)   p0_job(F, base, INP(14), 5632, 1024, 0, 5632, INP(2), (bf16_t*)(ws + WS_W_GU), 0, 5632, 2, 2816, 1);
    if (jobmask & 8)   p0_job(F, base, INP(15), 1024, 2816, 0, 1024, nullptr, (bf16_t*)(ws + WS_W_DN), 0, 1024, 0, 0, 1);
    if (jobmask & 16) { p0_job(F, base, INP(9), 1024, 1024, 0, 1024, INP(1) + 1024, (bf16_t*)(ws + WS_W_QKV), 0, 3072, 3, 0, 1);
                        p0_job(F, base, INP(7), 2048, 1024, 0, 1024, INP(6), (bf16_t*)(ws + WS_W_QKV), 1024, 3072, 3, 0, 1);
                        p0_job(F, base, INP(7), 2048, 1024, 1024, 1024, INP(6), (bf16_t*)(ws + WS_W_QKV), 2048, 3072, 0, 0, 1); }
    if (jobmask & 32)  p0_job(F, base, INP(13), 1024, 1024, 0, 1024, nullptr, (bf16_t*)(ws + WS_W_O), 0, 1024, 0, 0, 1);
    if (jobmask & 64)  p0_job(F, base, INP(17), 7168, 1024, 0, 7168, INP(2) + 1024, (bf16_t*)(ws + WS_W_MGU), 0, 7168, 2, 3584, 8);
    if (jobmask & 128) p0_job(F, base, INP(18), 1024, 3584, 0, 1024, nullptr, (bf16_t*)(ws + WS_W_MDN), 0, 1024, 0, 0, 8);
    const int gw = F.vcu * NWAVES + F.wave, NGW = F.G * NWAVES;
    for (int m = gw; m < M; m += NGW) rms_row_bf16(INP(0) + (size_t)m * D, INP(1), (bf16_t*)(ws + WS_XN0) + (size_t)m * D, F.lane);
}

__device__ __forceinline__ void up8(const v4u w, float (&f)[8]) { f[0] = bflo(w.x); f[1] = bfhi(w.x); f[2] = bflo(w.y); f[3] = bfhi(w.y); f[4] = bflo(w.z); f[5] = bfhi(w.z); f[6] = bflo(w.w); f[7] = bfhi(w.w); }
__device__ __forceinline__ void p2_conv(Frame& F) {
    const bf16_t* Bb = (const bf16_t*)(A_WS + WS_BB); const bf16_t* Ub = (const bf16_t*)(A_WS + WS_UB); bf16_t* G = (bf16_t*)(A_WS + WS_G); const float* cw = INP(4);
    const int gw = F.vcu * NWAVES + F.wave, NGW = F.G * NWAVES;
    for (int strip = gw; strip < 2048; strip += NGW) {
        const int r0 = (strip >> 1) * 16, c0 = (strip & 1) * 512 + F.lane * 8;
        float w0[8], w1[8], w2[8], um2[8], um1[8];
#pragma unroll
        for (int j = 0; j < 8; ++j) { w0[j] = cw[c0 + j]; w1[j] = cw[D + c0 + j]; w2[j] = cw[2 * D + c0 + j]; um2[j] = 0.f; um1[j] = 0.f; }
        if ((r0 & (SEQ - 1)) != 0) { up8(*(const GAS v4u*)(Ub + (size_t)(r0 - 2) * D + c0), um2); up8(*(const GAS v4u*)(Ub + (size_t)(r0 - 1) * D + c0), um1); }
#pragma unroll 4
        for (int i = 0; i < 16; ++i) { float u[8], b[8];
            up8(*(const GAS v4u*)(Ub + (size_t)(r0 + i) * D + c0), u); up8(*(const GAS v4u*)(Bb + (size_t)(r0 + i) * D + c0), b);
            float g[8];
#pragma unroll
            for (int j = 0; j < 8; ++j) { g[j] = b[j] * (w0[j] * um2[j] + w1[j] * um1[j] + w2[j] * u[j]); um2[j] = um1[j]; um1[j] = u[j]; }
            v4u o; o.x = pk2(g[0], g[1]); o.y = pk2(g[2], g[3]); o.z = pk2(g[4], g[5]); o.w = pk2(g[6], g[7]);
            *(GAS v4u*)(G + (size_t)(r0 + i) * D + c0) = o; }
    }
}

__device__ __forceinline__ void p8_diff(Frame& F) {
    const bf16_t* O0 = (const bf16_t*)(A_WS + WS_O0); const bf16_t* O1 = (const bf16_t*)(A_WS + WS_O1); bf16_t* ON = (bf16_t*)(A_WS + WS_ON);
    const float* lp = INP(11); const float* sn = INP(12); const int lane = F.lane;
    const float lam = __expf(wave_sum(lp[lane] * lp[64 + lane])) - __expf(wave_sum(lp[128 + lane] * lp[192 + lane])) + LAM_INIT;
    float gn[16];
#pragma unroll
    for (int j = 0; j < 16; ++j) gn[j] = sn[16 * (lane & 7) + j] * (1.f - LAM_INIT);
    const int gw = F.vcu * NWAVES + F.wave, NGW = F.G * NWAVES;
    for (int row = gw; row < M; row += NGW) {
        const size_t off = (size_t)row * D + 16 * lane; float a[16], a0[8], a1[8], b0[8], b1[8];
        up8(*(const GAS v4u*)(O0 + off), a0); up8(*(const GAS v4u*)(O0 + off + 8), a1);
        up8(*(const GAS v4u*)(O1 + off), b0); up8(*(const GAS v4u*)(O1 + off + 8), b1);
        float s = 0.f;
#pragma unroll
        for (int j = 0; j < 8; ++j) { a[j] = a0[j] - lam * b0[j]; a[8 + j] = a1[j] - lam * b1[j]; s += a[j] * a[j] + a[8 + j] * a[8 + j]; }
        s += __shfl_xor(s, 1); s += __shfl_xor(s, 2); s += __shfl_xor(s, 4);
        const float rstd = __builtin_amdgcn_rsqf(s * (1.f / VD) + EPS);
        v4u o0, o1; o0.x = pk2(a[0] * rstd * gn[0], a[1] * rstd * gn[1]); o0.y = pk2(a[2] * rstd * gn[2], a[3] * rstd * gn[3]); o0.z = pk2(a[4] * rstd * gn[4], a[5] * rstd * gn[5]); o0.w = pk2(a[6] * rstd * gn[6], a[7] * rstd * gn[7]);
        o1.x = pk2(a[8] * rstd * gn[8], a[9] * rstd * gn[9]); o1.y = pk2(a[10] * rstd * gn[10], a[11] * rstd * gn[11]); o1.z = pk2(a[12] * rstd * gn[12], a[13] * rstd * gn[13]); o1.w = pk2(a[14] * rstd * gn[14], a[15] * rstd * gn[15]);
        *(GAS v4u*)(ON + off) = o0; *(GAS v4u*)(ON + off + 8) = o1;
    }
}

__device__ __forceinline__ void p10a_router(Frame& F) {
    const float* x3 = A_OUT; const float* g = INP(2) + D; const float* Wr = INP(16);
    int* sel = (int*)(A_WS + WS_SEL); float* gate = (float*)(A_WS + WS_GATE); int* hist = (int*)(A_WS + WS_HIST);
    LAS int* lsel = (LAS int*)(F.lds + RING_OFF);
    const int lane = F.lane;
    for (int blk = blockIdx.x; blk < M / 64; blk += F.G) {
        for (int i = 0; i < 8; ++i) { const int tl = 8 * F.wave + i, row = 64 * blk + tl;
            const GAS f32x4* xr = (const GAS f32x4*)(x3 + (size_t)row * D) + lane; const GAS f32x4* gr = (const GAS f32x4*)g + lane;
            f32x4 v[4]; float s = 0.f;
#pragma unroll
            for (int j = 0; j < 4; ++j) { v[j] = xr[64 * j]; s += (v[j][0] * v[j][0] + v[j][1] * v[j][1]) + (v[j][2] * v[j][2] + v[j][3] * v[j][3]); }
            const float rstd = 1.0f / sqrtf(wave_sum(s) * (1.f / D) + EPS);
            float lg[8];
#pragma unroll
            for (int e = 0; e < 8; ++e) lg[e] = 0.f;
#pragma unroll
            for (int j = 0; j < 4; ++j) { const f32x4 gg = gr[64 * j];
#pragma unroll
                for (int q = 0; q < 4; ++q) { const float hv = v[j][q] * rstd * gg[q]; const int k = 4 * (lane + 64 * j) + q;
                    const f32x4 wa = *(const GAS f32x4*)(Wr + (size_t)k * 8), wb = *(const GAS f32x4*)(Wr + (size_t)k * 8 + 4);
                    lg[0] += hv * wa[0]; lg[1] += hv * wa[1]; lg[2] += hv * wa[2]; lg[3] += hv * wa[3]; lg[4] += hv * wb[0]; lg[5] += hv * wb[1]; lg[6] += hv * wb[2]; lg[7] += hv * wb[3]; } }
#pragma unroll
            for (int e = 0; e < 8; ++e) lg[e] = wave_sum(lg[e]);
            int i0 = 0; float v0 = lg[0];
#pragma unroll
            for (int e = 1; e < 8; ++e) if (lg[e] > v0) { v0 = lg[e]; i0 = e; }
            int i1 = 0; float v1 = -INFINITY;
#pragma unroll
            for (int e = 0; e < 8; ++e) if (e != i0 && lg[e] > v1) { v1 = lg[e]; i1 = e; }
            const float g1 = 1.f / (1.f + expf(v0 - v1));
            if (lane == 0) { sel[2 * row] = i0; sel[2 * row + 1] = i1; gate[2 * row] = 1.f - g1; gate[2 * row + 1] = g1; lsel[2 * tl] = i0; lsel[2 * tl + 1] = i1; }
        }
        LDS_WAIT(); __syncthreads();
        if (F.tid < 8) { int c = 0; for (int i = 0; i < 128; ++i) c += (lsel[i] == F.tid) ? 1 : 0; hist[blk * 8 + F.tid] = c; }
        LDS_WAIT(); __syncthreads();
    }
}
__device__ __forceinline__ void p10b_assign(Frame& F) {
    const int* hist = (const int*)(A_WS + WS_HIST); const int* sel = (const int*)(A_WS + WS_SEL); const float* gate = (const float*)(A_WS + WS_GATE); const float* ssq = (const float*)(A_WS + WS_SSQ);
    int* tok_slot = (int*)(A_WS + WS_TOKSLOT); float* rstds = (float*)(A_WS + WS_RSTDS); float* gates = (float*)(A_WS + WS_GATES); int* meta = (int*)(A_WS + WS_META);
    const bf16_t* Xb = (const bf16_t*)(A_WS + WS_XB); bf16_t* XG = (bf16_t*)(A_WS + WS_XG);
    LAS int* pre = (LAS int*)(F.lds + RING_OFF);
    LAS int* tot = pre + 2048;
    LAS int* ebase = tot + 8;
    LAS int* lslot = ebase + 8;
    const int lane = F.lane, e = F.wave;
    { int h[4], run = 0;
#pragma unroll
      for (int i = 0; i < 4; ++i) { h[i] = hist[(4 * lane + i) * 8 + e]; }
      const int mine = h[0] + h[1] + h[2] + h[3]; int inc = mine;
#pragma unroll
      for (int o = 1; o < 64; o <<= 1) { const int t = __shfl_up(inc, o); if (lane >= o) inc += t; }
      run = inc - mine;
#pragma unroll
      for (int i = 0; i < 4; ++i) { pre[(4 * lane + i) * 8 + e] = run; run += h[i]; }
      if (lane == 63) tot[e] = inc; }
    LDS_WAIT(); __syncthreads();
    if (F.tid == 0) { int b = 0; for (int k = 0; k < 8; ++k) { ebase[k] = b; if (blockIdx.x == 0) meta[k] = b >> 8; b += (tot[k] + 255) & ~255; } if (blockIdx.x == 0) meta[8] = b >> 8; }
    LDS_WAIT(); __syncthreads();
    for (int blk = blockIdx.x; blk < M / 64; blk += F.G) {
        if (F.wave == 0) { const int t = 64 * blk + lane; const int s0 = sel[2 * t], s1 = sel[2 * t + 1]; int sl0 = 0, sl1 = 0;
            const unsigned long long below = (1ull << lane) - 1ull;
#pragma unroll
            for (int k = 0; k < 8; ++k) { const unsigned long long m0 = __ballot(s0 == k), m1 = __ballot(s1 == k); const int b0 = ebase[k] + pre[blk * 8 + k];
                if (s0 == k) sl0 = b0 + __popcll(m0 & below); if (s1 == k) sl1 = b0 + __popcll(m0) + __popcll(m1 & below); }
            tok_slot[2 * t] = sl0; tok_slot[2 * t + 1] = sl1; lslot[2 * lane] = sl0; lslot[2 * lane + 1] = sl1;
            const float rs = pg8::rstd_of(ssq, t); rstds[sl0] = rs; rstds[sl1] = rs; gates[sl0] = gate[2 * t]; gates[sl1] = gate[2 * t + 1]; }
        LDS_WAIT(); __syncthreads();
        for (int i = 0; i < 8; ++i) { const int tl = 8 * F.wave + i; const size_t t = (size_t)(64 * blk + tl);
            const v4u a = *(const GAS v4u*)(Xb + t * D + 16 * lane), b = *(const GAS v4u*)(Xb + t * D + 16 * lane + 8);
            const int sl0 = lslot[2 * tl], sl1 = lslot[2 * tl + 1];
            *(GAS v4u*)(XG + (size_t)sl0 * D + 16 * lane) = a; *(GAS v4u*)(XG + (size_t)sl0 * D + 16 * lane + 8) = b;
            *(GAS v4u*)(XG + (size_t)sl1 * D + 16 * lane) = a; *(GAS v4u*)(XG + (size_t)sl1 * D + 16 * lane + 8) = b; }
        LDS_WAIT(); __syncthreads();
    }
}
__device__ __forceinline__ void p13_final(Frame& F) {
    const int* tok_slot = (const int*)(A_WS + WS_TOKSLOT); const bf16_t* Y = (const bf16_t*)(A_WS + WS_Y); float* out = A_OUT;
    const int gw = F.vcu * NWAVES + F.wave, NGW = F.G * NWAVES, lane = F.lane;
    for (int row = gw; row < M; row += NGW) { const int s0 = tok_slot[2 * row], s1 = tok_slot[2 * row + 1];
        GAS f32x4* xr = (GAS f32x4*)(out + (size_t)row * D) + lane; const GAS v2u* y0 = (const GAS v2u*)(Y + (size_t)s0 * D) + lane; const GAS v2u* y1 = (const GAS v2u*)(Y + (size_t)s1 * D) + lane;
#pragma unroll
        for (int j = 0; j < 4; ++j) { f32x4 v = xr[64 * j]; const v2u a = y0[64 * j], b = y1[64 * j];
            v[0] += bflo(a.x) + bflo(b.x); v[1] += bfhi(a.x) + bfhi(b.x); v[2] += bflo(a.y) + bflo(b.y); v[3] += bfhi(a.y) + bfhi(b.y); xr[64 * j] = v; } }
}

__global__ void __launch_bounds__(NWAVES * 64, 2) mega_fwd(Args args) {
    extern __shared__ __attribute__((aligned(16))) unsigned char lds[];
    Frame F;
    F.lds = (LAS unsigned char*)lds; F.tid = threadIdx.x; F.lane = F.tid & 63; F.wave = __builtin_amdgcn_readfirstlane(F.tid >> 6);
    F.G = gridDim.x; { const int bx = blockIdx.x; F.vcu = (F.G % 8 == 0) ? (bx % 8) * (F.G / 8) + bx / 8 : bx; }
    for (int u = F.tid; u < RING_OFF / 4; u += NWAVES * 64) ((LAS unsigned*)(F.lds + MISC_OFF))[u] = 0u;
    __syncthreads();
    if (KA->ph_hi - KA->ph_lo > 1) (void)xcd_barrier_post((unsigned*)(A_WS + WS_CTL) + CW_BAR + KA->li * XCD_BAR_WORDS, (volatile LAS unsigned*)(F.lds + MISC_OFF + 32));
#define IN(k) (KA->ph_lo <= (k) && (k) < KA->ph_hi)
#define SEAM(k) do { if (IN(k) && IN((k) + 1)) { XcdBarrier b_; b_.bar = (unsigned*)(A_WS + WS_CTL) + CW_BAR + KA->li * XCD_BAR_WORDS; b_.x = xb_xcc_id(); b_.st = (volatile LAS unsigned*)(F.lds + MISC_OFF + 32); xcd_barrier(b_); } } while (0)
#define ws A_WS
#define XB ((bf16_t*)(A_WS + WS_XB))
#define SSQ ((float*)(A_WS + WS_SSQ))

    if (IN(0)) { p0_prologue(F, KA->jobmask); } SEAM(0);
    if (IN(1)) { pg8::Gemm g{(const bf16_t*)(ws + WS_XN0), (const bf16_t*)(ws + WS_W_IN), M, 3072, 1024}; pg8::StaticOrder S; S.init(M, 3072, F.G, (int)blockIdx.x);
        pg8::EpiInProj E{(bf16_t*)(ws + WS_BB), (bf16_t*)(ws + WS_UB)};
        pg8::gemm_phase<pg8::EpiInProj, pg8::StaticOrder, true, true>(F.lds + RING_OFF, g, S, E); } SEAM(1);
    if (IN(2)) { p2_conv(F); } SEAM(2);
    if (IN(3)) { pg8::Gemm g{(const bf16_t*)(ws + WS_G), (const bf16_t*)(ws + WS_W_OUT), M, 1024, 1024}; pg8::StaticOrder S; S.init(M, 1024, F.G, (int)blockIdx.x);
        pg8::EpiResidSsq E{INP(0), A_OUT, XB, SSQ};
        pg8::gemm_phase<pg8::EpiResidSsq, pg8::StaticOrder, false, true>(F.lds + RING_OFF, g, S, E); } SEAM(3);
    if (IN(4)) { pg8::Gemm g{XB, (const bf16_t*)(ws + WS_W_GU), M, 5632, 1024}; pg8::StaticOrder S; S.init(M, 5632, F.G, (int)blockIdx.x);
        pg8::EpiSwiGLU E{(bf16_t*)(ws + WS_HACT), DFF, SSQ, nullptr, 22};
        pg8::gemm_phase<pg8::EpiSwiGLU, pg8::StaticOrder, true, true>(F.lds + RING_OFF, g, S, E); } SEAM(4);
    if (IN(5)) { pg8::Gemm g{(const bf16_t*)(ws + WS_HACT), (const bf16_t*)(ws + WS_W_DN), M, 1024, DFF}; pg8::StaticOrder S; S.init(M, 1024, F.G, (int)blockIdx.x);
        pg8::EpiResidSsq E{A_OUT, A_OUT, XB, SSQ};
        pg8::gemm_phase<pg8::EpiResidSsq, pg8::StaticOrder, false, true>(F.lds + RING_OFF, g, S, E); } SEAM(5);
    if (IN(6)) { pg8::Gemm g{XB, (const bf16_t*)(ws + WS_W_QKV), M, 3072, 1024}; pg8::StaticOrder S; S.init(M, 3072, F.G, (int)blockIdx.x);
        pg8::EpiQKV E{(bf16_t*)(ws + WS_Q), (bf16_t*)(ws + WS_K), (bf16_t*)(ws + WS_V), SSQ, INP(10), INP(8), attn_body::C2};
        pg8::gemm_phase<pg8::EpiQKV, pg8::StaticOrder, true, true>(F.lds + RING_OFF, g, S, E); } SEAM(6);
    if (IN(7)) {
        for (int vh = F.vcu; vh < BATCH * 32; vh += F.G) { const int b = vh >> 5, r = vh & 31, h = r >> 2, c = (r >> 1) & 1, vhalf = r & 1;
            attn_body::bf16* O = (attn_body::bf16*)(ws + (c ? WS_O1 : WS_O0));
            for (int qb = SEQ / 256 - 1; qb >= 0; --qb)
                attn_body::attn_unit<8>(b, (2 * h + c) * 64, h * 128 + vhalf * 64, qb, (const attn_body::bf16*)(ws + WS_Q), (const attn_body::bf16*)(ws + WS_K), (const attn_body::bf16*)(ws + WS_V), O, (char*)lds + RING_OFF); }
    } SEAM(7);
    if (IN(8)) { p8_diff(F); } SEAM(8);
    if (IN(9)) { pg8::Gemm g{(const bf16_t*)(ws + WS_ON), (const bf16_t*)(ws + WS_W_O), M, 1024, 1024}; pg8::StaticOrder S; S.init(M, 1024, F.G, (int)blockIdx.x);
        pg8::EpiResidSsq E{A_OUT, A_OUT, XB, SSQ};
        pg8::gemm_phase<pg8::EpiResidSsq, pg8::StaticOrder, false, true>(F.lds + RING_OFF, g, S, E); } SEAM(9);
    if (IN(10)) { p10a_router(F); } SEAM(10);
    if (IN(11)) { p10b_assign(F); } SEAM(11);
    if (IN(12)) { pg8::Gemm g{(const bf16_t*)(ws + WS_XG), (const bf16_t*)(ws + WS_W_MGU), SLOTS, 8 * 7168, 1024}; pg8::MoeOrder S; S.init((const int*)(ws + WS_META), 28, F.G, (int)blockIdx.x);
        pg8::EpiSwiGLU E{(bf16_t*)(ws + WS_HM), DFE, nullptr, (const float*)(ws + WS_RSTDS), 28};
        pg8::gemm_phase<pg8::EpiSwiGLU, pg8::MoeOrder, true, true>(F.lds + RING_OFF, g, S, E); } SEAM(12);
    if (IN(13)) { pg8::Gemm g{(const bf16_t*)(ws + WS_HM), (const bf16_t*)(ws + WS_W_MDN), SLOTS, 8 * 1024, DFE}; pg8::MoeOrder S; S.init((const int*)(ws + WS_META), 4, F.G, (int)blockIdx.x);
        pg8::EpiMoeDown E{(bf16_t*)(ws + WS_Y), (const float*)(ws + WS_GATES)};
        pg8::gemm_phase<pg8::EpiMoeDown, pg8::MoeOrder, true, true>(F.lds + RING_OFF, g, S, E); } SEAM(13);
    if (IN(14)) { p13_final(F); }
#undef IN
#undef SEAM
#undef ws
#undef XB
#undef SSQ
}
#ifndef MEGA_UPTO
#define MEGA_UPTO 15
#endif
#ifndef MEGA_ONE
#define MEGA_ONE 1
#endif
extern "C" void kernel_launch(void* const* d_in, const int* in_sizes, int n_in, void* d_out, int out_size, void* d_ws, size_t ws_size, hipStream_t stream) {
    static int grid = 0;
    if (grid == 0) {
        if (n_in != 19 || in_sizes[0] != M * D || out_size != M * D || ws_size < WS_END) { fprintf(stderr, "kernel_launch: unexpected shapes / workspace (%d inputs, ws %zu, need %zu)\n", n_in, ws_size, (size_t)WS_END); grid = -1; return; }
        int dev = 0, cus = 0, per_cu = 0;
        if (hipGetDevice(&dev) != hipSuccess || hipDeviceGetAttribute(&cus, hipDeviceAttributeMultiprocessorCount, dev) != hipSuccess) { grid = -1; return; }
        if (hipFuncSetAttribute((const void*)mega_fwd, hipFuncAttributeMaxDynamicSharedMemorySize, LDS_BYTES) != hipSuccess) { fprintf(stderr, "kernel_launch: hipFuncSetAttribute failed\n"); grid = -1; return; }
        if (hipOccupancyMaxActiveBlocksPerMultiprocessor(&per_cu, (const void*)mega_fwd, NWAVES * 64, LDS_BYTES) != hipSuccess || per_cu < 1) fprintf(stderr, "kernel_launch: note: occupancy query says %d\n", per_cu);
        (void)hipGetLastError();
        grid = cus < 256 ? cus : 256;
        if (grid != 256) fprintf(stderr, "kernel_launch: %d CUs; this kernel is built for 256\n", cus);
    }
    if (grid < 0) return;
    unsigned char* ws = (unsigned char*)d_ws; float* out = (float*)d_out;
    const float* x = (const float*)d_in[0]; const float* ln_mix = (const float*)d_in[1]; const float* ln_ffn = (const float*)d_in[2];
    const float* conv_w_in = (const float*)d_in[3]; const float* conv_w = (const float*)d_in[4]; const float* conv_w_out = (const float*)d_in[5];
    const float* ln_kv = (const float*)d_in[6]; const float* w_kv = (const float*)d_in[7]; const float* k_norm = (const float*)d_in[8];
    const float* attn_w_q = (const float*)d_in[9]; const float* q_norm = (const float*)d_in[10]; const float* lam_params = (const float*)d_in[11];
    const float* sub_norm = (const float*)d_in[12]; const float* attn_w_o = (const float*)d_in[13]; const float* ffn_w_gu = (const float*)d_in[14];
    const float* ffn_w_down = (const float*)d_in[15]; const float* router_w = (const float*)d_in[16]; const float* moe_w_gu = (const float*)d_in[17];
    const float* moe_w_down = (const float*)d_in[18];
    constexpr int UPTO = MEGA_UPTO;
    static_assert(UPTO == 0 || UPTO == 4 || UPTO == 6 || UPTO == 7 || UPTO == 9 || UPTO == 10 || UPTO == 15, "MEGA_UPTO");
    if (UPTO > 0) {
        if (hipMemsetAsync(ws + WS_CTL, 0, CTL_ZERO_BYTES, stream) != hipSuccess) { fprintf(stderr, "kernel_launch: memset failed\n"); return; }
        Args a{};
        for (int i = 0; i < 19; ++i) a.in[i] = (const float*)d_in[i];
        a.out = out; a.wsp = ws;
        a.jobmask = UPTO >= 15 ? 255 : UPTO >= 10 ? 63 : UPTO >= 7 ? 31 : UPTO >= 6 ? 15 : 3;
        if (MEGA_ONE) { a.ph_lo = 0; a.ph_hi = UPTO; a.li = 0; hipLaunchKernelGGL(mega_fwd, dim3(grid), dim3(NWAVES * 64), LDS_BYTES, stream, a); }
        else for (int p = 0; p < UPTO; ++p) { a.ph_lo = p; a.ph_hi = p + 1; a.li = 0; hipLaunchKernelGGL(mega_fwd, dim3(grid), dim3(NWAVES * 64), LDS_BYTES, stream, a); }
        const hipError_t le = hipPeekAtLastError();
        if (le != hipSuccess) fprintf(stderr, "kernel_launch: launch failed: %s\n", hipGetErrorName(le));
    }
    if (UPTO >= 15) return;
    bf16_t* Wt_in = (bf16_t*)(ws + WS_W_IN); bf16_t* Wt_out = (bf16_t*)(ws + WS_W_OUT); bf16_t* Wt_gu = (bf16_t*)(ws + WS_W_GU); bf16_t* Wt_dn = (bf16_t*)(ws + WS_W_DN);
    bf16_t* Wt_kv = (bf16_t*)(ws + WS_W_QKV); bf16_t* Wt_q = (bf16_t*)(ws + WS_W_QKV + (size_t)2048 * 1024 * 2); bf16_t* Wt_o = (bf16_t*)(ws + WS_W_O);
    bf16_t* Wt_mgu = (bf16_t*)(ws + WS_W_MGU); bf16_t* Wt_mdn = (bf16_t*)(ws + WS_W_MDN);
    bf16_t* HB = (bf16_t*)(ws + WS_HB); bf16_t* HB2 = (bf16_t*)(ws + WS_HB2); float* Yf = (float*)(ws + WS_YF);
    unsigned char* U = ws + WS_R; unsigned char* Vr = ws + WS_S;
    float* F1 = (float*)U; bf16_t* Hact = (bf16_t*)U; float* O0 = (float*)U; float* O1 = O0 + (size_t)M * D;
    float* Qn = (float*)Vr; float* Kn = Qn + (size_t)M * D; float* Vn = Kn + (size_t)M * D; float* Ymoe = (float*)Vr;
    int* sel = (int*)(ws + WS_NAIVE_SMALL); float* gate = (float*)(ws + WS_NAIVE_SMALL + 128 * 1024); int* slot_tok = (int*)(ws + WS_NAIVE_SMALL + 256 * 1024);
    int* tok_slot = (int*)(ws + WS_NAIVE_SMALL + 512 * 1024); int* gbase = (int*)(ws + WS_NAIVE_SMALL + 640 * 1024); int* gcount = gbase + 16;
    float* X = out;
    if (UPTO < 4) {
        k_wt<<<dim3(3072 / 32, D / 32, 1), 256, 0, stream>>>(conv_w_in, Wt_in, D, 3072);
        k_wt<<<dim3(D / 32, D / 32, 1), 256, 0, stream>>>(conv_w_out, Wt_out, D, D);
        k_rmsnorm<<<M / 4, 256, 0, stream>>>(x, ln_mix, HB);
        k_gemm<0><<<dim3(3072 / 64, M / 64, 1), 256, 0, stream>>>(HB, D, Wt_in, D, F1, 3072, M, D, 0, nullptr, nullptr, nullptr, 0);
        k_conv<<<M * D / 256, 256, 0, stream>>>(F1, conv_w, HB2);
        k_gemm<0><<<dim3(D / 64, M / 64, 1), 256, 0, stream>>>(HB2, D, Wt_out, D, Yf, D, M, D, 0, nullptr, nullptr, nullptr, 0);
        k_resid_norm<<<M / 4, 256, 0, stream>>>(x, Yf, X, ln_ffn, HB, nullptr, nullptr);
    } else if (UPTO == 4) k_rmsnorm<<<M / 4, 256, 0, stream>>>(X, ln_ffn, HB);
    if (UPTO < 6) {
        k_wt<<<dim3(2 * DFF / 32, D / 32, 1), 256, 0, stream>>>(ffn_w_gu, Wt_gu, D, 2 * DFF);
        k_wt<<<dim3(D / 32, DFF / 32, 1), 256, 0, stream>>>(ffn_w_down, Wt_dn, DFF, D);
        k_gemm<1><<<dim3(DFF / 64, M / 64, 1), 256, 0, stream>>>(HB, D, Wt_gu, D, Hact, DFF, M, D, DFF, nullptr, nullptr, nullptr, 0);
        k_gemm<0><<<dim3(D / 64, M / 64, 1), 256, 0, stream>>>(Hact, DFF, Wt_dn, DFF, Yf, D, M, DFF, 0, nullptr, nullptr, nullptr, 0);
        k_resid_norm<<<M / 4, 256, 0, stream>>>(X, Yf, X, ln_kv, HB, ln_mix + D, HB2);
    } else if (UPTO == 6) { k_rmsnorm<<<M / 4, 256, 0, stream>>>(X, ln_kv, HB); k_rmsnorm<<<M / 4, 256, 0, stream>>>(X, ln_mix + D, HB2); }
    if (UPTO < 7) {
        k_wt<<<dim3(2048 / 32, D / 32, 1), 256, 0, stream>>>(w_kv, Wt_kv, D, 2048);
        k_wt<<<dim3(D / 32, D / 32, 1), 256, 0, stream>>>(attn_w_q, Wt_q, D, D);
        k_gemm<0><<<dim3(2048 / 64, M / 64, 1), 256, 0, stream>>>(HB, D, Wt_kv, D, F1, 2048, M, D, 0, nullptr, nullptr, nullptr, 0);
        k_headnorm<<<M / 4, 256, 0, stream>>>(F1, 2048, 0, k_norm, 1.f, Kn);
        k_headnorm<<<M / 4, 256, 0, stream>>>(F1, 2048, 1024, nullptr, 1.f, Vn);
        k_gemm<0><<<dim3(D / 64, M / 64, 1), 256, 0, stream>>>(HB2, D, Wt_q, D, Yf, D, M, D, 0, nullptr, nullptr, nullptr, 0);
        k_headnorm<<<M / 4, 256, 0, stream>>>(Yf, D, 0, q_norm, 0.125f, Qn);
        k_attn<float><<<dim3(SEQ / 256, 2 * NH, BATCH), 256, 0, stream>>>(Qn, Kn, Vn, O0, O1, 1.0f);
    } else if (UPTO == 7) k_attn<bf16_t><<<dim3(SEQ / 256, 2 * NH, BATCH), 256, 0, stream>>>((const bf16_t*)(ws + WS_Q), (const bf16_t*)(ws + WS_K), (const bf16_t*)(ws + WS_V), O0, O1, 0.6931471805599453f);
    const bf16_t* ONp = HB;
    if (UPTO < 9) k_diff<<<M / 4, 256, 0, stream>>>(O0, O1, lam_params, sub_norm, HB); else ONp = (const bf16_t*)(ws + WS_ON);
    if (UPTO < 10) {
        k_wt<<<dim3(D / 32, D / 32, 1), 256, 0, stream>>>(attn_w_o, Wt_o, D, D);
        k_gemm<0><<<dim3(D / 64, M / 64, 1), 256, 0, stream>>>(ONp, D, Wt_o, D, Yf, D, M, D, 0, nullptr, nullptr, nullptr, 0);
        k_resid_norm<<<M / 4, 256, 0, stream>>>(X, Yf, X, ln_ffn + D, HB, nullptr, nullptr);
    } else k_rmsnorm<<<M / 4, 256, 0, stream>>>(X, ln_ffn + D, HB);
    k_wt<<<dim3(2 * DFE / 32, D / 32, NE), 256, 0, stream>>>(moe_w_gu, Wt_mgu, D, 2 * DFE);
    k_wt<<<dim3(D / 32, DFE / 32, NE), 256, 0, stream>>>(moe_w_down, Wt_mdn, DFE, D);
    k_router<<<M / 4, 256, 0, stream>>>(X, ln_ffn + D, router_w, sel, gate);
    k_bin<<<1, 1024, 0, stream>>>(sel, slot_tok, tok_slot, gbase, gcount);
    k_gemm<1><<<dim3(DFE / 64, M / 64, NE), 256, 0, stream>>>(HB, D, Wt_mgu, D, Hact, DFE, 0, D, DFE, slot_tok, gbase, gcount, (size_t)2 * DFE * D);
    k_gemm<0><<<dim3(D / 64, M / 64, NE), 256, 0, stream>>>(Hact, DFE, Wt_mdn, DFE, Ymoe, D, 0, DFE, 0, nullptr, gbase, gcount, (size_t)D * DFE);
    k_final<<<M * D / 4 / 256, 256, 0, stream>>>(X, Ymoe, tok_slot, gate, out);
}
```

```cpp
#include <hip/hip_runtime.h>
#include <hip/hip_bf16.h>
#include <stdint.h>
#include <stdio.h>
#include <cmath>
#define MEGA_UPTO 15
#define MEGA_ONE 1
typedef unsigned short bf16_t;
typedef short bf16x8 __attribute__((ext_vector_type(8)));
typedef float f32x4 __attribute__((ext_vector_type(4)));
constexpr int D = 1024, BATCH = 8, SEQ = 2048, M = BATCH * SEQ;
constexpr int NH = 8, HD = 64, VD = 128;
constexpr int DFF = 2816, NE = 8, DFE = 3584;
constexpr float EPS = 1e-6f;
constexpr float LAM_INIT = 0.35550907f;
constexpr int SLOTS = 2 * M + NE * 256;

__device__ __forceinline__ unsigned f2bf(float f) { unsigned u = __builtin_bit_cast(unsigned, f); return (u + 0x7fffu + ((u >> 16) & 1u)) >> 16; }
__device__ __forceinline__ float bf2f(unsigned short b) { return __builtin_bit_cast(float, (unsigned)b << 16); }
__device__ __forceinline__ float wave_sum(float v) {
#pragma unroll
    for (int o = 1; o < 64; o <<= 1) v += __shfl_xor(v, o);
    return v;
}

__global__ __launch_bounds__(256) void k_wt(const float* __restrict__ W, bf16_t* __restrict__ Bt, int K, int N) {
    __shared__ float t[32][33];
    const float* w = W + (size_t)blockIdx.z * K * N; bf16_t* o = Bt + (size_t)blockIdx.z * K * N;
    const int n0 = blockIdx.x * 32, k0 = blockIdx.y * 32, tx = threadIdx.x & 31, ty = threadIdx.x >> 5;
#pragma unroll
    for (int i = 0; i < 4; ++i) t[ty + 8 * i][tx] = w[(size_t)(k0 + ty + 8 * i) * N + n0 + tx];
    __syncthreads();
#pragma unroll
    for (int i = 0; i < 4; ++i) o[(size_t)(n0 + ty + 8 * i) * K + k0 + tx] = (bf16_t)f2bf(t[tx][ty + 8 * i]);
}

__global__ __launch_bounds__(256) void k_rmsnorm(const float* __restrict__ x, const float* __restrict__ g, bf16_t* __restrict__ out) {
    const int row = blockIdx.x * 4 + (threadIdx.x >> 6), lane = threadIdx.x & 63;
    const f32x4* xr = (const f32x4*)(x + (size_t)row * D) + lane; const f32x4* gr = (const f32x4*)g + lane;
    f32x4 v[4]; float s = 0.f;
#pragma unroll
    for (int j = 0; j < 4; ++j) { v[j] = xr[64 * j]; s += v[j].x * v[j].x + v[j].y * v[j].y + v[j].z * v[j].z + v[j].w * v[j].w; }
    const float rstd = rsqrtf(wave_sum(s) * (1.f / D) + EPS);
    unsigned long long* o8 = (unsigned long long*)(out + (size_t)row * D) + lane;
#pragma unroll
    for (int j = 0; j < 4; ++j) { const f32x4 gg = gr[64 * j];
        const unsigned a = f2bf(v[j].x * rstd * gg.x), b = f2bf(v[j].y * rstd * gg.y), c = f2bf(v[j].z * rstd * gg.z), d = f2bf(v[j].w * rstd * gg.w);
        o8[64 * j] = (unsigned long long)(a | (b << 16)) | ((unsigned long long)(c | (d << 16)) << 32); }
}

__global__ __launch_bounds__(256) void k_resid_norm(const float* __restrict__ xold, const float* __restrict__ y, float* __restrict__ xnew,
                                                    const float* __restrict__ g1, bf16_t* __restrict__ o1, const float* __restrict__ g2, bf16_t* __restrict__ o2) {
    const int row = blockIdx.x * 4 + (threadIdx.x >> 6), lane = threadIdx.x & 63;
    const f32x4* xr = (const f32x4*)(xold + (size_t)row * D) + lane; const f32x4* yr = (const f32x4*)(y + (size_t)row * D) + lane;
    f32x4* xo = (f32x4*)(xnew + (size_t)row * D) + lane;
    f32x4 v[4]; float s = 0.f;
#pragma unroll
    for (int j = 0; j < 4; ++j) { v[j] = xr[64 * j] + yr[64 * j]; xo[64 * j] = v[j]; s += v[j].x * v[j].x + v[j].y * v[j].y + v[j].z * v[j].z + v[j].w * v[j].w; }
    const float rstd = rsqrtf(wave_sum(s) * (1.f / D) + EPS);
#pragma unroll
    for (int p = 0; p < 2; ++p) { const float* g = p ? g2 : g1; bf16_t* o = p ? o2 : o1; if (!o) continue;
        const f32x4* gr = (const f32x4*)g + lane; unsigned long long* o8 = (unsigned long long*)(o + (size_t)row * D) + lane;
#pragma unroll
        for (int j = 0; j < 4; ++j) { const f32x4 gg = gr[64 * j];
            const unsigned a = f2bf(v[j].x * rstd * gg.x), b = f2bf(v[j].y * rstd * gg.y), c = f2bf(v[j].z * rstd * gg.z), d = f2bf(v[j].w * rstd * gg.w);
            o8[64 * j] = (unsigned long long)(a | (b << 16)) | ((unsigned long long)(c | (d << 16)) << 32); } }
}

template <int MODE>
__global__ __launch_bounds__(256) void k_gemm(const bf16_t* __restrict__ A, int lda, const bf16_t* __restrict__ Bt, int ldb, void* __restrict__ Cv, int ldc,
                                               int Mtot, int K, int dualOff, const int* __restrict__ arow, const int* __restrict__ gbase, const int* __restrict__ gcount, size_t bstride) {
    const int z = blockIdx.z; int start = 0, count = Mtot;
    if (gbase) { start = gbase[z]; count = gcount[z]; Bt += (size_t)z * bstride; }
    const int mt0 = blockIdx.y * 64; if (mt0 >= count) return;
    const int n0 = blockIdx.x * 64, w = threadIdx.x >> 6, lane = threadIdx.x & 63, r = lane & 15, q = lane >> 4;
    int ml = mt0 + 16 * w + r; if (ml >= count) ml = count - 1;
    const int mrow = start + ml; const int ar = arow ? arow[mrow] : mrow;
    const bf16_t* ap = A + (size_t)ar * lda + 8 * q;
    const bf16_t* bp = Bt + (size_t)(n0 + r) * ldb + 8 * q;
    f32x4 acc[4], acc2[4];
#pragma unroll
    for (int j = 0; j < 4; ++j) { acc[j] = (f32x4){0.f, 0.f, 0.f, 0.f}; acc2[j] = (f32x4){0.f, 0.f, 0.f, 0.f}; }
    for (int k0 = 0; k0 < K; k0 += 32) {
        const bf16x8 a = *(const bf16x8*)(ap + k0);
#pragma unroll
        for (int j = 0; j < 4; ++j) { const bf16x8 b = *(const bf16x8*)(bp + (size_t)(16 * j) * ldb + k0);
            acc[j] = __builtin_amdgcn_mfma_f32_16x16x32_bf16(a, b, acc[j], 0, 0, 0);
            if (MODE == 1) { const bf16x8 b2 = *(const bf16x8*)(bp + (size_t)(16 * j + dualOff) * ldb + k0);
                acc2[j] = __builtin_amdgcn_mfma_f32_16x16x32_bf16(a, b2, acc2[j], 0, 0, 0); } }
    }
#pragma unroll
    for (int j = 0; j < 4; ++j)
#pragma unroll
        for (int i = 0; i < 4; ++i) { const int mo = mt0 + 16 * w + 4 * q + i; if (mo >= count) continue;
            const size_t off = (size_t)(start + mo) * ldc + n0 + 16 * j + r;
            if (MODE == 0) ((float*)Cv)[off] = acc[j][i];
            else { const float g = acc[j][i], u = acc2[j][i]; ((bf16_t*)Cv)[off] = (bf16_t)f2bf(g / (1.f + expf(-g)) * u); } }
}

__global__ __launch_bounds__(256) void k_conv(const float* __restrict__ bcv, const float* __restrict__ cw, bf16_t* __restrict__ G) {
    const int idx = blockIdx.x * 256 + threadIdx.x; const int row = idx >> 10, c = idx & 1023, t = row & (SEQ - 1);
    const float* p = bcv + (size_t)row * 3072;
    float z = cw[2 * D + c] * (p[D + c] * p[2 * D + c]);
    if (t >= 1) z += cw[D + c] * (p[D + c - 3072] * p[2 * D + c - 3072]);
    if (t >= 2) z += cw[c] * (p[D + c - 6144] * p[2 * D + c - 6144]);
    G[idx] = (bf16_t)f2bf(p[c] * z);
}

__global__ __launch_bounds__(256) void k_headnorm(const float* __restrict__ in, int ldin, int c0, const float* __restrict__ gain, float scale, float* __restrict__ out) {
    const int row = blockIdx.x * 4 + (threadIdx.x >> 6), lane = threadIdx.x & 63;
    const f32x4* p = (const f32x4*)(in + (size_t)row * ldin + c0 + 16 * lane);
    f32x4 v[4]; float s = 0.f;
#pragma unroll
    for (int j = 0; j < 4; ++j) { v[j] = p[j]; s += v[j].x * v[j].x + v[j].y * v[j].y + v[j].z * v[j].z + v[j].w * v[j].w; }
    f32x4* o = (f32x4*)(out + (size_t)row * D + 16 * lane);
    if (gain) { s += __shfl_xor(s, 1); s += __shfl_xor(s, 2); const float rstd = rsqrtf(s * (1.f / HD) + EPS) * scale;
        const f32x4* g = (const f32x4*)(gain + 16 * (lane & 3));
#pragma unroll
        for (int j = 0; j < 4; ++j) o[j] = v[j] * rstd * g[j];
    } else {
#pragma unroll
        for (int j = 0; j < 4; ++j) o[j] = v[j]; }
}

__device__ __forceinline__ f32x4 ld4(const float* p) { return *(const f32x4*)p; }
__device__ __forceinline__ f32x4 ld4(const bf16_t* p) { const unsigned long long w = *(const unsigned long long*)p; return (f32x4){bf2f((unsigned short)w), bf2f((unsigned short)(w >> 16)), bf2f((unsigned short)(w >> 32)), bf2f((unsigned short)(w >> 48))}; }
template <typename T>
__global__ __launch_bounds__(256) void k_attn(const T* __restrict__ Q, const T* __restrict__ Kn, const T* __restrict__ V, float* __restrict__ O0, float* __restrict__ O1, float qmul) {
    __shared__ __attribute__((aligned(16))) float Ks[32][64];
    __shared__ __attribute__((aligned(16))) float Vs[32][128];
    const int qb = blockIdx.x, hc = blockIdx.y, b = blockIdx.z, h = hc >> 1, c = hc & 1, tid = threadIdx.x;
    const int qi = qb * 256 + tid; const size_t rowbase = (size_t)b * SEQ;
    float q[64], o[128];
    { const T* qp = Q + (rowbase + qi) * D + h * 128 + c * 64;
#pragma unroll
      for (int j = 0; j < 16; ++j) { const f32x4 t = ld4(qp + 4 * j); q[4 * j] = t.x * qmul; q[4 * j + 1] = t.y * qmul; q[4 * j + 2] = t.z * qmul; q[4 * j + 3] = t.w * qmul; } }
#pragma unroll
    for (int e = 0; e < 128; ++e) o[e] = 0.f;
    float mx = -INFINITY, l = 0.f;
    const int nkt = (qb * 256 + 256) / 32;
    for (int kt = 0; kt < nkt; ++kt) {
        __syncthreads();
#pragma unroll
        for (int i = 0; i < 2; ++i) { const int f = tid + 256 * i, kr = f >> 4, kc = f & 15;
            ((f32x4*)&Ks[0][0])[f] = ld4(Kn + (rowbase + kt * 32 + kr) * D + h * 128 + c * 64 + 4 * kc); }
#pragma unroll
        for (int i = 0; i < 4; ++i) { const int f = tid + 256 * i, kr = f >> 5, kc = f & 31;
            ((f32x4*)&Vs[0][0])[f] = ld4(V + (rowbase + kt * 32 + kr) * D + h * 128 + 4 * kc); }
        __syncthreads();
        for (int kk = 0; kk < 32; ++kk) {
            const int key = kt * 32 + kk; if (key > qi) break;
            float s = 0.f;
#pragma unroll
            for (int d = 0; d < 64; ++d) s += q[d] * Ks[kk][d];
            if (s > mx) { const float al = expf(mx - s); l *= al;
#pragma unroll
                for (int e = 0; e < 128; ++e) o[e] *= al;
                mx = s; }
            const float p = expf(s - mx); l += p;
#pragma unroll
            for (int e = 0; e < 128; ++e) o[e] += p * Vs[kk][e];
        }
    }
    const float il = 1.f / l; float* op = (c ? O1 : O0) + (rowbase + qi) * D + h * 128;
#pragma unroll
    for (int e = 0; e < 128; e += 4) *(f32x4*)(op + e) = (f32x4){o[e] * il, o[e + 1] * il, o[e + 2] * il, o[e + 3] * il};
}

__global__ __launch_bounds__(256) void k_diff(const float* __restrict__ O0, const float* __restrict__ O1, const float* __restrict__ lp, const float* __restrict__ sn, bf16_t* __restrict__ out) {
    const int row = blockIdx.x * 4 + (threadIdx.x >> 6), lane = threadIdx.x & 63;
    const float s01 = wave_sum(lp[lane] * lp[64 + lane]), s23 = wave_sum(lp[128 + lane] * lp[192 + lane]);
    const float lam = expf(s01) - expf(s23) + LAM_INIT;
    const f32x4* a = (const f32x4*)(O0 + (size_t)row * D + 16 * lane); const f32x4* b = (const f32x4*)(O1 + (size_t)row * D + 16 * lane);
    f32x4 v[4]; float s = 0.f;
#pragma unroll
    for (int j = 0; j < 4; ++j) { v[j] = a[j] - b[j] * lam; s += v[j].x * v[j].x + v[j].y * v[j].y + v[j].z * v[j].z + v[j].w * v[j].w; }
    s += __shfl_xor(s, 1); s += __shfl_xor(s, 2); s += __shfl_xor(s, 4);
    const float rstd = rsqrtf(s * (1.f / VD) + EPS) * (1.f - LAM_INIT);
    const f32x4* g = (const f32x4*)(sn + 16 * (lane & 7));
    unsigned long long* o8 = (unsigned long long*)(out + (size_t)row * D + 16 * lane);
#pragma unroll
    for (int j = 0; j < 4; ++j) { const f32x4 gg = g[j];
        const unsigned x0 = f2bf(v[j].x * rstd * gg.x), x1 = f2bf(v[j].y * rstd * gg.y), x2 = f2bf(v[j].z * rstd * gg.z), x3 = f2bf(v[j].w * rstd * gg.w);
        o8[j] = (unsigned long long)(x0 | (x1 << 16)) | ((unsigned long long)(x2 | (x3 << 16)) << 32); }
}

__global__ __launch_bounds__(256) void k_router(const float* __restrict__ x, const float* __restrict__ g, const float* __restrict__ Wr, int* __restrict__ sel, float* __restrict__ gate) {
    const int row = blockIdx.x * 4 + (threadIdx.x >> 6), lane = threadIdx.x & 63;
    const f32x4* xr = (const f32x4*)(x + (size_t)row * D) + lane; const f32x4* gr = (const f32x4*)g + lane;
    f32x4 v[4]; float s = 0.f;
#pragma unroll
    for (int j = 0; j < 4; ++j) { v[j] = xr[64 * j]; s += v[j].x * v[j].x + v[j].y * v[j].y + v[j].z * v[j].z + v[j].w * v[j].w; }
    const float rstd = rsqrtf(wave_sum(s) * (1.f / D) + EPS);
    float lg[8];
#pragma unroll
    for (int e = 0; e < 8; ++e) lg[e] = 0.f;
#pragma unroll
    for (int j = 0; j < 4; ++j) { const f32x4 gg = gr[64 * j]; const float hv[4] = {v[j].x * rstd * gg.x, v[j].y * rstd * gg.y, v[j].z * rstd * gg.z, v[j].w * rstd * gg.w};
#pragma unroll
        for (int i = 0; i < 4; ++i) { const int k = 4 * (lane + 64 * j) + i; const f32x4 w0 = *(const f32x4*)(Wr + (size_t)k * 8), w1 = *(const f32x4*)(Wr + (size_t)k * 8 + 4);
            lg[0] += hv[i] * w0.x; lg[1] += hv[i] * w0.y; lg[2] += hv[i] * w0.z; lg[3] += hv[i] * w0.w; lg[4] += hv[i] * w1.x; lg[5] += hv[i] * w1.y; lg[6] += hv[i] * w1.z; lg[7] += hv[i] * w1.w; } }
#pragma unroll
    for (int e = 0; e < 8; ++e) lg[e] = wave_sum(lg[e]);
    if (lane == 0) {
        int i0 = 0; float v0 = lg[0];
#pragma unroll
        for (int e = 1; e < 8; ++e) if (lg[e] > v0) { v0 = lg[e]; i0 = e; }
        int i1 = -1; float v1 = -INFINITY;
#pragma unroll
        for (int e = 0; e < 8; ++e) if (e != i0 && lg[e] > v1) { v1 = lg[e]; i1 = e; }
        const float g1 = 1.f / (1.f + expf(v0 - v1));
        sel[2 * row] = i0; sel[2 * row + 1] = i1; gate[2 * row] = 1.f - g1; gate[2 * row + 1] = g1;
    }
}

__global__ __launch_bounds__(1024) void k_bin(const int* __restrict__ sel, int* __restrict__ slot_tok, int* __restrict__ tok_slot, int* __restrict__ gbase, int* __restrict__ gcount) {
    __shared__ int cnt[NE][1024];
    __shared__ int base[NE], tot[NE];
    const int tid = threadIdx.x;
#pragma unroll
    for (int e = 0; e < NE; ++e) cnt[e][tid] = 0;
    for (int i = 0; i < 32; ++i) { const int e = sel[tid * 32 + i]; cnt[e][tid] += 1; }
    __syncthreads();
    if (tid < NE) { int run = 0; for (int i = 0; i < 1024; ++i) { const int c = cnt[tid][i]; cnt[tid][i] = run; run += c; } tot[tid] = run; }
    __syncthreads();
    if (tid == 0) { int b = 0; for (int e = 0; e < NE; ++e) { base[e] = b; gbase[e] = b; gcount[e] = tot[e]; b += (tot[e] + 255) & ~255; } }
    __syncthreads();
    for (int i = 0; i < 32; ++i) { const int e = sel[tid * 32 + i]; const int s = base[e] + cnt[e][tid]; cnt[e][tid] += 1; slot_tok[s] = (tid * 32 + i) >> 1; tok_slot[tid * 32 + i] = s; }
    for (int e = 0; e < NE; ++e) { const int padn = ((tot[e] + 255) & ~255) - tot[e]; if (tid < padn) slot_tok[base[e] + tot[e] + tid] = 0; }
}

__global__ __launch_bounds__(256) void k_final(const float* __restrict__ x3, const float* __restrict__ Y, const int* __restrict__ tok_slot, const float* __restrict__ gate, float* __restrict__ out) {
    const int idx = blockIdx.x * 256 + threadIdx.x; const int row = idx >> 8, c4 = idx & 255;
    const int s0 = tok_slot[2 * row], s1 = tok_slot[2 * row + 1]; const float g0 = gate[2 * row], g1 = gate[2 * row + 1];
    const f32x4 a = ((const f32x4*)x3)[idx], y0 = ((const f32x4*)(Y + (size_t)s0 * D))[c4], y1 = ((const f32x4*)(Y + (size_t)s1 * D))[c4];
    ((f32x4*)out)[idx] = a + y0 * g0 + y1 * g1;
}

namespace pg8 {
#define PG8_LAS __attribute__((address_space(3)))
typedef unsigned short bf16_t;
typedef short bf16x8 __attribute__((ext_vector_type(8)));
typedef float f32x4 __attribute__((ext_vector_type(4)));
typedef unsigned u32x4 __attribute__((ext_vector_type(4)));
typedef int i32x4 __attribute__((ext_vector_type(4)));
typedef int i32x8 __attribute__((ext_vector_type(8)));
constexpr int BM = 256, BK = 64, HALF = 128, HTB = HALF * BK * 2  , STAGE_BYTES = 8 * HTB, NXCD = 8, WGM = 8;

__host__ __device__ __forceinline__ int lds_byte(int r, int c) { const int st = (r >> 4) * 2 + (c >> 5), rr = r & 15, cc = c & 31, ob = rr * 64 + cc * 2; return st * 1024 + (ob ^ (((ob >> 9) & 1) << 5)); }
__host__ __device__ __forceinline__ void stage_rc(int b, int& R, int& C) { const int st = b / 1024, sb = b % 1024, swz = sb ^ (((sb >> 9) & 1) << 5); R = (st >> 1) * 16 + swz / 64; C = (st & 1) * 32 + (swz % 64) / 2; }
__host__ __device__ __forceinline__ int perm32(int rho) { const int n = rho >> 4, i = rho & 15; return 8 * (i >> 2) + 4 * n + (i & 3); }

struct Unit { int pm, pn; };
struct Gemm { const bf16_t* A; const bf16_t* Bt; int M, N, K; };

struct StaticOrder {
    int nM, nN, nwg, G, c;
    __host__ __device__ void init(int M, int N, int G_, int c_) { nM = M / BM; nN = N / BM; nwg = nM * nN; G = G_; c = c_; }
    __host__ __device__ bool next(int i, Unit& u) const {
        const long L = (long)i * G + c; if (L >= nwg) return false;
        int wgid = (int)L; { const int q = nwg / NXCD, r = nwg % NXCD, xcd = wgid % NXCD, off = wgid / NXCD; wgid = (xcd < r ? xcd * (q + 1) : r * (q + 1) + (xcd - r) * q) + off; }
        const int nig = WGM * nN, gid = wgid / nig, fm = gid * WGM, gsz = (nM - fm) < WGM ? (nM - fm) : WGM;
        u.pm = fm + ((wgid % nig) % gsz); u.pn = (wgid % nig) / gsz; return true;
    }
    __device__ __forceinline__ void a_ready(const Unit&) const {}
    __device__ __forceinline__ void done(const Unit&) const {}
};

__device__ __forceinline__ unsigned cvt_pk_bf16(float lo, float hi) { unsigned r; asm volatile("v_cvt_pk_bf16_f32 %0, %1, %2" : "=v"(r) : "v"(lo), "v"(hi)); return r; }
typedef float f32x2 __attribute__((ext_vector_type(2)));
typedef unsigned u32x2 __attribute__((ext_vector_type(2)));
constexpr float RMS_EPS = 1e-6f, LOG2E = 1.4426950408889634f;
constexpr int DM_ = 1024;
__device__ __forceinline__ u32x4 pack8(const f32x4 a, const f32x4 b) { u32x4 w; w.x = cvt_pk_bf16(a[0], a[1]); w.y = cvt_pk_bf16(a[2], a[3]); w.z = cvt_pk_bf16(b[0], b[1]); w.w = cvt_pk_bf16(b[2], b[3]); return w; }
__device__ __forceinline__ float rstd_of(const float* ssq, int row) { const f32x4 p = *(const f32x4*)(ssq + (size_t)row * 4); return __builtin_amdgcn_rsqf(((p[0] + p[1]) + (p[2] + p[3])) * (1.0f / 1024.0f) + RMS_EPS); }
__device__ __forceinline__ float silu_mul(float g, float u) { return g * u * __builtin_amdgcn_rcpf(1.0f + __builtin_amdgcn_exp2f(-g * LOG2E)); }

struct EpiInProj {
    static constexpr bool PERM = true, AFTER_DRAIN = false;
    bf16_t* Bb; bf16_t* Ub;
    __device__ __forceinline__ void operator()(const f32x4 (&acc)[2][2][4][2], const Unit& u, int wr, int wc, int fr, int fq) const {
        const int row0 = u.pm * BM + wr * 64 + fr;
        if (u.pn < 4) {
            const int col0 = u.pn * BM + wc * 32 + 8 * fq;
#pragma unroll
            for (int ai = 0; ai < 2; ++ai)
#pragma unroll
                for (int m = 0; m < 4; ++m) { bf16_t* rowp = Bb + (size_t)(row0 + ai * HALF + m * 16) * DM_ + col0;
#pragma unroll
                    for (int bj = 0; bj < 2; ++bj) *(u32x4*)(rowp + bj * HALF) = pack8(acc[ai][bj][m][0], acc[ai][bj][m][1]); }
        } else {
            const int col0 = (u.pn - 4) * 128 + wc * 32 + 8 * fq;
#pragma unroll
            for (int ai = 0; ai < 2; ++ai)
#pragma unroll
                for (int m = 0; m < 4; ++m) { bf16_t* rowp = Ub + (size_t)(row0 + ai * HALF + m * 16) * DM_ + col0;
                    *(u32x4*)rowp = pack8(acc[ai][0][m][0] * acc[ai][1][m][0], acc[ai][0][m][1] * acc[ai][1][m][1]); }
        }
    }
};

struct EpiResidSsq {
    static constexpr bool PERM = false, AFTER_DRAIN = true;
    const float* xold; float* xnew; bf16_t* xb; float* ssq;
    __device__ __forceinline__ void fused(f32x4 (&acc)[2][2][4][2], const Unit& u, int wr, int wc, int fr, int fq, PG8_LAS unsigned char* lds, int wid, int lane) const {
        PG8_LAS float* P = (PG8_LAS float*)lds;
        const int col0 = u.pn * BM + wc * 32 + 4 * fq;
#pragma unroll
        for (int ai = 0; ai < 2; ++ai)
#pragma unroll
            for (int m = 0; m < 4; ++m) { const int r = ai * HALF + wr * 64 + m * 16 + fr; const size_t off = (size_t)(u.pm * BM + r) * DM_ + col0; float s = 0.f;
#pragma unroll
                for (int bj = 0; bj < 2; ++bj)
#pragma unroll
                    for (int n = 0; n < 2; ++n) { const f32x4 v = *(const f32x4*)(xold + off + bj * HALF + n * 16) + acc[ai][bj][m][n];
                        *(f32x4*)(xnew + off + bj * HALF + n * 16) = v;
                        u32x2 w; w.x = cvt_pk_bf16(v[0], v[1]); w.y = cvt_pk_bf16(v[2], v[3]); *(u32x2*)(xb + off + bj * HALF + n * 16) = w;
                        s += (v[0] * v[0] + v[1] * v[1]) + (v[2] * v[2] + v[3] * v[3]); }
                s += __shfl_xor(s, 16); s += __shfl_xor(s, 32);
                if (fq == 0) P[r * 4 + wc] = s;
                if (m & 1) asm volatile("" ::: "memory"); }
        asm volatile("s_waitcnt lgkmcnt(0)" ::: "memory"); __builtin_amdgcn_s_barrier(); asm volatile("" ::: "memory");
        const int t = wid * 64 + lane;
        if (t < 256) { const PG8_LAS f32x4* Pr = (const PG8_LAS f32x4*)lds; const f32x4 p = Pr[t]; ssq[(size_t)(u.pm * BM + t) * 4 + u.pn] = (p[0] + p[1]) + (p[2] + p[3]); }
        asm volatile("s_waitcnt lgkmcnt(0)" ::: "memory"); __builtin_amdgcn_s_barrier(); asm volatile("" ::: "memory");
    }
};

struct EpiSwiGLU {
    static constexpr bool PERM = true, AFTER_DRAIN = false;
    bf16_t* H; int ldh; const float* ssq; const float* rstd; int ncol;
    __device__ __forceinline__ void operator()(const f32x4 (&acc)[2][2][4][2], const Unit& u, int wr, int wc, int fr, int fq) const {
        const int row0 = u.pm * BM + wr * 64 + fr, col0 = (u.pn % ncol) * 128 + wc * 32 + 8 * fq;
#pragma unroll
        for (int ai = 0; ai < 2; ++ai)
#pragma unroll
            for (int m = 0; m < 4; ++m) { const int row = row0 + ai * HALF + m * 16; const float rs = ssq ? rstd_of(ssq, row) : rstd[row];
                f32x4 h[2];
#pragma unroll
                for (int n = 0; n < 2; ++n) { const f32x4 g = acc[ai][0][m][n] * rs, uu = acc[ai][1][m][n] * rs;
#pragma unroll
                    for (int j = 0; j < 4; ++j) h[n][j] = silu_mul(g[j], uu[j]); }
                *(u32x4*)(H + (size_t)row * ldh + col0) = pack8(h[0], h[1]); }
    }
};

struct EpiQKV {
    static constexpr bool PERM = true, AFTER_DRAIN = false;
    bf16_t *Q, *K, *V; const float* ssq; const float* qg; const float* kg; float qscale;
    __device__ __forceinline__ void operator()(const f32x4 (&acc)[2][2][4][2], const Unit& u, int wr, int wc, int fr, int fq) const {
        const int row0 = u.pm * BM + wr * 64 + fr;
        if (u.pn < 8) {
            const bool isq = u.pn < 4; bf16_t* base = isq ? Q : K; const float* gn = isq ? qg : kg; const float sc = isq ? qscale : 1.0f;
            const int col0 = (4 * (u.pn & 3) + wc) * 64 + 8 * fq;
            f32x4 gv[2][2];
#pragma unroll
            for (int bj = 0; bj < 2; ++bj)
#pragma unroll
                for (int n = 0; n < 2; ++n) gv[bj][n] = *(const f32x4*)(gn + 32 * bj + 8 * fq + 4 * n);
#pragma unroll
            for (int ai = 0; ai < 2; ++ai)
#pragma unroll
                for (int m = 0; m < 4; ++m) { const int row = row0 + ai * HALF + m * 16; const float rs = rstd_of(ssq, row);
                    f32x4 v[2][2]; float ss = 0.f;
#pragma unroll
                    for (int bj = 0; bj < 2; ++bj)
#pragma unroll
                        for (int n = 0; n < 2; ++n) { v[bj][n] = acc[ai][bj][m][n] * rs; ss += (v[bj][n][0] * v[bj][n][0] + v[bj][n][1] * v[bj][n][1]) + (v[bj][n][2] * v[bj][n][2] + v[bj][n][3] * v[bj][n][3]); }
                    ss += __shfl_xor(ss, 16); ss += __shfl_xor(ss, 32);
                    const float r2 = __builtin_amdgcn_rsqf(ss * (1.0f / 64.0f) + RMS_EPS) * sc;
#pragma unroll
                    for (int bj = 0; bj < 2; ++bj) *(u32x4*)(base + (size_t)row * DM_ + col0 + 32 * bj) = pack8(v[bj][0] * r2 * gv[bj][0], v[bj][1] * r2 * gv[bj][1]); }
        } else {
            const int col0 = (u.pn - 8) * BM + wc * 32 + 8 * fq;
#pragma unroll
            for (int ai = 0; ai < 2; ++ai)
#pragma unroll
                for (int m = 0; m < 4; ++m) { const int row = row0 + ai * HALF + m * 16; const float rs = rstd_of(ssq, row);
#pragma unroll
                    for (int bj = 0; bj < 2; ++bj) *(u32x4*)(V + (size_t)row * DM_ + col0 + bj * HALF) = pack8(acc[ai][bj][m][0] * rs, acc[ai][bj][m][1] * rs); }
        }
    }
};

__device__ __forceinline__ float clamp448(float x) { return __builtin_amdgcn_fmed3f(x, -448.0f, 448.0f); }
__device__ __forceinline__ unsigned pk4_fp8(float a, float b, float c, float d) { int w = 0; w = __builtin_amdgcn_cvt_pk_fp8_f32(clamp448(a), clamp448(b), w, false); w = __builtin_amdgcn_cvt_pk_fp8_f32(clamp448(c), clamp448(d), w, true); return (unsigned)w; }
constexpr float F8_SA = 4.0f, F8_SWG = 256.0f, F8_SH = 8.0f, F8_SWD = 512.0f;

struct EpiSwiGLU8 {
    static constexpr bool PERM = true, AFTER_DRAIN = false;
    unsigned char* H; int ldh; int ncol;
    __device__ __forceinline__ void operator()(const f32x4 (&acc)[2][2][4][2], const Unit& u, int wr, int wc, int fr, int fq) const {
        const int row0 = u.pm * BM + wr * 64 + fr, col0 = (u.pn % ncol) * 128 + wc * 32 + 8 * fq; constexpr float cs = 1.0f / (F8_SA * F8_SWG);
#pragma unroll
        for (int ai = 0; ai < 2; ++ai)
#pragma unroll
            for (int m = 0; m < 4; ++m) { const int row = row0 + ai * HALF + m * 16; f32x4 h[2];
#pragma unroll
                for (int n = 0; n < 2; ++n) { const f32x4 g = acc[ai][0][m][n] * cs, uu = acc[ai][1][m][n] * (cs * F8_SH);
#pragma unroll
                    for (int j = 0; j < 4; ++j) h[n][j] = silu_mul(g[j], uu[j]); }
                u32x2 w; w.x = pk4_fp8(h[0][0], h[0][1], h[0][2], h[0][3]); w.y = pk4_fp8(h[1][0], h[1][1], h[1][2], h[1][3]);
                *(u32x2*)(H + (size_t)row * ldh + col0) = w; }
    }
};

struct EpiMoeDown {
    static constexpr bool PERM = true, AFTER_DRAIN = false;
    bf16_t* Y; const float* gate; float scale;
    __device__ __forceinline__ void operator()(const f32x4 (&acc)[2][2][4][2], const Unit& u, int wr, int wc, int fr, int fq) const {
        const int row0 = u.pm * BM + wr * 64 + fr, col0 = (u.pn & 3) * BM + wc * 32 + 8 * fq;
#pragma unroll
        for (int ai = 0; ai < 2; ++ai)
#pragma unroll
            for (int m = 0; m < 4; ++m) { const int row = row0 + ai * HALF + m * 16; const float gt = gate[row] * scale;
#pragma unroll
                for (int bj = 0; bj < 2; ++bj) *(u32x4*)(Y + (size_t)row * DM_ + col0 + bj * HALF) = pack8(acc[ai][bj][m][0] * gt, acc[ai][bj][m][1] * gt); }
    }
};

struct MoeOrder {
    int nM, nN, nwg, G, c; int t1, t2, t3, t4, t5, t6, t7;
    __device__ __forceinline__ void init(const int* meta, int nN_, int G_, int c_) {
        nM = meta[8]; nN = nN_; nwg = nM * nN; G = G_; c = c_; t1 = meta[1]; t2 = meta[2]; t3 = meta[3]; t4 = meta[4]; t5 = meta[5]; t6 = meta[6]; t7 = meta[7]; }
    __device__ __forceinline__ bool next(int i, Unit& u) const {
        const long L = (long)i * G + c; if (L >= nwg) return false;
        int wgid = (int)L; { const int q = nwg / NXCD, r = nwg % NXCD, xcd = wgid % NXCD, off = wgid / NXCD; wgid = (xcd < r ? xcd * (q + 1) : r * (q + 1) + (xcd - r) * q) + off; }
        const int nig = WGM * nN, gid = wgid / nig, fm = gid * WGM, gsz = (nM - fm) < WGM ? (nM - fm) : WGM;
        const int pm = fm + ((wgid % nig) % gsz), pnl = (wgid % nig) / gsz;
        const int e = (pm >= t1) + (pm >= t2) + (pm >= t3) + (pm >= t4) + (pm >= t5) + (pm >= t6) + (pm >= t7);
        u.pm = pm; u.pn = e * nN + pnl; return true;
    }
    __device__ __forceinline__ void a_ready(const Unit&) const {}
    __device__ __forceinline__ void done(const Unit&) const {}
};
template <class Epi, class Sched, bool ALIGN_EPI = false, bool SP2 = false, bool F8 = false>
__device__ __forceinline__ void gemm_phase(PG8_LAS unsigned char* lds, const Gemm g, const Sched& S, const Epi& E) {
    const int tid = threadIdx.x, wid = __builtin_amdgcn_readfirstlane(tid >> 6), lane = tid & 63, wr = wid >> 2, wc = wid & 3, fr = lane & 15, fq = lane >> 4;
    int K_ = g.K; asm volatile("" : "+s"(K_));
    const int K = K_, nt = K / BK;
    unsigned voffA[2], voffB[2];
#pragma unroll
    for (int i = 0; i < 2; ++i) { int R, C; stage_rc(tid * 16 + i * 8192, R, C); const int Rb = Epi::PERM ? ((R & ~31) + perm32(R & 31)) : R;
        voffA[i] = (unsigned)(R * K + C) * 2u; voffB[i] = (unsigned)(Rb * K + C) * 2u; }
    const size_t kstep = (size_t)(BK * 2);
    const size_t hstep = (size_t)HALF * K * 2;
    const size_t tstep = 2 * hstep;
    const unsigned ldsw = (unsigned)wid * 1024u;
    const int kcol = F8 ? 32 * (fq >> 1) + 16 * (fq & 1) : fq * 8;
    const int aoff = lds_byte(wr * 64 + fr, kcol), boff = lds_byte(wc * 32 + fr, kcol);
    constexpr int KSTEP = F8 ? 16 : 1024;
#define PG8_SA(b, h) (((b) * 2 + (h)) * HTB)
#define PG8_SB(b, h) ((4 + (b) * 2 + (h)) * HTB)
#define PG8_STAGE(bufoff, gbase, voff) do { _Pragma("unroll") for (int _i = 0; _i < 2; ++_i) \
        __builtin_amdgcn_global_load_lds((const unsigned*)((const char*)(gbase) + (voff)[_i]), (PG8_LAS unsigned*)(lds + (bufoff) + ldsw + _i * 8192), 16, 0, 0); } while (0)
#define PG8_LDA(dst, b, h) do { _Pragma("unroll") for (int m = 0; m < 4; ++m) _Pragma("unroll") for (int k = 0; k < 2; ++k) dst[m][k] = *(const PG8_LAS bf16x8*)(lds + PG8_SA(b, h) + aoff + m * 2048 + k * KSTEP); } while (0)
#define PG8_LDB(dst, b, h) do { _Pragma("unroll") for (int n = 0; n < 2; ++n) _Pragma("unroll") for (int k = 0; k < 2; ++k) dst[n][k] = *(const PG8_LAS bf16x8*)(lds + PG8_SB(b, h) + boff + n * 2048 + k * KSTEP); } while (0)
#define PG8_CAT8(x) __builtin_shufflevector(__builtin_bit_cast(i32x4, (x)[0]), __builtin_bit_cast(i32x4, (x)[1]), 0, 1, 2, 3, 4, 5, 6, 7)
#define PG8_MMA(ai, bj, At, Bt) do { __builtin_amdgcn_s_setprio(1); _Pragma("unroll") for (int m = 0; m < 4; ++m) _Pragma("unroll") for (int n = 0; n < 2; ++n) { \
        if constexpr (F8) asm volatile("s_nop 1\n\tv_mfma_f32_16x16x128_f8f6f4 %0, %1, %2, %0" : "+v"(acc[ai][bj][m][n]) : "v"(PG8_CAT8(Bt[n])), "v"(PG8_CAT8(At[m]))); \
        else { _Pragma("unroll") for (int k = 0; k < 2; ++k) acc[ai][bj][m][n] = __builtin_amdgcn_mfma_f32_16x16x32_bf16(Bt[n][k], At[m][k], acc[ai][bj][m][n], 0, 0, 0); } } \
        __builtin_amdgcn_s_setprio(0); } while (0)
#define PG8_WAIT_V(n) asm volatile("s_waitcnt vmcnt(" #n ")" ::: "memory")
#define PG8_WAIT_L(n) asm volatile("s_waitcnt lgkmcnt(" #n ")" ::: "memory")
#define PG8_BAR __builtin_amdgcn_s_barrier()
#define PG8_SCHED __builtin_amdgcn_sched_barrier(0)
    Unit cur, nxt; int ui = 0;
    if (!S.next(0, cur)) return;
    f32x4 acc[2][2][4][2];
#pragma unroll
    for (int a = 0; a < 2; ++a)
#pragma unroll
        for (int b = 0; b < 2; ++b)
#pragma unroll
            for (int m = 0; m < 4; ++m)
#pragma unroll
                for (int n = 0; n < 2; ++n) acc[a][b][m][n] = (f32x4){0.f, 0.f, 0.f, 0.f};
    bf16x8 At[4][2], B0[2][2], B1[2][2];
    const char* cA = (const char*)g.A + (size_t)cur.pm * tstep; const char* cB = (const char*)g.Bt + (size_t)cur.pn * tstep;
    S.a_ready(cur);
    if constexpr (SP2) {
        PG8_STAGE(PG8_SB(0, 0), cB, voffB); PG8_STAGE(PG8_SB(0, 1), cB + hstep, voffB); PG8_STAGE(PG8_SA(0, 0), cA, voffA); PG8_STAGE(PG8_SA(0, 1), cA + hstep, voffA);
        if (wr == 1) PG8_BAR;
        PG8_WAIT_V(2); PG8_BAR;
        PG8_STAGE(PG8_SB(1, 0), cB + kstep, voffB); PG8_STAGE(PG8_SA(1, 0), cA + kstep, voffA); PG8_STAGE(PG8_SB(1, 1), cB + hstep + kstep, voffB);
        PG8_WAIT_V(6); PG8_BAR;
    } else {
        PG8_STAGE(PG8_SB(0, 0), cB, voffB); PG8_STAGE(PG8_SA(0, 0), cA, voffA); PG8_STAGE(PG8_SB(0, 1), cB + hstep, voffB); PG8_STAGE(PG8_SA(0, 1), cA + hstep, voffA);
        if (wr == 1) PG8_BAR;
        PG8_WAIT_V(4); PG8_BAR;
        PG8_STAGE(PG8_SB(1, 0), cB + kstep, voffB); PG8_STAGE(PG8_SA(1, 0), cA + kstep, voffA); PG8_STAGE(PG8_SB(1, 1), cB + hstep + kstep, voffB);
        PG8_WAIT_V(6); PG8_BAR;
    }
    for (;;) {
        const bool has_next = S.next(ui + 1, nxt);
        const char* nA = has_next ? (const char*)g.A + (size_t)nxt.pm * tstep : cA; const char* nB = has_next ? (const char*)g.Bt + (size_t)nxt.pn * tstep : cB;
        for (int t = 0; t < nt; t += 2) {
            const bool last = (t == nt - 2);
            const char* a1 = cA + (size_t)(t + 1) * kstep;
            const char* a2 = last ? nA : cA + (size_t)(t + 2) * kstep; const char* b2 = last ? nB : cB + (size_t)(t + 2) * kstep;
            const char* a3 = a2 + kstep; const char* b3 = b2 + kstep;
            if (last && has_next) S.a_ready(nxt);
            if constexpr (SP2) {
            PG8_LDB(B0, 0, 0); PG8_LDB(B1, 0, 1); PG8_SCHED; PG8_LDA(At, 0, 0); PG8_STAGE(PG8_SA(1, 1), a1 + hstep, voffA);
            PG8_WAIT_V(8); PG8_WAIT_L(0); PG8_BAR; PG8_MMA(0, 0, At, B0); PG8_MMA(0, 1, At, B1); PG8_BAR; PG8_SCHED;
            PG8_LDA(At, 0, 1); PG8_STAGE(PG8_SB(0, 0), b2, voffB); PG8_STAGE(PG8_SB(0, 1), b2 + hstep, voffB); PG8_STAGE(PG8_SA(0, 0), a2, voffA);
            PG8_WAIT_V(8); PG8_WAIT_L(0); PG8_BAR; PG8_MMA(1, 0, At, B0); PG8_MMA(1, 1, At, B1); PG8_BAR; PG8_SCHED;
            PG8_LDB(B0, 1, 0); PG8_LDB(B1, 1, 1); PG8_SCHED; PG8_LDA(At, 1, 0); PG8_STAGE(PG8_SA(0, 1), a2 + hstep, voffA);
            PG8_WAIT_V(8); PG8_WAIT_L(0); PG8_BAR; PG8_MMA(0, 0, At, B0); PG8_MMA(0, 1, At, B1); PG8_BAR; PG8_SCHED;
            PG8_LDA(At, 1, 1); PG8_STAGE(PG8_SB(1, 0), b3, voffB); PG8_STAGE(PG8_SB(1, 1), b3 + hstep, voffB); PG8_STAGE(PG8_SA(1, 0), a3, voffA);
            PG8_WAIT_V(8); PG8_WAIT_L(0); PG8_BAR; PG8_MMA(1, 0, At, B0); PG8_MMA(1, 1, At, B1); PG8_BAR; PG8_SCHED;
            } else {
            PG8_LDB(B0, 0, 0); PG8_SCHED; PG8_LDA(At, 0, 0); PG8_STAGE(PG8_SA(1, 1), a1 + hstep, voffA);
            PG8_WAIT_L(8); PG8_BAR; PG8_WAIT_L(0); PG8_MMA(0, 0, At, B0); PG8_BAR; PG8_SCHED;
            PG8_LDB(B1, 0, 1); PG8_STAGE(PG8_SB(0, 0), b2, voffB);
            PG8_BAR; PG8_WAIT_L(0); PG8_MMA(0, 1, At, B1); PG8_BAR;
            PG8_LDA(At, 0, 1); PG8_STAGE(PG8_SA(0, 0), a2, voffA);
            PG8_BAR; PG8_WAIT_L(0); PG8_MMA(1, 0, At, B0); PG8_BAR; PG8_SCHED;
            PG8_STAGE(PG8_SB(0, 1), b2 + hstep, voffB);
            PG8_WAIT_V(6); PG8_BAR; PG8_MMA(1, 1, At, B1); PG8_BAR;
            PG8_LDB(B0, 1, 0); PG8_SCHED; PG8_LDA(At, 1, 0); PG8_STAGE(PG8_SA(0, 1), a2 + hstep, voffA);
            PG8_WAIT_L(8); PG8_BAR; PG8_WAIT_L(0); PG8_MMA(0, 0, At, B0); PG8_BAR; PG8_SCHED;
            PG8_LDB(B1, 1, 1); PG8_STAGE(PG8_SB(1, 0), b3, voffB);
            PG8_BAR; PG8_WAIT_L(0); PG8_MMA(0, 1, At, B1); PG8_BAR;
            PG8_LDA(At, 1, 1); PG8_STAGE(PG8_SA(1, 0), a3, voffA);
            PG8_BAR; PG8_WAIT_L(0); PG8_MMA(1, 0, At, B0); PG8_BAR; PG8_SCHED;
            PG8_STAGE(PG8_SB(1, 1), b3 + hstep, voffB);
            PG8_WAIT_V(6); PG8_BAR; PG8_MMA(1, 1, At, B1); PG8_BAR;
            }
        }
        if constexpr (F8) asm volatile("s_nop 15\n\ts_nop 15" ::: "memory");
        if constexpr (ALIGN_EPI) { if (wr == 0) PG8_BAR; }
        if constexpr (!Epi::AFTER_DRAIN) { E(acc, cur, wr, wc, fr, fq); S.done(cur); }
        if (!has_next) break;
#pragma unroll
        for (int a = 0; a < 2; ++a)
#pragma unroll
            for (int b = 0; b < 2; ++b)
#pragma unroll
                for (int m = 0; m < 4; ++m)
#pragma unroll
                    for (int n = 0; n < 2; ++n) acc[a][b][m][n] = (f32x4){0.f, 0.f, 0.f, 0.f};
        cur = nxt; cA = nA; cB = nB; ++ui;
        if constexpr (ALIGN_EPI) { if (wr == 1) PG8_BAR; }
    }
    PG8_WAIT_V(0);
    if constexpr (!ALIGN_EPI) { if (wr == 0) PG8_BAR; }
    PG8_BAR;
    if constexpr (Epi::AFTER_DRAIN) { E.fused(acc, cur, wr, wc, fr, fq, lds, wid, lane); S.done(cur); }
#undef PG8_SA
#undef PG8_SB
#undef PG8_STAGE
#undef PG8_LDA
#undef PG8_LDB
#undef PG8_MMA
#undef PG8_CAT8
#undef PG8_WAIT_V
#undef PG8_WAIT_L
#undef PG8_BAR
#undef PG8_SCHED
}
}
#include <hip/hip_bf16.h>
#include <cmath>
namespace attn_body {
using bf16=__hip_bfloat16;
using bf16x8=__attribute__((ext_vector_type(8)))short;
using s16x4=__attribute__((ext_vector_type(4)))short;
using f32x16=__attribute__((ext_vector_type(16)))float;
using u32x4=__attribute__((ext_vector_type(4)))unsigned;
constexpr int BATCH=8,NHEAD=16,SEQ=2048,D=64,DM=NHEAD*D;
constexpr int NW=8,QBLK=32,QB=QBLK*NW,KVBLK=64,NQB=SEQ/QB;
constexpr int ATTN_PITCH=DM, ATTN_UNIT_ROWS=QB;
__device__ __forceinline__ int crow(int r,int hi){return (r&3)+8*(r>>2)+4*hi;}
#define SBAR() __builtin_amdgcn_sched_barrier(0)
__device__ __forceinline__ void cmask(f32x16&p0,f32x16&p1,int jb,int qrel,int hi){
  const float NEG=-INFINITY; int kb=64*jb+4*hi;
  #pragma unroll
  for(int r=0;r<16;++r){int kv=kb+(r&3)+8*(r>>2); if(kv>qrel)p0[r]=NEG; if(kv+32>qrel)p1[r]=NEG;}
}

constexpr int NSLOT=3, SLOTB=8192;
constexpr int LDS_K=0, LDS_V=NSLOT*SLOTB, LDS_WS=2*NSLOT*SLOTB, LDS_OST=LDS_WS+NW*64*4, LDS_BYTES=LDS_OST+NW*4096;
constexpr float C2=0.125f*1.4426950408889634f;
__device__ __forceinline__ void glds16(const void*gsrc,unsigned lds_dst){unsigned keep;
  asm volatile("s_mov_b32 %0, m0\n\ts_mov_b32 m0, %2\n\ts_nop 0\n\tglobal_load_lds_dwordx4 %1, off\n\ts_mov_b32 m0, %0":"=&s"(keep):"v"(gsrc),"s"(lds_dst):"memory");}
__device__ __forceinline__ float max3f(float a,float b,float c){float r;asm("v_max3_f32 %0, %1, %2, %3":"=v"(r):"v"(a),"v"(b),"v"(c));return r;}
__device__ __forceinline__ float max2f(float a,float b){float r;asm("v_max_f32_e32 %0, %1, %2":"=v"(r):"v"(a),"v"(b));return r;}
__device__ __forceinline__ float fadd_s(float a,float b){float r;asm("v_add_f32_e32 %0, %1, %2":"=v"(r):"v"(a),"v"(b));return r;}
__device__ __forceinline__ float fsub_s(float a,float b){float r;asm("v_sub_f32_e32 %0, %1, %2":"=v"(r):"v"(a),"v"(b));return r;}
typedef float f32x2_t __attribute__((ext_vector_type(2))); typedef __bf16 bf16x2_t __attribute__((ext_vector_type(2)));
__device__ __forceinline__ unsigned cvtpk_s(float lo,float hi){f32x2_t v={lo,hi};bf16x2_t b=__builtin_convertvector(v,bf16x2_t);return __builtin_bit_cast(unsigned,b);}
#define WAIT_BAR(N) asm volatile("s_waitcnt vmcnt(" #N ") lgkmcnt(0)\n\ts_barrier":::"memory")

__device__ __forceinline__ void qkt(f32x16&p0,f32x16&p1,const char*Kslot,const bf16x8*qr,const f32x16&negm,int r32,int hi){
  const char*kb=Kslot+hi*1024+r32*16;
  #pragma unroll
  for(int d0=0;d0<4;++d0){
    const bf16x8 b0=*reinterpret_cast<const bf16x8*>(kb+d0*2048);
    const bf16x8 b1=*reinterpret_cast<const bf16x8*>(kb+d0*2048+512);
    if(d0==0){p0=__builtin_amdgcn_mfma_f32_32x32x16_bf16(b0,qr[0],negm,0,0,0);p1=__builtin_amdgcn_mfma_f32_32x32x16_bf16(b1,qr[0],negm,0,0,0);}
    else{p0=__builtin_amdgcn_mfma_f32_32x32x16_bf16(b0,qr[d0],p0,0,0,0);p1=__builtin_amdgcn_mfma_f32_32x32x16_bf16(b1,qr[d0],p1,0,0,0);}}
}
typedef __attribute__((address_space(3))) const char* lds_cptr;
typedef short v4i16_t __attribute__((ext_vector_type(4)));
__device__ __forceinline__ void kload8(bf16x8*kf,lds_cptr kp){
  kf[0]=*(const __attribute__((address_space(3))) bf16x8*)(kp);      kf[1]=*(const __attribute__((address_space(3))) bf16x8*)(kp+512);
  kf[2]=*(const __attribute__((address_space(3))) bf16x8*)(kp+2048); kf[3]=*(const __attribute__((address_space(3))) bf16x8*)(kp+2560);
  kf[4]=*(const __attribute__((address_space(3))) bf16x8*)(kp+4096); kf[5]=*(const __attribute__((address_space(3))) bf16x8*)(kp+4608);
  kf[6]=*(const __attribute__((address_space(3))) bf16x8*)(kp+6144); kf[7]=*(const __attribute__((address_space(3))) bf16x8*)(kp+6656);
}
__device__ __forceinline__ void kload2(bf16x8*kf,lds_cptr kp,int j){ kf[2*j]=*(const __attribute__((address_space(3))) bf16x8*)(kp+j*2048); kf[2*j+1]=*(const __attribute__((address_space(3))) bf16x8*)(kp+j*2048+512); }
__device__ __forceinline__ s16x4 vtr(lds_cptr p){ return __builtin_bit_cast(s16x4,__builtin_amdgcn_ds_read_tr16_b64_v4i16((__attribute__((address_space(3))) v4i16_t*)p)); }
__device__ __forceinline__ float rowmax(const f32x16&p0,const f32x16&p1){
  float a=max3f(p0[0],p0[1],p1[0]),b=max3f(p0[2],p0[3],p1[1]);a=max3f(a,p1[2],p1[3]);
  #pragma unroll
  for(int r=4;r<16;r+=4){a=max3f(a,p0[r],p0[r+1]);b=max3f(b,p0[r+2],p0[r+3]);a=max3f(a,p1[r],p1[r+1]);b=max3f(b,p1[r+2],p1[r+3]);}
  const float m=max2f(a,b);
  auto rr=__builtin_amdgcn_permlane32_swap(__float_as_uint(m),__float_as_uint(m),false,false);
  return max2f(__uint_as_float(rr[0]),__uint_as_float(rr[1]));
}
__device__ __forceinline__ void pv(f32x16*o,int vb,bf16x8 pa0,bf16x8 pa1,bf16x8 pa2,bf16x8 pa3){
  #pragma unroll
  for(int d0=0;d0<2;++d0){s16x4 lo[4],hi[4];
    #pragma unroll
    for(int ks=0;ks<4;++ks){
      asm volatile("ds_read_b64_tr_b16 %0,%1 offset:%c2":"=&v"(lo[ks]):"v"(vb),"i"(d0*4096+ks*1024):"memory");
      asm volatile("ds_read_b64_tr_b16 %0,%1 offset:%c2":"=&v"(hi[ks]):"v"(vb),"i"(d0*4096+ks*1024+512):"memory");}
    asm volatile("s_waitcnt lgkmcnt(0)":::"memory");SBAR();
    #define PK(k) (bf16x8){lo[k][0],lo[k][1],lo[k][2],lo[k][3],hi[k][0],hi[k][1],hi[k][2],hi[k][3]}
    o[d0]=__builtin_amdgcn_mfma_f32_32x32x16_bf16(pa0,PK(0),o[d0],0,0,0);
    o[d0]=__builtin_amdgcn_mfma_f32_32x32x16_bf16(pa1,PK(1),o[d0],0,0,0);
    o[d0]=__builtin_amdgcn_mfma_f32_32x32x16_bf16(pa2,PK(2),o[d0],0,0,0);
    o[d0]=__builtin_amdgcn_mfma_f32_32x32x16_bf16(pa3,PK(3),o[d0],0,0,0);
    #undef PK
  }
}

#ifndef ATTN_STORE16
#define ATTN_STORE16(p,v) (*(u32x4*)(p)=(v))
#endif
template<int THRL> __device__ __forceinline__ void attn_unit(int b,int qcol,int vcol,int qb,const bf16*Q,const bf16*__restrict__ K,const bf16*__restrict__ V,bf16*O,char*shm){
  int tid_=threadIdx.x; asm volatile("":"+v"(tid_));
  const int tid=tid_,lane=tid&63,r32=lane&31,hi=lane>>5; const int wid=__builtin_amdgcn_readfirstlane(tid>>6);
  const long rowbase=(long)b*SEQ; const int q0=qb*QB;
  const bf16*Qw=Q+(rowbase+q0+wid*QBLK)*DM+qcol;
  const bf16*Kh=K+rowbase*DM+qcol,*Vh=V+rowbase*DM+vcol;
  const unsigned lds0=(unsigned)(uintptr_t)shm;
  float*wsf=(float*)(shm+LDS_WS)+wid*64;
  const bf16*ksrc=Kh+(long)lane*DM+wid*8;
  const bf16*vsrc=Vh+(long)(16*(wid&3)+(lane>>2))*DM+(wid>>2)*32+(lane&3)*8;
  const unsigned kdst=lds0+LDS_K+wid*1024, vdst=lds0+LDS_V+wid*1024;
  #define DMA_K(t,slot) glds16(ksrc+(long)(t)*KVBLK*DM,(unsigned)__builtin_amdgcn_readfirstlane(kdst+(slot)))
  #define DMA_V(t,slot) glds16(vsrc+(long)(t)*KVBLK*DM,(unsigned)__builtin_amdgcn_readfirstlane(vdst+(slot)))
  const int vb0=(int)(lds0+LDS_V)+((lane>>4)&1)*32+(lane&3)*8+(4*hi+((lane&15)>>2))*64;
  const char*Kbase=shm+LDS_K; bf16x8 kf[8];
  const lds_cptr shm3=(lds_cptr)shm; const lds_cptr kp0=shm3+LDS_K+hi*1024+r32*16; const lds_cptr vp0=shm3+LDS_V+((lane>>4)&1)*32+(lane&3)*8+(4*hi+((lane&15)>>2))*64;
  const int NT=(q0+QB)/KVBLK;
  DMA_K(0,0);DMA_V(0,0);DMA_K(1,SLOTB);
  bf16x8 qr[4];
  #pragma unroll
  for(int d0=0;d0<4;++d0)qr[d0]=*reinterpret_cast<const bf16x8*>(&Qw[(long)r32*DM+d0*16+hi*8]);
  float mhat=0.f,l_reg=0.f;f32x16 o[2];o[0]=f32x16{};o[1]=f32x16{};f32x16 negm=f32x16{};asm volatile("":"+v"(negm));
  const int qrel=wid*QBLK+r32;
  #define CMASK(P0,P1,t) do{int jb_=(t)-(NT-4); if(jb_>=0)cmask(P0,P1,jb_,qrel,hi);}while(0)
  bool resc=false;
  #define START(P0,P1) do{ const float rm=rowmax(P0,P1); resc=false; \
    { const float dl=rm; mhat=fadd_s(mhat,dl); \
      _Pragma("unroll") for(int r=0;r<16;++r){P0[r]=fsub_s(P0[r],dl);P1[r]=fsub_s(P1[r],dl);} \
      _Pragma("unroll") for(int r=0;r<16;++r)negm[r]=-mhat; asm volatile("":"+v"(negm)); } \
    _Pragma("unroll") for(int r=0;r<16;++r)P0[r]=__builtin_amdgcn_exp2f(P0[r]); }while(0)
  #define RESC() do{ if(resc){ asm volatile("s_waitcnt lgkmcnt(0)":::"memory"); \
      _Pragma("unroll") for(int d_=0;d_<2;++d_) _Pragma("unroll") for(int r=0;r<16;++r)o[d_][r]*=wsf[crow(r,hi)]; } }while(0)
  f32x16 pA0,pA1,pB0,pB1;
  int sl_prev=0,sl_cur=0,sl_next=SLOTB;
  #define ROT() do{sl_prev=sl_cur;sl_cur=sl_next;sl_next=(sl_next==(NSLOT-1)*SLOTB)?0:sl_next+SLOTB;}while(0)
  DMA_K(2,2*SLOTB);
  WAIT_BAR(3);
  qkt(pA0,pA1,Kbase,qr,negm,r32,hi);asm volatile("s_nop 15\n\ts_nop 7":"+v"(pA0),"+v"(pA1));CMASK(pA0,pA1,0);
  START(pA0,pA1);
  _Pragma("unroll") for(int r=0;r<16;++r)pA1[r]=__builtin_amdgcn_exp2f(pA1[r]);
  WAIT_BAR(0);
  DMA_K(3,0);DMA_V(1,SLOTB);
  ROT();
  kload8(kf,kp0+sl_cur);
  WAIT_BAR(2);
  s16x4 vlo[8],vhi[8]; u32x4 pw0,pw1,pw2,pw3;
  #define PKW(P,B) cvtpk_s(P[B],P[B+1])
  #define PAF(k) __builtin_bit_cast(bf16x8,pw##k)
  #define VFR(i) (bf16x8){vlo[i][0],vlo[i][1],vlo[i][2],vlo[i][3],vhi[i][0],vhi[i][1],vhi[i][2],vhi[i][3]}
  #define PIN(x) asm volatile("":"+v"(x))
  #define MX3(a,b,c) __builtin_fmaxf(__builtin_fmaxf((a),(b)),(c))
  #define GAPA(MF,A0,A1,A2,A3,W0,W1,PW) do{ MF; sacc+=A0; sacc+=A1; sacc+=A2; sacc+=A3; PIN(sacc); W0; W1; PIN(PW); SBAR(); }while(0)
  #define EX(v) __builtin_amdgcn_exp2f(v)
  #define GAPB(MF,X,B) do{ MF; X[B]=EX(X[B]); X[B+1]=EX(X[B+1]); X[B+2]=EX(X[B+2]); X[B+3]=EX(X[B+3]); PIN(X); SBAR(); }while(0)
  #define VRD(i) do{ vlo[i]=vtr(vp_+(((i)>>2)*4096+((i)&3)*1024)); vhi[i]=vtr(vp_+(((i)>>2)*4096+((i)&3)*1024+512)); }while(0)
  #define KRD(G,j) do{ if(G){ kload2(kf,kp0+sl_next,j); SBAR(); } }while(0)
  #define STEP(C0,C1,P0,P1,t,GK,GV,GL) do{ SBAR(); \
    const lds_cptr vp_=vp0+sl_prev; \
    VRD(0); SBAR(); float sacc=(P0[0]+P0[1]); \
    GAPA(C0=__builtin_amdgcn_mfma_f32_32x32x16_bf16(kf[0],qr[0],negm,0,0,0), P0[2],P0[3],P0[4],P0[5],     pw0[0]=PKW(P0,0), pw0[1]=PKW(P0,2), pw0); \
    VRD(4); SBAR(); GAPA(C1=__builtin_amdgcn_mfma_f32_32x32x16_bf16(kf[1],qr[0],negm,0,0,0), P0[6],P0[7],P0[8],P0[9],     pw0[2]=PKW(P0,4), pw0[3]=PKW(P0,6), pw0); \
    VRD(1); SBAR(); GAPA(C0=__builtin_amdgcn_mfma_f32_32x32x16_bf16(kf[2],qr[1],C0,0,0,0),   P0[10],P0[11],P0[12],P0[13], pw1[0]=PKW(P0,8), pw1[1]=PKW(P0,10), pw1); \
    VRD(5); SBAR(); GAPA(C1=__builtin_amdgcn_mfma_f32_32x32x16_bf16(kf[3],qr[1],C1,0,0,0),   P0[14],P0[15],P1[0],P1[1],   pw1[2]=PKW(P0,12),pw1[3]=PKW(P0,14), pw1); \
    VRD(2); SBAR(); GAPA(C0=__builtin_amdgcn_mfma_f32_32x32x16_bf16(kf[4],qr[2],C0,0,0,0),   P1[2],P1[3],P1[4],P1[5],     pw2[0]=PKW(P1,0), pw2[1]=PKW(P1,2), pw2); \
    VRD(6); SBAR(); GAPA(C1=__builtin_amdgcn_mfma_f32_32x32x16_bf16(kf[5],qr[2],C1,0,0,0),   P1[6],P1[7],P1[8],P1[9],     pw2[2]=PKW(P1,4), pw2[3]=PKW(P1,6), pw2); \
    VRD(3); SBAR(); GAPA(C0=__builtin_amdgcn_mfma_f32_32x32x16_bf16(kf[6],qr[3],C0,0,0,0),   P1[10],P1[11],P1[12],P1[13], pw3[0]=PKW(P1,8), pw3[1]=PKW(P1,10), pw3); \
    VRD(7); SBAR(); GAPA(C1=__builtin_amdgcn_mfma_f32_32x32x16_bf16(kf[7],qr[3],C1,0,0,0),   P1[14],P1[15],0.f,0.f,       pw3[2]=PKW(P1,12),pw3[3]=PKW(P1,14), pw3); \
    l_reg+=sacc; \
    if(GK){DMA_K((t)+3,sl_cur);} if(GV){DMA_V((t)+1,sl_next);} \
    CMASK(C0,C1,t); \
    { float a=MX3(C0[0],C0[1],C1[0]),b=MX3(C0[2],C0[3],C1[1]); a=MX3(a,C1[2],C1[3]); \
      _Pragma("unroll") for(int r=4;r<16;r+=4){a=MX3(a,C0[r],C0[r+1]);b=MX3(b,C0[r+2],C0[r+3]);a=MX3(a,C1[r],C1[r+1]);b=MX3(b,C1[r+2],C1[r+3]);} \
      float rm=__builtin_fmaxf(a,b); { auto rr=__builtin_amdgcn_permlane32_swap(__float_as_uint(rm),__float_as_uint(rm),false,false); rm=__builtin_fmaxf(__uint_as_float(rr[0]),__uint_as_float(rr[1])); } \
      resc=false; \
      if(__builtin_expect(__any(rm>(float)THRL),0)){ const float dl=__builtin_fmaxf(rm,0.f); mhat+=dl; \
        _Pragma("unroll") for(int r=0;r<16;++r){C0[r]-=dl;C1[r]-=dl;} \
        _Pragma("unroll") for(int r=0;r<16;++r)negm[r]=-mhat; asm volatile("":"+v"(negm)); \
        const float f=__builtin_amdgcn_exp2f(-dl); l_reg*=f; if(hi==0)wsf[r32]=f; resc=true; } } \
    SBAR(); \
    GAPB(o[0]=__builtin_amdgcn_mfma_f32_32x32x16_bf16(PAF(0),VFR(0),o[0],0,0,0), C0,0); \
    GAPB(o[1]=__builtin_amdgcn_mfma_f32_32x32x16_bf16(PAF(0),VFR(4),o[1],0,0,0), C0,4); \
    KRD(GL,0); GAPB(o[0]=__builtin_amdgcn_mfma_f32_32x32x16_bf16(PAF(1),VFR(1),o[0],0,0,0), C0,8); \
    KRD(GL,1); GAPB(o[1]=__builtin_amdgcn_mfma_f32_32x32x16_bf16(PAF(1),VFR(5),o[1],0,0,0), C0,12); \
    KRD(GL,2); GAPB(o[0]=__builtin_amdgcn_mfma_f32_32x32x16_bf16(PAF(2),VFR(2),o[0],0,0,0), C1,0); \
    KRD(GL,3); GAPB(o[1]=__builtin_amdgcn_mfma_f32_32x32x16_bf16(PAF(2),VFR(6),o[1],0,0,0), C1,4); \
    GAPB(o[0]=__builtin_amdgcn_mfma_f32_32x32x16_bf16(PAF(3),VFR(3),o[0],0,0,0), C1,8); \
    GAPB(o[1]=__builtin_amdgcn_mfma_f32_32x32x16_bf16(PAF(3),VFR(7),o[1],0,0,0), C1,12); \
    }while(0)
  int t=1;
  #undef CMASK
  #define CMASK(P0,P1,t) do{}while(0)
  for(;t+5<NT;t+=2){
    STEP(pB0,pB1,pA0,pA1,t,true,true,true);     WAIT_BAR(2); RESC(); ROT();
    STEP(pA0,pA1,pB0,pB1,t+1,true,true,true);   WAIT_BAR(2); RESC(); ROT();
  }
  #undef CMASK
  #define CMASK(P0,P1,t) do{int jb_=(t)-(NT-4); if(jb_>=0)cmask(P0,P1,jb_,qrel,hi);}while(0)
  #define ENDW(tt) do{ if((tt)+3<NT){WAIT_BAR(2);} else if((tt)+2<NT){WAIT_BAR(1);} else {WAIT_BAR(0);} }while(0)
  for(;t+1<NT;t+=2){
    STEP(pB0,pB1,pA0,pA1,t,(t+3<NT),(t+1<NT),(t+1<NT));       ENDW(t);   RESC(); ROT();
    STEP(pA0,pA1,pB0,pB1,t+1,(t+4<NT),(t+2<NT),(t+2<NT));     ENDW(t+1); RESC(); ROT();
  }
  STEP(pB0,pB1,pA0,pA1,NT-1,false,false,false); RESC();
  { float sacc=pB0[0]+pB0[1]; _Pragma("unroll") for(int r=2;r<16;++r)sacc+=pB0[r]; _Pragma("unroll") for(int r=0;r<16;++r)sacc+=pB1[r]; l_reg+=sacc;
    pw0=(u32x4){PKW(pB0,0),PKW(pB0,2),PKW(pB0,4),PKW(pB0,6)};pw1=(u32x4){PKW(pB0,8),PKW(pB0,10),PKW(pB0,12),PKW(pB0,14)};pw2=(u32x4){PKW(pB1,0),PKW(pB1,2),PKW(pB1,4),PKW(pB1,6)};pw3=(u32x4){PKW(pB1,8),PKW(pB1,10),PKW(pB1,12),PKW(pB1,14)};
    SBAR(); pv(o,vb0+sl_cur,PAF(0),PAF(1),PAF(2),PAF(3)); }
  #undef PKW
  #undef PAF
  #undef VFR
  #undef PIN
  #undef MX3
  #undef GAPA
  #undef GAPB
  #undef EX
  #undef VRD
  #undef KRD
  #undef STEP
  #undef ENDW
  {auto rr=__builtin_amdgcn_permlane32_swap(__float_as_uint(l_reg),__float_as_uint(l_reg),false,false);l_reg=__uint_as_float(rr[0])+__uint_as_float(rr[1]);}
  if(hi==0)wsf[32+r32]=l_reg;asm volatile("s_waitcnt lgkmcnt(0)":::"memory");
  float rli[16];
  #pragma unroll
  for(int r=0;r<16;++r)rli[r]=__builtin_amdgcn_rcpf(wsf[32+crow(r,hi)]);
  bf16*Ow=O+(rowbase+q0+wid*QBLK)*DM+vcol;
  { bf16*stg=(bf16*)(shm+LDS_OST)+wid*2048;
    #pragma unroll
    for(int r=0;r<16;++r){const int orow=crow(r,hi);
      #pragma unroll
      for(int d0=0;d0<2;++d0)stg[orow*64+d0*32+r32]=__float2bfloat16(o[d0][r]*rli[r]);}
    asm volatile("s_waitcnt lgkmcnt(0)":::"memory");
    #pragma unroll
    for(int i=0;i<4;++i){const int row=i*8+(lane>>3),ch=lane&7; const u32x4 v=*(const u32x4*)(stg+row*64+ch*8); ATTN_STORE16(Ow+(long)row*DM+ch*8,v);} }
  asm volatile("s_waitcnt lgkmcnt(0)\n\ts_barrier":::"memory");
  #undef DMA_K
  #undef DMA_V
  #undef CMASK
  #undef START
  #undef RESC
  #undef ROT
}
constexpr int ATTN_LDS_BYTES=LDS_BYTES;
#undef SBAR
#undef WAIT_BAR
}
constexpr int NWAVES = 8;
constexpr int NPH = 15;
constexpr size_t MiB = 1u << 20;
constexpr size_t WS_CTL = 0, CTL_ZERO_BYTES = 1 * MiB;
constexpr size_t WS_W_IN = 1 * MiB;
constexpr size_t WS_W_OUT = WS_W_IN + (size_t)3072 * 1024 * 2;
constexpr size_t WS_W_GU = WS_W_OUT + (size_t)1024 * 1024 * 2;
constexpr size_t WS_W_DN = WS_W_GU + (size_t)5632 * 1024 * 2;
constexpr size_t WS_W_QKV = WS_W_DN + (size_t)1024 * 2816 * 2;
constexpr size_t WS_W_O = WS_W_QKV + (size_t)3072 * 1024 * 2;
constexpr size_t WS_W_MGU = WS_W_O + (size_t)1024 * 1024 * 2;
constexpr size_t WS_W_MDN = WS_W_MGU + (size_t)8 * 7168 * 1024 * 2;
constexpr size_t WS_W_END = WS_W_MDN + (size_t)8 * 1024 * 3584 * 2;
constexpr size_t WS_R = 202 * MiB;
constexpr size_t ACT = (size_t)M * D * 2;
constexpr size_t WS_XN0 = WS_R, WS_BB = WS_R + ACT, WS_UB = WS_R + 2 * ACT, WS_G = WS_R + 3 * ACT;
constexpr size_t WS_HACT = WS_R;
constexpr size_t WS_Q = WS_R + 4 * ACT, WS_K = WS_R + 5 * ACT, WS_V = WS_R + 6 * ACT;
constexpr size_t WS_O0 = WS_R, WS_O1 = WS_R + ACT, WS_ON = WS_R + 2 * ACT;
constexpr size_t WS_HM = WS_R;
constexpr size_t WS_S = 440 * MiB;
constexpr size_t WS_XG = WS_S, WS_Y = WS_S + 68 * MiB;
constexpr size_t WS_XB = 632 * MiB;
constexpr size_t WS_HB = 664 * MiB, WS_HB2 = 696 * MiB, WS_YF = 728 * MiB;
constexpr size_t WS_SMALL = 792 * MiB;
constexpr size_t WS_SSQ = WS_SMALL;
constexpr size_t WS_SEL = WS_SMALL + 256 * 1024, WS_GATE = WS_SEL + 128 * 1024, WS_TOKSLOT = WS_GATE + 128 * 1024;
constexpr size_t WS_RSTDS = WS_TOKSLOT + 128 * 1024, WS_GATES = WS_RSTDS + 256 * 1024;
constexpr size_t WS_HIST = WS_GATES + 256 * 1024, WS_META = WS_HIST + 16 * 1024;
constexpr size_t WS_NAIVE_SMALL = WS_SMALL + 2 * MiB;
constexpr size_t WS_END = 796 * MiB;
static_assert(WS_W_END <= WS_R && WS_R + (size_t)SLOTS * DFE * 2 <= WS_S && WS_Y + (size_t)SLOTS * D * 2 <= WS_XB && WS_V + ACT <= WS_S, "d_ws map");
constexpr int CW_TMO = 0, CW_CODE = 1, CW_BAR = 4096;
constexpr int MISC_OFF = 0, RING_OFF = 1024, RING_BYTES = 131072, LDS_BYTES = 147456;
constexpr int P0_SCR = 16640;

#define GAS __attribute__((address_space(1)))
#define LAS __attribute__((address_space(3)))
typedef unsigned v4u __attribute__((ext_vector_type(4)));
typedef unsigned v2u __attribute__((ext_vector_type(2)));
typedef GAS unsigned gu32;
#define RLX_AGENT __ATOMIC_RELAXED, __HIP_MEMORY_SCOPE_AGENT
#define LDS_WAIT() asm volatile("s_waitcnt lgkmcnt(0)" ::: "memory")
#define VM_WAIT() asm volatile("s_waitcnt vmcnt(0)" ::: "memory")
__device__ __forceinline__ unsigned pk2(float lo, float hi) { return f2bf(lo) | (f2bf(hi) << 16); }
__device__ __forceinline__ float bflo(unsigned w) { return __builtin_bit_cast(float, w << 16); }
__device__ __forceinline__ float bfhi(unsigned w) { return __builtin_bit_cast(float, w & 0xffff0000u); }

#define XB_TMO      128
#define XB_XCNT(j)  (256  + 64 * (j))
#define XB_XSUB(j)  (1280 + 64 * (j))
#define XB_XGEN(j)  (2304 + 64 * (j))
#define XB_TOP      3328
#define XB_TOPGEN   3392
#define XCD_BAR_WORDS 3456
#define XB_SPIN_CAP (1u << 18)

__device__ __forceinline__ unsigned xb_ld(unsigned* p)              { return __hip_atomic_load(p, __ATOMIC_RELAXED, __HIP_MEMORY_SCOPE_AGENT); }
__device__ __forceinline__ unsigned xb_add(unsigned* p, unsigned v) { return __hip_atomic_fetch_add(p, v, __ATOMIC_RELAXED, __HIP_MEMORY_SCOPE_AGENT); }
__device__ __forceinline__ unsigned xb_xcc_id() { return (unsigned)__builtin_amdgcn_s_getreg((3 << 11) | 20) & 0xFu; }
#define XB_SPIN(cond, bar) do { unsigned _sp = 0; while (cond) { __builtin_amdgcn_s_sleep(1); \
    if ((++_sp & 255u) == 0u) { if (xb_ld(&(bar)[XB_TMO])) break; if (_sp > XB_SPIN_CAP) { atomicAdd(&(bar)[XB_TMO], 1u); break; } } } } while (0)

struct XcdBarrier {
    unsigned* bar; unsigned x;
    volatile LAS unsigned* st;
};

__device__ __forceinline__ XcdBarrier xcd_barrier_post(unsigned* bar, volatile LAS unsigned* st) {
    XcdBarrier b; b.bar = bar; b.x = xb_xcc_id(); b.st = st;
    if (threadIdx.x == 0) (void)xb_add(&bar[XB_XCNT(b.x)], 1u);
    return b;
}
__device__ __forceinline__ void xcd_barrier_complete(unsigned* bar, unsigned x, unsigned& nloc, unsigned& nx) {
    const unsigned G = gridDim.x * gridDim.y * gridDim.z;
    unsigned sum, cnt, mine, sp = 0u;
    for (;;) {
        sum = 0u; cnt = 0u; mine = 0u;
#pragma unroll
        for (unsigned j = 0; j < 16; ++j) { const unsigned c = xb_ld(&bar[XB_XCNT(j)]); sum += c; cnt += (c > 0u) ? 1u : 0u; mine = (j == x) ? c : mine; }
        if (sum == G) break;
        __builtin_amdgcn_s_sleep(1);
        if ((++sp & 255u) == 0u) { if (xb_ld(&bar[XB_TMO])) break; if (sp > XB_SPIN_CAP) { atomicAdd(&bar[XB_TMO], 1u); break; } }
    }
    nloc = mine > 0u ? mine : 1u; nx = cnt > 0u ? cnt : 1u;
}

__device__ __forceinline__ void xcd_barrier(const XcdBarrier& b) {
    asm volatile("s_waitcnt vmcnt(0)" ::: "memory");
    __syncthreads();
    if (threadIdx.x == 0) {
        unsigned* bar = b.bar;
        __builtin_amdgcn_s_waitcnt(0);
        unsigned nloc = b.st[0], nx = b.st[1];
        if (nloc == 0u) { xcd_barrier_complete(bar, b.x, nloc, nx); b.st[0] = nloc; b.st[1] = nx; }
        const unsigned old = xb_add(&bar[XB_XSUB(b.x)], 1u);
        const unsigned gen = old / nloc;
        if (old + 1u == (gen + 1u) * nloc) {
            __builtin_amdgcn_fence(__ATOMIC_RELEASE, "agent");
            asm volatile("s_waitcnt vmcnt(0)" ::: "memory");
            const unsigned og = xb_add(&bar[XB_TOP], 1u);
            const unsigned tg = og / nx;
            if (og + 1u == (tg + 1u) * nx) xb_add(&bar[XB_TOPGEN], 1u);
            else XB_SPIN(xb_ld(&bar[XB_TOPGEN]) == tg, bar);
            __builtin_amdgcn_fence(__ATOMIC_ACQUIRE, "agent");
            xb_add(&bar[XB_XGEN(b.x)], 1u);
            asm volatile("s_waitcnt vmcnt(0)" ::: "memory");
        } else {
            XB_SPIN(xb_ld(&bar[XB_XGEN(b.x)]) == gen, bar);
            __builtin_amdgcn_fence(__ATOMIC_ACQUIRE, "agent");
            asm volatile("s_waitcnt vmcnt(0)" ::: "memory");
        }
    }
    __syncthreads();
}


struct Args { const float* in[19]; float* out; unsigned char* wsp; int ph_lo, ph_hi, li, jobmask; };
struct Frame { LAS unsigned char* lds; int tid, lane, wave, vcu, G; };
#define KA ((const Args*)__builtin_amdgcn_kernarg_segment_ptr())
#define INP(i) (KA->in[i])
#define A_WS (KA->wsp)
#define A_OUT (KA->out)

__device__ __forceinline__ void p0_item(const float* src, int ldw, const float* gain, bf16_t* dst, int K, int k0, int n0, int d0, int d1, LAS float* scr, int lane) {
    const int lr = lane >> 4, lc = lane & 15;
    f32x4 v[16];
#pragma unroll
    for (int i = 0; i < 16; ++i) v[i] = *(const GAS f32x4*)(src + (size_t)(k0 + 4 * i + lr) * ldw + n0 + 4 * lc);
    if (gain) {
#pragma unroll
        for (int i = 0; i < 16; ++i) v[i] = v[i] * gain[k0 + 4 * i + lr];
    }
#pragma unroll
    for (int i = 0; i < 16; ++i) { LAS float* p = scr + (4 * i + lr) * 65 + 4 * lc; p[0] = v[i][0]; p[1] = v[i][1]; p[2] = v[i][2]; p[3] = v[i][3]; }
    LDS_WAIT(); asm volatile("" ::: "memory");
    const int c = lane & 7;
#pragma unroll
    for (int jj = 0; jj < 8; ++jj) { const int nl = 8 * jj + (lane >> 3); const LAS float* s = scr + (8 * c) * 65 + nl;
        v4u o; o.x = pk2(s[0], s[65]); o.y = pk2(s[130], s[195]); o.z = pk2(s[260], s[325]); o.w = pk2(s[390], s[455]);
        const int drow = (jj < 4 ? d0 : d1 - 32) + nl;
        *(GAS v4u*)(dst + (size_t)drow * K + k0 + 8 * c) = o; }
    LDS_WAIT(); asm volatile("" ::: "memory");
}
__device__ __forceinline__ void p0_item8(const float* src, int ldw, const float* gain, float sc, unsigned char* dst, int K, int k0, int n0, int d0, int d1, LAS float* scr, int lane) {
    const int lr = lane >> 4, lc = lane & 15;
    f32x4 v[16];
#pragma unroll
    for (int i = 0; i < 16; ++i) v[i] = *(const GAS f32x4*)(src + (size_t)(k0 + 4 * i + lr) * ldw + n0 + 4 * lc);
#pragma unroll
    for (int i = 0; i < 16; ++i) v[i] = v[i] * (gain ? gain[k0 + 4 * i + lr] * sc : sc);
#pragma unroll
    for (int i = 0; i < 16; ++i) { LAS float* p = scr + (4 * i + lr) * 65 + 4 * lc; p[0] = v[i][0]; p[1] = v[i][1]; p[2] = v[i][2]; p[3] = v[i][3]; }
    LDS_WAIT(); asm volatile("" ::: "memory");
    const int c = lane & 7;
#pragma unroll
    for (int jj = 0; jj < 8; ++jj) { const int nl = 8 * jj + (lane >> 3); const LAS float* s = scr + (8 * c) * 65 + nl;
        v2u o; o.x = pg8::pk4_fp8(s[0], s[65], s[130], s[195]); o.y = pg8::pk4_fp8(s[260], s[325], s[390], s[455]);
        const int drow = (jj < 4 ? d0 : d1 - 32) + nl;
        *(GAS v2u*)(dst + (size_t)drow * K + k0 + 8 * c) = o; }
    LDS_WAIT(); asm volatile("" ::: "memory");
}
__device__ __forceinline__ int p0_dstrow(int mode, int aux, int col) {
    if (mode == 1) { if (col < 1024) return col; const int v = col >= 2048, cc = col - (v ? 2048 : 1024); return 1024 + 256 * (cc >> 7) + 128 * v + (cc & 127); }
    if (mode == 2) { const int up = col >= aux, cc = col - (up ? aux : 0); return 256 * (cc >> 7) + 128 * up + (cc & 127); }
    if (mode == 3) { const int g = col >> 6, bj = (col >> 5) & 1; return 256 * (g >> 2) + 32 * (4 * bj + (g & 3)) + (col & 31); }
    return col;
}
template <bool F8>
__device__ __forceinline__ void p0_job(Frame& F, int& base, const float* src, int ldw, int K, int c0, int ncols, const float* gain, void* dstv, int drow0, int dstrows, int mode, int aux, int nmat, float sc) {
    LAS float* scr = (LAS float*)(F.lds + RING_OFF + F.wave * P0_SCR);
    const int gw = F.vcu * NWAVES + F.wave, NGW = F.G * NWAVES, nk = K / 64, nn = ncols / 64, per = nk * nn, total = per * nmat;
    int it = (gw - base) % NGW; if (it < 0) it += NGW;
    for (; it < total; it += NGW) { const int mat = it / per, r = it % per, kb = r / nn, nb = r % nn; const int col = 64 * nb;
        if constexpr (F8) p0_item8(src + (size_t)mat * K * ldw + c0, ldw, gain, sc, (unsigned char*)dstv + (size_t)mat * dstrows * K, K, 64 * kb, col, drow0 + p0_dstrow(mode, aux, col), drow0 + p0_dstrow(mode, aux, col + 32), scr, F.lane);
        else p0_item(src + (size_t)mat * K * ldw + c0, ldw, gain, (bf16_t*)dstv + (size_t)mat * dstrows * K, K, 64 * kb, col, drow0 + p0_dstrow(mode, aux, col), drow0 + p0_dstrow(mode, aux, col + 32), scr, F.lane); }
    base = (base + total) % NGW;
}
__device__ __forceinline__ void rms_row_bf16(const float* xrow, const float* g, bf16_t* orow, int lane) {
    const GAS f32x4* xr = (const GAS f32x4*)xrow + lane; const GAS f32x4* gr = (const GAS f32x4*)g + lane;
    f32x4 v[4]; float s = 0.f;
#pragma unroll
    for (int j = 0; j < 4; ++j) { v[j] = xr[64 * j]; s += (v[j][0] * v[j][0] + v[j][1] * v[j][1]) + (v[j][2] * v[j][2] + v[j][3] * v[j][3]); }
    const float rstd = __builtin_amdgcn_rsqf(wave_sum(s) * (1.f / D) + EPS);
    GAS v2u* o8 = (GAS v2u*)orow + lane;
#pragma unroll
    for (int j = 0; j < 4; ++j) { const f32x4 gg = gr[64 * j]; v2u o; o.x = pk2(v[j][0] * rstd * gg[0], v[j][1] * rstd * gg[1]); o.y = pk2(v[j][2] * rstd * gg[2], v[j][3] * rstd * gg[3]); o8[64 * j] = o; }
}
__device__ __forceinline__ void p0_prologue(Frame& F, int jobmask) {
    unsigned char* ws = A_WS; int base = 0;
    if (jobmask & 1)   p0_job<false>(F, base, INP(3), 3072, 1024, 0, 3072, nullptr, (bf16_t*)(ws + WS_W_IN), 0, 3072, 1, 0, 1, 1.0f);
    if (jobmask & 2)   p0_job<false>(F, base, INP(5), 1024, 1024, 0, 1024, nullptr, (bf16_t*)(ws + WS_W_OUT), 0, 1024, 0, 0, 1, 1.0f);
    if (jobmask & 4)   p0_job<false>(F, base, INP(14), 5632, 1024, 0, 5632, INP(2), (bf16_t*)(ws + WS_W_GU), 0, 5632, 2, 2816, 1, 1.0f);
    if (jobmask & 8)   p0_job<false>(F, base, INP(15), 1024, 2816, 0, 1024, nullptr, (bf16_t*)(ws + WS_W_DN), 0, 1024, 0, 0, 1, 1.0f);
    if (jobmask & 16) { p0_job<false>(F, base, INP(9), 1024, 1024, 0, 1024, INP(1) + 1024, (bf16_t*)(ws + WS_W_QKV), 0, 3072, 3, 0, 1, 1.0f);
                        p0_job<false>(F, base, INP(7), 2048, 1024, 0, 1024, INP(6), (bf16_t*)(ws + WS_W_QKV), 1024, 3072, 3, 0, 1, 1.0f);
                        p0_job<false>(F, base, INP(7), 2048, 1024, 1024, 1024, INP(6), (bf16_t*)(ws + WS_W_QKV), 2048, 3072, 0, 0, 1, 1.0f); }
    if (jobmask & 32)  p0_job<false>(F, base, INP(13), 1024, 1024, 0, 1024, nullptr, (bf16_t*)(ws + WS_W_O), 0, 1024, 0, 0, 1, 1.0f);
    if (jobmask & 64)  p0_job<true>(F, base, INP(17), 7168, 1024, 0, 7168, INP(2) + 1024, (ws + WS_W_MGU), 0, 7168, 2, 3584, 8, pg8::F8_SWG);
    if (jobmask & 128) p0_job<true>(F, base, INP(18), 1024, 3584, 0, 1024, nullptr, (ws + WS_W_MDN), 0, 1024, 0, 0, 8, pg8::F8_SWD);
    const int gw = F.vcu * NWAVES + F.wave, NGW = F.G * NWAVES;
    for (int m = gw; m < M; m += NGW) rms_row_bf16(INP(0) + (size_t)m * D, INP(1), (bf16_t*)(ws + WS_XN0) + (size_t)m * D, F.lane);
}

__device__ __forceinline__ void up8(const v4u w, float (&f)[8]) { f[0] = bflo(w.x); f[1] = bfhi(w.x); f[2] = bflo(w.y); f[3] = bfhi(w.y); f[4] = bflo(w.z); f[5] = bfhi(w.z); f[6] = bflo(w.w); f[7] = bfhi(w.w); }
__device__ __forceinline__ void p2_conv(Frame& F) {
    const bf16_t* Bb = (const bf16_t*)(A_WS + WS_BB); const bf16_t* Ub = (const bf16_t*)(A_WS + WS_UB); bf16_t* G = (bf16_t*)(A_WS + WS_G); const float* cw = INP(4);
    const int gw = F.vcu * NWAVES + F.wave, NGW = F.G * NWAVES;
    for (int strip = gw; strip < 2048; strip += NGW) {
        const int r0 = (strip >> 1) * 16, c0 = (strip & 1) * 512 + F.lane * 8;
        float w0[8], w1[8], w2[8], um2[8], um1[8];
#pragma unroll
        for (int j = 0; j < 8; ++j) { w0[j] = cw[c0 + j]; w1[j] = cw[D + c0 + j]; w2[j] = cw[2 * D + c0 + j]; um2[j] = 0.f; um1[j] = 0.f; }
        if ((r0 & (SEQ - 1)) != 0) { up8(*(const GAS v4u*)(Ub + (size_t)(r0 - 2) * D + c0), um2); up8(*(const GAS v4u*)(Ub + (size_t)(r0 - 1) * D + c0), um1); }
#pragma unroll 4
        for (int i = 0; i < 16; ++i) { float u[8], b[8];
            up8(*(const GAS v4u*)(Ub + (size_t)(r0 + i) * D + c0), u); up8(*(const GAS v4u*)(Bb + (size_t)(r0 + i) * D + c0), b);
            float g[8];
#pragma unroll
            for (int j = 0; j < 8; ++j) { g[j] = b[j] * (w0[j] * um2[j] + w1[j] * um1[j] + w2[j] * u[j]); um2[j] = um1[j]; um1[j] = u[j]; }
            v4u o; o.x = pk2(g[0], g[1]); o.y = pk2(g[2], g[3]); o.z = pk2(g[4], g[5]); o.w = pk2(g[6], g[7]);
            *(GAS v4u*)(G + (size_t)(r0 + i) * D + c0) = o; }
    }
}

__device__ __forceinline__ void p8_diff(Frame& F) {
    const bf16_t* O0 = (const bf16_t*)(A_WS + WS_O0); const bf16_t* O1 = (const bf16_t*)(A_WS + WS_O1); bf16_t* ON = (bf16_t*)(A_WS + WS_ON);
    const float* lp = INP(11); const float* sn = INP(12); const int lane = F.lane;
    const float lam = __expf(wave_sum(lp[lane] * lp[64 + lane])) - __expf(wave_sum(lp[128 + lane] * lp[192 + lane])) + LAM_INIT;
    float gn[16];
#pragma unroll
    for (int j = 0; j < 16; ++j) gn[j] = sn[16 * (lane & 7) + j] * (1.f - LAM_INIT);
    const int gw = F.vcu * NWAVES + F.wave, NGW = F.G * NWAVES;
    for (int row = gw; row < M; row += NGW) {
        const size_t off = (size_t)row * D + 16 * lane; float a[16], a0[8], a1[8], b0[8], b1[8];
        up8(*(const GAS v4u*)(O0 + off), a0); up8(*(const GAS v4u*)(O0 + off + 8), a1);
        up8(*(const GAS v4u*)(O1 + off), b0); up8(*(const GAS v4u*)(O1 + off + 8), b1);
        float s = 0.f;
#pragma unroll
        for (int j = 0; j < 8; ++j) { a[j] = a0[j] - lam * b0[j]; a[8 + j] = a1[j] - lam * b1[j]; s += a[j] * a[j] + a[8 + j] * a[8 + j]; }
        s += __shfl_xor(s, 1); s += __shfl_xor(s, 2); s += __shfl_xor(s, 4);
        const float rstd = __builtin_amdgcn_rsqf(s * (1.f / VD) + EPS);
        v4u o0, o1; o0.x = pk2(a[0] * rstd * gn[0], a[1] * rstd * gn[1]); o0.y = pk2(a[2] * rstd * gn[2], a[3] * rstd * gn[3]); o0.z = pk2(a[4] * rstd * gn[4], a[5] * rstd * gn[5]); o0.w = pk2(a[6] * rstd * gn[6], a[7] * rstd * gn[7]);
        o1.x = pk2(a[8] * rstd * gn[8], a[9] * rstd * gn[9]); o1.y = pk2(a[10] * rstd * gn[10], a[11] * rstd * gn[11]); o1.z = pk2(a[12] * rstd * gn[12], a[13] * rstd * gn[13]); o1.w = pk2(a[14] * rstd * gn[14], a[15] * rstd * gn[15]);
        *(GAS v4u*)(ON + off) = o0; *(GAS v4u*)(ON + off + 8) = o1;
    }
}

__device__ __forceinline__ void p10a_router(Frame& F) {
    const float* x3 = A_OUT; const float* g = INP(2) + D; const float* Wr = INP(16);
    int* sel = (int*)(A_WS + WS_SEL); float* gate = (float*)(A_WS + WS_GATE); int* hist = (int*)(A_WS + WS_HIST);
    LAS int* lsel = (LAS int*)(F.lds + RING_OFF);
    const int lane = F.lane;
    for (int blk = blockIdx.x; blk < M / 64; blk += F.G) {
        for (int i = 0; i < 8; ++i) { const int tl = 8 * F.wave + i, row = 64 * blk + tl;
            const GAS f32x4* xr = (const GAS f32x4*)(x3 + (size_t)row * D) + lane; const GAS f32x4* gr = (const GAS f32x4*)g + lane;
            f32x4 v[4]; float s = 0.f;
#pragma unroll
            for (int j = 0; j < 4; ++j) { v[j] = xr[64 * j]; s += (v[j][0] * v[j][0] + v[j][1] * v[j][1]) + (v[j][2] * v[j][2] + v[j][3] * v[j][3]); }
            const float rstd = 1.0f / sqrtf(wave_sum(s) * (1.f / D) + EPS);
            float lg[8];
#pragma unroll
            for (int e = 0; e < 8; ++e) lg[e] = 0.f;
#pragma unroll
            for (int j = 0; j < 4; ++j) { const f32x4 gg = gr[64 * j];
#pragma unroll
                for (int q = 0; q < 4; ++q) { const float hv = v[j][q] * rstd * gg[q]; const int k = 4 * (lane + 64 * j) + q;
                    const f32x4 wa = *(const GAS f32x4*)(Wr + (size_t)k * 8), wb = *(const GAS f32x4*)(Wr + (size_t)k * 8 + 4);
                    lg[0] += hv * wa[0]; lg[1] += hv * wa[1]; lg[2] += hv * wa[2]; lg[3] += hv * wa[3]; lg[4] += hv * wb[0]; lg[5] += hv * wb[1]; lg[6] += hv * wb[2]; lg[7] += hv * wb[3]; } }
#pragma unroll
            for (int e = 0; e < 8; ++e) lg[e] = wave_sum(lg[e]);
            int i0 = 0; float v0 = lg[0];
#pragma unroll
            for (int e = 1; e < 8; ++e) if (lg[e] > v0) { v0 = lg[e]; i0 = e; }
            int i1 = 0; float v1 = -INFINITY;
#pragma unroll
            for (int e = 0; e < 8; ++e) if (e != i0 && lg[e] > v1) { v1 = lg[e]; i1 = e; }
            const float g1 = 1.f / (1.f + expf(v0 - v1));
            if (lane == 0) { sel[2 * row] = i0; sel[2 * row + 1] = i1; gate[2 * row] = 1.f - g1; gate[2 * row + 1] = g1; lsel[2 * tl] = i0; lsel[2 * tl + 1] = i1; }
        }
        LDS_WAIT(); __syncthreads();
        if (F.tid < 8) { int c = 0; for (int i = 0; i < 128; ++i) c += (lsel[i] == F.tid) ? 1 : 0; hist[blk * 8 + F.tid] = c; }
        LDS_WAIT(); __syncthreads();
    }
}
__device__ __forceinline__ void p10b_assign(Frame& F) {
    const int* hist = (const int*)(A_WS + WS_HIST); const int* sel = (const int*)(A_WS + WS_SEL); const float* gate = (const float*)(A_WS + WS_GATE); const float* ssq = (const float*)(A_WS + WS_SSQ);
    int* tok_slot = (int*)(A_WS + WS_TOKSLOT); float* gates = (float*)(A_WS + WS_GATES); int* meta = (int*)(A_WS + WS_META);
    const float* x3 = A_OUT; unsigned char* XG = A_WS + WS_XG;
    LAS int* pre = (LAS int*)(F.lds + RING_OFF);
    LAS int* tot = pre + 2048;
    LAS int* ebase = tot + 8;
    LAS int* lslot = ebase + 8;
    const int lane = F.lane, e = F.wave;
    { int h[4], run = 0;
#pragma unroll
      for (int i = 0; i < 4; ++i) { h[i] = hist[(4 * lane + i) * 8 + e]; }
      const int mine = h[0] + h[1] + h[2] + h[3]; int inc = mine;
#pragma unroll
      for (int o = 1; o < 64; o <<= 1) { const int t = __shfl_up(inc, o); if (lane >= o) inc += t; }
      run = inc - mine;
#pragma unroll
      for (int i = 0; i < 4; ++i) { pre[(4 * lane + i) * 8 + e] = run; run += h[i]; }
      if (lane == 63) tot[e] = inc; }
    LDS_WAIT(); __syncthreads();
    if (F.tid == 0) { int b = 0; for (int k = 0; k < 8; ++k) { ebase[k] = b; if (blockIdx.x == 0) meta[k] = b >> 8; b += (tot[k] + 255) & ~255; } if (blockIdx.x == 0) meta[8] = b >> 8; }
    LDS_WAIT(); __syncthreads();
    for (int blk = blockIdx.x; blk < M / 64; blk += F.G) {
        if (F.wave == 0) { const int t = 64 * blk + lane; const int s0 = sel[2 * t], s1 = sel[2 * t + 1]; int sl0 = 0, sl1 = 0;
            const unsigned long long below = (1ull << lane) - 1ull;
#pragma unroll
            for (int k = 0; k < 8; ++k) { const unsigned long long m0 = __ballot(s0 == k), m1 = __ballot(s1 == k); const int b0 = ebase[k] + pre[blk * 8 + k];
                if (s0 == k) sl0 = b0 + __popcll(m0 & below); if (s1 == k) sl1 = b0 + __popcll(m0) + __popcll(m1 & below); }
            tok_slot[2 * t] = sl0; tok_slot[2 * t + 1] = sl1; lslot[2 * lane] = sl0; lslot[2 * lane + 1] = sl1;
            gates[sl0] = gate[2 * t]; gates[sl1] = gate[2 * t + 1]; }
        LDS_WAIT(); __syncthreads();
        for (int i = 0; i < 8; ++i) { const int tl = 8 * F.wave + i; const size_t t = (size_t)(64 * blk + tl);
            const float rs = pg8::rstd_of(ssq, (int)t) * pg8::F8_SA; const GAS f32x4* xr = (const GAS f32x4*)(x3 + t * D + 16 * lane);
            const f32x4 a0 = xr[0] * rs, a1 = xr[1] * rs, a2 = xr[2] * rs, a3 = xr[3] * rs;
            v4u o; o.x = pg8::pk4_fp8(a0[0], a0[1], a0[2], a0[3]); o.y = pg8::pk4_fp8(a1[0], a1[1], a1[2], a1[3]); o.z = pg8::pk4_fp8(a2[0], a2[1], a2[2], a2[3]); o.w = pg8::pk4_fp8(a3[0], a3[1], a3[2], a3[3]);
            const int sl0 = lslot[2 * tl], sl1 = lslot[2 * tl + 1];
            *(GAS v4u*)(XG + (size_t)sl0 * D + 16 * lane) = o; *(GAS v4u*)(XG + (size_t)sl1 * D + 16 * lane) = o; }
        LDS_WAIT(); __syncthreads();
    }
}
__device__ __forceinline__ void p13_final(Frame& F) {
    const int* tok_slot = (const int*)(A_WS + WS_TOKSLOT); const bf16_t* Y = (const bf16_t*)(A_WS + WS_Y); float* out = A_OUT;
    const int gw = F.vcu * NWAVES + F.wave, NGW = F.G * NWAVES, lane = F.lane;
    for (int row = gw; row < M; row += NGW) { const int s0 = tok_slot[2 * row], s1 = tok_slot[2 * row + 1];
        GAS f32x4* xr = (GAS f32x4*)(out + (size_t)row * D) + lane; const GAS v2u* y0 = (const GAS v2u*)(Y + (size_t)s0 * D) + lane; const GAS v2u* y1 = (const GAS v2u*)(Y + (size_t)s1 * D) + lane;
#pragma unroll
        for (int j = 0; j < 4; ++j) { f32x4 v = xr[64 * j]; const v2u a = y0[64 * j], b = y1[64 * j];
            v[0] += bflo(a.x) + bflo(b.x); v[1] += bfhi(a.x) + bfhi(b.x); v[2] += bflo(a.y) + bflo(b.y); v[3] += bfhi(a.y) + bfhi(b.y); xr[64 * j] = v; } }
}

__global__ void __launch_bounds__(NWAVES * 64, 2) mega_fwd(Args args) {
    extern __shared__ __attribute__((aligned(16))) unsigned char lds[];
    Frame F;
    F.lds = (LAS unsigned char*)lds; F.tid = threadIdx.x; F.lane = F.tid & 63; F.wave = __builtin_amdgcn_readfirstlane(F.tid >> 6);
    F.G = gridDim.x; { const int bx = blockIdx.x; F.vcu = (F.G % 8 == 0) ? (bx % 8) * (F.G / 8) + bx / 8 : bx; }
    for (int u = F.tid; u < RING_OFF / 4; u += NWAVES * 64) ((LAS unsigned*)(F.lds + MISC_OFF))[u] = 0u;
    __syncthreads();
    if (KA->ph_hi - KA->ph_lo > 1) (void)xcd_barrier_post((unsigned*)(A_WS + WS_CTL) + CW_BAR + KA->li * XCD_BAR_WORDS, (volatile LAS unsigned*)(F.lds + MISC_OFF + 32));
#define IN(k) (KA->ph_lo <= (k) && (k) < KA->ph_hi)
#define SEAM(k) do { if (IN(k) && IN((k) + 1)) { XcdBarrier b_; b_.bar = (unsigned*)(A_WS + WS_CTL) + CW_BAR + KA->li * XCD_BAR_WORDS; b_.x = xb_xcc_id(); b_.st = (volatile LAS unsigned*)(F.lds + MISC_OFF + 32); xcd_barrier(b_); } } while (0)
#define ws A_WS
#define XB ((bf16_t*)(A_WS + WS_XB))
#define SSQ ((float*)(A_WS + WS_SSQ))

    if (IN(0)) { p0_prologue(F, KA->jobmask); } SEAM(0);
    if (IN(1)) { pg8::Gemm g{(const bf16_t*)(ws + WS_XN0), (const bf16_t*)(ws + WS_W_IN), M, 3072, 1024}; pg8::StaticOrder S; S.init(M, 3072, F.G, (int)blockIdx.x);
        pg8::EpiInProj E{(bf16_t*)(ws + WS_BB), (bf16_t*)(ws + WS_UB)};
        pg8::gemm_phase<pg8::EpiInProj, pg8::StaticOrder, true, true>(F.lds + RING_OFF, g, S, E); } SEAM(1);
    if (IN(2)) { p2_conv(F); } SEAM(2);
    if (IN(3)) { pg8::Gemm g{(const bf16_t*)(ws + WS_G), (const bf16_t*)(ws + WS_W_OUT), M, 1024, 1024}; pg8::StaticOrder S; S.init(M, 1024, F.G, (int)blockIdx.x);
        pg8::EpiResidSsq E{INP(0), A_OUT, XB, SSQ};
        pg8::gemm_phase<pg8::EpiResidSsq, pg8::StaticOrder, false, true>(F.lds + RING_OFF, g, S, E); } SEAM(3);
    if (IN(4)) { pg8::Gemm g{XB, (const bf16_t*)(ws + WS_W_GU), M, 5632, 1024}; pg8::StaticOrder S; S.init(M, 5632, F.G, (int)blockIdx.x);
        pg8::EpiSwiGLU E{(bf16_t*)(ws + WS_HACT), DFF, SSQ, nullptr, 22};
        pg8::gemm_phase<pg8::EpiSwiGLU, pg8::StaticOrder, true, true>(F.lds + RING_OFF, g, S, E); } SEAM(4);
    if (IN(5)) { pg8::Gemm g{(const bf16_t*)(ws + WS_HACT), (const bf16_t*)(ws + WS_W_DN), M, 1024, DFF}; pg8::StaticOrder S; S.init(M, 1024, F.G, (int)blockIdx.x);
        pg8::EpiResidSsq E{A_OUT, A_OUT, XB, SSQ};
        pg8::gemm_phase<pg8::EpiResidSsq, pg8::StaticOrder, false, true>(F.lds + RING_OFF, g, S, E); } SEAM(5);
    if (IN(6)) { pg8::Gemm g{XB, (const bf16_t*)(ws + WS_W_QKV), M, 3072, 1024}; pg8::StaticOrder S; S.init(M, 3072, F.G, (int)blockIdx.x);
        pg8::EpiQKV E{(bf16_t*)(ws + WS_Q), (bf16_t*)(ws + WS_K), (bf16_t*)(ws + WS_V), SSQ, INP(10), INP(8), attn_body::C2};
        pg8::gemm_phase<pg8::EpiQKV, pg8::StaticOrder, true, true>(F.lds + RING_OFF, g, S, E); } SEAM(6);
    if (IN(7)) {
        for (int vh = F.vcu; vh < BATCH * 32; vh += F.G) { const int b = vh >> 5, r = vh & 31, h = r >> 2, c = (r >> 1) & 1, vhalf = r & 1;
            attn_body::bf16* O = (attn_body::bf16*)(ws + (c ? WS_O1 : WS_O0));
            for (int qb = SEQ / 256 - 1; qb >= 0; --qb)
                attn_body::attn_unit<8>(b, (2 * h + c) * 64, h * 128 + vhalf * 64, qb, (const attn_body::bf16*)(ws + WS_Q), (const attn_body::bf16*)(ws + WS_K), (const attn_body::bf16*)(ws + WS_V), O, (char*)lds + RING_OFF); }
    } SEAM(7);
    if (IN(8)) { p8_diff(F); } SEAM(8);
    if (IN(9)) { pg8::Gemm g{(const bf16_t*)(ws + WS_ON), (const bf16_t*)(ws + WS_W_O), M, 1024, 1024}; pg8::StaticOrder S; S.init(M, 1024, F.G, (int)blockIdx.x);
        pg8::EpiResidSsq E{A_OUT, A_OUT, XB, SSQ};
        pg8::gemm_phase<pg8::EpiResidSsq, pg8::StaticOrder, false, true>(F.lds + RING_OFF, g, S, E); } SEAM(9);
    if (IN(10)) { p10a_router(F); } SEAM(10);
    if (IN(11)) { p10b_assign(F); } SEAM(11);
    if (IN(12)) { pg8::Gemm g{(const bf16_t*)(ws + WS_XG), (const bf16_t*)(ws + WS_W_MGU), SLOTS, 8 * 7168, 512}; pg8::MoeOrder S; S.init((const int*)(ws + WS_META), 28, F.G, (int)blockIdx.x);
        pg8::EpiSwiGLU8 E{ws + WS_HM, DFE, 28};
        pg8::gemm_phase<pg8::EpiSwiGLU8, pg8::MoeOrder, true, true, true>(F.lds + RING_OFF, g, S, E); } SEAM(12);
    if (IN(13)) { pg8::Gemm g{(const bf16_t*)(ws + WS_HM), (const bf16_t*)(ws + WS_W_MDN), SLOTS, 8 * 1024, DFE / 2}; pg8::MoeOrder S; S.init((const int*)(ws + WS_META), 4, F.G, (int)blockIdx.x);
        pg8::EpiMoeDown E{(bf16_t*)(ws + WS_Y), (const float*)(ws + WS_GATES), 1.0f / (pg8::F8_SH * pg8::F8_SWD)};
        pg8::gemm_phase<pg8::EpiMoeDown, pg8::MoeOrder, true, true, true>(F.lds + RING_OFF, g, S, E); } SEAM(13);
    if (IN(14)) { p13_final(F); }
#undef IN
#undef SEAM
#undef ws
#undef XB
#undef SSQ
}
#ifndef MEGA_UPTO
#define MEGA_UPTO 15
#endif
#ifndef MEGA_REPMASK
#define MEGA_REPMASK 0
#endif
#ifndef MEGA_ONE
#define MEGA_ONE 1
#endif
extern "C" void kernel_launch(void* const* d_in, const int* in_sizes, int n_in, void* d_out, int out_size, void* d_ws, size_t ws_size, hipStream_t stream) {
    static int grid = 0;
    if (grid == 0) {
        if (n_in != 19 || in_sizes[0] != M * D || out_size != M * D || ws_size < WS_END) { fprintf(stderr, "kernel_launch: unexpected shapes / workspace (%d inputs, ws %zu, need %zu)\n", n_in, ws_size, (size_t)WS_END); grid = -1; return; }
        int dev = 0, cus = 0, per_cu = 0;
        if (hipGetDevice(&dev) != hipSuccess || hipDeviceGetAttribute(&cus, hipDeviceAttributeMultiprocessorCount, dev) != hipSuccess) { grid = -1; return; }
        if (hipFuncSetAttribute((const void*)mega_fwd, hipFuncAttributeMaxDynamicSharedMemorySize, LDS_BYTES) != hipSuccess) { fprintf(stderr, "kernel_launch: hipFuncSetAttribute failed\n"); grid = -1; return; }
        if (hipOccupancyMaxActiveBlocksPerMultiprocessor(&per_cu, (const void*)mega_fwd, NWAVES * 64, LDS_BYTES) != hipSuccess || per_cu < 1) fprintf(stderr, "kernel_launch: note: occupancy query says %d\n", per_cu);
        (void)hipGetLastError();
        grid = cus < 256 ? cus : 256;
        if (grid != 256) fprintf(stderr, "kernel_launch: %d CUs; this kernel is built for 256\n", cus);
    }
    if (grid < 0) return;
    unsigned char* ws = (unsigned char*)d_ws; float* out = (float*)d_out;
    const float* x = (const float*)d_in[0]; const float* ln_mix = (const float*)d_in[1]; const float* ln_ffn = (const float*)d_in[2];
    const float* conv_w_in = (const float*)d_in[3]; const float* conv_w = (const float*)d_in[4]; const float* conv_w_out = (const float*)d_in[5];
    const float* ln_kv = (const float*)d_in[6]; const float* w_kv = (const float*)d_in[7]; const float* k_norm = (const float*)d_in[8];
    const float* attn_w_q = (const float*)d_in[9]; const float* q_norm = (const float*)d_in[10]; const float* lam_params = (const float*)d_in[11];
    const float* sub_norm = (const float*)d_in[12]; const float* attn_w_o = (const float*)d_in[13]; const float* ffn_w_gu = (const float*)d_in[14];
    const float* ffn_w_down = (const float*)d_in[15]; const float* router_w = (const float*)d_in[16]; const float* moe_w_gu = (const float*)d_in[17];
    const float* moe_w_down = (const float*)d_in[18];
    constexpr int UPTO = MEGA_UPTO;
    static_assert(UPTO == 0 || UPTO == 4 || UPTO == 6 || UPTO == 7 || UPTO == 9 || UPTO == 10 || UPTO == 15, "MEGA_UPTO");
    if (UPTO > 0) {
        if (hipMemsetAsync(ws + WS_CTL, 0, CTL_ZERO_BYTES, stream) != hipSuccess) { fprintf(stderr, "kernel_launch: memset failed\n"); return; }
        Args a{};
        for (int i = 0; i < 19; ++i) a.in[i] = (const float*)d_in[i];
        a.out = out; a.wsp = ws;
        a.jobmask = UPTO >= 15 ? 255 : UPTO >= 10 ? 63 : UPTO >= 7 ? 31 : UPTO >= 6 ? 15 : 3;
        if (MEGA_ONE) { a.ph_lo = 0; a.ph_hi = UPTO; a.li = 0; hipLaunchKernelGGL(mega_fwd, dim3(grid), dim3(NWAVES * 64), LDS_BYTES, stream, a); }
        else for (int p = 0; p < UPTO; ++p) { a.ph_lo = p; a.ph_hi = p + 1; a.li = 0; for (int r = 0; r <= ((MEGA_REPMASK >> p) & 1); ++r) hipLaunchKernelGGL(mega_fwd, dim3(grid), dim3(NWAVES * 64), LDS_BYTES, stream, a); }
        const hipError_t le = hipPeekAtLastError();
        if (le != hipSuccess) fprintf(stderr, "kernel_launch: launch failed: %s\n", hipGetErrorName(le));
    }
    if (UPTO >= 15) return;
    bf16_t* Wt_in = (bf16_t*)(ws + WS_W_IN); bf16_t* Wt_out = (bf16_t*)(ws + WS_W_OUT); bf16_t* Wt_gu = (bf16_t*)(ws + WS_W_GU); bf16_t* Wt_dn = (bf16_t*)(ws + WS_W_DN);
    bf16_t* Wt_kv = (bf16_t*)(ws + WS_W_QKV); bf16_t* Wt_q = (bf16_t*)(ws + WS_W_QKV + (size_t)2048 * 1024 * 2); bf16_t* Wt_o = (bf16_t*)(ws + WS_W_O);
    bf16_t* Wt_mgu = (bf16_t*)(ws + WS_W_MGU); bf16_t* Wt_mdn = (bf16_t*)(ws + WS_W_MDN);
    bf16_t* HB = (bf16_t*)(ws + WS_HB); bf16_t* HB2 = (bf16_t*)(ws + WS_HB2); float* Yf = (float*)(ws + WS_YF);
    unsigned char* U = ws + WS_R; unsigned char* Vr = ws + WS_S;
    float* F1 = (float*)U; bf16_t* Hact = (bf16_t*)U; float* O0 = (float*)U; float* O1 = O0 + (size_t)M * D;
    float* Qn = (float*)Vr; float* Kn = Qn + (size_t)M * D; float* Vn = Kn + (size_t)M * D; float* Ymoe = (float*)Vr;
    int* sel = (int*)(ws + WS_NAIVE_SMALL); float* gate = (float*)(ws + WS_NAIVE_SMALL + 128 * 1024); int* slot_tok = (int*)(ws + WS_NAIVE_SMALL + 256 * 1024);
    int* tok_slot = (int*)(ws + WS_NAIVE_SMALL + 512 * 1024); int* gbase = (int*)(ws + WS_NAIVE_SMALL + 640 * 1024); int* gcount = gbase + 16;
    float* X = out;
    if (UPTO < 4) {
        k_wt<<<dim3(3072 / 32, D / 32, 1), 256, 0, stream>>>(conv_w_in, Wt_in, D, 3072);
        k_wt<<<dim3(D / 32, D / 32, 1), 256, 0, stream>>>(conv_w_out, Wt_out, D, D);
        k_rmsnorm<<<M / 4, 256, 0, stream>>>(x, ln_mix, HB);
        k_gemm<0><<<dim3(3072 / 64, M / 64, 1), 256, 0, stream>>>(HB, D, Wt_in, D, F1, 3072, M, D, 0, nullptr, nullptr, nullptr, 0);
        k_conv<<<M * D / 256, 256, 0, stream>>>(F1, conv_w, HB2);
        k_gemm<0><<<dim3(D / 64, M / 64, 1), 256, 0, stream>>>(HB2, D, Wt_out, D, Yf, D, M, D, 0, nullptr, nullptr, nullptr, 0);
        k_resid_norm<<<M / 4, 256, 0, stream>>>(x, Yf, X, ln_ffn, HB, nullptr, nullptr);
    } else if (UPTO == 4) k_rmsnorm<<<M / 4, 256, 0, stream>>>(X, ln_ffn, HB);
    if (UPTO < 6) {
        k_wt<<<dim3(2 * DFF / 32, D / 32, 1), 256, 0, stream>>>(ffn_w_gu, Wt_gu, D, 2 * DFF);
        k_wt<<<dim3(D / 32, DFF / 32, 1), 256, 0, stream>>>(ffn_w_down, Wt_dn, DFF, D);
        k_gemm<1><<<dim3(DFF / 64, M / 64, 1), 256, 0, stream>>>(HB, D, Wt_gu, D, Hact, DFF, M, D, DFF, nullptr, nullptr, nullptr, 0);
        k_gemm<0><<<dim3(D / 64, M / 64, 1), 256, 0, stream>>>(Hact, DFF, Wt_dn, DFF, Yf, D, M, DFF, 0, nullptr, nullptr, nullptr, 0);
        k_resid_norm<<<M / 4, 256, 0, stream>>>(X, Yf, X, ln_kv, HB, ln_mix + D, HB2);
    } else if (UPTO == 6) { k_rmsnorm<<<M / 4, 256, 0, stream>>>(X, ln_kv, HB); k_rmsnorm<<<M / 4, 256, 0, stream>>>(X, ln_mix + D, HB2); }
    if (UPTO < 7) {
        k_wt<<<dim3(2048 / 32, D / 32, 1), 256, 0, stream>>>(w_kv, Wt_kv, D, 2048);
        k_wt<<<dim3(D / 32, D / 32, 1), 256, 0, stream>>>(attn_w_q, Wt_q, D, D);
        k_gemm<0><<<dim3(2048 / 64, M / 64, 1), 256, 0, stream>>>(HB, D, Wt_kv, D, F1, 2048, M, D, 0, nullptr, nullptr, nullptr, 0);
        k_headnorm<<<M / 4, 256, 0, stream>>>(F1, 2048, 0, k_norm, 1.f, Kn);
        k_headnorm<<<M / 4, 256, 0, stream>>>(F1, 2048, 1024, nullptr, 1.f, Vn);
        k_gemm<0><<<dim3(D / 64, M / 64, 1), 256, 0, stream>>>(HB2, D, Wt_q, D, Yf, D, M, D, 0, nullptr, nullptr, nullptr, 0);
        k_headnorm<<<M / 4, 256, 0, stream>>>(Yf, D, 0, q_norm, 0.125f, Qn);
        k_attn<float><<<dim3(SEQ / 256, 2 * NH, BATCH), 256, 0, stream>>>(Qn, Kn, Vn, O0, O1, 1.0f);
    } else if (UPTO == 7) k_attn<bf16_t><<<dim3(SEQ / 256, 2 * NH, BATCH), 256, 0, stream>>>((const bf16_t*)(ws + WS_Q), (const bf16_t*)(ws + WS_K), (const bf16_t*)(ws + WS_V), O0, O1, 0.6931471805599453f);
    const bf16_t* ONp = HB;
    if (UPTO < 9) k_diff<<<M / 4, 256, 0, stream>>>(O0, O1, lam_params, sub_norm, HB); else ONp = (const bf16_t*)(ws + WS_ON);
    if (UPTO < 10) {
        k_wt<<<dim3(D / 32, D / 32, 1), 256, 0, stream>>>(attn_w_o, Wt_o, D, D);
        k_gemm<0><<<dim3(D / 64, M / 64, 1), 256, 0, stream>>>(ONp, D, Wt_o, D, Yf, D, M, D, 0, nullptr, nullptr, nullptr, 0);
        k_resid_norm<<<M / 4, 256, 0, stream>>>(X, Yf, X, ln_ffn + D, HB, nullptr, nullptr);
    } else k_rmsnorm<<<M / 4, 256, 0, stream>>>(X, ln_ffn + D, HB);
    k_wt<<<dim3(2 * DFE / 32, D / 32, NE), 256, 0, stream>>>(moe_w_gu, Wt_mgu, D, 2 * DFE);
    k_wt<<<dim3(D / 32, DFE / 32, NE), 256, 0, stream>>>(moe_w_down, Wt_mdn, DFE, D);
    k_router<<<M / 4, 256, 0, stream>>>(X, ln_ffn + D, router_w, sel, gate);
    k_bin<<<1, 1024, 0, stream>>>(sel, slot_tok, tok_slot, gbase, gcount);
    k_gemm<1><<<dim3(DFE / 64, M / 64, NE), 256, 0, stream>>>(HB, D, Wt_mgu, D, Hact, DFE, 0, D, DFE, slot_tok, gbase, gcount, (size_t)2 * DFE * D);
    k_gemm<0><<<dim3(D / 64, M / 64, NE), 256, 0, stream>>>(Hact, DFE, Wt_mdn, DFE, Ymoe, D, 0, DFE, 0, nullptr, gbase, gcount, (size_t)D * DFE);
    k_final<<<M * D / 4 / 256, 256, 0, stream>>>(X, Ymoe, tok_slot, gate, out);
}
```

```cpp
#include <hip/hip_runtime.h>
#include <hip/hip_bf16.h>
#include <stdint.h>
#include <stdio.h>
#include <cmath>
#define MEGA_UPTO 15
#define MEGA_ONE 1
typedef unsigned short bf16_t;
typedef short bf16x8 __attribute__((ext_vector_type(8)));
typedef float f32x4 __attribute__((ext_vector_type(4)));
constexpr int D = 1024, BATCH = 8, SEQ = 2048, M = BATCH * SEQ;
constexpr int NH = 8, HD = 64, VD = 128;
constexpr int DFF = 2816, NE = 8, DFE = 3584;
constexpr float EPS = 1e-6f;
constexpr float LAM_INIT = 0.35550907f;
constexpr int SLOTS = 2 * M + NE * 256;

__device__ __forceinline__ unsigned f2bf(float f) { unsigned u = __builtin_bit_cast(unsigned, f); return (u + 0x7fffu + ((u >> 16) & 1u)) >> 16; }
__device__ __forceinline__ float bf2f(unsigned short b) { return __builtin_bit_cast(float, (unsigned)b << 16); }
__device__ __forceinline__ float wave_sum(float v) {
#pragma unroll
    for (int o = 1; o < 64; o <<= 1) v += __shfl_xor(v, o);
    return v;
}

__global__ __launch_bounds__(256) void k_wt(const float* __restrict__ W, bf16_t* __restrict__ Bt, int K, int N) {
    __shared__ float t[32][33];
    const float* w = W + (size_t)blockIdx.z * K * N; bf16_t* o = Bt + (size_t)blockIdx.z * K * N;
    const int n0 = blockIdx.x * 32, k0 = blockIdx.y * 32, tx = threadIdx.x & 31, ty = threadIdx.x >> 5;
#pragma unroll
    for (int i = 0; i < 4; ++i) t[ty + 8 * i][tx] = w[(size_t)(k0 + ty + 8 * i) * N + n0 + tx];
    __syncthreads();
#pragma unroll
    for (int i = 0; i < 4; ++i) o[(size_t)(n0 + ty + 8 * i) * K + k0 + tx] = (bf16_t)f2bf(t[tx][ty + 8 * i]);
}

__global__ __launch_bounds__(256) void k_rmsnorm(const float* __restrict__ x, const float* __restrict__ g, bf16_t* __restrict__ out) {
    const int row = blockIdx.x * 4 + (threadIdx.x >> 6), lane = threadIdx.x & 63;
    const f32x4* xr = (const f32x4*)(x + (size_t)row * D) + lane; const f32x4* gr = (const f32x4*)g + lane;
    f32x4 v[4]; float s = 0.f;
#pragma unroll
    for (int j = 0; j < 4; ++j) { v[j] = xr[64 * j]; s += v[j].x * v[j].x + v[j].y * v[j].y + v[j].z * v[j].z + v[j].w * v[j].w; }
    const float rstd = rsqrtf(wave_sum(s) * (1.f / D) + EPS);
    unsigned long long* o8 = (unsigned long long*)(out + (size_t)row * D) + lane;
#pragma unroll
    for (int j = 0; j < 4; ++j) { const f32x4 gg = gr[64 * j];
        const unsigned a = f2bf(v[j].x * rstd * gg.x), b = f2bf(v[j].y * rstd * gg.y), c = f2bf(v[j].z * rstd * gg.z), d = f2bf(v[j].w * rstd * gg.w);
        o8[64 * j] = (unsigned long long)(a | (b << 16)) | ((unsigned long long)(c | (d << 16)) << 32); }
}

__global__ __launch_bounds__(256) void k_resid_norm(const float* __restrict__ xold, const float* __restrict__ y, float* __restrict__ xnew,
                                                    const float* __restrict__ g1, bf16_t* __restrict__ o1, const float* __restrict__ g2, bf16_t* __restrict__ o2) {
    const int row = blockIdx.x * 4 + (threadIdx.x >> 6), lane = threadIdx.x & 63;
    const f32x4* xr = (const f32x4*)(xold + (size_t)row * D) + lane; const f32x4* yr = (const f32x4*)(y + (size_t)row * D) + lane;
    f32x4* xo = (f32x4*)(xnew + (size_t)row * D) + lane;
    f32x4 v[4]; float s = 0.f;
#pragma unroll
    for (int j = 0; j < 4; ++j) { v[j] = xr[64 * j] + yr[64 * j]; xo[64 * j] = v[j]; s += v[j].x * v[j].x + v[j].y * v[j].y + v[j].z * v[j].z + v[j].w * v[j].w; }
    const float rstd = rsqrtf(wave_sum(s) * (1.f / D) + EPS);
#pragma unroll
    for (int p = 0; p < 2; ++p) { const float* g = p ? g2 : g1; bf16_t* o = p ? o2 : o1; if (!o) continue;
        const f32x4* gr = (const f32x4*)g + lane; unsigned long long* o8 = (unsigned long long*)(o + (size_t)row * D) + lane;
#pragma unroll
        for (int j = 0; j < 4; ++j) { const f32x4 gg = gr[64 * j];
            const unsigned a = f2bf(v[j].x * rstd * gg.x), b = f2bf(v[j].y * rstd * gg.y), c = f2bf(v[j].z * rstd * gg.z), d = f2bf(v[j].w * rstd * gg.w);
            o8[64 * j] = (unsigned long long)(a | (b << 16)) | ((unsigned long long)(c | (d << 16)) << 32); } }
}

template <int MODE>
__global__ __launch_bounds__(256) void k_gemm(const bf16_t* __restrict__ A, int lda, const bf16_t* __restrict__ Bt, int ldb, void* __restrict__ Cv, int ldc,
                                               int Mtot, int K, int dualOff, const int* __restrict__ arow, const int* __restrict__ gbase, const int* __restrict__ gcount, size_t bstride) {
    const int z = blockIdx.z; int start = 0, count = Mtot;
    if (gbase) { start = gbase[z]; count = gcount[z]; Bt += (size_t)z * bstride; }
    const int mt0 = blockIdx.y * 64; if (mt0 >= count) return;
    const int n0 = blockIdx.x * 64, w = threadIdx.x >> 6, lane = threadIdx.x & 63, r = lane & 15, q = lane >> 4;
    int ml = mt0 + 16 * w + r; if (ml >= count) ml = count - 1;
    const int mrow = start + ml; const int ar = arow ? arow[mrow] : mrow;
    const bf16_t* ap = A + (size_t)ar * lda + 8 * q;
    const bf16_t* bp = Bt + (size_t)(n0 + r) * ldb + 8 * q;
    f32x4 acc[4], acc2[4];
#pragma unroll
    for (int j = 0; j < 4; ++j) { acc[j] = (f32x4){0.f, 0.f, 0.f, 0.f}; acc2[j] = (f32x4){0.f, 0.f, 0.f, 0.f}; }
    for (int k0 = 0; k0 < K; k0 += 32) {
        const bf16x8 a = *(const bf16x8*)(ap + k0);
#pragma unroll
        for (int j = 0; j < 4; ++j) { const bf16x8 b = *(const bf16x8*)(bp + (size_t)(16 * j) * ldb + k0);
            acc[j] = __builtin_amdgcn_mfma_f32_16x16x32_bf16(a, b, acc[j], 0, 0, 0);
            if (MODE == 1) { const bf16x8 b2 = *(const bf16x8*)(bp + (size_t)(16 * j + dualOff) * ldb + k0);
                acc2[j] = __builtin_amdgcn_mfma_f32_16x16x32_bf16(a, b2, acc2[j], 0, 0, 0); } }
    }
#pragma unroll
    for (int j = 0; j < 4; ++j)
#pragma unroll
        for (int i = 0; i < 4; ++i) { const int mo = mt0 + 16 * w + 4 * q + i; if (mo >= count) continue;
            const size_t off = (size_t)(start + mo) * ldc + n0 + 16 * j + r;
            if (MODE == 0) ((float*)Cv)[off] = acc[j][i];
            else { const float g = acc[j][i], u = acc2[j][i]; ((bf16_t*)Cv)[off] = (bf16_t)f2bf(g / (1.f + expf(-g)) * u); } }
}

__global__ __launch_bounds__(256) void k_conv(const float* __restrict__ bcv, const float* __restrict__ cw, bf16_t* __restrict__ G) {
    const int idx = blockIdx.x * 256 + threadIdx.x; const int row = idx >> 10, c = idx & 1023, t = row & (SEQ - 1);
    const float* p = bcv + (size_t)row * 3072;
    float z = cw[2 * D + c] * (p[D + c] * p[2 * D + c]);
    if (t >= 1) z += cw[D + c] * (p[D + c - 3072] * p[2 * D + c - 3072]);
    if (t >= 2) z += cw[c] * (p[D + c - 6144] * p[2 * D + c - 6144]);
    G[idx] = (bf16_t)f2bf(p[c] * z);
}

__global__ __launch_bounds__(256) void k_headnorm(const float* __restrict__ in, int ldin, int c0, const float* __restrict__ gain, float scale, float* __restrict__ out) {
    const int row = blockIdx.x * 4 + (threadIdx.x >> 6), lane = threadIdx.x & 63;
    const f32x4* p = (const f32x4*)(in + (size_t)row * ldin + c0 + 16 * lane);
    f32x4 v[4]; float s = 0.f;
#pragma unroll
    for (int j = 0; j < 4; ++j) { v[j] = p[j]; s += v[j].x * v[j].x + v[j].y * v[j].y + v[j].z * v[j].z + v[j].w * v[j].w; }
    f32x4* o = (f32x4*)(out + (size_t)row * D + 16 * lane);
    if (gain) { s += __shfl_xor(s, 1); s += __shfl_xor(s, 2); const float rstd = rsqrtf(s * (1.f / HD) + EPS) * scale;
        const f32x4* g = (const f32x4*)(gain + 16 * (lane & 3));
#pragma unroll
        for (int j = 0; j < 4; ++j) o[j] = v[j] * rstd * g[j];
    } else {
#pragma unroll
        for (int j = 0; j < 4; ++j) o[j] = v[j]; }
}

__device__ __forceinline__ f32x4 ld4(const float* p) { return *(const f32x4*)p; }
__device__ __forceinline__ f32x4 ld4(const bf16_t* p) { const unsigned long long w = *(const unsigned long long*)p; return (f32x4){bf2f((unsigned short)w), bf2f((unsigned short)(w >> 16)), bf2f((unsigned short)(w >> 32)), bf2f((unsigned short)(w >> 48))}; }
template <typename T>
__global__ __launch_bounds__(256) void k_attn(const T* __restrict__ Q, const T* __restrict__ Kn, const T* __restrict__ V, float* __restrict__ O0, float* __restrict__ O1, float qmul) {
    __shared__ __attribute__((aligned(16))) float Ks[32][64];
    __shared__ __attribute__((aligned(16))) float Vs[32][128];
    const int qb = blockIdx.x, hc = blockIdx.y, b = blockIdx.z, h = hc >> 1, c = hc & 1, tid = threadIdx.x;
    const int qi = qb * 256 + tid; const size_t rowbase = (size_t)b * SEQ;
    float q[64], o[128];
    { const T* qp = Q + (rowbase + qi) * D + h * 128 + c * 64;
#pragma unroll
      for (int j = 0; j < 16; ++j) { const f32x4 t = ld4(qp + 4 * j); q[4 * j] = t.x * qmul; q[4 * j + 1] = t.y * qmul; q[4 * j + 2] = t.z * qmul; q[4 * j + 3] = t.w * qmul; } }
#pragma unroll
    for (int e = 0; e < 128; ++e) o[e] = 0.f;
    float mx = -INFINITY, l = 0.f;
    const int nkt = (qb * 256 + 256) / 32;
    for (int kt = 0; kt < nkt; ++kt) {
        __syncthreads();
#pragma unroll
        for (int i = 0; i < 2; ++i) { const int f = tid + 256 * i, kr = f >> 4, kc = f & 15;
            ((f32x4*)&Ks[0][0])[f] = ld4(Kn + (rowbase + kt * 32 + kr) * D + h * 128 + c * 64 + 4 * kc); }
#pragma unroll
        for (int i = 0; i < 4; ++i) { const int f = tid + 256 * i, kr = f >> 5, kc = f & 31;
            ((f32x4*)&Vs[0][0])[f] = ld4(V + (rowbase + kt * 32 + kr) * D + h * 128 + 4 * kc); }
        __syncthreads();
        for (int kk = 0; kk < 32; ++kk) {
            const int key = kt * 32 + kk; if (key > qi) break;
            float s = 0.f;
#pragma unroll
            for (int d = 0; d < 64; ++d) s += q[d] * Ks[kk][d];
            if (s > mx) { const float al = expf(mx - s); l *= al;
#pragma unroll
                for (int e = 0; e < 128; ++e) o[e] *= al;
                mx = s; }
            const float p = expf(s - mx); l += p;
#pragma unroll
            for (int e = 0; e < 128; ++e) o[e] += p * Vs[kk][e];
        }
    }
    const float il = 1.f / l; float* op = (c ? O1 : O0) + (rowbase + qi) * D + h * 128;
#pragma unroll
    for (int e = 0; e < 128; e += 4) *(f32x4*)(op + e) = (f32x4){o[e] * il, o[e + 1] * il, o[e + 2] * il, o[e + 3] * il};
}

__global__ __launch_bounds__(256) void k_diff(const float* __restrict__ O0, const float* __restrict__ O1, const float* __restrict__ lp, const float* __restrict__ sn, bf16_t* __restrict__ out) {
    const int row = blockIdx.x * 4 + (threadIdx.x >> 6), lane = threadIdx.x & 63;
    const float s01 = wave_sum(lp[lane] * lp[64 + lane]), s23 = wave_sum(lp[128 + lane] * lp[192 + lane]);
    const float lam = expf(s01) - expf(s23) + LAM_INIT;
    const f32x4* a = (const f32x4*)(O0 + (size_t)row * D + 16 * lane); const f32x4* b = (const f32x4*)(O1 + (size_t)row * D + 16 * lane);
    f32x4 v[4]; float s = 0.f;
#pragma unroll
    for (int j = 0; j < 4; ++j) { v[j] = a[j] - b[j] * lam; s += v[j].x * v[j].x + v[j].y * v[j].y + v[j].z * v[j].z + v[j].w * v[j].w; }
    s += __shfl_xor(s, 1); s += __shfl_xor(s, 2); s += __shfl_xor(s, 4);
    const float rstd = rsqrtf(s * (1.f / VD) + EPS) * (1.f - LAM_INIT);
    const f32x4* g = (const f32x4*)(sn + 16 * (lane & 7));
    unsigned long long* o8 = (unsigned long long*)(out + (size_t)row * D + 16 * lane);
#pragma unroll
    for (int j = 0; j < 4; ++j) { const f32x4 gg = g[j];
        const unsigned x0 = f2bf(v[j].x * rstd * gg.x), x1 = f2bf(v[j].y * rstd * gg.y), x2 = f2bf(v[j].z * rstd * gg.z), x3 = f2bf(v[j].w * rstd * gg.w);
        o8[j] = (unsigned long long)(x0 | (x1 << 16)) | ((unsigned long long)(x2 | (x3 << 16)) << 32); }
}

__global__ __launch_bounds__(256) void k_router(const float* __restrict__ x, const float* __restrict__ g, const float* __restrict__ Wr, int* __restrict__ sel, float* __restrict__ gate) {
    const int row = blockIdx.x * 4 + (threadIdx.x >> 6), lane = threadIdx.x & 63;
    const f32x4* xr = (const f32x4*)(x + (size_t)row * D) + lane; const f32x4* gr = (const f32x4*)g + lane;
    f32x4 v[4]; float s = 0.f;
#pragma unroll
    for (int j = 0; j < 4; ++j) { v[j] = xr[64 * j]; s += v[j].x * v[j].x + v[j].y * v[j].y + v[j].z * v[j].z + v[j].w * v[j].w; }
    const float rstd = rsqrtf(wave_sum(s) * (1.f / D) + EPS);
    float lg[8];
#pragma unroll
    for (int e = 0; e < 8; ++e) lg[e] = 0.f;
#pragma unroll
    for (int j = 0; j < 4; ++j) { const f32x4 gg = gr[64 * j]; const float hv[4] = {v[j].x * rstd * gg.x, v[j].y * rstd * gg.y, v[j].z * rstd * gg.z, v[j].w * rstd * gg.w};
#pragma unroll
        for (int i = 0; i < 4; ++i) { const int k = 4 * (lane + 64 * j) + i; const f32x4 w0 = *(const f32x4*)(Wr + (size_t)k * 8), w1 = *(const f32x4*)(Wr + (size_t)k * 8 + 4);
            lg[0] += hv[i] * w0.x; lg[1] += hv[i] * w0.y; lg[2] += hv[i] * w0.z; lg[3] += hv[i] * w0.w; lg[4] += hv[i] * w1.x; lg[5] += hv[i] * w1.y; lg[6] += hv[i] * w1.z; lg[7] += hv[i] * w1.w; } }
#pragma unroll
    for (int e = 0; e < 8; ++e) lg[e] = wave_sum(lg[e]);
    if (lane == 0) {
        int i0 = 0; float v0 = lg[0];
#pragma unroll
        for (int e = 1; e < 8; ++e) if (lg[e] > v0) { v0 = lg[e]; i0 = e; }
        int i1 = -1; float v1 = -INFINITY;
#pragma unroll
        for (int e = 0; e < 8; ++e) if (e != i0 && lg[e] > v1) { v1 = lg[e]; i1 = e; }
        const float g1 = 1.f / (1.f + expf(v0 - v1));
        sel[2 * row] = i0; sel[2 * row + 1] = i1; gate[2 * row] = 1.f - g1; gate[2 * row + 1] = g1;
    }
}

__global__ __launch_bounds__(1024) void k_bin(const int* __restrict__ sel, int* __restrict__ slot_tok, int* __restrict__ tok_slot, int* __restrict__ gbase, int* __restrict__ gcount) {
    __shared__ int cnt[NE][1024];
    __shared__ int base[NE], tot[NE];
    const int tid = threadIdx.x;
#pragma unroll
    for (int e = 0; e < NE; ++e) cnt[e][tid] = 0;
    for (int i = 0; i < 32; ++i) { const int e = sel[tid * 32 + i]; cnt[e][tid] += 1; }
    __syncthreads();
    if (tid < NE) { int run = 0; for (int i = 0; i < 1024; ++i) { const int c = cnt[tid][i]; cnt[tid][i] = run; run += c; } tot[tid] = run; }
    __syncthreads();
    if (tid == 0) { int b = 0; for (int e = 0; e < NE; ++e) { base[e] = b; gbase[e] = b; gcount[e] = tot[e]; b += (tot[e] + 255) & ~255; } }
    __syncthreads();
    for (int i = 0; i < 32; ++i) { const int e = sel[tid * 32 + i]; const int s = base[e] + cnt[e][tid]; cnt[e][tid] += 1; slot_tok[s] = (tid * 32 + i) >> 1; tok_slot[tid * 32 + i] = s; }
    for (int e = 0; e < NE; ++e) { const int padn = ((tot[e] + 255) & ~255) - tot[e]; if (tid < padn) slot_tok[base[e] + tot[e] + tid] = 0; }
}

__global__ __launch_bounds__(256) void k_final(const float* __restrict__ x3, const float* __restrict__ Y, const int* __restrict__ tok_slot, const float* __restrict__ gate, float* __restrict__ out) {
    const int idx = blockIdx.x * 256 + threadIdx.x; const int row = idx >> 8, c4 = idx & 255;
    const int s0 = tok_slot[2 * row], s1 = tok_slot[2 * row + 1]; const float g0 = gate[2 * row], g1 = gate[2 * row + 1];
    const f32x4 a = ((const f32x4*)x3)[idx], y0 = ((const f32x4*)(Y + (size_t)s0 * D))[c4], y1 = ((const f32x4*)(Y + (size_t)s1 * D))[c4];
    ((f32x4*)out)[idx] = a + y0 * g0 + y1 * g1;
}

namespace pg8 {
#define PG8_LAS __attribute__((address_space(3)))
typedef unsigned short bf16_t;
typedef short bf16x8 __attribute__((ext_vector_type(8)));
typedef float f32x4 __attribute__((ext_vector_type(4)));
typedef unsigned u32x4 __attribute__((ext_vector_type(4)));
typedef int i32x4 __attribute__((ext_vector_type(4)));
typedef int i32x8 __attribute__((ext_vector_type(8)));
constexpr int BM = 256, BK = 64, HALF = 128, HTB = HALF * BK * 2  , STAGE_BYTES = 8 * HTB, NXCD = 8, WGM = 8;

__host__ __device__ __forceinline__ int lds_byte(int r, int c) { const int st = (r >> 4) * 2 + (c >> 5), rr = r & 15, cc = c & 31, ob = rr * 64 + cc * 2; return st * 1024 + (ob ^ (((ob >> 9) & 1) << 5)); }
__host__ __device__ __forceinline__ void stage_rc(int b, int& R, int& C) { const int st = b / 1024, sb = b % 1024, swz = sb ^ (((sb >> 9) & 1) << 5); R = (st >> 1) * 16 + swz / 64; C = (st & 1) * 32 + (swz % 64) / 2; }
__host__ __device__ __forceinline__ int perm32(int rho) { const int n = rho >> 4, i = rho & 15; return 8 * (i >> 2) + 4 * n + (i & 3); }

struct Unit { int pm, pn; };
struct Gemm { const bf16_t* A; const bf16_t* Bt; int M, N, K; };

struct StaticOrder {
    int nM, nN, nwg, G, c;
    __host__ __device__ void init(int M, int N, int G_, int c_) { nM = M / BM; nN = N / BM; nwg = nM * nN; G = G_; c = c_; }
    __host__ __device__ bool next(int i, Unit& u) const {
        const long L = (long)i * G + c; if (L >= nwg) return false;
        int wgid = (int)L; { const int q = nwg / NXCD, r = nwg % NXCD, xcd = wgid % NXCD, off = wgid / NXCD; wgid = (xcd < r ? xcd * (q + 1) : r * (q + 1) + (xcd - r) * q) + off; }
        const int nig = WGM * nN, gid = wgid / nig, fm = gid * WGM, gsz = (nM - fm) < WGM ? (nM - fm) : WGM;
        u.pm = fm + ((wgid % nig) % gsz); u.pn = (wgid % nig) / gsz; return true;
    }
    __device__ __forceinline__ void a_ready(const Unit&) const {}
    __device__ __forceinline__ void done(const Unit&) const {}
};

__device__ __forceinline__ unsigned cvt_pk_bf16(float lo, float hi) { unsigned r; asm volatile("v_cvt_pk_bf16_f32 %0, %1, %2" : "=v"(r) : "v"(lo), "v"(hi)); return r; }
typedef float f32x2 __attribute__((ext_vector_type(2)));
typedef unsigned u32x2 __attribute__((ext_vector_type(2)));
constexpr float RMS_EPS = 1e-6f, LOG2E = 1.4426950408889634f;
constexpr int DM_ = 1024;
__device__ __forceinline__ u32x4 pack8(const f32x4 a, const f32x4 b) { u32x4 w; w.x = cvt_pk_bf16(a[0], a[1]); w.y = cvt_pk_bf16(a[2], a[3]); w.z = cvt_pk_bf16(b[0], b[1]); w.w = cvt_pk_bf16(b[2], b[3]); return w; }
__device__ __forceinline__ float rstd_of(const float* ssq, int row) { const f32x4 p = *(const f32x4*)(ssq + (size_t)row * 4); return __builtin_amdgcn_rsqf(((p[0] + p[1]) + (p[2] + p[3])) * (1.0f / 1024.0f) + RMS_EPS); }
__device__ __forceinline__ float silu_mul(float g, float u) { return g * u * __builtin_amdgcn_rcpf(1.0f + __builtin_amdgcn_exp2f(-g * LOG2E)); }
__device__ __forceinline__ f32x2 swiglu2(f32x2 a, f32x2 b, float c1, float k) {
    const f32x2 t = a * c1; f32x2 e; e.x = __builtin_amdgcn_exp2f(t.x); e.y = __builtin_amdgcn_exp2f(t.y);
    const f32x2 d = e * k + k; f32x2 r; r.x = __builtin_amdgcn_rcpf(d.x); r.y = __builtin_amdgcn_rcpf(d.y);
    return (a * b) * r;
}

struct EpiInProj {
    static constexpr bool PERM = true, AFTER_DRAIN = false;
    bf16_t* Bb; bf16_t* Ub;
    __device__ __forceinline__ void operator()(const f32x4 (&acc)[2][2][4][2], const Unit& u, int wr, int wc, int fr, int fq) const {
        const int row0 = u.pm * BM + wr * 64 + fr;
        if (u.pn < 4) {
            const int col0 = u.pn * BM + wc * 32 + 8 * fq;
#pragma unroll
            for (int ai = 0; ai < 2; ++ai)
#pragma unroll
                for (int m = 0; m < 4; ++m) { bf16_t* rowp = Bb + (size_t)(row0 + ai * HALF + m * 16) * DM_ + col0;
#pragma unroll
                    for (int bj = 0; bj < 2; ++bj) *(u32x4*)(rowp + bj * HALF) = pack8(acc[ai][bj][m][0], acc[ai][bj][m][1]); }
        } else {
            const int col0 = (u.pn - 4) * 128 + wc * 32 + 8 * fq;
#pragma unroll
            for (int ai = 0; ai < 2; ++ai)
#pragma unroll
                for (int m = 0; m < 4; ++m) { bf16_t* rowp = Ub + (size_t)(row0 + ai * HALF + m * 16) * DM_ + col0;
                    *(u32x4*)rowp = pack8(acc[ai][0][m][0] * acc[ai][1][m][0], acc[ai][0][m][1] * acc[ai][1][m][1]); }
        }
    }
};

struct EpiResidSsq {
    static constexpr bool PERM = false, AFTER_DRAIN = true;
    const float* xold; float* xnew; bf16_t* xb; float* ssq;
    __device__ __forceinline__ void fused(f32x4 (&acc)[2][2][4][2], const Unit& u, int wr, int wc, int fr, int fq, PG8_LAS unsigned char* lds, int wid, int lane) const {
        PG8_LAS float* P = (PG8_LAS float*)lds;
        const int col0 = u.pn * BM + wc * 32 + 4 * fq;
#pragma unroll
        for (int ai = 0; ai < 2; ++ai)
#pragma unroll
            for (int m = 0; m < 4; ++m) { const int r = ai * HALF + wr * 64 + m * 16 + fr; const size_t off = (size_t)(u.pm * BM + r) * DM_ + col0; float s = 0.f;
#pragma unroll
                for (int bj = 0; bj < 2; ++bj)
#pragma unroll
                    for (int n = 0; n < 2; ++n) { const f32x4 v = *(const f32x4*)(xold + off + bj * HALF + n * 16) + acc[ai][bj][m][n];
                        *(f32x4*)(xnew + off + bj * HALF + n * 16) = v;
                        u32x2 w; w.x = cvt_pk_bf16(v[0], v[1]); w.y = cvt_pk_bf16(v[2], v[3]); *(u32x2*)(xb + off + bj * HALF + n * 16) = w;
                        s += (v[0] * v[0] + v[1] * v[1]) + (v[2] * v[2] + v[3] * v[3]); }
                s += __shfl_xor(s, 16); s += __shfl_xor(s, 32);
                if (fq == 0) P[r * 4 + wc] = s;
                if (m & 1) asm volatile("" ::: "memory"); }
        asm volatile("s_waitcnt lgkmcnt(0)" ::: "memory"); __builtin_amdgcn_s_barrier(); asm volatile("" ::: "memory");
        const int t = wid * 64 + lane;
        if (t < 256) { const PG8_LAS f32x4* Pr = (const PG8_LAS f32x4*)lds; const f32x4 p = Pr[t]; ssq[(size_t)(u.pm * BM + t) * 4 + u.pn] = (p[0] + p[1]) + (p[2] + p[3]); }
        asm volatile("s_waitcnt lgkmcnt(0)" ::: "memory"); __builtin_amdgcn_s_barrier(); asm volatile("" ::: "memory");
    }
};

struct EpiSwiGLU {
    static constexpr bool PERM = true, AFTER_DRAIN = false;
    bf16_t* H; int ldh; const float* ssq; const float* rstd; int ncol;
    __device__ __forceinline__ void operator()(const f32x4 (&acc)[2][2][4][2], const Unit& u, int wr, int wc, int fr, int fq) const {
        const int row0 = u.pm * BM + wr * 64 + fr, col0 = (u.pn % ncol) * 128 + wc * 32 + 8 * fq;
#pragma unroll
        for (int ai = 0; ai < 2; ++ai)
#pragma unroll
            for (int m = 0; m < 4; ++m) { const int row = row0 + ai * HALF + m * 16;
                float k; if (ssq) { const f32x4 p = *(const f32x4*)(ssq + (size_t)row * 4); k = ((p[0] + p[1]) + (p[2] + p[3])) * (1.0f / 1024.0f) + RMS_EPS; } else { const float r_ = rstd[row]; k = 1.0f / (r_ * r_); }
                const float c1 = -LOG2E * __builtin_amdgcn_rsqf(k);
                f32x4 h[2];
#pragma unroll
                for (int n = 0; n < 2; ++n) { const f32x4 a = acc[ai][0][m][n], b = acc[ai][1][m][n];
                    const f32x2 h0 = swiglu2((f32x2){a[0], a[1]}, (f32x2){b[0], b[1]}, c1, k), h1 = swiglu2((f32x2){a[2], a[3]}, (f32x2){b[2], b[3]}, c1, k);
                    h[n] = (f32x4){h0.x, h0.y, h1.x, h1.y}; }
                *(u32x4*)(H + (size_t)row * ldh + col0) = pack8(h[0], h[1]); }
    }
};

struct EpiQKV {
    static constexpr bool PERM = true, AFTER_DRAIN = false;
    bf16_t *Q, *K, *V; const float* ssq; const float* qg; const float* kg; float qscale;
    __device__ __forceinline__ void operator()(const f32x4 (&acc)[2][2][4][2], const Unit& u, int wr, int wc, int fr, int fq) const {
        const int row0 = u.pm * BM + wr * 64 + fr;
        if (u.pn < 8) {
            const bool isq = u.pn < 4; bf16_t* base = isq ? Q : K; const float* gn = isq ? qg : kg; const float sc = isq ? qscale : 1.0f;
            const int col0 = (4 * (u.pn & 3) + wc) * 64 + 8 * fq;
            f32x4 gv[2][2];
#pragma unroll
            for (int bj = 0; bj < 2; ++bj)
#pragma unroll
                for (int n = 0; n < 2; ++n) gv[bj][n] = *(const f32x4*)(gn + 32 * bj + 8 * fq + 4 * n);
#pragma unroll
            for (int ai = 0; ai < 2; ++ai)
#pragma unroll
                for (int m = 0; m < 4; ++m) { const int row = row0 + ai * HALF + m * 16; const float rs = rstd_of(ssq, row);
                    f32x4 v[2][2]; float ss = 0.f;
#pragma unroll
                    for (int bj = 0; bj < 2; ++bj)
#pragma unroll
                        for (int n = 0; n < 2; ++n) { v[bj][n] = acc[ai][bj][m][n] * rs; ss += (v[bj][n][0] * v[bj][n][0] + v[bj][n][1] * v[bj][n][1]) + (v[bj][n][2] * v[bj][n][2] + v[bj][n][3] * v[bj][n][3]); }
                    ss += __shfl_xor(ss, 16); ss += __shfl_xor(ss, 32);
                    const float r2 = __builtin_amdgcn_rsqf(ss * (1.0f / 64.0f) + RMS_EPS) * sc;
#pragma unroll
                    for (int bj = 0; bj < 2; ++bj) *(u32x4*)(base + (size_t)row * DM_ + col0 + 32 * bj) = pack8(v[bj][0] * r2 * gv[bj][0], v[bj][1] * r2 * gv[bj][1]); }
        } else {
            const int col0 = (u.pn - 8) * BM + wc * 32 + 8 * fq;
#pragma unroll
            for (int ai = 0; ai < 2; ++ai)
#pragma unroll
                for (int m = 0; m < 4; ++m) { const int row = row0 + ai * HALF + m * 16; const float rs = rstd_of(ssq, row);
#pragma unroll
                    for (int bj = 0; bj < 2; ++bj) *(u32x4*)(V + (size_t)row * DM_ + col0 + bj * HALF) = pack8(acc[ai][bj][m][0] * rs, acc[ai][bj][m][1] * rs); }
        }
    }
};

__device__ __forceinline__ float clamp448(float x) { return __builtin_amdgcn_fmed3f(x, -448.0f, 448.0f); }
__device__ __forceinline__ unsigned pk4_fp8(float a, float b, float c, float d) { int w = 0; w = __builtin_amdgcn_cvt_pk_fp8_f32(clamp448(a), clamp448(b), w, false); w = __builtin_amdgcn_cvt_pk_fp8_f32(clamp448(c), clamp448(d), w, true); return (unsigned)w; }
constexpr float F8_SA = 4.0f, F8_SWG = 256.0f, F8_SH = 8.0f, F8_SWD = 512.0f;

struct EpiSwiGLU8 {
    static constexpr bool PERM = true, AFTER_DRAIN = false;
    unsigned char* H; int ldh; int ncol;
    __device__ __forceinline__ void operator()(const f32x4 (&acc)[2][2][4][2], const Unit& u, int wr, int wc, int fr, int fq) const {
        const int row0 = u.pm * BM + wr * 64 + fr, col0 = (u.pn % ncol) * 128 + wc * 32 + 8 * fq; constexpr float cs = 1.0f / (F8_SA * F8_SWG);
#pragma unroll
        for (int ai = 0; ai < 2; ++ai)
#pragma unroll
            for (int m = 0; m < 4; ++m) { const int row = row0 + ai * HALF + m * 16; f32x4 h[2];
#pragma unroll
                for (int n = 0; n < 2; ++n) { const f32x4 a = acc[ai][0][m][n], b = acc[ai][1][m][n];
                    const f32x2 h0 = swiglu2((f32x2){a[0], a[1]}, (f32x2){b[0], b[1]}, -cs * LOG2E, 1.0f / (cs * cs * F8_SH)), h1 = swiglu2((f32x2){a[2], a[3]}, (f32x2){b[2], b[3]}, -cs * LOG2E, 1.0f / (cs * cs * F8_SH));
                    h[n] = (f32x4){h0.x, h0.y, h1.x, h1.y}; }
                u32x2 w; w.x = pk4_fp8(h[0][0], h[0][1], h[0][2], h[0][3]); w.y = pk4_fp8(h[1][0], h[1][1], h[1][2], h[1][3]);
                *(u32x2*)(H + (size_t)row * ldh + col0) = w; }
    }
};

struct EpiMoeDown {
    static constexpr bool PERM = true, AFTER_DRAIN = false;
    bf16_t* Y; const float* gate; float scale;
    __device__ __forceinline__ void operator()(const f32x4 (&acc)[2][2][4][2], const Unit& u, int wr, int wc, int fr, int fq) const {
        const int row0 = u.pm * BM + wr * 64 + fr, col0 = (u.pn & 3) * BM + wc * 32 + 8 * fq;
#pragma unroll
        for (int ai = 0; ai < 2; ++ai)
#pragma unroll
            for (int m = 0; m < 4; ++m) { const int row = row0 + ai * HALF + m * 16; const float gt = gate[row] * scale;
#pragma unroll
                for (int bj = 0; bj < 2; ++bj) *(u32x4*)(Y + (size_t)row * DM_ + col0 + bj * HALF) = pack8(acc[ai][bj][m][0] * gt, acc[ai][bj][m][1] * gt); }
    }
};

struct MoeOrder {
    int nM, nN, nwg, G, c; int t1, t2, t3, t4, t5, t6, t7;
    __device__ __forceinline__ void init(const int* meta, int nN_, int G_, int c_) {
        nM = meta[8]; nN = nN_; nwg = nM * nN; G = G_; c = c_; t1 = meta[1]; t2 = meta[2]; t3 = meta[3]; t4 = meta[4]; t5 = meta[5]; t6 = meta[6]; t7 = meta[7]; }
    __device__ __forceinline__ bool next(int i, Unit& u) const {
        const long L = (long)i * G + c; if (L >= nwg) return false;
        int wgid = (int)L; { const int q = nwg / NXCD, r = nwg % NXCD, xcd = wgid % NXCD, off = wgid / NXCD; wgid = (xcd < r ? xcd * (q + 1) : r * (q + 1) + (xcd - r) * q) + off; }
        const int nig = WGM * nN, gid = wgid / nig, fm = gid * WGM, gsz = (nM - fm) < WGM ? (nM - fm) : WGM;
        const int pm = fm + ((wgid % nig) % gsz), pnl = (wgid % nig) / gsz;
        const int e = (pm >= t1) + (pm >= t2) + (pm >= t3) + (pm >= t4) + (pm >= t5) + (pm >= t6) + (pm >= t7);
        u.pm = pm; u.pn = e * nN + pnl; return true;
    }
    __device__ __forceinline__ void a_ready(const Unit&) const {}
    __device__ __forceinline__ void done(const Unit&) const {}
};
template <class Epi, class Sched, bool ALIGN_EPI = false, bool SP2 = false, bool F8 = false>
__device__ __forceinline__ void gemm_phase(PG8_LAS unsigned char* lds, const Gemm g, const Sched& S, const Epi& E) {
    const int tid = threadIdx.x, wid = __builtin_amdgcn_readfirstlane(tid >> 6), lane = tid & 63, wr = wid >> 2, wc = wid & 3, fr = lane & 15, fq = lane >> 4;
    int K_ = g.K; asm volatile("" : "+s"(K_));
    const int K = K_, nt = K / BK;
    unsigned voffA[2], voffB[2];
#pragma unroll
    for (int i = 0; i < 2; ++i) { int R, C; stage_rc(tid * 16 + i * 8192, R, C); const int Rb = Epi::PERM ? ((R & ~31) + perm32(R & 31)) : R;
        voffA[i] = (unsigned)(R * K + C) * 2u; voffB[i] = (unsigned)(Rb * K + C) * 2u; }
    const size_t kstep = (size_t)(BK * 2);
    const size_t hstep = (size_t)HALF * K * 2;
    const size_t tstep = 2 * hstep;
    const unsigned ldsw = (unsigned)wid * 1024u;
    const int aoff = lds_byte(wr * 64 + fr, fq * 8), boff = lds_byte(wc * 32 + fr, fq * 8);
    constexpr int KSTEP = 1024;
#define PG8_SA(b, h) (((b) * 2 + (h)) * HTB)
#define PG8_SB(b, h) ((4 + (b) * 2 + (h)) * HTB)
#define PG8_STAGE(bufoff, gbase, voff) do { _Pragma("unroll") for (int _i = 0; _i < 2; ++_i) \
        __builtin_amdgcn_global_load_lds((const unsigned*)((const char*)(gbase) + (voff)[_i]), (PG8_LAS unsigned*)(lds + (bufoff) + ldsw + _i * 8192), 16, 0, 0); } while (0)
#define PG8_LDA(dst, b, h) do { _Pragma("unroll") for (int m = 0; m < 4; ++m) _Pragma("unroll") for (int k = 0; k < 2; ++k) dst[m][k] = *(const PG8_LAS bf16x8*)(lds + PG8_SA(b, h) + aoff + m * 2048 + k * KSTEP); } while (0)
#define PG8_LDB(dst, b, h) do { _Pragma("unroll") for (int n = 0; n < 2; ++n) _Pragma("unroll") for (int k = 0; k < 2; ++k) dst[n][k] = *(const PG8_LAS bf16x8*)(lds + PG8_SB(b, h) + boff + n * 2048 + k * KSTEP); } while (0)
#define PG8_CAT8(x) __builtin_shufflevector(__builtin_bit_cast(i32x4, (x)[0]), __builtin_bit_cast(i32x4, (x)[1]), 0, 1, 2, 3, 4, 5, 6, 7)
#define PG8_MMA(ai, bj, At, Bt) do { __builtin_amdgcn_s_setprio(1); _Pragma("unroll") for (int m = 0; m < 4; ++m) _Pragma("unroll") for (int n = 0; n < 2; ++n) { \
        if constexpr (F8) asm volatile("s_nop 1\n\tv_mfma_f32_16x16x128_f8f6f4 %0, %1, %2, %0" : "+v"(acc[ai][bj][m][n]) : "v"(PG8_CAT8(Bt[n])), "v"(PG8_CAT8(At[m]))); \
        else { _Pragma("unroll") for (int k = 0; k < 2; ++k) acc[ai][bj][m][n] = __builtin_amdgcn_mfma_f32_16x16x32_bf16(Bt[n][k], At[m][k], acc[ai][bj][m][n], 0, 0, 0); } } \
        __builtin_amdgcn_s_setprio(0); } while (0)
#define PG8_WAIT_V(n) asm volatile("s_waitcnt vmcnt(" #n ")" ::: "memory")
#define PG8_WAIT_L(n) asm volatile("s_waitcnt lgkmcnt(" #n ")" ::: "memory")
#define PG8_BAR __builtin_amdgcn_s_barrier()
#define PG8_SCHED __builtin_amdgcn_sched_barrier(0)
    Unit cur, nxt; int ui = 0;
    if (!S.next(0, cur)) return;
    f32x4 acc[2][2][4][2];
#pragma unroll
    for (int a = 0; a < 2; ++a)
#pragma unroll
        for (int b = 0; b < 2; ++b)
#pragma unroll
            for (int m = 0; m < 4; ++m)
#pragma unroll
                for (int n = 0; n < 2; ++n) acc[a][b][m][n] = (f32x4){0.f, 0.f, 0.f, 0.f};
    bf16x8 At[4][2], B0[2][2], B1[2][2];
    const char* cA = (const char*)g.A + (size_t)cur.pm * tstep; const char* cB = (const char*)g.Bt + (size_t)cur.pn * tstep;
    S.a_ready(cur);
    if constexpr (SP2) {
        PG8_STAGE(PG8_SB(0, 0), cB, voffB); PG8_STAGE(PG8_SB(0, 1), cB + hstep, voffB); PG8_STAGE(PG8_SA(0, 0), cA, voffA); PG8_STAGE(PG8_SA(0, 1), cA + hstep, voffA);
        if (wr == 1) PG8_BAR;
        PG8_WAIT_V(2); PG8_BAR;
        PG8_STAGE(PG8_SB(1, 0), cB + kstep, voffB); PG8_STAGE(PG8_SA(1, 0), cA + kstep, voffA); PG8_STAGE(PG8_SB(1, 1), cB + hstep + kstep, voffB);
        PG8_WAIT_V(6); PG8_BAR;
    } else {
        PG8_STAGE(PG8_SB(0, 0), cB, voffB); PG8_STAGE(PG8_SA(0, 0), cA, voffA); PG8_STAGE(PG8_SB(0, 1), cB + hstep, voffB); PG8_STAGE(PG8_SA(0, 1), cA + hstep, voffA);
        if (wr == 1) PG8_BAR;
        PG8_WAIT_V(4); PG8_BAR;
        PG8_STAGE(PG8_SB(1, 0), cB + kstep, voffB); PG8_STAGE(PG8_SA(1, 0), cA + kstep, voffA); PG8_STAGE(PG8_SB(1, 1), cB + hstep + kstep, voffB);
        PG8_WAIT_V(6); PG8_BAR;
    }
    for (;;) {
        const bool has_next = S.next(ui + 1, nxt);
        const char* nA = has_next ? (const char*)g.A + (size_t)nxt.pm * tstep : cA; const char* nB = has_next ? (const char*)g.Bt + (size_t)nxt.pn * tstep : cB;
        for (int t = 0; t < nt; t += 2) {
            const bool last = (t == nt - 2);
            const char* a1 = cA + (size_t)(t + 1) * kstep;
            const char* a2 = last ? nA : cA + (size_t)(t + 2) * kstep; const char* b2 = last ? nB : cB + (size_t)(t + 2) * kstep;
            const char* a3 = a2 + kstep; const char* b3 = b2 + kstep;
            if (last && has_next) S.a_ready(nxt);
            if constexpr (SP2) {
            PG8_LDB(B0, 0, 0); PG8_LDB(B1, 0, 1); PG8_SCHED; PG8_LDA(At, 0, 0); PG8_STAGE(PG8_SA(1, 1), a1 + hstep, voffA);
            PG8_WAIT_V(8); PG8_WAIT_L(0); PG8_BAR; PG8_MMA(0, 0, At, B0); PG8_MMA(0, 1, At, B1); PG8_BAR; PG8_SCHED;
            PG8_LDA(At, 0, 1); PG8_STAGE(PG8_SB(0, 0), b2, voffB); PG8_STAGE(PG8_SB(0, 1), b2 + hstep, voffB); PG8_STAGE(PG8_SA(0, 0), a2, voffA);
            PG8_WAIT_V(8); PG8_WAIT_L(0); PG8_BAR; PG8_MMA(1, 0, At, B0); PG8_MMA(1, 1, At, B1); PG8_BAR; PG8_SCHED;
            PG8_LDB(B0, 1, 0); PG8_LDB(B1, 1, 1); PG8_SCHED; PG8_LDA(At, 1, 0); PG8_STAGE(PG8_SA(0, 1), a2 + hstep, voffA);
            PG8_WAIT_V(8); PG8_WAIT_L(0); PG8_BAR; PG8_MMA(0, 0, At, B0); PG8_MMA(0, 1, At, B1); PG8_BAR; PG8_SCHED;
            PG8_LDA(At, 1, 1); PG8_STAGE(PG8_SB(1, 0), b3, voffB); PG8_STAGE(PG8_SB(1, 1), b3 + hstep, voffB); PG8_STAGE(PG8_SA(1, 0), a3, voffA);
            PG8_WAIT_V(8); PG8_WAIT_L(0); PG8_BAR; PG8_MMA(1, 0, At, B0); PG8_MMA(1, 1, At, B1); PG8_BAR; PG8_SCHED;
            } else {
            PG8_LDB(B0, 0, 0); PG8_SCHED; PG8_LDA(At, 0, 0); PG8_STAGE(PG8_SA(1, 1), a1 + hstep, voffA);
            PG8_WAIT_L(8); PG8_BAR; PG8_WAIT_L(0); PG8_MMA(0, 0, At, B0); PG8_BAR; PG8_SCHED;
            PG8_LDB(B1, 0, 1); PG8_STAGE(PG8_SB(0, 0), b2, voffB);
            PG8_BAR; PG8_WAIT_L(0); PG8_MMA(0, 1, At, B1); PG8_BAR;
            PG8_LDA(At, 0, 1); PG8_STAGE(PG8_SA(0, 0), a2, voffA);
            PG8_BAR; PG8_WAIT_L(0); PG8_MMA(1, 0, At, B0); PG8_BAR; PG8_SCHED;
            PG8_STAGE(PG8_SB(0, 1), b2 + hstep, voffB);
            PG8_WAIT_V(6); PG8_BAR; PG8_MMA(1, 1, At, B1); PG8_BAR;
            PG8_LDB(B0, 1, 0); PG8_SCHED; PG8_LDA(At, 1, 0); PG8_STAGE(PG8_SA(0, 1), a2 + hstep, voffA);
            PG8_WAIT_L(8); PG8_BAR; PG8_WAIT_L(0); PG8_MMA(0, 0, At, B0); PG8_BAR; PG8_SCHED;
            PG8_LDB(B1, 1, 1); PG8_STAGE(PG8_SB(1, 0), b3, voffB);
            PG8_BAR; PG8_WAIT_L(0); PG8_MMA(0, 1, At, B1); PG8_BAR;
            PG8_LDA(At, 1, 1); PG8_STAGE(PG8_SA(1, 0), a3, voffA);
            PG8_BAR; PG8_WAIT_L(0); PG8_MMA(1, 0, At, B0); PG8_BAR; PG8_SCHED;
            PG8_STAGE(PG8_SB(1, 1), b3 + hstep, voffB);
            PG8_WAIT_V(6); PG8_BAR; PG8_MMA(1, 1, At, B1); PG8_BAR;
            }
        }
        if constexpr (F8) asm volatile("s_nop 15\n\ts_nop 15" ::: "memory");
        if constexpr (ALIGN_EPI) { if (wr == 0) PG8_BAR; }
        if constexpr (!Epi::AFTER_DRAIN) { E(acc, cur, wr, wc, fr, fq); S.done(cur); }
        if (!has_next) break;
#pragma unroll
        for (int a = 0; a < 2; ++a)
#pragma unroll
            for (int b = 0; b < 2; ++b)
#pragma unroll
                for (int m = 0; m < 4; ++m)
#pragma unroll
                    for (int n = 0; n < 2; ++n) acc[a][b][m][n] = (f32x4){0.f, 0.f, 0.f, 0.f};
        cur = nxt; cA = nA; cB = nB; ++ui;
        if constexpr (ALIGN_EPI) { if (wr == 1) PG8_BAR; }
    }
    PG8_WAIT_V(0);
    if constexpr (!ALIGN_EPI) { if (wr == 0) PG8_BAR; }
    PG8_BAR;
    if constexpr (Epi::AFTER_DRAIN) { E.fused(acc, cur, wr, wc, fr, fq, lds, wid, lane); S.done(cur); }
#undef PG8_SA
#undef PG8_SB
#undef PG8_STAGE
#undef PG8_LDA
#undef PG8_LDB
#undef PG8_MMA
#undef PG8_CAT8
#undef PG8_WAIT_V
#undef PG8_WAIT_L
#undef PG8_BAR
#undef PG8_SCHED
}
}
#include <hip/hip_bf16.h>
#include <cmath>
namespace attn_body {
using bf16=__hip_bfloat16;
using bf16x8=__attribute__((ext_vector_type(8)))short;
using s16x4=__attribute__((ext_vector_type(4)))short;
using f32x16=__attribute__((ext_vector_type(16)))float;
using u32x4=__attribute__((ext_vector_type(4)))unsigned;
constexpr int BATCH=8,NHEAD=16,SEQ=2048,D=64,DM=NHEAD*D;
constexpr int NW=8,QBLK=32,QB=QBLK*NW,KVBLK=64,NQB=SEQ/QB;
constexpr int ATTN_PITCH=DM, ATTN_UNIT_ROWS=QB;
__device__ __forceinline__ int crow(int r,int hi){return (r&3)+8*(r>>2)+4*hi;}
#define SBAR() __builtin_amdgcn_sched_barrier(0)
__device__ __forceinline__ void cmask(f32x16&p0,f32x16&p1,int jb,int qrel,int hi){
  const float NEG=-INFINITY; int kb=64*jb+4*hi;
  #pragma unroll
  for(int r=0;r<16;++r){int kv=kb+(r&3)+8*(r>>2); if(kv>qrel)p0[r]=NEG; if(kv+32>qrel)p1[r]=NEG;}
}

constexpr int NSLOT=3, SLOTB=8192;
constexpr int LDS_K=0, LDS_V=NSLOT*SLOTB, LDS_WS=2*NSLOT*SLOTB, LDS_OST=LDS_WS+NW*64*4, LDS_BYTES=LDS_OST+NW*4096;
constexpr float C2=0.125f*1.4426950408889634f;
__device__ __forceinline__ void glds16(const void*gsrc,unsigned lds_dst){unsigned keep;
  asm volatile("s_mov_b32 %0, m0\n\ts_mov_b32 m0, %2\n\ts_nop 0\n\tglobal_load_lds_dwordx4 %1, off\n\ts_mov_b32 m0, %0":"=&s"(keep):"v"(gsrc),"s"(lds_dst):"memory");}
__device__ __forceinline__ float max3f(float a,float b,float c){float r;asm("v_max3_f32 %0, %1, %2, %3":"=v"(r):"v"(a),"v"(b),"v"(c));return r;}
__device__ __forceinline__ float max2f(float a,float b){float r;asm("v_max_f32_e32 %0, %1, %2":"=v"(r):"v"(a),"v"(b));return r;}
__device__ __forceinline__ float fadd_s(float a,float b){float r;asm("v_add_f32_e32 %0, %1, %2":"=v"(r):"v"(a),"v"(b));return r;}
__device__ __forceinline__ float fsub_s(float a,float b){float r;asm("v_sub_f32_e32 %0, %1, %2":"=v"(r):"v"(a),"v"(b));return r;}
typedef float f32x2_t __attribute__((ext_vector_type(2))); typedef __bf16 bf16x2_t __attribute__((ext_vector_type(2)));
__device__ __forceinline__ unsigned cvtpk_s(float lo,float hi){f32x2_t v={lo,hi};bf16x2_t b=__builtin_convertvector(v,bf16x2_t);return __builtin_bit_cast(unsigned,b);}
#define WAIT_BAR(N) asm volatile("s_waitcnt vmcnt(" #N ") lgkmcnt(0)\n\ts_barrier":::"memory")

__device__ __forceinline__ void qkt(f32x16&p0,f32x16&p1,const char*Kslot,const bf16x8*qr,const f32x16&negm,int r32,int hi){
  const char*kb=Kslot+hi*1024+r32*16;
  #pragma unroll
  for(int d0=0;d0<4;++d0){
    const bf16x8 b0=*reinterpret_cast<const bf16x8*>(kb+d0*2048);
    const bf16x8 b1=*reinterpret_cast<const bf16x8*>(kb+d0*2048+512);
    if(d0==0){p0=__builtin_amdgcn_mfma_f32_32x32x16_bf16(b0,qr[0],negm,0,0,0);p1=__builtin_amdgcn_mfma_f32_32x32x16_bf16(b1,qr[0],negm,0,0,0);}
    else{p0=__builtin_amdgcn_mfma_f32_32x32x16_bf16(b0,qr[d0],p0,0,0,0);p1=__builtin_amdgcn_mfma_f32_32x32x16_bf16(b1,qr[d0],p1,0,0,0);}}
}
typedef __attribute__((address_space(3))) const char* lds_cptr;
typedef short v4i16_t __attribute__((ext_vector_type(4)));
__device__ __forceinline__ void kload8(bf16x8*kf,lds_cptr kp){
  kf[0]=*(const __attribute__((address_space(3))) bf16x8*)(kp);      kf[1]=*(const __attribute__((address_space(3))) bf16x8*)(kp+512);
  kf[2]=*(const __attribute__((address_space(3))) bf16x8*)(kp+2048); kf[3]=*(const __attribute__((address_space(3))) bf16x8*)(kp+2560);
  kf[4]=*(const __attribute__((address_space(3))) bf16x8*)(kp+4096); kf[5]=*(const __attribute__((address_space(3))) bf16x8*)(kp+4608);
  kf[6]=*(const __attribute__((address_space(3))) bf16x8*)(kp+6144); kf[7]=*(const __attribute__((address_space(3))) bf16x8*)(kp+6656);
}
__device__ __forceinline__ void kload2(bf16x8*kf,lds_cptr kp,int j){ kf[2*j]=*(const __attribute__((address_space(3))) bf16x8*)(kp+j*2048); kf[2*j+1]=*(const __attribute__((address_space(3))) bf16x8*)(kp+j*2048+512); }
__device__ __forceinline__ s16x4 vtr(lds_cptr p){ return __builtin_bit_cast(s16x4,__builtin_amdgcn_ds_read_tr16_b64_v4i16((__attribute__((address_space(3))) v4i16_t*)p)); }
__device__ __forceinline__ float rowmax(const f32x16&p0,const f32x16&p1){
  float a=max3f(p0[0],p0[1],p1[0]),b=max3f(p0[2],p0[3],p1[1]);a=max3f(a,p1[2],p1[3]);
  #pragma unroll
  for(int r=4;r<16;r+=4){a=max3f(a,p0[r],p0[r+1]);b=max3f(b,p0[r+2],p0[r+3]);a=max3f(a,p1[r],p1[r+1]);b=max3f(b,p1[r+2],p1[r+3]);}
  const float m=max2f(a,b);
  auto rr=__builtin_amdgcn_permlane32_swap(__float_as_uint(m),__float_as_uint(m),false,false);
  return max2f(__uint_as_float(rr[0]),__uint_as_float(rr[1]));
}
__device__ __forceinline__ void pv(f32x16*o,int vb,bf16x8 pa0,bf16x8 pa1,bf16x8 pa2,bf16x8 pa3){
  #pragma unroll
  for(int d0=0;d0<2;++d0){s16x4 lo[4],hi[4];
    #pragma unroll
    for(int ks=0;ks<4;++ks){
      asm volatile("ds_read_b64_tr_b16 %0,%1 offset:%c2":"=&v"(lo[ks]):"v"(vb),"i"(d0*4096+ks*1024):"memory");
      asm volatile("ds_read_b64_tr_b16 %0,%1 offset:%c2":"=&v"(hi[ks]):"v"(vb),"i"(d0*4096+ks*1024+512):"memory");}
    asm volatile("s_waitcnt lgkmcnt(0)":::"memory");SBAR();
    #define PK(k) (bf16x8){lo[k][0],lo[k][1],lo[k][2],lo[k][3],hi[k][0],hi[k][1],hi[k][2],hi[k][3]}
    o[d0]=__builtin_amdgcn_mfma_f32_32x32x16_bf16(pa0,PK(0),o[d0],0,0,0);
    o[d0]=__builtin_amdgcn_mfma_f32_32x32x16_bf16(pa1,PK(1),o[d0],0,0,0);
    o[d0]=__builtin_amdgcn_mfma_f32_32x32x16_bf16(pa2,PK(2),o[d0],0,0,0);
    o[d0]=__builtin_amdgcn_mfma_f32_32x32x16_bf16(pa3,PK(3),o[d0],0,0,0);
    #undef PK
  }
}

#ifndef ATTN_STORE16
#define ATTN_STORE16(p,v) (*(u32x4*)(p)=(v))
#endif
template<int THRL> __device__ __forceinline__ void attn_unit(int b,int qcol,int vcol,int qb,const bf16*Q,const bf16*__restrict__ K,const bf16*__restrict__ V,bf16*O,char*shm){
  int tid_=threadIdx.x; asm volatile("":"+v"(tid_));
  const int tid=tid_,lane=tid&63,r32=lane&31,hi=lane>>5; const int wid=__builtin_amdgcn_readfirstlane(tid>>6);
  const long rowbase=(long)b*SEQ; const int q0=qb*QB;
  const bf16*Qw=Q+(rowbase+q0+wid*QBLK)*DM+qcol;
  const bf16*Kh=K+rowbase*DM+qcol,*Vh=V+rowbase*DM+vcol;
  const unsigned lds0=(unsigned)(uintptr_t)shm;
  float*wsf=(float*)(shm+LDS_WS)+wid*64;
  const bf16*ksrc=Kh+(long)lane*DM+wid*8;
  const bf16*vsrc=Vh+(long)(16*(wid&3)+(lane>>2))*DM+(wid>>2)*32+(lane&3)*8;
  const unsigned kdst=lds0+LDS_K+wid*1024, vdst=lds0+LDS_V+wid*1024;
  #define DMA_K(t,slot) glds16(ksrc+(long)(t)*KVBLK*DM,(unsigned)__builtin_amdgcn_readfirstlane(kdst+(slot)))
  #define DMA_V(t,slot) glds16(vsrc+(long)(t)*KVBLK*DM,(unsigned)__builtin_amdgcn_readfirstlane(vdst+(slot)))
  const int vb0=(int)(lds0+LDS_V)+((lane>>4)&1)*32+(lane&3)*8+(4*hi+((lane&15)>>2))*64;
  const char*Kbase=shm+LDS_K; bf16x8 kf[8];
  const lds_cptr shm3=(lds_cptr)shm; const lds_cptr kp0=shm3+LDS_K+hi*1024+r32*16; const lds_cptr vp0=shm3+LDS_V+((lane>>4)&1)*32+(lane&3)*8+(4*hi+((lane&15)>>2))*64;
  const int NT=(q0+QB)/KVBLK;
  DMA_K(0,0);DMA_V(0,0);DMA_K(1,SLOTB);
  bf16x8 qr[4];
  #pragma unroll
  for(int d0=0;d0<4;++d0)qr[d0]=*reinterpret_cast<const bf16x8*>(&Qw[(long)r32*DM+d0*16+hi*8]);
  float mhat=0.f,l_reg=0.f;f32x16 o[2];o[0]=f32x16{};o[1]=f32x16{};f32x16 negm=f32x16{};asm volatile("":"+v"(negm));
  const int qrel=wid*QBLK+r32;
  #define CMASK(P0,P1,t) do{int jb_=(t)-(NT-4); if(jb_>=0)cmask(P0,P1,jb_,qrel,hi);}while(0)
  bool resc=false;
  #define START(P0,P1) do{ const float rm=rowmax(P0,P1); resc=false; \
    { const float dl=rm; mhat=fadd_s(mhat,dl); \
      _Pragma("unroll") for(int r=0;r<16;++r){P0[r]=fsub_s(P0[r],dl);P1[r]=fsub_s(P1[r],dl);} \
      _Pragma("unroll") for(int r=0;r<16;++r)negm[r]=-mhat; asm volatile("":"+v"(negm)); } \
    _Pragma("unroll") for(int r=0;r<16;++r)P0[r]=__builtin_amdgcn_exp2f(P0[r]); }while(0)
  #define RESC() do{ if(resc){ asm volatile("s_waitcnt lgkmcnt(0)":::"memory"); \
      _Pragma("unroll") for(int d_=0;d_<2;++d_) _Pragma("unroll") for(int r=0;r<16;++r)o[d_][r]*=wsf[crow(r,hi)]; } }while(0)
  f32x16 pA0,pA1,pB0,pB1;
  int sl_prev=0,sl_cur=0,sl_next=SLOTB;
  #define ROT() do{sl_prev=sl_cur;sl_cur=sl_next;sl_next=(sl_next==(NSLOT-1)*SLOTB)?0:sl_next+SLOTB;}while(0)
  DMA_K(2,2*SLOTB);
  WAIT_BAR(3);
  qkt(pA0,pA1,Kbase,qr,negm,r32,hi);asm volatile("s_nop 15\n\ts_nop 7":"+v"(pA0),"+v"(pA1));CMASK(pA0,pA1,0);
  START(pA0,pA1);
  _Pragma("unroll") for(int r=0;r<16;++r)pA1[r]=__builtin_amdgcn_exp2f(pA1[r]);
  WAIT_BAR(0);
  DMA_K(3,0);DMA_V(1,SLOTB);
  ROT();
  kload8(kf,kp0+sl_cur);
  WAIT_BAR(2);
  s16x4 vlo[8],vhi[8]; u32x4 pw0,pw1,pw2,pw3;
  #define PKW(P,B) cvtpk_s(P[B],P[B+1])
  #define PAF(k) __builtin_bit_cast(bf16x8,pw##k)
  #define VFR(i) (bf16x8){vlo[i][0],vlo[i][1],vlo[i][2],vlo[i][3],vhi[i][0],vhi[i][1],vhi[i][2],vhi[i][3]}
  #define PIN(x) asm volatile("":"+v"(x))
  #define MX3(a,b,c) __builtin_fmaxf(__builtin_fmaxf((a),(b)),(c))
  #define GAPA(MF,A0,A1,A2,A3,W0,W1,PW) do{ MF; sacc+=A0; sacc+=A1; sacc+=A2; sacc+=A3; PIN(sacc); W0; W1; PIN(PW); SBAR(); }while(0)
  #define EX(v) __builtin_amdgcn_exp2f(v)
  #define GAPB(MF,X,B) do{ MF; X[B]=EX(X[B]); X[B+1]=EX(X[B+1]); X[B+2]=EX(X[B+2]); X[B+3]=EX(X[B+3]); PIN(X); SBAR(); }while(0)
  #define VRD(i) do{ vlo[i]=vtr(vp_+(((i)>>2)*4096+((i)&3)*1024)); vhi[i]=vtr(vp_+(((i)>>2)*4096+((i)&3)*1024+512)); }while(0)
  #define KRD(G,j) do{ if(G){ kload2(kf,kp0+sl_next,j); SBAR(); } }while(0)
  #define STEP(C0,C1,P0,P1,t,GK,GV,GL) do{ SBAR(); \
    const lds_cptr vp_=vp0+sl_prev; \
    VRD(0); SBAR(); float sacc=(P0[0]+P0[1]); \
    GAPA(C0=__builtin_amdgcn_mfma_f32_32x32x16_bf16(kf[0],qr[0],negm,0,0,0), P0[2],P0[3],P0[4],P0[5],     pw0[0]=PKW(P0,0), pw0[1]=PKW(P0,2), pw0); \
    VRD(4); SBAR(); GAPA(C1=__builtin_amdgcn_mfma_f32_32x32x16_bf16(kf[1],qr[0],negm,0,0,0), P0[6],P0[7],P0[8],P0[9],     pw0[2]=PKW(P0,4), pw0[3]=PKW(P0,6), pw0); \
    VRD(1); SBAR(); GAPA(C0=__builtin_amdgcn_mfma_f32_32x32x16_bf16(kf[2],qr[1],C0,0,0,0),   P0[10],P0[11],P0[12],P0[13], pw1[0]=PKW(P0,8), pw1[1]=PKW(P0,10), pw1); \
    VRD(5); SBAR(); GAPA(C1=__builtin_amdgcn_mfma_f32_32x32x16_bf16(kf[3],qr[1],C1,0,0,0),   P0[14],P0[15],P1[0],P1[1],   pw1[2]=PKW(P0,12),pw1[3]=PKW(P0,14), pw1); \
    VRD(2); SBAR(); GAPA(C0=__builtin_amdgcn_mfma_f32_32x32x16_bf16(kf[4],qr[2],C0,0,0,0),   P1[2],P1[3],P1[4],P1[5],     pw2[0]=PKW(P1,0), pw2[1]=PKW(P1,2), pw2); \
    VRD(6); SBAR(); GAPA(C1=__builtin_amdgcn_mfma_f32_32x32x16_bf16(kf[5],qr[2],C1,0,0,0),   P1[6],P1[7],P1[8],P1[9],     pw2[2]=PKW(P1,4), pw2[3]=PKW(P1,6), pw2); \
    VRD(3); SBAR(); GAPA(C0=__builtin_amdgcn_mfma_f32_32x32x16_bf16(kf[6],qr[3],C0,0,0,0),   P1[10],P1[11],P1[12],P1[13], pw3[0]=PKW(P1,8), pw3[1]=PKW(P1,10), pw3); \
    VRD(7); SBAR(); GAPA(C1=__builtin_amdgcn_mfma_f32_32x32x16_bf16(kf[7],qr[3],C1,0,0,0),   P1[14],P1[15],0.f,0.f,       pw3[2]=PKW(P1,12),pw3[3]=PKW(P1,14), pw3); \
    l_reg+=sacc; \
    if(GK){DMA_K((t)+3,sl_cur);} if(GV){DMA_V((t)+1,sl_next);} \
    CMASK(C0,C1,t); \
    { float a=MX3(C0[0],C0[1],C1[0]),b=MX3(C0[2],C0[3],C1[1]); a=MX3(a,C1[2],C1[3]); \
      _Pragma("unroll") for(int r=4;r<16;r+=4){a=MX3(a,C0[r],C0[r+1]);b=MX3(b,C0[r+2],C0[r+3]);a=MX3(a,C1[r],C1[r+1]);b=MX3(b,C1[r+2],C1[r+3]);} \
      float rm=__builtin_fmaxf(a,b); { auto rr=__builtin_amdgcn_permlane32_swap(__float_as_uint(rm),__float_as_uint(rm),false,false); rm=__builtin_fmaxf(__uint_as_float(rr[0]),__uint_as_float(rr[1])); } \
      resc=false; \
      if(__builtin_expect(__any(rm>(float)THRL),0)){ const float dl=__builtin_fmaxf(rm,0.f); mhat+=dl; \
        _Pragma("unroll") for(int r=0;r<16;++r){C0[r]-=dl;C1[r]-=dl;} \
        _Pragma("unroll") for(int r=0;r<16;++r)negm[r]=-mhat; asm volatile("":"+v"(negm)); \
        const float f=__builtin_amdgcn_exp2f(-dl); l_reg*=f; if(hi==0)wsf[r32]=f; resc=true; } } \
    SBAR(); \
    GAPB(o[0]=__builtin_amdgcn_mfma_f32_32x32x16_bf16(PAF(0),VFR(0),o[0],0,0,0), C0,0); \
    GAPB(o[1]=__builtin_amdgcn_mfma_f32_32x32x16_bf16(PAF(0),VFR(4),o[1],0,0,0), C0,4); \
    KRD(GL,0); GAPB(o[0]=__builtin_amdgcn_mfma_f32_32x32x16_bf16(PAF(1),VFR(1),o[0],0,0,0), C0,8); \
    KRD(GL,1); GAPB(o[1]=__builtin_amdgcn_mfma_f32_32x32x16_bf16(PAF(1),VFR(5),o[1],0,0,0), C0,12); \
    KRD(GL,2); GAPB(o[0]=__builtin_amdgcn_mfma_f32_32x32x16_bf16(PAF(2),VFR(2),o[0],0,0,0), C1,0); \
    KRD(GL,3); GAPB(o[1]=__builtin_amdgcn_mfma_f32_32x32x16_bf16(PAF(2),VFR(6),o[1],0,0,0), C1,4); \
    GAPB(o[0]=__builtin_amdgcn_mfma_f32_32x32x16_bf16(PAF(3),VFR(3),o[0],0,0,0), C1,8); \
    GAPB(o[1]=__builtin_amdgcn_mfma_f32_32x32x16_bf16(PAF(3),VFR(7),o[1],0,0,0), C1,12); \
    }while(0)
  int t=1;
  #undef CMASK
  #define CMASK(P0,P1,t) do{}while(0)
  for(;t+5<NT;t+=2){
    STEP(pB0,pB1,pA0,pA1,t,true,true,true);     WAIT_BAR(2); RESC(); ROT();
    STEP(pA0,pA1,pB0,pB1,t+1,true,true,true);   WAIT_BAR(2); RESC(); ROT();
  }
  #undef CMASK
  #define CMASK(P0,P1,t) do{int jb_=(t)-(NT-4); if(jb_>=0)cmask(P0,P1,jb_,qrel,hi);}while(0)
  #define ENDW(tt) do{ if((tt)+3<NT){WAIT_BAR(2);} else if((tt)+2<NT){WAIT_BAR(1);} else {WAIT_BAR(0);} }while(0)
  for(;t+1<NT;t+=2){
    STEP(pB0,pB1,pA0,pA1,t,(t+3<NT),(t+1<NT),(t+1<NT));       ENDW(t);   RESC(); ROT();
    STEP(pA0,pA1,pB0,pB1,t+1,(t+4<NT),(t+2<NT),(t+2<NT));     ENDW(t+1); RESC(); ROT();
  }
  STEP(pB0,pB1,pA0,pA1,NT-1,false,false,false); RESC();
  { float sacc=pB0[0]+pB0[1]; _Pragma("unroll") for(int r=2;r<16;++r)sacc+=pB0[r]; _Pragma("unroll") for(int r=0;r<16;++r)sacc+=pB1[r]; l_reg+=sacc;
    pw0=(u32x4){PKW(pB0,0),PKW(pB0,2),PKW(pB0,4),PKW(pB0,6)};pw1=(u32x4){PKW(pB0,8),PKW(pB0,10),PKW(pB0,12),PKW(pB0,14)};pw2=(u32x4){PKW(pB1,0),PKW(pB1,2),PKW(pB1,4),PKW(pB1,6)};pw3=(u32x4){PKW(pB1,8),PKW(pB1,10),PKW(pB1,12),PKW(pB1,14)};
    SBAR(); pv(o,vb0+sl_cur,PAF(0),PAF(1),PAF(2),PAF(3)); }
  #undef PKW
  #undef PAF
  #undef VFR
  #undef PIN
  #undef MX3
  #undef GAPA
  #undef GAPB
  #undef EX
  #undef VRD
  #undef KRD
  #undef STEP
  #undef ENDW
  {auto rr=__builtin_amdgcn_permlane32_swap(__float_as_uint(l_reg),__float_as_uint(l_reg),false,false);l_reg=__uint_as_float(rr[0])+__uint_as_float(rr[1]);}
  if(hi==0)wsf[32+r32]=l_reg;asm volatile("s_waitcnt lgkmcnt(0)":::"memory");
  float rli[16];
  #pragma unroll
  for(int r=0;r<16;++r)rli[r]=__builtin_amdgcn_rcpf(wsf[32+crow(r,hi)]);
  bf16*Ow=O+(rowbase+q0+wid*QBLK)*DM+vcol;
  { bf16*stg=(bf16*)(shm+LDS_OST)+wid*2048;
    #pragma unroll
    for(int r=0;r<16;++r){const int orow=crow(r,hi);
      #pragma unroll
      for(int d0=0;d0<2;++d0)stg[orow*64+d0*32+r32]=__float2bfloat16(o[d0][r]*rli[r]);}
    asm volatile("s_waitcnt lgkmcnt(0)":::"memory");
    #pragma unroll
    for(int i=0;i<4;++i){const int row=i*8+(lane>>3),ch=lane&7; const u32x4 v=*(const u32x4*)(stg+row*64+ch*8); ATTN_STORE16(Ow+(long)row*DM+ch*8,v);} }
  asm volatile("s_waitcnt lgkmcnt(0)\n\ts_barrier":::"memory");
  #undef DMA_K
  #undef DMA_V
  #undef CMASK
  #undef START
  #undef RESC
  #undef ROT
}
constexpr int ATTN_LDS_BYTES=LDS_BYTES;
#undef SBAR
#undef WAIT_BAR
}
constexpr int NWAVES = 8;
constexpr int NPH = 15;
constexpr size_t MiB = 1u << 20;
constexpr size_t WS_CTL = 0, CTL_ZERO_BYTES = 1 * MiB;
constexpr size_t WS_W_IN = 1 * MiB;
constexpr size_t WS_W_OUT = WS_W_IN + (size_t)3072 * 1024 * 2;
constexpr size_t WS_W_GU = WS_W_OUT + (size_t)1024 * 1024 * 2;
constexpr size_t WS_W_DN = WS_W_GU + (size_t)5632 * 1024 * 2;
constexpr size_t WS_W_QKV = WS_W_DN + (size_t)1024 * 2816 * 2;
constexpr size_t WS_W_O = WS_W_QKV + (size_t)3072 * 1024 * 2;
constexpr size_t WS_W_MGU = WS_W_O + (size_t)1024 * 1024 * 2;
constexpr size_t WS_W_MDN = WS_W_MGU + (size_t)8 * 7168 * 1024 * 2;
constexpr size_t WS_W_END = WS_W_MDN + (size_t)8 * 1024 * 3584 * 2;
constexpr size_t WS_R = 202 * MiB;
constexpr size_t ACT = (size_t)M * D * 2;
constexpr size_t WS_XN0 = WS_R, WS_BB = WS_R + ACT, WS_UB = WS_R + 2 * ACT, WS_G = WS_R + 3 * ACT;
constexpr size_t WS_HACT = WS_R;
constexpr size_t WS_Q = WS_R + 4 * ACT, WS_K = WS_R + 5 * ACT, WS_V = WS_R + 6 * ACT;
constexpr size_t WS_O0 = WS_R, WS_O1 = WS_R + ACT, WS_ON = WS_R + 2 * ACT;
constexpr size_t WS_HM = WS_R;
constexpr size_t WS_S = 440 * MiB;
constexpr size_t WS_XG = WS_S, WS_Y = WS_S + 68 * MiB;
constexpr size_t WS_XB = 632 * MiB;
constexpr size_t WS_HB = 664 * MiB, WS_HB2 = 696 * MiB, WS_YF = 728 * MiB;
constexpr size_t WS_SMALL = 792 * MiB;
constexpr size_t WS_SSQ = WS_SMALL;
constexpr size_t WS_SEL = WS_SMALL + 256 * 1024, WS_GATE = WS_SEL + 128 * 1024, WS_TOKSLOT = WS_GATE + 128 * 1024;
constexpr size_t WS_RSTDS = WS_TOKSLOT + 128 * 1024, WS_GATES = WS_RSTDS + 256 * 1024;
constexpr size_t WS_HIST = WS_GATES + 256 * 1024, WS_META = WS_HIST + 16 * 1024;
constexpr size_t WS_NAIVE_SMALL = WS_SMALL + 2 * MiB;
constexpr size_t WS_END = 796 * MiB;
static_assert(WS_W_END <= WS_R && WS_R + (size_t)SLOTS * DFE * 2 <= WS_S && WS_Y + (size_t)SLOTS * D * 2 <= WS_XB && WS_V + ACT <= WS_S, "d_ws map");
constexpr int CW_TMO = 0, CW_CODE = 1, CW_BAR = 4096;
constexpr int MISC_OFF = 0, RING_OFF = 1024, RING_BYTES = 131072, LDS_BYTES = 147456;
constexpr int P0_SCR = 16640;

#define GAS __attribute__((address_space(1)))
#define LAS __attribute__((address_space(3)))
typedef unsigned v4u __attribute__((ext_vector_type(4)));
typedef unsigned v2u __attribute__((ext_vector_type(2)));
typedef GAS unsigned gu32;
#define RLX_AGENT __ATOMIC_RELAXED, __HIP_MEMORY_SCOPE_AGENT
#define LDS_WAIT() asm volatile("s_waitcnt lgkmcnt(0)" ::: "memory")
#define VM_WAIT() asm volatile("s_waitcnt vmcnt(0)" ::: "memory")
__device__ __forceinline__ unsigned pk2(float lo, float hi) { return f2bf(lo) | (f2bf(hi) << 16); }
__device__ __forceinline__ float bflo(unsigned w) { return __builtin_bit_cast(float, w << 16); }
__device__ __forceinline__ float bfhi(unsigned w) { return __builtin_bit_cast(float, w & 0xffff0000u); }

#define XB_TMO      128
#define XB_XCNT(j)  (256  + 64 * (j))
#define XB_XSUB(j)  (1280 + 64 * (j))
#define XB_XGEN(j)  (2304 + 64 * (j))
#define XB_TOP      3328
#define XB_TOPGEN   3392
#define XCD_BAR_WORDS 3456
#define XB_SPIN_CAP (1u << 18)

__device__ __forceinline__ unsigned xb_ld(unsigned* p)              { return __hip_atomic_load(p, __ATOMIC_RELAXED, __HIP_MEMORY_SCOPE_AGENT); }
__device__ __forceinline__ unsigned xb_add(unsigned* p, unsigned v) { return __hip_atomic_fetch_add(p, v, __ATOMIC_RELAXED, __HIP_MEMORY_SCOPE_AGENT); }
__device__ __forceinline__ unsigned xb_xcc_id() { return (unsigned)__builtin_amdgcn_s_getreg((3 << 11) | 20) & 0xFu; }
#define XB_SPIN(cond, bar) do { unsigned _sp = 0; while (cond) { __builtin_amdgcn_s_sleep(1); \
    if ((++_sp & 255u) == 0u) { if (xb_ld(&(bar)[XB_TMO])) break; if (_sp > XB_SPIN_CAP) { atomicAdd(&(bar)[XB_TMO], 1u); break; } } } } while (0)

struct XcdBarrier {
    unsigned* bar; unsigned x;
    volatile LAS unsigned* st;
};

__device__ __forceinline__ XcdBarrier xcd_barrier_post(unsigned* bar, volatile LAS unsigned* st) {
    XcdBarrier b; b.bar = bar; b.x = xb_xcc_id(); b.st = st;
    if (threadIdx.x == 0) (void)xb_add(&bar[XB_XCNT(b.x)], 1u);
    return b;
}
__device__ __forceinline__ void xcd_barrier_complete(unsigned* bar, unsigned x, unsigned& nloc, unsigned& nx) {
    const unsigned G = gridDim.x * gridDim.y * gridDim.z;
    unsigned sum, cnt, mine, sp = 0u;
    for (;;) {
        sum = 0u; cnt = 0u; mine = 0u;
#pragma unroll
        for (unsigned j = 0; j < 16; ++j) { const unsigned c = xb_ld(&bar[XB_XCNT(j)]); sum += c; cnt += (c > 0u) ? 1u : 0u; mine = (j == x) ? c : mine; }
        if (sum == G) break;
        __builtin_amdgcn_s_sleep(1);
        if ((++sp & 255u) == 0u) { if (xb_ld(&bar[XB_TMO])) break; if (sp > XB_SPIN_CAP) { atomicAdd(&bar[XB_TMO], 1u); break; } }
    }
    nloc = mine > 0u ? mine : 1u; nx = cnt > 0u ? cnt : 1u;
}

__device__ __forceinline__ void xcd_barrier(const XcdBarrier& b) {
    asm volatile("s_waitcnt vmcnt(0)" ::: "memory");
    __syncthreads();
    if (threadIdx.x == 0) {
        unsigned* bar = b.bar;
        __builtin_amdgcn_s_waitcnt(0);
        unsigned nloc = b.st[0], nx = b.st[1];
        if (nloc == 0u) { xcd_barrier_complete(bar, b.x, nloc, nx); b.st[0] = nloc; b.st[1] = nx; }
        const unsigned old = xb_add(&bar[XB_XSUB(b.x)], 1u);
        const unsigned gen = old / nloc;
        if (old + 1u == (gen + 1u) * nloc) {
            __builtin_amdgcn_fence(__ATOMIC_RELEASE, "agent");
            asm volatile("s_waitcnt vmcnt(0)" ::: "memory");
            const unsigned og = xb_add(&bar[XB_TOP], 1u);
            const unsigned tg = og / nx;
            if (og + 1u == (tg + 1u) * nx) xb_add(&bar[XB_TOPGEN], 1u);
            else XB_SPIN(xb_ld(&bar[XB_TOPGEN]) == tg, bar);
            __builtin_amdgcn_fence(__ATOMIC_ACQUIRE, "agent");
            xb_add(&bar[XB_XGEN(b.x)], 1u);
            asm volatile("s_waitcnt vmcnt(0)" ::: "memory");
        } else {
            XB_SPIN(xb_ld(&bar[XB_XGEN(b.x)]) == gen, bar);
            __builtin_amdgcn_fence(__ATOMIC_ACQUIRE, "agent");
            asm volatile("s_waitcnt vmcnt(0)" ::: "memory");
        }
    }
    __syncthreads();
}


struct Args { const float* in[19]; float* out; unsigned char* wsp; int ph_lo, ph_hi, li, jobmask; };
struct Frame { LAS unsigned char* lds; int tid, lane, wave, vcu, G; };
#define KA ((const Args*)__builtin_amdgcn_kernarg_segment_ptr())
#define INP(i) (KA->in[i])
#define A_WS (KA->wsp)
#define A_OUT (KA->out)

__device__ __forceinline__ void p0_item(const float* src, int ldw, const float* gain, bf16_t* dst, int K, int k0, int n0, int d0, int d1, LAS float* scr, int lane) {
    const int lr = lane >> 4, lc = lane & 15;
    f32x4 v[16];
#pragma unroll
    for (int i = 0; i < 16; ++i) v[i] = *(const GAS f32x4*)(src + (size_t)(k0 + 4 * i + lr) * ldw + n0 + 4 * lc);
    if (gain) {
#pragma unroll
        for (int i = 0; i < 16; ++i) v[i] = v[i] * gain[k0 + 4 * i + lr];
    }
#pragma unroll
    for (int i = 0; i < 16; ++i) { LAS float* p = scr + (4 * i + lr) * 65 + 4 * lc; p[0] = v[i][0]; p[1] = v[i][1]; p[2] = v[i][2]; p[3] = v[i][3]; }
    LDS_WAIT(); asm volatile("" ::: "memory");
    const int c = lane & 7;
#pragma unroll
    for (int jj = 0; jj < 8; ++jj) { const int nl = 8 * jj + (lane >> 3); const LAS float* s = scr + (8 * c) * 65 + nl;
        v4u o; o.x = pk2(s[0], s[65]); o.y = pk2(s[130], s[195]); o.z = pk2(s[260], s[325]); o.w = pk2(s[390], s[455]);
        const int drow = (jj < 4 ? d0 : d1 - 32) + nl;
        *(GAS v4u*)(dst + (size_t)drow * K + k0 + 8 * c) = o; }
    LDS_WAIT(); asm volatile("" ::: "memory");
}
__device__ __forceinline__ void p0_item8(const float* src, int ldw, const float* gain, float sc, unsigned char* dst, int K, int k0, int n0, int d0, int d1, LAS float* scr, int lane) {
    const int lr = lane >> 4, lc = lane & 15;
    f32x4 v[16];
#pragma unroll
    for (int i = 0; i < 16; ++i) v[i] = *(const GAS f32x4*)(src + (size_t)(k0 + 4 * i + lr) * ldw + n0 + 4 * lc);
#pragma unroll
    for (int i = 0; i < 16; ++i) v[i] = v[i] * (gain ? gain[k0 + 4 * i + lr] * sc : sc);
#pragma unroll
    for (int i = 0; i < 16; ++i) { LAS float* p = scr + (4 * i + lr) * 65 + 4 * lc; p[0] = v[i][0]; p[1] = v[i][1]; p[2] = v[i][2]; p[3] = v[i][3]; }
    LDS_WAIT(); asm volatile("" ::: "memory");
    const int c = lane & 7;
#pragma unroll
    for (int jj = 0; jj < 8; ++jj) { const int nl = 8 * jj + (lane >> 3); const LAS float* s = scr + (8 * c) * 65 + nl;
        v2u o; o.x = pg8::pk4_fp8(s[0], s[65], s[130], s[195]); o.y = pg8::pk4_fp8(s[260], s[325], s[390], s[455]);
        const int drow = (jj < 4 ? d0 : d1 - 32) + nl;
        *(GAS v2u*)(dst + (size_t)drow * K + k0 + 8 * c) = o; }
    LDS_WAIT(); asm volatile("" ::: "memory");
}
__device__ __forceinline__ int p0_dstrow(int mode, int aux, int col) {
    if (mode == 1) { if (col < 1024) return col; const int v = col >= 2048, cc = col - (v ? 2048 : 1024); return 1024 + 256 * (cc >> 7) + 128 * v + (cc & 127); }
    if (mode == 2) { const int up = col >= aux, cc = col - (up ? aux : 0); return 256 * (cc >> 7) + 128 * up + (cc & 127); }
    if (mode == 3) { const int g = col >> 6, bj = (col >> 5) & 1; return 256 * (g >> 2) + 32 * (4 * bj + (g & 3)) + (col & 31); }
    return col;
}
template <bool F8>
__device__ __forceinline__ void p0_job(Frame& F, int& base, const float* src, int ldw, int K, int c0, int ncols, const float* gain, void* dstv, int drow0, int dstrows, int mode, int aux, int nmat, float sc) {
    LAS float* scr = (LAS float*)(F.lds + RING_OFF + F.wave * P0_SCR);
    const int gw = F.vcu * NWAVES + F.wave, NGW = F.G * NWAVES, nk = K / 64, nn = ncols / 64, per = nk * nn, total = per * nmat;
    int it = (gw - base) % NGW; if (it < 0) it += NGW;
    for (; it < total; it += NGW) { const int mat = it / per, r = it % per, kb = r / nn, nb = r % nn; const int col = 64 * nb;
        if constexpr (F8) p0_item8(src + (size_t)mat * K * ldw + c0, ldw, gain, sc, (unsigned char*)dstv + (size_t)mat * dstrows * K, K, 64 * kb, col, drow0 + p0_dstrow(mode, aux, col), drow0 + p0_dstrow(mode, aux, col + 32), scr, F.lane);
        else p0_item(src + (size_t)mat * K * ldw + c0, ldw, gain, (bf16_t*)dstv + (size_t)mat * dstrows * K, K, 64 * kb, col, drow0 + p0_dstrow(mode, aux, col), drow0 + p0_dstrow(mode, aux, col + 32), scr, F.lane); }
    base = (base + total) % NGW;
}
__device__ __forceinline__ void rms_row_bf16(const float* xrow, const float* g, bf16_t* orow, int lane) {
    const GAS f32x4* xr = (const GAS f32x4*)xrow + lane; const GAS f32x4* gr = (const GAS f32x4*)g + lane;
    f32x4 v[4]; float s = 0.f;
#pragma unroll
    for (int j = 0; j < 4; ++j) { v[j] = xr[64 * j]; s += (v[j][0] * v[j][0] + v[j][1] * v[j][1]) + (v[j][2] * v[j][2] + v[j][3] * v[j][3]); }
    const float rstd = __builtin_amdgcn_rsqf(wave_sum(s) * (1.f / D) + EPS);
    GAS v2u* o8 = (GAS v2u*)orow + lane;
#pragma unroll
    for (int j = 0; j < 4; ++j) { const f32x4 gg = gr[64 * j]; v2u o; o.x = pk2(v[j][0] * rstd * gg[0], v[j][1] * rstd * gg[1]); o.y = pk2(v[j][2] * rstd * gg[2], v[j][3] * rstd * gg[3]); o8[64 * j] = o; }
}
__device__ __forceinline__ void p0_prologue(Frame& F, int jobmask) {
    unsigned char* ws = A_WS; int base = 0;
    if (jobmask & 1)   p0_job<false>(F, base, INP(3), 3072, 1024, 0, 3072, nullptr, (bf16_t*)(ws + WS_W_IN), 0, 3072, 1, 0, 1, 1.0f);
    if (jobmask & 2)   p0_job<false>(F, base, INP(5), 1024, 1024, 0, 1024, nullptr, (bf16_t*)(ws + WS_W_OUT), 0, 1024, 0, 0, 1, 1.0f);
    if (jobmask & 4)   p0_job<false>(F, base, INP(14), 5632, 1024, 0, 5632, INP(2), (bf16_t*)(ws + WS_W_GU), 0, 5632, 2, 2816, 1, 1.0f);
    if (jobmask & 8)   p0_job<false>(F, base, INP(15), 1024, 2816, 0, 1024, nullptr, (bf16_t*)(ws + WS_W_DN), 0, 1024, 0, 0, 1, 1.0f);
    if (jobmask & 16) { p0_job<false>(F, base, INP(9), 1024, 1024, 0, 1024, INP(1) + 1024, (bf16_t*)(ws + WS_W_QKV), 0, 3072, 3, 0, 1, 1.0f);
                        p0_job<false>(F, base, INP(7), 2048, 1024, 0, 1024, INP(6), (bf16_t*)(ws + WS_W_QKV), 1024, 3072, 3, 0, 1, 1.0f);
                        p0_job<false>(F, base, INP(7), 2048, 1024, 1024, 1024, INP(6), (bf16_t*)(ws + WS_W_QKV), 2048, 3072, 0, 0, 1, 1.0f); }
    if (jobmask & 32)  p0_job<false>(F, base, INP(13), 1024, 1024, 0, 1024, nullptr, (bf16_t*)(ws + WS_W_O), 0, 1024, 0, 0, 1, 1.0f);
    if (jobmask & 64)  p0_job<true>(F, base, INP(17), 7168, 1024, 0, 7168, INP(2) + 1024, (ws + WS_W_MGU), 0, 7168, 2, 3584, 8, pg8::F8_SWG);
    if (jobmask & 128) p0_job<true>(F, base, INP(18), 1024, 3584, 0, 1024, nullptr, (ws + WS_W_MDN), 0, 1024, 0, 0, 8, pg8::F8_SWD);
    const int gw = F.vcu * NWAVES + F.wave, NGW = F.G * NWAVES;
    for (int m = gw; m < M; m += NGW) rms_row_bf16(INP(0) + (size_t)m * D, INP(1), (bf16_t*)(ws + WS_XN0) + (size_t)m * D, F.lane);
}

__device__ __forceinline__ void up8(const v4u w, float (&f)[8]) { f[0] = bflo(w.x); f[1] = bfhi(w.x); f[2] = bflo(w.y); f[3] = bfhi(w.y); f[4] = bflo(w.z); f[5] = bfhi(w.z); f[6] = bflo(w.w); f[7] = bfhi(w.w); }
__device__ __forceinline__ void p2_conv(Frame& F) {
    const bf16_t* Bb = (const bf16_t*)(A_WS + WS_BB); const bf16_t* Ub = (const bf16_t*)(A_WS + WS_UB); bf16_t* G = (bf16_t*)(A_WS + WS_G); const float* cw = INP(4);
    const int gw = F.vcu * NWAVES + F.wave, NGW = F.G * NWAVES;
    for (int strip = gw; strip < 2048; strip += NGW) {
        const int r0 = (strip >> 1) * 16, c0 = (strip & 1) * 512 + F.lane * 8;
        float w0[8], w1[8], w2[8], um2[8], um1[8];
#pragma unroll
        for (int j = 0; j < 8; ++j) { w0[j] = cw[c0 + j]; w1[j] = cw[D + c0 + j]; w2[j] = cw[2 * D + c0 + j]; um2[j] = 0.f; um1[j] = 0.f; }
        if ((r0 & (SEQ - 1)) != 0) { up8(*(const GAS v4u*)(Ub + (size_t)(r0 - 2) * D + c0), um2); up8(*(const GAS v4u*)(Ub + (size_t)(r0 - 1) * D + c0), um1); }
#pragma unroll
        for (int hb = 0; hb < 2; ++hb) { v4u ru[8], rb[8];
#pragma unroll
            for (int i = 0; i < 8; ++i) { ru[i] = *(const GAS v4u*)(Ub + (size_t)(r0 + 8 * hb + i) * D + c0); rb[i] = *(const GAS v4u*)(Bb + (size_t)(r0 + 8 * hb + i) * D + c0); }
#pragma unroll
            for (int ii = 0; ii < 8; ++ii) { const int i = 8 * hb + ii; float u[8], b[8]; up8(ru[ii], u); up8(rb[ii], b);
            float g[8];
#pragma unroll
            for (int j = 0; j < 8; ++j) { g[j] = b[j] * (w0[j] * um2[j] + w1[j] * um1[j] + w2[j] * u[j]); um2[j] = um1[j]; um1[j] = u[j]; }
            v4u o; o.x = pk2(g[0], g[1]); o.y = pk2(g[2], g[3]); o.z = pk2(g[4], g[5]); o.w = pk2(g[6], g[7]);
            *(GAS v4u*)(G + (size_t)(r0 + i) * D + c0) = o; } }
    }
}

__device__ __forceinline__ void p8_diff(Frame& F) {
    const bf16_t* O0 = (const bf16_t*)(A_WS + WS_O0); const bf16_t* O1 = (const bf16_t*)(A_WS + WS_O1); bf16_t* ON = (bf16_t*)(A_WS + WS_ON);
    const float* lp = INP(11); const float* sn = INP(12); const int lane = F.lane;
    const float lam = __expf(wave_sum(lp[lane] * lp[64 + lane])) - __expf(wave_sum(lp[128 + lane] * lp[192 + lane])) + LAM_INIT;
    float gn[16];
#pragma unroll
    for (int j = 0; j < 16; ++j) gn[j] = sn[16 * (lane & 7) + j] * (1.f - LAM_INIT);
    const int gw = F.vcu * NWAVES + F.wave, NGW = F.G * NWAVES;
    for (int rowb = gw; rowb < M; rowb += 4 * NGW) {
        v4u ra[4][2], rb[4][2];
#pragma unroll
        for (int i = 0; i < 4; ++i) { const int row = rowb + i * NGW; if (row < M) { const size_t off = (size_t)row * D + 16 * lane;
            ra[i][0] = *(const GAS v4u*)(O0 + off); ra[i][1] = *(const GAS v4u*)(O0 + off + 8); rb[i][0] = *(const GAS v4u*)(O1 + off); rb[i][1] = *(const GAS v4u*)(O1 + off + 8); } }
#pragma unroll
        for (int i = 0; i < 4; ++i) { const int row = rowb + i * NGW; if (row >= M) break; const size_t off = (size_t)row * D + 16 * lane;
            float a[16], a0[8], a1[8], b0[8], b1[8]; up8(ra[i][0], a0); up8(ra[i][1], a1); up8(rb[i][0], b0); up8(rb[i][1], b1);
            float s = 0.f;
#pragma unroll
            for (int j = 0; j < 8; ++j) { a[j] = a0[j] - lam * b0[j]; a[8 + j] = a1[j] - lam * b1[j]; s += a[j] * a[j] + a[8 + j] * a[8 + j]; }
            s += __shfl_xor(s, 1); s += __shfl_xor(s, 2); s += __shfl_xor(s, 4);
            const float rstd = __builtin_amdgcn_rsqf(s * (1.f / VD) + EPS);
            v4u o0, o1; o0.x = pk2(a[0] * rstd * gn[0], a[1] * rstd * gn[1]); o0.y = pk2(a[2] * rstd * gn[2], a[3] * rstd * gn[3]); o0.z = pk2(a[4] * rstd * gn[4], a[5] * rstd * gn[5]); o0.w = pk2(a[6] * rstd * gn[6], a[7] * rstd * gn[7]);
            o1.x = pk2(a[8] * rstd * gn[8], a[9] * rstd * gn[9]); o1.y = pk2(a[10] * rstd * gn[10], a[11] * rstd * gn[11]); o1.z = pk2(a[12] * rstd * gn[12], a[13] * rstd * gn[13]); o1.w = pk2(a[14] * rstd * gn[14], a[15] * rstd * gn[15]);
            *(GAS v4u*)(ON + off) = o0; *(GAS v4u*)(ON + off + 8) = o1; }
    }
}

#define TR_STEP(n, m) do { _Pragma("unroll") for (int i = 0; i < (n) / 2; ++i) { const bool up = (lane & (m)) != 0; const float keep = up ? v[i + (n) / 2] : v[i], send = up ? v[i] : v[i + (n) / 2]; v[i] = keep + __shfl_xor(send, (m)); } } while (0)
__device__ __forceinline__ void p10a_router(Frame& F) {
    const float* x3 = A_OUT; const float* g = INP(2) + D; const float* Wr = INP(16); const float* ssq = (const float*)(A_WS + WS_SSQ);
    int* sel = (int*)(A_WS + WS_SEL); float* gate = (float*)(A_WS + WS_GATE); int* hist = (int*)(A_WS + WS_HIST);
    LAS f32x4* WL = (LAS f32x4*)(F.lds + RING_OFF);
    LAS int* lcnt = (LAS int*)(F.lds + RING_OFF + 32768);
    const int lane = F.lane;
    for (int k = F.tid; k < D; k += NWAVES * 64) { const float gk = g[k]; const f32x4 w0 = *(const GAS f32x4*)(Wr + (size_t)k * 8) * gk, w1 = *(const GAS f32x4*)(Wr + (size_t)k * 8 + 4) * gk;
        const int base = (((k >> 8) * 4 + (k & 3)) * 2) * 64 + ((k >> 2) & 63); WL[base] = w0; WL[base + 64] = w1; }
    LDS_WAIT(); __syncthreads();
    for (int blk = blockIdx.x; blk < M / 64; blk += F.G) {
        const int row0 = 64 * blk + 8 * F.wave;
        f32x4 xv[8][4];
#pragma unroll
        for (int r = 0; r < 8; ++r)
#pragma unroll
            for (int j = 0; j < 4; ++j) xv[r][j] = *((const GAS f32x4*)(x3 + (size_t)(row0 + r) * D) + lane + 64 * j);
        float v[64];
#pragma unroll
        for (int i = 0; i < 64; ++i) v[i] = 0.f;
#pragma unroll
        for (int j = 0; j < 4; ++j)
#pragma unroll
            for (int q = 0; q < 4; ++q) { const f32x4 wa = WL[((j * 4 + q) * 2) * 64 + lane], wb = WL[((j * 4 + q) * 2 + 1) * 64 + lane];
#pragma unroll
                for (int r = 0; r < 8; ++r) { const float xx = xv[r][j][q];
                    v[r * 8 + 0] += xx * wa[0]; v[r * 8 + 1] += xx * wa[1]; v[r * 8 + 2] += xx * wa[2]; v[r * 8 + 3] += xx * wa[3];
                    v[r * 8 + 4] += xx * wb[0]; v[r * 8 + 5] += xx * wb[1]; v[r * 8 + 6] += xx * wb[2]; v[r * 8 + 7] += xx * wb[3]; } }
        TR_STEP(64, 32); TR_STEP(32, 16); TR_STEP(16, 8); TR_STEP(8, 4); TR_STEP(4, 2); TR_STEP(2, 1);
        float lg[8];
#pragma unroll
        for (int e = 0; e < 8; ++e) lg[e] = __shfl(v[0], (lane & ~7) | e);
        int i0 = 0; float v0 = lg[0];
#pragma unroll
        for (int e = 1; e < 8; ++e) if (lg[e] > v0) { v0 = lg[e]; i0 = e; }
        int i1 = 0; float v1 = -INFINITY;
#pragma unroll
        for (int e = 0; e < 8; ++e) if (e != i0 && lg[e] > v1) { v1 = lg[e]; i1 = e; }
        const int row = row0 + (lane >> 3); const float rs = pg8::rstd_of(ssq, row);
        const float g1 = 1.f / (1.f + expf((v0 - v1) * rs)); const bool wrt = (lane & 7) == 0;
        if (wrt) { sel[2 * row] = i0; sel[2 * row + 1] = i1; gate[2 * row] = 1.f - g1; gate[2 * row + 1] = g1; }
        int mycnt = 0;
#pragma unroll
        for (int e = 0; e < 8; ++e) { const int c = __popcll(__ballot(wrt && i0 == e)) + __popcll(__ballot(wrt && i1 == e)); if (lane == e) mycnt = c; }
        if (lane < 8) lcnt[F.wave * 8 + lane] = mycnt;
        LDS_WAIT(); __syncthreads();
        if (F.tid < 8) { int c = 0;
#pragma unroll
            for (int w = 0; w < 8; ++w) c += lcnt[w * 8 + F.tid];
            hist[blk * 8 + F.tid] = c; }
        LDS_WAIT(); __syncthreads();
    }
}
#undef TR_STEP
__device__ __forceinline__ void p10b_assign(Frame& F) {
    const int* hist = (const int*)(A_WS + WS_HIST); const int* sel = (const int*)(A_WS + WS_SEL); const float* gate = (const float*)(A_WS + WS_GATE); const float* ssq = (const float*)(A_WS + WS_SSQ);
    int* tok_slot = (int*)(A_WS + WS_TOKSLOT); float* gates = (float*)(A_WS + WS_GATES); int* meta = (int*)(A_WS + WS_META);
    const float* x3 = A_OUT; unsigned char* XG = A_WS + WS_XG;
    LAS int* pre = (LAS int*)(F.lds + RING_OFF);
    LAS int* tot = pre + 2048;
    LAS int* ebase = tot + 8;
    LAS int* lslot = ebase + 8;
    const int lane = F.lane, e = F.wave;
    { int h[4], run = 0;
#pragma unroll
      for (int i = 0; i < 4; ++i) { h[i] = hist[(4 * lane + i) * 8 + e]; }
      const int mine = h[0] + h[1] + h[2] + h[3]; int inc = mine;
#pragma unroll
      for (int o = 1; o < 64; o <<= 1) { const int t = __shfl_up(inc, o); if (lane >= o) inc += t; }
      run = inc - mine;
#pragma unroll
      for (int i = 0; i < 4; ++i) { pre[(4 * lane + i) * 8 + e] = run; run += h[i]; }
      if (lane == 63) tot[e] = inc; }
    LDS_WAIT(); __syncthreads();
    if (F.tid == 0) { int b = 0; for (int k = 0; k < 8; ++k) { ebase[k] = b; if (blockIdx.x == 0) meta[k] = b >> 8; b += (tot[k] + 255) & ~255; } if (blockIdx.x == 0) meta[8] = b >> 8; }
    LDS_WAIT(); __syncthreads();
    for (int blk = blockIdx.x; blk < M / 64; blk += F.G) {
        if (F.wave == 0) { const int t = 64 * blk + lane; const int s0 = sel[2 * t], s1 = sel[2 * t + 1]; int sl0 = 0, sl1 = 0;
            const unsigned long long below = (1ull << lane) - 1ull;
#pragma unroll
            for (int k = 0; k < 8; ++k) { const unsigned long long m0 = __ballot(s0 == k), m1 = __ballot(s1 == k); const int b0 = ebase[k] + pre[blk * 8 + k];
                if (s0 == k) sl0 = b0 + __popcll(m0 & below); if (s1 == k) sl1 = b0 + __popcll(m0) + __popcll(m1 & below); }
            tok_slot[2 * t] = sl0; tok_slot[2 * t + 1] = sl1; lslot[2 * lane] = sl0; lslot[2 * lane + 1] = sl1;
            gates[sl0] = gate[2 * t]; gates[sl1] = gate[2 * t + 1]; }
        LDS_WAIT(); __syncthreads();
        f32x4 xv[8][4];
#pragma unroll
        for (int i = 0; i < 8; ++i) { const GAS f32x4* xr = (const GAS f32x4*)(x3 + (size_t)(64 * blk + 8 * F.wave + i) * D + 16 * lane);
#pragma unroll
            for (int j = 0; j < 4; ++j) xv[i][j] = xr[j]; }
#pragma unroll
        for (int i = 0; i < 8; ++i) { const int tl = 8 * F.wave + i; const int t = 64 * blk + tl;
            const float rs = pg8::rstd_of(ssq, t) * pg8::F8_SA;
            const f32x4 a0 = xv[i][0] * rs, a1 = xv[i][1] * rs, a2 = xv[i][2] * rs, a3 = xv[i][3] * rs;
            v4u o; o.x = pg8::pk4_fp8(a0[0], a0[1], a0[2], a0[3]); o.y = pg8::pk4_fp8(a1[0], a1[1], a1[2], a1[3]); o.z = pg8::pk4_fp8(a2[0], a2[1], a2[2], a2[3]); o.w = pg8::pk4_fp8(a3[0], a3[1], a3[2], a3[3]);
            const int sl0 = lslot[2 * tl], sl1 = lslot[2 * tl + 1];
            *(GAS v4u*)(XG + (size_t)sl0 * D + 16 * lane) = o; *(GAS v4u*)(XG + (size_t)sl1 * D + 16 * lane) = o; }
        LDS_WAIT(); __syncthreads();
    }
}
__device__ __forceinline__ void p13_final(Frame& F) {
    const int* tok_slot = (const int*)(A_WS + WS_TOKSLOT); const bf16_t* Y = (const bf16_t*)(A_WS + WS_Y); float* out = A_OUT;
    const int gw = F.vcu * NWAVES + F.wave, NGW = F.G * NWAVES, lane = F.lane;
    for (int row = gw; row < M; row += NGW) { const int s0 = tok_slot[2 * row], s1 = tok_slot[2 * row + 1];
        GAS f32x4* xr = (GAS f32x4*)(out + (size_t)row * D) + lane; const GAS v2u* y0 = (const GAS v2u*)(Y + (size_t)s0 * D) + lane; const GAS v2u* y1 = (const GAS v2u*)(Y + (size_t)s1 * D) + lane;
#pragma unroll
        for (int j = 0; j < 4; ++j) { f32x4 v = xr[64 * j]; const v2u a = y0[64 * j], b = y1[64 * j];
            v[0] += bflo(a.x) + bflo(b.x); v[1] += bfhi(a.x) + bfhi(b.x); v[2] += bflo(a.y) + bflo(b.y); v[3] += bfhi(a.y) + bfhi(b.y); xr[64 * j] = v; } }
}

__global__ void __launch_bounds__(NWAVES * 64, 2) mega_fwd(Args args) {
    extern __shared__ __attribute__((aligned(16))) unsigned char lds[];
    Frame F;
    F.lds = (LAS unsigned char*)lds; F.tid = threadIdx.x; F.lane = F.tid & 63; F.wave = __builtin_amdgcn_readfirstlane(F.tid >> 6);
    F.G = gridDim.x; { const int bx = blockIdx.x; F.vcu = (F.G % 8 == 0) ? (bx % 8) * (F.G / 8) + bx / 8 : bx; }
    for (int u = F.tid; u < RING_OFF / 4; u += NWAVES * 64) ((LAS unsigned*)(F.lds + MISC_OFF))[u] = 0u;
    __syncthreads();
    if (KA->ph_hi - KA->ph_lo > 1) (void)xcd_barrier_post((unsigned*)(A_WS + WS_CTL) + CW_BAR + KA->li * XCD_BAR_WORDS, (volatile LAS unsigned*)(F.lds + MISC_OFF + 32));
#define IN(k) (KA->ph_lo <= (k) && (k) < KA->ph_hi)
#define SEAM(k) do { if (IN(k) && IN((k) + 1)) { XcdBarrier b_; b_.bar = (unsigned*)(A_WS + WS_CTL) + CW_BAR + KA->li * XCD_BAR_WORDS; b_.x = xb_xcc_id(); b_.st = (volatile LAS unsigned*)(F.lds + MISC_OFF + 32); xcd_barrier(b_); } } while (0)
#define ws A_WS
#define XB ((bf16_t*)(A_WS + WS_XB))
#define SSQ ((float*)(A_WS + WS_SSQ))

    if (IN(0)) { p0_prologue(F, KA->jobmask); } SEAM(0);
    if (IN(1)) { pg8::Gemm g{(const bf16_t*)(ws + WS_XN0), (const bf16_t*)(ws + WS_W_IN), M, 3072, 1024}; pg8::StaticOrder S; S.init(M, 3072, F.G, (int)blockIdx.x);
        pg8::EpiInProj E{(bf16_t*)(ws + WS_BB), (bf16_t*)(ws + WS_UB)};
        pg8::gemm_phase<pg8::EpiInProj, pg8::StaticOrder, true, true>(F.lds + RING_OFF, g, S, E); } SEAM(1);
    if (IN(2)) { p2_conv(F); } SEAM(2);
    if (IN(3)) { pg8::Gemm g{(const bf16_t*)(ws + WS_G), (const bf16_t*)(ws + WS_W_OUT), M, 1024, 1024}; pg8::StaticOrder S; S.init(M, 1024, F.G, (int)blockIdx.x);
        pg8::EpiResidSsq E{INP(0), A_OUT, XB, SSQ};
        pg8::gemm_phase<pg8::EpiResidSsq, pg8::StaticOrder, false, true>(F.lds + RING_OFF, g, S, E); } SEAM(3);
    if (IN(4)) { pg8::Gemm g{XB, (const bf16_t*)(ws + WS_W_GU), M, 5632, 1024}; pg8::StaticOrder S; S.init(M, 5632, F.G, (int)blockIdx.x);
        pg8::EpiSwiGLU E{(bf16_t*)(ws + WS_HACT), DFF, SSQ, nullptr, 22};
        pg8::gemm_phase<pg8::EpiSwiGLU, pg8::StaticOrder, true, true>(F.lds + RING_OFF, g, S, E); } SEAM(4);
    if (IN(5)) { pg8::Gemm g{(const bf16_t*)(ws + WS_HACT), (const bf16_t*)(ws + WS_W_DN), M, 1024, DFF}; pg8::StaticOrder S; S.init(M, 1024, F.G, (int)blockIdx.x);
        pg8::EpiResidSsq E{A_OUT, A_OUT, XB, SSQ};
        pg8::gemm_phase<pg8::EpiResidSsq, pg8::StaticOrder, false, true>(F.lds + RING_OFF, g, S, E); } SEAM(5);
    if (IN(6)) { pg8::Gemm g{XB, (const bf16_t*)(ws + WS_W_QKV), M, 3072, 1024}; pg8::StaticOrder S; S.init(M, 3072, F.G, (int)blockIdx.x);
        pg8::EpiQKV E{(bf16_t*)(ws + WS_Q), (bf16_t*)(ws + WS_K), (bf16_t*)(ws + WS_V), SSQ, INP(10), INP(8), attn_body::C2};
        pg8::gemm_phase<pg8::EpiQKV, pg8::StaticOrder, true, true>(F.lds + RING_OFF, g, S, E); } SEAM(6);
    if (IN(7)) {
        for (int vh = F.vcu; vh < BATCH * 32; vh += F.G) { const int b = vh >> 5, r = vh & 31, h = r >> 2, c = (r >> 1) & 1, vhalf = r & 1;
            attn_body::bf16* O = (attn_body::bf16*)(ws + (c ? WS_O1 : WS_O0));
            for (int qb = SEQ / 256 - 1; qb >= 0; --qb)
                attn_body::attn_unit<8>(b, (2 * h + c) * 64, h * 128 + vhalf * 64, qb, (const attn_body::bf16*)(ws + WS_Q), (const attn_body::bf16*)(ws + WS_K), (const attn_body::bf16*)(ws + WS_V), O, (char*)lds + RING_OFF); }
    } SEAM(7);
    if (IN(8)) { p8_diff(F); } SEAM(8);
    if (IN(9)) { pg8::Gemm g{(const bf16_t*)(ws + WS_ON), (const bf16_t*)(ws + WS_W_O), M, 1024, 1024}; pg8::StaticOrder S; S.init(M, 1024, F.G, (int)blockIdx.x);
        pg8::EpiResidSsq E{A_OUT, A_OUT, XB, SSQ};
        pg8::gemm_phase<pg8::EpiResidSsq, pg8::StaticOrder, false, true>(F.lds + RING_OFF, g, S, E); } SEAM(9);
    if (IN(10)) { p10a_router(F); } SEAM(10);
    if (IN(11)) { p10b_assign(F); } SEAM(11);
    if (IN(12)) { pg8::Gemm g{(const bf16_t*)(ws + WS_XG), (const bf16_t*)(ws + WS_W_MGU), SLOTS, 8 * 7168, 512}; pg8::MoeOrder S; S.init((const int*)(ws + WS_META), 28, F.G, (int)blockIdx.x);
        pg8::EpiSwiGLU8 E{ws + WS_HM, DFE, 28};
        pg8::gemm_phase<pg8::EpiSwiGLU8, pg8::MoeOrder, true, true, true>(F.lds + RING_OFF, g, S, E); } SEAM(12);
    if (IN(13)) { pg8::Gemm g{(const bf16_t*)(ws + WS_HM), (const bf16_t*)(ws + WS_W_MDN), SLOTS, 8 * 1024, DFE / 2}; pg8::MoeOrder S; S.init((const int*)(ws + WS_META), 4, F.G, (int)blockIdx.x);
        pg8::EpiMoeDown E{(bf16_t*)(ws + WS_Y), (const float*)(ws + WS_GATES), 1.0f / (pg8::F8_SH * pg8::F8_SWD)};
        pg8::gemm_phase<pg8::EpiMoeDown, pg8::MoeOrder, true, true, true>(F.lds + RING_OFF, g, S, E); } SEAM(13);
    if (IN(14)) { p13_final(F); }
#undef IN
#undef SEAM
#undef ws
#undef XB
#undef SSQ
}
#ifndef MEGA_UPTO
#define MEGA_UPTO 15
#endif
#ifndef MEGA_REPMASK
#define MEGA_REPMASK 0
#endif
#ifndef MEGA_ONE
#define MEGA_ONE 1
#endif
extern "C" void kernel_launch(void* const* d_in, const int* in_sizes, int n_in, void* d_out, int out_size, void* d_ws, size_t ws_size, hipStream_t stream) {
    static int grid = 0;
    if (grid == 0) {
        if (n_in != 19 || in_sizes[0] != M * D || out_size != M * D || ws_size < WS_END) { fprintf(stderr, "kernel_launch: unexpected shapes / workspace (%d inputs, ws %zu, need %zu)\n", n_in, ws_size, (size_t)WS_END); grid = -1; return; }
        int dev = 0, cus = 0, per_cu = 0;
        if (hipGetDevice(&dev) != hipSuccess || hipDeviceGetAttribute(&cus, hipDeviceAttributeMultiprocessorCount, dev) != hipSuccess) { grid = -1; return; }
        if (hipFuncSetAttribute((const void*)mega_fwd, hipFuncAttributeMaxDynamicSharedMemorySize, LDS_BYTES) != hipSuccess) { fprintf(stderr, "kernel_launch: hipFuncSetAttribute failed\n"); grid = -1; return; }
        if (hipOccupancyMaxActiveBlocksPerMultiprocessor(&per_cu, (const void*)mega_fwd, NWAVES * 64, LDS_BYTES) != hipSuccess || per_cu < 1) fprintf(stderr, "kernel_launch: note: occupancy query says %d\n", per_cu);
        (void)hipGetLastError();
        grid = cus < 256 ? cus : 256;
        if (grid != 256) fprintf(stderr, "kernel_launch: %d CUs; this kernel is built for 256\n", cus);
    }
    if (grid < 0) return;
    unsigned char* ws = (unsigned char*)d_ws; float* out = (float*)d_out;
    const float* x = (const float*)d_in[0]; const float* ln_mix = (const float*)d_in[1]; const float* ln_ffn = (const float*)d_in[2];
    const float* conv_w_in = (const float*)d_in[3]; const float* conv_w = (const float*)d_in[4]; const float* conv_w_out = (const float*)d_in[5];
    const float* ln_kv = (const float*)d_in[6]; const float* w_kv = (const float*)d_in[7]; const float* k_norm = (const float*)d_in[8];
    const float* attn_w_q = (const float*)d_in[9]; const float* q_norm = (const float*)d_in[10]; const float* lam_params = (const float*)d_in[11];
    const float* sub_norm = (const float*)d_in[12]; const float* attn_w_o = (const float*)d_in[13]; const float* ffn_w_gu = (const float*)d_in[14];
    const float* ffn_w_down = (const float*)d_in[15]; const float* router_w = (const float*)d_in[16]; const float* moe_w_gu = (const float*)d_in[17];
    const float* moe_w_down = (const float*)d_in[18];
    constexpr int UPTO = MEGA_UPTO;
    static_assert(UPTO == 0 || UPTO == 4 || UPTO == 6 || UPTO == 7 || UPTO == 9 || UPTO == 10 || UPTO == 15, "MEGA_UPTO");
    if (UPTO > 0) {
        if (hipMemsetAsync(ws + WS_CTL, 0, CTL_ZERO_BYTES, stream) != hipSuccess) { fprintf(stderr, "kernel_launch: memset failed\n"); return; }
        Args a{};
        for (int i = 0; i < 19; ++i) a.in[i] = (const float*)d_in[i];
        a.out = out; a.wsp = ws;
        a.jobmask = UPTO >= 15 ? 255 : UPTO >= 10 ? 63 : UPTO >= 7 ? 31 : UPTO >= 6 ? 15 : 3;
        if (MEGA_ONE) { a.ph_lo = 0; a.ph_hi = UPTO; a.li = 0; hipLaunchKernelGGL(mega_fwd, dim3(grid), dim3(NWAVES * 64), LDS_BYTES, stream, a); }
        else for (int p = 0; p < UPTO; ++p) { a.ph_lo = p; a.ph_hi = p + 1; a.li = 0; for (int r = 0; r <= ((MEGA_REPMASK >> p) & 1); ++r) hipLaunchKernelGGL(mega_fwd, dim3(grid), dim3(NWAVES * 64), LDS_BYTES, stream, a); }
        const hipError_t le = hipPeekAtLastError();
        if (le != hipSuccess) fprintf(stderr, "kernel_launch: launch failed: %s\n", hipGetErrorName(le));
    }
    if (UPTO >= 15) return;
    bf16_t* Wt_in = (bf16_t*)(ws + WS_W_IN); bf16_t* Wt_out = (bf16_t*)(ws + WS_W_OUT); bf16_t* Wt_gu = (bf16_t*)(ws + WS_W_GU); bf16_t* Wt_dn = (bf16_t*)(ws + WS_W_DN);
    bf16_t* Wt_kv = (bf16_t*)(ws + WS_W_QKV); bf16_t* Wt_q = (bf16_t*)(ws + WS_W_QKV + (size_t)2048 * 1024 * 2); bf16_t* Wt_o = (bf16_t*)(ws + WS_W_O);
    bf16_t* Wt_mgu = (bf16_t*)(ws + WS_W_MGU); bf16_t* Wt_mdn = (bf16_t*)(ws + WS_W_MDN);
    bf16_t* HB = (bf16_t*)(ws + WS_HB); bf16_t* HB2 = (bf16_t*)(ws + WS_HB2); float* Yf = (float*)(ws + WS_YF);
    unsigned char* U = ws + WS_R; unsigned char* Vr = ws + WS_S;
    float* F1 = (float*)U; bf16_t* Hact = (bf16_t*)U; float* O0 = (float*)U; float* O1 = O0 + (size_t)M * D;
    float* Qn = (float*)Vr; float* Kn = Qn + (size_t)M * D; float* Vn = Kn + (size_t)M * D; float* Ymoe = (float*)Vr;
    int* sel = (int*)(ws + WS_NAIVE_SMALL); float* gate = (float*)(ws + WS_NAIVE_SMALL + 128 * 1024); int* slot_tok = (int*)(ws + WS_NAIVE_SMALL + 256 * 1024);
    int* tok_slot = (int*)(ws + WS_NAIVE_SMALL + 512 * 1024); int* gbase = (int*)(ws + WS_NAIVE_SMALL + 640 * 1024); int* gcount = gbase + 16;
    float* X = out;
    if (UPTO < 4) {
        k_wt<<<dim3(3072 / 32, D / 32, 1), 256, 0, stream>>>(conv_w_in, Wt_in, D, 3072);
        k_wt<<<dim3(D / 32, D / 32, 1), 256, 0, stream>>>(conv_w_out, Wt_out, D, D);
        k_rmsnorm<<<M / 4, 256, 0, stream>>>(x, ln_mix, HB);
        k_gemm<0><<<dim3(3072 / 64, M / 64, 1), 256, 0, stream>>>(HB, D, Wt_in, D, F1, 3072, M, D, 0, nullptr, nullptr, nullptr, 0);
        k_conv<<<M * D / 256, 256, 0, stream>>>(F1, conv_w, HB2);
        k_gemm<0><<<dim3(D / 64, M / 64, 1), 256, 0, stream>>>(HB2, D, Wt_out, D, Yf, D, M, D, 0, nullptr, nullptr, nullptr, 0);
        k_resid_norm<<<M / 4, 256, 0, stream>>>(x, Yf, X, ln_ffn, HB, nullptr, nullptr);
    } else if (UPTO == 4) k_rmsnorm<<<M / 4, 256, 0, stream>>>(X, ln_ffn, HB);
    if (UPTO < 6) {
        k_wt<<<dim3(2 * DFF / 32, D / 32, 1), 256, 0, stream>>>(ffn_w_gu, Wt_gu, D, 2 * DFF);
        k_wt<<<dim3(D / 32, DFF / 32, 1), 256, 0, stream>>>(ffn_w_down, Wt_dn, DFF, D);
        k_gemm<1><<<dim3(DFF / 64, M / 64, 1), 256, 0, stream>>>(HB, D, Wt_gu, D, Hact, DFF, M, D, DFF, nullptr, nullptr, nullptr, 0);
        k_gemm<0><<<dim3(D / 64, M / 64, 1), 256, 0, stream>>>(Hact, DFF, Wt_dn, DFF, Yf, D, M, DFF, 0, nullptr, nullptr, nullptr, 0);
        k_resid_norm<<<M / 4, 256, 0, stream>>>(X, Yf, X, ln_kv, HB, ln_mix + D, HB2);
    } else if (UPTO == 6) { k_rmsnorm<<<M / 4, 256, 0, stream>>>(X, ln_kv, HB); k_rmsnorm<<<M / 4, 256, 0, stream>>>(X, ln_mix + D, HB2); }
    if (UPTO < 7) {
        k_wt<<<dim3(2048 / 32, D / 32, 1), 256, 0, stream>>>(w_kv, Wt_kv, D, 2048);
        k_wt<<<dim3(D / 32, D / 32, 1), 256, 0, stream>>>(attn_w_q, Wt_q, D, D);
        k_gemm<0><<<dim3(2048 / 64, M / 64, 1), 256, 0, stream>>>(HB, D, Wt_kv, D, F1, 2048, M, D, 0, nullptr, nullptr, nullptr, 0);
        k_headnorm<<<M / 4, 256, 0, stream>>>(F1, 2048, 0, k_norm, 1.f, Kn);
        k_headnorm<<<M / 4, 256, 0, stream>>>(F1, 2048, 1024, nullptr, 1.f, Vn);
        k_gemm<0><<<dim3(D / 64, M / 64, 1), 256, 0, stream>>>(HB2, D, Wt_q, D, Yf, D, M, D, 0, nullptr, nullptr, nullptr, 0);
        k_headnorm<<<M / 4, 256, 0, stream>>>(Yf, D, 0, q_norm, 0.125f, Qn);
        k_attn<float><<<dim3(SEQ / 256, 2 * NH, BATCH), 256, 0, stream>>>(Qn, Kn, Vn, O0, O1, 1.0f);
    } else if (UPTO == 7) k_attn<bf16_t><<<dim3(SEQ / 256, 2 * NH, BATCH), 256, 0, stream>>>((const bf16_t*)(ws + WS_Q), (const bf16_t*)(ws + WS_K), (const bf16_t*)(ws + WS_V), O0, O1, 0.6931471805599453f);
    const bf16_t* ONp = HB;
    if (UPTO < 9) k_diff<<<M / 4, 256, 0, stream>>>(O0, O1, lam_params, sub_norm, HB); else ONp = (const bf16_t*)(ws + WS_ON);
    if (UPTO < 10) {
        k_wt<<<dim3(D / 32, D / 32, 1), 256, 0, stream>>>(attn_w_o, Wt_o, D, D);
        k_gemm<0><<<dim3(D / 64, M / 64, 1), 256, 0, stream>>>(ONp, D, Wt_o, D, Yf, D, M, D, 0, nullptr, nullptr, nullptr, 0);
        k_resid_norm<<<M / 4, 256, 0, stream>>>(X, Yf, X, ln_ffn + D, HB, nullptr, nullptr);
    } else k_rmsnorm<<<M / 4, 256, 0, stream>>>(X, ln_ffn + D, HB);
    k_wt<<<dim3(2 * DFE / 32, D / 32, NE), 256, 0, stream>>>(moe_w_gu, Wt_mgu, D, 2 * DFE);
    k_wt<<<dim3(D / 32, DFE / 32, NE), 256, 0, stream>>>(moe_w_down, Wt_mdn, DFE, D);
    k_router<<<M / 4, 256, 0, stream>>>(X, ln_ffn + D, router_w, sel, gate);
    k_bin<<<1, 1024, 0, stream>>>(sel, slot_tok, tok_slot, gbase, gcount);
    k_gemm<1><<<dim3(DFE / 64, M / 64, NE), 256, 0, stream>>>(HB, D, Wt_mgu, D, Hact, DFE, 0, D, DFE, slot_tok, gbase, gcount, (size_t)2 * DFE * D);
    k_gemm<0><<<dim3(D / 64, M / 64, NE), 256, 0, stream>>>(Hact, DFE, Wt_mdn, DFE, Ymoe, D, 0, DFE, 0, nullptr, gbase, gcount, (size_t)D * DFE);
    k_final<<<M * D / 4 / 256, 256, 0, stream>>>(X, Ymoe, tok_slot, gate, out);
}
```

```cpp
#include <hip/hip_runtime.h>
#include <hip/hip_bf16.h>
#include <stdint.h>
#include <stdio.h>
#include <cmath>
#define MEGA_UPTO 15
#define MEGA_ONE 1
typedef unsigned short bf16_t;
typedef short bf16x8 __attribute__((ext_vector_type(8)));
typedef float f32x4 __attribute__((ext_vector_type(4)));
constexpr int D = 1024, BATCH = 8, SEQ = 2048, M = BATCH * SEQ;
constexpr int NH = 8, HD = 64, VD = 128;
constexpr int DFF = 2816, NE = 8, DFE = 3584;
constexpr float EPS = 1e-6f;
constexpr float LAM_INIT = 0.35550907f;
constexpr int SLOTS = 2 * M + NE * 256;

__device__ __forceinline__ unsigned f2bf(float f) { unsigned u = __builtin_bit_cast(unsigned, f); return (u + 0x7fffu + ((u >> 16) & 1u)) >> 16; }
__device__ __forceinline__ float bf2f(unsigned short b) { return __builtin_bit_cast(float, (unsigned)b << 16); }
__device__ __forceinline__ float wave_sum(float v) {
#pragma unroll
    for (int o = 1; o < 64; o <<= 1) v += __shfl_xor(v, o);
    return v;
}

namespace pg8 {
#define PG8_LAS __attribute__((address_space(3)))
typedef unsigned short bf16_t;
typedef short bf16x8 __attribute__((ext_vector_type(8)));
typedef float f32x4 __attribute__((ext_vector_type(4)));
typedef unsigned u32x4 __attribute__((ext_vector_type(4)));
typedef int i32x4 __attribute__((ext_vector_type(4)));
typedef int i32x8 __attribute__((ext_vector_type(8)));
constexpr int BM = 256, BK = 64, HALF = 128, HTB = HALF * BK * 2  , STAGE_BYTES = 8 * HTB, NXCD = 8, WGM = 8;

__host__ __device__ __forceinline__ int lds_byte(int r, int c) { const int st = (r >> 4) * 2 + (c >> 5), rr = r & 15, cc = c & 31, ob = rr * 64 + cc * 2; return st * 1024 + (ob ^ (((ob >> 9) & 1) << 5)); }
__host__ __device__ __forceinline__ void stage_rc(int b, int& R, int& C) { const int st = b / 1024, sb = b % 1024, swz = sb ^ (((sb >> 9) & 1) << 5); R = (st >> 1) * 16 + swz / 64; C = (st & 1) * 32 + (swz % 64) / 2; }
__host__ __device__ __forceinline__ int perm32(int rho) { const int n = rho >> 4, i = rho & 15; return 8 * (i >> 2) + 4 * n + (i & 3); }

struct Unit { int pm, pn; };
struct Gemm { const bf16_t* A; const bf16_t* Bt; int M, N, K; };

struct StaticOrder {
    int nM, nN, nwg, G, c;
    __host__ __device__ void init(int M, int N, int G_, int c_) { nM = M / BM; nN = N / BM; nwg = nM * nN; G = G_; c = c_; }
    __host__ __device__ bool next(int i, Unit& u) const {
        const long L = (long)i * G + c; if (L >= nwg) return false;
        int wgid = (int)L; { const int q = nwg / NXCD, r = nwg % NXCD, xcd = wgid % NXCD, off = wgid / NXCD; wgid = (xcd < r ? xcd * (q + 1) : r * (q + 1) + (xcd - r) * q) + off; }
        const int nig = WGM * nN, gid = wgid / nig, fm = gid * WGM, gsz = (nM - fm) < WGM ? (nM - fm) : WGM;
        u.pm = fm + ((wgid % nig) % gsz); u.pn = (wgid % nig) / gsz; return true;
    }
    __device__ __forceinline__ void a_ready(const Unit&) const {}
    __device__ __forceinline__ void done(const Unit&) const {}
};

__device__ __forceinline__ unsigned cvt_pk_bf16(float lo, float hi) { unsigned r; asm volatile("v_cvt_pk_bf16_f32 %0, %1, %2" : "=v"(r) : "v"(lo), "v"(hi)); return r; }
typedef float f32x2 __attribute__((ext_vector_type(2)));
typedef unsigned u32x2 __attribute__((ext_vector_type(2)));
constexpr float RMS_EPS = 1e-6f, LOG2E = 1.4426950408889634f;
constexpr int DM_ = 1024;
__device__ __forceinline__ u32x4 pack8(const f32x4 a, const f32x4 b) { u32x4 w; w.x = cvt_pk_bf16(a[0], a[1]); w.y = cvt_pk_bf16(a[2], a[3]); w.z = cvt_pk_bf16(b[0], b[1]); w.w = cvt_pk_bf16(b[2], b[3]); return w; }
__device__ __forceinline__ float rstd_of(const float* ssq, int row) { const f32x4 p = *(const f32x4*)(ssq + (size_t)row * 4); return __builtin_amdgcn_rsqf(((p[0] + p[1]) + (p[2] + p[3])) * (1.0f / 1024.0f) + RMS_EPS); }
__device__ __forceinline__ float silu_mul(float g, float u) { return g * u * __builtin_amdgcn_rcpf(1.0f + __builtin_amdgcn_exp2f(-g * LOG2E)); }
__device__ __forceinline__ f32x2 swiglu2(f32x2 a, f32x2 b, float c1, float k) {
    const f32x2 t = a * c1; f32x2 e; e.x = __builtin_amdgcn_exp2f(t.x); e.y = __builtin_amdgcn_exp2f(t.y);
    const f32x2 d = e * k + k; f32x2 r; r.x = __builtin_amdgcn_rcpf(d.x); r.y = __builtin_amdgcn_rcpf(d.y);
    return (a * b) * r;
}

struct EpiInProj {
    static constexpr bool PERM = true, AFTER_DRAIN = false;
    bf16_t* Bb; bf16_t* Ub;
    __device__ __forceinline__ void operator()(const f32x4 (&acc)[2][2][4][2], const Unit& u, int wr, int wc, int fr, int fq) const {
        const int row0 = u.pm * BM + wr * 64 + fr;
        if (u.pn < 4) {
            const int col0 = u.pn * BM + wc * 32 + 8 * fq;
#pragma unroll
            for (int ai = 0; ai < 2; ++ai)
#pragma unroll
                for (int m = 0; m < 4; ++m) { bf16_t* rowp = Bb + (size_t)(row0 + ai * HALF + m * 16) * DM_ + col0;
#pragma unroll
                    for (int bj = 0; bj < 2; ++bj) *(u32x4*)(rowp + bj * HALF) = pack8(acc[ai][bj][m][0], acc[ai][bj][m][1]); }
        } else {
            const int col0 = (u.pn - 4) * 128 + wc * 32 + 8 * fq;
#pragma unroll
            for (int ai = 0; ai < 2; ++ai)
#pragma unroll
                for (int m = 0; m < 4; ++m) { bf16_t* rowp = Ub + (size_t)(row0 + ai * HALF + m * 16) * DM_ + col0;
                    *(u32x4*)rowp = pack8(acc[ai][0][m][0] * acc[ai][1][m][0], acc[ai][0][m][1] * acc[ai][1][m][1]); }
        }
    }
};

template <bool FIRST> struct EpiResidSsq {
    static constexpr bool PERM = false, AFTER_DRAIN = true;
    const float* x0; bf16_t* xb; float* ssq;
    __device__ __forceinline__ void fused(f32x4 (&acc)[2][2][4][2], const Unit& u, int wr, int wc, int fr, int fq, PG8_LAS unsigned char* lds, int wid, int lane) const {
        PG8_LAS float* P = (PG8_LAS float*)lds;
        const int col0 = u.pn * BM + wc * 32 + 4 * fq;
#pragma unroll
        for (int ai = 0; ai < 2; ++ai) {
            f32x4 xo[4][2][2];
#pragma unroll
            for (int m = 0; m < 4; ++m) { const int r = ai * HALF + wr * 64 + m * 16 + fr; const size_t off = (size_t)(u.pm * BM + r) * DM_ + col0;
#pragma unroll
                for (int bj = 0; bj < 2; ++bj)
#pragma unroll
                    for (int n = 0; n < 2; ++n) {
                        if constexpr (FIRST) xo[m][bj][n] = *(const f32x4*)(x0 + off + bj * HALF + n * 16);
                        else { const u32x2 w = *(const u32x2*)(xb + off + bj * HALF + n * 16); xo[m][bj][n] = (f32x4){__builtin_bit_cast(float, w.x << 16), __builtin_bit_cast(float, w.x & 0xffff0000u), __builtin_bit_cast(float, w.y << 16), __builtin_bit_cast(float, w.y & 0xffff0000u)}; } } }
#pragma unroll
            for (int m = 0; m < 4; ++m) { const int r = ai * HALF + wr * 64 + m * 16 + fr; const size_t off = (size_t)(u.pm * BM + r) * DM_ + col0; float s = 0.f;
#pragma unroll
                for (int bj = 0; bj < 2; ++bj)
#pragma unroll
                    for (int n = 0; n < 2; ++n) { const f32x4 v = xo[m][bj][n] + acc[ai][bj][m][n];
                        u32x2 w; w.x = cvt_pk_bf16(v[0], v[1]); w.y = cvt_pk_bf16(v[2], v[3]); *(u32x2*)(xb + off + bj * HALF + n * 16) = w;
                        s += (v[0] * v[0] + v[1] * v[1]) + (v[2] * v[2] + v[3] * v[3]); }
                s += __shfl_xor(s, 16); s += __shfl_xor(s, 32);
                if (fq == 0) P[r * 4 + wc] = s; }
            asm volatile("" ::: "memory"); }
        asm volatile("s_waitcnt lgkmcnt(0)" ::: "memory"); __builtin_amdgcn_s_barrier(); asm volatile("" ::: "memory");
        const int t = wid * 64 + lane;
        if (t < 256) { const PG8_LAS f32x4* Pr = (const PG8_LAS f32x4*)lds; const f32x4 p = Pr[t]; ssq[(size_t)(u.pm * BM + t) * 4 + u.pn] = (p[0] + p[1]) + (p[2] + p[3]); }
        asm volatile("s_waitcnt lgkmcnt(0)" ::: "memory"); __builtin_amdgcn_s_barrier(); asm volatile("" ::: "memory");
    }
};

struct EpiSwiGLU {
    static constexpr bool PERM = true, AFTER_DRAIN = false;
    bf16_t* H; int ldh; const float* ssq; const float* rstd; int ncol;
    __device__ __forceinline__ void operator()(const f32x4 (&acc)[2][2][4][2], const Unit& u, int wr, int wc, int fr, int fq) const {
        const int row0 = u.pm * BM + wr * 64 + fr, col0 = (u.pn % ncol) * 128 + wc * 32 + 8 * fq;
#pragma unroll
        for (int ai = 0; ai < 2; ++ai)
#pragma unroll
            for (int m = 0; m < 4; ++m) { const int row = row0 + ai * HALF + m * 16;
                float k; if (ssq) { const f32x4 p = *(const f32x4*)(ssq + (size_t)row * 4); k = ((p[0] + p[1]) + (p[2] + p[3])) * (1.0f / 1024.0f) + RMS_EPS; } else { const float r_ = rstd[row]; k = 1.0f / (r_ * r_); }
                const float c1 = -LOG2E * __builtin_amdgcn_rsqf(k);
                f32x4 h[2];
#pragma unroll
                for (int n = 0; n < 2; ++n) { const f32x4 a = acc[ai][0][m][n], b = acc[ai][1][m][n];
                    const f32x2 h0 = swiglu2((f32x2){a[0], a[1]}, (f32x2){b[0], b[1]}, c1, k), h1 = swiglu2((f32x2){a[2], a[3]}, (f32x2){b[2], b[3]}, c1, k);
                    h[n] = (f32x4){h0.x, h0.y, h1.x, h1.y}; }
                *(u32x4*)(H + (size_t)row * ldh + col0) = pack8(h[0], h[1]); }
    }
};

struct EpiQKV {
    static constexpr bool PERM = true, AFTER_DRAIN = false;
    bf16_t *Q, *K, *V; const float* ssq; const float* qg; const float* kg; float qscale;
    __device__ __forceinline__ void operator()(const f32x4 (&acc)[2][2][4][2], const Unit& u, int wr, int wc, int fr, int fq) const {
        const int row0 = u.pm * BM + wr * 64 + fr;
        if (u.pn < 8) {
            const bool isq = u.pn < 4; bf16_t* base = isq ? Q : K; const float* gn = isq ? qg : kg; const float sc = isq ? qscale : 1.0f;
            const int col0 = (4 * (u.pn & 3) + wc) * 64 + 8 * fq;
            f32x4 gv[2][2];
#pragma unroll
            for (int bj = 0; bj < 2; ++bj)
#pragma unroll
                for (int n = 0; n < 2; ++n) gv[bj][n] = *(const f32x4*)(gn + 32 * bj + 8 * fq + 4 * n);
#pragma unroll
            for (int ai = 0; ai < 2; ++ai)
#pragma unroll
                for (int m = 0; m < 4; ++m) { const int row = row0 + ai * HALF + m * 16; const float rs = rstd_of(ssq, row);
                    f32x4 v[2][2]; float ss = 0.f;
#pragma unroll
                    for (int bj = 0; bj < 2; ++bj)
#pragma unroll
                        for (int n = 0; n < 2; ++n) { v[bj][n] = acc[ai][bj][m][n] * rs; ss += (v[bj][n][0] * v[bj][n][0] + v[bj][n][1] * v[bj][n][1]) + (v[bj][n][2] * v[bj][n][2] + v[bj][n][3] * v[bj][n][3]); }
                    ss += __shfl_xor(ss, 16); ss += __shfl_xor(ss, 32);
                    const float r2 = __builtin_amdgcn_rsqf(ss * (1.0f / 64.0f) + RMS_EPS) * sc;
#pragma unroll
                    for (int bj = 0; bj < 2; ++bj) *(u32x4*)(base + (size_t)row * DM_ + col0 + 32 * bj) = pack8(v[bj][0] * r2 * gv[bj][0], v[bj][1] * r2 * gv[bj][1]); }
        } else {
            const int col0 = (u.pn - 8) * BM + wc * 32 + 8 * fq;
#pragma unroll
            for (int ai = 0; ai < 2; ++ai)
#pragma unroll
                for (int m = 0; m < 4; ++m) { const int row = row0 + ai * HALF + m * 16; const float rs = rstd_of(ssq, row);
#pragma unroll
                    for (int bj = 0; bj < 2; ++bj) *(u32x4*)(V + (size_t)row * DM_ + col0 + bj * HALF) = pack8(acc[ai][bj][m][0] * rs, acc[ai][bj][m][1] * rs); }
        }
    }
};

__device__ __forceinline__ float clamp448(float x) { return __builtin_amdgcn_fmed3f(x, -448.0f, 448.0f); }
__device__ __forceinline__ unsigned pk4_fp8(float a, float b, float c, float d) { int w = 0; w = __builtin_amdgcn_cvt_pk_fp8_f32(clamp448(a), clamp448(b), w, false); w = __builtin_amdgcn_cvt_pk_fp8_f32(clamp448(c), clamp448(d), w, true); return (unsigned)w; }
constexpr float F8_SA = 4.0f, F8_SWG = 256.0f, F8_SH = 8.0f, F8_SWD = 512.0f;

struct EpiSwiGLU8 {
    static constexpr bool PERM = true, AFTER_DRAIN = false;
    unsigned char* H; int ldh; int ncol;
    __device__ __forceinline__ void operator()(const f32x4 (&acc)[2][2][4][2], const Unit& u, int wr, int wc, int fr, int fq) const {
        const int row0 = u.pm * BM + wr * 64 + fr, col0 = (u.pn % ncol) * 128 + wc * 32 + 8 * fq; constexpr float cs = 1.0f / (F8_SA * F8_SWG);
#pragma unroll
        for (int ai = 0; ai < 2; ++ai)
#pragma unroll
            for (int m = 0; m < 4; ++m) { const int row = row0 + ai * HALF + m * 16; f32x4 h[2];
#pragma unroll
                for (int n = 0; n < 2; ++n) { const f32x4 a = acc[ai][0][m][n], b = acc[ai][1][m][n];
                    const f32x2 h0 = swiglu2((f32x2){a[0], a[1]}, (f32x2){b[0], b[1]}, -cs * LOG2E, 1.0f / (cs * cs * F8_SH)), h1 = swiglu2((f32x2){a[2], a[3]}, (f32x2){b[2], b[3]}, -cs * LOG2E, 1.0f / (cs * cs * F8_SH));
                    h[n] = (f32x4){h0.x, h0.y, h1.x, h1.y}; }
                u32x2 w; w.x = pk4_fp8(h[0][0], h[0][1], h[0][2], h[0][3]); w.y = pk4_fp8(h[1][0], h[1][1], h[1][2], h[1][3]);
                *(u32x2*)(H + (size_t)row * ldh + col0) = w; }
    }
};

struct EpiMoeDown {
    static constexpr bool PERM = true, AFTER_DRAIN = false;
    bf16_t* Y; const float* gate; float scale;
    __device__ __forceinline__ void operator()(const f32x4 (&acc)[2][2][4][2], const Unit& u, int wr, int wc, int fr, int fq) const {
        const int row0 = u.pm * BM + wr * 64 + fr, col0 = (u.pn & 3) * BM + wc * 32 + 8 * fq;
#pragma unroll
        for (int ai = 0; ai < 2; ++ai)
#pragma unroll
            for (int m = 0; m < 4; ++m) { const int row = row0 + ai * HALF + m * 16; const float gt = gate[row] * scale;
#pragma unroll
                for (int bj = 0; bj < 2; ++bj) *(u32x4*)(Y + (size_t)row * DM_ + col0 + bj * HALF) = pack8(acc[ai][bj][m][0] * gt, acc[ai][bj][m][1] * gt); }
    }
};

struct MoeOrder {
    int nM, nN, nwg, G, c; int t1, t2, t3, t4, t5, t6, t7;
    __device__ __forceinline__ void init(const int* meta, int nN_, int G_, int c_) {
        nM = meta[8]; nN = nN_; nwg = nM * nN; G = G_; c = c_; t1 = meta[1]; t2 = meta[2]; t3 = meta[3]; t4 = meta[4]; t5 = meta[5]; t6 = meta[6]; t7 = meta[7]; }
    __device__ __forceinline__ bool next(int i, Unit& u) const {
        const long L = (long)i * G + c; if (L >= nwg) return false;
        int wgid = (int)L; { const int q = nwg / NXCD, r = nwg % NXCD, xcd = wgid % NXCD, off = wgid / NXCD; wgid = (xcd < r ? xcd * (q + 1) : r * (q + 1) + (xcd - r) * q) + off; }
        const int nig = WGM * nN, gid = wgid / nig, fm = gid * WGM, gsz = (nM - fm) < WGM ? (nM - fm) : WGM;
        const int pm = fm + ((wgid % nig) % gsz), pnl = (wgid % nig) / gsz;
        const int e = (pm >= t1) + (pm >= t2) + (pm >= t3) + (pm >= t4) + (pm >= t5) + (pm >= t6) + (pm >= t7);
        u.pm = pm; u.pn = e * nN + pnl; return true;
    }
    __device__ __forceinline__ void a_ready(const Unit&) const {}
    __device__ __forceinline__ void done(const Unit&) const {}
};
template <class Epi, class Sched, bool ALIGN_EPI = false, bool SP2 = false, bool F8 = false>
__device__ __forceinline__ void gemm_phase(PG8_LAS unsigned char* lds, const Gemm g, const Sched& S, const Epi& E) {
    const int tid = threadIdx.x, wid = __builtin_amdgcn_readfirstlane(tid >> 6), lane = tid & 63, wr = wid >> 2, wc = wid & 3, fr = lane & 15, fq = lane >> 4;
    int K_ = g.K; asm volatile("" : "+s"(K_));
    const int K = K_, nt = K / BK;
    unsigned voffA[2], voffB[2];
#pragma unroll
    for (int i = 0; i < 2; ++i) { int R, C; stage_rc(tid * 16 + i * 8192, R, C); const int Rb = Epi::PERM ? ((R & ~31) + perm32(R & 31)) : R;
        voffA[i] = (unsigned)(R * K + C) * 2u; voffB[i] = (unsigned)(Rb * K + C) * 2u; }
    const size_t kstep = (size_t)(BK * 2);
    const size_t hstep = (size_t)HALF * K * 2;
    const size_t tstep = 2 * hstep;
    const unsigned ldsw = (unsigned)wid * 1024u;
    const int aoff = lds_byte(wr * 64 + fr, fq * 8), boff = lds_byte(wc * 32 + fr, fq * 8);
    constexpr int KSTEP = 1024;
#define PG8_SA(b, h) (((b) * 2 + (h)) * HTB)
#define PG8_SB(b, h) ((4 + (b) * 2 + (h)) * HTB)
#define PG8_STAGE(bufoff, gbase, voff) do { _Pragma("unroll") for (int _i = 0; _i < 2; ++_i) \
        __builtin_amdgcn_global_load_lds((const unsigned*)((const char*)(gbase) + (voff)[_i]), (PG8_LAS unsigned*)(lds + (bufoff) + ldsw + _i * 8192), 16, 0, 0); } while (0)
#define PG8_LDA(dst, b, h) do { _Pragma("unroll") for (int m = 0; m < 4; ++m) _Pragma("unroll") for (int k = 0; k < 2; ++k) dst[m][k] = *(const PG8_LAS bf16x8*)(lds + PG8_SA(b, h) + aoff + m * 2048 + k * KSTEP); } while (0)
#define PG8_LDB(dst, b, h) do { _Pragma("unroll") for (int n = 0; n < 2; ++n) _Pragma("unroll") for (int k = 0; k < 2; ++k) dst[n][k] = *(const PG8_LAS bf16x8*)(lds + PG8_SB(b, h) + boff + n * 2048 + k * KSTEP); } while (0)
#define PG8_CAT8(x) __builtin_shufflevector(__builtin_bit_cast(i32x4, (x)[0]), __builtin_bit_cast(i32x4, (x)[1]), 0, 1, 2, 3, 4, 5, 6, 7)
#define PG8_MMA(ai, bj, At, Bt) do { __builtin_amdgcn_s_setprio(1); _Pragma("unroll") for (int m = 0; m < 4; ++m) _Pragma("unroll") for (int n = 0; n < 2; ++n) { \
        if constexpr (F8) asm volatile("s_nop 1\n\tv_mfma_f32_16x16x128_f8f6f4 %0, %1, %2, %0" : "+v"(acc[ai][bj][m][n]) : "v"(PG8_CAT8(Bt[n])), "v"(PG8_CAT8(At[m]))); \
        else { _Pragma("unroll") for (int k = 0; k < 2; ++k) acc[ai][bj][m][n] = __builtin_amdgcn_mfma_f32_16x16x32_bf16(Bt[n][k], At[m][k], acc[ai][bj][m][n], 0, 0, 0); } } \
        __builtin_amdgcn_s_setprio(0); } while (0)
#define PG8_WAIT_V(n) asm volatile("s_waitcnt vmcnt(" #n ")" ::: "memory")
#define PG8_WAIT_L(n) asm volatile("s_waitcnt lgkmcnt(" #n ")" ::: "memory")
#define PG8_BAR __builtin_amdgcn_s_barrier()
#define PG8_SCHED __builtin_amdgcn_sched_barrier(0)
    Unit cur, nxt; int ui = 0;
    if (!S.next(0, cur)) return;
    f32x4 acc[2][2][4][2];
#pragma unroll
    for (int a = 0; a < 2; ++a)
#pragma unroll
        for (int b = 0; b < 2; ++b)
#pragma unroll
            for (int m = 0; m < 4; ++m)
#pragma unroll
                for (int n = 0; n < 2; ++n) acc[a][b][m][n] = (f32x4){0.f, 0.f, 0.f, 0.f};
    bf16x8 At[4][2], B0[2][2], B1[2][2];
    const char* cA = (const char*)g.A + (size_t)cur.pm * tstep; const char* cB = (const char*)g.Bt + (size_t)cur.pn * tstep;
    S.a_ready(cur);
    if constexpr (SP2) {
        PG8_STAGE(PG8_SB(0, 0), cB, voffB); PG8_STAGE(PG8_SB(0, 1), cB + hstep, voffB); PG8_STAGE(PG8_SA(0, 0), cA, voffA); PG8_STAGE(PG8_SA(0, 1), cA + hstep, voffA);
        if (wr == 1) PG8_BAR;
        PG8_WAIT_V(2); PG8_BAR;
        PG8_STAGE(PG8_SB(1, 0), cB + kstep, voffB); PG8_STAGE(PG8_SA(1, 0), cA + kstep, voffA); PG8_STAGE(PG8_SB(1, 1), cB + hstep + kstep, voffB);
        PG8_WAIT_V(6); PG8_BAR;
    } else {
        PG8_STAGE(PG8_SB(0, 0), cB, voffB); PG8_STAGE(PG8_SA(0, 0), cA, voffA); PG8_STAGE(PG8_SB(0, 1), cB + hstep, voffB); PG8_STAGE(PG8_SA(0, 1), cA + hstep, voffA);
        if (wr == 1) PG8_BAR;
        PG8_WAIT_V(4); PG8_BAR;
        PG8_STAGE(PG8_SB(1, 0), cB + kstep, voffB); PG8_STAGE(PG8_SA(1, 0), cA + kstep, voffA); PG8_STAGE(PG8_SB(1, 1), cB + hstep + kstep, voffB);
        PG8_WAIT_V(6); PG8_BAR;
    }
    for (;;) {
        const bool has_next = S.next(ui + 1, nxt);
        const char* nA = has_next ? (const char*)g.A + (size_t)nxt.pm * tstep : cA; const char* nB = has_next ? (const char*)g.Bt + (size_t)nxt.pn * tstep : cB;
        for (int t = 0; t < nt; t += 2) {
            const bool last = (t == nt - 2);
            const char* a1 = cA + (size_t)(t + 1) * kstep;
            const char* a2 = last ? nA : cA + (size_t)(t + 2) * kstep; const char* b2 = last ? nB : cB + (size_t)(t + 2) * kstep;
            const char* a3 = a2 + kstep; const char* b3 = b2 + kstep;
            if (last && has_next) S.a_ready(nxt);
            if constexpr (SP2) {
            PG8_LDB(B0, 0, 0); PG8_LDB(B1, 0, 1); PG8_SCHED; PG8_LDA(At, 0, 0); PG8_STAGE(PG8_SA(1, 1), a1 + hstep, voffA);
            PG8_WAIT_V(8); PG8_WAIT_L(0); PG8_BAR; PG8_MMA(0, 0, At, B0); PG8_MMA(0, 1, At, B1); PG8_BAR; PG8_SCHED;
            PG8_LDA(At, 0, 1); PG8_STAGE(PG8_SB(0, 0), b2, voffB); PG8_STAGE(PG8_SB(0, 1), b2 + hstep, voffB); PG8_STAGE(PG8_SA(0, 0), a2, voffA);
            PG8_WAIT_V(8); PG8_WAIT_L(0); PG8_BAR; PG8_MMA(1, 0, At, B0); PG8_MMA(1, 1, At, B1); PG8_BAR; PG8_SCHED;
            PG8_LDB(B0, 1, 0); PG8_LDB(B1, 1, 1); PG8_SCHED; PG8_LDA(At, 1, 0); PG8_STAGE(PG8_SA(0, 1), a2 + hstep, voffA);
            PG8_WAIT_V(8); PG8_WAIT_L(0); PG8_BAR; PG8_MMA(0, 0, At, B0); PG8_MMA(0, 1, At, B1); PG8_BAR; PG8_SCHED;
            PG8_LDA(At, 1, 1); PG8_STAGE(PG8_SB(1, 0), b3, voffB); PG8_STAGE(PG8_SB(1, 1), b3 + hstep, voffB); PG8_STAGE(PG8_SA(1, 0), a3, voffA);
            PG8_WAIT_V(8); PG8_WAIT_L(0); PG8_BAR; PG8_MMA(1, 0, At, B0); PG8_MMA(1, 1, At, B1); PG8_BAR; PG8_SCHED;
            } else {
            PG8_LDB(B0, 0, 0); PG8_SCHED; PG8_LDA(At, 0, 0); PG8_STAGE(PG8_SA(1, 1), a1 + hstep, voffA);
            PG8_WAIT_L(8); PG8_BAR; PG8_WAIT_L(0); PG8_MMA(0, 0, At, B0); PG8_BAR; PG8_SCHED;
            PG8_LDB(B1, 0, 1); PG8_STAGE(PG8_SB(0, 0), b2, voffB);
            PG8_BAR; PG8_WAIT_L(0); PG8_MMA(0, 1, At, B1); PG8_BAR;
            PG8_LDA(At, 0, 1); PG8_STAGE(PG8_SA(0, 0), a2, voffA);
            PG8_BAR; PG8_WAIT_L(0); PG8_MMA(1, 0, At, B0); PG8_BAR; PG8_SCHED;
            PG8_STAGE(PG8_SB(0, 1), b2 + hstep, voffB);
            PG8_WAIT_V(6); PG8_BAR; PG8_MMA(1, 1, At, B1); PG8_BAR;
            PG8_LDB(B0, 1, 0); PG8_SCHED; PG8_LDA(At, 1, 0); PG8_STAGE(PG8_SA(0, 1), a2 + hstep, voffA);
            PG8_WAIT_L(8); PG8_BAR; PG8_WAIT_L(0); PG8_MMA(0, 0, At, B0); PG8_BAR; PG8_SCHED;
            PG8_LDB(B1, 1, 1); PG8_STAGE(PG8_SB(1, 0), b3, voffB);
            PG8_BAR; PG8_WAIT_L(0); PG8_MMA(0, 1, At, B1); PG8_BAR;
            PG8_LDA(At, 1, 1); PG8_STAGE(PG8_SA(1, 0), a3, voffA);
            PG8_BAR; PG8_WAIT_L(0); PG8_MMA(1, 0, At, B0); PG8_BAR; PG8_SCHED;
            PG8_STAGE(PG8_SB(1, 1), b3 + hstep, voffB);
            PG8_WAIT_V(6); PG8_BAR; PG8_MMA(1, 1, At, B1); PG8_BAR;
            }
        }
        if constexpr (F8) asm volatile("s_nop 15\n\ts_nop 15" ::: "memory");
        if constexpr (ALIGN_EPI) { if (wr == 0) PG8_BAR; }
        if constexpr (!Epi::AFTER_DRAIN) { E(acc, cur, wr, wc, fr, fq); S.done(cur); }
        if (!has_next) break;
#pragma unroll
        for (int a = 0; a < 2; ++a)
#pragma unroll
            for (int b = 0; b < 2; ++b)
#pragma unroll
                for (int m = 0; m < 4; ++m)
#pragma unroll
                    for (int n = 0; n < 2; ++n) acc[a][b][m][n] = (f32x4){0.f, 0.f, 0.f, 0.f};
        cur = nxt; cA = nA; cB = nB; ++ui;
        if constexpr (ALIGN_EPI) { if (wr == 1) PG8_BAR; }
    }
    PG8_WAIT_V(0);
    if constexpr (!ALIGN_EPI) { if (wr == 0) PG8_BAR; }
    PG8_BAR;
    if constexpr (Epi::AFTER_DRAIN) { E.fused(acc, cur, wr, wc, fr, fq, lds, wid, lane); S.done(cur); }
#undef PG8_SA
#undef PG8_SB
#undef PG8_STAGE
#undef PG8_LDA
#undef PG8_LDB
#undef PG8_MMA
#undef PG8_CAT8
#undef PG8_WAIT_V
#undef PG8_WAIT_L
#undef PG8_BAR
#undef PG8_SCHED
}
}
#include <hip/hip_bf16.h>
#include <cmath>
namespace attn_body {
using bf16=__hip_bfloat16;
using bf16x8=__attribute__((ext_vector_type(8)))short;
using s16x4=__attribute__((ext_vector_type(4)))short;
using f32x16=__attribute__((ext_vector_type(16)))float;
using u32x4=__attribute__((ext_vector_type(4)))unsigned;
constexpr int BATCH=8,NHEAD=16,SEQ=2048,D=64,DM=NHEAD*D;
constexpr int NW=8,QBLK=32,QB=QBLK*NW,KVBLK=64,NQB=SEQ/QB;
constexpr int ATTN_PITCH=DM, ATTN_UNIT_ROWS=QB;
__device__ __forceinline__ int crow(int r,int hi){return (r&3)+8*(r>>2)+4*hi;}
#define SBAR() __builtin_amdgcn_sched_barrier(0)
__device__ __forceinline__ void cmask(f32x16&p0,f32x16&p1,int jb,int qrel,int hi){
  const float NEG=-INFINITY; int kb=64*jb+4*hi;
  #pragma unroll
  for(int r=0;r<16;++r){int kv=kb+(r&3)+8*(r>>2); if(kv>qrel)p0[r]=NEG; if(kv+32>qrel)p1[r]=NEG;}
}

constexpr int NSLOT=3, SLOTB=8192;
constexpr int LDS_K=0, LDS_V=NSLOT*SLOTB, LDS_WS=2*NSLOT*SLOTB, LDS_OST=LDS_WS+NW*64*4, LDS_BYTES=LDS_OST+NW*4096;
constexpr float C2=0.125f*1.4426950408889634f;
__device__ __forceinline__ void glds16(const void*gsrc,unsigned lds_dst){unsigned keep;
  asm volatile("s_mov_b32 %0, m0\n\ts_mov_b32 m0, %2\n\ts_nop 0\n\tglobal_load_lds_dwordx4 %1, off\n\ts_mov_b32 m0, %0":"=&s"(keep):"v"(gsrc),"s"(lds_dst):"memory");}
__device__ __forceinline__ float max3f(float a,float b,float c){float r;asm("v_max3_f32 %0, %1, %2, %3":"=v"(r):"v"(a),"v"(b),"v"(c));return r;}
__device__ __forceinline__ float max2f(float a,float b){float r;asm("v_max_f32_e32 %0, %1, %2":"=v"(r):"v"(a),"v"(b));return r;}
__device__ __forceinline__ float fadd_s(float a,float b){float r;asm("v_add_f32_e32 %0, %1, %2":"=v"(r):"v"(a),"v"(b));return r;}
__device__ __forceinline__ float fsub_s(float a,float b){float r;asm("v_sub_f32_e32 %0, %1, %2":"=v"(r):"v"(a),"v"(b));return r;}
typedef float f32x2_t __attribute__((ext_vector_type(2))); typedef __bf16 bf16x2_t __attribute__((ext_vector_type(2)));
__device__ __forceinline__ unsigned cvtpk_s(float lo,float hi){f32x2_t v={lo,hi};bf16x2_t b=__builtin_convertvector(v,bf16x2_t);return __builtin_bit_cast(unsigned,b);}
#define WAIT_BAR(N) asm volatile("s_waitcnt vmcnt(" #N ") lgkmcnt(0)\n\ts_barrier":::"memory")

__device__ __forceinline__ void qkt(f32x16&p0,f32x16&p1,const char*Kslot,const bf16x8*qr,const f32x16&negm,int r32,int hi){
  const char*kb=Kslot+hi*1024+r32*16;
  #pragma unroll
  for(int d0=0;d0<4;++d0){
    const bf16x8 b0=*reinterpret_cast<const bf16x8*>(kb+d0*2048);
    const bf16x8 b1=*reinterpret_cast<const bf16x8*>(kb+d0*2048+512);
    if(d0==0){p0=__builtin_amdgcn_mfma_f32_32x32x16_bf16(b0,qr[0],negm,0,0,0);p1=__builtin_amdgcn_mfma_f32_32x32x16_bf16(b1,qr[0],negm,0,0,0);}
    else{p0=__builtin_amdgcn_mfma_f32_32x32x16_bf16(b0,qr[d0],p0,0,0,0);p1=__builtin_amdgcn_mfma_f32_32x32x16_bf16(b1,qr[d0],p1,0,0,0);}}
}
typedef __attribute__((address_space(3))) const char* lds_cptr;
typedef short v4i16_t __attribute__((ext_vector_type(4)));
__device__ __forceinline__ void kload8(bf16x8*kf,lds_cptr kp){
  kf[0]=*(const __attribute__((address_space(3))) bf16x8*)(kp);      kf[1]=*(const __attribute__((address_space(3))) bf16x8*)(kp+512);
  kf[2]=*(const __attribute__((address_space(3))) bf16x8*)(kp+2048); kf[3]=*(const __attribute__((address_space(3))) bf16x8*)(kp+2560);
  kf[4]=*(const __attribute__((address_space(3))) bf16x8*)(kp+4096); kf[5]=*(const __attribute__((address_space(3))) bf16x8*)(kp+4608);
  kf[6]=*(const __attribute__((address_space(3))) bf16x8*)(kp+6144); kf[7]=*(const __attribute__((address_space(3))) bf16x8*)(kp+6656);
}
__device__ __forceinline__ void kload2(bf16x8*kf,lds_cptr kp,int j){ kf[2*j]=*(const __attribute__((address_space(3))) bf16x8*)(kp+j*2048); kf[2*j+1]=*(const __attribute__((address_space(3))) bf16x8*)(kp+j*2048+512); }
__device__ __forceinline__ s16x4 vtr(lds_cptr p){ return __builtin_bit_cast(s16x4,__builtin_amdgcn_ds_read_tr16_b64_v4i16((__attribute__((address_space(3))) v4i16_t*)p)); }
__device__ __forceinline__ float rowmax(const f32x16&p0,const f32x16&p1){
  float a=max3f(p0[0],p0[1],p1[0]),b=max3f(p0[2],p0[3],p1[1]);a=max3f(a,p1[2],p1[3]);
  #pragma unroll
  for(int r=4;r<16;r+=4){a=max3f(a,p0[r],p0[r+1]);b=max3f(b,p0[r+2],p0[r+3]);a=max3f(a,p1[r],p1[r+1]);b=max3f(b,p1[r+2],p1[r+3]);}
  const float m=max2f(a,b);
  auto rr=__builtin_amdgcn_permlane32_swap(__float_as_uint(m),__float_as_uint(m),false,false);
  return max2f(__uint_as_float(rr[0]),__uint_as_float(rr[1]));
}
__device__ __forceinline__ void pv(f32x16*o,int vb,bf16x8 pa0,bf16x8 pa1,bf16x8 pa2,bf16x8 pa3){
  #pragma unroll
  for(int d0=0;d0<2;++d0){s16x4 lo[4],hi[4];
    #pragma unroll
    for(int ks=0;ks<4;++ks){
      asm volatile("ds_read_b64_tr_b16 %0,%1 offset:%c2":"=&v"(lo[ks]):"v"(vb),"i"(d0*4096+ks*1024):"memory");
      asm volatile("ds_read_b64_tr_b16 %0,%1 offset:%c2":"=&v"(hi[ks]):"v"(vb),"i"(d0*4096+ks*1024+512):"memory");}
    asm volatile("s_waitcnt lgkmcnt(0)":::"memory");SBAR();
    #define PK(k) (bf16x8){lo[k][0],lo[k][1],lo[k][2],lo[k][3],hi[k][0],hi[k][1],hi[k][2],hi[k][3]}
    o[d0]=__builtin_amdgcn_mfma_f32_32x32x16_bf16(pa0,PK(0),o[d0],0,0,0);
    o[d0]=__builtin_amdgcn_mfma_f32_32x32x16_bf16(pa1,PK(1),o[d0],0,0,0);
    o[d0]=__builtin_amdgcn_mfma_f32_32x32x16_bf16(pa2,PK(2),o[d0],0,0,0);
    o[d0]=__builtin_amdgcn_mfma_f32_32x32x16_bf16(pa3,PK(3),o[d0],0,0,0);
    #undef PK
  }
}

#ifndef ATTN_STORE16
#define ATTN_STORE16(p,v) (*(u32x4*)(p)=(v))
#endif
template<int THRL> __device__ __forceinline__ void attn_unit(int b,int qcol,int vcol,int qb,const bf16*Q,const bf16*__restrict__ K,const bf16*__restrict__ V,bf16*O,char*shm){
  int tid_=threadIdx.x; asm volatile("":"+v"(tid_));
  const int tid=tid_,lane=tid&63,r32=lane&31,hi=lane>>5; const int wid=__builtin_amdgcn_readfirstlane(tid>>6);
  const long rowbase=(long)b*SEQ; const int q0=qb*QB;
  const bf16*Qw=Q+(rowbase+q0+wid*QBLK)*DM+qcol;
  const bf16*Kh=K+rowbase*DM+qcol,*Vh=V+rowbase*DM+vcol;
  const unsigned lds0=(unsigned)(uintptr_t)shm;
  float*wsf=(float*)(shm+LDS_WS)+wid*64;
  const bf16*ksrc=Kh+(long)lane*DM+wid*8;
  const bf16*vsrc=Vh+(long)(16*(wid&3)+(lane>>2))*DM+(wid>>2)*32+(lane&3)*8;
  const unsigned kdst=lds0+LDS_K+wid*1024, vdst=lds0+LDS_V+wid*1024;
  #define DMA_K(t,slot) glds16(ksrc+(long)(t)*KVBLK*DM,(unsigned)__builtin_amdgcn_readfirstlane(kdst+(slot)))
  #define DMA_V(t,slot) glds16(vsrc+(long)(t)*KVBLK*DM,(unsigned)__builtin_amdgcn_readfirstlane(vdst+(slot)))
  const int vb0=(int)(lds0+LDS_V)+((lane>>4)&1)*32+(lane&3)*8+(4*hi+((lane&15)>>2))*64;
  const char*Kbase=shm+LDS_K; bf16x8 kf[8];
  const lds_cptr shm3=(lds_cptr)shm; const lds_cptr kp0=shm3+LDS_K+hi*1024+r32*16; const lds_cptr vp0=shm3+LDS_V+((lane>>4)&1)*32+(lane&3)*8+(4*hi+((lane&15)>>2))*64;
  const int NT=(q0+QB)/KVBLK;
  DMA_K(0,0);DMA_V(0,0);DMA_K(1,SLOTB);
  bf16x8 qr[4];
  #pragma unroll
  for(int d0=0;d0<4;++d0)qr[d0]=*reinterpret_cast<const bf16x8*>(&Qw[(long)r32*DM+d0*16+hi*8]);
  float mhat=0.f,l_reg=0.f;f32x16 o[2];o[0]=f32x16{};o[1]=f32x16{};f32x16 negm=f32x16{};asm volatile("":"+v"(negm));
  const int qrel=wid*QBLK+r32;
  #define CMASK(P0,P1,t) do{int jb_=(t)-(NT-4); if(jb_>=0)cmask(P0,P1,jb_,qrel,hi);}while(0)
  bool resc=false;
  #define START(P0,P1) do{ const float rm=rowmax(P0,P1); resc=false; \
    { const float dl=rm; mhat=fadd_s(mhat,dl); \
      _Pragma("unroll") for(int r=0;r<16;++r){P0[r]=fsub_s(P0[r],dl);P1[r]=fsub_s(P1[r],dl);} \
      _Pragma("unroll") for(int r=0;r<16;++r)negm[r]=-mhat; asm volatile("":"+v"(negm)); } \
    _Pragma("unroll") for(int r=0;r<16;++r)P0[r]=__builtin_amdgcn_exp2f(P0[r]); }while(0)
  #define RESC() do{ if(resc){ asm volatile("s_waitcnt lgkmcnt(0)":::"memory"); \
      _Pragma("unroll") for(int d_=0;d_<2;++d_) _Pragma("unroll") for(int r=0;r<16;++r)o[d_][r]*=wsf[crow(r,hi)]; } }while(0)
  f32x16 pA0,pA1,pB0,pB1;
  int sl_prev=0,sl_cur=0,sl_next=SLOTB;
  #define ROT() do{sl_prev=sl_cur;sl_cur=sl_next;sl_next=(sl_next==(NSLOT-1)*SLOTB)?0:sl_next+SLOTB;}while(0)
  DMA_K(2,2*SLOTB);
  WAIT_BAR(3);
  qkt(pA0,pA1,Kbase,qr,negm,r32,hi);asm volatile("s_nop 15\n\ts_nop 7":"+v"(pA0),"+v"(pA1));CMASK(pA0,pA1,0);
  START(pA0,pA1);
  _Pragma("unroll") for(int r=0;r<16;++r)pA1[r]=__builtin_amdgcn_exp2f(pA1[r]);
  WAIT_BAR(0);
  DMA_K(3,0);DMA_V(1,SLOTB);
  ROT();
  kload8(kf,kp0+sl_cur);
  WAIT_BAR(2);
  s16x4 vlo[8],vhi[8]; u32x4 pw0,pw1,pw2,pw3;
  #define PKW(P,B) cvtpk_s(P[B],P[B+1])
  #define PAF(k) __builtin_bit_cast(bf16x8,pw##k)
  #define VFR(i) (bf16x8){vlo[i][0],vlo[i][1],vlo[i][2],vlo[i][3],vhi[i][0],vhi[i][1],vhi[i][2],vhi[i][3]}
  #define PIN(x) asm volatile("":"+v"(x))
  #define MX3(a,b,c) __builtin_fmaxf(__builtin_fmaxf((a),(b)),(c))
  #define GAPA(MF,A0,A1,A2,A3,W0,W1,PW) do{ MF; sacc+=A0; sacc+=A1; sacc+=A2; sacc+=A3; PIN(sacc); W0; W1; PIN(PW); SBAR(); }while(0)
  #define EX(v) __builtin_amdgcn_exp2f(v)
  #define GAPB(MF,X,B) do{ MF; X[B]=EX(X[B]); X[B+1]=EX(X[B+1]); X[B+2]=EX(X[B+2]); X[B+3]=EX(X[B+3]); PIN(X); SBAR(); }while(0)
  #define VRD(i) do{ vlo[i]=vtr(vp_+(((i)>>2)*4096+((i)&3)*1024)); vhi[i]=vtr(vp_+(((i)>>2)*4096+((i)&3)*1024+512)); }while(0)
  #define KRD(G,j) do{ if(G){ kload2(kf,kp0+sl_next,j); SBAR(); } }while(0)
  #define STEP(C0,C1,P0,P1,t,GK,GV,GL) do{ SBAR(); \
    const lds_cptr vp_=vp0+sl_prev; \
    VRD(0); SBAR(); float sacc=(P0[0]+P0[1]); \
    GAPA(C0=__builtin_amdgcn_mfma_f32_32x32x16_bf16(kf[0],qr[0],negm,0,0,0), P0[2],P0[3],P0[4],P0[5],     pw0[0]=PKW(P0,0), pw0[1]=PKW(P0,2), pw0); \
    VRD(4); SBAR(); GAPA(C1=__builtin_amdgcn_mfma_f32_32x32x16_bf16(kf[1],qr[0],negm,0,0,0), P0[6],P0[7],P0[8],P0[9],     pw0[2]=PKW(P0,4), pw0[3]=PKW(P0,6), pw0); \
    VRD(1); SBAR(); GAPA(C0=__builtin_amdgcn_mfma_f32_32x32x16_bf16(kf[2],qr[1],C0,0,0,0),   P0[10],P0[11],P0[12],P0[13], pw1[0]=PKW(P0,8), pw1[1]=PKW(P0,10), pw1); \
    VRD(5); SBAR(); GAPA(C1=__builtin_amdgcn_mfma_f32_32x32x16_bf16(kf[3],qr[1],C1,0,0,0),   P0[14],P0[15],P1[0],P1[1],   pw1[2]=PKW(P0,12),pw1[3]=PKW(P0,14), pw1); \
    VRD(2); SBAR(); GAPA(C0=__builtin_amdgcn_mfma_f32_32x32x16_bf16(kf[4],qr[2],C0,0,0,0),   P1[2],P1[3],P1[4],P1[5],     pw2[0]=PKW(P1,0), pw2[1]=PKW(P1,2), pw2); \
    VRD(6); SBAR(); GAPA(C1=__builtin_amdgcn_mfma_f32_32x32x16_bf16(kf[5],qr[2],C1,0,0,0),   P1[6],P1[7],P1[8],P1[9],     pw2[2]=PKW(P1,4), pw2[3]=PKW(P1,6), pw2); \
    VRD(3); SBAR(); GAPA(C0=__builtin_amdgcn_mfma_f32_32x32x16_bf16(kf[6],qr[3],C0,0,0,0),   P1[10],P1[11],P1[12],P1[13], pw3[0]=PKW(P1,8), pw3[1]=PKW(P1,10), pw3); \
    VRD(7); SBAR(); GAPA(C1=__builtin_amdgcn_mfma_f32_32x32x16_bf16(kf[7],qr[3],C1,0,0,0),   P1[14],P1[15],0.f,0.f,       pw3[2]=PKW(P1,12),pw3[3]=PKW(P1,14), pw3); \
    l_reg+=sacc; \
    if(GK){DMA_K((t)+3,sl_cur);} if(GV){DMA_V((t)+1,sl_next);} \
    CMASK(C0,C1,t); \
    { float a=MX3(C0[0],C0[1],C1[0]),b=MX3(C0[2],C0[3],C1[1]); a=MX3(a,C1[2],C1[3]); \
      _Pragma("unroll") for(int r=4;r<16;r+=4){a=MX3(a,C0[r],C0[r+1]);b=MX3(b,C0[r+2],C0[r+3]);a=MX3(a,C1[r],C1[r+1]);b=MX3(b,C1[r+2],C1[r+3]);} \
      float rm=__builtin_fmaxf(a,b); { auto rr=__builtin_amdgcn_permlane32_swap(__float_as_uint(rm),__float_as_uint(rm),false,false); rm=__builtin_fmaxf(__uint_as_float(rr[0]),__uint_as_float(rr[1])); } \
      resc=false; \
      if(__builtin_expect(__any(rm>(float)THRL),0)){ const float dl=__builtin_fmaxf(rm,0.f); mhat+=dl; \
        _Pragma("unroll") for(int r=0;r<16;++r){C0[r]-=dl;C1[r]-=dl;} \
        _Pragma("unroll") for(int r=0;r<16;++r)negm[r]=-mhat; asm volatile("":"+v"(negm)); \
        const float f=__builtin_amdgcn_exp2f(-dl); l_reg*=f; if(hi==0)wsf[r32]=f; resc=true; } } \
    SBAR(); \
    GAPB(o[0]=__builtin_amdgcn_mfma_f32_32x32x16_bf16(PAF(0),VFR(0),o[0],0,0,0), C0,0); \
    GAPB(o[1]=__builtin_amdgcn_mfma_f32_32x32x16_bf16(PAF(0),VFR(4),o[1],0,0,0), C0,4); \
    KRD(GL,0); GAPB(o[0]=__builtin_amdgcn_mfma_f32_32x32x16_bf16(PAF(1),VFR(1),o[0],0,0,0), C0,8); \
    KRD(GL,1); GAPB(o[1]=__builtin_amdgcn_mfma_f32_32x32x16_bf16(PAF(1),VFR(5),o[1],0,0,0), C0,12); \
    KRD(GL,2); GAPB(o[0]=__builtin_amdgcn_mfma_f32_32x32x16_bf16(PAF(2),VFR(2),o[0],0,0,0), C1,0); \
    KRD(GL,3); GAPB(o[1]=__builtin_amdgcn_mfma_f32_32x32x16_bf16(PAF(2),VFR(6),o[1],0,0,0), C1,4); \
    GAPB(o[0]=__builtin_amdgcn_mfma_f32_32x32x16_bf16(PAF(3),VFR(3),o[0],0,0,0), C1,8); \
    GAPB(o[1]=__builtin_amdgcn_mfma_f32_32x32x16_bf16(PAF(3),VFR(7),o[1],0,0,0), C1,12); \
    }while(0)
  int t=1;
  #undef CMASK
  #define CMASK(P0,P1,t) do{}while(0)
  for(;t+5<NT;t+=2){
    STEP(pB0,pB1,pA0,pA1,t,true,true,true);     WAIT_BAR(2); RESC(); ROT();
    STEP(pA0,pA1,pB0,pB1,t+1,true,true,true);   WAIT_BAR(2); RESC(); ROT();
  }
  #undef CMASK
  #define CMASK(P0,P1,t) do{int jb_=(t)-(NT-4); if(jb_>=0)cmask(P0,P1,jb_,qrel,hi);}while(0)
  #define ENDW(tt) do{ if((tt)+3<NT){WAIT_BAR(2);} else if((tt)+2<NT){WAIT_BAR(1);} else {WAIT_BAR(0);} }while(0)
  for(;t+1<NT;t+=2){
    STEP(pB0,pB1,pA0,pA1,t,(t+3<NT),(t+1<NT),(t+1<NT));       ENDW(t);   RESC(); ROT();
    STEP(pA0,pA1,pB0,pB1,t+1,(t+4<NT),(t+2<NT),(t+2<NT));     ENDW(t+1); RESC(); ROT();
  }
  STEP(pB0,pB1,pA0,pA1,NT-1,false,false,false); RESC();
  { float sacc=pB0[0]+pB0[1]; _Pragma("unroll") for(int r=2;r<16;++r)sacc+=pB0[r]; _Pragma("unroll") for(int r=0;r<16;++r)sacc+=pB1[r]; l_reg+=sacc;
    pw0=(u32x4){PKW(pB0,0),PKW(pB0,2),PKW(pB0,4),PKW(pB0,6)};pw1=(u32x4){PKW(pB0,8),PKW(pB0,10),PKW(pB0,12),PKW(pB0,14)};pw2=(u32x4){PKW(pB1,0),PKW(pB1,2),PKW(pB1,4),PKW(pB1,6)};pw3=(u32x4){PKW(pB1,8),PKW(pB1,10),PKW(pB1,12),PKW(pB1,14)};
    SBAR(); pv(o,vb0+sl_cur,PAF(0),PAF(1),PAF(2),PAF(3)); }
  #undef PKW
  #undef PAF
  #undef VFR
  #undef PIN
  #undef MX3
  #undef GAPA
  #undef GAPB
  #undef EX
  #undef VRD
  #undef KRD
  #undef STEP
  #undef ENDW
  {auto rr=__builtin_amdgcn_permlane32_swap(__float_as_uint(l_reg),__float_as_uint(l_reg),false,false);l_reg=__uint_as_float(rr[0])+__uint_as_float(rr[1]);}
  if(hi==0)wsf[32+r32]=l_reg;asm volatile("s_waitcnt lgkmcnt(0)":::"memory");
  float rli[16];
  #pragma unroll
  for(int r=0;r<16;++r)rli[r]=__builtin_amdgcn_rcpf(wsf[32+crow(r,hi)]);
  bf16*Ow=O+(rowbase+q0+wid*QBLK)*DM+vcol;
  { bf16*stg=(bf16*)(shm+LDS_OST)+wid*2048;
    #pragma unroll
    for(int r=0;r<16;++r){const int orow=crow(r,hi);
      #pragma unroll
      for(int d0=0;d0<2;++d0)stg[orow*64+d0*32+r32]=__float2bfloat16(o[d0][r]*rli[r]);}
    asm volatile("s_waitcnt lgkmcnt(0)":::"memory");
    #pragma unroll
    for(int i=0;i<4;++i){const int row=i*8+(lane>>3),ch=lane&7; const u32x4 v=*(const u32x4*)(stg+row*64+ch*8); ATTN_STORE16(Ow+(long)row*DM+ch*8,v);} }
  asm volatile("s_waitcnt lgkmcnt(0)\n\ts_barrier":::"memory");
  #undef DMA_K
  #undef DMA_V
  #undef CMASK
  #undef START
  #undef RESC
  #undef ROT
}
constexpr int ATTN_LDS_BYTES=LDS_BYTES;
#undef SBAR
#undef WAIT_BAR
}
constexpr int NWAVES = 8;
constexpr int NPH = 15;
constexpr size_t MiB = 1u << 20;
constexpr size_t WS_CTL = 0, CTL_ZERO_BYTES = 1 * MiB;
constexpr size_t WS_W_IN = 1 * MiB;
constexpr size_t WS_W_OUT = WS_W_IN + (size_t)3072 * 1024 * 2;
constexpr size_t WS_W_GU = WS_W_OUT + (size_t)1024 * 1024 * 2;
constexpr size_t WS_W_DN = WS_W_GU + (size_t)5632 * 1024 * 2;
constexpr size_t WS_W_QKV = WS_W_DN + (size_t)1024 * 2816 * 2;
constexpr size_t WS_W_O = WS_W_QKV + (size_t)3072 * 1024 * 2;
constexpr size_t WS_W_MGU = WS_W_O + (size_t)1024 * 1024 * 2;
constexpr size_t WS_W_MDN = WS_W_MGU + (size_t)8 * 7168 * 1024 * 2;
constexpr size_t WS_W_END = WS_W_MDN + (size_t)8 * 1024 * 3584 * 2;
constexpr size_t WS_R = 202 * MiB;
constexpr size_t ACT = (size_t)M * D * 2;
constexpr size_t WS_XN0 = WS_R, WS_BB = WS_R + ACT, WS_UB = WS_R + 2 * ACT, WS_G = WS_R + 3 * ACT;
constexpr size_t WS_HACT = WS_R;
constexpr size_t WS_Q = WS_R + 4 * ACT, WS_K = WS_R + 5 * ACT, WS_V = WS_R + 6 * ACT;
constexpr size_t WS_O0 = WS_R, WS_O1 = WS_R + ACT, WS_ON = WS_R + 2 * ACT;
constexpr size_t WS_HM = WS_R;
constexpr size_t WS_S = 440 * MiB;
constexpr size_t WS_XG = WS_S, WS_Y = WS_S + 68 * MiB;
constexpr size_t WS_XB = 632 * MiB;
constexpr size_t WS_HB = 664 * MiB, WS_HB2 = 696 * MiB, WS_YF = 728 * MiB;
constexpr size_t WS_SMALL = 792 * MiB;
constexpr size_t WS_SSQ = WS_SMALL;
constexpr size_t WS_SEL = WS_SMALL + 256 * 1024, WS_GATE = WS_SEL + 128 * 1024, WS_TOKSLOT = WS_GATE + 128 * 1024;
constexpr size_t WS_RSTDS = WS_TOKSLOT + 128 * 1024, WS_GATES = WS_RSTDS + 256 * 1024;
constexpr size_t WS_HIST = WS_GATES + 256 * 1024, WS_META = WS_HIST + 16 * 1024;
constexpr size_t WS_NAIVE_SMALL = WS_SMALL + 2 * MiB;
constexpr size_t WS_END = 796 * MiB;
static_assert(WS_W_END <= WS_R && WS_R + (size_t)SLOTS * DFE * 2 <= WS_S && WS_Y + (size_t)SLOTS * D * 2 <= WS_XB && WS_V + ACT <= WS_S, "d_ws map");
constexpr int CW_TMO = 0, CW_CODE = 1, CW_BAR = 4096;
constexpr int MISC_OFF = 0, RING_OFF = 1024, RING_BYTES = 131072, LDS_BYTES = 147456;
constexpr int P0_SCR = 16640;

#define GAS __attribute__((address_space(1)))
#define LAS __attribute__((address_space(3)))
typedef unsigned v4u __attribute__((ext_vector_type(4)));
typedef unsigned v2u __attribute__((ext_vector_type(2)));
typedef GAS unsigned gu32;
#define RLX_AGENT __ATOMIC_RELAXED, __HIP_MEMORY_SCOPE_AGENT
#define LDS_WAIT() asm volatile("s_waitcnt lgkmcnt(0)" ::: "memory")
#define VM_WAIT() asm volatile("s_waitcnt vmcnt(0)" ::: "memory")
__device__ __forceinline__ unsigned pk2(float lo, float hi) { return f2bf(lo) | (f2bf(hi) << 16); }
__device__ __forceinline__ float bflo(unsigned w) { return __builtin_bit_cast(float, w << 16); }
__device__ __forceinline__ float bfhi(unsigned w) { return __builtin_bit_cast(float, w & 0xffff0000u); }

#define XB_TMO      128
#define XB_XCNT(j)  (256  + 64 * (j))
#define XB_XSUB(j)  (1280 + 64 * (j))
#define XB_XGEN(j)  (2304 + 64 * (j))
#define XB_TOP      3328
#define XB_TOPGEN   3392
#define XCD_BAR_WORDS 3456
#define XB_SPIN_CAP (1u << 18)

__device__ __forceinline__ unsigned xb_ld(unsigned* p)              { return __hip_atomic_load(p, __ATOMIC_RELAXED, __HIP_MEMORY_SCOPE_AGENT); }
__device__ __forceinline__ unsigned xb_add(unsigned* p, unsigned v) { return __hip_atomic_fetch_add(p, v, __ATOMIC_RELAXED, __HIP_MEMORY_SCOPE_AGENT); }
__device__ __forceinline__ unsigned xb_xcc_id() { return (unsigned)__builtin_amdgcn_s_getreg((3 << 11) | 20) & 0xFu; }
#define XB_SPIN(cond, bar) do { unsigned _sp = 0; while (cond) { __builtin_amdgcn_s_sleep(1); \
    if ((++_sp & 255u) == 0u) { if (xb_ld(&(bar)[XB_TMO])) break; if (_sp > XB_SPIN_CAP) { atomicAdd(&(bar)[XB_TMO], 1u); break; } } } } while (0)

struct XcdBarrier {
    unsigned* bar; unsigned x;
    volatile LAS unsigned* st;
};

__device__ __forceinline__ XcdBarrier xcd_barrier_post(unsigned* bar, volatile LAS unsigned* st) {
    XcdBarrier b; b.bar = bar; b.x = xb_xcc_id(); b.st = st;
    if (threadIdx.x == 0) (void)xb_add(&bar[XB_XCNT(b.x)], 1u);
    return b;
}
__device__ __forceinline__ void xcd_barrier_complete(unsigned* bar, unsigned x, unsigned& nloc, unsigned& nx) {
    const unsigned G = gridDim.x * gridDim.y * gridDim.z;
    unsigned sum, cnt, mine, sp = 0u;
    for (;;) {
        sum = 0u; cnt = 0u; mine = 0u;
#pragma unroll
        for (unsigned j = 0; j < 16; ++j) { const unsigned c = xb_ld(&bar[XB_XCNT(j)]); sum += c; cnt += (c > 0u) ? 1u : 0u; mine = (j == x) ? c : mine; }
        if (sum == G) break;
        __builtin_amdgcn_s_sleep(1);
        if ((++sp & 255u) == 0u) { if (xb_ld(&bar[XB_TMO])) break; if (sp > XB_SPIN_CAP) { atomicAdd(&bar[XB_TMO], 1u); break; } }
    }
    nloc = mine > 0u ? mine : 1u; nx = cnt > 0u ? cnt : 1u;
}

__device__ __forceinline__ void xcd_barrier(const XcdBarrier& b) {
    asm volatile("s_waitcnt vmcnt(0)" ::: "memory");
    __syncthreads();
    if (threadIdx.x == 0) {
        unsigned* bar = b.bar;
        __builtin_amdgcn_s_waitcnt(0);
        unsigned nloc = b.st[0], nx = b.st[1];
        if (nloc == 0u) { xcd_barrier_complete(bar, b.x, nloc, nx); b.st[0] = nloc; b.st[1] = nx; }
        const unsigned old = xb_add(&bar[XB_XSUB(b.x)], 1u);
        const unsigned gen = old / nloc;
        if (old + 1u == (gen + 1u) * nloc) {
            __builtin_amdgcn_fence(__ATOMIC_RELEASE, "agent");
            asm volatile("s_waitcnt vmcnt(0)" ::: "memory");
            const unsigned og = xb_add(&bar[XB_TOP], 1u);
            const unsigned tg = og / nx;
            if (og + 1u == (tg + 1u) * nx) xb_add(&bar[XB_TOPGEN], 1u);
            else XB_SPIN(xb_ld(&bar[XB_TOPGEN]) == tg, bar);
            __builtin_amdgcn_fence(__ATOMIC_ACQUIRE, "agent");
            xb_add(&bar[XB_XGEN(b.x)], 1u);
            asm volatile("s_waitcnt vmcnt(0)" ::: "memory");
        } else {
            XB_SPIN(xb_ld(&bar[XB_XGEN(b.x)]) == gen, bar);
            __builtin_amdgcn_fence(__ATOMIC_ACQUIRE, "agent");
            asm volatile("s_waitcnt vmcnt(0)" ::: "memory");
        }
    }
    __syncthreads();
}


struct Args { const float* in[19]; float* out; unsigned char* wsp; int ph_lo, ph_hi, li, jobmask; };
struct Frame { LAS unsigned char* lds; int tid, lane, wave, vcu, G; };
#define KA ((const Args*)__builtin_amdgcn_kernarg_segment_ptr())
#define INP(i) (KA->in[i])
#define A_WS (KA->wsp)
#define A_OUT (KA->out)

__device__ __forceinline__ void p0_item(const float* src, int ldw, const float* gain, bf16_t* dst, int K, int k0, int n0, int d0, int d1, LAS float* scr, int lane) {
    const int lr = lane >> 4, lc = lane & 15;
    f32x4 v[16];
#pragma unroll
    for (int i = 0; i < 16; ++i) v[i] = *(const GAS f32x4*)(src + (size_t)(k0 + 4 * i + lr) * ldw + n0 + 4 * lc);
    if (gain) {
#pragma unroll
        for (int i = 0; i < 16; ++i) v[i] = v[i] * gain[k0 + 4 * i + lr];
    }
#pragma unroll
    for (int i = 0; i < 16; ++i) { LAS float* p = scr + (4 * i + lr) * 65 + 4 * lc; p[0] = v[i][0]; p[1] = v[i][1]; p[2] = v[i][2]; p[3] = v[i][3]; }
    LDS_WAIT(); asm volatile("" ::: "memory");
    const int c = lane & 7;
#pragma unroll
    for (int jj = 0; jj < 8; ++jj) { const int nl = 8 * jj + (lane >> 3); const LAS float* s = scr + (8 * c) * 65 + nl;
        v4u o; o.x = pk2(s[0], s[65]); o.y = pk2(s[130], s[195]); o.z = pk2(s[260], s[325]); o.w = pk2(s[390], s[455]);
        const int drow = (jj < 4 ? d0 : d1 - 32) + nl;
        *(GAS v4u*)(dst + (size_t)drow * K + k0 + 8 * c) = o; }
    LDS_WAIT(); asm volatile("" ::: "memory");
}
__device__ __forceinline__ void p0_item8(const float* src, int ldw, const float* gain, float sc, unsigned char* dst, int K, int k0, int n0, int d0, int d1, LAS float* scr, int lane) {
    const int lr = lane >> 4, lc = lane & 15;
    f32x4 v[16];
#pragma unroll
    for (int i = 0; i < 16; ++i) v[i] = *(const GAS f32x4*)(src + (size_t)(k0 + 4 * i + lr) * ldw + n0 + 4 * lc);
#pragma unroll
    for (int i = 0; i < 16; ++i) v[i] = v[i] * (gain ? gain[k0 + 4 * i + lr] * sc : sc);
#pragma unroll
    for (int i = 0; i < 16; ++i) { LAS float* p = scr + (4 * i + lr) * 65 + 4 * lc; p[0] = v[i][0]; p[1] = v[i][1]; p[2] = v[i][2]; p[3] = v[i][3]; }
    LDS_WAIT(); asm volatile("" ::: "memory");
    const int c = lane & 7;
#pragma unroll
    for (int jj = 0; jj < 8; ++jj) { const int nl = 8 * jj + (lane >> 3); const LAS float* s = scr + (8 * c) * 65 + nl;
        v2u o; o.x = pg8::pk4_fp8(s[0], s[65], s[130], s[195]); o.y = pg8::pk4_fp8(s[260], s[325], s[390], s[455]);
        const int drow = (jj < 4 ? d0 : d1 - 32) + nl;
        *(GAS v2u*)(dst + (size_t)drow * K + k0 + 8 * c) = o; }
    LDS_WAIT(); asm volatile("" ::: "memory");
}
__device__ __forceinline__ int p0_dstrow(int mode, int aux, int col) {
    if (mode == 1) { if (col < 1024) return col; const int v = col >= 2048, cc = col - (v ? 2048 : 1024); return 1024 + 256 * (cc >> 7) + 128 * v + (cc & 127); }
    if (mode == 2) { const int up = col >= aux, cc = col - (up ? aux : 0); return 256 * (cc >> 7) + 128 * up + (cc & 127); }
    if (mode == 3) { const int g = col >> 6, bj = (col >> 5) & 1; return 256 * (g >> 2) + 32 * (4 * bj + (g & 3)) + (col & 31); }
    return col;
}
template <bool F8>
__device__ __forceinline__ void p0_job(Frame& F, int& base, const float* src, int ldw, int K, int c0, int ncols, const float* gain, void* dstv, int drow0, int dstrows, int mode, int aux, int nmat, float sc) {
    LAS float* scr = (LAS float*)(F.lds + RING_OFF + F.wave * P0_SCR);
    const int gw = F.vcu * NWAVES + F.wave, NGW = F.G * NWAVES, nk = K / 64, nn = ncols / 64, per = nk * nn, total = per * nmat;
    int it = (gw - base) % NGW; if (it < 0) it += NGW;
    for (; it < total; it += NGW) { const int mat = it / per, r = it % per, kb = r / nn, nb = r % nn; const int col = 64 * nb;
        if constexpr (F8) p0_item8(src + (size_t)mat * K * ldw + c0, ldw, gain, sc, (unsigned char*)dstv + (size_t)mat * dstrows * K, K, 64 * kb, col, drow0 + p0_dstrow(mode, aux, col), drow0 + p0_dstrow(mode, aux, col + 32), scr, F.lane);
        else p0_item(src + (size_t)mat * K * ldw + c0, ldw, gain, (bf16_t*)dstv + (size_t)mat * dstrows * K, K, 64 * kb, col, drow0 + p0_dstrow(mode, aux, col), drow0 + p0_dstrow(mode, aux, col + 32), scr, F.lane); }
    base = (base + total) % NGW;
}
__device__ __forceinline__ void rms_row_bf16(const float* xrow, const float* g, bf16_t* orow, int lane) {
    const GAS f32x4* xr = (const GAS f32x4*)xrow + lane; const GAS f32x4* gr = (const GAS f32x4*)g + lane;
    f32x4 v[4]; float s = 0.f;
#pragma unroll
    for (int j = 0; j < 4; ++j) { v[j] = xr[64 * j]; s += (v[j][0] * v[j][0] + v[j][1] * v[j][1]) + (v[j][2] * v[j][2] + v[j][3] * v[j][3]); }
    const float rstd = __builtin_amdgcn_rsqf(wave_sum(s) * (1.f / D) + EPS);
    GAS v2u* o8 = (GAS v2u*)orow + lane;
#pragma unroll
    for (int j = 0; j < 4; ++j) { const f32x4 gg = gr[64 * j]; v2u o; o.x = pk2(v[j][0] * rstd * gg[0], v[j][1] * rstd * gg[1]); o.y = pk2(v[j][2] * rstd * gg[2], v[j][3] * rstd * gg[3]); o8[64 * j] = o; }
}
__device__ __forceinline__ void p0_prologue(Frame& F, int jobmask) {
    unsigned char* ws = A_WS; int base = 0;
    if (jobmask & 1)   p0_job<false>(F, base, INP(3), 3072, 1024, 0, 3072, nullptr, (bf16_t*)(ws + WS_W_IN), 0, 3072, 1, 0, 1, 1.0f);
    if (jobmask & 2)   p0_job<false>(F, base, INP(5), 1024, 1024, 0, 1024, nullptr, (bf16_t*)(ws + WS_W_OUT), 0, 1024, 0, 0, 1, 1.0f);
    if (jobmask & 4)   p0_job<false>(F, base, INP(14), 5632, 1024, 0, 5632, INP(2), (bf16_t*)(ws + WS_W_GU), 0, 5632, 2, 2816, 1, 1.0f);
    if (jobmask & 8)   p0_job<false>(F, base, INP(15), 1024, 2816, 0, 1024, nullptr, (bf16_t*)(ws + WS_W_DN), 0, 1024, 0, 0, 1, 1.0f);
    if (jobmask & 16) { p0_job<false>(F, base, INP(9), 1024, 1024, 0, 1024, INP(1) + 1024, (bf16_t*)(ws + WS_W_QKV), 0, 3072, 3, 0, 1, 1.0f);
                        p0_job<false>(F, base, INP(7), 2048, 1024, 0, 1024, INP(6), (bf16_t*)(ws + WS_W_QKV), 1024, 3072, 3, 0, 1, 1.0f);
                        p0_job<false>(F, base, INP(7), 2048, 1024, 1024, 1024, INP(6), (bf16_t*)(ws + WS_W_QKV), 2048, 3072, 0, 0, 1, 1.0f); }
    if (jobmask & 32)  p0_job<false>(F, base, INP(13), 1024, 1024, 0, 1024, nullptr, (bf16_t*)(ws + WS_W_O), 0, 1024, 0, 0, 1, 1.0f);
    if (jobmask & 64)  p0_job<true>(F, base, INP(17), 7168, 1024, 0, 7168, INP(2) + 1024, (ws + WS_W_MGU), 0, 7168, 2, 3584, 8, pg8::F8_SWG);
    if (jobmask & 128) p0_job<true>(F, base, INP(18), 1024, 3584, 0, 1024, nullptr, (ws + WS_W_MDN), 0, 1024, 0, 0, 8, pg8::F8_SWD);
    const int gw = F.vcu * NWAVES + F.wave, NGW = F.G * NWAVES;
    for (int m = gw; m < M; m += NGW) rms_row_bf16(INP(0) + (size_t)m * D, INP(1), (bf16_t*)(ws + WS_XN0) + (size_t)m * D, F.lane);
}

__device__ __forceinline__ void up8(const v4u w, float (&f)[8]) { f[0] = bflo(w.x); f[1] = bfhi(w.x); f[2] = bflo(w.y); f[3] = bfhi(w.y); f[4] = bflo(w.z); f[5] = bfhi(w.z); f[6] = bflo(w.w); f[7] = bfhi(w.w); }
__device__ __forceinline__ void p2_conv(Frame& F) {
    const bf16_t* Bb = (const bf16_t*)(A_WS + WS_BB); const bf16_t* Ub = (const bf16_t*)(A_WS + WS_UB); bf16_t* G = (bf16_t*)(A_WS + WS_G); const float* cw = INP(4);
    const int gw = F.vcu * NWAVES + F.wave, NGW = F.G * NWAVES;
    for (int strip = gw; strip < 2048; strip += NGW) {
        const int r0 = (strip >> 1) * 16, c0 = (strip & 1) * 512 + F.lane * 8;
        float w0[8], w1[8], w2[8], um2[8], um1[8];
#pragma unroll
        for (int j = 0; j < 8; ++j) { w0[j] = cw[c0 + j]; w1[j] = cw[D + c0 + j]; w2[j] = cw[2 * D + c0 + j]; um2[j] = 0.f; um1[j] = 0.f; }
        if ((r0 & (SEQ - 1)) != 0) { up8(*(const GAS v4u*)(Ub + (size_t)(r0 - 2) * D + c0), um2); up8(*(const GAS v4u*)(Ub + (size_t)(r0 - 1) * D + c0), um1); }
#pragma unroll
        for (int hb = 0; hb < 2; ++hb) { v4u ru[8], rb[8];
#pragma unroll
            for (int i = 0; i < 8; ++i) { ru[i] = *(const GAS v4u*)(Ub + (size_t)(r0 + 8 * hb + i) * D + c0); rb[i] = *(const GAS v4u*)(Bb + (size_t)(r0 + 8 * hb + i) * D + c0); }
#pragma unroll
            for (int ii = 0; ii < 8; ++ii) { const int i = 8 * hb + ii; float u[8], b[8]; up8(ru[ii], u); up8(rb[ii], b);
            float g[8];
#pragma unroll
            for (int j = 0; j < 8; ++j) { g[j] = b[j] * (w0[j] * um2[j] + w1[j] * um1[j] + w2[j] * u[j]); um2[j] = um1[j]; um1[j] = u[j]; }
            v4u o; o.x = pk2(g[0], g[1]); o.y = pk2(g[2], g[3]); o.z = pk2(g[4], g[5]); o.w = pk2(g[6], g[7]);
            *(GAS v4u*)(G + (size_t)(r0 + i) * D + c0) = o; } }
    }
}

__device__ __forceinline__ void p8_diff(Frame& F) {
    const bf16_t* O0 = (const bf16_t*)(A_WS + WS_O0); const bf16_t* O1 = (const bf16_t*)(A_WS + WS_O1); bf16_t* ON = (bf16_t*)(A_WS + WS_ON);
    const float* lp = INP(11); const float* sn = INP(12); const int lane = F.lane;
    const float lam = __expf(wave_sum(lp[lane] * lp[64 + lane])) - __expf(wave_sum(lp[128 + lane] * lp[192 + lane])) + LAM_INIT;
    float gn[16];
#pragma unroll
    for (int j = 0; j < 16; ++j) gn[j] = sn[16 * (lane & 7) + j] * (1.f - LAM_INIT);
    const int gw = F.vcu * NWAVES + F.wave, NGW = F.G * NWAVES;
    for (int rowb = gw; rowb < M; rowb += 4 * NGW) {
        v4u ra[4][2], rb[4][2];
#pragma unroll
        for (int i = 0; i < 4; ++i) { const int row = rowb + i * NGW; if (row < M) { const size_t off = (size_t)row * D + 16 * lane;
            ra[i][0] = *(const GAS v4u*)(O0 + off); ra[i][1] = *(const GAS v4u*)(O0 + off + 8); rb[i][0] = *(const GAS v4u*)(O1 + off); rb[i][1] = *(const GAS v4u*)(O1 + off + 8); } }
#pragma unroll
        for (int i = 0; i < 4; ++i) { const int row = rowb + i * NGW; if (row >= M) break; const size_t off = (size_t)row * D + 16 * lane;
            float a[16], a0[8], a1[8], b0[8], b1[8]; up8(ra[i][0], a0); up8(ra[i][1], a1); up8(rb[i][0], b0); up8(rb[i][1], b1);
            float s = 0.f;
#pragma unroll
            for (int j = 0; j < 8; ++j) { a[j] = a0[j] - lam * b0[j]; a[8 + j] = a1[j] - lam * b1[j]; s += a[j] * a[j] + a[8 + j] * a[8 + j]; }
            s += __shfl_xor(s, 1); s += __shfl_xor(s, 2); s += __shfl_xor(s, 4);
            const float rstd = __builtin_amdgcn_rsqf(s * (1.f / VD) + EPS);
            v4u o0, o1; o0.x = pk2(a[0] * rstd * gn[0], a[1] * rstd * gn[1]); o0.y = pk2(a[2] * rstd * gn[2], a[3] * rstd * gn[3]); o0.z = pk2(a[4] * rstd * gn[4], a[5] * rstd * gn[5]); o0.w = pk2(a[6] * rstd * gn[6], a[7] * rstd * gn[7]);
            o1.x = pk2(a[8] * rstd * gn[8], a[9] * rstd * gn[9]); o1.y = pk2(a[10] * rstd * gn[10], a[11] * rstd * gn[11]); o1.z = pk2(a[12] * rstd * gn[12], a[13] * rstd * gn[13]); o1.w = pk2(a[14] * rstd * gn[14], a[15] * rstd * gn[15]);
            *(GAS v4u*)(ON + off) = o0; *(GAS v4u*)(ON + off + 8) = o1; }
    }
}

#define TR_STEP(n, m) do { _Pragma("unroll") for (int i = 0; i < (n) / 2; ++i) { const bool up = (lane & (m)) != 0; const float keep = up ? v[i + (n) / 2] : v[i], send = up ? v[i] : v[i + (n) / 2]; v[i] = keep + __shfl_xor(send, (m)); } } while (0)
__device__ __forceinline__ void p10a_router(Frame& F) {
    const bf16_t* x3 = (const bf16_t*)(A_WS + WS_XB); const float* g = INP(2) + D; const float* Wr = INP(16); const float* ssq = (const float*)(A_WS + WS_SSQ);
    int* sel = (int*)(A_WS + WS_SEL); float* gate = (float*)(A_WS + WS_GATE); int* hist = (int*)(A_WS + WS_HIST);
    LAS f32x4* WL = (LAS f32x4*)(F.lds + RING_OFF);
    LAS int* lcnt = (LAS int*)(F.lds + RING_OFF + 32768);
    const int lane = F.lane;
    for (int k = F.tid; k < D; k += NWAVES * 64) { const float gk = g[k]; const f32x4 w0 = *(const GAS f32x4*)(Wr + (size_t)k * 8) * gk, w1 = *(const GAS f32x4*)(Wr + (size_t)k * 8 + 4) * gk;
        const int base = (((k >> 8) * 4 + (k & 3)) * 2) * 64 + ((k >> 2) & 63); WL[base] = w0; WL[base + 64] = w1; }
    LDS_WAIT(); __syncthreads();
    for (int blk = blockIdx.x; blk < M / 64; blk += F.G) {
        const int row0 = 64 * blk + 8 * F.wave;
        f32x4 xv[8][4];
#pragma unroll
        for (int r = 0; r < 8; ++r)
#pragma unroll
            for (int j = 0; j < 4; ++j) { const v2u w = *((const GAS v2u*)(x3 + (size_t)(row0 + r) * D) + lane + 64 * j); xv[r][j] = (f32x4){bflo(w.x), bfhi(w.x), bflo(w.y), bfhi(w.y)}; }
        float v[64];
#pragma unroll
        for (int i = 0; i < 64; ++i) v[i] = 0.f;
#pragma unroll
        for (int j = 0; j < 4; ++j)
#pragma unroll
            for (int q = 0; q < 4; ++q) { const f32x4 wa = WL[((j * 4 + q) * 2) * 64 + lane], wb = WL[((j * 4 + q) * 2 + 1) * 64 + lane];
#pragma unroll
                for (int r = 0; r < 8; ++r) { const float xx = xv[r][j][q];
                    v[r * 8 + 0] += xx * wa[0]; v[r * 8 + 1] += xx * wa[1]; v[r * 8 + 2] += xx * wa[2]; v[r * 8 + 3] += xx * wa[3];
                    v[r * 8 + 4] += xx * wb[0]; v[r * 8 + 5] += xx * wb[1]; v[r * 8 + 6] += xx * wb[2]; v[r * 8 + 7] += xx * wb[3]; } }
        TR_STEP(64, 32); TR_STEP(32, 16); TR_STEP(16, 8); TR_STEP(8, 4); TR_STEP(4, 2); TR_STEP(2, 1);
        float lg[8];
#pragma unroll
        for (int e = 0; e < 8; ++e) lg[e] = __shfl(v[0], (lane & ~7) | e);
        int i0 = 0; float v0 = lg[0];
#pragma unroll
        for (int e = 1; e < 8; ++e) if (lg[e] > v0) { v0 = lg[e]; i0 = e; }
        int i1 = 0; float v1 = -INFINITY;
#pragma unroll
        for (int e = 0; e < 8; ++e) if (e != i0 && lg[e] > v1) { v1 = lg[e]; i1 = e; }
        const int row = row0 + (lane >> 3); const float rs = pg8::rstd_of(ssq, row);
        const float g1 = 1.f / (1.f + expf((v0 - v1) * rs)); const bool wrt = (lane & 7) == 0;
        if (wrt) { sel[2 * row] = i0; sel[2 * row + 1] = i1; gate[2 * row] = 1.f - g1; gate[2 * row + 1] = g1; }
        int mycnt = 0;
#pragma unroll
        for (int e = 0; e < 8; ++e) { const int c = __popcll(__ballot(wrt && i0 == e)) + __popcll(__ballot(wrt && i1 == e)); if (lane == e) mycnt = c; }
        if (lane < 8) lcnt[F.wave * 8 + lane] = mycnt;
        LDS_WAIT(); __syncthreads();
        if (F.tid < 8) { int c = 0;
#pragma unroll
            for (int w = 0; w < 8; ++w) c += lcnt[w * 8 + F.tid];
            hist[blk * 8 + F.tid] = c; }
        LDS_WAIT(); __syncthreads();
    }
}
#undef TR_STEP
__device__ __forceinline__ void p10b_assign(Frame& F) {
    const int* hist = (const int*)(A_WS + WS_HIST); const int* sel = (const int*)(A_WS + WS_SEL); const float* gate = (const float*)(A_WS + WS_GATE); const float* ssq = (const float*)(A_WS + WS_SSQ);
    int* tok_slot = (int*)(A_WS + WS_TOKSLOT); float* gates = (float*)(A_WS + WS_GATES); int* meta = (int*)(A_WS + WS_META);
    const bf16_t* x3 = (const bf16_t*)(A_WS + WS_XB); unsigned char* XG = A_WS + WS_XG;
    LAS int* pre = (LAS int*)(F.lds + RING_OFF);
    LAS int* tot = pre + 2048;
    LAS int* ebase = tot + 8;
    LAS int* lslot = ebase + 8;
    const int lane = F.lane, e = F.wave;
    { int h[4], run = 0;
#pragma unroll
      for (int i = 0; i < 4; ++i) { h[i] = hist[(4 * lane + i) * 8 + e]; }
      const int mine = h[0] + h[1] + h[2] + h[3]; int inc = mine;
#pragma unroll
      for (int o = 1; o < 64; o <<= 1) { const int t = __shfl_up(inc, o); if (lane >= o) inc += t; }
      run = inc - mine;
#pragma unroll
      for (int i = 0; i < 4; ++i) { pre[(4 * lane + i) * 8 + e] = run; run += h[i]; }
      if (lane == 63) tot[e] = inc; }
    LDS_WAIT(); __syncthreads();
    if (F.tid == 0) { int b = 0; for (int k = 0; k < 8; ++k) { ebase[k] = b; if (blockIdx.x == 0) meta[k] = b >> 8; b += (tot[k] + 255) & ~255; } if (blockIdx.x == 0) meta[8] = b >> 8; }
    LDS_WAIT(); __syncthreads();
    for (int blk = blockIdx.x; blk < M / 64; blk += F.G) {
        if (F.wave == 0) { const int t = 64 * blk + lane; const int s0 = sel[2 * t], s1 = sel[2 * t + 1]; int sl0 = 0, sl1 = 0;
            const unsigned long long below = (1ull << lane) - 1ull;
#pragma unroll
            for (int k = 0; k < 8; ++k) { const unsigned long long m0 = __ballot(s0 == k), m1 = __ballot(s1 == k); const int b0 = ebase[k] + pre[blk * 8 + k];
                if (s0 == k) sl0 = b0 + __popcll(m0 & below); if (s1 == k) sl1 = b0 + __popcll(m0) + __popcll(m1 & below); }
            tok_slot[2 * t] = sl0; tok_slot[2 * t + 1] = sl1; lslot[2 * lane] = sl0; lslot[2 * lane + 1] = sl1;
            gates[sl0] = gate[2 * t]; gates[sl1] = gate[2 * t + 1]; }
        LDS_WAIT(); __syncthreads();
        v4u xw[8][2];
#pragma unroll
        for (int i = 0; i < 8; ++i) { const GAS v4u* xr = (const GAS v4u*)(x3 + (size_t)(64 * blk + 8 * F.wave + i) * D + 16 * lane); xw[i][0] = xr[0]; xw[i][1] = xr[1]; }
#pragma unroll
        for (int i = 0; i < 8; ++i) { const int tl = 8 * F.wave + i; const int t = 64 * blk + tl;
            const float rs = pg8::rstd_of(ssq, t) * pg8::F8_SA; float a[8], b[8]; up8(xw[i][0], a); up8(xw[i][1], b);
            v4u o; o.x = pg8::pk4_fp8(a[0] * rs, a[1] * rs, a[2] * rs, a[3] * rs); o.y = pg8::pk4_fp8(a[4] * rs, a[5] * rs, a[6] * rs, a[7] * rs); o.z = pg8::pk4_fp8(b[0] * rs, b[1] * rs, b[2] * rs, b[3] * rs); o.w = pg8::pk4_fp8(b[4] * rs, b[5] * rs, b[6] * rs, b[7] * rs);
            const int sl0 = lslot[2 * tl], sl1 = lslot[2 * tl + 1];
            *(GAS v4u*)(XG + (size_t)sl0 * D + 16 * lane) = o; *(GAS v4u*)(XG + (size_t)sl1 * D + 16 * lane) = o; }
        LDS_WAIT(); __syncthreads();
    }
}
__device__ __forceinline__ void p13_final(Frame& F) {
    const int* tok_slot = (const int*)(A_WS + WS_TOKSLOT); const bf16_t* Y = (const bf16_t*)(A_WS + WS_Y); const bf16_t* X3 = (const bf16_t*)(A_WS + WS_XB); float* out = A_OUT;
    const int gw = F.vcu * NWAVES + F.wave, NGW = F.G * NWAVES, lane = F.lane;
    for (int rowb = gw; rowb < M; rowb += 2 * NGW) {
        v2u xa[2][4], ya[2][4], yb[2][4];
#pragma unroll
        for (int i = 0; i < 2; ++i) { const int row = rowb + i * NGW; if (row < M) { const int s0 = tok_slot[2 * row], s1 = tok_slot[2 * row + 1];
            const GAS v2u* xr = (const GAS v2u*)(X3 + (size_t)row * D) + lane; const GAS v2u* y0 = (const GAS v2u*)(Y + (size_t)s0 * D) + lane; const GAS v2u* y1 = (const GAS v2u*)(Y + (size_t)s1 * D) + lane;
#pragma unroll
            for (int j = 0; j < 4; ++j) { xa[i][j] = xr[64 * j]; ya[i][j] = y0[64 * j]; yb[i][j] = y1[64 * j]; } } }
#pragma unroll
        for (int i = 0; i < 2; ++i) { const int row = rowb + i * NGW; if (row >= M) break; GAS f32x4* orow = (GAS f32x4*)(out + (size_t)row * D) + lane;
#pragma unroll
            for (int j = 0; j < 4; ++j) { const v2u x = xa[i][j], a = ya[i][j], b = yb[i][j];
                orow[64 * j] = (f32x4){bflo(x.x) + (bflo(a.x) + bflo(b.x)), bfhi(x.x) + (bfhi(a.x) + bfhi(b.x)), bflo(x.y) + (bflo(a.y) + bflo(b.y)), bfhi(x.y) + (bfhi(a.y) + bfhi(b.y))}; } }
    }
}

__global__ void __launch_bounds__(NWAVES * 64, 2) mega_fwd(Args args) {
    extern __shared__ __attribute__((aligned(16))) unsigned char lds[];
    Frame F;
    F.lds = (LAS unsigned char*)lds; F.tid = threadIdx.x; F.lane = F.tid & 63; F.wave = __builtin_amdgcn_readfirstlane(F.tid >> 6);
    F.G = gridDim.x; { const int bx = blockIdx.x; F.vcu = (F.G % 8 == 0) ? (bx % 8) * (F.G / 8) + bx / 8 : bx; }
    for (int u = F.tid; u < RING_OFF / 4; u += NWAVES * 64) ((LAS unsigned*)(F.lds + MISC_OFF))[u] = 0u;
    __syncthreads();
    if (KA->ph_hi - KA->ph_lo > 1) (void)xcd_barrier_post((unsigned*)(A_WS + WS_CTL) + CW_BAR + KA->li * XCD_BAR_WORDS, (volatile LAS unsigned*)(F.lds + MISC_OFF + 32));
#define IN(k) (KA->ph_lo <= (k) && (k) < KA->ph_hi)
#define SEAM(k) do { if (IN(k) && IN((k) + 1)) { XcdBarrier b_; b_.bar = (unsigned*)(A_WS + WS_CTL) + CW_BAR + KA->li * XCD_BAR_WORDS; b_.x = xb_xcc_id(); b_.st = (volatile LAS unsigned*)(F.lds + MISC_OFF + 32); xcd_barrier(b_); } } while (0)
#define ws A_WS
#define XB ((bf16_t*)(A_WS + WS_XB))
#define SSQ ((float*)(A_WS + WS_SSQ))

    if (IN(0)) { p0_prologue(F, KA->jobmask); } SEAM(0);
    if (IN(1)) { pg8::Gemm g{(const bf16_t*)(ws + WS_XN0), (const bf16_t*)(ws + WS_W_IN), M, 3072, 1024}; pg8::StaticOrder S; S.init(M, 3072, F.G, (int)blockIdx.x);
        pg8::EpiInProj E{(bf16_t*)(ws + WS_BB), (bf16_t*)(ws + WS_UB)};
        pg8::gemm_phase<pg8::EpiInProj, pg8::StaticOrder, true, true>(F.lds + RING_OFF, g, S, E); } SEAM(1);
    if (IN(2)) { p2_conv(F); } SEAM(2);
    if (IN(3)) { pg8::Gemm g{(const bf16_t*)(ws + WS_G), (const bf16_t*)(ws + WS_W_OUT), M, 1024, 1024}; pg8::StaticOrder S; S.init(M, 1024, F.G, (int)blockIdx.x);
        pg8::EpiResidSsq<true> E{INP(0), XB, SSQ};
        pg8::gemm_phase<pg8::EpiResidSsq<true>, pg8::StaticOrder, false, true>(F.lds + RING_OFF, g, S, E); } SEAM(3);
    if (IN(4)) { pg8::Gemm g{XB, (const bf16_t*)(ws + WS_W_GU), M, 5632, 1024}; pg8::StaticOrder S; S.init(M, 5632, F.G, (int)blockIdx.x);
        pg8::EpiSwiGLU E{(bf16_t*)(ws + WS_HACT), DFF, SSQ, nullptr, 22};
        pg8::gemm_phase<pg8::EpiSwiGLU, pg8::StaticOrder, true, true>(F.lds + RING_OFF, g, S, E); } SEAM(4);
    if (IN(5)) { pg8::Gemm g{(const bf16_t*)(ws + WS_HACT), (const bf16_t*)(ws + WS_W_DN), M, 1024, DFF}; pg8::StaticOrder S; S.init(M, 1024, F.G, (int)blockIdx.x);
        pg8::EpiResidSsq<false> E{nullptr, XB, SSQ};
        pg8::gemm_phase<pg8::EpiResidSsq<false>, pg8::StaticOrder, false, true>(F.lds + RING_OFF, g, S, E); } SEAM(5);
    if (IN(6)) { pg8::Gemm g{XB, (const bf16_t*)(ws + WS_W_QKV), M, 3072, 1024}; pg8::StaticOrder S; S.init(M, 3072, F.G, (int)blockIdx.x);
        pg8::EpiQKV E{(bf16_t*)(ws + WS_Q), (bf16_t*)(ws + WS_K), (bf16_t*)(ws + WS_V), SSQ, INP(10), INP(8), attn_body::C2};
        pg8::gemm_phase<pg8::EpiQKV, pg8::StaticOrder, true, true>(F.lds + RING_OFF, g, S, E); } SEAM(6);
    if (IN(7)) {
        for (int vh = F.vcu; vh < BATCH * 32; vh += F.G) { const int b = vh >> 5, r = vh & 31, h = r >> 2, c = (r >> 1) & 1, vhalf = r & 1;
            attn_body::bf16* O = (attn_body::bf16*)(ws + (c ? WS_O1 : WS_O0));
            for (int qb = SEQ / 256 - 1; qb >= 0; --qb)
                attn_body::attn_unit<8>(b, (2 * h + c) * 64, h * 128 + vhalf * 64, qb, (const attn_body::bf16*)(ws + WS_Q), (const attn_body::bf16*)(ws + WS_K), (const attn_body::bf16*)(ws + WS_V), O, (char*)lds + RING_OFF); }
    } SEAM(7);
    if (IN(8)) { p8_diff(F); } SEAM(8);
    if (IN(9)) { pg8::Gemm g{(const bf16_t*)(ws + WS_ON), (const bf16_t*)(ws + WS_W_O), M, 1024, 1024}; pg8::StaticOrder S; S.init(M, 1024, F.G, (int)blockIdx.x);
        pg8::EpiResidSsq<false> E{nullptr, XB, SSQ};
        pg8::gemm_phase<pg8::EpiResidSsq<false>, pg8::StaticOrder, false, true>(F.lds + RING_OFF, g, S, E); } SEAM(9);
    if (IN(10)) { p10a_router(F); } SEAM(10);
    if (IN(11)) { p10b_assign(F); } SEAM(11);
    if (IN(12)) { pg8::Gemm g{(const bf16_t*)(ws + WS_XG), (const bf16_t*)(ws + WS_W_MGU), SLOTS, 8 * 7168, 512}; pg8::MoeOrder S; S.init((const int*)(ws + WS_META), 28, F.G, (int)blockIdx.x);
        pg8::EpiSwiGLU8 E{ws + WS_HM, DFE, 28};
        pg8::gemm_phase<pg8::EpiSwiGLU8, pg8::MoeOrder, true, true, true>(F.lds + RING_OFF, g, S, E); } SEAM(12);
    if (IN(13)) { pg8::Gemm g{(const bf16_t*)(ws + WS_HM), (const bf16_t*)(ws + WS_W_MDN), SLOTS, 8 * 1024, DFE / 2}; pg8::MoeOrder S; S.init((const int*)(ws + WS_META), 4, F.G, (int)blockIdx.x);
        pg8::EpiMoeDown E{(bf16_t*)(ws + WS_Y), (const float*)(ws + WS_GATES), 1.0f / (pg8::F8_SH * pg8::F8_SWD)};
        pg8::gemm_phase<pg8::EpiMoeDown, pg8::MoeOrder, true, true, true>(F.lds + RING_OFF, g, S, E); } SEAM(13);
    if (IN(14)) { p13_final(F); }
#undef IN
#undef SEAM
#undef ws
#undef XB
#undef SSQ
}
#ifndef MEGA_UPTO
#define MEGA_UPTO 15
#endif
#ifndef MEGA_REPMASK
#define MEGA_REPMASK 0
#endif
#ifndef MEGA_ONE
#define MEGA_ONE 1
#endif
extern "C" void kernel_launch(void* const* d_in, const int* in_sizes, int n_in, void* d_out, int out_size, void* d_ws, size_t ws_size, hipStream_t stream) {
    static int grid = 0;
    if (grid == 0) {
        if (n_in != 19 || in_sizes[0] != M * D || out_size != M * D || ws_size < WS_END) { fprintf(stderr, "kernel_launch: unexpected shapes / workspace (%d inputs, ws %zu, need %zu)\n", n_in, ws_size, (size_t)WS_END); grid = -1; return; }
        int dev = 0, cus = 0, per_cu = 0;
        if (hipGetDevice(&dev) != hipSuccess || hipDeviceGetAttribute(&cus, hipDeviceAttributeMultiprocessorCount, dev) != hipSuccess) { grid = -1; return; }
        if (hipFuncSetAttribute((const void*)mega_fwd, hipFuncAttributeMaxDynamicSharedMemorySize, LDS_BYTES) != hipSuccess) { fprintf(stderr, "kernel_launch: hipFuncSetAttribute failed\n"); grid = -1; return; }
        if (hipOccupancyMaxActiveBlocksPerMultiprocessor(&per_cu, (const void*)mega_fwd, NWAVES * 64, LDS_BYTES) != hipSuccess || per_cu < 1) fprintf(stderr, "kernel_launch: note: occupancy query says %d\n", per_cu);
        (void)hipGetLastError();
        grid = cus < 256 ? cus : 256;
        if (grid != 256) fprintf(stderr, "kernel_launch: %d CUs; this kernel is built for 256\n", cus);
    }
    if (grid < 0) return;
    unsigned char* ws = (unsigned char*)d_ws; float* out = (float*)d_out;
    constexpr int UPTO = MEGA_UPTO;
    static_assert(UPTO == 15, "the plain reference kernels of the transition builds are gone: all 15 phases run in the persistent kernel");
    if (UPTO > 0) {
        if (hipMemsetAsync(ws + WS_CTL, 0, CTL_ZERO_BYTES, stream) != hipSuccess) { fprintf(stderr, "kernel_launch: memset failed\n"); return; }
        Args a{};
        for (int i = 0; i < 19; ++i) a.in[i] = (const float*)d_in[i];
        a.out = out; a.wsp = ws;
        a.jobmask = UPTO >= 15 ? 255 : UPTO >= 10 ? 63 : UPTO >= 7 ? 31 : UPTO >= 6 ? 15 : 3;
        if (MEGA_ONE) { a.ph_lo = 0; a.ph_hi = UPTO; a.li = 0; hipLaunchKernelGGL(mega_fwd, dim3(grid), dim3(NWAVES * 64), LDS_BYTES, stream, a); }
        else for (int p = 0; p < UPTO; ++p) { a.ph_lo = p; a.ph_hi = p + 1; a.li = 0; for (int r = 0; r <= ((MEGA_REPMASK >> p) & 1); ++r) hipLaunchKernelGGL(mega_fwd, dim3(grid), dim3(NWAVES * 64), LDS_BYTES, stream, a); }
        const hipError_t le = hipPeekAtLastError();
        if (le != hipSuccess) fprintf(stderr, "kernel_launch: launch failed: %s\n", hipGetErrorName(le));
    }
}
```

```cpp
#include <hip/hip_runtime.h>
#include <hip/hip_bf16.h>
#include <stdint.h>
#include <stdio.h>
#include <cmath>
#define MEGA_UPTO 15
#define MEGA_ONE 1
typedef unsigned short bf16_t;
typedef short bf16x8 __attribute__((ext_vector_type(8)));
typedef float f32x4 __attribute__((ext_vector_type(4)));
constexpr int D = 1024, BATCH = 8, SEQ = 2048, M = BATCH * SEQ;
constexpr int NH = 8, HD = 64, VD = 128;
constexpr int DFF = 2816, NE = 8, DFE = 3584;
constexpr float EPS = 1e-6f;
constexpr float LAM_INIT = 0.35550907f;
constexpr int SLOTS = 2 * M + NE * 256;

__device__ __forceinline__ unsigned f2bf(float f) { unsigned u = __builtin_bit_cast(unsigned, f); return (u + 0x7fffu + ((u >> 16) & 1u)) >> 16; }
__device__ __forceinline__ float bf2f(unsigned short b) { return __builtin_bit_cast(float, (unsigned)b << 16); }
__device__ __forceinline__ float wave_sum(float v) {
#pragma unroll
    for (int o = 1; o < 64; o <<= 1) v += __shfl_xor(v, o);
    return v;
}

namespace pg8 {
#define PG8_LAS __attribute__((address_space(3)))
typedef unsigned short bf16_t;
typedef short bf16x8 __attribute__((ext_vector_type(8)));
typedef float f32x4 __attribute__((ext_vector_type(4)));
typedef unsigned u32x4 __attribute__((ext_vector_type(4)));
typedef int i32x4 __attribute__((ext_vector_type(4)));
typedef int i32x8 __attribute__((ext_vector_type(8)));
constexpr int BM = 256, BK = 64, HALF = 128, HTB = HALF * BK * 2  , STAGE_BYTES = 8 * HTB, NXCD = 8, WGM = 8;

__host__ __device__ __forceinline__ int lds_byte(int r, int c) { const int st = (r >> 4) * 2 + (c >> 5), rr = r & 15, cc = c & 31, ob = rr * 64 + cc * 2; return st * 1024 + (ob ^ (((ob >> 9) & 1) << 5)); }
__host__ __device__ __forceinline__ void stage_rc(int b, int& R, int& C) { const int st = b / 1024, sb = b % 1024, swz = sb ^ (((sb >> 9) & 1) << 5); R = (st >> 1) * 16 + swz / 64; C = (st & 1) * 32 + (swz % 64) / 2; }
__host__ __device__ __forceinline__ int perm32(int rho) { const int n = rho >> 4, i = rho & 15; return 8 * (i >> 2) + 4 * n + (i & 3); }

struct Unit { int pm, pn; int kt0, nkt, aux; };
struct Gemm { const bf16_t* A; const bf16_t* Bt; int M, N, K; };

struct StaticOrder {
    int nM, nN, nwg, G, c;
    __host__ __device__ void init(int M, int N, int G_, int c_) { nM = M / BM; nN = N / BM; nwg = nM * nN; G = G_; c = c_; }
    __host__ __device__ bool next(int i, Unit& u) const {
        const long L = (long)i * G + c; if (L >= nwg) return false;
        int wgid = (int)L; { const int q = nwg / NXCD, r = nwg % NXCD, xcd = wgid % NXCD, off = wgid / NXCD; wgid = (xcd < r ? xcd * (q + 1) : r * (q + 1) + (xcd - r) * q) + off; }
        const int nig = WGM * nN, gid = wgid / nig, fm = gid * WGM, gsz = (nM - fm) < WGM ? (nM - fm) : WGM;
        u.pm = fm + ((wgid % nig) % gsz); u.pn = (wgid % nig) / gsz; u.kt0 = 0; u.nkt = 0; u.aux = -1; return true;
    }
    __device__ __forceinline__ void a_ready(const Unit&) const {}
    __device__ __forceinline__ void done(const Unit&) const {}
};

__device__ __forceinline__ unsigned cvt_pk_bf16(float lo, float hi) { unsigned r; asm volatile("v_cvt_pk_bf16_f32 %0, %1, %2" : "=v"(r) : "v"(lo), "v"(hi)); return r; }
typedef float f32x2 __attribute__((ext_vector_type(2)));
typedef unsigned u32x2 __attribute__((ext_vector_type(2)));
constexpr float RMS_EPS = 1e-6f, LOG2E = 1.4426950408889634f;
constexpr int DM_ = 1024;
__device__ __forceinline__ u32x4 pack8(const f32x4 a, const f32x4 b) { u32x4 w; w.x = cvt_pk_bf16(a[0], a[1]); w.y = cvt_pk_bf16(a[2], a[3]); w.z = cvt_pk_bf16(b[0], b[1]); w.w = cvt_pk_bf16(b[2], b[3]); return w; }
__device__ __forceinline__ float rstd_of(const float* ssq, int row) { const f32x4 p = *(const f32x4*)(ssq + (size_t)row * 4); return __builtin_amdgcn_rsqf(((p[0] + p[1]) + (p[2] + p[3])) * (1.0f / 1024.0f) + RMS_EPS); }
__device__ __forceinline__ float silu_mul(float g, float u) { return g * u * __builtin_amdgcn_rcpf(1.0f + __builtin_amdgcn_exp2f(-g * LOG2E)); }
__device__ __forceinline__ f32x2 swiglu2(f32x2 a, f32x2 b, float c1, float k) {
    const f32x2 t = a * c1; f32x2 e; e.x = __builtin_amdgcn_exp2f(t.x); e.y = __builtin_amdgcn_exp2f(t.y);
    const f32x2 d = e * k + k; f32x2 r; r.x = __builtin_amdgcn_rcpf(d.x); r.y = __builtin_amdgcn_rcpf(d.y);
    return (a * b) * r;
}

__device__ __forceinline__ float clamp448(float x) { return __builtin_amdgcn_fmed3f(x, -448.0f, 448.0f); }
__device__ __forceinline__ unsigned pk4_fp8(float a, float b, float c, float d) { int w = 0; w = __builtin_amdgcn_cvt_pk_fp8_f32(clamp448(a), clamp448(b), w, false); w = __builtin_amdgcn_cvt_pk_fp8_f32(clamp448(c), clamp448(d), w, true); return (unsigned)w; }
constexpr float F8_SA = 4.0f, F8_SWG = 256.0f, F8_SH = 8.0f, F8_SWD = 512.0f;
constexpr float F8_SHD = 8.0f, F8_SWDD = 256.0f;

struct EpiInProj {
    static constexpr bool PERM = true, AFTER_DRAIN = false;
    bf16_t* Bb; bf16_t* Ub;
    __device__ __forceinline__ void operator()(const f32x4 (&acc)[2][2][4][2], const Unit& u, int wr, int wc, int fr, int fq) const {
        const int row0 = u.pm * BM + wr * 64 + fr;
        if (u.pn < 4) {
            const int col0 = u.pn * BM + wc * 32 + 8 * fq;
#pragma unroll
            for (int ai = 0; ai < 2; ++ai)
#pragma unroll
                for (int m = 0; m < 4; ++m) { bf16_t* rowp = Bb + (size_t)(row0 + ai * HALF + m * 16) * DM_ + col0;
#pragma unroll
                    for (int bj = 0; bj < 2; ++bj) *(u32x4*)(rowp + bj * HALF) = pack8(acc[ai][bj][m][0], acc[ai][bj][m][1]); }
        } else {
            const int col0 = (u.pn - 4) * 128 + wc * 32 + 8 * fq;
#pragma unroll
            for (int ai = 0; ai < 2; ++ai)
#pragma unroll
                for (int m = 0; m < 4; ++m) { bf16_t* rowp = Ub + (size_t)(row0 + ai * HALF + m * 16) * DM_ + col0;
                    *(u32x4*)rowp = pack8(acc[ai][0][m][0] * acc[ai][1][m][0], acc[ai][0][m][1] * acc[ai][1][m][1]); }
        }
    }
};

template <bool FIRST> struct EpiResidSsq {
    static constexpr bool PERM = false, AFTER_DRAIN = true;
    const float* x0; bf16_t* xb; float* ssq; float ascale;
    __device__ __forceinline__ void fused(f32x4 (&acc)[2][2][4][2], const Unit& u, int wr, int wc, int fr, int fq, PG8_LAS unsigned char* lds, int wid, int lane) const {
        PG8_LAS float* P = (PG8_LAS float*)lds;
        const int col0 = u.pn * BM + wc * 32 + 4 * fq;
#pragma unroll
        for (int ai = 0; ai < 2; ++ai) {
            f32x4 xo[4][2][2];
#pragma unroll
            for (int m = 0; m < 4; ++m) { const int r = ai * HALF + wr * 64 + m * 16 + fr; const size_t off = (size_t)(u.pm * BM + r) * DM_ + col0;
#pragma unroll
                for (int bj = 0; bj < 2; ++bj)
#pragma unroll
                    for (int n = 0; n < 2; ++n) {
                        if constexpr (FIRST) xo[m][bj][n] = *(const f32x4*)(x0 + off + bj * HALF + n * 16);
                        else { const u32x2 w = *(const u32x2*)(xb + off + bj * HALF + n * 16); xo[m][bj][n] = (f32x4){__builtin_bit_cast(float, w.x << 16), __builtin_bit_cast(float, w.x & 0xffff0000u), __builtin_bit_cast(float, w.y << 16), __builtin_bit_cast(float, w.y & 0xffff0000u)}; } } }
#pragma unroll
            for (int m = 0; m < 4; ++m) { const int r = ai * HALF + wr * 64 + m * 16 + fr; const size_t off = (size_t)(u.pm * BM + r) * DM_ + col0; float s = 0.f;
#pragma unroll
                for (int bj = 0; bj < 2; ++bj)
#pragma unroll
                    for (int n = 0; n < 2; ++n) { const f32x4 v = xo[m][bj][n] + acc[ai][bj][m][n] * ascale;
                        u32x2 w; w.x = cvt_pk_bf16(v[0], v[1]); w.y = cvt_pk_bf16(v[2], v[3]); *(u32x2*)(xb + off + bj * HALF + n * 16) = w;
                        s += (v[0] * v[0] + v[1] * v[1]) + (v[2] * v[2] + v[3] * v[3]); }
                s += __shfl_xor(s, 16); s += __shfl_xor(s, 32);
                if (fq == 0) P[r * 4 + wc] = s; }
            asm volatile("" ::: "memory"); }
        asm volatile("s_waitcnt lgkmcnt(0)" ::: "memory"); __builtin_amdgcn_s_barrier(); asm volatile("" ::: "memory");
        const int t = wid * 64 + lane;
        if (t < 256) { const PG8_LAS f32x4* Pr = (const PG8_LAS f32x4*)lds; const f32x4 p = Pr[t]; ssq[(size_t)(u.pm * BM + t) * 4 + u.pn] = (p[0] + p[1]) + (p[2] + p[3]); }
        asm volatile("s_waitcnt lgkmcnt(0)" ::: "memory"); __builtin_amdgcn_s_barrier(); asm volatile("" ::: "memory");
    }
};

template <bool OUT8> struct EpiSwiGLU {
    static constexpr bool PERM = true, AFTER_DRAIN = false;
    void* H; int ldh; const float* ssq; const float* rstd; int ncol;
    __device__ __forceinline__ void operator()(const f32x4 (&acc)[2][2][4][2], const Unit& u, int wr, int wc, int fr, int fq) const {
        const int row0 = u.pm * BM + wr * 64 + fr, col0 = (u.pn % ncol) * 128 + wc * 32 + 8 * fq;
#pragma unroll
        for (int ai = 0; ai < 2; ++ai)
#pragma unroll
            for (int m = 0; m < 4; ++m) { const int row = row0 + ai * HALF + m * 16;
                float k; if (ssq) { const f32x4 p = *(const f32x4*)(ssq + (size_t)row * 4); k = ((p[0] + p[1]) + (p[2] + p[3])) * (1.0f / 1024.0f) + RMS_EPS; } else { const float r_ = rstd[row]; k = 1.0f / (r_ * r_); }
                const float c1 = -LOG2E * __builtin_amdgcn_rsqf(k);
                f32x4 h[2];
#pragma unroll
                for (int n = 0; n < 2; ++n) { const f32x4 a = acc[ai][0][m][n], b = acc[ai][1][m][n];
                    const f32x2 h0 = swiglu2((f32x2){a[0], a[1]}, (f32x2){b[0], b[1]}, c1, k), h1 = swiglu2((f32x2){a[2], a[3]}, (f32x2){b[2], b[3]}, c1, k);
                    h[n] = (f32x4){h0.x, h0.y, h1.x, h1.y}; }
                if constexpr (OUT8) { u32x2 w; w.x = pk4_fp8(h[0][0] * F8_SHD, h[0][1] * F8_SHD, h[0][2] * F8_SHD, h[0][3] * F8_SHD); w.y = pk4_fp8(h[1][0] * F8_SHD, h[1][1] * F8_SHD, h[1][2] * F8_SHD, h[1][3] * F8_SHD);
                    *(u32x2*)((unsigned char*)H + (size_t)row * ldh + col0) = w; }
                else *(u32x4*)((bf16_t*)H + (size_t)row * ldh + col0) = pack8(h[0], h[1]); }
    }
};

struct EpiQKV {
    static constexpr bool PERM = true, AFTER_DRAIN = false;
    bf16_t *Q, *K, *V; const float* ssq; const float* qg; const float* kg; float qscale;
    __device__ __forceinline__ void operator()(const f32x4 (&acc)[2][2][4][2], const Unit& u, int wr, int wc, int fr, int fq) const {
        const int row0 = u.pm * BM + wr * 64 + fr;
        if (u.pn < 8) {
            const bool isq = u.pn < 4; bf16_t* base = isq ? Q : K; const float* gn = isq ? qg : kg; const float sc = isq ? qscale : 1.0f;
            const int col0 = (4 * (u.pn & 3) + wc) * 64 + 8 * fq;
            f32x4 gv[2][2];
#pragma unroll
            for (int bj = 0; bj < 2; ++bj)
#pragma unroll
                for (int n = 0; n < 2; ++n) gv[bj][n] = *(const f32x4*)(gn + 32 * bj + 8 * fq + 4 * n);
#pragma unroll
            for (int ai = 0; ai < 2; ++ai)
#pragma unroll
                for (int m = 0; m < 4; ++m) { const int row = row0 + ai * HALF + m * 16; const float rs = rstd_of(ssq, row);
                    f32x4 v[2][2]; float ss = 0.f;
#pragma unroll
                    for (int bj = 0; bj < 2; ++bj)
#pragma unroll
                        for (int n = 0; n < 2; ++n) { v[bj][n] = acc[ai][bj][m][n] * rs; ss += (v[bj][n][0] * v[bj][n][0] + v[bj][n][1] * v[bj][n][1]) + (v[bj][n][2] * v[bj][n][2] + v[bj][n][3] * v[bj][n][3]); }
                    ss += __shfl_xor(ss, 16); ss += __shfl_xor(ss, 32);
                    const float r2 = __builtin_amdgcn_rsqf(ss * (1.0f / 64.0f) + RMS_EPS) * sc;
#pragma unroll
                    for (int bj = 0; bj < 2; ++bj) *(u32x4*)(base + (size_t)row * DM_ + col0 + 32 * bj) = pack8(v[bj][0] * r2 * gv[bj][0], v[bj][1] * r2 * gv[bj][1]); }
        } else {
            const int col0 = (u.pn - 8) * BM + wc * 32 + 8 * fq;
#pragma unroll
            for (int ai = 0; ai < 2; ++ai)
#pragma unroll
                for (int m = 0; m < 4; ++m) { const int row = row0 + ai * HALF + m * 16; const float rs = rstd_of(ssq, row);
#pragma unroll
                    for (int bj = 0; bj < 2; ++bj) *(u32x4*)(V + (size_t)row * DM_ + col0 + bj * HALF) = pack8(acc[ai][bj][m][0] * rs, acc[ai][bj][m][1] * rs); }
        }
    }
};

struct EpiSwiGLU8 {
    static constexpr bool PERM = true, AFTER_DRAIN = false;
    unsigned char* H; int ldh; int ncol;
    __device__ __forceinline__ void operator()(const f32x4 (&acc)[2][2][4][2], const Unit& u, int wr, int wc, int fr, int fq) const {
        const int row0 = u.pm * BM + wr * 64 + fr, col0 = (u.pn % ncol) * 128 + wc * 32 + 8 * fq; constexpr float cs = 1.0f / (F8_SA * F8_SWG);
#pragma unroll
        for (int ai = 0; ai < 2; ++ai)
#pragma unroll
            for (int m = 0; m < 4; ++m) { const int row = row0 + ai * HALF + m * 16; f32x4 h[2];
#pragma unroll
                for (int n = 0; n < 2; ++n) { const f32x4 a = acc[ai][0][m][n], b = acc[ai][1][m][n];
                    const f32x2 h0 = swiglu2((f32x2){a[0], a[1]}, (f32x2){b[0], b[1]}, -cs * LOG2E, 1.0f / (cs * cs * F8_SH)), h1 = swiglu2((f32x2){a[2], a[3]}, (f32x2){b[2], b[3]}, -cs * LOG2E, 1.0f / (cs * cs * F8_SH));
                    h[n] = (f32x4){h0.x, h0.y, h1.x, h1.y}; }
                u32x2 w; w.x = pk4_fp8(h[0][0], h[0][1], h[0][2], h[0][3]); w.y = pk4_fp8(h[1][0], h[1][1], h[1][2], h[1][3]);
                *(u32x2*)(H + (size_t)row * ldh + col0) = w; }
    }
};

struct EpiMoeDown {
    static constexpr bool PERM = true, AFTER_DRAIN = false;
    bf16_t* Y; const float* gate; float scale; float* Pp;
    __device__ __forceinline__ void operator()(const f32x4 (&acc)[2][2][4][2], const Unit& u, int wr, int wc, int fr, int fq) const {
        const int col0 = (u.pn & 3) * BM + wc * 32 + 8 * fq;
        if (u.aux >= 0) {
            float* base = Pp + ((size_t)u.aux * BM + wr * 64 + fr) * DM_ + col0;
#pragma unroll
            for (int ai = 0; ai < 2; ++ai)
#pragma unroll
                for (int m = 0; m < 4; ++m)
#pragma unroll
                    for (int bj = 0; bj < 2; ++bj) { float* p = base + (size_t)(ai * HALF + m * 16) * DM_ + bj * HALF; *(f32x4*)p = acc[ai][bj][m][0]; *(f32x4*)(p + 4) = acc[ai][bj][m][1]; }
            return; }
        const int row0 = u.pm * BM + wr * 64 + fr;
#pragma unroll
        for (int ai = 0; ai < 2; ++ai)
#pragma unroll
            for (int m = 0; m < 4; ++m) { const int row = row0 + ai * HALF + m * 16; const float gt = gate[row] * scale;
#pragma unroll
                for (int bj = 0; bj < 2; ++bj) *(u32x4*)(Y + (size_t)row * DM_ + col0 + bj * HALF) = pack8(acc[ai][bj][m][0] * gt, acc[ai][bj][m][1] * gt); }
    }
};

struct MoeOrder {
    int nM, nN, nwg, G, c, T, P0, npieces; int t1, t2, t3, t4, t5, t6, t7;
    static constexpr int SPL = 7, PKT = 4;
    __device__ __forceinline__ void init(const int* meta, int nN_, int G_, int c_, bool split) {
        T = meta[8]; nM = split ? meta[9] : T; nN = nN_; nwg = nM * nN; G = G_; c = c_; t1 = meta[1]; t2 = meta[2]; t3 = meta[3]; t4 = meta[4]; t5 = meta[5]; t6 = meta[6]; t7 = meta[7];
        P0 = ((nwg + G - 1) / G) * G; npieces = (T - nM) * nN * SPL; }
    __device__ __forceinline__ int expert_of(int pm) const { return (pm >= t1) + (pm >= t2) + (pm >= t3) + (pm >= t4) + (pm >= t5) + (pm >= t6) + (pm >= t7); }
    __device__ __forceinline__ bool next(int i, Unit& u) const {
        const long L = (long)i * G + c;
        if (L >= nwg) { const long q = L - P0; if (q < 0 || q >= npieces) return false;
            const int rt = (int)q / (nN * SPL), rem = (int)q % (nN * SPL), pnl = rem / SPL, kp = rem % SPL;
            u.pm = nM + rt; u.pn = expert_of(u.pm) * nN + pnl; u.kt0 = kp * PKT; u.nkt = PKT; u.aux = rt * SPL + kp; return true; }
        int wgid = (int)L; { const int q = nwg / NXCD, r = nwg % NXCD, xcd = wgid % NXCD, off = wgid / NXCD; wgid = (xcd < r ? xcd * (q + 1) : r * (q + 1) + (xcd - r) * q) + off; }
        const int nig = WGM * nN, gid = wgid / nig, fm = gid * WGM, gsz = (nM - fm) < WGM ? (nM - fm) : WGM;
        const int pm = fm + ((wgid % nig) % gsz), pnl = (wgid % nig) / gsz;
        u.pm = pm; u.pn = expert_of(pm) * nN + pnl; u.kt0 = 0; u.nkt = 0; u.aux = -1; return true;
    }
    __device__ __forceinline__ void a_ready(const Unit&) const {}
    __device__ __forceinline__ void done(const Unit&) const {}
};
template <class Epi, class Sched, bool ALIGN_EPI = false, bool SP2 = false, bool F8 = false>
__device__ __forceinline__ void gemm_phase(PG8_LAS unsigned char* lds, const Gemm g, const Sched& S, const Epi& E) {
    const int tid = threadIdx.x, wid = __builtin_amdgcn_readfirstlane(tid >> 6), lane = tid & 63, wr = wid >> 2, wc = wid & 3, fr = lane & 15, fq = lane >> 4;
    int K_ = g.K; asm volatile("" : "+s"(K_));
    const int K = K_, nt = K / BK;
    unsigned voffA[2], voffB[2];
#pragma unroll
    for (int i = 0; i < 2; ++i) { int R, C; stage_rc(tid * 16 + i * 8192, R, C); const int Rb = Epi::PERM ? ((R & ~31) + perm32(R & 31)) : R;
        voffA[i] = (unsigned)(R * K + C) * 2u; voffB[i] = (unsigned)(Rb * K + C) * 2u; }
    const size_t kstep = (size_t)(BK * 2);
    const size_t hstep = (size_t)HALF * K * 2;
    const size_t tstep = 2 * hstep;
    const unsigned ldsw = (unsigned)wid * 1024u;
    const int aoff = lds_byte(wr * 64 + fr, fq * 8), boff = lds_byte(wc * 32 + fr, fq * 8);
    constexpr int KSTEP = 1024;
#define PG8_SA(b, h) (((b) * 2 + (h)) * HTB)
#define PG8_SB(b, h) ((4 + (b) * 2 + (h)) * HTB)
#define PG8_STAGE(bufoff, gbase, voff) do { _Pragma("unroll") for (int _i = 0; _i < 2; ++_i) \
        __builtin_amdgcn_global_load_lds((const unsigned*)((const char*)(gbase) + (voff)[_i]), (PG8_LAS unsigned*)(lds + (bufoff) + ldsw + _i * 8192), 16, 0, 0); } while (0)
#define PG8_LDA(dst, b, h) do { _Pragma("unroll") for (int m = 0; m < 4; ++m) _Pragma("unroll") for (int k = 0; k < 2; ++k) dst[m][k] = *(const PG8_LAS bf16x8*)(lds + PG8_SA(b, h) + aoff + m * 2048 + k * KSTEP); } while (0)
#define PG8_LDB(dst, b, h) do { _Pragma("unroll") for (int n = 0; n < 2; ++n) _Pragma("unroll") for (int k = 0; k < 2; ++k) dst[n][k] = *(const PG8_LAS bf16x8*)(lds + PG8_SB(b, h) + boff + n * 2048 + k * KSTEP); } while (0)
#define PG8_CAT8(x) __builtin_shufflevector(__builtin_bit_cast(i32x4, (x)[0]), __builtin_bit_cast(i32x4, (x)[1]), 0, 1, 2, 3, 4, 5, 6, 7)
#define PG8_MMA(ai, bj, At, Bt) do { __builtin_amdgcn_s_setprio(1); _Pragma("unroll") for (int m = 0; m < 4; ++m) _Pragma("unroll") for (int n = 0; n < 2; ++n) { \
        if constexpr (F8) asm volatile("s_nop 1\n\tv_mfma_f32_16x16x128_f8f6f4 %0, %1, %2, %0" : "+v"(acc[ai][bj][m][n]) : "v"(PG8_CAT8(Bt[n])), "v"(PG8_CAT8(At[m]))); \
        else { _Pragma("unroll") for (int k = 0; k < 2; ++k) acc[ai][bj][m][n] = __builtin_amdgcn_mfma_f32_16x16x32_bf16(Bt[n][k], At[m][k], acc[ai][bj][m][n], 0, 0, 0); } } \
        __builtin_amdgcn_s_setprio(0); } while (0)
#define PG8_WAIT_V(n) asm volatile("s_waitcnt vmcnt(" #n ")" ::: "memory")
#define PG8_WAIT_L(n) asm volatile("s_waitcnt lgkmcnt(" #n ")" ::: "memory")
#define PG8_BAR __builtin_amdgcn_s_barrier()
#define PG8_SCHED __builtin_amdgcn_sched_barrier(0)
    Unit cur, nxt; int ui = 0;
    if (!S.next(0, cur)) return;
    f32x4 acc[2][2][4][2];
#pragma unroll
    for (int a = 0; a < 2; ++a)
#pragma unroll
        for (int b = 0; b < 2; ++b)
#pragma unroll
            for (int m = 0; m < 4; ++m)
#pragma unroll
                for (int n = 0; n < 2; ++n) acc[a][b][m][n] = (f32x4){0.f, 0.f, 0.f, 0.f};
    bf16x8 At[4][2], B0[2][2], B1[2][2];
    const char* cA = (const char*)g.A + (size_t)cur.pm * tstep + (size_t)cur.kt0 * kstep; const char* cB = (const char*)g.Bt + (size_t)cur.pn * tstep + (size_t)cur.kt0 * kstep;
    S.a_ready(cur);
    if constexpr (SP2) {
        PG8_STAGE(PG8_SB(0, 0), cB, voffB); PG8_STAGE(PG8_SB(0, 1), cB + hstep, voffB); PG8_STAGE(PG8_SA(0, 0), cA, voffA); PG8_STAGE(PG8_SA(0, 1), cA + hstep, voffA);
        if (wr == 1) PG8_BAR;
        PG8_WAIT_V(2); PG8_BAR;
        PG8_STAGE(PG8_SB(1, 0), cB + kstep, voffB); PG8_STAGE(PG8_SA(1, 0), cA + kstep, voffA); PG8_STAGE(PG8_SB(1, 1), cB + hstep + kstep, voffB);
        PG8_WAIT_V(6); PG8_BAR;
    } else {
        PG8_STAGE(PG8_SB(0, 0), cB, voffB); PG8_STAGE(PG8_SA(0, 0), cA, voffA); PG8_STAGE(PG8_SB(0, 1), cB + hstep, voffB); PG8_STAGE(PG8_SA(0, 1), cA + hstep, voffA);
        if (wr == 1) PG8_BAR;
        PG8_WAIT_V(4); PG8_BAR;
        PG8_STAGE(PG8_SB(1, 0), cB + kstep, voffB); PG8_STAGE(PG8_SA(1, 0), cA + kstep, voffA); PG8_STAGE(PG8_SB(1, 1), cB + hstep + kstep, voffB);
        PG8_WAIT_V(6); PG8_BAR;
    }
    for (;;) {
        const bool has_next = S.next(ui + 1, nxt);
        const char* nA = has_next ? (const char*)g.A + (size_t)nxt.pm * tstep + (size_t)nxt.kt0 * kstep : cA; const char* nB = has_next ? (const char*)g.Bt + (size_t)nxt.pn * tstep + (size_t)nxt.kt0 * kstep : cB;
        const int ntu = cur.nkt ? cur.nkt : nt;
        for (int t = 0; t < ntu; t += 2) {
            const bool last = (t == ntu - 2);
            const char* a1 = cA + (size_t)(t + 1) * kstep;
            const char* a2 = last ? nA : cA + (size_t)(t + 2) * kstep; const char* b2 = last ? nB : cB + (size_t)(t + 2) * kstep;
            const char* a3 = a2 + kstep; const char* b3 = b2 + kstep;
            if (last && has_next) S.a_ready(nxt);
            if constexpr (SP2) {
            PG8_LDB(B0, 0, 0); PG8_LDB(B1, 0, 1); PG8_SCHED; PG8_LDA(At, 0, 0); PG8_STAGE(PG8_SA(1, 1), a1 + hstep, voffA);
            PG8_WAIT_V(8); PG8_WAIT_L(0); PG8_BAR; PG8_MMA(0, 0, At, B0); PG8_MMA(0, 1, At, B1); PG8_BAR; PG8_SCHED;
            PG8_LDA(At, 0, 1); PG8_STAGE(PG8_SB(0, 0), b2, voffB); PG8_STAGE(PG8_SB(0, 1), b2 + hstep, voffB); PG8_STAGE(PG8_SA(0, 0), a2, voffA);
            PG8_WAIT_V(8); PG8_WAIT_L(0); PG8_BAR; PG8_MMA(1, 0, At, B0); PG8_MMA(1, 1, At, B1); PG8_BAR; PG8_SCHED;
            PG8_LDB(B0, 1, 0); PG8_LDB(B1, 1, 1); PG8_SCHED; PG8_LDA(At, 1, 0); PG8_STAGE(PG8_SA(0, 1), a2 + hstep, voffA);
            PG8_WAIT_V(8); PG8_WAIT_L(0); PG8_BAR; PG8_MMA(0, 0, At, B0); PG8_MMA(0, 1, At, B1); PG8_BAR; PG8_SCHED;
            PG8_LDA(At, 1, 1); PG8_STAGE(PG8_SB(1, 0), b3, voffB); PG8_STAGE(PG8_SB(1, 1), b3 + hstep, voffB); PG8_STAGE(PG8_SA(1, 0), a3, voffA);
            PG8_WAIT_V(8); PG8_WAIT_L(0); PG8_BAR; PG8_MMA(1, 0, At, B0); PG8_MMA(1, 1, At, B1); PG8_BAR; PG8_SCHED;
            } else {
            PG8_LDB(B0, 0, 0); PG8_SCHED; PG8_LDA(At, 0, 0); PG8_STAGE(PG8_SA(1, 1), a1 + hstep, voffA);
            PG8_WAIT_L(8); PG8_BAR; PG8_WAIT_L(0); PG8_MMA(0, 0, At, B0); PG8_BAR; PG8_SCHED;
            PG8_LDB(B1, 0, 1); PG8_STAGE(PG8_SB(0, 0), b2, voffB);
            PG8_BAR; PG8_WAIT_L(0); PG8_MMA(0, 1, At, B1); PG8_BAR;
            PG8_LDA(At, 0, 1); PG8_STAGE(PG8_SA(0, 0), a2, voffA);
            PG8_BAR; PG8_WAIT_L(0); PG8_MMA(1, 0, At, B0); PG8_BAR; PG8_SCHED;
            PG8_STAGE(PG8_SB(0, 1), b2 + hstep, voffB);
            PG8_WAIT_V(6); PG8_BAR; PG8_MMA(1, 1, At, B1); PG8_BAR;
            PG8_LDB(B0, 1, 0); PG8_SCHED; PG8_LDA(At, 1, 0); PG8_STAGE(PG8_SA(0, 1), a2 + hstep, voffA);
            PG8_WAIT_L(8); PG8_BAR; PG8_WAIT_L(0); PG8_MMA(0, 0, At, B0); PG8_BAR; PG8_SCHED;
            PG8_LDB(B1, 1, 1); PG8_STAGE(PG8_SB(1, 0), b3, voffB);
            PG8_BAR; PG8_WAIT_L(0); PG8_MMA(0, 1, At, B1); PG8_BAR;
            PG8_LDA(At, 1, 1); PG8_STAGE(PG8_SA(1, 0), a3, voffA);
            PG8_BAR; PG8_WAIT_L(0); PG8_MMA(1, 0, At, B0); PG8_BAR; PG8_SCHED;
            PG8_STAGE(PG8_SB(1, 1), b3 + hstep, voffB);
            PG8_WAIT_V(6); PG8_BAR; PG8_MMA(1, 1, At, B1); PG8_BAR;
            }
        }
        if constexpr (F8) asm volatile("s_nop 15\n\ts_nop 15" ::: "memory");
        if constexpr (ALIGN_EPI) { if (wr == 0) PG8_BAR; }
        if constexpr (!Epi::AFTER_DRAIN) { E(acc, cur, wr, wc, fr, fq); S.done(cur); }
        if (!has_next) break;
#pragma unroll
        for (int a = 0; a < 2; ++a)
#pragma unroll
            for (int b = 0; b < 2; ++b)
#pragma unroll
                for (int m = 0; m < 4; ++m)
#pragma unroll
                    for (int n = 0; n < 2; ++n) acc[a][b][m][n] = (f32x4){0.f, 0.f, 0.f, 0.f};
        cur = nxt; cA = nA; cB = nB; ++ui;
        if constexpr (ALIGN_EPI) { if (wr == 1) PG8_BAR; }
    }
    PG8_WAIT_V(0);
    if constexpr (!ALIGN_EPI) { if (wr == 0) PG8_BAR; }
    PG8_BAR;
    if constexpr (Epi::AFTER_DRAIN) { E.fused(acc, cur, wr, wc, fr, fq, lds, wid, lane); S.done(cur); }
#undef PG8_SA
#undef PG8_SB
#undef PG8_STAGE
#undef PG8_LDA
#undef PG8_LDB
#undef PG8_MMA
#undef PG8_CAT8
#undef PG8_WAIT_V
#undef PG8_WAIT_L
#undef PG8_BAR
#undef PG8_SCHED
}
}
#include <hip/hip_bf16.h>
#include <cmath>
namespace attn_body {
using bf16=__hip_bfloat16;
using bf16x8=__attribute__((ext_vector_type(8)))short;
using s16x4=__attribute__((ext_vector_type(4)))short;
using f32x16=__attribute__((ext_vector_type(16)))float;
using u32x4=__attribute__((ext_vector_type(4)))unsigned;
constexpr int BATCH=8,NHEAD=16,SEQ=2048,D=64,DM=NHEAD*D;
constexpr int NW=8,QBLK=32,QB=QBLK*NW,KVBLK=64,NQB=SEQ/QB;
constexpr int ATTN_PITCH=DM, ATTN_UNIT_ROWS=QB;
__device__ __forceinline__ int crow(int r,int hi){return (r&3)+8*(r>>2)+4*hi;}
#define SBAR() __builtin_amdgcn_sched_barrier(0)
__device__ __forceinline__ void cmask(f32x16&p0,f32x16&p1,int jb,int qrel,int hi){
  const float NEG=-INFINITY; int kb=64*jb+4*hi;
  #pragma unroll
  for(int r=0;r<16;++r){int kv=kb+(r&3)+8*(r>>2); if(kv>qrel)p0[r]=NEG; if(kv+32>qrel)p1[r]=NEG;}
}

constexpr int NSLOT=3, SLOTB=8192;
constexpr int LDS_K=0, LDS_V=NSLOT*SLOTB, LDS_WS=2*NSLOT*SLOTB, LDS_OST=LDS_WS+NW*64*4, LDS_BYTES=LDS_OST+NW*4096;
constexpr float C2=0.125f*1.4426950408889634f;
__device__ __forceinline__ void glds16(const void*gsrc,unsigned lds_dst){unsigned keep;
  asm volatile("s_mov_b32 %0, m0\n\ts_mov_b32 m0, %2\n\ts_nop 0\n\tglobal_load_lds_dwordx4 %1, off\n\ts_mov_b32 m0, %0":"=&s"(keep):"v"(gsrc),"s"(lds_dst):"memory");}
__device__ __forceinline__ float max3f(float a,float b,float c){float r;asm("v_max3_f32 %0, %1, %2, %3":"=v"(r):"v"(a),"v"(b),"v"(c));return r;}
__device__ __forceinline__ float max2f(float a,float b){float r;asm("v_max_f32_e32 %0, %1, %2":"=v"(r):"v"(a),"v"(b));return r;}
__device__ __forceinline__ float fadd_s(float a,float b){float r;asm("v_add_f32_e32 %0, %1, %2":"=v"(r):"v"(a),"v"(b));return r;}
__device__ __forceinline__ float fsub_s(float a,float b){float r;asm("v_sub_f32_e32 %0, %1, %2":"=v"(r):"v"(a),"v"(b));return r;}
typedef float f32x2_t __attribute__((ext_vector_type(2))); typedef __bf16 bf16x2_t __attribute__((ext_vector_type(2)));
__device__ __forceinline__ unsigned cvtpk_s(float lo,float hi){f32x2_t v={lo,hi};bf16x2_t b=__builtin_convertvector(v,bf16x2_t);return __builtin_bit_cast(unsigned,b);}
#define WAIT_BAR(N) asm volatile("s_waitcnt vmcnt(" #N ") lgkmcnt(0)\n\ts_barrier":::"memory")

__device__ __forceinline__ void qkt(f32x16&p0,f32x16&p1,const char*Kslot,const bf16x8*qr,const f32x16&negm,int r32,int hi){
  const char*kb=Kslot+hi*1024+r32*16;
  #pragma unroll
  for(int d0=0;d0<4;++d0){
    const bf16x8 b0=*reinterpret_cast<const bf16x8*>(kb+d0*2048);
    const bf16x8 b1=*reinterpret_cast<const bf16x8*>(kb+d0*2048+512);
    if(d0==0){p0=__builtin_amdgcn_mfma_f32_32x32x16_bf16(b0,qr[0],negm,0,0,0);p1=__builtin_amdgcn_mfma_f32_32x32x16_bf16(b1,qr[0],negm,0,0,0);}
    else{p0=__builtin_amdgcn_mfma_f32_32x32x16_bf16(b0,qr[d0],p0,0,0,0);p1=__builtin_amdgcn_mfma_f32_32x32x16_bf16(b1,qr[d0],p1,0,0,0);}}
}
typedef __attribute__((address_space(3))) const char* lds_cptr;
typedef short v4i16_t __attribute__((ext_vector_type(4)));
__device__ __forceinline__ void kload8(bf16x8*kf,lds_cptr kp){
  kf[0]=*(const __attribute__((address_space(3))) bf16x8*)(kp);      kf[1]=*(const __attribute__((address_space(3))) bf16x8*)(kp+512);
  kf[2]=*(const __attribute__((address_space(3))) bf16x8*)(kp+2048); kf[3]=*(const __attribute__((address_space(3))) bf16x8*)(kp+2560);
  kf[4]=*(const __attribute__((address_space(3))) bf16x8*)(kp+4096); kf[5]=*(const __attribute__((address_space(3))) bf16x8*)(kp+4608);
  kf[6]=*(const __attribute__((address_space(3))) bf16x8*)(kp+6144); kf[7]=*(const __attribute__((address_space(3))) bf16x8*)(kp+6656);
}
__device__ __forceinline__ void kload2(bf16x8*kf,lds_cptr kp,int j){ kf[2*j]=*(const __attribute__((address_space(3))) bf16x8*)(kp+j*2048); kf[2*j+1]=*(const __attribute__((address_space(3))) bf16x8*)(kp+j*2048+512); }
__device__ __forceinline__ s16x4 vtr(lds_cptr p){ return __builtin_bit_cast(s16x4,__builtin_amdgcn_ds_read_tr16_b64_v4i16((__attribute__((address_space(3))) v4i16_t*)p)); }
__device__ __forceinline__ float rowmax(const f32x16&p0,const f32x16&p1){
  float a=max3f(p0[0],p0[1],p1[0]),b=max3f(p0[2],p0[3],p1[1]);a=max3f(a,p1[2],p1[3]);
  #pragma unroll
  for(int r=4;r<16;r+=4){a=max3f(a,p0[r],p0[r+1]);b=max3f(b,p0[r+2],p0[r+3]);a=max3f(a,p1[r],p1[r+1]);b=max3f(b,p1[r+2],p1[r+3]);}
  const float m=max2f(a,b);
  auto rr=__builtin_amdgcn_permlane32_swap(__float_as_uint(m),__float_as_uint(m),false,false);
  return max2f(__uint_as_float(rr[0]),__uint_as_float(rr[1]));
}
__device__ __forceinline__ void pv(f32x16*o,int vb,bf16x8 pa0,bf16x8 pa1,bf16x8 pa2,bf16x8 pa3){
  #pragma unroll
  for(int d0=0;d0<2;++d0){s16x4 lo[4],hi[4];
    #pragma unroll
    for(int ks=0;ks<4;++ks){
      asm volatile("ds_read_b64_tr_b16 %0,%1 offset:%c2":"=&v"(lo[ks]):"v"(vb),"i"(d0*4096+ks*1024):"memory");
      asm volatile("ds_read_b64_tr_b16 %0,%1 offset:%c2":"=&v"(hi[ks]):"v"(vb),"i"(d0*4096+ks*1024+512):"memory");}
    asm volatile("s_waitcnt lgkmcnt(0)":::"memory");SBAR();
    #define PK(k) (bf16x8){lo[k][0],lo[k][1],lo[k][2],lo[k][3],hi[k][0],hi[k][1],hi[k][2],hi[k][3]}
    o[d0]=__builtin_amdgcn_mfma_f32_32x32x16_bf16(pa0,PK(0),o[d0],0,0,0);
    o[d0]=__builtin_amdgcn_mfma_f32_32x32x16_bf16(pa1,PK(1),o[d0],0,0,0);
    o[d0]=__builtin_amdgcn_mfma_f32_32x32x16_bf16(pa2,PK(2),o[d0],0,0,0);
    o[d0]=__builtin_amdgcn_mfma_f32_32x32x16_bf16(pa3,PK(3),o[d0],0,0,0);
    #undef PK
  }
}

#ifndef ATTN_STORE16
#define ATTN_STORE16(p,v) (*(u32x4*)(p)=(v))
#endif
template<int THRL> __device__ __forceinline__ void attn_unit(int b,int qcol,int vcol,int qb,const bf16*Q,const bf16*__restrict__ K,const bf16*__restrict__ V,bf16*O,char*shm){
  int tid_=threadIdx.x; asm volatile("":"+v"(tid_));
  const int tid=tid_,lane=tid&63,r32=lane&31,hi=lane>>5; const int wid=__builtin_amdgcn_readfirstlane(tid>>6);
  const long rowbase=(long)b*SEQ; const int q0=qb*QB;
  const bf16*Qw=Q+(rowbase+q0+wid*QBLK)*DM+qcol;
  const bf16*Kh=K+rowbase*DM+qcol,*Vh=V+rowbase*DM+vcol;
  const unsigned lds0=(unsigned)(uintptr_t)shm;
  float*wsf=(float*)(shm+LDS_WS)+wid*64;
  const bf16*ksrc=Kh+(long)lane*DM+wid*8;
  const bf16*vsrc=Vh+(long)(16*(wid&3)+(lane>>2))*DM+(wid>>2)*32+(lane&3)*8;
  const unsigned kdst=lds0+LDS_K+wid*1024, vdst=lds0+LDS_V+wid*1024;
  #define DMA_K(t,slot) glds16(ksrc+(long)(t)*KVBLK*DM,(unsigned)__builtin_amdgcn_readfirstlane(kdst+(slot)))
  #define DMA_V(t,slot) glds16(vsrc+(long)(t)*KVBLK*DM,(unsigned)__builtin_amdgcn_readfirstlane(vdst+(slot)))
  const int vb0=(int)(lds0+LDS_V)+((lane>>4)&1)*32+(lane&3)*8+(4*hi+((lane&15)>>2))*64;
  const char*Kbase=shm+LDS_K; bf16x8 kf[8];
  const lds_cptr shm3=(lds_cptr)shm; const lds_cptr kp0=shm3+LDS_K+hi*1024+r32*16; const lds_cptr vp0=shm3+LDS_V+((lane>>4)&1)*32+(lane&3)*8+(4*hi+((lane&15)>>2))*64;
  const int NT=(q0+QB)/KVBLK;
  DMA_K(0,0);DMA_V(0,0);DMA_K(1,SLOTB);
  bf16x8 qr[4];
  #pragma unroll
  for(int d0=0;d0<4;++d0)qr[d0]=*reinterpret_cast<const bf16x8*>(&Qw[(long)r32*DM+d0*16+hi*8]);
  float mhat=0.f,l_reg=0.f;f32x16 o[2];o[0]=f32x16{};o[1]=f32x16{};f32x16 negm=f32x16{};asm volatile("":"+v"(negm));
  const int qrel=wid*QBLK+r32;
  #define CMASK(P0,P1,t) do{int jb_=(t)-(NT-4); if(jb_>=0)cmask(P0,P1,jb_,qrel,hi);}while(0)
  bool resc=false;
  #define START(P0,P1) do{ const float rm=rowmax(P0,P1); resc=false; \
    { const float dl=rm; mhat=fadd_s(mhat,dl); \
      _Pragma("unroll") for(int r=0;r<16;++r){P0[r]=fsub_s(P0[r],dl);P1[r]=fsub_s(P1[r],dl);} \
      _Pragma("unroll") for(int r=0;r<16;++r)negm[r]=-mhat; asm volatile("":"+v"(negm)); } \
    _Pragma("unroll") for(int r=0;r<16;++r)P0[r]=__builtin_amdgcn_exp2f(P0[r]); }while(0)
  #define RESC() do{ if(resc){ asm volatile("s_waitcnt lgkmcnt(0)":::"memory"); \
      _Pragma("unroll") for(int d_=0;d_<2;++d_) _Pragma("unroll") for(int r=0;r<16;++r)o[d_][r]*=wsf[crow(r,hi)]; } }while(0)
  f32x16 pA0,pA1,pB0,pB1;
  int sl_prev=0,sl_cur=0,sl_next=SLOTB;
  #define ROT() do{sl_prev=sl_cur;sl_cur=sl_next;sl_next=(sl_next==(NSLOT-1)*SLOTB)?0:sl_next+SLOTB;}while(0)
  DMA_K(2,2*SLOTB);
  WAIT_BAR(3);
  qkt(pA0,pA1,Kbase,qr,negm,r32,hi);asm volatile("s_nop 15\n\ts_nop 7":"+v"(pA0),"+v"(pA1));CMASK(pA0,pA1,0);
  START(pA0,pA1);
  _Pragma("unroll") for(int r=0;r<16;++r)pA1[r]=__builtin_amdgcn_exp2f(pA1[r]);
  WAIT_BAR(0);
  DMA_K(3,0);DMA_V(1,SLOTB);
  ROT();
  kload8(kf,kp0+sl_cur);
  WAIT_BAR(2);
  s16x4 vlo[8],vhi[8]; u32x4 pw0,pw1,pw2,pw3;
  #define PKW(P,B) cvtpk_s(P[B],P[B+1])
  #define PAF(k) __builtin_bit_cast(bf16x8,pw##k)
  #define VFR(i) (bf16x8){vlo[i][0],vlo[i][1],vlo[i][2],vlo[i][3],vhi[i][0],vhi[i][1],vhi[i][2],vhi[i][3]}
  #define PIN(x) asm volatile("":"+v"(x))
  #define MX3(a,b,c) __builtin_fmaxf(__builtin_fmaxf((a),(b)),(c))
  #define GAPA(MF,A0,A1,A2,A3,W0,W1,PW) do{ MF; sacc+=A0; sacc+=A1; sacc+=A2; sacc+=A3; PIN(sacc); W0; W1; PIN(PW); SBAR(); }while(0)
  #define EX(v) __builtin_amdgcn_exp2f(v)
  #define GAPB(MF,X,B) do{ MF; X[B]=EX(X[B]); X[B+1]=EX(X[B+1]); X[B+2]=EX(X[B+2]); X[B+3]=EX(X[B+3]); PIN(X); SBAR(); }while(0)
  #define VRD(i) do{ vlo[i]=vtr(vp_+(((i)>>2)*4096+((i)&3)*1024)); vhi[i]=vtr(vp_+(((i)>>2)*4096+((i)&3)*1024+512)); }while(0)
  #define KRD(G,j) do{ if(G){ kload2(kf,kp0+sl_next,j); SBAR(); } }while(0)
  #define STEP(C0,C1,P0,P1,t,GK,GV,GL) do{ SBAR(); \
    const lds_cptr vp_=vp0+sl_prev; \
    VRD(0); SBAR(); float sacc=(P0[0]+P0[1]); \
    GAPA(C0=__builtin_amdgcn_mfma_f32_32x32x16_bf16(kf[0],qr[0],negm,0,0,0), P0[2],P0[3],P0[4],P0[5],     pw0[0]=PKW(P0,0), pw0[1]=PKW(P0,2), pw0); \
    VRD(4); SBAR(); GAPA(C1=__builtin_amdgcn_mfma_f32_32x32x16_bf16(kf[1],qr[0],negm,0,0,0), P0[6],P0[7],P0[8],P0[9],     pw0[2]=PKW(P0,4), pw0[3]=PKW(P0,6), pw0); \
    VRD(1); SBAR(); GAPA(C0=__builtin_amdgcn_mfma_f32_32x32x16_bf16(kf[2],qr[1],C0,0,0,0),   P0[10],P0[11],P0[12],P0[13], pw1[0]=PKW(P0,8), pw1[1]=PKW(P0,10), pw1); \
    VRD(5); SBAR(); GAPA(C1=__builtin_amdgcn_mfma_f32_32x32x16_bf16(kf[3],qr[1],C1,0,0,0),   P0[14],P0[15],P1[0],P1[1],   pw1[2]=PKW(P0,12),pw1[3]=PKW(P0,14), pw1); \
    VRD(2); SBAR(); GAPA(C0=__builtin_amdgcn_mfma_f32_32x32x16_bf16(kf[4],qr[2],C0,0,0,0),   P1[2],P1[3],P1[4],P1[5],     pw2[0]=PKW(P1,0), pw2[1]=PKW(P1,2), pw2); \
    VRD(6); SBAR(); GAPA(C1=__builtin_amdgcn_mfma_f32_32x32x16_bf16(kf[5],qr[2],C1,0,0,0),   P1[6],P1[7],P1[8],P1[9],     pw2[2]=PKW(P1,4), pw2[3]=PKW(P1,6), pw2); \
    VRD(3); SBAR(); GAPA(C0=__builtin_amdgcn_mfma_f32_32x32x16_bf16(kf[6],qr[3],C0,0,0,0),   P1[10],P1[11],P1[12],P1[13], pw3[0]=PKW(P1,8), pw3[1]=PKW(P1,10), pw3); \
    VRD(7); SBAR(); GAPA(C1=__builtin_amdgcn_mfma_f32_32x32x16_bf16(kf[7],qr[3],C1,0,0,0),   P1[14],P1[15],0.f,0.f,       pw3[2]=PKW(P1,12),pw3[3]=PKW(P1,14), pw3); \
    l_reg+=sacc; \
    if(GK){DMA_K((t)+3,sl_cur);} if(GV){DMA_V((t)+1,sl_next);} \
    CMASK(C0,C1,t); \
    { float a=MX3(C0[0],C0[1],C1[0]),b=MX3(C0[2],C0[3],C1[1]); a=MX3(a,C1[2],C1[3]); \
      _Pragma("unroll") for(int r=4;r<16;r+=4){a=MX3(a,C0[r],C0[r+1]);b=MX3(b,C0[r+2],C0[r+3]);a=MX3(a,C1[r],C1[r+1]);b=MX3(b,C1[r+2],C1[r+3]);} \
      float rm=__builtin_fmaxf(a,b); { auto rr=__builtin_amdgcn_permlane32_swap(__float_as_uint(rm),__float_as_uint(rm),false,false); rm=__builtin_fmaxf(__uint_as_float(rr[0]),__uint_as_float(rr[1])); } \
      resc=false; \
      if(__builtin_expect(__any(rm>(float)THRL),0)){ const float dl=__builtin_fmaxf(rm,0.f); mhat+=dl; \
        _Pragma("unroll") for(int r=0;r<16;++r){C0[r]-=dl;C1[r]-=dl;} \
        _Pragma("unroll") for(int r=0;r<16;++r)negm[r]=-mhat; asm volatile("":"+v"(negm)); \
        const float f=__builtin_amdgcn_exp2f(-dl); l_reg*=f; if(hi==0)wsf[r32]=f; resc=true; } } \
    SBAR(); \
    GAPB(o[0]=__builtin_amdgcn_mfma_f32_32x32x16_bf16(PAF(0),VFR(0),o[0],0,0,0), C0,0); \
    GAPB(o[1]=__builtin_amdgcn_mfma_f32_32x32x16_bf16(PAF(0),VFR(4),o[1],0,0,0), C0,4); \
    KRD(GL,0); GAPB(o[0]=__builtin_amdgcn_mfma_f32_32x32x16_bf16(PAF(1),VFR(1),o[0],0,0,0), C0,8); \
    KRD(GL,1); GAPB(o[1]=__builtin_amdgcn_mfma_f32_32x32x16_bf16(PAF(1),VFR(5),o[1],0,0,0), C0,12); \
    KRD(GL,2); GAPB(o[0]=__builtin_amdgcn_mfma_f32_32x32x16_bf16(PAF(2),VFR(2),o[0],0,0,0), C1,0); \
    KRD(GL,3); GAPB(o[1]=__builtin_amdgcn_mfma_f32_32x32x16_bf16(PAF(2),VFR(6),o[1],0,0,0), C1,4); \
    GAPB(o[0]=__builtin_amdgcn_mfma_f32_32x32x16_bf16(PAF(3),VFR(3),o[0],0,0,0), C1,8); \
    GAPB(o[1]=__builtin_amdgcn_mfma_f32_32x32x16_bf16(PAF(3),VFR(7),o[1],0,0,0), C1,12); \
    }while(0)
  int t=1;
  #undef CMASK
  #define CMASK(P0,P1,t) do{}while(0)
  for(;t+5<NT;t+=2){
    STEP(pB0,pB1,pA0,pA1,t,true,true,true);     WAIT_BAR(2); RESC(); ROT();
    STEP(pA0,pA1,pB0,pB1,t+1,true,true,true);   WAIT_BAR(2); RESC(); ROT();
  }
  #undef CMASK
  #define CMASK(P0,P1,t) do{int jb_=(t)-(NT-4); if(jb_>=0)cmask(P0,P1,jb_,qrel,hi);}while(0)
  #define ENDW(tt) do{ if((tt)+3<NT){WAIT_BAR(2);} else if((tt)+2<NT){WAIT_BAR(1);} else {WAIT_BAR(0);} }while(0)
  for(;t+1<NT;t+=2){
    STEP(pB0,pB1,pA0,pA1,t,(t+3<NT),(t+1<NT),(t+1<NT));       ENDW(t);   RESC(); ROT();
    STEP(pA0,pA1,pB0,pB1,t+1,(t+4<NT),(t+2<NT),(t+2<NT));     ENDW(t+1); RESC(); ROT();
  }
  STEP(pB0,pB1,pA0,pA1,NT-1,false,false,false); RESC();
  { float sacc=pB0[0]+pB0[1]; _Pragma("unroll") for(int r=2;r<16;++r)sacc+=pB0[r]; _Pragma("unroll") for(int r=0;r<16;++r)sacc+=pB1[r]; l_reg+=sacc;
    pw0=(u32x4){PKW(pB0,0),PKW(pB0,2),PKW(pB0,4),PKW(pB0,6)};pw1=(u32x4){PKW(pB0,8),PKW(pB0,10),PKW(pB0,12),PKW(pB0,14)};pw2=(u32x4){PKW(pB1,0),PKW(pB1,2),PKW(pB1,4),PKW(pB1,6)};pw3=(u32x4){PKW(pB1,8),PKW(pB1,10),PKW(pB1,12),PKW(pB1,14)};
    SBAR(); pv(o,vb0+sl_cur,PAF(0),PAF(1),PAF(2),PAF(3)); }
  #undef PKW
  #undef PAF
  #undef VFR
  #undef PIN
  #undef MX3
  #undef GAPA
  #undef GAPB
  #undef EX
  #undef VRD
  #undef KRD
  #undef STEP
  #undef ENDW
  {auto rr=__builtin_amdgcn_permlane32_swap(__float_as_uint(l_reg),__float_as_uint(l_reg),false,false);l_reg=__uint_as_float(rr[0])+__uint_as_float(rr[1]);}
  if(hi==0)wsf[32+r32]=l_reg;asm volatile("s_waitcnt lgkmcnt(0)":::"memory");
  float rli[16];
  #pragma unroll
  for(int r=0;r<16;++r)rli[r]=__builtin_amdgcn_rcpf(wsf[32+crow(r,hi)]);
  bf16*Ow=O+(rowbase+q0+wid*QBLK)*DM+vcol;
  { bf16*stg=(bf16*)(shm+LDS_OST)+wid*2048;
    #pragma unroll
    for(int r=0;r<16;++r){const int orow=crow(r,hi);
      #pragma unroll
      for(int d0=0;d0<2;++d0)stg[orow*64+d0*32+r32]=__float2bfloat16(o[d0][r]*rli[r]);}
    asm volatile("s_waitcnt lgkmcnt(0)":::"memory");
    #pragma unroll
    for(int i=0;i<4;++i){const int row=i*8+(lane>>3),ch=lane&7; const u32x4 v=*(const u32x4*)(stg+row*64+ch*8); ATTN_STORE16(Ow+(long)row*DM+ch*8,v);} }
  asm volatile("s_waitcnt lgkmcnt(0)\n\ts_barrier":::"memory");
  #undef DMA_K
  #undef DMA_V
  #undef CMASK
  #undef START
  #undef RESC
  #undef ROT
}
constexpr int ATTN_LDS_BYTES=LDS_BYTES;
#undef SBAR
#undef WAIT_BAR
}
constexpr int NWAVES = 8;
constexpr int NPH = 15;
constexpr size_t MiB = 1u << 20;
constexpr size_t WS_CTL = 0, CTL_ZERO_BYTES = 1 * MiB;
constexpr size_t WS_W_IN = 1 * MiB;
constexpr size_t WS_W_OUT = WS_W_IN + (size_t)3072 * 1024 * 2;
constexpr size_t WS_W_GU = WS_W_OUT + (size_t)1024 * 1024 * 2;
constexpr size_t WS_W_DN = WS_W_GU + (size_t)5632 * 1024 * 2;
constexpr size_t WS_W_QKV = WS_W_DN + (size_t)1024 * 2816 * 2;
constexpr size_t WS_W_O = WS_W_QKV + (size_t)3072 * 1024 * 2;
constexpr size_t WS_W_MGU = WS_W_O + (size_t)1024 * 1024 * 2;
constexpr size_t WS_W_MDN = WS_W_MGU + (size_t)8 * 7168 * 1024 * 2;
constexpr size_t WS_W_END = WS_W_MDN + (size_t)8 * 1024 * 3584 * 2;
constexpr size_t WS_R = 202 * MiB;
constexpr size_t ACT = (size_t)M * D * 2;
constexpr size_t WS_XN0 = WS_R, WS_BB = WS_R + ACT, WS_UB = WS_R + 2 * ACT, WS_G = WS_R + 3 * ACT;
constexpr size_t WS_HACT = WS_R;
constexpr size_t WS_Q = WS_R + 4 * ACT, WS_K = WS_R + 5 * ACT, WS_V = WS_R + 6 * ACT;
constexpr size_t WS_O0 = WS_R, WS_O1 = WS_R + ACT, WS_ON = WS_R + 2 * ACT;
constexpr size_t WS_HM = WS_R;
constexpr size_t WS_PP = WS_R + 128 * MiB;
constexpr size_t WS_S = 440 * MiB;
constexpr size_t WS_XG = WS_S, WS_Y = WS_S + 68 * MiB;
constexpr size_t WS_XB = 632 * MiB;
constexpr size_t WS_HB = 664 * MiB, WS_HB2 = 696 * MiB, WS_YF = 728 * MiB;
constexpr size_t WS_SMALL = 792 * MiB;
constexpr size_t WS_SSQ = WS_SMALL;
constexpr size_t WS_SEL = WS_SMALL + 256 * 1024, WS_GATE = WS_SEL + 128 * 1024, WS_TOKSLOT = WS_GATE + 128 * 1024;
constexpr size_t WS_RSTDS = WS_TOKSLOT + 128 * 1024, WS_GATES = WS_RSTDS + 256 * 1024;
constexpr size_t WS_HIST = WS_GATES + 256 * 1024, WS_META = WS_HIST + 16 * 1024;
constexpr size_t WS_NAIVE_SMALL = WS_SMALL + 2 * MiB;
constexpr size_t WS_END = 796 * MiB;
static_assert(WS_W_END <= WS_R && WS_R + (size_t)SLOTS * DFE * 2 <= WS_S && WS_Y + (size_t)SLOTS * D * 2 <= WS_XB && WS_V + ACT <= WS_S, "d_ws map");
constexpr int CW_TMO = 0, CW_CODE = 1, CW_BAR = 4096;
constexpr int MISC_OFF = 0, RING_OFF = 1024, RING_BYTES = 131072, LDS_BYTES = 147456;
constexpr int P0_SCR = 16640;

#define GAS __attribute__((address_space(1)))
#define LAS __attribute__((address_space(3)))
typedef unsigned v4u __attribute__((ext_vector_type(4)));
typedef unsigned v2u __attribute__((ext_vector_type(2)));
typedef GAS unsigned gu32;
#define RLX_AGENT __ATOMIC_RELAXED, __HIP_MEMORY_SCOPE_AGENT
#define LDS_WAIT() asm volatile("s_waitcnt lgkmcnt(0)" ::: "memory")
#define VM_WAIT() asm volatile("s_waitcnt vmcnt(0)" ::: "memory")
__device__ __forceinline__ unsigned pk2(float lo, float hi) { return f2bf(lo) | (f2bf(hi) << 16); }
__device__ __forceinline__ float bflo(unsigned w) { return __builtin_bit_cast(float, w << 16); }
__device__ __forceinline__ float bfhi(unsigned w) { return __builtin_bit_cast(float, w & 0xffff0000u); }

#define XB_TMO      128
#define XB_XCNT(j)  (256  + 64 * (j))
#define XB_XSUB(j)  (1280 + 64 * (j))
#define XB_XGEN(j)  (2304 + 64 * (j))
#define XB_TOP      3328
#define XB_TOPGEN   3392
#define XCD_BAR_WORDS 3456
#define XB_SPIN_CAP (1u << 18)

__device__ __forceinline__ unsigned xb_ld(unsigned* p)              { return __hip_atomic_load(p, __ATOMIC_RELAXED, __HIP_MEMORY_SCOPE_AGENT); }
__device__ __forceinline__ unsigned xb_add(unsigned* p, unsigned v) { return __hip_atomic_fetch_add(p, v, __ATOMIC_RELAXED, __HIP_MEMORY_SCOPE_AGENT); }
__device__ __forceinline__ unsigned xb_xcc_id() { return (unsigned)__builtin_amdgcn_s_getreg((3 << 11) | 20) & 0xFu; }
#define XB_SPIN(cond, bar) do { unsigned _sp = 0; while (cond) { __builtin_amdgcn_s_sleep(1); \
    if ((++_sp & 255u) == 0u) { if (xb_ld(&(bar)[XB_TMO])) break; if (_sp > XB_SPIN_CAP) { atomicAdd(&(bar)[XB_TMO], 1u); break; } } } } while (0)

struct XcdBarrier {
    unsigned* bar; unsigned x;
    volatile LAS unsigned* st;
};

__device__ __forceinline__ XcdBarrier xcd_barrier_post(unsigned* bar, volatile LAS unsigned* st) {
    XcdBarrier b; b.bar = bar; b.x = xb_xcc_id(); b.st = st;
    if (threadIdx.x == 0) (void)xb_add(&bar[XB_XCNT(b.x)], 1u);
    return b;
}
__device__ __forceinline__ void xcd_barrier_complete(unsigned* bar, unsigned x, unsigned& nloc, unsigned& nx) {
    const unsigned G = gridDim.x * gridDim.y * gridDim.z;
    unsigned sum, cnt, mine, sp = 0u;
    for (;;) {
        sum = 0u; cnt = 0u; mine = 0u;
#pragma unroll
        for (unsigned j = 0; j < 16; ++j) { const unsigned c = xb_ld(&bar[XB_XCNT(j)]); sum += c; cnt += (c > 0u) ? 1u : 0u; mine = (j == x) ? c : mine; }
        if (sum == G) break;
        __builtin_amdgcn_s_sleep(1);
        if ((++sp & 255u) == 0u) { if (xb_ld(&bar[XB_TMO])) break; if (sp > XB_SPIN_CAP) { atomicAdd(&bar[XB_TMO], 1u); break; } }
    }
    nloc = mine > 0u ? mine : 1u; nx = cnt > 0u ? cnt : 1u;
}

__device__ __forceinline__ void xcd_barrier(const XcdBarrier& b) {
    asm volatile("s_waitcnt vmcnt(0)" ::: "memory");
    __syncthreads();
    if (threadIdx.x == 0) {
        unsigned* bar = b.bar;
        __builtin_amdgcn_s_waitcnt(0);
        unsigned nloc = b.st[0], nx = b.st[1];
        if (nloc == 0u) { xcd_barrier_complete(bar, b.x, nloc, nx); b.st[0] = nloc; b.st[1] = nx; }
        const unsigned old = xb_add(&bar[XB_XSUB(b.x)], 1u);
        const unsigned gen = old / nloc;
        if (old + 1u == (gen + 1u) * nloc) {
            __builtin_amdgcn_fence(__ATOMIC_RELEASE, "agent");
            asm volatile("s_waitcnt vmcnt(0)" ::: "memory");
            const unsigned og = xb_add(&bar[XB_TOP], 1u);
            const unsigned tg = og / nx;
            if (og + 1u == (tg + 1u) * nx) xb_add(&bar[XB_TOPGEN], 1u);
            else XB_SPIN(xb_ld(&bar[XB_TOPGEN]) == tg, bar);
            __builtin_amdgcn_fence(__ATOMIC_ACQUIRE, "agent");
            xb_add(&bar[XB_XGEN(b.x)], 1u);
            asm volatile("s_waitcnt vmcnt(0)" ::: "memory");
        } else {
            XB_SPIN(xb_ld(&bar[XB_XGEN(b.x)]) == gen, bar);
            __builtin_amdgcn_fence(__ATOMIC_ACQUIRE, "agent");
            asm volatile("s_waitcnt vmcnt(0)" ::: "memory");
        }
    }
    __syncthreads();
}


struct Args { const float* in[19]; float* out; unsigned char* wsp; int ph_lo, ph_hi, li, jobmask; };
struct Frame { LAS unsigned char* lds; int tid, lane, wave, vcu, G; };
#define KA ((const Args*)__builtin_amdgcn_kernarg_segment_ptr())
#define INP(i) (KA->in[i])
#define A_WS (KA->wsp)
#define A_OUT (KA->out)

__device__ __forceinline__ int p0_dstrow(int mode, int aux, int col) {
    if (mode == 1) { if (col < 1024) return col; const int v = col >= 2048, cc = col - (v ? 2048 : 1024); return 1024 + 256 * (cc >> 7) + 128 * v + (cc & 127); }
    if (mode == 2) { const int up = col >= aux, cc = col - (up ? aux : 0); return 256 * (cc >> 7) + 128 * up + (cc & 127); }
    if (mode == 3) { const int g = col >> 6, bj = (col >> 5) & 1; return 256 * (g >> 2) + 32 * (4 * bj + (g & 3)) + (col & 31); }
    return col;
}
struct P0Item { const float* src; const float* gain; unsigned char* dst; int ldw, K, k0, d0, d1, f8; float sc; };
#define P0_JOB(SRC, LDW, KK, C0, NCOLS, GAIN, DSTOFF, DROW0, DSTROWS, MODE, AUX, NMAT, SC, F8) { \
    constexpr int nn_ = (NCOLS) / 64, per_ = ((KK) / 64) * nn_, cnt_ = per_ * (NMAT); \
    if (it < cnt_) { const int mat = it / per_, r = it % per_, kb = r / nn_, col = 64 * (r % nn_); \
        I.src = (SRC) + (size_t)mat * (KK) * (LDW) + (C0) + col; I.gain = (GAIN); I.dst = A_WS + (DSTOFF) + (size_t)mat * (DSTROWS) * (KK) * ((F8) ? 1 : 2); \
        I.ldw = (LDW); I.K = (KK); I.k0 = 64 * kb; I.d0 = (DROW0) + p0_dstrow(MODE, AUX, col); I.d1 = (DROW0) + p0_dstrow(MODE, AUX, col + 32); I.f8 = (F8); I.sc = (SC); return; } \
    it -= cnt_; }
constexpr int P0_NITEMS = 16 * 48 + 16 * 16 + 16 * 88 + 44 * 16 + 3 * 16 * 16 + 16 * 16 + 8 * 16 * 112 + 8 * 56 * 16;
__device__ __forceinline__ void p0_decode(int it, P0Item& I) {
    P0_JOB(INP(3), 3072, 1024, 0, 3072, nullptr, WS_W_IN, 0, 3072, 1, 0, 1, 1.0f, 0)
    P0_JOB(INP(5), 1024, 1024, 0, 1024, nullptr, WS_W_OUT, 0, 1024, 0, 0, 1, 1.0f, 0)
    P0_JOB(INP(14), 5632, 1024, 0, 5632, INP(2), WS_W_GU, 0, 5632, 2, 2816, 1, 1.0f, 0)
    P0_JOB(INP(15), 1024, 2816, 0, 1024, nullptr, WS_W_DN, 0, 1024, 0, 0, 1, pg8::F8_SWDD, 1)
    P0_JOB(INP(9), 1024, 1024, 0, 1024, INP(1) + 1024, WS_W_QKV, 0, 3072, 3, 0, 1, 1.0f, 0)
    P0_JOB(INP(7), 2048, 1024, 0, 1024, INP(6), WS_W_QKV, 1024, 3072, 3, 0, 1, 1.0f, 0)
    P0_JOB(INP(7), 2048, 1024, 1024, 1024, INP(6), WS_W_QKV, 2048, 3072, 0, 0, 1, 1.0f, 0)
    P0_JOB(INP(13), 1024, 1024, 0, 1024, nullptr, WS_W_O, 0, 1024, 0, 0, 1, 1.0f, 0)
    P0_JOB(INP(17), 7168, 1024, 0, 7168, INP(2) + 1024, WS_W_MGU, 0, 7168, 2, 3584, 8, pg8::F8_SWG, 1)
    P0_JOB(INP(18), 1024, 3584, 0, 1024, nullptr, WS_W_MDN, 0, 1024, 0, 0, 8, pg8::F8_SWD, 1)
}
#undef P0_JOB
struct P0Regs { f32x4 v[16]; float g[16]; };
__device__ __forceinline__ void p0_load(const P0Item& I, P0Regs& R, int lane) {
    const int lr = lane >> 4, lc = lane & 15;
#pragma unroll
    for (int i = 0; i < 16; ++i) R.v[i] = *(const GAS f32x4*)(I.src + (size_t)(I.k0 + 4 * i + lr) * I.ldw + 4 * lc);
    if (I.gain) {
#pragma unroll
        for (int i = 0; i < 16; ++i) R.g[i] = I.gain[I.k0 + 4 * i + lr];
    } else {
#pragma unroll
        for (int i = 0; i < 16; ++i) R.g[i] = 1.0f;
    }
}
__device__ __forceinline__ void p0_store(const P0Item& I, const P0Regs& R, LAS float* scr, int lane) {
    const int lr = lane >> 4, lc = lane & 15;
#pragma unroll
    for (int i = 0; i < 16; ++i) { const f32x4 w = R.v[i] * (R.g[i] * I.sc); LAS float* p = scr + (4 * i + lr) * 65 + 4 * lc; p[0] = w[0]; p[1] = w[1]; p[2] = w[2]; p[3] = w[3]; }
    LDS_WAIT(); asm volatile("" ::: "memory");
    const int c = lane & 7;
#pragma unroll
    for (int jj = 0; jj < 8; ++jj) { const int nl = 8 * jj + (lane >> 3); const LAS float* s = scr + (8 * c) * 65 + nl;
        const int drow = (jj < 4 ? I.d0 : I.d1 - 32) + nl;
        if (I.f8) { v2u o; o.x = pg8::pk4_fp8(s[0], s[65], s[130], s[195]); o.y = pg8::pk4_fp8(s[260], s[325], s[390], s[455]);
            *(GAS v2u*)(I.dst + (size_t)drow * I.K + I.k0 + 8 * c) = o; }
        else { v4u o; o.x = pk2(s[0], s[65]); o.y = pk2(s[130], s[195]); o.z = pk2(s[260], s[325]); o.w = pk2(s[390], s[455]);
            *(GAS v4u*)(I.dst + ((size_t)drow * I.K + I.k0 + 8 * c) * 2) = o; } }
    LDS_WAIT(); asm volatile("" ::: "memory");
}
__device__ __forceinline__ void rms_row_bf16(const float* xrow, const float* g, bf16_t* orow, int lane) {
    const GAS f32x4* xr = (const GAS f32x4*)xrow + lane; const GAS f32x4* gr = (const GAS f32x4*)g + lane;
    f32x4 v[4]; float s = 0.f;
#pragma unroll
    for (int j = 0; j < 4; ++j) { v[j] = xr[64 * j]; s += (v[j][0] * v[j][0] + v[j][1] * v[j][1]) + (v[j][2] * v[j][2] + v[j][3] * v[j][3]); }
    const float rstd = __builtin_amdgcn_rsqf(wave_sum(s) * (1.f / D) + EPS);
    GAS v2u* o8 = (GAS v2u*)orow + lane;
#pragma unroll
    for (int j = 0; j < 4; ++j) { const f32x4 gg = gr[64 * j]; v2u o; o.x = pk2(v[j][0] * rstd * gg[0], v[j][1] * rstd * gg[1]); o.y = pk2(v[j][2] * rstd * gg[2], v[j][3] * rstd * gg[3]); o8[64 * j] = o; }
}
__device__ __forceinline__ void p0_prologue(Frame& F) {
    const int gw = F.vcu * NWAVES + F.wave, NGW = F.G * NWAVES;
    {
        const float* x = INP(0); const float* g = INP(1); bf16_t* XN = (bf16_t*)(A_WS + WS_XN0);
        const GAS f32x4* gr = (const GAS f32x4*)g + F.lane; f32x4 gg[4];
#pragma unroll
        for (int j = 0; j < 4; ++j) gg[j] = gr[64 * j];
        for (int mb = gw; mb < M; mb += 4 * NGW) { f32x4 v[4][4];
#pragma unroll
            for (int i = 0; i < 4; ++i) { const int m = mb + i * NGW; if (m < M) { const GAS f32x4* xr = (const GAS f32x4*)(x + (size_t)m * D) + F.lane;
#pragma unroll
                for (int j = 0; j < 4; ++j) v[i][j] = xr[64 * j]; } }
#pragma unroll
            for (int i = 0; i < 4; ++i) { const int m = mb + i * NGW; if (m >= M) break; float s = 0.f;
#pragma unroll
                for (int j = 0; j < 4; ++j) s += (v[i][j][0] * v[i][j][0] + v[i][j][1] * v[i][j][1]) + (v[i][j][2] * v[i][j][2] + v[i][j][3] * v[i][j][3]);
                const float rstd = __builtin_amdgcn_rsqf(wave_sum(s) * (1.f / D) + EPS); GAS v2u* o8 = (GAS v2u*)(XN + (size_t)m * D) + F.lane;
#pragma unroll
                for (int j = 0; j < 4; ++j) { v2u o; o.x = pk2(v[i][j][0] * rstd * gg[j][0], v[i][j][1] * rstd * gg[j][1]); o.y = pk2(v[i][j][2] * rstd * gg[j][2], v[i][j][3] * rstd * gg[j][3]); o8[64 * j] = o; } } }
    }
    LAS float* scr = (LAS float*)(F.lds + RING_OFF + F.wave * P0_SCR);
    int it = gw; if (it >= P0_NITEMS) return;
    P0Item cur; P0Regs ra; p0_decode(it, cur); p0_load(cur, ra, F.lane);
    for (;;) { const int nit = it + NGW; const bool has = nit < P0_NITEMS; P0Item nx; P0Regs rb;
        if (has) { p0_decode(nit, nx); p0_load(nx, rb, F.lane); }
        p0_store(cur, ra, scr, F.lane);
        if (!has) break;
        cur = nx; ra = rb; it = nit; }
}

__device__ __forceinline__ void up8(const v4u w, float (&f)[8]) { f[0] = bflo(w.x); f[1] = bfhi(w.x); f[2] = bflo(w.y); f[3] = bfhi(w.y); f[4] = bflo(w.z); f[5] = bfhi(w.z); f[6] = bflo(w.w); f[7] = bfhi(w.w); }
__device__ __forceinline__ void p2_conv(Frame& F) {
    const bf16_t* Bb = (const bf16_t*)(A_WS + WS_BB); const bf16_t* Ub = (const bf16_t*)(A_WS + WS_UB); bf16_t* G = (bf16_t*)(A_WS + WS_G); const float* cw = INP(4);
    const int gw = F.vcu * NWAVES + F.wave, NGW = F.G * NWAVES;
    for (int strip = gw; strip < 2048; strip += NGW) {
        const int r0 = (strip >> 1) * 16, c0 = (strip & 1) * 512 + F.lane * 8;
        float w0[8], w1[8], w2[8], um2[8], um1[8];
#pragma unroll
        for (int j = 0; j < 8; ++j) { w0[j] = cw[c0 + j]; w1[j] = cw[D + c0 + j]; w2[j] = cw[2 * D + c0 + j]; um2[j] = 0.f; um1[j] = 0.f; }
        if ((r0 & (SEQ - 1)) != 0) { up8(*(const GAS v4u*)(Ub + (size_t)(r0 - 2) * D + c0), um2); up8(*(const GAS v4u*)(Ub + (size_t)(r0 - 1) * D + c0), um1); }
#pragma unroll
        for (int hb = 0; hb < 2; ++hb) { v4u ru[8], rb[8];
#pragma unroll
            for (int i = 0; i < 8; ++i) { ru[i] = *(const GAS v4u*)(Ub + (size_t)(r0 + 8 * hb + i) * D + c0); rb[i] = *(const GAS v4u*)(Bb + (size_t)(r0 + 8 * hb + i) * D + c0); }
#pragma unroll
            for (int ii = 0; ii < 8; ++ii) { const int i = 8 * hb + ii; float u[8], b[8]; up8(ru[ii], u); up8(rb[ii], b);
            float g[8];
#pragma unroll
            for (int j = 0; j < 8; ++j) { g[j] = b[j] * (w0[j] * um2[j] + w1[j] * um1[j] + w2[j] * u[j]); um2[j] = um1[j]; um1[j] = u[j]; }
            v4u o; o.x = pk2(g[0], g[1]); o.y = pk2(g[2], g[3]); o.z = pk2(g[4], g[5]); o.w = pk2(g[6], g[7]);
            *(GAS v4u*)(G + (size_t)(r0 + i) * D + c0) = o; } }
    }
}

__device__ __forceinline__ void p8_diff(Frame& F) {
    const bf16_t* O0 = (const bf16_t*)(A_WS + WS_O0); const bf16_t* O1 = (const bf16_t*)(A_WS + WS_O1); bf16_t* ON = (bf16_t*)(A_WS + WS_ON);
    const float* lp = INP(11); const float* sn = INP(12); const int lane = F.lane;
    const float lam = __expf(wave_sum(lp[lane] * lp[64 + lane])) - __expf(wave_sum(lp[128 + lane] * lp[192 + lane])) + LAM_INIT;
    float gn[16];
#pragma unroll
    for (int j = 0; j < 16; ++j) gn[j] = sn[16 * (lane & 7) + j] * (1.f - LAM_INIT);
    const int gw = F.vcu * NWAVES + F.wave, NGW = F.G * NWAVES;
    for (int rowb = gw; rowb < M; rowb += 4 * NGW) {
        v4u ra[4][2], rb[4][2];
#pragma unroll
        for (int i = 0; i < 4; ++i) { const int row = rowb + i * NGW; if (row < M) { const size_t off = (size_t)row * D + 16 * lane;
            ra[i][0] = *(const GAS v4u*)(O0 + off); ra[i][1] = *(const GAS v4u*)(O0 + off + 8); rb[i][0] = *(const GAS v4u*)(O1 + off); rb[i][1] = *(const GAS v4u*)(O1 + off + 8); } }
#pragma unroll
        for (int i = 0; i < 4; ++i) { const int row = rowb + i * NGW; if (row >= M) break; const size_t off = (size_t)row * D + 16 * lane;
            float a[16], a0[8], a1[8], b0[8], b1[8]; up8(ra[i][0], a0); up8(ra[i][1], a1); up8(rb[i][0], b0); up8(rb[i][1], b1);
            float s = 0.f;
#pragma unroll
            for (int j = 0; j < 8; ++j) { a[j] = a0[j] - lam * b0[j]; a[8 + j] = a1[j] - lam * b1[j]; s += a[j] * a[j] + a[8 + j] * a[8 + j]; }
            s += __shfl_xor(s, 1); s += __shfl_xor(s, 2); s += __shfl_xor(s, 4);
            const float rstd = __builtin_amdgcn_rsqf(s * (1.f / VD) + EPS);
            v4u o0, o1; o0.x = pk2(a[0] * rstd * gn[0], a[1] * rstd * gn[1]); o0.y = pk2(a[2] * rstd * gn[2], a[3] * rstd * gn[3]); o0.z = pk2(a[4] * rstd * gn[4], a[5] * rstd * gn[5]); o0.w = pk2(a[6] * rstd * gn[6], a[7] * rstd * gn[7]);
            o1.x = pk2(a[8] * rstd * gn[8], a[9] * rstd * gn[9]); o1.y = pk2(a[10] * rstd * gn[10], a[11] * rstd * gn[11]); o1.z = pk2(a[12] * rstd * gn[12], a[13] * rstd * gn[13]); o1.w = pk2(a[14] * rstd * gn[14], a[15] * rstd * gn[15]);
            *(GAS v4u*)(ON + off) = o0; *(GAS v4u*)(ON + off + 8) = o1; }
    }
}

#define TR_STEP(n, m) do { _Pragma("unroll") for (int i = 0; i < (n) / 2; ++i) { const bool up = (lane & (m)) != 0; const float keep = up ? v[i + (n) / 2] : v[i], send = up ? v[i] : v[i + (n) / 2]; v[i] = keep + __shfl_xor(send, (m)); } } while (0)
__device__ __forceinline__ void p10a_router(Frame& F) {
    const bf16_t* x3 = (const bf16_t*)(A_WS + WS_XB); const float* g = INP(2) + D; const float* Wr = INP(16); const float* ssq = (const float*)(A_WS + WS_SSQ);
    int* sel = (int*)(A_WS + WS_SEL); float* gate = (float*)(A_WS + WS_GATE); int* hist = (int*)(A_WS + WS_HIST);
    LAS f32x4* WL = (LAS f32x4*)(F.lds + RING_OFF);
    LAS int* lcnt = (LAS int*)(F.lds + RING_OFF + 32768);
    const int lane = F.lane;
    for (int k = F.tid; k < D; k += NWAVES * 64) { const float gk = g[k]; const f32x4 w0 = *(const GAS f32x4*)(Wr + (size_t)k * 8) * gk, w1 = *(const GAS f32x4*)(Wr + (size_t)k * 8 + 4) * gk;
        const int base = (((k >> 8) * 4 + (k & 3)) * 2) * 64 + ((k >> 2) & 63); WL[base] = w0; WL[base + 64] = w1; }
    LDS_WAIT(); __syncthreads();
    for (int blk = blockIdx.x; blk < M / 64; blk += F.G) {
        const int row0 = 64 * blk + 8 * F.wave;
        f32x4 xv[8][4];
#pragma unroll
        for (int r = 0; r < 8; ++r)
#pragma unroll
            for (int j = 0; j < 4; ++j) { const v2u w = *((const GAS v2u*)(x3 + (size_t)(row0 + r) * D) + lane + 64 * j); xv[r][j] = (f32x4){bflo(w.x), bfhi(w.x), bflo(w.y), bfhi(w.y)}; }
        float v[64];
#pragma unroll
        for (int i = 0; i < 64; ++i) v[i] = 0.f;
#pragma unroll
        for (int j = 0; j < 4; ++j)
#pragma unroll
            for (int q = 0; q < 4; ++q) { const f32x4 wa = WL[((j * 4 + q) * 2) * 64 + lane], wb = WL[((j * 4 + q) * 2 + 1) * 64 + lane];
#pragma unroll
                for (int r = 0; r < 8; ++r) { const float xx = xv[r][j][q];
                    v[r * 8 + 0] += xx * wa[0]; v[r * 8 + 1] += xx * wa[1]; v[r * 8 + 2] += xx * wa[2]; v[r * 8 + 3] += xx * wa[3];
                    v[r * 8 + 4] += xx * wb[0]; v[r * 8 + 5] += xx * wb[1]; v[r * 8 + 6] += xx * wb[2]; v[r * 8 + 7] += xx * wb[3]; } }
        TR_STEP(64, 32); TR_STEP(32, 16); TR_STEP(16, 8); TR_STEP(8, 4); TR_STEP(4, 2); TR_STEP(2, 1);
        float lg[8];
#pragma unroll
        for (int e = 0; e < 8; ++e) lg[e] = __shfl(v[0], (lane & ~7) | e);
        int i0 = 0; float v0 = lg[0];
#pragma unroll
        for (int e = 1; e < 8; ++e) if (lg[e] > v0) { v0 = lg[e]; i0 = e; }
        int i1 = 0; float v1 = -INFINITY;
#pragma unroll
        for (int e = 0; e < 8; ++e) if (e != i0 && lg[e] > v1) { v1 = lg[e]; i1 = e; }
        const int row = row0 + (lane >> 3); const float rs = pg8::rstd_of(ssq, row);
        const float g1 = 1.f / (1.f + expf((v0 - v1) * rs)); const bool wrt = (lane & 7) == 0;
        if (wrt) { sel[2 * row] = i0; sel[2 * row + 1] = i1; gate[2 * row] = 1.f - g1; gate[2 * row + 1] = g1; }
        int mycnt = 0;
#pragma unroll
        for (int e = 0; e < 8; ++e) { const int c = __popcll(__ballot(wrt && i0 == e)) + __popcll(__ballot(wrt && i1 == e)); if (lane == e) mycnt = c; }
        if (lane < 8) lcnt[F.wave * 8 + lane] = mycnt;
        LDS_WAIT(); __syncthreads();
        if (F.tid < 8) { int c = 0;
#pragma unroll
            for (int w = 0; w < 8; ++w) c += lcnt[w * 8 + F.tid];
            hist[blk * 8 + F.tid] = c; }
        LDS_WAIT(); __syncthreads();
    }
}
#undef TR_STEP
__device__ __forceinline__ void p10b_assign(Frame& F) {
    const int* hist = (const int*)(A_WS + WS_HIST); const int* sel = (const int*)(A_WS + WS_SEL); const float* gate = (const float*)(A_WS + WS_GATE); const float* ssq = (const float*)(A_WS + WS_SSQ);
    int* tok_slot = (int*)(A_WS + WS_TOKSLOT); float* gates = (float*)(A_WS + WS_GATES); int* meta = (int*)(A_WS + WS_META);
    const bf16_t* x3 = (const bf16_t*)(A_WS + WS_XB); unsigned char* XG = A_WS + WS_XG;
    LAS int* pre = (LAS int*)(F.lds + RING_OFF);
    LAS int* tot = pre + 2048;
    LAS int* ebase = tot + 8;
    LAS int* lslot = ebase + 8;
    const int lane = F.lane, e = F.wave;
    { int h[4], run = 0;
#pragma unroll
      for (int i = 0; i < 4; ++i) { h[i] = hist[(4 * lane + i) * 8 + e]; }
      const int mine = h[0] + h[1] + h[2] + h[3]; int inc = mine;
#pragma unroll
      for (int o = 1; o < 64; o <<= 1) { const int t = __shfl_up(inc, o); if (lane >= o) inc += t; }
      run = inc - mine;
#pragma unroll
      for (int i = 0; i < 4; ++i) { pre[(4 * lane + i) * 8 + e] = run; run += h[i]; }
      if (lane == 63) tot[e] = inc; }
    LDS_WAIT(); __syncthreads();
    if (F.tid == 0) { int b = 0; for (int k = 0; k < 8; ++k) { ebase[k] = b; if (blockIdx.x == 0) meta[k] = b >> 8; b += (tot[k] + 255) & ~255; } if (blockIdx.x == 0) { const int T = b >> 8, full = 2 * F.G / 4; meta[8] = T; meta[9] = T < full ? T : full; } }
    LDS_WAIT(); __syncthreads();
    for (int blk = blockIdx.x; blk < M / 64; blk += F.G) {
        if (F.wave == 0) { const int t = 64 * blk + lane; const int s0 = sel[2 * t], s1 = sel[2 * t + 1]; int sl0 = 0, sl1 = 0;
            const unsigned long long below = (1ull << lane) - 1ull;
#pragma unroll
            for (int k = 0; k < 8; ++k) { const unsigned long long m0 = __ballot(s0 == k), m1 = __ballot(s1 == k); const int b0 = ebase[k] + pre[blk * 8 + k];
                if (s0 == k) sl0 = b0 + __popcll(m0 & below); if (s1 == k) sl1 = b0 + __popcll(m0) + __popcll(m1 & below); }
            tok_slot[2 * t] = sl0; tok_slot[2 * t + 1] = sl1; lslot[2 * lane] = sl0; lslot[2 * lane + 1] = sl1;
            gates[sl0] = gate[2 * t]; gates[sl1] = gate[2 * t + 1]; }
        LDS_WAIT(); __syncthreads();
        v4u xw[8][2];
#pragma unroll
        for (int i = 0; i < 8; ++i) { const GAS v4u* xr = (const GAS v4u*)(x3 + (size_t)(64 * blk + 8 * F.wave + i) * D + 16 * lane); xw[i][0] = xr[0]; xw[i][1] = xr[1]; }
#pragma unroll
        for (int i = 0; i < 8; ++i) { const int tl = 8 * F.wave + i; const int t = 64 * blk + tl;
            const float rs = pg8::rstd_of(ssq, t) * pg8::F8_SA; float a[8], b[8]; up8(xw[i][0], a); up8(xw[i][1], b);
            v4u o; o.x = pg8::pk4_fp8(a[0] * rs, a[1] * rs, a[2] * rs, a[3] * rs); o.y = pg8::pk4_fp8(a[4] * rs, a[5] * rs, a[6] * rs, a[7] * rs); o.z = pg8::pk4_fp8(b[0] * rs, b[1] * rs, b[2] * rs, b[3] * rs); o.w = pg8::pk4_fp8(b[4] * rs, b[5] * rs, b[6] * rs, b[7] * rs);
            const int sl0 = lslot[2 * tl], sl1 = lslot[2 * tl + 1];
            *(GAS v4u*)(XG + (size_t)sl0 * D + 16 * lane) = o; *(GAS v4u*)(XG + (size_t)sl1 * D + 16 * lane) = o; }
        LDS_WAIT(); __syncthreads();
    }
}
__device__ __forceinline__ void p13_load_y(const bf16_t* Y, const float* Pp, const float* gates, int nfull, int slot, int lane, v2u (&y)[4]) {
    const int rt = (slot >> 8) - nfull;
    if (rt < 0) { const GAS v2u* yr = (const GAS v2u*)(Y + (size_t)slot * D) + lane;
#pragma unroll
        for (int j = 0; j < 4; ++j) y[j] = yr[64 * j];
    } else { const float gt = gates[slot] * (1.0f / (pg8::F8_SH * pg8::F8_SWD));
#pragma unroll
        for (int j = 0; j < 4; ++j) { f32x4 s = (f32x4){0.f, 0.f, 0.f, 0.f};
#pragma unroll
            for (int kp = 0; kp < pg8::MoeOrder::SPL; ++kp) s += *((const GAS f32x4*)(Pp + ((size_t)(rt * pg8::MoeOrder::SPL + kp) * 256 + (slot & 255)) * D) + lane + 64 * j);
            y[j].x = pk2(s[0] * gt, s[1] * gt); y[j].y = pk2(s[2] * gt, s[3] * gt); } }
}
__device__ __forceinline__ void p13_final(Frame& F) {
    const int* tok_slot = (const int*)(A_WS + WS_TOKSLOT); const bf16_t* Y = (const bf16_t*)(A_WS + WS_Y); const bf16_t* X3 = (const bf16_t*)(A_WS + WS_XB); float* out = A_OUT;
    const float* Pp = (const float*)(A_WS + WS_PP); const float* gates = (const float*)(A_WS + WS_GATES); const int nfull = ((const int*)(A_WS + WS_META))[9];
    const int gw = F.vcu * NWAVES + F.wave, NGW = F.G * NWAVES, lane = F.lane;
    for (int rowb = gw; rowb < M; rowb += 2 * NGW) {
        v2u xa[2][4], ya[2][4], yb[2][4];
#pragma unroll
        for (int i = 0; i < 2; ++i) { const int row = rowb + i * NGW; if (row < M) { const int s0 = tok_slot[2 * row], s1 = tok_slot[2 * row + 1];
            const GAS v2u* xr = (const GAS v2u*)(X3 + (size_t)row * D) + lane;
#pragma unroll
            for (int j = 0; j < 4; ++j) xa[i][j] = xr[64 * j];
            p13_load_y(Y, Pp, gates, nfull, s0, lane, ya[i]); p13_load_y(Y, Pp, gates, nfull, s1, lane, yb[i]); } }
#pragma unroll
        for (int i = 0; i < 2; ++i) { const int row = rowb + i * NGW; if (row >= M) break; GAS f32x4* orow = (GAS f32x4*)(out + (size_t)row * D) + lane;
#pragma unroll
            for (int j = 0; j < 4; ++j) { const v2u x = xa[i][j], a = ya[i][j], b = yb[i][j];
                orow[64 * j] = (f32x4){bflo(x.x) + (bflo(a.x) + bflo(b.x)), bfhi(x.x) + (bfhi(a.x) + bfhi(b.x)), bflo(x.y) + (bflo(a.y) + bflo(b.y)), bfhi(x.y) + (bfhi(a.y) + bfhi(b.y))}; } }
    }
}

__global__ void __launch_bounds__(NWAVES * 64, 2) mega_fwd(Args args) {
    extern __shared__ __attribute__((aligned(16))) unsigned char lds[];
    Frame F;
    F.lds = (LAS unsigned char*)lds; F.tid = threadIdx.x; F.lane = F.tid & 63; F.wave = __builtin_amdgcn_readfirstlane(F.tid >> 6);
    F.G = gridDim.x; { const int bx = blockIdx.x; F.vcu = (F.G % 8 == 0) ? (bx % 8) * (F.G / 8) + bx / 8 : bx; }
    for (int u = F.tid; u < RING_OFF / 4; u += NWAVES * 64) ((LAS unsigned*)(F.lds + MISC_OFF))[u] = 0u;
    __syncthreads();
    if (KA->ph_hi - KA->ph_lo > 1) (void)xcd_barrier_post((unsigned*)(A_WS + WS_CTL) + CW_BAR + KA->li * XCD_BAR_WORDS, (volatile LAS unsigned*)(F.lds + MISC_OFF + 32));
#define IN(k) (KA->ph_lo <= (k) && (k) < KA->ph_hi)
#define SEAM(k) do { if (IN(k) && IN((k) + 1)) { XcdBarrier b_; b_.bar = (unsigned*)(A_WS + WS_CTL) + CW_BAR + KA->li * XCD_BAR_WORDS; b_.x = xb_xcc_id(); b_.st = (volatile LAS unsigned*)(F.lds + MISC_OFF + 32); xcd_barrier(b_); } } while (0)
#define ws A_WS
#define XB ((bf16_t*)(A_WS + WS_XB))
#define SSQ ((float*)(A_WS + WS_SSQ))

    if (IN(0)) { p0_prologue(F); } SEAM(0);
    if (IN(1)) { pg8::Gemm g{(const bf16_t*)(ws + WS_XN0), (const bf16_t*)(ws + WS_W_IN), M, 3072, 1024}; pg8::StaticOrder S; S.init(M, 3072, F.G, (int)blockIdx.x);
        pg8::EpiInProj E{(bf16_t*)(ws + WS_BB), (bf16_t*)(ws + WS_UB)};
        pg8::gemm_phase<pg8::EpiInProj, pg8::StaticOrder, true, true>(F.lds + RING_OFF, g, S, E); } SEAM(1);
    if (IN(2)) { p2_conv(F); } SEAM(2);
    if (IN(3)) { pg8::Gemm g{(const bf16_t*)(ws + WS_G), (const bf16_t*)(ws + WS_W_OUT), M, 1024, 1024}; pg8::StaticOrder S; S.init(M, 1024, F.G, (int)blockIdx.x);
        pg8::EpiResidSsq<true> E{INP(0), XB, SSQ, 1.0f};
        pg8::gemm_phase<pg8::EpiResidSsq<true>, pg8::StaticOrder, false, true>(F.lds + RING_OFF, g, S, E); } SEAM(3);
    if (IN(4)) { pg8::Gemm g{XB, (const bf16_t*)(ws + WS_W_GU), M, 5632, 1024}; pg8::StaticOrder S; S.init(M, 5632, F.G, (int)blockIdx.x);
        pg8::EpiSwiGLU<true> E{ws + WS_HACT, DFF, SSQ, nullptr, 22};
        pg8::gemm_phase<pg8::EpiSwiGLU<true>, pg8::StaticOrder, true, true>(F.lds + RING_OFF, g, S, E); } SEAM(4);
    if (IN(5)) { pg8::Gemm g{(const bf16_t*)(ws + WS_HACT), (const bf16_t*)(ws + WS_W_DN), M, 1024, DFF / 2}; pg8::StaticOrder S; S.init(M, 1024, F.G, (int)blockIdx.x);
        pg8::EpiResidSsq<false> E{nullptr, XB, SSQ, 1.0f / (pg8::F8_SHD * pg8::F8_SWDD)};
        pg8::gemm_phase<pg8::EpiResidSsq<false>, pg8::StaticOrder, false, true, true>(F.lds + RING_OFF, g, S, E); } SEAM(5);
    if (IN(6)) { pg8::Gemm g{XB, (const bf16_t*)(ws + WS_W_QKV), M, 3072, 1024}; pg8::StaticOrder S; S.init(M, 3072, F.G, (int)blockIdx.x);
        pg8::EpiQKV E{(bf16_t*)(ws + WS_Q), (bf16_t*)(ws + WS_K), (bf16_t*)(ws + WS_V), SSQ, INP(10), INP(8), attn_body::C2};
        pg8::gemm_phase<pg8::EpiQKV, pg8::StaticOrder, true, true>(F.lds + RING_OFF, g, S, E); } SEAM(6);
    if (IN(7)) {
        for (int vh = F.vcu; vh < BATCH * 32; vh += F.G) { const int b = vh >> 5, r = vh & 31, h = r >> 2, c = (r >> 1) & 1, vhalf = r & 1;
            attn_body::bf16* O = (attn_body::bf16*)(ws + (c ? WS_O1 : WS_O0));
            for (int qb = SEQ / 256 - 1; qb >= 0; --qb)
                attn_body::attn_unit<8>(b, (2 * h + c) * 64, h * 128 + vhalf * 64, qb, (const attn_body::bf16*)(ws + WS_Q), (const attn_body::bf16*)(ws + WS_K), (const attn_body::bf16*)(ws + WS_V), O, (char*)lds + RING_OFF); }
    } SEAM(7);
    if (IN(8)) { p8_diff(F); } SEAM(8);
    if (IN(9)) { pg8::Gemm g{(const bf16_t*)(ws + WS_ON), (const bf16_t*)(ws + WS_W_O), M, 1024, 1024}; pg8::StaticOrder S; S.init(M, 1024, F.G, (int)blockIdx.x);
        pg8::EpiResidSsq<false> E{nullptr, XB, SSQ, 1.0f};
        pg8::gemm_phase<pg8::EpiResidSsq<false>, pg8::StaticOrder, false, true>(F.lds + RING_OFF, g, S, E); } SEAM(9);
    if (IN(10)) { p10a_router(F); } SEAM(10);
    if (IN(11)) { p10b_assign(F); } SEAM(11);
    if (IN(12)) { pg8::Gemm g{(const bf16_t*)(ws + WS_XG), (const bf16_t*)(ws + WS_W_MGU), SLOTS, 8 * 7168, 512}; pg8::MoeOrder S; S.init((const int*)(ws + WS_META), 28, F.G, (int)blockIdx.x, false);
        pg8::EpiSwiGLU8 E{ws + WS_HM, DFE, 28};
        pg8::gemm_phase<pg8::EpiSwiGLU8, pg8::MoeOrder, true, true, true>(F.lds + RING_OFF, g, S, E); } SEAM(12);
    if (IN(13)) { pg8::Gemm g{(const bf16_t*)(ws + WS_HM), (const bf16_t*)(ws + WS_W_MDN), SLOTS, 8 * 1024, DFE / 2}; pg8::MoeOrder S; S.init((const int*)(ws + WS_META), 4, F.G, (int)blockIdx.x, true);
        pg8::EpiMoeDown E{(bf16_t*)(ws + WS_Y), (const float*)(ws + WS_GATES), 1.0f / (pg8::F8_SH * pg8::F8_SWD), (float*)(ws + WS_PP)};
        pg8::gemm_phase<pg8::EpiMoeDown, pg8::MoeOrder, true, true, true>(F.lds + RING_OFF, g, S, E); } SEAM(13);
    if (IN(14)) { p13_final(F); }
#undef IN
#undef SEAM
#undef ws
#undef XB
#undef SSQ
}
#ifndef MEGA_UPTO
#define MEGA_UPTO 15
#endif
#ifndef MEGA_REPMASK
#define MEGA_REPMASK 0
#endif
#ifndef MEGA_ONE
#define MEGA_ONE 1
#endif
extern "C" void kernel_launch(void* const* d_in, const int* in_sizes, int n_in, void* d_out, int out_size, void* d_ws, size_t ws_size, hipStream_t stream) {
    static int grid = 0;
    if (grid == 0) {
        if (n_in != 19 || in_sizes[0] != M * D || out_size != M * D || ws_size < WS_END) { fprintf(stderr, "kernel_launch: unexpected shapes / workspace (%d inputs, ws %zu, need %zu)\n", n_in, ws_size, (size_t)WS_END); grid = -1; return; }
        int dev = 0, cus = 0, per_cu = 0;
        if (hipGetDevice(&dev) != hipSuccess || hipDeviceGetAttribute(&cus, hipDeviceAttributeMultiprocessorCount, dev) != hipSuccess) { grid = -1; return; }
        if (hipFuncSetAttribute((const void*)mega_fwd, hipFuncAttributeMaxDynamicSharedMemorySize, LDS_BYTES) != hipSuccess) { fprintf(stderr, "kernel_launch: hipFuncSetAttribute failed\n"); grid = -1; return; }
        if (hipOccupancyMaxActiveBlocksPerMultiprocessor(&per_cu, (const void*)mega_fwd, NWAVES * 64, LDS_BYTES) != hipSuccess || per_cu < 1) fprintf(stderr, "kernel_launch: note: occupancy query says %d\n", per_cu);
        (void)hipGetLastError();
        grid = cus < 256 ? cus : 256;
        if (grid != 256) fprintf(stderr, "kernel_launch: %d CUs; this kernel is built for 256\n", cus);
    }
    if (grid < 0) return;
    unsigned char* ws = (unsigned char*)d_ws; float* out = (float*)d_out;
    constexpr int UPTO = MEGA_UPTO;
    static_assert(UPTO == 15, "the plain reference kernels of the transition builds are gone: all 15 phases run in the persistent kernel");
    if (UPTO > 0) {
        if (hipMemsetAsync(ws + WS_CTL, 0, CTL_ZERO_BYTES, stream) != hipSuccess) { fprintf(stderr, "kernel_launch: memset failed\n"); return; }
        Args a{};
        for (int i = 0; i < 19; ++i) a.in[i] = (const float*)d_in[i];
        a.out = out; a.wsp = ws;
        a.jobmask = UPTO >= 15 ? 255 : UPTO >= 10 ? 63 : UPTO >= 7 ? 31 : UPTO >= 6 ? 15 : 3;
        if (MEGA_ONE) { a.ph_lo = 0; a.ph_hi = UPTO; a.li = 0; hipLaunchKernelGGL(mega_fwd, dim3(grid), dim3(NWAVES * 64), LDS_BYTES, stream, a); }
        else for (int p = 0; p < UPTO; ++p) { a.ph_lo = p; a.ph_hi = p + 1; a.li = 0; for (int r = 0; r <= ((MEGA_REPMASK >> p) & 1); ++r) hipLaunchKernelGGL(mega_fwd, dim3(grid), dim3(NWAVES * 64), LDS_BYTES, stream, a); }
        const hipError_t le = hipPeekAtLastError();
        if (le != hipSuccess) fprintf(stderr, "kernel_launch: launch failed: %s\n", hipGetErrorName(le));
    }
}
```

```cpp
#include <hip/hip_runtime.h>
#include <hip/hip_bf16.h>
#include <stdint.h>
#include <stdio.h>
#include <cmath>
#define MEGA_UPTO 15
#define MEGA_ONE 1
typedef unsigned short bf16_t;
typedef short bf16x8 __attribute__((ext_vector_type(8)));
typedef float f32x4 __attribute__((ext_vector_type(4)));
constexpr int D = 1024, BATCH = 8, SEQ = 2048, M = BATCH * SEQ;
constexpr int NH = 8, HD = 64, VD = 128;
constexpr int DFF = 2816, NE = 8, DFE = 3584;
constexpr float EPS = 1e-6f;
constexpr float LAM_INIT = 0.35550907f;
constexpr int SLOTS = 2 * M + NE * 256;

__device__ __forceinline__ unsigned f2bf(float f) { unsigned u = __builtin_bit_cast(unsigned, f); return (u + 0x7fffu + ((u >> 16) & 1u)) >> 16; }
__device__ __forceinline__ float bf2f(unsigned short b) { return __builtin_bit_cast(float, (unsigned)b << 16); }
__device__ __forceinline__ float wave_sum(float v) {
#pragma unroll
    for (int o = 1; o < 64; o <<= 1) v += __shfl_xor(v, o);
    return v;
}

namespace pg8 {
#define PG8_LAS __attribute__((address_space(3)))
typedef unsigned short bf16_t;
typedef short bf16x8 __attribute__((ext_vector_type(8)));
typedef float f32x4 __attribute__((ext_vector_type(4)));
typedef unsigned u32x4 __attribute__((ext_vector_type(4)));
typedef int i32x4 __attribute__((ext_vector_type(4)));
typedef int i32x8 __attribute__((ext_vector_type(8)));
constexpr int BM = 256, BK = 64, HALF = 128, HTB = HALF * BK * 2  , STAGE_BYTES = 8 * HTB, NXCD = 8, WGM = 8;

__host__ __device__ __forceinline__ int lds_byte(int r, int c) { const int st = (r >> 4) * 2 + (c >> 5), rr = r & 15, cc = c & 31, ob = rr * 64 + cc * 2; return st * 1024 + (ob ^ (((ob >> 9) & 1) << 5)); }
__host__ __device__ __forceinline__ void stage_rc(int b, int& R, int& C) { const int st = b / 1024, sb = b % 1024, swz = sb ^ (((sb >> 9) & 1) << 5); R = (st >> 1) * 16 + swz / 64; C = (st & 1) * 32 + (swz % 64) / 2; }
__host__ __device__ __forceinline__ int perm32(int rho) { const int n = rho >> 4, i = rho & 15; return 8 * (i >> 2) + 4 * n + (i & 3); }

struct Unit { int pm, pn; int kt0, nkt, aux; };
struct Gemm { const bf16_t* A; const bf16_t* Bt; int M, N, K; };

struct StaticOrder {
    int nM, nN, nwg, G, c;
    __host__ __device__ void init(int M, int N, int G_, int c_) { nM = M / BM; nN = N / BM; nwg = nM * nN; G = G_; c = c_; }
    __host__ __device__ bool next(int i, Unit& u) const {
        const long L = (long)i * G + c; if (L >= nwg) return false;
        int wgid = (int)L; { const int q = nwg / NXCD, r = nwg % NXCD, xcd = wgid % NXCD, off = wgid / NXCD; wgid = (xcd < r ? xcd * (q + 1) : r * (q + 1) + (xcd - r) * q) + off; }
        const int nig = WGM * nN, gid = wgid / nig, fm = gid * WGM, gsz = (nM - fm) < WGM ? (nM - fm) : WGM;
        u.pm = fm + ((wgid % nig) % gsz); u.pn = (wgid % nig) / gsz; u.kt0 = 0; u.nkt = 0; u.aux = -1; return true;
    }
    __device__ __forceinline__ void a_ready(const Unit&) const {}
    __device__ __forceinline__ void done(const Unit&) const {}
};

__device__ __forceinline__ unsigned cvt_pk_bf16(float lo, float hi) { unsigned r; asm volatile("v_cvt_pk_bf16_f32 %0, %1, %2" : "=v"(r) : "v"(lo), "v"(hi)); return r; }
typedef float f32x2 __attribute__((ext_vector_type(2)));
typedef unsigned u32x2 __attribute__((ext_vector_type(2)));
constexpr float RMS_EPS = 1e-6f, LOG2E = 1.4426950408889634f;
constexpr int DM_ = 1024;
__device__ __forceinline__ u32x4 pack8(const f32x4 a, const f32x4 b) { u32x4 w; w.x = cvt_pk_bf16(a[0], a[1]); w.y = cvt_pk_bf16(a[2], a[3]); w.z = cvt_pk_bf16(b[0], b[1]); w.w = cvt_pk_bf16(b[2], b[3]); return w; }
__device__ __forceinline__ float rstd_of(const float* ssq, int row) { const f32x4 p = *(const f32x4*)(ssq + (size_t)row * 4); return __builtin_amdgcn_rsqf(((p[0] + p[1]) + (p[2] + p[3])) * (1.0f / 1024.0f) + RMS_EPS); }
__device__ __forceinline__ float silu_mul(float g, float u) { return g * u * __builtin_amdgcn_rcpf(1.0f + __builtin_amdgcn_exp2f(-g * LOG2E)); }
__device__ __forceinline__ f32x2 swiglu2(f32x2 a, f32x2 b, float c1, float k) {
    const f32x2 t = a * c1; f32x2 e; e.x = __builtin_amdgcn_exp2f(t.x); e.y = __builtin_amdgcn_exp2f(t.y);
    const f32x2 d = e * k + k; f32x2 r; r.x = __builtin_amdgcn_rcpf(d.x); r.y = __builtin_amdgcn_rcpf(d.y);
    return (a * b) * r;
}

__device__ __forceinline__ float clamp448(float x) { return __builtin_amdgcn_fmed3f(x, -448.0f, 448.0f); }
__device__ __forceinline__ unsigned pk4_fp8(float a, float b, float c, float d) { int w = 0; w = __builtin_amdgcn_cvt_pk_fp8_f32(clamp448(a), clamp448(b), w, false); w = __builtin_amdgcn_cvt_pk_fp8_f32(clamp448(c), clamp448(d), w, true); return (unsigned)w; }
constexpr float F8_SA = 4.0f, F8_SWG = 256.0f, F8_SH = 8.0f, F8_SWD = 512.0f;
constexpr float F8_SHD = 8.0f, F8_SWDD = 256.0f, F8_SX = 4.0f, F8_SWGD = 256.0f;

struct EpiInProj {
    static constexpr bool PERM = true, AFTER_DRAIN = false;
    bf16_t* Bb; bf16_t* Ub;
    __device__ __forceinline__ void operator()(const f32x4 (&acc)[2][2][4][2], const Unit& u, int wr, int wc, int fr, int fq) const {
        const int row0 = u.pm * BM + wr * 64 + fr;
        if (u.pn < 4) {
            const int col0 = u.pn * BM + wc * 32 + 8 * fq;
#pragma unroll
            for (int ai = 0; ai < 2; ++ai)
#pragma unroll
                for (int m = 0; m < 4; ++m) { bf16_t* rowp = Bb + (size_t)(row0 + ai * HALF + m * 16) * DM_ + col0;
#pragma unroll
                    for (int bj = 0; bj < 2; ++bj) *(u32x4*)(rowp + bj * HALF) = pack8(acc[ai][bj][m][0], acc[ai][bj][m][1]); }
        } else {
            const int col0 = (u.pn - 4) * 128 + wc * 32 + 8 * fq;
#pragma unroll
            for (int ai = 0; ai < 2; ++ai)
#pragma unroll
                for (int m = 0; m < 4; ++m) { bf16_t* rowp = Ub + (size_t)(row0 + ai * HALF + m * 16) * DM_ + col0;
                    *(u32x4*)rowp = pack8(acc[ai][0][m][0] * acc[ai][1][m][0], acc[ai][0][m][1] * acc[ai][1][m][1]); }
        }
    }
};

template <bool FIRST> struct EpiResidSsq {
    static constexpr bool PERM = true, AFTER_DRAIN = true;
    const float* x0; bf16_t* xb; float* ssq; float ascale; unsigned char* x8;
    __device__ __forceinline__ void fused(f32x4 (&acc)[2][2][4][2], const Unit& u, int wr, int wc, int fr, int fq, PG8_LAS unsigned char* lds, int wid, int lane) const {
        PG8_LAS float* P = (PG8_LAS float*)lds;
        const int col0 = u.pn * BM + wc * 32 + 8 * fq;
#pragma unroll
        for (int ai = 0; ai < 2; ++ai) {
            f32x4 xo[4][2][2];
#pragma unroll
            for (int m = 0; m < 4; ++m) { const int r = ai * HALF + wr * 64 + m * 16 + fr; const size_t off = (size_t)(u.pm * BM + r) * DM_ + col0;
#pragma unroll
                for (int bj = 0; bj < 2; ++bj) {
                    if constexpr (FIRST) { xo[m][bj][0] = *(const f32x4*)(x0 + off + bj * HALF); xo[m][bj][1] = *(const f32x4*)(x0 + off + bj * HALF + 4); }
                    else { const u32x4 w = *(const u32x4*)(xb + off + bj * HALF);
                        xo[m][bj][0] = (f32x4){__builtin_bit_cast(float, w.x << 16), __builtin_bit_cast(float, w.x & 0xffff0000u), __builtin_bit_cast(float, w.y << 16), __builtin_bit_cast(float, w.y & 0xffff0000u)};
                        xo[m][bj][1] = (f32x4){__builtin_bit_cast(float, w.z << 16), __builtin_bit_cast(float, w.z & 0xffff0000u), __builtin_bit_cast(float, w.w << 16), __builtin_bit_cast(float, w.w & 0xffff0000u)}; } } }
#pragma unroll
            for (int m = 0; m < 4; ++m) { const int r = ai * HALF + wr * 64 + m * 16 + fr; const size_t off = (size_t)(u.pm * BM + r) * DM_ + col0; float s = 0.f;
#pragma unroll
                for (int bj = 0; bj < 2; ++bj) { const f32x4 v0 = xo[m][bj][0] + acc[ai][bj][m][0] * ascale, v1 = xo[m][bj][1] + acc[ai][bj][m][1] * ascale;
                    *(u32x4*)(xb + off + bj * HALF) = pack8(v0, v1);
                    if constexpr (FIRST) { u32x2 w; w.x = pk4_fp8(v0[0] * F8_SX, v0[1] * F8_SX, v0[2] * F8_SX, v0[3] * F8_SX); w.y = pk4_fp8(v1[0] * F8_SX, v1[1] * F8_SX, v1[2] * F8_SX, v1[3] * F8_SX); *(u32x2*)(x8 + off + bj * HALF) = w; }
                    s += ((v0[0] * v0[0] + v0[1] * v0[1]) + (v0[2] * v0[2] + v0[3] * v0[3])) + ((v1[0] * v1[0] + v1[1] * v1[1]) + (v1[2] * v1[2] + v1[3] * v1[3])); }
                s += __shfl_xor(s, 16); s += __shfl_xor(s, 32);
                if (fq == 0) P[r * 4 + wc] = s; }
            asm volatile("" ::: "memory"); }
        asm volatile("s_waitcnt lgkmcnt(0)" ::: "memory"); __builtin_amdgcn_s_barrier(); asm volatile("" ::: "memory");
        const int t = wid * 64 + lane;
        if (t < 256) { const PG8_LAS f32x4* Pr = (const PG8_LAS f32x4*)lds; const f32x4 p = Pr[t]; ssq[(size_t)(u.pm * BM + t) * 4 + u.pn] = (p[0] + p[1]) + (p[2] + p[3]); }
        asm volatile("s_waitcnt lgkmcnt(0)" ::: "memory"); __builtin_amdgcn_s_barrier(); asm volatile("" ::: "memory");
    }
};

template <bool OUT8> struct EpiSwiGLU {
    static constexpr bool PERM = true, AFTER_DRAIN = false;
    void* H; int ldh; const float* ssq; const float* rstd; int ncol; float cs;
    __device__ __forceinline__ void operator()(const f32x4 (&acc)[2][2][4][2], const Unit& u, int wr, int wc, int fr, int fq) const {
        const int row0 = u.pm * BM + wr * 64 + fr, col0 = (u.pn % ncol) * 128 + wc * 32 + 8 * fq;
#pragma unroll
        for (int ai = 0; ai < 2; ++ai)
#pragma unroll
            for (int m = 0; m < 4; ++m) { const int row = row0 + ai * HALF + m * 16;
                float k; if (ssq) { const f32x4 p = *(const f32x4*)(ssq + (size_t)row * 4); k = ((p[0] + p[1]) + (p[2] + p[3])) * (1.0f / 1024.0f) + RMS_EPS; } else { const float r_ = rstd[row]; k = 1.0f / (r_ * r_); }
                const float c1 = -LOG2E * cs * __builtin_amdgcn_rsqf(k); k = k / (cs * cs);
                f32x4 h[2];
#pragma unroll
                for (int n = 0; n < 2; ++n) { const f32x4 a = acc[ai][0][m][n], b = acc[ai][1][m][n];
                    const f32x2 h0 = swiglu2((f32x2){a[0], a[1]}, (f32x2){b[0], b[1]}, c1, k), h1 = swiglu2((f32x2){a[2], a[3]}, (f32x2){b[2], b[3]}, c1, k);
                    h[n] = (f32x4){h0.x, h0.y, h1.x, h1.y}; }
                if constexpr (OUT8) { u32x2 w; w.x = pk4_fp8(h[0][0] * F8_SHD, h[0][1] * F8_SHD, h[0][2] * F8_SHD, h[0][3] * F8_SHD); w.y = pk4_fp8(h[1][0] * F8_SHD, h[1][1] * F8_SHD, h[1][2] * F8_SHD, h[1][3] * F8_SHD);
                    *(u32x2*)((unsigned char*)H + (size_t)row * ldh + col0) = w; }
                else *(u32x4*)((bf16_t*)H + (size_t)row * ldh + col0) = pack8(h[0], h[1]); }
    }
};

struct EpiQKV {
    static constexpr bool PERM = true, AFTER_DRAIN = false;
    bf16_t *Q, *K, *V; const float* ssq; const float* qg; const float* kg; float qscale;
    __device__ __forceinline__ void operator()(const f32x4 (&acc)[2][2][4][2], const Unit& u, int wr, int wc, int fr, int fq) const {
        const int row0 = u.pm * BM + wr * 64 + fr;
        if (u.pn < 8) {
            const bool isq = u.pn < 4; bf16_t* base = isq ? Q : K; const float* gn = isq ? qg : kg; const float sc = isq ? qscale : 1.0f;
            const int col0 = (4 * (u.pn & 3) + wc) * 64 + 8 * fq;
            f32x4 gv[2][2];
#pragma unroll
            for (int bj = 0; bj < 2; ++bj)
#pragma unroll
                for (int n = 0; n < 2; ++n) gv[bj][n] = *(const f32x4*)(gn + 32 * bj + 8 * fq + 4 * n);
#pragma unroll
            for (int ai = 0; ai < 2; ++ai)
#pragma unroll
                for (int m = 0; m < 4; ++m) { const int row = row0 + ai * HALF + m * 16; const float rs = rstd_of(ssq, row);
                    f32x4 v[2][2]; float ss = 0.f;
#pragma unroll
                    for (int bj = 0; bj < 2; ++bj)
#pragma unroll
                        for (int n = 0; n < 2; ++n) { v[bj][n] = acc[ai][bj][m][n] * rs; ss += (v[bj][n][0] * v[bj][n][0] + v[bj][n][1] * v[bj][n][1]) + (v[bj][n][2] * v[bj][n][2] + v[bj][n][3] * v[bj][n][3]); }
                    ss += __shfl_xor(ss, 16); ss += __shfl_xor(ss, 32);
                    const float r2 = __builtin_amdgcn_rsqf(ss * (1.0f / 64.0f) + RMS_EPS) * sc;
#pragma unroll
                    for (int bj = 0; bj < 2; ++bj) *(u32x4*)(base + (size_t)row * DM_ + col0 + 32 * bj) = pack8(v[bj][0] * r2 * gv[bj][0], v[bj][1] * r2 * gv[bj][1]); }
        } else {
            const int col0 = (u.pn - 8) * BM + wc * 32 + 8 * fq;
#pragma unroll
            for (int ai = 0; ai < 2; ++ai)
#pragma unroll
                for (int m = 0; m < 4; ++m) { const int row = row0 + ai * HALF + m * 16; const float rs = rstd_of(ssq, row);
#pragma unroll
                    for (int bj = 0; bj < 2; ++bj) *(u32x4*)(V + (size_t)row * DM_ + col0 + bj * HALF) = pack8(acc[ai][bj][m][0] * rs, acc[ai][bj][m][1] * rs); }
        }
    }
};

struct EpiSwiGLU8 {
    static constexpr bool PERM = true, AFTER_DRAIN = false;
    unsigned char* H; int ldh; int ncol;
    __device__ __forceinline__ void operator()(const f32x4 (&acc)[2][2][4][2], const Unit& u, int wr, int wc, int fr, int fq) const {
        const int row0 = u.pm * BM + wr * 64 + fr, col0 = (u.pn % ncol) * 128 + wc * 32 + 8 * fq; constexpr float cs = 1.0f / (F8_SA * F8_SWG);
#pragma unroll
        for (int ai = 0; ai < 2; ++ai)
#pragma unroll
            for (int m = 0; m < 4; ++m) { const int row = row0 + ai * HALF + m * 16; f32x4 h[2];
#pragma unroll
                for (int n = 0; n < 2; ++n) { const f32x4 a = acc[ai][0][m][n], b = acc[ai][1][m][n];
                    const f32x2 h0 = swiglu2((f32x2){a[0], a[1]}, (f32x2){b[0], b[1]}, -cs * LOG2E, 1.0f / (cs * cs * F8_SH)), h1 = swiglu2((f32x2){a[2], a[3]}, (f32x2){b[2], b[3]}, -cs * LOG2E, 1.0f / (cs * cs * F8_SH));
                    h[n] = (f32x4){h0.x, h0.y, h1.x, h1.y}; }
                u32x2 w; w.x = pk4_fp8(h[0][0], h[0][1], h[0][2], h[0][3]); w.y = pk4_fp8(h[1][0], h[1][1], h[1][2], h[1][3]);
                *(u32x2*)(H + (size_t)row * ldh + col0) = w; }
    }
};

struct EpiMoeDown {
    static constexpr bool PERM = true, AFTER_DRAIN = false;
    bf16_t* Y; const float* gate; float scale; float* Pp;
    __device__ __forceinline__ void operator()(const f32x4 (&acc)[2][2][4][2], const Unit& u, int wr, int wc, int fr, int fq) const {
        const int col0 = (u.pn & 3) * BM + wc * 32 + 8 * fq;
        if (u.aux >= 0) {
            float* base = Pp + ((size_t)u.aux * BM + wr * 64 + fr) * DM_ + col0;
#pragma unroll
            for (int ai = 0; ai < 2; ++ai)
#pragma unroll
                for (int m = 0; m < 4; ++m)
#pragma unroll
                    for (int bj = 0; bj < 2; ++bj) { float* p = base + (size_t)(ai * HALF + m * 16) * DM_ + bj * HALF; *(f32x4*)p = acc[ai][bj][m][0]; *(f32x4*)(p + 4) = acc[ai][bj][m][1]; }
            return; }
        const int row0 = u.pm * BM + wr * 64 + fr;
#pragma unroll
        for (int ai = 0; ai < 2; ++ai)
#pragma unroll
            for (int m = 0; m < 4; ++m) { const int row = row0 + ai * HALF + m * 16; const float gt = gate[row] * scale;
#pragma unroll
                for (int bj = 0; bj < 2; ++bj) *(u32x4*)(Y + (size_t)row * DM_ + col0 + bj * HALF) = pack8(acc[ai][bj][m][0] * gt, acc[ai][bj][m][1] * gt); }
    }
};

struct MoeOrder {
    int nM, nN, nwg, G, c, T, P0, npieces; int t1, t2, t3, t4, t5, t6, t7;
    static constexpr int SPL = 7, PKT = 4;
    __device__ __forceinline__ void init(const int* meta, int nN_, int G_, int c_, bool split) {
        T = meta[8]; nM = split ? meta[9] : T; nN = nN_; nwg = nM * nN; G = G_; c = c_; t1 = meta[1]; t2 = meta[2]; t3 = meta[3]; t4 = meta[4]; t5 = meta[5]; t6 = meta[6]; t7 = meta[7];
        P0 = ((nwg + G - 1) / G) * G; npieces = (T - nM) * nN * SPL; }
    __device__ __forceinline__ int expert_of(int pm) const { return (pm >= t1) + (pm >= t2) + (pm >= t3) + (pm >= t4) + (pm >= t5) + (pm >= t6) + (pm >= t7); }
    __device__ __forceinline__ bool next(int i, Unit& u) const {
        const long L = (long)i * G + c;
        if (L >= nwg) { const long q = L - P0; if (q < 0 || q >= npieces) return false;
            const int rt = (int)q / (nN * SPL), rem = (int)q % (nN * SPL), pnl = rem / SPL, kp = rem % SPL;
            u.pm = nM + rt; u.pn = expert_of(u.pm) * nN + pnl; u.kt0 = kp * PKT; u.nkt = PKT; u.aux = rt * SPL + kp; return true; }
        int wgid = (int)L; { const int q = nwg / NXCD, r = nwg % NXCD, xcd = wgid % NXCD, off = wgid / NXCD; wgid = (xcd < r ? xcd * (q + 1) : r * (q + 1) + (xcd - r) * q) + off; }
        const int nig = WGM * nN, gid = wgid / nig, fm = gid * WGM, gsz = (nM - fm) < WGM ? (nM - fm) : WGM;
        const int pm = fm + ((wgid % nig) % gsz), pnl = (wgid % nig) / gsz;
        u.pm = pm; u.pn = expert_of(pm) * nN + pnl; u.kt0 = 0; u.nkt = 0; u.aux = -1; return true;
    }
    __device__ __forceinline__ void a_ready(const Unit&) const {}
    __device__ __forceinline__ void done(const Unit&) const {}
};
template <class Epi, class Sched, bool ALIGN_EPI = false, bool SP2 = false, bool F8 = false>
__device__ __forceinline__ void gemm_phase(PG8_LAS unsigned char* lds, const Gemm g, const Sched& S, const Epi& E) {
    const int tid = threadIdx.x, wid = __builtin_amdgcn_readfirstlane(tid >> 6), lane = tid & 63, wr = wid >> 2, wc = wid & 3, fr = lane & 15, fq = lane >> 4;
    int K_ = g.K; asm volatile("" : "+s"(K_));
    const int K = K_, nt = K / BK;
    unsigned voffA[2], voffB[2];
#pragma unroll
    for (int i = 0; i < 2; ++i) { int R, C; stage_rc(tid * 16 + i * 8192, R, C); const int Rb = Epi::PERM ? ((R & ~31) + perm32(R & 31)) : R;
        voffA[i] = (unsigned)(R * K + C) * 2u; voffB[i] = (unsigned)(Rb * K + C) * 2u; }
    const size_t kstep = (size_t)(BK * 2);
    const size_t hstep = (size_t)HALF * K * 2;
    const size_t tstep = 2 * hstep;
    const unsigned ldsw = (unsigned)wid * 1024u;
    const int aoff = lds_byte(wr * 64 + fr, fq * 8), boff = lds_byte(wc * 32 + fr, fq * 8);
    constexpr int KSTEP = 1024;
#define PG8_SA(b, h) (((b) * 2 + (h)) * HTB)
#define PG8_SB(b, h) ((4 + (b) * 2 + (h)) * HTB)
#define PG8_STAGE(bufoff, gbase, voff) do { _Pragma("unroll") for (int _i = 0; _i < 2; ++_i) \
        __builtin_amdgcn_global_load_lds((const unsigned*)((const char*)(gbase) + (voff)[_i]), (PG8_LAS unsigned*)(lds + (bufoff) + ldsw + _i * 8192), 16, 0, 0); } while (0)
#define PG8_LDA(dst, b, h) do { _Pragma("unroll") for (int m = 0; m < 4; ++m) _Pragma("unroll") for (int k = 0; k < 2; ++k) dst[m][k] = *(const PG8_LAS bf16x8*)(lds + PG8_SA(b, h) + aoff + m * 2048 + k * KSTEP); } while (0)
#define PG8_LDB(dst, b, h) do { _Pragma("unroll") for (int n = 0; n < 2; ++n) _Pragma("unroll") for (int k = 0; k < 2; ++k) dst[n][k] = *(const PG8_LAS bf16x8*)(lds + PG8_SB(b, h) + boff + n * 2048 + k * KSTEP); } while (0)
#define PG8_CAT8(x) __builtin_shufflevector(__builtin_bit_cast(i32x4, (x)[0]), __builtin_bit_cast(i32x4, (x)[1]), 0, 1, 2, 3, 4, 5, 6, 7)
#define PG8_MMA(ai, bj, At, Bt) do { __builtin_amdgcn_s_setprio(1); _Pragma("unroll") for (int m = 0; m < 4; ++m) _Pragma("unroll") for (int n = 0; n < 2; ++n) { \
        if constexpr (F8) asm volatile("s_nop 1\n\tv_mfma_f32_16x16x128_f8f6f4 %0, %1, %2, %0" : "+v"(acc[ai][bj][m][n]) : "v"(PG8_CAT8(Bt[n])), "v"(PG8_CAT8(At[m]))); \
        else { _Pragma("unroll") for (int k = 0; k < 2; ++k) acc[ai][bj][m][n] = __builtin_amdgcn_mfma_f32_16x16x32_bf16(Bt[n][k], At[m][k], acc[ai][bj][m][n], 0, 0, 0); } } \
        __builtin_amdgcn_s_setprio(0); } while (0)
#define PG8_WAIT_V(n) asm volatile("s_waitcnt vmcnt(" #n ")" ::: "memory")
#define PG8_WAIT_L(n) asm volatile("s_waitcnt lgkmcnt(" #n ")" ::: "memory")
#define PG8_BAR __builtin_amdgcn_s_barrier()
#define PG8_SCHED __builtin_amdgcn_sched_barrier(0)
    Unit cur, nxt; int ui = 0;
    if (!S.next(0, cur)) return;
    f32x4 acc[2][2][4][2];
#pragma unroll
    for (int a = 0; a < 2; ++a)
#pragma unroll
        for (int b = 0; b < 2; ++b)
#pragma unroll
            for (int m = 0; m < 4; ++m)
#pragma unroll
                for (int n = 0; n < 2; ++n) acc[a][b][m][n] = (f32x4){0.f, 0.f, 0.f, 0.f};
    bf16x8 At[4][2], B0[2][2], B1[2][2];
    const char* cA = (const char*)g.A + (size_t)cur.pm * tstep + (size_t)cur.kt0 * kstep; const char* cB = (const char*)g.Bt + (size_t)cur.pn * tstep + (size_t)cur.kt0 * kstep;
    S.a_ready(cur);
    if constexpr (SP2) {
        PG8_STAGE(PG8_SB(0, 0), cB, voffB); PG8_STAGE(PG8_SB(0, 1), cB + hstep, voffB); PG8_STAGE(PG8_SA(0, 0), cA, voffA); PG8_STAGE(PG8_SA(0, 1), cA + hstep, voffA);
        if (wr == 1) PG8_BAR;
        PG8_WAIT_V(2); PG8_BAR;
        PG8_STAGE(PG8_SB(1, 0), cB + kstep, voffB); PG8_STAGE(PG8_SA(1, 0), cA + kstep, voffA); PG8_STAGE(PG8_SB(1, 1), cB + hstep + kstep, voffB);
        PG8_WAIT_V(6); PG8_BAR;
    } else {
        PG8_STAGE(PG8_SB(0, 0), cB, voffB); PG8_STAGE(PG8_SA(0, 0), cA, voffA); PG8_STAGE(PG8_SB(0, 1), cB + hstep, voffB); PG8_STAGE(PG8_SA(0, 1), cA + hstep, voffA);
        if (wr == 1) PG8_BAR;
        PG8_WAIT_V(4); PG8_BAR;
        PG8_STAGE(PG8_SB(1, 0), cB + kstep, voffB); PG8_STAGE(PG8_SA(1, 0), cA + kstep, voffA); PG8_STAGE(PG8_SB(1, 1), cB + hstep + kstep, voffB);
        PG8_WAIT_V(6); PG8_BAR;
    }
    for (;;) {
        const bool has_next = S.next(ui + 1, nxt);
        const char* nA = has_next ? (const char*)g.A + (size_t)nxt.pm * tstep + (size_t)nxt.kt0 * kstep : cA; const char* nB = has_next ? (const char*)g.Bt + (size_t)nxt.pn * tstep + (size_t)nxt.kt0 * kstep : cB;
        const int ntu = cur.nkt ? cur.nkt : nt;
        for (int t = 0; t < ntu; t += 2) {
            const bool last = (t == ntu - 2);
            const char* a1 = cA + (size_t)(t + 1) * kstep;
            const char* a2 = last ? nA : cA + (size_t)(t + 2) * kstep; const char* b2 = last ? nB : cB + (size_t)(t + 2) * kstep;
            const char* a3 = a2 + kstep; const char* b3 = b2 + kstep;
            if (last && has_next) S.a_ready(nxt);
            if constexpr (SP2) {
            PG8_LDB(B0, 0, 0); PG8_LDB(B1, 0, 1); PG8_SCHED; PG8_LDA(At, 0, 0); PG8_STAGE(PG8_SA(1, 1), a1 + hstep, voffA);
            PG8_WAIT_V(8); PG8_WAIT_L(0); PG8_BAR; PG8_MMA(0, 0, At, B0); PG8_MMA(0, 1, At, B1); PG8_BAR; PG8_SCHED;
            PG8_LDA(At, 0, 1); PG8_STAGE(PG8_SB(0, 0), b2, voffB); PG8_STAGE(PG8_SB(0, 1), b2 + hstep, voffB); PG8_STAGE(PG8_SA(0, 0), a2, voffA);
            PG8_WAIT_V(8); PG8_WAIT_L(0); PG8_BAR; PG8_MMA(1, 0, At, B0); PG8_MMA(1, 1, At, B1); PG8_BAR; PG8_SCHED;
            PG8_LDB(B0, 1, 0); PG8_LDB(B1, 1, 1); PG8_SCHED; PG8_LDA(At, 1, 0); PG8_STAGE(PG8_SA(0, 1), a2 + hstep, voffA);
            PG8_WAIT_V(8); PG8_WAIT_L(0); PG8_BAR; PG8_MMA(0, 0, At, B0); PG8_MMA(0, 1, At, B1); PG8_BAR; PG8_SCHED;
            PG8_LDA(At, 1, 1); PG8_STAGE(PG8_SB(1, 0), b3, voffB); PG8_STAGE(PG8_SB(1, 1), b3 + hstep, voffB); PG8_STAGE(PG8_SA(1, 0), a3, voffA);
            PG8_WAIT_V(8); PG8_WAIT_L(0); PG8_BAR; PG8_MMA(1, 0, At, B0); PG8_MMA(1, 1, At, B1); PG8_BAR; PG8_SCHED;
            } else {
            PG8_LDB(B0, 0, 0); PG8_SCHED; PG8_LDA(At, 0, 0); PG8_STAGE(PG8_SA(1, 1), a1 + hstep, voffA);
            PG8_WAIT_L(8); PG8_BAR; PG8_WAIT_L(0); PG8_MMA(0, 0, At, B0); PG8_BAR; PG8_SCHED;
            PG8_LDB(B1, 0, 1); PG8_STAGE(PG8_SB(0, 0), b2, voffB);
            PG8_BAR; PG8_WAIT_L(0); PG8_MMA(0, 1, At, B1); PG8_BAR;
            PG8_LDA(At, 0, 1); PG8_STAGE(PG8_SA(0, 0), a2, voffA);
            PG8_BAR; PG8_WAIT_L(0); PG8_MMA(1, 0, At, B0); PG8_BAR; PG8_SCHED;
            PG8_STAGE(PG8_SB(0, 1), b2 + hstep, voffB);
            PG8_WAIT_V(6); PG8_BAR; PG8_MMA(1, 1, At, B1); PG8_BAR;
            PG8_LDB(B0, 1, 0); PG8_SCHED; PG8_LDA(At, 1, 0); PG8_STAGE(PG8_SA(0, 1), a2 + hstep, voffA);
            PG8_WAIT_L(8); PG8_BAR; PG8_WAIT_L(0); PG8_MMA(0, 0, At, B0); PG8_BAR; PG8_SCHED;
            PG8_LDB(B1, 1, 1); PG8_STAGE(PG8_SB(1, 0), b3, voffB);
            PG8_BAR; PG8_WAIT_L(0); PG8_MMA(0, 1, At, B1); PG8_BAR;
            PG8_LDA(At, 1, 1); PG8_STAGE(PG8_SA(1, 0), a3, voffA);
            PG8_BAR; PG8_WAIT_L(0); PG8_MMA(1, 0, At, B0); PG8_BAR; PG8_SCHED;
            PG8_STAGE(PG8_SB(1, 1), b3 + hstep, voffB);
            PG8_WAIT_V(6); PG8_BAR; PG8_MMA(1, 1, At, B1); PG8_BAR;
            }
        }
        if constexpr (F8) asm volatile("s_nop 15\n\ts_nop 15" ::: "memory");
        if constexpr (ALIGN_EPI) { if (wr == 0) PG8_BAR; }
        if constexpr (!Epi::AFTER_DRAIN) { E(acc, cur, wr, wc, fr, fq); S.done(cur); }
        if (!has_next) break;
#pragma unroll
        for (int a = 0; a < 2; ++a)
#pragma unroll
            for (int b = 0; b < 2; ++b)
#pragma unroll
                for (int m = 0; m < 4; ++m)
#pragma unroll
                    for (int n = 0; n < 2; ++n) acc[a][b][m][n] = (f32x4){0.f, 0.f, 0.f, 0.f};
        cur = nxt; cA = nA; cB = nB; ++ui;
        if constexpr (ALIGN_EPI) { if (wr == 1) PG8_BAR; }
    }
    PG8_WAIT_V(0);
    if constexpr (!ALIGN_EPI) { if (wr == 0) PG8_BAR; }
    PG8_BAR;
    if constexpr (Epi::AFTER_DRAIN) { E.fused(acc, cur, wr, wc, fr, fq, lds, wid, lane); S.done(cur); }
#undef PG8_SA
#undef PG8_SB
#undef PG8_STAGE
#undef PG8_LDA
#undef PG8_LDB
#undef PG8_MMA
#undef PG8_CAT8
#undef PG8_WAIT_V
#undef PG8_WAIT_L
#undef PG8_BAR
#undef PG8_SCHED
}
}
#include <hip/hip_bf16.h>
#include <cmath>
namespace attn_body {
using bf16=__hip_bfloat16;
using bf16x8=__attribute__((ext_vector_type(8)))short;
using s16x4=__attribute__((ext_vector_type(4)))short;
using f32x16=__attribute__((ext_vector_type(16)))float;
using u32x4=__attribute__((ext_vector_type(4)))unsigned;
constexpr int BATCH=8,NHEAD=16,SEQ=2048,D=64,DM=NHEAD*D;
constexpr int NW=8,QBLK=32,QB=QBLK*NW,KVBLK=64,NQB=SEQ/QB;
constexpr int ATTN_PITCH=DM, ATTN_UNIT_ROWS=QB;
__device__ __forceinline__ int crow(int r,int hi){return (r&3)+8*(r>>2)+4*hi;}
#define SBAR() __builtin_amdgcn_sched_barrier(0)
__device__ __forceinline__ void cmask(f32x16&p0,f32x16&p1,int jb,int qrel,int hi){
  const float NEG=-INFINITY; int kb=64*jb+4*hi;
  #pragma unroll
  for(int r=0;r<16;++r){int kv=kb+(r&3)+8*(r>>2); if(kv>qrel)p0[r]=NEG; if(kv+32>qrel)p1[r]=NEG;}
}

constexpr int NSLOT=3, SLOTB=8192;
constexpr int LDS_K=0, LDS_V=NSLOT*SLOTB, LDS_WS=2*NSLOT*SLOTB, LDS_OST=LDS_WS+NW*64*4, LDS_BYTES=LDS_OST+NW*4096;
constexpr float C2=0.125f*1.4426950408889634f;
__device__ __forceinline__ void glds16(const void*gsrc,unsigned lds_dst){unsigned keep;
  asm volatile("s_mov_b32 %0, m0\n\ts_mov_b32 m0, %2\n\ts_nop 0\n\tglobal_load_lds_dwordx4 %1, off\n\ts_mov_b32 m0, %0":"=&s"(keep):"v"(gsrc),"s"(lds_dst):"memory");}
__device__ __forceinline__ float max3f(float a,float b,float c){float r;asm("v_max3_f32 %0, %1, %2, %3":"=v"(r):"v"(a),"v"(b),"v"(c));return r;}
__device__ __forceinline__ float max2f(float a,float b){float r;asm("v_max_f32_e32 %0, %1, %2":"=v"(r):"v"(a),"v"(b));return r;}
__device__ __forceinline__ float fadd_s(float a,float b){float r;asm("v_add_f32_e32 %0, %1, %2":"=v"(r):"v"(a),"v"(b));return r;}
__device__ __forceinline__ float fsub_s(float a,float b){float r;asm("v_sub_f32_e32 %0, %1, %2":"=v"(r):"v"(a),"v"(b));return r;}
typedef float f32x2_t __attribute__((ext_vector_type(2))); typedef __bf16 bf16x2_t __attribute__((ext_vector_type(2)));
__device__ __forceinline__ unsigned cvtpk_s(float lo,float hi){f32x2_t v={lo,hi};bf16x2_t b=__builtin_convertvector(v,bf16x2_t);return __builtin_bit_cast(unsigned,b);}
#define WAIT_BAR(N) asm volatile("s_waitcnt vmcnt(" #N ") lgkmcnt(0)\n\ts_barrier":::"memory")

__device__ __forceinline__ void qkt(f32x16&p0,f32x16&p1,const char*Kslot,const bf16x8*qr,const f32x16&negm,int r32,int hi){
  const char*kb=Kslot+hi*1024+r32*16;
  #pragma unroll
  for(int d0=0;d0<4;++d0){
    const bf16x8 b0=*reinterpret_cast<const bf16x8*>(kb+d0*2048);
    const bf16x8 b1=*reinterpret_cast<const bf16x8*>(kb+d0*2048+512);
    if(d0==0){p0=__builtin_amdgcn_mfma_f32_32x32x16_bf16(b0,qr[0],negm,0,0,0);p1=__builtin_amdgcn_mfma_f32_32x32x16_bf16(b1,qr[0],negm,0,0,0);}
    else{p0=__builtin_amdgcn_mfma_f32_32x32x16_bf16(b0,qr[d0],p0,0,0,0);p1=__builtin_amdgcn_mfma_f32_32x32x16_bf16(b1,qr[d0],p1,0,0,0);}}
}
typedef __attribute__((address_space(3))) const char* lds_cptr;
typedef short v4i16_t __attribute__((ext_vector_type(4)));
__device__ __forceinline__ void kload8(bf16x8*kf,lds_cptr kp){
  kf[0]=*(const __attribute__((address_space(3))) bf16x8*)(kp);      kf[1]=*(const __attribute__((address_space(3))) bf16x8*)(kp+512);
  kf[2]=*(const __attribute__((address_space(3))) bf16x8*)(kp+2048); kf[3]=*(const __attribute__((address_space(3))) bf16x8*)(kp+2560);
  kf[4]=*(const __attribute__((address_space(3))) bf16x8*)(kp+4096); kf[5]=*(const __attribute__((address_space(3))) bf16x8*)(kp+4608);
  kf[6]=*(const __attribute__((address_space(3))) bf16x8*)(kp+6144); kf[7]=*(const __attribute__((address_space(3))) bf16x8*)(kp+6656);
}
__device__ __forceinline__ void kload2(bf16x8*kf,lds_cptr kp,int j){ kf[2*j]=*(const __attribute__((address_space(3))) bf16x8*)(kp+j*2048); kf[2*j+1]=*(const __attribute__((address_space(3))) bf16x8*)(kp+j*2048+512); }
__device__ __forceinline__ s16x4 vtr(lds_cptr p){ return __builtin_bit_cast(s16x4,__builtin_amdgcn_ds_read_tr16_b64_v4i16((__attribute__((address_space(3))) v4i16_t*)p)); }
__device__ __forceinline__ float rowmax(const f32x16&p0,const f32x16&p1){
  float a=max3f(p0[0],p0[1],p1[0]),b=max3f(p0[2],p0[3],p1[1]);a=max3f(a,p1[2],p1[3]);
  #pragma unroll
  for(int r=4;r<16;r+=4){a=max3f(a,p0[r],p0[r+1]);b=max3f(b,p0[r+2],p0[r+3]);a=max3f(a,p1[r],p1[r+1]);b=max3f(b,p1[r+2],p1[r+3]);}
  const float m=max2f(a,b);
  auto rr=__builtin_amdgcn_permlane32_swap(__float_as_uint(m),__float_as_uint(m),false,false);
  return max2f(__uint_as_float(rr[0]),__uint_as_float(rr[1]));
}
__device__ __forceinline__ void pv(f32x16*o,int vb,bf16x8 pa0,bf16x8 pa1,bf16x8 pa2,bf16x8 pa3){
  #pragma unroll
  for(int d0=0;d0<2;++d0){s16x4 lo[4],hi[4];
    #pragma unroll
    for(int ks=0;ks<4;++ks){
      asm volatile("ds_read_b64_tr_b16 %0,%1 offset:%c2":"=&v"(lo[ks]):"v"(vb),"i"(d0*4096+ks*1024):"memory");
      asm volatile("ds_read_b64_tr_b16 %0,%1 offset:%c2":"=&v"(hi[ks]):"v"(vb),"i"(d0*4096+ks*1024+512):"memory");}
    asm volatile("s_waitcnt lgkmcnt(0)":::"memory");SBAR();
    #define PK(k) (bf16x8){lo[k][0],lo[k][1],lo[k][2],lo[k][3],hi[k][0],hi[k][1],hi[k][2],hi[k][3]}
    o[d0]=__builtin_amdgcn_mfma_f32_32x32x16_bf16(pa0,PK(0),o[d0],0,0,0);
    o[d0]=__builtin_amdgcn_mfma_f32_32x32x16_bf16(pa1,PK(1),o[d0],0,0,0);
    o[d0]=__builtin_amdgcn_mfma_f32_32x32x16_bf16(pa2,PK(2),o[d0],0,0,0);
    o[d0]=__builtin_amdgcn_mfma_f32_32x32x16_bf16(pa3,PK(3),o[d0],0,0,0);
    #undef PK
  }
}

#ifndef ATTN_STORE16
#define ATTN_STORE16(p,v) (*(u32x4*)(p)=(v))
#endif
template<int THRL> __device__ __forceinline__ void attn_unit(int b,int qcol,int vcol,int qb,const bf16*Q,const bf16*__restrict__ K,const bf16*__restrict__ V,bf16*O,char*shm){
  int tid_=threadIdx.x; asm volatile("":"+v"(tid_));
  const int tid=tid_,lane=tid&63,r32=lane&31,hi=lane>>5; const int wid=__builtin_amdgcn_readfirstlane(tid>>6);
  const long rowbase=(long)b*SEQ; const int q0=qb*QB;
  const bf16*Qw=Q+(rowbase+q0+wid*QBLK)*DM+qcol;
  const bf16*Kh=K+rowbase*DM+qcol,*Vh=V+rowbase*DM+vcol;
  const unsigned lds0=(unsigned)(uintptr_t)shm;
  float*wsf=(float*)(shm+LDS_WS)+wid*64;
  const bf16*ksrc=Kh+(long)lane*DM+wid*8;
  const bf16*vsrc=Vh+(long)(16*(wid&3)+(lane>>2))*DM+(wid>>2)*32+(lane&3)*8;
  const unsigned kdst=lds0+LDS_K+wid*1024, vdst=lds0+LDS_V+wid*1024;
  #define DMA_K(t,slot) glds16(ksrc+(long)(t)*KVBLK*DM,(unsigned)__builtin_amdgcn_readfirstlane(kdst+(slot)))
  #define DMA_V(t,slot) glds16(vsrc+(long)(t)*KVBLK*DM,(unsigned)__builtin_amdgcn_readfirstlane(vdst+(slot)))
  const int vb0=(int)(lds0+LDS_V)+((lane>>4)&1)*32+(lane&3)*8+(4*hi+((lane&15)>>2))*64;
  const char*Kbase=shm+LDS_K; bf16x8 kf[8];
  const lds_cptr shm3=(lds_cptr)shm; const lds_cptr kp0=shm3+LDS_K+hi*1024+r32*16; const lds_cptr vp0=shm3+LDS_V+((lane>>4)&1)*32+(lane&3)*8+(4*hi+((lane&15)>>2))*64;
  const int NT=(q0+QB)/KVBLK;
  DMA_K(0,0);DMA_V(0,0);DMA_K(1,SLOTB);
  bf16x8 qr[4];
  #pragma unroll
  for(int d0=0;d0<4;++d0)qr[d0]=*reinterpret_cast<const bf16x8*>(&Qw[(long)r32*DM+d0*16+hi*8]);
  float mhat=0.f,l_reg=0.f;f32x16 o[2];o[0]=f32x16{};o[1]=f32x16{};f32x16 negm=f32x16{};asm volatile("":"+v"(negm));
  const int qrel=wid*QBLK+r32;
  #define CMASK(P0,P1,t) do{int jb_=(t)-(NT-4); if(jb_>=0)cmask(P0,P1,jb_,qrel,hi);}while(0)
  bool resc=false;
  #define START(P0,P1) do{ const float rm=rowmax(P0,P1); resc=false; \
    { const float dl=rm; mhat=fadd_s(mhat,dl); \
      _Pragma("unroll") for(int r=0;r<16;++r){P0[r]=fsub_s(P0[r],dl);P1[r]=fsub_s(P1[r],dl);} \
      _Pragma("unroll") for(int r=0;r<16;++r)negm[r]=-mhat; asm volatile("":"+v"(negm)); } \
    _Pragma("unroll") for(int r=0;r<16;++r)P0[r]=__builtin_amdgcn_exp2f(P0[r]); }while(0)
  #define RESC() do{ if(resc){ asm volatile("s_waitcnt lgkmcnt(0)":::"memory"); \
      _Pragma("unroll") for(int d_=0;d_<2;++d_) _Pragma("unroll") for(int r=0;r<16;++r)o[d_][r]*=wsf[crow(r,hi)]; } }while(0)
  f32x16 pA0,pA1,pB0,pB1;
  int sl_prev=0,sl_cur=0,sl_next=SLOTB;
  #define ROT() do{sl_prev=sl_cur;sl_cur=sl_next;sl_next=(sl_next==(NSLOT-1)*SLOTB)?0:sl_next+SLOTB;}while(0)
  DMA_K(2,2*SLOTB);
  WAIT_BAR(3);
  qkt(pA0,pA1,Kbase,qr,negm,r32,hi);asm volatile("s_nop 15\n\ts_nop 7":"+v"(pA0),"+v"(pA1));CMASK(pA0,pA1,0);
  START(pA0,pA1);
  _Pragma("unroll") for(int r=0;r<16;++r)pA1[r]=__builtin_amdgcn_exp2f(pA1[r]);
  WAIT_BAR(0);
  DMA_K(3,0);DMA_V(1,SLOTB);
  ROT();
  kload8(kf,kp0+sl_cur);
  WAIT_BAR(2);
  s16x4 vlo[8],vhi[8]; u32x4 pw0,pw1,pw2,pw3;
  #define PKW(P,B) cvtpk_s(P[B],P[B+1])
  #define PAF(k) __builtin_bit_cast(bf16x8,pw##k)
  #define VFR(i) (bf16x8){vlo[i][0],vlo[i][1],vlo[i][2],vlo[i][3],vhi[i][0],vhi[i][1],vhi[i][2],vhi[i][3]}
  #define PIN(x) asm volatile("":"+v"(x))
  #define MX3(a,b,c) __builtin_fmaxf(__builtin_fmaxf((a),(b)),(c))
  #define GAPA(MF,A0,A1,A2,A3,W0,W1,PW) do{ MF; sacc+=A0; sacc+=A1; sacc+=A2; sacc+=A3; PIN(sacc); W0; W1; PIN(PW); SBAR(); }while(0)
  #define EX(v) __builtin_amdgcn_exp2f(v)
  #define GAPB(MF,X,B) do{ MF; X[B]=EX(X[B]); X[B+1]=EX(X[B+1]); X[B+2]=EX(X[B+2]); X[B+3]=EX(X[B+3]); PIN(X); SBAR(); }while(0)
  #define VRD(i) do{ vlo[i]=vtr(vp_+(((i)>>2)*4096+((i)&3)*1024)); vhi[i]=vtr(vp_+(((i)>>2)*4096+((i)&3)*1024+512)); }while(0)
  #define KRD(G,j) do{ if(G){ kload2(kf,kp0+sl_next,j); SBAR(); } }while(0)
  #define STEP(C0,C1,P0,P1,t,GK,GV,GL) do{ SBAR(); \
    const lds_cptr vp_=vp0+sl_prev; \
    VRD(0); SBAR(); float sacc=(P0[0]+P0[1]); \
    GAPA(C0=__builtin_amdgcn_mfma_f32_32x32x16_bf16(kf[0],qr[0],negm,0,0,0), P0[2],P0[3],P0[4],P0[5],     pw0[0]=PKW(P0,0), pw0[1]=PKW(P0,2), pw0); \
    VRD(4); SBAR(); GAPA(C1=__builtin_amdgcn_mfma_f32_32x32x16_bf16(kf[1],qr[0],negm,0,0,0), P0[6],P0[7],P0[8],P0[9],     pw0[2]=PKW(P0,4), pw0[3]=PKW(P0,6), pw0); \
    VRD(1); SBAR(); GAPA(C0=__builtin_amdgcn_mfma_f32_32x32x16_bf16(kf[2],qr[1],C0,0,0,0),   P0[10],P0[11],P0[12],P0[13], pw1[0]=PKW(P0,8), pw1[1]=PKW(P0,10), pw1); \
    VRD(5); SBAR(); GAPA(C1=__builtin_amdgcn_mfma_f32_32x32x16_bf16(kf[3],qr[1],C1,0,0,0),   P0[14],P0[15],P1[0],P1[1],   pw1[2]=PKW(P0,12),pw1[3]=PKW(P0,14), pw1); \
    VRD(2); SBAR(); GAPA(C0=__builtin_amdgcn_mfma_f32_32x32x16_bf16(kf[4],qr[2],C0,0,0,0),   P1[2],P1[3],P1[4],P1[5],     pw2[0]=PKW(P1,0), pw2[1]=PKW(P1,2), pw2); \
    VRD(6); SBAR(); GAPA(C1=__builtin_amdgcn_mfma_f32_32x32x16_bf16(kf[5],qr[2],C1,0,0,0),   P1[6],P1[7],P1[8],P1[9],     pw2[2]=PKW(P1,4), pw2[3]=PKW(P1,6), pw2); \
    VRD(3); SBAR(); GAPA(C0=__builtin_amdgcn_mfma_f32_32x32x16_bf16(kf[6],qr[3],C0,0,0,0),   P1[10],P1[11],P1[12],P1[13], pw3[0]=PKW(P1,8), pw3[1]=PKW(P1,10), pw3); \
    VRD(7); SBAR(); GAPA(C1=__builtin_amdgcn_mfma_f32_32x32x16_bf16(kf[7],qr[3],C1,0,0,0),   P1[14],P1[15],0.f,0.f,       pw3[2]=PKW(P1,12),pw3[3]=PKW(P1,14), pw3); \
    l_reg+=sacc; \
    if(GK){DMA_K((t)+3,sl_cur);} if(GV){DMA_V((t)+1,sl_next);} \
    CMASK(C0,C1,t); \
    { float a=MX3(C0[0],C0[1],C1[0]),b=MX3(C0[2],C0[3],C1[1]); a=MX3(a,C1[2],C1[3]); \
      _Pragma("unroll") for(int r=4;r<16;r+=4){a=MX3(a,C0[r],C0[r+1]);b=MX3(b,C0[r+2],C0[r+3]);a=MX3(a,C1[r],C1[r+1]);b=MX3(b,C1[r+2],C1[r+3]);} \
      float rm=__builtin_fmaxf(a,b); { auto rr=__builtin_amdgcn_permlane32_swap(__float_as_uint(rm),__float_as_uint(rm),false,false); rm=__builtin_fmaxf(__uint_as_float(rr[0]),__uint_as_float(rr[1])); } \
      resc=false; \
      if(__builtin_expect(__any(rm>(float)THRL),0)){ const float dl=__builtin_fmaxf(rm,0.f); mhat+=dl; \
        _Pragma("unroll") for(int r=0;r<16;++r){C0[r]-=dl;C1[r]-=dl;} \
        _Pragma("unroll") for(int r=0;r<16;++r)negm[r]=-mhat; asm volatile("":"+v"(negm)); \
        const float f=__builtin_amdgcn_exp2f(-dl); l_reg*=f; if(hi==0)wsf[r32]=f; resc=true; } } \
    SBAR(); \
    GAPB(o[0]=__builtin_amdgcn_mfma_f32_32x32x16_bf16(PAF(0),VFR(0),o[0],0,0,0), C0,0); \
    GAPB(o[1]=__builtin_amdgcn_mfma_f32_32x32x16_bf16(PAF(0),VFR(4),o[1],0,0,0), C0,4); \
    KRD(GL,0); GAPB(o[0]=__builtin_amdgcn_mfma_f32_32x32x16_bf16(PAF(1),VFR(1),o[0],0,0,0), C0,8); \
    KRD(GL,1); GAPB(o[1]=__builtin_amdgcn_mfma_f32_32x32x16_bf16(PAF(1),VFR(5),o[1],0,0,0), C0,12); \
    KRD(GL,2); GAPB(o[0]=__builtin_amdgcn_mfma_f32_32x32x16_bf16(PAF(2),VFR(2),o[0],0,0,0), C1,0); \
    KRD(GL,3); GAPB(o[1]=__builtin_amdgcn_mfma_f32_32x32x16_bf16(PAF(2),VFR(6),o[1],0,0,0), C1,4); \
    GAPB(o[0]=__builtin_amdgcn_mfma_f32_32x32x16_bf16(PAF(3),VFR(3),o[0],0,0,0), C1,8); \
    GAPB(o[1]=__builtin_amdgcn_mfma_f32_32x32x16_bf16(PAF(3),VFR(7),o[1],0,0,0), C1,12); \
    }while(0)
  int t=1;
  #undef CMASK
  #define CMASK(P0,P1,t) do{}while(0)
  for(;t+5<NT;t+=2){
    STEP(pB0,pB1,pA0,pA1,t,true,true,true);     WAIT_BAR(2); RESC(); ROT();
    STEP(pA0,pA1,pB0,pB1,t+1,true,true,true);   WAIT_BAR(2); RESC(); ROT();
  }
  #undef CMASK
  #define CMASK(P0,P1,t) do{int jb_=(t)-(NT-4); if(jb_>=0)cmask(P0,P1,jb_,qrel,hi);}while(0)
  #define ENDW(tt) do{ if((tt)+3<NT){WAIT_BAR(2);} else if((tt)+2<NT){WAIT_BAR(1);} else {WAIT_BAR(0);} }while(0)
  for(;t+1<NT;t+=2){
    STEP(pB0,pB1,pA0,pA1,t,(t+3<NT),(t+1<NT),(t+1<NT));       ENDW(t);   RESC(); ROT();
    STEP(pA0,pA1,pB0,pB1,t+1,(t+4<NT),(t+2<NT),(t+2<NT));     ENDW(t+1); RESC(); ROT();
  }
  STEP(pB0,pB1,pA0,pA1,NT-1,false,false,false); RESC();
  { float sacc=pB0[0]+pB0[1]; _Pragma("unroll") for(int r=2;r<16;++r)sacc+=pB0[r]; _Pragma("unroll") for(int r=0;r<16;++r)sacc+=pB1[r]; l_reg+=sacc;
    pw0=(u32x4){PKW(pB0,0),PKW(pB0,2),PKW(pB0,4),PKW(pB0,6)};pw1=(u32x4){PKW(pB0,8),PKW(pB0,10),PKW(pB0,12),PKW(pB0,14)};pw2=(u32x4){PKW(pB1,0),PKW(pB1,2),PKW(pB1,4),PKW(pB1,6)};pw3=(u32x4){PKW(pB1,8),PKW(pB1,10),PKW(pB1,12),PKW(pB1,14)};
    SBAR(); pv(o,vb0+sl_cur,PAF(0),PAF(1),PAF(2),PAF(3)); }
  #undef PKW
  #undef PAF
  #undef VFR
  #undef PIN
  #undef MX3
  #undef GAPA
  #undef GAPB
  #undef EX
  #undef VRD
  #undef KRD
  #undef STEP
  #undef ENDW
  {auto rr=__builtin_amdgcn_permlane32_swap(__float_as_uint(l_reg),__float_as_uint(l_reg),false,false);l_reg=__uint_as_float(rr[0])+__uint_as_float(rr[1]);}
  if(hi==0)wsf[32+r32]=l_reg;asm volatile("s_waitcnt lgkmcnt(0)":::"memory");
  float rli[16];
  #pragma unroll
  for(int r=0;r<16;++r)rli[r]=__builtin_amdgcn_rcpf(wsf[32+crow(r,hi)]);
  bf16*Ow=O+(rowbase+q0+wid*QBLK)*DM+vcol;
  { bf16*stg=(bf16*)(shm+LDS_OST)+wid*2048;
    #pragma unroll
    for(int r=0;r<16;++r){const int orow=crow(r,hi);
      #pragma unroll
      for(int d0=0;d0<2;++d0)stg[orow*64+d0*32+r32]=__float2bfloat16(o[d0][r]*rli[r]);}
    asm volatile("s_waitcnt lgkmcnt(0)":::"memory");
    #pragma unroll
    for(int i=0;i<4;++i){const int row=i*8+(lane>>3),ch=lane&7; const u32x4 v=*(const u32x4*)(stg+row*64+ch*8); ATTN_STORE16(Ow+(long)row*DM+ch*8,v);} }
  asm volatile("s_waitcnt lgkmcnt(0)\n\ts_barrier":::"memory");
  #undef DMA_K
  #undef DMA_V
  #undef CMASK
  #undef START
  #undef RESC
  #undef ROT
}
constexpr int ATTN_LDS_BYTES=LDS_BYTES;
#undef SBAR
#undef WAIT_BAR
}
constexpr int NWAVES = 8;
constexpr int NPH = 15;
constexpr size_t MiB = 1u << 20;
constexpr size_t WS_CTL = 0, CTL_ZERO_BYTES = 1 * MiB;
constexpr size_t WS_W_IN = 1 * MiB;
constexpr size_t WS_W_OUT = WS_W_IN + (size_t)3072 * 1024 * 2;
constexpr size_t WS_W_GU = WS_W_OUT + (size_t)1024 * 1024 * 2;
constexpr size_t WS_W_DN = WS_W_GU + (size_t)5632 * 1024 * 2;
constexpr size_t WS_W_QKV = WS_W_DN + (size_t)1024 * 2816 * 2;
constexpr size_t WS_W_O = WS_W_QKV + (size_t)3072 * 1024 * 2;
constexpr size_t WS_W_MGU = WS_W_O + (size_t)1024 * 1024 * 2;
constexpr size_t WS_W_MDN = WS_W_MGU + (size_t)8 * 7168 * 1024 * 2;
constexpr size_t WS_W_END = WS_W_MDN + (size_t)8 * 1024 * 3584 * 2;
constexpr size_t WS_R = 202 * MiB;
constexpr size_t ACT = (size_t)M * D * 2;
constexpr size_t WS_XN0 = WS_R, WS_BB = WS_R + ACT, WS_UB = WS_R + 2 * ACT, WS_G = WS_R + 3 * ACT;
constexpr size_t WS_HACT = WS_R;
constexpr size_t WS_Q = WS_R + 4 * ACT, WS_K = WS_R + 5 * ACT, WS_V = WS_R + 6 * ACT;
constexpr size_t WS_X8 = WS_R + 5 * ACT;
constexpr size_t WS_O0 = WS_R, WS_O1 = WS_R + ACT, WS_ON = WS_R + 2 * ACT;
constexpr size_t WS_HM = WS_R;
constexpr size_t WS_PP = WS_R + 128 * MiB;
constexpr size_t WS_S = 440 * MiB;
constexpr size_t WS_XG = WS_S, WS_Y = WS_S + 68 * MiB;
constexpr size_t WS_XB = 632 * MiB;
constexpr size_t WS_HB = 664 * MiB, WS_HB2 = 696 * MiB, WS_YF = 728 * MiB;
constexpr size_t WS_SMALL = 792 * MiB;
constexpr size_t WS_SSQ = WS_SMALL;
constexpr size_t WS_SEL = WS_SMALL + 256 * 1024, WS_GATE = WS_SEL + 128 * 1024, WS_TOKSLOT = WS_GATE + 128 * 1024;
constexpr size_t WS_RSTDS = WS_TOKSLOT + 128 * 1024, WS_GATES = WS_RSTDS + 256 * 1024;
constexpr size_t WS_HIST = WS_GATES + 256 * 1024, WS_META = WS_HIST + 16 * 1024;
constexpr size_t WS_NAIVE_SMALL = WS_SMALL + 2 * MiB;
constexpr size_t WS_END = 796 * MiB;
static_assert(WS_W_END <= WS_R && WS_R + (size_t)SLOTS * DFE * 2 <= WS_S && WS_Y + (size_t)SLOTS * D * 2 <= WS_XB && WS_V + ACT <= WS_S, "d_ws map");
constexpr int CW_TMO = 0, CW_CODE = 1, CW_BAR = 4096;
constexpr int MISC_OFF = 0, RING_OFF = 1024, RING_BYTES = 131072, LDS_BYTES = 147456;
constexpr int P0_SCR = 16640;

#define GAS __attribute__((address_space(1)))
#define LAS __attribute__((address_space(3)))
typedef unsigned v4u __attribute__((ext_vector_type(4)));
typedef unsigned v2u __attribute__((ext_vector_type(2)));
typedef GAS unsigned gu32;
#define RLX_AGENT __ATOMIC_RELAXED, __HIP_MEMORY_SCOPE_AGENT
#define LDS_WAIT() asm volatile("s_waitcnt lgkmcnt(0)" ::: "memory")
#define VM_WAIT() asm volatile("s_waitcnt vmcnt(0)" ::: "memory")
__device__ __forceinline__ unsigned pk2(float lo, float hi) { return f2bf(lo) | (f2bf(hi) << 16); }
__device__ __forceinline__ float bflo(unsigned w) { return __builtin_bit_cast(float, w << 16); }
__device__ __forceinline__ float bfhi(unsigned w) { return __builtin_bit_cast(float, w & 0xffff0000u); }

#define XB_TMO      128
#define XB_XCNT(j)  (256  + 64 * (j))
#define XB_XSUB(j)  (1280 + 64 * (j))
#define XB_XGEN(j)  (2304 + 64 * (j))
#define XB_TOP      3328
#define XB_TOPGEN   3392
#define XCD_BAR_WORDS 3456
#define XB_SPIN_CAP (1u << 18)

__device__ __forceinline__ unsigned xb_ld(unsigned* p)              { return __hip_atomic_load(p, __ATOMIC_RELAXED, __HIP_MEMORY_SCOPE_AGENT); }
__device__ __forceinline__ unsigned xb_add(unsigned* p, unsigned v) { return __hip_atomic_fetch_add(p, v, __ATOMIC_RELAXED, __HIP_MEMORY_SCOPE_AGENT); }
__device__ __forceinline__ unsigned xb_xcc_id() { return (unsigned)__builtin_amdgcn_s_getreg((3 << 11) | 20) & 0xFu; }
#define XB_SPIN(cond, bar) do { unsigned _sp = 0; while (cond) { __builtin_amdgcn_s_sleep(1); \
    if ((++_sp & 255u) == 0u) { if (xb_ld(&(bar)[XB_TMO])) break; if (_sp > XB_SPIN_CAP) { atomicAdd(&(bar)[XB_TMO], 1u); break; } } } } while (0)

struct XcdBarrier {
    unsigned* bar; unsigned x;
    volatile LAS unsigned* st;
};

__device__ __forceinline__ XcdBarrier xcd_barrier_post(unsigned* bar, volatile LAS unsigned* st) {
    XcdBarrier b; b.bar = bar; b.x = xb_xcc_id(); b.st = st;
    if (threadIdx.x == 0) (void)xb_add(&bar[XB_XCNT(b.x)], 1u);
    return b;
}
__device__ __forceinline__ void xcd_barrier_complete(unsigned* bar, unsigned x, unsigned& nloc, unsigned& nx) {
    const unsigned G = gridDim.x * gridDim.y * gridDim.z;
    unsigned sum, cnt, mine, sp = 0u;
    for (;;) {
        sum = 0u; cnt = 0u; mine = 0u;
#pragma unroll
        for (unsigned j = 0; j < 16; ++j) { const unsigned c = xb_ld(&bar[XB_XCNT(j)]); sum += c; cnt += (c > 0u) ? 1u : 0u; mine = (j == x) ? c : mine; }
        if (sum == G) break;
        __builtin_amdgcn_s_sleep(1);
        if ((++sp & 255u) == 0u) { if (xb_ld(&bar[XB_TMO])) break; if (sp > XB_SPIN_CAP) { atomicAdd(&bar[XB_TMO], 1u); break; } }
    }
    nloc = mine > 0u ? mine : 1u; nx = cnt > 0u ? cnt : 1u;
}

__device__ __forceinline__ void xcd_barrier(const XcdBarrier& b) {
    asm volatile("s_waitcnt vmcnt(0)" ::: "memory");
    __syncthreads();
    if (threadIdx.x == 0) {
        unsigned* bar = b.bar;
        __builtin_amdgcn_s_waitcnt(0);
        unsigned nloc = b.st[0], nx = b.st[1];
        if (nloc == 0u) { xcd_barrier_complete(bar, b.x, nloc, nx); b.st[0] = nloc; b.st[1] = nx; }
        const unsigned old = xb_add(&bar[XB_XSUB(b.x)], 1u);
        const unsigned gen = old / nloc;
        if (old + 1u == (gen + 1u) * nloc) {
            __builtin_amdgcn_fence(__ATOMIC_RELEASE, "agent");
            asm volatile("s_waitcnt vmcnt(0)" ::: "memory");
            const unsigned og = xb_add(&bar[XB_TOP], 1u);
            const unsigned tg = og / nx;
            if (og + 1u == (tg + 1u) * nx) xb_add(&bar[XB_TOPGEN], 1u);
            else XB_SPIN(xb_ld(&bar[XB_TOPGEN]) == tg, bar);
            __builtin_amdgcn_fence(__ATOMIC_ACQUIRE, "agent");
            xb_add(&bar[XB_XGEN(b.x)], 1u);
            asm volatile("s_waitcnt vmcnt(0)" ::: "memory");
        } else {
            XB_SPIN(xb_ld(&bar[XB_XGEN(b.x)]) == gen, bar);
            __builtin_amdgcn_fence(__ATOMIC_ACQUIRE, "agent");
            asm volatile("s_waitcnt vmcnt(0)" ::: "memory");
        }
    }
    __syncthreads();
}


struct Args { const float* in[19]; float* out; unsigned char* wsp; int ph_lo, ph_hi, li, jobmask; };
struct Frame { LAS unsigned char* lds; int tid, lane, wave, vcu, G; };
#define KA ((const Args*)__builtin_amdgcn_kernarg_segment_ptr())
#define INP(i) (KA->in[i])
#define A_WS (KA->wsp)
#define A_OUT (KA->out)

__device__ __forceinline__ int p0_dstrow(int mode, int aux, int col) {
    if (mode == 1) { if (col < 1024) return col; const int v = col >= 2048, cc = col - (v ? 2048 : 1024); return 1024 + 256 * (cc >> 7) + 128 * v + (cc & 127); }
    if (mode == 2) { const int up = col >= aux, cc = col - (up ? aux : 0); return 256 * (cc >> 7) + 128 * up + (cc & 127); }
    if (mode == 3) { const int g = col >> 6, bj = (col >> 5) & 1; return 256 * (g >> 2) + 32 * (4 * bj + (g & 3)) + (col & 31); }
    return col;
}
struct P0Item { const float* src; const float* gain; unsigned char* dst; int ldw, K, k0, d0, d1, f8; float sc; };
#define P0_JOB(SRC, LDW, KK, C0, NCOLS, GAIN, DSTOFF, DROW0, DSTROWS, MODE, AUX, NMAT, SC, F8) { \
    constexpr int nn_ = (NCOLS) / 64, per_ = ((KK) / 64) * nn_, cnt_ = per_ * (NMAT); \
    if (it < cnt_) { const int mat = it / per_, r = it % per_, kb = r / nn_, col = 64 * (r % nn_); \
        I.src = (SRC) + (size_t)mat * (KK) * (LDW) + (C0) + col; I.gain = (GAIN); I.dst = A_WS + (DSTOFF) + (size_t)mat * (DSTROWS) * (KK) * ((F8) ? 1 : 2); \
        I.ldw = (LDW); I.K = (KK); I.k0 = 64 * kb; I.d0 = (DROW0) + p0_dstrow(MODE, AUX, col); I.d1 = (DROW0) + p0_dstrow(MODE, AUX, col + 32); I.f8 = (F8); I.sc = (SC); return; } \
    it -= cnt_; }
constexpr int P0_NITEMS = 16 * 48 + 16 * 16 + 16 * 88 + 44 * 16 + 3 * 16 * 16 + 16 * 16 + 8 * 16 * 112 + 8 * 56 * 16;
__device__ __forceinline__ void p0_decode(int it, P0Item& I) {
    P0_JOB(INP(3), 3072, 1024, 0, 3072, nullptr, WS_W_IN, 0, 3072, 1, 0, 1, 1.0f, 0)
    P0_JOB(INP(5), 1024, 1024, 0, 1024, nullptr, WS_W_OUT, 0, 1024, 0, 0, 1, 1.0f, 0)
    P0_JOB(INP(14), 5632, 1024, 0, 5632, INP(2), WS_W_GU, 0, 5632, 2, 2816, 1, pg8::F8_SWGD, 1)
    P0_JOB(INP(15), 1024, 2816, 0, 1024, nullptr, WS_W_DN, 0, 1024, 0, 0, 1, pg8::F8_SWDD, 1)
    P0_JOB(INP(9), 1024, 1024, 0, 1024, INP(1) + 1024, WS_W_QKV, 0, 3072, 3, 0, 1, 1.0f, 0)
    P0_JOB(INP(7), 2048, 1024, 0, 1024, INP(6), WS_W_QKV, 1024, 3072, 3, 0, 1, 1.0f, 0)
    P0_JOB(INP(7), 2048, 1024, 1024, 1024, INP(6), WS_W_QKV, 2048, 3072, 0, 0, 1, 1.0f, 0)
    P0_JOB(INP(13), 1024, 1024, 0, 1024, nullptr, WS_W_O, 0, 1024, 0, 0, 1, 1.0f, 0)
    P0_JOB(INP(17), 7168, 1024, 0, 7168, INP(2) + 1024, WS_W_MGU, 0, 7168, 2, 3584, 8, pg8::F8_SWG, 1)
    P0_JOB(INP(18), 1024, 3584, 0, 1024, nullptr, WS_W_MDN, 0, 1024, 0, 0, 8, pg8::F8_SWD, 1)
}
#undef P0_JOB
struct P0Regs { f32x4 v[16]; float g[16]; };
__device__ __forceinline__ void p0_load(const P0Item& I, P0Regs& R, int lane) {
    const int lr = lane >> 4, lc = lane & 15;
#pragma unroll
    for (int i = 0; i < 16; ++i) R.v[i] = *(const GAS f32x4*)(I.src + (size_t)(I.k0 + 4 * i + lr) * I.ldw + 4 * lc);
    if (I.gain) {
#pragma unroll
        for (int i = 0; i < 16; ++i) R.g[i] = I.gain[I.k0 + 4 * i + lr];
    } else {
#pragma unroll
        for (int i = 0; i < 16; ++i) R.g[i] = 1.0f;
    }
}
__device__ __forceinline__ void p0_store(const P0Item& I, const P0Regs& R, LAS float* scr, int lane) {
    const int lr = lane >> 4, lc = lane & 15;
#pragma unroll
    for (int i = 0; i < 16; ++i) { const f32x4 w = R.v[i] * (R.g[i] * I.sc); LAS float* p = scr + (4 * i + lr) * 65 + 4 * lc; p[0] = w[0]; p[1] = w[1]; p[2] = w[2]; p[3] = w[3]; }
    LDS_WAIT(); asm volatile("" ::: "memory");
    const int c = lane & 7;
#pragma unroll
    for (int jj = 0; jj < 8; ++jj) { const int nl = 8 * jj + (lane >> 3); const LAS float* s = scr + (8 * c) * 65 + nl;
        const int drow = (jj < 4 ? I.d0 : I.d1 - 32) + nl;
        if (I.f8) { v2u o; o.x = pg8::pk4_fp8(s[0], s[65], s[130], s[195]); o.y = pg8::pk4_fp8(s[260], s[325], s[390], s[455]);
            *(GAS v2u*)(I.dst + (size_t)drow * I.K + I.k0 + 8 * c) = o; }
        else { v4u o; o.x = pk2(s[0], s[65]); o.y = pk2(s[130], s[195]); o.z = pk2(s[260], s[325]); o.w = pk2(s[390], s[455]);
            *(GAS v4u*)(I.dst + ((size_t)drow * I.K + I.k0 + 8 * c) * 2) = o; } }
    LDS_WAIT(); asm volatile("" ::: "memory");
}
__device__ __forceinline__ void rms_row_bf16(const float* xrow, const float* g, bf16_t* orow, int lane) {
    const GAS f32x4* xr = (const GAS f32x4*)xrow + lane; const GAS f32x4* gr = (const GAS f32x4*)g + lane;
    f32x4 v[4]; float s = 0.f;
#pragma unroll
    for (int j = 0; j < 4; ++j) { v[j] = xr[64 * j]; s += (v[j][0] * v[j][0] + v[j][1] * v[j][1]) + (v[j][2] * v[j][2] + v[j][3] * v[j][3]); }
    const float rstd = __builtin_amdgcn_rsqf(wave_sum(s) * (1.f / D) + EPS);
    GAS v2u* o8 = (GAS v2u*)orow + lane;
#pragma unroll
    for (int j = 0; j < 4; ++j) { const f32x4 gg = gr[64 * j]; v2u o; o.x = pk2(v[j][0] * rstd * gg[0], v[j][1] * rstd * gg[1]); o.y = pk2(v[j][2] * rstd * gg[2], v[j][3] * rstd * gg[3]); o8[64 * j] = o; }
}
__device__ __forceinline__ void p0_prologue(Frame& F) {
    const int gw = F.vcu * NWAVES + F.wave, NGW = F.G * NWAVES;
    {
        const float* x = INP(0); const float* g = INP(1); bf16_t* XN = (bf16_t*)(A_WS + WS_XN0);
        const GAS f32x4* gr = (const GAS f32x4*)g + F.lane; f32x4 gg[4];
#pragma unroll
        for (int j = 0; j < 4; ++j) gg[j] = gr[64 * j];
        for (int mb = gw; mb < M; mb += 4 * NGW) { f32x4 v[4][4];
#pragma unroll
            for (int i = 0; i < 4; ++i) { const int m = mb + i * NGW; if (m < M) { const GAS f32x4* xr = (const GAS f32x4*)(x + (size_t)m * D) + F.lane;
#pragma unroll
                for (int j = 0; j < 4; ++j) v[i][j] = xr[64 * j]; } }
#pragma unroll
            for (int i = 0; i < 4; ++i) { const int m = mb + i * NGW; if (m >= M) break; float s = 0.f;
#pragma unroll
                for (int j = 0; j < 4; ++j) s += (v[i][j][0] * v[i][j][0] + v[i][j][1] * v[i][j][1]) + (v[i][j][2] * v[i][j][2] + v[i][j][3] * v[i][j][3]);
                const float rstd = __builtin_amdgcn_rsqf(wave_sum(s) * (1.f / D) + EPS); GAS v2u* o8 = (GAS v2u*)(XN + (size_t)m * D) + F.lane;
#pragma unroll
                for (int j = 0; j < 4; ++j) { v2u o; o.x = pk2(v[i][j][0] * rstd * gg[j][0], v[i][j][1] * rstd * gg[j][1]); o.y = pk2(v[i][j][2] * rstd * gg[j][2], v[i][j][3] * rstd * gg[j][3]); o8[64 * j] = o; } } }
    }
    LAS float* scr = (LAS float*)(F.lds + RING_OFF + F.wave * P0_SCR);
    int it = gw; if (it >= P0_NITEMS) return;
    P0Item cur; P0Regs ra; p0_decode(it, cur); p0_load(cur, ra, F.lane);
    for (;;) { const int nit = it + NGW; const bool has = nit < P0_NITEMS; P0Item nx; P0Regs rb;
        if (has) { p0_decode(nit, nx); p0_load(nx, rb, F.lane); }
        p0_store(cur, ra, scr, F.lane);
        if (!has) break;
        cur = nx; ra = rb; it = nit; }
}

__device__ __forceinline__ void up8(const v4u w, float (&f)[8]) { f[0] = bflo(w.x); f[1] = bfhi(w.x); f[2] = bflo(w.y); f[3] = bfhi(w.y); f[4] = bflo(w.z); f[5] = bfhi(w.z); f[6] = bflo(w.w); f[7] = bfhi(w.w); }
__device__ __forceinline__ void p2_conv(Frame& F) {
    const bf16_t* Bb = (const bf16_t*)(A_WS + WS_BB); const bf16_t* Ub = (const bf16_t*)(A_WS + WS_UB); bf16_t* G = (bf16_t*)(A_WS + WS_G); const float* cw = INP(4);
    const int gw = F.vcu * NWAVES + F.wave, NGW = F.G * NWAVES;
    for (int strip = gw; strip < 2048; strip += NGW) {
        const int r0 = (strip >> 1) * 16, c0 = (strip & 1) * 512 + F.lane * 8;
        float w0[8], w1[8], w2[8], um2[8], um1[8];
#pragma unroll
        for (int j = 0; j < 8; ++j) { w0[j] = cw[c0 + j]; w1[j] = cw[D + c0 + j]; w2[j] = cw[2 * D + c0 + j]; um2[j] = 0.f; um1[j] = 0.f; }
        if ((r0 & (SEQ - 1)) != 0) { up8(*(const GAS v4u*)(Ub + (size_t)(r0 - 2) * D + c0), um2); up8(*(const GAS v4u*)(Ub + (size_t)(r0 - 1) * D + c0), um1); }
#pragma unroll
        for (int hb = 0; hb < 2; ++hb) { v4u ru[8], rb[8];
#pragma unroll
            for (int i = 0; i < 8; ++i) { ru[i] = *(const GAS v4u*)(Ub + (size_t)(r0 + 8 * hb + i) * D + c0); rb[i] = *(const GAS v4u*)(Bb + (size_t)(r0 + 8 * hb + i) * D + c0); }
#pragma unroll
            for (int ii = 0; ii < 8; ++ii) { const int i = 8 * hb + ii; float u[8], b[8]; up8(ru[ii], u); up8(rb[ii], b);
            float g[8];
#pragma unroll
            for (int j = 0; j < 8; ++j) { g[j] = b[j] * (w0[j] * um2[j] + w1[j] * um1[j] + w2[j] * u[j]); um2[j] = um1[j]; um1[j] = u[j]; }
            v4u o; o.x = pk2(g[0], g[1]); o.y = pk2(g[2], g[3]); o.z = pk2(g[4], g[5]); o.w = pk2(g[6], g[7]);
            *(GAS v4u*)(G + (size_t)(r0 + i) * D + c0) = o; } }
    }
}

__device__ __forceinline__ void p8_diff(Frame& F) {
    const bf16_t* O0 = (const bf16_t*)(A_WS + WS_O0); const bf16_t* O1 = (const bf16_t*)(A_WS + WS_O1); bf16_t* ON = (bf16_t*)(A_WS + WS_ON);
    const float* lp = INP(11); const float* sn = INP(12); const int lane = F.lane;
    const float lam = __expf(wave_sum(lp[lane] * lp[64 + lane])) - __expf(wave_sum(lp[128 + lane] * lp[192 + lane])) + LAM_INIT;
    float gn[16];
#pragma unroll
    for (int j = 0; j < 16; ++j) gn[j] = sn[16 * (lane & 7) + j] * (1.f - LAM_INIT);
    const int gw = F.vcu * NWAVES + F.wave, NGW = F.G * NWAVES;
    for (int rowb = gw; rowb < M; rowb += 4 * NGW) {
        v4u ra[4][2], rb[4][2];
#pragma unroll
        for (int i = 0; i < 4; ++i) { const int row = rowb + i * NGW; if (row < M) { const size_t off = (size_t)row * D + 16 * lane;
            ra[i][0] = *(const GAS v4u*)(O0 + off); ra[i][1] = *(const GAS v4u*)(O0 + off + 8); rb[i][0] = *(const GAS v4u*)(O1 + off); rb[i][1] = *(const GAS v4u*)(O1 + off + 8); } }
#pragma unroll
        for (int i = 0; i < 4; ++i) { const int row = rowb + i * NGW; if (row >= M) break; const size_t off = (size_t)row * D + 16 * lane;
            float a[16], a0[8], a1[8], b0[8], b1[8]; up8(ra[i][0], a0); up8(ra[i][1], a1); up8(rb[i][0], b0); up8(rb[i][1], b1);
            float s = 0.f;
#pragma unroll
            for (int j = 0; j < 8; ++j) { a[j] = a0[j] - lam * b0[j]; a[8 + j] = a1[j] - lam * b1[j]; s += a[j] * a[j] + a[8 + j] * a[8 + j]; }
            s += __shfl_xor(s, 1); s += __shfl_xor(s, 2); s += __shfl_xor(s, 4);
            const float rstd = __builtin_amdgcn_rsqf(s * (1.f / VD) + EPS);
            v4u o0, o1; o0.x = pk2(a[0] * rstd * gn[0], a[1] * rstd * gn[1]); o0.y = pk2(a[2] * rstd * gn[2], a[3] * rstd * gn[3]); o0.z = pk2(a[4] * rstd * gn[4], a[5] * rstd * gn[5]); o0.w = pk2(a[6] * rstd * gn[6], a[7] * rstd * gn[7]);
            o1.x = pk2(a[8] * rstd * gn[8], a[9] * rstd * gn[9]); o1.y = pk2(a[10] * rstd * gn[10], a[11] * rstd * gn[11]); o1.z = pk2(a[12] * rstd * gn[12], a[13] * rstd * gn[13]); o1.w = pk2(a[14] * rstd * gn[14], a[15] * rstd * gn[15]);
            *(GAS v4u*)(ON + off) = o0; *(GAS v4u*)(ON + off + 8) = o1; }
    }
}

#define TR_STEP(n, m) do { _Pragma("unroll") for (int i = 0; i < (n) / 2; ++i) { const bool up = (lane & (m)) != 0; const float keep = up ? v[i + (n) / 2] : v[i], send = up ? v[i] : v[i + (n) / 2]; v[i] = keep + __shfl_xor(send, (m)); } } while (0)
__device__ __forceinline__ void p10a_router(Frame& F) {
    const bf16_t* x3 = (const bf16_t*)(A_WS + WS_XB); const float* g = INP(2) + D; const float* Wr = INP(16); const float* ssq = (const float*)(A_WS + WS_SSQ);
    int* sel = (int*)(A_WS + WS_SEL); float* gate = (float*)(A_WS + WS_GATE); int* hist = (int*)(A_WS + WS_HIST);
    LAS f32x4* WL = (LAS f32x4*)(F.lds + RING_OFF);
    LAS int* lcnt = (LAS int*)(F.lds + RING_OFF + 32768);
    const int lane = F.lane;
    for (int k = F.tid; k < D; k += NWAVES * 64) { const float gk = g[k]; const f32x4 w0 = *(const GAS f32x4*)(Wr + (size_t)k * 8) * gk, w1 = *(const GAS f32x4*)(Wr + (size_t)k * 8 + 4) * gk;
        const int base = (((k >> 8) * 4 + (k & 3)) * 2) * 64 + ((k >> 2) & 63); WL[base] = w0; WL[base + 64] = w1; }
    LDS_WAIT(); __syncthreads();
    for (int blk = blockIdx.x; blk < M / 64; blk += F.G) {
        const int row0 = 64 * blk + 8 * F.wave;
        f32x4 xv[8][4];
#pragma unroll
        for (int r = 0; r < 8; ++r)
#pragma unroll
            for (int j = 0; j < 4; ++j) { const v2u w = *((const GAS v2u*)(x3 + (size_t)(row0 + r) * D) + lane + 64 * j); xv[r][j] = (f32x4){bflo(w.x), bfhi(w.x), bflo(w.y), bfhi(w.y)}; }
        float v[64];
#pragma unroll
        for (int i = 0; i < 64; ++i) v[i] = 0.f;
#pragma unroll
        for (int j = 0; j < 4; ++j)
#pragma unroll
            for (int q = 0; q < 4; ++q) { const f32x4 wa = WL[((j * 4 + q) * 2) * 64 + lane], wb = WL[((j * 4 + q) * 2 + 1) * 64 + lane];
#pragma unroll
                for (int r = 0; r < 8; ++r) { const float xx = xv[r][j][q];
                    v[r * 8 + 0] += xx * wa[0]; v[r * 8 + 1] += xx * wa[1]; v[r * 8 + 2] += xx * wa[2]; v[r * 8 + 3] += xx * wa[3];
                    v[r * 8 + 4] += xx * wb[0]; v[r * 8 + 5] += xx * wb[1]; v[r * 8 + 6] += xx * wb[2]; v[r * 8 + 7] += xx * wb[3]; } }
        TR_STEP(64, 32); TR_STEP(32, 16); TR_STEP(16, 8); TR_STEP(8, 4); TR_STEP(4, 2); TR_STEP(2, 1);
        float lg[8];
#pragma unroll
        for (int e = 0; e < 8; ++e) lg[e] = __shfl(v[0], (lane & ~7) | e);
        int i0 = 0; float v0 = lg[0];
#pragma unroll
        for (int e = 1; e < 8; ++e) if (lg[e] > v0) { v0 = lg[e]; i0 = e; }
        int i1 = 0; float v1 = -INFINITY;
#pragma unroll
        for (int e = 0; e < 8; ++e) if (e != i0 && lg[e] > v1) { v1 = lg[e]; i1 = e; }
        const int row = row0 + (lane >> 3); const float rs = pg8::rstd_of(ssq, row);
        const float g1 = 1.f / (1.f + expf((v0 - v1) * rs)); const bool wrt = (lane & 7) == 0;
        if (wrt) { sel[2 * row] = i0; sel[2 * row + 1] = i1; gate[2 * row] = 1.f - g1; gate[2 * row + 1] = g1; }
        int mycnt = 0;
#pragma unroll
        for (int e = 0; e < 8; ++e) { const int c = __popcll(__ballot(wrt && i0 == e)) + __popcll(__ballot(wrt && i1 == e)); if (lane == e) mycnt = c; }
        if (lane < 8) lcnt[F.wave * 8 + lane] = mycnt;
        LDS_WAIT(); __syncthreads();
        if (F.tid < 8) { int c = 0;
#pragma unroll
            for (int w = 0; w < 8; ++w) c += lcnt[w * 8 + F.tid];
            hist[blk * 8 + F.tid] = c; }
        LDS_WAIT(); __syncthreads();
    }
}
#undef TR_STEP
__device__ __forceinline__ void p10b_assign(Frame& F) {
    const int* hist = (const int*)(A_WS + WS_HIST); const int* sel = (const int*)(A_WS + WS_SEL); const float* gate = (const float*)(A_WS + WS_GATE); const float* ssq = (const float*)(A_WS + WS_SSQ);
    int* tok_slot = (int*)(A_WS + WS_TOKSLOT); float* gates = (float*)(A_WS + WS_GATES); int* meta = (int*)(A_WS + WS_META);
    const bf16_t* x3 = (const bf16_t*)(A_WS + WS_XB); unsigned char* XG = A_WS + WS_XG;
    LAS int* pre = (LAS int*)(F.lds + RING_OFF);
    LAS int* tot = pre + 2048;
    LAS int* ebase = tot + 8;
    LAS int* lslot = ebase + 8;
    const int lane = F.lane, e = F.wave;
    { int h[4], run = 0;
#pragma unroll
      for (int i = 0; i < 4; ++i) { h[i] = hist[(4 * lane + i) * 8 + e]; }
      const int mine = h[0] + h[1] + h[2] + h[3]; int inc = mine;
#pragma unroll
      for (int o = 1; o < 64; o <<= 1) { const int t = __shfl_up(inc, o); if (lane >= o) inc += t; }
      run = inc - mine;
#pragma unroll
      for (int i = 0; i < 4; ++i) { pre[(4 * lane + i) * 8 + e] = run; run += h[i]; }
      if (lane == 63) tot[e] = inc; }
    LDS_WAIT(); __syncthreads();
    if (F.tid == 0) { int b = 0; for (int k = 0; k < 8; ++k) { ebase[k] = b; if (blockIdx.x == 0) meta[k] = b >> 8; b += (tot[k] + 255) & ~255; } if (blockIdx.x == 0) { const int T = b >> 8, full = 2 * F.G / 4; meta[8] = T; meta[9] = T < full ? T : full; } }
    LDS_WAIT(); __syncthreads();
    for (int blk = blockIdx.x; blk < M / 64; blk += F.G) {
        if (F.wave == 0) { const int t = 64 * blk + lane; const int s0 = sel[2 * t], s1 = sel[2 * t + 1]; int sl0 = 0, sl1 = 0;
            const unsigned long long below = (1ull << lane) - 1ull;
#pragma unroll
            for (int k = 0; k < 8; ++k) { const unsigned long long m0 = __ballot(s0 == k), m1 = __ballot(s1 == k); const int b0 = ebase[k] + pre[blk * 8 + k];
                if (s0 == k) sl0 = b0 + __popcll(m0 & below); if (s1 == k) sl1 = b0 + __popcll(m0) + __popcll(m1 & below); }
            tok_slot[2 * t] = sl0; tok_slot[2 * t + 1] = sl1; lslot[2 * lane] = sl0; lslot[2 * lane + 1] = sl1;
            gates[sl0] = gate[2 * t]; gates[sl1] = gate[2 * t + 1]; }
        LDS_WAIT(); __syncthreads();
        v4u xw[8][2];
#pragma unroll
        for (int i = 0; i < 8; ++i) { const GAS v4u* xr = (const GAS v4u*)(x3 + (size_t)(64 * blk + 8 * F.wave + i) * D + 16 * lane); xw[i][0] = xr[0]; xw[i][1] = xr[1]; }
#pragma unroll
        for (int i = 0; i < 8; ++i) { const int tl = 8 * F.wave + i; const int t = 64 * blk + tl;
            const float rs = pg8::rstd_of(ssq, t) * pg8::F8_SA; float a[8], b[8]; up8(xw[i][0], a); up8(xw[i][1], b);
            v4u o; o.x = pg8::pk4_fp8(a[0] * rs, a[1] * rs, a[2] * rs, a[3] * rs); o.y = pg8::pk4_fp8(a[4] * rs, a[5] * rs, a[6] * rs, a[7] * rs); o.z = pg8::pk4_fp8(b[0] * rs, b[1] * rs, b[2] * rs, b[3] * rs); o.w = pg8::pk4_fp8(b[4] * rs, b[5] * rs, b[6] * rs, b[7] * rs);
            const int sl0 = lslot[2 * tl], sl1 = lslot[2 * tl + 1];
            *(GAS v4u*)(XG + (size_t)sl0 * D + 16 * lane) = o; *(GAS v4u*)(XG + (size_t)sl1 * D + 16 * lane) = o; }
        LDS_WAIT(); __syncthreads();
    }
}
__device__ __forceinline__ void p13_load_y(const bf16_t* Y, const float* Pp, const float* gates, int nfull, int slot, int lane, v2u (&y)[4]) {
    const int rt = (slot >> 8) - nfull;
    if (rt < 0) { const GAS v2u* yr = (const GAS v2u*)(Y + (size_t)slot * D) + lane;
#pragma unroll
        for (int j = 0; j < 4; ++j) y[j] = yr[64 * j];
    } else { const float gt = gates[slot] * (1.0f / (pg8::F8_SH * pg8::F8_SWD));
#pragma unroll
        for (int j = 0; j < 4; ++j) { f32x4 s = (f32x4){0.f, 0.f, 0.f, 0.f};
#pragma unroll
            for (int kp = 0; kp < pg8::MoeOrder::SPL; ++kp) s += *((const GAS f32x4*)(Pp + ((size_t)(rt * pg8::MoeOrder::SPL + kp) * 256 + (slot & 255)) * D) + lane + 64 * j);
            y[j].x = pk2(s[0] * gt, s[1] * gt); y[j].y = pk2(s[2] * gt, s[3] * gt); } }
}
__device__ __forceinline__ void p13_final(Frame& F) {
    const int* tok_slot = (const int*)(A_WS + WS_TOKSLOT); const bf16_t* Y = (const bf16_t*)(A_WS + WS_Y); const bf16_t* X3 = (const bf16_t*)(A_WS + WS_XB); float* out = A_OUT;
    const float* Pp = (const float*)(A_WS + WS_PP); const float* gates = (const float*)(A_WS + WS_GATES); const int nfull = ((const int*)(A_WS + WS_META))[9];
    const int gw = F.vcu * NWAVES + F.wave, NGW = F.G * NWAVES, lane = F.lane;
    for (int rowb = gw; rowb < M; rowb += 2 * NGW) {
        v2u xa[2][4], ya[2][4], yb[2][4];
#pragma unroll
        for (int i = 0; i < 2; ++i) { const int row = rowb + i * NGW; if (row < M) { const int s0 = tok_slot[2 * row], s1 = tok_slot[2 * row + 1];
            const GAS v2u* xr = (const GAS v2u*)(X3 + (size_t)row * D) + lane;
#pragma unroll
            for (int j = 0; j < 4; ++j) xa[i][j] = xr[64 * j];
            p13_load_y(Y, Pp, gates, nfull, s0, lane, ya[i]); p13_load_y(Y, Pp, gates, nfull, s1, lane, yb[i]); } }
#pragma unroll
        for (int i = 0; i < 2; ++i) { const int row = rowb + i * NGW; if (row >= M) break; GAS f32x4* orow = (GAS f32x4*)(out + (size_t)row * D) + lane;
#pragma unroll
            for (int j = 0; j < 4; ++j) { const v2u x = xa[i][j], a = ya[i][j], b = yb[i][j];
                orow[64 * j] = (f32x4){bflo(x.x) + (bflo(a.x) + bflo(b.x)), bfhi(x.x) + (bfhi(a.x) + bfhi(b.x)), bflo(x.y) + (bflo(a.y) + bflo(b.y)), bfhi(x.y) + (bfhi(a.y) + bfhi(b.y))}; } }
    }
}

__global__ void __launch_bounds__(NWAVES * 64, 2) mega_fwd(Args args) {
    extern __shared__ __attribute__((aligned(16))) unsigned char lds[];
    Frame F;
    F.lds = (LAS unsigned char*)lds; F.tid = threadIdx.x; F.lane = F.tid & 63; F.wave = __builtin_amdgcn_readfirstlane(F.tid >> 6);
    F.G = gridDim.x; { const int bx = blockIdx.x; F.vcu = (F.G % 8 == 0) ? (bx % 8) * (F.G / 8) + bx / 8 : bx; }
    for (int u = F.tid; u < RING_OFF / 4; u += NWAVES * 64) ((LAS unsigned*)(F.lds + MISC_OFF))[u] = 0u;
    __syncthreads();
    if (KA->ph_hi - KA->ph_lo > 1) (void)xcd_barrier_post((unsigned*)(A_WS + WS_CTL) + CW_BAR + KA->li * XCD_BAR_WORDS, (volatile LAS unsigned*)(F.lds + MISC_OFF + 32));
#define IN(k) (KA->ph_lo <= (k) && (k) < KA->ph_hi)
#define SEAM(k) do { if (IN(k) && IN((k) + 1)) { XcdBarrier b_; b_.bar = (unsigned*)(A_WS + WS_CTL) + CW_BAR + KA->li * XCD_BAR_WORDS; b_.x = xb_xcc_id(); b_.st = (volatile LAS unsigned*)(F.lds + MISC_OFF + 32); xcd_barrier(b_); } } while (0)
#define ws A_WS
#define XB ((bf16_t*)(A_WS + WS_XB))
#define SSQ ((float*)(A_WS + WS_SSQ))

    if (IN(0)) { p0_prologue(F); } SEAM(0);
    if (IN(1)) { pg8::Gemm g{(const bf16_t*)(ws + WS_XN0), (const bf16_t*)(ws + WS_W_IN), M, 3072, 1024}; pg8::StaticOrder S; S.init(M, 3072, F.G, (int)blockIdx.x);
        pg8::EpiInProj E{(bf16_t*)(ws + WS_BB), (bf16_t*)(ws + WS_UB)};
        pg8::gemm_phase<pg8::EpiInProj, pg8::StaticOrder, true, true>(F.lds + RING_OFF, g, S, E); } SEAM(1);
    if (IN(2)) { p2_conv(F); } SEAM(2);
    if (IN(3)) { pg8::Gemm g{(const bf16_t*)(ws + WS_G), (const bf16_t*)(ws + WS_W_OUT), M, 1024, 1024}; pg8::StaticOrder S; S.init(M, 1024, F.G, (int)blockIdx.x);
        pg8::EpiResidSsq<true> E{INP(0), XB, SSQ, 1.0f, ws + WS_X8};
        pg8::gemm_phase<pg8::EpiResidSsq<true>, pg8::StaticOrder, false, true>(F.lds + RING_OFF, g, S, E); } SEAM(3);
    if (IN(4)) { pg8::Gemm g{(const bf16_t*)(ws + WS_X8), (const bf16_t*)(ws + WS_W_GU), M, 5632, 512}; pg8::StaticOrder S; S.init(M, 5632, F.G, (int)blockIdx.x);
        pg8::EpiSwiGLU<true> E{ws + WS_HACT, DFF, SSQ, nullptr, 22, 1.0f / (pg8::F8_SX * pg8::F8_SWGD)};
        pg8::gemm_phase<pg8::EpiSwiGLU<true>, pg8::StaticOrder, true, true, true>(F.lds + RING_OFF, g, S, E); } SEAM(4);
    if (IN(5)) { pg8::Gemm g{(const bf16_t*)(ws + WS_HACT), (const bf16_t*)(ws + WS_W_DN), M, 1024, DFF / 2}; pg8::StaticOrder S; S.init(M, 1024, F.G, (int)blockIdx.x);
        pg8::EpiResidSsq<false> E{nullptr, XB, SSQ, 1.0f / (pg8::F8_SHD * pg8::F8_SWDD), nullptr};
        pg8::gemm_phase<pg8::EpiResidSsq<false>, pg8::StaticOrder, false, true, true>(F.lds + RING_OFF, g, S, E); } SEAM(5);
    if (IN(6)) { pg8::Gemm g{XB, (const bf16_t*)(ws + WS_W_QKV), M, 3072, 1024}; pg8::StaticOrder S; S.init(M, 3072, F.G, (int)blockIdx.x);
        pg8::EpiQKV E{(bf16_t*)(ws + WS_Q), (bf16_t*)(ws + WS_K), (bf16_t*)(ws + WS_V), SSQ, INP(10), INP(8), attn_body::C2};
        pg8::gemm_phase<pg8::EpiQKV, pg8::StaticOrder, true, true>(F.lds + RING_OFF, g, S, E); } SEAM(6);
    if (IN(7)) {
        for (int vh = F.vcu; vh < BATCH * 32; vh += F.G) { const int b = vh >> 5, r = vh & 31, h = r >> 2, c = (r >> 1) & 1, vhalf = r & 1;
            attn_body::bf16* O = (attn_body::bf16*)(ws + (c ? WS_O1 : WS_O0));
            for (int qb = SEQ / 256 - 1; qb >= 0; --qb)
                attn_body::attn_unit<8>(b, (2 * h + c) * 64, h * 128 + vhalf * 64, qb, (const attn_body::bf16*)(ws + WS_Q), (const attn_body::bf16*)(ws + WS_K), (const attn_body::bf16*)(ws + WS_V), O, (char*)lds + RING_OFF); }
    } SEAM(7);
    if (IN(8)) { p8_diff(F); } SEAM(8);
    if (IN(9)) { pg8::Gemm g{(const bf16_t*)(ws + WS_ON), (const bf16_t*)(ws + WS_W_O), M, 1024, 1024}; pg8::StaticOrder S; S.init(M, 1024, F.G, (int)blockIdx.x);
        pg8::EpiResidSsq<false> E{nullptr, XB, SSQ, 1.0f, nullptr};
        pg8::gemm_phase<pg8::EpiResidSsq<false>, pg8::StaticOrder, false, true>(F.lds + RING_OFF, g, S, E); } SEAM(9);
    if (IN(10)) { p10a_router(F); } SEAM(10);
    if (IN(11)) { p10b_assign(F); } SEAM(11);
    if (IN(12)) { pg8::Gemm g{(const bf16_t*)(ws + WS_XG), (const bf16_t*)(ws + WS_W_MGU), SLOTS, 8 * 7168, 512}; pg8::MoeOrder S; S.init((const int*)(ws + WS_META), 28, F.G, (int)blockIdx.x, false);
        pg8::EpiSwiGLU8 E{ws + WS_HM, DFE, 28};
        pg8::gemm_phase<pg8::EpiSwiGLU8, pg8::MoeOrder, true, true, true>(F.lds + RING_OFF, g, S, E); } SEAM(12);
    if (IN(13)) { pg8::Gemm g{(const bf16_t*)(ws + WS_HM), (const bf16_t*)(ws + WS_W_MDN), SLOTS, 8 * 1024, DFE / 2}; pg8::MoeOrder S; S.init((const int*)(ws + WS_META), 4, F.G, (int)blockIdx.x, true);
        pg8::EpiMoeDown E{(bf16_t*)(ws + WS_Y), (const float*)(ws + WS_GATES), 1.0f / (pg8::F8_SH * pg8::F8_SWD), (float*)(ws + WS_PP)};
        pg8::gemm_phase<pg8::EpiMoeDown, pg8::MoeOrder, true, true, true>(F.lds + RING_OFF, g, S, E); } SEAM(13);
    if (IN(14)) { p13_final(F); }
#undef IN
#undef SEAM
#undef ws
#undef XB
#undef SSQ
}
#ifndef MEGA_UPTO
#define MEGA_UPTO 15
#endif
#ifndef MEGA_REPMASK
#define MEGA_REPMASK 0
#endif
#ifndef MEGA_ONE
#define MEGA_ONE 1
#endif
extern "C" void kernel_launch(void* const* d_in, const int* in_sizes, int n_in, void* d_out, int out_size, void* d_ws, size_t ws_size, hipStream_t stream) {
    static int grid = 0;
    if (grid == 0) {
        if (n_in != 19 || in_sizes[0] != M * D || out_size != M * D || ws_size < WS_END) { fprintf(stderr, "kernel_launch: unexpected shapes / workspace (%d inputs, ws %zu, need %zu)\n", n_in, ws_size, (size_t)WS_END); grid = -1; return; }
        int dev = 0, cus = 0, per_cu = 0;
        if (hipGetDevice(&dev) != hipSuccess || hipDeviceGetAttribute(&cus, hipDeviceAttributeMultiprocessorCount, dev) != hipSuccess) { grid = -1; return; }
        if (hipFuncSetAttribute((const void*)mega_fwd, hipFuncAttributeMaxDynamicSharedMemorySize, LDS_BYTES) != hipSuccess) { fprintf(stderr, "kernel_launch: hipFuncSetAttribute failed\n"); grid = -1; return; }
        if (hipOccupancyMaxActiveBlocksPerMultiprocessor(&per_cu, (const void*)mega_fwd, NWAVES * 64, LDS_BYTES) != hipSuccess || per_cu < 1) fprintf(stderr, "kernel_launch: note: occupancy query says %d\n", per_cu);
        (void)hipGetLastError();
        grid = cus < 256 ? cus : 256;
        if (grid != 256) fprintf(stderr, "kernel_launch: %d CUs; this kernel is built for 256\n", cus);
    }
    if (grid < 0) return;
    unsigned char* ws = (unsigned char*)d_ws; float* out = (float*)d_out;
    constexpr int UPTO = MEGA_UPTO;
    static_assert(UPTO == 15, "the plain reference kernels of the transition builds are gone: all 15 phases run in the persistent kernel");
    if (UPTO > 0) {
        if (hipMemsetAsync(ws + WS_CTL, 0, CTL_ZERO_BYTES, stream) != hipSuccess) { fprintf(stderr, "kernel_launch: memset failed\n"); return; }
        Args a{};
        for (int i = 0; i < 19; ++i) a.in[i] = (const float*)d_in[i];
        a.out = out; a.wsp = ws;
        a.jobmask = UPTO >= 15 ? 255 : UPTO >= 10 ? 63 : UPTO >= 7 ? 31 : UPTO >= 6 ? 15 : 3;
        if (MEGA_ONE) { a.ph_lo = 0; a.ph_hi = UPTO; a.li = 0; hipLaunchKernelGGL(mega_fwd, dim3(grid), dim3(NWAVES * 64), LDS_BYTES, stream, a); }
        else for (int p = 0; p < UPTO; ++p) { a.ph_lo = p; a.ph_hi = p + 1; a.li = 0; for (int r = 0; r <= ((MEGA_REPMASK >> p) & 1); ++r) hipLaunchKernelGGL(mega_fwd, dim3(grid), dim3(NWAVES * 64), LDS_BYTES, stream, a); }
        const hipError_t le = hipPeekAtLastError();
        if (le != hipSuccess) fprintf(stderr, "kernel_launch: launch failed: %s\n", hipGetErrorName(le));
    }
}
```

```cpp
#include <hip/hip_runtime.h>
#include <hip/hip_bf16.h>
#include <stdint.h>
#include <stdio.h>
#include <cmath>
#define MEGA_UPTO 15
#define MEGA_ONE 1
typedef unsigned short bf16_t;
typedef short bf16x8 __attribute__((ext_vector_type(8)));
typedef float f32x4 __attribute__((ext_vector_type(4)));
constexpr int D = 1024, BATCH = 8, SEQ = 2048, M = BATCH * SEQ;
constexpr int NH = 8, HD = 64, VD = 128;
constexpr int DFF = 2816, NE = 8, DFE = 3584;
constexpr float EPS = 1e-6f;
constexpr float LAM_INIT = 0.35550907f;
constexpr int SLOTS = 2 * M + NE * 256;

__device__ __forceinline__ unsigned f2bf(float f) { unsigned u = __builtin_bit_cast(unsigned, f); return (u + 0x7fffu + ((u >> 16) & 1u)) >> 16; }
__device__ __forceinline__ float bf2f(unsigned short b) { return __builtin_bit_cast(float, (unsigned)b << 16); }
__device__ __forceinline__ float wave_sum(float v) {
#pragma unroll
    for (int o = 1; o < 64; o <<= 1) v += __shfl_xor(v, o);
    return v;
}

namespace pg8 {
#define PG8_LAS __attribute__((address_space(3)))
typedef unsigned short bf16_t;
typedef short bf16x8 __attribute__((ext_vector_type(8)));
typedef float f32x4 __attribute__((ext_vector_type(4)));
typedef unsigned u32x4 __attribute__((ext_vector_type(4)));
typedef int i32x4 __attribute__((ext_vector_type(4)));
typedef int i32x8 __attribute__((ext_vector_type(8)));
constexpr int BM = 256, BK = 64, HALF = 128, HTB = HALF * BK * 2  , STAGE_BYTES = 8 * HTB, NXCD = 8, WGM = 8;

__host__ __device__ __forceinline__ int lds_byte(int r, int c) { const int st = (r >> 4) * 2 + (c >> 5), rr = r & 15, cc = c & 31, ob = rr * 64 + cc * 2; return st * 1024 + (ob ^ (((ob >> 9) & 1) << 5)); }
__host__ __device__ __forceinline__ void stage_rc(int b, int& R, int& C) { const int st = b / 1024, sb = b % 1024, swz = sb ^ (((sb >> 9) & 1) << 5); R = (st >> 1) * 16 + swz / 64; C = (st & 1) * 32 + (swz % 64) / 2; }
__host__ __device__ __forceinline__ int perm32(int rho) { const int n = rho >> 4, i = rho & 15; return 8 * (i >> 2) + 4 * n + (i & 3); }

struct Unit { int pm, pn; int kt0, nkt, aux; };
struct Gemm { const bf16_t* A; const bf16_t* Bt; int M, N, K; };

struct StaticOrder {
    int nM, nN, nwg, G, c;
    __host__ __device__ void init(int M, int N, int G_, int c_) { nM = M / BM; nN = N / BM; nwg = nM * nN; G = G_; c = c_; }
    __host__ __device__ bool next(int i, Unit& u) const {
        const long L = (long)i * G + c; if (L >= nwg) return false;
        int wgid = (int)L; { const int q = nwg / NXCD, r = nwg % NXCD, xcd = wgid % NXCD, off = wgid / NXCD; wgid = (xcd < r ? xcd * (q + 1) : r * (q + 1) + (xcd - r) * q) + off; }
        const int nig = WGM * nN, gid = wgid / nig, fm = gid * WGM, gsz = (nM - fm) < WGM ? (nM - fm) : WGM;
        u.pm = fm + ((wgid % nig) % gsz); u.pn = (wgid % nig) / gsz; u.kt0 = 0; u.nkt = 0; u.aux = -1; return true;
    }
    __device__ __forceinline__ void a_ready(const Unit&) const {}
    __device__ __forceinline__ void done(const Unit&) const {}
};

__device__ __forceinline__ unsigned cvt_pk_bf16(float lo, float hi) { unsigned r; asm volatile("v_cvt_pk_bf16_f32 %0, %1, %2" : "=v"(r) : "v"(lo), "v"(hi)); return r; }
typedef float f32x2 __attribute__((ext_vector_type(2)));
#ifndef PG8_WT
#define PG8_WT 0
#endif
__device__ __forceinline__ void st16_wt(void* p, u32x4 v) {
#if PG8_WT
    asm volatile("global_store_dwordx4 %0, %1, off sc1\n\ts_nop 1" :: "v"(p), "v"(v) : "memory");
#else
    *(u32x4*)p = v;
#endif
}
__device__ __forceinline__ void st8_wt(void* p, unsigned x, unsigned y) {
#if PG8_WT
    typedef unsigned u32x2_ __attribute__((ext_vector_type(2))); const u32x2_ v = {x, y};
    asm volatile("global_store_dwordx2 %0, %1, off sc1\n\ts_nop 1" :: "v"(p), "v"(v) : "memory");
#else
    typedef unsigned u32x2_ __attribute__((ext_vector_type(2))); *(u32x2_*)p = (u32x2_){x, y};
#endif
}
typedef unsigned u32x2 __attribute__((ext_vector_type(2)));
constexpr float RMS_EPS = 1e-6f, LOG2E = 1.4426950408889634f;
constexpr int DM_ = 1024;
__device__ __forceinline__ u32x4 pack8(const f32x4 a, const f32x4 b) { u32x4 w; w.x = cvt_pk_bf16(a[0], a[1]); w.y = cvt_pk_bf16(a[2], a[3]); w.z = cvt_pk_bf16(b[0], b[1]); w.w = cvt_pk_bf16(b[2], b[3]); return w; }
__device__ __forceinline__ float rstd_of(const float* ssq, int row) { const f32x4 p = *(const f32x4*)(ssq + (size_t)row * 4); return __builtin_amdgcn_rsqf(((p[0] + p[1]) + (p[2] + p[3])) * (1.0f / 1024.0f) + RMS_EPS); }
__device__ __forceinline__ float silu_mul(float g, float u) { return g * u * __builtin_amdgcn_rcpf(1.0f + __builtin_amdgcn_exp2f(-g * LOG2E)); }
__device__ __forceinline__ f32x2 swiglu2(f32x2 a, f32x2 b, float c1, float k) {
    const f32x2 t = a * c1; f32x2 e; e.x = __builtin_amdgcn_exp2f(t.x); e.y = __builtin_amdgcn_exp2f(t.y);
    const f32x2 d = e * k + k; f32x2 r; r.x = __builtin_amdgcn_rcpf(d.x); r.y = __builtin_amdgcn_rcpf(d.y);
    return (a * b) * r;
}

__device__ __forceinline__ float clamp448(float x) { return __builtin_amdgcn_fmed3f(x, -448.0f, 448.0f); }
__device__ __forceinline__ unsigned pk4_fp8(float a, float b, float c, float d) { int w = 0; w = __builtin_amdgcn_cvt_pk_fp8_f32(clamp448(a), clamp448(b), w, false); w = __builtin_amdgcn_cvt_pk_fp8_f32(clamp448(c), clamp448(d), w, true); return (unsigned)w; }
constexpr float F8_SA = 4.0f, F8_SWG = 256.0f, F8_SH = 8.0f, F8_SWD = 512.0f;
constexpr float F8_SHD = 8.0f, F8_SWDD = 256.0f, F8_SX = 4.0f, F8_SWGD = 256.0f;

struct EpiInProj {
    static constexpr bool PERM = true, AFTER_DRAIN = false;
    bf16_t* Bb; bf16_t* Ub;
    __device__ __forceinline__ void operator()(const f32x4 (&acc)[2][2][4][2], const Unit& u, int wr, int wc, int fr, int fq) const {
        const int row0 = u.pm * BM + wr * 64 + fr;
        if (u.pn < 4) {
            const int col0 = u.pn * BM + wc * 32 + 8 * fq;
#pragma unroll
            for (int ai = 0; ai < 2; ++ai)
#pragma unroll
                for (int m = 0; m < 4; ++m) { bf16_t* rowp = Bb + (size_t)(row0 + ai * HALF + m * 16) * DM_ + col0;
#pragma unroll
                    for (int bj = 0; bj < 2; ++bj) st16_wt(rowp + bj * HALF, pack8(acc[ai][bj][m][0], acc[ai][bj][m][1])); }
        } else {
            const int col0 = (u.pn - 4) * 128 + wc * 32 + 8 * fq;
#pragma unroll
            for (int ai = 0; ai < 2; ++ai)
#pragma unroll
                for (int m = 0; m < 4; ++m) { bf16_t* rowp = Ub + (size_t)(row0 + ai * HALF + m * 16) * DM_ + col0;
                    st16_wt(rowp, pack8(acc[ai][0][m][0] * acc[ai][1][m][0], acc[ai][0][m][1] * acc[ai][1][m][1])); }
        }
    }
};

template <bool FIRST> struct EpiResidSsq {
    static constexpr bool PERM = true, AFTER_DRAIN = true;
    const float* x0; bf16_t* xb; float* ssq; float ascale; unsigned char* x8;
    __device__ __forceinline__ void fused(f32x4 (&acc)[2][2][4][2], const Unit& u, int wr, int wc, int fr, int fq, PG8_LAS unsigned char* lds, int wid, int lane) const {
        PG8_LAS float* P = (PG8_LAS float*)lds;
        const int col0 = u.pn * BM + wc * 32 + 8 * fq;
#pragma unroll
        for (int ai = 0; ai < 2; ++ai) {
            f32x4 xo[4][2][2];
#pragma unroll
            for (int m = 0; m < 4; ++m) { const int r = ai * HALF + wr * 64 + m * 16 + fr; const size_t off = (size_t)(u.pm * BM + r) * DM_ + col0;
#pragma unroll
                for (int bj = 0; bj < 2; ++bj) {
                    if constexpr (FIRST) { xo[m][bj][0] = *(const f32x4*)(x0 + off + bj * HALF); xo[m][bj][1] = *(const f32x4*)(x0 + off + bj * HALF + 4); }
                    else { const u32x4 w = *(const u32x4*)(xb + off + bj * HALF);
                        xo[m][bj][0] = (f32x4){__builtin_bit_cast(float, w.x << 16), __builtin_bit_cast(float, w.x & 0xffff0000u), __builtin_bit_cast(float, w.y << 16), __builtin_bit_cast(float, w.y & 0xffff0000u)};
                        xo[m][bj][1] = (f32x4){__builtin_bit_cast(float, w.z << 16), __builtin_bit_cast(float, w.z & 0xffff0000u), __builtin_bit_cast(float, w.w << 16), __builtin_bit_cast(float, w.w & 0xffff0000u)}; } } }
#pragma unroll
            for (int m = 0; m < 4; ++m) { const int r = ai * HALF + wr * 64 + m * 16 + fr; const size_t off = (size_t)(u.pm * BM + r) * DM_ + col0; float s = 0.f;
#pragma unroll
                for (int bj = 0; bj < 2; ++bj) { const f32x4 v0 = xo[m][bj][0] + acc[ai][bj][m][0] * ascale, v1 = xo[m][bj][1] + acc[ai][bj][m][1] * ascale;
                    st16_wt(xb + off + bj * HALF, pack8(v0, v1));
                    if constexpr (FIRST) { u32x2 w; w.x = pk4_fp8(v0[0] * F8_SX, v0[1] * F8_SX, v0[2] * F8_SX, v0[3] * F8_SX); w.y = pk4_fp8(v1[0] * F8_SX, v1[1] * F8_SX, v1[2] * F8_SX, v1[3] * F8_SX); st8_wt(x8 + off + bj * HALF, w.x, w.y); }
                    s += ((v0[0] * v0[0] + v0[1] * v0[1]) + (v0[2] * v0[2] + v0[3] * v0[3])) + ((v1[0] * v1[0] + v1[1] * v1[1]) + (v1[2] * v1[2] + v1[3] * v1[3])); }
                s += __shfl_xor(s, 16); s += __shfl_xor(s, 32);
                if (fq == 0) P[r * 4 + wc] = s; }
            asm volatile("" ::: "memory"); }
        asm volatile("s_waitcnt lgkmcnt(0)" ::: "memory"); __builtin_amdgcn_s_barrier(); asm volatile("" ::: "memory");
        const int t = wid * 64 + lane;
        if (t < 256) { const PG8_LAS f32x4* Pr = (const PG8_LAS f32x4*)lds; const f32x4 p = Pr[t]; ssq[(size_t)(u.pm * BM + t) * 4 + u.pn] = (p[0] + p[1]) + (p[2] + p[3]); }
        asm volatile("s_waitcnt lgkmcnt(0)" ::: "memory"); __builtin_amdgcn_s_barrier(); asm volatile("" ::: "memory");
    }
};

template <bool OUT8> struct EpiSwiGLU {
    static constexpr bool PERM = true, AFTER_DRAIN = false;
    void* H; int ldh; const float* ssq; const float* rstd; int ncol; float cs;
    __device__ __forceinline__ void operator()(const f32x4 (&acc)[2][2][4][2], const Unit& u, int wr, int wc, int fr, int fq) const {
        const int row0 = u.pm * BM + wr * 64 + fr, col0 = (u.pn % ncol) * 128 + wc * 32 + 8 * fq;
#pragma unroll
        for (int ai = 0; ai < 2; ++ai)
#pragma unroll
            for (int m = 0; m < 4; ++m) { const int row = row0 + ai * HALF + m * 16;
                float k; if (ssq) { const f32x4 p = *(const f32x4*)(ssq + (size_t)row * 4); k = ((p[0] + p[1]) + (p[2] + p[3])) * (1.0f / 1024.0f) + RMS_EPS; } else { const float r_ = rstd[row]; k = 1.0f / (r_ * r_); }
                const float c1 = -LOG2E * cs * __builtin_amdgcn_rsqf(k); k = k / (cs * cs);
                f32x4 h[2];
#pragma unroll
                for (int n = 0; n < 2; ++n) { const f32x4 a = acc[ai][0][m][n], b = acc[ai][1][m][n];
                    const f32x2 h0 = swiglu2((f32x2){a[0], a[1]}, (f32x2){b[0], b[1]}, c1, k), h1 = swiglu2((f32x2){a[2], a[3]}, (f32x2){b[2], b[3]}, c1, k);
                    h[n] = (f32x4){h0.x, h0.y, h1.x, h1.y}; }
                if constexpr (OUT8) { u32x2 w; w.x = pk4_fp8(h[0][0] * F8_SHD, h[0][1] * F8_SHD, h[0][2] * F8_SHD, h[0][3] * F8_SHD); w.y = pk4_fp8(h[1][0] * F8_SHD, h[1][1] * F8_SHD, h[1][2] * F8_SHD, h[1][3] * F8_SHD);
                    st8_wt((unsigned char*)H + (size_t)row * ldh + col0, w.x, w.y); }
                else st16_wt((bf16_t*)H + (size_t)row * ldh + col0, pack8(h[0], h[1])); }
    }
};

struct EpiQKV {
    static constexpr bool PERM = true, AFTER_DRAIN = false;
    bf16_t *Q, *K, *V; const float* ssq; const float* qg; const float* kg; float qscale;
    __device__ __forceinline__ void operator()(const f32x4 (&acc)[2][2][4][2], const Unit& u, int wr, int wc, int fr, int fq) const {
        const int row0 = u.pm * BM + wr * 64 + fr;
        if (u.pn < 8) {
            const bool isq = u.pn < 4; bf16_t* base = isq ? Q : K; const float* gn = isq ? qg : kg; const float sc = isq ? qscale : 1.0f;
            const int col0 = (4 * (u.pn & 3) + wc) * 64 + 8 * fq;
            f32x4 gv[2][2];
#pragma unroll
            for (int bj = 0; bj < 2; ++bj)
#pragma unroll
                for (int n = 0; n < 2; ++n) gv[bj][n] = *(const f32x4*)(gn + 32 * bj + 8 * fq + 4 * n);
#pragma unroll
            for (int ai = 0; ai < 2; ++ai)
#pragma unroll
                for (int m = 0; m < 4; ++m) { const int row = row0 + ai * HALF + m * 16; const float rs = rstd_of(ssq, row);
                    f32x4 v[2][2]; float ss = 0.f;
#pragma unroll
                    for (int bj = 0; bj < 2; ++bj)
#pragma unroll
                        for (int n = 0; n < 2; ++n) { v[bj][n] = acc[ai][bj][m][n] * rs; ss += (v[bj][n][0] * v[bj][n][0] + v[bj][n][1] * v[bj][n][1]) + (v[bj][n][2] * v[bj][n][2] + v[bj][n][3] * v[bj][n][3]); }
                    ss += __shfl_xor(ss, 16); ss += __shfl_xor(ss, 32);
                    const float r2 = __builtin_amdgcn_rsqf(ss * (1.0f / 64.0f) + RMS_EPS) * sc;
#pragma unroll
                    for (int bj = 0; bj < 2; ++bj) st16_wt(base + (size_t)row * DM_ + col0 + 32 * bj, pack8(v[bj][0] * r2 * gv[bj][0], v[bj][1] * r2 * gv[bj][1])); }
        } else {
            const int col0 = (u.pn - 8) * BM + wc * 32 + 8 * fq;
#pragma unroll
            for (int ai = 0; ai < 2; ++ai)
#pragma unroll
                for (int m = 0; m < 4; ++m) { const int row = row0 + ai * HALF + m * 16; const float rs = rstd_of(ssq, row);
#pragma unroll
                    for (int bj = 0; bj < 2; ++bj) st16_wt(V + (size_t)row * DM_ + col0 + bj * HALF, pack8(acc[ai][bj][m][0] * rs, acc[ai][bj][m][1] * rs)); }
        }
    }
};

struct EpiSwiGLU8 {
    static constexpr bool PERM = true, AFTER_DRAIN = false;
    unsigned char* H; int ldh; int ncol;
    __device__ __forceinline__ void operator()(const f32x4 (&acc)[2][2][4][2], const Unit& u, int wr, int wc, int fr, int fq) const {
        const int row0 = u.pm * BM + wr * 64 + fr, col0 = (u.pn % ncol) * 128 + wc * 32 + 8 * fq; constexpr float cs = 1.0f / (F8_SA * F8_SWG);
#pragma unroll
        for (int ai = 0; ai < 2; ++ai)
#pragma unroll
            for (int m = 0; m < 4; ++m) { const int row = row0 + ai * HALF + m * 16; f32x4 h[2];
#pragma unroll
                for (int n = 0; n < 2; ++n) { const f32x4 a = acc[ai][0][m][n], b = acc[ai][1][m][n];
                    const f32x2 h0 = swiglu2((f32x2){a[0], a[1]}, (f32x2){b[0], b[1]}, -cs * LOG2E, 1.0f / (cs * cs * F8_SH)), h1 = swiglu2((f32x2){a[2], a[3]}, (f32x2){b[2], b[3]}, -cs * LOG2E, 1.0f / (cs * cs * F8_SH));
                    h[n] = (f32x4){h0.x, h0.y, h1.x, h1.y}; }
                u32x2 w; w.x = pk4_fp8(h[0][0], h[0][1], h[0][2], h[0][3]); w.y = pk4_fp8(h[1][0], h[1][1], h[1][2], h[1][3]);
                st8_wt(H + (size_t)row * ldh + col0, w.x, w.y); }
    }
};

struct EpiMoeDown {
    static constexpr bool PERM = true, AFTER_DRAIN = false;
    bf16_t* Y; const float* gate; float scale; float* Pp;
    __device__ __forceinline__ void operator()(const f32x4 (&acc)[2][2][4][2], const Unit& u, int wr, int wc, int fr, int fq) const {
        const int col0 = (u.pn & 3) * BM + wc * 32 + 8 * fq;
        if (u.aux >= 0) {
            float* base = Pp + ((size_t)u.aux * BM + wr * 64 + fr) * DM_ + col0;
#pragma unroll
            for (int ai = 0; ai < 2; ++ai)
#pragma unroll
                for (int m = 0; m < 4; ++m)
#pragma unroll
                    for (int bj = 0; bj < 2; ++bj) { float* p = base + (size_t)(ai * HALF + m * 16) * DM_ + bj * HALF; st16_wt(p, __builtin_bit_cast(u32x4, acc[ai][bj][m][0])); st16_wt(p + 4, __builtin_bit_cast(u32x4, acc[ai][bj][m][1])); }
            return; }
        const int row0 = u.pm * BM + wr * 64 + fr;
#pragma unroll
        for (int ai = 0; ai < 2; ++ai)
#pragma unroll
            for (int m = 0; m < 4; ++m) { const int row = row0 + ai * HALF + m * 16; const float gt = gate[row] * scale;
#pragma unroll
                for (int bj = 0; bj < 2; ++bj) st16_wt(Y + (size_t)row * DM_ + col0 + bj * HALF, pack8(acc[ai][bj][m][0] * gt, acc[ai][bj][m][1] * gt)); }
    }
};

struct MoeOrder {
    int nM, nN, nwg, G, c, T, P0, npieces; int t1, t2, t3, t4, t5, t6, t7;
    static constexpr int SPL = 7, PKT = 4;
    __device__ __forceinline__ void init(const int* meta, int nN_, int G_, int c_, bool split) {
        T = meta[8]; nM = split ? meta[9] : T; nN = nN_; nwg = nM * nN; G = G_; c = c_; t1 = meta[1]; t2 = meta[2]; t3 = meta[3]; t4 = meta[4]; t5 = meta[5]; t6 = meta[6]; t7 = meta[7];
        P0 = ((nwg + G - 1) / G) * G; npieces = (T - nM) * nN * SPL; }
    __device__ __forceinline__ int expert_of(int pm) const { return (pm >= t1) + (pm >= t2) + (pm >= t3) + (pm >= t4) + (pm >= t5) + (pm >= t6) + (pm >= t7); }
    __device__ __forceinline__ bool next(int i, Unit& u) const {
        const long L = (long)i * G + c;
        if (L >= nwg) { const long q = L - P0; if (q < 0 || q >= npieces) return false;
            const int rt = (int)q / (nN * SPL), rem = (int)q % (nN * SPL), pnl = rem / SPL, kp = rem % SPL;
            u.pm = nM + rt; u.pn = expert_of(u.pm) * nN + pnl; u.kt0 = kp * PKT; u.nkt = PKT; u.aux = rt * SPL + kp; return true; }
        int wgid = (int)L; { const int q = nwg / NXCD, r = nwg % NXCD, xcd = wgid % NXCD, off = wgid / NXCD; wgid = (xcd < r ? xcd * (q + 1) : r * (q + 1) + (xcd - r) * q) + off; }
        const int nig = WGM * nN, gid = wgid / nig, fm = gid * WGM, gsz = (nM - fm) < WGM ? (nM - fm) : WGM;
        const int pm = fm + ((wgid % nig) % gsz), pnl = (wgid % nig) / gsz;
        u.pm = pm; u.pn = expert_of(pm) * nN + pnl; u.kt0 = 0; u.nkt = 0; u.aux = -1; return true;
    }
    __device__ __forceinline__ void a_ready(const Unit&) const {}
    __device__ __forceinline__ void done(const Unit&) const {}
};
template <class Epi, class Sched, bool ALIGN_EPI = false, bool SP2 = false, bool F8 = false>
__device__ __forceinline__ void gemm_phase(PG8_LAS unsigned char* lds, const Gemm g, const Sched& S, const Epi& E) {
    const int tid = threadIdx.x, wid = __builtin_amdgcn_readfirstlane(tid >> 6), lane = tid & 63, wr = wid >> 2, wc = wid & 3, fr = lane & 15, fq = lane >> 4;
    int K_ = g.K; asm volatile("" : "+s"(K_));
    const int K = K_, nt = K / BK;
    unsigned voffA[2], voffB[2];
#pragma unroll
    for (int i = 0; i < 2; ++i) { int R, C; stage_rc(tid * 16 + i * 8192, R, C); const int Rb = Epi::PERM ? ((R & ~31) + perm32(R & 31)) : R;
        voffA[i] = (unsigned)(R * K + C) * 2u; voffB[i] = (unsigned)(Rb * K + C) * 2u; }
    const size_t kstep = (size_t)(BK * 2);
    const size_t hstep = (size_t)HALF * K * 2;
    const size_t tstep = 2 * hstep;
    const unsigned ldsw = (unsigned)wid * 1024u;
    const int aoff = lds_byte(wr * 64 + fr, fq * 8), boff = lds_byte(wc * 32 + fr, fq * 8);
    constexpr int KSTEP = 1024;
#define PG8_SA(b, h) (((b) * 2 + (h)) * HTB)
#define PG8_SB(b, h) ((4 + (b) * 2 + (h)) * HTB)
#define PG8_STAGE(bufoff, gbase, voff) do { _Pragma("unroll") for (int _i = 0; _i < 2; ++_i) \
        __builtin_amdgcn_global_load_lds((const unsigned*)((const char*)(gbase) + (voff)[_i]), (PG8_LAS unsigned*)(lds + (bufoff) + ldsw + _i * 8192), 16, 0, 0); } while (0)
#define PG8_LDA(dst, b, h) do { _Pragma("unroll") for (int m = 0; m < 4; ++m) _Pragma("unroll") for (int k = 0; k < 2; ++k) dst[m][k] = *(const PG8_LAS bf16x8*)(lds + PG8_SA(b, h) + aoff + m * 2048 + k * KSTEP); } while (0)
#define PG8_LDB(dst, b, h) do { _Pragma("unroll") for (int n = 0; n < 2; ++n) _Pragma("unroll") for (int k = 0; k < 2; ++k) dst[n][k] = *(const PG8_LAS bf16x8*)(lds + PG8_SB(b, h) + boff + n * 2048 + k * KSTEP); } while (0)
#define PG8_CAT8(x) __builtin_shufflevector(__builtin_bit_cast(i32x4, (x)[0]), __builtin_bit_cast(i32x4, (x)[1]), 0, 1, 2, 3, 4, 5, 6, 7)
#define PG8_MMA(ai, bj, At, Bt) do { __builtin_amdgcn_s_setprio(1); _Pragma("unroll") for (int m = 0; m < 4; ++m) _Pragma("unroll") for (int n = 0; n < 2; ++n) { \
        if constexpr (F8) asm volatile("s_nop 1\n\tv_mfma_f32_16x16x128_f8f6f4 %0, %1, %2, %0" : "+v"(acc[ai][bj][m][n]) : "v"(PG8_CAT8(Bt[n])), "v"(PG8_CAT8(At[m]))); \
        else { _Pragma("unroll") for (int k = 0; k < 2; ++k) acc[ai][bj][m][n] = __builtin_amdgcn_mfma_f32_16x16x32_bf16(Bt[n][k], At[m][k], acc[ai][bj][m][n], 0, 0, 0); } } \
        __builtin_amdgcn_s_setprio(0); } while (0)
#define PG8_WAIT_V(n) asm volatile("s_waitcnt vmcnt(" #n ")" ::: "memory")
#define PG8_WAIT_L(n) asm volatile("s_waitcnt lgkmcnt(" #n ")" ::: "memory")
#define PG8_BAR __builtin_amdgcn_s_barrier()
#define PG8_SCHED __builtin_amdgcn_sched_barrier(0)
    Unit cur, nxt; int ui = 0;
    if (!S.next(0, cur)) return;
    f32x4 acc[2][2][4][2];
#pragma unroll
    for (int a = 0; a < 2; ++a)
#pragma unroll
        for (int b = 0; b < 2; ++b)
#pragma unroll
            for (int m = 0; m < 4; ++m)
#pragma unroll
                for (int n = 0; n < 2; ++n) acc[a][b][m][n] = (f32x4){0.f, 0.f, 0.f, 0.f};
    bf16x8 At[4][2], B0[2][2], B1[2][2];
    const char* cA = (const char*)g.A + (size_t)cur.pm * tstep + (size_t)cur.kt0 * kstep; const char* cB = (const char*)g.Bt + (size_t)cur.pn * tstep + (size_t)cur.kt0 * kstep;
    S.a_ready(cur);
    if constexpr (SP2) {
        PG8_STAGE(PG8_SB(0, 0), cB, voffB); PG8_STAGE(PG8_SB(0, 1), cB + hstep, voffB); PG8_STAGE(PG8_SA(0, 0), cA, voffA); PG8_STAGE(PG8_SA(0, 1), cA + hstep, voffA);
        if (wr == 1) PG8_BAR;
        PG8_WAIT_V(2); PG8_BAR;
        PG8_STAGE(PG8_SB(1, 0), cB + kstep, voffB); PG8_STAGE(PG8_SA(1, 0), cA + kstep, voffA); PG8_STAGE(PG8_SB(1, 1), cB + hstep + kstep, voffB);
        PG8_WAIT_V(6); PG8_BAR;
    } else {
        PG8_STAGE(PG8_SB(0, 0), cB, voffB); PG8_STAGE(PG8_SA(0, 0), cA, voffA); PG8_STAGE(PG8_SB(0, 1), cB + hstep, voffB); PG8_STAGE(PG8_SA(0, 1), cA + hstep, voffA);
        if (wr == 1) PG8_BAR;
        PG8_WAIT_V(4); PG8_BAR;
        PG8_STAGE(PG8_SB(1, 0), cB + kstep, voffB); PG8_STAGE(PG8_SA(1, 0), cA + kstep, voffA); PG8_STAGE(PG8_SB(1, 1), cB + hstep + kstep, voffB);
        PG8_WAIT_V(6); PG8_BAR;
    }
    for (;;) {
        const bool has_next = S.next(ui + 1, nxt);
        const char* nA = has_next ? (const char*)g.A + (size_t)nxt.pm * tstep + (size_t)nxt.kt0 * kstep : cA; const char* nB = has_next ? (const char*)g.Bt + (size_t)nxt.pn * tstep + (size_t)nxt.kt0 * kstep : cB;
        const int ntu = cur.nkt ? cur.nkt : nt;
        for (int t = 0; t < ntu; t += 2) {
            const bool last = (t == ntu - 2);
            const char* a1 = cA + (size_t)(t + 1) * kstep;
            const char* a2 = last ? nA : cA + (size_t)(t + 2) * kstep; const char* b2 = last ? nB : cB + (size_t)(t + 2) * kstep;
            const char* a3 = a2 + kstep; const char* b3 = b2 + kstep;
            if (last && has_next) S.a_ready(nxt);
            if constexpr (SP2) {
            PG8_LDB(B0, 0, 0); PG8_LDB(B1, 0, 1); PG8_SCHED; PG8_LDA(At, 0, 0); PG8_STAGE(PG8_SA(1, 1), a1 + hstep, voffA);
            PG8_WAIT_V(8); PG8_WAIT_L(0); PG8_BAR; PG8_MMA(0, 0, At, B0); PG8_MMA(0, 1, At, B1); PG8_BAR; PG8_SCHED;
            PG8_LDA(At, 0, 1); PG8_STAGE(PG8_SB(0, 0), b2, voffB); PG8_STAGE(PG8_SB(0, 1), b2 + hstep, voffB); PG8_STAGE(PG8_SA(0, 0), a2, voffA);
            PG8_WAIT_V(8); PG8_WAIT_L(0); PG8_BAR; PG8_MMA(1, 0, At, B0); PG8_MMA(1, 1, At, B1); PG8_BAR; PG8_SCHED;
            PG8_LDB(B0, 1, 0); PG8_LDB(B1, 1, 1); PG8_SCHED; PG8_LDA(At, 1, 0); PG8_STAGE(PG8_SA(0, 1), a2 + hstep, voffA);
            PG8_WAIT_V(8); PG8_WAIT_L(0); PG8_BAR; PG8_MMA(0, 0, At, B0); PG8_MMA(0, 1, At, B1); PG8_BAR; PG8_SCHED;
            PG8_LDA(At, 1, 1); PG8_STAGE(PG8_SB(1, 0), b3, voffB); PG8_STAGE(PG8_SB(1, 1), b3 + hstep, voffB); PG8_STAGE(PG8_SA(1, 0), a3, voffA);
            PG8_WAIT_V(8); PG8_WAIT_L(0); PG8_BAR; PG8_MMA(1, 0, At, B0); PG8_MMA(1, 1, At, B1); PG8_BAR; PG8_SCHED;
            } else {
            PG8_LDB(B0, 0, 0); PG8_SCHED; PG8_LDA(At, 0, 0); PG8_STAGE(PG8_SA(1, 1), a1 + hstep, voffA);
            PG8_WAIT_L(8); PG8_BAR; PG8_WAIT_L(0); PG8_MMA(0, 0, At, B0); PG8_BAR; PG8_SCHED;
            PG8_LDB(B1, 0, 1); PG8_STAGE(PG8_SB(0, 0), b2, voffB);
            PG8_BAR; PG8_WAIT_L(0); PG8_MMA(0, 1, At, B1); PG8_BAR;
            PG8_LDA(At, 0, 1); PG8_STAGE(PG8_SA(0, 0), a2, voffA);
            PG8_BAR; PG8_WAIT_L(0); PG8_MMA(1, 0, At, B0); PG8_BAR; PG8_SCHED;
            PG8_STAGE(PG8_SB(0, 1), b2 + hstep, voffB);
            PG8_WAIT_V(6); PG8_BAR; PG8_MMA(1, 1, At, B1); PG8_BAR;
            PG8_LDB(B0, 1, 0); PG8_SCHED; PG8_LDA(At, 1, 0); PG8_STAGE(PG8_SA(0, 1), a2 + hstep, voffA);
            PG8_WAIT_L(8); PG8_BAR; PG8_WAIT_L(0); PG8_MMA(0, 0, At, B0); PG8_BAR; PG8_SCHED;
            PG8_LDB(B1, 1, 1); PG8_STAGE(PG8_SB(1, 0), b3, voffB);
            PG8_BAR; PG8_WAIT_L(0); PG8_MMA(0, 1, At, B1); PG8_BAR;
            PG8_LDA(At, 1, 1); PG8_STAGE(PG8_SA(1, 0), a3, voffA);
            PG8_BAR; PG8_WAIT_L(0); PG8_MMA(1, 0, At, B0); PG8_BAR; PG8_SCHED;
            PG8_STAGE(PG8_SB(1, 1), b3 + hstep, voffB);
            PG8_WAIT_V(6); PG8_BAR; PG8_MMA(1, 1, At, B1); PG8_BAR;
            }
        }
        if constexpr (F8) asm volatile("s_nop 15\n\ts_nop 15" ::: "memory");
        if constexpr (ALIGN_EPI) { if (wr == 0) PG8_BAR; }
        if constexpr (!Epi::AFTER_DRAIN) { E(acc, cur, wr, wc, fr, fq); S.done(cur); }
        if (!has_next) break;
#pragma unroll
        for (int a = 0; a < 2; ++a)
#pragma unroll
            for (int b = 0; b < 2; ++b)
#pragma unroll
                for (int m = 0; m < 4; ++m)
#pragma unroll
                    for (int n = 0; n < 2; ++n) acc[a][b][m][n] = (f32x4){0.f, 0.f, 0.f, 0.f};
        cur = nxt; cA = nA; cB = nB; ++ui;
        if constexpr (ALIGN_EPI) { if (wr == 1) PG8_BAR; }
    }
    PG8_WAIT_V(0);
    if constexpr (!ALIGN_EPI) { if (wr == 0) PG8_BAR; }
    PG8_BAR;
    if constexpr (Epi::AFTER_DRAIN) { E.fused(acc, cur, wr, wc, fr, fq, lds, wid, lane); S.done(cur); }
#undef PG8_SA
#undef PG8_SB
#undef PG8_STAGE
#undef PG8_LDA
#undef PG8_LDB
#undef PG8_MMA
#undef PG8_CAT8
#undef PG8_WAIT_V
#undef PG8_WAIT_L
#undef PG8_BAR
#undef PG8_SCHED
}
}
#include <hip/hip_bf16.h>
#include <cmath>
namespace attn_body {
using bf16=__hip_bfloat16;
using bf16x8=__attribute__((ext_vector_type(8)))short;
using s16x4=__attribute__((ext_vector_type(4)))short;
using f32x16=__attribute__((ext_vector_type(16)))float;
using u32x4=__attribute__((ext_vector_type(4)))unsigned;
constexpr int BATCH=8,NHEAD=16,SEQ=2048,D=64,DM=NHEAD*D;
constexpr int NW=8,QBLK=32,QB=QBLK*NW,KVBLK=64,NQB=SEQ/QB;
constexpr int ATTN_PITCH=DM, ATTN_UNIT_ROWS=QB;
__device__ __forceinline__ int crow(int r,int hi){return (r&3)+8*(r>>2)+4*hi;}
#define SBAR() __builtin_amdgcn_sched_barrier(0)
__device__ __forceinline__ void cmask(f32x16&p0,f32x16&p1,int jb,int qrel,int hi){
  const float NEG=-INFINITY; int kb=64*jb+4*hi;
  #pragma unroll
  for(int r=0;r<16;++r){int kv=kb+(r&3)+8*(r>>2); if(kv>qrel)p0[r]=NEG; if(kv+32>qrel)p1[r]=NEG;}
}

constexpr int NSLOT=3, SLOTB=8192;
constexpr int LDS_K=0, LDS_V=NSLOT*SLOTB, LDS_WS=3*NSLOT*SLOTB, LDS_QS=LDS_WS+NW*64*4, LDS_OST=LDS_QS+NW*4096, LDS_BYTES=LDS_OST+NW*4096;
constexpr float C2=0.125f*1.4426950408889634f;
__device__ __forceinline__ void glds16(const void*gsrc,unsigned lds_dst){unsigned keep;
  asm volatile("s_mov_b32 %0, m0\n\ts_mov_b32 m0, %2\n\ts_nop 0\n\tglobal_load_lds_dwordx4 %1, off\n\ts_mov_b32 m0, %0":"=&s"(keep):"v"(gsrc),"s"(lds_dst):"memory");}
__device__ __forceinline__ float max3f(float a,float b,float c){float r;asm("v_max3_f32 %0, %1, %2, %3":"=v"(r):"v"(a),"v"(b),"v"(c));return r;}
__device__ __forceinline__ float max2f(float a,float b){float r;asm("v_max_f32_e32 %0, %1, %2":"=v"(r):"v"(a),"v"(b));return r;}
__device__ __forceinline__ float fadd_s(float a,float b){float r;asm("v_add_f32_e32 %0, %1, %2":"=v"(r):"v"(a),"v"(b));return r;}
__device__ __forceinline__ float fsub_s(float a,float b){float r;asm("v_sub_f32_e32 %0, %1, %2":"=v"(r):"v"(a),"v"(b));return r;}
typedef float f32x2_t __attribute__((ext_vector_type(2))); typedef __bf16 bf16x2_t __attribute__((ext_vector_type(2)));
__device__ __forceinline__ unsigned cvtpk_s(float lo,float hi){f32x2_t v={lo,hi};bf16x2_t b=__builtin_convertvector(v,bf16x2_t);return __builtin_bit_cast(unsigned,b);}
#define WAIT_BAR(N) asm volatile("s_waitcnt vmcnt(" #N ") lgkmcnt(0)\n\ts_barrier":::"memory")

__device__ __forceinline__ void qkt(f32x16&p0,f32x16&p1,const char*Kslot,const bf16x8*qr,int r32,int hi){ const f32x16 negm=f32x16{};
  const char*kb=Kslot+hi*1024+r32*16;
  #pragma unroll
  for(int d0=0;d0<4;++d0){
    const bf16x8 b0=*reinterpret_cast<const bf16x8*>(kb+d0*2048);
    const bf16x8 b1=*reinterpret_cast<const bf16x8*>(kb+d0*2048+512);
    if(d0==0){p0=__builtin_amdgcn_mfma_f32_32x32x16_bf16(b0,qr[0],negm,0,0,0);p1=__builtin_amdgcn_mfma_f32_32x32x16_bf16(b1,qr[0],negm,0,0,0);}
    else{p0=__builtin_amdgcn_mfma_f32_32x32x16_bf16(b0,qr[d0],p0,0,0,0);p1=__builtin_amdgcn_mfma_f32_32x32x16_bf16(b1,qr[d0],p1,0,0,0);}}
}
typedef __attribute__((address_space(3))) const char* lds_cptr;
typedef short v4i16_t __attribute__((ext_vector_type(4)));
__device__ __forceinline__ void kload8(bf16x8*kf,lds_cptr kp){
  kf[0]=*(const __attribute__((address_space(3))) bf16x8*)(kp);      kf[1]=*(const __attribute__((address_space(3))) bf16x8*)(kp+512);
  kf[2]=*(const __attribute__((address_space(3))) bf16x8*)(kp+2048); kf[3]=*(const __attribute__((address_space(3))) bf16x8*)(kp+2560);
  kf[4]=*(const __attribute__((address_space(3))) bf16x8*)(kp+4096); kf[5]=*(const __attribute__((address_space(3))) bf16x8*)(kp+4608);
  kf[6]=*(const __attribute__((address_space(3))) bf16x8*)(kp+6144); kf[7]=*(const __attribute__((address_space(3))) bf16x8*)(kp+6656);
}
__device__ __forceinline__ void kload2(bf16x8*kf,lds_cptr kp,int j){ kf[2*j]=*(const __attribute__((address_space(3))) bf16x8*)(kp+j*2048); kf[2*j+1]=*(const __attribute__((address_space(3))) bf16x8*)(kp+j*2048+512); }
__device__ __forceinline__ s16x4 vtr(lds_cptr p){ return __builtin_bit_cast(s16x4,__builtin_amdgcn_ds_read_tr16_b64_v4i16((__attribute__((address_space(3))) v4i16_t*)p)); }
__device__ __forceinline__ float rowmax(const f32x16&p0,const f32x16&p1){
  float a=max3f(p0[0],p0[1],p1[0]),b=max3f(p0[2],p0[3],p1[1]);a=max3f(a,p1[2],p1[3]);
  #pragma unroll
  for(int r=4;r<16;r+=4){a=max3f(a,p0[r],p0[r+1]);b=max3f(b,p0[r+2],p0[r+3]);a=max3f(a,p1[r],p1[r+1]);b=max3f(b,p1[r+2],p1[r+3]);}
  const float m=max2f(a,b);
  auto rr=__builtin_amdgcn_permlane32_swap(__float_as_uint(m),__float_as_uint(m),false,false);
  return max2f(__uint_as_float(rr[0]),__uint_as_float(rr[1]));
}
__device__ __forceinline__ void pv(f32x16*o,int vb,bf16x8 pa0,bf16x8 pa1,bf16x8 pa2,bf16x8 pa3){
  #pragma unroll
  for(int d0=0;d0<4;++d0){s16x4 lo[4],hi[4];
    #pragma unroll
    for(int ks=0;ks<4;++ks){
      asm volatile("ds_read_b64_tr_b16 %0,%1 offset:%c2":"=&v"(lo[ks]):"v"(vb),"i"(d0*4096+ks*1024):"memory");
      asm volatile("ds_read_b64_tr_b16 %0,%1 offset:%c2":"=&v"(hi[ks]):"v"(vb),"i"(d0*4096+ks*1024+512):"memory");}
    asm volatile("s_waitcnt lgkmcnt(0)":::"memory");SBAR();
    #define PK(k) (bf16x8){lo[k][0],lo[k][1],lo[k][2],lo[k][3],hi[k][0],hi[k][1],hi[k][2],hi[k][3]}
    o[d0]=__builtin_amdgcn_mfma_f32_32x32x16_bf16(pa0,PK(0),o[d0],0,0,0);
    o[d0]=__builtin_amdgcn_mfma_f32_32x32x16_bf16(pa1,PK(1),o[d0],0,0,0);
    o[d0]=__builtin_amdgcn_mfma_f32_32x32x16_bf16(pa2,PK(2),o[d0],0,0,0);
    o[d0]=__builtin_amdgcn_mfma_f32_32x32x16_bf16(pa3,PK(3),o[d0],0,0,0);
    #undef PK
  }
}

#ifndef ATTN_STORE16
#define ATTN_STORE16(p,v) pg8::st16_wt((void*)(p),(v))
#endif
template<int THRL> __device__ __forceinline__ void attn_unit(int b,int qcol,int vcol,int qb,const bf16*Q,const bf16*__restrict__ K,const bf16*__restrict__ V,bf16*O,char*shm){
  int tid_=threadIdx.x; asm volatile("":"+v"(tid_));
  const int tid=tid_,lane=tid&63,r32=lane&31,hi=lane>>5; const int wid=__builtin_amdgcn_readfirstlane(tid>>6);
  const long rowbase=(long)b*SEQ; const int q0=qb*QB;
  const bf16*Qw=Q+(rowbase+q0+wid*QBLK)*DM+qcol;
  const bf16*Kh=K+rowbase*DM+qcol,*Vh=V+rowbase*DM+vcol;
  const unsigned lds0=(unsigned)(uintptr_t)shm;
  float*wsf=(float*)(shm+LDS_WS)+wid*64;
  const bf16*ksrc=Kh+(long)lane*DM+wid*8;
  const bf16*vsrc=Vh+(long)(16*(wid&3)+(lane>>2))*DM+(wid>>2)*32+(lane&3)*8;
  const unsigned kdst=lds0+LDS_K+wid*1024, vdst=lds0+LDS_V+wid*1024;
  #define DMA_K(t,slot) glds16(ksrc+(long)(t)*KVBLK*DM,(unsigned)__builtin_amdgcn_readfirstlane(kdst+(slot)))
  #define DMA_V(t,slot) do{ glds16(vsrc+(long)(t)*KVBLK*DM,(unsigned)__builtin_amdgcn_readfirstlane(vdst+2*(slot))); glds16(vsrc+(long)(t)*KVBLK*DM+64,(unsigned)__builtin_amdgcn_readfirstlane(vdst+2*(slot)+8192)); }while(0)
  const int vb0=(int)(lds0+LDS_V)+((lane>>4)&1)*32+(lane&3)*8+(4*hi+((lane&15)>>2))*64;
  const char*Kbase=shm+LDS_K; bf16x8 kf[8];
  const lds_cptr shm3=(lds_cptr)shm; const lds_cptr kp0=shm3+LDS_K+hi*1024+r32*16; const lds_cptr vp0=shm3+LDS_V+((lane>>4)&1)*32+(lane&3)*8+(4*hi+((lane&15)>>2))*64;
  const int NT=(q0+QB)/KVBLK;
  DMA_K(0,0);DMA_V(0,0);DMA_K(1,SLOTB);
  bf16x8 qr[4];
  #pragma unroll
  for(int d0=0;d0<4;++d0)qr[d0]=*reinterpret_cast<const bf16x8*>(&Qw[(long)r32*DM+d0*16+hi*8]);
  float mhat=0.f,l_reg=0.f;f32x16 o[4];o[0]=f32x16{};o[1]=f32x16{};o[2]=f32x16{};o[3]=f32x16{};
  typedef __attribute__((address_space(3))) bf16x8* lds_q8; const lds_cptr qp0=shm3+LDS_QS+wid*4096+lane*16;
  #define QF(j) (*(const __attribute__((address_space(3))) bf16x8*)(qp0+(j)*1024))
  const int qrel=wid*QBLK+r32;
  #define CMASK(P0,P1,t) do{int jb_=(t)-(NT-4); if(jb_>=0)cmask(P0,P1,jb_,qrel,hi);}while(0)
  bool resc=false;
  #define START(P0,P1) do{ const float rm=rowmax(P0,P1); resc=false; \
    { const float dl=rm; mhat=fadd_s(mhat,dl); \
      _Pragma("unroll") for(int r=0;r<16;++r){P0[r]=fsub_s(P0[r],dl);P1[r]=fsub_s(P1[r],dl);} } \
    _Pragma("unroll") for(int r=0;r<16;++r)P0[r]=__builtin_amdgcn_exp2f(P0[r]); }while(0)
  #define RESC() do{ if(resc){ asm volatile("s_waitcnt lgkmcnt(0)":::"memory"); \
      _Pragma("unroll") for(int d_=0;d_<4;++d_) _Pragma("unroll") for(int r=0;r<16;++r)o[d_][r]*=wsf[crow(r,hi)]; } }while(0)
  f32x16 pA0,pA1,pB0,pB1;
  int sl_prev=0,sl_cur=0,sl_next=SLOTB;
  #define ROT() do{sl_prev=sl_cur;sl_cur=sl_next;sl_next=(sl_next==(NSLOT-1)*SLOTB)?0:sl_next+SLOTB;}while(0)
  DMA_K(2,2*SLOTB);
  _Pragma("unroll") for(int d0=0;d0<4;++d0)*(__attribute__((address_space(3))) bf16x8*)(__attribute__((address_space(3))) char*)(qp0+d0*1024)=qr[d0];
  WAIT_BAR(4);
  qkt(pA0,pA1,Kbase,qr,r32,hi);asm volatile("s_nop 15\n\ts_nop 7":"+v"(pA0),"+v"(pA1));CMASK(pA0,pA1,0);
  START(pA0,pA1);
  _Pragma("unroll") for(int r=0;r<16;++r)pA1[r]=__builtin_amdgcn_exp2f(pA1[r]);
  WAIT_BAR(0);
  DMA_K(3,0);DMA_V(1,SLOTB);
  ROT();
  kload8(kf,kp0+sl_cur);
  bf16x8 qa=QF(0),qb_=QF(1);
  WAIT_BAR(3);
  s16x4 vlo[8],vhi[8]; u32x4 pw0,pw1,pw2,pw3;
  #define PKW(P,B) cvtpk_s(P[B],P[B+1])
  #define PAF(k) __builtin_bit_cast(bf16x8,pw##k)
  #define VFR(i) (bf16x8){vlo[i][0],vlo[i][1],vlo[i][2],vlo[i][3],vhi[i][0],vhi[i][1],vhi[i][2],vhi[i][3]}
  #define PIN(x) asm volatile("":"+v"(x))
  #define MX3(a,b,c) __builtin_fmaxf(__builtin_fmaxf((a),(b)),(c))
  #define GAPA(MF,A0,A1,A2,A3,W0,W1,PW) do{ MF; sacc+=A0; sacc+=A1; sacc+=A2; sacc+=A3; PIN(sacc); W0; W1; PIN(PW); SBAR(); }while(0)
  #define EX(v) __builtin_amdgcn_exp2f(v)
  #define GAPB(MF,X,B) do{ MF; X[B]=EX(X[B]); X[B+1]=EX(X[B+1]); PIN(X); SBAR(); }while(0)
  #define VRD(i) do{ vlo[i]=vtr(vp_+(((i)>>2)*4096+((i)&3)*1024)); vhi[i]=vtr(vp_+(((i)>>2)*4096+((i)&3)*1024+512)); }while(0)
  #define VRDX(reg,fr) do{ vlo[reg]=vtr(vp_+(((fr)>>2)*4096+((fr)&3)*1024)); vhi[reg]=vtr(vp_+(((fr)>>2)*4096+((fr)&3)*1024+512)); SBAR(); }while(0)
  #define KRD(G,j) do{ if(G){ kload2(kf,kp0+sl_next,j); SBAR(); } }while(0)
  #define ZC f32x16{}
  #define STEP(C0,C1,P0,P1,t,GK,GV,GL) do{ SBAR(); \
    const lds_cptr vp_=vp0+2*sl_prev; \
    VRD(0); SBAR(); float sacc=(P0[0]+P0[1]); \
    GAPA(C0=__builtin_amdgcn_mfma_f32_32x32x16_bf16(kf[0],qa,ZC,0,0,0), P0[2],P0[3],P0[4],P0[5],     pw0[0]=PKW(P0,0), pw0[1]=PKW(P0,2), pw0); \
    VRD(4); SBAR(); GAPA(C1=__builtin_amdgcn_mfma_f32_32x32x16_bf16(kf[1],qa,ZC,0,0,0), P0[6],P0[7],P0[8],P0[9],     pw0[2]=PKW(P0,4), pw0[3]=PKW(P0,6), pw0); \
    qa=QF(2); SBAR(); \
    VRD(1); SBAR(); GAPA(C0=__builtin_amdgcn_mfma_f32_32x32x16_bf16(kf[2],qb_,C0,0,0,0),   P0[10],P0[11],P0[12],P0[13], pw1[0]=PKW(P0,8), pw1[1]=PKW(P0,10), pw1); \
    VRD(5); SBAR(); GAPA(C1=__builtin_amdgcn_mfma_f32_32x32x16_bf16(kf[3],qb_,C1,0,0,0),   P0[14],P0[15],P1[0],P1[1],   pw1[2]=PKW(P0,12),pw1[3]=PKW(P0,14), pw1); \
    qb_=QF(3); SBAR(); \
    VRD(2); SBAR(); GAPA(C0=__builtin_amdgcn_mfma_f32_32x32x16_bf16(kf[4],qa,C0,0,0,0),   P1[2],P1[3],P1[4],P1[5],     pw2[0]=PKW(P1,0), pw2[1]=PKW(P1,2), pw2); \
    VRD(6); SBAR(); GAPA(C1=__builtin_amdgcn_mfma_f32_32x32x16_bf16(kf[5],qa,C1,0,0,0),   P1[6],P1[7],P1[8],P1[9],     pw2[2]=PKW(P1,4), pw2[3]=PKW(P1,6), pw2); \
    VRD(3); SBAR(); GAPA(C0=__builtin_amdgcn_mfma_f32_32x32x16_bf16(kf[6],qb_,C0,0,0,0),   P1[10],P1[11],P1[12],P1[13], pw3[0]=PKW(P1,8), pw3[1]=PKW(P1,10), pw3); \
    VRD(7); SBAR(); GAPA(C1=__builtin_amdgcn_mfma_f32_32x32x16_bf16(kf[7],qb_,C1,0,0,0),   P1[14],P1[15],0.f,0.f,       pw3[2]=PKW(P1,12),pw3[3]=PKW(P1,14), pw3); \
    l_reg+=sacc; \
    if(GK){DMA_K((t)+3,sl_cur);} if(GV){DMA_V((t)+1,sl_next);} \
    CMASK(C0,C1,t); \
    { float a=MX3(C0[0],C0[1],C1[0]),b=MX3(C0[2],C0[3],C1[1]); a=MX3(a,C1[2],C1[3]); \
      _Pragma("unroll") for(int r=4;r<16;r+=4){a=MX3(a,C0[r],C0[r+1]);b=MX3(b,C0[r+2],C0[r+3]);a=MX3(a,C1[r],C1[r+1]);b=MX3(b,C1[r+2],C1[r+3]);} \
      float rm=__builtin_fmaxf(a,b); { auto rr=__builtin_amdgcn_permlane32_swap(__float_as_uint(rm),__float_as_uint(rm),false,false); rm=__builtin_fmaxf(__uint_as_float(rr[0]),__uint_as_float(rr[1])); } \
      rm-=mhat; resc=false;                                      \
      if(__builtin_expect(__any(rm>(float)THRL),0)){ const float dl=__builtin_fmaxf(rm,0.f); mhat+=dl; \
        const float f=__builtin_amdgcn_exp2f(-dl); l_reg*=f; if(hi==0)wsf[r32]=f; resc=true; } \
      _Pragma("unroll") for(int r=0;r<16;++r){C0[r]-=mhat;C1[r]-=mhat;} } \
    SBAR(); \
    GAPB(o[0]=__builtin_amdgcn_mfma_f32_32x32x16_bf16(PAF(0),VFR(0),o[0],0,0,0), C0,0);  VRDX(0,8); \
    GAPB(o[1]=__builtin_amdgcn_mfma_f32_32x32x16_bf16(PAF(0),VFR(4),o[1],0,0,0), C0,2);  VRDX(4,12); \
    GAPB(o[0]=__builtin_amdgcn_mfma_f32_32x32x16_bf16(PAF(1),VFR(1),o[0],0,0,0), C0,4);  VRDX(1,9); \
    GAPB(o[1]=__builtin_amdgcn_mfma_f32_32x32x16_bf16(PAF(1),VFR(5),o[1],0,0,0), C0,6);  VRDX(5,13); \
    GAPB(o[0]=__builtin_amdgcn_mfma_f32_32x32x16_bf16(PAF(2),VFR(2),o[0],0,0,0), C0,8);  VRDX(2,10); \
    GAPB(o[1]=__builtin_amdgcn_mfma_f32_32x32x16_bf16(PAF(2),VFR(6),o[1],0,0,0), C0,10); VRDX(6,14); \
    GAPB(o[0]=__builtin_amdgcn_mfma_f32_32x32x16_bf16(PAF(3),VFR(3),o[0],0,0,0), C0,12); VRDX(3,11); \
    GAPB(o[1]=__builtin_amdgcn_mfma_f32_32x32x16_bf16(PAF(3),VFR(7),o[1],0,0,0), C0,14); VRDX(7,15); \
    KRD(GL,0); GAPB(o[2]=__builtin_amdgcn_mfma_f32_32x32x16_bf16(PAF(0),VFR(0),o[2],0,0,0), C1,0); \
    KRD(GL,1); GAPB(o[3]=__builtin_amdgcn_mfma_f32_32x32x16_bf16(PAF(0),VFR(4),o[3],0,0,0), C1,2); \
    KRD(GL,2); GAPB(o[2]=__builtin_amdgcn_mfma_f32_32x32x16_bf16(PAF(1),VFR(1),o[2],0,0,0), C1,4); \
    KRD(GL,3); GAPB(o[3]=__builtin_amdgcn_mfma_f32_32x32x16_bf16(PAF(1),VFR(5),o[3],0,0,0), C1,6); \
    GAPB(o[2]=__builtin_amdgcn_mfma_f32_32x32x16_bf16(PAF(2),VFR(2),o[2],0,0,0), C1,8); \
    GAPB(o[3]=__builtin_amdgcn_mfma_f32_32x32x16_bf16(PAF(2),VFR(6),o[3],0,0,0), C1,10); \
    qa=QF(0); SBAR(); \
    GAPB(o[2]=__builtin_amdgcn_mfma_f32_32x32x16_bf16(PAF(3),VFR(3),o[2],0,0,0), C1,12); \
    qb_=QF(1); SBAR(); \
    GAPB(o[3]=__builtin_amdgcn_mfma_f32_32x32x16_bf16(PAF(3),VFR(7),o[3],0,0,0), C1,14); \
    }while(0)
  int t=1;
  #undef CMASK
  #define CMASK(P0,P1,t) do{}while(0)
  for(;t+5<NT;t+=2){
    STEP(pB0,pB1,pA0,pA1,t,true,true,true);     WAIT_BAR(3); RESC(); ROT();
    STEP(pA0,pA1,pB0,pB1,t+1,true,true,true);   WAIT_BAR(3); RESC(); ROT();
  }
  #undef CMASK
  #define CMASK(P0,P1,t) do{int jb_=(t)-(NT-4); if(jb_>=0)cmask(P0,P1,jb_,qrel,hi);}while(0)
  #define ENDW(tt) do{ if((tt)+3<NT){WAIT_BAR(3);} else if((tt)+2<NT){WAIT_BAR(2);} else {WAIT_BAR(0);} }while(0)
  for(;t+1<NT;t+=2){
    STEP(pB0,pB1,pA0,pA1,t,(t+3<NT),(t+1<NT),(t+1<NT));       ENDW(t);   RESC(); ROT();
    STEP(pA0,pA1,pB0,pB1,t+1,(t+4<NT),(t+2<NT),(t+2<NT));     ENDW(t+1); RESC(); ROT();
  }
  STEP(pB0,pB1,pA0,pA1,NT-1,false,false,false); RESC();
  { float sacc=pB0[0]+pB0[1]; _Pragma("unroll") for(int r=2;r<16;++r)sacc+=pB0[r]; _Pragma("unroll") for(int r=0;r<16;++r)sacc+=pB1[r]; l_reg+=sacc;
    pw0=(u32x4){PKW(pB0,0),PKW(pB0,2),PKW(pB0,4),PKW(pB0,6)};pw1=(u32x4){PKW(pB0,8),PKW(pB0,10),PKW(pB0,12),PKW(pB0,14)};pw2=(u32x4){PKW(pB1,0),PKW(pB1,2),PKW(pB1,4),PKW(pB1,6)};pw3=(u32x4){PKW(pB1,8),PKW(pB1,10),PKW(pB1,12),PKW(pB1,14)};
    SBAR(); pv(o,vb0+2*sl_cur,PAF(0),PAF(1),PAF(2),PAF(3)); }
  #undef PKW
  #undef PAF
  #undef VFR
  #undef PIN
  #undef MX3
  #undef GAPA
  #undef GAPB
  #undef EX
  #undef VRD
  #undef VRDX
  #undef ZC
  #undef QF
  #undef KRD
  #undef STEP
  #undef ENDW
  {auto rr=__builtin_amdgcn_permlane32_swap(__float_as_uint(l_reg),__float_as_uint(l_reg),false,false);l_reg=__uint_as_float(rr[0])+__uint_as_float(rr[1]);}
  if(hi==0)wsf[32+r32]=l_reg;asm volatile("s_waitcnt lgkmcnt(0)":::"memory");
  float rli[16];
  #pragma unroll
  for(int r=0;r<16;++r)rli[r]=__builtin_amdgcn_rcpf(wsf[32+crow(r,hi)]);
  bf16*Ow=O+(rowbase+q0+wid*QBLK)*DM+vcol;
  { bf16*stg=(bf16*)(shm+LDS_OST)+wid*2048;
    #pragma unroll
    for(int hf=0;hf<2;++hf){
      #pragma unroll
      for(int r=0;r<16;++r){const int orow=crow(r,hi);
        #pragma unroll
        for(int d0=0;d0<2;++d0)stg[orow*64+d0*32+r32]=__float2bfloat16(o[2*hf+d0][r]*rli[r]);}
      asm volatile("s_waitcnt lgkmcnt(0)":::"memory");
      #pragma unroll
      for(int i=0;i<4;++i){const int row=i*8+(lane>>3),ch=lane&7; const u32x4 v=*(const u32x4*)(stg+row*64+ch*8); ATTN_STORE16(Ow+(long)row*DM+hf*64+ch*8,v);}
      asm volatile("s_waitcnt lgkmcnt(0)":::"memory"); } }
  asm volatile("s_waitcnt lgkmcnt(0)\n\ts_barrier":::"memory");
  #undef DMA_K
  #undef DMA_V
  #undef CMASK
  #undef START
  #undef RESC
  #undef ROT
}
constexpr int ATTN_LDS_BYTES=LDS_BYTES;
#undef SBAR
#undef WAIT_BAR
}
constexpr int NWAVES = 8;
constexpr int NPH = 15;
constexpr size_t MiB = 1u << 20;
constexpr size_t WS_CTL = 0, CTL_ZERO_BYTES = 1 * MiB;
constexpr size_t WS_W_IN = 1 * MiB;
constexpr size_t WS_W_OUT = WS_W_IN + (size_t)3072 * 1024 * 2;
constexpr size_t WS_W_GU = WS_W_OUT + (size_t)1024 * 1024 * 2;
constexpr size_t WS_W_DN = WS_W_GU + (size_t)5632 * 1024 * 2;
constexpr size_t WS_W_QKV = WS_W_DN + (size_t)1024 * 2816 * 2;
constexpr size_t WS_W_O = WS_W_QKV + (size_t)3072 * 1024 * 2;
constexpr size_t WS_W_MGU = WS_W_O + (size_t)1024 * 1024 * 2;
constexpr size_t WS_W_MDN = WS_W_MGU + (size_t)8 * 7168 * 1024 * 2;
constexpr size_t WS_W_END = WS_W_MDN + (size_t)8 * 1024 * 3584 * 2;
constexpr size_t WS_R = 202 * MiB;
constexpr size_t ACT = (size_t)M * D * 2;
constexpr size_t WS_XN0 = WS_R, WS_BB = WS_R + ACT, WS_UB = WS_R + 2 * ACT, WS_G = WS_R + 3 * ACT;
constexpr size_t WS_HACT = WS_R;
constexpr size_t WS_Q = WS_R + 4 * ACT, WS_K = WS_R + 5 * ACT, WS_V = WS_R + 6 * ACT;
constexpr size_t WS_X8 = WS_R + 5 * ACT;
constexpr size_t WS_O0 = WS_R, WS_O1 = WS_R + ACT, WS_ON = WS_R + 2 * ACT;
constexpr size_t WS_HM = WS_R;
constexpr size_t WS_PP = WS_R + 128 * MiB;
constexpr size_t WS_S = 440 * MiB;
constexpr size_t WS_XG = WS_S, WS_Y = WS_S + 68 * MiB;
constexpr size_t WS_XB = 632 * MiB;
constexpr size_t WS_HB = 664 * MiB, WS_HB2 = 696 * MiB, WS_YF = 728 * MiB;
constexpr size_t WS_SMALL = 792 * MiB;
constexpr size_t WS_SSQ = WS_SMALL;
constexpr size_t WS_SEL = WS_SMALL + 256 * 1024, WS_GATE = WS_SEL + 128 * 1024, WS_TOKSLOT = WS_GATE + 128 * 1024;
constexpr size_t WS_RSTDS = WS_TOKSLOT + 128 * 1024, WS_GATES = WS_RSTDS + 256 * 1024;
constexpr size_t WS_HIST = WS_GATES + 256 * 1024, WS_META = WS_HIST + 16 * 1024;
constexpr size_t WS_NAIVE_SMALL = WS_SMALL + 2 * MiB;
constexpr size_t WS_END = 796 * MiB;
static_assert(WS_W_END <= WS_R && WS_R + (size_t)SLOTS * DFE * 2 <= WS_S && WS_Y + (size_t)SLOTS * D * 2 <= WS_XB && WS_V + ACT <= WS_S, "d_ws map");
constexpr int CW_TMO = 0, CW_CODE = 1, CW_BAR = 4096;
constexpr int MISC_OFF = 0, RING_OFF = 1024, RING_BYTES = 131072, LDS_BYTES = 147456;
constexpr int P0_SCR = 16640;

#define GAS __attribute__((address_space(1)))
#define LAS __attribute__((address_space(3)))
typedef unsigned v4u __attribute__((ext_vector_type(4)));
typedef unsigned v2u __attribute__((ext_vector_type(2)));
typedef GAS unsigned gu32;
#define RLX_AGENT __ATOMIC_RELAXED, __HIP_MEMORY_SCOPE_AGENT
#define LDS_WAIT() asm volatile("s_waitcnt lgkmcnt(0)" ::: "memory")
#define VM_WAIT() asm volatile("s_waitcnt vmcnt(0)" ::: "memory")
__device__ __forceinline__ unsigned pk2(float lo, float hi) { return f2bf(lo) | (f2bf(hi) << 16); }
__device__ __forceinline__ float bflo(unsigned w) { return __builtin_bit_cast(float, w << 16); }
__device__ __forceinline__ float bfhi(unsigned w) { return __builtin_bit_cast(float, w & 0xffff0000u); }

#define XB_TMO      128
#define XB_XCNT(j)  (256  + 64 * (j))
#define XB_XSUB(j)  (1280 + 64 * (j))
#define XB_XGEN(j)  (2304 + 64 * (j))
#define XB_TOP      3328
#define XB_TOPGEN   3392
#define XCD_BAR_WORDS 3456
#define XB_SPIN_CAP (1u << 18)

__device__ __forceinline__ unsigned xb_ld(unsigned* p)              { return __hip_atomic_load(p, __ATOMIC_RELAXED, __HIP_MEMORY_SCOPE_AGENT); }
__device__ __forceinline__ unsigned xb_add(unsigned* p, unsigned v) { return __hip_atomic_fetch_add(p, v, __ATOMIC_RELAXED, __HIP_MEMORY_SCOPE_AGENT); }
__device__ __forceinline__ unsigned xb_xcc_id() { return (unsigned)__builtin_amdgcn_s_getreg((3 << 11) | 20) & 0xFu; }
#define XB_SPIN(cond, bar) do { unsigned _sp = 0; while (cond) { __builtin_amdgcn_s_sleep(1); \
    if ((++_sp & 255u) == 0u) { if (xb_ld(&(bar)[XB_TMO])) break; if (_sp > XB_SPIN_CAP) { atomicAdd(&(bar)[XB_TMO], 1u); break; } } } } while (0)

struct XcdBarrier {
    unsigned* bar; unsigned x;
    volatile LAS unsigned* st;
};

__device__ __forceinline__ XcdBarrier xcd_barrier_post(unsigned* bar, volatile LAS unsigned* st) {
    XcdBarrier b; b.bar = bar; b.x = xb_xcc_id(); b.st = st;
    if (threadIdx.x == 0) (void)xb_add(&bar[XB_XCNT(b.x)], 1u);
    return b;
}
__device__ __forceinline__ void xcd_barrier_complete(unsigned* bar, unsigned x, unsigned& nloc, unsigned& nx) {
    const unsigned G = gridDim.x * gridDim.y * gridDim.z;
    unsigned sum, cnt, mine, sp = 0u;
    for (;;) {
        sum = 0u; cnt = 0u; mine = 0u;
#pragma unroll
        for (unsigned j = 0; j < 16; ++j) { const unsigned c = xb_ld(&bar[XB_XCNT(j)]); sum += c; cnt += (c > 0u) ? 1u : 0u; mine = (j == x) ? c : mine; }
        if (sum == G) break;
        __builtin_amdgcn_s_sleep(1);
        if ((++sp & 255u) == 0u) { if (xb_ld(&bar[XB_TMO])) break; if (sp > XB_SPIN_CAP) { atomicAdd(&bar[XB_TMO], 1u); break; } }
    }
    nloc = mine > 0u ? mine : 1u; nx = cnt > 0u ? cnt : 1u;
}

__device__ __forceinline__ void xcd_barrier(const XcdBarrier& b) {
    asm volatile("s_waitcnt vmcnt(0)" ::: "memory");
    __syncthreads();
    if (threadIdx.x == 0) {
        unsigned* bar = b.bar;
        __builtin_amdgcn_s_waitcnt(0);
        unsigned nloc = b.st[0], nx = b.st[1];
        if (nloc == 0u) { xcd_barrier_complete(bar, b.x, nloc, nx); b.st[0] = nloc; b.st[1] = nx; }
        const unsigned old = xb_add(&bar[XB_XSUB(b.x)], 1u);
        const unsigned gen = old / nloc;
        if (old + 1u == (gen + 1u) * nloc) {
            __builtin_amdgcn_fence(__ATOMIC_RELEASE, "agent");
            asm volatile("s_waitcnt vmcnt(0)" ::: "memory");
            const unsigned og = xb_add(&bar[XB_TOP], 1u);
            const unsigned tg = og / nx;
            if (og + 1u == (tg + 1u) * nx) xb_add(&bar[XB_TOPGEN], 1u);
            else XB_SPIN(xb_ld(&bar[XB_TOPGEN]) == tg, bar);
            __builtin_amdgcn_fence(__ATOMIC_ACQUIRE, "agent");
            xb_add(&bar[XB_XGEN(b.x)], 1u);
            asm volatile("s_waitcnt vmcnt(0)" ::: "memory");
        } else {
            XB_SPIN(xb_ld(&bar[XB_XGEN(b.x)]) == gen, bar);
            __builtin_amdgcn_fence(__ATOMIC_ACQUIRE, "agent");
            asm volatile("s_waitcnt vmcnt(0)" ::: "memory");
        }
    }
    __syncthreads();
}


struct Args { const float* in[19]; float* out; unsigned char* wsp; int ph_lo, ph_hi, li, jobmask; };
struct Frame { LAS unsigned char* lds; int tid, lane, wave, vcu, G; };
#define KA ((const Args*)__builtin_amdgcn_kernarg_segment_ptr())
#define INP(i) (KA->in[i])
#define A_WS (KA->wsp)
#define A_OUT (KA->out)

__device__ __forceinline__ int p0_dstrow(int mode, int aux, int col) {
    if (mode == 1) { if (col < 1024) return col; const int v = col >= 2048, cc = col - (v ? 2048 : 1024); return 1024 + 256 * (cc >> 7) + 128 * v + (cc & 127); }
    if (mode == 2) { const int up = col >= aux, cc = col - (up ? aux : 0); return 256 * (cc >> 7) + 128 * up + (cc & 127); }
    if (mode == 3) { const int g = col >> 6, bj = (col >> 5) & 1; return 256 * (g >> 2) + 32 * (4 * bj + (g & 3)) + (col & 31); }
    return col;
}
struct P0Item { const float* src; const float* gain; unsigned char* dst; int ldw, K, k0, d0, d1, f8; float sc; };
#define P0_JOB(SRC, LDW, KK, C0, NCOLS, GAIN, DSTOFF, DROW0, DSTROWS, MODE, AUX, NMAT, SC, F8) { \
    constexpr int nn_ = (NCOLS) / 64, per_ = ((KK) / 64) * nn_, cnt_ = per_ * (NMAT); \
    if (it < cnt_) { const int mat = it / per_, r = it % per_, kb = r / nn_, col = 64 * (r % nn_); \
        I.src = (SRC) + (size_t)mat * (KK) * (LDW) + (C0) + col; I.gain = (GAIN); I.dst = A_WS + (DSTOFF) + (size_t)mat * (DSTROWS) * (KK) * ((F8) ? 1 : 2); \
        I.ldw = (LDW); I.K = (KK); I.k0 = 64 * kb; I.d0 = (DROW0) + p0_dstrow(MODE, AUX, col); I.d1 = (DROW0) + p0_dstrow(MODE, AUX, col + 32); I.f8 = (F8); I.sc = (SC); return; } \
    it -= cnt_; }
constexpr int P0_NITEMS = 16 * 48 + 16 * 16 + 16 * 88 + 44 * 16 + 3 * 16 * 16 + 16 * 16 + 8 * 16 * 112 + 8 * 56 * 16;
__device__ __forceinline__ void p0_decode(int it, P0Item& I) {
    P0_JOB(INP(3), 3072, 1024, 0, 3072, nullptr, WS_W_IN, 0, 3072, 1, 0, 1, 1.0f, 0)
    P0_JOB(INP(5), 1024, 1024, 0, 1024, nullptr, WS_W_OUT, 0, 1024, 0, 0, 1, 1.0f, 0)
    P0_JOB(INP(14), 5632, 1024, 0, 5632, INP(2), WS_W_GU, 0, 5632, 2, 2816, 1, pg8::F8_SWGD, 1)
    P0_JOB(INP(15), 1024, 2816, 0, 1024, nullptr, WS_W_DN, 0, 1024, 0, 0, 1, pg8::F8_SWDD, 1)
    P0_JOB(INP(9), 1024, 1024, 0, 1024, INP(1) + 1024, WS_W_QKV, 0, 3072, 3, 0, 1, 1.0f, 0)
    P0_JOB(INP(7), 2048, 1024, 0, 1024, INP(6), WS_W_QKV, 1024, 3072, 3, 0, 1, 1.0f, 0)
    P0_JOB(INP(7), 2048, 1024, 1024, 1024, INP(6), WS_W_QKV, 2048, 3072, 0, 0, 1, 1.0f, 0)
    P0_JOB(INP(13), 1024, 1024, 0, 1024, nullptr, WS_W_O, 0, 1024, 0, 0, 1, 1.0f, 0)
    P0_JOB(INP(17), 7168, 1024, 0, 7168, INP(2) + 1024, WS_W_MGU, 0, 7168, 2, 3584, 8, pg8::F8_SWG, 1)
    P0_JOB(INP(18), 1024, 3584, 0, 1024, nullptr, WS_W_MDN, 0, 1024, 0, 0, 8, pg8::F8_SWD, 1)
}
#undef P0_JOB
struct P0Regs { f32x4 v[16]; float g[16]; };
__device__ __forceinline__ void p0_load(const P0Item& I, P0Regs& R, int lane) {
    const int lr = lane >> 4, lc = lane & 15;
#pragma unroll
    for (int i = 0; i < 16; ++i) R.v[i] = *(const GAS f32x4*)(I.src + (size_t)(I.k0 + 4 * i + lr) * I.ldw + 4 * lc);
    if (I.gain) {
#pragma unroll
        for (int i = 0; i < 16; ++i) R.g[i] = I.gain[I.k0 + 4 * i + lr];
    } else {
#pragma unroll
        for (int i = 0; i < 16; ++i) R.g[i] = 1.0f;
    }
}
__device__ __forceinline__ void p0_store(const P0Item& I, const P0Regs& R, LAS float* scr, int lane) {
    const int lr = lane >> 4, lc = lane & 15;
#pragma unroll
    for (int i = 0; i < 16; ++i) { const f32x4 w = R.v[i] * (R.g[i] * I.sc); LAS float* p = scr + (4 * i + lr) * 65 + 4 * lc; p[0] = w[0]; p[1] = w[1]; p[2] = w[2]; p[3] = w[3]; }
    LDS_WAIT(); asm volatile("" ::: "memory");
    const int c = lane & 7;
#pragma unroll
    for (int jj = 0; jj < 8; ++jj) { const int nl = 8 * jj + (lane >> 3); const LAS float* s = scr + (8 * c) * 65 + nl;
        const int drow = (jj < 4 ? I.d0 : I.d1 - 32) + nl;
        if (I.f8) { v2u o; o.x = pg8::pk4_fp8(s[0], s[65], s[130], s[195]); o.y = pg8::pk4_fp8(s[260], s[325], s[390], s[455]);
            pg8::st8_wt(I.dst + (size_t)drow * I.K + I.k0 + 8 * c, o.x, o.y); }
        else { v4u o; o.x = pk2(s[0], s[65]); o.y = pk2(s[130], s[195]); o.z = pk2(s[260], s[325]); o.w = pk2(s[390], s[455]);
            pg8::st16_wt(I.dst + ((size_t)drow * I.K + I.k0 + 8 * c) * 2, o); } }
    LDS_WAIT(); asm volatile("" ::: "memory");
}
__device__ __forceinline__ void rms_row_bf16(const float* xrow, const float* g, bf16_t* orow, int lane) {
    const GAS f32x4* xr = (const GAS f32x4*)xrow + lane; const GAS f32x4* gr = (const GAS f32x4*)g + lane;
    f32x4 v[4]; float s = 0.f;
#pragma unroll
    for (int j = 0; j < 4; ++j) { v[j] = xr[64 * j]; s += (v[j][0] * v[j][0] + v[j][1] * v[j][1]) + (v[j][2] * v[j][2] + v[j][3] * v[j][3]); }
    const float rstd = __builtin_amdgcn_rsqf(wave_sum(s) * (1.f / D) + EPS);
    GAS v2u* o8 = (GAS v2u*)orow + lane;
#pragma unroll
    for (int j = 0; j < 4; ++j) { const f32x4 gg = gr[64 * j]; v2u o; o.x = pk2(v[j][0] * rstd * gg[0], v[j][1] * rstd * gg[1]); o.y = pk2(v[j][2] * rstd * gg[2], v[j][3] * rstd * gg[3]); o8[64 * j] = o; }
}
__device__ __forceinline__ void p0_prologue(Frame& F) {
    const int gw = F.vcu * NWAVES + F.wave, NGW = F.G * NWAVES;
    {
        const float* x = INP(0); const float* g = INP(1); bf16_t* XN = (bf16_t*)(A_WS + WS_XN0);
        const GAS f32x4* gr = (const GAS f32x4*)g + F.lane; f32x4 gg[4];
#pragma unroll
        for (int j = 0; j < 4; ++j) gg[j] = gr[64 * j];
        for (int mb = gw; mb < M; mb += 4 * NGW) { f32x4 v[4][4];
#pragma unroll
            for (int i = 0; i < 4; ++i) { const int m = mb + i * NGW; if (m < M) { const GAS f32x4* xr = (const GAS f32x4*)(x + (size_t)m * D) + F.lane;
#pragma unroll
                for (int j = 0; j < 4; ++j) v[i][j] = xr[64 * j]; } }
#pragma unroll
            for (int i = 0; i < 4; ++i) { const int m = mb + i * NGW; if (m >= M) break; float s = 0.f;
#pragma unroll
                for (int j = 0; j < 4; ++j) s += (v[i][j][0] * v[i][j][0] + v[i][j][1] * v[i][j][1]) + (v[i][j][2] * v[i][j][2] + v[i][j][3] * v[i][j][3]);
                const float rstd = __builtin_amdgcn_rsqf(wave_sum(s) * (1.f / D) + EPS); GAS v2u* o8 = (GAS v2u*)(XN + (size_t)m * D) + F.lane;
#pragma unroll
                for (int j = 0; j < 4; ++j) { v2u o; o.x = pk2(v[i][j][0] * rstd * gg[j][0], v[i][j][1] * rstd * gg[j][1]); o.y = pk2(v[i][j][2] * rstd * gg[j][2], v[i][j][3] * rstd * gg[j][3]); o8[64 * j] = o; } } }
    }
    LAS float* scr = (LAS float*)(F.lds + RING_OFF + F.wave * P0_SCR);
    int it = gw; if (it >= P0_NITEMS) return;
    P0Item cur; P0Regs ra; p0_decode(it, cur); p0_load(cur, ra, F.lane);
    for (;;) { const int nit = it + NGW; const bool has = nit < P0_NITEMS; P0Item nx; P0Regs rb;
        if (has) { p0_decode(nit, nx); p0_load(nx, rb, F.lane); }
        p0_store(cur, ra, scr, F.lane);
        if (!has) break;
        cur = nx; ra = rb; it = nit; }
}

__device__ __forceinline__ void up8(const v4u w, float (&f)[8]) { f[0] = bflo(w.x); f[1] = bfhi(w.x); f[2] = bflo(w.y); f[3] = bfhi(w.y); f[4] = bflo(w.z); f[5] = bfhi(w.z); f[6] = bflo(w.w); f[7] = bfhi(w.w); }
__device__ __forceinline__ void p2_conv(Frame& F) {
    const bf16_t* Bb = (const bf16_t*)(A_WS + WS_BB); const bf16_t* Ub = (const bf16_t*)(A_WS + WS_UB); bf16_t* G = (bf16_t*)(A_WS + WS_G); const float* cw = INP(4);
    const int gw = F.vcu * NWAVES + F.wave, NGW = F.G * NWAVES;
    for (int strip = gw; strip < 2048; strip += NGW) {
        const int r0 = (strip >> 1) * 16, c0 = (strip & 1) * 512 + F.lane * 8;
        float w0[8], w1[8], w2[8], um2[8], um1[8];
#pragma unroll
        for (int j = 0; j < 8; ++j) { w0[j] = cw[c0 + j]; w1[j] = cw[D + c0 + j]; w2[j] = cw[2 * D + c0 + j]; um2[j] = 0.f; um1[j] = 0.f; }
        if ((r0 & (SEQ - 1)) != 0) { up8(*(const GAS v4u*)(Ub + (size_t)(r0 - 2) * D + c0), um2); up8(*(const GAS v4u*)(Ub + (size_t)(r0 - 1) * D + c0), um1); }
#pragma unroll
        for (int hb = 0; hb < 2; ++hb) { v4u ru[8], rb[8];
#pragma unroll
            for (int i = 0; i < 8; ++i) { ru[i] = *(const GAS v4u*)(Ub + (size_t)(r0 + 8 * hb + i) * D + c0); rb[i] = *(const GAS v4u*)(Bb + (size_t)(r0 + 8 * hb + i) * D + c0); }
#pragma unroll
            for (int ii = 0; ii < 8; ++ii) { const int i = 8 * hb + ii; float u[8], b[8]; up8(ru[ii], u); up8(rb[ii], b);
            float g[8];
#pragma unroll
            for (int j = 0; j < 8; ++j) { g[j] = b[j] * (w0[j] * um2[j] + w1[j] * um1[j] + w2[j] * u[j]); um2[j] = um1[j]; um1[j] = u[j]; }
            v4u o; o.x = pk2(g[0], g[1]); o.y = pk2(g[2], g[3]); o.z = pk2(g[4], g[5]); o.w = pk2(g[6], g[7]);
            pg8::st16_wt(G + (size_t)(r0 + i) * D + c0, o); } }
    }
}

__device__ __forceinline__ void p8_diff(Frame& F) {
    const bf16_t* O0 = (const bf16_t*)(A_WS + WS_O0); const bf16_t* O1 = (const bf16_t*)(A_WS + WS_O1); bf16_t* ON = (bf16_t*)(A_WS + WS_ON);
    const float* lp = INP(11); const float* sn = INP(12); const int lane = F.lane;
    const float lam = __expf(wave_sum(lp[lane] * lp[64 + lane])) - __expf(wave_sum(lp[128 + lane] * lp[192 + lane])) + LAM_INIT;
    float gn[16];
#pragma unroll
    for (int j = 0; j < 16; ++j) gn[j] = sn[16 * (lane & 7) + j] * (1.f - LAM_INIT);
    const int gw = F.vcu * NWAVES + F.wave, NGW = F.G * NWAVES;
    for (int rowb = gw; rowb < M; rowb += 4 * NGW) {
        v4u ra[4][2], rb[4][2];
#pragma unroll
        for (int i = 0; i < 4; ++i) { const int row = rowb + i * NGW; if (row < M) { const size_t off = (size_t)row * D + 16 * lane;
            ra[i][0] = *(const GAS v4u*)(O0 + off); ra[i][1] = *(const GAS v4u*)(O0 + off + 8); rb[i][0] = *(const GAS v4u*)(O1 + off); rb[i][1] = *(const GAS v4u*)(O1 + off + 8); } }
#pragma unroll
        for (int i = 0; i < 4; ++i) { const int row = rowb + i * NGW; if (row >= M) break; const size_t off = (size_t)row * D + 16 * lane;
            float a[16], a0[8], a1[8], b0[8], b1[8]; up8(ra[i][0], a0); up8(ra[i][1], a1); up8(rb[i][0], b0); up8(rb[i][1], b1);
            float s = 0.f;
#pragma unroll
            for (int j = 0; j < 8; ++j) { a[j] = a0[j] - lam * b0[j]; a[8 + j] = a1[j] - lam * b1[j]; s += a[j] * a[j] + a[8 + j] * a[8 + j]; }
            s += __shfl_xor(s, 1); s += __shfl_xor(s, 2); s += __shfl_xor(s, 4);
            const float rstd = __builtin_amdgcn_rsqf(s * (1.f / VD) + EPS);
            v4u o0, o1; o0.x = pk2(a[0] * rstd * gn[0], a[1] * rstd * gn[1]); o0.y = pk2(a[2] * rstd * gn[2], a[3] * rstd * gn[3]); o0.z = pk2(a[4] * rstd * gn[4], a[5] * rstd * gn[5]); o0.w = pk2(a[6] * rstd * gn[6], a[7] * rstd * gn[7]);
            o1.x = pk2(a[8] * rstd * gn[8], a[9] * rstd * gn[9]); o1.y = pk2(a[10] * rstd * gn[10], a[11] * rstd * gn[11]); o1.z = pk2(a[12] * rstd * gn[12], a[13] * rstd * gn[13]); o1.w = pk2(a[14] * rstd * gn[14], a[15] * rstd * gn[15]);
            pg8::st16_wt(ON + off, o0); pg8::st16_wt(ON + off + 8, o1); }
    }
}

#define TR_STEP(n, m) do { _Pragma("unroll") for (int i = 0; i < (n) / 2; ++i) { const bool up = (lane & (m)) != 0; const float keep = up ? v[i + (n) / 2] : v[i], send = up ? v[i] : v[i + (n) / 2]; v[i] = keep + __shfl_xor(send, (m)); } } while (0)
__device__ __forceinline__ void p10a_router(Frame& F) {
    const bf16_t* x3 = (const bf16_t*)(A_WS + WS_XB); const float* g = INP(2) + D; const float* Wr = INP(16); const float* ssq = (const float*)(A_WS + WS_SSQ);
    int* sel = (int*)(A_WS + WS_SEL); float* gate = (float*)(A_WS + WS_GATE); int* hist = (int*)(A_WS + WS_HIST);
    LAS f32x4* WL = (LAS f32x4*)(F.lds + RING_OFF);
    LAS int* lcnt = (LAS int*)(F.lds + RING_OFF + 32768);
    const int lane = F.lane;
    for (int k = F.tid; k < D; k += NWAVES * 64) { const float gk = g[k]; const f32x4 w0 = *(const GAS f32x4*)(Wr + (size_t)k * 8) * gk, w1 = *(const GAS f32x4*)(Wr + (size_t)k * 8 + 4) * gk;
        const int base = (((k >> 8) * 4 + (k & 3)) * 2) * 64 + ((k >> 2) & 63); WL[base] = w0; WL[base + 64] = w1; }
    LDS_WAIT(); __syncthreads();
    for (int blk = blockIdx.x; blk < M / 64; blk += F.G) {
        const int row0 = 64 * blk + 8 * F.wave;
        f32x4 xv[8][4];
#pragma unroll
        for (int r = 0; r < 8; ++r)
#pragma unroll
            for (int j = 0; j < 4; ++j) { const v2u w = *((const GAS v2u*)(x3 + (size_t)(row0 + r) * D) + lane + 64 * j); xv[r][j] = (f32x4){bflo(w.x), bfhi(w.x), bflo(w.y), bfhi(w.y)}; }
        float v[64];
#pragma unroll
        for (int i = 0; i < 64; ++i) v[i] = 0.f;
#pragma unroll
        for (int j = 0; j < 4; ++j)
#pragma unroll
            for (int q = 0; q < 4; ++q) { const f32x4 wa = WL[((j * 4 + q) * 2) * 64 + lane], wb = WL[((j * 4 + q) * 2 + 1) * 64 + lane];
#pragma unroll
                for (int r = 0; r < 8; ++r) { const float xx = xv[r][j][q];
                    v[r * 8 + 0] += xx * wa[0]; v[r * 8 + 1] += xx * wa[1]; v[r * 8 + 2] += xx * wa[2]; v[r * 8 + 3] += xx * wa[3];
                    v[r * 8 + 4] += xx * wb[0]; v[r * 8 + 5] += xx * wb[1]; v[r * 8 + 6] += xx * wb[2]; v[r * 8 + 7] += xx * wb[3]; } }
        TR_STEP(64, 32); TR_STEP(32, 16); TR_STEP(16, 8); TR_STEP(8, 4); TR_STEP(4, 2); TR_STEP(2, 1);
        float lg[8];
#pragma unroll
        for (int e = 0; e < 8; ++e) lg[e] = __shfl(v[0], (lane & ~7) | e);
        int i0 = 0; float v0 = lg[0];
#pragma unroll
        for (int e = 1; e < 8; ++e) if (lg[e] > v0) { v0 = lg[e]; i0 = e; }
        int i1 = 0; float v1 = -INFINITY;
#pragma unroll
        for (int e = 0; e < 8; ++e) if (e != i0 && lg[e] > v1) { v1 = lg[e]; i1 = e; }
        const int row = row0 + (lane >> 3); const float rs = pg8::rstd_of(ssq, row);
        const float g1 = 1.f / (1.f + expf((v0 - v1) * rs)); const bool wrt = (lane & 7) == 0;
        if (wrt) { sel[2 * row] = i0; sel[2 * row + 1] = i1; gate[2 * row] = 1.f - g1; gate[2 * row + 1] = g1; }
        int mycnt = 0;
#pragma unroll
        for (int e = 0; e < 8; ++e) { const int c = __popcll(__ballot(wrt && i0 == e)) + __popcll(__ballot(wrt && i1 == e)); if (lane == e) mycnt = c; }
        if (lane < 8) lcnt[F.wave * 8 + lane] = mycnt;
        LDS_WAIT(); __syncthreads();
        if (F.tid < 8) { int c = 0;
#pragma unroll
            for (int w = 0; w < 8; ++w) c += lcnt[w * 8 + F.tid];
            hist[blk * 8 + F.tid] = c; }
        LDS_WAIT(); __syncthreads();
    }
}
#undef TR_STEP
__device__ __forceinline__ void p10b_assign(Frame& F) {
    const int* hist = (const int*)(A_WS + WS_HIST); const int* sel = (const int*)(A_WS + WS_SEL); const float* gate = (const float*)(A_WS + WS_GATE); const float* ssq = (const float*)(A_WS + WS_SSQ);
    int* tok_slot = (int*)(A_WS + WS_TOKSLOT); float* gates = (float*)(A_WS + WS_GATES); int* meta = (int*)(A_WS + WS_META);
    const bf16_t* x3 = (const bf16_t*)(A_WS + WS_XB); unsigned char* XG = A_WS + WS_XG;
    LAS int* pre = (LAS int*)(F.lds + RING_OFF);
    LAS int* tot = pre + 2048;
    LAS int* ebase = tot + 8;
    LAS int* lslot = ebase + 8;
    const int lane = F.lane, e = F.wave;
    { int h[4], run = 0;
#pragma unroll
      for (int i = 0; i < 4; ++i) { h[i] = hist[(4 * lane + i) * 8 + e]; }
      const int mine = h[0] + h[1] + h[2] + h[3]; int inc = mine;
#pragma unroll
      for (int o = 1; o < 64; o <<= 1) { const int t = __shfl_up(inc, o); if (lane >= o) inc += t; }
      run = inc - mine;
#pragma unroll
      for (int i = 0; i < 4; ++i) { pre[(4 * lane + i) * 8 + e] = run; run += h[i]; }
      if (lane == 63) tot[e] = inc; }
    LDS_WAIT(); __syncthreads();
    if (F.tid == 0) { int b = 0; for (int k = 0; k < 8; ++k) { ebase[k] = b; if (blockIdx.x == 0) meta[k] = b >> 8; b += (tot[k] + 255) & ~255; } if (blockIdx.x == 0) { const int T = b >> 8, full = 2 * F.G / 4; meta[8] = T; meta[9] = T < full ? T : full; } }
    LDS_WAIT(); __syncthreads();
    for (int blk = blockIdx.x; blk < M / 64; blk += F.G) {
        if (F.wave == 0) { const int t = 64 * blk + lane; const int s0 = sel[2 * t], s1 = sel[2 * t + 1]; int sl0 = 0, sl1 = 0;
            const unsigned long long below = (1ull << lane) - 1ull;
#pragma unroll
            for (int k = 0; k < 8; ++k) { const unsigned long long m0 = __ballot(s0 == k), m1 = __ballot(s1 == k); const int b0 = ebase[k] + pre[blk * 8 + k];
                if (s0 == k) sl0 = b0 + __popcll(m0 & below); if (s1 == k) sl1 = b0 + __popcll(m0) + __popcll(m1 & below); }
            tok_slot[2 * t] = sl0; tok_slot[2 * t + 1] = sl1; lslot[2 * lane] = sl0; lslot[2 * lane + 1] = sl1;
            gates[sl0] = gate[2 * t]; gates[sl1] = gate[2 * t + 1]; }
        LDS_WAIT(); __syncthreads();
        v4u xw[8][2];
#pragma unroll
        for (int i = 0; i < 8; ++i) { const GAS v4u* xr = (const GAS v4u*)(x3 + (size_t)(64 * blk + 8 * F.wave + i) * D + 16 * lane); xw[i][0] = xr[0]; xw[i][1] = xr[1]; }
#pragma unroll
        for (int i = 0; i < 8; ++i) { const int tl = 8 * F.wave + i; const int t = 64 * blk + tl;
            const float rs = pg8::rstd_of(ssq, t) * pg8::F8_SA; float a[8], b[8]; up8(xw[i][0], a); up8(xw[i][1], b);
            v4u o; o.x = pg8::pk4_fp8(a[0] * rs, a[1] * rs, a[2] * rs, a[3] * rs); o.y = pg8::pk4_fp8(a[4] * rs, a[5] * rs, a[6] * rs, a[7] * rs); o.z = pg8::pk4_fp8(b[0] * rs, b[1] * rs, b[2] * rs, b[3] * rs); o.w = pg8::pk4_fp8(b[4] * rs, b[5] * rs, b[6] * rs, b[7] * rs);
            const int sl0 = lslot[2 * tl], sl1 = lslot[2 * tl + 1];
            pg8::st16_wt(XG + (size_t)sl0 * D + 16 * lane, o); pg8::st16_wt(XG + (size_t)sl1 * D + 16 * lane, o); }
        LDS_WAIT(); __syncthreads();
    }
}
__device__ __forceinline__ void p13_load_y(const bf16_t* Y, const float* Pp, const float* gates, int nfull, int slot, int lane, v2u (&y)[4]) {
    const int rt = (slot >> 8) - nfull;
    if (rt < 0) { const GAS v2u* yr = (const GAS v2u*)(Y + (size_t)slot * D) + lane;
#pragma unroll
        for (int j = 0; j < 4; ++j) y[j] = yr[64 * j];
    } else { const float gt = gates[slot] * (1.0f / (pg8::F8_SH * pg8::F8_SWD));
#pragma unroll
        for (int j = 0; j < 4; ++j) { f32x4 s = (f32x4){0.f, 0.f, 0.f, 0.f};
#pragma unroll
            for (int kp = 0; kp < pg8::MoeOrder::SPL; ++kp) s += *((const GAS f32x4*)(Pp + ((size_t)(rt * pg8::MoeOrder::SPL + kp) * 256 + (slot & 255)) * D) + lane + 64 * j);
            y[j].x = pk2(s[0] * gt, s[1] * gt); y[j].y = pk2(s[2] * gt, s[3] * gt); } }
}
__device__ __forceinline__ void p13_final(Frame& F) {
    const int* tok_slot = (const int*)(A_WS + WS_TOKSLOT); const bf16_t* Y = (const bf16_t*)(A_WS + WS_Y); const bf16_t* X3 = (const bf16_t*)(A_WS + WS_XB); float* out = A_OUT;
    const float* Pp = (const float*)(A_WS + WS_PP); const float* gates = (const float*)(A_WS + WS_GATES); const int nfull = ((const int*)(A_WS + WS_META))[9];
    const int gw = F.vcu * NWAVES + F.wave, NGW = F.G * NWAVES, lane = F.lane;
    for (int rowb = gw; rowb < M; rowb += 2 * NGW) {
        v2u xa[2][4], ya[2][4], yb[2][4];
#pragma unroll
        for (int i = 0; i < 2; ++i) { const int row = rowb + i * NGW; if (row < M) { const int s0 = tok_slot[2 * row], s1 = tok_slot[2 * row + 1];
            const GAS v2u* xr = (const GAS v2u*)(X3 + (size_t)row * D) + lane;
#pragma unroll
            for (int j = 0; j < 4; ++j) xa[i][j] = xr[64 * j];
            p13_load_y(Y, Pp, gates, nfull, s0, lane, ya[i]); p13_load_y(Y, Pp, gates, nfull, s1, lane, yb[i]); } }
#pragma unroll
        for (int i = 0; i < 2; ++i) { const int row = rowb + i * NGW; if (row >= M) break; GAS f32x4* orow = (GAS f32x4*)(out + (size_t)row * D) + lane;
#pragma unroll
            for (int j = 0; j < 4; ++j) { const v2u x = xa[i][j], a = ya[i][j], b = yb[i][j];
                orow[64 * j] = (f32x4){bflo(x.x) + (bflo(a.x) + bflo(b.x)), bfhi(x.x) + (bfhi(a.x) + bfhi(b.x)), bflo(x.y) + (bflo(a.y) + bflo(b.y)), bfhi(x.y) + (bfhi(a.y) + bfhi(b.y))}; } }
    }
}

__global__ void __launch_bounds__(NWAVES * 64, 2) mega_fwd(Args args) {
    extern __shared__ __attribute__((aligned(16))) unsigned char lds[];
    Frame F;
    F.lds = (LAS unsigned char*)lds; F.tid = threadIdx.x; F.lane = F.tid & 63; F.wave = __builtin_amdgcn_readfirstlane(F.tid >> 6);
    F.G = gridDim.x; { const int bx = blockIdx.x; F.vcu = (F.G % 8 == 0) ? (bx % 8) * (F.G / 8) + bx / 8 : bx; }
    for (int u = F.tid; u < RING_OFF / 4; u += NWAVES * 64) ((LAS unsigned*)(F.lds + MISC_OFF))[u] = 0u;
    __syncthreads();
    if (KA->ph_hi - KA->ph_lo > 1) (void)xcd_barrier_post((unsigned*)(A_WS + WS_CTL) + CW_BAR + KA->li * XCD_BAR_WORDS, (volatile LAS unsigned*)(F.lds + MISC_OFF + 32));
#define IN(k) (KA->ph_lo <= (k) && (k) < KA->ph_hi)
#define SEAM(k) do { if (IN(k) && IN((k) + 1)) { XcdBarrier b_; b_.bar = (unsigned*)(A_WS + WS_CTL) + CW_BAR + KA->li * XCD_BAR_WORDS; b_.x = xb_xcc_id(); b_.st = (volatile LAS unsigned*)(F.lds + MISC_OFF + 32); xcd_barrier(b_); } } while (0)
#define ws A_WS
#define XB ((bf16_t*)(A_WS + WS_XB))
#define SSQ ((float*)(A_WS + WS_SSQ))

    if (IN(0)) { p0_prologue(F); } SEAM(0);
    if (IN(1)) { pg8::Gemm g{(const bf16_t*)(ws + WS_XN0), (const bf16_t*)(ws + WS_W_IN), M, 3072, 1024}; pg8::StaticOrder S; S.init(M, 3072, F.G, (int)blockIdx.x);
        pg8::EpiInProj E{(bf16_t*)(ws + WS_BB), (bf16_t*)(ws + WS_UB)};
        pg8::gemm_phase<pg8::EpiInProj, pg8::StaticOrder, true, true>(F.lds + RING_OFF, g, S, E); } SEAM(1);
    if (IN(2)) { p2_conv(F); } SEAM(2);
    if (IN(3)) { pg8::Gemm g{(const bf16_t*)(ws + WS_G), (const bf16_t*)(ws + WS_W_OUT), M, 1024, 1024}; pg8::StaticOrder S; S.init(M, 1024, F.G, (int)blockIdx.x);
        pg8::EpiResidSsq<true> E{INP(0), XB, SSQ, 1.0f, ws + WS_X8};
        pg8::gemm_phase<pg8::EpiResidSsq<true>, pg8::StaticOrder, false, true>(F.lds + RING_OFF, g, S, E); } SEAM(3);
    if (IN(4)) { pg8::Gemm g{(const bf16_t*)(ws + WS_X8), (const bf16_t*)(ws + WS_W_GU), M, 5632, 512}; pg8::StaticOrder S; S.init(M, 5632, F.G, (int)blockIdx.x);
        pg8::EpiSwiGLU<true> E{ws + WS_HACT, DFF, SSQ, nullptr, 22, 1.0f / (pg8::F8_SX * pg8::F8_SWGD)};
        pg8::gemm_phase<pg8::EpiSwiGLU<true>, pg8::StaticOrder, true, true, true>(F.lds + RING_OFF, g, S, E); } SEAM(4);
    if (IN(5)) { pg8::Gemm g{(const bf16_t*)(ws + WS_HACT), (const bf16_t*)(ws + WS_W_DN), M, 1024, DFF / 2}; pg8::StaticOrder S; S.init(M, 1024, F.G, (int)blockIdx.x);
        pg8::EpiResidSsq<false> E{nullptr, XB, SSQ, 1.0f / (pg8::F8_SHD * pg8::F8_SWDD), nullptr};
        pg8::gemm_phase<pg8::EpiResidSsq<false>, pg8::StaticOrder, false, true, true>(F.lds + RING_OFF, g, S, E); } SEAM(5);
    if (IN(6)) { pg8::Gemm g{XB, (const bf16_t*)(ws + WS_W_QKV), M, 3072, 1024}; pg8::StaticOrder S; S.init(M, 3072, F.G, (int)blockIdx.x);
        pg8::EpiQKV E{(bf16_t*)(ws + WS_Q), (bf16_t*)(ws + WS_K), (bf16_t*)(ws + WS_V), SSQ, INP(10), INP(8), attn_body::C2};
        pg8::gemm_phase<pg8::EpiQKV, pg8::StaticOrder, true, true>(F.lds + RING_OFF, g, S, E); } SEAM(6);
    if (IN(7)) {
        for (int it = F.vcu; it < BATCH * 32; it += F.G) { const int tr = it >> 1, b = tr >> 4, h = (tr >> 1) & 7, c = tr & 1;
            attn_body::bf16* O = (attn_body::bf16*)(ws + (c ? WS_O1 : WS_O0));
            for (int i = 0; i < 4; ++i) { const int p = 2 * (i >> 1) + (it & 1), qb = (i & 1) ? 7 - p : p;
                attn_body::attn_unit<8>(b, (2 * h + c) * 64, h * 128, qb, (const attn_body::bf16*)(ws + WS_Q), (const attn_body::bf16*)(ws + WS_K), (const attn_body::bf16*)(ws + WS_V), O, (char*)lds + RING_OFF); } }
    } SEAM(7);
    if (IN(8)) { p8_diff(F); } SEAM(8);
    if (IN(9)) { pg8::Gemm g{(const bf16_t*)(ws + WS_ON), (const bf16_t*)(ws + WS_W_O), M, 1024, 1024}; pg8::StaticOrder S; S.init(M, 1024, F.G, (int)blockIdx.x);
        pg8::EpiResidSsq<false> E{nullptr, XB, SSQ, 1.0f, nullptr};
        pg8::gemm_phase<pg8::EpiResidSsq<false>, pg8::StaticOrder, false, true>(F.lds + RING_OFF, g, S, E); } SEAM(9);
    if (IN(10)) { p10a_router(F); } SEAM(10);
    if (IN(11)) { p10b_assign(F); } SEAM(11);
    if (IN(12)) { pg8::Gemm g{(const bf16_t*)(ws + WS_XG), (const bf16_t*)(ws + WS_W_MGU), SLOTS, 8 * 7168, 512}; pg8::MoeOrder S; S.init((const int*)(ws + WS_META), 28, F.G, (int)blockIdx.x, false);
        pg8::EpiSwiGLU8 E{ws + WS_HM, DFE, 28};
        pg8::gemm_phase<pg8::EpiSwiGLU8, pg8::MoeOrder, true, true, true>(F.lds + RING_OFF, g, S, E); } SEAM(12);
    if (IN(13)) { pg8::Gemm g{(const bf16_t*)(ws + WS_HM), (const bf16_t*)(ws + WS_W_MDN), SLOTS, 8 * 1024, DFE / 2}; pg8::MoeOrder S; S.init((const int*)(ws + WS_META), 4, F.G, (int)blockIdx.x, true);
        pg8::EpiMoeDown E{(bf16_t*)(ws + WS_Y), (const float*)(ws + WS_GATES), 1.0f / (pg8::F8_SH * pg8::F8_SWD), (float*)(ws + WS_PP)};
        pg8::gemm_phase<pg8::EpiMoeDown, pg8::MoeOrder, true, true, true>(F.lds + RING_OFF, g, S, E); } SEAM(13);
    if (IN(14)) { p13_final(F); }
#undef IN
#undef SEAM
#undef ws
#undef XB
#undef SSQ
}
#ifndef MEGA_UPTO
#define MEGA_UPTO 15
#endif
#ifndef MEGA_REPMASK
#define MEGA_REPMASK 0
#endif
#ifndef MEGA_ONE
#define MEGA_ONE 1
#endif
extern "C" void kernel_launch(void* const* d_in, const int* in_sizes, int n_in, void* d_out, int out_size, void* d_ws, size_t ws_size, hipStream_t stream) {
    static int grid = 0;
    if (grid == 0) {
        if (n_in != 19 || in_sizes[0] != M * D || out_size != M * D || ws_size < WS_END) { fprintf(stderr, "kernel_launch: unexpected shapes / workspace (%d inputs, ws %zu, need %zu)\n", n_in, ws_size, (size_t)WS_END); grid = -1; return; }
        int dev = 0, cus = 0, per_cu = 0;
        if (hipGetDevice(&dev) != hipSuccess || hipDeviceGetAttribute(&cus, hipDeviceAttributeMultiprocessorCount, dev) != hipSuccess) { grid = -1; return; }
        if (hipFuncSetAttribute((const void*)mega_fwd, hipFuncAttributeMaxDynamicSharedMemorySize, LDS_BYTES) != hipSuccess) { fprintf(stderr, "kernel_launch: hipFuncSetAttribute failed\n"); grid = -1; return; }
        if (hipOccupancyMaxActiveBlocksPerMultiprocessor(&per_cu, (const void*)mega_fwd, NWAVES * 64, LDS_BYTES) != hipSuccess || per_cu < 1) fprintf(stderr, "kernel_launch: note: occupancy query says %d\n", per_cu);
        (void)hipGetLastError();
        grid = cus < 256 ? cus : 256;
        if (grid != 256) fprintf(stderr, "kernel_launch: %d CUs; this kernel is built for 256\n", cus);
    }
    if (grid < 0) return;
    unsigned char* ws = (unsigned char*)d_ws; float* out = (float*)d_out;
    constexpr int UPTO = MEGA_UPTO;
    static_assert(UPTO == 15, "the plain reference kernels of the transition builds are gone: all 15 phases run in the persistent kernel");
    if (UPTO > 0) {
        if (hipMemsetAsync(ws + WS_CTL, 0, CTL_ZERO_BYTES, stream) != hipSuccess) { fprintf(stderr, "kernel_launch: memset failed\n"); return; }
        Args a{};
        for (int i = 0; i < 19; ++i) a.in[i] = (const float*)d_in[i];
        a.out = out; a.wsp = ws;
        a.jobmask = UPTO >= 15 ? 255 : UPTO >= 10 ? 63 : UPTO >= 7 ? 31 : UPTO >= 6 ? 15 : 3;
        if (MEGA_ONE) { a.ph_lo = 0; a.ph_hi = UPTO; a.li = 0; hipLaunchKernelGGL(mega_fwd, dim3(grid), dim3(NWAVES * 64), LDS_BYTES, stream, a); }
        else for (int p = 0; p < UPTO; ++p) { a.ph_lo = p; a.ph_hi = p + 1; a.li = 0; for (int r = 0; r <= ((MEGA_REPMASK >> p) & 1); ++r) hipLaunchKernelGGL(mega_fwd, dim3(grid), dim3(NWAVES * 64), LDS_BYTES, stream, a); }
        const hipError_t le = hipPeekAtLastError();
        if (le != hipSuccess) fprintf(stderr, "kernel_launch: launch failed: %s\n", hipGetErrorName(le));
    }
}
```

```cpp
#include <hip/hip_runtime.h>
#include <hip/hip_bf16.h>
#include <stdint.h>
#include <stdio.h>
#include <cmath>
#define MEGA_UPTO 15
#define MEGA_ONE 1
typedef unsigned short bf16_t;
typedef short bf16x8 __attribute__((ext_vector_type(8)));
typedef float f32x4 __attribute__((ext_vector_type(4)));
constexpr int D = 1024, BATCH = 8, SEQ = 2048, M = BATCH * SEQ;
constexpr int NH = 8, HD = 64, VD = 128;
constexpr int DFF = 2816, NE = 8, DFE = 3584;
constexpr float EPS = 1e-6f;
constexpr float LAM_INIT = 0.35550907f;
constexpr int SLOTS = 2 * M + NE * 256;

__device__ __forceinline__ unsigned f2bf(float f) { unsigned u = __builtin_bit_cast(unsigned, f); return (u + 0x7fffu + ((u >> 16) & 1u)) >> 16; }
__device__ __forceinline__ float bf2f(unsigned short b) { return __builtin_bit_cast(float, (unsigned)b << 16); }
__device__ __forceinline__ float wave_sum(float v) {
#pragma unroll
    for (int o = 1; o < 64; o <<= 1) v += __shfl_xor(v, o);
    return v;
}

namespace pg8 {
#define PG8_LAS __attribute__((address_space(3)))
typedef unsigned short bf16_t;
typedef short bf16x8 __attribute__((ext_vector_type(8)));
typedef float f32x4 __attribute__((ext_vector_type(4)));
typedef unsigned u32x4 __attribute__((ext_vector_type(4)));
typedef int i32x4 __attribute__((ext_vector_type(4)));
typedef int i32x8 __attribute__((ext_vector_type(8)));
constexpr int BM = 256, BK = 64, HALF = 128, HTB = HALF * BK * 2  , STAGE_BYTES = 8 * HTB, NXCD = 8, WGM = 8;

__host__ __device__ __forceinline__ int lds_byte(int r, int c) { const int st = (r >> 4) * 2 + (c >> 5), rr = r & 15, cc = c & 31, ob = rr * 64 + cc * 2; return st * 1024 + (ob ^ (((ob >> 9) & 1) << 5)); }
__host__ __device__ __forceinline__ void stage_rc(int b, int& R, int& C) { const int st = b / 1024, sb = b % 1024, swz = sb ^ (((sb >> 9) & 1) << 5); R = (st >> 1) * 16 + swz / 64; C = (st & 1) * 32 + (swz % 64) / 2; }
__host__ __device__ __forceinline__ int perm32(int rho) { const int n = rho >> 4, i = rho & 15; return 8 * (i >> 2) + 4 * n + (i & 3); }

struct Unit { int pm, pn; int kt0, nkt, aux; };
struct Gemm { const bf16_t* A; const bf16_t* Bt; int M, N, K; };

struct StaticOrder {
    int nM, nN, nwg, G, c;
    __host__ __device__ void init(int M, int N, int G_, int c_) { nM = M / BM; nN = N / BM; nwg = nM * nN; G = G_; c = c_; }
    __host__ __device__ bool next(int i, Unit& u) const {
        const long L = (long)i * G + c; if (L >= nwg) return false;
        int wgid = (int)L; { const int q = nwg / NXCD, r = nwg % NXCD, xcd = wgid % NXCD, off = wgid / NXCD; wgid = (xcd < r ? xcd * (q + 1) : r * (q + 1) + (xcd - r) * q) + off; }
        const int nig = WGM * nN, gid = wgid / nig, fm = gid * WGM, gsz = (nM - fm) < WGM ? (nM - fm) : WGM;
        u.pm = fm + ((wgid % nig) % gsz); u.pn = (wgid % nig) / gsz; u.kt0 = 0; u.nkt = 0; u.aux = -1; return true;
    }
    __device__ __forceinline__ void a_ready(const Unit&) const {}
    __device__ __forceinline__ void done(const Unit&) const {}
};

__device__ __forceinline__ unsigned cvt_pk_bf16(float lo, float hi) { unsigned r; asm volatile("v_cvt_pk_bf16_f32 %0, %1, %2" : "=v"(r) : "v"(lo), "v"(hi)); return r; }
typedef float f32x2 __attribute__((ext_vector_type(2)));
#ifndef PG8_WT
#define PG8_WT 0
#endif
__device__ __forceinline__ void st16_wt(void* p, u32x4 v) {
#if PG8_WT
    asm volatile("global_store_dwordx4 %0, %1, off sc1\n\ts_nop 1" :: "v"(p), "v"(v) : "memory");
#else
    *(u32x4*)p = v;
#endif
}
__device__ __forceinline__ void st8_wt(void* p, unsigned x, unsigned y) {
#if PG8_WT
    typedef unsigned u32x2_ __attribute__((ext_vector_type(2))); const u32x2_ v = {x, y};
    asm volatile("global_store_dwordx2 %0, %1, off sc1\n\ts_nop 1" :: "v"(p), "v"(v) : "memory");
#else
    typedef unsigned u32x2_ __attribute__((ext_vector_type(2))); *(u32x2_*)p = (u32x2_){x, y};
#endif
}
typedef unsigned u32x2 __attribute__((ext_vector_type(2)));
constexpr float RMS_EPS = 1e-6f, LOG2E = 1.4426950408889634f;
constexpr int DM_ = 1024;
__device__ __forceinline__ u32x4 pack8(const f32x4 a, const f32x4 b) { u32x4 w; w.x = cvt_pk_bf16(a[0], a[1]); w.y = cvt_pk_bf16(a[2], a[3]); w.z = cvt_pk_bf16(b[0], b[1]); w.w = cvt_pk_bf16(b[2], b[3]); return w; }
__device__ __forceinline__ float rstd_of(const float* ssq, int row) { const f32x4 p = *(const f32x4*)(ssq + (size_t)row * 4); return __builtin_amdgcn_rsqf(((p[0] + p[1]) + (p[2] + p[3])) * (1.0f / 1024.0f) + RMS_EPS); }
__device__ __forceinline__ float silu_mul(float g, float u) { return g * u * __builtin_amdgcn_rcpf(1.0f + __builtin_amdgcn_exp2f(-g * LOG2E)); }
__device__ __forceinline__ f32x2 swiglu2(f32x2 a, f32x2 b, float c1, float k) {
    const f32x2 t = a * c1; f32x2 e; e.x = __builtin_amdgcn_exp2f(t.x); e.y = __builtin_amdgcn_exp2f(t.y);
    const f32x2 d = e * k + k; f32x2 r; r.x = __builtin_amdgcn_rcpf(d.x); r.y = __builtin_amdgcn_rcpf(d.y);
    return (a * b) * r;
}

__device__ __forceinline__ float clamp448(float x) { return __builtin_amdgcn_fmed3f(x, -448.0f, 448.0f); }
__device__ __forceinline__ unsigned pk4_fp8(float a, float b, float c, float d) { int w = 0; w = __builtin_amdgcn_cvt_pk_fp8_f32(clamp448(a), clamp448(b), w, false); w = __builtin_amdgcn_cvt_pk_fp8_f32(clamp448(c), clamp448(d), w, true); return (unsigned)w; }
constexpr float F8_SA = 4.0f, F8_SWG = 256.0f, F8_SH = 8.0f, F8_SWD = 512.0f;
constexpr float F8_SHD = 8.0f, F8_SWDD = 256.0f, F8_SX = 4.0f, F8_SWGD = 256.0f;

struct EpiInProj {
    static constexpr bool PERM = true, AFTER_DRAIN = false;
    bf16_t* Bb; bf16_t* Ub;
    __device__ __forceinline__ void operator()(const f32x4 (&acc)[2][2][4][2], const Unit& u, int wr, int wc, int fr, int fq) const {
        const int row0 = u.pm * BM + wr * 64 + fr;
        if (u.pn < 4) {
            const int col0 = u.pn * BM + wc * 32 + 8 * fq;
#pragma unroll
            for (int ai = 0; ai < 2; ++ai)
#pragma unroll
                for (int m = 0; m < 4; ++m) { bf16_t* rowp = Bb + (size_t)(row0 + ai * HALF + m * 16) * DM_ + col0;
#pragma unroll
                    for (int bj = 0; bj < 2; ++bj) st16_wt(rowp + bj * HALF, pack8(acc[ai][bj][m][0], acc[ai][bj][m][1])); }
        } else {
            const int col0 = (u.pn - 4) * 128 + wc * 32 + 8 * fq;
#pragma unroll
            for (int ai = 0; ai < 2; ++ai)
#pragma unroll
                for (int m = 0; m < 4; ++m) { bf16_t* rowp = Ub + (size_t)(row0 + ai * HALF + m * 16) * DM_ + col0;
                    st16_wt(rowp, pack8(acc[ai][0][m][0] * acc[ai][1][m][0], acc[ai][0][m][1] * acc[ai][1][m][1])); }
        }
    }
};

template <bool FIRST> struct EpiResidSsq {
    static constexpr bool PERM = true, AFTER_DRAIN = true;
    const float* x0; bf16_t* xb; float* ssq; float ascale; unsigned char* x8;
    __device__ __forceinline__ void fused(f32x4 (&acc)[2][2][4][2], const Unit& u, int wr, int wc, int fr, int fq, PG8_LAS unsigned char* lds, int wid, int lane) const {
        PG8_LAS float* P = (PG8_LAS float*)lds;
        const int col0 = u.pn * BM + wc * 32 + 8 * fq;
#pragma unroll
        for (int ai = 0; ai < 2; ++ai) {
            f32x4 xo[4][2][2];
#pragma unroll
            for (int m = 0; m < 4; ++m) { const int r = ai * HALF + wr * 64 + m * 16 + fr; const size_t off = (size_t)(u.pm * BM + r) * DM_ + col0;
#pragma unroll
                for (int bj = 0; bj < 2; ++bj) {
                    if constexpr (FIRST) { xo[m][bj][0] = *(const f32x4*)(x0 + off + bj * HALF); xo[m][bj][1] = *(const f32x4*)(x0 + off + bj * HALF + 4); }
                    else { const u32x4 w = *(const u32x4*)(xb + off + bj * HALF);
                        xo[m][bj][0] = (f32x4){__builtin_bit_cast(float, w.x << 16), __builtin_bit_cast(float, w.x & 0xffff0000u), __builtin_bit_cast(float, w.y << 16), __builtin_bit_cast(float, w.y & 0xffff0000u)};
                        xo[m][bj][1] = (f32x4){__builtin_bit_cast(float, w.z << 16), __builtin_bit_cast(float, w.z & 0xffff0000u), __builtin_bit_cast(float, w.w << 16), __builtin_bit_cast(float, w.w & 0xffff0000u)}; } } }
#pragma unroll
            for (int m = 0; m < 4; ++m) { const int r = ai * HALF + wr * 64 + m * 16 + fr; const size_t off = (size_t)(u.pm * BM + r) * DM_ + col0; float s = 0.f;
#pragma unroll
                for (int bj = 0; bj < 2; ++bj) { const f32x4 v0 = xo[m][bj][0] + acc[ai][bj][m][0] * ascale, v1 = xo[m][bj][1] + acc[ai][bj][m][1] * ascale;
                    st16_wt(xb + off + bj * HALF, pack8(v0, v1));
                    if constexpr (FIRST) { u32x2 w; w.x = pk4_fp8(v0[0] * F8_SX, v0[1] * F8_SX, v0[2] * F8_SX, v0[3] * F8_SX); w.y = pk4_fp8(v1[0] * F8_SX, v1[1] * F8_SX, v1[2] * F8_SX, v1[3] * F8_SX); st8_wt(x8 + off + bj * HALF, w.x, w.y); }
                    s += ((v0[0] * v0[0] + v0[1] * v0[1]) + (v0[2] * v0[2] + v0[3] * v0[3])) + ((v1[0] * v1[0] + v1[1] * v1[1]) + (v1[2] * v1[2] + v1[3] * v1[3])); }
                s += __shfl_xor(s, 16); s += __shfl_xor(s, 32);
                if (fq == 0) P[r * 4 + wc] = s; }
            asm volatile("" ::: "memory"); }
        asm volatile("s_waitcnt lgkmcnt(0)" ::: "memory"); __builtin_amdgcn_s_barrier(); asm volatile("" ::: "memory");
        const int t = wid * 64 + lane;
        if (t < 256) { const PG8_LAS f32x4* Pr = (const PG8_LAS f32x4*)lds; const f32x4 p = Pr[t]; ssq[(size_t)(u.pm * BM + t) * 4 + u.pn] = (p[0] + p[1]) + (p[2] + p[3]); }
        asm volatile("s_waitcnt lgkmcnt(0)" ::: "memory"); __builtin_amdgcn_s_barrier(); asm volatile("" ::: "memory");
    }
};

template <bool OUT8> struct EpiSwiGLU {
    static constexpr bool PERM = true, AFTER_DRAIN = false;
    void* H; int ldh; const float* ssq; const float* rstd; int ncol; float cs;
    __device__ __forceinline__ void operator()(const f32x4 (&acc)[2][2][4][2], const Unit& u, int wr, int wc, int fr, int fq) const {
        const int row0 = u.pm * BM + wr * 64 + fr, col0 = (u.pn % ncol) * 128 + wc * 32 + 8 * fq;
#pragma unroll
        for (int ai = 0; ai < 2; ++ai)
#pragma unroll
            for (int m = 0; m < 4; ++m) { const int row = row0 + ai * HALF + m * 16;
                float k; if (ssq) { const f32x4 p = *(const f32x4*)(ssq + (size_t)row * 4); k = ((p[0] + p[1]) + (p[2] + p[3])) * (1.0f / 1024.0f) + RMS_EPS; } else { const float r_ = rstd[row]; k = 1.0f / (r_ * r_); }
                const float c1 = -LOG2E * cs * __builtin_amdgcn_rsqf(k); k = k / (cs * cs);
                f32x4 h[2];
#pragma unroll
                for (int n = 0; n < 2; ++n) { const f32x4 a = acc[ai][0][m][n], b = acc[ai][1][m][n];
                    const f32x2 h0 = swiglu2((f32x2){a[0], a[1]}, (f32x2){b[0], b[1]}, c1, k), h1 = swiglu2((f32x2){a[2], a[3]}, (f32x2){b[2], b[3]}, c1, k);
                    h[n] = (f32x4){h0.x, h0.y, h1.x, h1.y}; }
                if constexpr (OUT8) { u32x2 w; w.x = pk4_fp8(h[0][0] * F8_SHD, h[0][1] * F8_SHD, h[0][2] * F8_SHD, h[0][3] * F8_SHD); w.y = pk4_fp8(h[1][0] * F8_SHD, h[1][1] * F8_SHD, h[1][2] * F8_SHD, h[1][3] * F8_SHD);
                    st8_wt((unsigned char*)H + (size_t)row * ldh + col0, w.x, w.y); }
                else st16_wt((bf16_t*)H + (size_t)row * ldh + col0, pack8(h[0], h[1])); }
    }
};

struct EpiQKV {
    static constexpr bool PERM = true, AFTER_DRAIN = false;
    bf16_t *Q, *K, *V; const float* ssq; const float* qg; const float* kg; float qscale;
    __device__ __forceinline__ void operator()(const f32x4 (&acc)[2][2][4][2], const Unit& u, int wr, int wc, int fr, int fq) const {
        const int row0 = u.pm * BM + wr * 64 + fr;
        if (u.pn < 8) {
            const bool isq = u.pn < 4; bf16_t* base = isq ? Q : K; const float* gn = isq ? qg : kg; const float sc = isq ? qscale : 1.0f;
            const int col0 = (4 * (u.pn & 3) + wc) * 64 + 8 * fq;
            f32x4 gv[2][2];
#pragma unroll
            for (int bj = 0; bj < 2; ++bj)
#pragma unroll
                for (int n = 0; n < 2; ++n) gv[bj][n] = *(const f32x4*)(gn + 32 * bj + 8 * fq + 4 * n);
#pragma unroll
            for (int ai = 0; ai < 2; ++ai)
#pragma unroll
                for (int m = 0; m < 4; ++m) { const int row = row0 + ai * HALF + m * 16; const float rs = rstd_of(ssq, row);
                    f32x4 v[2][2]; float ss = 0.f;
#pragma unroll
                    for (int bj = 0; bj < 2; ++bj)
#pragma unroll
                        for (int n = 0; n < 2; ++n) { v[bj][n] = acc[ai][bj][m][n] * rs; ss += (v[bj][n][0] * v[bj][n][0] + v[bj][n][1] * v[bj][n][1]) + (v[bj][n][2] * v[bj][n][2] + v[bj][n][3] * v[bj][n][3]); }
                    ss += __shfl_xor(ss, 16); ss += __shfl_xor(ss, 32);
                    const float r2 = __builtin_amdgcn_rsqf(ss * (1.0f / 64.0f) + RMS_EPS) * sc;
#pragma unroll
                    for (int bj = 0; bj < 2; ++bj) st16_wt(base + (size_t)row * DM_ + col0 + 32 * bj, pack8(v[bj][0] * r2 * gv[bj][0], v[bj][1] * r2 * gv[bj][1])); }
        } else {
            const int col0 = (u.pn - 8) * BM + wc * 32 + 8 * fq;
#pragma unroll
            for (int ai = 0; ai < 2; ++ai)
#pragma unroll
                for (int m = 0; m < 4; ++m) { const int row = row0 + ai * HALF + m * 16; const float rs = rstd_of(ssq, row);
#pragma unroll
                    for (int bj = 0; bj < 2; ++bj) st16_wt(V + (size_t)row * DM_ + col0 + bj * HALF, pack8(acc[ai][bj][m][0] * rs, acc[ai][bj][m][1] * rs)); }
        }
    }
};

struct EpiSwiGLU8 {
    static constexpr bool PERM = true, AFTER_DRAIN = false;
    unsigned char* H; int ldh; int ncol;
    __device__ __forceinline__ void operator()(const f32x4 (&acc)[2][2][4][2], const Unit& u, int wr, int wc, int fr, int fq) const {
        const int row0 = u.pm * BM + wr * 64 + fr, col0 = (u.pn % ncol) * 128 + wc * 32 + 8 * fq; constexpr float cs = 1.0f / (F8_SA * F8_SWG);
#pragma unroll
        for (int ai = 0; ai < 2; ++ai)
#pragma unroll
            for (int m = 0; m < 4; ++m) { const int row = row0 + ai * HALF + m * 16; f32x4 h[2];
#pragma unroll
                for (int n = 0; n < 2; ++n) { const f32x4 a = acc[ai][0][m][n], b = acc[ai][1][m][n];
                    const f32x2 h0 = swiglu2((f32x2){a[0], a[1]}, (f32x2){b[0], b[1]}, -cs * LOG2E, 1.0f / (cs * cs * F8_SH)), h1 = swiglu2((f32x2){a[2], a[3]}, (f32x2){b[2], b[3]}, -cs * LOG2E, 1.0f / (cs * cs * F8_SH));
                    h[n] = (f32x4){h0.x, h0.y, h1.x, h1.y}; }
                u32x2 w; w.x = pk4_fp8(h[0][0], h[0][1], h[0][2], h[0][3]); w.y = pk4_fp8(h[1][0], h[1][1], h[1][2], h[1][3]);
                st8_wt(H + (size_t)row * ldh + col0, w.x, w.y); }
    }
};

struct EpiMoeDown {
    static constexpr bool PERM = true, AFTER_DRAIN = false;
    bf16_t* Y; const float* gate; float scale; float* Pp;
    __device__ __forceinline__ void operator()(const f32x4 (&acc)[2][2][4][2], const Unit& u, int wr, int wc, int fr, int fq) const {
        const int col0 = (u.pn & 3) * BM + wc * 32 + 8 * fq;
        if (u.aux >= 0) {
            float* base = Pp + ((size_t)u.aux * BM + wr * 64 + fr) * DM_ + col0;
#pragma unroll
            for (int ai = 0; ai < 2; ++ai)
#pragma unroll
                for (int m = 0; m < 4; ++m)
#pragma unroll
                    for (int bj = 0; bj < 2; ++bj) { float* p = base + (size_t)(ai * HALF + m * 16) * DM_ + bj * HALF; st16_wt(p, __builtin_bit_cast(u32x4, acc[ai][bj][m][0])); st16_wt(p + 4, __builtin_bit_cast(u32x4, acc[ai][bj][m][1])); }
            return; }
        const int row0 = u.pm * BM + wr * 64 + fr;
#pragma unroll
        for (int ai = 0; ai < 2; ++ai)
#pragma unroll
            for (int m = 0; m < 4; ++m) { const int row = row0 + ai * HALF + m * 16; const float gt = gate[row] * scale;
#pragma unroll
                for (int bj = 0; bj < 2; ++bj) st16_wt(Y + (size_t)row * DM_ + col0 + bj * HALF, pack8(acc[ai][bj][m][0] * gt, acc[ai][bj][m][1] * gt)); }
    }
};

struct MoeOrder {
    int nM, nN, nwg, G, c, T, P0, npieces; int t1, t2, t3, t4, t5, t6, t7;
    static constexpr int SPL = 7, PKT = 4;
    __device__ __forceinline__ void init(const int* meta, int nN_, int G_, int c_, bool split) {
        T = meta[8]; nM = split ? meta[9] : T; nN = nN_; nwg = nM * nN; G = G_; c = c_; t1 = meta[1]; t2 = meta[2]; t3 = meta[3]; t4 = meta[4]; t5 = meta[5]; t6 = meta[6]; t7 = meta[7];
        P0 = ((nwg + G - 1) / G) * G; npieces = (T - nM) * nN * SPL; }
    __device__ __forceinline__ int expert_of(int pm) const { return (pm >= t1) + (pm >= t2) + (pm >= t3) + (pm >= t4) + (pm >= t5) + (pm >= t6) + (pm >= t7); }
    __device__ __forceinline__ bool next(int i, Unit& u) const {
        const long L = (long)i * G + c;
        if (L >= nwg) { const long q = L - P0; if (q < 0 || q >= npieces) return false;
            const int rt = (int)q / (nN * SPL), rem = (int)q % (nN * SPL), pnl = rem / SPL, kp = rem % SPL;
            u.pm = nM + rt; u.pn = expert_of(u.pm) * nN + pnl; u.kt0 = kp * PKT; u.nkt = PKT; u.aux = rt * SPL + kp; return true; }
        int wgid = (int)L; { const int q = nwg / NXCD, r = nwg % NXCD, xcd = wgid % NXCD, off = wgid / NXCD; wgid = (xcd < r ? xcd * (q + 1) : r * (q + 1) + (xcd - r) * q) + off; }
        const int nig = WGM * nN, gid = wgid / nig, fm = gid * WGM, gsz = (nM - fm) < WGM ? (nM - fm) : WGM;
        const int pm = fm + ((wgid % nig) % gsz), pnl = (wgid % nig) / gsz;
        u.pm = pm; u.pn = expert_of(pm) * nN + pnl; u.kt0 = 0; u.nkt = 0; u.aux = -1; return true;
    }
    __device__ __forceinline__ void a_ready(const Unit&) const {}
    __device__ __forceinline__ void done(const Unit&) const {}
};
template <class Epi, class Sched, bool ALIGN_EPI = false, bool SP2 = false, bool F8 = false>
__device__ __forceinline__ void gemm_phase(PG8_LAS unsigned char* lds, const Gemm g, const Sched& S, const Epi& E) {
    const int tid = threadIdx.x, wid = __builtin_amdgcn_readfirstlane(tid >> 6), lane = tid & 63, wr = wid >> 2, wc = wid & 3, fr = lane & 15, fq = lane >> 4;
    int K_ = g.K; asm volatile("" : "+s"(K_));
    const int K = K_, nt = K / BK;
    unsigned voffA[2], voffB[2];
#pragma unroll
    for (int i = 0; i < 2; ++i) { int R, C; stage_rc(tid * 16 + i * 8192, R, C); const int Rb = Epi::PERM ? ((R & ~31) + perm32(R & 31)) : R;
        voffA[i] = (unsigned)(R * K + C) * 2u; voffB[i] = (unsigned)(Rb * K + C) * 2u; }
    const size_t kstep = (size_t)(BK * 2);
    const size_t hstep = (size_t)HALF * K * 2;
    const size_t tstep = 2 * hstep;
    const unsigned ldsw = (unsigned)wid * 1024u;
    const int aoff = lds_byte(wr * 64 + fr, fq * 8), boff = lds_byte(wc * 32 + fr, fq * 8);
    constexpr int KSTEP = 1024;
#define PG8_SA(b, h) (((b) * 2 + (h)) * HTB)
#define PG8_SB(b, h) ((4 + (b) * 2 + (h)) * HTB)
#define PG8_STAGE(bufoff, gbase, voff) do { _Pragma("unroll") for (int _i = 0; _i < 2; ++_i) \
        __builtin_amdgcn_global_load_lds((const unsigned*)((const char*)(gbase) + (voff)[_i]), (PG8_LAS unsigned*)(lds + (bufoff) + ldsw + _i * 8192), 16, 0, 0); } while (0)
#define PG8_LDA(dst, b, h) do { _Pragma("unroll") for (int m = 0; m < 4; ++m) _Pragma("unroll") for (int k = 0; k < 2; ++k) dst[m][k] = *(const PG8_LAS bf16x8*)(lds + PG8_SA(b, h) + aoff + m * 2048 + k * KSTEP); } while (0)
#define PG8_LDB(dst, b, h) do { _Pragma("unroll") for (int n = 0; n < 2; ++n) _Pragma("unroll") for (int k = 0; k < 2; ++k) dst[n][k] = *(const PG8_LAS bf16x8*)(lds + PG8_SB(b, h) + boff + n * 2048 + k * KSTEP); } while (0)
#define PG8_CAT8(x) __builtin_shufflevector(__builtin_bit_cast(i32x4, (x)[0]), __builtin_bit_cast(i32x4, (x)[1]), 0, 1, 2, 3, 4, 5, 6, 7)
#define PG8_MMA(ai, bj, At, Bt) do { __builtin_amdgcn_s_setprio(1); _Pragma("unroll") for (int m = 0; m < 4; ++m) _Pragma("unroll") for (int n = 0; n < 2; ++n) { \
        if constexpr (F8) asm volatile("s_nop 1\n\tv_mfma_f32_16x16x128_f8f6f4 %0, %1, %2, %0" : "+v"(acc[ai][bj][m][n]) : "v"(PG8_CAT8(Bt[n])), "v"(PG8_CAT8(At[m]))); \
        else { _Pragma("unroll") for (int k = 0; k < 2; ++k) acc[ai][bj][m][n] = __builtin_amdgcn_mfma_f32_16x16x32_bf16(Bt[n][k], At[m][k], acc[ai][bj][m][n], 0, 0, 0); } } \
        __builtin_amdgcn_s_setprio(0); } while (0)
#define PG8_MMA0(ai, bj, At, Bt) do { __builtin_amdgcn_s_setprio(1); _Pragma("unroll") for (int m = 0; m < 4; ++m) _Pragma("unroll") for (int n = 0; n < 2; ++n) \
        asm volatile("s_nop 1\n\tv_mfma_f32_16x16x128_f8f6f4 %0, %1, %2, 0" : "=&v"(acc[ai][bj][m][n]) : "v"(PG8_CAT8(Bt[n])), "v"(PG8_CAT8(At[m]))); \
        __builtin_amdgcn_s_setprio(0); } while (0)
#define PG8_MMAF(ai, bj, At, Bt) do { if constexpr (F8) { if (t == 0) PG8_MMA0(ai, bj, At, Bt); else PG8_MMA(ai, bj, At, Bt); } else PG8_MMA(ai, bj, At, Bt); } while (0)
#define PG8_WAIT_V(n) asm volatile("s_waitcnt vmcnt(" #n ")" ::: "memory")
#define PG8_WAIT_L(n) asm volatile("s_waitcnt lgkmcnt(" #n ")" ::: "memory")
#define PG8_BAR __builtin_amdgcn_s_barrier()
#define PG8_SCHED __builtin_amdgcn_sched_barrier(0)
    Unit cur, nxt; int ui = 0;
    if (!S.next(0, cur)) return;
    f32x4 acc[2][2][4][2];
    if constexpr (!F8) {
#pragma unroll
    for (int a = 0; a < 2; ++a)
#pragma unroll
        for (int b = 0; b < 2; ++b)
#pragma unroll
            for (int m = 0; m < 4; ++m)
#pragma unroll
                for (int n = 0; n < 2; ++n) acc[a][b][m][n] = (f32x4){0.f, 0.f, 0.f, 0.f};
    }
    bf16x8 At[4][2], B0[2][2], B1[2][2];
    const char* cA = (const char*)g.A + (size_t)cur.pm * tstep + (size_t)cur.kt0 * kstep; const char* cB = (const char*)g.Bt + (size_t)cur.pn * tstep + (size_t)cur.kt0 * kstep;
    S.a_ready(cur);
    if constexpr (SP2) {
        PG8_STAGE(PG8_SB(0, 0), cB, voffB); PG8_STAGE(PG8_SB(0, 1), cB + hstep, voffB); PG8_STAGE(PG8_SA(0, 0), cA, voffA); PG8_STAGE(PG8_SA(0, 1), cA + hstep, voffA);
        if (wr == 1) PG8_BAR;
        PG8_WAIT_V(2); PG8_BAR;
        PG8_STAGE(PG8_SB(1, 0), cB + kstep, voffB); PG8_STAGE(PG8_SA(1, 0), cA + kstep, voffA); PG8_STAGE(PG8_SB(1, 1), cB + hstep + kstep, voffB);
        PG8_WAIT_V(6); PG8_BAR;
    } else {
        PG8_STAGE(PG8_SB(0, 0), cB, voffB); PG8_STAGE(PG8_SA(0, 0), cA, voffA); PG8_STAGE(PG8_SB(0, 1), cB + hstep, voffB); PG8_STAGE(PG8_SA(0, 1), cA + hstep, voffA);
        if (wr == 1) PG8_BAR;
        PG8_WAIT_V(4); PG8_BAR;
        PG8_STAGE(PG8_SB(1, 0), cB + kstep, voffB); PG8_STAGE(PG8_SA(1, 0), cA + kstep, voffA); PG8_STAGE(PG8_SB(1, 1), cB + hstep + kstep, voffB);
        PG8_WAIT_V(6); PG8_BAR;
    }
    for (;;) {
        const bool has_next = S.next(ui + 1, nxt);
        const char* nA = has_next ? (const char*)g.A + (size_t)nxt.pm * tstep + (size_t)nxt.kt0 * kstep : cA; const char* nB = has_next ? (const char*)g.Bt + (size_t)nxt.pn * tstep + (size_t)nxt.kt0 * kstep : cB;
        const int ntu = cur.nkt ? cur.nkt : nt;
        for (int t = 0; t < ntu; t += 2) {
            const bool last = (t == ntu - 2);
            const char* a1 = cA + (size_t)(t + 1) * kstep;
            const char* a2 = last ? nA : cA + (size_t)(t + 2) * kstep; const char* b2 = last ? nB : cB + (size_t)(t + 2) * kstep;
            const char* a3 = a2 + kstep; const char* b3 = b2 + kstep;
            if (last && has_next) S.a_ready(nxt);
            if constexpr (SP2) {
            PG8_LDB(B0, 0, 0); PG8_LDB(B1, 0, 1); PG8_SCHED; PG8_LDA(At, 0, 0); PG8_STAGE(PG8_SA(1, 1), a1 + hstep, voffA);
            PG8_WAIT_V(8); PG8_WAIT_L(0); PG8_BAR; PG8_MMAF(0, 0, At, B0); PG8_MMAF(0, 1, At, B1); PG8_BAR; PG8_SCHED;
            PG8_LDA(At, 0, 1); PG8_STAGE(PG8_SB(0, 0), b2, voffB); PG8_STAGE(PG8_SB(0, 1), b2 + hstep, voffB); PG8_STAGE(PG8_SA(0, 0), a2, voffA);
            PG8_WAIT_V(8); PG8_WAIT_L(0); PG8_BAR; PG8_MMAF(1, 0, At, B0); PG8_MMAF(1, 1, At, B1); PG8_BAR; PG8_SCHED;
            PG8_LDB(B0, 1, 0); PG8_LDB(B1, 1, 1); PG8_SCHED; PG8_LDA(At, 1, 0); PG8_STAGE(PG8_SA(0, 1), a2 + hstep, voffA);
            PG8_WAIT_V(8); PG8_WAIT_L(0); PG8_BAR; PG8_MMA(0, 0, At, B0); PG8_MMA(0, 1, At, B1); PG8_BAR; PG8_SCHED;
            PG8_LDA(At, 1, 1); PG8_STAGE(PG8_SB(1, 0), b3, voffB); PG8_STAGE(PG8_SB(1, 1), b3 + hstep, voffB); PG8_STAGE(PG8_SA(1, 0), a3, voffA);
            PG8_WAIT_V(8); PG8_WAIT_L(0); PG8_BAR; PG8_MMA(1, 0, At, B0); PG8_MMA(1, 1, At, B1); PG8_BAR; PG8_SCHED;
            } else {
            PG8_LDB(B0, 0, 0); PG8_SCHED; PG8_LDA(At, 0, 0); PG8_STAGE(PG8_SA(1, 1), a1 + hstep, voffA);
            PG8_WAIT_L(8); PG8_BAR; PG8_WAIT_L(0); PG8_MMAF(0, 0, At, B0); PG8_BAR; PG8_SCHED;
            PG8_LDB(B1, 0, 1); PG8_STAGE(PG8_SB(0, 0), b2, voffB);
            PG8_BAR; PG8_WAIT_L(0); PG8_MMAF(0, 1, At, B1); PG8_BAR;
            PG8_LDA(At, 0, 1); PG8_STAGE(PG8_SA(0, 0), a2, voffA);
            PG8_BAR; PG8_WAIT_L(0); PG8_MMAF(1, 0, At, B0); PG8_BAR; PG8_SCHED;
            PG8_STAGE(PG8_SB(0, 1), b2 + hstep, voffB);
            PG8_WAIT_V(6); PG8_BAR; PG8_MMAF(1, 1, At, B1); PG8_BAR;
            PG8_LDB(B0, 1, 0); PG8_SCHED; PG8_LDA(At, 1, 0); PG8_STAGE(PG8_SA(0, 1), a2 + hstep, voffA);
            PG8_WAIT_L(8); PG8_BAR; PG8_WAIT_L(0); PG8_MMA(0, 0, At, B0); PG8_BAR; PG8_SCHED;
            PG8_LDB(B1, 1, 1); PG8_STAGE(PG8_SB(1, 0), b3, voffB);
            PG8_BAR; PG8_WAIT_L(0); PG8_MMA(0, 1, At, B1); PG8_BAR;
            PG8_LDA(At, 1, 1); PG8_STAGE(PG8_SA(1, 0), a3, voffA);
            PG8_BAR; PG8_WAIT_L(0); PG8_MMA(1, 0, At, B0); PG8_BAR; PG8_SCHED;
            PG8_STAGE(PG8_SB(1, 1), b3 + hstep, voffB);
            PG8_WAIT_V(6); PG8_BAR; PG8_MMA(1, 1, At, B1); PG8_BAR;
            }
        }
        if constexpr (F8) asm volatile("s_nop 15\n\ts_nop 15" ::: "memory");
        if constexpr (ALIGN_EPI) { if (wr == 0) PG8_BAR; }
        if constexpr (!Epi::AFTER_DRAIN) { E(acc, cur, wr, wc, fr, fq); S.done(cur); }
        if (!has_next) break;
        if constexpr (!F8) {
#pragma unroll
        for (int a = 0; a < 2; ++a)
#pragma unroll
            for (int b = 0; b < 2; ++b)
#pragma unroll
                for (int m = 0; m < 4; ++m)
#pragma unroll
                    for (int n = 0; n < 2; ++n) acc[a][b][m][n] = (f32x4){0.f, 0.f, 0.f, 0.f};
        }
        cur = nxt; cA = nA; cB = nB; ++ui;
        if constexpr (ALIGN_EPI) { if (wr == 1) PG8_BAR; }
    }
    PG8_WAIT_V(0);
    if constexpr (!ALIGN_EPI) { if (wr == 0) PG8_BAR; }
    PG8_BAR;
    if constexpr (Epi::AFTER_DRAIN) { E.fused(acc, cur, wr, wc, fr, fq, lds, wid, lane); S.done(cur); }
#undef PG8_SA
#undef PG8_SB
#undef PG8_STAGE
#undef PG8_LDA
#undef PG8_LDB
#undef PG8_MMA
#undef PG8_MMA0
#undef PG8_MMAF
#undef PG8_CAT8
#undef PG8_WAIT_V
#undef PG8_WAIT_L
#undef PG8_BAR
#undef PG8_SCHED
}
}
#include <hip/hip_bf16.h>
#include <cmath>
namespace attn_body {
using bf16=__hip_bfloat16;
using bf16x8=__attribute__((ext_vector_type(8)))short;
using s16x4=__attribute__((ext_vector_type(4)))short;
using f32x16=__attribute__((ext_vector_type(16)))float;
using u32x4=__attribute__((ext_vector_type(4)))unsigned;
constexpr int BATCH=8,NHEAD=16,SEQ=2048,D=64,DM=NHEAD*D;
constexpr int NW=8,QBLK=32,QB=QBLK*NW,KVBLK=64,NQB=SEQ/QB;
constexpr int ATTN_PITCH=DM, ATTN_UNIT_ROWS=QB;
__device__ __forceinline__ int crow(int r,int hi){return (r&3)+8*(r>>2)+4*hi;}
#define SBAR() __builtin_amdgcn_sched_barrier(0)
__device__ __forceinline__ void cmask(f32x16&p0,f32x16&p1,int jb,int qrel,int hi){
  const float NEG=-INFINITY; int kb=64*jb+4*hi;
  #pragma unroll
  for(int r=0;r<16;++r){int kv=kb+(r&3)+8*(r>>2); if(kv>qrel)p0[r]=NEG; if(kv+32>qrel)p1[r]=NEG;}
}

constexpr int NSLOT=3, SLOTB=8192;
constexpr int LDS_K=0, LDS_V=NSLOT*SLOTB, LDS_WS=3*NSLOT*SLOTB, LDS_QS=LDS_WS+NW*64*4, LDS_OST=LDS_QS+NW*4096, LDS_BYTES=LDS_OST+NW*4096;
constexpr float C2=0.125f*1.4426950408889634f;
__device__ __forceinline__ void glds16(const void*gsrc,unsigned lds_dst){unsigned keep;
  asm volatile("s_mov_b32 %0, m0\n\ts_mov_b32 m0, %2\n\ts_nop 0\n\tglobal_load_lds_dwordx4 %1, off\n\ts_mov_b32 m0, %0":"=&s"(keep):"v"(gsrc),"s"(lds_dst):"memory");}
__device__ __forceinline__ float max3f(float a,float b,float c){float r;asm("v_max3_f32 %0, %1, %2, %3":"=v"(r):"v"(a),"v"(b),"v"(c));return r;}
__device__ __forceinline__ float max2f(float a,float b){float r;asm("v_max_f32_e32 %0, %1, %2":"=v"(r):"v"(a),"v"(b));return r;}
__device__ __forceinline__ float fadd_s(float a,float b){float r;asm("v_add_f32_e32 %0, %1, %2":"=v"(r):"v"(a),"v"(b));return r;}
__device__ __forceinline__ float fsub_s(float a,float b){float r;asm("v_sub_f32_e32 %0, %1, %2":"=v"(r):"v"(a),"v"(b));return r;}
typedef float f32x2_t __attribute__((ext_vector_type(2))); typedef __bf16 bf16x2_t __attribute__((ext_vector_type(2)));
__device__ __forceinline__ unsigned cvtpk_s(float lo,float hi){f32x2_t v={lo,hi};bf16x2_t b=__builtin_convertvector(v,bf16x2_t);return __builtin_bit_cast(unsigned,b);}
#define WAIT_BAR(N) asm volatile("s_waitcnt vmcnt(" #N ") lgkmcnt(0)\n\ts_barrier":::"memory")

__device__ __forceinline__ void qkt(f32x16&p0,f32x16&p1,const char*Kslot,const bf16x8*qr,int r32,int hi){ const f32x16 negm=f32x16{};
  const char*kb=Kslot+hi*1024+r32*16;
  #pragma unroll
  for(int d0=0;d0<4;++d0){
    const bf16x8 b0=*reinterpret_cast<const bf16x8*>(kb+d0*2048);
    const bf16x8 b1=*reinterpret_cast<const bf16x8*>(kb+d0*2048+512);
    if(d0==0){p0=__builtin_amdgcn_mfma_f32_32x32x16_bf16(b0,qr[0],negm,0,0,0);p1=__builtin_amdgcn_mfma_f32_32x32x16_bf16(b1,qr[0],negm,0,0,0);}
    else{p0=__builtin_amdgcn_mfma_f32_32x32x16_bf16(b0,qr[d0],p0,0,0,0);p1=__builtin_amdgcn_mfma_f32_32x32x16_bf16(b1,qr[d0],p1,0,0,0);}}
}
typedef __attribute__((address_space(3))) const char* lds_cptr;
typedef short v4i16_t __attribute__((ext_vector_type(4)));
__device__ __forceinline__ void kload8(bf16x8*kf,lds_cptr kp){
  kf[0]=*(const __attribute__((address_space(3))) bf16x8*)(kp);      kf[1]=*(const __attribute__((address_space(3))) bf16x8*)(kp+512);
  kf[2]=*(const __attribute__((address_space(3))) bf16x8*)(kp+2048); kf[3]=*(const __attribute__((address_space(3))) bf16x8*)(kp+2560);
  kf[4]=*(const __attribute__((address_space(3))) bf16x8*)(kp+4096); kf[5]=*(const __attribute__((address_space(3))) bf16x8*)(kp+4608);
  kf[6]=*(const __attribute__((address_space(3))) bf16x8*)(kp+6144); kf[7]=*(const __attribute__((address_space(3))) bf16x8*)(kp+6656);
}
__device__ __forceinline__ void kload2(bf16x8*kf,lds_cptr kp,int j){ kf[2*j]=*(const __attribute__((address_space(3))) bf16x8*)(kp+j*2048); kf[2*j+1]=*(const __attribute__((address_space(3))) bf16x8*)(kp+j*2048+512); }
__device__ __forceinline__ s16x4 vtr(lds_cptr p){ return __builtin_bit_cast(s16x4,__builtin_amdgcn_ds_read_tr16_b64_v4i16((__attribute__((address_space(3))) v4i16_t*)p)); }
__device__ __forceinline__ float rowmax(const f32x16&p0,const f32x16&p1){
  float a=max3f(p0[0],p0[1],p1[0]),b=max3f(p0[2],p0[3],p1[1]);a=max3f(a,p1[2],p1[3]);
  #pragma unroll
  for(int r=4;r<16;r+=4){a=max3f(a,p0[r],p0[r+1]);b=max3f(b,p0[r+2],p0[r+3]);a=max3f(a,p1[r],p1[r+1]);b=max3f(b,p1[r+2],p1[r+3]);}
  const float m=max2f(a,b);
  auto rr=__builtin_amdgcn_permlane32_swap(__float_as_uint(m),__float_as_uint(m),false,false);
  return max2f(__uint_as_float(rr[0]),__uint_as_float(rr[1]));
}
__device__ __forceinline__ void pv(f32x16*o,int vb,bf16x8 pa0,bf16x8 pa1,bf16x8 pa2,bf16x8 pa3){
  #pragma unroll
  for(int d0=0;d0<4;++d0){s16x4 lo[4],hi[4];
    #pragma unroll
    for(int ks=0;ks<4;++ks){
      asm volatile("ds_read_b64_tr_b16 %0,%1 offset:%c2":"=&v"(lo[ks]):"v"(vb),"i"(d0*4096+ks*1024):"memory");
      asm volatile("ds_read_b64_tr_b16 %0,%1 offset:%c2":"=&v"(hi[ks]):"v"(vb),"i"(d0*4096+ks*1024+512):"memory");}
    asm volatile("s_waitcnt lgkmcnt(0)":::"memory");SBAR();
    #define PK(k) (bf16x8){lo[k][0],lo[k][1],lo[k][2],lo[k][3],hi[k][0],hi[k][1],hi[k][2],hi[k][3]}
    o[d0]=__builtin_amdgcn_mfma_f32_32x32x16_bf16(pa0,PK(0),o[d0],0,0,0);
    o[d0]=__builtin_amdgcn_mfma_f32_32x32x16_bf16(pa1,PK(1),o[d0],0,0,0);
    o[d0]=__builtin_amdgcn_mfma_f32_32x32x16_bf16(pa2,PK(2),o[d0],0,0,0);
    o[d0]=__builtin_amdgcn_mfma_f32_32x32x16_bf16(pa3,PK(3),o[d0],0,0,0);
    #undef PK
  }
}

#ifndef ATTN_STORE16
#define ATTN_STORE16(p,v) pg8::st16_wt((void*)(p),(v))
#endif
template<int THRL,int MODE> __device__ __forceinline__ void attn_unit(int b,int qcol,int vcol,int qb,const bf16*Q,const bf16*__restrict__ K,const bf16*__restrict__ V,bf16*O,char*shm,bf16*ON,float lam,const float*subn){
  int tid_=threadIdx.x; asm volatile("":"+v"(tid_));
  const int tid=tid_,lane=tid&63,r32=lane&31,hi=lane>>5; const int wid=__builtin_amdgcn_readfirstlane(tid>>6);
  const long rowbase=(long)b*SEQ; const int q0=qb*QB;
  const bf16*Qw=Q+(rowbase+q0+wid*QBLK)*DM+qcol;
  const bf16*Kh=K+rowbase*DM+qcol,*Vh=V+rowbase*DM+vcol;
  const unsigned lds0=(unsigned)(uintptr_t)shm;
  float*wsf=(float*)(shm+LDS_WS)+wid*64;
  const bf16*ksrc=Kh+(long)lane*DM+wid*8;
  const bf16*vsrc=Vh+(long)(16*(wid&3)+(lane>>2))*DM+(wid>>2)*32+(lane&3)*8;
  const unsigned kdst=lds0+LDS_K+wid*1024, vdst=lds0+LDS_V+wid*1024;
  #define DMA_K(t,slot) glds16(ksrc+(long)(t)*KVBLK*DM,(unsigned)__builtin_amdgcn_readfirstlane(kdst+(slot)))
  #define DMA_V(t,slot) do{ glds16(vsrc+(long)(t)*KVBLK*DM,(unsigned)__builtin_amdgcn_readfirstlane(vdst+2*(slot))); glds16(vsrc+(long)(t)*KVBLK*DM+64,(unsigned)__builtin_amdgcn_readfirstlane(vdst+2*(slot)+8192)); }while(0)
  const int vb0=(int)(lds0+LDS_V)+((lane>>4)&1)*32+(lane&3)*8+(4*hi+((lane&15)>>2))*64;
  const char*Kbase=shm+LDS_K; bf16x8 kf[8];
  const lds_cptr shm3=(lds_cptr)shm; const lds_cptr kp0=shm3+LDS_K+hi*1024+r32*16; const lds_cptr vp0=shm3+LDS_V+((lane>>4)&1)*32+(lane&3)*8+(4*hi+((lane&15)>>2))*64;
  const int NT=(q0+QB)/KVBLK;
  DMA_K(0,0);DMA_V(0,0);DMA_K(1,SLOTB);
  bf16x8 qr[4];
  #pragma unroll
  for(int d0=0;d0<4;++d0)qr[d0]=*reinterpret_cast<const bf16x8*>(&Qw[(long)r32*DM+d0*16+hi*8]);
  float mhat=0.f,l_reg=0.f;f32x16 o[4];o[0]=f32x16{};o[1]=f32x16{};o[2]=f32x16{};o[3]=f32x16{};
  typedef __attribute__((address_space(3))) bf16x8* lds_q8; const lds_cptr qp0=shm3+LDS_QS+wid*4096+lane*16;
  #define QF(j) (*(const __attribute__((address_space(3))) bf16x8*)(qp0+(j)*1024))
  const int qrel=wid*QBLK+r32;
  #define CMASK(P0,P1,t) do{int jb_=(t)-(NT-4); if(jb_>=0)cmask(P0,P1,jb_,qrel,hi);}while(0)
  bool resc=false;
  #define START(P0,P1) do{ const float rm=rowmax(P0,P1); resc=false; \
    { const float dl=rm; mhat=fadd_s(mhat,dl); \
      _Pragma("unroll") for(int r=0;r<16;++r){P0[r]=fsub_s(P0[r],dl);P1[r]=fsub_s(P1[r],dl);} } \
    _Pragma("unroll") for(int r=0;r<16;++r)P0[r]=__builtin_amdgcn_exp2f(P0[r]); }while(0)
  #define RESC() do{ if(resc){ asm volatile("s_waitcnt lgkmcnt(0)":::"memory"); \
      _Pragma("unroll") for(int d_=0;d_<4;++d_) _Pragma("unroll") for(int r=0;r<16;++r)o[d_][r]*=wsf[crow(r,hi)]; } }while(0)
  f32x16 pA0,pA1,pB0,pB1;
  int sl_prev=0,sl_cur=0,sl_next=SLOTB;
  #define ROT() do{sl_prev=sl_cur;sl_cur=sl_next;sl_next=(sl_next==(NSLOT-1)*SLOTB)?0:sl_next+SLOTB;}while(0)
  DMA_K(2,2*SLOTB);
  _Pragma("unroll") for(int d0=0;d0<4;++d0)*(__attribute__((address_space(3))) bf16x8*)(__attribute__((address_space(3))) char*)(qp0+d0*1024)=qr[d0];
  WAIT_BAR(4);
  qkt(pA0,pA1,Kbase,qr,r32,hi);asm volatile("s_nop 15\n\ts_nop 7":"+v"(pA0),"+v"(pA1));CMASK(pA0,pA1,0);
  START(pA0,pA1);
  _Pragma("unroll") for(int r=0;r<16;++r)pA1[r]=__builtin_amdgcn_exp2f(pA1[r]);
  WAIT_BAR(0);
  DMA_K(3,0);DMA_V(1,SLOTB);
  ROT();
  kload8(kf,kp0+sl_cur);
  bf16x8 qa=QF(0),qb_=QF(1);
  WAIT_BAR(3);
  s16x4 vlo[8],vhi[8]; u32x4 pw0,pw1,pw2,pw3;
  #define PKW(P,B) cvtpk_s(P[B],P[B+1])
  #define PAF(k) __builtin_bit_cast(bf16x8,pw##k)
  #define VFR(i) (bf16x8){vlo[i][0],vlo[i][1],vlo[i][2],vlo[i][3],vhi[i][0],vhi[i][1],vhi[i][2],vhi[i][3]}
  #define PIN(x) asm volatile("":"+v"(x))
  #define MX3(a,b,c) __builtin_fmaxf(__builtin_fmaxf((a),(b)),(c))
  #define GAPA(MF,A0,A1,A2,A3,W0,W1,PW) do{ MF; sacc+=A0; sacc+=A1; sacc+=A2; sacc+=A3; PIN(sacc); W0; W1; PIN(PW); SBAR(); }while(0)
  #define EX(v) __builtin_amdgcn_exp2f(v)
  #define GAPB(MF,X,B) do{ MF; X[B]=EX(X[B]); X[B+1]=EX(X[B+1]); PIN(X); SBAR(); }while(0)
  #define VRD(i) do{ vlo[i]=vtr(vp_+(((i)>>2)*4096+((i)&3)*1024)); vhi[i]=vtr(vp_+(((i)>>2)*4096+((i)&3)*1024+512)); }while(0)
  #define VRDX(reg,fr) do{ vlo[reg]=vtr(vp_+(((fr)>>2)*4096+((fr)&3)*1024)); vhi[reg]=vtr(vp_+(((fr)>>2)*4096+((fr)&3)*1024+512)); SBAR(); }while(0)
  #define KRD(G,j) do{ if(G){ kload2(kf,kp0+sl_next,j); SBAR(); } }while(0)
  #define ZC f32x16{}
  #define STEP(C0,C1,P0,P1,t,GK,GV,GL) do{ SBAR(); \
    const lds_cptr vp_=vp0+2*sl_prev; \
    VRD(0); SBAR(); float sacc=(P0[0]+P0[1]); \
    GAPA(C0=__builtin_amdgcn_mfma_f32_32x32x16_bf16(kf[0],qa,ZC,0,0,0), P0[2],P0[3],P0[4],P0[5],     pw0[0]=PKW(P0,0), pw0[1]=PKW(P0,2), pw0); \
    VRD(4); SBAR(); GAPA(C1=__builtin_amdgcn_mfma_f32_32x32x16_bf16(kf[1],qa,ZC,0,0,0), P0[6],P0[7],P0[8],P0[9],     pw0[2]=PKW(P0,4), pw0[3]=PKW(P0,6), pw0); \
    qa=QF(2); SBAR(); \
    VRD(1); SBAR(); GAPA(C0=__builtin_amdgcn_mfma_f32_32x32x16_bf16(kf[2],qb_,C0,0,0,0),   P0[10],P0[11],P0[12],P0[13], pw1[0]=PKW(P0,8), pw1[1]=PKW(P0,10), pw1); \
    VRD(5); SBAR(); GAPA(C1=__builtin_amdgcn_mfma_f32_32x32x16_bf16(kf[3],qb_,C1,0,0,0),   P0[14],P0[15],P1[0],P1[1],   pw1[2]=PKW(P0,12),pw1[3]=PKW(P0,14), pw1); \
    qb_=QF(3); SBAR(); \
    VRD(2); SBAR(); GAPA(C0=__builtin_amdgcn_mfma_f32_32x32x16_bf16(kf[4],qa,C0,0,0,0),   P1[2],P1[3],P1[4],P1[5],     pw2[0]=PKW(P1,0), pw2[1]=PKW(P1,2), pw2); \
    VRD(6); SBAR(); GAPA(C1=__builtin_amdgcn_mfma_f32_32x32x16_bf16(kf[5],qa,C1,0,0,0),   P1[6],P1[7],P1[8],P1[9],     pw2[2]=PKW(P1,4), pw2[3]=PKW(P1,6), pw2); \
    VRD(3); SBAR(); GAPA(C0=__builtin_amdgcn_mfma_f32_32x32x16_bf16(kf[6],qb_,C0,0,0,0),   P1[10],P1[11],P1[12],P1[13], pw3[0]=PKW(P1,8), pw3[1]=PKW(P1,10), pw3); \
    VRD(7); SBAR(); GAPA(C1=__builtin_amdgcn_mfma_f32_32x32x16_bf16(kf[7],qb_,C1,0,0,0),   P1[14],P1[15],0.f,0.f,       pw3[2]=PKW(P1,12),pw3[3]=PKW(P1,14), pw3); \
    l_reg+=sacc; \
    if(GK){DMA_K((t)+3,sl_cur);} if(GV){DMA_V((t)+1,sl_next);} \
    CMASK(C0,C1,t); \
    { float a=MX3(C0[0],C0[1],C1[0]),b=MX3(C0[2],C0[3],C1[1]); a=MX3(a,C1[2],C1[3]); \
      _Pragma("unroll") for(int r=4;r<16;r+=4){a=MX3(a,C0[r],C0[r+1]);b=MX3(b,C0[r+2],C0[r+3]);a=MX3(a,C1[r],C1[r+1]);b=MX3(b,C1[r+2],C1[r+3]);} \
      float rm=__builtin_fmaxf(a,b); { auto rr=__builtin_amdgcn_permlane32_swap(__float_as_uint(rm),__float_as_uint(rm),false,false); rm=__builtin_fmaxf(__uint_as_float(rr[0]),__uint_as_float(rr[1])); } \
      rm-=mhat; resc=false;                                      \
      if(__builtin_expect(__any(rm>(float)THRL),0)){ const float dl=__builtin_fmaxf(rm,0.f); mhat+=dl; \
        const float f=__builtin_amdgcn_exp2f(-dl); l_reg*=f; if(hi==0)wsf[r32]=f; resc=true; } \
      _Pragma("unroll") for(int r=0;r<16;++r){C0[r]-=mhat;C1[r]-=mhat;} } \
    SBAR(); \
    GAPB(o[0]=__builtin_amdgcn_mfma_f32_32x32x16_bf16(PAF(0),VFR(0),o[0],0,0,0), C0,0);  VRDX(0,8); \
    GAPB(o[1]=__builtin_amdgcn_mfma_f32_32x32x16_bf16(PAF(0),VFR(4),o[1],0,0,0), C0,2);  VRDX(4,12); \
    GAPB(o[0]=__builtin_amdgcn_mfma_f32_32x32x16_bf16(PAF(1),VFR(1),o[0],0,0,0), C0,4);  VRDX(1,9); \
    GAPB(o[1]=__builtin_amdgcn_mfma_f32_32x32x16_bf16(PAF(1),VFR(5),o[1],0,0,0), C0,6);  VRDX(5,13); \
    GAPB(o[0]=__builtin_amdgcn_mfma_f32_32x32x16_bf16(PAF(2),VFR(2),o[0],0,0,0), C0,8);  VRDX(2,10); \
    GAPB(o[1]=__builtin_amdgcn_mfma_f32_32x32x16_bf16(PAF(2),VFR(6),o[1],0,0,0), C0,10); VRDX(6,14); \
    GAPB(o[0]=__builtin_amdgcn_mfma_f32_32x32x16_bf16(PAF(3),VFR(3),o[0],0,0,0), C0,12); VRDX(3,11); \
    GAPB(o[1]=__builtin_amdgcn_mfma_f32_32x32x16_bf16(PAF(3),VFR(7),o[1],0,0,0), C0,14); VRDX(7,15); \
    KRD(GL,0); GAPB(o[2]=__builtin_amdgcn_mfma_f32_32x32x16_bf16(PAF(0),VFR(0),o[2],0,0,0), C1,0); \
    KRD(GL,1); GAPB(o[3]=__builtin_amdgcn_mfma_f32_32x32x16_bf16(PAF(0),VFR(4),o[3],0,0,0), C1,2); \
    KRD(GL,2); GAPB(o[2]=__builtin_amdgcn_mfma_f32_32x32x16_bf16(PAF(1),VFR(1),o[2],0,0,0), C1,4); \
    KRD(GL,3); GAPB(o[3]=__builtin_amdgcn_mfma_f32_32x32x16_bf16(PAF(1),VFR(5),o[3],0,0,0), C1,6); \
    GAPB(o[2]=__builtin_amdgcn_mfma_f32_32x32x16_bf16(PAF(2),VFR(2),o[2],0,0,0), C1,8); \
    GAPB(o[3]=__builtin_amdgcn_mfma_f32_32x32x16_bf16(PAF(2),VFR(6),o[3],0,0,0), C1,10); \
    qa=QF(0); SBAR(); \
    GAPB(o[2]=__builtin_amdgcn_mfma_f32_32x32x16_bf16(PAF(3),VFR(3),o[2],0,0,0), C1,12); \
    qb_=QF(1); SBAR(); \
    GAPB(o[3]=__builtin_amdgcn_mfma_f32_32x32x16_bf16(PAF(3),VFR(7),o[3],0,0,0), C1,14); \
    }while(0)
  int t=1;
  #undef CMASK
  #define CMASK(P0,P1,t) do{}while(0)
  for(;t+5<NT;t+=2){
    STEP(pB0,pB1,pA0,pA1,t,true,true,true);     WAIT_BAR(3); RESC(); ROT();
    STEP(pA0,pA1,pB0,pB1,t+1,true,true,true);   WAIT_BAR(3); RESC(); ROT();
  }
  #undef CMASK
  #define CMASK(P0,P1,t) do{int jb_=(t)-(NT-4); if(jb_>=0)cmask(P0,P1,jb_,qrel,hi);}while(0)
  #define ENDW(tt) do{ if((tt)+3<NT){WAIT_BAR(3);} else if((tt)+2<NT){WAIT_BAR(2);} else {WAIT_BAR(0);} }while(0)
  for(;t+1<NT;t+=2){
    STEP(pB0,pB1,pA0,pA1,t,(t+3<NT),(t+1<NT),(t+1<NT));       ENDW(t);   RESC(); ROT();
    STEP(pA0,pA1,pB0,pB1,t+1,(t+4<NT),(t+2<NT),(t+2<NT));     ENDW(t+1); RESC(); ROT();
  }
  STEP(pB0,pB1,pA0,pA1,NT-1,false,false,false); RESC();
  { float sacc=pB0[0]+pB0[1]; _Pragma("unroll") for(int r=2;r<16;++r)sacc+=pB0[r]; _Pragma("unroll") for(int r=0;r<16;++r)sacc+=pB1[r]; l_reg+=sacc;
    pw0=(u32x4){PKW(pB0,0),PKW(pB0,2),PKW(pB0,4),PKW(pB0,6)};pw1=(u32x4){PKW(pB0,8),PKW(pB0,10),PKW(pB0,12),PKW(pB0,14)};pw2=(u32x4){PKW(pB1,0),PKW(pB1,2),PKW(pB1,4),PKW(pB1,6)};pw3=(u32x4){PKW(pB1,8),PKW(pB1,10),PKW(pB1,12),PKW(pB1,14)};
    SBAR(); pv(o,vb0+2*sl_cur,PAF(0),PAF(1),PAF(2),PAF(3)); }
  #undef PKW
  #undef PAF
  #undef VFR
  #undef PIN
  #undef MX3
  #undef GAPA
  #undef GAPB
  #undef EX
  #undef VRD
  #undef VRDX
  #undef ZC
  #undef QF
  #undef KRD
  #undef STEP
  #undef ENDW
  {auto rr=__builtin_amdgcn_permlane32_swap(__float_as_uint(l_reg),__float_as_uint(l_reg),false,false);l_reg=__uint_as_float(rr[0])+__uint_as_float(rr[1]);}
  if(hi==0)wsf[32+r32]=l_reg;asm volatile("s_waitcnt lgkmcnt(0)":::"memory");
  float rli[16];
  #pragma unroll
  for(int r=0;r<16;++r)rli[r]=__builtin_amdgcn_rcpf(wsf[32+crow(r,hi)]);
  bf16*Ow=O+(rowbase+q0+wid*QBLK)*DM+vcol;
  if constexpr(MODE==0){ bf16*stg=(bf16*)(shm+LDS_OST)+wid*2048;
    #pragma unroll
    for(int hf=0;hf<2;++hf){
      #pragma unroll
      for(int r=0;r<16;++r){const int orow=crow(r,hi);
        #pragma unroll
        for(int d0=0;d0<2;++d0)stg[orow*64+d0*32+r32]=__float2bfloat16(o[2*hf+d0][r]*rli[r]);}
      asm volatile("s_waitcnt lgkmcnt(0)":::"memory");
      #pragma unroll
      for(int i=0;i<4;++i){const int row=i*8+(lane>>3),ch=lane&7; const u32x4 v=*(const u32x4*)(stg+row*64+ch*8); ATTN_STORE16(Ow+(long)row*DM+hf*64+ch*8,v);}
      asm volatile("s_waitcnt lgkmcnt(0)":::"memory"); } }
  else { bf16*stg0=(bf16*)(shm+LDS_OST)+wid*2048,*stg1=(bf16*)(shm+LDS_QS)+wid*2048;
    #pragma unroll
    for(int r=0;r<16;++r){const int orow=crow(r,hi);
      #pragma unroll
      for(int d0=0;d0<2;++d0){stg0[orow*64+d0*32+r32]=__float2bfloat16(o[d0][r]*rli[r]);stg1[orow*64+d0*32+r32]=__float2bfloat16(o[2+d0][r]*rli[r]);}}
    asm volatile("s_waitcnt vmcnt(0) lgkmcnt(0)":::"memory");
    const int ch=lane&7; float g0[8],g1[8];
    #pragma unroll
    for(int j=0;j<8;++j){g0[j]=subn[ch*8+j];g1[j]=subn[64+ch*8+j];}
    bf16*ONw=ON+(rowbase+q0+wid*QBLK)*DM+vcol;
    #pragma unroll
    for(int i=0;i<4;++i){const int row=i*8+(lane>>3);
      const u32x4 a0=*(const u32x4*)(stg0+row*64+ch*8),a1=*(const u32x4*)(stg1+row*64+ch*8);
      const u32x4 b0=*(const u32x4*)(Ow+(long)row*DM+ch*8),b1=*(const u32x4*)(Ow+(long)row*DM+64+ch*8);
      float d[16];
      #pragma unroll
      for(int j=0;j<4;++j){
        d[2*j]  =__uint_as_float(b0[j]<<16)        -lam*__uint_as_float(a0[j]<<16);
        d[2*j+1]=__uint_as_float(b0[j]&0xffff0000u)-lam*__uint_as_float(a0[j]&0xffff0000u);
        d[8+2*j]  =__uint_as_float(b1[j]<<16)        -lam*__uint_as_float(a1[j]<<16);
        d[8+2*j+1]=__uint_as_float(b1[j]&0xffff0000u)-lam*__uint_as_float(a1[j]&0xffff0000u);}
      float ss=0.f;
      #pragma unroll
      for(int j=0;j<16;++j)ss+=d[j]*d[j];
      ss+=__shfl_xor(ss,1);ss+=__shfl_xor(ss,2);ss+=__shfl_xor(ss,4);
      const float rs=__builtin_amdgcn_rsqf(ss*(1.0f/128.0f)+1e-6f);
      u32x4 w0,w1;
      #pragma unroll
      for(int j=0;j<4;++j){w0[j]=cvtpk_s(d[2*j]*rs*g0[2*j],d[2*j+1]*rs*g0[2*j+1]);w1[j]=cvtpk_s(d[8+2*j]*rs*g1[2*j],d[8+2*j+1]*rs*g1[2*j+1]);}
      ATTN_STORE16(ONw+(long)row*DM+ch*8,w0);ATTN_STORE16(ONw+(long)row*DM+64+ch*8,w1);}
    asm volatile("s_waitcnt lgkmcnt(0)":::"memory"); }
  asm volatile("s_waitcnt lgkmcnt(0)\n\ts_barrier":::"memory");
  #undef DMA_K
  #undef DMA_V
  #undef CMASK
  #undef START
  #undef RESC
  #undef ROT
}
constexpr int ATTN_LDS_BYTES=LDS_BYTES;
#undef SBAR
#undef WAIT_BAR
}
constexpr int NWAVES = 8;
constexpr int NPH = 15;
constexpr size_t MiB = 1u << 20;
constexpr size_t WS_CTL = 0, CTL_ZERO_BYTES = 1 * MiB;
constexpr size_t WS_W_IN = 1 * MiB;
constexpr size_t WS_W_OUT = WS_W_IN + (size_t)3072 * 1024 * 2;
constexpr size_t WS_W_GU = WS_W_OUT + (size_t)1024 * 1024 * 2;
constexpr size_t WS_W_DN = WS_W_GU + (size_t)5632 * 1024 * 2;
constexpr size_t WS_W_QKV = WS_W_DN + (size_t)1024 * 2816 * 2;
constexpr size_t WS_W_O = WS_W_QKV + (size_t)3072 * 1024 * 2;
constexpr size_t WS_W_MGU = WS_W_O + (size_t)1024 * 1024 * 2;
constexpr size_t WS_W_MDN = WS_W_MGU + (size_t)8 * 7168 * 1024 * 2;
constexpr size_t WS_W_END = WS_W_MDN + (size_t)8 * 1024 * 3584 * 2;
constexpr size_t WS_R = 202 * MiB;
constexpr size_t ACT = (size_t)M * D * 2;
constexpr size_t WS_XN0 = WS_R, WS_BB = WS_R + ACT, WS_UB = WS_R + 2 * ACT, WS_G = WS_R + 3 * ACT;
constexpr size_t WS_HACT = WS_R;
constexpr size_t WS_Q = WS_R + 4 * ACT, WS_K = WS_R + 5 * ACT, WS_V = WS_R + 6 * ACT;
constexpr size_t WS_X8 = WS_R + 5 * ACT;
constexpr size_t WS_O0 = WS_R, WS_O1 = WS_R + ACT, WS_ON = WS_R + 2 * ACT;
constexpr size_t WS_HM = WS_R;
constexpr size_t WS_PP = WS_R + 128 * MiB;
constexpr size_t WS_S = 440 * MiB;
constexpr size_t WS_XG = WS_S, WS_Y = WS_S + 68 * MiB;
constexpr size_t WS_XB = 632 * MiB;
constexpr size_t WS_HB = 664 * MiB, WS_HB2 = 696 * MiB, WS_YF = 728 * MiB;
constexpr size_t WS_SMALL = 792 * MiB;
constexpr size_t WS_SSQ = WS_SMALL;
constexpr size_t WS_SEL = WS_SMALL + 256 * 1024, WS_GATE = WS_SEL + 128 * 1024, WS_TOKSLOT = WS_GATE + 128 * 1024;
constexpr size_t WS_RSTDS = WS_TOKSLOT + 128 * 1024, WS_GATES = WS_RSTDS + 256 * 1024;
constexpr size_t WS_HIST = WS_GATES + 256 * 1024, WS_META = WS_HIST + 16 * 1024;
constexpr size_t WS_NAIVE_SMALL = WS_SMALL + 2 * MiB;
constexpr size_t WS_END = 796 * MiB;
static_assert(WS_W_END <= WS_R && WS_R + (size_t)SLOTS * DFE * 2 <= WS_S && WS_Y + (size_t)SLOTS * D * 2 <= WS_XB && WS_V + ACT <= WS_S, "d_ws map");
constexpr int CW_TMO = 0, CW_CODE = 1, CW_BAR = 4096;
constexpr int MISC_OFF = 0, RING_OFF = 1024, RING_BYTES = 131072, LDS_BYTES = 147456;
constexpr int P0_SCR = 16640;

#define GAS __attribute__((address_space(1)))
#define LAS __attribute__((address_space(3)))
typedef unsigned v4u __attribute__((ext_vector_type(4)));
typedef unsigned v2u __attribute__((ext_vector_type(2)));
typedef GAS unsigned gu32;
#define RLX_AGENT __ATOMIC_RELAXED, __HIP_MEMORY_SCOPE_AGENT
#define LDS_WAIT() asm volatile("s_waitcnt lgkmcnt(0)" ::: "memory")
#define VM_WAIT() asm volatile("s_waitcnt vmcnt(0)" ::: "memory")
__device__ __forceinline__ unsigned pk2(float lo, float hi) { return f2bf(lo) | (f2bf(hi) << 16); }
__device__ __forceinline__ float bflo(unsigned w) { return __builtin_bit_cast(float, w << 16); }
__device__ __forceinline__ float bfhi(unsigned w) { return __builtin_bit_cast(float, w & 0xffff0000u); }

#define XB_TMO      128
#define XB_XCNT(j)  (256  + 64 * (j))
#define XB_XSUB(j)  (1280 + 64 * (j))
#define XB_XGEN(j)  (2304 + 64 * (j))
#define XB_TOP      3328
#define XB_TOPGEN   3392
#define XCD_BAR_WORDS 3456
#define XB_SPIN_CAP (1u << 18)

__device__ __forceinline__ unsigned xb_ld(unsigned* p)              { return __hip_atomic_load(p, __ATOMIC_RELAXED, __HIP_MEMORY_SCOPE_AGENT); }
__device__ __forceinline__ unsigned xb_add(unsigned* p, unsigned v) { return __hip_atomic_fetch_add(p, v, __ATOMIC_RELAXED, __HIP_MEMORY_SCOPE_AGENT); }
__device__ __forceinline__ unsigned xb_xcc_id() { return (unsigned)__builtin_amdgcn_s_getreg((3 << 11) | 20) & 0xFu; }
#define XB_SPIN(cond, bar) do { unsigned _sp = 0; while (cond) { __builtin_amdgcn_s_sleep(1); \
    if ((++_sp & 255u) == 0u) { if (xb_ld(&(bar)[XB_TMO])) break; if (_sp > XB_SPIN_CAP) { atomicAdd(&(bar)[XB_TMO], 1u); break; } } } } while (0)

struct XcdBarrier {
    unsigned* bar; unsigned x;
    volatile LAS unsigned* st;
};

__device__ __forceinline__ XcdBarrier xcd_barrier_post(unsigned* bar, volatile LAS unsigned* st) {
    XcdBarrier b; b.bar = bar; b.x = xb_xcc_id(); b.st = st;
    if (threadIdx.x == 0) (void)xb_add(&bar[XB_XCNT(b.x)], 1u);
    return b;
}
__device__ __forceinline__ void xcd_barrier_complete(unsigned* bar, unsigned x, unsigned& nloc, unsigned& nx) {
    const unsigned G = gridDim.x * gridDim.y * gridDim.z;
    unsigned sum, cnt, mine, sp = 0u;
    for (;;) {
        sum = 0u; cnt = 0u; mine = 0u;
#pragma unroll
        for (unsigned j = 0; j < 16; ++j) { const unsigned c = xb_ld(&bar[XB_XCNT(j)]); sum += c; cnt += (c > 0u) ? 1u : 0u; mine = (j == x) ? c : mine; }
        if (sum == G) break;
        __builtin_amdgcn_s_sleep(1);
        if ((++sp & 255u) == 0u) { if (xb_ld(&bar[XB_TMO])) break; if (sp > XB_SPIN_CAP) { atomicAdd(&bar[XB_TMO], 1u); break; } }
    }
    nloc = mine > 0u ? mine : 1u; nx = cnt > 0u ? cnt : 1u;
}

__device__ __forceinline__ void xcd_barrier(const XcdBarrier& b) {
    asm volatile("s_waitcnt vmcnt(0)" ::: "memory");
    __syncthreads();
    if (threadIdx.x == 0) {
        unsigned* bar = b.bar;
        __builtin_amdgcn_s_waitcnt(0);
        unsigned nloc = b.st[0], nx = b.st[1];
        if (nloc == 0u) { xcd_barrier_complete(bar, b.x, nloc, nx); b.st[0] = nloc; b.st[1] = nx; }
        const unsigned old = xb_add(&bar[XB_XSUB(b.x)], 1u);
        const unsigned gen = old / nloc;
        if (old + 1u == (gen + 1u) * nloc) {
            __builtin_amdgcn_fence(__ATOMIC_RELEASE, "agent");
            asm volatile("s_waitcnt vmcnt(0)" ::: "memory");
            const unsigned og = xb_add(&bar[XB_TOP], 1u);
            const unsigned tg = og / nx;
            if (og + 1u == (tg + 1u) * nx) xb_add(&bar[XB_TOPGEN], 1u);
            else XB_SPIN(xb_ld(&bar[XB_TOPGEN]) == tg, bar);
            __builtin_amdgcn_fence(__ATOMIC_ACQUIRE, "agent");
            xb_add(&bar[XB_XGEN(b.x)], 1u);
            asm volatile("s_waitcnt vmcnt(0)" ::: "memory");
        } else {
            XB_SPIN(xb_ld(&bar[XB_XGEN(b.x)]) == gen, bar);
            __builtin_amdgcn_fence(__ATOMIC_ACQUIRE, "agent");
            asm volatile("s_waitcnt vmcnt(0)" ::: "memory");
        }
    }
    __syncthreads();
}


struct Args { const float* in[19]; float* out; unsigned char* wsp; int ph_lo, ph_hi, li, jobmask; };
struct Frame { LAS unsigned char* lds; int tid, lane, wave, vcu, G; };
#define KA ((const Args*)__builtin_amdgcn_kernarg_segment_ptr())
#define INP(i) (KA->in[i])
#define A_WS (KA->wsp)
#define A_OUT (KA->out)

__device__ __forceinline__ int p0_dstrow(int mode, int aux, int col) {
    if (mode == 1) { if (col < 1024) return col; const int v = col >= 2048, cc = col - (v ? 2048 : 1024); return 1024 + 256 * (cc >> 7) + 128 * v + (cc & 127); }
    if (mode == 2) { const int up = col >= aux, cc = col - (up ? aux : 0); return 256 * (cc >> 7) + 128 * up + (cc & 127); }
    if (mode == 3) { const int g = col >> 6, bj = (col >> 5) & 1; return 256 * (g >> 2) + 32 * (4 * bj + (g & 3)) + (col & 31); }
    return col;
}
struct P0Item { const float* src; const float* gain; unsigned char* dst; int ldw, K, k0, d0, d1, f8; float sc; };
#define P0_JOB(SRC, LDW, KK, C0, NCOLS, GAIN, DSTOFF, DROW0, DSTROWS, MODE, AUX, NMAT, SC, F8) { \
    constexpr int nn_ = (NCOLS) / 64, per_ = ((KK) / 64) * nn_, cnt_ = per_ * (NMAT); \
    if (it < cnt_) { const int mat = it / per_, r = it % per_, kb = r / nn_, col = 64 * (r % nn_); \
        I.src = (SRC) + (size_t)mat * (KK) * (LDW) + (C0) + col; I.gain = (GAIN); I.dst = A_WS + (DSTOFF) + (size_t)mat * (DSTROWS) * (KK) * ((F8) ? 1 : 2); \
        I.ldw = (LDW); I.K = (KK); I.k0 = 64 * kb; I.d0 = (DROW0) + p0_dstrow(MODE, AUX, col); I.d1 = (DROW0) + p0_dstrow(MODE, AUX, col + 32); I.f8 = (F8); I.sc = (SC); return; } \
    it -= cnt_; }
constexpr int P0_NITEMS = 16 * 48 + 16 * 16 + 16 * 88 + 44 * 16 + 3 * 16 * 16 + 16 * 16 + 8 * 16 * 112 + 8 * 56 * 16;
__device__ __forceinline__ void p0_decode(int it, P0Item& I) {
    P0_JOB(INP(3), 3072, 1024, 0, 3072, nullptr, WS_W_IN, 0, 3072, 1, 0, 1, 1.0f, 0)
    P0_JOB(INP(5), 1024, 1024, 0, 1024, nullptr, WS_W_OUT, 0, 1024, 0, 0, 1, 1.0f, 0)
    P0_JOB(INP(14), 5632, 1024, 0, 5632, INP(2), WS_W_GU, 0, 5632, 2, 2816, 1, pg8::F8_SWGD, 1)
    P0_JOB(INP(15), 1024, 2816, 0, 1024, nullptr, WS_W_DN, 0, 1024, 0, 0, 1, pg8::F8_SWDD, 1)
    P0_JOB(INP(9), 1024, 1024, 0, 1024, INP(1) + 1024, WS_W_QKV, 0, 3072, 3, 0, 1, 1.0f, 0)
    P0_JOB(INP(7), 2048, 1024, 0, 1024, INP(6), WS_W_QKV, 1024, 3072, 3, 0, 1, 1.0f, 0)
    P0_JOB(INP(7), 2048, 1024, 1024, 1024, INP(6), WS_W_QKV, 2048, 3072, 0, 0, 1, 1.0f, 0)
    P0_JOB(INP(13), 1024, 1024, 0, 1024, nullptr, WS_W_O, 0, 1024, 0, 0, 1, 1.0f, 0)
    P0_JOB(INP(17), 7168, 1024, 0, 7168, INP(2) + 1024, WS_W_MGU, 0, 7168, 2, 3584, 8, pg8::F8_SWG, 1)
    P0_JOB(INP(18), 1024, 3584, 0, 1024, nullptr, WS_W_MDN, 0, 1024, 0, 0, 8, pg8::F8_SWD, 1)
}
#undef P0_JOB
struct P0Regs { f32x4 v[16]; float g[16]; };
__device__ __forceinline__ void p0_load(const P0Item& I, P0Regs& R, int lane) {
    const int lr = lane >> 4, lc = lane & 15;
#pragma unroll
    for (int i = 0; i < 16; ++i) R.v[i] = *(const GAS f32x4*)(I.src + (size_t)(I.k0 + 4 * i + lr) * I.ldw + 4 * lc);
    if (I.gain) {
#pragma unroll
        for (int i = 0; i < 16; ++i) R.g[i] = I.gain[I.k0 + 4 * i + lr];
    } else {
#pragma unroll
        for (int i = 0; i < 16; ++i) R.g[i] = 1.0f;
    }
}
__device__ __forceinline__ void p0_store(const P0Item& I, const P0Regs& R, LAS float* scr, int lane) {
    const int lr = lane >> 4, lc = lane & 15;
#pragma unroll
    for (int i = 0; i < 16; ++i) { const f32x4 w = R.v[i] * (R.g[i] * I.sc); LAS float* p = scr + (4 * i + lr) * 65 + 4 * lc; p[0] = w[0]; p[1] = w[1]; p[2] = w[2]; p[3] = w[3]; }
    LDS_WAIT(); asm volatile("" ::: "memory");
    const int c = lane & 7;
#pragma unroll
    for (int jj = 0; jj < 8; ++jj) { const int nl = 8 * jj + (lane >> 3); const LAS float* s = scr + (8 * c) * 65 + nl;
        const int drow = (jj < 4 ? I.d0 : I.d1 - 32) + nl;
        if (I.f8) { v2u o; o.x = pg8::pk4_fp8(s[0], s[65], s[130], s[195]); o.y = pg8::pk4_fp8(s[260], s[325], s[390], s[455]);
            pg8::st8_wt(I.dst + (size_t)drow * I.K + I.k0 + 8 * c, o.x, o.y); }
        else { v4u o; o.x = pk2(s[0], s[65]); o.y = pk2(s[130], s[195]); o.z = pk2(s[260], s[325]); o.w = pk2(s[390], s[455]);
            pg8::st16_wt(I.dst + ((size_t)drow * I.K + I.k0 + 8 * c) * 2, o); } }
    LDS_WAIT(); asm volatile("" ::: "memory");
}
__device__ __forceinline__ void rms_row_bf16(const float* xrow, const float* g, bf16_t* orow, int lane) {
    const GAS f32x4* xr = (const GAS f32x4*)xrow + lane; const GAS f32x4* gr = (const GAS f32x4*)g + lane;
    f32x4 v[4]; float s = 0.f;
#pragma unroll
    for (int j = 0; j < 4; ++j) { v[j] = xr[64 * j]; s += (v[j][0] * v[j][0] + v[j][1] * v[j][1]) + (v[j][2] * v[j][2] + v[j][3] * v[j][3]); }
    const float rstd = __builtin_amdgcn_rsqf(wave_sum(s) * (1.f / D) + EPS);
    GAS v2u* o8 = (GAS v2u*)orow + lane;
#pragma unroll
    for (int j = 0; j < 4; ++j) { const f32x4 gg = gr[64 * j]; v2u o; o.x = pk2(v[j][0] * rstd * gg[0], v[j][1] * rstd * gg[1]); o.y = pk2(v[j][2] * rstd * gg[2], v[j][3] * rstd * gg[3]); o8[64 * j] = o; }
}
__device__ __forceinline__ void p0_prologue(Frame& F) {
    const int gw = F.vcu * NWAVES + F.wave, NGW = F.G * NWAVES;
    {
        const float* x = INP(0); const float* g = INP(1); bf16_t* XN = (bf16_t*)(A_WS + WS_XN0);
        const GAS f32x4* gr = (const GAS f32x4*)g + F.lane; f32x4 gg[4];
#pragma unroll
        for (int j = 0; j < 4; ++j) gg[j] = gr[64 * j];
        for (int mb = gw; mb < M; mb += 4 * NGW) { f32x4 v[4][4];
#pragma unroll
            for (int i = 0; i < 4; ++i) { const int m = mb + i * NGW; if (m < M) { const GAS f32x4* xr = (const GAS f32x4*)(x + (size_t)m * D) + F.lane;
#pragma unroll
                for (int j = 0; j < 4; ++j) v[i][j] = xr[64 * j]; } }
#pragma unroll
            for (int i = 0; i < 4; ++i) { const int m = mb + i * NGW; if (m >= M) break; float s = 0.f;
#pragma unroll
                for (int j = 0; j < 4; ++j) s += (v[i][j][0] * v[i][j][0] + v[i][j][1] * v[i][j][1]) + (v[i][j][2] * v[i][j][2] + v[i][j][3] * v[i][j][3]);
                const float rstd = __builtin_amdgcn_rsqf(wave_sum(s) * (1.f / D) + EPS); GAS v2u* o8 = (GAS v2u*)(XN + (size_t)m * D) + F.lane;
#pragma unroll
                for (int j = 0; j < 4; ++j) { v2u o; o.x = pk2(v[i][j][0] * rstd * gg[j][0], v[i][j][1] * rstd * gg[j][1]); o.y = pk2(v[i][j][2] * rstd * gg[j][2], v[i][j][3] * rstd * gg[j][3]); o8[64 * j] = o; } } }
    }
    LAS float* scr = (LAS float*)(F.lds + RING_OFF + F.wave * P0_SCR);
    int it = gw; if (it >= P0_NITEMS) return;
    P0Item cur; P0Regs ra; p0_decode(it, cur); p0_load(cur, ra, F.lane);
    for (;;) { const int nit = it + NGW; const bool has = nit < P0_NITEMS; P0Item nx; P0Regs rb;
        if (has) { p0_decode(nit, nx); p0_load(nx, rb, F.lane); }
        p0_store(cur, ra, scr, F.lane);
        if (!has) break;
        cur = nx; ra = rb; it = nit; }
}

__device__ __forceinline__ void up8(const v4u w, float (&f)[8]) { f[0] = bflo(w.x); f[1] = bfhi(w.x); f[2] = bflo(w.y); f[3] = bfhi(w.y); f[4] = bflo(w.z); f[5] = bfhi(w.z); f[6] = bflo(w.w); f[7] = bfhi(w.w); }
__device__ __forceinline__ void p2_conv(Frame& F) {
    const bf16_t* Bb = (const bf16_t*)(A_WS + WS_BB); const bf16_t* Ub = (const bf16_t*)(A_WS + WS_UB); bf16_t* G = (bf16_t*)(A_WS + WS_G); const float* cw = INP(4);
    const int gw = F.vcu * NWAVES + F.wave, NGW = F.G * NWAVES;
    for (int strip = gw; strip < 2048; strip += NGW) {
        const int r0 = (strip >> 1) * 16, c0 = (strip & 1) * 512 + F.lane * 8;
        float w0[8], w1[8], w2[8], um2[8], um1[8];
#pragma unroll
        for (int j = 0; j < 8; ++j) { w0[j] = cw[c0 + j]; w1[j] = cw[D + c0 + j]; w2[j] = cw[2 * D + c0 + j]; um2[j] = 0.f; um1[j] = 0.f; }
        if ((r0 & (SEQ - 1)) != 0) { up8(*(const GAS v4u*)(Ub + (size_t)(r0 - 2) * D + c0), um2); up8(*(const GAS v4u*)(Ub + (size_t)(r0 - 1) * D + c0), um1); }
#pragma unroll
        for (int hb = 0; hb < 2; ++hb) { v4u ru[8], rb[8];
#pragma unroll
            for (int i = 0; i < 8; ++i) { ru[i] = *(const GAS v4u*)(Ub + (size_t)(r0 + 8 * hb + i) * D + c0); rb[i] = *(const GAS v4u*)(Bb + (size_t)(r0 + 8 * hb + i) * D + c0); }
#pragma unroll
            for (int ii = 0; ii < 8; ++ii) { const int i = 8 * hb + ii; float u[8], b[8]; up8(ru[ii], u); up8(rb[ii], b);
            float g[8];
#pragma unroll
            for (int j = 0; j < 8; ++j) { g[j] = b[j] * (w0[j] * um2[j] + w1[j] * um1[j] + w2[j] * u[j]); um2[j] = um1[j]; um1[j] = u[j]; }
            v4u o; o.x = pk2(g[0], g[1]); o.y = pk2(g[2], g[3]); o.z = pk2(g[4], g[5]); o.w = pk2(g[6], g[7]);
            pg8::st16_wt(G + (size_t)(r0 + i) * D + c0, o); } }
    }
}

__device__ __forceinline__ void p8_diff(Frame& F) {
    const bf16_t* O0 = (const bf16_t*)(A_WS + WS_O0); const bf16_t* O1 = (const bf16_t*)(A_WS + WS_O1); bf16_t* ON = (bf16_t*)(A_WS + WS_ON);
    const float* lp = INP(11); const float* sn = INP(12); const int lane = F.lane;
    const float lam = __expf(wave_sum(lp[lane] * lp[64 + lane])) - __expf(wave_sum(lp[128 + lane] * lp[192 + lane])) + LAM_INIT;
    float gn[16];
#pragma unroll
    for (int j = 0; j < 16; ++j) gn[j] = sn[16 * (lane & 7) + j] * (1.f - LAM_INIT);
    const int gw = F.vcu * NWAVES + F.wave, NGW = F.G * NWAVES;
    for (int rowb = gw; rowb < M; rowb += 4 * NGW) {
        v4u ra[4][2], rb[4][2];
#pragma unroll
        for (int i = 0; i < 4; ++i) { const int row = rowb + i * NGW; if (row < M) { const size_t off = (size_t)row * D + 16 * lane;
            ra[i][0] = *(const GAS v4u*)(O0 + off); ra[i][1] = *(const GAS v4u*)(O0 + off + 8); rb[i][0] = *(const GAS v4u*)(O1 + off); rb[i][1] = *(const GAS v4u*)(O1 + off + 8); } }
#pragma unroll
        for (int i = 0; i < 4; ++i) { const int row = rowb + i * NGW; if (row >= M) break; const size_t off = (size_t)row * D + 16 * lane;
            float a[16], a0[8], a1[8], b0[8], b1[8]; up8(ra[i][0], a0); up8(ra[i][1], a1); up8(rb[i][0], b0); up8(rb[i][1], b1);
            float s = 0.f;
#pragma unroll
            for (int j = 0; j < 8; ++j) { a[j] = a0[j] - lam * b0[j]; a[8 + j] = a1[j] - lam * b1[j]; s += a[j] * a[j] + a[8 + j] * a[8 + j]; }
            s += __shfl_xor(s, 1); s += __shfl_xor(s, 2); s += __shfl_xor(s, 4);
            const float rstd = __builtin_amdgcn_rsqf(s * (1.f / VD) + EPS);
            v4u o0, o1; o0.x = pk2(a[0] * rstd * gn[0], a[1] * rstd * gn[1]); o0.y = pk2(a[2] * rstd * gn[2], a[3] * rstd * gn[3]); o0.z = pk2(a[4] * rstd * gn[4], a[5] * rstd * gn[5]); o0.w = pk2(a[6] * rstd * gn[6], a[7] * rstd * gn[7]);
            o1.x = pk2(a[8] * rstd * gn[8], a[9] * rstd * gn[9]); o1.y = pk2(a[10] * rstd * gn[10], a[11] * rstd * gn[11]); o1.z = pk2(a[12] * rstd * gn[12], a[13] * rstd * gn[13]); o1.w = pk2(a[14] * rstd * gn[14], a[15] * rstd * gn[15]);
            pg8::st16_wt(ON + off, o0); pg8::st16_wt(ON + off + 8, o1); }
    }
}

#define TR_STEP(n, m) do { _Pragma("unroll") for (int i = 0; i < (n) / 2; ++i) { const bool up = (lane & (m)) != 0; const float keep = up ? v[i + (n) / 2] : v[i], send = up ? v[i] : v[i + (n) / 2]; v[i] = keep + __shfl_xor(send, (m)); } } while (0)
__device__ __forceinline__ void p10a_router(Frame& F) {
    const bf16_t* x3 = (const bf16_t*)(A_WS + WS_XB); const float* g = INP(2) + D; const float* Wr = INP(16); const float* ssq = (const float*)(A_WS + WS_SSQ);
    int* sel = (int*)(A_WS + WS_SEL); float* gate = (float*)(A_WS + WS_GATE); int* hist = (int*)(A_WS + WS_HIST);
    LAS f32x4* WL = (LAS f32x4*)(F.lds + RING_OFF);
    LAS int* lcnt = (LAS int*)(F.lds + RING_OFF + 32768);
    const int lane = F.lane;
    for (int k = F.tid; k < D; k += NWAVES * 64) { const float gk = g[k]; const f32x4 w0 = *(const GAS f32x4*)(Wr + (size_t)k * 8) * gk, w1 = *(const GAS f32x4*)(Wr + (size_t)k * 8 + 4) * gk;
        const int base = (((k >> 8) * 4 + (k & 3)) * 2) * 64 + ((k >> 2) & 63); WL[base] = w0; WL[base + 64] = w1; }
    LDS_WAIT(); __syncthreads();
    for (int blk = blockIdx.x; blk < M / 64; blk += F.G) {
        const int row0 = 64 * blk + 8 * F.wave;
        f32x4 xv[8][4];
#pragma unroll
        for (int r = 0; r < 8; ++r)
#pragma unroll
            for (int j = 0; j < 4; ++j) { const v2u w = *((const GAS v2u*)(x3 + (size_t)(row0 + r) * D) + lane + 64 * j); xv[r][j] = (f32x4){bflo(w.x), bfhi(w.x), bflo(w.y), bfhi(w.y)}; }
        float v[64];
#pragma unroll
        for (int i = 0; i < 64; ++i) v[i] = 0.f;
#pragma unroll
        for (int j = 0; j < 4; ++j)
#pragma unroll
            for (int q = 0; q < 4; ++q) { const f32x4 wa = WL[((j * 4 + q) * 2) * 64 + lane], wb = WL[((j * 4 + q) * 2 + 1) * 64 + lane];
#pragma unroll
                for (int r = 0; r < 8; ++r) { const float xx = xv[r][j][q];
                    v[r * 8 + 0] += xx * wa[0]; v[r * 8 + 1] += xx * wa[1]; v[r * 8 + 2] += xx * wa[2]; v[r * 8 + 3] += xx * wa[3];
                    v[r * 8 + 4] += xx * wb[0]; v[r * 8 + 5] += xx * wb[1]; v[r * 8 + 6] += xx * wb[2]; v[r * 8 + 7] += xx * wb[3]; } }
        TR_STEP(64, 32); TR_STEP(32, 16); TR_STEP(16, 8); TR_STEP(8, 4); TR_STEP(4, 2); TR_STEP(2, 1);
        float lg[8];
#pragma unroll
        for (int e = 0; e < 8; ++e) lg[e] = __shfl(v[0], (lane & ~7) | e);
        int i0 = 0; float v0 = lg[0];
#pragma unroll
        for (int e = 1; e < 8; ++e) if (lg[e] > v0) { v0 = lg[e]; i0 = e; }
        int i1 = 0; float v1 = -INFINITY;
#pragma unroll
        for (int e = 0; e < 8; ++e) if (e != i0 && lg[e] > v1) { v1 = lg[e]; i1 = e; }
        const int row = row0 + (lane >> 3); const float rs = pg8::rstd_of(ssq, row);
        const float g1 = 1.f / (1.f + expf((v0 - v1) * rs)); const bool wrt = (lane & 7) == 0;
        if (wrt) { sel[2 * row] = i0; sel[2 * row + 1] = i1; gate[2 * row] = 1.f - g1; gate[2 * row + 1] = g1; }
        int mycnt = 0;
#pragma unroll
        for (int e = 0; e < 8; ++e) { const int c = __popcll(__ballot(wrt && i0 == e)) + __popcll(__ballot(wrt && i1 == e)); if (lane == e) mycnt = c; }
        if (lane < 8) lcnt[F.wave * 8 + lane] = mycnt;
        LDS_WAIT(); __syncthreads();
        if (F.tid < 8) { int c = 0;
#pragma unroll
            for (int w = 0; w < 8; ++w) c += lcnt[w * 8 + F.tid];
            hist[blk * 8 + F.tid] = c; }
        LDS_WAIT(); __syncthreads();
    }
}
#undef TR_STEP
__device__ __forceinline__ void p10b_assign(Frame& F) {
    const int* hist = (const int*)(A_WS + WS_HIST); const int* sel = (const int*)(A_WS + WS_SEL); const float* gate = (const float*)(A_WS + WS_GATE); const float* ssq = (const float*)(A_WS + WS_SSQ);
    int* tok_slot = (int*)(A_WS + WS_TOKSLOT); float* gates = (float*)(A_WS + WS_GATES); int* meta = (int*)(A_WS + WS_META);
    const bf16_t* x3 = (const bf16_t*)(A_WS + WS_XB); unsigned char* XG = A_WS + WS_XG;
    LAS int* pre = (LAS int*)(F.lds + RING_OFF);
    LAS int* tot = pre + 2048;
    LAS int* ebase = tot + 8;
    LAS int* lslot = ebase + 8;
    const int lane = F.lane, e = F.wave;
    { int h[4], run = 0;
#pragma unroll
      for (int i = 0; i < 4; ++i) { h[i] = hist[(4 * lane + i) * 8 + e]; }
      const int mine = h[0] + h[1] + h[2] + h[3]; int inc = mine;
#pragma unroll
      for (int o = 1; o < 64; o <<= 1) { const int t = __shfl_up(inc, o); if (lane >= o) inc += t; }
      run = inc - mine;
#pragma unroll
      for (int i = 0; i < 4; ++i) { pre[(4 * lane + i) * 8 + e] = run; run += h[i]; }
      if (lane == 63) tot[e] = inc; }
    LDS_WAIT(); __syncthreads();
    if (F.tid == 0) { int b = 0; for (int k = 0; k < 8; ++k) { ebase[k] = b; if (blockIdx.x == 0) meta[k] = b >> 8; b += (tot[k] + 255) & ~255; } if (blockIdx.x == 0) { const int T = b >> 8, full = 2 * F.G / 4; meta[8] = T; meta[9] = T < full ? T : full; } }
    LDS_WAIT(); __syncthreads();
    for (int blk = blockIdx.x; blk < M / 64; blk += F.G) {
        if (F.wave == 0) { const int t = 64 * blk + lane; const int s0 = sel[2 * t], s1 = sel[2 * t + 1]; int sl0 = 0, sl1 = 0;
            const unsigned long long below = (1ull << lane) - 1ull;
#pragma unroll
            for (int k = 0; k < 8; ++k) { const unsigned long long m0 = __ballot(s0 == k), m1 = __ballot(s1 == k); const int b0 = ebase[k] + pre[blk * 8 + k];
                if (s0 == k) sl0 = b0 + __popcll(m0 & below); if (s1 == k) sl1 = b0 + __popcll(m0) + __popcll(m1 & below); }
            tok_slot[2 * t] = sl0; tok_slot[2 * t + 1] = sl1; lslot[2 * lane] = sl0; lslot[2 * lane + 1] = sl1;
            gates[sl0] = gate[2 * t]; gates[sl1] = gate[2 * t + 1]; }
        LDS_WAIT(); __syncthreads();
        v4u xw[8][2];
#pragma unroll
        for (int i = 0; i < 8; ++i) { const GAS v4u* xr = (const GAS v4u*)(x3 + (size_t)(64 * blk + 8 * F.wave + i) * D + 16 * lane); xw[i][0] = xr[0]; xw[i][1] = xr[1]; }
#pragma unroll
        for (int i = 0; i < 8; ++i) { const int tl = 8 * F.wave + i; const int t = 64 * blk + tl;
            const float rs = pg8::rstd_of(ssq, t) * pg8::F8_SA; float a[8], b[8]; up8(xw[i][0], a); up8(xw[i][1], b);
            v4u o; o.x = pg8::pk4_fp8(a[0] * rs, a[1] * rs, a[2] * rs, a[3] * rs); o.y = pg8::pk4_fp8(a[4] * rs, a[5] * rs, a[6] * rs, a[7] * rs); o.z = pg8::pk4_fp8(b[0] * rs, b[1] * rs, b[2] * rs, b[3] * rs); o.w = pg8::pk4_fp8(b[4] * rs, b[5] * rs, b[6] * rs, b[7] * rs);
            const int sl0 = lslot[2 * tl], sl1 = lslot[2 * tl + 1];
            pg8::st16_wt(XG + (size_t)sl0 * D + 16 * lane, o); pg8::st16_wt(XG + (size_t)sl1 * D + 16 * lane, o); }
        LDS_WAIT(); __syncthreads();
    }
}
__device__ __forceinline__ void p13_load_y(const bf16_t* Y, const float* Pp, const float* gates, int nfull, int slot, int lane, v2u (&y)[4]) {
    const int rt = (slot >> 8) - nfull;
    if (rt < 0) { const GAS v2u* yr = (const GAS v2u*)(Y + (size_t)slot * D) + lane;
#pragma unroll
        for (int j = 0; j < 4; ++j) y[j] = yr[64 * j];
    } else { const float gt = gates[slot] * (1.0f / (pg8::F8_SH * pg8::F8_SWD));
#pragma unroll
        for (int j = 0; j < 4; ++j) { f32x4 s = (f32x4){0.f, 0.f, 0.f, 0.f};
#pragma unroll
            for (int kp = 0; kp < pg8::MoeOrder::SPL; ++kp) s += *((const GAS f32x4*)(Pp + ((size_t)(rt * pg8::MoeOrder::SPL + kp) * 256 + (slot & 255)) * D) + lane + 64 * j);
            y[j].x = pk2(s[0] * gt, s[1] * gt); y[j].y = pk2(s[2] * gt, s[3] * gt); } }
}
__device__ __forceinline__ void p13_final(Frame& F) {
    const int* tok_slot = (const int*)(A_WS + WS_TOKSLOT); const bf16_t* Y = (const bf16_t*)(A_WS + WS_Y); const bf16_t* X3 = (const bf16_t*)(A_WS + WS_XB); float* out = A_OUT;
    const float* Pp = (const float*)(A_WS + WS_PP); const float* gates = (const float*)(A_WS + WS_GATES); const int nfull = ((const int*)(A_WS + WS_META))[9];
    const int gw = F.vcu * NWAVES + F.wave, NGW = F.G * NWAVES, lane = F.lane;
    for (int rowb = gw; rowb < M; rowb += 2 * NGW) {
        v2u xa[2][4], ya[2][4], yb[2][4];
#pragma unroll
        for (int i = 0; i < 2; ++i) { const int row = rowb + i * NGW; if (row < M) { const int s0 = tok_slot[2 * row], s1 = tok_slot[2 * row + 1];
            const GAS v2u* xr = (const GAS v2u*)(X3 + (size_t)row * D) + lane;
#pragma unroll
            for (int j = 0; j < 4; ++j) xa[i][j] = xr[64 * j];
            p13_load_y(Y, Pp, gates, nfull, s0, lane, ya[i]); p13_load_y(Y, Pp, gates, nfull, s1, lane, yb[i]); } }
#pragma unroll
        for (int i = 0; i < 2; ++i) { const int row = rowb + i * NGW; if (row >= M) break; GAS f32x4* orow = (GAS f32x4*)(out + (size_t)row * D) + lane;
#pragma unroll
            for (int j = 0; j < 4; ++j) { const v2u x = xa[i][j], a = ya[i][j], b = yb[i][j];
                orow[64 * j] = (f32x4){bflo(x.x) + (bflo(a.x) + bflo(b.x)), bfhi(x.x) + (bfhi(a.x) + bfhi(b.x)), bflo(x.y) + (bflo(a.y) + bflo(b.y)), bfhi(x.y) + (bfhi(a.y) + bfhi(b.y))}; } }
    }
}

__global__ void __launch_bounds__(NWAVES * 64, 2) mega_fwd(Args args) {
    extern __shared__ __attribute__((aligned(16))) unsigned char lds[];
    Frame F;
    F.lds = (LAS unsigned char*)lds; F.tid = threadIdx.x; F.lane = F.tid & 63; F.wave = __builtin_amdgcn_readfirstlane(F.tid >> 6);
    F.G = gridDim.x; { const int bx = blockIdx.x; F.vcu = (F.G % 8 == 0) ? (bx % 8) * (F.G / 8) + bx / 8 : bx; }
    for (int u = F.tid; u < RING_OFF / 4; u += NWAVES * 64) ((LAS unsigned*)(F.lds + MISC_OFF))[u] = 0u;
    __syncthreads();
    if (KA->ph_hi - KA->ph_lo > 1) (void)xcd_barrier_post((unsigned*)(A_WS + WS_CTL) + CW_BAR + KA->li * XCD_BAR_WORDS, (volatile LAS unsigned*)(F.lds + MISC_OFF + 32));
#define IN(k) (KA->ph_lo <= (k) && (k) < KA->ph_hi)
#define SEAM(k) do { if (IN(k) && IN((k) + 1)) SEAM_NOW(); } while (0)
#define SEAM_NOW() do { { XcdBarrier b_; b_.bar = (unsigned*)(A_WS + WS_CTL) + CW_BAR + KA->li * XCD_BAR_WORDS; b_.x = xb_xcc_id(); b_.st = (volatile LAS unsigned*)(F.lds + MISC_OFF + 32); xcd_barrier(b_); } } while (0)
#define ws A_WS
#define XB ((bf16_t*)(A_WS + WS_XB))
#define SSQ ((float*)(A_WS + WS_SSQ))

    if (IN(0)) { p0_prologue(F); } SEAM(0);
    if (IN(1)) { pg8::Gemm g{(const bf16_t*)(ws + WS_XN0), (const bf16_t*)(ws + WS_W_IN), M, 3072, 1024}; pg8::StaticOrder S; S.init(M, 3072, F.G, (int)blockIdx.x);
        pg8::EpiInProj E{(bf16_t*)(ws + WS_BB), (bf16_t*)(ws + WS_UB)};
        pg8::gemm_phase<pg8::EpiInProj, pg8::StaticOrder, true, true>(F.lds + RING_OFF, g, S, E); } SEAM(1);
    if (IN(2)) { p2_conv(F); } SEAM(2);
    if (IN(3)) { pg8::Gemm g{(const bf16_t*)(ws + WS_G), (const bf16_t*)(ws + WS_W_OUT), M, 1024, 1024}; pg8::StaticOrder S; S.init(M, 1024, F.G, (int)blockIdx.x);
        pg8::EpiResidSsq<true> E{INP(0), XB, SSQ, 1.0f, ws + WS_X8};
        pg8::gemm_phase<pg8::EpiResidSsq<true>, pg8::StaticOrder, false, true>(F.lds + RING_OFF, g, S, E); } SEAM(3);
    if (IN(4)) { pg8::Gemm g{(const bf16_t*)(ws + WS_X8), (const bf16_t*)(ws + WS_W_GU), M, 5632, 512}; pg8::StaticOrder S; S.init(M, 5632, F.G, (int)blockIdx.x);
        pg8::EpiSwiGLU<true> E{ws + WS_HACT, DFF, SSQ, nullptr, 22, 1.0f / (pg8::F8_SX * pg8::F8_SWGD)};
        pg8::gemm_phase<pg8::EpiSwiGLU<true>, pg8::StaticOrder, true, true, true>(F.lds + RING_OFF, g, S, E); } SEAM(4);
    if (IN(5)) { pg8::Gemm g{(const bf16_t*)(ws + WS_HACT), (const bf16_t*)(ws + WS_W_DN), M, 1024, DFF / 2}; pg8::StaticOrder S; S.init(M, 1024, F.G, (int)blockIdx.x);
        pg8::EpiResidSsq<false> E{nullptr, XB, SSQ, 1.0f / (pg8::F8_SHD * pg8::F8_SWDD), nullptr};
        pg8::gemm_phase<pg8::EpiResidSsq<false>, pg8::StaticOrder, false, true, true>(F.lds + RING_OFF, g, S, E); } SEAM(5);
    if (IN(6)) { pg8::Gemm g{XB, (const bf16_t*)(ws + WS_W_QKV), M, 3072, 1024}; pg8::StaticOrder S; S.init(M, 3072, F.G, (int)blockIdx.x);
        pg8::EpiQKV E{(bf16_t*)(ws + WS_Q), (bf16_t*)(ws + WS_K), (bf16_t*)(ws + WS_V), SSQ, INP(10), INP(8), attn_body::C2};
        pg8::gemm_phase<pg8::EpiQKV, pg8::StaticOrder, true, true>(F.lds + RING_OFF, g, S, E); } SEAM(6);
    if (IN(7)) {
        const float* lp = INP(11); const float* sn = INP(12);
        const float lam = __expf(wave_sum(lp[F.lane] * lp[64 + F.lane])) - __expf(wave_sum(lp[128 + F.lane] * lp[192 + F.lane])) + LAM_INIT;
        LAS float* sng = (LAS float*)(F.lds + MISC_OFF + 256);
        if (F.tid < VD) sng[F.tid] = sn[F.tid] * (1.f - LAM_INIT);
        LDS_WAIT(); __syncthreads();
        for (int it = F.vcu; it < BATCH * 32; it += F.G) { const int b = it >> 5, h = (it >> 2) & 7, p = it & 3;
            attn_body::bf16* O0 = (attn_body::bf16*)(ws + WS_O0); attn_body::bf16* ONp = (attn_body::bf16*)(ws + WS_ON);
            for (int i = 0; i < 2; ++i) { const int qb = i ? 7 - p : p;
                attn_body::attn_unit<8, 0>(b, (2 * h) * 64, h * 128, qb, (const attn_body::bf16*)(ws + WS_Q), (const attn_body::bf16*)(ws + WS_K), (const attn_body::bf16*)(ws + WS_V), O0, (char*)lds + RING_OFF, nullptr, 0.f, nullptr);
                attn_body::attn_unit<8, 1>(b, (2 * h + 1) * 64, h * 128, qb, (const attn_body::bf16*)(ws + WS_Q), (const attn_body::bf16*)(ws + WS_K), (const attn_body::bf16*)(ws + WS_V), O0, (char*)lds + RING_OFF, ONp, lam, (const float*)((char*)lds + MISC_OFF + 256)); } }
    } if (IN(7) && IN(9)) SEAM_NOW();
    if (IN(9)) { pg8::Gemm g{(const bf16_t*)(ws + WS_ON), (const bf16_t*)(ws + WS_W_O), M, 1024, 1024}; pg8::StaticOrder S; S.init(M, 1024, F.G, (int)blockIdx.x);
        pg8::EpiResidSsq<false> E{nullptr, XB, SSQ, 1.0f, nullptr};
        pg8::gemm_phase<pg8::EpiResidSsq<false>, pg8::StaticOrder, false, true>(F.lds + RING_OFF, g, S, E); } SEAM(9);
    if (IN(10)) { p10a_router(F); } SEAM(10);
    if (IN(11)) { p10b_assign(F); } SEAM(11);
    if (IN(12)) { pg8::Gemm g{(const bf16_t*)(ws + WS_XG), (const bf16_t*)(ws + WS_W_MGU), SLOTS, 8 * 7168, 512}; pg8::MoeOrder S; S.init((const int*)(ws + WS_META), 28, F.G, (int)blockIdx.x, false);
        pg8::EpiSwiGLU8 E{ws + WS_HM, DFE, 28};
        pg8::gemm_phase<pg8::EpiSwiGLU8, pg8::MoeOrder, true, true, true>(F.lds + RING_OFF, g, S, E); } SEAM(12);
    if (IN(13)) { pg8::Gemm g{(const bf16_t*)(ws + WS_HM), (const bf16_t*)(ws + WS_W_MDN), SLOTS, 8 * 1024, DFE / 2}; pg8::MoeOrder S; S.init((const int*)(ws + WS_META), 4, F.G, (int)blockIdx.x, true);
        pg8::EpiMoeDown E{(bf16_t*)(ws + WS_Y), (const float*)(ws + WS_GATES), 1.0f / (pg8::F8_SH * pg8::F8_SWD), (float*)(ws + WS_PP)};
        pg8::gemm_phase<pg8::EpiMoeDown, pg8::MoeOrder, true, true, true>(F.lds + RING_OFF, g, S, E); } SEAM(13);
    if (IN(14)) { p13_final(F); }
#undef IN
#undef SEAM
#undef SEAM_NOW
#undef ws
#undef XB
#undef SSQ
}
#ifndef MEGA_UPTO
#define MEGA_UPTO 15
#endif
#ifndef MEGA_REPMASK
#define MEGA_REPMASK 0
#endif
#ifndef MEGA_ONE
#define MEGA_ONE 1
#endif
extern "C" void kernel_launch(void* const* d_in, const int* in_sizes, int n_in, void* d_out, int out_size, void* d_ws, size_t ws_size, hipStream_t stream) {
    static int grid = 0;
    if (grid == 0) {
        if (n_in != 19 || in_sizes[0] != M * D || out_size != M * D || ws_size < WS_END) { fprintf(stderr, "kernel_launch: unexpected shapes / workspace (%d inputs, ws %zu, need %zu)\n", n_in, ws_size, (size_t)WS_END); grid = -1; return; }
        int dev = 0, cus = 0, per_cu = 0;
        if (hipGetDevice(&dev) != hipSuccess || hipDeviceGetAttribute(&cus, hipDeviceAttributeMultiprocessorCount, dev) != hipSuccess) { grid = -1; return; }
        if (hipFuncSetAttribute((const void*)mega_fwd, hipFuncAttributeMaxDynamicSharedMemorySize, LDS_BYTES) != hipSuccess) { fprintf(stderr, "kernel_launch: hipFuncSetAttribute failed\n"); grid = -1; return; }
        if (hipOccupancyMaxActiveBlocksPerMultiprocessor(&per_cu, (const void*)mega_fwd, NWAVES * 64, LDS_BYTES) != hipSuccess || per_cu < 1) fprintf(stderr, "kernel_launch: note: occupancy query says %d\n", per_cu);
        (void)hipGetLastError();
        grid = cus < 256 ? cus : 256;
        if (grid != 256) fprintf(stderr, "kernel_launch: %d CUs; this kernel is built for 256\n", cus);
    }
    if (grid < 0) return;
    unsigned char* ws = (unsigned char*)d_ws; float* out = (float*)d_out;
    constexpr int UPTO = MEGA_UPTO;
    static_assert(UPTO == 15, "the plain reference kernels of the transition builds are gone: all 15 phases run in the persistent kernel");
    if (UPTO > 0) {
        if (hipMemsetAsync(ws + WS_CTL, 0, CTL_ZERO_BYTES, stream) != hipSuccess) { fprintf(stderr, "kernel_launch: memset failed\n"); return; }
        Args a{};
        for (int i = 0; i < 19; ++i) a.in[i] = (const float*)d_in[i];
        a.out = out; a.wsp = ws;
        a.jobmask = UPTO >= 15 ? 255 : UPTO >= 10 ? 63 : UPTO >= 7 ? 31 : UPTO >= 6 ? 15 : 3;
        if (MEGA_ONE) { a.ph_lo = 0; a.ph_hi = UPTO; a.li = 0; hipLaunchKernelGGL(mega_fwd, dim3(grid), dim3(NWAVES * 64), LDS_BYTES, stream, a); }
        else for (int p = 0; p < UPTO; ++p) { a.ph_lo = p; a.ph_hi = p + 1; a.li = 0; for (int r = 0; r <= ((MEGA_REPMASK >> p) & 1); ++r) hipLaunchKernelGGL(mega_fwd, dim3(grid), dim3(NWAVES * 64), LDS_BYTES, stream, a); }
        const hipError_t le = hipPeekAtLastError();
        if (le != hipSuccess) fprintf(stderr, "kernel_launch: launch failed: %s\n", hipGetErrorName(le));
    }
}
```

```cpp
#include <hip/hip_runtime.h>
#include <hip/hip_bf16.h>
#include <stdint.h>
#include <stdio.h>
#include <cmath>
#define MEGA_UPTO 15
#define MEGA_ONE 1
typedef unsigned short bf16_t;
typedef short bf16x8 __attribute__((ext_vector_type(8)));
typedef float f32x4 __attribute__((ext_vector_type(4)));
constexpr int D = 1024, BATCH = 8, SEQ = 2048, M = BATCH * SEQ;
constexpr int NH = 8, HD = 64, VD = 128;
constexpr int DFF = 2816, NE = 8, DFE = 3584;
constexpr float EPS = 1e-6f;
constexpr float LAM_INIT = 0.35550907f;
constexpr int SLOTS = 2 * M + NE * 256;

__device__ __forceinline__ unsigned f2bf(float f) { unsigned u = __builtin_bit_cast(unsigned, f); return (u + 0x7fffu + ((u >> 16) & 1u)) >> 16; }
__device__ __forceinline__ float bf2f(unsigned short b) { return __builtin_bit_cast(float, (unsigned)b << 16); }
__device__ __forceinline__ float wave_sum(float v) {
#pragma unroll
    for (int o = 1; o < 64; o <<= 1) v += __shfl_xor(v, o);
    return v;
}

namespace pg8 {
#define PG8_LAS __attribute__((address_space(3)))
typedef unsigned short bf16_t;
typedef short bf16x8 __attribute__((ext_vector_type(8)));
typedef float f32x4 __attribute__((ext_vector_type(4)));
typedef unsigned u32x4 __attribute__((ext_vector_type(4)));
typedef int i32x4 __attribute__((ext_vector_type(4)));
typedef int i32x8 __attribute__((ext_vector_type(8)));
constexpr int BM = 256, BK = 64, HALF = 128, HTB = HALF * BK * 2  , STAGE_BYTES = 8 * HTB, NXCD = 8, WGM = 8;

__host__ __device__ __forceinline__ int lds_byte(int r, int c) { const int st = (r >> 4) * 2 + (c >> 5), rr = r & 15, cc = c & 31, ob = rr * 64 + cc * 2; return st * 1024 + (ob ^ (((ob >> 9) & 1) << 5)); }
__host__ __device__ __forceinline__ void stage_rc(int b, int& R, int& C) { const int st = b / 1024, sb = b % 1024, swz = sb ^ (((sb >> 9) & 1) << 5); R = (st >> 1) * 16 + swz / 64; C = (st & 1) * 32 + (swz % 64) / 2; }
__host__ __device__ __forceinline__ int perm32(int rho) { const int n = rho >> 4, i = rho & 15; return 8 * (i >> 2) + 4 * n + (i & 3); }

struct Unit { int pm, pn; int kt0, nkt, aux; };
struct Gemm { const bf16_t* A; const bf16_t* Bt; int M, N, K; };

struct StaticOrder {
    int nM, nN, nwg, G, c;
    __host__ __device__ void init(int M, int N, int G_, int c_) { nM = M / BM; nN = N / BM; nwg = nM * nN; G = G_; c = c_; }
    __host__ __device__ bool next(int i, Unit& u) const {
        const long L = (long)i * G + c; if (L >= nwg) return false;
        int wgid = (int)L; { const int q = nwg / NXCD, r = nwg % NXCD, xcd = wgid % NXCD, off = wgid / NXCD; wgid = (xcd < r ? xcd * (q + 1) : r * (q + 1) + (xcd - r) * q) + off; }
        const int nig = WGM * nN, gid = wgid / nig, fm = gid * WGM, gsz = (nM - fm) < WGM ? (nM - fm) : WGM;
        u.pm = fm + ((wgid % nig) % gsz); u.pn = (wgid % nig) / gsz; u.kt0 = 0; u.nkt = 0; u.aux = -1; return true;
    }
    __device__ __forceinline__ void a_ready(const Unit&) const {}
    __device__ __forceinline__ void done(const Unit&) const {}
};

__device__ __forceinline__ unsigned cvt_pk_bf16(float lo, float hi) { unsigned r; asm volatile("v_cvt_pk_bf16_f32 %0, %1, %2" : "=v"(r) : "v"(lo), "v"(hi)); return r; }
typedef float f32x2 __attribute__((ext_vector_type(2)));
#ifndef PG8_WT
#define PG8_WT 0
#endif
__device__ __forceinline__ void st16_wt(void* p, u32x4 v) {
#if PG8_WT
    asm volatile("global_store_dwordx4 %0, %1, off sc1\n\ts_nop 1" :: "v"(p), "v"(v) : "memory");
#else
    *(u32x4*)p = v;
#endif
}
__device__ __forceinline__ void st8_wt(void* p, unsigned x, unsigned y) {
#if PG8_WT
    typedef unsigned u32x2_ __attribute__((ext_vector_type(2))); const u32x2_ v = {x, y};
    asm volatile("global_store_dwordx2 %0, %1, off sc1\n\ts_nop 1" :: "v"(p), "v"(v) : "memory");
#else
    typedef unsigned u32x2_ __attribute__((ext_vector_type(2))); *(u32x2_*)p = (u32x2_){x, y};
#endif
}
typedef unsigned u32x2 __attribute__((ext_vector_type(2)));
constexpr float RMS_EPS = 1e-6f, LOG2E = 1.4426950408889634f;
constexpr int DM_ = 1024;
__device__ __forceinline__ u32x4 pack8(const f32x4 a, const f32x4 b) { u32x4 w; w.x = cvt_pk_bf16(a[0], a[1]); w.y = cvt_pk_bf16(a[2], a[3]); w.z = cvt_pk_bf16(b[0], b[1]); w.w = cvt_pk_bf16(b[2], b[3]); return w; }
__device__ __forceinline__ float rstd_of(const float* ssq, int row) { const f32x4 p = *(const f32x4*)(ssq + (size_t)row * 4); return __builtin_amdgcn_rsqf(((p[0] + p[1]) + (p[2] + p[3])) * (1.0f / 1024.0f) + RMS_EPS); }
__device__ __forceinline__ float silu_mul(float g, float u) { return g * u * __builtin_amdgcn_rcpf(1.0f + __builtin_amdgcn_exp2f(-g * LOG2E)); }
__device__ __forceinline__ f32x2 swiglu2(f32x2 a, f32x2 b, float c1, float k) {
    const f32x2 t = a * c1; f32x2 e; e.x = __builtin_amdgcn_exp2f(t.x); e.y = __builtin_amdgcn_exp2f(t.y);
    const f32x2 d = e * k + k; f32x2 r; r.x = __builtin_amdgcn_rcpf(d.x); r.y = __builtin_amdgcn_rcpf(d.y);
    return (a * b) * r;
}

__device__ __forceinline__ float clamp448(float x) { return __builtin_amdgcn_fmed3f(x, -448.0f, 448.0f); }
__device__ __forceinline__ unsigned pk4_fp8(float a, float b, float c, float d) { int w = 0; w = __builtin_amdgcn_cvt_pk_fp8_f32(clamp448(a), clamp448(b), w, false); w = __builtin_amdgcn_cvt_pk_fp8_f32(clamp448(c), clamp448(d), w, true); return (unsigned)w; }
constexpr float F8_SA = 4.0f, F8_SWG = 256.0f, F8_SH = 8.0f, F8_SWD = 512.0f;
constexpr float F8_SHD = 8.0f, F8_SWDD = 256.0f, F8_SX = 4.0f, F8_SWGD = 256.0f;

struct EpiInProj {
    static constexpr bool PERM = true, AFTER_DRAIN = false;
    bf16_t* Bb; bf16_t* Ub;
    __device__ __forceinline__ void operator()(const f32x4 (&acc)[2][2][4][2], const Unit& u, int wr, int wc, int fr, int fq) const {
        const int row0 = u.pm * BM + wr * 64 + fr;
        if (u.pn < 4) {
            const int col0 = u.pn * BM + wc * 32 + 8 * fq;
#pragma unroll
            for (int ai = 0; ai < 2; ++ai)
#pragma unroll
                for (int m = 0; m < 4; ++m) { bf16_t* rowp = Bb + (size_t)(row0 + ai * HALF + m * 16) * DM_ + col0;
#pragma unroll
                    for (int bj = 0; bj < 2; ++bj) st16_wt(rowp + bj * HALF, pack8(acc[ai][bj][m][0], acc[ai][bj][m][1])); }
        } else {
            const int col0 = (u.pn - 4) * 128 + wc * 32 + 8 * fq;
#pragma unroll
            for (int ai = 0; ai < 2; ++ai)
#pragma unroll
                for (int m = 0; m < 4; ++m) { bf16_t* rowp = Ub + (size_t)(row0 + ai * HALF + m * 16) * DM_ + col0;
                    st16_wt(rowp, pack8(acc[ai][0][m][0] * acc[ai][1][m][0], acc[ai][0][m][1] * acc[ai][1][m][1])); }
        }
    }
};

template <bool FIRST> struct EpiResidSsq {
    static constexpr bool PERM = true, AFTER_DRAIN = true;
    const float* x0; bf16_t* xb; float* ssq; float ascale; unsigned char* x8;
    __device__ __forceinline__ void fused(f32x4 (&acc)[2][2][4][2], const Unit& u, int wr, int wc, int fr, int fq, PG8_LAS unsigned char* lds, int wid, int lane) const {
        PG8_LAS float* P = (PG8_LAS float*)lds;
        const int col0 = u.pn * BM + wc * 32 + 8 * fq;
#pragma unroll
        for (int ai = 0; ai < 2; ++ai) {
            f32x4 xo[4][2][2];
#pragma unroll
            for (int m = 0; m < 4; ++m) { const int r = ai * HALF + wr * 64 + m * 16 + fr; const size_t off = (size_t)(u.pm * BM + r) * DM_ + col0;
#pragma unroll
                for (int bj = 0; bj < 2; ++bj) {
                    if constexpr (FIRST) { xo[m][bj][0] = *(const f32x4*)(x0 + off + bj * HALF); xo[m][bj][1] = *(const f32x4*)(x0 + off + bj * HALF + 4); }
                    else { const u32x4 w = *(const u32x4*)(xb + off + bj * HALF);
                        xo[m][bj][0] = (f32x4){__builtin_bit_cast(float, w.x << 16), __builtin_bit_cast(float, w.x & 0xffff0000u), __builtin_bit_cast(float, w.y << 16), __builtin_bit_cast(float, w.y & 0xffff0000u)};
                        xo[m][bj][1] = (f32x4){__builtin_bit_cast(float, w.z << 16), __builtin_bit_cast(float, w.z & 0xffff0000u), __builtin_bit_cast(float, w.w << 16), __builtin_bit_cast(float, w.w & 0xffff0000u)}; } } }
#pragma unroll
            for (int m = 0; m < 4; ++m) { const int r = ai * HALF + wr * 64 + m * 16 + fr; const size_t off = (size_t)(u.pm * BM + r) * DM_ + col0; float s = 0.f;
#pragma unroll
                for (int bj = 0; bj < 2; ++bj) { const f32x4 v0 = xo[m][bj][0] + acc[ai][bj][m][0] * ascale, v1 = xo[m][bj][1] + acc[ai][bj][m][1] * ascale;
                    st16_wt(xb + off + bj * HALF, pack8(v0, v1));
                    if constexpr (FIRST) { u32x2 w; w.x = pk4_fp8(v0[0] * F8_SX, v0[1] * F8_SX, v0[2] * F8_SX, v0[3] * F8_SX); w.y = pk4_fp8(v1[0] * F8_SX, v1[1] * F8_SX, v1[2] * F8_SX, v1[3] * F8_SX); st8_wt(x8 + off + bj * HALF, w.x, w.y); }
                    s += ((v0[0] * v0[0] + v0[1] * v0[1]) + (v0[2] * v0[2] + v0[3] * v0[3])) + ((v1[0] * v1[0] + v1[1] * v1[1]) + (v1[2] * v1[2] + v1[3] * v1[3])); }
                s += __shfl_xor(s, 16); s += __shfl_xor(s, 32);
                if (fq == 0) P[r * 4 + wc] = s; }
            asm volatile("" ::: "memory"); }
        asm volatile("s_waitcnt lgkmcnt(0)" ::: "memory"); __builtin_amdgcn_s_barrier(); asm volatile("" ::: "memory");
        const int t = wid * 64 + lane;
        if (t < 256) { const PG8_LAS f32x4* Pr = (const PG8_LAS f32x4*)lds; const f32x4 p = Pr[t]; ssq[(size_t)(u.pm * BM + t) * 4 + u.pn] = (p[0] + p[1]) + (p[2] + p[3]); }
        asm volatile("s_waitcnt lgkmcnt(0)" ::: "memory"); __builtin_amdgcn_s_barrier(); asm volatile("" ::: "memory");
    }
};

template <bool OUT8> struct EpiSwiGLU {
    static constexpr bool PERM = true, AFTER_DRAIN = false;
    void* H; int ldh; const float* ssq; const float* rstd; int ncol; float cs;
    __device__ __forceinline__ void operator()(const f32x4 (&acc)[2][2][4][2], const Unit& u, int wr, int wc, int fr, int fq) const {
        const int row0 = u.pm * BM + wr * 64 + fr, col0 = (u.pn % ncol) * 128 + wc * 32 + 8 * fq;
#pragma unroll
        for (int ai = 0; ai < 2; ++ai)
#pragma unroll
            for (int m = 0; m < 4; ++m) { const int row = row0 + ai * HALF + m * 16;
                float k; if (ssq) { const f32x4 p = *(const f32x4*)(ssq + (size_t)row * 4); k = ((p[0] + p[1]) + (p[2] + p[3])) * (1.0f / 1024.0f) + RMS_EPS; } else { const float r_ = rstd[row]; k = 1.0f / (r_ * r_); }
                const float c1 = -LOG2E * cs * __builtin_amdgcn_rsqf(k); k = k / (cs * cs);
                f32x4 h[2];
#pragma unroll
                for (int n = 0; n < 2; ++n) { const f32x4 a = acc[ai][0][m][n], b = acc[ai][1][m][n];
                    const f32x2 h0 = swiglu2((f32x2){a[0], a[1]}, (f32x2){b[0], b[1]}, c1, k), h1 = swiglu2((f32x2){a[2], a[3]}, (f32x2){b[2], b[3]}, c1, k);
                    h[n] = (f32x4){h0.x, h0.y, h1.x, h1.y}; }
                if constexpr (OUT8) { u32x2 w; w.x = pk4_fp8(h[0][0] * F8_SHD, h[0][1] * F8_SHD, h[0][2] * F8_SHD, h[0][3] * F8_SHD); w.y = pk4_fp8(h[1][0] * F8_SHD, h[1][1] * F8_SHD, h[1][2] * F8_SHD, h[1][3] * F8_SHD);
                    st8_wt((unsigned char*)H + (size_t)row * ldh + col0, w.x, w.y); }
                else st16_wt((bf16_t*)H + (size_t)row * ldh + col0, pack8(h[0], h[1])); }
    }
};

struct EpiQKV {
    static constexpr bool PERM = true, AFTER_DRAIN = false;
    bf16_t *Q, *K, *V; const float* ssq; const float* qg; const float* kg; float qscale;
    __device__ __forceinline__ void operator()(const f32x4 (&acc)[2][2][4][2], const Unit& u, int wr, int wc, int fr, int fq) const {
        const int row0 = u.pm * BM + wr * 64 + fr;
        if (u.pn < 8) {
            const bool isq = u.pn < 4; bf16_t* base = isq ? Q : K; const float* gn = isq ? qg : kg; const float sc = isq ? qscale : 1.0f;
            const int col0 = (4 * (u.pn & 3) + wc) * 64 + 8 * fq;
            f32x4 gv[2][2];
#pragma unroll
            for (int bj = 0; bj < 2; ++bj)
#pragma unroll
                for (int n = 0; n < 2; ++n) gv[bj][n] = *(const f32x4*)(gn + 32 * bj + 8 * fq + 4 * n);
#pragma unroll
            for (int ai = 0; ai < 2; ++ai)
#pragma unroll
                for (int m = 0; m < 4; ++m) { const int row = row0 + ai * HALF + m * 16; const float rs = rstd_of(ssq, row);
                    f32x4 v[2][2]; float ss = 0.f;
#pragma unroll
                    for (int bj = 0; bj < 2; ++bj)
#pragma unroll
                        for (int n = 0; n < 2; ++n) { v[bj][n] = acc[ai][bj][m][n] * rs; ss += (v[bj][n][0] * v[bj][n][0] + v[bj][n][1] * v[bj][n][1]) + (v[bj][n][2] * v[bj][n][2] + v[bj][n][3] * v[bj][n][3]); }
                    ss += __shfl_xor(ss, 16); ss += __shfl_xor(ss, 32);
                    const float r2 = __builtin_amdgcn_rsqf(ss * (1.0f / 64.0f) + RMS_EPS) * sc;
#pragma unroll
                    for (int bj = 0; bj < 2; ++bj) st16_wt(base + (size_t)row * DM_ + col0 + 32 * bj, pack8(v[bj][0] * r2 * gv[bj][0], v[bj][1] * r2 * gv[bj][1])); }
        } else {
            const int col0 = (u.pn - 8) * BM + wc * 32 + 8 * fq;
#pragma unroll
            for (int ai = 0; ai < 2; ++ai)
#pragma unroll
                for (int m = 0; m < 4; ++m) { const int row = row0 + ai * HALF + m * 16; const float rs = rstd_of(ssq, row);
#pragma unroll
                    for (int bj = 0; bj < 2; ++bj) st16_wt(V + (size_t)row * DM_ + col0 + bj * HALF, pack8(acc[ai][bj][m][0] * rs, acc[ai][bj][m][1] * rs)); }
        }
    }
};

struct EpiSwiGLU8 {
    static constexpr bool PERM = true, AFTER_DRAIN = false;
    unsigned char* H; int ldh; int ncol;
    __device__ __forceinline__ void operator()(const f32x4 (&acc)[2][2][4][2], const Unit& u, int wr, int wc, int fr, int fq) const {
        const int row0 = u.pm * BM + wr * 64 + fr, col0 = (u.pn % ncol) * 128 + wc * 32 + 8 * fq; constexpr float cs = 1.0f / (F8_SA * F8_SWG);
#pragma unroll
        for (int ai = 0; ai < 2; ++ai)
#pragma unroll
            for (int m = 0; m < 4; ++m) { const int row = row0 + ai * HALF + m * 16; f32x4 h[2];
#pragma unroll
                for (int n = 0; n < 2; ++n) { const f32x4 a = acc[ai][0][m][n], b = acc[ai][1][m][n];
                    const f32x2 h0 = swiglu2((f32x2){a[0], a[1]}, (f32x2){b[0], b[1]}, -cs * LOG2E, 1.0f / (cs * cs * F8_SH)), h1 = swiglu2((f32x2){a[2], a[3]}, (f32x2){b[2], b[3]}, -cs * LOG2E, 1.0f / (cs * cs * F8_SH));
                    h[n] = (f32x4){h0.x, h0.y, h1.x, h1.y}; }
                u32x2 w; w.x = pk4_fp8(h[0][0], h[0][1], h[0][2], h[0][3]); w.y = pk4_fp8(h[1][0], h[1][1], h[1][2], h[1][3]);
                st8_wt(H + (size_t)row * ldh + col0, w.x, w.y); }
    }
};

struct EpiMoeDown {
    static constexpr bool PERM = true, AFTER_DRAIN = false;
    bf16_t* Y; const float* gate; float scale; float* Pp;
    __device__ __forceinline__ void operator()(const f32x4 (&acc)[2][2][4][2], const Unit& u, int wr, int wc, int fr, int fq) const {
        const int col0 = (u.pn & 3) * BM + wc * 32 + 8 * fq;
        if (u.aux >= 0) {
            float* base = Pp + ((size_t)u.aux * BM + wr * 64 + fr) * DM_ + col0;
#pragma unroll
            for (int ai = 0; ai < 2; ++ai)
#pragma unroll
                for (int m = 0; m < 4; ++m)
#pragma unroll
                    for (int bj = 0; bj < 2; ++bj) { float* p = base + (size_t)(ai * HALF + m * 16) * DM_ + bj * HALF; st16_wt(p, __builtin_bit_cast(u32x4, acc[ai][bj][m][0])); st16_wt(p + 4, __builtin_bit_cast(u32x4, acc[ai][bj][m][1])); }
            return; }
        const int row0 = u.pm * BM + wr * 64 + fr;
#pragma unroll
        for (int ai = 0; ai < 2; ++ai)
#pragma unroll
            for (int m = 0; m < 4; ++m) { const int row = row0 + ai * HALF + m * 16; const float gt = gate[row] * scale;
#pragma unroll
                for (int bj = 0; bj < 2; ++bj) st16_wt(Y + (size_t)row * DM_ + col0 + bj * HALF, pack8(acc[ai][bj][m][0] * gt, acc[ai][bj][m][1] * gt)); }
    }
};

struct MoeOrder {
    int nM, nN, nwg, G, c, T, P0, npieces; int t1, t2, t3, t4, t5, t6, t7;
    static constexpr int SPL = 7, PKT = 4;
    __device__ __forceinline__ void init(const int* meta, int nN_, int G_, int c_, bool split) {
        T = meta[8]; nM = split ? meta[9] : T; nN = nN_; nwg = nM * nN; G = G_; c = c_; t1 = meta[1]; t2 = meta[2]; t3 = meta[3]; t4 = meta[4]; t5 = meta[5]; t6 = meta[6]; t7 = meta[7];
        P0 = ((nwg + G - 1) / G) * G; npieces = (T - nM) * nN * SPL; }
    __device__ __forceinline__ int expert_of(int pm) const { return (pm >= t1) + (pm >= t2) + (pm >= t3) + (pm >= t4) + (pm >= t5) + (pm >= t6) + (pm >= t7); }
    __device__ __forceinline__ bool next(int i, Unit& u) const {
        const long L = (long)i * G + c;
        if (L >= nwg) { const long q = L - P0; if (q < 0 || q >= npieces) return false;
            const int rt = (int)q / (nN * SPL), rem = (int)q % (nN * SPL), pnl = rem / SPL, kp = rem % SPL;
            u.pm = nM + rt; u.pn = expert_of(u.pm) * nN + pnl; u.kt0 = kp * PKT; u.nkt = PKT; u.aux = rt * SPL + kp; return true; }
        int wgid = (int)L; { const int q = nwg / NXCD, r = nwg % NXCD, xcd = wgid % NXCD, off = wgid / NXCD; wgid = (xcd < r ? xcd * (q + 1) : r * (q + 1) + (xcd - r) * q) + off; }
        const int nig = WGM * nN, gid = wgid / nig, fm = gid * WGM, gsz = (nM - fm) < WGM ? (nM - fm) : WGM;
        const int pm = fm + ((wgid % nig) % gsz), pnl = (wgid % nig) / gsz;
        u.pm = pm; u.pn = expert_of(pm) * nN + pnl; u.kt0 = 0; u.nkt = 0; u.aux = -1; return true;
    }
    __device__ __forceinline__ void a_ready(const Unit&) const {}
    __device__ __forceinline__ void done(const Unit&) const {}
};
template <class Epi, class Sched, bool ALIGN_EPI = false, bool SP2 = false, bool F8 = false>
__device__ __forceinline__ void gemm_phase(PG8_LAS unsigned char* lds, const Gemm g, const Sched& S, const Epi& E) {
    const int tid = threadIdx.x, wid = __builtin_amdgcn_readfirstlane(tid >> 6), lane = tid & 63, wr = wid >> 2, wc = wid & 3, fr = lane & 15, fq = lane >> 4;
    int K_ = g.K; asm volatile("" : "+s"(K_));
    const int K = K_, nt = K / BK;
    unsigned voffA[2], voffB[2];
#pragma unroll
    for (int i = 0; i < 2; ++i) { int R, C; stage_rc(tid * 16 + i * 8192, R, C); const int Rb = Epi::PERM ? ((R & ~31) + perm32(R & 31)) : R;
        voffA[i] = (unsigned)(R * K + C) * 2u; voffB[i] = (unsigned)(Rb * K + C) * 2u; }
    const size_t kstep = (size_t)(BK * 2);
    const size_t hstep = (size_t)HALF * K * 2;
    const size_t tstep = 2 * hstep;
    const unsigned ldsw = (unsigned)wid * 1024u;
    const int aoff = lds_byte(wr * 64 + fr, fq * 8), boff = lds_byte(wc * 32 + fr, fq * 8);
    constexpr int KSTEP = 1024;
#define PG8_SA(b, h) (((b) * 2 + (h)) * HTB)
#define PG8_SB(b, h) ((4 + (b) * 2 + (h)) * HTB)
#define PG8_STAGE(bufoff, gbase, voff) do { _Pragma("unroll") for (int _i = 0; _i < 2; ++_i) \
        __builtin_amdgcn_global_load_lds((const unsigned*)((const char*)(gbase) + (voff)[_i]), (PG8_LAS unsigned*)(lds + (bufoff) + ldsw + _i * 8192), 16, 0, 0); } while (0)
#define PG8_LDA(dst, b, h) do { _Pragma("unroll") for (int m = 0; m < 4; ++m) _Pragma("unroll") for (int k = 0; k < 2; ++k) dst[m][k] = *(const PG8_LAS bf16x8*)(lds + PG8_SA(b, h) + aoff + m * 2048 + k * KSTEP); } while (0)
#define PG8_LDB(dst, b, h) do { _Pragma("unroll") for (int n = 0; n < 2; ++n) _Pragma("unroll") for (int k = 0; k < 2; ++k) dst[n][k] = *(const PG8_LAS bf16x8*)(lds + PG8_SB(b, h) + boff + n * 2048 + k * KSTEP); } while (0)
#define PG8_CAT8(x) __builtin_shufflevector(__builtin_bit_cast(i32x4, (x)[0]), __builtin_bit_cast(i32x4, (x)[1]), 0, 1, 2, 3, 4, 5, 6, 7)
#define PG8_MMA(ai, bj, At, Bt) do { __builtin_amdgcn_s_setprio(1); _Pragma("unroll") for (int m = 0; m < 4; ++m) _Pragma("unroll") for (int n = 0; n < 2; ++n) { \
        if constexpr (F8) asm volatile("s_nop 1\n\tv_mfma_f32_16x16x128_f8f6f4 %0, %1, %2, %0" : "+v"(acc[ai][bj][m][n]) : "v"(PG8_CAT8(Bt[n])), "v"(PG8_CAT8(At[m]))); \
        else { _Pragma("unroll") for (int k = 0; k < 2; ++k) acc[ai][bj][m][n] = __builtin_amdgcn_mfma_f32_16x16x32_bf16(Bt[n][k], At[m][k], acc[ai][bj][m][n], 0, 0, 0); } } \
        __builtin_amdgcn_s_setprio(0); } while (0)
#define PG8_MMA0(ai, bj, At, Bt) do { __builtin_amdgcn_s_setprio(1); _Pragma("unroll") for (int m = 0; m < 4; ++m) _Pragma("unroll") for (int n = 0; n < 2; ++n) \
        asm volatile("s_nop 1\n\tv_mfma_f32_16x16x128_f8f6f4 %0, %1, %2, 0" : "=&v"(acc[ai][bj][m][n]) : "v"(PG8_CAT8(Bt[n])), "v"(PG8_CAT8(At[m]))); \
        __builtin_amdgcn_s_setprio(0); } while (0)
#define PG8_MMAF(ai, bj, At, Bt) do { if constexpr (F8) { if (t == 0) PG8_MMA0(ai, bj, At, Bt); else PG8_MMA(ai, bj, At, Bt); } else PG8_MMA(ai, bj, At, Bt); } while (0)
#define PG8_WAIT_V(n) asm volatile("s_waitcnt vmcnt(" #n ")" ::: "memory")
#define PG8_WAIT_L(n) asm volatile("s_waitcnt lgkmcnt(" #n ")" ::: "memory")
#define PG8_BAR __builtin_amdgcn_s_barrier()
#define PG8_SCHED __builtin_amdgcn_sched_barrier(0)
    Unit cur, nxt; int ui = 0;
    if (!S.next(0, cur)) return;
    f32x4 acc[2][2][4][2];
    if constexpr (!F8) {
#pragma unroll
    for (int a = 0; a < 2; ++a)
#pragma unroll
        for (int b = 0; b < 2; ++b)
#pragma unroll
            for (int m = 0; m < 4; ++m)
#pragma unroll
                for (int n = 0; n < 2; ++n) acc[a][b][m][n] = (f32x4){0.f, 0.f, 0.f, 0.f};
    }
    bf16x8 At[4][2], B0[2][2], B1[2][2];
    const char* cA = (const char*)g.A + (size_t)cur.pm * tstep + (size_t)cur.kt0 * kstep; const char* cB = (const char*)g.Bt + (size_t)cur.pn * tstep + (size_t)cur.kt0 * kstep;
    S.a_ready(cur);
    if constexpr (SP2) {
        PG8_STAGE(PG8_SB(0, 0), cB, voffB); PG8_STAGE(PG8_SB(0, 1), cB + hstep, voffB); PG8_STAGE(PG8_SA(0, 0), cA, voffA); PG8_STAGE(PG8_SA(0, 1), cA + hstep, voffA);
        if (wr == 1) PG8_BAR;
        PG8_WAIT_V(2); PG8_BAR;
        PG8_STAGE(PG8_SB(1, 0), cB + kstep, voffB); PG8_STAGE(PG8_SA(1, 0), cA + kstep, voffA); PG8_STAGE(PG8_SB(1, 1), cB + hstep + kstep, voffB);
        PG8_WAIT_V(6); PG8_BAR;
    } else {
        PG8_STAGE(PG8_SB(0, 0), cB, voffB); PG8_STAGE(PG8_SA(0, 0), cA, voffA); PG8_STAGE(PG8_SB(0, 1), cB + hstep, voffB); PG8_STAGE(PG8_SA(0, 1), cA + hstep, voffA);
        if (wr == 1) PG8_BAR;
        PG8_WAIT_V(4); PG8_BAR;
        PG8_STAGE(PG8_SB(1, 0), cB + kstep, voffB); PG8_STAGE(PG8_SA(1, 0), cA + kstep, voffA); PG8_STAGE(PG8_SB(1, 1), cB + hstep + kstep, voffB);
        PG8_WAIT_V(6); PG8_BAR;
    }
    for (;;) {
        const bool has_next = S.next(ui + 1, nxt);
        const char* nA = has_next ? (const char*)g.A + (size_t)nxt.pm * tstep + (size_t)nxt.kt0 * kstep : cA; const char* nB = has_next ? (const char*)g.Bt + (size_t)nxt.pn * tstep + (size_t)nxt.kt0 * kstep : cB;
        const int ntu = cur.nkt ? cur.nkt : nt;
        for (int t = 0; t < ntu; t += 2) {
            const bool last = (t == ntu - 2);
            const char* a1 = cA + (size_t)(t + 1) * kstep;
            const char* a2 = last ? nA : cA + (size_t)(t + 2) * kstep; const char* b2 = last ? nB : cB + (size_t)(t + 2) * kstep;
            const char* a3 = a2 + kstep; const char* b3 = b2 + kstep;
            if (last && has_next) S.a_ready(nxt);
            if constexpr (SP2) {
            PG8_LDB(B0, 0, 0); PG8_LDB(B1, 0, 1); PG8_SCHED; PG8_LDA(At, 0, 0); PG8_STAGE(PG8_SA(1, 1), a1 + hstep, voffA);
            PG8_WAIT_V(8); PG8_WAIT_L(0); PG8_BAR; PG8_MMAF(0, 0, At, B0); PG8_MMAF(0, 1, At, B1); PG8_BAR; PG8_SCHED;
            PG8_LDA(At, 0, 1); PG8_STAGE(PG8_SB(0, 0), b2, voffB); PG8_STAGE(PG8_SB(0, 1), b2 + hstep, voffB); PG8_STAGE(PG8_SA(0, 0), a2, voffA);
            PG8_WAIT_V(8); PG8_WAIT_L(0); PG8_BAR; PG8_MMAF(1, 0, At, B0); PG8_MMAF(1, 1, At, B1); PG8_BAR; PG8_SCHED;
            PG8_LDB(B0, 1, 0); PG8_LDB(B1, 1, 1); PG8_SCHED; PG8_LDA(At, 1, 0); PG8_STAGE(PG8_SA(0, 1), a2 + hstep, voffA);
            PG8_WAIT_V(8); PG8_WAIT_L(0); PG8_BAR; PG8_MMA(0, 0, At, B0); PG8_MMA(0, 1, At, B1); PG8_BAR; PG8_SCHED;
            PG8_LDA(At, 1, 1); PG8_STAGE(PG8_SB(1, 0), b3, voffB); PG8_STAGE(PG8_SB(1, 1), b3 + hstep, voffB); PG8_STAGE(PG8_SA(1, 0), a3, voffA);
            PG8_WAIT_V(8); PG8_WAIT_L(0); PG8_BAR; PG8_MMA(1, 0, At, B0); PG8_MMA(1, 1, At, B1); PG8_BAR; PG8_SCHED;
            } else {
            PG8_LDB(B0, 0, 0); PG8_SCHED; PG8_LDA(At, 0, 0); PG8_STAGE(PG8_SA(1, 1), a1 + hstep, voffA);
            PG8_WAIT_L(8); PG8_BAR; PG8_WAIT_L(0); PG8_MMAF(0, 0, At, B0); PG8_BAR; PG8_SCHED;
            PG8_LDB(B1, 0, 1); PG8_STAGE(PG8_SB(0, 0), b2, voffB);
            PG8_BAR; PG8_WAIT_L(0); PG8_MMAF(0, 1, At, B1); PG8_BAR;
            PG8_LDA(At, 0, 1); PG8_STAGE(PG8_SA(0, 0), a2, voffA);
            PG8_BAR; PG8_WAIT_L(0); PG8_MMAF(1, 0, At, B0); PG8_BAR; PG8_SCHED;
            PG8_STAGE(PG8_SB(0, 1), b2 + hstep, voffB);
            PG8_WAIT_V(6); PG8_BAR; PG8_MMAF(1, 1, At, B1); PG8_BAR;
            PG8_LDB(B0, 1, 0); PG8_SCHED; PG8_LDA(At, 1, 0); PG8_STAGE(PG8_SA(0, 1), a2 + hstep, voffA);
            PG8_WAIT_L(8); PG8_BAR; PG8_WAIT_L(0); PG8_MMA(0, 0, At, B0); PG8_BAR; PG8_SCHED;
            PG8_LDB(B1, 1, 1); PG8_STAGE(PG8_SB(1, 0), b3, voffB);
            PG8_BAR; PG8_WAIT_L(0); PG8_MMA(0, 1, At, B1); PG8_BAR;
            PG8_LDA(At, 1, 1); PG8_STAGE(PG8_SA(1, 0), a3, voffA);
            PG8_BAR; PG8_WAIT_L(0); PG8_MMA(1, 0, At, B0); PG8_BAR; PG8_SCHED;
            PG8_STAGE(PG8_SB(1, 1), b3 + hstep, voffB);
            PG8_WAIT_V(6); PG8_BAR; PG8_MMA(1, 1, At, B1); PG8_BAR;
            }
        }
        if constexpr (F8) asm volatile("s_nop 15\n\ts_nop 15" ::: "memory");
        if constexpr (ALIGN_EPI) { if (wr == 0) PG8_BAR; }
        if constexpr (!Epi::AFTER_DRAIN) { E(acc, cur, wr, wc, fr, fq); S.done(cur); }
        if (!has_next) break;
        if constexpr (!F8) {
#pragma unroll
        for (int a = 0; a < 2; ++a)
#pragma unroll
            for (int b = 0; b < 2; ++b)
#pragma unroll
                for (int m = 0; m < 4; ++m)
#pragma unroll
                    for (int n = 0; n < 2; ++n) acc[a][b][m][n] = (f32x4){0.f, 0.f, 0.f, 0.f};
        }
        cur = nxt; cA = nA; cB = nB; ++ui;
        if constexpr (ALIGN_EPI) { if (wr == 1) PG8_BAR; }
    }
    PG8_WAIT_V(0);
    if constexpr (!ALIGN_EPI) { if (wr == 0) PG8_BAR; }
    PG8_BAR;
    if constexpr (Epi::AFTER_DRAIN) { E.fused(acc, cur, wr, wc, fr, fq, lds, wid, lane); S.done(cur); }
#undef PG8_SA
#undef PG8_SB
#undef PG8_STAGE
#undef PG8_LDA
#undef PG8_LDB
#undef PG8_MMA
#undef PG8_MMA0
#undef PG8_MMAF
#undef PG8_CAT8
#undef PG8_WAIT_V
#undef PG8_WAIT_L
#undef PG8_BAR
#undef PG8_SCHED
}
}
#include <hip/hip_bf16.h>
#include <cmath>
namespace attn_body {
using bf16=__hip_bfloat16;
using bf16x8=__attribute__((ext_vector_type(8)))short;
using s16x4=__attribute__((ext_vector_type(4)))short;
using f32x16=__attribute__((ext_vector_type(16)))float;
using u32x4=__attribute__((ext_vector_type(4)))unsigned;
constexpr int BATCH=8,NHEAD=16,SEQ=2048,D=64,DM=NHEAD*D;
constexpr int NW=8,QBLK=32,QB=QBLK*NW,KVBLK=64,NQB=SEQ/QB;
constexpr int ATTN_PITCH=DM, ATTN_UNIT_ROWS=QB;
__device__ __forceinline__ int crow(int r,int hi){return (r&3)+8*(r>>2)+4*hi;}
#define SBAR() __builtin_amdgcn_sched_barrier(0)
__device__ __forceinline__ void cmask(f32x16&p0,f32x16&p1,int jb,int qrel,int hi){
  const float NEG=-INFINITY; int kb=64*jb+4*hi;
  #pragma unroll
  for(int r=0;r<16;++r){int kv=kb+(r&3)+8*(r>>2); if(kv>qrel)p0[r]=NEG; if(kv+32>qrel)p1[r]=NEG;}
}

constexpr int NSLOT=3, SLOTB=8192;
constexpr int LDS_K=0, LDS_V=NSLOT*SLOTB, LDS_WS=3*NSLOT*SLOTB, LDS_QS=LDS_WS+NW*64*4, LDS_OST=LDS_QS+NW*4096, LDS_BYTES=LDS_OST+NW*4096;
constexpr float C2=0.125f*1.4426950408889634f;
__device__ __forceinline__ void glds16(const void*gsrc,unsigned lds_dst){unsigned keep;
  asm volatile("s_mov_b32 %0, m0\n\ts_mov_b32 m0, %2\n\ts_nop 0\n\tglobal_load_lds_dwordx4 %1, off\n\ts_mov_b32 m0, %0":"=&s"(keep):"v"(gsrc),"s"(lds_dst):"memory");}
__device__ __forceinline__ float max3f(float a,float b,float c){float r;asm("v_max3_f32 %0, %1, %2, %3":"=v"(r):"v"(a),"v"(b),"v"(c));return r;}
__device__ __forceinline__ float max2f(float a,float b){float r;asm("v_max_f32_e32 %0, %1, %2":"=v"(r):"v"(a),"v"(b));return r;}
__device__ __forceinline__ float fadd_s(float a,float b){float r;asm("v_add_f32_e32 %0, %1, %2":"=v"(r):"v"(a),"v"(b));return r;}
__device__ __forceinline__ float fsub_s(float a,float b){float r;asm("v_sub_f32_e32 %0, %1, %2":"=v"(r):"v"(a),"v"(b));return r;}
typedef float f32x2_t __attribute__((ext_vector_type(2))); typedef __bf16 bf16x2_t __attribute__((ext_vector_type(2)));
__device__ __forceinline__ unsigned cvtpk_s(float lo,float hi){f32x2_t v={lo,hi};bf16x2_t b=__builtin_convertvector(v,bf16x2_t);return __builtin_bit_cast(unsigned,b);}
#define WAIT_BAR(N) asm volatile("s_waitcnt vmcnt(" #N ") lgkmcnt(0)\n\ts_barrier":::"memory")

__device__ __forceinline__ void qkt(f32x16&p0,f32x16&p1,const char*Kslot,const bf16x8*qr,int r32,int hi){ const f32x16 negm=f32x16{};
  const char*kb=Kslot+hi*1024+r32*16;
  #pragma unroll
  for(int d0=0;d0<4;++d0){
    const bf16x8 b0=*reinterpret_cast<const bf16x8*>(kb+d0*2048);
    const bf16x8 b1=*reinterpret_cast<const bf16x8*>(kb+d0*2048+512);
    if(d0==0){p0=__builtin_amdgcn_mfma_f32_32x32x16_bf16(b0,qr[0],negm,0,0,0);p1=__builtin_amdgcn_mfma_f32_32x32x16_bf16(b1,qr[0],negm,0,0,0);}
    else{p0=__builtin_amdgcn_mfma_f32_32x32x16_bf16(b0,qr[d0],p0,0,0,0);p1=__builtin_amdgcn_mfma_f32_32x32x16_bf16(b1,qr[d0],p1,0,0,0);}}
}
typedef __attribute__((address_space(3))) const char* lds_cptr;
typedef short v4i16_t __attribute__((ext_vector_type(4)));
__device__ __forceinline__ void kload8(bf16x8*kf,lds_cptr kp){
  kf[0]=*(const __attribute__((address_space(3))) bf16x8*)(kp);      kf[1]=*(const __attribute__((address_space(3))) bf16x8*)(kp+512);
  kf[2]=*(const __attribute__((address_space(3))) bf16x8*)(kp+2048); kf[3]=*(const __attribute__((address_space(3))) bf16x8*)(kp+2560);
  kf[4]=*(const __attribute__((address_space(3))) bf16x8*)(kp+4096); kf[5]=*(const __attribute__((address_space(3))) bf16x8*)(kp+4608);
  kf[6]=*(const __attribute__((address_space(3))) bf16x8*)(kp+6144); kf[7]=*(const __attribute__((address_space(3))) bf16x8*)(kp+6656);
}
__device__ __forceinline__ void kload2(bf16x8*kf,lds_cptr kp,int j){ kf[2*j]=*(const __attribute__((address_space(3))) bf16x8*)(kp+j*2048); kf[2*j+1]=*(const __attribute__((address_space(3))) bf16x8*)(kp+j*2048+512); }
__device__ __forceinline__ s16x4 vtr(lds_cptr p){ return __builtin_bit_cast(s16x4,__builtin_amdgcn_ds_read_tr16_b64_v4i16((__attribute__((address_space(3))) v4i16_t*)p)); }
__device__ __forceinline__ float rowmax(const f32x16&p0,const f32x16&p1){
  float a=max3f(p0[0],p0[1],p1[0]),b=max3f(p0[2],p0[3],p1[1]);a=max3f(a,p1[2],p1[3]);
  #pragma unroll
  for(int r=4;r<16;r+=4){a=max3f(a,p0[r],p0[r+1]);b=max3f(b,p0[r+2],p0[r+3]);a=max3f(a,p1[r],p1[r+1]);b=max3f(b,p1[r+2],p1[r+3]);}
  const float m=max2f(a,b);
  auto rr=__builtin_amdgcn_permlane32_swap(__float_as_uint(m),__float_as_uint(m),false,false);
  return max2f(__uint_as_float(rr[0]),__uint_as_float(rr[1]));
}
__device__ __forceinline__ void pv(f32x16*o,int vb,bf16x8 pa0,bf16x8 pa1,bf16x8 pa2,bf16x8 pa3){
  #pragma unroll
  for(int d0=0;d0<4;++d0){s16x4 lo[4],hi[4];
    #pragma unroll
    for(int ks=0;ks<4;++ks){
      asm volatile("ds_read_b64_tr_b16 %0,%1 offset:%c2":"=&v"(lo[ks]):"v"(vb),"i"(d0*4096+ks*1024):"memory");
      asm volatile("ds_read_b64_tr_b16 %0,%1 offset:%c2":"=&v"(hi[ks]):"v"(vb),"i"(d0*4096+ks*1024+512):"memory");}
    asm volatile("s_waitcnt lgkmcnt(0)":::"memory");SBAR();
    #define PK(k) (bf16x8){lo[k][0],lo[k][1],lo[k][2],lo[k][3],hi[k][0],hi[k][1],hi[k][2],hi[k][3]}
    o[d0]=__builtin_amdgcn_mfma_f32_32x32x16_bf16(pa0,PK(0),o[d0],0,0,0);
    o[d0]=__builtin_amdgcn_mfma_f32_32x32x16_bf16(pa1,PK(1),o[d0],0,0,0);
    o[d0]=__builtin_amdgcn_mfma_f32_32x32x16_bf16(pa2,PK(2),o[d0],0,0,0);
    o[d0]=__builtin_amdgcn_mfma_f32_32x32x16_bf16(pa3,PK(3),o[d0],0,0,0);
    #undef PK
  }
}

#ifndef ATTN_STORE16
#define ATTN_STORE16(p,v) pg8::st16_wt((void*)(p),(v))
#endif
template<int THRL,int MODE> __device__ __forceinline__ void attn_unit(int b,int qcol,int vcol,int qb,const bf16*Q,const bf16*__restrict__ K,const bf16*__restrict__ V,bf16*O,char*shm,bf16*ON,float lam,const float*subn){
  int tid_=threadIdx.x; asm volatile("":"+v"(tid_));
  const int tid=tid_,lane=tid&63,r32=lane&31,hi=lane>>5; const int wid=__builtin_amdgcn_readfirstlane(tid>>6);
  const long rowbase=(long)b*SEQ; const int q0=qb*QB;
  const bf16*Qw=Q+(rowbase+q0+wid*QBLK)*DM+qcol;
  const bf16*Kh=K+rowbase*DM+qcol,*Vh=V+rowbase*DM+vcol;
  const unsigned lds0=(unsigned)(uintptr_t)shm;
  float*wsf=(float*)(shm+LDS_WS)+wid*64;
  const bf16*ksrc=Kh+(long)lane*DM+wid*8;
  const bf16*vsrc=Vh+(long)(16*(wid&3)+(lane>>2))*DM+(wid>>2)*32+(lane&3)*8;
  const unsigned kdst=lds0+LDS_K+wid*1024, vdst=lds0+LDS_V+wid*1024;
  #define DMA_K(t,slot) glds16(ksrc+(long)(t)*KVBLK*DM,(unsigned)__builtin_amdgcn_readfirstlane(kdst+(slot)))
  #define DMA_V(t,slot) do{ glds16(vsrc+(long)(t)*KVBLK*DM,(unsigned)__builtin_amdgcn_readfirstlane(vdst+2*(slot))); glds16(vsrc+(long)(t)*KVBLK*DM+64,(unsigned)__builtin_amdgcn_readfirstlane(vdst+2*(slot)+8192)); }while(0)
  const int vb0=(int)(lds0+LDS_V)+((lane>>4)&1)*32+(lane&3)*8+(4*hi+((lane&15)>>2))*64;
  const char*Kbase=shm+LDS_K; bf16x8 kf[8];
  const lds_cptr shm3=(lds_cptr)shm; const lds_cptr kp0=shm3+LDS_K+hi*1024+r32*16; const lds_cptr vp0=shm3+LDS_V+((lane>>4)&1)*32+(lane&3)*8+(4*hi+((lane&15)>>2))*64;
  const int NT=(q0+QB)/KVBLK;
  DMA_K(0,0);DMA_V(0,0);DMA_K(1,SLOTB);
  bf16x8 qr[4];
  #pragma unroll
  for(int d0=0;d0<4;++d0)qr[d0]=*reinterpret_cast<const bf16x8*>(&Qw[(long)r32*DM+d0*16+hi*8]);
  float mhat=0.f,l_reg=0.f;f32x16 o[4];o[0]=f32x16{};o[1]=f32x16{};o[2]=f32x16{};o[3]=f32x16{};
  typedef __attribute__((address_space(3))) bf16x8* lds_q8; const lds_cptr qp0=shm3+LDS_QS+wid*4096+lane*16;
  #define QF(j) (*(const __attribute__((address_space(3))) bf16x8*)(qp0+(j)*1024))
  const int qrel=wid*QBLK+r32;
  #define CMASK(P0,P1,t) do{int jb_=(t)-(NT-4); if(jb_>=0)cmask(P0,P1,jb_,qrel,hi);}while(0)
  bool resc=false;
  #define START(P0,P1) do{ resc=false; if constexpr(THRL>=0){ const float rm=rowmax(P0,P1); \
    { const float dl=rm; mhat=fadd_s(mhat,dl); \
      _Pragma("unroll") for(int r=0;r<16;++r){P0[r]=fsub_s(P0[r],dl);P1[r]=fsub_s(P1[r],dl);} } } \
    _Pragma("unroll") for(int r=0;r<16;++r)P0[r]=__builtin_amdgcn_exp2f(P0[r]); }while(0)
  #define RESC() do{ if(resc){ asm volatile("s_waitcnt lgkmcnt(0)":::"memory"); \
      _Pragma("unroll") for(int d_=0;d_<4;++d_) _Pragma("unroll") for(int r=0;r<16;++r)o[d_][r]*=wsf[crow(r,hi)]; } }while(0)
  f32x16 pA0,pA1,pB0,pB1;
  int sl_prev=0,sl_cur=0,sl_next=SLOTB;
  #define ROT() do{sl_prev=sl_cur;sl_cur=sl_next;sl_next=(sl_next==(NSLOT-1)*SLOTB)?0:sl_next+SLOTB;}while(0)
  DMA_K(2,2*SLOTB);
  _Pragma("unroll") for(int d0=0;d0<4;++d0)*(__attribute__((address_space(3))) bf16x8*)(__attribute__((address_space(3))) char*)(qp0+d0*1024)=qr[d0];
  WAIT_BAR(4);
  qkt(pA0,pA1,Kbase,qr,r32,hi);asm volatile("s_nop 15\n\ts_nop 7":"+v"(pA0),"+v"(pA1));CMASK(pA0,pA1,0);
  START(pA0,pA1);
  _Pragma("unroll") for(int r=0;r<16;++r)pA1[r]=__builtin_amdgcn_exp2f(pA1[r]);
  WAIT_BAR(0);
  DMA_K(3,0);DMA_V(1,SLOTB);
  ROT();
  kload8(kf,kp0+sl_cur);
  bf16x8 qa=QF(0),qb_=QF(1);
  WAIT_BAR(3);
  s16x4 vlo[8],vhi[8]; u32x4 pw0,pw1,pw2,pw3;
  #define PKW(P,B) cvtpk_s(P[B],P[B+1])
  #define PAF(k) __builtin_bit_cast(bf16x8,pw##k)
  #define VFR(i) (bf16x8){vlo[i][0],vlo[i][1],vlo[i][2],vlo[i][3],vhi[i][0],vhi[i][1],vhi[i][2],vhi[i][3]}
  #define PIN(x) asm volatile("":"+v"(x))
  #define MX3(a,b,c) __builtin_fmaxf(__builtin_fmaxf((a),(b)),(c))
  #define GAPA(MF,A0,A1,A2,A3,W0,W1,PW) do{ MF; sacc+=A0; sacc+=A1; sacc+=A2; sacc+=A3; PIN(sacc); W0; W1; PIN(PW); SBAR(); }while(0)
  #define EX(v) __builtin_amdgcn_exp2f(v)
  #define GAPB(MF,X,B) do{ MF; X[B]=EX(X[B]); X[B+1]=EX(X[B+1]); PIN(X); SBAR(); }while(0)
  #define VRD(i) do{ vlo[i]=vtr(vp_+(((i)>>2)*4096+((i)&3)*1024)); vhi[i]=vtr(vp_+(((i)>>2)*4096+((i)&3)*1024+512)); }while(0)
  #define VRDX(reg,fr) do{ vlo[reg]=vtr(vp_+(((fr)>>2)*4096+((fr)&3)*1024)); vhi[reg]=vtr(vp_+(((fr)>>2)*4096+((fr)&3)*1024+512)); SBAR(); }while(0)
  #define KRD(G,j) do{ if(G){ kload2(kf,kp0+sl_next,j); SBAR(); } }while(0)
  #define ZC f32x16{}
  #define STEP(C0,C1,P0,P1,t,GK,GV,GL) do{ SBAR(); \
    const lds_cptr vp_=vp0+2*sl_prev; \
    VRD(0); SBAR(); float sacc=(P0[0]+P0[1]); \
    GAPA(C0=__builtin_amdgcn_mfma_f32_32x32x16_bf16(kf[0],qa,ZC,0,0,0), P0[2],P0[3],P0[4],P0[5],     pw0[0]=PKW(P0,0), pw0[1]=PKW(P0,2), pw0); \
    VRD(4); SBAR(); GAPA(C1=__builtin_amdgcn_mfma_f32_32x32x16_bf16(kf[1],qa,ZC,0,0,0), P0[6],P0[7],P0[8],P0[9],     pw0[2]=PKW(P0,4), pw0[3]=PKW(P0,6), pw0); \
    qa=QF(2); SBAR(); \
    VRD(1); SBAR(); GAPA(C0=__builtin_amdgcn_mfma_f32_32x32x16_bf16(kf[2],qb_,C0,0,0,0),   P0[10],P0[11],P0[12],P0[13], pw1[0]=PKW(P0,8), pw1[1]=PKW(P0,10), pw1); \
    VRD(5); SBAR(); GAPA(C1=__builtin_amdgcn_mfma_f32_32x32x16_bf16(kf[3],qb_,C1,0,0,0),   P0[14],P0[15],P1[0],P1[1],   pw1[2]=PKW(P0,12),pw1[3]=PKW(P0,14), pw1); \
    qb_=QF(3); SBAR(); \
    VRD(2); SBAR(); GAPA(C0=__builtin_amdgcn_mfma_f32_32x32x16_bf16(kf[4],qa,C0,0,0,0),   P1[2],P1[3],P1[4],P1[5],     pw2[0]=PKW(P1,0), pw2[1]=PKW(P1,2), pw2); \
    VRD(6); SBAR(); GAPA(C1=__builtin_amdgcn_mfma_f32_32x32x16_bf16(kf[5],qa,C1,0,0,0),   P1[6],P1[7],P1[8],P1[9],     pw2[2]=PKW(P1,4), pw2[3]=PKW(P1,6), pw2); \
    VRD(3); SBAR(); GAPA(C0=__builtin_amdgcn_mfma_f32_32x32x16_bf16(kf[6],qb_,C0,0,0,0),   P1[10],P1[11],P1[12],P1[13], pw3[0]=PKW(P1,8), pw3[1]=PKW(P1,10), pw3); \
    VRD(7); SBAR(); GAPA(C1=__builtin_amdgcn_mfma_f32_32x32x16_bf16(kf[7],qb_,C1,0,0,0),   P1[14],P1[15],0.f,0.f,       pw3[2]=PKW(P1,12),pw3[3]=PKW(P1,14), pw3); \
    l_reg+=sacc; \
    if(GK){DMA_K((t)+3,sl_cur);} if(GV){DMA_V((t)+1,sl_next);} \
    CMASK(C0,C1,t); \
    if constexpr(THRL>=0){ float a=MX3(C0[0],C0[1],C1[0]),b=MX3(C0[2],C0[3],C1[1]); a=MX3(a,C1[2],C1[3]); \
      _Pragma("unroll") for(int r=4;r<16;r+=4){a=MX3(a,C0[r],C0[r+1]);b=MX3(b,C0[r+2],C0[r+3]);a=MX3(a,C1[r],C1[r+1]);b=MX3(b,C1[r+2],C1[r+3]);} \
      float rm=__builtin_fmaxf(a,b); { auto rr=__builtin_amdgcn_permlane32_swap(__float_as_uint(rm),__float_as_uint(rm),false,false); rm=__builtin_fmaxf(__uint_as_float(rr[0]),__uint_as_float(rr[1])); } \
      rm-=mhat; resc=false;                                      \
      if(__builtin_expect(__any(rm>(float)THRL),0)){ const float dl=__builtin_fmaxf(rm,0.f); mhat+=dl; \
        const float f=__builtin_amdgcn_exp2f(-dl); l_reg*=f; if(hi==0)wsf[r32]=f; resc=true; } \
      _Pragma("unroll") for(int r=0;r<16;++r){C0[r]-=mhat;C1[r]-=mhat;} } \
    SBAR(); \
    GAPB(o[0]=__builtin_amdgcn_mfma_f32_32x32x16_bf16(PAF(0),VFR(0),o[0],0,0,0), C0,0);  VRDX(0,8); \
    GAPB(o[1]=__builtin_amdgcn_mfma_f32_32x32x16_bf16(PAF(0),VFR(4),o[1],0,0,0), C0,2);  VRDX(4,12); \
    GAPB(o[0]=__builtin_amdgcn_mfma_f32_32x32x16_bf16(PAF(1),VFR(1),o[0],0,0,0), C0,4);  VRDX(1,9); \
    GAPB(o[1]=__builtin_amdgcn_mfma_f32_32x32x16_bf16(PAF(1),VFR(5),o[1],0,0,0), C0,6);  VRDX(5,13); \
    GAPB(o[0]=__builtin_amdgcn_mfma_f32_32x32x16_bf16(PAF(2),VFR(2),o[0],0,0,0), C0,8);  VRDX(2,10); \
    GAPB(o[1]=__builtin_amdgcn_mfma_f32_32x32x16_bf16(PAF(2),VFR(6),o[1],0,0,0), C0,10); VRDX(6,14); \
    GAPB(o[0]=__builtin_amdgcn_mfma_f32_32x32x16_bf16(PAF(3),VFR(3),o[0],0,0,0), C0,12); VRDX(3,11); \
    GAPB(o[1]=__builtin_amdgcn_mfma_f32_32x32x16_bf16(PAF(3),VFR(7),o[1],0,0,0), C0,14); VRDX(7,15); \
    KRD(GL,0); GAPB(o[2]=__builtin_amdgcn_mfma_f32_32x32x16_bf16(PAF(0),VFR(0),o[2],0,0,0), C1,0); \
    KRD(GL,1); GAPB(o[3]=__builtin_amdgcn_mfma_f32_32x32x16_bf16(PAF(0),VFR(4),o[3],0,0,0), C1,2); \
    KRD(GL,2); GAPB(o[2]=__builtin_amdgcn_mfma_f32_32x32x16_bf16(PAF(1),VFR(1),o[2],0,0,0), C1,4); \
    KRD(GL,3); GAPB(o[3]=__builtin_amdgcn_mfma_f32_32x32x16_bf16(PAF(1),VFR(5),o[3],0,0,0), C1,6); \
    GAPB(o[2]=__builtin_amdgcn_mfma_f32_32x32x16_bf16(PAF(2),VFR(2),o[2],0,0,0), C1,8); \
    GAPB(o[3]=__builtin_amdgcn_mfma_f32_32x32x16_bf16(PAF(2),VFR(6),o[3],0,0,0), C1,10); \
    qa=QF(0); SBAR(); \
    GAPB(o[2]=__builtin_amdgcn_mfma_f32_32x32x16_bf16(PAF(3),VFR(3),o[2],0,0,0), C1,12); \
    qb_=QF(1); SBAR(); \
    GAPB(o[3]=__builtin_amdgcn_mfma_f32_32x32x16_bf16(PAF(3),VFR(7),o[3],0,0,0), C1,14); \
    }while(0)
  int t=1;
  #undef CMASK
  #define CMASK(P0,P1,t) do{}while(0)
  for(;t+5<NT;t+=2){
    STEP(pB0,pB1,pA0,pA1,t,true,true,true);     WAIT_BAR(3); RESC(); ROT();
    STEP(pA0,pA1,pB0,pB1,t+1,true,true,true);   WAIT_BAR(3); RESC(); ROT();
  }
  #undef CMASK
  #define CMASK(P0,P1,t) do{int jb_=(t)-(NT-4); if(jb_>=0)cmask(P0,P1,jb_,qrel,hi);}while(0)
  #define ENDW(tt) do{ if((tt)+3<NT){WAIT_BAR(3);} else if((tt)+2<NT){WAIT_BAR(2);} else {WAIT_BAR(0);} }while(0)
  for(;t+1<NT;t+=2){
    STEP(pB0,pB1,pA0,pA1,t,(t+3<NT),(t+1<NT),(t+1<NT));       ENDW(t);   RESC(); ROT();
    STEP(pA0,pA1,pB0,pB1,t+1,(t+4<NT),(t+2<NT),(t+2<NT));     ENDW(t+1); RESC(); ROT();
  }
  STEP(pB0,pB1,pA0,pA1,NT-1,false,false,false); RESC();
  { float sacc=pB0[0]+pB0[1]; _Pragma("unroll") for(int r=2;r<16;++r)sacc+=pB0[r]; _Pragma("unroll") for(int r=0;r<16;++r)sacc+=pB1[r]; l_reg+=sacc;
    pw0=(u32x4){PKW(pB0,0),PKW(pB0,2),PKW(pB0,4),PKW(pB0,6)};pw1=(u32x4){PKW(pB0,8),PKW(pB0,10),PKW(pB0,12),PKW(pB0,14)};pw2=(u32x4){PKW(pB1,0),PKW(pB1,2),PKW(pB1,4),PKW(pB1,6)};pw3=(u32x4){PKW(pB1,8),PKW(pB1,10),PKW(pB1,12),PKW(pB1,14)};
    SBAR(); pv(o,vb0+2*sl_cur,PAF(0),PAF(1),PAF(2),PAF(3)); }
  #undef PKW
  #undef PAF
  #undef VFR
  #undef PIN
  #undef MX3
  #undef GAPA
  #undef GAPB
  #undef EX
  #undef VRD
  #undef VRDX
  #undef ZC
  #undef QF
  #undef KRD
  #undef STEP
  #undef ENDW
  {auto rr=__builtin_amdgcn_permlane32_swap(__float_as_uint(l_reg),__float_as_uint(l_reg),false,false);l_reg=__uint_as_float(rr[0])+__uint_as_float(rr[1]);}
  if(hi==0)wsf[32+r32]=l_reg;asm volatile("s_waitcnt lgkmcnt(0)":::"memory");
  float rli[16];
  #pragma unroll
  for(int r=0;r<16;++r)rli[r]=__builtin_amdgcn_rcpf(wsf[32+crow(r,hi)]);
  bf16*Ow=O+(rowbase+q0+wid*QBLK)*DM+vcol;
  if constexpr(MODE==0){ bf16*stg=(bf16*)(shm+LDS_OST)+wid*2048;
    #pragma unroll
    for(int hf=0;hf<2;++hf){
      #pragma unroll
      for(int r=0;r<16;++r){const int orow=crow(r,hi);
        #pragma unroll
        for(int d0=0;d0<2;++d0)stg[orow*64+d0*32+r32]=__float2bfloat16(o[2*hf+d0][r]*rli[r]);}
      asm volatile("s_waitcnt lgkmcnt(0)":::"memory");
      #pragma unroll
      for(int i=0;i<4;++i){const int row=i*8+(lane>>3),ch=lane&7; const u32x4 v=*(const u32x4*)(stg+row*64+ch*8); ATTN_STORE16(Ow+(long)row*DM+hf*64+ch*8,v);}
      asm volatile("s_waitcnt lgkmcnt(0)":::"memory"); } }
  else { bf16*stg0=(bf16*)(shm+LDS_OST)+wid*2048,*stg1=(bf16*)(shm+LDS_QS)+wid*2048;
    #pragma unroll
    for(int r=0;r<16;++r){const int orow=crow(r,hi);
      #pragma unroll
      for(int d0=0;d0<2;++d0){stg0[orow*64+d0*32+r32]=__float2bfloat16(o[d0][r]*rli[r]);stg1[orow*64+d0*32+r32]=__float2bfloat16(o[2+d0][r]*rli[r]);}}
    asm volatile("s_waitcnt vmcnt(0) lgkmcnt(0)":::"memory");
    const int ch=lane&7; float g0[8],g1[8];
    #pragma unroll
    for(int j=0;j<8;++j){g0[j]=subn[ch*8+j];g1[j]=subn[64+ch*8+j];}
    bf16*ONw=ON+(rowbase+q0+wid*QBLK)*DM+vcol;
    #pragma unroll
    for(int i=0;i<4;++i){const int row=i*8+(lane>>3);
      const u32x4 a0=*(const u32x4*)(stg0+row*64+ch*8),a1=*(const u32x4*)(stg1+row*64+ch*8);
      const u32x4 b0=*(const u32x4*)(Ow+(long)row*DM+ch*8),b1=*(const u32x4*)(Ow+(long)row*DM+64+ch*8);
      float d[16];
      #pragma unroll
      for(int j=0;j<4;++j){
        d[2*j]  =__uint_as_float(b0[j]<<16)        -lam*__uint_as_float(a0[j]<<16);
        d[2*j+1]=__uint_as_float(b0[j]&0xffff0000u)-lam*__uint_as_float(a0[j]&0xffff0000u);
        d[8+2*j]  =__uint_as_float(b1[j]<<16)        -lam*__uint_as_float(a1[j]<<16);
        d[8+2*j+1]=__uint_as_float(b1[j]&0xffff0000u)-lam*__uint_as_float(a1[j]&0xffff0000u);}
      float ss=0.f;
      #pragma unroll
      for(int j=0;j<16;++j)ss+=d[j]*d[j];
      ss+=__shfl_xor(ss,1);ss+=__shfl_xor(ss,2);ss+=__shfl_xor(ss,4);
      const float rs=__builtin_amdgcn_rsqf(ss*(1.0f/128.0f)+1e-6f);
      u32x4 w0,w1;
      #pragma unroll
      for(int j=0;j<4;++j){w0[j]=cvtpk_s(d[2*j]*rs*g0[2*j],d[2*j+1]*rs*g0[2*j+1]);w1[j]=cvtpk_s(d[8+2*j]*rs*g1[2*j],d[8+2*j+1]*rs*g1[2*j+1]);}
      ATTN_STORE16(ONw+(long)row*DM+ch*8,w0);ATTN_STORE16(ONw+(long)row*DM+64+ch*8,w1);}
    asm volatile("s_waitcnt lgkmcnt(0)":::"memory"); }
  asm volatile("s_waitcnt lgkmcnt(0)\n\ts_barrier":::"memory");
  #undef DMA_K
  #undef DMA_V
  #undef CMASK
  #undef START
  #undef RESC
  #undef ROT
}
constexpr int ATTN_LDS_BYTES=LDS_BYTES;
#undef SBAR
#undef WAIT_BAR
}
constexpr int NWAVES = 8;
constexpr int NPH = 15;
constexpr size_t MiB = 1u << 20;
constexpr size_t WS_CTL = 0, CTL_ZERO_BYTES = 1 * MiB;
constexpr size_t WS_W_IN = 1 * MiB;
constexpr size_t WS_W_OUT = WS_W_IN + (size_t)3072 * 1024 * 2;
constexpr size_t WS_W_GU = WS_W_OUT + (size_t)1024 * 1024 * 2;
constexpr size_t WS_W_DN = WS_W_GU + (size_t)5632 * 1024 * 2;
constexpr size_t WS_W_QKV = WS_W_DN + (size_t)1024 * 2816 * 2;
constexpr size_t WS_W_O = WS_W_QKV + (size_t)3072 * 1024 * 2;
constexpr size_t WS_W_MGU = WS_W_O + (size_t)1024 * 1024 * 2;
constexpr size_t WS_W_MDN = WS_W_MGU + (size_t)8 * 7168 * 1024 * 2;
constexpr size_t WS_W_END = WS_W_MDN + (size_t)8 * 1024 * 3584 * 2;
constexpr size_t WS_R = 202 * MiB;
constexpr size_t ACT = (size_t)M * D * 2;
constexpr size_t WS_XN0 = WS_R, WS_BB = WS_R + ACT, WS_UB = WS_R + 2 * ACT, WS_G = WS_R + 3 * ACT;
constexpr size_t WS_HACT = WS_R;
constexpr size_t WS_Q = WS_R + 4 * ACT, WS_K = WS_R + 5 * ACT, WS_V = WS_R + 6 * ACT;
constexpr size_t WS_X8 = WS_R + 5 * ACT;
constexpr size_t WS_O0 = WS_R, WS_O1 = WS_R + ACT, WS_ON = WS_R + 2 * ACT;
constexpr size_t WS_HM = WS_R;
constexpr size_t WS_PP = WS_R + 128 * MiB;
constexpr size_t WS_S = 440 * MiB;
constexpr size_t WS_XG = WS_S, WS_Y = WS_S + 68 * MiB;
constexpr size_t WS_XB = 632 * MiB;
constexpr size_t WS_HB = 664 * MiB, WS_HB2 = 696 * MiB, WS_YF = 728 * MiB;
constexpr size_t WS_SMALL = 792 * MiB;
constexpr size_t WS_SSQ = WS_SMALL;
constexpr size_t WS_SEL = WS_SMALL + 256 * 1024, WS_GATE = WS_SEL + 128 * 1024, WS_TOKSLOT = WS_GATE + 128 * 1024;
constexpr size_t WS_RSTDS = WS_TOKSLOT + 128 * 1024, WS_GATES = WS_RSTDS + 256 * 1024;
constexpr size_t WS_HIST = WS_GATES + 256 * 1024, WS_META = WS_HIST + 16 * 1024;
constexpr size_t WS_NAIVE_SMALL = WS_SMALL + 2 * MiB;
constexpr size_t WS_END = 796 * MiB;
static_assert(WS_W_END <= WS_R && WS_R + (size_t)SLOTS * DFE * 2 <= WS_S && WS_Y + (size_t)SLOTS * D * 2 <= WS_XB && WS_V + ACT <= WS_S, "d_ws map");
constexpr int CW_TMO = 0, CW_CODE = 1, CW_BAR = 4096;
constexpr int MISC_OFF = 0, RING_OFF = 1024, RING_BYTES = 131072, LDS_BYTES = 147456;
constexpr int P0_SCR = 16640;

#define GAS __attribute__((address_space(1)))
#define LAS __attribute__((address_space(3)))
typedef unsigned v4u __attribute__((ext_vector_type(4)));
typedef unsigned v2u __attribute__((ext_vector_type(2)));
typedef GAS unsigned gu32;
#define RLX_AGENT __ATOMIC_RELAXED, __HIP_MEMORY_SCOPE_AGENT
#define LDS_WAIT() asm volatile("s_waitcnt lgkmcnt(0)" ::: "memory")
#define VM_WAIT() asm volatile("s_waitcnt vmcnt(0)" ::: "memory")
__device__ __forceinline__ unsigned pk2(float lo, float hi) { return f2bf(lo) | (f2bf(hi) << 16); }
__device__ __forceinline__ float bflo(unsigned w) { return __builtin_bit_cast(float, w << 16); }
__device__ __forceinline__ float bfhi(unsigned w) { return __builtin_bit_cast(float, w & 0xffff0000u); }

#define XB_TMO      128
#define XB_XCNT(j)  (256  + 64 * (j))
#define XB_XSUB(j)  (1280 + 64 * (j))
#define XB_XGEN(j)  (2304 + 64 * (j))
#define XB_TOP      3328
#define XB_TOPGEN   3392
#define XCD_BAR_WORDS 3456
#define XB_SPIN_CAP (1u << 18)

__device__ __forceinline__ unsigned xb_ld(unsigned* p)              { return __hip_atomic_load(p, __ATOMIC_RELAXED, __HIP_MEMORY_SCOPE_AGENT); }
__device__ __forceinline__ unsigned xb_add(unsigned* p, unsigned v) { return __hip_atomic_fetch_add(p, v, __ATOMIC_RELAXED, __HIP_MEMORY_SCOPE_AGENT); }
__device__ __forceinline__ unsigned xb_xcc_id() { return (unsigned)__builtin_amdgcn_s_getreg((3 << 11) | 20) & 0xFu; }
#define XB_SPIN(cond, bar) do { unsigned _sp = 0; while (cond) { __builtin_amdgcn_s_sleep(1); \
    if ((++_sp & 255u) == 0u) { if (xb_ld(&(bar)[XB_TMO])) break; if (_sp > XB_SPIN_CAP) { atomicAdd(&(bar)[XB_TMO], 1u); break; } } } } while (0)

struct XcdBarrier {
    unsigned* bar; unsigned x;
    volatile LAS unsigned* st;
};

__device__ __forceinline__ XcdBarrier xcd_barrier_post(unsigned* bar, volatile LAS unsigned* st) {
    XcdBarrier b; b.bar = bar; b.x = xb_xcc_id(); b.st = st;
    if (threadIdx.x == 0) (void)xb_add(&bar[XB_XCNT(b.x)], 1u);
    return b;
}
__device__ __forceinline__ void xcd_barrier_complete(unsigned* bar, unsigned x, unsigned& nloc, unsigned& nx) {
    const unsigned G = gridDim.x * gridDim.y * gridDim.z;
    unsigned sum, cnt, mine, sp = 0u;
    for (;;) {
        sum = 0u; cnt = 0u; mine = 0u;
#pragma unroll
        for (unsigned j = 0; j < 16; ++j) { const unsigned c = xb_ld(&bar[XB_XCNT(j)]); sum += c; cnt += (c > 0u) ? 1u : 0u; mine = (j == x) ? c : mine; }
        if (sum == G) break;
        __builtin_amdgcn_s_sleep(1);
        if ((++sp & 255u) == 0u) { if (xb_ld(&bar[XB_TMO])) break; if (sp > XB_SPIN_CAP) { atomicAdd(&bar[XB_TMO], 1u); break; } }
    }
    nloc = mine > 0u ? mine : 1u; nx = cnt > 0u ? cnt : 1u;
}

__device__ __forceinline__ void xcd_barrier(const XcdBarrier& b) {
    asm volatile("s_waitcnt vmcnt(0)" ::: "memory");
    __syncthreads();
    if (threadIdx.x == 0) {
        unsigned* bar = b.bar;
        __builtin_amdgcn_s_waitcnt(0);
        unsigned nloc = b.st[0], nx = b.st[1];
        if (nloc == 0u) { xcd_barrier_complete(bar, b.x, nloc, nx); b.st[0] = nloc; b.st[1] = nx; }
        const unsigned old = xb_add(&bar[XB_XSUB(b.x)], 1u);
        const unsigned gen = old / nloc;
        if (old + 1u == (gen + 1u) * nloc) {
            __builtin_amdgcn_fence(__ATOMIC_RELEASE, "agent");
            asm volatile("s_waitcnt vmcnt(0)" ::: "memory");
            const unsigned og = xb_add(&bar[XB_TOP], 1u);
            const unsigned tg = og / nx;
            if (og + 1u == (tg + 1u) * nx) xb_add(&bar[XB_TOPGEN], 1u);
            else XB_SPIN(xb_ld(&bar[XB_TOPGEN]) == tg, bar);
            __builtin_amdgcn_fence(__ATOMIC_ACQUIRE, "agent");
            xb_add(&bar[XB_XGEN(b.x)], 1u);
            asm volatile("s_waitcnt vmcnt(0)" ::: "memory");
        } else {
            XB_SPIN(xb_ld(&bar[XB_XGEN(b.x)]) == gen, bar);
            __builtin_amdgcn_fence(__ATOMIC_ACQUIRE, "agent");
            asm volatile("s_waitcnt vmcnt(0)" ::: "memory");
        }
    }
    __syncthreads();
}


struct Args { const float* in[19]; float* out; unsigned char* wsp; int ph_lo, ph_hi, li, jobmask; };
struct Frame { LAS unsigned char* lds; int tid, lane, wave, vcu, G; };
#define KA ((const Args*)__builtin_amdgcn_kernarg_segment_ptr())
#define INP(i) (KA->in[i])
#define A_WS (KA->wsp)
#define A_OUT (KA->out)

__device__ __forceinline__ int p0_dstrow(int mode, int aux, int col) {
    if (mode == 1) { if (col < 1024) return col; const int v = col >= 2048, cc = col - (v ? 2048 : 1024); return 1024 + 256 * (cc >> 7) + 128 * v + (cc & 127); }
    if (mode == 2) { const int up = col >= aux, cc = col - (up ? aux : 0); return 256 * (cc >> 7) + 128 * up + (cc & 127); }
    if (mode == 3) { const int g = col >> 6, bj = (col >> 5) & 1; return 256 * (g >> 2) + 32 * (4 * bj + (g & 3)) + (col & 31); }
    return col;
}
struct P0Item { const float* src; const float* gain; unsigned char* dst; int ldw, K, k0, d0, d1, f8; float sc; };
#define P0_JOB(SRC, LDW, KK, C0, NCOLS, GAIN, DSTOFF, DROW0, DSTROWS, MODE, AUX, NMAT, SC, F8) { \
    constexpr int nn_ = (NCOLS) / 64, per_ = ((KK) / 64) * nn_, cnt_ = per_ * (NMAT); \
    if (it < cnt_) { const int mat = it / per_, r = it % per_, kb = r / nn_, col = 64 * (r % nn_); \
        I.src = (SRC) + (size_t)mat * (KK) * (LDW) + (C0) + col; I.gain = (GAIN); I.dst = A_WS + (DSTOFF) + (size_t)mat * (DSTROWS) * (KK) * ((F8) ? 1 : 2); \
        I.ldw = (LDW); I.K = (KK); I.k0 = 64 * kb; I.d0 = (DROW0) + p0_dstrow(MODE, AUX, col); I.d1 = (DROW0) + p0_dstrow(MODE, AUX, col + 32); I.f8 = (F8); I.sc = (SC); return; } \
    it -= cnt_; }
constexpr int P0_NITEMS = 16 * 48 + 16 * 16 + 16 * 88 + 44 * 16 + 3 * 16 * 16 + 16 * 16 + 8 * 16 * 112 + 8 * 56 * 16;
__device__ __forceinline__ void p0_decode(int it, P0Item& I) {
    P0_JOB(INP(3), 3072, 1024, 0, 3072, nullptr, WS_W_IN, 0, 3072, 1, 0, 1, 1.0f, 0)
    P0_JOB(INP(5), 1024, 1024, 0, 1024, nullptr, WS_W_OUT, 0, 1024, 0, 0, 1, 1.0f, 0)
    P0_JOB(INP(14), 5632, 1024, 0, 5632, INP(2), WS_W_GU, 0, 5632, 2, 2816, 1, pg8::F8_SWGD, 1)
    P0_JOB(INP(15), 1024, 2816, 0, 1024, nullptr, WS_W_DN, 0, 1024, 0, 0, 1, pg8::F8_SWDD, 1)
    P0_JOB(INP(9), 1024, 1024, 0, 1024, INP(1) + 1024, WS_W_QKV, 0, 3072, 3, 0, 1, 1.0f, 0)
    P0_JOB(INP(7), 2048, 1024, 0, 1024, INP(6), WS_W_QKV, 1024, 3072, 3, 0, 1, 1.0f, 0)
    P0_JOB(INP(7), 2048, 1024, 1024, 1024, INP(6), WS_W_QKV, 2048, 3072, 0, 0, 1, 1.0f, 0)
    P0_JOB(INP(13), 1024, 1024, 0, 1024, nullptr, WS_W_O, 0, 1024, 0, 0, 1, 1.0f, 0)
    P0_JOB(INP(17), 7168, 1024, 0, 7168, INP(2) + 1024, WS_W_MGU, 0, 7168, 2, 3584, 8, pg8::F8_SWG, 1)
    P0_JOB(INP(18), 1024, 3584, 0, 1024, nullptr, WS_W_MDN, 0, 1024, 0, 0, 8, pg8::F8_SWD, 1)
}
#undef P0_JOB
struct P0Regs { f32x4 v[16]; float g[16]; };
__device__ __forceinline__ void p0_load(const P0Item& I, P0Regs& R, int lane) {
    const int lr = lane >> 4, lc = lane & 15;
#pragma unroll
    for (int i = 0; i < 16; ++i) R.v[i] = *(const GAS f32x4*)(I.src + (size_t)(I.k0 + 4 * i + lr) * I.ldw + 4 * lc);
    if (I.gain) {
#pragma unroll
        for (int i = 0; i < 16; ++i) R.g[i] = I.gain[I.k0 + 4 * i + lr];
    } else {
#pragma unroll
        for (int i = 0; i < 16; ++i) R.g[i] = 1.0f;
    }
}
__device__ __forceinline__ void p0_store(const P0Item& I, const P0Regs& R, LAS float* scr, int lane) {
    const int lr = lane >> 4, lc = lane & 15;
#pragma unroll
    for (int i = 0; i < 16; ++i) { const f32x4 w = R.v[i] * (R.g[i] * I.sc); LAS float* p = scr + (4 * i + lr) * 65 + 4 * lc; p[0] = w[0]; p[1] = w[1]; p[2] = w[2]; p[3] = w[3]; }
    LDS_WAIT(); asm volatile("" ::: "memory");
    const int c = lane & 7;
#pragma unroll
    for (int jj = 0; jj < 8; ++jj) { const int nl = 8 * jj + (lane >> 3); const LAS float* s = scr + (8 * c) * 65 + nl;
        const int drow = (jj < 4 ? I.d0 : I.d1 - 32) + nl;
        if (I.f8) { v2u o; o.x = pg8::pk4_fp8(s[0], s[65], s[130], s[195]); o.y = pg8::pk4_fp8(s[260], s[325], s[390], s[455]);
            pg8::st8_wt(I.dst + (size_t)drow * I.K + I.k0 + 8 * c, o.x, o.y); }
        else { v4u o; o.x = pk2(s[0], s[65]); o.y = pk2(s[130], s[195]); o.z = pk2(s[260], s[325]); o.w = pk2(s[390], s[455]);
            pg8::st16_wt(I.dst + ((size_t)drow * I.K + I.k0 + 8 * c) * 2, o); } }
    LDS_WAIT(); asm volatile("" ::: "memory");
}
__device__ __forceinline__ void rms_row_bf16(const float* xrow, const float* g, bf16_t* orow, int lane) {
    const GAS f32x4* xr = (const GAS f32x4*)xrow + lane; const GAS f32x4* gr = (const GAS f32x4*)g + lane;
    f32x4 v[4]; float s = 0.f;
#pragma unroll
    for (int j = 0; j < 4; ++j) { v[j] = xr[64 * j]; s += (v[j][0] * v[j][0] + v[j][1] * v[j][1]) + (v[j][2] * v[j][2] + v[j][3] * v[j][3]); }
    const float rstd = __builtin_amdgcn_rsqf(wave_sum(s) * (1.f / D) + EPS);
    GAS v2u* o8 = (GAS v2u*)orow + lane;
#pragma unroll
    for (int j = 0; j < 4; ++j) { const f32x4 gg = gr[64 * j]; v2u o; o.x = pk2(v[j][0] * rstd * gg[0], v[j][1] * rstd * gg[1]); o.y = pk2(v[j][2] * rstd * gg[2], v[j][3] * rstd * gg[3]); o8[64 * j] = o; }
}
__device__ __forceinline__ void p0_prologue(Frame& F) {
    const int gw = F.vcu * NWAVES + F.wave, NGW = F.G * NWAVES;
    {
        const float* x = INP(0); const float* g = INP(1); bf16_t* XN = (bf16_t*)(A_WS + WS_XN0);
        const GAS f32x4* gr = (const GAS f32x4*)g + F.lane; f32x4 gg[4];
#pragma unroll
        for (int j = 0; j < 4; ++j) gg[j] = gr[64 * j];
        for (int mb = gw; mb < M; mb += 4 * NGW) { f32x4 v[4][4];
#pragma unroll
            for (int i = 0; i < 4; ++i) { const int m = mb + i * NGW; if (m < M) { const GAS f32x4* xr = (const GAS f32x4*)(x + (size_t)m * D) + F.lane;
#pragma unroll
                for (int j = 0; j < 4; ++j) v[i][j] = xr[64 * j]; } }
#pragma unroll
            for (int i = 0; i < 4; ++i) { const int m = mb + i * NGW; if (m >= M) break; float s = 0.f;
#pragma unroll
                for (int j = 0; j < 4; ++j) s += (v[i][j][0] * v[i][j][0] + v[i][j][1] * v[i][j][1]) + (v[i][j][2] * v[i][j][2] + v[i][j][3] * v[i][j][3]);
                const float rstd = __builtin_amdgcn_rsqf(wave_sum(s) * (1.f / D) + EPS); GAS v2u* o8 = (GAS v2u*)(XN + (size_t)m * D) + F.lane;
#pragma unroll
                for (int j = 0; j < 4; ++j) { v2u o; o.x = pk2(v[i][j][0] * rstd * gg[j][0], v[i][j][1] * rstd * gg[j][1]); o.y = pk2(v[i][j][2] * rstd * gg[j][2], v[i][j][3] * rstd * gg[j][3]); o8[64 * j] = o; } } }
    }
    LAS float* scr = (LAS float*)(F.lds + RING_OFF + F.wave * P0_SCR);
    int it = gw; if (it >= P0_NITEMS) return;
    P0Item cur; P0Regs ra; p0_decode(it, cur); p0_load(cur, ra, F.lane);
    for (;;) { const int nit = it + NGW; const bool has = nit < P0_NITEMS; P0Item nx; P0Regs rb;
        if (has) { p0_decode(nit, nx); p0_load(nx, rb, F.lane); }
        p0_store(cur, ra, scr, F.lane);
        if (!has) break;
        cur = nx; ra = rb; it = nit; }
}

__device__ __forceinline__ void up8(const v4u w, float (&f)[8]) { f[0] = bflo(w.x); f[1] = bfhi(w.x); f[2] = bflo(w.y); f[3] = bfhi(w.y); f[4] = bflo(w.z); f[5] = bfhi(w.z); f[6] = bflo(w.w); f[7] = bfhi(w.w); }
__device__ __forceinline__ void p2_conv(Frame& F) {
    const bf16_t* Bb = (const bf16_t*)(A_WS + WS_BB); const bf16_t* Ub = (const bf16_t*)(A_WS + WS_UB); bf16_t* G = (bf16_t*)(A_WS + WS_G); const float* cw = INP(4);
    const int gw = F.vcu * NWAVES + F.wave, NGW = F.G * NWAVES;
    for (int strip = gw; strip < 2048; strip += NGW) {
        const int r0 = (strip >> 1) * 16, c0 = (strip & 1) * 512 + F.lane * 8;
        float w0[8], w1[8], w2[8], um2[8], um1[8];
#pragma unroll
        for (int j = 0; j < 8; ++j) { w0[j] = cw[c0 + j]; w1[j] = cw[D + c0 + j]; w2[j] = cw[2 * D + c0 + j]; um2[j] = 0.f; um1[j] = 0.f; }
        if ((r0 & (SEQ - 1)) != 0) { up8(*(const GAS v4u*)(Ub + (size_t)(r0 - 2) * D + c0), um2); up8(*(const GAS v4u*)(Ub + (size_t)(r0 - 1) * D + c0), um1); }
#pragma unroll
        for (int hb = 0; hb < 2; ++hb) { v4u ru[8], rb[8];
#pragma unroll
            for (int i = 0; i < 8; ++i) { ru[i] = *(const GAS v4u*)(Ub + (size_t)(r0 + 8 * hb + i) * D + c0); rb[i] = *(const GAS v4u*)(Bb + (size_t)(r0 + 8 * hb + i) * D + c0); }
#pragma unroll
            for (int ii = 0; ii < 8; ++ii) { const int i = 8 * hb + ii; float u[8], b[8]; up8(ru[ii], u); up8(rb[ii], b);
            float g[8];
#pragma unroll
            for (int j = 0; j < 8; ++j) { g[j] = b[j] * (w0[j] * um2[j] + w1[j] * um1[j] + w2[j] * u[j]); um2[j] = um1[j]; um1[j] = u[j]; }
            v4u o; o.x = pk2(g[0], g[1]); o.y = pk2(g[2], g[3]); o.z = pk2(g[4], g[5]); o.w = pk2(g[6], g[7]);
            pg8::st16_wt(G + (size_t)(r0 + i) * D + c0, o); } }
    }
}

__device__ __forceinline__ void p8_diff(Frame& F) {
    const bf16_t* O0 = (const bf16_t*)(A_WS + WS_O0); const bf16_t* O1 = (const bf16_t*)(A_WS + WS_O1); bf16_t* ON = (bf16_t*)(A_WS + WS_ON);
    const float* lp = INP(11); const float* sn = INP(12); const int lane = F.lane;
    const float lam = __expf(wave_sum(lp[lane] * lp[64 + lane])) - __expf(wave_sum(lp[128 + lane] * lp[192 + lane])) + LAM_INIT;
    float gn[16];
#pragma unroll
    for (int j = 0; j < 16; ++j) gn[j] = sn[16 * (lane & 7) + j] * (1.f - LAM_INIT);
    const int gw = F.vcu * NWAVES + F.wave, NGW = F.G * NWAVES;
    for (int rowb = gw; rowb < M; rowb += 4 * NGW) {
        v4u ra[4][2], rb[4][2];
#pragma unroll
        for (int i = 0; i < 4; ++i) { const int row = rowb + i * NGW; if (row < M) { const size_t off = (size_t)row * D + 16 * lane;
            ra[i][0] = *(const GAS v4u*)(O0 + off); ra[i][1] = *(const GAS v4u*)(O0 + off + 8); rb[i][0] = *(const GAS v4u*)(O1 + off); rb[i][1] = *(const GAS v4u*)(O1 + off + 8); } }
#pragma unroll
        for (int i = 0; i < 4; ++i) { const int row = rowb + i * NGW; if (row >= M) break; const size_t off = (size_t)row * D + 16 * lane;
            float a[16], a0[8], a1[8], b0[8], b1[8]; up8(ra[i][0], a0); up8(ra[i][1], a1); up8(rb[i][0], b0); up8(rb[i][1], b1);
            float s = 0.f;
#pragma unroll
            for (int j = 0; j < 8; ++j) { a[j] = a0[j] - lam * b0[j]; a[8 + j] = a1[j] - lam * b1[j]; s += a[j] * a[j] + a[8 + j] * a[8 + j]; }
            s += __shfl_xor(s, 1); s += __shfl_xor(s, 2); s += __shfl_xor(s, 4);
            const float rstd = __builtin_amdgcn_rsqf(s * (1.f / VD) + EPS);
            v4u o0, o1; o0.x = pk2(a[0] * rstd * gn[0], a[1] * rstd * gn[1]); o0.y = pk2(a[2] * rstd * gn[2], a[3] * rstd * gn[3]); o0.z = pk2(a[4] * rstd * gn[4], a[5] * rstd * gn[5]); o0.w = pk2(a[6] * rstd * gn[6], a[7] * rstd * gn[7]);
            o1.x = pk2(a[8] * rstd * gn[8], a[9] * rstd * gn[9]); o1.y = pk2(a[10] * rstd * gn[10], a[11] * rstd * gn[11]); o1.z = pk2(a[12] * rstd * gn[12], a[13] * rstd * gn[13]); o1.w = pk2(a[14] * rstd * gn[14], a[15] * rstd * gn[15]);
            pg8::st16_wt(ON + off, o0); pg8::st16_wt(ON + off + 8, o1); }
    }
}

#define TR_STEP(n, m) do { _Pragma("unroll") for (int i = 0; i < (n) / 2; ++i) { const bool up = (lane & (m)) != 0; const float keep = up ? v[i + (n) / 2] : v[i], send = up ? v[i] : v[i + (n) / 2]; v[i] = keep + __shfl_xor(send, (m)); } } while (0)
__device__ __forceinline__ void p10a_router(Frame& F) {
    const bf16_t* x3 = (const bf16_t*)(A_WS + WS_XB); const float* g = INP(2) + D; const float* Wr = INP(16); const float* ssq = (const float*)(A_WS + WS_SSQ);
    int* sel = (int*)(A_WS + WS_SEL); float* gate = (float*)(A_WS + WS_GATE); int* hist = (int*)(A_WS + WS_HIST);
    LAS f32x4* WL = (LAS f32x4*)(F.lds + RING_OFF);
    LAS int* lcnt = (LAS int*)(F.lds + RING_OFF + 32768);
    const int lane = F.lane;
    for (int k = F.tid; k < D; k += NWAVES * 64) { const float gk = g[k]; const f32x4 w0 = *(const GAS f32x4*)(Wr + (size_t)k * 8) * gk, w1 = *(const GAS f32x4*)(Wr + (size_t)k * 8 + 4) * gk;
        const int base = (((k >> 8) * 4 + (k & 3)) * 2) * 64 + ((k >> 2) & 63); WL[base] = w0; WL[base + 64] = w1; }
    LDS_WAIT(); __syncthreads();
    for (int blk = blockIdx.x; blk < M / 64; blk += F.G) {
        const int row0 = 64 * blk + 8 * F.wave;
        f32x4 xv[8][4];
#pragma unroll
        for (int r = 0; r < 8; ++r)
#pragma unroll
            for (int j = 0; j < 4; ++j) { const v2u w = *((const GAS v2u*)(x3 + (size_t)(row0 + r) * D) + lane + 64 * j); xv[r][j] = (f32x4){bflo(w.x), bfhi(w.x), bflo(w.y), bfhi(w.y)}; }
        float v[64];
#pragma unroll
        for (int i = 0; i < 64; ++i) v[i] = 0.f;
#pragma unroll
        for (int j = 0; j < 4; ++j)
#pragma unroll
            for (int q = 0; q < 4; ++q) { const f32x4 wa = WL[((j * 4 + q) * 2) * 64 + lane], wb = WL[((j * 4 + q) * 2 + 1) * 64 + lane];
#pragma unroll
                for (int r = 0; r < 8; ++r) { const float xx = xv[r][j][q];
                    v[r * 8 + 0] += xx * wa[0]; v[r * 8 + 1] += xx * wa[1]; v[r * 8 + 2] += xx * wa[2]; v[r * 8 + 3] += xx * wa[3];
                    v[r * 8 + 4] += xx * wb[0]; v[r * 8 + 5] += xx * wb[1]; v[r * 8 + 6] += xx * wb[2]; v[r * 8 + 7] += xx * wb[3]; } }
        TR_STEP(64, 32); TR_STEP(32, 16); TR_STEP(16, 8); TR_STEP(8, 4); TR_STEP(4, 2); TR_STEP(2, 1);
        float lg[8];
#pragma unroll
        for (int e = 0; e < 8; ++e) lg[e] = __shfl(v[0], (lane & ~7) | e);
        int i0 = 0; float v0 = lg[0];
#pragma unroll
        for (int e = 1; e < 8; ++e) if (lg[e] > v0) { v0 = lg[e]; i0 = e; }
        int i1 = 0; float v1 = -INFINITY;
#pragma unroll
        for (int e = 0; e < 8; ++e) if (e != i0 && lg[e] > v1) { v1 = lg[e]; i1 = e; }
        const int row = row0 + (lane >> 3); const float rs = pg8::rstd_of(ssq, row);
        const float g1 = 1.f / (1.f + expf((v0 - v1) * rs)); const bool wrt = (lane & 7) == 0;
        if (wrt) { sel[2 * row] = i0; sel[2 * row + 1] = i1; gate[2 * row] = 1.f - g1; gate[2 * row + 1] = g1; }
        int mycnt = 0;
#pragma unroll
        for (int e = 0; e < 8; ++e) { const int c = __popcll(__ballot(wrt && i0 == e)) + __popcll(__ballot(wrt && i1 == e)); if (lane == e) mycnt = c; }
        if (lane < 8) lcnt[F.wave * 8 + lane] = mycnt;
        LDS_WAIT(); __syncthreads();
        if (F.tid < 8) { int c = 0;
#pragma unroll
            for (int w = 0; w < 8; ++w) c += lcnt[w * 8 + F.tid];
            hist[blk * 8 + F.tid] = c; }
        LDS_WAIT(); __syncthreads();
    }
}
#undef TR_STEP
__device__ __forceinline__ void p10b_assign(Frame& F) {
    const int* hist = (const int*)(A_WS + WS_HIST); const int* sel = (const int*)(A_WS + WS_SEL); const float* gate = (const float*)(A_WS + WS_GATE); const float* ssq = (const float*)(A_WS + WS_SSQ);
    int* tok_slot = (int*)(A_WS + WS_TOKSLOT); float* gates = (float*)(A_WS + WS_GATES); int* meta = (int*)(A_WS + WS_META);
    const bf16_t* x3 = (const bf16_t*)(A_WS + WS_XB); unsigned char* XG = A_WS + WS_XG;
    LAS int* pre = (LAS int*)(F.lds + RING_OFF);
    LAS int* tot = pre + 2048;
    LAS int* ebase = tot + 8;
    LAS int* lslot = ebase + 8;
    const int lane = F.lane, e = F.wave;
    { int h[4], run = 0;
#pragma unroll
      for (int i = 0; i < 4; ++i) { h[i] = hist[(4 * lane + i) * 8 + e]; }
      const int mine = h[0] + h[1] + h[2] + h[3]; int inc = mine;
#pragma unroll
      for (int o = 1; o < 64; o <<= 1) { const int t = __shfl_up(inc, o); if (lane >= o) inc += t; }
      run = inc - mine;
#pragma unroll
      for (int i = 0; i < 4; ++i) { pre[(4 * lane + i) * 8 + e] = run; run += h[i]; }
      if (lane == 63) tot[e] = inc; }
    LDS_WAIT(); __syncthreads();
    if (F.tid == 0) { int b = 0; for (int k = 0; k < 8; ++k) { ebase[k] = b; if (blockIdx.x == 0) meta[k] = b >> 8; b += (tot[k] + 255) & ~255; } if (blockIdx.x == 0) { const int T = b >> 8, full = 2 * F.G / 4; meta[8] = T; meta[9] = T < full ? T : full; } }
    LDS_WAIT(); __syncthreads();
    for (int blk = blockIdx.x; blk < M / 64; blk += F.G) {
        if (F.wave == 0) { const int t = 64 * blk + lane; const int s0 = sel[2 * t], s1 = sel[2 * t + 1]; int sl0 = 0, sl1 = 0;
            const unsigned long long below = (1ull << lane) - 1ull;
#pragma unroll
            for (int k = 0; k < 8; ++k) { const unsigned long long m0 = __ballot(s0 == k), m1 = __ballot(s1 == k); const int b0 = ebase[k] + pre[blk * 8 + k];
                if (s0 == k) sl0 = b0 + __popcll(m0 & below); if (s1 == k) sl1 = b0 + __popcll(m0) + __popcll(m1 & below); }
            tok_slot[2 * t] = sl0; tok_slot[2 * t + 1] = sl1; lslot[2 * lane] = sl0; lslot[2 * lane + 1] = sl1;
            gates[sl0] = gate[2 * t]; gates[sl1] = gate[2 * t + 1]; }
        LDS_WAIT(); __syncthreads();
        v4u xw[8][2];
#pragma unroll
        for (int i = 0; i < 8; ++i) { const GAS v4u* xr = (const GAS v4u*)(x3 + (size_t)(64 * blk + 8 * F.wave + i) * D + 16 * lane); xw[i][0] = xr[0]; xw[i][1] = xr[1]; }
#pragma unroll
        for (int i = 0; i < 8; ++i) { const int tl = 8 * F.wave + i; const int t = 64 * blk + tl;
            const float rs = pg8::rstd_of(ssq, t) * pg8::F8_SA; float a[8], b[8]; up8(xw[i][0], a); up8(xw[i][1], b);
            v4u o; o.x = pg8::pk4_fp8(a[0] * rs, a[1] * rs, a[2] * rs, a[3] * rs); o.y = pg8::pk4_fp8(a[4] * rs, a[5] * rs, a[6] * rs, a[7] * rs); o.z = pg8::pk4_fp8(b[0] * rs, b[1] * rs, b[2] * rs, b[3] * rs); o.w = pg8::pk4_fp8(b[4] * rs, b[5] * rs, b[6] * rs, b[7] * rs);
            const int sl0 = lslot[2 * tl], sl1 = lslot[2 * tl + 1];
            pg8::st16_wt(XG + (size_t)sl0 * D + 16 * lane, o); pg8::st16_wt(XG + (size_t)sl1 * D + 16 * lane, o); }
        LDS_WAIT(); __syncthreads();
    }
}
__device__ __forceinline__ void p13_load_y(const bf16_t* Y, const float* Pp, const float* gates, int nfull, int slot, int lane, v2u (&y)[4]) {
    const int rt = (slot >> 8) - nfull;
    if (rt < 0) { const GAS v2u* yr = (const GAS v2u*)(Y + (size_t)slot * D) + lane;
#pragma unroll
        for (int j = 0; j < 4; ++j) y[j] = yr[64 * j];
    } else { const float gt = gates[slot] * (1.0f / (pg8::F8_SH * pg8::F8_SWD));
#pragma unroll
        for (int j = 0; j < 4; ++j) { f32x4 s = (f32x4){0.f, 0.f, 0.f, 0.f};
#pragma unroll
            for (int kp = 0; kp < pg8::MoeOrder::SPL; ++kp) s += *((const GAS f32x4*)(Pp + ((size_t)(rt * pg8::MoeOrder::SPL + kp) * 256 + (slot & 255)) * D) + lane + 64 * j);
            y[j].x = pk2(s[0] * gt, s[1] * gt); y[j].y = pk2(s[2] * gt, s[3] * gt); } }
}
__device__ __forceinline__ void p13_final(Frame& F) {
    const int* tok_slot = (const int*)(A_WS + WS_TOKSLOT); const bf16_t* Y = (const bf16_t*)(A_WS + WS_Y); const bf16_t* X3 = (const bf16_t*)(A_WS + WS_XB); float* out = A_OUT;
    const float* Pp = (const float*)(A_WS + WS_PP); const float* gates = (const float*)(A_WS + WS_GATES); const int nfull = ((const int*)(A_WS + WS_META))[9];
    const int gw = F.vcu * NWAVES + F.wave, NGW = F.G * NWAVES, lane = F.lane;
    for (int rowb = gw; rowb < M; rowb += 2 * NGW) {
        v2u xa[2][4], ya[2][4], yb[2][4];
#pragma unroll
        for (int i = 0; i < 2; ++i) { const int row = rowb + i * NGW; if (row < M) { const int s0 = tok_slot[2 * row], s1 = tok_slot[2 * row + 1];
            const GAS v2u* xr = (const GAS v2u*)(X3 + (size_t)row * D) + lane;
#pragma unroll
            for (int j = 0; j < 4; ++j) xa[i][j] = xr[64 * j];
            p13_load_y(Y, Pp, gates, nfull, s0, lane, ya[i]); p13_load_y(Y, Pp, gates, nfull, s1, lane, yb[i]); } }
#pragma unroll
        for (int i = 0; i < 2; ++i) { const int row = rowb + i * NGW; if (row >= M) break; GAS f32x4* orow = (GAS f32x4*)(out + (size_t)row * D) + lane;
#pragma unroll
            for (int j = 0; j < 4; ++j) { const v2u x = xa[i][j], a = ya[i][j], b = yb[i][j];
                orow[64 * j] = (f32x4){bflo(x.x) + (bflo(a.x) + bflo(b.x)), bfhi(x.x) + (bfhi(a.x) + bfhi(b.x)), bflo(x.y) + (bflo(a.y) + bflo(b.y)), bfhi(x.y) + (bfhi(a.y) + bfhi(b.y))}; } }
    }
}

__global__ void __launch_bounds__(NWAVES * 64, 2) mega_fwd(Args args) {
    extern __shared__ __attribute__((aligned(16))) unsigned char lds[];
    Frame F;
    F.lds = (LAS unsigned char*)lds; F.tid = threadIdx.x; F.lane = F.tid & 63; F.wave = __builtin_amdgcn_readfirstlane(F.tid >> 6);
    F.G = gridDim.x; { const int bx = blockIdx.x; F.vcu = (F.G % 8 == 0) ? (bx % 8) * (F.G / 8) + bx / 8 : bx; }
    for (int u = F.tid; u < RING_OFF / 4; u += NWAVES * 64) ((LAS unsigned*)(F.lds + MISC_OFF))[u] = 0u;
    __syncthreads();
    if (KA->ph_hi - KA->ph_lo > 1) (void)xcd_barrier_post((unsigned*)(A_WS + WS_CTL) + CW_BAR + KA->li * XCD_BAR_WORDS, (volatile LAS unsigned*)(F.lds + MISC_OFF + 32));
#define IN(k) (KA->ph_lo <= (k) && (k) < KA->ph_hi)
#define SEAM(k) do { if (IN(k) && IN((k) + 1)) SEAM_NOW(); } while (0)
#define SEAM_NOW() do { { XcdBarrier b_; b_.bar = (unsigned*)(A_WS + WS_CTL) + CW_BAR + KA->li * XCD_BAR_WORDS; b_.x = xb_xcc_id(); b_.st = (volatile LAS unsigned*)(F.lds + MISC_OFF + 32); xcd_barrier(b_); } } while (0)
#define ws A_WS
#define XB ((bf16_t*)(A_WS + WS_XB))
#define SSQ ((float*)(A_WS + WS_SSQ))

    if (IN(0)) { p0_prologue(F); } SEAM(0);
    if (IN(1)) { pg8::Gemm g{(const bf16_t*)(ws + WS_XN0), (const bf16_t*)(ws + WS_W_IN), M, 3072, 1024}; pg8::StaticOrder S; S.init(M, 3072, F.G, (int)blockIdx.x);
        pg8::EpiInProj E{(bf16_t*)(ws + WS_BB), (bf16_t*)(ws + WS_UB)};
        pg8::gemm_phase<pg8::EpiInProj, pg8::StaticOrder, true, true>(F.lds + RING_OFF, g, S, E); } SEAM(1);
    if (IN(2)) { p2_conv(F); } SEAM(2);
    if (IN(3)) { pg8::Gemm g{(const bf16_t*)(ws + WS_G), (const bf16_t*)(ws + WS_W_OUT), M, 1024, 1024}; pg8::StaticOrder S; S.init(M, 1024, F.G, (int)blockIdx.x);
        pg8::EpiResidSsq<true> E{INP(0), XB, SSQ, 1.0f, ws + WS_X8};
        pg8::gemm_phase<pg8::EpiResidSsq<true>, pg8::StaticOrder, false, true>(F.lds + RING_OFF, g, S, E); } SEAM(3);
    if (IN(4)) { pg8::Gemm g{(const bf16_t*)(ws + WS_X8), (const bf16_t*)(ws + WS_W_GU), M, 5632, 512}; pg8::StaticOrder S; S.init(M, 5632, F.G, (int)blockIdx.x);
        pg8::EpiSwiGLU<true> E{ws + WS_HACT, DFF, SSQ, nullptr, 22, 1.0f / (pg8::F8_SX * pg8::F8_SWGD)};
        pg8::gemm_phase<pg8::EpiSwiGLU<true>, pg8::StaticOrder, true, true, true>(F.lds + RING_OFF, g, S, E); } SEAM(4);
    if (IN(5)) { pg8::Gemm g{(const bf16_t*)(ws + WS_HACT), (const bf16_t*)(ws + WS_W_DN), M, 1024, DFF / 2}; pg8::StaticOrder S; S.init(M, 1024, F.G, (int)blockIdx.x);
        pg8::EpiResidSsq<false> E{nullptr, XB, SSQ, 1.0f / (pg8::F8_SHD * pg8::F8_SWDD), nullptr};
        pg8::gemm_phase<pg8::EpiResidSsq<false>, pg8::StaticOrder, false, true, true>(F.lds + RING_OFF, g, S, E); } SEAM(5);
    if (IN(6)) { pg8::Gemm g{XB, (const bf16_t*)(ws + WS_W_QKV), M, 3072, 1024}; pg8::StaticOrder S; S.init(M, 3072, F.G, (int)blockIdx.x);
        pg8::EpiQKV E{(bf16_t*)(ws + WS_Q), (bf16_t*)(ws + WS_K), (bf16_t*)(ws + WS_V), SSQ, INP(10), INP(8), attn_body::C2};
        pg8::gemm_phase<pg8::EpiQKV, pg8::StaticOrder, true, true>(F.lds + RING_OFF, g, S, E); } SEAM(6);
    if (IN(7)) {
        const float* lp = INP(11); const float* sn = INP(12);
        const float lam = __expf(wave_sum(lp[F.lane] * lp[64 + F.lane])) - __expf(wave_sum(lp[128 + F.lane] * lp[192 + F.lane])) + LAM_INIT;
        LAS float* sng = (LAS float*)(F.lds + MISC_OFF + 256);
        if (F.tid < VD) sng[F.tid] = sn[F.tid] * (1.f - LAM_INIT);
        LDS_WAIT(); __syncthreads();
        for (int it = F.vcu; it < BATCH * 32; it += F.G) { const int b = it >> 5, h = (it >> 2) & 7, p = it & 3;
            attn_body::bf16* O0 = (attn_body::bf16*)(ws + WS_O0); attn_body::bf16* ONp = (attn_body::bf16*)(ws + WS_ON);
            for (int i = 0; i < 2; ++i) { const int qb = i ? 7 - p : p;
                attn_body::attn_unit<-1, 0>(b, (2 * h) * 64, h * 128, qb, (const attn_body::bf16*)(ws + WS_Q), (const attn_body::bf16*)(ws + WS_K), (const attn_body::bf16*)(ws + WS_V), O0, (char*)lds + RING_OFF, nullptr, 0.f, nullptr);
                attn_body::attn_unit<-1, 1>(b, (2 * h + 1) * 64, h * 128, qb, (const attn_body::bf16*)(ws + WS_Q), (const attn_body::bf16*)(ws + WS_K), (const attn_body::bf16*)(ws + WS_V), O0, (char*)lds + RING_OFF, ONp, lam, (const float*)((char*)lds + MISC_OFF + 256)); } }
    } if (IN(7) && IN(9)) SEAM_NOW();
    if (IN(9)) { pg8::Gemm g{(const bf16_t*)(ws + WS_ON), (const bf16_t*)(ws + WS_W_O), M, 1024, 1024}; pg8::StaticOrder S; S.init(M, 1024, F.G, (int)blockIdx.x);
        pg8::EpiResidSsq<false> E{nullptr, XB, SSQ, 1.0f, nullptr};
        pg8::gemm_phase<pg8::EpiResidSsq<false>, pg8::StaticOrder, false, true>(F.lds + RING_OFF, g, S, E); } SEAM(9);
    if (IN(10)) { p10a_router(F); } SEAM(10);
    if (IN(11)) { p10b_assign(F); } SEAM(11);
    if (IN(12)) { pg8::Gemm g{(const bf16_t*)(ws + WS_XG), (const bf16_t*)(ws + WS_W_MGU), SLOTS, 8 * 7168, 512}; pg8::MoeOrder S; S.init((const int*)(ws + WS_META), 28, F.G, (int)blockIdx.x, false);
        pg8::EpiSwiGLU8 E{ws + WS_HM, DFE, 28};
        pg8::gemm_phase<pg8::EpiSwiGLU8, pg8::MoeOrder, true, true, true>(F.lds + RING_OFF, g, S, E); } SEAM(12);
    if (IN(13)) { pg8::Gemm g{(const bf16_t*)(ws + WS_HM), (const bf16_t*)(ws + WS_W_MDN), SLOTS, 8 * 1024, DFE / 2}; pg8::MoeOrder S; S.init((const int*)(ws + WS_META), 4, F.G, (int)blockIdx.x, true);
        pg8::EpiMoeDown E{(bf16_t*)(ws + WS_Y), (const float*)(ws + WS_GATES), 1.0f / (pg8::F8_SH * pg8::F8_SWD), (float*)(ws + WS_PP)};
        pg8::gemm_phase<pg8::EpiMoeDown, pg8::MoeOrder, true, true, true>(F.lds + RING_OFF, g, S, E); } SEAM(13);
    if (IN(14)) { p13_final(F); }
#undef IN
#undef SEAM
#undef SEAM_NOW
#undef ws
#undef XB
#undef SSQ
}
#ifndef MEGA_UPTO
#define MEGA_UPTO 15
#endif
#ifndef MEGA_REPMASK
#define MEGA_REPMASK 0
#endif
#ifndef MEGA_ONE
#define MEGA_ONE 1
#endif
extern "C" void kernel_launch(void* const* d_in, const int* in_sizes, int n_in, void* d_out, int out_size, void* d_ws, size_t ws_size, hipStream_t stream) {
    static int grid = 0;
    if (grid == 0) {
        if (n_in != 19 || in_sizes[0] != M * D || out_size != M * D || ws_size < WS_END) { fprintf(stderr, "kernel_launch: unexpected shapes / workspace (%d inputs, ws %zu, need %zu)\n", n_in, ws_size, (size_t)WS_END); grid = -1; return; }
        int dev = 0, cus = 0, per_cu = 0;
        if (hipGetDevice(&dev) != hipSuccess || hipDeviceGetAttribute(&cus, hipDeviceAttributeMultiprocessorCount, dev) != hipSuccess) { grid = -1; return; }
        if (hipFuncSetAttribute((const void*)mega_fwd, hipFuncAttributeMaxDynamicSharedMemorySize, LDS_BYTES) != hipSuccess) { fprintf(stderr, "kernel_launch: hipFuncSetAttribute failed\n"); grid = -1; return; }
        if (hipOccupancyMaxActiveBlocksPerMultiprocessor(&per_cu, (const void*)mega_fwd, NWAVES * 64, LDS_BYTES) != hipSuccess || per_cu < 1) fprintf(stderr, "kernel_launch: note: occupancy query says %d\n", per_cu);
        (void)hipGetLastError();
        grid = cus < 256 ? cus : 256;
        if (grid != 256) fprintf(stderr, "kernel_launch: %d CUs; this kernel is built for 256\n", cus);
    }
    if (grid < 0) return;
    unsigned char* ws = (unsigned char*)d_ws; float* out = (float*)d_out;
    constexpr int UPTO = MEGA_UPTO;
    static_assert(UPTO == 15, "the plain reference kernels of the transition builds are gone: all 15 phases run in the persistent kernel");
    if (UPTO > 0) {
        if (hipMemsetAsync(ws + WS_CTL, 0, CTL_ZERO_BYTES, stream) != hipSuccess) { fprintf(stderr, "kernel_launch: memset failed\n"); return; }
        Args a{};
        for (int i = 0; i < 19; ++i) a.in[i] = (const float*)d_in[i];
        a.out = out; a.wsp = ws;
        a.jobmask = UPTO >= 15 ? 255 : UPTO >= 10 ? 63 : UPTO >= 7 ? 31 : UPTO >= 6 ? 15 : 3;
        if (MEGA_ONE) { a.ph_lo = 0; a.ph_hi = UPTO; a.li = 0; hipLaunchKernelGGL(mega_fwd, dim3(grid), dim3(NWAVES * 64), LDS_BYTES, stream, a); }
        else for (int p = 0; p < UPTO; ++p) { a.ph_lo = p; a.ph_hi = p + 1; a.li = 0; for (int r = 0; r <= ((MEGA_REPMASK >> p) & 1); ++r) hipLaunchKernelGGL(mega_fwd, dim3(grid), dim3(NWAVES * 64), LDS_BYTES, stream, a); }
        const hipError_t le = hipPeekAtLastError();
        if (le != hipSuccess) fprintf(stderr, "kernel_launch: launch failed: %s\n", hipGetErrorName(le));
    }
}
```

```cpp
#include <hip/hip_runtime.h>
#include <hip/hip_bf16.h>
#include <stdint.h>
#include <stdio.h>
#include <cmath>
#define MEGA_UPTO 15
#define MEGA_ONE 1
typedef unsigned short bf16_t;
typedef short bf16x8 __attribute__((ext_vector_type(8)));
typedef float f32x4 __attribute__((ext_vector_type(4)));
constexpr int D = 1024, BATCH = 8, SEQ = 2048, M = BATCH * SEQ;
constexpr int NH = 8, HD = 64, VD = 128;
constexpr int DFF = 2816, NE = 8, DFE = 3584;
constexpr float EPS = 1e-6f;
constexpr float LAM_INIT = 0.35550907f;
constexpr int SLOTS = 2 * M + NE * 256;

__device__ __forceinline__ unsigned f2bf(float f) { unsigned u = __builtin_bit_cast(unsigned, f); return (u + 0x7fffu + ((u >> 16) & 1u)) >> 16; }
__device__ __forceinline__ float bf2f(unsigned short b) { return __builtin_bit_cast(float, (unsigned)b << 16); }
__device__ __forceinline__ float wave_sum(float v) {
#pragma unroll
    for (int o = 1; o < 64; o <<= 1) v += __shfl_xor(v, o);
    return v;
}

namespace pg8 {
#define PG8_LAS __attribute__((address_space(3)))
typedef unsigned short bf16_t;
typedef short bf16x8 __attribute__((ext_vector_type(8)));
typedef float f32x4 __attribute__((ext_vector_type(4)));
typedef unsigned u32x4 __attribute__((ext_vector_type(4)));
typedef int i32x4 __attribute__((ext_vector_type(4)));
typedef int i32x8 __attribute__((ext_vector_type(8)));
constexpr int BM = 256, BK = 64, HALF = 128, HTB = HALF * BK * 2  , STAGE_BYTES = 8 * HTB, NXCD = 8, WGM = 8;

__host__ __device__ __forceinline__ int lds_byte(int r, int c) { const int st = (r >> 4) * 2 + (c >> 5), rr = r & 15, cc = c & 31, ob = rr * 64 + cc * 2; return st * 1024 + (ob ^ (((ob >> 9) & 1) << 5)); }
__host__ __device__ __forceinline__ void stage_rc(int b, int& R, int& C) { const int st = b / 1024, sb = b % 1024, swz = sb ^ (((sb >> 9) & 1) << 5); R = (st >> 1) * 16 + swz / 64; C = (st & 1) * 32 + (swz % 64) / 2; }
__host__ __device__ __forceinline__ int perm32(int rho) { const int n = rho >> 4, i = rho & 15; return 8 * (i >> 2) + 4 * n + (i & 3); }

struct Unit { int pm, pn; int kt0, nkt, aux; };
struct Gemm { const bf16_t* A; const bf16_t* Bt; int M, N, K; };

struct StaticOrder {
    int nM, nN, nwg, G, c;
    __host__ __device__ void init(int M, int N, int G_, int c_) { nM = M / BM; nN = N / BM; nwg = nM * nN; G = G_; c = c_; }
    __host__ __device__ bool next(int i, Unit& u) const {
        const long L = (long)i * G + c; if (L >= nwg) return false;
        int wgid = (int)L; { const int q = nwg / NXCD, r = nwg % NXCD, xcd = wgid % NXCD, off = wgid / NXCD; wgid = (xcd < r ? xcd * (q + 1) : r * (q + 1) + (xcd - r) * q) + off; }
        const int nig = WGM * nN, gid = wgid / nig, fm = gid * WGM, gsz = (nM - fm) < WGM ? (nM - fm) : WGM;
        u.pm = fm + ((wgid % nig) % gsz); u.pn = (wgid % nig) / gsz; u.kt0 = 0; u.nkt = 0; u.aux = -1; return true;
    }
    __device__ __forceinline__ void a_ready(const Unit&) const {}
    __device__ __forceinline__ void done(const Unit&) const {}
};

__device__ __forceinline__ unsigned cvt_pk_bf16(float lo, float hi) { unsigned r; asm volatile("v_cvt_pk_bf16_f32 %0, %1, %2" : "=v"(r) : "v"(lo), "v"(hi)); return r; }
typedef float f32x2 __attribute__((ext_vector_type(2)));
#ifndef PG8_WT
#define PG8_WT 0
#endif
__device__ __forceinline__ void st16_wt(void* p, u32x4 v) {
#if PG8_WT
    asm volatile("global_store_dwordx4 %0, %1, off sc1\n\ts_nop 1" :: "v"(p), "v"(v) : "memory");
#else
    *(u32x4*)p = v;
#endif
}
__device__ __forceinline__ void st8_wt(void* p, unsigned x, unsigned y) {
#if PG8_WT
    typedef unsigned u32x2_ __attribute__((ext_vector_type(2))); const u32x2_ v = {x, y};
    asm volatile("global_store_dwordx2 %0, %1, off sc1\n\ts_nop 1" :: "v"(p), "v"(v) : "memory");
#else
    typedef unsigned u32x2_ __attribute__((ext_vector_type(2))); *(u32x2_*)p = (u32x2_){x, y};
#endif
}
typedef unsigned u32x2 __attribute__((ext_vector_type(2)));
constexpr float RMS_EPS = 1e-6f, LOG2E = 1.4426950408889634f;
constexpr int DM_ = 1024;
__device__ __forceinline__ u32x4 pack8(const f32x4 a, const f32x4 b) { u32x4 w; w.x = cvt_pk_bf16(a[0], a[1]); w.y = cvt_pk_bf16(a[2], a[3]); w.z = cvt_pk_bf16(b[0], b[1]); w.w = cvt_pk_bf16(b[2], b[3]); return w; }
__device__ __forceinline__ float rstd_of(const float* ssq, int row) { const f32x4 p = *(const f32x4*)(ssq + (size_t)row * 4); return __builtin_amdgcn_rsqf(((p[0] + p[1]) + (p[2] + p[3])) * (1.0f / 1024.0f) + RMS_EPS); }
__device__ __forceinline__ float silu_mul(float g, float u) { return g * u * __builtin_amdgcn_rcpf(1.0f + __builtin_amdgcn_exp2f(-g * LOG2E)); }
__device__ __forceinline__ f32x2 swiglu2(f32x2 a, f32x2 b, float c1, float k) {
    const f32x2 t = a * c1; f32x2 e; e.x = __builtin_amdgcn_exp2f(t.x); e.y = __builtin_amdgcn_exp2f(t.y);
    const f32x2 d = e * k + k; f32x2 r; r.x = __builtin_amdgcn_rcpf(d.x); r.y = __builtin_amdgcn_rcpf(d.y);
    return (a * b) * r;
}

__device__ __forceinline__ float clamp448(float x) { return __builtin_amdgcn_fmed3f(x, -448.0f, 448.0f); }
__device__ __forceinline__ unsigned pk4_fp8(float a, float b, float c, float d) { int w = 0; w = __builtin_amdgcn_cvt_pk_fp8_f32(clamp448(a), clamp448(b), w, false); w = __builtin_amdgcn_cvt_pk_fp8_f32(clamp448(c), clamp448(d), w, true); return (unsigned)w; }
constexpr float F8_SA = 4.0f, F8_SWG = 256.0f, F8_SH = 8.0f, F8_SWD = 512.0f;
constexpr float F8_SHD = 8.0f, F8_SWDD = 256.0f, F8_SX = 4.0f, F8_SWGD = 256.0f;

struct EpiInProj {
    static constexpr bool PERM = true, AFTER_DRAIN = false;
    bf16_t* Bb; bf16_t* Ub;
    __device__ __forceinline__ void operator()(const f32x4 (&acc)[2][2][4][2], const Unit& u, int wr, int wc, int fr, int fq) const {
        const int row0 = u.pm * BM + wr * 64 + fr;
        if (u.pn < 4) {
            const int col0 = u.pn * BM + wc * 32 + 8 * fq;
#pragma unroll
            for (int ai = 0; ai < 2; ++ai)
#pragma unroll
                for (int m = 0; m < 4; ++m) { bf16_t* rowp = Bb + (size_t)(row0 + ai * HALF + m * 16) * DM_ + col0;
#pragma unroll
                    for (int bj = 0; bj < 2; ++bj) st16_wt(rowp + bj * HALF, pack8(acc[ai][bj][m][0], acc[ai][bj][m][1])); }
        } else {
            const int col0 = (u.pn - 4) * 128 + wc * 32 + 8 * fq;
#pragma unroll
            for (int ai = 0; ai < 2; ++ai)
#pragma unroll
                for (int m = 0; m < 4; ++m) { bf16_t* rowp = Ub + (size_t)(row0 + ai * HALF + m * 16) * DM_ + col0;
                    st16_wt(rowp, pack8(acc[ai][0][m][0] * acc[ai][1][m][0], acc[ai][0][m][1] * acc[ai][1][m][1])); }
        }
    }
};

template <bool FIRST> struct EpiResidSsq {
    static constexpr bool PERM = true, AFTER_DRAIN = true;
    const float* x0; bf16_t* xb; float* ssq; float ascale; unsigned char* x8;
    __device__ __forceinline__ void fused(f32x4 (&acc)[2][2][4][2], const Unit& u, int wr, int wc, int fr, int fq, PG8_LAS unsigned char* lds, int wid, int lane) const {
        PG8_LAS float* P = (PG8_LAS float*)lds;
        const int col0 = u.pn * BM + wc * 32 + 8 * fq;
#pragma unroll
        for (int ai = 0; ai < 2; ++ai) {
            f32x4 xo[4][2][2];
#pragma unroll
            for (int m = 0; m < 4; ++m) { const int r = ai * HALF + wr * 64 + m * 16 + fr; const size_t off = (size_t)(u.pm * BM + r) * DM_ + col0;
#pragma unroll
                for (int bj = 0; bj < 2; ++bj) {
                    if constexpr (FIRST) { xo[m][bj][0] = __builtin_nontemporal_load((const f32x4*)(x0 + off + bj * HALF)); xo[m][bj][1] = __builtin_nontemporal_load((const f32x4*)(x0 + off + bj * HALF + 4)); }
                    else { const u32x4 w = *(const u32x4*)(xb + off + bj * HALF);
                        xo[m][bj][0] = (f32x4){__builtin_bit_cast(float, w.x << 16), __builtin_bit_cast(float, w.x & 0xffff0000u), __builtin_bit_cast(float, w.y << 16), __builtin_bit_cast(float, w.y & 0xffff0000u)};
                        xo[m][bj][1] = (f32x4){__builtin_bit_cast(float, w.z << 16), __builtin_bit_cast(float, w.z & 0xffff0000u), __builtin_bit_cast(float, w.w << 16), __builtin_bit_cast(float, w.w & 0xffff0000u)}; } } }
#pragma unroll
            for (int m = 0; m < 4; ++m) { const int r = ai * HALF + wr * 64 + m * 16 + fr; const size_t off = (size_t)(u.pm * BM + r) * DM_ + col0; float s = 0.f;
#pragma unroll
                for (int bj = 0; bj < 2; ++bj) { const f32x4 v0 = xo[m][bj][0] + acc[ai][bj][m][0] * ascale, v1 = xo[m][bj][1] + acc[ai][bj][m][1] * ascale;
                    st16_wt(xb + off + bj * HALF, pack8(v0, v1));
                    if constexpr (FIRST) { u32x2 w; w.x = pk4_fp8(v0[0] * F8_SX, v0[1] * F8_SX, v0[2] * F8_SX, v0[3] * F8_SX); w.y = pk4_fp8(v1[0] * F8_SX, v1[1] * F8_SX, v1[2] * F8_SX, v1[3] * F8_SX); st8_wt(x8 + off + bj * HALF, w.x, w.y); }
                    s += ((v0[0] * v0[0] + v0[1] * v0[1]) + (v0[2] * v0[2] + v0[3] * v0[3])) + ((v1[0] * v1[0] + v1[1] * v1[1]) + (v1[2] * v1[2] + v1[3] * v1[3])); }
                s += __shfl_xor(s, 16); s += __shfl_xor(s, 32);
                if (fq == 0) P[r * 4 + wc] = s; }
            asm volatile("" ::: "memory"); }
        asm volatile("s_waitcnt lgkmcnt(0)" ::: "memory"); __builtin_amdgcn_s_barrier(); asm volatile("" ::: "memory");
        const int t = wid * 64 + lane;
        if (t < 256) { const PG8_LAS f32x4* Pr = (const PG8_LAS f32x4*)lds; const f32x4 p = Pr[t]; ssq[(size_t)(u.pm * BM + t) * 4 + u.pn] = (p[0] + p[1]) + (p[2] + p[3]); }
        asm volatile("s_waitcnt lgkmcnt(0)" ::: "memory"); __builtin_amdgcn_s_barrier(); asm volatile("" ::: "memory");
    }
};

template <bool OUT8> struct EpiSwiGLU {
    static constexpr bool PERM = true, AFTER_DRAIN = false;
    void* H; int ldh; const float* ssq; const float* rstd; int ncol; float cs;
    __device__ __forceinline__ void operator()(const f32x4 (&acc)[2][2][4][2], const Unit& u, int wr, int wc, int fr, int fq) const {
        const int row0 = u.pm * BM + wr * 64 + fr, col0 = (u.pn % ncol) * 128 + wc * 32 + 8 * fq;
#pragma unroll
        for (int ai = 0; ai < 2; ++ai)
#pragma unroll
            for (int m = 0; m < 4; ++m) { const int row = row0 + ai * HALF + m * 16;
                float k; if (ssq) { const f32x4 p = *(const f32x4*)(ssq + (size_t)row * 4); k = ((p[0] + p[1]) + (p[2] + p[3])) * (1.0f / 1024.0f) + RMS_EPS; } else { const float r_ = rstd[row]; k = 1.0f / (r_ * r_); }
                const float c1 = -LOG2E * cs * __builtin_amdgcn_rsqf(k); k = k / (cs * cs);
                f32x4 h[2];
#pragma unroll
                for (int n = 0; n < 2; ++n) { const f32x4 a = acc[ai][0][m][n], b = acc[ai][1][m][n];
                    const f32x2 h0 = swiglu2((f32x2){a[0], a[1]}, (f32x2){b[0], b[1]}, c1, k), h1 = swiglu2((f32x2){a[2], a[3]}, (f32x2){b[2], b[3]}, c1, k);
                    h[n] = (f32x4){h0.x, h0.y, h1.x, h1.y}; }
                if constexpr (OUT8) { u32x2 w; w.x = pk4_fp8(h[0][0] * F8_SHD, h[0][1] * F8_SHD, h[0][2] * F8_SHD, h[0][3] * F8_SHD); w.y = pk4_fp8(h[1][0] * F8_SHD, h[1][1] * F8_SHD, h[1][2] * F8_SHD, h[1][3] * F8_SHD);
                    st8_wt((unsigned char*)H + (size_t)row * ldh + col0, w.x, w.y); }
                else st16_wt((bf16_t*)H + (size_t)row * ldh + col0, pack8(h[0], h[1])); }
    }
};

struct EpiQKV {
    static constexpr bool PERM = true, AFTER_DRAIN = false;
    bf16_t *Q, *K, *V; const float* ssq; const float* qg; const float* kg; float qscale;
    __device__ __forceinline__ void operator()(const f32x4 (&acc)[2][2][4][2], const Unit& u, int wr, int wc, int fr, int fq) const {
        const int row0 = u.pm * BM + wr * 64 + fr;
        if (u.pn < 8) {
            const bool isq = u.pn < 4; bf16_t* base = isq ? Q : K; const float* gn = isq ? qg : kg; const float sc = isq ? qscale : 1.0f;
            const int col0 = (4 * (u.pn & 3) + wc) * 64 + 8 * fq;
            f32x4 gv[2][2];
#pragma unroll
            for (int bj = 0; bj < 2; ++bj)
#pragma unroll
                for (int n = 0; n < 2; ++n) gv[bj][n] = *(const f32x4*)(gn + 32 * bj + 8 * fq + 4 * n);
#pragma unroll
            for (int ai = 0; ai < 2; ++ai)
#pragma unroll
                for (int m = 0; m < 4; ++m) { const int row = row0 + ai * HALF + m * 16; const float rs = rstd_of(ssq, row);
                    f32x4 v[2][2]; float ss = 0.f;
#pragma unroll
                    for (int bj = 0; bj < 2; ++bj)
#pragma unroll
                        for (int n = 0; n < 2; ++n) { v[bj][n] = acc[ai][bj][m][n] * rs; ss += (v[bj][n][0] * v[bj][n][0] + v[bj][n][1] * v[bj][n][1]) + (v[bj][n][2] * v[bj][n][2] + v[bj][n][3] * v[bj][n][3]); }
                    ss += __shfl_xor(ss, 16); ss += __shfl_xor(ss, 32);
                    const float r2 = __builtin_amdgcn_rsqf(ss * (1.0f / 64.0f) + RMS_EPS) * sc;
#pragma unroll
                    for (int bj = 0; bj < 2; ++bj) st16_wt(base + (size_t)row * DM_ + col0 + 32 * bj, pack8(v[bj][0] * r2 * gv[bj][0], v[bj][1] * r2 * gv[bj][1])); }
        } else {
            const int col0 = (u.pn - 8) * BM + wc * 32 + 8 * fq;
#pragma unroll
            for (int ai = 0; ai < 2; ++ai)
#pragma unroll
                for (int m = 0; m < 4; ++m) { const int row = row0 + ai * HALF + m * 16; const float rs = rstd_of(ssq, row);
#pragma unroll
                    for (int bj = 0; bj < 2; ++bj) st16_wt(V + (size_t)row * DM_ + col0 + bj * HALF, pack8(acc[ai][bj][m][0] * rs, acc[ai][bj][m][1] * rs)); }
        }
    }
};

struct EpiSwiGLU8 {
    static constexpr bool PERM = true, AFTER_DRAIN = false;
    unsigned char* H; int ldh; int ncol;
    __device__ __forceinline__ void operator()(const f32x4 (&acc)[2][2][4][2], const Unit& u, int wr, int wc, int fr, int fq) const {
        const int row0 = u.pm * BM + wr * 64 + fr, col0 = (u.pn % ncol) * 128 + wc * 32 + 8 * fq; constexpr float cs = 1.0f / (F8_SA * F8_SWG);
#pragma unroll
        for (int ai = 0; ai < 2; ++ai)
#pragma unroll
            for (int m = 0; m < 4; ++m) { const int row = row0 + ai * HALF + m * 16; f32x4 h[2];
#pragma unroll
                for (int n = 0; n < 2; ++n) { const f32x4 a = acc[ai][0][m][n], b = acc[ai][1][m][n];
                    const f32x2 h0 = swiglu2((f32x2){a[0], a[1]}, (f32x2){b[0], b[1]}, -cs * LOG2E, 1.0f / (cs * cs * F8_SH)), h1 = swiglu2((f32x2){a[2], a[3]}, (f32x2){b[2], b[3]}, -cs * LOG2E, 1.0f / (cs * cs * F8_SH));
                    h[n] = (f32x4){h0.x, h0.y, h1.x, h1.y}; }
                u32x2 w; w.x = pk4_fp8(h[0][0], h[0][1], h[0][2], h[0][3]); w.y = pk4_fp8(h[1][0], h[1][1], h[1][2], h[1][3]);
                st8_wt(H + (size_t)row * ldh + col0, w.x, w.y); }
    }
};

struct EpiMoeDown {
    static constexpr bool PERM = true, AFTER_DRAIN = false;
    bf16_t* Y; const float* gate; float scale; float* Pp;
    __device__ __forceinline__ void operator()(const f32x4 (&acc)[2][2][4][2], const Unit& u, int wr, int wc, int fr, int fq) const {
        const int col0 = (u.pn & 3) * BM + wc * 32 + 8 * fq;
        if (u.aux >= 0) {
            float* base = Pp + ((size_t)u.aux * BM + wr * 64 + fr) * DM_ + col0;
#pragma unroll
            for (int ai = 0; ai < 2; ++ai)
#pragma unroll
                for (int m = 0; m < 4; ++m)
#pragma unroll
                    for (int bj = 0; bj < 2; ++bj) { float* p = base + (size_t)(ai * HALF + m * 16) * DM_ + bj * HALF; st16_wt(p, __builtin_bit_cast(u32x4, acc[ai][bj][m][0])); st16_wt(p + 4, __builtin_bit_cast(u32x4, acc[ai][bj][m][1])); }
            return; }
        const int row0 = u.pm * BM + wr * 64 + fr;
#pragma unroll
        for (int ai = 0; ai < 2; ++ai)
#pragma unroll
            for (int m = 0; m < 4; ++m) { const int row = row0 + ai * HALF + m * 16; const float gt = gate[row] * scale;
#pragma unroll
                for (int bj = 0; bj < 2; ++bj) st16_wt(Y + (size_t)row * DM_ + col0 + bj * HALF, pack8(acc[ai][bj][m][0] * gt, acc[ai][bj][m][1] * gt)); }
    }
};

struct MoeOrder {
    int nM, nN, nwg, G, c, T, P0, npieces; int t1, t2, t3, t4, t5, t6, t7;
    static constexpr int SPL = 7, PKT = 4;
    __device__ __forceinline__ void init(const int* meta, int nN_, int G_, int c_, bool split) {
        T = meta[8]; nM = split ? meta[9] : T; nN = nN_; nwg = nM * nN; G = G_; c = c_; t1 = meta[1]; t2 = meta[2]; t3 = meta[3]; t4 = meta[4]; t5 = meta[5]; t6 = meta[6]; t7 = meta[7];
        P0 = ((nwg + G - 1) / G) * G; npieces = (T - nM) * nN * SPL; }
    __device__ __forceinline__ int expert_of(int pm) const { return (pm >= t1) + (pm >= t2) + (pm >= t3) + (pm >= t4) + (pm >= t5) + (pm >= t6) + (pm >= t7); }
    __device__ __forceinline__ bool next(int i, Unit& u) const {
        const long L = (long)i * G + c;
        if (L >= nwg) { const long q = L - P0; if (q < 0 || q >= npieces) return false;
            const int rt = (int)q / (nN * SPL), rem = (int)q % (nN * SPL), pnl = rem / SPL, kp = rem % SPL;
            u.pm = nM + rt; u.pn = expert_of(u.pm) * nN + pnl; u.kt0 = kp * PKT; u.nkt = PKT; u.aux = rt * SPL + kp; return true; }
        int wgid = (int)L; { const int q = nwg / NXCD, r = nwg % NXCD, xcd = wgid % NXCD, off = wgid / NXCD; wgid = (xcd < r ? xcd * (q + 1) : r * (q + 1) + (xcd - r) * q) + off; }
        const int nig = WGM * nN, gid = wgid / nig, fm = gid * WGM, gsz = (nM - fm) < WGM ? (nM - fm) : WGM;
        const int pm = fm + ((wgid % nig) % gsz), pnl = (wgid % nig) / gsz;
        u.pm = pm; u.pn = expert_of(pm) * nN + pnl; u.kt0 = 0; u.nkt = 0; u.aux = -1; return true;
    }
    __device__ __forceinline__ void a_ready(const Unit&) const {}
    __device__ __forceinline__ void done(const Unit&) const {}
};
template <class Epi, class Sched, bool ALIGN_EPI = false, bool SP2 = false, bool F8 = false>
__device__ __forceinline__ void gemm_phase(PG8_LAS unsigned char* lds, const Gemm g, const Sched& S, const Epi& E) {
    const int tid = threadIdx.x, wid = __builtin_amdgcn_readfirstlane(tid >> 6), lane = tid & 63, wr = wid >> 2, wc = wid & 3, fr = lane & 15, fq = lane >> 4;
    int K_ = g.K; asm volatile("" : "+s"(K_));
    const int K = K_, nt = K / BK;
    unsigned voffA[2], voffB[2];
#pragma unroll
    for (int i = 0; i < 2; ++i) { int R, C; stage_rc(tid * 16 + i * 8192, R, C); const int Rb = Epi::PERM ? ((R & ~31) + perm32(R & 31)) : R;
        voffA[i] = (unsigned)(R * K + C) * 2u; voffB[i] = (unsigned)(Rb * K + C) * 2u; }
    const size_t kstep = (size_t)(BK * 2);
    const size_t hstep = (size_t)HALF * K * 2;
    const size_t tstep = 2 * hstep;
    const unsigned ldsw = (unsigned)wid * 1024u;
    const int aoff = lds_byte(wr * 64 + fr, fq * 8), boff = lds_byte(wc * 32 + fr, fq * 8);
    constexpr int KSTEP = 1024;
#define PG8_SA(b, h) (((b) * 2 + (h)) * HTB)
#define PG8_SB(b, h) ((4 + (b) * 2 + (h)) * HTB)
#define PG8_STAGE(bufoff, gbase, voff) do { _Pragma("unroll") for (int _i = 0; _i < 2; ++_i) \
        __builtin_amdgcn_global_load_lds((const unsigned*)((const char*)(gbase) + (voff)[_i]), (PG8_LAS unsigned*)(lds + (bufoff) + ldsw + _i * 8192), 16, 0, 0); } while (0)
#define PG8_LDA(dst, b, h) do { _Pragma("unroll") for (int m = 0; m < 4; ++m) _Pragma("unroll") for (int k = 0; k < 2; ++k) dst[m][k] = *(const PG8_LAS bf16x8*)(lds + PG8_SA(b, h) + aoff + m * 2048 + k * KSTEP); } while (0)
#define PG8_LDB(dst, b, h) do { _Pragma("unroll") for (int n = 0; n < 2; ++n) _Pragma("unroll") for (int k = 0; k < 2; ++k) dst[n][k] = *(const PG8_LAS bf16x8*)(lds + PG8_SB(b, h) + boff + n * 2048 + k * KSTEP); } while (0)
#define PG8_CAT8(x) __builtin_shufflevector(__builtin_bit_cast(i32x4, (x)[0]), __builtin_bit_cast(i32x4, (x)[1]), 0, 1, 2, 3, 4, 5, 6, 7)
#define PG8_MMA(ai, bj, At, Bt) do { __builtin_amdgcn_s_setprio(1); _Pragma("unroll") for (int m = 0; m < 4; ++m) _Pragma("unroll") for (int n = 0; n < 2; ++n) { \
        if constexpr (F8) asm volatile("s_nop 1\n\tv_mfma_f32_16x16x128_f8f6f4 %0, %1, %2, %0" : "+v"(acc[ai][bj][m][n]) : "v"(PG8_CAT8(Bt[n])), "v"(PG8_CAT8(At[m]))); \
        else { _Pragma("unroll") for (int k = 0; k < 2; ++k) acc[ai][bj][m][n] = __builtin_amdgcn_mfma_f32_16x16x32_bf16(Bt[n][k], At[m][k], acc[ai][bj][m][n], 0, 0, 0); } } \
        __builtin_amdgcn_s_setprio(0); } while (0)
#define PG8_MMA0(ai, bj, At, Bt) do { __builtin_amdgcn_s_setprio(1); _Pragma("unroll") for (int m = 0; m < 4; ++m) _Pragma("unroll") for (int n = 0; n < 2; ++n) \
        asm volatile("s_nop 1\n\tv_mfma_f32_16x16x128_f8f6f4 %0, %1, %2, 0" : "=&v"(acc[ai][bj][m][n]) : "v"(PG8_CAT8(Bt[n])), "v"(PG8_CAT8(At[m]))); \
        __builtin_amdgcn_s_setprio(0); } while (0)
#define PG8_MMAF(ai, bj, At, Bt) do { if constexpr (F8) { if (t == 0) PG8_MMA0(ai, bj, At, Bt); else PG8_MMA(ai, bj, At, Bt); } else PG8_MMA(ai, bj, At, Bt); } while (0)
#define PG8_WAIT_V(n) asm volatile("s_waitcnt vmcnt(" #n ")" ::: "memory")
#define PG8_WAIT_L(n) asm volatile("s_waitcnt lgkmcnt(" #n ")" ::: "memory")
#define PG8_BAR __builtin_amdgcn_s_barrier()
#define PG8_SCHED __builtin_amdgcn_sched_barrier(0)
    Unit cur, nxt; int ui = 0;
    if (!S.next(0, cur)) return;
    f32x4 acc[2][2][4][2];
    if constexpr (!F8) {
#pragma unroll
    for (int a = 0; a < 2; ++a)
#pragma unroll
        for (int b = 0; b < 2; ++b)
#pragma unroll
            for (int m = 0; m < 4; ++m)
#pragma unroll
                for (int n = 0; n < 2; ++n) acc[a][b][m][n] = (f32x4){0.f, 0.f, 0.f, 0.f};
    }
    bf16x8 At[4][2], B0[2][2], B1[2][2];
    const char* cA = (const char*)g.A + (size_t)cur.pm * tstep + (size_t)cur.kt0 * kstep; const char* cB = (const char*)g.Bt + (size_t)cur.pn * tstep + (size_t)cur.kt0 * kstep;
    S.a_ready(cur);
    if constexpr (SP2) {
        PG8_STAGE(PG8_SB(0, 0), cB, voffB); PG8_STAGE(PG8_SB(0, 1), cB + hstep, voffB); PG8_STAGE(PG8_SA(0, 0), cA, voffA); PG8_STAGE(PG8_SA(0, 1), cA + hstep, voffA);
        if (wr == 1) PG8_BAR;
        PG8_WAIT_V(2); PG8_BAR;
        PG8_STAGE(PG8_SB(1, 0), cB + kstep, voffB); PG8_STAGE(PG8_SA(1, 0), cA + kstep, voffA); PG8_STAGE(PG8_SB(1, 1), cB + hstep + kstep, voffB);
        PG8_WAIT_V(6); PG8_BAR;
    } else {
        PG8_STAGE(PG8_SB(0, 0), cB, voffB); PG8_STAGE(PG8_SA(0, 0), cA, voffA); PG8_STAGE(PG8_SB(0, 1), cB + hstep, voffB); PG8_STAGE(PG8_SA(0, 1), cA + hstep, voffA);
        if (wr == 1) PG8_BAR;
        PG8_WAIT_V(4); PG8_BAR;
        PG8_STAGE(PG8_SB(1, 0), cB + kstep, voffB); PG8_STAGE(PG8_SA(1, 0), cA + kstep, voffA); PG8_STAGE(PG8_SB(1, 1), cB + hstep + kstep, voffB);
        PG8_WAIT_V(6); PG8_BAR;
    }
    for (;;) {
        const bool has_next = S.next(ui + 1, nxt);
        const char* nA = has_next ? (const char*)g.A + (size_t)nxt.pm * tstep + (size_t)nxt.kt0 * kstep : cA; const char* nB = has_next ? (const char*)g.Bt + (size_t)nxt.pn * tstep + (size_t)nxt.kt0 * kstep : cB;
        const int ntu = cur.nkt ? cur.nkt : nt;
        for (int t = 0; t < ntu; t += 2) {
            const bool last = (t == ntu - 2);
            const char* a1 = cA + (size_t)(t + 1) * kstep;
            const char* a2 = last ? nA : cA + (size_t)(t + 2) * kstep; const char* b2 = last ? nB : cB + (size_t)(t + 2) * kstep;
            const char* a3 = a2 + kstep; const char* b3 = b2 + kstep;
            if (last && has_next) S.a_ready(nxt);
            if constexpr (SP2) {
            PG8_LDB(B0, 0, 0); PG8_LDB(B1, 0, 1); PG8_SCHED; PG8_LDA(At, 0, 0); PG8_STAGE(PG8_SA(1, 1), a1 + hstep, voffA);
            PG8_WAIT_V(8); PG8_WAIT_L(0); PG8_BAR; PG8_MMAF(0, 0, At, B0); PG8_MMAF(0, 1, At, B1); PG8_BAR; PG8_SCHED;
            PG8_LDA(At, 0, 1); PG8_STAGE(PG8_SB(0, 0), b2, voffB); PG8_STAGE(PG8_SB(0, 1), b2 + hstep, voffB); PG8_STAGE(PG8_SA(0, 0), a2, voffA);
            PG8_WAIT_V(8); PG8_WAIT_L(0); PG8_BAR; PG8_MMAF(1, 0, At, B0); PG8_MMAF(1, 1, At, B1); PG8_BAR; PG8_SCHED;
            PG8_LDB(B0, 1, 0); PG8_LDB(B1, 1, 1); PG8_SCHED; PG8_LDA(At, 1, 0); PG8_STAGE(PG8_SA(0, 1), a2 + hstep, voffA);
            PG8_WAIT_V(8); PG8_WAIT_L(0); PG8_BAR; PG8_MMA(0, 0, At, B0); PG8_MMA(0, 1, At, B1); PG8_BAR; PG8_SCHED;
            PG8_LDA(At, 1, 1); PG8_STAGE(PG8_SB(1, 0), b3, voffB); PG8_STAGE(PG8_SB(1, 1), b3 + hstep, voffB); PG8_STAGE(PG8_SA(1, 0), a3, voffA);
            PG8_WAIT_V(8); PG8_WAIT_L(0); PG8_BAR; PG8_MMA(1, 0, At, B0); PG8_MMA(1, 1, At, B1); PG8_BAR; PG8_SCHED;
            } else {
            PG8_LDB(B0, 0, 0); PG8_SCHED; PG8_LDA(At, 0, 0); PG8_STAGE(PG8_SA(1, 1), a1 + hstep, voffA);
            PG8_WAIT_L(8); PG8_BAR; PG8_WAIT_L(0); PG8_MMAF(0, 0, At, B0); PG8_BAR; PG8_SCHED;
            PG8_LDB(B1, 0, 1); PG8_STAGE(PG8_SB(0, 0), b2, voffB);
            PG8_BAR; PG8_WAIT_L(0); PG8_MMAF(0, 1, At, B1); PG8_BAR;
            PG8_LDA(At, 0, 1); PG8_STAGE(PG8_SA(0, 0), a2, voffA);
            PG8_BAR; PG8_WAIT_L(0); PG8_MMAF(1, 0, At, B0); PG8_BAR; PG8_SCHED;
            PG8_STAGE(PG8_SB(0, 1), b2 + hstep, voffB);
            PG8_WAIT_V(6); PG8_BAR; PG8_MMAF(1, 1, At, B1); PG8_BAR;
            PG8_LDB(B0, 1, 0); PG8_SCHED; PG8_LDA(At, 1, 0); PG8_STAGE(PG8_SA(0, 1), a2 + hstep, voffA);
            PG8_WAIT_L(8); PG8_BAR; PG8_WAIT_L(0); PG8_MMA(0, 0, At, B0); PG8_BAR; PG8_SCHED;
            PG8_LDB(B1, 1, 1); PG8_STAGE(PG8_SB(1, 0), b3, voffB);
            PG8_BAR; PG8_WAIT_L(0); PG8_MMA(0, 1, At, B1); PG8_BAR;
            PG8_LDA(At, 1, 1); PG8_STAGE(PG8_SA(1, 0), a3, voffA);
            PG8_BAR; PG8_WAIT_L(0); PG8_MMA(1, 0, At, B0); PG8_BAR; PG8_SCHED;
            PG8_STAGE(PG8_SB(1, 1), b3 + hstep, voffB);
            PG8_WAIT_V(6); PG8_BAR; PG8_MMA(1, 1, At, B1); PG8_BAR;
            }
        }
        if constexpr (F8) asm volatile("s_nop 15\n\ts_nop 15" ::: "memory");
        if constexpr (ALIGN_EPI) { if (wr == 0) PG8_BAR; }
        if constexpr (!Epi::AFTER_DRAIN) { E(acc, cur, wr, wc, fr, fq); S.done(cur); }
        if (!has_next) break;
        if constexpr (!F8) {
#pragma unroll
        for (int a = 0; a < 2; ++a)
#pragma unroll
            for (int b = 0; b < 2; ++b)
#pragma unroll
                for (int m = 0; m < 4; ++m)
#pragma unroll
                    for (int n = 0; n < 2; ++n) acc[a][b][m][n] = (f32x4){0.f, 0.f, 0.f, 0.f};
        }
        cur = nxt; cA = nA; cB = nB; ++ui;
        if constexpr (ALIGN_EPI) { if (wr == 1) PG8_BAR; }
    }
    PG8_WAIT_V(0);
    if constexpr (!ALIGN_EPI) { if (wr == 0) PG8_BAR; }
    PG8_BAR;
    if constexpr (Epi::AFTER_DRAIN) { E.fused(acc, cur, wr, wc, fr, fq, lds, wid, lane); S.done(cur); }
#undef PG8_SA
#undef PG8_SB
#undef PG8_STAGE
#undef PG8_LDA
#undef PG8_LDB
#undef PG8_MMA
#undef PG8_MMA0
#undef PG8_MMAF
#undef PG8_CAT8
#undef PG8_WAIT_V
#undef PG8_WAIT_L
#undef PG8_BAR
#undef PG8_SCHED
}
}
#include <hip/hip_bf16.h>
#include <cmath>
namespace attn_body {
using bf16=__hip_bfloat16;
using bf16x8=__attribute__((ext_vector_type(8)))short;
using s16x4=__attribute__((ext_vector_type(4)))short;
using f32x16=__attribute__((ext_vector_type(16)))float;
using u32x4=__attribute__((ext_vector_type(4)))unsigned;
constexpr int BATCH=8,NHEAD=16,SEQ=2048,D=64,DM=NHEAD*D;
constexpr int NW=8,QBLK=32,QB=QBLK*NW,KVBLK=64,NQB=SEQ/QB;
constexpr int ATTN_PITCH=DM, ATTN_UNIT_ROWS=QB;
__device__ __forceinline__ int crow(int r,int hi){return (r&3)+8*(r>>2)+4*hi;}
#define SBAR() __builtin_amdgcn_sched_barrier(0)
__device__ __forceinline__ void cmask(f32x16&p0,f32x16&p1,int jb,int qrel,int hi){
  const float NEG=-INFINITY; int kb=64*jb+4*hi;
  #pragma unroll
  for(int r=0;r<16;++r){int kv=kb+(r&3)+8*(r>>2); if(kv>qrel)p0[r]=NEG; if(kv+32>qrel)p1[r]=NEG;}
}

constexpr int NSLOT=3, SLOTB=8192;
constexpr int LDS_K=0, LDS_V=NSLOT*SLOTB, LDS_WS=3*NSLOT*SLOTB, LDS_QS=LDS_WS+NW*64*4, LDS_OST=LDS_QS+NW*4096, LDS_BYTES=LDS_OST+NW*4096;
constexpr float C2=0.125f*1.4426950408889634f;
__device__ __forceinline__ void glds16(const void*gsrc,unsigned lds_dst){unsigned keep;
  asm volatile("s_mov_b32 %0, m0\n\ts_mov_b32 m0, %2\n\ts_nop 0\n\tglobal_load_lds_dwordx4 %1, off\n\ts_mov_b32 m0, %0":"=&s"(keep):"v"(gsrc),"s"(lds_dst):"memory");}
__device__ __forceinline__ float max3f(float a,float b,float c){float r;asm("v_max3_f32 %0, %1, %2, %3":"=v"(r):"v"(a),"v"(b),"v"(c));return r;}
__device__ __forceinline__ float max2f(float a,float b){float r;asm("v_max_f32_e32 %0, %1, %2":"=v"(r):"v"(a),"v"(b));return r;}
__device__ __forceinline__ float fadd_s(float a,float b){float r;asm("v_add_f32_e32 %0, %1, %2":"=v"(r):"v"(a),"v"(b));return r;}
__device__ __forceinline__ float fsub_s(float a,float b){float r;asm("v_sub_f32_e32 %0, %1, %2":"=v"(r):"v"(a),"v"(b));return r;}
typedef float f32x2_t __attribute__((ext_vector_type(2))); typedef __bf16 bf16x2_t __attribute__((ext_vector_type(2)));
__device__ __forceinline__ unsigned cvtpk_s(float lo,float hi){f32x2_t v={lo,hi};bf16x2_t b=__builtin_convertvector(v,bf16x2_t);return __builtin_bit_cast(unsigned,b);}
#define WAIT_BAR(N) asm volatile("s_waitcnt vmcnt(" #N ") lgkmcnt(0)\n\ts_barrier":::"memory")

__device__ __forceinline__ void qkt(f32x16&p0,f32x16&p1,const char*Kslot,const bf16x8*qr,int r32,int hi){ const f32x16 negm=f32x16{};
  const char*kb=Kslot+hi*1024+r32*16;
  #pragma unroll
  for(int d0=0;d0<4;++d0){
    const bf16x8 b0=*reinterpret_cast<const bf16x8*>(kb+d0*2048);
    const bf16x8 b1=*reinterpret_cast<const bf16x8*>(kb+d0*2048+512);
    if(d0==0){p0=__builtin_amdgcn_mfma_f32_32x32x16_bf16(b0,qr[0],negm,0,0,0);p1=__builtin_amdgcn_mfma_f32_32x32x16_bf16(b1,qr[0],negm,0,0,0);}
    else{p0=__builtin_amdgcn_mfma_f32_32x32x16_bf16(b0,qr[d0],p0,0,0,0);p1=__builtin_amdgcn_mfma_f32_32x32x16_bf16(b1,qr[d0],p1,0,0,0);}}
}
typedef __attribute__((address_space(3))) const char* lds_cptr;
typedef short v4i16_t __attribute__((ext_vector_type(4)));
__device__ __forceinline__ void kload8(bf16x8*kf,lds_cptr kp){
  kf[0]=*(const __attribute__((address_space(3))) bf16x8*)(kp);      kf[1]=*(const __attribute__((address_space(3))) bf16x8*)(kp+512);
  kf[2]=*(const __attribute__((address_space(3))) bf16x8*)(kp+2048); kf[3]=*(const __attribute__((address_space(3))) bf16x8*)(kp+2560);
  kf[4]=*(const __attribute__((address_space(3))) bf16x8*)(kp+4096); kf[5]=*(const __attribute__((address_space(3))) bf16x8*)(kp+4608);
  kf[6]=*(const __attribute__((address_space(3))) bf16x8*)(kp+6144); kf[7]=*(const __attribute__((address_space(3))) bf16x8*)(kp+6656);
}
__device__ __forceinline__ void kload2(bf16x8*kf,lds_cptr kp,int j){ kf[2*j]=*(const __attribute__((address_space(3))) bf16x8*)(kp+j*2048); kf[2*j+1]=*(const __attribute__((address_space(3))) bf16x8*)(kp+j*2048+512); }
__device__ __forceinline__ s16x4 vtr(lds_cptr p){ return __builtin_bit_cast(s16x4,__builtin_amdgcn_ds_read_tr16_b64_v4i16((__attribute__((address_space(3))) v4i16_t*)p)); }
__device__ __forceinline__ float rowmax(const f32x16&p0,const f32x16&p1){
  float a=max3f(p0[0],p0[1],p1[0]),b=max3f(p0[2],p0[3],p1[1]);a=max3f(a,p1[2],p1[3]);
  #pragma unroll
  for(int r=4;r<16;r+=4){a=max3f(a,p0[r],p0[r+1]);b=max3f(b,p0[r+2],p0[r+3]);a=max3f(a,p1[r],p1[r+1]);b=max3f(b,p1[r+2],p1[r+3]);}
  const float m=max2f(a,b);
  auto rr=__builtin_amdgcn_permlane32_swap(__float_as_uint(m),__float_as_uint(m),false,false);
  return max2f(__uint_as_float(rr[0]),__uint_as_float(rr[1]));
}
__device__ __forceinline__ void pv(f32x16*o,int vb,bf16x8 pa0,bf16x8 pa1,bf16x8 pa2,bf16x8 pa3){
  #pragma unroll
  for(int d0=0;d0<4;++d0){s16x4 lo[4],hi[4];
    #pragma unroll
    for(int ks=0;ks<4;++ks){
      asm volatile("ds_read_b64_tr_b16 %0,%1 offset:%c2":"=&v"(lo[ks]):"v"(vb),"i"(d0*4096+ks*1024):"memory");
      asm volatile("ds_read_b64_tr_b16 %0,%1 offset:%c2":"=&v"(hi[ks]):"v"(vb),"i"(d0*4096+ks*1024+512):"memory");}
    asm volatile("s_waitcnt lgkmcnt(0)":::"memory");SBAR();
    #define PK(k) (bf16x8){lo[k][0],lo[k][1],lo[k][2],lo[k][3],hi[k][0],hi[k][1],hi[k][2],hi[k][3]}
    o[d0]=__builtin_amdgcn_mfma_f32_32x32x16_bf16(pa0,PK(0),o[d0],0,0,0);
    o[d0]=__builtin_amdgcn_mfma_f32_32x32x16_bf16(pa1,PK(1),o[d0],0,0,0);
    o[d0]=__builtin_amdgcn_mfma_f32_32x32x16_bf16(pa2,PK(2),o[d0],0,0,0);
    o[d0]=__builtin_amdgcn_mfma_f32_32x32x16_bf16(pa3,PK(3),o[d0],0,0,0);
    #undef PK
  }
}

#ifndef ATTN_STORE16
#define ATTN_STORE16(p,v) pg8::st16_wt((void*)(p),(v))
#endif
template<int THRL,int MODE> __device__ __forceinline__ void attn_unit(int b,int qcol,int vcol,int qb,const bf16*Q,const bf16*__restrict__ K,const bf16*__restrict__ V,bf16*O,char*shm,bf16*ON,float lam,const float*subn){
  int tid_=threadIdx.x; asm volatile("":"+v"(tid_));
  const int tid=tid_,lane=tid&63,r32=lane&31,hi=lane>>5; const int wid=__builtin_amdgcn_readfirstlane(tid>>6);
  const long rowbase=(long)b*SEQ; const int q0=qb*QB;
  const bf16*Qw=Q+(rowbase+q0+wid*QBLK)*DM+qcol;
  const bf16*Kh=K+rowbase*DM+qcol,*Vh=V+rowbase*DM+vcol;
  const unsigned lds0=(unsigned)(uintptr_t)shm;
  float*wsf=(float*)(shm+LDS_WS)+wid*64;
  const bf16*ksrc=Kh+(long)lane*DM+wid*8;
  const bf16*vsrc=Vh+(long)(16*(wid&3)+(lane>>2))*DM+(wid>>2)*32+(lane&3)*8;
  const unsigned kdst=lds0+LDS_K+wid*1024, vdst=lds0+LDS_V+wid*1024;
  #define DMA_K(t,slot) glds16(ksrc+(long)(t)*KVBLK*DM,(unsigned)__builtin_amdgcn_readfirstlane(kdst+(slot)))
  #define DMA_V(t,slot) do{ glds16(vsrc+(long)(t)*KVBLK*DM,(unsigned)__builtin_amdgcn_readfirstlane(vdst+2*(slot))); glds16(vsrc+(long)(t)*KVBLK*DM+64,(unsigned)__builtin_amdgcn_readfirstlane(vdst+2*(slot)+8192)); }while(0)
  const int vb0=(int)(lds0+LDS_V)+((lane>>4)&1)*32+(lane&3)*8+(4*hi+((lane&15)>>2))*64;
  const char*Kbase=shm+LDS_K; bf16x8 kf[8];
  const lds_cptr shm3=(lds_cptr)shm; const lds_cptr kp0=shm3+LDS_K+hi*1024+r32*16; const lds_cptr vp0=shm3+LDS_V+((lane>>4)&1)*32+(lane&3)*8+(4*hi+((lane&15)>>2))*64;
  const int NT=(q0+QB)/KVBLK;
  DMA_K(0,0);DMA_V(0,0);DMA_K(1,SLOTB);
  bf16x8 qr[4];
  #pragma unroll
  for(int d0=0;d0<4;++d0)qr[d0]=*reinterpret_cast<const bf16x8*>(&Qw[(long)r32*DM+d0*16+hi*8]);
  float mhat=0.f,l_reg=0.f;f32x16 o[4];o[0]=f32x16{};o[1]=f32x16{};o[2]=f32x16{};o[3]=f32x16{};
  typedef __attribute__((address_space(3))) bf16x8* lds_q8; const lds_cptr qp0=shm3+LDS_QS+wid*4096+lane*16;
  #define QF(j) (*(const __attribute__((address_space(3))) bf16x8*)(qp0+(j)*1024))
  const int qrel=wid*QBLK+r32;
  #define CMASK(P0,P1,t) do{int jb_=(t)-(NT-4); if(jb_>=0)cmask(P0,P1,jb_,qrel,hi);}while(0)
  bool resc=false;
  #define START(P0,P1) do{ resc=false; if constexpr(THRL>=0){ const float rm=rowmax(P0,P1); \
    { const float dl=rm; mhat=fadd_s(mhat,dl); \
      _Pragma("unroll") for(int r=0;r<16;++r){P0[r]=fsub_s(P0[r],dl);P1[r]=fsub_s(P1[r],dl);} } } \
    _Pragma("unroll") for(int r=0;r<16;++r)P0[r]=__builtin_amdgcn_exp2f(P0[r]); }while(0)
  #define RESC() do{ if(resc){ asm volatile("s_waitcnt lgkmcnt(0)":::"memory"); \
      _Pragma("unroll") for(int d_=0;d_<4;++d_) _Pragma("unroll") for(int r=0;r<16;++r)o[d_][r]*=wsf[crow(r,hi)]; } }while(0)
  f32x16 pA0,pA1,pB0,pB1;
  int sl_prev=0,sl_cur=0,sl_next=SLOTB;
  #define ROT() do{sl_prev=sl_cur;sl_cur=sl_next;sl_next=(sl_next==(NSLOT-1)*SLOTB)?0:sl_next+SLOTB;}while(0)
  DMA_K(2,2*SLOTB);
  _Pragma("unroll") for(int d0=0;d0<4;++d0)*(__attribute__((address_space(3))) bf16x8*)(__attribute__((address_space(3))) char*)(qp0+d0*1024)=qr[d0];
  WAIT_BAR(4);
  qkt(pA0,pA1,Kbase,qr,r32,hi);asm volatile("s_nop 15\n\ts_nop 7":"+v"(pA0),"+v"(pA1));CMASK(pA0,pA1,0);
  START(pA0,pA1);
  _Pragma("unroll") for(int r=0;r<16;++r)pA1[r]=__builtin_amdgcn_exp2f(pA1[r]);
  WAIT_BAR(0);
  DMA_K(3,0);DMA_V(1,SLOTB);
  ROT();
  kload8(kf,kp0+sl_cur);
  bf16x8 qa=QF(0),qb_=QF(1);
  WAIT_BAR(3);
  s16x4 vlo[8],vhi[8]; u32x4 pw0,pw1,pw2,pw3;
  #define PKW(P,B) cvtpk_s(P[B],P[B+1])
  #define PAF(k) __builtin_bit_cast(bf16x8,pw##k)
  #define VFR(i) (bf16x8){vlo[i][0],vlo[i][1],vlo[i][2],vlo[i][3],vhi[i][0],vhi[i][1],vhi[i][2],vhi[i][3]}
  #define PIN(x) asm volatile("":"+v"(x))
  #define MX3(a,b,c) __builtin_fmaxf(__builtin_fmaxf((a),(b)),(c))
  #define GAPA(MF,A0,A1,A2,A3,W0,W1,PW) do{ MF; sacc+=A0; sacc+=A1; sacc+=A2; sacc+=A3; PIN(sacc); W0; W1; PIN(PW); SBAR(); }while(0)
  #define EX(v) __builtin_amdgcn_exp2f(v)
  #define GAPB(MF,X,B) do{ MF; X[B]=EX(X[B]); X[B+1]=EX(X[B+1]); PIN(X); SBAR(); }while(0)
  #define VRD(i) do{ vlo[i]=vtr(vp_+(((i)>>2)*4096+((i)&3)*1024)); vhi[i]=vtr(vp_+(((i)>>2)*4096+((i)&3)*1024+512)); }while(0)
  #define VRDX(reg,fr) do{ vlo[reg]=vtr(vp_+(((fr)>>2)*4096+((fr)&3)*1024)); vhi[reg]=vtr(vp_+(((fr)>>2)*4096+((fr)&3)*1024+512)); SBAR(); }while(0)
  #define KRD(G,j) do{ if(G){ kload2(kf,kp0+sl_next,j); SBAR(); } }while(0)
  #define ZC f32x16{}
  #define STEP(C0,C1,P0,P1,t,GK,GV,GL) do{ SBAR(); \
    const lds_cptr vp_=vp0+2*sl_prev; \
    VRD(0); SBAR(); float sacc=(P0[0]+P0[1]); \
    GAPA(C0=__builtin_amdgcn_mfma_f32_32x32x16_bf16(kf[0],qa,ZC,0,0,0), P0[2],P0[3],P0[4],P0[5],     pw0[0]=PKW(P0,0), pw0[1]=PKW(P0,2), pw0); \
    VRD(4); SBAR(); GAPA(C1=__builtin_amdgcn_mfma_f32_32x32x16_bf16(kf[1],qa,ZC,0,0,0), P0[6],P0[7],P0[8],P0[9],     pw0[2]=PKW(P0,4), pw0[3]=PKW(P0,6), pw0); \
    qa=QF(2); SBAR(); \
    VRD(1); SBAR(); GAPA(C0=__builtin_amdgcn_mfma_f32_32x32x16_bf16(kf[2],qb_,C0,0,0,0),   P0[10],P0[11],P0[12],P0[13], pw1[0]=PKW(P0,8), pw1[1]=PKW(P0,10), pw1); \
    VRD(5); SBAR(); GAPA(C1=__builtin_amdgcn_mfma_f32_32x32x16_bf16(kf[3],qb_,C1,0,0,0),   P0[14],P0[15],P1[0],P1[1],   pw1[2]=PKW(P0,12),pw1[3]=PKW(P0,14), pw1); \
    qb_=QF(3); SBAR(); \
    VRD(2); SBAR(); GAPA(C0=__builtin_amdgcn_mfma_f32_32x32x16_bf16(kf[4],qa,C0,0,0,0),   P1[2],P1[3],P1[4],P1[5],     pw2[0]=PKW(P1,0), pw2[1]=PKW(P1,2), pw2); \
    VRD(6); SBAR(); GAPA(C1=__builtin_amdgcn_mfma_f32_32x32x16_bf16(kf[5],qa,C1,0,0,0),   P1[6],P1[7],P1[8],P1[9],     pw2[2]=PKW(P1,4), pw2[3]=PKW(P1,6), pw2); \
    VRD(3); SBAR(); GAPA(C0=__builtin_amdgcn_mfma_f32_32x32x16_bf16(kf[6],qb_,C0,0,0,0),   P1[10],P1[11],P1[12],P1[13], pw3[0]=PKW(P1,8), pw3[1]=PKW(P1,10), pw3); \
    VRD(7); SBAR(); GAPA(C1=__builtin_amdgcn_mfma_f32_32x32x16_bf16(kf[7],qb_,C1,0,0,0),   P1[14],P1[15],0.f,0.f,       pw3[2]=PKW(P1,12),pw3[3]=PKW(P1,14), pw3); \
    l_reg+=sacc; \
    if(GK){DMA_K((t)+3,sl_cur);} if(GV){DMA_V((t)+1,sl_next);} \
    CMASK(C0,C1,t); \
    if constexpr(THRL>=0){ float a=MX3(C0[0],C0[1],C1[0]),b=MX3(C0[2],C0[3],C1[1]); a=MX3(a,C1[2],C1[3]); \
      _Pragma("unroll") for(int r=4;r<16;r+=4){a=MX3(a,C0[r],C0[r+1]);b=MX3(b,C0[r+2],C0[r+3]);a=MX3(a,C1[r],C1[r+1]);b=MX3(b,C1[r+2],C1[r+3]);} \
      float rm=__builtin_fmaxf(a,b); { auto rr=__builtin_amdgcn_permlane32_swap(__float_as_uint(rm),__float_as_uint(rm),false,false); rm=__builtin_fmaxf(__uint_as_float(rr[0]),__uint_as_float(rr[1])); } \
      rm-=mhat; resc=false;                                      \
      if(__builtin_expect(__any(rm>(float)THRL),0)){ const float dl=__builtin_fmaxf(rm,0.f); mhat+=dl; \
        const float f=__builtin_amdgcn_exp2f(-dl); l_reg*=f; if(hi==0)wsf[r32]=f; resc=true; } \
      _Pragma("unroll") for(int r=0;r<16;++r){C0[r]-=mhat;C1[r]-=mhat;} } \
    SBAR(); \
    GAPB(o[0]=__builtin_amdgcn_mfma_f32_32x32x16_bf16(PAF(0),VFR(0),o[0],0,0,0), C0,0);  VRDX(0,8); \
    GAPB(o[1]=__builtin_amdgcn_mfma_f32_32x32x16_bf16(PAF(0),VFR(4),o[1],0,0,0), C0,2);  VRDX(4,12); \
    GAPB(o[0]=__builtin_amdgcn_mfma_f32_32x32x16_bf16(PAF(1),VFR(1),o[0],0,0,0), C0,4);  VRDX(1,9); \
    GAPB(o[1]=__builtin_amdgcn_mfma_f32_32x32x16_bf16(PAF(1),VFR(5),o[1],0,0,0), C0,6);  VRDX(5,13); \
    GAPB(o[0]=__builtin_amdgcn_mfma_f32_32x32x16_bf16(PAF(2),VFR(2),o[0],0,0,0), C0,8);  VRDX(2,10); \
    GAPB(o[1]=__builtin_amdgcn_mfma_f32_32x32x16_bf16(PAF(2),VFR(6),o[1],0,0,0), C0,10); VRDX(6,14); \
    GAPB(o[0]=__builtin_amdgcn_mfma_f32_32x32x16_bf16(PAF(3),VFR(3),o[0],0,0,0), C0,12); VRDX(3,11); \
    GAPB(o[1]=__builtin_amdgcn_mfma_f32_32x32x16_bf16(PAF(3),VFR(7),o[1],0,0,0), C0,14); VRDX(7,15); \
    KRD(GL,0); GAPB(o[2]=__builtin_amdgcn_mfma_f32_32x32x16_bf16(PAF(0),VFR(0),o[2],0,0,0), C1,0); \
    KRD(GL,1); GAPB(o[3]=__builtin_amdgcn_mfma_f32_32x32x16_bf16(PAF(0),VFR(4),o[3],0,0,0), C1,2); \
    KRD(GL,2); GAPB(o[2]=__builtin_amdgcn_mfma_f32_32x32x16_bf16(PAF(1),VFR(1),o[2],0,0,0), C1,4); \
    KRD(GL,3); GAPB(o[3]=__builtin_amdgcn_mfma_f32_32x32x16_bf16(PAF(1),VFR(5),o[3],0,0,0), C1,6); \
    GAPB(o[2]=__builtin_amdgcn_mfma_f32_32x32x16_bf16(PAF(2),VFR(2),o[2],0,0,0), C1,8); \
    GAPB(o[3]=__builtin_amdgcn_mfma_f32_32x32x16_bf16(PAF(2),VFR(6),o[3],0,0,0), C1,10); \
    qa=QF(0); SBAR(); \
    GAPB(o[2]=__builtin_amdgcn_mfma_f32_32x32x16_bf16(PAF(3),VFR(3),o[2],0,0,0), C1,12); \
    qb_=QF(1); SBAR(); \
    GAPB(o[3]=__builtin_amdgcn_mfma_f32_32x32x16_bf16(PAF(3),VFR(7),o[3],0,0,0), C1,14); \
    }while(0)
  int t=1;
  #undef CMASK
  #define CMASK(P0,P1,t) do{}while(0)
  for(;t+5<NT;t+=2){
    STEP(pB0,pB1,pA0,pA1,t,true,true,true);     WAIT_BAR(3); RESC(); ROT();
    STEP(pA0,pA1,pB0,pB1,t+1,true,true,true);   WAIT_BAR(3); RESC(); ROT();
  }
  #undef CMASK
  #define CMASK(P0,P1,t) do{int jb_=(t)-(NT-4); if(jb_>=0)cmask(P0,P1,jb_,qrel,hi);}while(0)
  #define ENDW(tt) do{ if((tt)+3<NT){WAIT_BAR(3);} else if((tt)+2<NT){WAIT_BAR(2);} else {WAIT_BAR(0);} }while(0)
  for(;t+1<NT;t+=2){
    STEP(pB0,pB1,pA0,pA1,t,(t+3<NT),(t+1<NT),(t+1<NT));       ENDW(t);   RESC(); ROT();
    STEP(pA0,pA1,pB0,pB1,t+1,(t+4<NT),(t+2<NT),(t+2<NT));     ENDW(t+1); RESC(); ROT();
  }
  STEP(pB0,pB1,pA0,pA1,NT-1,false,false,false); RESC();
  { float sacc=pB0[0]+pB0[1]; _Pragma("unroll") for(int r=2;r<16;++r)sacc+=pB0[r]; _Pragma("unroll") for(int r=0;r<16;++r)sacc+=pB1[r]; l_reg+=sacc;
    pw0=(u32x4){PKW(pB0,0),PKW(pB0,2),PKW(pB0,4),PKW(pB0,6)};pw1=(u32x4){PKW(pB0,8),PKW(pB0,10),PKW(pB0,12),PKW(pB0,14)};pw2=(u32x4){PKW(pB1,0),PKW(pB1,2),PKW(pB1,4),PKW(pB1,6)};pw3=(u32x4){PKW(pB1,8),PKW(pB1,10),PKW(pB1,12),PKW(pB1,14)};
    SBAR(); pv(o,vb0+2*sl_cur,PAF(0),PAF(1),PAF(2),PAF(3)); }
  #undef PKW
  #undef PAF
  #undef VFR
  #undef PIN
  #undef MX3
  #undef GAPA
  #undef GAPB
  #undef EX
  #undef VRD
  #undef VRDX
  #undef ZC
  #undef QF
  #undef KRD
  #undef STEP
  #undef ENDW
  {auto rr=__builtin_amdgcn_permlane32_swap(__float_as_uint(l_reg),__float_as_uint(l_reg),false,false);l_reg=__uint_as_float(rr[0])+__uint_as_float(rr[1]);}
  if(hi==0)wsf[32+r32]=l_reg;asm volatile("s_waitcnt lgkmcnt(0)":::"memory");
  float rli[16];
  #pragma unroll
  for(int r=0;r<16;++r)rli[r]=__builtin_amdgcn_rcpf(wsf[32+crow(r,hi)]);
  bf16*Ow=O+(rowbase+q0+wid*QBLK)*DM+vcol;
  if constexpr(MODE==0){ bf16*stg=(bf16*)(shm+LDS_OST)+wid*2048;
    #pragma unroll
    for(int hf=0;hf<2;++hf){
      #pragma unroll
      for(int r=0;r<16;++r){const int orow=crow(r,hi);
        #pragma unroll
        for(int d0=0;d0<2;++d0)stg[orow*64+d0*32+r32]=__float2bfloat16(o[2*hf+d0][r]*rli[r]);}
      asm volatile("s_waitcnt lgkmcnt(0)":::"memory");
      #pragma unroll
      for(int i=0;i<4;++i){const int row=i*8+(lane>>3),ch=lane&7; const u32x4 v=*(const u32x4*)(stg+row*64+ch*8); ATTN_STORE16(Ow+(long)row*DM+hf*64+ch*8,v);}
      asm volatile("s_waitcnt lgkmcnt(0)":::"memory"); } }
  else { bf16*stg0=(bf16*)(shm+LDS_OST)+wid*2048,*stg1=(bf16*)(shm+LDS_QS)+wid*2048;
    #pragma unroll
    for(int r=0;r<16;++r){const int orow=crow(r,hi);
      #pragma unroll
      for(int d0=0;d0<2;++d0){stg0[orow*64+d0*32+r32]=__float2bfloat16(o[d0][r]*rli[r]);stg1[orow*64+d0*32+r32]=__float2bfloat16(o[2+d0][r]*rli[r]);}}
    asm volatile("s_waitcnt vmcnt(0) lgkmcnt(0)":::"memory");
    const int ch=lane&7; float g0[8],g1[8];
    #pragma unroll
    for(int j=0;j<8;++j){g0[j]=subn[ch*8+j];g1[j]=subn[64+ch*8+j];}
    bf16*ONw=ON+(rowbase+q0+wid*QBLK)*DM+vcol;
    #pragma unroll
    for(int i=0;i<4;++i){const int row=i*8+(lane>>3);
      const u32x4 a0=*(const u32x4*)(stg0+row*64+ch*8),a1=*(const u32x4*)(stg1+row*64+ch*8);
      const u32x4 b0=*(const u32x4*)(Ow+(long)row*DM+ch*8),b1=*(const u32x4*)(Ow+(long)row*DM+64+ch*8);
      float d[16];
      #pragma unroll
      for(int j=0;j<4;++j){
        d[2*j]  =__uint_as_float(b0[j]<<16)        -lam*__uint_as_float(a0[j]<<16);
        d[2*j+1]=__uint_as_float(b0[j]&0xffff0000u)-lam*__uint_as_float(a0[j]&0xffff0000u);
        d[8+2*j]  =__uint_as_float(b1[j]<<16)        -lam*__uint_as_float(a1[j]<<16);
        d[8+2*j+1]=__uint_as_float(b1[j]&0xffff0000u)-lam*__uint_as_float(a1[j]&0xffff0000u);}
      float ss=0.f;
      #pragma unroll
      for(int j=0;j<16;++j)ss+=d[j]*d[j];
      ss+=__shfl_xor(ss,1);ss+=__shfl_xor(ss,2);ss+=__shfl_xor(ss,4);
      const float rs=__builtin_amdgcn_rsqf(ss*(1.0f/128.0f)+1e-6f);
      u32x4 w0,w1;
      #pragma unroll
      for(int j=0;j<4;++j){w0[j]=cvtpk_s(d[2*j]*rs*g0[2*j],d[2*j+1]*rs*g0[2*j+1]);w1[j]=cvtpk_s(d[8+2*j]*rs*g1[2*j],d[8+2*j+1]*rs*g1[2*j+1]);}
      ATTN_STORE16(ONw+(long)row*DM+ch*8,w0);ATTN_STORE16(ONw+(long)row*DM+64+ch*8,w1);}
    asm volatile("s_waitcnt lgkmcnt(0)":::"memory"); }
  asm volatile("s_waitcnt lgkmcnt(0)\n\ts_barrier":::"memory");
  #undef DMA_K
  #undef DMA_V
  #undef CMASK
  #undef START
  #undef RESC
  #undef ROT
}
constexpr int ATTN_LDS_BYTES=LDS_BYTES;
#undef SBAR
#undef WAIT_BAR
}
constexpr int NWAVES = 8;
constexpr int NPH = 15;
constexpr size_t MiB = 1u << 20;
constexpr size_t WS_CTL = 0, CTL_ZERO_BYTES = 1 * MiB;
constexpr size_t WS_W_IN = 1 * MiB;
constexpr size_t WS_W_OUT = WS_W_IN + (size_t)3072 * 1024 * 2;
constexpr size_t WS_W_GU = WS_W_OUT + (size_t)1024 * 1024 * 2;
constexpr size_t WS_W_DN = WS_W_GU + (size_t)5632 * 1024 * 2;
constexpr size_t WS_W_QKV = WS_W_DN + (size_t)1024 * 2816 * 2;
constexpr size_t WS_W_O = WS_W_QKV + (size_t)3072 * 1024 * 2;
constexpr size_t WS_W_MGU = WS_W_O + (size_t)1024 * 1024 * 2;
constexpr size_t WS_W_MDN = WS_W_MGU + (size_t)8 * 7168 * 1024 * 2;
constexpr size_t WS_W_END = WS_W_MDN + (size_t)8 * 1024 * 3584 * 2;
constexpr size_t WS_R = 202 * MiB;
constexpr size_t ACT = (size_t)M * D * 2;
constexpr size_t WS_XN0 = WS_R, WS_BB = WS_R + ACT, WS_UB = WS_R + 2 * ACT, WS_G = WS_R + 3 * ACT;
constexpr size_t WS_HACT = WS_R;
constexpr size_t WS_Q = WS_R + 4 * ACT, WS_K = WS_R + 5 * ACT, WS_V = WS_R + 6 * ACT;
constexpr size_t WS_X8 = WS_R + 5 * ACT;
constexpr size_t WS_O0 = WS_R, WS_O1 = WS_R + ACT, WS_ON = WS_R + 2 * ACT;
constexpr size_t WS_HM = WS_R;
constexpr size_t WS_PP = WS_R + 128 * MiB;
constexpr size_t WS_S = 440 * MiB;
constexpr size_t WS_XG = WS_S, WS_Y = WS_S + 68 * MiB;
constexpr size_t WS_XB = 632 * MiB;
constexpr size_t WS_HB = 664 * MiB, WS_HB2 = 696 * MiB, WS_YF = 728 * MiB;
constexpr size_t WS_SMALL = 792 * MiB;
constexpr size_t WS_SSQ = WS_SMALL;
constexpr size_t WS_SEL = WS_SMALL + 256 * 1024, WS_GATE = WS_SEL + 128 * 1024, WS_TOKSLOT = WS_GATE + 128 * 1024;
constexpr size_t WS_RSTDS = WS_TOKSLOT + 128 * 1024, WS_GATES = WS_RSTDS + 256 * 1024;
constexpr size_t WS_HIST = WS_GATES + 256 * 1024, WS_META = WS_HIST + 16 * 1024;
constexpr size_t WS_NAIVE_SMALL = WS_SMALL + 2 * MiB;
constexpr size_t WS_END = 796 * MiB;
static_assert(WS_W_END <= WS_R && WS_R + (size_t)SLOTS * DFE * 2 <= WS_S && WS_Y + (size_t)SLOTS * D * 2 <= WS_XB && WS_V + ACT <= WS_S, "d_ws map");
constexpr int CW_TMO = 0, CW_CODE = 1, CW_BAR = 4096;
constexpr int MISC_OFF = 0, RING_OFF = 1024, RING_BYTES = 131072, LDS_BYTES = 147456;
constexpr int P0_SCR = 16640;

#define GAS __attribute__((address_space(1)))
#define LAS __attribute__((address_space(3)))
typedef unsigned v4u __attribute__((ext_vector_type(4)));
typedef unsigned v2u __attribute__((ext_vector_type(2)));
typedef GAS unsigned gu32;
#define RLX_AGENT __ATOMIC_RELAXED, __HIP_MEMORY_SCOPE_AGENT
#define LDS_WAIT() asm volatile("s_waitcnt lgkmcnt(0)" ::: "memory")
#define VM_WAIT() asm volatile("s_waitcnt vmcnt(0)" ::: "memory")
__device__ __forceinline__ unsigned pk2(float lo, float hi) { return f2bf(lo) | (f2bf(hi) << 16); }
__device__ __forceinline__ float bflo(unsigned w) { return __builtin_bit_cast(float, w << 16); }
__device__ __forceinline__ float bfhi(unsigned w) { return __builtin_bit_cast(float, w & 0xffff0000u); }

#define XB_TMO      128
#define XB_XCNT(j)  (256  + 64 * (j))
#define XB_XSUB(j)  (1280 + 64 * (j))
#define XB_XGEN(j)  (2304 + 64 * (j))
#define XB_TOP      3328
#define XB_TOPGEN   3392
#define XCD_BAR_WORDS 3456
#define XB_SPIN_CAP (1u << 18)

__device__ __forceinline__ unsigned xb_ld(unsigned* p)              { return __hip_atomic_load(p, __ATOMIC_RELAXED, __HIP_MEMORY_SCOPE_AGENT); }
__device__ __forceinline__ unsigned xb_add(unsigned* p, unsigned v) { return __hip_atomic_fetch_add(p, v, __ATOMIC_RELAXED, __HIP_MEMORY_SCOPE_AGENT); }
__device__ __forceinline__ unsigned xb_xcc_id() { return (unsigned)__builtin_amdgcn_s_getreg((3 << 11) | 20) & 0xFu; }
#define XB_SPIN(cond, bar) do { unsigned _sp = 0; while (cond) { __builtin_amdgcn_s_sleep(1); \
    if ((++_sp & 255u) == 0u) { if (xb_ld(&(bar)[XB_TMO])) break; if (_sp > XB_SPIN_CAP) { atomicAdd(&(bar)[XB_TMO], 1u); break; } } } } while (0)

struct XcdBarrier {
    unsigned* bar; unsigned x;
    volatile LAS unsigned* st;
};

__device__ __forceinline__ XcdBarrier xcd_barrier_post(unsigned* bar, volatile LAS unsigned* st) {
    XcdBarrier b; b.bar = bar; b.x = xb_xcc_id(); b.st = st;
    if (threadIdx.x == 0) (void)xb_add(&bar[XB_XCNT(b.x)], 1u);
    return b;
}
__device__ __forceinline__ void xcd_barrier_complete(unsigned* bar, unsigned x, unsigned& nloc, unsigned& nx) {
    const unsigned G = gridDim.x * gridDim.y * gridDim.z;
    unsigned sum, cnt, mine, sp = 0u;
    for (;;) {
        sum = 0u; cnt = 0u; mine = 0u;
#pragma unroll
        for (unsigned j = 0; j < 16; ++j) { const unsigned c = xb_ld(&bar[XB_XCNT(j)]); sum += c; cnt += (c > 0u) ? 1u : 0u; mine = (j == x) ? c : mine; }
        if (sum == G) break;
        __builtin_amdgcn_s_sleep(1);
        if ((++sp & 255u) == 0u) { if (xb_ld(&bar[XB_TMO])) break; if (sp > XB_SPIN_CAP) { atomicAdd(&bar[XB_TMO], 1u); break; } }
    }
    nloc = mine > 0u ? mine : 1u; nx = cnt > 0u ? cnt : 1u;
}

__device__ __forceinline__ void xcd_barrier(const XcdBarrier& b) {
    asm volatile("s_waitcnt vmcnt(0)" ::: "memory");
    __syncthreads();
    if (threadIdx.x == 0) {
        unsigned* bar = b.bar;
        __builtin_amdgcn_s_waitcnt(0);
        unsigned nloc = b.st[0], nx = b.st[1];
        if (nloc == 0u) { xcd_barrier_complete(bar, b.x, nloc, nx); b.st[0] = nloc; b.st[1] = nx; }
        const unsigned old = xb_add(&bar[XB_XSUB(b.x)], 1u);
        const unsigned gen = old / nloc;
        if (old + 1u == (gen + 1u) * nloc) {
            __builtin_amdgcn_fence(__ATOMIC_RELEASE, "agent");
            asm volatile("s_waitcnt vmcnt(0)" ::: "memory");
            const unsigned og = xb_add(&bar[XB_TOP], 1u);
            const unsigned tg = og / nx;
            if (og + 1u == (tg + 1u) * nx) xb_add(&bar[XB_TOPGEN], 1u);
            else XB_SPIN(xb_ld(&bar[XB_TOPGEN]) == tg, bar);
            __builtin_amdgcn_fence(__ATOMIC_ACQUIRE, "agent");
            xb_add(&bar[XB_XGEN(b.x)], 1u);
            asm volatile("s_waitcnt vmcnt(0)" ::: "memory");
        } else {
            XB_SPIN(xb_ld(&bar[XB_XGEN(b.x)]) == gen, bar);
            __builtin_amdgcn_fence(__ATOMIC_ACQUIRE, "agent");
            asm volatile("s_waitcnt vmcnt(0)" ::: "memory");
        }
    }
    __syncthreads();
}


struct Args { const float* in[19]; float* out; unsigned char* wsp; int ph_lo, ph_hi, li, jobmask; };
struct Frame { LAS unsigned char* lds; int tid, lane, wave, vcu, G; };
#define KA ((const Args*)__builtin_amdgcn_kernarg_segment_ptr())
#define INP(i) (KA->in[i])
#define A_WS (KA->wsp)
#define A_OUT (KA->out)

__device__ __forceinline__ int p0_dstrow(int mode, int aux, int col) {
    if (mode == 1) { if (col < 1024) return col; const int v = col >= 2048, cc = col - (v ? 2048 : 1024); return 1024 + 256 * (cc >> 7) + 128 * v + (cc & 127); }
    if (mode == 2) { const int up = col >= aux, cc = col - (up ? aux : 0); return 256 * (cc >> 7) + 128 * up + (cc & 127); }
    if (mode == 3) { const int g = col >> 6, bj = (col >> 5) & 1; return 256 * (g >> 2) + 32 * (4 * bj + (g & 3)) + (col & 31); }
    return col;
}
struct P0Item { const float* src; const float* gain; unsigned char* dst; int ldw, K, k0, d0, d1, f8; float sc; };
#define P0_JOB(SRC, LDW, KK, C0, NCOLS, GAIN, DSTOFF, DROW0, DSTROWS, MODE, AUX, NMAT, SC, F8) { \
    constexpr int nn_ = (NCOLS) / 64, per_ = ((KK) / 64) * nn_, cnt_ = per_ * (NMAT); \
    if (it < cnt_) { const int mat = it / per_, r = it % per_, kb = r / nn_, col = 64 * (r % nn_); \
        I.src = (SRC) + (size_t)mat * (KK) * (LDW) + (C0) + col; I.gain = (GAIN); I.dst = A_WS + (DSTOFF) + (size_t)mat * (DSTROWS) * (KK) * ((F8) ? 1 : 2); \
        I.ldw = (LDW); I.K = (KK); I.k0 = 64 * kb; I.d0 = (DROW0) + p0_dstrow(MODE, AUX, col); I.d1 = (DROW0) + p0_dstrow(MODE, AUX, col + 32); I.f8 = (F8); I.sc = (SC); return; } \
    it -= cnt_; }
constexpr int P0_NITEMS = 16 * 48 + 16 * 16 + 16 * 88 + 44 * 16 + 3 * 16 * 16 + 16 * 16 + 8 * 16 * 112 + 8 * 56 * 16;
__device__ __forceinline__ void p0_decode(int it, P0Item& I) {
    P0_JOB(INP(3), 3072, 1024, 0, 3072, nullptr, WS_W_IN, 0, 3072, 1, 0, 1, 1.0f, 0)
    P0_JOB(INP(5), 1024, 1024, 0, 1024, nullptr, WS_W_OUT, 0, 1024, 0, 0, 1, 1.0f, 0)
    P0_JOB(INP(14), 5632, 1024, 0, 5632, INP(2), WS_W_GU, 0, 5632, 2, 2816, 1, pg8::F8_SWGD, 1)
    P0_JOB(INP(15), 1024, 2816, 0, 1024, nullptr, WS_W_DN, 0, 1024, 0, 0, 1, pg8::F8_SWDD, 1)
    P0_JOB(INP(9), 1024, 1024, 0, 1024, INP(1) + 1024, WS_W_QKV, 0, 3072, 3, 0, 1, 1.0f, 0)
    P0_JOB(INP(7), 2048, 1024, 0, 1024, INP(6), WS_W_QKV, 1024, 3072, 3, 0, 1, 1.0f, 0)
    P0_JOB(INP(7), 2048, 1024, 1024, 1024, INP(6), WS_W_QKV, 2048, 3072, 0, 0, 1, 1.0f, 0)
    P0_JOB(INP(13), 1024, 1024, 0, 1024, nullptr, WS_W_O, 0, 1024, 0, 0, 1, 1.0f, 0)
    P0_JOB(INP(17), 7168, 1024, 0, 7168, INP(2) + 1024, WS_W_MGU, 0, 7168, 2, 3584, 8, pg8::F8_SWG, 1)
    P0_JOB(INP(18), 1024, 3584, 0, 1024, nullptr, WS_W_MDN, 0, 1024, 0, 0, 8, pg8::F8_SWD, 1)
}
#undef P0_JOB
struct P0Regs { f32x4 v[16]; float g[16]; };
__device__ __forceinline__ void p0_load(const P0Item& I, P0Regs& R, int lane) {
    const int lr = lane >> 4, lc = lane & 15;
#pragma unroll
    for (int i = 0; i < 16; ++i) R.v[i] = __builtin_nontemporal_load((const GAS f32x4*)(I.src + (size_t)(I.k0 + 4 * i + lr) * I.ldw + 4 * lc));
    if (I.gain) {
#pragma unroll
        for (int i = 0; i < 16; ++i) R.g[i] = I.gain[I.k0 + 4 * i + lr];
    } else {
#pragma unroll
        for (int i = 0; i < 16; ++i) R.g[i] = 1.0f;
    }
}
__device__ __forceinline__ void p0_store(const P0Item& I, const P0Regs& R, LAS float* scr, int lane) {
    const int lr = lane >> 4, lc = lane & 15;
#pragma unroll
    for (int i = 0; i < 16; ++i) { const f32x4 w = R.v[i] * (R.g[i] * I.sc); LAS float* p = scr + (4 * i + lr) * 65 + 4 * lc; p[0] = w[0]; p[1] = w[1]; p[2] = w[2]; p[3] = w[3]; }
    LDS_WAIT(); asm volatile("" ::: "memory");
    const int c = lane & 7;
#pragma unroll
    for (int jj = 0; jj < 8; ++jj) { const int nl = 8 * jj + (lane >> 3); const LAS float* s = scr + (8 * c) * 65 + nl;
        const int drow = (jj < 4 ? I.d0 : I.d1 - 32) + nl;
        if (I.f8) { v2u o; o.x = pg8::pk4_fp8(s[0], s[65], s[130], s[195]); o.y = pg8::pk4_fp8(s[260], s[325], s[390], s[455]);
            pg8::st8_wt(I.dst + (size_t)drow * I.K + I.k0 + 8 * c, o.x, o.y); }
        else { v4u o; o.x = pk2(s[0], s[65]); o.y = pk2(s[130], s[195]); o.z = pk2(s[260], s[325]); o.w = pk2(s[390], s[455]);
            pg8::st16_wt(I.dst + ((size_t)drow * I.K + I.k0 + 8 * c) * 2, o); } }
    LDS_WAIT(); asm volatile("" ::: "memory");
}
__device__ __forceinline__ void rms_row_bf16(const float* xrow, const float* g, bf16_t* orow, int lane) {
    const GAS f32x4* xr = (const GAS f32x4*)xrow + lane; const GAS f32x4* gr = (const GAS f32x4*)g + lane;
    f32x4 v[4]; float s = 0.f;
#pragma unroll
    for (int j = 0; j < 4; ++j) { v[j] = xr[64 * j]; s += (v[j][0] * v[j][0] + v[j][1] * v[j][1]) + (v[j][2] * v[j][2] + v[j][3] * v[j][3]); }
    const float rstd = __builtin_amdgcn_rsqf(wave_sum(s) * (1.f / D) + EPS);
    GAS v2u* o8 = (GAS v2u*)orow + lane;
#pragma unroll
    for (int j = 0; j < 4; ++j) { const f32x4 gg = gr[64 * j]; v2u o; o.x = pk2(v[j][0] * rstd * gg[0], v[j][1] * rstd * gg[1]); o.y = pk2(v[j][2] * rstd * gg[2], v[j][3] * rstd * gg[3]); o8[64 * j] = o; }
}
__device__ __forceinline__ void p0_prologue(Frame& F) {
    const int gw = F.vcu * NWAVES + F.wave, NGW = F.G * NWAVES;
    {
        const float* x = INP(0); const float* g = INP(1); bf16_t* XN = (bf16_t*)(A_WS + WS_XN0);
        const GAS f32x4* gr = (const GAS f32x4*)g + F.lane; f32x4 gg[4];
#pragma unroll
        for (int j = 0; j < 4; ++j) gg[j] = gr[64 * j];
        for (int mb = gw; mb < M; mb += 4 * NGW) { f32x4 v[4][4];
#pragma unroll
            for (int i = 0; i < 4; ++i) { const int m = mb + i * NGW; if (m < M) { const GAS f32x4* xr = (const GAS f32x4*)(x + (size_t)m * D) + F.lane;
#pragma unroll
                for (int j = 0; j < 4; ++j) v[i][j] = __builtin_nontemporal_load(xr + 64 * j); } }
#pragma unroll
            for (int i = 0; i < 4; ++i) { const int m = mb + i * NGW; if (m >= M) break; float s = 0.f;
#pragma unroll
                for (int j = 0; j < 4; ++j) s += (v[i][j][0] * v[i][j][0] + v[i][j][1] * v[i][j][1]) + (v[i][j][2] * v[i][j][2] + v[i][j][3] * v[i][j][3]);
                const float rstd = __builtin_amdgcn_rsqf(wave_sum(s) * (1.f / D) + EPS); GAS v2u* o8 = (GAS v2u*)(XN + (size_t)m * D) + F.lane;
#pragma unroll
                for (int j = 0; j < 4; ++j) { v2u o; o.x = pk2(v[i][j][0] * rstd * gg[j][0], v[i][j][1] * rstd * gg[j][1]); o.y = pk2(v[i][j][2] * rstd * gg[j][2], v[i][j][3] * rstd * gg[j][3]); o8[64 * j] = o; } } }
    }
    LAS float* scr = (LAS float*)(F.lds + RING_OFF + F.wave * P0_SCR);
    int it = gw; if (it >= P0_NITEMS) return;
    P0Item cur; P0Regs ra; p0_decode(it, cur); p0_load(cur, ra, F.lane);
    for (;;) { const int nit = it + NGW; const bool has = nit < P0_NITEMS; P0Item nx; P0Regs rb;
        if (has) { p0_decode(nit, nx); p0_load(nx, rb, F.lane); }
        p0_store(cur, ra, scr, F.lane);
        if (!has) break;
        cur = nx; ra = rb; it = nit; }
}

__device__ __forceinline__ void up8(const v4u w, float (&f)[8]) { f[0] = bflo(w.x); f[1] = bfhi(w.x); f[2] = bflo(w.y); f[3] = bfhi(w.y); f[4] = bflo(w.z); f[5] = bfhi(w.z); f[6] = bflo(w.w); f[7] = bfhi(w.w); }
__device__ __forceinline__ void p2_conv(Frame& F) {
    const bf16_t* Bb = (const bf16_t*)(A_WS + WS_BB); const bf16_t* Ub = (const bf16_t*)(A_WS + WS_UB); bf16_t* G = (bf16_t*)(A_WS + WS_G); const float* cw = INP(4);
    const int gw = F.vcu * NWAVES + F.wave, NGW = F.G * NWAVES;
    for (int strip = gw; strip < 2048; strip += NGW) {
        const int r0 = (strip >> 1) * 16, c0 = (strip & 1) * 512 + F.lane * 8;
        float w0[8], w1[8], w2[8], um2[8], um1[8];
#pragma unroll
        for (int j = 0; j < 8; ++j) { w0[j] = cw[c0 + j]; w1[j] = cw[D + c0 + j]; w2[j] = cw[2 * D + c0 + j]; um2[j] = 0.f; um1[j] = 0.f; }
        if ((r0 & (SEQ - 1)) != 0) { up8(*(const GAS v4u*)(Ub + (size_t)(r0 - 2) * D + c0), um2); up8(*(const GAS v4u*)(Ub + (size_t)(r0 - 1) * D + c0), um1); }
#pragma unroll
        for (int hb = 0; hb < 2; ++hb) { v4u ru[8], rb[8];
#pragma unroll
            for (int i = 0; i < 8; ++i) { ru[i] = *(const GAS v4u*)(Ub + (size_t)(r0 + 8 * hb + i) * D + c0); rb[i] = *(const GAS v4u*)(Bb + (size_t)(r0 + 8 * hb + i) * D + c0); }
#pragma unroll
            for (int ii = 0; ii < 8; ++ii) { const int i = 8 * hb + ii; float u[8], b[8]; up8(ru[ii], u); up8(rb[ii], b);
            float g[8];
#pragma unroll
            for (int j = 0; j < 8; ++j) { g[j] = b[j] * (w0[j] * um2[j] + w1[j] * um1[j] + w2[j] * u[j]); um2[j] = um1[j]; um1[j] = u[j]; }
            v4u o; o.x = pk2(g[0], g[1]); o.y = pk2(g[2], g[3]); o.z = pk2(g[4], g[5]); o.w = pk2(g[6], g[7]);
            pg8::st16_wt(G + (size_t)(r0 + i) * D + c0, o); } }
    }
}

__device__ __forceinline__ void p8_diff(Frame& F) {
    const bf16_t* O0 = (const bf16_t*)(A_WS + WS_O0); const bf16_t* O1 = (const bf16_t*)(A_WS + WS_O1); bf16_t* ON = (bf16_t*)(A_WS + WS_ON);
    const float* lp = INP(11); const float* sn = INP(12); const int lane = F.lane;
    const float lam = __expf(wave_sum(lp[lane] * lp[64 + lane])) - __expf(wave_sum(lp[128 + lane] * lp[192 + lane])) + LAM_INIT;
    float gn[16];
#pragma unroll
    for (int j = 0; j < 16; ++j) gn[j] = sn[16 * (lane & 7) + j] * (1.f - LAM_INIT);
    const int gw = F.vcu * NWAVES + F.wave, NGW = F.G * NWAVES;
    for (int rowb = gw; rowb < M; rowb += 4 * NGW) {
        v4u ra[4][2], rb[4][2];
#pragma unroll
        for (int i = 0; i < 4; ++i) { const int row = rowb + i * NGW; if (row < M) { const size_t off = (size_t)row * D + 16 * lane;
            ra[i][0] = *(const GAS v4u*)(O0 + off); ra[i][1] = *(const GAS v4u*)(O0 + off + 8); rb[i][0] = *(const GAS v4u*)(O1 + off); rb[i][1] = *(const GAS v4u*)(O1 + off + 8); } }
#pragma unroll
        for (int i = 0; i < 4; ++i) { const int row = rowb + i * NGW; if (row >= M) break; const size_t off = (size_t)row * D + 16 * lane;
            float a[16], a0[8], a1[8], b0[8], b1[8]; up8(ra[i][0], a0); up8(ra[i][1], a1); up8(rb[i][0], b0); up8(rb[i][1], b1);
            float s = 0.f;
#pragma unroll
            for (int j = 0; j < 8; ++j) { a[j] = a0[j] - lam * b0[j]; a[8 + j] = a1[j] - lam * b1[j]; s += a[j] * a[j] + a[8 + j] * a[8 + j]; }
            s += __shfl_xor(s, 1); s += __shfl_xor(s, 2); s += __shfl_xor(s, 4);
            const float rstd = __builtin_amdgcn_rsqf(s * (1.f / VD) + EPS);
            v4u o0, o1; o0.x = pk2(a[0] * rstd * gn[0], a[1] * rstd * gn[1]); o0.y = pk2(a[2] * rstd * gn[2], a[3] * rstd * gn[3]); o0.z = pk2(a[4] * rstd * gn[4], a[5] * rstd * gn[5]); o0.w = pk2(a[6] * rstd * gn[6], a[7] * rstd * gn[7]);
            o1.x = pk2(a[8] * rstd * gn[8], a[9] * rstd * gn[9]); o1.y = pk2(a[10] * rstd * gn[10], a[11] * rstd * gn[11]); o1.z = pk2(a[12] * rstd * gn[12], a[13] * rstd * gn[13]); o1.w = pk2(a[14] * rstd * gn[14], a[15] * rstd * gn[15]);
            pg8::st16_wt(ON + off, o0); pg8::st16_wt(ON + off + 8, o1); }
    }
}

#define TR_STEP(n, m) do { _Pragma("unroll") for (int i = 0; i < (n) / 2; ++i) { const bool up = (lane & (m)) != 0; const float keep = up ? v[i + (n) / 2] : v[i], send = up ? v[i] : v[i + (n) / 2]; v[i] = keep + __shfl_xor(send, (m)); } } while (0)
__device__ __forceinline__ void p10a_router(Frame& F) {
    const bf16_t* x3 = (const bf16_t*)(A_WS + WS_XB); const float* g = INP(2) + D; const float* Wr = INP(16); const float* ssq = (const float*)(A_WS + WS_SSQ);
    int* sel = (int*)(A_WS + WS_SEL); float* gate = (float*)(A_WS + WS_GATE); int* hist = (int*)(A_WS + WS_HIST);
    LAS f32x4* WL = (LAS f32x4*)(F.lds + RING_OFF);
    LAS int* lcnt = (LAS int*)(F.lds + RING_OFF + 32768);
    const int lane = F.lane;
    for (int k = F.tid; k < D; k += NWAVES * 64) { const float gk = g[k]; const f32x4 w0 = *(const GAS f32x4*)(Wr + (size_t)k * 8) * gk, w1 = *(const GAS f32x4*)(Wr + (size_t)k * 8 + 4) * gk;
        const int base = (((k >> 8) * 4 + (k & 3)) * 2) * 64 + ((k >> 2) & 63); WL[base] = w0; WL[base + 64] = w1; }
    LDS_WAIT(); __syncthreads();
    for (int blk = blockIdx.x; blk < M / 64; blk += F.G) {
        const int row0 = 64 * blk + 8 * F.wave;
        f32x4 xv[8][4];
#pragma unroll
        for (int r = 0; r < 8; ++r)
#pragma unroll
            for (int j = 0; j < 4; ++j) { const v2u w = *((const GAS v2u*)(x3 + (size_t)(row0 + r) * D) + lane + 64 * j); xv[r][j] = (f32x4){bflo(w.x), bfhi(w.x), bflo(w.y), bfhi(w.y)}; }
        float v[64];
#pragma unroll
        for (int i = 0; i < 64; ++i) v[i] = 0.f;
#pragma unroll
        for (int j = 0; j < 4; ++j)
#pragma unroll
            for (int q = 0; q < 4; ++q) { const f32x4 wa = WL[((j * 4 + q) * 2) * 64 + lane], wb = WL[((j * 4 + q) * 2 + 1) * 64 + lane];
#pragma unroll
                for (int r = 0; r < 8; ++r) { const float xx = xv[r][j][q];
                    v[r * 8 + 0] += xx * wa[0]; v[r * 8 + 1] += xx * wa[1]; v[r * 8 + 2] += xx * wa[2]; v[r * 8 + 3] += xx * wa[3];
                    v[r * 8 + 4] += xx * wb[0]; v[r * 8 + 5] += xx * wb[1]; v[r * 8 + 6] += xx * wb[2]; v[r * 8 + 7] += xx * wb[3]; } }
        TR_STEP(64, 32); TR_STEP(32, 16); TR_STEP(16, 8); TR_STEP(8, 4); TR_STEP(4, 2); TR_STEP(2, 1);
        float lg[8];
#pragma unroll
        for (int e = 0; e < 8; ++e) lg[e] = __shfl(v[0], (lane & ~7) | e);
        int i0 = 0; float v0 = lg[0];
#pragma unroll
        for (int e = 1; e < 8; ++e) if (lg[e] > v0) { v0 = lg[e]; i0 = e; }
        int i1 = 0; float v1 = -INFINITY;
#pragma unroll
        for (int e = 0; e < 8; ++e) if (e != i0 && lg[e] > v1) { v1 = lg[e]; i1 = e; }
        const int row = row0 + (lane >> 3); const float rs = pg8::rstd_of(ssq, row);
        const float g1 = 1.f / (1.f + expf((v0 - v1) * rs)); const bool wrt = (lane & 7) == 0;
        if (wrt) { sel[2 * row] = i0; sel[2 * row + 1] = i1; gate[2 * row] = 1.f - g1; gate[2 * row + 1] = g1; }
        int mycnt = 0;
#pragma unroll
        for (int e = 0; e < 8; ++e) { const int c = __popcll(__ballot(wrt && i0 == e)) + __popcll(__ballot(wrt && i1 == e)); if (lane == e) mycnt = c; }
        if (lane < 8) lcnt[F.wave * 8 + lane] = mycnt;
        LDS_WAIT(); __syncthreads();
        if (F.tid < 8) { int c = 0;
#pragma unroll
            for (int w = 0; w < 8; ++w) c += lcnt[w * 8 + F.tid];
            hist[blk * 8 + F.tid] = c; }
        LDS_WAIT(); __syncthreads();
    }
}
#undef TR_STEP
__device__ __forceinline__ void p10b_assign(Frame& F) {
    const int* hist = (const int*)(A_WS + WS_HIST); const int* sel = (const int*)(A_WS + WS_SEL); const float* gate = (const float*)(A_WS + WS_GATE); const float* ssq = (const float*)(A_WS + WS_SSQ);
    int* tok_slot = (int*)(A_WS + WS_TOKSLOT); float* gates = (float*)(A_WS + WS_GATES); int* meta = (int*)(A_WS + WS_META);
    const bf16_t* x3 = (const bf16_t*)(A_WS + WS_XB); unsigned char* XG = A_WS + WS_XG;
    LAS int* pre = (LAS int*)(F.lds + RING_OFF);
    LAS int* tot = pre + 2048;
    LAS int* ebase = tot + 8;
    LAS int* lslot = ebase + 8;
    const int lane = F.lane, e = F.wave;
    { int h[4], run = 0;
#pragma unroll
      for (int i = 0; i < 4; ++i) { h[i] = hist[(4 * lane + i) * 8 + e]; }
      const int mine = h[0] + h[1] + h[2] + h[3]; int inc = mine;
#pragma unroll
      for (int o = 1; o < 64; o <<= 1) { const int t = __shfl_up(inc, o); if (lane >= o) inc += t; }
      run = inc - mine;
#pragma unroll
      for (int i = 0; i < 4; ++i) { pre[(4 * lane + i) * 8 + e] = run; run += h[i]; }
      if (lane == 63) tot[e] = inc; }
    LDS_WAIT(); __syncthreads();
    if (F.tid == 0) { int b = 0; for (int k = 0; k < 8; ++k) { ebase[k] = b; if (blockIdx.x == 0) meta[k] = b >> 8; b += (tot[k] + 255) & ~255; } if (blockIdx.x == 0) { const int T = b >> 8, full = 2 * F.G / 4; meta[8] = T; meta[9] = T < full ? T : full; } }
    LDS_WAIT(); __syncthreads();
    for (int blk = blockIdx.x; blk < M / 64; blk += F.G) {
        if (F.wave == 0) { const int t = 64 * blk + lane; const int s0 = sel[2 * t], s1 = sel[2 * t + 1]; int sl0 = 0, sl1 = 0;
            const unsigned long long below = (1ull << lane) - 1ull;
#pragma unroll
            for (int k = 0; k < 8; ++k) { const unsigned long long m0 = __ballot(s0 == k), m1 = __ballot(s1 == k); const int b0 = ebase[k] + pre[blk * 8 + k];
                if (s0 == k) sl0 = b0 + __popcll(m0 & below); if (s1 == k) sl1 = b0 + __popcll(m0) + __popcll(m1 & below); }
            tok_slot[2 * t] = sl0; tok_slot[2 * t + 1] = sl1; lslot[2 * lane] = sl0; lslot[2 * lane + 1] = sl1;
            gates[sl0] = gate[2 * t]; gates[sl1] = gate[2 * t + 1]; }
        LDS_WAIT(); __syncthreads();
        v4u xw[8][2];
#pragma unroll
        for (int i = 0; i < 8; ++i) { const GAS v4u* xr = (const GAS v4u*)(x3 + (size_t)(64 * blk + 8 * F.wave + i) * D + 16 * lane); xw[i][0] = xr[0]; xw[i][1] = xr[1]; }
#pragma unroll
        for (int i = 0; i < 8; ++i) { const int tl = 8 * F.wave + i; const int t = 64 * blk + tl;
            const float rs = pg8::rstd_of(ssq, t) * pg8::F8_SA; float a[8], b[8]; up8(xw[i][0], a); up8(xw[i][1], b);
            v4u o; o.x = pg8::pk4_fp8(a[0] * rs, a[1] * rs, a[2] * rs, a[3] * rs); o.y = pg8::pk4_fp8(a[4] * rs, a[5] * rs, a[6] * rs, a[7] * rs); o.z = pg8::pk4_fp8(b[0] * rs, b[1] * rs, b[2] * rs, b[3] * rs); o.w = pg8::pk4_fp8(b[4] * rs, b[5] * rs, b[6] * rs, b[7] * rs);
            const int sl0 = lslot[2 * tl], sl1 = lslot[2 * tl + 1];
            pg8::st16_wt(XG + (size_t)sl0 * D + 16 * lane, o); pg8::st16_wt(XG + (size_t)sl1 * D + 16 * lane, o); }
        LDS_WAIT(); __syncthreads();
    }
}
__device__ __forceinline__ void p13_load_y(const bf16_t* Y, const float* Pp, const float* gates, int nfull, int slot, int lane, v2u (&y)[4]) {
    const int rt = (slot >> 8) - nfull;
    if (rt < 0) { const GAS v2u* yr = (const GAS v2u*)(Y + (size_t)slot * D) + lane;
#pragma unroll
        for (int j = 0; j < 4; ++j) y[j] = yr[64 * j];
    } else { const float gt = gates[slot] * (1.0f / (pg8::F8_SH * pg8::F8_SWD));
#pragma unroll
        for (int j = 0; j < 4; ++j) { f32x4 s = (f32x4){0.f, 0.f, 0.f, 0.f};
#pragma unroll
            for (int kp = 0; kp < pg8::MoeOrder::SPL; ++kp) s += *((const GAS f32x4*)(Pp + ((size_t)(rt * pg8::MoeOrder::SPL + kp) * 256 + (slot & 255)) * D) + lane + 64 * j);
            y[j].x = pk2(s[0] * gt, s[1] * gt); y[j].y = pk2(s[2] * gt, s[3] * gt); } }
}
__device__ __forceinline__ void p13_final(Frame& F) {
    const int* tok_slot = (const int*)(A_WS + WS_TOKSLOT); const bf16_t* Y = (const bf16_t*)(A_WS + WS_Y); const bf16_t* X3 = (const bf16_t*)(A_WS + WS_XB); float* out = A_OUT;
    const float* Pp = (const float*)(A_WS + WS_PP); const float* gates = (const float*)(A_WS + WS_GATES); const int nfull = ((const int*)(A_WS + WS_META))[9];
    const int gw = F.vcu * NWAVES + F.wave, NGW = F.G * NWAVES, lane = F.lane;
    for (int rowb = gw; rowb < M; rowb += 2 * NGW) {
        v2u xa[2][4], ya[2][4], yb[2][4];
#pragma unroll
        for (int i = 0; i < 2; ++i) { const int row = rowb + i * NGW; if (row < M) { const int s0 = tok_slot[2 * row], s1 = tok_slot[2 * row + 1];
            const GAS v2u* xr = (const GAS v2u*)(X3 + (size_t)row * D) + lane;
#pragma unroll
            for (int j = 0; j < 4; ++j) xa[i][j] = xr[64 * j];
            p13_load_y(Y, Pp, gates, nfull, s0, lane, ya[i]); p13_load_y(Y, Pp, gates, nfull, s1, lane, yb[i]); } }
#pragma unroll
        for (int i = 0; i < 2; ++i) { const int row = rowb + i * NGW; if (row >= M) break; GAS f32x4* orow = (GAS f32x4*)(out + (size_t)row * D) + lane;
#pragma unroll
            for (int j = 0; j < 4; ++j) { const v2u x = xa[i][j], a = ya[i][j], b = yb[i][j];
                orow[64 * j] = (f32x4){bflo(x.x) + (bflo(a.x) + bflo(b.x)), bfhi(x.x) + (bfhi(a.x) + bfhi(b.x)), bflo(x.y) + (bflo(a.y) + bflo(b.y)), bfhi(x.y) + (bfhi(a.y) + bfhi(b.y))}; } }
    }
}

__global__ void __launch_bounds__(NWAVES * 64, 2) mega_fwd(Args args) {
    extern __shared__ __attribute__((aligned(16))) unsigned char lds[];
    Frame F;
    F.lds = (LAS unsigned char*)lds; F.tid = threadIdx.x; F.lane = F.tid & 63; F.wave = __builtin_amdgcn_readfirstlane(F.tid >> 6);
    F.G = gridDim.x; { const int bx = blockIdx.x; F.vcu = (F.G % 8 == 0) ? (bx % 8) * (F.G / 8) + bx / 8 : bx; }
    for (int u = F.tid; u < RING_OFF / 4; u += NWAVES * 64) ((LAS unsigned*)(F.lds + MISC_OFF))[u] = 0u;
    __syncthreads();
    if (KA->ph_hi - KA->ph_lo > 1) (void)xcd_barrier_post((unsigned*)(A_WS + WS_CTL) + CW_BAR + KA->li * XCD_BAR_WORDS, (volatile LAS unsigned*)(F.lds + MISC_OFF + 32));
#define IN(k) (KA->ph_lo <= (k) && (k) < KA->ph_hi)
#define SEAM(k) do { if (IN(k) && IN((k) + 1)) SEAM_NOW(); } while (0)
#define SEAM_NOW() do { { XcdBarrier b_; b_.bar = (unsigned*)(A_WS + WS_CTL) + CW_BAR + KA->li * XCD_BAR_WORDS; b_.x = xb_xcc_id(); b_.st = (volatile LAS unsigned*)(F.lds + MISC_OFF + 32); xcd_barrier(b_); } } while (0)
#define ws A_WS
#define XB ((bf16_t*)(A_WS + WS_XB))
#define SSQ ((float*)(A_WS + WS_SSQ))

    if (IN(0)) { p0_prologue(F); } SEAM(0);
    if (IN(1)) { pg8::Gemm g{(const bf16_t*)(ws + WS_XN0), (const bf16_t*)(ws + WS_W_IN), M, 3072, 1024}; pg8::StaticOrder S; S.init(M, 3072, F.G, (int)blockIdx.x);
        pg8::EpiInProj E{(bf16_t*)(ws + WS_BB), (bf16_t*)(ws + WS_UB)};
        pg8::gemm_phase<pg8::EpiInProj, pg8::StaticOrder, true, true>(F.lds + RING_OFF, g, S, E); } SEAM(1);
    if (IN(2)) { p2_conv(F); } SEAM(2);
    if (IN(3)) { pg8::Gemm g{(const bf16_t*)(ws + WS_G), (const bf16_t*)(ws + WS_W_OUT), M, 1024, 1024}; pg8::StaticOrder S; S.init(M, 1024, F.G, (int)blockIdx.x);
        pg8::EpiResidSsq<true> E{INP(0), XB, SSQ, 1.0f, ws + WS_X8};
        pg8::gemm_phase<pg8::EpiResidSsq<true>, pg8::StaticOrder, false, true>(F.lds + RING_OFF, g, S, E); } SEAM(3);
    if (IN(4)) { pg8::Gemm g{(const bf16_t*)(ws + WS_X8), (const bf16_t*)(ws + WS_W_GU), M, 5632, 512}; pg8::StaticOrder S; S.init(M, 5632, F.G, (int)blockIdx.x);
        pg8::EpiSwiGLU<true> E{ws + WS_HACT, DFF, SSQ, nullptr, 22, 1.0f / (pg8::F8_SX * pg8::F8_SWGD)};
        pg8::gemm_phase<pg8::EpiSwiGLU<true>, pg8::StaticOrder, true, true, true>(F.lds + RING_OFF, g, S, E); } SEAM(4);
    if (IN(5)) { pg8::Gemm g{(const bf16_t*)(ws + WS_HACT), (const bf16_t*)(ws + WS_W_DN), M, 1024, DFF / 2}; pg8::StaticOrder S; S.init(M, 1024, F.G, (int)blockIdx.x);
        pg8::EpiResidSsq<false> E{nullptr, XB, SSQ, 1.0f / (pg8::F8_SHD * pg8::F8_SWDD), nullptr};
        pg8::gemm_phase<pg8::EpiResidSsq<false>, pg8::StaticOrder, false, true, true>(F.lds + RING_OFF, g, S, E); } SEAM(5);
    if (IN(6)) { pg8::Gemm g{XB, (const bf16_t*)(ws + WS_W_QKV), M, 3072, 1024}; pg8::StaticOrder S; S.init(M, 3072, F.G, (int)blockIdx.x);
        pg8::EpiQKV E{(bf16_t*)(ws + WS_Q), (bf16_t*)(ws + WS_K), (bf16_t*)(ws + WS_V), SSQ, INP(10), INP(8), attn_body::C2};
        pg8::gemm_phase<pg8::EpiQKV, pg8::StaticOrder, true, true>(F.lds + RING_OFF, g, S, E); } SEAM(6);
    if (IN(7)) {
        const float* lp = INP(11); const float* sn = INP(12);
        const float lam = __expf(wave_sum(lp[F.lane] * lp[64 + F.lane])) - __expf(wave_sum(lp[128 + F.lane] * lp[192 + F.lane])) + LAM_INIT;
        LAS float* sng = (LAS float*)(F.lds + MISC_OFF + 256);
        if (F.tid < VD) sng[F.tid] = sn[F.tid] * (1.f - LAM_INIT);
        LDS_WAIT(); __syncthreads();
        for (int it = F.vcu; it < BATCH * 32; it += F.G) { const int b = it >> 5, h = (it >> 2) & 7, p = it & 3;
            attn_body::bf16* O0 = (attn_body::bf16*)(ws + WS_O0); attn_body::bf16* ONp = (attn_body::bf16*)(ws + WS_ON);
            for (int i = 0; i < 2; ++i) { const int qb = i ? 7 - p : p;
                attn_body::attn_unit<-1, 0>(b, (2 * h) * 64, h * 128, qb, (const attn_body::bf16*)(ws + WS_Q), (const attn_body::bf16*)(ws + WS_K), (const attn_body::bf16*)(ws + WS_V), O0, (char*)lds + RING_OFF, nullptr, 0.f, nullptr);
                attn_body::attn_unit<-1, 1>(b, (2 * h + 1) * 64, h * 128, qb, (const attn_body::bf16*)(ws + WS_Q), (const attn_body::bf16*)(ws + WS_K), (const attn_body::bf16*)(ws + WS_V), O0, (char*)lds + RING_OFF, ONp, lam, (const float*)((char*)lds + MISC_OFF + 256)); } }
    } if (IN(7) && IN(9)) SEAM_NOW();
    if (IN(9)) { pg8::Gemm g{(const bf16_t*)(ws + WS_ON), (const bf16_t*)(ws + WS_W_O), M, 1024, 1024}; pg8::StaticOrder S; S.init(M, 1024, F.G, (int)blockIdx.x);
        pg8::EpiResidSsq<false> E{nullptr, XB, SSQ, 1.0f, nullptr};
        pg8::gemm_phase<pg8::EpiResidSsq<false>, pg8::StaticOrder, false, true>(F.lds + RING_OFF, g, S, E); } SEAM(9);
    if (IN(10)) { p10a_router(F); } SEAM(10);
    if (IN(11)) { p10b_assign(F); } SEAM(11);
    if (IN(12)) { pg8::Gemm g{(const bf16_t*)(ws + WS_XG), (const bf16_t*)(ws + WS_W_MGU), SLOTS, 8 * 7168, 512}; pg8::MoeOrder S; S.init((const int*)(ws + WS_META), 28, F.G, (int)blockIdx.x, false);
        pg8::EpiSwiGLU8 E{ws + WS_HM, DFE, 28};
        pg8::gemm_phase<pg8::EpiSwiGLU8, pg8::MoeOrder, true, true, true>(F.lds + RING_OFF, g, S, E); } SEAM(12);
    if (IN(13)) { pg8::Gemm g{(const bf16_t*)(ws + WS_HM), (const bf16_t*)(ws + WS_W_MDN), SLOTS, 8 * 1024, DFE / 2}; pg8::MoeOrder S; S.init((const int*)(ws + WS_META), 4, F.G, (int)blockIdx.x, true);
        pg8::EpiMoeDown E{(bf16_t*)(ws + WS_Y), (const float*)(ws + WS_GATES), 1.0f / (pg8::F8_SH * pg8::F8_SWD), (float*)(ws + WS_PP)};
        pg8::gemm_phase<pg8::EpiMoeDown, pg8::MoeOrder, true, true, true>(F.lds + RING_OFF, g, S, E); } SEAM(13);
    if (IN(14)) { p13_final(F); }
#undef IN
#undef SEAM
#undef SEAM_NOW
#undef ws
#undef XB
#undef SSQ
}
#ifndef MEGA_UPTO
#define MEGA_UPTO 15
#endif
#ifndef MEGA_REPMASK
#define MEGA_REPMASK 0
#endif
#ifndef MEGA_ONE
#define MEGA_ONE 1
#endif
extern "C" void kernel_launch(void* const* d_in, const int* in_sizes, int n_in, void* d_out, int out_size, void* d_ws, size_t ws_size, hipStream_t stream) {
    static int grid = 0;
    if (grid == 0) {
        if (n_in != 19 || in_sizes[0] != M * D || out_size != M * D || ws_size < WS_END) { fprintf(stderr, "kernel_launch: unexpected shapes / workspace (%d inputs, ws %zu, need %zu)\n", n_in, ws_size, (size_t)WS_END); grid = -1; return; }
        int dev = 0, cus = 0, per_cu = 0;
        if (hipGetDevice(&dev) != hipSuccess || hipDeviceGetAttribute(&cus, hipDeviceAttributeMultiprocessorCount, dev) != hipSuccess) { grid = -1; return; }
        if (hipFuncSetAttribute((const void*)mega_fwd, hipFuncAttributeMaxDynamicSharedMemorySize, LDS_BYTES) != hipSuccess) { fprintf(stderr, "kernel_launch: hipFuncSetAttribute failed\n"); grid = -1; return; }
        if (hipOccupancyMaxActiveBlocksPerMultiprocessor(&per_cu, (const void*)mega_fwd, NWAVES * 64, LDS_BYTES) != hipSuccess || per_cu < 1) fprintf(stderr, "kernel_launch: note: occupancy query says %d\n", per_cu);
        (void)hipGetLastError();
        grid = cus < 256 ? cus : 256;
        if (grid != 256) fprintf(stderr, "kernel_launch: %d CUs; this kernel is built for 256\n", cus);
    }
    if (grid < 0) return;
    unsigned char* ws = (unsigned char*)d_ws; float* out = (float*)d_out;
    constexpr int UPTO = MEGA_UPTO;
    static_assert(UPTO == 15, "the plain reference kernels of the transition builds are gone: all 15 phases run in the persistent kernel");
    if (UPTO > 0) {
        if (hipMemsetAsync(ws + WS_CTL, 0, CTL_ZERO_BYTES, stream) != hipSuccess) { fprintf(stderr, "kernel_launch: memset failed\n"); return; }
        Args a{};
        for (int i = 0; i < 19; ++i) a.in[i] = (const float*)d_in[i];
        a.out = out; a.wsp = ws;
        a.jobmask = UPTO >= 15 ? 255 : UPTO >= 10 ? 63 : UPTO >= 7 ? 31 : UPTO >= 6 ? 15 : 3;
        if (MEGA_ONE) { a.ph_lo = 0; a.ph_hi = UPTO; a.li = 0; hipLaunchKernelGGL(mega_fwd, dim3(grid), dim3(NWAVES * 64), LDS_BYTES, stream, a); }
        else for (int p = 0; p < UPTO; ++p) { a.ph_lo = p; a.ph_hi = p + 1; a.li = 0; for (int r = 0; r <= ((MEGA_REPMASK >> p) & 1); ++r) hipLaunchKernelGGL(mega_fwd, dim3(grid), dim3(NWAVES * 64), LDS_BYTES, stream, a); }
        const hipError_t le = hipPeekAtLastError();
        if (le != hipSuccess) fprintf(stderr, "kernel_launch: launch failed: %s\n", hipGetErrorName(le));
    }
}
```

```cpp
#include <hip/hip_runtime.h>
#include <hip/hip_bf16.h>
#include <stdint.h>
#include <stdio.h>
#include <cmath>
#define MEGA_UPTO 15
#define MEGA_ONE 1
typedef unsigned short bf16_t;
typedef short bf16x8 __attribute__((ext_vector_type(8)));
typedef float f32x4 __attribute__((ext_vector_type(4)));
constexpr int D = 1024, BATCH = 8, SEQ = 2048, M = BATCH * SEQ;
constexpr int NH = 8, HD = 64, VD = 128;
constexpr int DFF = 2816, NE = 8, DFE = 3584;
constexpr float EPS = 1e-6f;
constexpr float LAM_INIT = 0.35550907f;
constexpr int SLOTS = 2 * M + NE * 256;

__device__ __forceinline__ unsigned f2bf(float f) { unsigned u = __builtin_bit_cast(unsigned, f); return (u + 0x7fffu + ((u >> 16) & 1u)) >> 16; }
__device__ __forceinline__ float bf2f(unsigned short b) { return __builtin_bit_cast(float, (unsigned)b << 16); }
__device__ __forceinline__ float wave_sum(float v) {
#pragma unroll
    for (int o = 1; o < 64; o <<= 1) v += __shfl_xor(v, o);
    return v;
}

namespace pg8 {
#define PG8_LAS __attribute__((address_space(3)))
typedef unsigned short bf16_t;
typedef short bf16x8 __attribute__((ext_vector_type(8)));
typedef float f32x4 __attribute__((ext_vector_type(4)));
typedef unsigned u32x4 __attribute__((ext_vector_type(4)));
typedef int i32x4 __attribute__((ext_vector_type(4)));
typedef int i32x8 __attribute__((ext_vector_type(8)));
constexpr int BM = 256, BK = 64, HALF = 128, HTB = HALF * BK * 2  , STAGE_BYTES = 8 * HTB, NXCD = 8, WGM = 8;

__host__ __device__ __forceinline__ int lds_byte(int r, int c) { const int st = (r >> 4) * 2 + (c >> 5), rr = r & 15, cc = c & 31, ob = rr * 64 + cc * 2; return st * 1024 + (ob ^ (((ob >> 9) & 1) << 5)); }
__host__ __device__ __forceinline__ void stage_rc(int b, int& R, int& C) { const int st = b / 1024, sb = b % 1024, swz = sb ^ (((sb >> 9) & 1) << 5); R = (st >> 1) * 16 + swz / 64; C = (st & 1) * 32 + (swz % 64) / 2; }
__host__ __device__ __forceinline__ int perm32(int rho) { const int n = rho >> 4, i = rho & 15; return 8 * (i >> 2) + 4 * n + (i & 3); }

struct Unit { int pm, pn; int kt0, nkt, aux; };
struct Gemm { const bf16_t* A; const bf16_t* Bt; int M, N, K; };

struct StaticOrder {
    int nM, nN, nwg, G, c;
    __host__ __device__ void init(int M, int N, int G_, int c_) { nM = M / BM; nN = N / BM; nwg = nM * nN; G = G_; c = c_; }
    __host__ __device__ bool next(int i, Unit& u) const {
        const long L = (long)i * G + c; if (L >= nwg) return false;
        int wgid = (int)L; { const int q = nwg / NXCD, r = nwg % NXCD, xcd = wgid % NXCD, off = wgid / NXCD; wgid = (xcd < r ? xcd * (q + 1) : r * (q + 1) + (xcd - r) * q) + off; }
        const int nig = WGM * nN, gid = wgid / nig, fm = gid * WGM, gsz = (nM - fm) < WGM ? (nM - fm) : WGM;
        u.pm = fm + ((wgid % nig) % gsz); u.pn = (wgid % nig) / gsz; u.kt0 = 0; u.nkt = 0; u.aux = -1; return true;
    }
    __device__ __forceinline__ void a_ready(const Unit&) const {}
    __device__ __forceinline__ void done(const Unit&) const {}
};

__device__ __forceinline__ unsigned cvt_pk_bf16(float lo, float hi) { unsigned r; asm volatile("v_cvt_pk_bf16_f32 %0, %1, %2" : "=v"(r) : "v"(lo), "v"(hi)); return r; }
typedef float f32x2 __attribute__((ext_vector_type(2)));
#ifndef PG8_WT
#define PG8_WT 0
#endif
__device__ __forceinline__ void st16_wt(void* p, u32x4 v) {
#if PG8_WT
    asm volatile("global_store_dwordx4 %0, %1, off sc1\n\ts_nop 1" :: "v"(p), "v"(v) : "memory");
#else
    *(u32x4*)p = v;
#endif
}
__device__ __forceinline__ void st8_wt(void* p, unsigned x, unsigned y) {
#if PG8_WT
    typedef unsigned u32x2_ __attribute__((ext_vector_type(2))); const u32x2_ v = {x, y};
    asm volatile("global_store_dwordx2 %0, %1, off sc1\n\ts_nop 1" :: "v"(p), "v"(v) : "memory");
#else
    typedef unsigned u32x2_ __attribute__((ext_vector_type(2))); *(u32x2_*)p = (u32x2_){x, y};
#endif
}
typedef unsigned u32x2 __attribute__((ext_vector_type(2)));
constexpr float RMS_EPS = 1e-6f, LOG2E = 1.4426950408889634f;
constexpr int DM_ = 1024;
__device__ __forceinline__ u32x4 pack8(const f32x4 a, const f32x4 b) { u32x4 w; w.x = cvt_pk_bf16(a[0], a[1]); w.y = cvt_pk_bf16(a[2], a[3]); w.z = cvt_pk_bf16(b[0], b[1]); w.w = cvt_pk_bf16(b[2], b[3]); return w; }
__device__ __forceinline__ float rstd_of(const float* ssq, int row) { const f32x4 p = *(const f32x4*)(ssq + (size_t)row * 4); return __builtin_amdgcn_rsqf(((p[0] + p[1]) + (p[2] + p[3])) * (1.0f / 1024.0f) + RMS_EPS); }
__device__ __forceinline__ float silu_mul(float g, float u) { return g * u * __builtin_amdgcn_rcpf(1.0f + __builtin_amdgcn_exp2f(-g * LOG2E)); }
__device__ __forceinline__ f32x2 swiglu2(f32x2 a, f32x2 b, float c1, float k) {
    const f32x2 t = a * c1; f32x2 e; e.x = __builtin_amdgcn_exp2f(t.x); e.y = __builtin_amdgcn_exp2f(t.y);
    const f32x2 d = e * k + k; f32x2 r; r.x = __builtin_amdgcn_rcpf(d.x); r.y = __builtin_amdgcn_rcpf(d.y);
    return (a * b) * r;
}

__device__ __forceinline__ float clamp448(float x) { return __builtin_amdgcn_fmed3f(x, -448.0f, 448.0f); }
__device__ __forceinline__ unsigned pk4_fp8(float a, float b, float c, float d) { int w = 0; w = __builtin_amdgcn_cvt_pk_fp8_f32(clamp448(a), clamp448(b), w, false); w = __builtin_amdgcn_cvt_pk_fp8_f32(clamp448(c), clamp448(d), w, true); return (unsigned)w; }
constexpr float F8_SA = 4.0f, F8_SWG = 256.0f, F8_SH = 8.0f, F8_SWD = 512.0f;
constexpr float F8_SHD = 8.0f, F8_SWDD = 256.0f, F8_SX = 4.0f, F8_SWGD = 256.0f;

struct EpiInProj {
    static constexpr bool PERM = true, AFTER_DRAIN = false;
    bf16_t* Bb; bf16_t* Ub;
    __device__ __forceinline__ void operator()(const f32x4 (&acc)[2][2][4][2], const Unit& u, int wr, int wc, int fr, int fq) const {
        const int row0 = u.pm * BM + wr * 64 + fr;
        if (u.pn < 4) {
            const int col0 = u.pn * BM + wc * 32 + 8 * fq;
#pragma unroll
            for (int ai = 0; ai < 2; ++ai)
#pragma unroll
                for (int m = 0; m < 4; ++m) { bf16_t* rowp = Bb + (size_t)(row0 + ai * HALF + m * 16) * DM_ + col0;
#pragma unroll
                    for (int bj = 0; bj < 2; ++bj) st16_wt(rowp + bj * HALF, pack8(acc[ai][bj][m][0], acc[ai][bj][m][1])); }
        } else {
            const int col0 = (u.pn - 4) * 128 + wc * 32 + 8 * fq;
#pragma unroll
            for (int ai = 0; ai < 2; ++ai)
#pragma unroll
                for (int m = 0; m < 4; ++m) { bf16_t* rowp = Ub + (size_t)(row0 + ai * HALF + m * 16) * DM_ + col0;
                    st16_wt(rowp, pack8(acc[ai][0][m][0] * acc[ai][1][m][0], acc[ai][0][m][1] * acc[ai][1][m][1])); }
        }
    }
};

template <bool FIRST> struct EpiResidSsq {
    static constexpr bool PERM = true, AFTER_DRAIN = true;
    const float* x0; bf16_t* xb; float* ssq; float ascale; unsigned char* x8;
    __device__ __forceinline__ void fused(f32x4 (&acc)[2][2][4][2], const Unit& u, int wr, int wc, int fr, int fq, PG8_LAS unsigned char* lds, int wid, int lane) const {
        PG8_LAS float* P = (PG8_LAS float*)lds;
        const int col0 = u.pn * BM + wc * 32 + 8 * fq;
#pragma unroll
        for (int ai = 0; ai < 2; ++ai) {
            f32x4 xo[4][2][2];
#pragma unroll
            for (int m = 0; m < 4; ++m) { const int r = ai * HALF + wr * 64 + m * 16 + fr; const size_t off = (size_t)(u.pm * BM + r) * DM_ + col0;
#pragma unroll
                for (int bj = 0; bj < 2; ++bj) {
                    if constexpr (FIRST) { xo[m][bj][0] = __builtin_nontemporal_load((const f32x4*)(x0 + off + bj * HALF)); xo[m][bj][1] = __builtin_nontemporal_load((const f32x4*)(x0 + off + bj * HALF + 4)); }
                    else { const u32x4 w = *(const u32x4*)(xb + off + bj * HALF);
                        xo[m][bj][0] = (f32x4){__builtin_bit_cast(float, w.x << 16), __builtin_bit_cast(float, w.x & 0xffff0000u), __builtin_bit_cast(float, w.y << 16), __builtin_bit_cast(float, w.y & 0xffff0000u)};
                        xo[m][bj][1] = (f32x4){__builtin_bit_cast(float, w.z << 16), __builtin_bit_cast(float, w.z & 0xffff0000u), __builtin_bit_cast(float, w.w << 16), __builtin_bit_cast(float, w.w & 0xffff0000u)}; } } }
#pragma unroll
            for (int m = 0; m < 4; ++m) { const int r = ai * HALF + wr * 64 + m * 16 + fr; const size_t off = (size_t)(u.pm * BM + r) * DM_ + col0; float s = 0.f;
#pragma unroll
                for (int bj = 0; bj < 2; ++bj) { const f32x4 v0 = xo[m][bj][0] + acc[ai][bj][m][0] * ascale, v1 = xo[m][bj][1] + acc[ai][bj][m][1] * ascale;
                    st16_wt(xb + off + bj * HALF, pack8(v0, v1));
                    if constexpr (FIRST) { u32x2 w; w.x = pk4_fp8(v0[0] * F8_SX, v0[1] * F8_SX, v0[2] * F8_SX, v0[3] * F8_SX); w.y = pk4_fp8(v1[0] * F8_SX, v1[1] * F8_SX, v1[2] * F8_SX, v1[3] * F8_SX); st8_wt(x8 + off + bj * HALF, w.x, w.y); }
                    s += ((v0[0] * v0[0] + v0[1] * v0[1]) + (v0[2] * v0[2] + v0[3] * v0[3])) + ((v1[0] * v1[0] + v1[1] * v1[1]) + (v1[2] * v1[2] + v1[3] * v1[3])); }
                s += __shfl_xor(s, 16); s += __shfl_xor(s, 32);
                if (fq == 0) P[r * 4 + wc] = s; }
            asm volatile("" ::: "memory"); }
        asm volatile("s_waitcnt lgkmcnt(0)" ::: "memory"); __builtin_amdgcn_s_barrier(); asm volatile("" ::: "memory");
        const int t = wid * 64 + lane;
        if (t < 256) { const PG8_LAS f32x4* Pr = (const PG8_LAS f32x4*)lds; const f32x4 p = Pr[t]; ssq[(size_t)(u.pm * BM + t) * 4 + u.pn] = (p[0] + p[1]) + (p[2] + p[3]); }
        asm volatile("s_waitcnt lgkmcnt(0)" ::: "memory"); __builtin_amdgcn_s_barrier(); asm volatile("" ::: "memory");
    }
};

template <bool OUT8> struct EpiSwiGLU {
    static constexpr bool PERM = true, AFTER_DRAIN = false;
    void* H; int ldh; const float* ssq; const float* rstd; int ncol; float cs;
    __device__ __forceinline__ void operator()(const f32x4 (&acc)[2][2][4][2], const Unit& u, int wr, int wc, int fr, int fq) const {
        const int row0 = u.pm * BM + wr * 64 + fr, col0 = (u.pn % ncol) * 128 + wc * 32 + 8 * fq;
#pragma unroll
        for (int ai = 0; ai < 2; ++ai)
#pragma unroll
            for (int m = 0; m < 4; ++m) { const int row = row0 + ai * HALF + m * 16;
                float k; if (ssq) { const f32x4 p = *(const f32x4*)(ssq + (size_t)row * 4); k = ((p[0] + p[1]) + (p[2] + p[3])) * (1.0f / 1024.0f) + RMS_EPS; } else { const float r_ = rstd[row]; k = 1.0f / (r_ * r_); }
                const float c1 = -LOG2E * cs * __builtin_amdgcn_rsqf(k); k = k / (cs * cs);
                f32x4 h[2];
#pragma unroll
                for (int n = 0; n < 2; ++n) { const f32x4 a = acc[ai][0][m][n], b = acc[ai][1][m][n];
                    const f32x2 h0 = swiglu2((f32x2){a[0], a[1]}, (f32x2){b[0], b[1]}, c1, k), h1 = swiglu2((f32x2){a[2], a[3]}, (f32x2){b[2], b[3]}, c1, k);
                    h[n] = (f32x4){h0.x, h0.y, h1.x, h1.y}; }
                if constexpr (OUT8) { u32x2 w; w.x = pk4_fp8(h[0][0] * F8_SHD, h[0][1] * F8_SHD, h[0][2] * F8_SHD, h[0][3] * F8_SHD); w.y = pk4_fp8(h[1][0] * F8_SHD, h[1][1] * F8_SHD, h[1][2] * F8_SHD, h[1][3] * F8_SHD);
                    st8_wt((unsigned char*)H + (size_t)row * ldh + col0, w.x, w.y); }
                else st16_wt((bf16_t*)H + (size_t)row * ldh + col0, pack8(h[0], h[1])); }
    }
};

struct EpiQKV {
    static constexpr bool PERM = true, AFTER_DRAIN = false;
    bf16_t *Q, *K, *V; const float* ssq; const float* qg; const float* kg; float qscale;
    __device__ __forceinline__ void operator()(const f32x4 (&acc)[2][2][4][2], const Unit& u, int wr, int wc, int fr, int fq) const {
        const int row0 = u.pm * BM + wr * 64 + fr;
        if (u.pn < 8) {
            const bool isq = u.pn < 4; bf16_t* base = isq ? Q : K; const float* gn = isq ? qg : kg; const float sc = isq ? qscale : 1.0f;
            const int col0 = (4 * (u.pn & 3) + wc) * 64 + 8 * fq;
            f32x4 gv[2][2];
#pragma unroll
            for (int bj = 0; bj < 2; ++bj)
#pragma unroll
                for (int n = 0; n < 2; ++n) gv[bj][n] = *(const f32x4*)(gn + 32 * bj + 8 * fq + 4 * n);
#pragma unroll
            for (int ai = 0; ai < 2; ++ai)
#pragma unroll
                for (int m = 0; m < 4; ++m) { const int row = row0 + ai * HALF + m * 16; const float rs = rstd_of(ssq, row);
                    f32x4 v[2][2]; float ss = 0.f;
#pragma unroll
                    for (int bj = 0; bj < 2; ++bj)
#pragma unroll
                        for (int n = 0; n < 2; ++n) { v[bj][n] = acc[ai][bj][m][n] * rs; ss += (v[bj][n][0] * v[bj][n][0] + v[bj][n][1] * v[bj][n][1]) + (v[bj][n][2] * v[bj][n][2] + v[bj][n][3] * v[bj][n][3]); }
                    ss += __shfl_xor(ss, 16); ss += __shfl_xor(ss, 32);
                    const float r2 = __builtin_amdgcn_rsqf(ss * (1.0f / 64.0f) + RMS_EPS) * sc;
#pragma unroll
                    for (int bj = 0; bj < 2; ++bj) st16_wt(base + (size_t)row * DM_ + col0 + 32 * bj, pack8(v[bj][0] * r2 * gv[bj][0], v[bj][1] * r2 * gv[bj][1])); }
        } else {
            const int col0 = (u.pn - 8) * BM + wc * 32 + 8 * fq;
#pragma unroll
            for (int ai = 0; ai < 2; ++ai)
#pragma unroll
                for (int m = 0; m < 4; ++m) { const int row = row0 + ai * HALF + m * 16; const float rs = rstd_of(ssq, row);
#pragma unroll
                    for (int bj = 0; bj < 2; ++bj) st16_wt(V + (size_t)row * DM_ + col0 + bj * HALF, pack8(acc[ai][bj][m][0] * rs, acc[ai][bj][m][1] * rs)); }
        }
    }
};

struct EpiSwiGLU8 {
    static constexpr bool PERM = true, AFTER_DRAIN = false;
    unsigned char* H; int ldh; int ncol;
    __device__ __forceinline__ void operator()(const f32x4 (&acc)[2][2][4][2], const Unit& u, int wr, int wc, int fr, int fq) const {
        const int row0 = u.pm * BM + wr * 64 + fr, col0 = (u.pn % ncol) * 128 + wc * 32 + 8 * fq; constexpr float cs = 1.0f / (F8_SA * F8_SWG);
#pragma unroll
        for (int ai = 0; ai < 2; ++ai)
#pragma unroll
            for (int m = 0; m < 4; ++m) { const int row = row0 + ai * HALF + m * 16; f32x4 h[2];
#pragma unroll
                for (int n = 0; n < 2; ++n) { const f32x4 a = acc[ai][0][m][n], b = acc[ai][1][m][n];
                    const f32x2 h0 = swiglu2((f32x2){a[0], a[1]}, (f32x2){b[0], b[1]}, -cs * LOG2E, 1.0f / (cs * cs * F8_SH)), h1 = swiglu2((f32x2){a[2], a[3]}, (f32x2){b[2], b[3]}, -cs * LOG2E, 1.0f / (cs * cs * F8_SH));
                    h[n] = (f32x4){h0.x, h0.y, h1.x, h1.y}; }
                u32x2 w; w.x = pk4_fp8(h[0][0], h[0][1], h[0][2], h[0][3]); w.y = pk4_fp8(h[1][0], h[1][1], h[1][2], h[1][3]);
                st8_wt(H + (size_t)row * ldh + col0, w.x, w.y); }
    }
};

struct EpiMoeDown {
    static constexpr bool PERM = true, AFTER_DRAIN = false;
    bf16_t* Y; const float* gate; float scale; bf16_t* Pp;
    __device__ __forceinline__ void operator()(const f32x4 (&acc)[2][2][4][2], const Unit& u, int wr, int wc, int fr, int fq) const {
        const int col0 = (u.pn & 3) * BM + wc * 32 + 8 * fq;
        if (u.aux >= 0) {
            bf16_t* base = Pp + ((size_t)u.aux * BM + wr * 64 + fr) * DM_ + col0;
#pragma unroll
            for (int ai = 0; ai < 2; ++ai)
#pragma unroll
                for (int m = 0; m < 4; ++m)
#pragma unroll
                    for (int bj = 0; bj < 2; ++bj) st16_wt(base + (size_t)(ai * HALF + m * 16) * DM_ + bj * HALF, pack8(acc[ai][bj][m][0] * scale, acc[ai][bj][m][1] * scale));
            return; }
        const int row0 = u.pm * BM + wr * 64 + fr;
#pragma unroll
        for (int ai = 0; ai < 2; ++ai)
#pragma unroll
            for (int m = 0; m < 4; ++m) { const int row = row0 + ai * HALF + m * 16; const float gt = gate[row] * scale;
#pragma unroll
                for (int bj = 0; bj < 2; ++bj) st16_wt(Y + (size_t)row * DM_ + col0 + bj * HALF, pack8(acc[ai][bj][m][0] * gt, acc[ai][bj][m][1] * gt)); }
    }
};

struct MoeOrder {
    int nM, nN, nwg, G, c, T, P0, npieces; int t1, t2, t3, t4, t5, t6, t7;
    static constexpr int SPL = 7, PKT = 4;
    __device__ __forceinline__ void init(const int* meta, int nN_, int G_, int c_, bool split) {
        T = meta[8]; nM = split ? meta[9] : T; nN = nN_; nwg = nM * nN; G = G_; c = c_; t1 = meta[1]; t2 = meta[2]; t3 = meta[3]; t4 = meta[4]; t5 = meta[5]; t6 = meta[6]; t7 = meta[7];
        P0 = ((nwg + G - 1) / G) * G; npieces = (T - nM) * nN * SPL; }
    __device__ __forceinline__ int expert_of(int pm) const { return (pm >= t1) + (pm >= t2) + (pm >= t3) + (pm >= t4) + (pm >= t5) + (pm >= t6) + (pm >= t7); }
    __device__ __forceinline__ bool next(int i, Unit& u) const {
        const long L = (long)i * G + c;
        if (L >= nwg) { const long q = L - P0; if (q < 0 || q >= npieces) return false;
            const int rt = (int)q / (nN * SPL), rem = (int)q % (nN * SPL), pnl = rem / SPL, kp = rem % SPL;
            u.pm = nM + rt; u.pn = expert_of(u.pm) * nN + pnl; u.kt0 = kp * PKT; u.nkt = PKT; u.aux = rt * SPL + kp; return true; }
        int wgid = (int)L; { const int q = nwg / NXCD, r = nwg % NXCD, xcd = wgid % NXCD, off = wgid / NXCD; wgid = (xcd < r ? xcd * (q + 1) : r * (q + 1) + (xcd - r) * q) + off; }
        const int nig = WGM * nN, gid = wgid / nig, fm = gid * WGM, gsz = (nM - fm) < WGM ? (nM - fm) : WGM;
        const int pm = fm + ((wgid % nig) % gsz), pnl = (wgid % nig) / gsz;
        u.pm = pm; u.pn = expert_of(pm) * nN + pnl; u.kt0 = 0; u.nkt = 0; u.aux = -1; return true;
    }
    __device__ __forceinline__ void a_ready(const Unit&) const {}
    __device__ __forceinline__ void done(const Unit&) const {}
};
template <class Epi, class Sched, bool ALIGN_EPI = false, bool SP2 = false, bool F8 = false>
__device__ __forceinline__ void gemm_phase(PG8_LAS unsigned char* lds, const Gemm g, const Sched& S, const Epi& E) {
    const int tid = threadIdx.x, wid = __builtin_amdgcn_readfirstlane(tid >> 6), lane = tid & 63, wr = wid >> 2, wc = wid & 3, fr = lane & 15, fq = lane >> 4;
    int K_ = g.K; asm volatile("" : "+s"(K_));
    const int K = K_, nt = K / BK;
    unsigned voffA[2], voffB[2];
#pragma unroll
    for (int i = 0; i < 2; ++i) { int R, C; stage_rc(tid * 16 + i * 8192, R, C); const int Rb = Epi::PERM ? ((R & ~31) + perm32(R & 31)) : R;
        voffA[i] = (unsigned)(R * K + C) * 2u; voffB[i] = (unsigned)(Rb * K + C) * 2u; }
    const size_t kstep = (size_t)(BK * 2);
    const size_t hstep = (size_t)HALF * K * 2;
    const size_t tstep = 2 * hstep;
    const unsigned ldsw = (unsigned)wid * 1024u;
    const int aoff = lds_byte(wr * 64 + fr, fq * 8), boff = lds_byte(wc * 32 + fr, fq * 8);
    constexpr int KSTEP = 1024;
#define PG8_SA(b, h) (((b) * 2 + (h)) * HTB)
#define PG8_SB(b, h) ((4 + (b) * 2 + (h)) * HTB)
#define PG8_STAGE(bufoff, gbase, voff) do { _Pragma("unroll") for (int _i = 0; _i < 2; ++_i) \
        __builtin_amdgcn_global_load_lds((const unsigned*)((const char*)(gbase) + (voff)[_i]), (PG8_LAS unsigned*)(lds + (bufoff) + ldsw + _i * 8192), 16, 0, 0); } while (0)
#define PG8_LDA(dst, b, h) do { _Pragma("unroll") for (int m = 0; m < 4; ++m) _Pragma("unroll") for (int k = 0; k < 2; ++k) dst[m][k] = *(const PG8_LAS bf16x8*)(lds + PG8_SA(b, h) + aoff + m * 2048 + k * KSTEP); } while (0)
#define PG8_LDB(dst, b, h) do { _Pragma("unroll") for (int n = 0; n < 2; ++n) _Pragma("unroll") for (int k = 0; k < 2; ++k) dst[n][k] = *(const PG8_LAS bf16x8*)(lds + PG8_SB(b, h) + boff + n * 2048 + k * KSTEP); } while (0)
#define PG8_CAT8(x) __builtin_shufflevector(__builtin_bit_cast(i32x4, (x)[0]), __builtin_bit_cast(i32x4, (x)[1]), 0, 1, 2, 3, 4, 5, 6, 7)
#define PG8_MMA(ai, bj, At, Bt) do { __builtin_amdgcn_s_setprio(1); _Pragma("unroll") for (int m = 0; m < 4; ++m) _Pragma("unroll") for (int n = 0; n < 2; ++n) { \
        if constexpr (F8) asm volatile("s_nop 1\n\tv_mfma_f32_16x16x128_f8f6f4 %0, %1, %2, %0" : "+v"(acc[ai][bj][m][n]) : "v"(PG8_CAT8(Bt[n])), "v"(PG8_CAT8(At[m]))); \
        else { _Pragma("unroll") for (int k = 0; k < 2; ++k) acc[ai][bj][m][n] = __builtin_amdgcn_mfma_f32_16x16x32_bf16(Bt[n][k], At[m][k], acc[ai][bj][m][n], 0, 0, 0); } } \
        __builtin_amdgcn_s_setprio(0); } while (0)
#define PG8_MMA0(ai, bj, At, Bt) do { __builtin_amdgcn_s_setprio(1); _Pragma("unroll") for (int m = 0; m < 4; ++m) _Pragma("unroll") for (int n = 0; n < 2; ++n) \
        asm volatile("s_nop 1\n\tv_mfma_f32_16x16x128_f8f6f4 %0, %1, %2, 0" : "=&v"(acc[ai][bj][m][n]) : "v"(PG8_CAT8(Bt[n])), "v"(PG8_CAT8(At[m]))); \
        __builtin_amdgcn_s_setprio(0); } while (0)
#define PG8_MMAF(ai, bj, At, Bt) do { if constexpr (F8) { if (t == 0) PG8_MMA0(ai, bj, At, Bt); else PG8_MMA(ai, bj, At, Bt); } else PG8_MMA(ai, bj, At, Bt); } while (0)
#define PG8_WAIT_V(n) asm volatile("s_waitcnt vmcnt(" #n ")" ::: "memory")
#define PG8_WAIT_L(n) asm volatile("s_waitcnt lgkmcnt(" #n ")" ::: "memory")
#define PG8_BAR __builtin_amdgcn_s_barrier()
#define PG8_SCHED __builtin_amdgcn_sched_barrier(0)
    Unit cur, nxt; int ui = 0;
    if (!S.next(0, cur)) return;
    f32x4 acc[2][2][4][2];
    if constexpr (!F8) {
#pragma unroll
    for (int a = 0; a < 2; ++a)
#pragma unroll
        for (int b = 0; b < 2; ++b)
#pragma unroll
            for (int m = 0; m < 4; ++m)
#pragma unroll
                for (int n = 0; n < 2; ++n) acc[a][b][m][n] = (f32x4){0.f, 0.f, 0.f, 0.f};
    }
    bf16x8 At[4][2], B0[2][2], B1[2][2];
    const char* cA = (const char*)g.A + (size_t)cur.pm * tstep + (size_t)cur.kt0 * kstep; const char* cB = (const char*)g.Bt + (size_t)cur.pn * tstep + (size_t)cur.kt0 * kstep;
    S.a_ready(cur);
    if constexpr (SP2) {
        PG8_STAGE(PG8_SB(0, 0), cB, voffB); PG8_STAGE(PG8_SB(0, 1), cB + hstep, voffB); PG8_STAGE(PG8_SA(0, 0), cA, voffA); PG8_STAGE(PG8_SA(0, 1), cA + hstep, voffA);
        if (wr == 1) PG8_BAR;
        PG8_WAIT_V(2); PG8_BAR;
        PG8_STAGE(PG8_SB(1, 0), cB + kstep, voffB); PG8_STAGE(PG8_SA(1, 0), cA + kstep, voffA); PG8_STAGE(PG8_SB(1, 1), cB + hstep + kstep, voffB);
        PG8_WAIT_V(6); PG8_BAR;
    } else {
        PG8_STAGE(PG8_SB(0, 0), cB, voffB); PG8_STAGE(PG8_SA(0, 0), cA, voffA); PG8_STAGE(PG8_SB(0, 1), cB + hstep, voffB); PG8_STAGE(PG8_SA(0, 1), cA + hstep, voffA);
        if (wr == 1) PG8_BAR;
        PG8_WAIT_V(4); PG8_BAR;
        PG8_STAGE(PG8_SB(1, 0), cB + kstep, voffB); PG8_STAGE(PG8_SA(1, 0), cA + kstep, voffA); PG8_STAGE(PG8_SB(1, 1), cB + hstep + kstep, voffB);
        PG8_WAIT_V(6); PG8_BAR;
    }
    for (;;) {
        const bool has_next = S.next(ui + 1, nxt);
        const char* nA = has_next ? (const char*)g.A + (size_t)nxt.pm * tstep + (size_t)nxt.kt0 * kstep : cA; const char* nB = has_next ? (const char*)g.Bt + (size_t)nxt.pn * tstep + (size_t)nxt.kt0 * kstep : cB;
        const int ntu = cur.nkt ? cur.nkt : nt;
        for (int t = 0; t < ntu; t += 2) {
            const bool last = (t == ntu - 2);
            const char* a1 = cA + (size_t)(t + 1) * kstep;
            const char* a2 = last ? nA : cA + (size_t)(t + 2) * kstep; const char* b2 = last ? nB : cB + (size_t)(t + 2) * kstep;
            const char* a3 = a2 + kstep; const char* b3 = b2 + kstep;
            if (last && has_next) S.a_ready(nxt);
            if constexpr (SP2) {
            PG8_LDB(B0, 0, 0); PG8_LDB(B1, 0, 1); PG8_SCHED; PG8_LDA(At, 0, 0); PG8_STAGE(PG8_SA(1, 1), a1 + hstep, voffA);
            PG8_WAIT_V(8); PG8_WAIT_L(0); PG8_BAR; PG8_MMAF(0, 0, At, B0); PG8_MMAF(0, 1, At, B1); PG8_BAR; PG8_SCHED;
            PG8_LDA(At, 0, 1); PG8_STAGE(PG8_SB(0, 0), b2, voffB); PG8_STAGE(PG8_SB(0, 1), b2 + hstep, voffB); PG8_STAGE(PG8_SA(0, 0), a2, voffA);
            PG8_WAIT_V(8); PG8_WAIT_L(0); PG8_BAR; PG8_MMAF(1, 0, At, B0); PG8_MMAF(1, 1, At, B1); PG8_BAR; PG8_SCHED;
            PG8_LDB(B0, 1, 0); PG8_LDB(B1, 1, 1); PG8_SCHED; PG8_LDA(At, 1, 0); PG8_STAGE(PG8_SA(0, 1), a2 + hstep, voffA);
            PG8_WAIT_V(8); PG8_WAIT_L(0); PG8_BAR; PG8_MMA(0, 0, At, B0); PG8_MMA(0, 1, At, B1); PG8_BAR; PG8_SCHED;
            PG8_LDA(At, 1, 1); PG8_STAGE(PG8_SB(1, 0), b3, voffB); PG8_STAGE(PG8_SB(1, 1), b3 + hstep, voffB); PG8_STAGE(PG8_SA(1, 0), a3, voffA);
            PG8_WAIT_V(8); PG8_WAIT_L(0); PG8_BAR; PG8_MMA(1, 0, At, B0); PG8_MMA(1, 1, At, B1); PG8_BAR; PG8_SCHED;
            } else {
            PG8_LDB(B0, 0, 0); PG8_SCHED; PG8_LDA(At, 0, 0); PG8_STAGE(PG8_SA(1, 1), a1 + hstep, voffA);
            PG8_WAIT_L(8); PG8_BAR; PG8_WAIT_L(0); PG8_MMAF(0, 0, At, B0); PG8_BAR; PG8_SCHED;
            PG8_LDB(B1, 0, 1); PG8_STAGE(PG8_SB(0, 0), b2, voffB);
            PG8_BAR; PG8_WAIT_L(0); PG8_MMAF(0, 1, At, B1); PG8_BAR;
            PG8_LDA(At, 0, 1); PG8_STAGE(PG8_SA(0, 0), a2, voffA);
            PG8_BAR; PG8_WAIT_L(0); PG8_MMAF(1, 0, At, B0); PG8_BAR; PG8_SCHED;
            PG8_STAGE(PG8_SB(0, 1), b2 + hstep, voffB);
            PG8_WAIT_V(6); PG8_BAR; PG8_MMAF(1, 1, At, B1); PG8_BAR;
            PG8_LDB(B0, 1, 0); PG8_SCHED; PG8_LDA(At, 1, 0); PG8_STAGE(PG8_SA(0, 1), a2 + hstep, voffA);
            PG8_WAIT_L(8); PG8_BAR; PG8_WAIT_L(0); PG8_MMA(0, 0, At, B0); PG8_BAR; PG8_SCHED;
            PG8_LDB(B1, 1, 1); PG8_STAGE(PG8_SB(1, 0), b3, voffB);
            PG8_BAR; PG8_WAIT_L(0); PG8_MMA(0, 1, At, B1); PG8_BAR;
            PG8_LDA(At, 1, 1); PG8_STAGE(PG8_SA(1, 0), a3, voffA);
            PG8_BAR; PG8_WAIT_L(0); PG8_MMA(1, 0, At, B0); PG8_BAR; PG8_SCHED;
            PG8_STAGE(PG8_SB(1, 1), b3 + hstep, voffB);
            PG8_WAIT_V(6); PG8_BAR; PG8_MMA(1, 1, At, B1); PG8_BAR;
            }
        }
        if constexpr (F8) asm volatile("s_nop 15\n\ts_nop 15" ::: "memory");
        if constexpr (ALIGN_EPI) { if (wr == 0) PG8_BAR; }
        if constexpr (!Epi::AFTER_DRAIN) { E(acc, cur, wr, wc, fr, fq); S.done(cur); }
        if (!has_next) break;
        if constexpr (!F8) {
#pragma unroll
        for (int a = 0; a < 2; ++a)
#pragma unroll
            for (int b = 0; b < 2; ++b)
#pragma unroll
                for (int m = 0; m < 4; ++m)
#pragma unroll
                    for (int n = 0; n < 2; ++n) acc[a][b][m][n] = (f32x4){0.f, 0.f, 0.f, 0.f};
        }
        cur = nxt; cA = nA; cB = nB; ++ui;
        if constexpr (ALIGN_EPI) { if (wr == 1) PG8_BAR; }
    }
    PG8_WAIT_V(0);
    if constexpr (!ALIGN_EPI) { if (wr == 0) PG8_BAR; }
    PG8_BAR;
    if constexpr (Epi::AFTER_DRAIN) { E.fused(acc, cur, wr, wc, fr, fq, lds, wid, lane); S.done(cur); }
#undef PG8_SA
#undef PG8_SB
#undef PG8_STAGE
#undef PG8_LDA
#undef PG8_LDB
#undef PG8_MMA
#undef PG8_MMA0
#undef PG8_MMAF
#undef PG8_CAT8
#undef PG8_WAIT_V
#undef PG8_WAIT_L
#undef PG8_BAR
#undef PG8_SCHED
}
}
#include <hip/hip_bf16.h>
#include <cmath>
namespace attn_body {
using bf16=__hip_bfloat16;
using bf16x8=__attribute__((ext_vector_type(8)))short;
using s16x4=__attribute__((ext_vector_type(4)))short;
using f32x16=__attribute__((ext_vector_type(16)))float;
using u32x4=__attribute__((ext_vector_type(4)))unsigned;
constexpr int BATCH=8,NHEAD=16,SEQ=2048,D=64,DM=NHEAD*D;
constexpr int NW=8,QBLK=32,QB=QBLK*NW,KVBLK=64,NQB=SEQ/QB;
constexpr int ATTN_PITCH=DM, ATTN_UNIT_ROWS=QB;
__device__ __forceinline__ int crow(int r,int hi){return (r&3)+8*(r>>2)+4*hi;}
#define SBAR() __builtin_amdgcn_sched_barrier(0)
__device__ __forceinline__ void cmask(f32x16&p0,f32x16&p1,int jb,int qrel,int hi){
  const float NEG=-INFINITY; int kb=64*jb+4*hi;
  #pragma unroll
  for(int r=0;r<16;++r){int kv=kb+(r&3)+8*(r>>2); if(kv>qrel)p0[r]=NEG; if(kv+32>qrel)p1[r]=NEG;}
}

constexpr int NSLOT=3, SLOTB=8192;
constexpr int LDS_K=0, LDS_V=NSLOT*SLOTB, LDS_WS=3*NSLOT*SLOTB, LDS_QS=LDS_WS+NW*64*4, LDS_OST=LDS_QS+NW*4096, LDS_BYTES=LDS_OST+NW*4096;
constexpr float C2=0.125f*1.4426950408889634f;
__device__ __forceinline__ void glds16(const void*gsrc,unsigned lds_dst){unsigned keep;
  asm volatile("s_mov_b32 %0, m0\n\ts_mov_b32 m0, %2\n\ts_nop 0\n\tglobal_load_lds_dwordx4 %1, off\n\ts_mov_b32 m0, %0":"=&s"(keep):"v"(gsrc),"s"(lds_dst):"memory");}
__device__ __forceinline__ float max3f(float a,float b,float c){float r;asm("v_max3_f32 %0, %1, %2, %3":"=v"(r):"v"(a),"v"(b),"v"(c));return r;}
__device__ __forceinline__ float max2f(float a,float b){float r;asm("v_max_f32_e32 %0, %1, %2":"=v"(r):"v"(a),"v"(b));return r;}
__device__ __forceinline__ float fadd_s(float a,float b){float r;asm("v_add_f32_e32 %0, %1, %2":"=v"(r):"v"(a),"v"(b));return r;}
__device__ __forceinline__ float fsub_s(float a,float b){float r;asm("v_sub_f32_e32 %0, %1, %2":"=v"(r):"v"(a),"v"(b));return r;}
typedef float f32x2_t __attribute__((ext_vector_type(2))); typedef __bf16 bf16x2_t __attribute__((ext_vector_type(2)));
__device__ __forceinline__ unsigned cvtpk_s(float lo,float hi){f32x2_t v={lo,hi};bf16x2_t b=__builtin_convertvector(v,bf16x2_t);return __builtin_bit_cast(unsigned,b);}
#define WAIT_BAR(N) asm volatile("s_waitcnt vmcnt(" #N ") lgkmcnt(0)\n\ts_barrier":::"memory")

__device__ __forceinline__ void qkt(f32x16&p0,f32x16&p1,const char*Kslot,const bf16x8*qr,int r32,int hi){ const f32x16 negm=f32x16{};
  const char*kb=Kslot+hi*1024+r32*16;
  #pragma unroll
  for(int d0=0;d0<4;++d0){
    const bf16x8 b0=*reinterpret_cast<const bf16x8*>(kb+d0*2048);
    const bf16x8 b1=*reinterpret_cast<const bf16x8*>(kb+d0*2048+512);
    if(d0==0){p0=__builtin_amdgcn_mfma_f32_32x32x16_bf16(b0,qr[0],negm,0,0,0);p1=__builtin_amdgcn_mfma_f32_32x32x16_bf16(b1,qr[0],negm,0,0,0);}
    else{p0=__builtin_amdgcn_mfma_f32_32x32x16_bf16(b0,qr[d0],p0,0,0,0);p1=__builtin_amdgcn_mfma_f32_32x32x16_bf16(b1,qr[d0],p1,0,0,0);}}
}
typedef __attribute__((address_space(3))) const char* lds_cptr;
typedef short v4i16_t __attribute__((ext_vector_type(4)));
__device__ __forceinline__ void kload8(bf16x8*kf,lds_cptr kp){
  kf[0]=*(const __attribute__((address_space(3))) bf16x8*)(kp);      kf[1]=*(const __attribute__((address_space(3))) bf16x8*)(kp+512);
  kf[2]=*(const __attribute__((address_space(3))) bf16x8*)(kp+2048); kf[3]=*(const __attribute__((address_space(3))) bf16x8*)(kp+2560);
  kf[4]=*(const __attribute__((address_space(3))) bf16x8*)(kp+4096); kf[5]=*(const __attribute__((address_space(3))) bf16x8*)(kp+4608);
  kf[6]=*(const __attribute__((address_space(3))) bf16x8*)(kp+6144); kf[7]=*(const __attribute__((address_space(3))) bf16x8*)(kp+6656);
}
__device__ __forceinline__ void kload2(bf16x8*kf,lds_cptr kp,int j){ kf[2*j]=*(const __attribute__((address_space(3))) bf16x8*)(kp+j*2048); kf[2*j+1]=*(const __attribute__((address_space(3))) bf16x8*)(kp+j*2048+512); }
__device__ __forceinline__ s16x4 vtr(lds_cptr p){ return __builtin_bit_cast(s16x4,__builtin_amdgcn_ds_read_tr16_b64_v4i16((__attribute__((address_space(3))) v4i16_t*)p)); }
__device__ __forceinline__ float rowmax(const f32x16&p0,const f32x16&p1){
  float a=max3f(p0[0],p0[1],p1[0]),b=max3f(p0[2],p0[3],p1[1]);a=max3f(a,p1[2],p1[3]);
  #pragma unroll
  for(int r=4;r<16;r+=4){a=max3f(a,p0[r],p0[r+1]);b=max3f(b,p0[r+2],p0[r+3]);a=max3f(a,p1[r],p1[r+1]);b=max3f(b,p1[r+2],p1[r+3]);}
  const float m=max2f(a,b);
  auto rr=__builtin_amdgcn_permlane32_swap(__float_as_uint(m),__float_as_uint(m),false,false);
  return max2f(__uint_as_float(rr[0]),__uint_as_float(rr[1]));
}
__device__ __forceinline__ void pv(f32x16*o,int vb,bf16x8 pa0,bf16x8 pa1,bf16x8 pa2,bf16x8 pa3){
  #pragma unroll
  for(int d0=0;d0<4;++d0){s16x4 lo[4],hi[4];
    #pragma unroll
    for(int ks=0;ks<4;++ks){
      asm volatile("ds_read_b64_tr_b16 %0,%1 offset:%c2":"=&v"(lo[ks]):"v"(vb),"i"(d0*4096+ks*1024):"memory");
      asm volatile("ds_read_b64_tr_b16 %0,%1 offset:%c2":"=&v"(hi[ks]):"v"(vb),"i"(d0*4096+ks*1024+512):"memory");}
    asm volatile("s_waitcnt lgkmcnt(0)":::"memory");SBAR();
    #define PK(k) (bf16x8){lo[k][0],lo[k][1],lo[k][2],lo[k][3],hi[k][0],hi[k][1],hi[k][2],hi[k][3]}
    o[d0]=__builtin_amdgcn_mfma_f32_32x32x16_bf16(pa0,PK(0),o[d0],0,0,0);
    o[d0]=__builtin_amdgcn_mfma_f32_32x32x16_bf16(pa1,PK(1),o[d0],0,0,0);
    o[d0]=__builtin_amdgcn_mfma_f32_32x32x16_bf16(pa2,PK(2),o[d0],0,0,0);
    o[d0]=__builtin_amdgcn_mfma_f32_32x32x16_bf16(pa3,PK(3),o[d0],0,0,0);
    #undef PK
  }
}

#ifndef ATTN_STORE16
#define ATTN_STORE16(p,v) pg8::st16_wt((void*)(p),(v))
#endif
template<int THRL,int MODE> __device__ __forceinline__ void attn_unit(int b,int qcol,int vcol,int qb,const bf16*Q,const bf16*__restrict__ K,const bf16*__restrict__ V,bf16*O,char*shm,bf16*ON,float lam,const float*subn){
  int tid_=threadIdx.x; asm volatile("":"+v"(tid_));
  const int tid=tid_,lane=tid&63,r32=lane&31,hi=lane>>5; const int wid=__builtin_amdgcn_readfirstlane(tid>>6);
  const long rowbase=(long)b*SEQ; const int q0=qb*QB;
  const bf16*Qw=Q+(rowbase+q0+wid*QBLK)*DM+qcol;
  const bf16*Kh=K+rowbase*DM+qcol,*Vh=V+rowbase*DM+vcol;
  const unsigned lds0=(unsigned)(uintptr_t)shm;
  float*wsf=(float*)(shm+LDS_WS)+wid*64;
  const bf16*ksrc=Kh+(long)lane*DM+wid*8;
  const bf16*vsrc=Vh+(long)(16*(wid&3)+(lane>>2))*DM+(wid>>2)*32+(lane&3)*8;
  const unsigned kdst=lds0+LDS_K+wid*1024, vdst=lds0+LDS_V+wid*1024;
  #define DMA_K(t,slot) glds16(ksrc+(long)(t)*KVBLK*DM,(unsigned)__builtin_amdgcn_readfirstlane(kdst+(slot)))
  #define DMA_V(t,slot) do{ glds16(vsrc+(long)(t)*KVBLK*DM,(unsigned)__builtin_amdgcn_readfirstlane(vdst+2*(slot))); glds16(vsrc+(long)(t)*KVBLK*DM+64,(unsigned)__builtin_amdgcn_readfirstlane(vdst+2*(slot)+8192)); }while(0)
  const int vb0=(int)(lds0+LDS_V)+((lane>>4)&1)*32+(lane&3)*8+(4*hi+((lane&15)>>2))*64;
  const char*Kbase=shm+LDS_K; bf16x8 kf[8];
  const lds_cptr shm3=(lds_cptr)shm; const lds_cptr kp0=shm3+LDS_K+hi*1024+r32*16; const lds_cptr vp0=shm3+LDS_V+((lane>>4)&1)*32+(lane&3)*8+(4*hi+((lane&15)>>2))*64;
  const int NT=(q0+QB)/KVBLK;
  DMA_K(0,0);DMA_V(0,0);DMA_K(1,SLOTB);
  bf16x8 qr[4];
  #pragma unroll
  for(int d0=0;d0<4;++d0)qr[d0]=*reinterpret_cast<const bf16x8*>(&Qw[(long)r32*DM+d0*16+hi*8]);
  float mhat=0.f,l_reg=0.f;f32x16 o[4];o[0]=f32x16{};o[1]=f32x16{};o[2]=f32x16{};o[3]=f32x16{};
  typedef __attribute__((address_space(3))) bf16x8* lds_q8; const lds_cptr qp0=shm3+LDS_QS+wid*4096+lane*16;
  #define QF(j) (*(const __attribute__((address_space(3))) bf16x8*)(qp0+(j)*1024))
  const int qrel=wid*QBLK+r32;
  #define CMASK(P0,P1,t) do{int jb_=(t)-(NT-4); if(jb_>=0)cmask(P0,P1,jb_,qrel,hi);}while(0)
  bool resc=false;
  #define START(P0,P1) do{ resc=false; if constexpr(THRL>=0){ const float rm=rowmax(P0,P1); \
    { const float dl=rm; mhat=fadd_s(mhat,dl); \
      _Pragma("unroll") for(int r=0;r<16;++r){P0[r]=fsub_s(P0[r],dl);P1[r]=fsub_s(P1[r],dl);} } } \
    _Pragma("unroll") for(int r=0;r<16;++r)P0[r]=__builtin_amdgcn_exp2f(P0[r]); }while(0)
  #define RESC() do{ if(resc){ asm volatile("s_waitcnt lgkmcnt(0)":::"memory"); \
      _Pragma("unroll") for(int d_=0;d_<4;++d_) _Pragma("unroll") for(int r=0;r<16;++r)o[d_][r]*=wsf[crow(r,hi)]; } }while(0)
  f32x16 pA0,pA1,pB0,pB1;
  int sl_prev=0,sl_cur=0,sl_next=SLOTB;
  #define ROT() do{sl_prev=sl_cur;sl_cur=sl_next;sl_next=(sl_next==(NSLOT-1)*SLOTB)?0:sl_next+SLOTB;}while(0)
  DMA_K(2,2*SLOTB);
  _Pragma("unroll") for(int d0=0;d0<4;++d0)*(__attribute__((address_space(3))) bf16x8*)(__attribute__((address_space(3))) char*)(qp0+d0*1024)=qr[d0];
  WAIT_BAR(4);
  qkt(pA0,pA1,Kbase,qr,r32,hi);asm volatile("s_nop 15\n\ts_nop 7":"+v"(pA0),"+v"(pA1));CMASK(pA0,pA1,0);
  START(pA0,pA1);
  _Pragma("unroll") for(int r=0;r<16;++r)pA1[r]=__builtin_amdgcn_exp2f(pA1[r]);
  WAIT_BAR(0);
  DMA_K(3,0);DMA_V(1,SLOTB);
  ROT();
  kload8(kf,kp0+sl_cur);
  bf16x8 qa=QF(0),qb_=QF(1);
  WAIT_BAR(3);
  s16x4 vlo[8],vhi[8]; u32x4 pw0,pw1,pw2,pw3;
  #define PKW(P,B) cvtpk_s(P[B],P[B+1])
  #define PAF(k) __builtin_bit_cast(bf16x8,pw##k)
  #define VFR(i) (bf16x8){vlo[i][0],vlo[i][1],vlo[i][2],vlo[i][3],vhi[i][0],vhi[i][1],vhi[i][2],vhi[i][3]}
  #define PIN(x) asm volatile("":"+v"(x))
  #define MX3(a,b,c) __builtin_fmaxf(__builtin_fmaxf((a),(b)),(c))
  #define GAPA(MF,A0,A1,A2,A3,W0,W1,PW) do{ MF; sacc+=A0; sacc+=A1; sacc+=A2; sacc+=A3; PIN(sacc); W0; W1; PIN(PW); SBAR(); }while(0)
  #define EX(v) __builtin_amdgcn_exp2f(v)
  #define GAPB(MF,X,B) do{ MF; X[B]=EX(X[B]); X[B+1]=EX(X[B+1]); PIN(X); SBAR(); }while(0)
  #define VRD(i) do{ vlo[i]=vtr(vp_+(((i)>>2)*4096+((i)&3)*1024)); vhi[i]=vtr(vp_+(((i)>>2)*4096+((i)&3)*1024+512)); }while(0)
  #define VRDX(reg,fr) do{ vlo[reg]=vtr(vp_+(((fr)>>2)*4096+((fr)&3)*1024)); vhi[reg]=vtr(vp_+(((fr)>>2)*4096+((fr)&3)*1024+512)); SBAR(); }while(0)
  #define KRD(G,j) do{ if(G){ kload2(kf,kp0+sl_next,j); SBAR(); } }while(0)
  #define ZC f32x16{}
  #define STEP(C0,C1,P0,P1,t,GK,GV,GL) do{ SBAR(); \
    const lds_cptr vp_=vp0+2*sl_prev; \
    VRD(0); SBAR(); float sacc=(P0[0]+P0[1]); \
    GAPA(C0=__builtin_amdgcn_mfma_f32_32x32x16_bf16(kf[0],qa,ZC,0,0,0), P0[2],P0[3],P0[4],P0[5],     pw0[0]=PKW(P0,0), pw0[1]=PKW(P0,2), pw0); \
    VRD(4); SBAR(); GAPA(C1=__builtin_amdgcn_mfma_f32_32x32x16_bf16(kf[1],qa,ZC,0,0,0), P0[6],P0[7],P0[8],P0[9],     pw0[2]=PKW(P0,4), pw0[3]=PKW(P0,6), pw0); \
    qa=QF(2); SBAR(); \
    VRD(1); SBAR(); GAPA(C0=__builtin_amdgcn_mfma_f32_32x32x16_bf16(kf[2],qb_,C0,0,0,0),   P0[10],P0[11],P0[12],P0[13], pw1[0]=PKW(P0,8), pw1[1]=PKW(P0,10), pw1); \
    VRD(5); SBAR(); GAPA(C1=__builtin_amdgcn_mfma_f32_32x32x16_bf16(kf[3],qb_,C1,0,0,0),   P0[14],P0[15],P1[0],P1[1],   pw1[2]=PKW(P0,12),pw1[3]=PKW(P0,14), pw1); \
    qb_=QF(3); SBAR(); \
    VRD(2); SBAR(); GAPA(C0=__builtin_amdgcn_mfma_f32_32x32x16_bf16(kf[4],qa,C0,0,0,0),   P1[2],P1[3],P1[4],P1[5],     pw2[0]=PKW(P1,0), pw2[1]=PKW(P1,2), pw2); \
    VRD(6); SBAR(); GAPA(C1=__builtin_amdgcn_mfma_f32_32x32x16_bf16(kf[5],qa,C1,0,0,0),   P1[6],P1[7],P1[8],P1[9],     pw2[2]=PKW(P1,4), pw2[3]=PKW(P1,6), pw2); \
    VRD(3); SBAR(); GAPA(C0=__builtin_amdgcn_mfma_f32_32x32x16_bf16(kf[6],qb_,C0,0,0,0),   P1[10],P1[11],P1[12],P1[13], pw3[0]=PKW(P1,8), pw3[1]=PKW(P1,10), pw3); \
    VRD(7); SBAR(); GAPA(C1=__builtin_amdgcn_mfma_f32_32x32x16_bf16(kf[7],qb_,C1,0,0,0),   P1[14],P1[15],0.f,0.f,       pw3[2]=PKW(P1,12),pw3[3]=PKW(P1,14), pw3); \
    l_reg+=sacc; \
    if(GK){DMA_K((t)+3,sl_cur);} if(GV){DMA_V((t)+1,sl_next);} \
    CMASK(C0,C1,t); \
    if constexpr(THRL>=0){ float a=MX3(C0[0],C0[1],C1[0]),b=MX3(C0[2],C0[3],C1[1]); a=MX3(a,C1[2],C1[3]); \
      _Pragma("unroll") for(int r=4;r<16;r+=4){a=MX3(a,C0[r],C0[r+1]);b=MX3(b,C0[r+2],C0[r+3]);a=MX3(a,C1[r],C1[r+1]);b=MX3(b,C1[r+2],C1[r+3]);} \
      float rm=__builtin_fmaxf(a,b); { auto rr=__builtin_amdgcn_permlane32_swap(__float_as_uint(rm),__float_as_uint(rm),false,false); rm=__builtin_fmaxf(__uint_as_float(rr[0]),__uint_as_float(rr[1])); } \
      rm-=mhat; resc=false;                                      \
      if(__builtin_expect(__any(rm>(float)THRL),0)){ const float dl=__builtin_fmaxf(rm,0.f); mhat+=dl; \
        const float f=__builtin_amdgcn_exp2f(-dl); l_reg*=f; if(hi==0)wsf[r32]=f; resc=true; } \
      _Pragma("unroll") for(int r=0;r<16;++r){C0[r]-=mhat;C1[r]-=mhat;} } \
    SBAR(); \
    GAPB(o[0]=__builtin_amdgcn_mfma_f32_32x32x16_bf16(PAF(0),VFR(0),o[0],0,0,0), C0,0);  VRDX(0,8); \
    GAPB(o[1]=__builtin_amdgcn_mfma_f32_32x32x16_bf16(PAF(0),VFR(4),o[1],0,0,0), C0,2);  VRDX(4,12); \
    GAPB(o[0]=__builtin_amdgcn_mfma_f32_32x32x16_bf16(PAF(1),VFR(1),o[0],0,0,0), C0,4);  VRDX(1,9); \
    GAPB(o[1]=__builtin_amdgcn_mfma_f32_32x32x16_bf16(PAF(1),VFR(5),o[1],0,0,0), C0,6);  VRDX(5,13); \
    GAPB(o[0]=__builtin_amdgcn_mfma_f32_32x32x16_bf16(PAF(2),VFR(2),o[0],0,0,0), C0,8);  VRDX(2,10); \
    GAPB(o[1]=__builtin_amdgcn_mfma_f32_32x32x16_bf16(PAF(2),VFR(6),o[1],0,0,0), C0,10); VRDX(6,14); \
    GAPB(o[0]=__builtin_amdgcn_mfma_f32_32x32x16_bf16(PAF(3),VFR(3),o[0],0,0,0), C0,12); VRDX(3,11); \
    GAPB(o[1]=__builtin_amdgcn_mfma_f32_32x32x16_bf16(PAF(3),VFR(7),o[1],0,0,0), C0,14); VRDX(7,15); \
    KRD(GL,0); GAPB(o[2]=__builtin_amdgcn_mfma_f32_32x32x16_bf16(PAF(0),VFR(0),o[2],0,0,0), C1,0); \
    KRD(GL,1); GAPB(o[3]=__builtin_amdgcn_mfma_f32_32x32x16_bf16(PAF(0),VFR(4),o[3],0,0,0), C1,2); \
    KRD(GL,2); GAPB(o[2]=__builtin_amdgcn_mfma_f32_32x32x16_bf16(PAF(1),VFR(1),o[2],0,0,0), C1,4); \
    KRD(GL,3); GAPB(o[3]=__builtin_amdgcn_mfma_f32_32x32x16_bf16(PAF(1),VFR(5),o[3],0,0,0), C1,6); \
    GAPB(o[2]=__builtin_amdgcn_mfma_f32_32x32x16_bf16(PAF(2),VFR(2),o[2],0,0,0), C1,8); \
    GAPB(o[3]=__builtin_amdgcn_mfma_f32_32x32x16_bf16(PAF(2),VFR(6),o[3],0,0,0), C1,10); \
    qa=QF(0); SBAR(); \
    GAPB(o[2]=__builtin_amdgcn_mfma_f32_32x32x16_bf16(PAF(3),VFR(3),o[2],0,0,0), C1,12); \
    qb_=QF(1); SBAR(); \
    GAPB(o[3]=__builtin_amdgcn_mfma_f32_32x32x16_bf16(PAF(3),VFR(7),o[3],0,0,0), C1,14); \
    }while(0)
  int t=1;
  #undef CMASK
  #define CMASK(P0,P1,t) do{}while(0)
  for(;t+5<NT;t+=2){
    STEP(pB0,pB1,pA0,pA1,t,true,true,true);     WAIT_BAR(3); RESC(); ROT();
    STEP(pA0,pA1,pB0,pB1,t+1,true,true,true);   WAIT_BAR(3); RESC(); ROT();
  }
  #undef CMASK
  #define CMASK(P0,P1,t) do{int jb_=(t)-(NT-4); if(jb_>=0)cmask(P0,P1,jb_,qrel,hi);}while(0)
  #define ENDW(tt) do{ if((tt)+3<NT){WAIT_BAR(3);} else if((tt)+2<NT){WAIT_BAR(2);} else {WAIT_BAR(0);} }while(0)
  for(;t+1<NT;t+=2){
    STEP(pB0,pB1,pA0,pA1,t,(t+3<NT),(t+1<NT),(t+1<NT));       ENDW(t);   RESC(); ROT();
    STEP(pA0,pA1,pB0,pB1,t+1,(t+4<NT),(t+2<NT),(t+2<NT));     ENDW(t+1); RESC(); ROT();
  }
  STEP(pB0,pB1,pA0,pA1,NT-1,false,false,false); RESC();
  { float sacc=pB0[0]+pB0[1]; _Pragma("unroll") for(int r=2;r<16;++r)sacc+=pB0[r]; _Pragma("unroll") for(int r=0;r<16;++r)sacc+=pB1[r]; l_reg+=sacc;
    pw0=(u32x4){PKW(pB0,0),PKW(pB0,2),PKW(pB0,4),PKW(pB0,6)};pw1=(u32x4){PKW(pB0,8),PKW(pB0,10),PKW(pB0,12),PKW(pB0,14)};pw2=(u32x4){PKW(pB1,0),PKW(pB1,2),PKW(pB1,4),PKW(pB1,6)};pw3=(u32x4){PKW(pB1,8),PKW(pB1,10),PKW(pB1,12),PKW(pB1,14)};
    SBAR(); pv(o,vb0+2*sl_cur,PAF(0),PAF(1),PAF(2),PAF(3)); }
  #undef PKW
  #undef PAF
  #undef VFR
  #undef PIN
  #undef MX3
  #undef GAPA
  #undef GAPB
  #undef EX
  #undef VRD
  #undef VRDX
  #undef ZC
  #undef QF
  #undef KRD
  #undef STEP
  #undef ENDW
  {auto rr=__builtin_amdgcn_permlane32_swap(__float_as_uint(l_reg),__float_as_uint(l_reg),false,false);l_reg=__uint_as_float(rr[0])+__uint_as_float(rr[1]);}
  if(hi==0)wsf[32+r32]=l_reg;asm volatile("s_waitcnt lgkmcnt(0)":::"memory");
  float rli[16];
  #pragma unroll
  for(int r=0;r<16;++r)rli[r]=__builtin_amdgcn_rcpf(wsf[32+crow(r,hi)]);
  bf16*Ow=O+(rowbase+q0+wid*QBLK)*DM+vcol;
  if constexpr(MODE==0){ bf16*stg=(bf16*)(shm+LDS_OST)+wid*2048;
    #pragma unroll
    for(int hf=0;hf<2;++hf){
      #pragma unroll
      for(int r=0;r<16;++r){const int orow=crow(r,hi);
        #pragma unroll
        for(int d0=0;d0<2;++d0)stg[orow*64+d0*32+r32]=__float2bfloat16(o[2*hf+d0][r]*rli[r]);}
      asm volatile("s_waitcnt lgkmcnt(0)":::"memory");
      #pragma unroll
      for(int i=0;i<4;++i){const int row=i*8+(lane>>3),ch=lane&7; const u32x4 v=*(const u32x4*)(stg+row*64+ch*8); ATTN_STORE16(Ow+(long)row*DM+hf*64+ch*8,v);}
      asm volatile("s_waitcnt lgkmcnt(0)":::"memory"); } }
  else { bf16*stg0=(bf16*)(shm+LDS_OST)+wid*2048,*stg1=(bf16*)(shm+LDS_QS)+wid*2048;
    #pragma unroll
    for(int r=0;r<16;++r){const int orow=crow(r,hi);
      #pragma unroll
      for(int d0=0;d0<2;++d0){stg0[orow*64+d0*32+r32]=__float2bfloat16(o[d0][r]*rli[r]);stg1[orow*64+d0*32+r32]=__float2bfloat16(o[2+d0][r]*rli[r]);}}
    asm volatile("s_waitcnt vmcnt(0) lgkmcnt(0)":::"memory");
    const int ch=lane&7; float g0[8],g1[8];
    #pragma unroll
    for(int j=0;j<8;++j){g0[j]=subn[ch*8+j];g1[j]=subn[64+ch*8+j];}
    bf16*ONw=ON+(rowbase+q0+wid*QBLK)*DM+vcol;
    #pragma unroll
    for(int i=0;i<4;++i){const int row=i*8+(lane>>3);
      const u32x4 a0=*(const u32x4*)(stg0+row*64+ch*8),a1=*(const u32x4*)(stg1+row*64+ch*8);
      const u32x4 b0=*(const u32x4*)(Ow+(long)row*DM+ch*8),b1=*(const u32x4*)(Ow+(long)row*DM+64+ch*8);
      float d[16];
      #pragma unroll
      for(int j=0;j<4;++j){
        d[2*j]  =__uint_as_float(b0[j]<<16)        -lam*__uint_as_float(a0[j]<<16);
        d[2*j+1]=__uint_as_float(b0[j]&0xffff0000u)-lam*__uint_as_float(a0[j]&0xffff0000u);
        d[8+2*j]  =__uint_as_float(b1[j]<<16)        -lam*__uint_as_float(a1[j]<<16);
        d[8+2*j+1]=__uint_as_float(b1[j]&0xffff0000u)-lam*__uint_as_float(a1[j]&0xffff0000u);}
      float ss=0.f;
      #pragma unroll
      for(int j=0;j<16;++j)ss+=d[j]*d[j];
      ss+=__shfl_xor(ss,1);ss+=__shfl_xor(ss,2);ss+=__shfl_xor(ss,4);
      const float rs=__builtin_amdgcn_rsqf(ss*(1.0f/128.0f)+1e-6f);
      u32x4 w0,w1;
      #pragma unroll
      for(int j=0;j<4;++j){w0[j]=cvtpk_s(d[2*j]*rs*g0[2*j],d[2*j+1]*rs*g0[2*j+1]);w1[j]=cvtpk_s(d[8+2*j]*rs*g1[2*j],d[8+2*j+1]*rs*g1[2*j+1]);}
      ATTN_STORE16(ONw+(long)row*DM+ch*8,w0);ATTN_STORE16(ONw+(long)row*DM+64+ch*8,w1);}
    asm volatile("s_waitcnt lgkmcnt(0)":::"memory"); }
  asm volatile("s_waitcnt lgkmcnt(0)\n\ts_barrier":::"memory");
  #undef DMA_K
  #undef DMA_V
  #undef CMASK
  #undef START
  #undef RESC
  #undef ROT
}
constexpr int ATTN_LDS_BYTES=LDS_BYTES;
#undef SBAR
#undef WAIT_BAR
}
constexpr int NWAVES = 8;
constexpr int NPH = 15;
constexpr size_t MiB = 1u << 20;
constexpr size_t WS_CTL = 0, CTL_ZERO_BYTES = 1 * MiB;
constexpr size_t WS_W_IN = 1 * MiB;
constexpr size_t WS_W_OUT = WS_W_IN + (size_t)3072 * 1024 * 2;
constexpr size_t WS_W_GU = WS_W_OUT + (size_t)1024 * 1024 * 2;
constexpr size_t WS_W_DN = WS_W_GU + (size_t)5632 * 1024 * 2;
constexpr size_t WS_W_QKV = WS_W_DN + (size_t)1024 * 2816 * 2;
constexpr size_t WS_W_O = WS_W_QKV + (size_t)3072 * 1024 * 2;
constexpr size_t WS_W_MGU = WS_W_O + (size_t)1024 * 1024 * 2;
constexpr size_t WS_W_MDN = WS_W_MGU + (size_t)8 * 7168 * 1024 * 2;
constexpr size_t WS_W_END = WS_W_MDN + (size_t)8 * 1024 * 3584 * 2;
constexpr size_t WS_R = 202 * MiB;
constexpr size_t ACT = (size_t)M * D * 2;
constexpr size_t WS_XN0 = WS_R, WS_BB = WS_R + ACT, WS_UB = WS_R + 2 * ACT, WS_G = WS_R + 3 * ACT;
constexpr size_t WS_HACT = WS_R;
constexpr size_t WS_Q = WS_R + 4 * ACT, WS_K = WS_R + 5 * ACT, WS_V = WS_R + 6 * ACT;
constexpr size_t WS_X8 = WS_R + 5 * ACT;
constexpr size_t WS_O0 = WS_R, WS_O1 = WS_R + ACT, WS_ON = WS_R + 2 * ACT;
constexpr size_t WS_HM = WS_R;
constexpr size_t WS_PP = WS_R + 128 * MiB;
constexpr size_t WS_S = 440 * MiB;
constexpr size_t WS_XG = WS_S, WS_Y = WS_S + 68 * MiB;
constexpr size_t WS_XB = 632 * MiB;
constexpr size_t WS_HB = 664 * MiB, WS_HB2 = 696 * MiB, WS_YF = 728 * MiB;
constexpr size_t WS_SMALL = 792 * MiB;
constexpr size_t WS_SSQ = WS_SMALL;
constexpr size_t WS_SEL = WS_SMALL + 256 * 1024, WS_GATE = WS_SEL + 128 * 1024, WS_TOKSLOT = WS_GATE + 128 * 1024;
constexpr size_t WS_RSTDS = WS_TOKSLOT + 128 * 1024, WS_GATES = WS_RSTDS + 256 * 1024;
constexpr size_t WS_HIST = WS_GATES + 256 * 1024, WS_META = WS_HIST + 16 * 1024;
constexpr size_t WS_NAIVE_SMALL = WS_SMALL + 2 * MiB;
constexpr size_t WS_END = 796 * MiB;
static_assert(WS_W_END <= WS_R && WS_R + (size_t)SLOTS * DFE * 2 <= WS_S && WS_Y + (size_t)SLOTS * D * 2 <= WS_XB && WS_V + ACT <= WS_S, "d_ws map");
constexpr int CW_TMO = 0, CW_CODE = 1, CW_BAR = 4096;
constexpr int MISC_OFF = 0, RING_OFF = 1024, RING_BYTES = 131072, LDS_BYTES = 147456;
constexpr int P0_SCR = 16640;

#define GAS __attribute__((address_space(1)))
#define LAS __attribute__((address_space(3)))
typedef unsigned v4u __attribute__((ext_vector_type(4)));
typedef unsigned v2u __attribute__((ext_vector_type(2)));
typedef GAS unsigned gu32;
#define RLX_AGENT __ATOMIC_RELAXED, __HIP_MEMORY_SCOPE_AGENT
#define LDS_WAIT() asm volatile("s_waitcnt lgkmcnt(0)" ::: "memory")
#define VM_WAIT() asm volatile("s_waitcnt vmcnt(0)" ::: "memory")
__device__ __forceinline__ unsigned pk2(float lo, float hi) { return f2bf(lo) | (f2bf(hi) << 16); }
__device__ __forceinline__ float bflo(unsigned w) { return __builtin_bit_cast(float, w << 16); }
__device__ __forceinline__ float bfhi(unsigned w) { return __builtin_bit_cast(float, w & 0xffff0000u); }

#define XB_TMO      128
#define XB_XCNT(j)  (256  + 64 * (j))
#define XB_XSUB(j)  (1280 + 64 * (j))
#define XB_XGEN(j)  (2304 + 64 * (j))
#define XB_TOP      3328
#define XB_TOPGEN   3392
#define XCD_BAR_WORDS 3456
#define XB_SPIN_CAP (1u << 18)

__device__ __forceinline__ unsigned xb_ld(unsigned* p)              { return __hip_atomic_load(p, __ATOMIC_RELAXED, __HIP_MEMORY_SCOPE_AGENT); }
__device__ __forceinline__ unsigned xb_add(unsigned* p, unsigned v) { return __hip_atomic_fetch_add(p, v, __ATOMIC_RELAXED, __HIP_MEMORY_SCOPE_AGENT); }
__device__ __forceinline__ unsigned xb_xcc_id() { return (unsigned)__builtin_amdgcn_s_getreg((3 << 11) | 20) & 0xFu; }
#define XB_SPIN(cond, bar) do { unsigned _sp = 0; while (cond) { __builtin_amdgcn_s_sleep(1); \
    if ((++_sp & 255u) == 0u) { if (xb_ld(&(bar)[XB_TMO])) break; if (_sp > XB_SPIN_CAP) { atomicAdd(&(bar)[XB_TMO], 1u); break; } } } } while (0)

struct XcdBarrier {
    unsigned* bar; unsigned x;
    volatile LAS unsigned* st;
};

__device__ __forceinline__ XcdBarrier xcd_barrier_post(unsigned* bar, volatile LAS unsigned* st) {
    XcdBarrier b; b.bar = bar; b.x = xb_xcc_id(); b.st = st;
    if (threadIdx.x == 0) (void)xb_add(&bar[XB_XCNT(b.x)], 1u);
    return b;
}
__device__ __forceinline__ void xcd_barrier_complete(unsigned* bar, unsigned x, unsigned& nloc, unsigned& nx) {
    const unsigned G = gridDim.x * gridDim.y * gridDim.z;
    unsigned sum, cnt, mine, sp = 0u;
    for (;;) {
        sum = 0u; cnt = 0u; mine = 0u;
#pragma unroll
        for (unsigned j = 0; j < 16; ++j) { const unsigned c = xb_ld(&bar[XB_XCNT(j)]); sum += c; cnt += (c > 0u) ? 1u : 0u; mine = (j == x) ? c : mine; }
        if (sum == G) break;
        __builtin_amdgcn_s_sleep(1);
        if ((++sp & 255u) == 0u) { if (xb_ld(&bar[XB_TMO])) break; if (sp > XB_SPIN_CAP) { atomicAdd(&bar[XB_TMO], 1u); break; } }
    }
    nloc = mine > 0u ? mine : 1u; nx = cnt > 0u ? cnt : 1u;
}

__device__ __forceinline__ void xcd_barrier(const XcdBarrier& b) {
    asm volatile("s_waitcnt vmcnt(0)" ::: "memory");
    __syncthreads();
    if (threadIdx.x == 0) {
        unsigned* bar = b.bar;
        __builtin_amdgcn_s_waitcnt(0);
        unsigned nloc = b.st[0], nx = b.st[1];
        if (nloc == 0u) { xcd_barrier_complete(bar, b.x, nloc, nx); b.st[0] = nloc; b.st[1] = nx; }
        const unsigned old = xb_add(&bar[XB_XSUB(b.x)], 1u);
        const unsigned gen = old / nloc;
        if (old + 1u == (gen + 1u) * nloc) {
            __builtin_amdgcn_fence(__ATOMIC_RELEASE, "agent");
            asm volatile("s_waitcnt vmcnt(0)" ::: "memory");
            const unsigned og = xb_add(&bar[XB_TOP], 1u);
            const unsigned tg = og / nx;
            if (og + 1u == (tg + 1u) * nx) xb_add(&bar[XB_TOPGEN], 1u);
            else XB_SPIN(xb_ld(&bar[XB_TOPGEN]) == tg, bar);
            __builtin_amdgcn_fence(__ATOMIC_ACQUIRE, "agent");
            xb_add(&bar[XB_XGEN(b.x)], 1u);
            asm volatile("s_waitcnt vmcnt(0)" ::: "memory");
        } else {
            XB_SPIN(xb_ld(&bar[XB_XGEN(b.x)]) == gen, bar);
            __builtin_amdgcn_fence(__ATOMIC_ACQUIRE, "agent");
            asm volatile("s_waitcnt vmcnt(0)" ::: "memory");
        }
    }
    __syncthreads();
}


struct Args { const float* in[19]; float* out; unsigned char* wsp; int ph_lo, ph_hi, li, jobmask; };
struct Frame { LAS unsigned char* lds; int tid, lane, wave, vcu, G; };
#define KA ((const Args*)__builtin_amdgcn_kernarg_segment_ptr())
#define INP(i) (KA->in[i])
#define A_WS (KA->wsp)
#define A_OUT (KA->out)

__device__ __forceinline__ int p0_dstrow(int mode, int aux, int col) {
    if (mode == 1) { if (col < 1024) return col; const int v = col >= 2048, cc = col - (v ? 2048 : 1024); return 1024 + 256 * (cc >> 7) + 128 * v + (cc & 127); }
    if (mode == 2) { const int up = col >= aux, cc = col - (up ? aux : 0); return 256 * (cc >> 7) + 128 * up + (cc & 127); }
    if (mode == 3) { const int g = col >> 6, bj = (col >> 5) & 1; return 256 * (g >> 2) + 32 * (4 * bj + (g & 3)) + (col & 31); }
    return col;
}
struct P0Item { const float* src; const float* gain; unsigned char* dst; int ldw, K, k0, d0, d1, f8; float sc; };
#define P0_JOB(SRC, LDW, KK, C0, NCOLS, GAIN, DSTOFF, DROW0, DSTROWS, MODE, AUX, NMAT, SC, F8) { \
    constexpr int nn_ = (NCOLS) / 64, per_ = ((KK) / 64) * nn_, cnt_ = per_ * (NMAT); \
    if (it < cnt_) { const int mat = it / per_, r = it % per_, kb = r / nn_, col = 64 * (r % nn_); \
        I.src = (SRC) + (size_t)mat * (KK) * (LDW) + (C0) + col; I.gain = (GAIN); I.dst = A_WS + (DSTOFF) + (size_t)mat * (DSTROWS) * (KK) * ((F8) ? 1 : 2); \
        I.ldw = (LDW); I.K = (KK); I.k0 = 64 * kb; I.d0 = (DROW0) + p0_dstrow(MODE, AUX, col); I.d1 = (DROW0) + p0_dstrow(MODE, AUX, col + 32); I.f8 = (F8); I.sc = (SC); return; } \
    it -= cnt_; }
constexpr int P0_NITEMS = 16 * 48 + 16 * 16 + 16 * 88 + 44 * 16 + 3 * 16 * 16 + 16 * 16 + 8 * 16 * 112 + 8 * 56 * 16;
__device__ __forceinline__ void p0_decode(int it, P0Item& I) {
    P0_JOB(INP(3), 3072, 1024, 0, 3072, nullptr, WS_W_IN, 0, 3072, 1, 0, 1, 1.0f, 0)
    P0_JOB(INP(5), 1024, 1024, 0, 1024, nullptr, WS_W_OUT, 0, 1024, 0, 0, 1, 1.0f, 0)
    P0_JOB(INP(14), 5632, 1024, 0, 5632, INP(2), WS_W_GU, 0, 5632, 2, 2816, 1, pg8::F8_SWGD, 1)
    P0_JOB(INP(15), 1024, 2816, 0, 1024, nullptr, WS_W_DN, 0, 1024, 0, 0, 1, pg8::F8_SWDD, 1)
    P0_JOB(INP(9), 1024, 1024, 0, 1024, INP(1) + 1024, WS_W_QKV, 0, 3072, 3, 0, 1, 1.0f, 0)
    P0_JOB(INP(7), 2048, 1024, 0, 1024, INP(6), WS_W_QKV, 1024, 3072, 3, 0, 1, 1.0f, 0)
    P0_JOB(INP(7), 2048, 1024, 1024, 1024, INP(6), WS_W_QKV, 2048, 3072, 0, 0, 1, 1.0f, 0)
    P0_JOB(INP(13), 1024, 1024, 0, 1024, nullptr, WS_W_O, 0, 1024, 0, 0, 1, 1.0f, 0)
    P0_JOB(INP(17), 7168, 1024, 0, 7168, INP(2) + 1024, WS_W_MGU, 0, 7168, 2, 3584, 8, pg8::F8_SWG, 1)
    P0_JOB(INP(18), 1024, 3584, 0, 1024, nullptr, WS_W_MDN, 0, 1024, 0, 0, 8, pg8::F8_SWD, 1)
}
#undef P0_JOB
struct P0Regs { f32x4 v[16]; float g[16]; };
__device__ __forceinline__ void p0_load(const P0Item& I, P0Regs& R, int lane) {
    const int lr = lane >> 4, lc = lane & 15;
#pragma unroll
    for (int i = 0; i < 16; ++i) R.v[i] = __builtin_nontemporal_load((const GAS f32x4*)(I.src + (size_t)(I.k0 + 4 * i + lr) * I.ldw + 4 * lc));
    if (I.gain) {
#pragma unroll
        for (int i = 0; i < 16; ++i) R.g[i] = I.gain[I.k0 + 4 * i + lr];
    } else {
#pragma unroll
        for (int i = 0; i < 16; ++i) R.g[i] = 1.0f;
    }
}
__device__ __forceinline__ void p0_store(const P0Item& I, const P0Regs& R, LAS float* scr, int lane) {
    const int lr = lane >> 4, lc = lane & 15;
#pragma unroll
    for (int i = 0; i < 16; ++i) { const f32x4 w = R.v[i] * (R.g[i] * I.sc); LAS float* p = scr + (4 * i + lr) * 65 + 4 * lc; p[0] = w[0]; p[1] = w[1]; p[2] = w[2]; p[3] = w[3]; }
    LDS_WAIT(); asm volatile("" ::: "memory");
    const int c = lane & 7;
#pragma unroll
    for (int jj = 0; jj < 8; ++jj) { const int nl = 8 * jj + (lane >> 3); const LAS float* s = scr + (8 * c) * 65 + nl;
        const int drow = (jj < 4 ? I.d0 : I.d1 - 32) + nl;
        if (I.f8) { v2u o; o.x = pg8::pk4_fp8(s[0], s[65], s[130], s[195]); o.y = pg8::pk4_fp8(s[260], s[325], s[390], s[455]);
            pg8::st8_wt(I.dst + (size_t)drow * I.K + I.k0 + 8 * c, o.x, o.y); }
        else { v4u o; o.x = pk2(s[0], s[65]); o.y = pk2(s[130], s[195]); o.z = pk2(s[260], s[325]); o.w = pk2(s[390], s[455]);
            pg8::st16_wt(I.dst + ((size_t)drow * I.K + I.k0 + 8 * c) * 2, o); } }
    LDS_WAIT(); asm volatile("" ::: "memory");
}
__device__ __forceinline__ void rms_row_bf16(const float* xrow, const float* g, bf16_t* orow, int lane) {
    const GAS f32x4* xr = (const GAS f32x4*)xrow + lane; const GAS f32x4* gr = (const GAS f32x4*)g + lane;
    f32x4 v[4]; float s = 0.f;
#pragma unroll
    for (int j = 0; j < 4; ++j) { v[j] = xr[64 * j]; s += (v[j][0] * v[j][0] + v[j][1] * v[j][1]) + (v[j][2] * v[j][2] + v[j][3] * v[j][3]); }
    const float rstd = __builtin_amdgcn_rsqf(wave_sum(s) * (1.f / D) + EPS);
    GAS v2u* o8 = (GAS v2u*)orow + lane;
#pragma unroll
    for (int j = 0; j < 4; ++j) { const f32x4 gg = gr[64 * j]; v2u o; o.x = pk2(v[j][0] * rstd * gg[0], v[j][1] * rstd * gg[1]); o.y = pk2(v[j][2] * rstd * gg[2], v[j][3] * rstd * gg[3]); o8[64 * j] = o; }
}
__device__ __forceinline__ void p0_prologue(Frame& F) {
    const int gw = F.vcu * NWAVES + F.wave, NGW = F.G * NWAVES;
    {
        const float* x = INP(0); const float* g = INP(1); bf16_t* XN = (bf16_t*)(A_WS + WS_XN0);
        const GAS f32x4* gr = (const GAS f32x4*)g + F.lane; f32x4 gg[4];
#pragma unroll
        for (int j = 0; j < 4; ++j) gg[j] = gr[64 * j];
        for (int mb = gw; mb < M; mb += 4 * NGW) { f32x4 v[4][4];
#pragma unroll
            for (int i = 0; i < 4; ++i) { const int m = mb + i * NGW; if (m < M) { const GAS f32x4* xr = (const GAS f32x4*)(x + (size_t)m * D) + F.lane;
#pragma unroll
                for (int j = 0; j < 4; ++j) v[i][j] = __builtin_nontemporal_load(xr + 64 * j); } }
#pragma unroll
            for (int i = 0; i < 4; ++i) { const int m = mb + i * NGW; if (m >= M) break; float s = 0.f;
#pragma unroll
                for (int j = 0; j < 4; ++j) s += (v[i][j][0] * v[i][j][0] + v[i][j][1] * v[i][j][1]) + (v[i][j][2] * v[i][j][2] + v[i][j][3] * v[i][j][3]);
                const float rstd = __builtin_amdgcn_rsqf(wave_sum(s) * (1.f / D) + EPS); GAS v2u* o8 = (GAS v2u*)(XN + (size_t)m * D) + F.lane;
#pragma unroll
                for (int j = 0; j < 4; ++j) { v2u o; o.x = pk2(v[i][j][0] * rstd * gg[j][0], v[i][j][1] * rstd * gg[j][1]); o.y = pk2(v[i][j][2] * rstd * gg[j][2], v[i][j][3] * rstd * gg[j][3]); o8[64 * j] = o; } } }
    }
    LAS float* scr = (LAS float*)(F.lds + RING_OFF + F.wave * P0_SCR);
    int it = gw; if (it >= P0_NITEMS) return;
    P0Item cur; P0Regs ra; p0_decode(it, cur); p0_load(cur, ra, F.lane);
    for (;;) { const int nit = it + NGW; const bool has = nit < P0_NITEMS; P0Item nx; P0Regs rb;
        if (has) { p0_decode(nit, nx); p0_load(nx, rb, F.lane); }
        p0_store(cur, ra, scr, F.lane);
        if (!has) break;
        cur = nx; ra = rb; it = nit; }
}

__device__ __forceinline__ void up8(const v4u w, float (&f)[8]) { f[0] = bflo(w.x); f[1] = bfhi(w.x); f[2] = bflo(w.y); f[3] = bfhi(w.y); f[4] = bflo(w.z); f[5] = bfhi(w.z); f[6] = bflo(w.w); f[7] = bfhi(w.w); }
__device__ __forceinline__ void p2_conv(Frame& F) {
    const bf16_t* Bb = (const bf16_t*)(A_WS + WS_BB); const bf16_t* Ub = (const bf16_t*)(A_WS + WS_UB); bf16_t* G = (bf16_t*)(A_WS + WS_G); const float* cw = INP(4);
    const int gw = F.vcu * NWAVES + F.wave, NGW = F.G * NWAVES;
    for (int strip = gw; strip < 2048; strip += NGW) {
        const int r0 = (strip >> 1) * 16, c0 = (strip & 1) * 512 + F.lane * 8;
        float w0[8], w1[8], w2[8], um2[8], um1[8];
#pragma unroll
        for (int j = 0; j < 8; ++j) { w0[j] = cw[c0 + j]; w1[j] = cw[D + c0 + j]; w2[j] = cw[2 * D + c0 + j]; um2[j] = 0.f; um1[j] = 0.f; }
        if ((r0 & (SEQ - 1)) != 0) { up8(*(const GAS v4u*)(Ub + (size_t)(r0 - 2) * D + c0), um2); up8(*(const GAS v4u*)(Ub + (size_t)(r0 - 1) * D + c0), um1); }
#pragma unroll
        for (int hb = 0; hb < 2; ++hb) { v4u ru[8], rb[8];
#pragma unroll
            for (int i = 0; i < 8; ++i) { ru[i] = *(const GAS v4u*)(Ub + (size_t)(r0 + 8 * hb + i) * D + c0); rb[i] = *(const GAS v4u*)(Bb + (size_t)(r0 + 8 * hb + i) * D + c0); }
#pragma unroll
            for (int ii = 0; ii < 8; ++ii) { const int i = 8 * hb + ii; float u[8], b[8]; up8(ru[ii], u); up8(rb[ii], b);
            float g[8];
#pragma unroll
            for (int j = 0; j < 8; ++j) { g[j] = b[j] * (w0[j] * um2[j] + w1[j] * um1[j] + w2[j] * u[j]); um2[j] = um1[j]; um1[j] = u[j]; }
            v4u o; o.x = pk2(g[0], g[1]); o.y = pk2(g[2], g[3]); o.z = pk2(g[4], g[5]); o.w = pk2(g[6], g[7]);
            pg8::st16_wt(G + (size_t)(r0 + i) * D + c0, o); } }
    }
}

__device__ __forceinline__ void p8_diff(Frame& F) {
    const bf16_t* O0 = (const bf16_t*)(A_WS + WS_O0); const bf16_t* O1 = (const bf16_t*)(A_WS + WS_O1); bf16_t* ON = (bf16_t*)(A_WS + WS_ON);
    const float* lp = INP(11); const float* sn = INP(12); const int lane = F.lane;
    const float lam = __expf(wave_sum(lp[lane] * lp[64 + lane])) - __expf(wave_sum(lp[128 + lane] * lp[192 + lane])) + LAM_INIT;
    float gn[16];
#pragma unroll
    for (int j = 0; j < 16; ++j) gn[j] = sn[16 * (lane & 7) + j] * (1.f - LAM_INIT);
    const int gw = F.vcu * NWAVES + F.wave, NGW = F.G * NWAVES;
    for (int rowb = gw; rowb < M; rowb += 4 * NGW) {
        v4u ra[4][2], rb[4][2];
#pragma unroll
        for (int i = 0; i < 4; ++i) { const int row = rowb + i * NGW; if (row < M) { const size_t off = (size_t)row * D + 16 * lane;
            ra[i][0] = *(const GAS v4u*)(O0 + off); ra[i][1] = *(const GAS v4u*)(O0 + off + 8); rb[i][0] = *(const GAS v4u*)(O1 + off); rb[i][1] = *(const GAS v4u*)(O1 + off + 8); } }
#pragma unroll
        for (int i = 0; i < 4; ++i) { const int row = rowb + i * NGW; if (row >= M) break; const size_t off = (size_t)row * D + 16 * lane;
            float a[16], a0[8], a1[8], b0[8], b1[8]; up8(ra[i][0], a0); up8(ra[i][1], a1); up8(rb[i][0], b0); up8(rb[i][1], b1);
            float s = 0.f;
#pragma unroll
            for (int j = 0; j < 8; ++j) { a[j] = a0[j] - lam * b0[j]; a[8 + j] = a1[j] - lam * b1[j]; s += a[j] * a[j] + a[8 + j] * a[8 + j]; }
            s += __shfl_xor(s, 1); s += __shfl_xor(s, 2); s += __shfl_xor(s, 4);
            const float rstd = __builtin_amdgcn_rsqf(s * (1.f / VD) + EPS);
            v4u o0, o1; o0.x = pk2(a[0] * rstd * gn[0], a[1] * rstd * gn[1]); o0.y = pk2(a[2] * rstd * gn[2], a[3] * rstd * gn[3]); o0.z = pk2(a[4] * rstd * gn[4], a[5] * rstd * gn[5]); o0.w = pk2(a[6] * rstd * gn[6], a[7] * rstd * gn[7]);
            o1.x = pk2(a[8] * rstd * gn[8], a[9] * rstd * gn[9]); o1.y = pk2(a[10] * rstd * gn[10], a[11] * rstd * gn[11]); o1.z = pk2(a[12] * rstd * gn[12], a[13] * rstd * gn[13]); o1.w = pk2(a[14] * rstd * gn[14], a[15] * rstd * gn[15]);
            pg8::st16_wt(ON + off, o0); pg8::st16_wt(ON + off + 8, o1); }
    }
}

#define TR_STEP(n, m) do { _Pragma("unroll") for (int i = 0; i < (n) / 2; ++i) { const bool up = (lane & (m)) != 0; const float keep = up ? v[i + (n) / 2] : v[i], send = up ? v[i] : v[i + (n) / 2]; v[i] = keep + __shfl_xor(send, (m)); } } while (0)
__device__ __forceinline__ void p10a_router(Frame& F) {
    const bf16_t* x3 = (const bf16_t*)(A_WS + WS_XB); const float* g = INP(2) + D; const float* Wr = INP(16); const float* ssq = (const float*)(A_WS + WS_SSQ);
    int* sel = (int*)(A_WS + WS_SEL); float* gate = (float*)(A_WS + WS_GATE); int* hist = (int*)(A_WS + WS_HIST);
    LAS f32x4* WL = (LAS f32x4*)(F.lds + RING_OFF);
    LAS int* lcnt = (LAS int*)(F.lds + RING_OFF + 32768);
    const int lane = F.lane;
    for (int k = F.tid; k < D; k += NWAVES * 64) { const float gk = g[k]; const f32x4 w0 = *(const GAS f32x4*)(Wr + (size_t)k * 8) * gk, w1 = *(const GAS f32x4*)(Wr + (size_t)k * 8 + 4) * gk;
        const int base = (((k >> 8) * 4 + (k & 3)) * 2) * 64 + ((k >> 2) & 63); WL[base] = w0; WL[base + 64] = w1; }
    LDS_WAIT(); __syncthreads();
    for (int blk = blockIdx.x; blk < M / 64; blk += F.G) {
        const int row0 = 64 * blk + 8 * F.wave;
        f32x4 xv[8][4];
#pragma unroll
        for (int r = 0; r < 8; ++r)
#pragma unroll
            for (int j = 0; j < 4; ++j) { const v2u w = *((const GAS v2u*)(x3 + (size_t)(row0 + r) * D) + lane + 64 * j); xv[r][j] = (f32x4){bflo(w.x), bfhi(w.x), bflo(w.y), bfhi(w.y)}; }
        float v[64];
#pragma unroll
        for (int i = 0; i < 64; ++i) v[i] = 0.f;
#pragma unroll
        for (int j = 0; j < 4; ++j)
#pragma unroll
            for (int q = 0; q < 4; ++q) { const f32x4 wa = WL[((j * 4 + q) * 2) * 64 + lane], wb = WL[((j * 4 + q) * 2 + 1) * 64 + lane];
#pragma unroll
                for (int r = 0; r < 8; ++r) { const float xx = xv[r][j][q];
                    v[r * 8 + 0] += xx * wa[0]; v[r * 8 + 1] += xx * wa[1]; v[r * 8 + 2] += xx * wa[2]; v[r * 8 + 3] += xx * wa[3];
                    v[r * 8 + 4] += xx * wb[0]; v[r * 8 + 5] += xx * wb[1]; v[r * 8 + 6] += xx * wb[2]; v[r * 8 + 7] += xx * wb[3]; } }
        TR_STEP(64, 32); TR_STEP(32, 16); TR_STEP(16, 8); TR_STEP(8, 4); TR_STEP(4, 2); TR_STEP(2, 1);
        float lg[8];
#pragma unroll
        for (int e = 0; e < 8; ++e) lg[e] = __shfl(v[0], (lane & ~7) | e);
        int i0 = 0; float v0 = lg[0];
#pragma unroll
        for (int e = 1; e < 8; ++e) if (lg[e] > v0) { v0 = lg[e]; i0 = e; }
        int i1 = 0; float v1 = -INFINITY;
#pragma unroll
        for (int e = 0; e < 8; ++e) if (e != i0 && lg[e] > v1) { v1 = lg[e]; i1 = e; }
        const int row = row0 + (lane >> 3); const float rs = pg8::rstd_of(ssq, row);
        const float g1 = 1.f / (1.f + expf((v0 - v1) * rs)); const bool wrt = (lane & 7) == 0;
        if (wrt) { sel[2 * row] = i0; sel[2 * row + 1] = i1; gate[2 * row] = 1.f - g1; gate[2 * row + 1] = g1; }
        int mycnt = 0;
#pragma unroll
        for (int e = 0; e < 8; ++e) { const int c = __popcll(__ballot(wrt && i0 == e)) + __popcll(__ballot(wrt && i1 == e)); if (lane == e) mycnt = c; }
        if (lane < 8) lcnt[F.wave * 8 + lane] = mycnt;
        LDS_WAIT(); __syncthreads();
        if (F.tid < 8) { int c = 0;
#pragma unroll
            for (int w = 0; w < 8; ++w) c += lcnt[w * 8 + F.tid];
            hist[blk * 8 + F.tid] = c; }
        LDS_WAIT(); __syncthreads();
    }
}
#undef TR_STEP
__device__ __forceinline__ void p10b_assign(Frame& F) {
    const int* hist = (const int*)(A_WS + WS_HIST); const int* sel = (const int*)(A_WS + WS_SEL); const float* gate = (const float*)(A_WS + WS_GATE); const float* ssq = (const float*)(A_WS + WS_SSQ);
    int* tok_slot = (int*)(A_WS + WS_TOKSLOT); float* gates = (float*)(A_WS + WS_GATES); int* meta = (int*)(A_WS + WS_META);
    const bf16_t* x3 = (const bf16_t*)(A_WS + WS_XB); unsigned char* XG = A_WS + WS_XG;
    LAS int* pre = (LAS int*)(F.lds + RING_OFF);
    LAS int* tot = pre + 2048;
    LAS int* ebase = tot + 8;
    LAS int* lslot = ebase + 8;
    const int lane = F.lane, e = F.wave;
    { int h[4], run = 0;
#pragma unroll
      for (int i = 0; i < 4; ++i) { h[i] = hist[(4 * lane + i) * 8 + e]; }
      const int mine = h[0] + h[1] + h[2] + h[3]; int inc = mine;
#pragma unroll
      for (int o = 1; o < 64; o <<= 1) { const int t = __shfl_up(inc, o); if (lane >= o) inc += t; }
      run = inc - mine;
#pragma unroll
      for (int i = 0; i < 4; ++i) { pre[(4 * lane + i) * 8 + e] = run; run += h[i]; }
      if (lane == 63) tot[e] = inc; }
    LDS_WAIT(); __syncthreads();
    if (F.tid == 0) { int b = 0; for (int k = 0; k < 8; ++k) { ebase[k] = b; if (blockIdx.x == 0) meta[k] = b >> 8; b += (tot[k] + 255) & ~255; } if (blockIdx.x == 0) { const int T = b >> 8, full = 2 * F.G / 4; meta[8] = T; meta[9] = T < full ? T : full; } }
    LDS_WAIT(); __syncthreads();
    for (int blk = blockIdx.x; blk < M / 64; blk += F.G) {
        if (F.wave == 0) { const int t = 64 * blk + lane; const int s0 = sel[2 * t], s1 = sel[2 * t + 1]; int sl0 = 0, sl1 = 0;
            const unsigned long long below = (1ull << lane) - 1ull;
#pragma unroll
            for (int k = 0; k < 8; ++k) { const unsigned long long m0 = __ballot(s0 == k), m1 = __ballot(s1 == k); const int b0 = ebase[k] + pre[blk * 8 + k];
                if (s0 == k) sl0 = b0 + __popcll(m0 & below); if (s1 == k) sl1 = b0 + __popcll(m0) + __popcll(m1 & below); }
            tok_slot[2 * t] = sl0; tok_slot[2 * t + 1] = sl1; lslot[2 * lane] = sl0; lslot[2 * lane + 1] = sl1;
            gates[sl0] = gate[2 * t]; gates[sl1] = gate[2 * t + 1]; }
        LDS_WAIT(); __syncthreads();
        v4u xw[8][2];
#pragma unroll
        for (int i = 0; i < 8; ++i) { const GAS v4u* xr = (const GAS v4u*)(x3 + (size_t)(64 * blk + 8 * F.wave + i) * D + 16 * lane); xw[i][0] = xr[0]; xw[i][1] = xr[1]; }
#pragma unroll
        for (int i = 0; i < 8; ++i) { const int tl = 8 * F.wave + i; const int t = 64 * blk + tl;
            const float rs = pg8::rstd_of(ssq, t) * pg8::F8_SA; float a[8], b[8]; up8(xw[i][0], a); up8(xw[i][1], b);
            v4u o; o.x = pg8::pk4_fp8(a[0] * rs, a[1] * rs, a[2] * rs, a[3] * rs); o.y = pg8::pk4_fp8(a[4] * rs, a[5] * rs, a[6] * rs, a[7] * rs); o.z = pg8::pk4_fp8(b[0] * rs, b[1] * rs, b[2] * rs, b[3] * rs); o.w = pg8::pk4_fp8(b[4] * rs, b[5] * rs, b[6] * rs, b[7] * rs);
            const int sl0 = lslot[2 * tl], sl1 = lslot[2 * tl + 1];
            pg8::st16_wt(XG + (size_t)sl0 * D + 16 * lane, o); pg8::st16_wt(XG + (size_t)sl1 * D + 16 * lane, o); }
        LDS_WAIT(); __syncthreads();
    }
}
__device__ __forceinline__ void p13_load_y(const bf16_t* Y, const bf16_t* Pp, const float* gates, int nfull, int slot, int lane, v2u (&y)[4]) {
    const int rt = (slot >> 8) - nfull;
    if (rt < 0) { const GAS v2u* yr = (const GAS v2u*)(Y + (size_t)slot * D) + lane;
#pragma unroll
        for (int j = 0; j < 4; ++j) y[j] = yr[64 * j];
    } else { const float gt = gates[slot];
#pragma unroll
        for (int j = 0; j < 4; ++j) { f32x4 s = (f32x4){0.f, 0.f, 0.f, 0.f};
#pragma unroll
            for (int kp = 0; kp < pg8::MoeOrder::SPL; ++kp) { const v2u w = *((const GAS v2u*)(Pp + ((size_t)(rt * pg8::MoeOrder::SPL + kp) * 256 + (slot & 255)) * D) + lane + 64 * j);
                s += (f32x4){bflo(w.x), bfhi(w.x), bflo(w.y), bfhi(w.y)}; }
            y[j].x = pk2(s[0] * gt, s[1] * gt); y[j].y = pk2(s[2] * gt, s[3] * gt); } }
}
__device__ __forceinline__ void p13_final(Frame& F) {
    const int* tok_slot = (const int*)(A_WS + WS_TOKSLOT); const bf16_t* Y = (const bf16_t*)(A_WS + WS_Y); const bf16_t* X3 = (const bf16_t*)(A_WS + WS_XB); float* out = A_OUT;
    const bf16_t* Pp = (const bf16_t*)(A_WS + WS_PP); const float* gates = (const float*)(A_WS + WS_GATES); const int nfull = ((const int*)(A_WS + WS_META))[9];
    const int gw = F.vcu * NWAVES + F.wave, NGW = F.G * NWAVES, lane = F.lane;
    for (int rowb = gw; rowb < M; rowb += 2 * NGW) {
        v2u xa[2][4], ya[2][4], yb[2][4];
#pragma unroll
        for (int i = 0; i < 2; ++i) { const int row = rowb + i * NGW; if (row < M) { const int s0 = tok_slot[2 * row], s1 = tok_slot[2 * row + 1];
            const GAS v2u* xr = (const GAS v2u*)(X3 + (size_t)row * D) + lane;
#pragma unroll
            for (int j = 0; j < 4; ++j) xa[i][j] = xr[64 * j];
            p13_load_y(Y, Pp, gates, nfull, s0, lane, ya[i]); p13_load_y(Y, Pp, gates, nfull, s1, lane, yb[i]); } }
#pragma unroll
        for (int i = 0; i < 2; ++i) { const int row = rowb + i * NGW; if (row >= M) break; GAS f32x4* orow = (GAS f32x4*)(out + (size_t)row * D) + lane;
#pragma unroll
            for (int j = 0; j < 4; ++j) { const v2u x = xa[i][j], a = ya[i][j], b = yb[i][j];
                orow[64 * j] = (f32x4){bflo(x.x) + (bflo(a.x) + bflo(b.x)), bfhi(x.x) + (bfhi(a.x) + bfhi(b.x)), bflo(x.y) + (bflo(a.y) + bflo(b.y)), bfhi(x.y) + (bfhi(a.y) + bfhi(b.y))}; } }
    }
}

__global__ void __launch_bounds__(NWAVES * 64, 2) mega_fwd(Args args) {
    extern __shared__ __attribute__((aligned(16))) unsigned char lds[];
    Frame F;
    F.lds = (LAS unsigned char*)lds; F.tid = threadIdx.x; F.lane = F.tid & 63; F.wave = __builtin_amdgcn_readfirstlane(F.tid >> 6);
    F.G = gridDim.x; { const int bx = blockIdx.x; F.vcu = (F.G % 8 == 0) ? (bx % 8) * (F.G / 8) + bx / 8 : bx; }
    for (int u = F.tid; u < RING_OFF / 4; u += NWAVES * 64) ((LAS unsigned*)(F.lds + MISC_OFF))[u] = 0u;
    __syncthreads();
    if (KA->ph_hi - KA->ph_lo > 1) (void)xcd_barrier_post((unsigned*)(A_WS + WS_CTL) + CW_BAR + KA->li * XCD_BAR_WORDS, (volatile LAS unsigned*)(F.lds + MISC_OFF + 32));
#define IN(k) (KA->ph_lo <= (k) && (k) < KA->ph_hi)
#define SEAM(k) do { if (IN(k) && IN((k) + 1)) SEAM_NOW(); } while (0)
#define SEAM_NOW() do { { XcdBarrier b_; b_.bar = (unsigned*)(A_WS + WS_CTL) + CW_BAR + KA->li * XCD_BAR_WORDS; b_.x = xb_xcc_id(); b_.st = (volatile LAS unsigned*)(F.lds + MISC_OFF + 32); xcd_barrier(b_); } } while (0)
#define ws A_WS
#define XB ((bf16_t*)(A_WS + WS_XB))
#define SSQ ((float*)(A_WS + WS_SSQ))

    if (IN(0)) { p0_prologue(F); } SEAM(0);
    if (IN(1)) { pg8::Gemm g{(const bf16_t*)(ws + WS_XN0), (const bf16_t*)(ws + WS_W_IN), M, 3072, 1024}; pg8::StaticOrder S; S.init(M, 3072, F.G, (int)blockIdx.x);
        pg8::EpiInProj E{(bf16_t*)(ws + WS_BB), (bf16_t*)(ws + WS_UB)};
        pg8::gemm_phase<pg8::EpiInProj, pg8::StaticOrder, true, true>(F.lds + RING_OFF, g, S, E); } SEAM(1);
    if (IN(2)) { p2_conv(F); } SEAM(2);
    if (IN(3)) { pg8::Gemm g{(const bf16_t*)(ws + WS_G), (const bf16_t*)(ws + WS_W_OUT), M, 1024, 1024}; pg8::StaticOrder S; S.init(M, 1024, F.G, (int)blockIdx.x);
        pg8::EpiResidSsq<true> E{INP(0), XB, SSQ, 1.0f, ws + WS_X8};
        pg8::gemm_phase<pg8::EpiResidSsq<true>, pg8::StaticOrder, false, true>(F.lds + RING_OFF, g, S, E); } SEAM(3);
    if (IN(4)) { pg8::Gemm g{(const bf16_t*)(ws + WS_X8), (const bf16_t*)(ws + WS_W_GU), M, 5632, 512}; pg8::StaticOrder S; S.init(M, 5632, F.G, (int)blockIdx.x);
        pg8::EpiSwiGLU<true> E{ws + WS_HACT, DFF, SSQ, nullptr, 22, 1.0f / (pg8::F8_SX * pg8::F8_SWGD)};
        pg8::gemm_phase<pg8::EpiSwiGLU<true>, pg8::StaticOrder, true, true, true>(F.lds + RING_OFF, g, S, E); } SEAM(4);
    if (IN(5)) { pg8::Gemm g{(const bf16_t*)(ws + WS_HACT), (const bf16_t*)(ws + WS_W_DN), M, 1024, DFF / 2}; pg8::StaticOrder S; S.init(M, 1024, F.G, (int)blockIdx.x);
        pg8::EpiResidSsq<false> E{nullptr, XB, SSQ, 1.0f / (pg8::F8_SHD * pg8::F8_SWDD), nullptr};
        pg8::gemm_phase<pg8::EpiResidSsq<false>, pg8::StaticOrder, false, true, true>(F.lds + RING_OFF, g, S, E); } SEAM(5);
    if (IN(6)) { pg8::Gemm g{XB, (const bf16_t*)(ws + WS_W_QKV), M, 3072, 1024}; pg8::StaticOrder S; S.init(M, 3072, F.G, (int)blockIdx.x);
        pg8::EpiQKV E{(bf16_t*)(ws + WS_Q), (bf16_t*)(ws + WS_K), (bf16_t*)(ws + WS_V), SSQ, INP(10), INP(8), attn_body::C2};
        pg8::gemm_phase<pg8::EpiQKV, pg8::StaticOrder, true, true>(F.lds + RING_OFF, g, S, E); } SEAM(6);
    if (IN(7)) {
        const float* lp = INP(11); const float* sn = INP(12);
        const float lam = __expf(wave_sum(lp[F.lane] * lp[64 + F.lane])) - __expf(wave_sum(lp[128 + F.lane] * lp[192 + F.lane])) + LAM_INIT;
        LAS float* sng = (LAS float*)(F.lds + MISC_OFF + 256);
        if (F.tid < VD) sng[F.tid] = sn[F.tid] * (1.f - LAM_INIT);
        LDS_WAIT(); __syncthreads();
        for (int it = F.vcu; it < BATCH * 32; it += F.G) { const int b = it >> 5, h = (it >> 2) & 7, p = it & 3;
            attn_body::bf16* O0 = (attn_body::bf16*)(ws + WS_O0); attn_body::bf16* ONp = (attn_body::bf16*)(ws + WS_ON);
            for (int i = 0; i < 2; ++i) { const int qb = i ? 7 - p : p;
                attn_body::attn_unit<-1, 0>(b, (2 * h) * 64, h * 128, qb, (const attn_body::bf16*)(ws + WS_Q), (const attn_body::bf16*)(ws + WS_K), (const attn_body::bf16*)(ws + WS_V), O0, (char*)lds + RING_OFF, nullptr, 0.f, nullptr);
                attn_body::attn_unit<-1, 1>(b, (2 * h + 1) * 64, h * 128, qb, (const attn_body::bf16*)(ws + WS_Q), (const attn_body::bf16*)(ws + WS_K), (const attn_body::bf16*)(ws + WS_V), O0, (char*)lds + RING_OFF, ONp, lam, (const float*)((char*)lds + MISC_OFF + 256)); } }
    } if (IN(7) && IN(9)) SEAM_NOW();
    if (IN(9)) { pg8::Gemm g{(const bf16_t*)(ws + WS_ON), (const bf16_t*)(ws + WS_W_O), M, 1024, 1024}; pg8::StaticOrder S; S.init(M, 1024, F.G, (int)blockIdx.x);
        pg8::EpiResidSsq<false> E{nullptr, XB, SSQ, 1.0f, nullptr};
        pg8::gemm_phase<pg8::EpiResidSsq<false>, pg8::StaticOrder, false, true>(F.lds + RING_OFF, g, S, E); } SEAM(9);
    if (IN(10)) { p10a_router(F); } SEAM(10);
    if (IN(11)) { p10b_assign(F); } SEAM(11);
    if (IN(12)) { pg8::Gemm g{(const bf16_t*)(ws + WS_XG), (const bf16_t*)(ws + WS_W_MGU), SLOTS, 8 * 7168, 512}; pg8::MoeOrder S; S.init((const int*)(ws + WS_META), 28, F.G, (int)blockIdx.x, false);
        pg8::EpiSwiGLU8 E{ws + WS_HM, DFE, 28};
        pg8::gemm_phase<pg8::EpiSwiGLU8, pg8::MoeOrder, true, true, true>(F.lds + RING_OFF, g, S, E); } SEAM(12);
    if (IN(13)) { pg8::Gemm g{(const bf16_t*)(ws + WS_HM), (const bf16_t*)(ws + WS_W_MDN), SLOTS, 8 * 1024, DFE / 2}; pg8::MoeOrder S; S.init((const int*)(ws + WS_META), 4, F.G, (int)blockIdx.x, true);
        pg8::EpiMoeDown E{(bf16_t*)(ws + WS_Y), (const float*)(ws + WS_GATES), 1.0f / (pg8::F8_SH * pg8::F8_SWD), (bf16_t*)(ws + WS_PP)};
        pg8::gemm_phase<pg8::EpiMoeDown, pg8::MoeOrder, true, true, true>(F.lds + RING_OFF, g, S, E); } SEAM(13);
    if (IN(14)) { p13_final(F); }
#undef IN
#undef SEAM
#undef SEAM_NOW
#undef ws
#undef XB
#undef SSQ
}
#ifndef MEGA_UPTO
#define MEGA_UPTO 15
#endif
#ifndef MEGA_REPMASK
#define MEGA_REPMASK 0
#endif
#ifndef MEGA_ONE
#define MEGA_ONE 1
#endif
extern "C" void kernel_launch(void* const* d_in, const int* in_sizes, int n_in, void* d_out, int out_size, void* d_ws, size_t ws_size, hipStream_t stream) {
    static int grid = 0;
    if (grid == 0) {
        if (n_in != 19 || in_sizes[0] != M * D || out_size != M * D || ws_size < WS_END) { fprintf(stderr, "kernel_launch: unexpected shapes / workspace (%d inputs, ws %zu, need %zu)\n", n_in, ws_size, (size_t)WS_END); grid = -1; return; }
        int dev = 0, cus = 0, per_cu = 0;
        if (hipGetDevice(&dev) != hipSuccess || hipDeviceGetAttribute(&cus, hipDeviceAttributeMultiprocessorCount, dev) != hipSuccess) { grid = -1; return; }
        if (hipFuncSetAttribute((const void*)mega_fwd, hipFuncAttributeMaxDynamicSharedMemorySize, LDS_BYTES) != hipSuccess) { fprintf(stderr, "kernel_launch: hipFuncSetAttribute failed\n"); grid = -1; return; }
        if (hipOccupancyMaxActiveBlocksPerMultiprocessor(&per_cu, (const void*)mega_fwd, NWAVES * 64, LDS_BYTES) != hipSuccess || per_cu < 1) fprintf(stderr, "kernel_launch: note: occupancy query says %d\n", per_cu);
        (void)hipGetLastError();
        grid = cus < 256 ? cus : 256;
        if (grid != 256) fprintf(stderr, "kernel_launch: %d CUs; this kernel is built for 256\n", cus);
    }
    if (grid < 0) return;
    unsigned char* ws = (unsigned char*)d_ws; float* out = (float*)d_out;
    constexpr int UPTO = MEGA_UPTO;
    static_assert(UPTO == 15, "the plain reference kernels of the transition builds are gone: all 15 phases run in the persistent kernel");
    if (UPTO > 0) {
        if (hipMemsetAsync(ws + WS_CTL, 0, CTL_ZERO_BYTES, stream) != hipSuccess) { fprintf(stderr, "kernel_launch: memset failed\n"); return; }
        Args a{};
        for (int i = 0; i < 19; ++i) a.in[i] = (const float*)d_in[i];
        a.out = out; a.wsp = ws;
        a.jobmask = UPTO >= 15 ? 255 : UPTO >= 10 ? 63 : UPTO >= 7 ? 31 : UPTO >= 6 ? 15 : 3;
        if (MEGA_ONE) { a.ph_lo = 0; a.ph_hi = UPTO; a.li = 0; hipLaunchKernelGGL(mega_fwd, dim3(grid), dim3(NWAVES * 64), LDS_BYTES, stream, a); }
        else for (int p = 0; p < UPTO; ++p) { a.ph_lo = p; a.ph_hi = p + 1; a.li = 0; for (int r = 0; r <= ((MEGA_REPMASK >> p) & 1); ++r) hipLaunchKernelGGL(mega_fwd, dim3(grid), dim3(NWAVES * 64), LDS_BYTES, stream, a); }
        const hipError_t le = hipPeekAtLastError();
        if (le != hipSuccess) fprintf(stderr, "kernel_launch: launch failed: %s\n", hipGetErrorName(le));
    }
}
```

```cpp
#include <hip/hip_runtime.h>
#include <hip/hip_bf16.h>
#include <stdint.h>
#include <stdio.h>
#include <cmath>
#define MEGA_UPTO 15
#define MEGA_ONE 1
typedef unsigned short bf16_t;
typedef short bf16x8 __attribute__((ext_vector_type(8)));
typedef float f32x4 __attribute__((ext_vector_type(4)));
constexpr int D = 1024, BATCH = 8, SEQ = 2048, M = BATCH * SEQ;
constexpr int NH = 8, HD = 64, VD = 128;
constexpr int DFF = 2816, NE = 8, DFE = 3584;
constexpr float EPS = 1e-6f;
constexpr float LAM_INIT = 0.35550907f;
constexpr int SLOTS = 2 * M + NE * 256;

__device__ __forceinline__ unsigned f2bf(float f) { unsigned u = __builtin_bit_cast(unsigned, f); return (u + 0x7fffu + ((u >> 16) & 1u)) >> 16; }
__device__ __forceinline__ float bf2f(unsigned short b) { return __builtin_bit_cast(float, (unsigned)b << 16); }
__device__ __forceinline__ float wave_sum(float v) {
#pragma unroll
    for (int o = 1; o < 64; o <<= 1) v += __shfl_xor(v, o);
    return v;
}

namespace pg8 {
#define PG8_LAS __attribute__((address_space(3)))
typedef unsigned short bf16_t;
typedef short bf16x8 __attribute__((ext_vector_type(8)));
typedef float f32x4 __attribute__((ext_vector_type(4)));
typedef unsigned u32x4 __attribute__((ext_vector_type(4)));
typedef int i32x4 __attribute__((ext_vector_type(4)));
typedef int i32x8 __attribute__((ext_vector_type(8)));
constexpr int BM = 256, BK = 64, HALF = 128, HTB = HALF * BK * 2  , STAGE_BYTES = 8 * HTB, NXCD = 8, WGM = 8;

__host__ __device__ __forceinline__ int lds_byte(int r, int c) { const int st = (r >> 4) * 2 + (c >> 5), rr = r & 15, cc = c & 31, ob = rr * 64 + cc * 2; return st * 1024 + (ob ^ (((ob >> 9) & 1) << 5)); }
__host__ __device__ __forceinline__ void stage_rc(int b, int& R, int& C) { const int st = b / 1024, sb = b % 1024, swz = sb ^ (((sb >> 9) & 1) << 5); R = (st >> 1) * 16 + swz / 64; C = (st & 1) * 32 + (swz % 64) / 2; }
__host__ __device__ __forceinline__ int perm32(int rho) { const int n = rho >> 4, i = rho & 15; return 8 * (i >> 2) + 4 * n + (i & 3); }

struct Unit { int pm, pn; int kt0, nkt, aux; };
struct Gemm { const bf16_t* A; const bf16_t* Bt; int M, N, K; };

struct StaticOrder {
    int nM, nN, nwg, G, c;
    __host__ __device__ void init(int M, int N, int G_, int c_) { nM = M / BM; nN = N / BM; nwg = nM * nN; G = G_; c = c_; }
    __host__ __device__ bool next(int i, Unit& u) const {
        const long L = (long)i * G + c; if (L >= nwg) return false;
        int wgid = (int)L; { const int q = nwg / NXCD, r = nwg % NXCD, xcd = wgid % NXCD, off = wgid / NXCD; wgid = (xcd < r ? xcd * (q + 1) : r * (q + 1) + (xcd - r) * q) + off; }
        const int nig = WGM * nN, gid = wgid / nig, fm = gid * WGM, gsz = (nM - fm) < WGM ? (nM - fm) : WGM;
        u.pm = fm + ((wgid % nig) % gsz); u.pn = (wgid % nig) / gsz; u.kt0 = 0; u.nkt = 0; u.aux = -1; return true;
    }
    __device__ __forceinline__ void a_ready(const Unit&) const {}
    __device__ __forceinline__ void done(const Unit&) const {}
};

__device__ __forceinline__ unsigned cvt_pk_bf16(float lo, float hi) { unsigned r; asm volatile("v_cvt_pk_bf16_f32 %0, %1, %2" : "=v"(r) : "v"(lo), "v"(hi)); return r; }
typedef float f32x2 __attribute__((ext_vector_type(2)));
#ifndef PG8_WT
#define PG8_WT 0
#endif
__device__ __forceinline__ void st16_wt(void* p, u32x4 v) {
#if PG8_WT
    asm volatile("global_store_dwordx4 %0, %1, off sc1\n\ts_nop 1" :: "v"(p), "v"(v) : "memory");
#else
    *(u32x4*)p = v;
#endif
}
__device__ __forceinline__ void st8_wt(void* p, unsigned x, unsigned y) {
#if PG8_WT
    typedef unsigned u32x2_ __attribute__((ext_vector_type(2))); const u32x2_ v = {x, y};
    asm volatile("global_store_dwordx2 %0, %1, off sc1\n\ts_nop 1" :: "v"(p), "v"(v) : "memory");
#else
    typedef unsigned u32x2_ __attribute__((ext_vector_type(2))); *(u32x2_*)p = (u32x2_){x, y};
#endif
}
typedef unsigned u32x2 __attribute__((ext_vector_type(2)));
constexpr float RMS_EPS = 1e-6f, LOG2E = 1.4426950408889634f;
constexpr int DM_ = 1024;
__device__ __forceinline__ u32x4 pack8(const f32x4 a, const f32x4 b) { u32x4 w; w.x = cvt_pk_bf16(a[0], a[1]); w.y = cvt_pk_bf16(a[2], a[3]); w.z = cvt_pk_bf16(b[0], b[1]); w.w = cvt_pk_bf16(b[2], b[3]); return w; }
__device__ __forceinline__ float rstd_of(const float* ssq, int row) { const f32x4 p = *(const f32x4*)(ssq + (size_t)row * 4); return __builtin_amdgcn_rsqf(((p[0] + p[1]) + (p[2] + p[3])) * (1.0f / 1024.0f) + RMS_EPS); }
__device__ __forceinline__ float silu_mul(float g, float u) { return g * u * __builtin_amdgcn_rcpf(1.0f + __builtin_amdgcn_exp2f(-g * LOG2E)); }
__device__ __forceinline__ f32x2 swiglu2(f32x2 a, f32x2 b, float c1, float k) {
    const f32x2 t = a * c1; f32x2 e; e.x = __builtin_amdgcn_exp2f(t.x); e.y = __builtin_amdgcn_exp2f(t.y);
    const f32x2 d = e * k + k; f32x2 r; r.x = __builtin_amdgcn_rcpf(d.x); r.y = __builtin_amdgcn_rcpf(d.y);
    return (a * b) * r;
}

__device__ __forceinline__ float clamp448(float x) { return __builtin_amdgcn_fmed3f(x, -448.0f, 448.0f); }
__device__ __forceinline__ unsigned pk4_fp8(float a, float b, float c, float d) { int w = 0; w = __builtin_amdgcn_cvt_pk_fp8_f32(clamp448(a), clamp448(b), w, false); w = __builtin_amdgcn_cvt_pk_fp8_f32(clamp448(c), clamp448(d), w, true); return (unsigned)w; }
constexpr float F8_SA = 4.0f, F8_SWG = 256.0f, F8_SH = 8.0f, F8_SWD = 512.0f;
constexpr float F8_SY = 64.0f;
constexpr float F8_SHD = 8.0f, F8_SWDD = 256.0f, F8_SX = 4.0f, F8_SWGD = 256.0f;

struct EpiInProj {
    static constexpr bool PERM = true, AFTER_DRAIN = false;
    bf16_t* Bb; bf16_t* Ub; const float* ssq;
    __device__ __forceinline__ void operator()(const f32x4 (&acc)[2][2][4][2], const Unit& u, int wr, int wc, int fr, int fq) const {
        const int row0 = u.pm * BM + wr * 64 + fr;
        float rsv[2][4];
#pragma unroll
        for (int ai = 0; ai < 2; ++ai)
#pragma unroll
            for (int m = 0; m < 4; ++m) rsv[ai][m] = rstd_of(ssq, row0 + ai * HALF + m * 16);
        if (u.pn < 4) {
            const int col0 = u.pn * BM + wc * 32 + 8 * fq;
#pragma unroll
            for (int ai = 0; ai < 2; ++ai)
#pragma unroll
                for (int m = 0; m < 4; ++m) { bf16_t* rowp = Bb + (size_t)(row0 + ai * HALF + m * 16) * DM_ + col0;
#pragma unroll
                    for (int bj = 0; bj < 2; ++bj) st16_wt(rowp + bj * HALF, pack8(acc[ai][bj][m][0] * rsv[ai][m], acc[ai][bj][m][1] * rsv[ai][m])); }
        } else {
            const int col0 = (u.pn - 4) * 128 + wc * 32 + 8 * fq;
#pragma unroll
            for (int ai = 0; ai < 2; ++ai)
#pragma unroll
                for (int m = 0; m < 4; ++m) { bf16_t* rowp = Ub + (size_t)(row0 + ai * HALF + m * 16) * DM_ + col0;
                    const float r2 = rsv[ai][m] * rsv[ai][m]; st16_wt(rowp, pack8(acc[ai][0][m][0] * acc[ai][1][m][0] * r2, acc[ai][0][m][1] * acc[ai][1][m][1] * r2)); }
        }
    }
};

template <bool FIRST> struct EpiResidSsq {
    static constexpr bool PERM = true, AFTER_DRAIN = true;
    const float* x0; bf16_t* xb; float* ssq; float ascale; unsigned char* x8;
    __device__ __forceinline__ void fused(f32x4 (&acc)[2][2][4][2], const Unit& u, int wr, int wc, int fr, int fq, PG8_LAS unsigned char* lds, int wid, int lane) const {
        PG8_LAS float* P = (PG8_LAS float*)lds;
        const int col0 = u.pn * BM + wc * 32 + 8 * fq;
#pragma unroll
        for (int ai = 0; ai < 2; ++ai) {
            f32x4 xo[4][2][2];
#pragma unroll
            for (int m = 0; m < 4; ++m) { const int r = ai * HALF + wr * 64 + m * 16 + fr; const size_t off = (size_t)(u.pm * BM + r) * DM_ + col0;
#pragma unroll
                for (int bj = 0; bj < 2; ++bj) {
                    { const u32x4 w = *(const u32x4*)(xb + off + bj * HALF);
                        xo[m][bj][0] = (f32x4){__builtin_bit_cast(float, w.x << 16), __builtin_bit_cast(float, w.x & 0xffff0000u), __builtin_bit_cast(float, w.y << 16), __builtin_bit_cast(float, w.y & 0xffff0000u)};
                        xo[m][bj][1] = (f32x4){__builtin_bit_cast(float, w.z << 16), __builtin_bit_cast(float, w.z & 0xffff0000u), __builtin_bit_cast(float, w.w << 16), __builtin_bit_cast(float, w.w & 0xffff0000u)}; } } }
#pragma unroll
            for (int m = 0; m < 4; ++m) { const int r = ai * HALF + wr * 64 + m * 16 + fr; const size_t off = (size_t)(u.pm * BM + r) * DM_ + col0; float s = 0.f;
#pragma unroll
                for (int bj = 0; bj < 2; ++bj) { const f32x4 v0 = xo[m][bj][0] + acc[ai][bj][m][0] * ascale, v1 = xo[m][bj][1] + acc[ai][bj][m][1] * ascale;
                    st16_wt(xb + off + bj * HALF, pack8(v0, v1));
                    if constexpr (FIRST) { u32x2 w; w.x = pk4_fp8(v0[0] * F8_SX, v0[1] * F8_SX, v0[2] * F8_SX, v0[3] * F8_SX); w.y = pk4_fp8(v1[0] * F8_SX, v1[1] * F8_SX, v1[2] * F8_SX, v1[3] * F8_SX); st8_wt(x8 + off + bj * HALF, w.x, w.y); }
                    s += ((v0[0] * v0[0] + v0[1] * v0[1]) + (v0[2] * v0[2] + v0[3] * v0[3])) + ((v1[0] * v1[0] + v1[1] * v1[1]) + (v1[2] * v1[2] + v1[3] * v1[3])); }
                s += __shfl_xor(s, 16); s += __shfl_xor(s, 32);
                if (fq == 0) P[r * 4 + wc] = s; }
            asm volatile("" ::: "memory"); }
        asm volatile("s_waitcnt lgkmcnt(0)" ::: "memory"); __builtin_amdgcn_s_barrier(); asm volatile("" ::: "memory");
        const int t = wid * 64 + lane;
        if (t < 256) { const PG8_LAS f32x4* Pr = (const PG8_LAS f32x4*)lds; const f32x4 p = Pr[t]; ssq[(size_t)(u.pm * BM + t) * 4 + u.pn] = (p[0] + p[1]) + (p[2] + p[3]); }
        asm volatile("s_waitcnt lgkmcnt(0)" ::: "memory"); __builtin_amdgcn_s_barrier(); asm volatile("" ::: "memory");
    }
};

template <bool OUT8> struct EpiSwiGLU {
    static constexpr bool PERM = true, AFTER_DRAIN = false;
    void* H; int ldh; const float* ssq; const float* rstd; int ncol; float cs;
    __device__ __forceinline__ void operator()(const f32x4 (&acc)[2][2][4][2], const Unit& u, int wr, int wc, int fr, int fq) const {
        const int row0 = u.pm * BM + wr * 64 + fr, col0 = (u.pn % ncol) * 128 + wc * 32 + 8 * fq;
        float kk[2][4];
#pragma unroll
        for (int ai = 0; ai < 2; ++ai)
#pragma unroll
            for (int m = 0; m < 4; ++m) { const int row = row0 + ai * HALF + m * 16;
                if (ssq) { const f32x4 p = *(const f32x4*)(ssq + (size_t)row * 4); kk[ai][m] = ((p[0] + p[1]) + (p[2] + p[3])) * (1.0f / 1024.0f) + RMS_EPS; } else { const float r_ = rstd[row]; kk[ai][m] = 1.0f / (r_ * r_); } }
#pragma unroll
        for (int ai = 0; ai < 2; ++ai)
#pragma unroll
            for (int m = 0; m < 4; ++m) { const int row = row0 + ai * HALF + m * 16;
                float k = kk[ai][m];
                const float c1 = -LOG2E * cs * __builtin_amdgcn_rsqf(k); k = k / (cs * cs);
                f32x4 h[2];
#pragma unroll
                for (int n = 0; n < 2; ++n) { const f32x4 a = acc[ai][0][m][n], b = acc[ai][1][m][n];
                    const f32x2 h0 = swiglu2((f32x2){a[0], a[1]}, (f32x2){b[0], b[1]}, c1, k), h1 = swiglu2((f32x2){a[2], a[3]}, (f32x2){b[2], b[3]}, c1, k);
                    h[n] = (f32x4){h0.x, h0.y, h1.x, h1.y}; }
                if constexpr (OUT8) { u32x2 w; w.x = pk4_fp8(h[0][0] * F8_SHD, h[0][1] * F8_SHD, h[0][2] * F8_SHD, h[0][3] * F8_SHD); w.y = pk4_fp8(h[1][0] * F8_SHD, h[1][1] * F8_SHD, h[1][2] * F8_SHD, h[1][3] * F8_SHD);
                    st8_wt((unsigned char*)H + (size_t)row * ldh + col0, w.x, w.y); }
                else st16_wt((bf16_t*)H + (size_t)row * ldh + col0, pack8(h[0], h[1])); }
    }
};

struct EpiQKV {
    static constexpr bool PERM = true, AFTER_DRAIN = false;
    bf16_t *Q, *K, *V; const float* ssq; const float* qg; const float* kg; float qscale;
    __device__ __forceinline__ void operator()(const f32x4 (&acc)[2][2][4][2], const Unit& u, int wr, int wc, int fr, int fq) const {
        const int row0 = u.pm * BM + wr * 64 + fr;
        float rsv[2][4];
#pragma unroll
        for (int ai = 0; ai < 2; ++ai)
#pragma unroll
            for (int m = 0; m < 4; ++m) rsv[ai][m] = rstd_of(ssq, row0 + ai * HALF + m * 16);
        if (u.pn < 8) {
            const bool isq = u.pn < 4; bf16_t* base = isq ? Q : K; const float* gn = isq ? qg : kg; const float sc = isq ? qscale : 1.0f;
            const int col0 = (4 * (u.pn & 3) + wc) * 64 + 8 * fq;
            f32x4 gv[2][2];
#pragma unroll
            for (int bj = 0; bj < 2; ++bj)
#pragma unroll
                for (int n = 0; n < 2; ++n) gv[bj][n] = *(const f32x4*)(gn + 32 * bj + 8 * fq + 4 * n);
#pragma unroll
            for (int ai = 0; ai < 2; ++ai)
#pragma unroll
                for (int m = 0; m < 4; ++m) { const int row = row0 + ai * HALF + m * 16; const float rs = rsv[ai][m];
                    f32x4 v[2][2]; float ss = 0.f;
#pragma unroll
                    for (int bj = 0; bj < 2; ++bj)
#pragma unroll
                        for (int n = 0; n < 2; ++n) { v[bj][n] = acc[ai][bj][m][n] * rs; ss += (v[bj][n][0] * v[bj][n][0] + v[bj][n][1] * v[bj][n][1]) + (v[bj][n][2] * v[bj][n][2] + v[bj][n][3] * v[bj][n][3]); }
                    ss += __shfl_xor(ss, 16); ss += __shfl_xor(ss, 32);
                    const float r2 = __builtin_amdgcn_rsqf(ss * (1.0f / 64.0f) + RMS_EPS) * sc;
#pragma unroll
                    for (int bj = 0; bj < 2; ++bj) st16_wt(base + (size_t)row * DM_ + col0 + 32 * bj, pack8(v[bj][0] * r2 * gv[bj][0], v[bj][1] * r2 * gv[bj][1])); }
        } else {
            const int col0 = (u.pn - 8) * BM + wc * 32 + 8 * fq;
#pragma unroll
            for (int ai = 0; ai < 2; ++ai)
#pragma unroll
                for (int m = 0; m < 4; ++m) { const int row = row0 + ai * HALF + m * 16; const float rs = rsv[ai][m];
#pragma unroll
                    for (int bj = 0; bj < 2; ++bj) st16_wt(V + (size_t)row * DM_ + col0 + bj * HALF, pack8(acc[ai][bj][m][0] * rs, acc[ai][bj][m][1] * rs)); }
        }
    }
};

struct EpiSwiGLU8 {
    static constexpr bool PERM = true, AFTER_DRAIN = false;
    unsigned char* H; int ldh; int ncol;
    __device__ __forceinline__ void operator()(const f32x4 (&acc)[2][2][4][2], const Unit& u, int wr, int wc, int fr, int fq) const {
        const int row0 = u.pm * BM + wr * 64 + fr, col0 = (u.pn % ncol) * 128 + wc * 32 + 8 * fq; constexpr float cs = 1.0f / (F8_SA * F8_SWG);
#pragma unroll
        for (int ai = 0; ai < 2; ++ai)
#pragma unroll
            for (int m = 0; m < 4; ++m) { const int row = row0 + ai * HALF + m * 16; f32x4 h[2];
#pragma unroll
                for (int n = 0; n < 2; ++n) { const f32x4 a = acc[ai][0][m][n], b = acc[ai][1][m][n];
                    const f32x2 h0 = swiglu2((f32x2){a[0], a[1]}, (f32x2){b[0], b[1]}, -cs * LOG2E, 1.0f / (cs * cs * F8_SH)), h1 = swiglu2((f32x2){a[2], a[3]}, (f32x2){b[2], b[3]}, -cs * LOG2E, 1.0f / (cs * cs * F8_SH));
                    h[n] = (f32x4){h0.x, h0.y, h1.x, h1.y}; }
                u32x2 w; w.x = pk4_fp8(h[0][0], h[0][1], h[0][2], h[0][3]); w.y = pk4_fp8(h[1][0], h[1][1], h[1][2], h[1][3]);
                st8_wt(H + (size_t)row * ldh + col0, w.x, w.y); }
    }
};

struct EpiMoeDown {
    static constexpr bool PERM = true, AFTER_DRAIN = false;
    unsigned char* Y; const float* gate; float scale; bf16_t* Pp;
    __device__ __forceinline__ void operator()(const f32x4 (&acc)[2][2][4][2], const Unit& u, int wr, int wc, int fr, int fq) const {
        const int col0 = (u.pn & 3) * BM + wc * 32 + 8 * fq;
        if (u.aux >= 0) {
            bf16_t* base = Pp + ((size_t)u.aux * BM + wr * 64 + fr) * DM_ + col0;
#pragma unroll
            for (int ai = 0; ai < 2; ++ai)
#pragma unroll
                for (int m = 0; m < 4; ++m)
#pragma unroll
                    for (int bj = 0; bj < 2; ++bj) st16_wt(base + (size_t)(ai * HALF + m * 16) * DM_ + bj * HALF, pack8(acc[ai][bj][m][0] * scale, acc[ai][bj][m][1] * scale));
            return; }
        const int row0 = u.pm * BM + wr * 64 + fr;
        float gv[2][4];
#pragma unroll
        for (int ai = 0; ai < 2; ++ai)
#pragma unroll
            for (int m = 0; m < 4; ++m) gv[ai][m] = gate[row0 + ai * HALF + m * 16] * (scale * F8_SY);
#pragma unroll
        for (int ai = 0; ai < 2; ++ai)
#pragma unroll
            for (int m = 0; m < 4; ++m) { const int row = row0 + ai * HALF + m * 16; const float gt = gv[ai][m];
#pragma unroll
                for (int bj = 0; bj < 2; ++bj) { const f32x4 y0 = acc[ai][bj][m][0] * gt, y1 = acc[ai][bj][m][1] * gt; st8_wt(Y + (size_t)row * DM_ + col0 + bj * HALF, pk4_fp8(y0[0], y0[1], y0[2], y0[3]), pk4_fp8(y1[0], y1[1], y1[2], y1[3])); } }
    }
};

struct MoeOrder {
    int nM, nN, nwg, G, c, T, P0, npieces; int t1, t2, t3, t4, t5, t6, t7;
    static constexpr int SPL = 7, PKT = 4;
    __device__ __forceinline__ void init(const int* meta, int nN_, int G_, int c_, bool split) {
        T = meta[8]; nM = split ? meta[9] : T; nN = nN_; nwg = nM * nN; G = G_; c = c_; t1 = meta[1]; t2 = meta[2]; t3 = meta[3]; t4 = meta[4]; t5 = meta[5]; t6 = meta[6]; t7 = meta[7];
        P0 = ((nwg + G - 1) / G) * G; npieces = (T - nM) * nN * SPL; }
    __device__ __forceinline__ int expert_of(int pm) const { return (pm >= t1) + (pm >= t2) + (pm >= t3) + (pm >= t4) + (pm >= t5) + (pm >= t6) + (pm >= t7); }
    __device__ __forceinline__ bool next(int i, Unit& u) const {
        const long L = (long)i * G + c;
        if (L >= nwg) { const long q = L - P0; if (q < 0 || q >= npieces) return false;
            const int rt = (int)q / (nN * SPL), rem = (int)q % (nN * SPL), pnl = rem / SPL, kp = rem % SPL;
            u.pm = nM + rt; u.pn = expert_of(u.pm) * nN + pnl; u.kt0 = kp * PKT; u.nkt = PKT; u.aux = rt * SPL + kp; return true; }
        int wgid = (int)L; { const int q = nwg / NXCD, r = nwg % NXCD, xcd = wgid % NXCD, off = wgid / NXCD; wgid = (xcd < r ? xcd * (q + 1) : r * (q + 1) + (xcd - r) * q) + off; }
        const int nig = WGM * nN, gid = wgid / nig, fm = gid * WGM, gsz = (nM - fm) < WGM ? (nM - fm) : WGM;
        const int pm = fm + ((wgid % nig) % gsz), pnl = (wgid % nig) / gsz;
        u.pm = pm; u.pn = expert_of(pm) * nN + pnl; u.kt0 = 0; u.nkt = 0; u.aux = -1; return true;
    }
    __device__ __forceinline__ void a_ready(const Unit&) const {}
    __device__ __forceinline__ void done(const Unit&) const {}
};
template <class Epi, class Sched, bool ALIGN_EPI = false, bool SP2 = false, bool F8 = false>
__device__ __forceinline__ void gemm_phase(PG8_LAS unsigned char* lds, const Gemm g, const Sched& S, const Epi& E) {
    const int tid = threadIdx.x, wid = __builtin_amdgcn_readfirstlane(tid >> 6), lane = tid & 63, wr = wid >> 2, wc = wid & 3, fr = lane & 15, fq = lane >> 4;
    int K_ = g.K; asm volatile("" : "+s"(K_));
    const int K = K_, nt = K / BK;
    unsigned voffA[2], voffB[2];
#pragma unroll
    for (int i = 0; i < 2; ++i) { int R, C; stage_rc(tid * 16 + i * 8192, R, C); const int Rb = Epi::PERM ? ((R & ~31) + perm32(R & 31)) : R;
        voffA[i] = (unsigned)(R * K + C) * 2u; voffB[i] = (unsigned)(Rb * K + C) * 2u; }
    const size_t kstep = (size_t)(BK * 2);
    const size_t hstep = (size_t)HALF * K * 2;
    const size_t tstep = 2 * hstep;
    const unsigned ldsw = (unsigned)wid * 1024u;
    const int aoff = lds_byte(wr * 64 + fr, fq * 8), boff = lds_byte(wc * 32 + fr, fq * 8);
    constexpr int KSTEP = 1024;
#define PG8_SA(b, h) (((b) * 2 + (h)) * HTB)
#define PG8_SB(b, h) ((4 + (b) * 2 + (h)) * HTB)
#define PG8_STAGE(bufoff, gbase, voff) do { _Pragma("unroll") for (int _i = 0; _i < 2; ++_i) \
        __builtin_amdgcn_global_load_lds((const unsigned*)((const char*)(gbase) + (voff)[_i]), (PG8_LAS unsigned*)(lds + (bufoff) + ldsw + _i * 8192), 16, 0, 0); } while (0)
#define PG8_LDA(dst, b, h) do { _Pragma("unroll") for (int m = 0; m < 4; ++m) _Pragma("unroll") for (int k = 0; k < 2; ++k) dst[m][k] = *(const PG8_LAS bf16x8*)(lds + PG8_SA(b, h) + aoff + m * 2048 + k * KSTEP); } while (0)
#define PG8_LDB(dst, b, h) do { _Pragma("unroll") for (int n = 0; n < 2; ++n) _Pragma("unroll") for (int k = 0; k < 2; ++k) dst[n][k] = *(const PG8_LAS bf16x8*)(lds + PG8_SB(b, h) + boff + n * 2048 + k * KSTEP); } while (0)
#define PG8_CAT8(x) __builtin_shufflevector(__builtin_bit_cast(i32x4, (x)[0]), __builtin_bit_cast(i32x4, (x)[1]), 0, 1, 2, 3, 4, 5, 6, 7)
#define PG8_MMA(ai, bj, At, Bt) do { __builtin_amdgcn_s_setprio(1); _Pragma("unroll") for (int m = 0; m < 4; ++m) _Pragma("unroll") for (int n = 0; n < 2; ++n) { \
        if constexpr (F8) asm volatile("s_nop 1\n\tv_mfma_f32_16x16x128_f8f6f4 %0, %1, %2, %0" : "+v"(acc[ai][bj][m][n]) : "v"(PG8_CAT8(Bt[n])), "v"(PG8_CAT8(At[m]))); \
        else { _Pragma("unroll") for (int k = 0; k < 2; ++k) acc[ai][bj][m][n] = __builtin_amdgcn_mfma_f32_16x16x32_bf16(Bt[n][k], At[m][k], acc[ai][bj][m][n], 0, 0, 0); } } \
        __builtin_amdgcn_s_setprio(0); } while (0)
#define PG8_MMA0(ai, bj, At, Bt) do { __builtin_amdgcn_s_setprio(1); _Pragma("unroll") for (int m = 0; m < 4; ++m) _Pragma("unroll") for (int n = 0; n < 2; ++n) \
        asm volatile("s_nop 1\n\tv_mfma_f32_16x16x128_f8f6f4 %0, %1, %2, 0" : "=&v"(acc[ai][bj][m][n]) : "v"(PG8_CAT8(Bt[n])), "v"(PG8_CAT8(At[m]))); \
        __builtin_amdgcn_s_setprio(0); } while (0)
#define PG8_MMAF(ai, bj, At, Bt) do { if constexpr (F8) { if (t == 0) PG8_MMA0(ai, bj, At, Bt); else PG8_MMA(ai, bj, At, Bt); } else PG8_MMA(ai, bj, At, Bt); } while (0)
#define PG8_WAIT_V(n) asm volatile("s_waitcnt vmcnt(" #n ")" ::: "memory")
#define PG8_WAIT_L(n) asm volatile("s_waitcnt lgkmcnt(" #n ")" ::: "memory")
#define PG8_BAR __builtin_amdgcn_s_barrier()
#define PG8_SCHED __builtin_amdgcn_sched_barrier(0)
    Unit cur, nxt; int ui = 0;
    if (!S.next(0, cur)) return;
    f32x4 acc[2][2][4][2];
    if constexpr (!F8) {
#pragma unroll
    for (int a = 0; a < 2; ++a)
#pragma unroll
        for (int b = 0; b < 2; ++b)
#pragma unroll
            for (int m = 0; m < 4; ++m)
#pragma unroll
                for (int n = 0; n < 2; ++n) acc[a][b][m][n] = (f32x4){0.f, 0.f, 0.f, 0.f};
    }
    bf16x8 At[4][2], B0[2][2], B1[2][2];
    const char* cA = (const char*)g.A + (size_t)cur.pm * tstep + (size_t)cur.kt0 * kstep; const char* cB = (const char*)g.Bt + (size_t)cur.pn * tstep + (size_t)cur.kt0 * kstep;
    S.a_ready(cur);
    if constexpr (SP2) {
        PG8_STAGE(PG8_SB(0, 0), cB, voffB); PG8_STAGE(PG8_SB(0, 1), cB + hstep, voffB); PG8_STAGE(PG8_SA(0, 0), cA, voffA); PG8_STAGE(PG8_SA(0, 1), cA + hstep, voffA);
        if (wr == 1) PG8_BAR;
        PG8_WAIT_V(2); PG8_BAR;
        PG8_STAGE(PG8_SB(1, 0), cB + kstep, voffB); PG8_STAGE(PG8_SA(1, 0), cA + kstep, voffA); PG8_STAGE(PG8_SB(1, 1), cB + hstep + kstep, voffB);
        PG8_WAIT_V(6); PG8_BAR;
    } else {
        PG8_STAGE(PG8_SB(0, 0), cB, voffB); PG8_STAGE(PG8_SA(0, 0), cA, voffA); PG8_STAGE(PG8_SB(0, 1), cB + hstep, voffB); PG8_STAGE(PG8_SA(0, 1), cA + hstep, voffA);
        if (wr == 1) PG8_BAR;
        PG8_WAIT_V(4); PG8_BAR;
        PG8_STAGE(PG8_SB(1, 0), cB + kstep, voffB); PG8_STAGE(PG8_SA(1, 0), cA + kstep, voffA); PG8_STAGE(PG8_SB(1, 1), cB + hstep + kstep, voffB);
        PG8_WAIT_V(6); PG8_BAR;
    }
    for (;;) {
        const bool has_next = S.next(ui + 1, nxt);
        const char* nA = has_next ? (const char*)g.A + (size_t)nxt.pm * tstep + (size_t)nxt.kt0 * kstep : cA; const char* nB = has_next ? (const char*)g.Bt + (size_t)nxt.pn * tstep + (size_t)nxt.kt0 * kstep : cB;
        const int ntu = cur.nkt ? cur.nkt : nt;
        for (int t = 0; t < ntu; t += 2) {
            const bool last = (t == ntu - 2);
            const char* a1 = cA + (size_t)(t + 1) * kstep;
            const char* a2 = last ? nA : cA + (size_t)(t + 2) * kstep; const char* b2 = last ? nB : cB + (size_t)(t + 2) * kstep;
            const char* a3 = a2 + kstep; const char* b3 = b2 + kstep;
            if (last && has_next) S.a_ready(nxt);
            if constexpr (SP2) {
            PG8_LDB(B0, 0, 0); PG8_LDB(B1, 0, 1); PG8_SCHED; PG8_LDA(At, 0, 0); PG8_STAGE(PG8_SA(1, 1), a1 + hstep, voffA);
            PG8_WAIT_V(8); PG8_WAIT_L(0); PG8_BAR; PG8_MMAF(0, 0, At, B0); PG8_MMAF(0, 1, At, B1); PG8_BAR; PG8_SCHED;
            PG8_LDA(At, 0, 1); PG8_STAGE(PG8_SB(0, 0), b2, voffB); PG8_STAGE(PG8_SB(0, 1), b2 + hstep, voffB); PG8_STAGE(PG8_SA(0, 0), a2, voffA);
            PG8_WAIT_V(8); PG8_WAIT_L(0); PG8_BAR; PG8_MMAF(1, 0, At, B0); PG8_MMAF(1, 1, At, B1); PG8_BAR; PG8_SCHED;
            PG8_LDB(B0, 1, 0); PG8_LDB(B1, 1, 1); PG8_SCHED; PG8_LDA(At, 1, 0); PG8_STAGE(PG8_SA(0, 1), a2 + hstep, voffA);
            PG8_WAIT_V(8); PG8_WAIT_L(0); PG8_BAR; PG8_MMA(0, 0, At, B0); PG8_MMA(0, 1, At, B1); PG8_BAR; PG8_SCHED;
            PG8_LDA(At, 1, 1); PG8_STAGE(PG8_SB(1, 0), b3, voffB); PG8_STAGE(PG8_SB(1, 1), b3 + hstep, voffB); PG8_STAGE(PG8_SA(1, 0), a3, voffA);
            PG8_WAIT_V(8); PG8_WAIT_L(0); PG8_BAR; PG8_MMA(1, 0, At, B0); PG8_MMA(1, 1, At, B1); PG8_BAR; PG8_SCHED;
            } else {
            PG8_LDB(B0, 0, 0); PG8_SCHED; PG8_LDA(At, 0, 0); PG8_STAGE(PG8_SA(1, 1), a1 + hstep, voffA);
            PG8_WAIT_L(8); PG8_BAR; PG8_WAIT_L(0); PG8_MMAF(0, 0, At, B0); PG8_BAR; PG8_SCHED;
            PG8_LDB(B1, 0, 1); PG8_STAGE(PG8_SB(0, 0), b2, voffB);
            PG8_BAR; PG8_WAIT_L(0); PG8_MMAF(0, 1, At, B1); PG8_BAR;
            PG8_LDA(At, 0, 1); PG8_STAGE(PG8_SA(0, 0), a2, voffA);
            PG8_BAR; PG8_WAIT_L(0); PG8_MMAF(1, 0, At, B0); PG8_BAR; PG8_SCHED;
            PG8_STAGE(PG8_SB(0, 1), b2 + hstep, voffB);
            PG8_WAIT_V(6); PG8_BAR; PG8_MMAF(1, 1, At, B1); PG8_BAR;
            PG8_LDB(B0, 1, 0); PG8_SCHED; PG8_LDA(At, 1, 0); PG8_STAGE(PG8_SA(0, 1), a2 + hstep, voffA);
            PG8_WAIT_L(8); PG8_BAR; PG8_WAIT_L(0); PG8_MMA(0, 0, At, B0); PG8_BAR; PG8_SCHED;
            PG8_LDB(B1, 1, 1); PG8_STAGE(PG8_SB(1, 0), b3, voffB);
            PG8_BAR; PG8_WAIT_L(0); PG8_MMA(0, 1, At, B1); PG8_BAR;
            PG8_LDA(At, 1, 1); PG8_STAGE(PG8_SA(1, 0), a3, voffA);
            PG8_BAR; PG8_WAIT_L(0); PG8_MMA(1, 0, At, B0); PG8_BAR; PG8_SCHED;
            PG8_STAGE(PG8_SB(1, 1), b3 + hstep, voffB);
            PG8_WAIT_V(6); PG8_BAR; PG8_MMA(1, 1, At, B1); PG8_BAR;
            }
        }
        if constexpr (F8) asm volatile("s_nop 15\n\ts_nop 15" ::: "memory");
        if constexpr (ALIGN_EPI) { if (wr == 0) PG8_BAR; }
        if constexpr (!Epi::AFTER_DRAIN) { E(acc, cur, wr, wc, fr, fq); S.done(cur); }
        if (!has_next) break;
        if constexpr (!F8) {
#pragma unroll
        for (int a = 0; a < 2; ++a)
#pragma unroll
            for (int b = 0; b < 2; ++b)
#pragma unroll
                for (int m = 0; m < 4; ++m)
#pragma unroll
                    for (int n = 0; n < 2; ++n) acc[a][b][m][n] = (f32x4){0.f, 0.f, 0.f, 0.f};
        }
        cur = nxt; cA = nA; cB = nB; ++ui;
        if constexpr (ALIGN_EPI) { if (wr == 1) PG8_BAR; }
    }
    PG8_WAIT_V(0);
    if constexpr (!ALIGN_EPI) { if (wr == 0) PG8_BAR; }
    PG8_BAR;
    if constexpr (Epi::AFTER_DRAIN) { E.fused(acc, cur, wr, wc, fr, fq, lds, wid, lane); S.done(cur); }
#undef PG8_SA
#undef PG8_SB
#undef PG8_STAGE
#undef PG8_LDA
#undef PG8_LDB
#undef PG8_MMA
#undef PG8_MMA0
#undef PG8_MMAF
#undef PG8_CAT8
#undef PG8_WAIT_V
#undef PG8_WAIT_L
#undef PG8_BAR
#undef PG8_SCHED
}
}
#include <hip/hip_bf16.h>
#include <cmath>
namespace attn_body {
using bf16=__hip_bfloat16;
using bf16x8=__attribute__((ext_vector_type(8)))short;
using s16x4=__attribute__((ext_vector_type(4)))short;
using f32x16=__attribute__((ext_vector_type(16)))float;
using u32x4=__attribute__((ext_vector_type(4)))unsigned;
constexpr int BATCH=8,NHEAD=16,SEQ=2048,D=64,DM=NHEAD*D;
constexpr int NW=8,QBLK=32,QB=QBLK*NW,KVBLK=64,NQB=SEQ/QB;
constexpr int ATTN_PITCH=DM, ATTN_UNIT_ROWS=QB;
__device__ __forceinline__ int crow(int r,int hi){return (r&3)+8*(r>>2)+4*hi;}
#define SBAR() __builtin_amdgcn_sched_barrier(0)
__device__ __forceinline__ void cmask(f32x16&p0,f32x16&p1,int jb,int qrel,int hi){
  const float NEG=-INFINITY; int kb=64*jb+4*hi;
  #pragma unroll
  for(int r=0;r<16;++r){int kv=kb+(r&3)+8*(r>>2); if(kv>qrel)p0[r]=NEG; if(kv+32>qrel)p1[r]=NEG;}
}

constexpr int NSLOT=3, SLOTB=8192;
constexpr int LDS_K=0, LDS_V=NSLOT*SLOTB, LDS_WS=3*NSLOT*SLOTB, LDS_QS=LDS_WS+NW*64*4, LDS_OST=LDS_QS+NW*4096, LDS_BYTES=LDS_OST+NW*4096;
constexpr float C2=0.125f*1.4426950408889634f;
__device__ __forceinline__ void glds16(const void*gsrc,unsigned lds_dst){unsigned keep;
  asm volatile("s_mov_b32 %0, m0\n\ts_mov_b32 m0, %2\n\ts_nop 0\n\tglobal_load_lds_dwordx4 %1, off\n\ts_mov_b32 m0, %0":"=&s"(keep):"v"(gsrc),"s"(lds_dst):"memory");}
__device__ __forceinline__ float max3f(float a,float b,float c){float r;asm("v_max3_f32 %0, %1, %2, %3":"=v"(r):"v"(a),"v"(b),"v"(c));return r;}
__device__ __forceinline__ float max2f(float a,float b){float r;asm("v_max_f32_e32 %0, %1, %2":"=v"(r):"v"(a),"v"(b));return r;}
__device__ __forceinline__ float fadd_s(float a,float b){float r;asm("v_add_f32_e32 %0, %1, %2":"=v"(r):"v"(a),"v"(b));return r;}
__device__ __forceinline__ float fsub_s(float a,float b){float r;asm("v_sub_f32_e32 %0, %1, %2":"=v"(r):"v"(a),"v"(b));return r;}
typedef float f32x2_t __attribute__((ext_vector_type(2))); typedef __bf16 bf16x2_t __attribute__((ext_vector_type(2)));
__device__ __forceinline__ unsigned cvtpk_s(float lo,float hi){f32x2_t v={lo,hi};bf16x2_t b=__builtin_convertvector(v,bf16x2_t);return __builtin_bit_cast(unsigned,b);}
#define WAIT_BAR(N) asm volatile("s_waitcnt vmcnt(" #N ") lgkmcnt(0)\n\ts_barrier":::"memory")

__device__ __forceinline__ void qkt(f32x16&p0,f32x16&p1,const char*Kslot,const bf16x8*qr,int r32,int hi){ const f32x16 negm=f32x16{};
  const char*kb=Kslot+hi*1024+r32*16;
  #pragma unroll
  for(int d0=0;d0<4;++d0){
    const bf16x8 b0=*reinterpret_cast<const bf16x8*>(kb+d0*2048);
    const bf16x8 b1=*reinterpret_cast<const bf16x8*>(kb+d0*2048+512);
    if(d0==0){p0=__builtin_amdgcn_mfma_f32_32x32x16_bf16(b0,qr[0],negm,0,0,0);p1=__builtin_amdgcn_mfma_f32_32x32x16_bf16(b1,qr[0],negm,0,0,0);}
    else{p0=__builtin_amdgcn_mfma_f32_32x32x16_bf16(b0,qr[d0],p0,0,0,0);p1=__builtin_amdgcn_mfma_f32_32x32x16_bf16(b1,qr[d0],p1,0,0,0);}}
}
typedef __attribute__((address_space(3))) const char* lds_cptr;
typedef short v4i16_t __attribute__((ext_vector_type(4)));
__device__ __forceinline__ void kload8(bf16x8*kf,lds_cptr kp){
  kf[0]=*(const __attribute__((address_space(3))) bf16x8*)(kp);      kf[1]=*(const __attribute__((address_space(3))) bf16x8*)(kp+512);
  kf[2]=*(const __attribute__((address_space(3))) bf16x8*)(kp+2048); kf[3]=*(const __attribute__((address_space(3))) bf16x8*)(kp+2560);
  kf[4]=*(const __attribute__((address_space(3))) bf16x8*)(kp+4096); kf[5]=*(const __attribute__((address_space(3))) bf16x8*)(kp+4608);
  kf[6]=*(const __attribute__((address_space(3))) bf16x8*)(kp+6144); kf[7]=*(const __attribute__((address_space(3))) bf16x8*)(kp+6656);
}
__device__ __forceinline__ void kload2(bf16x8*kf,lds_cptr kp,int j){ kf[2*j]=*(const __attribute__((address_space(3))) bf16x8*)(kp+j*2048); kf[2*j+1]=*(const __attribute__((address_space(3))) bf16x8*)(kp+j*2048+512); }
__device__ __forceinline__ s16x4 vtr(lds_cptr p){ return __builtin_bit_cast(s16x4,__builtin_amdgcn_ds_read_tr16_b64_v4i16((__attribute__((address_space(3))) v4i16_t*)p)); }
__device__ __forceinline__ float rowmax(const f32x16&p0,const f32x16&p1){
  float a=max3f(p0[0],p0[1],p1[0]),b=max3f(p0[2],p0[3],p1[1]);a=max3f(a,p1[2],p1[3]);
  #pragma unroll
  for(int r=4;r<16;r+=4){a=max3f(a,p0[r],p0[r+1]);b=max3f(b,p0[r+2],p0[r+3]);a=max3f(a,p1[r],p1[r+1]);b=max3f(b,p1[r+2],p1[r+3]);}
  const float m=max2f(a,b);
  auto rr=__builtin_amdgcn_permlane32_swap(__float_as_uint(m),__float_as_uint(m),false,false);
  return max2f(__uint_as_float(rr[0]),__uint_as_float(rr[1]));
}
__device__ __forceinline__ void pv(f32x16*o,int vb,bf16x8 pa0,bf16x8 pa1,bf16x8 pa2,bf16x8 pa3){
  #pragma unroll
  for(int d0=0;d0<4;++d0){s16x4 lo[4],hi[4];
    #pragma unroll
    for(int ks=0;ks<4;++ks){
      asm volatile("ds_read_b64_tr_b16 %0,%1 offset:%c2":"=&v"(lo[ks]):"v"(vb),"i"(d0*4096+ks*1024):"memory");
      asm volatile("ds_read_b64_tr_b16 %0,%1 offset:%c2":"=&v"(hi[ks]):"v"(vb),"i"(d0*4096+ks*1024+512):"memory");}
    asm volatile("s_waitcnt lgkmcnt(0)":::"memory");SBAR();
    #define PK(k) (bf16x8){lo[k][0],lo[k][1],lo[k][2],lo[k][3],hi[k][0],hi[k][1],hi[k][2],hi[k][3]}
    o[d0]=__builtin_amdgcn_mfma_f32_32x32x16_bf16(pa0,PK(0),o[d0],0,0,0);
    o[d0]=__builtin_amdgcn_mfma_f32_32x32x16_bf16(pa1,PK(1),o[d0],0,0,0);
    o[d0]=__builtin_amdgcn_mfma_f32_32x32x16_bf16(pa2,PK(2),o[d0],0,0,0);
    o[d0]=__builtin_amdgcn_mfma_f32_32x32x16_bf16(pa3,PK(3),o[d0],0,0,0);
    #undef PK
  }
}

#ifndef ATTN_STORE16
#define ATTN_STORE16(p,v) pg8::st16_wt((void*)(p),(v))
#endif
template<int THRL,int MODE,bool PRE=false,bool NEXT=false> __device__ __forceinline__ void attn_unit(int b,int qcol,int vcol,int qb,const bf16*Q,const bf16*__restrict__ K,const bf16*__restrict__ V,bf16*O,char*shm,bf16*ON,float lam,const float*subn,int nqcol=0){
  int tid_=threadIdx.x; asm volatile("":"+v"(tid_));
  const int tid=tid_,lane=tid&63,r32=lane&31,hi=lane>>5; const int wid=__builtin_amdgcn_readfirstlane(tid>>6);
  const long rowbase=(long)b*SEQ; const int q0=qb*QB;
  const bf16*Qw=Q+(rowbase+q0+wid*QBLK)*DM+qcol;
  const bf16*Kh=K+rowbase*DM+qcol,*Vh=V+rowbase*DM+vcol;
  const unsigned lds0=(unsigned)(uintptr_t)shm;
  float*wsf=(float*)(shm+LDS_WS)+wid*64;
  const bf16*ksrc=Kh+(long)lane*DM+wid*8;
  const bf16*vsrc=Vh+(long)(16*(wid&3)+(lane>>2))*DM+(wid>>2)*32+(lane&3)*8;
  const unsigned kdst=lds0+LDS_K+wid*1024, vdst=lds0+LDS_V+wid*1024;
  #define DMA_K(t,slot) glds16(ksrc+(long)(t)*KVBLK*DM,(unsigned)__builtin_amdgcn_readfirstlane(kdst+(slot)))
  #define DMA_V(t,slot) do{ glds16(vsrc+(long)(t)*KVBLK*DM,(unsigned)__builtin_amdgcn_readfirstlane(vdst+2*(slot))); glds16(vsrc+(long)(t)*KVBLK*DM+64,(unsigned)__builtin_amdgcn_readfirstlane(vdst+2*(slot)+8192)); }while(0)
  const int vb0=(int)(lds0+LDS_V)+((lane>>4)&1)*32+(lane&3)*8+(4*hi+((lane&15)>>2))*64;
  const char*Kbase=shm+LDS_K; bf16x8 kf[8];
  const lds_cptr shm3=(lds_cptr)shm; const lds_cptr kp0=shm3+LDS_K+hi*1024+r32*16; const lds_cptr vp0=shm3+LDS_V+((lane>>4)&1)*32+(lane&3)*8+(4*hi+((lane&15)>>2))*64;
  const int NT=(q0+QB)/KVBLK;
  if constexpr(!PRE){ DMA_K(0,0);DMA_V(0,0);DMA_K(1,SLOTB); }
  bf16x8 qr[4];
  #pragma unroll
  for(int d0=0;d0<4;++d0)qr[d0]=*reinterpret_cast<const bf16x8*>(&Qw[(long)r32*DM+d0*16+hi*8]);
  float mhat=0.f,l_reg=0.f;f32x16 o[4];o[0]=f32x16{};o[1]=f32x16{};o[2]=f32x16{};o[3]=f32x16{};
  typedef __attribute__((address_space(3))) bf16x8* lds_q8; const lds_cptr qp0=shm3+LDS_QS+wid*4096+lane*16;
  #define QF(j) (*(const __attribute__((address_space(3))) bf16x8*)(qp0+(j)*1024))
  const int qrel=wid*QBLK+r32;
  #define CMASK(P0,P1,t) do{int jb_=(t)-(NT-4); if(jb_>=0)cmask(P0,P1,jb_,qrel,hi);}while(0)
  bool resc=false;
  #define START(P0,P1) do{ resc=false; if constexpr(THRL>=0){ const float rm=rowmax(P0,P1); \
    { const float dl=rm; mhat=fadd_s(mhat,dl); \
      _Pragma("unroll") for(int r=0;r<16;++r){P0[r]=fsub_s(P0[r],dl);P1[r]=fsub_s(P1[r],dl);} } } \
    _Pragma("unroll") for(int r=0;r<16;++r)P0[r]=__builtin_amdgcn_exp2f(P0[r]); }while(0)
  #define RESC() do{ if(resc){ asm volatile("s_waitcnt lgkmcnt(0)":::"memory"); \
      _Pragma("unroll") for(int d_=0;d_<4;++d_) _Pragma("unroll") for(int r=0;r<16;++r)o[d_][r]*=wsf[crow(r,hi)]; } }while(0)
  f32x16 pA0,pA1,pB0,pB1;
  int sl_prev=0,sl_cur=0,sl_next=SLOTB;
  #define ROT() do{sl_prev=sl_cur;sl_cur=sl_next;sl_next=(sl_next==(NSLOT-1)*SLOTB)?0:sl_next+SLOTB;}while(0)
  DMA_K(2,2*SLOTB);
  _Pragma("unroll") for(int d0=0;d0<4;++d0)*(__attribute__((address_space(3))) bf16x8*)(__attribute__((address_space(3))) char*)(qp0+d0*1024)=qr[d0];
  WAIT_BAR(4);
  qkt(pA0,pA1,Kbase,qr,r32,hi);asm volatile("s_nop 15\n\ts_nop 7":"+v"(pA0),"+v"(pA1));CMASK(pA0,pA1,0);
  START(pA0,pA1);
  _Pragma("unroll") for(int r=0;r<16;++r)pA1[r]=__builtin_amdgcn_exp2f(pA1[r]);
  WAIT_BAR(0);
  DMA_K(3,0);DMA_V(1,SLOTB);
  ROT();
  kload8(kf,kp0+sl_cur);
  bf16x8 qa=QF(0),qb_=QF(1);
  WAIT_BAR(3);
  s16x4 vlo[8],vhi[8]; u32x4 pw0,pw1,pw2,pw3;
  #define PKW(P,B) cvtpk_s(P[B],P[B+1])
  #define PAF(k) __builtin_bit_cast(bf16x8,pw##k)
  #define VFR(i) (bf16x8){vlo[i][0],vlo[i][1],vlo[i][2],vlo[i][3],vhi[i][0],vhi[i][1],vhi[i][2],vhi[i][3]}
  #define PIN(x) asm volatile("":"+v"(x))
  #define MX3(a,b,c) __builtin_fmaxf(__builtin_fmaxf((a),(b)),(c))
  #define GAPA(MF,A0,A1,A2,A3,W0,W1,PW) do{ MF; sacc+=A0; sacc2+=A1; sacc+=A2; sacc2+=A3; PIN(sacc); PIN(sacc2); W0; W1; PIN(PW); SBAR(); }while(0)
  #define EX(v) __builtin_amdgcn_exp2f(v)
  #define GAPB(MF,X,B) do{ MF; X[B]=EX(X[B]); X[B+1]=EX(X[B+1]); PIN(X); SBAR(); }while(0)
  #define VRD(i) do{ vlo[i]=vtr(vp_+(((i)>>2)*4096+((i)&3)*1024)); vhi[i]=vtr(vp_+(((i)>>2)*4096+((i)&3)*1024+512)); }while(0)
  #define VRDX(reg,fr) do{ vlo[reg]=vtr(vp_+(((fr)>>2)*4096+((fr)&3)*1024)); vhi[reg]=vtr(vp_+(((fr)>>2)*4096+((fr)&3)*1024+512)); SBAR(); }while(0)
  #define KRD(G,j) do{ if(G){ kload2(kf,kp0+sl_next,j); SBAR(); } }while(0)
  #define ZC f32x16{}
  #define STEP(C0,C1,P0,P1,t,GK,GV,GL) do{ SBAR(); \
    const lds_cptr vp_=vp0+2*sl_prev; \
    VRD(0); SBAR(); float sacc=P0[0],sacc2=P0[1]; \
    GAPA(C0=__builtin_amdgcn_mfma_f32_32x32x16_bf16(kf[0],qa,ZC,0,0,0), P0[2],P0[3],P0[4],P0[5],     pw0[0]=PKW(P0,0), pw0[1]=PKW(P0,2), pw0); \
    VRD(4); SBAR(); GAPA(C1=__builtin_amdgcn_mfma_f32_32x32x16_bf16(kf[1],qa,ZC,0,0,0), P0[6],P0[7],P0[8],P0[9],     pw0[2]=PKW(P0,4), pw0[3]=PKW(P0,6), pw0); \
    qa=QF(2); SBAR(); \
    VRD(1); SBAR(); GAPA(C0=__builtin_amdgcn_mfma_f32_32x32x16_bf16(kf[2],qb_,C0,0,0,0),   P0[10],P0[11],P0[12],P0[13], pw1[0]=PKW(P0,8), pw1[1]=PKW(P0,10), pw1); \
    VRD(5); SBAR(); GAPA(C1=__builtin_amdgcn_mfma_f32_32x32x16_bf16(kf[3],qb_,C1,0,0,0),   P0[14],P0[15],P1[0],P1[1],   pw1[2]=PKW(P0,12),pw1[3]=PKW(P0,14), pw1); \
    qb_=QF(3); SBAR(); \
    VRD(2); SBAR(); GAPA(C0=__builtin_amdgcn_mfma_f32_32x32x16_bf16(kf[4],qa,C0,0,0,0),   P1[2],P1[3],P1[4],P1[5],     pw2[0]=PKW(P1,0), pw2[1]=PKW(P1,2), pw2); \
    VRD(6); SBAR(); GAPA(C1=__builtin_amdgcn_mfma_f32_32x32x16_bf16(kf[5],qa,C1,0,0,0),   P1[6],P1[7],P1[8],P1[9],     pw2[2]=PKW(P1,4), pw2[3]=PKW(P1,6), pw2); \
    VRD(3); SBAR(); GAPA(C0=__builtin_amdgcn_mfma_f32_32x32x16_bf16(kf[6],qb_,C0,0,0,0),   P1[10],P1[11],P1[12],P1[13], pw3[0]=PKW(P1,8), pw3[1]=PKW(P1,10), pw3); \
    VRD(7); SBAR(); GAPA(C1=__builtin_amdgcn_mfma_f32_32x32x16_bf16(kf[7],qb_,C1,0,0,0),   P1[14],P1[15],0.f,0.f,       pw3[2]=PKW(P1,12),pw3[3]=PKW(P1,14), pw3); \
    l_reg+=sacc+sacc2; \
    if(GK){DMA_K((t)+3,sl_cur);} if(GV){DMA_V((t)+1,sl_next);} \
    CMASK(C0,C1,t); \
    if constexpr(THRL>=0){ float a=MX3(C0[0],C0[1],C1[0]),b=MX3(C0[2],C0[3],C1[1]); a=MX3(a,C1[2],C1[3]); \
      _Pragma("unroll") for(int r=4;r<16;r+=4){a=MX3(a,C0[r],C0[r+1]);b=MX3(b,C0[r+2],C0[r+3]);a=MX3(a,C1[r],C1[r+1]);b=MX3(b,C1[r+2],C1[r+3]);} \
      float rm=__builtin_fmaxf(a,b); { auto rr=__builtin_amdgcn_permlane32_swap(__float_as_uint(rm),__float_as_uint(rm),false,false); rm=__builtin_fmaxf(__uint_as_float(rr[0]),__uint_as_float(rr[1])); } \
      rm-=mhat; resc=false;                                      \
      if(__builtin_expect(__any(rm>(float)THRL),0)){ const float dl=__builtin_fmaxf(rm,0.f); mhat+=dl; \
        const float f=__builtin_amdgcn_exp2f(-dl); l_reg*=f; if(hi==0)wsf[r32]=f; resc=true; } \
      _Pragma("unroll") for(int r=0;r<16;++r){C0[r]-=mhat;C1[r]-=mhat;} } \
    SBAR(); \
    GAPB(o[0]=__builtin_amdgcn_mfma_f32_32x32x16_bf16(PAF(0),VFR(0),o[0],0,0,0), C0,0);  VRDX(0,8); \
    GAPB(o[1]=__builtin_amdgcn_mfma_f32_32x32x16_bf16(PAF(0),VFR(4),o[1],0,0,0), C0,2);  VRDX(4,12); \
    GAPB(o[0]=__builtin_amdgcn_mfma_f32_32x32x16_bf16(PAF(1),VFR(1),o[0],0,0,0), C0,4);  VRDX(1,9); \
    GAPB(o[1]=__builtin_amdgcn_mfma_f32_32x32x16_bf16(PAF(1),VFR(5),o[1],0,0,0), C0,6);  VRDX(5,13); \
    GAPB(o[0]=__builtin_amdgcn_mfma_f32_32x32x16_bf16(PAF(2),VFR(2),o[0],0,0,0), C0,8);  VRDX(2,10); \
    GAPB(o[1]=__builtin_amdgcn_mfma_f32_32x32x16_bf16(PAF(2),VFR(6),o[1],0,0,0), C0,10); VRDX(6,14); \
    GAPB(o[0]=__builtin_amdgcn_mfma_f32_32x32x16_bf16(PAF(3),VFR(3),o[0],0,0,0), C0,12); VRDX(3,11); \
    GAPB(o[1]=__builtin_amdgcn_mfma_f32_32x32x16_bf16(PAF(3),VFR(7),o[1],0,0,0), C0,14); VRDX(7,15); \
    KRD(GL,0); GAPB(o[2]=__builtin_amdgcn_mfma_f32_32x32x16_bf16(PAF(0),VFR(0),o[2],0,0,0), C1,0); \
    KRD(GL,1); GAPB(o[3]=__builtin_amdgcn_mfma_f32_32x32x16_bf16(PAF(0),VFR(4),o[3],0,0,0), C1,2); \
    KRD(GL,2); GAPB(o[2]=__builtin_amdgcn_mfma_f32_32x32x16_bf16(PAF(1),VFR(1),o[2],0,0,0), C1,4); \
    KRD(GL,3); GAPB(o[3]=__builtin_amdgcn_mfma_f32_32x32x16_bf16(PAF(1),VFR(5),o[3],0,0,0), C1,6); \
    GAPB(o[2]=__builtin_amdgcn_mfma_f32_32x32x16_bf16(PAF(2),VFR(2),o[2],0,0,0), C1,8); \
    GAPB(o[3]=__builtin_amdgcn_mfma_f32_32x32x16_bf16(PAF(2),VFR(6),o[3],0,0,0), C1,10); \
    qa=QF(0); SBAR(); \
    GAPB(o[2]=__builtin_amdgcn_mfma_f32_32x32x16_bf16(PAF(3),VFR(3),o[2],0,0,0), C1,12); \
    qb_=QF(1); SBAR(); \
    GAPB(o[3]=__builtin_amdgcn_mfma_f32_32x32x16_bf16(PAF(3),VFR(7),o[3],0,0,0), C1,14); \
    }while(0)
  int t=1;
  #undef CMASK
  #define CMASK(P0,P1,t) do{}while(0)
  for(;t+5<NT;t+=2){
    STEP(pB0,pB1,pA0,pA1,t,true,true,true);     WAIT_BAR(3); RESC(); ROT();
    STEP(pA0,pA1,pB0,pB1,t+1,true,true,true);   WAIT_BAR(3); RESC(); ROT();
  }
  #undef CMASK
  #define CMASK(P0,P1,t) do{int jb_=(t)-(NT-4); if(jb_>=0)cmask(P0,P1,jb_,qrel,hi);}while(0)
  #define ENDW(tt) do{ if((tt)+3<NT){WAIT_BAR(3);} else if((tt)+2<NT){WAIT_BAR(2);} else {WAIT_BAR(0);} }while(0)
  for(;t+1<NT;t+=2){
    STEP(pB0,pB1,pA0,pA1,t,(t+3<NT),(t+1<NT),(t+1<NT));       ENDW(t);   RESC(); ROT();
    STEP(pA0,pA1,pB0,pB1,t+1,(t+4<NT),(t+2<NT),(t+2<NT));     ENDW(t+1); RESC(); ROT();
  }
  STEP(pB0,pB1,pA0,pA1,NT-1,false,false,false); RESC();
  { float sacc=pB0[0]+pB0[1]; _Pragma("unroll") for(int r=2;r<16;++r)sacc+=pB0[r]; _Pragma("unroll") for(int r=0;r<16;++r)sacc+=pB1[r]; l_reg+=sacc;
    pw0=(u32x4){PKW(pB0,0),PKW(pB0,2),PKW(pB0,4),PKW(pB0,6)};pw1=(u32x4){PKW(pB0,8),PKW(pB0,10),PKW(pB0,12),PKW(pB0,14)};pw2=(u32x4){PKW(pB1,0),PKW(pB1,2),PKW(pB1,4),PKW(pB1,6)};pw3=(u32x4){PKW(pB1,8),PKW(pB1,10),PKW(pB1,12),PKW(pB1,14)};
    SBAR(); pv(o,vb0+2*sl_cur,PAF(0),PAF(1),PAF(2),PAF(3)); }
  asm volatile("s_waitcnt lgkmcnt(0)\n\ts_barrier":::"memory");
  if constexpr(NEXT){ const bf16*ksrc_n=K+rowbase*DM+nqcol+(long)lane*DM+wid*8;
    glds16(ksrc_n,(unsigned)__builtin_amdgcn_readfirstlane(kdst)); DMA_V(0,0); glds16(ksrc_n+(long)KVBLK*DM,(unsigned)__builtin_amdgcn_readfirstlane(kdst+SLOTB)); }
  #undef PKW
  #undef PAF
  #undef VFR
  #undef PIN
  #undef MX3
  #undef GAPA
  #undef GAPB
  #undef EX
  #undef VRD
  #undef VRDX
  #undef ZC
  #undef QF
  #undef KRD
  #undef STEP
  #undef ENDW
  {auto rr=__builtin_amdgcn_permlane32_swap(__float_as_uint(l_reg),__float_as_uint(l_reg),false,false);l_reg=__uint_as_float(rr[0])+__uint_as_float(rr[1]);}
  if(hi==0)wsf[32+r32]=l_reg;asm volatile("s_waitcnt lgkmcnt(0)":::"memory");
  float rli[16];
  #pragma unroll
  for(int r=0;r<16;++r)rli[r]=__builtin_amdgcn_rcpf(wsf[32+crow(r,hi)]);
  bf16*Ow=O+(rowbase+q0+wid*QBLK)*DM+vcol;
  if constexpr(MODE==0){ bf16*stg=(bf16*)(shm+LDS_OST)+wid*2048;
    #pragma unroll
    for(int hf=0;hf<2;++hf){
      #pragma unroll
      for(int r=0;r<16;++r){const int orow=crow(r,hi);
        #pragma unroll
        for(int d0=0;d0<2;++d0)stg[orow*64+d0*32+r32]=__float2bfloat16(o[2*hf+d0][r]*rli[r]);}
      asm volatile("s_waitcnt lgkmcnt(0)":::"memory");
      #pragma unroll
      for(int i=0;i<4;++i){const int row=i*8+(lane>>3),ch=lane&7; const u32x4 v=*(const u32x4*)(stg+row*64+ch*8); ATTN_STORE16(Ow+(long)row*DM+hf*64+ch*8,v);}
      asm volatile("s_waitcnt lgkmcnt(0)":::"memory"); } }
  else { bf16*stg0=(bf16*)(shm+LDS_OST)+wid*2048,*stg1=(bf16*)(shm+LDS_QS)+wid*2048;
    #pragma unroll
    for(int r=0;r<16;++r){const int orow=crow(r,hi);
      #pragma unroll
      for(int d0=0;d0<2;++d0){stg0[orow*64+d0*32+r32]=__float2bfloat16(o[d0][r]*rli[r]);stg1[orow*64+d0*32+r32]=__float2bfloat16(o[2+d0][r]*rli[r]);}}
    if constexpr(NEXT) asm volatile("s_waitcnt vmcnt(4) lgkmcnt(0)":::"memory");
    else asm volatile("s_waitcnt vmcnt(0) lgkmcnt(0)":::"memory");
    const int ch=lane&7; float g0[8],g1[8];
    #pragma unroll
    for(int j=0;j<8;++j){g0[j]=subn[ch*8+j];g1[j]=subn[64+ch*8+j];}
    bf16*ONw=ON+(rowbase+q0+wid*QBLK)*DM+vcol;
    #pragma unroll
    for(int i=0;i<4;++i){const int row=i*8+(lane>>3);
      const u32x4 a0=*(const u32x4*)(stg0+row*64+ch*8),a1=*(const u32x4*)(stg1+row*64+ch*8);
      const u32x4 b0=*(const u32x4*)(Ow+(long)row*DM+ch*8),b1=*(const u32x4*)(Ow+(long)row*DM+64+ch*8);
      float d[16];
      #pragma unroll
      for(int j=0;j<4;++j){
        d[2*j]  =__uint_as_float(b0[j]<<16)        -lam*__uint_as_float(a0[j]<<16);
        d[2*j+1]=__uint_as_float(b0[j]&0xffff0000u)-lam*__uint_as_float(a0[j]&0xffff0000u);
        d[8+2*j]  =__uint_as_float(b1[j]<<16)        -lam*__uint_as_float(a1[j]<<16);
        d[8+2*j+1]=__uint_as_float(b1[j]&0xffff0000u)-lam*__uint_as_float(a1[j]&0xffff0000u);}
      float ss=0.f;
      #pragma unroll
      for(int j=0;j<16;++j)ss+=d[j]*d[j];
      ss+=__shfl_xor(ss,1);ss+=__shfl_xor(ss,2);ss+=__shfl_xor(ss,4);
      const float rs=__builtin_amdgcn_rsqf(ss*(1.0f/128.0f)+1e-6f);
      u32x4 w0,w1;
      #pragma unroll
      for(int j=0;j<4;++j){w0[j]=cvtpk_s(d[2*j]*rs*g0[2*j],d[2*j+1]*rs*g0[2*j+1]);w1[j]=cvtpk_s(d[8+2*j]*rs*g1[2*j],d[8+2*j+1]*rs*g1[2*j+1]);}
      ATTN_STORE16(ONw+(long)row*DM+ch*8,w0);ATTN_STORE16(ONw+(long)row*DM+64+ch*8,w1);}
    asm volatile("s_waitcnt lgkmcnt(0)":::"memory"); }
  asm volatile("s_waitcnt lgkmcnt(0)":::"memory");
  #undef DMA_K
  #undef DMA_V
  #undef CMASK
  #undef START
  #undef RESC
  #undef ROT
}
constexpr int ATTN_LDS_BYTES=LDS_BYTES;
#undef SBAR
#undef WAIT_BAR
}
constexpr int NWAVES = 8;
constexpr int NPH = 15;
constexpr size_t MiB = 1u << 20;
constexpr size_t WS_CTL = 0, CTL_ZERO_BYTES = 40960;
constexpr size_t WS_W_IN = 1 * MiB;
constexpr size_t WS_W_OUT = WS_W_IN + (size_t)3072 * 1024 * 2;
constexpr size_t WS_W_GU = WS_W_OUT + (size_t)1024 * 1024 * 2;
constexpr size_t WS_W_DN = WS_W_GU + (size_t)5632 * 1024 * 2;
constexpr size_t WS_W_QKV = WS_W_DN + (size_t)1024 * 2816 * 2;
constexpr size_t WS_W_O = WS_W_QKV + (size_t)3072 * 1024 * 2;
constexpr size_t WS_W_MGU = WS_W_O + (size_t)1024 * 1024 * 2;
constexpr size_t WS_W_MDN = WS_W_MGU + (size_t)8 * 7168 * 1024 * 2;
constexpr size_t WS_W_END = WS_W_MDN + (size_t)8 * 1024 * 3584 * 2;
constexpr size_t WS_R = 202 * MiB;
constexpr size_t ACT = (size_t)M * D * 2;
constexpr size_t WS_XN0 = WS_R, WS_BB = WS_R + ACT, WS_UB = WS_R + 2 * ACT, WS_G = WS_R + 3 * ACT;
constexpr size_t WS_HACT = WS_R;
constexpr size_t WS_X8 = WS_R + 48 * MiB;
constexpr size_t WS_Q = WS_R + 2 * ACT, WS_K = WS_R + 3 * ACT, WS_V = WS_R + 4 * ACT;
constexpr size_t WS_O0 = WS_R + 5 * ACT, WS_ON = WS_R + 6 * ACT;
constexpr size_t WS_HM = WS_R;
constexpr size_t WS_PP = WS_R + 128 * MiB;
constexpr size_t WS_S = 440 * MiB;
constexpr size_t WS_XG = WS_S, WS_Y = WS_S + 68 * MiB;
constexpr size_t WS_XB = 632 * MiB;
constexpr size_t WS_SMALL = 792 * MiB;
constexpr size_t WS_SSQ = WS_SMALL;
constexpr size_t WS_SEL = WS_SMALL + 256 * 1024, WS_GATE = WS_SEL + 128 * 1024, WS_TOKSLOT = WS_GATE + 128 * 1024;
constexpr size_t WS_GATES = WS_TOKSLOT + 384 * 1024;
constexpr size_t WS_HIST = WS_GATES + 256 * 1024, WS_META = WS_HIST + 16 * 1024;
constexpr size_t WS_END = 796 * MiB;
static_assert(WS_HACT + (size_t)M * DFF <= WS_X8 && WS_X8 + (size_t)M * D <= WS_Q && WS_ON + ACT <= WS_S, "P3..P9 buffers disjoint");
static_assert(WS_W_END <= WS_R && WS_R + (size_t)SLOTS * DFE * 2 <= WS_S && WS_Y + (size_t)SLOTS * D * 2 <= WS_XB && WS_V + ACT <= WS_S, "d_ws map");
constexpr int CW_TMO = 0, CW_CODE = 1, CW_FQ = 64, CW_FQ4 = 128, CW_MAPBAD = 192, CW_BAR = 4096, CW_XLSUB = 8192, CW_XLGEN = 8704;
constexpr int MISC_OFF = 0, RING_OFF = 1024, RING_BYTES = 131072, LDS_BYTES = 147456;
constexpr int P0_SCR = 16640;

#define GAS __attribute__((address_space(1)))
#define LAS __attribute__((address_space(3)))
typedef unsigned v4u __attribute__((ext_vector_type(4)));
typedef unsigned v2u __attribute__((ext_vector_type(2)));
typedef GAS unsigned gu32;
#define RLX_AGENT __ATOMIC_RELAXED, __HIP_MEMORY_SCOPE_AGENT
#define LDS_WAIT() asm volatile("s_waitcnt lgkmcnt(0)" ::: "memory")
#define VM_WAIT() asm volatile("s_waitcnt vmcnt(0)" ::: "memory")
__device__ __forceinline__ unsigned pk2(float lo, float hi) { return f2bf(lo) | (f2bf(hi) << 16); }
__device__ __forceinline__ float bflo(unsigned w) { return __builtin_bit_cast(float, w << 16); }
__device__ __forceinline__ float bfhi(unsigned w) { return __builtin_bit_cast(float, w & 0xffff0000u); }

#define XB_TMO      128
#define XB_XCNT(j)  (256  + 64 * (j))
#define XB_XSUB(j)  (1280 + 64 * (j))
#define XB_XGEN(j)  (2304 + 64 * (j))
#define XB_TOP      3328
#define XB_TOPGEN   3392
#define XCD_BAR_WORDS 3456
#define XB_SPIN_CAP (1u << 18)

__device__ __forceinline__ unsigned xb_ld(unsigned* p)              { return __hip_atomic_load(p, __ATOMIC_RELAXED, __HIP_MEMORY_SCOPE_AGENT); }
__device__ __forceinline__ unsigned xb_add(unsigned* p, unsigned v) { return __hip_atomic_fetch_add(p, v, __ATOMIC_RELAXED, __HIP_MEMORY_SCOPE_AGENT); }
__device__ __forceinline__ unsigned xb_xcc_id() { return (unsigned)__builtin_amdgcn_s_getreg((3 << 11) | 20) & 0xFu; }
#define XB_SPIN(cond, bar) do { unsigned _sp = 0; while (cond) { __builtin_amdgcn_s_sleep(1); \
    if ((++_sp & 255u) == 0u) { if (xb_ld(&(bar)[XB_TMO])) break; if (_sp > XB_SPIN_CAP) { atomicAdd(&(bar)[XB_TMO], 1u); break; } } } } while (0)

struct XcdBarrier {
    unsigned* bar; unsigned x;
    volatile LAS unsigned* st;
};

__device__ __forceinline__ XcdBarrier xcd_barrier_post(unsigned* bar, volatile LAS unsigned* st) {
    XcdBarrier b; b.bar = bar; b.x = xb_xcc_id(); b.st = st;
    if (threadIdx.x == 0) (void)xb_add(&bar[XB_XCNT(b.x)], 1u);
    return b;
}
__device__ __forceinline__ void xcd_barrier_complete(unsigned* bar, unsigned x, unsigned& nloc, unsigned& nx) {
    const unsigned G = gridDim.x * gridDim.y * gridDim.z;
    unsigned sum, cnt, mine, sp = 0u;
    for (;;) {
        sum = 0u; cnt = 0u; mine = 0u;
#pragma unroll
        for (unsigned j = 0; j < 16; ++j) { const unsigned c = xb_ld(&bar[XB_XCNT(j)]); sum += c; cnt += (c > 0u) ? 1u : 0u; mine = (j == x) ? c : mine; }
        if (sum == G) break;
        __builtin_amdgcn_s_sleep(1);
        if ((++sp & 255u) == 0u) { if (xb_ld(&bar[XB_TMO])) break; if (sp > XB_SPIN_CAP) { atomicAdd(&bar[XB_TMO], 1u); break; } }
    }
    nloc = mine > 0u ? mine : 1u; nx = cnt > 0u ? cnt : 1u;
}

__device__ __forceinline__ void xcd_barrier(const XcdBarrier& b) {
    asm volatile("s_waitcnt vmcnt(0)" ::: "memory");
    __syncthreads();
    if (threadIdx.x == 0) {
        unsigned* bar = b.bar;
        __builtin_amdgcn_s_waitcnt(0);
        unsigned nloc = b.st[0], nx = b.st[1];
        if (nloc == 0u) { xcd_barrier_complete(bar, b.x, nloc, nx); b.st[0] = nloc; b.st[1] = nx; }
        const unsigned old = xb_add(&bar[XB_XSUB(b.x)], 1u);
        const unsigned gen = old / nloc;
        if (old + 1u == (gen + 1u) * nloc) {
            __builtin_amdgcn_fence(__ATOMIC_RELEASE, "agent");
            asm volatile("s_waitcnt vmcnt(0)" ::: "memory");
            const unsigned og = xb_add(&bar[XB_TOP], 1u);
            const unsigned tg = og / nx;
            if (og + 1u == (tg + 1u) * nx) xb_add(&bar[XB_TOPGEN], 1u);
            else XB_SPIN(xb_ld(&bar[XB_TOPGEN]) == tg, bar);
            __builtin_amdgcn_fence(__ATOMIC_ACQUIRE, "agent");
            xb_add(&bar[XB_XGEN(b.x)], 1u);
            asm volatile("s_waitcnt vmcnt(0)" ::: "memory");
        } else {
            XB_SPIN(xb_ld(&bar[XB_XGEN(b.x)]) == gen, bar);
            __builtin_amdgcn_fence(__ATOMIC_ACQUIRE, "agent");
            asm volatile("s_waitcnt vmcnt(0)" ::: "memory");
        }
    }
    __syncthreads();
}


struct Args { const float* in[19]; float* out; unsigned char* wsp; int ph_lo, ph_hi, li, pad; };
struct Frame { LAS unsigned char* lds; int tid, lane, wave, vcu, G; };
#define KA ((const Args*)__builtin_amdgcn_kernarg_segment_ptr())
#define INP(i) (KA->in[i])
#define A_WS (KA->wsp)
#define A_OUT (KA->out)

__device__ __forceinline__ int p0_dstrow(int mode, int aux, int col) {
    if (mode == 1) { if (col < 1024) return col; const int v = col >= 2048, cc = col - (v ? 2048 : 1024); return 1024 + 256 * (cc >> 7) + 128 * v + (cc & 127); }
    if (mode == 2) { const int up = col >= aux, cc = col - (up ? aux : 0); return 256 * (cc >> 7) + 128 * up + (cc & 127); }
    if (mode == 3) { const int g = col >> 6, bj = (col >> 5) & 1; return 256 * (g >> 2) + 32 * (4 * bj + (g & 3)) + (col & 31); }
    return col;
}
struct P0Item { const float* src; const float* gain; unsigned char* dst; int ldw, K, k0, d0, d1, f8; float sc; };
#define P0_JOB(SRC, LDW, KK, C0, NCOLS, GAIN, DSTOFF, DROW0, DSTROWS, MODE, AUX, NMAT, SC, F8) { \
    constexpr int nn_ = (NCOLS) / 64, per_ = ((KK) / 64) * nn_, cnt_ = per_ * (NMAT); \
    if (it < cnt_) { const int mat = it / per_, r = it % per_, kb = r / nn_, col = 64 * (r % nn_); \
        I.src = (SRC) + (size_t)mat * (KK) * (LDW) + (C0) + col; I.gain = (GAIN); I.dst = A_WS + (DSTOFF) + (size_t)mat * (DSTROWS) * (KK) * ((F8) ? 1 : 2); \
        I.ldw = (LDW); I.K = (KK); I.k0 = 64 * kb; I.d0 = (DROW0) + p0_dstrow(MODE, AUX, col); I.d1 = (DROW0) + p0_dstrow(MODE, AUX, col + 32); I.f8 = (F8); I.sc = (SC); return; } \
    it -= cnt_; }
constexpr int P0_NITEMS = 16 * 48 + 16 * 16 + 16 * 88 + 44 * 16 + 3 * 16 * 16 + 16 * 16 + 8 * 16 * 112 + 8 * 56 * 16;
constexpr int P0_FIRST = 16 * 48;
constexpr int P0_E_WOUT = P0_FIRST + 16 * 16, P0_E_WGU = P0_E_WOUT + 16 * 88, P0_E_WDN = P0_E_WGU + 44 * 16, P0_E_QKV = P0_E_WDN + 3 * 16 * 16, P0_E_WO = P0_E_QKV + 16 * 16;
constexpr int P0_DENSE_ITEMS = P0_E_WO;
constexpr int P0_GU_END = P0_DENSE_ITEMS + 8 * 16 * 112;
__device__ __forceinline__ void p0_decode(int it, P0Item& I) {
    P0_JOB(INP(3), 3072, 1024, 0, 3072, INP(1), WS_W_IN, 0, 3072, 1, 0, 1, 1.0f, 0)
    P0_JOB(INP(5), 1024, 1024, 0, 1024, nullptr, WS_W_OUT, 0, 1024, 0, 0, 1, 1.0f, 0)
    P0_JOB(INP(14), 5632, 1024, 0, 5632, INP(2), WS_W_GU, 0, 5632, 2, 2816, 1, pg8::F8_SWGD, 1)
    P0_JOB(INP(15), 1024, 2816, 0, 1024, nullptr, WS_W_DN, 0, 1024, 0, 0, 1, pg8::F8_SWDD, 1)
    P0_JOB(INP(9), 1024, 1024, 0, 1024, INP(1) + 1024, WS_W_QKV, 0, 3072, 3, 0, 1, 1.0f, 0)
    P0_JOB(INP(7), 2048, 1024, 0, 1024, INP(6), WS_W_QKV, 1024, 3072, 3, 0, 1, 1.0f, 0)
    P0_JOB(INP(7), 2048, 1024, 1024, 1024, INP(6), WS_W_QKV, 2048, 3072, 0, 0, 1, 1.0f, 0)
    P0_JOB(INP(13), 1024, 1024, 0, 1024, nullptr, WS_W_O, 0, 1024, 0, 0, 1, 1.0f, 0)
    P0_JOB(INP(17), 7168, 1024, 0, 7168, INP(2) + 1024, WS_W_MGU, 0, 7168, 2, 3584, 8, pg8::F8_SWG, 1)
    P0_JOB(INP(18), 1024, 3584, 0, 1024, nullptr, WS_W_MDN, 0, 1024, 0, 0, 8, pg8::F8_SWD, 1)
}
#undef P0_JOB
struct P0Regs { f32x4 v[16]; float g[16]; };
__device__ __forceinline__ void p0_load(const P0Item& I, P0Regs& R, int lane) {
    const int lr = lane >> 4, lc = lane & 15;
#pragma unroll
    for (int i = 0; i < 16; ++i) R.v[i] = __builtin_nontemporal_load((const GAS f32x4*)(I.src + (size_t)(I.k0 + 4 * i + lr) * I.ldw + 4 * lc));
    if (I.gain) {
#pragma unroll
        for (int i = 0; i < 16; ++i) R.g[i] = I.gain[I.k0 + 4 * i + lr];
    } else {
#pragma unroll
        for (int i = 0; i < 16; ++i) R.g[i] = 1.0f;
    }
}
__device__ __forceinline__ void p0_store(const P0Item& I, const P0Regs& R, LAS float* scr, int lane) {
    const int lr = lane >> 4, lc = lane & 15;
#pragma unroll
    for (int i = 0; i < 16; ++i) { const f32x4 w = R.v[i] * (R.g[i] * I.sc); LAS float* p = scr + (4 * i + lr) * 65 + 4 * lc; p[0] = w[0]; p[1] = w[1]; p[2] = w[2]; p[3] = w[3]; }
    LDS_WAIT(); asm volatile("" ::: "memory");
    const int c = lane & 7;
#pragma unroll
    for (int jj = 0; jj < 8; ++jj) { const int nl = 8 * jj + (lane >> 3); const LAS float* s = scr + (8 * c) * 65 + nl;
        const int drow = (jj < 4 ? I.d0 : I.d1 - 32) + nl;
        if (I.f8) { v2u o; o.x = pg8::pk4_fp8(s[0], s[65], s[130], s[195]); o.y = pg8::pk4_fp8(s[260], s[325], s[390], s[455]);
            pg8::st8_wt(I.dst + (size_t)drow * I.K + I.k0 + 8 * c, o.x, o.y); }
        else { v4u o; o.x = pk2(s[0], s[65]); o.y = pk2(s[130], s[195]); o.z = pk2(s[260], s[325]); o.w = pk2(s[390], s[455]);
            pg8::st16_wt(I.dst + ((size_t)drow * I.K + I.k0 + 8 * c) * 2, o); } }
    LDS_WAIT(); asm volatile("" ::: "memory");
}
__device__ __forceinline__ void rms_row_bf16(const float* xrow, const float* g, bf16_t* orow, int lane) {
    const GAS f32x4* xr = (const GAS f32x4*)xrow + lane; const GAS f32x4* gr = (const GAS f32x4*)g + lane;
    f32x4 v[4]; float s = 0.f;
#pragma unroll
    for (int j = 0; j < 4; ++j) { v[j] = xr[64 * j]; s += (v[j][0] * v[j][0] + v[j][1] * v[j][1]) + (v[j][2] * v[j][2] + v[j][3] * v[j][3]); }
    const float rstd = __builtin_amdgcn_rsqf(wave_sum(s) * (1.f / D) + EPS);
    GAS v2u* o8 = (GAS v2u*)orow + lane;
#pragma unroll
    for (int j = 0; j < 4; ++j) { const f32x4 gg = gr[64 * j]; v2u o; o.x = pk2(v[j][0] * rstd * gg[0], v[j][1] * rstd * gg[1]); o.y = pk2(v[j][2] * rstd * gg[2], v[j][3] * rstd * gg[3]); o8[64 * j] = o; }
}
__device__ __forceinline__ void p0_prologue(Frame& F) {
    const int gw = F.vcu * NWAVES + F.wave, NGW = F.G * NWAVES;
    {
        const float* x = INP(0); bf16_t* XBp = (bf16_t*)(A_WS + WS_XB); float* ssq = (float*)(A_WS + WS_SSQ);
        for (int mb = gw; mb < M; mb += 4 * NGW) { f32x4 v[4][4];
#pragma unroll
            for (int i = 0; i < 4; ++i) { const int m = mb + i * NGW; if (m < M) { const GAS f32x4* xr = (const GAS f32x4*)(x + (size_t)m * D) + F.lane;
#pragma unroll
                for (int j = 0; j < 4; ++j) v[i][j] = __builtin_nontemporal_load(xr + 64 * j); } }
#pragma unroll
            for (int i = 0; i < 4; ++i) { const int m = mb + i * NGW; if (m >= M) break; float s = 0.f;
#pragma unroll
                for (int j = 0; j < 4; ++j) s += (v[i][j][0] * v[i][j][0] + v[i][j][1] * v[i][j][1]) + (v[i][j][2] * v[i][j][2] + v[i][j][3] * v[i][j][3]);
                s = wave_sum(s); GAS v2u* o8 = (GAS v2u*)(XBp + (size_t)m * D) + F.lane;
                if (F.lane == 0) *(GAS f32x4*)(ssq + (size_t)m * 4) = (f32x4){s, 0.f, 0.f, 0.f};
#pragma unroll
                for (int j = 0; j < 4; ++j) { v2u o; o.x = pk2(v[i][j][0], v[i][j][1]); o.y = pk2(v[i][j][2], v[i][j][3]); o8[64 * j] = o; } } }
    }
    LAS float* scr = (LAS float*)(F.lds + RING_OFF + F.wave * P0_SCR);
    int it = gw; if (it >= P0_FIRST) return;
    P0Item cur; P0Regs ra; p0_decode(it, cur); p0_load(cur, ra, F.lane);
    for (;;) { const int nit = it + NGW; const bool has = nit < P0_FIRST; P0Item nx; P0Regs rb;
        if (has) { p0_decode(nit, nx); p0_load(nx, rb, F.lane); }
        p0_store(cur, ra, scr, F.lane);
        if (!has) break;
        cur = nx; ra = rb; it = nit; }
}

#ifndef FILL_CAP
#define FILL_CAP 1
#endif
__device__ __forceinline__ void fill_items(Frame& F, int bound, volatile LAS unsigned* flag) {
    if (F.wave == 0) return;
    volatile LAS unsigned* curp = (volatile LAS unsigned*)(F.lds + MISC_OFF + 64) + F.wave;
    int c = __builtin_amdgcn_readfirstlane((int)*curp);
    const int base = P0_FIRST + F.vcu * (NWAVES - 1) + (F.wave - 1), stride = F.G * (NWAVES - 1);
    if (base + c * stride >= bound) return;
    LAS float* scr = (LAS float*)(F.lds + RING_OFF + F.wave * P0_SCR);
    for (int n = 0;; ++n) { const int it = base + c * stride; if (it >= bound) break; if (flag && (n >= FILL_CAP || *flag != 0u)) break;
        P0Item I; P0Regs R; p0_decode(it, I); p0_load(I, R, F.lane); p0_store(I, R, scr, F.lane); ++c; }
    if (F.lane == 0) *curp = (unsigned)c;
}
__device__ __forceinline__ void xcd_barrier_fill(const XcdBarrier& b, Frame& F, int bound) {
    volatile LAS unsigned* flag = (volatile LAS unsigned*)(F.lds + MISC_OFF + 48);
    asm volatile("s_waitcnt vmcnt(0)" ::: "memory");
    if (threadIdx.x == 0) *flag = 0u;
    __syncthreads();
    if (threadIdx.x == 0) {
        unsigned* bar = b.bar;
        __builtin_amdgcn_s_waitcnt(0);
        unsigned nloc = b.st[0], nx = b.st[1];
        if (nloc == 0u) { xcd_barrier_complete(bar, b.x, nloc, nx); b.st[0] = nloc; b.st[1] = nx; }
        const unsigned old = xb_add(&bar[XB_XSUB(b.x)], 1u);
        const unsigned gen = old / nloc;
        if (old + 1u == (gen + 1u) * nloc) {
            __builtin_amdgcn_fence(__ATOMIC_RELEASE, "agent");
            asm volatile("s_waitcnt vmcnt(0)" ::: "memory");
            const unsigned og = xb_add(&bar[XB_TOP], 1u);
            const unsigned tg = og / nx;
            if (og + 1u == (tg + 1u) * nx) xb_add(&bar[XB_TOPGEN], 1u);
            else XB_SPIN(xb_ld(&bar[XB_TOPGEN]) == tg, bar);
            __builtin_amdgcn_fence(__ATOMIC_ACQUIRE, "agent");
            xb_add(&bar[XB_XGEN(b.x)], 1u);
            asm volatile("s_waitcnt vmcnt(0)" ::: "memory");
        } else {
            XB_SPIN(xb_ld(&bar[XB_XGEN(b.x)]) == gen, bar);
            __builtin_amdgcn_fence(__ATOMIC_ACQUIRE, "agent");
            asm volatile("s_waitcnt vmcnt(0)" ::: "memory");
        }
        *flag = 1u;
    } else if (threadIdx.x >= 64) fill_items(F, bound, flag);
    __syncthreads();
}

__device__ __forceinline__ void xcd_local_barrier_fill(Frame& F, unsigned* bar, int bound) {
    unsigned* ctl = (unsigned*)(A_WS + WS_CTL);
    volatile LAS unsigned* flag = (volatile LAS unsigned*)(F.lds + MISC_OFF + 48);
    volatile LAS unsigned* lgen = (volatile LAS unsigned*)(F.lds + MISC_OFF + 56);
    asm volatile("s_waitcnt vmcnt(0)" ::: "memory");
    if (threadIdx.x == 0) *flag = 0u;
    __syncthreads();
    if (threadIdx.x == 0) {
        __builtin_amdgcn_s_waitcnt(0);
        const unsigned x = blockIdx.x & 7u, gen = *lgen; *lgen = gen + 1u;
        const unsigned old = xb_add(&ctl[CW_XLSUB + 64 * x], 1u);
        if (old + 1u == (gen + 1u) * (gridDim.x >> 3)) (void)xb_add(&ctl[CW_XLGEN + 64 * x], 1u);
        else XB_SPIN(xb_ld(&ctl[CW_XLGEN + 64 * x]) == gen, bar);
        __builtin_amdgcn_fence(__ATOMIC_ACQUIRE, "agent");
        asm volatile("s_waitcnt vmcnt(0)" ::: "memory");
        *flag = 1u;
    } else if (threadIdx.x >= 64) fill_items(F, bound, flag);
    __syncthreads();
}

#define FILL_TAIL0(F) (P0_FIRST + 11 * (F).G * (NWAVES - 1))
constexpr int FILL_D4_CHUNKS = 384;
__device__ __forceinline__ void fill_tail(Frame& F, int cw, int it0, int it1) {
    unsigned* ctr = (unsigned*)(A_WS + WS_CTL) + cw;
    volatile LAS unsigned* qs = (volatile LAS unsigned*)(F.lds + MISC_OFF + 96);
    const int nchunks = (it1 - it0 + NWAVES - 2) / (NWAVES - 1);
    if (nchunks <= 0) return;
    LAS float* scr = (LAS float*)(F.lds + RING_OFF + F.wave * P0_SCR);
    if (F.tid == 0) *qs = __hip_atomic_fetch_add(ctr, 1u, __ATOMIC_RELAXED, __HIP_MEMORY_SCOPE_AGENT);
    __syncthreads();
    for (;;) {
        const int q = (int)*qs;
        __syncthreads();
        if (q >= nchunks) break;
        if (F.tid == 0) *qs = __hip_atomic_fetch_add(ctr, 1u, __ATOMIC_RELAXED, __HIP_MEMORY_SCOPE_AGENT);
        if (F.wave) { const int it = it0 + q * (NWAVES - 1) + (F.wave - 1);
            if (it < it1) { P0Item I; P0Regs R; p0_decode(it, I); p0_load(I, R, F.lane); p0_store(I, R, scr, F.lane); } }
        __syncthreads();
    }
}
__device__ __forceinline__ int fill_d4_end(Frame& F) { const int e = FILL_TAIL0(F) + FILL_D4_CHUNKS * (NWAVES - 1); return e < P0_NITEMS ? e : P0_NITEMS; }

__device__ __forceinline__ void up8(const v4u w, float (&f)[8]) { f[0] = bflo(w.x); f[1] = bfhi(w.x); f[2] = bflo(w.y); f[3] = bfhi(w.y); f[4] = bflo(w.z); f[5] = bfhi(w.z); f[6] = bflo(w.w); f[7] = bfhi(w.w); }
__device__ __forceinline__ void p2_conv(Frame& F) {
    const bf16_t* Bb = (const bf16_t*)(A_WS + WS_BB); const bf16_t* Ub = (const bf16_t*)(A_WS + WS_UB); bf16_t* G = (bf16_t*)(A_WS + WS_G); const float* cw = INP(4);
    const int gw = F.vcu * NWAVES + F.wave, NGW = F.G * NWAVES;
    for (int strip = gw; strip < 2048; strip += NGW) {
        const int r0 = (strip >> 1) * 16, c0 = (strip & 1) * 512 + F.lane * 8;
        float w0[8], w1[8], w2[8], um2[8], um1[8];
#pragma unroll
        for (int j = 0; j < 8; ++j) { w0[j] = cw[c0 + j]; w1[j] = cw[D + c0 + j]; w2[j] = cw[2 * D + c0 + j]; um2[j] = 0.f; um1[j] = 0.f; }
        if ((r0 & (SEQ - 1)) != 0) { up8(*(const GAS v4u*)(Ub + (size_t)(r0 - 2) * D + c0), um2); up8(*(const GAS v4u*)(Ub + (size_t)(r0 - 1) * D + c0), um1); }
#pragma unroll
        for (int hb = 0; hb < 2; ++hb) { v4u ru[8], rb[8];
#pragma unroll
            for (int i = 0; i < 8; ++i) { ru[i] = *(const GAS v4u*)(Ub + (size_t)(r0 + 8 * hb + i) * D + c0); rb[i] = *(const GAS v4u*)(Bb + (size_t)(r0 + 8 * hb + i) * D + c0); }
#pragma unroll
            for (int ii = 0; ii < 8; ++ii) { const int i = 8 * hb + ii; float u[8], b[8]; up8(ru[ii], u); up8(rb[ii], b);
            float g[8];
#pragma unroll
            for (int j = 0; j < 8; ++j) { g[j] = b[j] * (w0[j] * um2[j] + w1[j] * um1[j] + w2[j] * u[j]); um2[j] = um1[j]; um1[j] = u[j]; }
            v4u o; o.x = pk2(g[0], g[1]); o.y = pk2(g[2], g[3]); o.z = pk2(g[4], g[5]); o.w = pk2(g[6], g[7]);
            pg8::st16_wt(G + (size_t)(r0 + i) * D + c0, o); } }
    }
}

#define TR_STEP(n, m) do { _Pragma("unroll") for (int i = 0; i < (n) / 2; ++i) { const bool up = (lane & (m)) != 0; const float keep = up ? v[i + (n) / 2] : v[i], send = up ? v[i] : v[i + (n) / 2]; v[i] = keep + __shfl_xor(send, (m)); } } while (0)
__device__ __forceinline__ void p10a_router(Frame& F) {
    const bf16_t* x3 = (const bf16_t*)(A_WS + WS_XB); const float* g = INP(2) + D; const float* Wr = INP(16); const float* ssq = (const float*)(A_WS + WS_SSQ);
    int* sel = (int*)(A_WS + WS_SEL); float* gate = (float*)(A_WS + WS_GATE); int* hist = (int*)(A_WS + WS_HIST);
    LAS f32x4* WL = (LAS f32x4*)(F.lds + RING_OFF);
    LAS int* lcnt = (LAS int*)(F.lds + RING_OFF + 32768);
    const int lane = F.lane;
    for (int k = F.tid; k < D; k += NWAVES * 64) { const float gk = g[k]; const f32x4 w0 = *(const GAS f32x4*)(Wr + (size_t)k * 8) * gk, w1 = *(const GAS f32x4*)(Wr + (size_t)k * 8 + 4) * gk;
        const int base = (((k >> 8) * 4 + (k & 3)) * 2) * 64 + ((k >> 2) & 63); WL[base] = w0; WL[base + 64] = w1; }
    LDS_WAIT(); __syncthreads();
    for (int blk = F.vcu; blk < M / 64; blk += F.G) {
        const int row0 = 64 * blk + 8 * F.wave;
        f32x4 xv[8][4];
#pragma unroll
        for (int r = 0; r < 8; ++r)
#pragma unroll
            for (int j = 0; j < 4; ++j) { const v2u w = *((const GAS v2u*)(x3 + (size_t)(row0 + r) * D) + lane + 64 * j); xv[r][j] = (f32x4){bflo(w.x), bfhi(w.x), bflo(w.y), bfhi(w.y)}; }
        float v[64];
#pragma unroll
        for (int i = 0; i < 64; ++i) v[i] = 0.f;
#pragma unroll
        for (int j = 0; j < 4; ++j)
#pragma unroll
            for (int q = 0; q < 4; ++q) { const f32x4 wa = WL[((j * 4 + q) * 2) * 64 + lane], wb = WL[((j * 4 + q) * 2 + 1) * 64 + lane];
#pragma unroll
                for (int r = 0; r < 8; ++r) { const float xx = xv[r][j][q];
                    v[r * 8 + 0] += xx * wa[0]; v[r * 8 + 1] += xx * wa[1]; v[r * 8 + 2] += xx * wa[2]; v[r * 8 + 3] += xx * wa[3];
                    v[r * 8 + 4] += xx * wb[0]; v[r * 8 + 5] += xx * wb[1]; v[r * 8 + 6] += xx * wb[2]; v[r * 8 + 7] += xx * wb[3]; } }
        TR_STEP(64, 32); TR_STEP(32, 16); TR_STEP(16, 8); TR_STEP(8, 4); TR_STEP(4, 2); TR_STEP(2, 1);
        float lg[8];
#pragma unroll
        for (int e = 0; e < 8; ++e) lg[e] = __shfl(v[0], (lane & ~7) | e);
        int i0 = 0; float v0 = lg[0];
#pragma unroll
        for (int e = 1; e < 8; ++e) if (lg[e] > v0) { v0 = lg[e]; i0 = e; }
        int i1 = 0; float v1 = -INFINITY;
#pragma unroll
        for (int e = 0; e < 8; ++e) if (e != i0 && lg[e] > v1) { v1 = lg[e]; i1 = e; }
        const int row = row0 + (lane >> 3); const float rs = pg8::rstd_of(ssq, row);
        const float g1 = 1.f / (1.f + expf((v0 - v1) * rs)); const bool wrt = (lane & 7) == 0;
        if (wrt) { sel[2 * row] = i0; sel[2 * row + 1] = i1; gate[2 * row] = 1.f - g1; gate[2 * row + 1] = g1; }
        int mycnt = 0;
#pragma unroll
        for (int e = 0; e < 8; ++e) { const int c = __popcll(__ballot(wrt && i0 == e)) + __popcll(__ballot(wrt && i1 == e)); if (lane == e) mycnt = c; }
        if (lane < 8) lcnt[F.wave * 8 + lane] = mycnt;
        LDS_WAIT(); __syncthreads();
        if (F.tid < 8) { int c = 0;
#pragma unroll
            for (int w = 0; w < 8; ++w) c += lcnt[w * 8 + F.tid];
            hist[blk * 8 + F.tid] = c; }
        LDS_WAIT(); __syncthreads();
    }
}
#undef TR_STEP
__device__ __forceinline__ void p10b_assign(Frame& F) {
    const int* hist = (const int*)(A_WS + WS_HIST); const int* sel = (const int*)(A_WS + WS_SEL); const float* gate = (const float*)(A_WS + WS_GATE); const float* ssq = (const float*)(A_WS + WS_SSQ);
    int* tok_slot = (int*)(A_WS + WS_TOKSLOT); float* gates = (float*)(A_WS + WS_GATES); int* meta = (int*)(A_WS + WS_META);
    const bf16_t* x3 = (const bf16_t*)(A_WS + WS_XB); unsigned char* XG = A_WS + WS_XG;
    LAS int* pre = (LAS int*)(F.lds + RING_OFF);
    LAS int* tot = pre + 2048;
    LAS int* ebase = tot + 8;
    LAS int* lslot = ebase + 8;
    const int lane = F.lane, e = F.wave;
    { int h[4], run = 0;
#pragma unroll
      for (int i = 0; i < 4; ++i) { h[i] = hist[(4 * lane + i) * 8 + e]; }
      const int mine = h[0] + h[1] + h[2] + h[3]; int inc = mine;
#pragma unroll
      for (int o = 1; o < 64; o <<= 1) { const int t = __shfl_up(inc, o); if (lane >= o) inc += t; }
      run = inc - mine;
#pragma unroll
      for (int i = 0; i < 4; ++i) { pre[(4 * lane + i) * 8 + e] = run; run += h[i]; }
      if (lane == 63) tot[e] = inc; }
    LDS_WAIT(); __syncthreads();
    if (F.tid == 0) { int b = 0; for (int k = 0; k < 8; ++k) { ebase[k] = b; if (blockIdx.x == 0) meta[k] = b >> 8; b += (tot[k] + 255) & ~255; } if (blockIdx.x == 0) { const int T = b >> 8, full = 2 * F.G / 4; meta[8] = T; meta[9] = T < full ? T : full; } }
    LDS_WAIT(); __syncthreads();
    for (int blk = blockIdx.x; blk < M / 64; blk += F.G) {
        if (F.wave == 0) { const int t = 64 * blk + lane; const int s0 = sel[2 * t], s1 = sel[2 * t + 1]; int sl0 = 0, sl1 = 0;
            const unsigned long long below = (1ull << lane) - 1ull;
#pragma unroll
            for (int k = 0; k < 8; ++k) { const unsigned long long m0 = __ballot(s0 == k), m1 = __ballot(s1 == k); const int b0 = ebase[k] + pre[blk * 8 + k];
                if (s0 == k) sl0 = b0 + __popcll(m0 & below); if (s1 == k) sl1 = b0 + __popcll(m0) + __popcll(m1 & below); }
            tok_slot[2 * t] = sl0; tok_slot[2 * t + 1] = sl1; lslot[2 * lane] = sl0; lslot[2 * lane + 1] = sl1;
            gates[sl0] = gate[2 * t]; gates[sl1] = gate[2 * t + 1]; }
        LDS_WAIT(); __syncthreads();
        v4u xw[8][2];
#pragma unroll
        for (int i = 0; i < 8; ++i) { const GAS v4u* xr = (const GAS v4u*)(x3 + (size_t)(64 * blk + 8 * F.wave + i) * D + 16 * lane); xw[i][0] = xr[0]; xw[i][1] = xr[1]; }
#pragma unroll
        for (int i = 0; i < 8; ++i) { const int tl = 8 * F.wave + i; const int t = 64 * blk + tl;
            const float rs = pg8::rstd_of(ssq, t) * pg8::F8_SA; float a[8], b[8]; up8(xw[i][0], a); up8(xw[i][1], b);
            v4u o; o.x = pg8::pk4_fp8(a[0] * rs, a[1] * rs, a[2] * rs, a[3] * rs); o.y = pg8::pk4_fp8(a[4] * rs, a[5] * rs, a[6] * rs, a[7] * rs); o.z = pg8::pk4_fp8(b[0] * rs, b[1] * rs, b[2] * rs, b[3] * rs); o.w = pg8::pk4_fp8(b[4] * rs, b[5] * rs, b[6] * rs, b[7] * rs);
            const int sl0 = lslot[2 * tl], sl1 = lslot[2 * tl + 1];
            pg8::st16_wt(XG + (size_t)sl0 * D + 16 * lane, o); pg8::st16_wt(XG + (size_t)sl1 * D + 16 * lane, o); }
        LDS_WAIT(); __syncthreads();
    }
}
typedef float f32x2_ __attribute__((ext_vector_type(2)));
__device__ __forceinline__ void p13_load_y(const unsigned char* Y, const bf16_t* Pp, const float* gates, int nfull, int slot, int lane, f32x4 (&y)[4]) {
    const int rt = (slot >> 8) - nfull;
    if (rt < 0) { const GAS unsigned* yr = (const GAS unsigned*)(Y + (size_t)slot * D) + lane;
#pragma unroll
        for (int j = 0; j < 4; ++j) { const int w = (int)yr[64 * j]; const f32x2_ lo = __builtin_amdgcn_cvt_pk_f32_fp8(w, false), hi = __builtin_amdgcn_cvt_pk_f32_fp8(w, true);
            y[j] = (f32x4){lo.x, lo.y, hi.x, hi.y} * (1.0f / pg8::F8_SY); }
    } else { const float gt = gates[slot];
#pragma unroll
        for (int j = 0; j < 4; ++j) { f32x4 s = (f32x4){0.f, 0.f, 0.f, 0.f};
#pragma unroll
            for (int kp = 0; kp < pg8::MoeOrder::SPL; ++kp) { const v2u w = *((const GAS v2u*)(Pp + ((size_t)(rt * pg8::MoeOrder::SPL + kp) * 256 + (slot & 255)) * D) + lane + 64 * j);
                s += (f32x4){bflo(w.x), bfhi(w.x), bflo(w.y), bfhi(w.y)}; }
            y[j] = s * gt; } }
}
__device__ __forceinline__ void p13_final(Frame& F) {
    const int* tok_slot = (const int*)(A_WS + WS_TOKSLOT); const unsigned char* Y = A_WS + WS_Y; const bf16_t* X3 = (const bf16_t*)(A_WS + WS_XB); float* out = A_OUT;
    const bf16_t* Pp = (const bf16_t*)(A_WS + WS_PP); const float* gates = (const float*)(A_WS + WS_GATES); const int nfull = ((const int*)(A_WS + WS_META))[9];
    const int gw = F.vcu * NWAVES + F.wave, NGW = F.G * NWAVES, lane = F.lane;
    for (int rowb = gw; rowb < M; rowb += 2 * NGW) {
        v2u xa[2][4]; f32x4 ya[2][4], yb[2][4];
#pragma unroll
        for (int i = 0; i < 2; ++i) { const int row = rowb + i * NGW; if (row < M) { const int s0 = tok_slot[2 * row], s1 = tok_slot[2 * row + 1];
            const GAS v2u* xr = (const GAS v2u*)(X3 + (size_t)row * D) + lane;
#pragma unroll
            for (int j = 0; j < 4; ++j) xa[i][j] = xr[64 * j];
            p13_load_y(Y, Pp, gates, nfull, s0, lane, ya[i]); p13_load_y(Y, Pp, gates, nfull, s1, lane, yb[i]); } }
#pragma unroll
        for (int i = 0; i < 2; ++i) { const int row = rowb + i * NGW; if (row >= M) break; GAS f32x4* orow = (GAS f32x4*)(out + (size_t)row * D) + lane;
#pragma unroll
            for (int j = 0; j < 4; ++j) { const v2u x = xa[i][j];
                orow[64 * j] = (f32x4){bflo(x.x), bfhi(x.x), bflo(x.y), bfhi(x.y)} + (ya[i][j] + yb[i][j]); } }
    }
}

__global__ void __launch_bounds__(NWAVES * 64, 2) mega_fwd(Args args) {
    extern __shared__ __attribute__((aligned(16))) unsigned char lds[];
    Frame F;
    F.lds = (LAS unsigned char*)lds; F.tid = threadIdx.x; F.lane = F.tid & 63; F.wave = __builtin_amdgcn_readfirstlane(F.tid >> 6);
    F.G = gridDim.x; { const int bx = blockIdx.x; F.vcu = (F.G % 8 == 0) ? (bx % 8) * (F.G / 8) + bx / 8 : bx; }
    for (int u = F.tid; u < RING_OFF / 4; u += NWAVES * 64) ((LAS unsigned*)(F.lds + MISC_OFF))[u] = 0u;
    __syncthreads();
    if (F.tid == 0 && xb_xcc_id() != (blockIdx.x & 7u)) (void)__hip_atomic_fetch_or((unsigned*)(A_WS + WS_CTL) + CW_MAPBAD, 1u, __ATOMIC_RELAXED, __HIP_MEMORY_SCOPE_AGENT);
    if (KA->ph_hi - KA->ph_lo > 1) (void)xcd_barrier_post((unsigned*)(A_WS + WS_CTL) + CW_BAR + KA->li * XCD_BAR_WORDS, (volatile LAS unsigned*)(F.lds + MISC_OFF + 32));
#define IN(k) (KA->ph_lo <= (k) && (k) < KA->ph_hi)
#define FILL_BOUND(k) ((k) <= 11 ? FILL_TAIL0(F) : 0)
#define FILL_NEED(k) ((k) == 2 ? P0_E_WO : (k) == 11 ? P0_GU_END : (k) == 12 ? FILL_TAIL0(F) : 0)
#define SEAM(k) do { if (IN(k) && FILL_NEED(k) != 0) fill_items(F, FILL_NEED(k), nullptr); if ((k) == 12 && IN(12)) { if (!IN(4) || (1408 % F.G) == 0) fill_tail(F, CW_FQ4, FILL_TAIL0(F), fill_d4_end(F)); fill_tail(F, CW_FQ, fill_d4_end(F), P0_NITEMS); } \
    if ((k) == 4 && IN(4) && (1408 % F.G) != 0 && (int)blockIdx.x >= 1408 % F.G) fill_tail(F, CW_FQ4, FILL_TAIL0(F), fill_d4_end(F));     \
    if (IN(k) && IN((k) + 1)) { if (SEAM_LOCAL(k) && *(volatile LAS unsigned*)(F.lds + MISC_OFF + 52) != 0u) SEAM_NOWL(FILL_BOUND(k)); else SEAM_NOWF(FILL_BOUND(k)); } \
    if ((k) == 0 && IN(0) && IN(1)) { if (F.tid == 0) *(volatile LAS unsigned*)(F.lds + MISC_OFF + 52) = (F.G == 256 && xb_ld((unsigned*)(A_WS + WS_CTL) + CW_MAPBAD) == 0u) ? 1u : 0u; LDS_WAIT(); __syncthreads(); } } while (0)
#define SEAM_LOCAL(k) ((k) == 1 || ((k) >= 3 && (k) <= 7) || (k) == 9)
#define SEAM_NOWL(bound) xcd_local_barrier_fill(F, (unsigned*)(A_WS + WS_CTL) + CW_BAR + KA->li * XCD_BAR_WORDS, (bound))
#define SEAM_NOWF(bound) do { { XcdBarrier b_; b_.bar = (unsigned*)(A_WS + WS_CTL) + CW_BAR + KA->li * XCD_BAR_WORDS; b_.x = xb_xcc_id(); b_.st = (volatile LAS unsigned*)(F.lds + MISC_OFF + 32); xcd_barrier_fill(b_, F, (bound)); } } while (0)
#define SEAM_NOW() do { { XcdBarrier b_; b_.bar = (unsigned*)(A_WS + WS_CTL) + CW_BAR + KA->li * XCD_BAR_WORDS; b_.x = xb_xcc_id(); b_.st = (volatile LAS unsigned*)(F.lds + MISC_OFF + 32); xcd_barrier(b_); } } while (0)
#define ws A_WS
#define XB ((bf16_t*)(A_WS + WS_XB))
#define SSQ ((float*)(A_WS + WS_SSQ))

    if (IN(0)) { p0_prologue(F); } SEAM(0);
    if (IN(1)) { pg8::Gemm g{XB, (const bf16_t*)(ws + WS_W_IN), M, 3072, 1024}; pg8::StaticOrder S; S.init(M, 3072, F.G, (int)blockIdx.x);
        pg8::EpiInProj E{(bf16_t*)(ws + WS_BB), (bf16_t*)(ws + WS_UB), SSQ};
        pg8::gemm_phase<pg8::EpiInProj, pg8::StaticOrder, true, true>(F.lds + RING_OFF, g, S, E); } SEAM(1);
    if (IN(2)) { p2_conv(F); } SEAM(2);
    if (IN(3)) { pg8::Gemm g{(const bf16_t*)(ws + WS_G), (const bf16_t*)(ws + WS_W_OUT), M, 1024, 1024}; pg8::StaticOrder S; S.init(M, 1024, F.G, (int)blockIdx.x);
        pg8::EpiResidSsq<true> E{INP(0), XB, SSQ, 1.0f, ws + WS_X8};
        pg8::gemm_phase<pg8::EpiResidSsq<true>, pg8::StaticOrder, false, true>(F.lds + RING_OFF, g, S, E); } SEAM(3);
    if (IN(4)) { pg8::Gemm g{(const bf16_t*)(ws + WS_X8), (const bf16_t*)(ws + WS_W_GU), M, 5632, 512}; pg8::StaticOrder S; S.init(M, 5632, F.G, (int)blockIdx.x);
        pg8::EpiSwiGLU<true> E{ws + WS_HACT, DFF, SSQ, nullptr, 22, 1.0f / (pg8::F8_SX * pg8::F8_SWGD)};
        pg8::gemm_phase<pg8::EpiSwiGLU<true>, pg8::StaticOrder, true, true, true>(F.lds + RING_OFF, g, S, E); } SEAM(4);
    if (IN(5)) { pg8::Gemm g{(const bf16_t*)(ws + WS_HACT), (const bf16_t*)(ws + WS_W_DN), M, 1024, DFF / 2}; pg8::StaticOrder S; S.init(M, 1024, F.G, (int)blockIdx.x);
        pg8::EpiResidSsq<false> E{nullptr, XB, SSQ, 1.0f / (pg8::F8_SHD * pg8::F8_SWDD), nullptr};
        pg8::gemm_phase<pg8::EpiResidSsq<false>, pg8::StaticOrder, false, true, true>(F.lds + RING_OFF, g, S, E); } SEAM(5);
    if (IN(6)) { pg8::Gemm g{XB, (const bf16_t*)(ws + WS_W_QKV), M, 3072, 1024}; pg8::StaticOrder S; S.init(M, 3072, F.G, (int)blockIdx.x);
        pg8::EpiQKV E{(bf16_t*)(ws + WS_Q), (bf16_t*)(ws + WS_K), (bf16_t*)(ws + WS_V), SSQ, INP(10), INP(8), attn_body::C2};
        pg8::gemm_phase<pg8::EpiQKV, pg8::StaticOrder, true, true>(F.lds + RING_OFF, g, S, E); } SEAM(6);
    if (IN(7)) {
        const float* lp = INP(11); const float* sn = INP(12);
        const float lam = __expf(wave_sum(lp[F.lane] * lp[64 + F.lane])) - __expf(wave_sum(lp[128 + F.lane] * lp[192 + F.lane])) + LAM_INIT;
        LAS float* sng = (LAS float*)(F.lds + MISC_OFF + 256);
        if (F.tid < VD) sng[F.tid] = sn[F.tid] * (1.f - LAM_INIT);
        LDS_WAIT(); __syncthreads();
        for (int it = F.vcu; it < BATCH * 32; it += F.G) { const int b = it >> 5, h = (it >> 2) & 7, p = it & 3;
            attn_body::bf16* O0 = (attn_body::bf16*)(ws + WS_O0); attn_body::bf16* ONp = (attn_body::bf16*)(ws + WS_ON);
            for (int i = 0; i < 2; ++i) { const int qb = i ? 7 - p : p;
                if (i == 0) attn_body::attn_unit<-1, 0, false, true>(b, (2 * h) * 64, h * 128, qb, (const attn_body::bf16*)(ws + WS_Q), (const attn_body::bf16*)(ws + WS_K), (const attn_body::bf16*)(ws + WS_V), O0, (char*)lds + RING_OFF, nullptr, 0.f, nullptr, (2 * h + 1) * 64);
                else attn_body::attn_unit<-1, 0, true, true>(b, (2 * h) * 64, h * 128, qb, (const attn_body::bf16*)(ws + WS_Q), (const attn_body::bf16*)(ws + WS_K), (const attn_body::bf16*)(ws + WS_V), O0, (char*)lds + RING_OFF, nullptr, 0.f, nullptr, (2 * h + 1) * 64);
                if (i == 0) attn_body::attn_unit<-1, 1, true, true>(b, (2 * h + 1) * 64, h * 128, qb, (const attn_body::bf16*)(ws + WS_Q), (const attn_body::bf16*)(ws + WS_K), (const attn_body::bf16*)(ws + WS_V), O0, (char*)lds + RING_OFF, ONp, lam, (const float*)((char*)lds + MISC_OFF + 256), (2 * h) * 64);
                else attn_body::attn_unit<-1, 1, true, false>(b, (2 * h + 1) * 64, h * 128, qb, (const attn_body::bf16*)(ws + WS_Q), (const attn_body::bf16*)(ws + WS_K), (const attn_body::bf16*)(ws + WS_V), O0, (char*)lds + RING_OFF, ONp, lam, (const float*)((char*)lds + MISC_OFF + 256)); } }
    } if (IN(7) && IN(9)) { if (*(volatile LAS unsigned*)(F.lds + MISC_OFF + 52) != 0u) SEAM_NOWL(FILL_TAIL0(F)); else SEAM_NOWF(FILL_TAIL0(F)); }
    if (IN(9)) { pg8::Gemm g{(const bf16_t*)(ws + WS_ON), (const bf16_t*)(ws + WS_W_O), M, 1024, 1024}; pg8::StaticOrder S; S.init(M, 1024, F.G, (int)blockIdx.x);
        pg8::EpiResidSsq<false> E{nullptr, XB, SSQ, 1.0f, nullptr};
        pg8::gemm_phase<pg8::EpiResidSsq<false>, pg8::StaticOrder, false, true>(F.lds + RING_OFF, g, S, E); } SEAM(9);
    if (IN(10)) { p10a_router(F); } SEAM(10);
    if (IN(11)) { p10b_assign(F); } SEAM(11);
    if (IN(12)) { pg8::Gemm g{(const bf16_t*)(ws + WS_XG), (const bf16_t*)(ws + WS_W_MGU), SLOTS, 8 * 7168, 512}; pg8::MoeOrder S; S.init((const int*)(ws + WS_META), 28, F.G, (int)blockIdx.x, false);
        pg8::EpiSwiGLU8 E{ws + WS_HM, DFE, 28};
        pg8::gemm_phase<pg8::EpiSwiGLU8, pg8::MoeOrder, true, true, true>(F.lds + RING_OFF, g, S, E); } SEAM(12);
    if (IN(13)) { pg8::Gemm g{(const bf16_t*)(ws + WS_HM), (const bf16_t*)(ws + WS_W_MDN), SLOTS, 8 * 1024, DFE / 2}; pg8::MoeOrder S; S.init((const int*)(ws + WS_META), 4, F.G, (int)blockIdx.x, true);
        pg8::EpiMoeDown E{ws + WS_Y, (const float*)(ws + WS_GATES), 1.0f / (pg8::F8_SH * pg8::F8_SWD), (bf16_t*)(ws + WS_PP)};
        pg8::gemm_phase<pg8::EpiMoeDown, pg8::MoeOrder, true, true, true>(F.lds + RING_OFF, g, S, E); } SEAM(13);
    if (IN(14)) { p13_final(F); }
#undef IN
#undef SEAM
#undef SEAM_NOW
#undef SEAM_NOWF
#undef SEAM_NOWL
#undef SEAM_LOCAL
#undef ws
#undef XB
#undef SSQ
}
#ifndef MEGA_UPTO
#define MEGA_UPTO 15
#endif
#ifndef MEGA_REPMASK
#define MEGA_REPMASK 0
#endif
#ifndef MEGA_ONE
#define MEGA_ONE 1
#endif
extern "C" void kernel_launch(void* const* d_in, const int* in_sizes, int n_in, void* d_out, int out_size, void* d_ws, size_t ws_size, hipStream_t stream) {
    static int grid = 0;
    if (grid == 0) {
        if (n_in != 19 || in_sizes[0] != M * D || out_size != M * D || ws_size < WS_END) { fprintf(stderr, "kernel_launch: unexpected shapes / workspace (%d inputs, ws %zu, need %zu)\n", n_in, ws_size, (size_t)WS_END); grid = -1; return; }
        int dev = 0, cus = 0, per_cu = 0;
        if (hipGetDevice(&dev) != hipSuccess || hipDeviceGetAttribute(&cus, hipDeviceAttributeMultiprocessorCount, dev) != hipSuccess) { grid = -1; return; }
        if (hipFuncSetAttribute((const void*)mega_fwd, hipFuncAttributeMaxDynamicSharedMemorySize, LDS_BYTES) != hipSuccess) { fprintf(stderr, "kernel_launch: hipFuncSetAttribute failed\n"); grid = -1; return; }
        if (hipOccupancyMaxActiveBlocksPerMultiprocessor(&per_cu, (const void*)mega_fwd, NWAVES * 64, LDS_BYTES) != hipSuccess || per_cu < 1) fprintf(stderr, "kernel_launch: note: occupancy query says %d\n", per_cu);
        (void)hipGetLastError();
        grid = cus < 256 ? cus : 256;
        if (grid != 256) fprintf(stderr, "kernel_launch: %d CUs; this kernel is built for 256\n", cus);
    }
    if (grid < 0) return;
    unsigned char* ws = (unsigned char*)d_ws; float* out = (float*)d_out;
    constexpr int UPTO = MEGA_UPTO;
    static_assert(UPTO == 15, "the plain reference kernels of the transition builds are gone: all 15 phases run in the persistent kernel");
    if (UPTO > 0) {
        if (hipMemsetAsync(ws + WS_CTL, 0, CTL_ZERO_BYTES, stream) != hipSuccess) { fprintf(stderr, "kernel_launch: memset failed\n"); return; }
        Args a{};
        for (int i = 0; i < 19; ++i) a.in[i] = (const float*)d_in[i];
        a.out = out; a.wsp = ws;
        if (MEGA_ONE) { a.ph_lo = 0; a.ph_hi = UPTO; a.li = 0; hipLaunchKernelGGL(mega_fwd, dim3(grid), dim3(NWAVES * 64), LDS_BYTES, stream, a); }
        else for (int p = 0; p < UPTO; ++p) { a.ph_lo = p; a.ph_hi = p + 1; a.li = 0; for (int r = 0; r <= ((MEGA_REPMASK >> p) & 1); ++r) hipLaunchKernelGGL(mega_fwd, dim3(grid), dim3(NWAVES * 64), LDS_BYTES, stream, a); }
        const hipError_t le = hipPeekAtLastError();
        if (le != hipSuccess) fprintf(stderr, "kernel_launch: launch failed: %s\n", hipGetErrorName(le));
    }
}
```

```cpp
#include <hip/hip_runtime.h>
#include <hip/hip_bf16.h>
#include <stdint.h>
#include <stdio.h>
#include <cmath>
#define MEGA_UPTO 15
#define MEGA_ONE 1
typedef unsigned short bf16_t;
typedef short bf16x8 __attribute__((ext_vector_type(8)));
typedef float f32x4 __attribute__((ext_vector_type(4)));
constexpr int D = 1024, BATCH = 8, SEQ = 2048, M = BATCH * SEQ;
constexpr int NH = 8, HD = 64, VD = 128;
constexpr int DFF = 2816, NE = 8, DFE = 3584;
constexpr float EPS = 1e-6f;
constexpr float LAM_INIT = 0.35550907f;
constexpr int SLOTS = 2 * M + NE * 256;

__device__ __forceinline__ unsigned f2bf(float f) { unsigned u = __builtin_bit_cast(unsigned, f); return (u + 0x7fffu + ((u >> 16) & 1u)) >> 16; }
__device__ __forceinline__ float bf2f(unsigned short b) { return __builtin_bit_cast(float, (unsigned)b << 16); }
__device__ __forceinline__ float wave_sum(float v) {
#pragma unroll
    for (int o = 1; o < 64; o <<= 1) v += __shfl_xor(v, o);
    return v;
}

namespace pg8 {
#define PG8_LAS __attribute__((address_space(3)))
typedef unsigned short bf16_t;
typedef short bf16x8 __attribute__((ext_vector_type(8)));
typedef float f32x4 __attribute__((ext_vector_type(4)));
typedef unsigned u32x4 __attribute__((ext_vector_type(4)));
typedef int i32x4 __attribute__((ext_vector_type(4)));
typedef int i32x8 __attribute__((ext_vector_type(8)));
constexpr int BM = 256, BK = 64, HALF = 128, HTB = HALF * BK * 2  , STAGE_BYTES = 8 * HTB, NXCD = 8, WGM = 8;

__host__ __device__ __forceinline__ int lds_byte(int r, int c) { const int st = (r >> 4) * 2 + (c >> 5), rr = r & 15, cc = c & 31, ob = rr * 64 + cc * 2; return st * 1024 + (ob ^ (((ob >> 9) & 1) << 5)); }
__host__ __device__ __forceinline__ void stage_rc(int b, int& R, int& C) { const int st = b / 1024, sb = b % 1024, swz = sb ^ (((sb >> 9) & 1) << 5); R = (st >> 1) * 16 + swz / 64; C = (st & 1) * 32 + (swz % 64) / 2; }
__host__ __device__ __forceinline__ int perm32(int rho) { const int n = rho >> 4, i = rho & 15; return 8 * (i >> 2) + 4 * n + (i & 3); }

struct Unit { int pm, pn; int kt0, nkt, aux; };
struct Gemm { const bf16_t* A; const bf16_t* Bt; int M, N, K; };

struct StaticOrder {
    int nM, nN, nwg, G, c;
    __host__ __device__ void init(int M, int N, int G_, int c_) { nM = M / BM; nN = N / BM; nwg = nM * nN; G = G_; c = c_; }
    __host__ __device__ bool next(int i, Unit& u) const {
        const long L = (long)i * G + c; if (L >= nwg) return false;
        int wgid = (int)L; { const int q = nwg / NXCD, r = nwg % NXCD, xcd = wgid % NXCD, off = wgid / NXCD; wgid = (xcd < r ? xcd * (q + 1) : r * (q + 1) + (xcd - r) * q) + off; }
        const int nig = WGM * nN, gid = wgid / nig, fm = gid * WGM, gsz = (nM - fm) < WGM ? (nM - fm) : WGM;
        u.pm = fm + ((wgid % nig) % gsz); u.pn = (wgid % nig) / gsz; u.kt0 = 0; u.nkt = 0; u.aux = -1; return true;
    }
    __device__ __forceinline__ void a_ready(const Unit&) const {}
    __device__ __forceinline__ void done(const Unit&) const {}
};

__device__ __forceinline__ unsigned cvt_pk_bf16(float lo, float hi) { unsigned r; asm volatile("v_cvt_pk_bf16_f32 %0, %1, %2" : "=v"(r) : "v"(lo), "v"(hi)); return r; }
typedef float f32x2 __attribute__((ext_vector_type(2)));
#ifndef PG8_WT
#define PG8_WT 0
#endif
__device__ __forceinline__ void st16_wt(void* p, u32x4 v) {
#if PG8_WT
    asm volatile("global_store_dwordx4 %0, %1, off sc1\n\ts_nop 1" :: "v"(p), "v"(v) : "memory");
#else
    *(u32x4*)p = v;
#endif
}
__device__ __forceinline__ void st8_wt(void* p, unsigned x, unsigned y) {
#if PG8_WT
    typedef unsigned u32x2_ __attribute__((ext_vector_type(2))); const u32x2_ v = {x, y};
    asm volatile("global_store_dwordx2 %0, %1, off sc1\n\ts_nop 1" :: "v"(p), "v"(v) : "memory");
#else
    typedef unsigned u32x2_ __attribute__((ext_vector_type(2))); *(u32x2_*)p = (u32x2_){x, y};
#endif
}
typedef unsigned u32x2 __attribute__((ext_vector_type(2)));
constexpr float RMS_EPS = 1e-6f, LOG2E = 1.4426950408889634f;
constexpr int DM_ = 1024;
__device__ __forceinline__ u32x4 pack8(const f32x4 a, const f32x4 b) { u32x4 w; w.x = cvt_pk_bf16(a[0], a[1]); w.y = cvt_pk_bf16(a[2], a[3]); w.z = cvt_pk_bf16(b[0], b[1]); w.w = cvt_pk_bf16(b[2], b[3]); return w; }
__device__ __forceinline__ float rstd_of(const float* ssq, int row) { const f32x4 p = *(const f32x4*)(ssq + (size_t)row * 4); return __builtin_amdgcn_rsqf(((p[0] + p[1]) + (p[2] + p[3])) * (1.0f / 1024.0f) + RMS_EPS); }
__device__ __forceinline__ float silu_mul(float g, float u) { return g * u * __builtin_amdgcn_rcpf(1.0f + __builtin_amdgcn_exp2f(-g * LOG2E)); }
__device__ __forceinline__ f32x2 swiglu2(f32x2 a, f32x2 b, float c1, float k) {
    const f32x2 t = a * c1; f32x2 e; e.x = __builtin_amdgcn_exp2f(t.x); e.y = __builtin_amdgcn_exp2f(t.y);
    const f32x2 d = e * k + k; f32x2 r; r.x = __builtin_amdgcn_rcpf(d.x); r.y = __builtin_amdgcn_rcpf(d.y);
    return (a * b) * r;
}

__device__ __forceinline__ float clamp448(float x) { return __builtin_amdgcn_fmed3f(x, -448.0f, 448.0f); }
__device__ __forceinline__ unsigned pk4_fp8(float a, float b, float c, float d) { int w = 0; w = __builtin_amdgcn_cvt_pk_fp8_f32(clamp448(a), clamp448(b), w, false); w = __builtin_amdgcn_cvt_pk_fp8_f32(clamp448(c), clamp448(d), w, true); return (unsigned)w; }
constexpr float F8_SA = 4.0f, F8_SWG = 256.0f, F8_SH = 8.0f, F8_SWD = 512.0f;
constexpr float F8_SY = 64.0f;
constexpr float F8_SHD = 8.0f, F8_SWDD = 256.0f, F8_SX = 4.0f, F8_SWGD = 256.0f;

struct EpiInProj {
    static constexpr bool PERM = true, AFTER_DRAIN = false;
    bf16_t* Bb; bf16_t* Ub; const float* ssq;
    __device__ __forceinline__ void operator()(const f32x4 (&acc)[2][2][4][2], const Unit& u, int wr, int wc, int fr, int fq) const {
        const int row0 = u.pm * BM + wr * 64 + fr;
        float rsv[2][4];
#pragma unroll
        for (int ai = 0; ai < 2; ++ai)
#pragma unroll
            for (int m = 0; m < 4; ++m) rsv[ai][m] = rstd_of(ssq, row0 + ai * HALF + m * 16);
        if (u.pn < 4) {
            const int col0 = u.pn * BM + wc * 32 + 8 * fq;
#pragma unroll
            for (int ai = 0; ai < 2; ++ai)
#pragma unroll
                for (int m = 0; m < 4; ++m) { bf16_t* rowp = Bb + (size_t)(row0 + ai * HALF + m * 16) * DM_ + col0;
#pragma unroll
                    for (int bj = 0; bj < 2; ++bj) st16_wt(rowp + bj * HALF, pack8(acc[ai][bj][m][0] * rsv[ai][m], acc[ai][bj][m][1] * rsv[ai][m])); }
        } else {
            const int col0 = (u.pn - 4) * 128 + wc * 32 + 8 * fq;
#pragma unroll
            for (int ai = 0; ai < 2; ++ai)
#pragma unroll
                for (int m = 0; m < 4; ++m) { bf16_t* rowp = Ub + (size_t)(row0 + ai * HALF + m * 16) * DM_ + col0;
                    const float r2 = rsv[ai][m] * rsv[ai][m]; st16_wt(rowp, pack8(acc[ai][0][m][0] * acc[ai][1][m][0] * r2, acc[ai][0][m][1] * acc[ai][1][m][1] * r2)); }
        }
    }
};

template <bool FIRST> struct EpiResidSsq {
    static constexpr bool PERM = true, AFTER_DRAIN = true;
    const float* x0; bf16_t* xb; float* ssq; float ascale; unsigned char* x8;
    __device__ __forceinline__ void fused(f32x4 (&acc)[2][2][4][2], const Unit& u, int wr, int wc, int fr, int fq, PG8_LAS unsigned char* lds, int wid, int lane) const {
        PG8_LAS float* P = (PG8_LAS float*)lds;
        const int col0 = u.pn * BM + wc * 32 + 8 * fq;
#pragma unroll
        for (int ai = 0; ai < 2; ++ai) {
            f32x4 xo[4][2][2];
#pragma unroll
            for (int m = 0; m < 4; ++m) { const int r = ai * HALF + wr * 64 + m * 16 + fr; const size_t off = (size_t)(u.pm * BM + r) * DM_ + col0;
#pragma unroll
                for (int bj = 0; bj < 2; ++bj) {
                    { const u32x4 w = *(const u32x4*)(xb + off + bj * HALF);
                        xo[m][bj][0] = (f32x4){__builtin_bit_cast(float, w.x << 16), __builtin_bit_cast(float, w.x & 0xffff0000u), __builtin_bit_cast(float, w.y << 16), __builtin_bit_cast(float, w.y & 0xffff0000u)};
                        xo[m][bj][1] = (f32x4){__builtin_bit_cast(float, w.z << 16), __builtin_bit_cast(float, w.z & 0xffff0000u), __builtin_bit_cast(float, w.w << 16), __builtin_bit_cast(float, w.w & 0xffff0000u)}; } } }
#pragma unroll
            for (int m = 0; m < 4; ++m) { const int r = ai * HALF + wr * 64 + m * 16 + fr; const size_t off = (size_t)(u.pm * BM + r) * DM_ + col0; float s = 0.f;
#pragma unroll
                for (int bj = 0; bj < 2; ++bj) { const f32x4 v0 = xo[m][bj][0] + acc[ai][bj][m][0] * ascale, v1 = xo[m][bj][1] + acc[ai][bj][m][1] * ascale;
                    st16_wt(xb + off + bj * HALF, pack8(v0, v1));
                    if constexpr (FIRST) { u32x2 w; w.x = pk4_fp8(v0[0] * F8_SX, v0[1] * F8_SX, v0[2] * F8_SX, v0[3] * F8_SX); w.y = pk4_fp8(v1[0] * F8_SX, v1[1] * F8_SX, v1[2] * F8_SX, v1[3] * F8_SX); st8_wt(x8 + off + bj * HALF, w.x, w.y); }
                    s += ((v0[0] * v0[0] + v0[1] * v0[1]) + (v0[2] * v0[2] + v0[3] * v0[3])) + ((v1[0] * v1[0] + v1[1] * v1[1]) + (v1[2] * v1[2] + v1[3] * v1[3])); }
                s += __shfl_xor(s, 16); s += __shfl_xor(s, 32);
                if (fq == 0) P[r * 4 + wc] = s; }
            asm volatile("" ::: "memory"); }
        asm volatile("s_waitcnt lgkmcnt(0)" ::: "memory"); __builtin_amdgcn_s_barrier(); asm volatile("" ::: "memory");
        const int t = wid * 64 + lane;
        if (t < 256) { const PG8_LAS f32x4* Pr = (const PG8_LAS f32x4*)lds; const f32x4 p = Pr[t]; ssq[(size_t)(u.pm * BM + t) * 4 + u.pn] = (p[0] + p[1]) + (p[2] + p[3]); }
        asm volatile("s_waitcnt lgkmcnt(0)" ::: "memory"); __builtin_amdgcn_s_barrier(); asm volatile("" ::: "memory");
    }
};

template <bool OUT8> struct EpiSwiGLU {
    static constexpr bool PERM = true, AFTER_DRAIN = false;
    void* H; int ldh; const float* ssq; const float* rstd; int ncol; float cs;
    __device__ __forceinline__ void operator()(const f32x4 (&acc)[2][2][4][2], const Unit& u, int wr, int wc, int fr, int fq) const {
        const int row0 = u.pm * BM + wr * 64 + fr, col0 = (u.pn % ncol) * 128 + wc * 32 + 8 * fq;
        float kk[2][4];
#pragma unroll
        for (int ai = 0; ai < 2; ++ai)
#pragma unroll
            for (int m = 0; m < 4; ++m) { const int row = row0 + ai * HALF + m * 16;
                if (ssq) { const f32x4 p = *(const f32x4*)(ssq + (size_t)row * 4); kk[ai][m] = ((p[0] + p[1]) + (p[2] + p[3])) * (1.0f / 1024.0f) + RMS_EPS; } else { const float r_ = rstd[row]; kk[ai][m] = 1.0f / (r_ * r_); } }
#pragma unroll
        for (int ai = 0; ai < 2; ++ai)
#pragma unroll
            for (int m = 0; m < 4; ++m) { const int row = row0 + ai * HALF + m * 16;
                float k = kk[ai][m];
                const float c1 = -LOG2E * cs * __builtin_amdgcn_rsqf(k); k = k / (cs * cs);
                f32x4 h[2];
#pragma unroll
                for (int n = 0; n < 2; ++n) { const f32x4 a = acc[ai][0][m][n], b = acc[ai][1][m][n];
                    const f32x2 h0 = swiglu2((f32x2){a[0], a[1]}, (f32x2){b[0], b[1]}, c1, k), h1 = swiglu2((f32x2){a[2], a[3]}, (f32x2){b[2], b[3]}, c1, k);
                    h[n] = (f32x4){h0.x, h0.y, h1.x, h1.y}; }
                if constexpr (OUT8) { u32x2 w; w.x = pk4_fp8(h[0][0] * F8_SHD, h[0][1] * F8_SHD, h[0][2] * F8_SHD, h[0][3] * F8_SHD); w.y = pk4_fp8(h[1][0] * F8_SHD, h[1][1] * F8_SHD, h[1][2] * F8_SHD, h[1][3] * F8_SHD);
                    st8_wt((unsigned char*)H + (size_t)row * ldh + col0, w.x, w.y); }
                else st16_wt((bf16_t*)H + (size_t)row * ldh + col0, pack8(h[0], h[1])); }
    }
};

struct EpiQKV {
    static constexpr bool PERM = true, AFTER_DRAIN = false;
    bf16_t *Q, *K, *V; const float* ssq; const float* qg; const float* kg; float qscale;
    __device__ __forceinline__ void operator()(const f32x4 (&acc)[2][2][4][2], const Unit& u, int wr, int wc, int fr, int fq) const {
        const int row0 = u.pm * BM + wr * 64 + fr;
        float rsv[2][4];
#pragma unroll
        for (int ai = 0; ai < 2; ++ai)
#pragma unroll
            for (int m = 0; m < 4; ++m) rsv[ai][m] = rstd_of(ssq, row0 + ai * HALF + m * 16);
        if (u.pn < 8) {
            const bool isq = u.pn < 4; bf16_t* base = isq ? Q : K; const float* gn = isq ? qg : kg; const float sc = isq ? qscale : 1.0f;
            const int col0 = (4 * (u.pn & 3) + wc) * 64 + 8 * fq;
            f32x4 gv[2][2];
#pragma unroll
            for (int bj = 0; bj < 2; ++bj)
#pragma unroll
                for (int n = 0; n < 2; ++n) gv[bj][n] = *(const f32x4*)(gn + 32 * bj + 8 * fq + 4 * n);
#pragma unroll
            for (int ai = 0; ai < 2; ++ai)
#pragma unroll
                for (int m = 0; m < 4; ++m) { const int row = row0 + ai * HALF + m * 16; const float rs = rsv[ai][m];
                    f32x4 v[2][2]; float ss = 0.f;
#pragma unroll
                    for (int bj = 0; bj < 2; ++bj)
#pragma unroll
                        for (int n = 0; n < 2; ++n) { v[bj][n] = acc[ai][bj][m][n] * rs; ss += (v[bj][n][0] * v[bj][n][0] + v[bj][n][1] * v[bj][n][1]) + (v[bj][n][2] * v[bj][n][2] + v[bj][n][3] * v[bj][n][3]); }
                    ss += __shfl_xor(ss, 16); ss += __shfl_xor(ss, 32);
                    const float r2 = __builtin_amdgcn_rsqf(ss * (1.0f / 64.0f) + RMS_EPS) * sc;
#pragma unroll
                    for (int bj = 0; bj < 2; ++bj) st16_wt(base + (size_t)row * DM_ + col0 + 32 * bj, pack8(v[bj][0] * r2 * gv[bj][0], v[bj][1] * r2 * gv[bj][1])); }
        } else {
            const int col0 = (u.pn - 8) * BM + wc * 32 + 8 * fq;
#pragma unroll
            for (int ai = 0; ai < 2; ++ai)
#pragma unroll
                for (int m = 0; m < 4; ++m) { const int row = row0 + ai * HALF + m * 16; const float rs = rsv[ai][m];
#pragma unroll
                    for (int bj = 0; bj < 2; ++bj) st16_wt(V + (size_t)row * DM_ + col0 + bj * HALF, pack8(acc[ai][bj][m][0] * rs, acc[ai][bj][m][1] * rs)); }
        }
    }
};

struct EpiSwiGLU8 {
    static constexpr bool PERM = true, AFTER_DRAIN = false;
    unsigned char* H; int ldh; int ncol;
    __device__ __forceinline__ void operator()(const f32x4 (&acc)[2][2][4][2], const Unit& u, int wr, int wc, int fr, int fq) const {
        const int row0 = u.pm * BM + wr * 64 + fr, col0 = (u.pn % ncol) * 128 + wc * 32 + 8 * fq; constexpr float cs = 1.0f / (F8_SA * F8_SWG);
#pragma unroll
        for (int ai = 0; ai < 2; ++ai)
#pragma unroll
            for (int m = 0; m < 4; ++m) { const int row = row0 + ai * HALF + m * 16; f32x4 h[2];
#pragma unroll
                for (int n = 0; n < 2; ++n) { const f32x4 a = acc[ai][0][m][n], b = acc[ai][1][m][n];
                    const f32x2 h0 = swiglu2((f32x2){a[0], a[1]}, (f32x2){b[0], b[1]}, -cs * LOG2E, 1.0f / (cs * cs * F8_SH)), h1 = swiglu2((f32x2){a[2], a[3]}, (f32x2){b[2], b[3]}, -cs * LOG2E, 1.0f / (cs * cs * F8_SH));
                    h[n] = (f32x4){h0.x, h0.y, h1.x, h1.y}; }
                u32x2 w; w.x = pk4_fp8(h[0][0], h[0][1], h[0][2], h[0][3]); w.y = pk4_fp8(h[1][0], h[1][1], h[1][2], h[1][3]);
                st8_wt(H + (size_t)row * ldh + col0, w.x, w.y); }
    }
};

struct EpiMoeDown {
    static constexpr bool PERM = true, AFTER_DRAIN = false;
    unsigned char* Y; const float* gate; float scale; bf16_t* Pp;
    __device__ __forceinline__ void operator()(const f32x4 (&acc)[2][2][4][2], const Unit& u, int wr, int wc, int fr, int fq) const {
        const int col0 = (u.pn & 3) * BM + wc * 32 + 8 * fq;
        if (u.aux >= 0) {
            bf16_t* base = Pp + ((size_t)u.aux * BM + wr * 64 + fr) * DM_ + col0;
#pragma unroll
            for (int ai = 0; ai < 2; ++ai)
#pragma unroll
                for (int m = 0; m < 4; ++m)
#pragma unroll
                    for (int bj = 0; bj < 2; ++bj) st16_wt(base + (size_t)(ai * HALF + m * 16) * DM_ + bj * HALF, pack8(acc[ai][bj][m][0] * scale, acc[ai][bj][m][1] * scale));
            return; }
        const int row0 = u.pm * BM + wr * 64 + fr;
        float gv[2][4];
#pragma unroll
        for (int ai = 0; ai < 2; ++ai)
#pragma unroll
            for (int m = 0; m < 4; ++m) gv[ai][m] = gate[row0 + ai * HALF + m * 16] * (scale * F8_SY);
#pragma unroll
        for (int ai = 0; ai < 2; ++ai)
#pragma unroll
            for (int m = 0; m < 4; ++m) { const int row = row0 + ai * HALF + m * 16; const float gt = gv[ai][m];
#pragma unroll
                for (int bj = 0; bj < 2; ++bj) { const f32x4 y0 = acc[ai][bj][m][0] * gt, y1 = acc[ai][bj][m][1] * gt; st8_wt(Y + (size_t)row * DM_ + col0 + bj * HALF, pk4_fp8(y0[0], y0[1], y0[2], y0[3]), pk4_fp8(y1[0], y1[1], y1[2], y1[3])); } }
    }
};

struct MoeOrder {
    int nM, nN, nwg, G, c, T, P0, npieces; int t1, t2, t3, t4, t5, t6, t7;
    static constexpr int SPL = 7, PKT = 4;
    __device__ __forceinline__ void init(const int* meta, int nN_, int G_, int c_, bool split) {
        T = meta[8]; nM = split ? meta[9] : T; nN = nN_; nwg = nM * nN; G = G_; c = c_; t1 = meta[1]; t2 = meta[2]; t3 = meta[3]; t4 = meta[4]; t5 = meta[5]; t6 = meta[6]; t7 = meta[7];
        P0 = ((nwg + G - 1) / G) * G; npieces = (T - nM) * nN * SPL; }
    __device__ __forceinline__ int expert_of(int pm) const { return (pm >= t1) + (pm >= t2) + (pm >= t3) + (pm >= t4) + (pm >= t5) + (pm >= t6) + (pm >= t7); }
    __device__ __forceinline__ bool next(int i, Unit& u) const {
        const long L = (long)i * G + c;
        if (L >= nwg) { const long q = L - P0; if (q < 0 || q >= npieces) return false;
            const int rt = (int)q / (nN * SPL), rem = (int)q % (nN * SPL), pnl = rem / SPL, kp = rem % SPL;
            u.pm = nM + rt; u.pn = expert_of(u.pm) * nN + pnl; u.kt0 = kp * PKT; u.nkt = PKT; u.aux = rt * SPL + kp; return true; }
        int wgid = (int)L; { const int q = nwg / NXCD, r = nwg % NXCD, xcd = wgid % NXCD, off = wgid / NXCD; wgid = (xcd < r ? xcd * (q + 1) : r * (q + 1) + (xcd - r) * q) + off; }
        const int nig = WGM * nN, gid = wgid / nig, fm = gid * WGM, gsz = (nM - fm) < WGM ? (nM - fm) : WGM;
        const int pm = fm + ((wgid % nig) % gsz), pnl = (wgid % nig) / gsz;
        u.pm = pm; u.pn = expert_of(pm) * nN + pnl; u.kt0 = 0; u.nkt = 0; u.aux = -1; return true;
    }
    __device__ __forceinline__ void a_ready(const Unit&) const {}
    __device__ __forceinline__ void done(const Unit&) const {}
};
template <class Epi, class Sched, bool ALIGN_EPI = false, bool SP2 = false, bool F8 = false>
__device__ __forceinline__ void gemm_phase(PG8_LAS unsigned char* lds, const Gemm g, const Sched& S, const Epi& E) {
    const int tid = threadIdx.x, wid = __builtin_amdgcn_readfirstlane(tid >> 6), lane = tid & 63, wr = wid >> 2, wc = wid & 3, fr = lane & 15, fq = lane >> 4;
    int K_ = g.K; asm volatile("" : "+s"(K_));
    const int K = K_, nt = K / BK;
    unsigned voffA[2], voffB[2];
#pragma unroll
    for (int i = 0; i < 2; ++i) { int R, C; stage_rc(tid * 16 + i * 8192, R, C); const int Rb = Epi::PERM ? ((R & ~31) + perm32(R & 31)) : R;
        voffA[i] = (unsigned)(R * K + C) * 2u; voffB[i] = (unsigned)(Rb * K + C) * 2u; }
    const size_t kstep = (size_t)(BK * 2);
    const size_t hstep = (size_t)HALF * K * 2;
    const size_t tstep = 2 * hstep;
    const unsigned ldsw = (unsigned)wid * 1024u;
    const int aoff = lds_byte(wr * 64 + fr, fq * 8), boff = lds_byte(wc * 32 + fr, fq * 8);
    constexpr int KSTEP = 1024;
#define PG8_SA(b, h) (((b) * 2 + (h)) * HTB)
#define PG8_SB(b, h) ((4 + (b) * 2 + (h)) * HTB)
#define PG8_STAGE(bufoff, gbase, voff) do { _Pragma("unroll") for (int _i = 0; _i < 2; ++_i) \
        __builtin_amdgcn_global_load_lds((const unsigned*)((const char*)(gbase) + (voff)[_i]), (PG8_LAS unsigned*)(lds + (bufoff) + ldsw + _i * 8192), 16, 0, 0); } while (0)
#define PG8_LDA(dst, b, h) do { _Pragma("unroll") for (int m = 0; m < 4; ++m) _Pragma("unroll") for (int k = 0; k < 2; ++k) dst[m][k] = *(const PG8_LAS bf16x8*)(lds + PG8_SA(b, h) + aoff + m * 2048 + k * KSTEP); } while (0)
#define PG8_LDB(dst, b, h) do { _Pragma("unroll") for (int n = 0; n < 2; ++n) _Pragma("unroll") for (int k = 0; k < 2; ++k) dst[n][k] = *(const PG8_LAS bf16x8*)(lds + PG8_SB(b, h) + boff + n * 2048 + k * KSTEP); } while (0)
#define PG8_CAT8(x) __builtin_shufflevector(__builtin_bit_cast(i32x4, (x)[0]), __builtin_bit_cast(i32x4, (x)[1]), 0, 1, 2, 3, 4, 5, 6, 7)
#define PG8_MMA(ai, bj, At, Bt) do { __builtin_amdgcn_s_setprio(1); _Pragma("unroll") for (int m = 0; m < 4; ++m) _Pragma("unroll") for (int n = 0; n < 2; ++n) { \
        if constexpr (F8) asm volatile("s_nop 1\n\tv_mfma_f32_16x16x128_f8f6f4 %0, %1, %2, %0" : "+v"(acc[ai][bj][m][n]) : "v"(PG8_CAT8(Bt[n])), "v"(PG8_CAT8(At[m]))); \
        else { _Pragma("unroll") for (int k = 0; k < 2; ++k) acc[ai][bj][m][n] = __builtin_amdgcn_mfma_f32_16x16x32_bf16(Bt[n][k], At[m][k], acc[ai][bj][m][n], 0, 0, 0); } } \
        __builtin_amdgcn_s_setprio(0); } while (0)
#define PG8_MMA0(ai, bj, At, Bt) do { __builtin_amdgcn_s_setprio(1); _Pragma("unroll") for (int m = 0; m < 4; ++m) _Pragma("unroll") for (int n = 0; n < 2; ++n) \
        asm volatile("s_nop 1\n\tv_mfma_f32_16x16x128_f8f6f4 %0, %1, %2, 0" : "=&v"(acc[ai][bj][m][n]) : "v"(PG8_CAT8(Bt[n])), "v"(PG8_CAT8(At[m]))); \
        __builtin_amdgcn_s_setprio(0); } while (0)
#define PG8_MMAF(ai, bj, At, Bt) do { if constexpr (F8) { if (t == 0) PG8_MMA0(ai, bj, At, Bt); else PG8_MMA(ai, bj, At, Bt); } else PG8_MMA(ai, bj, At, Bt); } while (0)
#define PG8_WAIT_V(n) asm volatile("s_waitcnt vmcnt(" #n ")" ::: "memory")
#define PG8_WAIT_L(n) asm volatile("s_waitcnt lgkmcnt(" #n ")" ::: "memory")
#define PG8_BAR __builtin_amdgcn_s_barrier()
#define PG8_SCHED __builtin_amdgcn_sched_barrier(0)
    Unit cur, nxt; int ui = 0;
    if (!S.next(0, cur)) return;
    f32x4 acc[2][2][4][2];
    if constexpr (!F8) {
#pragma unroll
    for (int a = 0; a < 2; ++a)
#pragma unroll
        for (int b = 0; b < 2; ++b)
#pragma unroll
            for (int m = 0; m < 4; ++m)
#pragma unroll
                for (int n = 0; n < 2; ++n) acc[a][b][m][n] = (f32x4){0.f, 0.f, 0.f, 0.f};
    }
    bf16x8 At[4][2], B0[2][2], B1[2][2];
    const char* cA = (const char*)g.A + (size_t)cur.pm * tstep + (size_t)cur.kt0 * kstep; const char* cB = (const char*)g.Bt + (size_t)cur.pn * tstep + (size_t)cur.kt0 * kstep;
    S.a_ready(cur);
    if constexpr (SP2) {
        PG8_STAGE(PG8_SB(0, 0), cB, voffB); PG8_STAGE(PG8_SB(0, 1), cB + hstep, voffB); PG8_STAGE(PG8_SA(0, 0), cA, voffA); PG8_STAGE(PG8_SA(0, 1), cA + hstep, voffA);
        if (wr == 1) PG8_BAR;
        PG8_WAIT_V(2); PG8_BAR;
        PG8_STAGE(PG8_SB(1, 0), cB + kstep, voffB); PG8_STAGE(PG8_SA(1, 0), cA + kstep, voffA); PG8_STAGE(PG8_SB(1, 1), cB + hstep + kstep, voffB);
        PG8_WAIT_V(6); PG8_BAR;
    } else {
        PG8_STAGE(PG8_SB(0, 0), cB, voffB); PG8_STAGE(PG8_SA(0, 0), cA, voffA); PG8_STAGE(PG8_SB(0, 1), cB + hstep, voffB); PG8_STAGE(PG8_SA(0, 1), cA + hstep, voffA);
        if (wr == 1) PG8_BAR;
        PG8_WAIT_V(4); PG8_BAR;
        PG8_STAGE(PG8_SB(1, 0), cB + kstep, voffB); PG8_STAGE(PG8_SA(1, 0), cA + kstep, voffA); PG8_STAGE(PG8_SB(1, 1), cB + hstep + kstep, voffB);
        PG8_WAIT_V(6); PG8_BAR;
    }
    for (;;) {
        const bool has_next = S.next(ui + 1, nxt);
        const char* nA = has_next ? (const char*)g.A + (size_t)nxt.pm * tstep + (size_t)nxt.kt0 * kstep : cA; const char* nB = has_next ? (const char*)g.Bt + (size_t)nxt.pn * tstep + (size_t)nxt.kt0 * kstep : cB;
        const int ntu = cur.nkt ? cur.nkt : nt;
        for (int t = 0; t < ntu; t += 2) {
            const bool last = (t == ntu - 2);
            const char* a1 = cA + (size_t)(t + 1) * kstep;
            const char* a2 = last ? nA : cA + (size_t)(t + 2) * kstep; const char* b2 = last ? nB : cB + (size_t)(t + 2) * kstep;
            const char* a3 = a2 + kstep; const char* b3 = b2 + kstep;
            if (last && has_next) S.a_ready(nxt);
            if constexpr (SP2) {
            PG8_LDB(B0, 0, 0); PG8_LDB(B1, 0, 1); PG8_SCHED; PG8_LDA(At, 0, 0); PG8_STAGE(PG8_SA(1, 1), a1 + hstep, voffA);
            PG8_WAIT_V(8); PG8_WAIT_L(0); PG8_BAR; PG8_MMAF(0, 0, At, B0); PG8_MMAF(0, 1, At, B1); PG8_BAR; PG8_SCHED;
            PG8_LDA(At, 0, 1); PG8_STAGE(PG8_SB(0, 0), b2, voffB); PG8_STAGE(PG8_SB(0, 1), b2 + hstep, voffB); PG8_STAGE(PG8_SA(0, 0), a2, voffA);
            PG8_WAIT_V(8); PG8_WAIT_L(0); PG8_BAR; PG8_MMAF(1, 0, At, B0); PG8_MMAF(1, 1, At, B1); PG8_BAR; PG8_SCHED;
            PG8_LDB(B0, 1, 0); PG8_LDB(B1, 1, 1); PG8_SCHED; PG8_LDA(At, 1, 0); PG8_STAGE(PG8_SA(0, 1), a2 + hstep, voffA);
            PG8_WAIT_V(8); PG8_WAIT_L(0); PG8_BAR; PG8_MMA(0, 0, At, B0); PG8_MMA(0, 1, At, B1); PG8_BAR; PG8_SCHED;
            PG8_LDA(At, 1, 1); PG8_STAGE(PG8_SB(1, 0), b3, voffB); PG8_STAGE(PG8_SB(1, 1), b3 + hstep, voffB); PG8_STAGE(PG8_SA(1, 0), a3, voffA);
            PG8_WAIT_V(8); PG8_WAIT_L(0); PG8_BAR; PG8_MMA(1, 0, At, B0); PG8_MMA(1, 1, At, B1); PG8_BAR; PG8_SCHED;
            } else {
            PG8_LDB(B0, 0, 0); PG8_SCHED; PG8_LDA(At, 0, 0); PG8_STAGE(PG8_SA(1, 1), a1 + hstep, voffA);
            PG8_WAIT_L(8); PG8_BAR; PG8_WAIT_L(0); PG8_MMAF(0, 0, At, B0); PG8_BAR; PG8_SCHED;
            PG8_LDB(B1, 0, 1); PG8_STAGE(PG8_SB(0, 0), b2, voffB);
            PG8_BAR; PG8_WAIT_L(0); PG8_MMAF(0, 1, At, B1); PG8_BAR;
            PG8_LDA(At, 0, 1); PG8_STAGE(PG8_SA(0, 0), a2, voffA);
            PG8_BAR; PG8_WAIT_L(0); PG8_MMAF(1, 0, At, B0); PG8_BAR; PG8_SCHED;
            PG8_STAGE(PG8_SB(0, 1), b2 + hstep, voffB);
            PG8_WAIT_V(6); PG8_BAR; PG8_MMAF(1, 1, At, B1); PG8_BAR;
            PG8_LDB(B0, 1, 0); PG8_SCHED; PG8_LDA(At, 1, 0); PG8_STAGE(PG8_SA(0, 1), a2 + hstep, voffA);
            PG8_WAIT_L(8); PG8_BAR; PG8_WAIT_L(0); PG8_MMA(0, 0, At, B0); PG8_BAR; PG8_SCHED;
            PG8_LDB(B1, 1, 1); PG8_STAGE(PG8_SB(1, 0), b3, voffB);
            PG8_BAR; PG8_WAIT_L(0); PG8_MMA(0, 1, At, B1); PG8_BAR;
            PG8_LDA(At, 1, 1); PG8_STAGE(PG8_SA(1, 0), a3, voffA);
            PG8_BAR; PG8_WAIT_L(0); PG8_MMA(1, 0, At, B0); PG8_BAR; PG8_SCHED;
            PG8_STAGE(PG8_SB(1, 1), b3 + hstep, voffB);
            PG8_WAIT_V(6); PG8_BAR; PG8_MMA(1, 1, At, B1); PG8_BAR;
            }
        }
        if constexpr (F8) asm volatile("s_nop 15\n\ts_nop 15" ::: "memory");
        if constexpr (ALIGN_EPI) { if (wr == 0) PG8_BAR; }
        if constexpr (!Epi::AFTER_DRAIN) { E(acc, cur, wr, wc, fr, fq); S.done(cur); }
        if (!has_next) break;
        if constexpr (!F8) {
#pragma unroll
        for (int a = 0; a < 2; ++a)
#pragma unroll
            for (int b = 0; b < 2; ++b)
#pragma unroll
                for (int m = 0; m < 4; ++m)
#pragma unroll
                    for (int n = 0; n < 2; ++n) acc[a][b][m][n] = (f32x4){0.f, 0.f, 0.f, 0.f};
        }
        cur = nxt; cA = nA; cB = nB; ++ui;
        if constexpr (ALIGN_EPI) { if (wr == 1) PG8_BAR; }
    }
    PG8_WAIT_V(0);
    if constexpr (!ALIGN_EPI) { if (wr == 0) PG8_BAR; }
    PG8_BAR;
    if constexpr (Epi::AFTER_DRAIN) { E.fused(acc, cur, wr, wc, fr, fq, lds, wid, lane); S.done(cur); }
#undef PG8_SA
#undef PG8_SB
#undef PG8_STAGE
#undef PG8_LDA
#undef PG8_LDB
#undef PG8_MMA
#undef PG8_MMA0
#undef PG8_MMAF
#undef PG8_CAT8
#undef PG8_WAIT_V
#undef PG8_WAIT_L
#undef PG8_BAR
#undef PG8_SCHED
}
}
#include <hip/hip_bf16.h>
#include <cmath>
namespace attn_body {
using bf16=__hip_bfloat16;
using bf16x8=__attribute__((ext_vector_type(8)))short;
using s16x4=__attribute__((ext_vector_type(4)))short;
using f32x16=__attribute__((ext_vector_type(16)))float;
using u32x4=__attribute__((ext_vector_type(4)))unsigned;
constexpr int BATCH=8,NHEAD=16,SEQ=2048,D=64,DM=NHEAD*D;
constexpr int NW=8,QBLK=32,QB=QBLK*NW,KVBLK=64,NQB=SEQ/QB;
constexpr int ATTN_PITCH=DM, ATTN_UNIT_ROWS=QB;
__device__ __forceinline__ int crow(int r,int hi){return (r&3)+8*(r>>2)+4*hi;}
#define SBAR() __builtin_amdgcn_sched_barrier(0)
__device__ __forceinline__ void cmask(f32x16&p0,f32x16&p1,int jb,int qrel,int hi){
  const float NEG=-INFINITY; int kb=64*jb+4*hi;
  #pragma unroll
  for(int r=0;r<16;++r){int kv=kb+(r&3)+8*(r>>2); if(kv>qrel)p0[r]=NEG; if(kv+32>qrel)p1[r]=NEG;}
}

constexpr int NSLOT=3, SLOTB=8192;
constexpr int LDS_K=0, LDS_V=NSLOT*SLOTB, LDS_WS=3*NSLOT*SLOTB, LDS_QS=LDS_WS+NW*64*4, LDS_OST=LDS_QS+NW*4096, LDS_BYTES=LDS_OST+NW*4096;
constexpr float C2=0.125f*1.4426950408889634f;
__device__ __forceinline__ void glds16(const void*gsrc,unsigned lds_dst){unsigned keep;
  asm volatile("s_mov_b32 %0, m0\n\ts_mov_b32 m0, %2\n\ts_nop 0\n\tglobal_load_lds_dwordx4 %1, off\n\ts_mov_b32 m0, %0":"=&s"(keep):"v"(gsrc),"s"(lds_dst):"memory");}
__device__ __forceinline__ float max3f(float a,float b,float c){float r;asm("v_max3_f32 %0, %1, %2, %3":"=v"(r):"v"(a),"v"(b),"v"(c));return r;}
__device__ __forceinline__ float max2f(float a,float b){float r;asm("v_max_f32_e32 %0, %1, %2":"=v"(r):"v"(a),"v"(b));return r;}
__device__ __forceinline__ float fadd_s(float a,float b){float r;asm("v_add_f32_e32 %0, %1, %2":"=v"(r):"v"(a),"v"(b));return r;}
__device__ __forceinline__ float fsub_s(float a,float b){float r;asm("v_sub_f32_e32 %0, %1, %2":"=v"(r):"v"(a),"v"(b));return r;}
typedef float f32x2_t __attribute__((ext_vector_type(2))); typedef __bf16 bf16x2_t __attribute__((ext_vector_type(2)));
__device__ __forceinline__ unsigned cvtpk_s(float lo,float hi){f32x2_t v={lo,hi};bf16x2_t b=__builtin_convertvector(v,bf16x2_t);return __builtin_bit_cast(unsigned,b);}
#define WAIT_BAR(N) asm volatile("s_waitcnt vmcnt(" #N ") lgkmcnt(0)\n\ts_barrier":::"memory")

__device__ __forceinline__ void qkt(f32x16&p0,f32x16&p1,const char*Kslot,const bf16x8*qr,int r32,int hi){ const f32x16 negm=f32x16{};
  const char*kb=Kslot+hi*1024+r32*16;
  #pragma unroll
  for(int d0=0;d0<4;++d0){
    const bf16x8 b0=*reinterpret_cast<const bf16x8*>(kb+d0*2048);
    const bf16x8 b1=*reinterpret_cast<const bf16x8*>(kb+d0*2048+512);
    if(d0==0){p0=__builtin_amdgcn_mfma_f32_32x32x16_bf16(b0,qr[0],negm,0,0,0);p1=__builtin_amdgcn_mfma_f32_32x32x16_bf16(b1,qr[0],negm,0,0,0);}
    else{p0=__builtin_amdgcn_mfma_f32_32x32x16_bf16(b0,qr[d0],p0,0,0,0);p1=__builtin_amdgcn_mfma_f32_32x32x16_bf16(b1,qr[d0],p1,0,0,0);}}
}
typedef __attribute__((address_space(3))) const char* lds_cptr;
typedef short v4i16_t __attribute__((ext_vector_type(4)));
__device__ __forceinline__ void kload8(bf16x8*kf,lds_cptr kp){
  kf[0]=*(const __attribute__((address_space(3))) bf16x8*)(kp);      kf[1]=*(const __attribute__((address_space(3))) bf16x8*)(kp+512);
  kf[2]=*(const __attribute__((address_space(3))) bf16x8*)(kp+2048); kf[3]=*(const __attribute__((address_space(3))) bf16x8*)(kp+2560);
  kf[4]=*(const __attribute__((address_space(3))) bf16x8*)(kp+4096); kf[5]=*(const __attribute__((address_space(3))) bf16x8*)(kp+4608);
  kf[6]=*(const __attribute__((address_space(3))) bf16x8*)(kp+6144); kf[7]=*(const __attribute__((address_space(3))) bf16x8*)(kp+6656);
}
__device__ __forceinline__ void kload2(bf16x8*kf,lds_cptr kp,int j){ kf[2*j]=*(const __attribute__((address_space(3))) bf16x8*)(kp+j*2048); kf[2*j+1]=*(const __attribute__((address_space(3))) bf16x8*)(kp+j*2048+512); }
__device__ __forceinline__ s16x4 vtr(lds_cptr p){ return __builtin_bit_cast(s16x4,__builtin_amdgcn_ds_read_tr16_b64_v4i16((__attribute__((address_space(3))) v4i16_t*)p)); }
__device__ __forceinline__ float rowmax(const f32x16&p0,const f32x16&p1){
  float a=max3f(p0[0],p0[1],p1[0]),b=max3f(p0[2],p0[3],p1[1]);a=max3f(a,p1[2],p1[3]);
  #pragma unroll
  for(int r=4;r<16;r+=4){a=max3f(a,p0[r],p0[r+1]);b=max3f(b,p0[r+2],p0[r+3]);a=max3f(a,p1[r],p1[r+1]);b=max3f(b,p1[r+2],p1[r+3]);}
  const float m=max2f(a,b);
  auto rr=__builtin_amdgcn_permlane32_swap(__float_as_uint(m),__float_as_uint(m),false,false);
  return max2f(__uint_as_float(rr[0]),__uint_as_float(rr[1]));
}
__device__ __forceinline__ void pv(f32x16*o,int vb,bf16x8 pa0,bf16x8 pa1,bf16x8 pa2,bf16x8 pa3){
  #pragma unroll
  for(int d0=0;d0<4;++d0){s16x4 lo[4],hi[4];
    #pragma unroll
    for(int ks=0;ks<4;++ks){
      asm volatile("ds_read_b64_tr_b16 %0,%1 offset:%c2":"=&v"(lo[ks]):"v"(vb),"i"(d0*4096+ks*1024):"memory");
      asm volatile("ds_read_b64_tr_b16 %0,%1 offset:%c2":"=&v"(hi[ks]):"v"(vb),"i"(d0*4096+ks*1024+512):"memory");}
    asm volatile("s_waitcnt lgkmcnt(0)":::"memory");SBAR();
    #define PK(k) (bf16x8){lo[k][0],lo[k][1],lo[k][2],lo[k][3],hi[k][0],hi[k][1],hi[k][2],hi[k][3]}
    o[d0]=__builtin_amdgcn_mfma_f32_32x32x16_bf16(pa0,PK(0),o[d0],0,0,0);
    o[d0]=__builtin_amdgcn_mfma_f32_32x32x16_bf16(pa1,PK(1),o[d0],0,0,0);
    o[d0]=__builtin_amdgcn_mfma_f32_32x32x16_bf16(pa2,PK(2),o[d0],0,0,0);
    o[d0]=__builtin_amdgcn_mfma_f32_32x32x16_bf16(pa3,PK(3),o[d0],0,0,0);
    #undef PK
  }
}

#ifndef ATTN_STORE16
#define ATTN_STORE16(p,v) pg8::st16_wt((void*)(p),(v))
#endif
template<int THRL,int MODE,bool PRE=false,bool NEXT=false> __device__ __forceinline__ void attn_unit(int b,int qcol,int vcol,int qb,const bf16*Q,const bf16*__restrict__ K,const bf16*__restrict__ V,bf16*O,char*shm,bf16*ON,float lam,const float*subn,int nqcol=0){
  int tid_=threadIdx.x; asm volatile("":"+v"(tid_));
  const int tid=tid_,lane=tid&63,r32=lane&31,hi=lane>>5; const int wid=__builtin_amdgcn_readfirstlane(tid>>6);
  const long rowbase=(long)b*SEQ; const int q0=qb*QB;
  const bf16*Qw=Q+(rowbase+q0+wid*QBLK)*DM+qcol;
  const bf16*Kh=K+rowbase*DM+qcol,*Vh=V+rowbase*DM+vcol;
  const unsigned lds0=(unsigned)(uintptr_t)shm;
  float*wsf=(float*)(shm+LDS_WS)+wid*64;
  const bf16*ksrc=Kh+(long)lane*DM+wid*8;
  const bf16*vsrc=Vh+(long)(16*(wid&3)+(lane>>2))*DM+(wid>>2)*32+(lane&3)*8;
  const unsigned kdst=lds0+LDS_K+wid*1024, vdst=lds0+LDS_V+wid*1024;
  #define DMA_K(t,slot) glds16(ksrc+(long)(t)*KVBLK*DM,(unsigned)__builtin_amdgcn_readfirstlane(kdst+(slot)))
  #define DMA_V(t,slot) do{ glds16(vsrc+(long)(t)*KVBLK*DM,(unsigned)__builtin_amdgcn_readfirstlane(vdst+2*(slot))); glds16(vsrc+(long)(t)*KVBLK*DM+64,(unsigned)__builtin_amdgcn_readfirstlane(vdst+2*(slot)+8192)); }while(0)
  const int vb0=(int)(lds0+LDS_V)+((lane>>4)&1)*32+(lane&3)*8+(4*hi+((lane&15)>>2))*64;
  const char*Kbase=shm+LDS_K; bf16x8 kf[8];
  const lds_cptr shm3=(lds_cptr)shm; const lds_cptr kp0=shm3+LDS_K+hi*1024+r32*16; const lds_cptr vp0=shm3+LDS_V+((lane>>4)&1)*32+(lane&3)*8+(4*hi+((lane&15)>>2))*64;
  const int NT=(q0+QB)/KVBLK;
  if constexpr(!PRE){ DMA_K(0,0);DMA_V(0,0);DMA_K(1,SLOTB); }
  bf16x8 qr[4];
  #pragma unroll
  for(int d0=0;d0<4;++d0)qr[d0]=*reinterpret_cast<const bf16x8*>(&Qw[(long)r32*DM+d0*16+hi*8]);
  float mhat=0.f,l_reg=0.f;f32x16 o[4];o[0]=f32x16{};o[1]=f32x16{};o[2]=f32x16{};o[3]=f32x16{};
  typedef __attribute__((address_space(3))) bf16x8* lds_q8; const lds_cptr qp0=shm3+LDS_QS+wid*4096+lane*16;
  #define QF(j) (*(const __attribute__((address_space(3))) bf16x8*)(qp0+(j)*1024))
  const int qrel=wid*QBLK+r32;
  #define CMASK(P0,P1,t) do{int jb_=(t)-(NT-4); if(jb_>=0)cmask(P0,P1,jb_,qrel,hi);}while(0)
  bool resc=false;
  #define START(P0,P1) do{ resc=false; if constexpr(THRL>=0){ const float rm=rowmax(P0,P1); \
    { const float dl=rm; mhat=fadd_s(mhat,dl); \
      _Pragma("unroll") for(int r=0;r<16;++r){P0[r]=fsub_s(P0[r],dl);P1[r]=fsub_s(P1[r],dl);} } } \
    _Pragma("unroll") for(int r=0;r<16;++r)P0[r]=__builtin_amdgcn_exp2f(P0[r]); }while(0)
  #define RESC() do{ if(resc){ asm volatile("s_waitcnt lgkmcnt(0)":::"memory"); \
      _Pragma("unroll") for(int d_=0;d_<4;++d_) _Pragma("unroll") for(int r=0;r<16;++r)o[d_][r]*=wsf[crow(r,hi)]; } }while(0)
  f32x16 pA0,pA1,pB0,pB1;
  int sl_prev=0,sl_cur=0,sl_next=SLOTB;
  #define ROT() do{sl_prev=sl_cur;sl_cur=sl_next;sl_next=(sl_next==(NSLOT-1)*SLOTB)?0:sl_next+SLOTB;}while(0)
  DMA_K(2,2*SLOTB);
  _Pragma("unroll") for(int d0=0;d0<4;++d0)*(__attribute__((address_space(3))) bf16x8*)(__attribute__((address_space(3))) char*)(qp0+d0*1024)=qr[d0];
  WAIT_BAR(4);
  qkt(pA0,pA1,Kbase,qr,r32,hi);asm volatile("s_nop 15\n\ts_nop 7":"+v"(pA0),"+v"(pA1));CMASK(pA0,pA1,0);
  START(pA0,pA1);
  _Pragma("unroll") for(int r=0;r<16;++r)pA1[r]=__builtin_amdgcn_exp2f(pA1[r]);
  WAIT_BAR(0);
  DMA_K(3,0);DMA_V(1,SLOTB);
  ROT();
  kload8(kf,kp0+sl_cur);
  bf16x8 qa=QF(0),qb_=QF(1);
  WAIT_BAR(3);
  s16x4 vlo[8],vhi[8]; u32x4 pw0,pw1,pw2,pw3;
  #define PKW(P,B) cvtpk_s(P[B],P[B+1])
  #define PAF(k) __builtin_bit_cast(bf16x8,pw##k)
  #define VFR(i) (bf16x8){vlo[i][0],vlo[i][1],vlo[i][2],vlo[i][3],vhi[i][0],vhi[i][1],vhi[i][2],vhi[i][3]}
  #define PIN(x) asm volatile("":"+v"(x))
  #define MX3(a,b,c) __builtin_fmaxf(__builtin_fmaxf((a),(b)),(c))
  #define GAPA(MF,A0,A1,A2,A3,W0,W1,PW) do{ MF; sacc+=A0; sacc2+=A1; sacc+=A2; sacc2+=A3; PIN(sacc); PIN(sacc2); W0; W1; PIN(PW); SBAR(); }while(0)
  #define EX(v) __builtin_amdgcn_exp2f(v)
  #define GAPB(MF,X,B) do{ MF; X[B]=EX(X[B]); X[B+1]=EX(X[B+1]); PIN(X); SBAR(); }while(0)
  #define VRD(i) do{ vlo[i]=vtr(vp_+(((i)>>2)*4096+((i)&3)*1024)); vhi[i]=vtr(vp_+(((i)>>2)*4096+((i)&3)*1024+512)); }while(0)
  #define VRDX(reg,fr) do{ vlo[reg]=vtr(vp_+(((fr)>>2)*4096+((fr)&3)*1024)); vhi[reg]=vtr(vp_+(((fr)>>2)*4096+((fr)&3)*1024+512)); SBAR(); }while(0)
  #define KRD(G,j) do{ if(G){ kload2(kf,kp0+sl_next,j); SBAR(); } }while(0)
  #define ZC f32x16{}
  #define STEP(C0,C1,P0,P1,t,GK,GV,GL) do{ SBAR(); \
    const lds_cptr vp_=vp0+2*sl_prev; \
    VRD(0); SBAR(); float sacc=P0[0],sacc2=P0[1]; \
    GAPA(C0=__builtin_amdgcn_mfma_f32_32x32x16_bf16(kf[0],qa,ZC,0,0,0), P0[2],P0[3],P0[4],P0[5],     pw0[0]=PKW(P0,0), pw0[1]=PKW(P0,2), pw0); \
    VRD(4); SBAR(); GAPA(C1=__builtin_amdgcn_mfma_f32_32x32x16_bf16(kf[1],qa,ZC,0,0,0), P0[6],P0[7],P0[8],P0[9],     pw0[2]=PKW(P0,4), pw0[3]=PKW(P0,6), pw0); \
    qa=QF(2); SBAR(); \
    VRD(1); SBAR(); GAPA(C0=__builtin_amdgcn_mfma_f32_32x32x16_bf16(kf[2],qb_,C0,0,0,0),   P0[10],P0[11],P0[12],P0[13], pw1[0]=PKW(P0,8), pw1[1]=PKW(P0,10), pw1); \
    VRD(5); SBAR(); GAPA(C1=__builtin_amdgcn_mfma_f32_32x32x16_bf16(kf[3],qb_,C1,0,0,0),   P0[14],P0[15],P1[0],P1[1],   pw1[2]=PKW(P0,12),pw1[3]=PKW(P0,14), pw1); \
    qb_=QF(3); SBAR(); \
    VRD(2); SBAR(); GAPA(C0=__builtin_amdgcn_mfma_f32_32x32x16_bf16(kf[4],qa,C0,0,0,0),   P1[2],P1[3],P1[4],P1[5],     pw2[0]=PKW(P1,0), pw2[1]=PKW(P1,2), pw2); \
    VRD(6); SBAR(); GAPA(C1=__builtin_amdgcn_mfma_f32_32x32x16_bf16(kf[5],qa,C1,0,0,0),   P1[6],P1[7],P1[8],P1[9],     pw2[2]=PKW(P1,4), pw2[3]=PKW(P1,6), pw2); \
    VRD(3); SBAR(); GAPA(C0=__builtin_amdgcn_mfma_f32_32x32x16_bf16(kf[6],qb_,C0,0,0,0),   P1[10],P1[11],P1[12],P1[13], pw3[0]=PKW(P1,8), pw3[1]=PKW(P1,10), pw3); \
    VRD(7); SBAR(); GAPA(C1=__builtin_amdgcn_mfma_f32_32x32x16_bf16(kf[7],qb_,C1,0,0,0),   P1[14],P1[15],0.f,0.f,       pw3[2]=PKW(P1,12),pw3[3]=PKW(P1,14), pw3); \
    l_reg+=sacc+sacc2; \
    if(GK){DMA_K((t)+3,sl_cur);} if(GV){DMA_V((t)+1,sl_next);} \
    CMASK(C0,C1,t); \
    if constexpr(THRL>=0){ float a=MX3(C0[0],C0[1],C1[0]),b=MX3(C0[2],C0[3],C1[1]); a=MX3(a,C1[2],C1[3]); \
      _Pragma("unroll") for(int r=4;r<16;r+=4){a=MX3(a,C0[r],C0[r+1]);b=MX3(b,C0[r+2],C0[r+3]);a=MX3(a,C1[r],C1[r+1]);b=MX3(b,C1[r+2],C1[r+3]);} \
      float rm=__builtin_fmaxf(a,b); { auto rr=__builtin_amdgcn_permlane32_swap(__float_as_uint(rm),__float_as_uint(rm),false,false); rm=__builtin_fmaxf(__uint_as_float(rr[0]),__uint_as_float(rr[1])); } \
      rm-=mhat; resc=false;                                      \
      if(__builtin_expect(__any(rm>(float)THRL),0)){ const float dl=__builtin_fmaxf(rm,0.f); mhat+=dl; \
        const float f=__builtin_amdgcn_exp2f(-dl); l_reg*=f; if(hi==0)wsf[r32]=f; resc=true; } \
      _Pragma("unroll") for(int r=0;r<16;++r){C0[r]-=mhat;C1[r]-=mhat;} } \
    SBAR(); \
    GAPB(o[0]=__builtin_amdgcn_mfma_f32_32x32x16_bf16(PAF(0),VFR(0),o[0],0,0,0), C0,0);  VRDX(0,8); \
    GAPB(o[1]=__builtin_amdgcn_mfma_f32_32x32x16_bf16(PAF(0),VFR(4),o[1],0,0,0), C0,2);  VRDX(4,12); \
    GAPB(o[0]=__builtin_amdgcn_mfma_f32_32x32x16_bf16(PAF(1),VFR(1),o[0],0,0,0), C0,4);  VRDX(1,9); \
    GAPB(o[1]=__builtin_amdgcn_mfma_f32_32x32x16_bf16(PAF(1),VFR(5),o[1],0,0,0), C0,6);  VRDX(5,13); \
    GAPB(o[0]=__builtin_amdgcn_mfma_f32_32x32x16_bf16(PAF(2),VFR(2),o[0],0,0,0), C0,8);  VRDX(2,10); \
    GAPB(o[1]=__builtin_amdgcn_mfma_f32_32x32x16_bf16(PAF(2),VFR(6),o[1],0,0,0), C0,10); VRDX(6,14); \
    GAPB(o[0]=__builtin_amdgcn_mfma_f32_32x32x16_bf16(PAF(3),VFR(3),o[0],0,0,0), C0,12); VRDX(3,11); \
    GAPB(o[1]=__builtin_amdgcn_mfma_f32_32x32x16_bf16(PAF(3),VFR(7),o[1],0,0,0), C0,14); VRDX(7,15); \
    KRD(GL,0); GAPB(o[2]=__builtin_amdgcn_mfma_f32_32x32x16_bf16(PAF(0),VFR(0),o[2],0,0,0), C1,0); \
    KRD(GL,1); GAPB(o[3]=__builtin_amdgcn_mfma_f32_32x32x16_bf16(PAF(0),VFR(4),o[3],0,0,0), C1,2); \
    KRD(GL,2); GAPB(o[2]=__builtin_amdgcn_mfma_f32_32x32x16_bf16(PAF(1),VFR(1),o[2],0,0,0), C1,4); \
    KRD(GL,3); GAPB(o[3]=__builtin_amdgcn_mfma_f32_32x32x16_bf16(PAF(1),VFR(5),o[3],0,0,0), C1,6); \
    GAPB(o[2]=__builtin_amdgcn_mfma_f32_32x32x16_bf16(PAF(2),VFR(2),o[2],0,0,0), C1,8); \
    GAPB(o[3]=__builtin_amdgcn_mfma_f32_32x32x16_bf16(PAF(2),VFR(6),o[3],0,0,0), C1,10); \
    qa=QF(0); SBAR(); \
    GAPB(o[2]=__builtin_amdgcn_mfma_f32_32x32x16_bf16(PAF(3),VFR(3),o[2],0,0,0), C1,12); \
    qb_=QF(1); SBAR(); \
    GAPB(o[3]=__builtin_amdgcn_mfma_f32_32x32x16_bf16(PAF(3),VFR(7),o[3],0,0,0), C1,14); \
    }while(0)
  int t=1;
  #undef CMASK
  #define CMASK(P0,P1,t) do{}while(0)
  for(;t+5<NT;t+=2){
    STEP(pB0,pB1,pA0,pA1,t,true,true,true);     WAIT_BAR(3); RESC(); ROT();
    STEP(pA0,pA1,pB0,pB1,t+1,true,true,true);   WAIT_BAR(3); RESC(); ROT();
  }
  #undef CMASK
  #define CMASK(P0,P1,t) do{int jb_=(t)-(NT-4); if(jb_>=0)cmask(P0,P1,jb_,qrel,hi);}while(0)
  #define ENDW(tt) do{ if((tt)+3<NT){WAIT_BAR(3);} else if((tt)+2<NT){WAIT_BAR(2);} else {WAIT_BAR(0);} }while(0)
  for(;t+1<NT;t+=2){
    STEP(pB0,pB1,pA0,pA1,t,(t+3<NT),(t+1<NT),(t+1<NT));       ENDW(t);   RESC(); ROT();
    STEP(pA0,pA1,pB0,pB1,t+1,(t+4<NT),(t+2<NT),(t+2<NT));     ENDW(t+1); RESC(); ROT();
  }
  STEP(pB0,pB1,pA0,pA1,NT-1,false,false,false); RESC();
  { float sacc=pB0[0]+pB0[1]; _Pragma("unroll") for(int r=2;r<16;++r)sacc+=pB0[r]; _Pragma("unroll") for(int r=0;r<16;++r)sacc+=pB1[r]; l_reg+=sacc;
    pw0=(u32x4){PKW(pB0,0),PKW(pB0,2),PKW(pB0,4),PKW(pB0,6)};pw1=(u32x4){PKW(pB0,8),PKW(pB0,10),PKW(pB0,12),PKW(pB0,14)};pw2=(u32x4){PKW(pB1,0),PKW(pB1,2),PKW(pB1,4),PKW(pB1,6)};pw3=(u32x4){PKW(pB1,8),PKW(pB1,10),PKW(pB1,12),PKW(pB1,14)};
    SBAR(); pv(o,vb0+2*sl_cur,PAF(0),PAF(1),PAF(2),PAF(3)); }
  asm volatile("s_waitcnt lgkmcnt(0)\n\ts_barrier":::"memory");
  if constexpr(NEXT){ const bf16*ksrc_n=K+rowbase*DM+nqcol+(long)lane*DM+wid*8;
    glds16(ksrc_n,(unsigned)__builtin_amdgcn_readfirstlane(kdst)); DMA_V(0,0); glds16(ksrc_n+(long)KVBLK*DM,(unsigned)__builtin_amdgcn_readfirstlane(kdst+SLOTB)); }
  #undef PKW
  #undef PAF
  #undef VFR
  #undef PIN
  #undef MX3
  #undef GAPA
  #undef GAPB
  #undef EX
  #undef VRD
  #undef VRDX
  #undef ZC
  #undef QF
  #undef KRD
  #undef STEP
  #undef ENDW
  {auto rr=__builtin_amdgcn_permlane32_swap(__float_as_uint(l_reg),__float_as_uint(l_reg),false,false);l_reg=__uint_as_float(rr[0])+__uint_as_float(rr[1]);}
  if(hi==0)wsf[32+r32]=l_reg;asm volatile("s_waitcnt lgkmcnt(0)":::"memory");
  float rli[16];
  #pragma unroll
  for(int r=0;r<16;++r)rli[r]=__builtin_amdgcn_rcpf(wsf[32+crow(r,hi)]);
  bf16*Ow=O+(rowbase+q0+wid*QBLK)*DM+vcol;
  if constexpr(MODE==0){ bf16*stg=(bf16*)(shm+LDS_OST)+wid*2048;
    #pragma unroll
    for(int hf=0;hf<2;++hf){
      #pragma unroll
      for(int r=0;r<16;++r){const int orow=crow(r,hi);
        #pragma unroll
        for(int d0=0;d0<2;++d0)stg[orow*64+d0*32+r32]=__float2bfloat16(o[2*hf+d0][r]*rli[r]);}
      asm volatile("s_waitcnt lgkmcnt(0)":::"memory");
      #pragma unroll
      for(int i=0;i<4;++i){const int row=i*8+(lane>>3),ch=lane&7; const u32x4 v=*(const u32x4*)(stg+row*64+ch*8); ATTN_STORE16(Ow+(long)row*DM+hf*64+ch*8,v);}
      asm volatile("s_waitcnt lgkmcnt(0)":::"memory"); } }
  else { bf16*stg0=(bf16*)(shm+LDS_OST)+wid*2048,*stg1=(bf16*)(shm+LDS_QS)+wid*2048;
    #pragma unroll
    for(int r=0;r<16;++r){const int orow=crow(r,hi);
      #pragma unroll
      for(int d0=0;d0<2;++d0){stg0[orow*64+d0*32+r32]=__float2bfloat16(o[d0][r]*rli[r]);stg1[orow*64+d0*32+r32]=__float2bfloat16(o[2+d0][r]*rli[r]);}}
    if constexpr(NEXT) asm volatile("s_waitcnt vmcnt(4) lgkmcnt(0)":::"memory");
    else asm volatile("s_waitcnt vmcnt(0) lgkmcnt(0)":::"memory");
    const int ch=lane&7; float g0[8],g1[8];
    #pragma unroll
    for(int j=0;j<8;++j){g0[j]=subn[ch*8+j];g1[j]=subn[64+ch*8+j];}
    bf16*ONw=ON+(rowbase+q0+wid*QBLK)*DM+vcol;
    #pragma unroll
    for(int i=0;i<4;++i){const int row=i*8+(lane>>3);
      const u32x4 a0=*(const u32x4*)(stg0+row*64+ch*8),a1=*(const u32x4*)(stg1+row*64+ch*8);
      const u32x4 b0=*(const u32x4*)(Ow+(long)row*DM+ch*8),b1=*(const u32x4*)(Ow+(long)row*DM+64+ch*8);
      float d[16];
      #pragma unroll
      for(int j=0;j<4;++j){
        d[2*j]  =__uint_as_float(b0[j]<<16)        -lam*__uint_as_float(a0[j]<<16);
        d[2*j+1]=__uint_as_float(b0[j]&0xffff0000u)-lam*__uint_as_float(a0[j]&0xffff0000u);
        d[8+2*j]  =__uint_as_float(b1[j]<<16)        -lam*__uint_as_float(a1[j]<<16);
        d[8+2*j+1]=__uint_as_float(b1[j]&0xffff0000u)-lam*__uint_as_float(a1[j]&0xffff0000u);}
      float ss=0.f;
      #pragma unroll
      for(int j=0;j<16;++j)ss+=d[j]*d[j];
      ss+=__shfl_xor(ss,1);ss+=__shfl_xor(ss,2);ss+=__shfl_xor(ss,4);
      const float rs=__builtin_amdgcn_rsqf(ss*(1.0f/128.0f)+1e-6f);
      u32x4 w0,w1;
      #pragma unroll
      for(int j=0;j<4;++j){w0[j]=cvtpk_s(d[2*j]*rs*g0[2*j],d[2*j+1]*rs*g0[2*j+1]);w1[j]=cvtpk_s(d[8+2*j]*rs*g1[2*j],d[8+2*j+1]*rs*g1[2*j+1]);}
      ATTN_STORE16(ONw+(long)row*DM+ch*8,w0);ATTN_STORE16(ONw+(long)row*DM+64+ch*8,w1);}
    asm volatile("s_waitcnt lgkmcnt(0)":::"memory"); }
  asm volatile("s_waitcnt lgkmcnt(0)":::"memory");
  #undef DMA_K
  #undef DMA_V
  #undef CMASK
  #undef START
  #undef RESC
  #undef ROT
}
constexpr int ATTN_LDS_BYTES=LDS_BYTES;
#undef SBAR
#undef WAIT_BAR
}
constexpr int NWAVES = 8;
constexpr int NPH = 15;
constexpr size_t MiB = 1u << 20;
constexpr size_t WS_CTL = 0, CTL_ZERO_BYTES = 40960;
constexpr size_t WS_W_IN = 1 * MiB;
constexpr size_t WS_W_OUT = WS_W_IN + (size_t)3072 * 1024 * 2;
constexpr size_t WS_W_GU = WS_W_OUT + (size_t)1024 * 1024 * 2;
constexpr size_t WS_W_DN = WS_W_GU + (size_t)5632 * 1024 * 2;
constexpr size_t WS_W_QKV = WS_W_DN + (size_t)1024 * 2816 * 2;
constexpr size_t WS_W_O = WS_W_QKV + (size_t)3072 * 1024 * 2;
constexpr size_t WS_W_MGU = WS_W_O + (size_t)1024 * 1024 * 2;
constexpr size_t WS_W_MDN = WS_W_MGU + (size_t)8 * 7168 * 1024 * 2;
constexpr size_t WS_W_END = WS_W_MDN + (size_t)8 * 1024 * 3584 * 2;
constexpr size_t WS_R = 202 * MiB;
constexpr size_t ACT = (size_t)M * D * 2;
constexpr size_t AR_S = 20 * MiB, AR_BB = 0, AR_UB = 4 * MiB, AR_G = 8 * MiB, AR_X8 = 0, AR_HACT = 2 * MiB, AR_Q = 0, AR_K = 4 * MiB, AR_V = 8 * MiB, AR_O0 = 12 * MiB, AR_ON = 16 * MiB;
#define ARP(off, pitch) (A_WS + WS_R + (size_t)(blockIdx.x & 7) * (AR_S - (size_t)SEQ * (pitch)) + (off))
static_assert(SEQ * 8 == M && AR_HACT + (size_t)SEQ * DFF <= AR_G && AR_ON + (size_t)SEQ * D * 2 <= AR_S, "arena map");
constexpr size_t WS_XG = WS_R, WS_Y = WS_R;
constexpr size_t WS_HM = WS_R + 36 * MiB;
constexpr size_t WS_PP = WS_R + 156 * MiB;
constexpr size_t WS_S = 440 * MiB;
constexpr size_t WS_XB = 632 * MiB;
constexpr size_t WS_SMALL = 792 * MiB;
constexpr size_t WS_SSQ = WS_SMALL;
constexpr size_t WS_SEL = WS_SMALL + 256 * 1024, WS_GATE = WS_SEL + 128 * 1024, WS_TOKSLOT = WS_GATE + 128 * 1024;
constexpr size_t WS_GATES = WS_TOKSLOT + 384 * 1024;
constexpr size_t WS_HIST = WS_GATES + 256 * 1024, WS_META = WS_HIST + 16 * 1024;
constexpr size_t WS_END = 796 * MiB;
static_assert(WS_W_END <= WS_R && WS_XG + (size_t)SLOTS * D <= WS_HM && WS_HM + (size_t)SLOTS * DFE <= WS_PP && WS_PP + (size_t)56 * 256 * D * 2 <= WS_S && 8 * AR_S <= WS_S - WS_R, "d_ws map");
constexpr int CW_TMO = 0, CW_CODE = 1, CW_FQ = 64, CW_FQ4 = 128, CW_MAPBAD = 192, CW_BAR = 4096, CW_XLSUB = 8192, CW_XLGEN = 8704;
constexpr int MISC_OFF = 0, RING_OFF = 1024, RING_BYTES = 131072, LDS_BYTES = 147456;
constexpr int P0_SCR = 16640;

#define GAS __attribute__((address_space(1)))
#define LAS __attribute__((address_space(3)))
typedef unsigned v4u __attribute__((ext_vector_type(4)));
typedef unsigned v2u __attribute__((ext_vector_type(2)));
typedef GAS unsigned gu32;
#define RLX_AGENT __ATOMIC_RELAXED, __HIP_MEMORY_SCOPE_AGENT
#define LDS_WAIT() asm volatile("s_waitcnt lgkmcnt(0)" ::: "memory")
#define VM_WAIT() asm volatile("s_waitcnt vmcnt(0)" ::: "memory")
__device__ __forceinline__ unsigned pk2(float lo, float hi) { return f2bf(lo) | (f2bf(hi) << 16); }
__device__ __forceinline__ float bflo(unsigned w) { return __builtin_bit_cast(float, w << 16); }
__device__ __forceinline__ float bfhi(unsigned w) { return __builtin_bit_cast(float, w & 0xffff0000u); }

#define XB_TMO      128
#define XB_XCNT(j)  (256  + 64 * (j))
#define XB_XSUB(j)  (1280 + 64 * (j))
#define XB_XGEN(j)  (2304 + 64 * (j))
#define XB_TOP      3328
#define XB_TOPGEN   3392
#define XCD_BAR_WORDS 3456
#define XB_SPIN_CAP (1u << 18)

__device__ __forceinline__ unsigned xb_ld(unsigned* p)              { return __hip_atomic_load(p, __ATOMIC_RELAXED, __HIP_MEMORY_SCOPE_AGENT); }
__device__ __forceinline__ unsigned xb_add(unsigned* p, unsigned v) { return __hip_atomic_fetch_add(p, v, __ATOMIC_RELAXED, __HIP_MEMORY_SCOPE_AGENT); }
__device__ __forceinline__ unsigned xb_xcc_id() { return (unsigned)__builtin_amdgcn_s_getreg((3 << 11) | 20) & 0xFu; }
#define XB_SPIN(cond, bar) do { unsigned _sp = 0; while (cond) { __builtin_amdgcn_s_sleep(1); \
    if ((++_sp & 255u) == 0u) { if (xb_ld(&(bar)[XB_TMO])) break; if (_sp > XB_SPIN_CAP) { atomicAdd(&(bar)[XB_TMO], 1u); break; } } } } while (0)

struct XcdBarrier {
    unsigned* bar; unsigned x;
    volatile LAS unsigned* st;
};

__device__ __forceinline__ XcdBarrier xcd_barrier_post(unsigned* bar, volatile LAS unsigned* st) {
    XcdBarrier b; b.bar = bar; b.x = xb_xcc_id(); b.st = st;
    if (threadIdx.x == 0) (void)xb_add(&bar[XB_XCNT(b.x)], 1u);
    return b;
}
__device__ __forceinline__ void xcd_barrier_complete(unsigned* bar, unsigned x, unsigned& nloc, unsigned& nx) {
    const unsigned G = gridDim.x * gridDim.y * gridDim.z;
    unsigned sum, cnt, mine, sp = 0u;
    for (;;) {
        sum = 0u; cnt = 0u; mine = 0u;
#pragma unroll
        for (unsigned j = 0; j < 16; ++j) { const unsigned c = xb_ld(&bar[XB_XCNT(j)]); sum += c; cnt += (c > 0u) ? 1u : 0u; mine = (j == x) ? c : mine; }
        if (sum == G) break;
        __builtin_amdgcn_s_sleep(1);
        if ((++sp & 255u) == 0u) { if (xb_ld(&bar[XB_TMO])) break; if (sp > XB_SPIN_CAP) { atomicAdd(&bar[XB_TMO], 1u); break; } }
    }
    nloc = mine > 0u ? mine : 1u; nx = cnt > 0u ? cnt : 1u;
}

__device__ __forceinline__ void xcd_barrier(const XcdBarrier& b) {
    asm volatile("s_waitcnt vmcnt(0)" ::: "memory");
    __syncthreads();
    if (threadIdx.x == 0) {
        unsigned* bar = b.bar;
        __builtin_amdgcn_s_waitcnt(0);
        unsigned nloc = b.st[0], nx = b.st[1];
        if (nloc == 0u) { xcd_barrier_complete(bar, b.x, nloc, nx); b.st[0] = nloc; b.st[1] = nx; }
        const unsigned old = xb_add(&bar[XB_XSUB(b.x)], 1u);
        const unsigned gen = old / nloc;
        if (old + 1u == (gen + 1u) * nloc) {
            __builtin_amdgcn_fence(__ATOMIC_RELEASE, "agent");
            asm volatile("s_waitcnt vmcnt(0)" ::: "memory");
            const unsigned og = xb_add(&bar[XB_TOP], 1u);
            const unsigned tg = og / nx;
            if (og + 1u == (tg + 1u) * nx) xb_add(&bar[XB_TOPGEN], 1u);
            else XB_SPIN(xb_ld(&bar[XB_TOPGEN]) == tg, bar);
            __builtin_amdgcn_fence(__ATOMIC_ACQUIRE, "agent");
            xb_add(&bar[XB_XGEN(b.x)], 1u);
            asm volatile("s_waitcnt vmcnt(0)" ::: "memory");
        } else {
            XB_SPIN(xb_ld(&bar[XB_XGEN(b.x)]) == gen, bar);
            __builtin_amdgcn_fence(__ATOMIC_ACQUIRE, "agent");
            asm volatile("s_waitcnt vmcnt(0)" ::: "memory");
        }
    }
    __syncthreads();
}


struct Args { const float* in[19]; float* out; unsigned char* wsp; int ph_lo, ph_hi, li, pad; };
struct Frame { LAS unsigned char* lds; int tid, lane, wave, vcu, G; };
#define KA ((const Args*)__builtin_amdgcn_kernarg_segment_ptr())
#define INP(i) (KA->in[i])
#define A_WS (KA->wsp)
#define A_OUT (KA->out)

__device__ __forceinline__ int p0_dstrow(int mode, int aux, int col) {
    if (mode == 1) { if (col < 1024) return col; const int v = col >= 2048, cc = col - (v ? 2048 : 1024); return 1024 + 256 * (cc >> 7) + 128 * v + (cc & 127); }
    if (mode == 2) { const int up = col >= aux, cc = col - (up ? aux : 0); return 256 * (cc >> 7) + 128 * up + (cc & 127); }
    if (mode == 3) { const int g = col >> 6, bj = (col >> 5) & 1; return 256 * (g >> 2) + 32 * (4 * bj + (g & 3)) + (col & 31); }
    return col;
}
struct P0Item { const float* src; const float* gain; unsigned char* dst; int ldw, K, k0, d0, d1, f8; float sc; };
#define P0_JOB(SRC, LDW, KK, C0, NCOLS, GAIN, DSTOFF, DROW0, DSTROWS, MODE, AUX, NMAT, SC, F8) { \
    constexpr int nn_ = (NCOLS) / 64, per_ = ((KK) / 64) * nn_, cnt_ = per_ * (NMAT); \
    if (it < cnt_) { const int mat = it / per_, r = it % per_, kb = r / nn_, col = 64 * (r % nn_); \
        I.src = (SRC) + (size_t)mat * (KK) * (LDW) + (C0) + col; I.gain = (GAIN); I.dst = A_WS + (DSTOFF) + (size_t)mat * (DSTROWS) * (KK) * ((F8) ? 1 : 2); \
        I.ldw = (LDW); I.K = (KK); I.k0 = 64 * kb; I.d0 = (DROW0) + p0_dstrow(MODE, AUX, col); I.d1 = (DROW0) + p0_dstrow(MODE, AUX, col + 32); I.f8 = (F8); I.sc = (SC); return; } \
    it -= cnt_; }
constexpr int P0_NITEMS = 16 * 48 + 16 * 16 + 16 * 88 + 44 * 16 + 3 * 16 * 16 + 16 * 16 + 8 * 16 * 112 + 8 * 56 * 16;
constexpr int P0_FIRST = 16 * 48;
constexpr int P0_E_WOUT = P0_FIRST + 16 * 16, P0_E_WGU = P0_E_WOUT + 16 * 88, P0_E_WDN = P0_E_WGU + 44 * 16, P0_E_QKV = P0_E_WDN + 3 * 16 * 16, P0_E_WO = P0_E_QKV + 16 * 16;
constexpr int P0_DENSE_ITEMS = P0_E_WO;
constexpr int P0_GU_END = P0_DENSE_ITEMS + 8 * 16 * 112;
__device__ __forceinline__ void p0_decode(int it, P0Item& I) {
    P0_JOB(INP(3), 3072, 1024, 0, 3072, INP(1), WS_W_IN, 0, 3072, 1, 0, 1, 1.0f, 0)
    P0_JOB(INP(5), 1024, 1024, 0, 1024, nullptr, WS_W_OUT, 0, 1024, 0, 0, 1, 1.0f, 0)
    P0_JOB(INP(14), 5632, 1024, 0, 5632, INP(2), WS_W_GU, 0, 5632, 2, 2816, 1, pg8::F8_SWGD, 1)
    P0_JOB(INP(15), 1024, 2816, 0, 1024, nullptr, WS_W_DN, 0, 1024, 0, 0, 1, pg8::F8_SWDD, 1)
    P0_JOB(INP(9), 1024, 1024, 0, 1024, INP(1) + 1024, WS_W_QKV, 0, 3072, 3, 0, 1, 1.0f, 0)
    P0_JOB(INP(7), 2048, 1024, 0, 1024, INP(6), WS_W_QKV, 1024, 3072, 3, 0, 1, 1.0f, 0)
    P0_JOB(INP(7), 2048, 1024, 1024, 1024, INP(6), WS_W_QKV, 2048, 3072, 0, 0, 1, 1.0f, 0)
    P0_JOB(INP(13), 1024, 1024, 0, 1024, nullptr, WS_W_O, 0, 1024, 0, 0, 1, 1.0f, 0)
    P0_JOB(INP(17), 7168, 1024, 0, 7168, INP(2) + 1024, WS_W_MGU, 0, 7168, 2, 3584, 8, pg8::F8_SWG, 1)
    P0_JOB(INP(18), 1024, 3584, 0, 1024, nullptr, WS_W_MDN, 0, 1024, 0, 0, 8, pg8::F8_SWD, 1)
}
#undef P0_JOB
struct P0Regs { f32x4 v[16]; float g[16]; };
__device__ __forceinline__ void p0_load(const P0Item& I, P0Regs& R, int lane) {
    const int lr = lane >> 4, lc = lane & 15;
#pragma unroll
    for (int i = 0; i < 16; ++i) R.v[i] = __builtin_nontemporal_load((const GAS f32x4*)(I.src + (size_t)(I.k0 + 4 * i + lr) * I.ldw + 4 * lc));
    if (I.gain) {
#pragma unroll
        for (int i = 0; i < 16; ++i) R.g[i] = I.gain[I.k0 + 4 * i + lr];
    } else {
#pragma unroll
        for (int i = 0; i < 16; ++i) R.g[i] = 1.0f;
    }
}
__device__ __forceinline__ void p0_store(const P0Item& I, const P0Regs& R, LAS float* scr, int lane) {
    const int lr = lane >> 4, lc = lane & 15;
#pragma unroll
    for (int i = 0; i < 16; ++i) { const f32x4 w = R.v[i] * (R.g[i] * I.sc); LAS float* p = scr + (4 * i + lr) * 65 + 4 * lc; p[0] = w[0]; p[1] = w[1]; p[2] = w[2]; p[3] = w[3]; }
    LDS_WAIT(); asm volatile("" ::: "memory");
    const int c = lane & 7;
#pragma unroll
    for (int jj = 0; jj < 8; ++jj) { const int nl = 8 * jj + (lane >> 3); const LAS float* s = scr + (8 * c) * 65 + nl;
        const int drow = (jj < 4 ? I.d0 : I.d1 - 32) + nl;
        if (I.f8) { v2u o; o.x = pg8::pk4_fp8(s[0], s[65], s[130], s[195]); o.y = pg8::pk4_fp8(s[260], s[325], s[390], s[455]);
            pg8::st8_wt(I.dst + (size_t)drow * I.K + I.k0 + 8 * c, o.x, o.y); }
        else { v4u o; o.x = pk2(s[0], s[65]); o.y = pk2(s[130], s[195]); o.z = pk2(s[260], s[325]); o.w = pk2(s[390], s[455]);
            pg8::st16_wt(I.dst + ((size_t)drow * I.K + I.k0 + 8 * c) * 2, o); } }
    LDS_WAIT(); asm volatile("" ::: "memory");
}
__device__ __forceinline__ void rms_row_bf16(const float* xrow, const float* g, bf16_t* orow, int lane) {
    const GAS f32x4* xr = (const GAS f32x4*)xrow + lane; const GAS f32x4* gr = (const GAS f32x4*)g + lane;
    f32x4 v[4]; float s = 0.f;
#pragma unroll
    for (int j = 0; j < 4; ++j) { v[j] = xr[64 * j]; s += (v[j][0] * v[j][0] + v[j][1] * v[j][1]) + (v[j][2] * v[j][2] + v[j][3] * v[j][3]); }
    const float rstd = __builtin_amdgcn_rsqf(wave_sum(s) * (1.f / D) + EPS);
    GAS v2u* o8 = (GAS v2u*)orow + lane;
#pragma unroll
    for (int j = 0; j < 4; ++j) { const f32x4 gg = gr[64 * j]; v2u o; o.x = pk2(v[j][0] * rstd * gg[0], v[j][1] * rstd * gg[1]); o.y = pk2(v[j][2] * rstd * gg[2], v[j][3] * rstd * gg[3]); o8[64 * j] = o; }
}
__device__ __forceinline__ void p0_prologue(Frame& F) {
    const int gw = F.vcu * NWAVES + F.wave, NGW = F.G * NWAVES;
    {
        const float* x = INP(0); bf16_t* XBp = (bf16_t*)(A_WS + WS_XB); float* ssq = (float*)(A_WS + WS_SSQ);
        for (int mb = gw; mb < M; mb += 4 * NGW) { f32x4 v[4][4];
#pragma unroll
            for (int i = 0; i < 4; ++i) { const int m = mb + i * NGW; if (m < M) { const GAS f32x4* xr = (const GAS f32x4*)(x + (size_t)m * D) + F.lane;
#pragma unroll
                for (int j = 0; j < 4; ++j) v[i][j] = __builtin_nontemporal_load(xr + 64 * j); } }
#pragma unroll
            for (int i = 0; i < 4; ++i) { const int m = mb + i * NGW; if (m >= M) break; float s = 0.f;
#pragma unroll
                for (int j = 0; j < 4; ++j) s += (v[i][j][0] * v[i][j][0] + v[i][j][1] * v[i][j][1]) + (v[i][j][2] * v[i][j][2] + v[i][j][3] * v[i][j][3]);
                s = wave_sum(s); GAS v2u* o8 = (GAS v2u*)(XBp + (size_t)m * D) + F.lane;
                if (F.lane == 0) *(GAS f32x4*)(ssq + (size_t)m * 4) = (f32x4){s, 0.f, 0.f, 0.f};
#pragma unroll
                for (int j = 0; j < 4; ++j) { v2u o; o.x = pk2(v[i][j][0], v[i][j][1]); o.y = pk2(v[i][j][2], v[i][j][3]); o8[64 * j] = o; } } }
    }
    LAS float* scr = (LAS float*)(F.lds + RING_OFF + F.wave * P0_SCR);
    int it = gw; if (it >= P0_FIRST) return;
    P0Item cur; P0Regs ra; p0_decode(it, cur); p0_load(cur, ra, F.lane);
    for (;;) { const int nit = it + NGW; const bool has = nit < P0_FIRST; P0Item nx; P0Regs rb;
        if (has) { p0_decode(nit, nx); p0_load(nx, rb, F.lane); }
        p0_store(cur, ra, scr, F.lane);
        if (!has) break;
        cur = nx; ra = rb; it = nit; }
}

#ifndef FILL_CAP
#define FILL_CAP 1
#endif
__device__ __forceinline__ void fill_items(Frame& F, int bound, volatile LAS unsigned* flag) {
    if (F.wave == 0) return;
    volatile LAS unsigned* curp = (volatile LAS unsigned*)(F.lds + MISC_OFF + 64) + F.wave;
    int c = __builtin_amdgcn_readfirstlane((int)*curp);
    const int base = P0_FIRST + F.vcu * (NWAVES - 1) + (F.wave - 1), stride = F.G * (NWAVES - 1);
    if (base + c * stride >= bound) return;
    LAS float* scr = (LAS float*)(F.lds + RING_OFF + F.wave * P0_SCR);
    for (int n = 0;; ++n) { const int it = base + c * stride; if (it >= bound) break; if (flag && (n >= FILL_CAP || *flag != 0u)) break;
        P0Item I; P0Regs R; p0_decode(it, I); p0_load(I, R, F.lane); p0_store(I, R, scr, F.lane); ++c; }
    if (F.lane == 0) *curp = (unsigned)c;
}
__device__ __forceinline__ void xcd_barrier_fill(const XcdBarrier& b, Frame& F, int bound) {
    volatile LAS unsigned* flag = (volatile LAS unsigned*)(F.lds + MISC_OFF + 48);
    asm volatile("s_waitcnt vmcnt(0)" ::: "memory");
    if (threadIdx.x == 0) *flag = 0u;
    __syncthreads();
    if (threadIdx.x == 0) {
        unsigned* bar = b.bar;
        __builtin_amdgcn_s_waitcnt(0);
        unsigned nloc = b.st[0], nx = b.st[1];
        if (nloc == 0u) { xcd_barrier_complete(bar, b.x, nloc, nx); b.st[0] = nloc; b.st[1] = nx; }
        const unsigned old = xb_add(&bar[XB_XSUB(b.x)], 1u);
        const unsigned gen = old / nloc;
        if (old + 1u == (gen + 1u) * nloc) {
            __builtin_amdgcn_fence(__ATOMIC_RELEASE, "agent");
            asm volatile("s_waitcnt vmcnt(0)" ::: "memory");
            const unsigned og = xb_add(&bar[XB_TOP], 1u);
            const unsigned tg = og / nx;
            if (og + 1u == (tg + 1u) * nx) xb_add(&bar[XB_TOPGEN], 1u);
            else XB_SPIN(xb_ld(&bar[XB_TOPGEN]) == tg, bar);
            __builtin_amdgcn_fence(__ATOMIC_ACQUIRE, "agent");
            xb_add(&bar[XB_XGEN(b.x)], 1u);
            asm volatile("s_waitcnt vmcnt(0)" ::: "memory");
        } else {
            XB_SPIN(xb_ld(&bar[XB_XGEN(b.x)]) == gen, bar);
            __builtin_amdgcn_fence(__ATOMIC_ACQUIRE, "agent");
            asm volatile("s_waitcnt vmcnt(0)" ::: "memory");
        }
        *flag = 1u;
    } else if (threadIdx.x >= 64) fill_items(F, bound, flag);
    __syncthreads();
}

__device__ __forceinline__ void xcd_local_barrier_fill(Frame& F, unsigned* bar, int bound) {
    unsigned* ctl = (unsigned*)(A_WS + WS_CTL);
    volatile LAS unsigned* flag = (volatile LAS unsigned*)(F.lds + MISC_OFF + 48);
    volatile LAS unsigned* lgen = (volatile LAS unsigned*)(F.lds + MISC_OFF + 56);
    asm volatile("s_waitcnt vmcnt(0)" ::: "memory");
    if (threadIdx.x == 0) *flag = 0u;
    __syncthreads();
    if (threadIdx.x == 0) {
        __builtin_amdgcn_s_waitcnt(0);
        const unsigned x = blockIdx.x & 7u, gen = *lgen; *lgen = gen + 1u;
        const unsigned old = xb_add(&ctl[CW_XLSUB + 64 * x], 1u);
        if (old + 1u == (gen + 1u) * (gridDim.x >> 3)) (void)xb_add(&ctl[CW_XLGEN + 64 * x], 1u);
        else XB_SPIN(xb_ld(&ctl[CW_XLGEN + 64 * x]) == gen, bar);
        __builtin_amdgcn_fence(__ATOMIC_ACQUIRE, "agent");
        asm volatile("s_waitcnt vmcnt(0)" ::: "memory");
        *flag = 1u;
    } else if (threadIdx.x >= 64) fill_items(F, bound, flag);
    __syncthreads();
}

#define FILL_TAIL0(F) (P0_FIRST + 11 * (F).G * (NWAVES - 1))
constexpr int FILL_D4_CHUNKS = 384;
__device__ __forceinline__ void fill_tail(Frame& F, int cw, int it0, int it1) {
    unsigned* ctr = (unsigned*)(A_WS + WS_CTL) + cw;
    volatile LAS unsigned* qs = (volatile LAS unsigned*)(F.lds + MISC_OFF + 96);
    const int nchunks = (it1 - it0 + NWAVES - 2) / (NWAVES - 1);
    if (nchunks <= 0) return;
    LAS float* scr = (LAS float*)(F.lds + RING_OFF + F.wave * P0_SCR);
    if (F.tid == 0) *qs = __hip_atomic_fetch_add(ctr, 1u, __ATOMIC_RELAXED, __HIP_MEMORY_SCOPE_AGENT);
    __syncthreads();
    for (;;) {
        const int q = (int)*qs;
        __syncthreads();
        if (q >= nchunks) break;
        if (F.tid == 0) *qs = __hip_atomic_fetch_add(ctr, 1u, __ATOMIC_RELAXED, __HIP_MEMORY_SCOPE_AGENT);
        if (F.wave) { const int it = it0 + q * (NWAVES - 1) + (F.wave - 1);
            if (it < it1) { P0Item I; P0Regs R; p0_decode(it, I); p0_load(I, R, F.lane); p0_store(I, R, scr, F.lane); } }
        __syncthreads();
    }
}
__device__ __forceinline__ int fill_d4_end(Frame& F) { const int e = FILL_TAIL0(F) + FILL_D4_CHUNKS * (NWAVES - 1); return e < P0_NITEMS ? e : P0_NITEMS; }

__device__ __forceinline__ void up8(const v4u w, float (&f)[8]) { f[0] = bflo(w.x); f[1] = bfhi(w.x); f[2] = bflo(w.y); f[3] = bfhi(w.y); f[4] = bflo(w.z); f[5] = bfhi(w.z); f[6] = bflo(w.w); f[7] = bfhi(w.w); }
__device__ __forceinline__ void p2_conv(Frame& F) {
    const bf16_t* Bb = (const bf16_t*)ARP(AR_BB, D * 2); const bf16_t* Ub = (const bf16_t*)ARP(AR_UB, D * 2); bf16_t* G = (bf16_t*)ARP(AR_G, D * 2); const float* cw = INP(4);
    const int gw = F.vcu * NWAVES + F.wave, NGW = F.G * NWAVES;
    for (int strip = gw; strip < 2048; strip += NGW) {
        const int r0 = (strip >> 1) * 16, c0 = (strip & 1) * 512 + F.lane * 8;
        float w0[8], w1[8], w2[8], um2[8], um1[8];
#pragma unroll
        for (int j = 0; j < 8; ++j) { w0[j] = cw[c0 + j]; w1[j] = cw[D + c0 + j]; w2[j] = cw[2 * D + c0 + j]; um2[j] = 0.f; um1[j] = 0.f; }
        if ((r0 & (SEQ - 1)) != 0) { up8(*(const GAS v4u*)(Ub + (size_t)(r0 - 2) * D + c0), um2); up8(*(const GAS v4u*)(Ub + (size_t)(r0 - 1) * D + c0), um1); }
#pragma unroll
        for (int hb = 0; hb < 2; ++hb) { v4u ru[8], rb[8];
#pragma unroll
            for (int i = 0; i < 8; ++i) { ru[i] = *(const GAS v4u*)(Ub + (size_t)(r0 + 8 * hb + i) * D + c0); rb[i] = *(const GAS v4u*)(Bb + (size_t)(r0 + 8 * hb + i) * D + c0); }
#pragma unroll
            for (int ii = 0; ii < 8; ++ii) { const int i = 8 * hb + ii; float u[8], b[8]; up8(ru[ii], u); up8(rb[ii], b);
            float g[8];
#pragma unroll
            for (int j = 0; j < 8; ++j) { g[j] = b[j] * (w0[j] * um2[j] + w1[j] * um1[j] + w2[j] * u[j]); um2[j] = um1[j]; um1[j] = u[j]; }
            v4u o; o.x = pk2(g[0], g[1]); o.y = pk2(g[2], g[3]); o.z = pk2(g[4], g[5]); o.w = pk2(g[6], g[7]);
            pg8::st16_wt(G + (size_t)(r0 + i) * D + c0, o); } }
    }
}

#define TR_STEP(n, m) do { _Pragma("unroll") for (int i = 0; i < (n) / 2; ++i) { const bool up = (lane & (m)) != 0; const float keep = up ? v[i + (n) / 2] : v[i], send = up ? v[i] : v[i + (n) / 2]; v[i] = keep + __shfl_xor(send, (m)); } } while (0)
__device__ __forceinline__ void p10a_router(Frame& F) {
    const bf16_t* x3 = (const bf16_t*)(A_WS + WS_XB); const float* g = INP(2) + D; const float* Wr = INP(16); const float* ssq = (const float*)(A_WS + WS_SSQ);
    int* sel = (int*)(A_WS + WS_SEL); float* gate = (float*)(A_WS + WS_GATE); int* hist = (int*)(A_WS + WS_HIST);
    LAS f32x4* WL = (LAS f32x4*)(F.lds + RING_OFF);
    LAS int* lcnt = (LAS int*)(F.lds + RING_OFF + 32768);
    const int lane = F.lane;
    for (int k = F.tid; k < D; k += NWAVES * 64) { const float gk = g[k]; const f32x4 w0 = *(const GAS f32x4*)(Wr + (size_t)k * 8) * gk, w1 = *(const GAS f32x4*)(Wr + (size_t)k * 8 + 4) * gk;
        const int base = (((k >> 8) * 4 + (k & 3)) * 2) * 64 + ((k >> 2) & 63); WL[base] = w0; WL[base + 64] = w1; }
    LDS_WAIT(); __syncthreads();
    for (int blk = F.vcu; blk < M / 64; blk += F.G) {
        const int row0 = 64 * blk + 8 * F.wave;
        f32x4 xv[8][4];
#pragma unroll
        for (int r = 0; r < 8; ++r)
#pragma unroll
            for (int j = 0; j < 4; ++j) { const v2u w = *((const GAS v2u*)(x3 + (size_t)(row0 + r) * D) + lane + 64 * j); xv[r][j] = (f32x4){bflo(w.x), bfhi(w.x), bflo(w.y), bfhi(w.y)}; }
        float v[64];
#pragma unroll
        for (int i = 0; i < 64; ++i) v[i] = 0.f;
#pragma unroll
        for (int j = 0; j < 4; ++j)
#pragma unroll
            for (int q = 0; q < 4; ++q) { const f32x4 wa = WL[((j * 4 + q) * 2) * 64 + lane], wb = WL[((j * 4 + q) * 2 + 1) * 64 + lane];
#pragma unroll
                for (int r = 0; r < 8; ++r) { const float xx = xv[r][j][q];
                    v[r * 8 + 0] += xx * wa[0]; v[r * 8 + 1] += xx * wa[1]; v[r * 8 + 2] += xx * wa[2]; v[r * 8 + 3] += xx * wa[3];
                    v[r * 8 + 4] += xx * wb[0]; v[r * 8 + 5] += xx * wb[1]; v[r * 8 + 6] += xx * wb[2]; v[r * 8 + 7] += xx * wb[3]; } }
        TR_STEP(64, 32); TR_STEP(32, 16); TR_STEP(16, 8); TR_STEP(8, 4); TR_STEP(4, 2); TR_STEP(2, 1);
        float lg[8];
#pragma unroll
        for (int e = 0; e < 8; ++e) lg[e] = __shfl(v[0], (lane & ~7) | e);
        int i0 = 0; float v0 = lg[0];
#pragma unroll
        for (int e = 1; e < 8; ++e) if (lg[e] > v0) { v0 = lg[e]; i0 = e; }
        int i1 = 0; float v1 = -INFINITY;
#pragma unroll
        for (int e = 0; e < 8; ++e) if (e != i0 && lg[e] > v1) { v1 = lg[e]; i1 = e; }
        const int row = row0 + (lane >> 3); const float rs = pg8::rstd_of(ssq, row);
        const float g1 = 1.f / (1.f + expf((v0 - v1) * rs)); const bool wrt = (lane & 7) == 0;
        if (wrt) { sel[2 * row] = i0; sel[2 * row + 1] = i1; gate[2 * row] = 1.f - g1; gate[2 * row + 1] = g1; }
        int mycnt = 0;
#pragma unroll
        for (int e = 0; e < 8; ++e) { const int c = __popcll(__ballot(wrt && i0 == e)) + __popcll(__ballot(wrt && i1 == e)); if (lane == e) mycnt = c; }
        if (lane < 8) lcnt[F.wave * 8 + lane] = mycnt;
        LDS_WAIT(); __syncthreads();
        if (F.tid < 8) { int c = 0;
#pragma unroll
            for (int w = 0; w < 8; ++w) c += lcnt[w * 8 + F.tid];
            hist[blk * 8 + F.tid] = c; }
        LDS_WAIT(); __syncthreads();
    }
}
#undef TR_STEP
__device__ __forceinline__ void p10b_assign(Frame& F) {
    const int* hist = (const int*)(A_WS + WS_HIST); const int* sel = (const int*)(A_WS + WS_SEL); const float* gate = (const float*)(A_WS + WS_GATE); const float* ssq = (const float*)(A_WS + WS_SSQ);
    int* tok_slot = (int*)(A_WS + WS_TOKSLOT); float* gates = (float*)(A_WS + WS_GATES); int* meta = (int*)(A_WS + WS_META);
    const bf16_t* x3 = (const bf16_t*)(A_WS + WS_XB); unsigned char* XG = A_WS + WS_XG;
    LAS int* pre = (LAS int*)(F.lds + RING_OFF);
    LAS int* tot = pre + 2048;
    LAS int* ebase = tot + 8;
    LAS int* lslot = ebase + 8;
    const int lane = F.lane, e = F.wave;
    { int h[4], run = 0;
#pragma unroll
      for (int i = 0; i < 4; ++i) { h[i] = hist[(4 * lane + i) * 8 + e]; }
      const int mine = h[0] + h[1] + h[2] + h[3]; int inc = mine;
#pragma unroll
      for (int o = 1; o < 64; o <<= 1) { const int t = __shfl_up(inc, o); if (lane >= o) inc += t; }
      run = inc - mine;
#pragma unroll
      for (int i = 0; i < 4; ++i) { pre[(4 * lane + i) * 8 + e] = run; run += h[i]; }
      if (lane == 63) tot[e] = inc; }
    LDS_WAIT(); __syncthreads();
    if (F.tid == 0) { int b = 0; for (int k = 0; k < 8; ++k) { ebase[k] = b; if (blockIdx.x == 0) meta[k] = b >> 8; b += (tot[k] + 255) & ~255; } if (blockIdx.x == 0) { const int T = b >> 8, full = 2 * F.G / 4; meta[8] = T; meta[9] = T < full ? T : full; } }
    LDS_WAIT(); __syncthreads();
    for (int blk = blockIdx.x; blk < M / 64; blk += F.G) {
        if (F.wave == 0) { const int t = 64 * blk + lane; const int s0 = sel[2 * t], s1 = sel[2 * t + 1]; int sl0 = 0, sl1 = 0;
            const unsigned long long below = (1ull << lane) - 1ull;
#pragma unroll
            for (int k = 0; k < 8; ++k) { const unsigned long long m0 = __ballot(s0 == k), m1 = __ballot(s1 == k); const int b0 = ebase[k] + pre[blk * 8 + k];
                if (s0 == k) sl0 = b0 + __popcll(m0 & below); if (s1 == k) sl1 = b0 + __popcll(m0) + __popcll(m1 & below); }
            tok_slot[2 * t] = sl0; tok_slot[2 * t + 1] = sl1; lslot[2 * lane] = sl0; lslot[2 * lane + 1] = sl1;
            gates[sl0] = gate[2 * t]; gates[sl1] = gate[2 * t + 1]; }
        LDS_WAIT(); __syncthreads();
        v4u xw[8][2];
#pragma unroll
        for (int i = 0; i < 8; ++i) { const GAS v4u* xr = (const GAS v4u*)(x3 + (size_t)(64 * blk + 8 * F.wave + i) * D + 16 * lane); xw[i][0] = xr[0]; xw[i][1] = xr[1]; }
#pragma unroll
        for (int i = 0; i < 8; ++i) { const int tl = 8 * F.wave + i; const int t = 64 * blk + tl;
            const float rs = pg8::rstd_of(ssq, t) * pg8::F8_SA; float a[8], b[8]; up8(xw[i][0], a); up8(xw[i][1], b);
            v4u o; o.x = pg8::pk4_fp8(a[0] * rs, a[1] * rs, a[2] * rs, a[3] * rs); o.y = pg8::pk4_fp8(a[4] * rs, a[5] * rs, a[6] * rs, a[7] * rs); o.z = pg8::pk4_fp8(b[0] * rs, b[1] * rs, b[2] * rs, b[3] * rs); o.w = pg8::pk4_fp8(b[4] * rs, b[5] * rs, b[6] * rs, b[7] * rs);
            const int sl0 = lslot[2 * tl], sl1 = lslot[2 * tl + 1];
            pg8::st16_wt(XG + (size_t)sl0 * D + 16 * lane, o); pg8::st16_wt(XG + (size_t)sl1 * D + 16 * lane, o); }
        LDS_WAIT(); __syncthreads();
    }
}
typedef float f32x2_ __attribute__((ext_vector_type(2)));
__device__ __forceinline__ void p13_load_y(const unsigned char* Y, const bf16_t* Pp, const float* gates, int nfull, int slot, int lane, f32x4 (&y)[4]) {
    const int rt = (slot >> 8) - nfull;
    if (rt < 0) { const GAS unsigned* yr = (const GAS unsigned*)(Y + (size_t)slot * D) + lane;
#pragma unroll
        for (int j = 0; j < 4; ++j) { const int w = (int)yr[64 * j]; const f32x2_ lo = __builtin_amdgcn_cvt_pk_f32_fp8(w, false), hi = __builtin_amdgcn_cvt_pk_f32_fp8(w, true);
            y[j] = (f32x4){lo.x, lo.y, hi.x, hi.y} * (1.0f / pg8::F8_SY); }
    } else { const float gt = gates[slot];
#pragma unroll
        for (int j = 0; j < 4; ++j) { f32x4 s = (f32x4){0.f, 0.f, 0.f, 0.f};
#pragma unroll
            for (int kp = 0; kp < pg8::MoeOrder::SPL; ++kp) { const v2u w = *((const GAS v2u*)(Pp + ((size_t)(rt * pg8::MoeOrder::SPL + kp) * 256 + (slot & 255)) * D) + lane + 64 * j);
                s += (f32x4){bflo(w.x), bfhi(w.x), bflo(w.y), bfhi(w.y)}; }
            y[j] = s * gt; } }
}
__device__ __forceinline__ void p13_final(Frame& F) {
    const int* tok_slot = (const int*)(A_WS + WS_TOKSLOT); const unsigned char* Y = A_WS + WS_Y; const bf16_t* X3 = (const bf16_t*)(A_WS + WS_XB); float* out = A_OUT;
    const bf16_t* Pp = (const bf16_t*)(A_WS + WS_PP); const float* gates = (const float*)(A_WS + WS_GATES); const int nfull = ((const int*)(A_WS + WS_META))[9];
    const int gw = F.vcu * NWAVES + F.wave, NGW = F.G * NWAVES, lane = F.lane;
    for (int rowb = gw; rowb < M; rowb += 2 * NGW) {
        v2u xa[2][4]; f32x4 ya[2][4], yb[2][4];
#pragma unroll
        for (int i = 0; i < 2; ++i) { const int row = rowb + i * NGW; if (row < M) { const int s0 = tok_slot[2 * row], s1 = tok_slot[2 * row + 1];
            const GAS v2u* xr = (const GAS v2u*)(X3 + (size_t)row * D) + lane;
#pragma unroll
            for (int j = 0; j < 4; ++j) xa[i][j] = xr[64 * j];
            p13_load_y(Y, Pp, gates, nfull, s0, lane, ya[i]); p13_load_y(Y, Pp, gates, nfull, s1, lane, yb[i]); } }
#pragma unroll
        for (int i = 0; i < 2; ++i) { const int row = rowb + i * NGW; if (row >= M) break; GAS f32x4* orow = (GAS f32x4*)(out + (size_t)row * D) + lane;
#pragma unroll
            for (int j = 0; j < 4; ++j) { const v2u x = xa[i][j];
                orow[64 * j] = (f32x4){bflo(x.x), bfhi(x.x), bflo(x.y), bfhi(x.y)} + (ya[i][j] + yb[i][j]); } }
    }
}

__global__ void __launch_bounds__(NWAVES * 64, 2) mega_fwd(Args args) {
    extern __shared__ __attribute__((aligned(16))) unsigned char lds[];
    Frame F;
    F.lds = (LAS unsigned char*)lds; F.tid = threadIdx.x; F.lane = F.tid & 63; F.wave = __builtin_amdgcn_readfirstlane(F.tid >> 6);
    F.G = gridDim.x; { const int bx = blockIdx.x; F.vcu = (F.G % 8 == 0) ? (bx % 8) * (F.G / 8) + bx / 8 : bx; }
    for (int u = F.tid; u < RING_OFF / 4; u += NWAVES * 64) ((LAS unsigned*)(F.lds + MISC_OFF))[u] = 0u;
    __syncthreads();
    if (F.tid == 0 && xb_xcc_id() != (blockIdx.x & 7u)) (void)__hip_atomic_fetch_or((unsigned*)(A_WS + WS_CTL) + CW_MAPBAD, 1u, __ATOMIC_RELAXED, __HIP_MEMORY_SCOPE_AGENT);
    if (KA->ph_hi - KA->ph_lo > 1) (void)xcd_barrier_post((unsigned*)(A_WS + WS_CTL) + CW_BAR + KA->li * XCD_BAR_WORDS, (volatile LAS unsigned*)(F.lds + MISC_OFF + 32));
#define IN(k) (KA->ph_lo <= (k) && (k) < KA->ph_hi)
#define FILL_BOUND(k) ((k) <= 11 ? FILL_TAIL0(F) : 0)
#define FILL_NEED(k) ((k) == 2 ? P0_E_WO : (k) == 11 ? P0_GU_END : (k) == 12 ? FILL_TAIL0(F) : 0)
#define SEAM(k) do { if (IN(k) && FILL_NEED(k) != 0) fill_items(F, FILL_NEED(k), nullptr); if ((k) == 12 && IN(12)) { if (!IN(4) || (1408 % F.G) == 0) fill_tail(F, CW_FQ4, FILL_TAIL0(F), fill_d4_end(F)); fill_tail(F, CW_FQ, fill_d4_end(F), P0_NITEMS); } \
    if ((k) == 4 && IN(4) && (1408 % F.G) != 0 && (int)blockIdx.x >= 1408 % F.G) fill_tail(F, CW_FQ4, FILL_TAIL0(F), fill_d4_end(F));     \
    if (IN(k) && IN((k) + 1)) { if (SEAM_LOCAL(k) && *(volatile LAS unsigned*)(F.lds + MISC_OFF + 52) != 0u) SEAM_NOWL(FILL_BOUND(k)); else SEAM_NOWF(FILL_BOUND(k)); } \
    if ((k) == 0 && IN(0) && IN(1)) { if (F.tid == 0) *(volatile LAS unsigned*)(F.lds + MISC_OFF + 52) = (F.G == 256 && xb_ld((unsigned*)(A_WS + WS_CTL) + CW_MAPBAD) == 0u) ? 1u : 0u; LDS_WAIT(); __syncthreads(); } } while (0)
#define SEAM_LOCAL(k) ((k) == 1 || ((k) >= 3 && (k) <= 7) || (k) == 9)
#define SEAM_NOWL(bound) xcd_local_barrier_fill(F, (unsigned*)(A_WS + WS_CTL) + CW_BAR + KA->li * XCD_BAR_WORDS, (bound))
#define SEAM_NOWF(bound) do { { XcdBarrier b_; b_.bar = (unsigned*)(A_WS + WS_CTL) + CW_BAR + KA->li * XCD_BAR_WORDS; b_.x = xb_xcc_id(); b_.st = (volatile LAS unsigned*)(F.lds + MISC_OFF + 32); xcd_barrier_fill(b_, F, (bound)); } } while (0)
#define SEAM_NOW() do { { XcdBarrier b_; b_.bar = (unsigned*)(A_WS + WS_CTL) + CW_BAR + KA->li * XCD_BAR_WORDS; b_.x = xb_xcc_id(); b_.st = (volatile LAS unsigned*)(F.lds + MISC_OFF + 32); xcd_barrier(b_); } } while (0)
#define ws A_WS
#define XB ((bf16_t*)(A_WS + WS_XB))
#define SSQ ((float*)(A_WS + WS_SSQ))

    if (IN(0)) { p0_prologue(F); } SEAM(0);
    if (IN(1)) { pg8::Gemm g{XB, (const bf16_t*)(ws + WS_W_IN), M, 3072, 1024}; pg8::StaticOrder S; S.init(M, 3072, F.G, (int)blockIdx.x);
        pg8::EpiInProj E{(bf16_t*)ARP(AR_BB, D * 2), (bf16_t*)ARP(AR_UB, D * 2), SSQ};
        pg8::gemm_phase<pg8::EpiInProj, pg8::StaticOrder, true, true>(F.lds + RING_OFF, g, S, E); } SEAM(1);
    if (IN(2)) { p2_conv(F); } SEAM(2);
    if (IN(3)) { pg8::Gemm g{(const bf16_t*)ARP(AR_G, D * 2), (const bf16_t*)(ws + WS_W_OUT), M, 1024, 1024}; pg8::StaticOrder S; S.init(M, 1024, F.G, (int)blockIdx.x);
        pg8::EpiResidSsq<true> E{INP(0), XB, SSQ, 1.0f, ARP(AR_X8, D)};
        pg8::gemm_phase<pg8::EpiResidSsq<true>, pg8::StaticOrder, false, true>(F.lds + RING_OFF, g, S, E); } SEAM(3);
    if (IN(4)) { pg8::Gemm g{(const bf16_t*)ARP(AR_X8, D), (const bf16_t*)(ws + WS_W_GU), M, 5632, 512}; pg8::StaticOrder S; S.init(M, 5632, F.G, (int)blockIdx.x);
        pg8::EpiSwiGLU<true> E{ARP(AR_HACT, DFF), DFF, SSQ, nullptr, 22, 1.0f / (pg8::F8_SX * pg8::F8_SWGD)};
        pg8::gemm_phase<pg8::EpiSwiGLU<true>, pg8::StaticOrder, true, true, true>(F.lds + RING_OFF, g, S, E); } SEAM(4);
    if (IN(5)) { pg8::Gemm g{(const bf16_t*)ARP(AR_HACT, DFF), (const bf16_t*)(ws + WS_W_DN), M, 1024, DFF / 2}; pg8::StaticOrder S; S.init(M, 1024, F.G, (int)blockIdx.x);
        pg8::EpiResidSsq<false> E{nullptr, XB, SSQ, 1.0f / (pg8::F8_SHD * pg8::F8_SWDD), nullptr};
        pg8::gemm_phase<pg8::EpiResidSsq<false>, pg8::StaticOrder, false, true, true>(F.lds + RING_OFF, g, S, E); } SEAM(5);
    if (IN(6)) { pg8::Gemm g{XB, (const bf16_t*)(ws + WS_W_QKV), M, 3072, 1024}; pg8::StaticOrder S; S.init(M, 3072, F.G, (int)blockIdx.x);
        pg8::EpiQKV E{(bf16_t*)ARP(AR_Q, D * 2), (bf16_t*)ARP(AR_K, D * 2), (bf16_t*)ARP(AR_V, D * 2), SSQ, INP(10), INP(8), attn_body::C2};
        pg8::gemm_phase<pg8::EpiQKV, pg8::StaticOrder, true, true>(F.lds + RING_OFF, g, S, E); } SEAM(6);
    if (IN(7)) {
        const float* lp = INP(11); const float* sn = INP(12);
        const float lam = __expf(wave_sum(lp[F.lane] * lp[64 + F.lane])) - __expf(wave_sum(lp[128 + F.lane] * lp[192 + F.lane])) + LAM_INIT;
        LAS float* sng = (LAS float*)(F.lds + MISC_OFF + 256);
        if (F.tid < VD) sng[F.tid] = sn[F.tid] * (1.f - LAM_INIT);
        LDS_WAIT(); __syncthreads();
        for (int it = F.vcu; it < BATCH * 32; it += F.G) { const int b = it >> 5, h = (it >> 2) & 7, p = it & 3;
            attn_body::bf16* O0 = (attn_body::bf16*)ARP(AR_O0, D * 2); attn_body::bf16* ONp = (attn_body::bf16*)ARP(AR_ON, D * 2);
            for (int i = 0; i < 2; ++i) { const int qb = i ? 7 - p : p;
                if (i == 0) attn_body::attn_unit<-1, 0, false, true>(b, (2 * h) * 64, h * 128, qb, (const attn_body::bf16*)ARP(AR_Q, D * 2), (const attn_body::bf16*)ARP(AR_K, D * 2), (const attn_body::bf16*)ARP(AR_V, D * 2), O0, (char*)lds + RING_OFF, nullptr, 0.f, nullptr, (2 * h + 1) * 64);
                else attn_body::attn_unit<-1, 0, true, true>(b, (2 * h) * 64, h * 128, qb, (const attn_body::bf16*)ARP(AR_Q, D * 2), (const attn_body::bf16*)ARP(AR_K, D * 2), (const attn_body::bf16*)ARP(AR_V, D * 2), O0, (char*)lds + RING_OFF, nullptr, 0.f, nullptr, (2 * h + 1) * 64);
                if (i == 0) attn_body::attn_unit<-1, 1, true, true>(b, (2 * h + 1) * 64, h * 128, qb, (const attn_body::bf16*)ARP(AR_Q, D * 2), (const attn_body::bf16*)ARP(AR_K, D * 2), (const attn_body::bf16*)ARP(AR_V, D * 2), O0, (char*)lds + RING_OFF, ONp, lam, (const float*)((char*)lds + MISC_OFF + 256), (2 * h) * 64);
                else attn_body::attn_unit<-1, 1, true, false>(b, (2 * h + 1) * 64, h * 128, qb, (const attn_body::bf16*)ARP(AR_Q, D * 2), (const attn_body::bf16*)ARP(AR_K, D * 2), (const attn_body::bf16*)ARP(AR_V, D * 2), O0, (char*)lds + RING_OFF, ONp, lam, (const float*)((char*)lds + MISC_OFF + 256)); } }
    } if (IN(7) && IN(9)) { if (*(volatile LAS unsigned*)(F.lds + MISC_OFF + 52) != 0u) SEAM_NOWL(FILL_TAIL0(F)); else SEAM_NOWF(FILL_TAIL0(F)); }
    if (IN(9)) { pg8::Gemm g{(const bf16_t*)ARP(AR_ON, D * 2), (const bf16_t*)(ws + WS_W_O), M, 1024, 1024}; pg8::StaticOrder S; S.init(M, 1024, F.G, (int)blockIdx.x);
        pg8::EpiResidSsq<false> E{nullptr, XB, SSQ, 1.0f, nullptr};
        pg8::gemm_phase<pg8::EpiResidSsq<false>, pg8::StaticOrder, false, true>(F.lds + RING_OFF, g, S, E); } SEAM(9);
    if (IN(10)) { p10a_router(F); } SEAM(10);
    if (IN(11)) { p10b_assign(F); } SEAM(11);
    if (IN(12)) { pg8::Gemm g{(const bf16_t*)(ws + WS_XG), (const bf16_t*)(ws + WS_W_MGU), SLOTS, 8 * 7168, 512}; pg8::MoeOrder S; S.init((const int*)(ws + WS_META), 28, F.G, (int)blockIdx.x, false);
        pg8::EpiSwiGLU8 E{ws + WS_HM, DFE, 28};
        pg8::gemm_phase<pg8::EpiSwiGLU8, pg8::MoeOrder, true, true, true>(F.lds + RING_OFF, g, S, E); } SEAM(12);
    if (IN(13)) { pg8::Gemm g{(const bf16_t*)(ws + WS_HM), (const bf16_t*)(ws + WS_W_MDN), SLOTS, 8 * 1024, DFE / 2}; pg8::MoeOrder S; S.init((const int*)(ws + WS_META), 4, F.G, (int)blockIdx.x, true);
        pg8::EpiMoeDown E{ws + WS_Y, (const float*)(ws + WS_GATES), 1.0f / (pg8::F8_SH * pg8::F8_SWD), (bf16_t*)(ws + WS_PP)};
        pg8::gemm_phase<pg8::EpiMoeDown, pg8::MoeOrder, true, true, true>(F.lds + RING_OFF, g, S, E); } SEAM(13);
    if (IN(14)) { p13_final(F); }
#undef IN
#undef SEAM
#undef SEAM_NOW
#undef SEAM_NOWF
#undef SEAM_NOWL
#undef SEAM_LOCAL
#undef ws
#undef XB
#undef SSQ
}
#ifndef MEGA_UPTO
#define MEGA_UPTO 15
#endif
#ifndef MEGA_REPMASK
#define MEGA_REPMASK 0
#endif
#ifndef MEGA_ONE
#define MEGA_ONE 1
#endif
extern "C" void kernel_launch(void* const* d_in, const int* in_sizes, int n_in, void* d_out, int out_size, void* d_ws, size_t ws_size, hipStream_t stream) {
    static int grid = 0;
    if (grid == 0) {
        if (n_in != 19 || in_sizes[0] != M * D || out_size != M * D || ws_size < WS_END) { fprintf(stderr, "kernel_launch: unexpected shapes / workspace (%d inputs, ws %zu, need %zu)\n", n_in, ws_size, (size_t)WS_END); grid = -1; return; }
        int dev = 0, cus = 0, per_cu = 0;
        if (hipGetDevice(&dev) != hipSuccess || hipDeviceGetAttribute(&cus, hipDeviceAttributeMultiprocessorCount, dev) != hipSuccess) { grid = -1; return; }
        if (hipFuncSetAttribute((const void*)mega_fwd, hipFuncAttributeMaxDynamicSharedMemorySize, LDS_BYTES) != hipSuccess) { fprintf(stderr, "kernel_launch: hipFuncSetAttribute failed\n"); grid = -1; return; }
        if (hipOccupancyMaxActiveBlocksPerMultiprocessor(&per_cu, (const void*)mega_fwd, NWAVES * 64, LDS_BYTES) != hipSuccess || per_cu < 1) fprintf(stderr, "kernel_launch: note: occupancy query says %d\n", per_cu);
        (void)hipGetLastError();
        grid = cus < 256 ? cus : 256;
        if (grid != 256) fprintf(stderr, "kernel_launch: %d CUs; this kernel is built for 256\n", cus);
    }
    if (grid < 0) return;
    unsigned char* ws = (unsigned char*)d_ws; float* out = (float*)d_out;
    constexpr int UPTO = MEGA_UPTO;
    static_assert(UPTO == 15, "the plain reference kernels of the transition builds are gone: all 15 phases run in the persistent kernel");
    if (UPTO > 0) {
        if (hipMemsetAsync(ws + WS_CTL, 0, CTL_ZERO_BYTES, stream) != hipSuccess) { fprintf(stderr, "kernel_launch: memset failed\n"); return; }
        Args a{};
        for (int i = 0; i < 19; ++i) a.in[i] = (const float*)d_in[i];
        a.out = out; a.wsp = ws;
        if (MEGA_ONE) { a.ph_lo = 0; a.ph_hi = UPTO; a.li = 0; hipLaunchKernelGGL(mega_fwd, dim3(grid), dim3(NWAVES * 64), LDS_BYTES, stream, a); }
        else for (int p = 0; p < UPTO; ++p) { a.ph_lo = p; a.ph_hi = p + 1; a.li = 0; for (int r = 0; r <= ((MEGA_REPMASK >> p) & 1); ++r) hipLaunchKernelGGL(mega_fwd, dim3(grid), dim3(NWAVES * 64), LDS_BYTES, stream, a); }
        const hipError_t le = hipPeekAtLastError();
        if (le != hipSuccess) fprintf(stderr, "kernel_launch: launch failed: %s\n", hipGetErrorName(le));
    }
}
```

```cpp
#include <hip/hip_runtime.h>
#include <hip/hip_bf16.h>
#include <stdint.h>
#include <stdio.h>
#include <cmath>
#define MEGA_UPTO 15
#define MEGA_ONE 1
typedef unsigned short bf16_t;
typedef short bf16x8 __attribute__((ext_vector_type(8)));
typedef float f32x4 __attribute__((ext_vector_type(4)));
constexpr int D = 1024, BATCH = 8, SEQ = 2048, M = BATCH * SEQ;
constexpr int NH = 8, HD = 64, VD = 128;
constexpr int DFF = 2816, NE = 8, DFE = 3584;
constexpr float EPS = 1e-6f;
constexpr float LAM_INIT = 0.35550907f;
constexpr int SLOTS = 2 * M + NE * 256;

__device__ __forceinline__ unsigned f2bf(float f) { unsigned u = __builtin_bit_cast(unsigned, f); return (u + 0x7fffu + ((u >> 16) & 1u)) >> 16; }
__device__ __forceinline__ float bf2f(unsigned short b) { return __builtin_bit_cast(float, (unsigned)b << 16); }
__device__ __forceinline__ float wave_sum(float v) {
#pragma unroll
    for (int o = 1; o < 64; o <<= 1) v += __shfl_xor(v, o);
    return v;
}

namespace pg8 {
#define PG8_LAS __attribute__((address_space(3)))
typedef unsigned short bf16_t;
typedef short bf16x8 __attribute__((ext_vector_type(8)));
typedef float f32x4 __attribute__((ext_vector_type(4)));
typedef unsigned u32x4 __attribute__((ext_vector_type(4)));
typedef int i32x4 __attribute__((ext_vector_type(4)));
typedef int i32x8 __attribute__((ext_vector_type(8)));
constexpr int BM = 256, BK = 64, HALF = 128, HTB = HALF * BK * 2  , STAGE_BYTES = 8 * HTB, NXCD = 8, WGM = 8;

__host__ __device__ __forceinline__ int lds_byte(int r, int c) { const int st = (r >> 4) * 2 + (c >> 5), rr = r & 15, cc = c & 31, ob = rr * 64 + cc * 2; return st * 1024 + (ob ^ (((ob >> 9) & 1) << 5)); }
__host__ __device__ __forceinline__ void stage_rc(int b, int& R, int& C) { const int st = b / 1024, sb = b % 1024, swz = sb ^ (((sb >> 9) & 1) << 5); R = (st >> 1) * 16 + swz / 64; C = (st & 1) * 32 + (swz % 64) / 2; }
__host__ __device__ __forceinline__ int perm32(int rho) { const int n = rho >> 4, i = rho & 15; return 8 * (i >> 2) + 4 * n + (i & 3); }

struct Unit { int pm, pn; int kt0, nkt, aux; };
struct Gemm { const bf16_t* A; const bf16_t* Bt; int M, N, K; };

struct StaticOrder {
    int nM, nN, nwg, G, c;
    __host__ __device__ void init(int M, int N, int G_, int c_) { nM = M / BM; nN = N / BM; nwg = nM * nN; G = G_; c = c_; }
    __host__ __device__ bool next(int i, Unit& u) const {
        const long L = (long)i * G + c; if (L >= nwg) return false;
        int wgid = (int)L; { const int q = nwg / NXCD, r = nwg % NXCD, xcd = wgid % NXCD, off = wgid / NXCD; wgid = (xcd < r ? xcd * (q + 1) : r * (q + 1) + (xcd - r) * q) + off; }
        const int nig = WGM * nN, gid = wgid / nig, fm = gid * WGM, gsz = (nM - fm) < WGM ? (nM - fm) : WGM;
        u.pm = fm + ((wgid % nig) % gsz); u.pn = (wgid % nig) / gsz; u.kt0 = 0; u.nkt = 0; u.aux = -1; return true;
    }
    __device__ __forceinline__ void a_ready(const Unit&) const {}
    __device__ __forceinline__ void done(const Unit&) const {}
};

__device__ __forceinline__ unsigned cvt_pk_bf16(float lo, float hi) { unsigned r; asm volatile("v_cvt_pk_bf16_f32 %0, %1, %2" : "=v"(r) : "v"(lo), "v"(hi)); return r; }
typedef float f32x2 __attribute__((ext_vector_type(2)));
#ifndef PG8_WT
#define PG8_WT 0
#endif
__device__ __forceinline__ void st16_wt(void* p, u32x4 v) {
#if PG8_WT
    asm volatile("global_store_dwordx4 %0, %1, off sc1\n\ts_nop 1" :: "v"(p), "v"(v) : "memory");
#else
    *(u32x4*)p = v;
#endif
}
__device__ __forceinline__ void st8_wt(void* p, unsigned x, unsigned y) {
#if PG8_WT
    typedef unsigned u32x2_ __attribute__((ext_vector_type(2))); const u32x2_ v = {x, y};
    asm volatile("global_store_dwordx2 %0, %1, off sc1\n\ts_nop 1" :: "v"(p), "v"(v) : "memory");
#else
    typedef unsigned u32x2_ __attribute__((ext_vector_type(2))); *(u32x2_*)p = (u32x2_){x, y};
#endif
}
typedef unsigned u32x2 __attribute__((ext_vector_type(2)));
constexpr float RMS_EPS = 1e-6f, LOG2E = 1.4426950408889634f;
constexpr int DM_ = 1024;
__device__ __forceinline__ u32x4 pack8(const f32x4 a, const f32x4 b) { u32x4 w; w.x = cvt_pk_bf16(a[0], a[1]); w.y = cvt_pk_bf16(a[2], a[3]); w.z = cvt_pk_bf16(b[0], b[1]); w.w = cvt_pk_bf16(b[2], b[3]); return w; }
__device__ __forceinline__ float rstd_of(const float* ssq, int row) { const f32x4 p = *(const f32x4*)(ssq + (size_t)row * 4); return __builtin_amdgcn_rsqf(((p[0] + p[1]) + (p[2] + p[3])) * (1.0f / 1024.0f) + RMS_EPS); }
__device__ __forceinline__ float silu_mul(float g, float u) { return g * u * __builtin_amdgcn_rcpf(1.0f + __builtin_amdgcn_exp2f(-g * LOG2E)); }
__device__ __forceinline__ f32x2 swiglu2(f32x2 a, f32x2 b, float c1, float k) {
    const f32x2 t = a * c1; f32x2 e; e.x = __builtin_amdgcn_exp2f(t.x); e.y = __builtin_amdgcn_exp2f(t.y);
    const f32x2 d = e * k + k; f32x2 r; r.x = __builtin_amdgcn_rcpf(d.x); r.y = __builtin_amdgcn_rcpf(d.y);
    return (a * b) * r;
}

__device__ __forceinline__ float clamp448(float x) { return __builtin_amdgcn_fmed3f(x, -448.0f, 448.0f); }
__device__ __forceinline__ unsigned pk4_fp8(float a, float b, float c, float d) { int w = 0; w = __builtin_amdgcn_cvt_pk_fp8_f32(clamp448(a), clamp448(b), w, false); w = __builtin_amdgcn_cvt_pk_fp8_f32(clamp448(c), clamp448(d), w, true); return (unsigned)w; }
constexpr float F8_SA = 4.0f, F8_SWG = 256.0f, F8_SH = 8.0f, F8_SWD = 512.0f;
constexpr float F8_SY = 64.0f;
constexpr float F8_SHD = 8.0f, F8_SWDD = 256.0f, F8_SX = 4.0f, F8_SWGD = 256.0f;

struct EpiInProj {
    static constexpr bool PERM = true, AFTER_DRAIN = false;
    bf16_t* Bb; bf16_t* Ub; const float* ssq;
    __device__ __forceinline__ void operator()(const f32x4 (&acc)[2][2][4][2], const Unit& u, int wr, int wc, int fr, int fq) const {
        const int row0 = u.pm * BM + wr * 64 + fr;
        float rsv[2][4];
#pragma unroll
        for (int ai = 0; ai < 2; ++ai)
#pragma unroll
            for (int m = 0; m < 4; ++m) rsv[ai][m] = rstd_of(ssq, row0 + ai * HALF + m * 16);
        if (u.pn < 4) {
            const int col0 = u.pn * BM + wc * 32 + 8 * fq;
#pragma unroll
            for (int ai = 0; ai < 2; ++ai)
#pragma unroll
                for (int m = 0; m < 4; ++m) { bf16_t* rowp = Bb + (size_t)(row0 + ai * HALF + m * 16) * DM_ + col0;
#pragma unroll
                    for (int bj = 0; bj < 2; ++bj) st16_wt(rowp + bj * HALF, pack8(acc[ai][bj][m][0] * rsv[ai][m], acc[ai][bj][m][1] * rsv[ai][m])); }
        } else {
            const int col0 = (u.pn - 4) * 128 + wc * 32 + 8 * fq;
#pragma unroll
            for (int ai = 0; ai < 2; ++ai)
#pragma unroll
                for (int m = 0; m < 4; ++m) { bf16_t* rowp = Ub + (size_t)(row0 + ai * HALF + m * 16) * DM_ + col0;
                    const float r2 = rsv[ai][m] * rsv[ai][m]; st16_wt(rowp, pack8(acc[ai][0][m][0] * acc[ai][1][m][0] * r2, acc[ai][0][m][1] * acc[ai][1][m][1] * r2)); }
        }
    }
};

template <bool FIRST> struct EpiResidSsq {
    static constexpr bool PERM = true, AFTER_DRAIN = true;
    const float* x0; bf16_t* xb; float* ssq; float ascale; unsigned char* x8;
    __device__ __forceinline__ void fused(f32x4 (&acc)[2][2][4][2], const Unit& u, int wr, int wc, int fr, int fq, PG8_LAS unsigned char* lds, int wid, int lane) const {
        PG8_LAS float* P = (PG8_LAS float*)lds;
        const int col0 = u.pn * BM + wc * 32 + 8 * fq;
#pragma unroll
        for (int ai = 0; ai < 2; ++ai) {
            f32x4 xo[4][2][2];
#pragma unroll
            for (int m = 0; m < 4; ++m) { const int r = ai * HALF + wr * 64 + m * 16 + fr; const size_t off = (size_t)(u.pm * BM + r) * DM_ + col0;
#pragma unroll
                for (int bj = 0; bj < 2; ++bj) {
                    { const u32x4 w = *(const u32x4*)(xb + off + bj * HALF);
                        xo[m][bj][0] = (f32x4){__builtin_bit_cast(float, w.x << 16), __builtin_bit_cast(float, w.x & 0xffff0000u), __builtin_bit_cast(float, w.y << 16), __builtin_bit_cast(float, w.y & 0xffff0000u)};
                        xo[m][bj][1] = (f32x4){__builtin_bit_cast(float, w.z << 16), __builtin_bit_cast(float, w.z & 0xffff0000u), __builtin_bit_cast(float, w.w << 16), __builtin_bit_cast(float, w.w & 0xffff0000u)}; } } }
#pragma unroll
            for (int m = 0; m < 4; ++m) { const int r = ai * HALF + wr * 64 + m * 16 + fr; const size_t off = (size_t)(u.pm * BM + r) * DM_ + col0; float s = 0.f;
#pragma unroll
                for (int bj = 0; bj < 2; ++bj) { const f32x4 v0 = xo[m][bj][0] + acc[ai][bj][m][0] * ascale, v1 = xo[m][bj][1] + acc[ai][bj][m][1] * ascale;
                    st16_wt(xb + off + bj * HALF, pack8(v0, v1));
                    if constexpr (FIRST) { u32x2 w; w.x = pk4_fp8(v0[0] * F8_SX, v0[1] * F8_SX, v0[2] * F8_SX, v0[3] * F8_SX); w.y = pk4_fp8(v1[0] * F8_SX, v1[1] * F8_SX, v1[2] * F8_SX, v1[3] * F8_SX); st8_wt(x8 + off + bj * HALF, w.x, w.y); }
                    s += ((v0[0] * v0[0] + v0[1] * v0[1]) + (v0[2] * v0[2] + v0[3] * v0[3])) + ((v1[0] * v1[0] + v1[1] * v1[1]) + (v1[2] * v1[2] + v1[3] * v1[3])); }
                s += __shfl_xor(s, 16); s += __shfl_xor(s, 32);
                if (fq == 0) P[r * 4 + wc] = s; }
            asm volatile("" ::: "memory"); }
        asm volatile("s_waitcnt lgkmcnt(0)" ::: "memory"); __builtin_amdgcn_s_barrier(); asm volatile("" ::: "memory");
        const int t = wid * 64 + lane;
        if (t < 256) { const PG8_LAS f32x4* Pr = (const PG8_LAS f32x4*)lds; const f32x4 p = Pr[t]; ssq[(size_t)(u.pm * BM + t) * 4 + u.pn] = (p[0] + p[1]) + (p[2] + p[3]); }
        asm volatile("s_waitcnt lgkmcnt(0)" ::: "memory"); __builtin_amdgcn_s_barrier(); asm volatile("" ::: "memory");
    }
};

template <bool OUT8> struct EpiSwiGLU {
    static constexpr bool PERM = true, AFTER_DRAIN = false;
    void* H; int ldh; const float* ssq; const float* rstd; int ncol; float cs;
    __device__ __forceinline__ void operator()(const f32x4 (&acc)[2][2][4][2], const Unit& u, int wr, int wc, int fr, int fq) const {
        const int row0 = u.pm * BM + wr * 64 + fr, col0 = (u.pn % ncol) * 128 + wc * 32 + 8 * fq;
        float kk[2][4];
#pragma unroll
        for (int ai = 0; ai < 2; ++ai)
#pragma unroll
            for (int m = 0; m < 4; ++m) { const int row = row0 + ai * HALF + m * 16;
                if (ssq) { const f32x4 p = *(const f32x4*)(ssq + (size_t)row * 4); kk[ai][m] = ((p[0] + p[1]) + (p[2] + p[3])) * (1.0f / 1024.0f) + RMS_EPS; } else { const float r_ = rstd[row]; kk[ai][m] = 1.0f / (r_ * r_); } }
#pragma unroll
        for (int ai = 0; ai < 2; ++ai)
#pragma unroll
            for (int m = 0; m < 4; ++m) { const int row = row0 + ai * HALF + m * 16;
                float k = kk[ai][m];
                const float c1 = -LOG2E * cs * __builtin_amdgcn_rsqf(k); k = k / (cs * cs);
                f32x4 h[2];
#pragma unroll
                for (int n = 0; n < 2; ++n) { const f32x4 a = acc[ai][0][m][n], b = acc[ai][1][m][n];
                    const f32x2 h0 = swiglu2((f32x2){a[0], a[1]}, (f32x2){b[0], b[1]}, c1, k), h1 = swiglu2((f32x2){a[2], a[3]}, (f32x2){b[2], b[3]}, c1, k);
                    h[n] = (f32x4){h0.x, h0.y, h1.x, h1.y}; }
                if constexpr (OUT8) { u32x2 w; w.x = pk4_fp8(h[0][0] * F8_SHD, h[0][1] * F8_SHD, h[0][2] * F8_SHD, h[0][3] * F8_SHD); w.y = pk4_fp8(h[1][0] * F8_SHD, h[1][1] * F8_SHD, h[1][2] * F8_SHD, h[1][3] * F8_SHD);
                    st8_wt((unsigned char*)H + (size_t)row * ldh + col0, w.x, w.y); }
                else st16_wt((bf16_t*)H + (size_t)row * ldh + col0, pack8(h[0], h[1])); }
    }
};

struct EpiQKV {
    static constexpr bool PERM = true, AFTER_DRAIN = false;
    bf16_t *Q, *K, *V; const float* ssq; const float* qg; const float* kg; float qscale;
    __device__ __forceinline__ void operator()(const f32x4 (&acc)[2][2][4][2], const Unit& u, int wr, int wc, int fr, int fq) const {
        const int row0 = u.pm * BM + wr * 64 + fr;
        float rsv[2][4];
#pragma unroll
        for (int ai = 0; ai < 2; ++ai)
#pragma unroll
            for (int m = 0; m < 4; ++m) rsv[ai][m] = rstd_of(ssq, row0 + ai * HALF + m * 16);
        if (u.pn < 8) {
            const bool isq = u.pn < 4; bf16_t* base = isq ? Q : K; const float* gn = isq ? qg : kg; const float sc = isq ? qscale : 1.0f;
            const int col0 = (4 * (u.pn & 3) + wc) * 64 + 8 * fq;
            f32x4 gv[2][2];
#pragma unroll
            for (int bj = 0; bj < 2; ++bj)
#pragma unroll
                for (int n = 0; n < 2; ++n) gv[bj][n] = *(const f32x4*)(gn + 32 * bj + 8 * fq + 4 * n);
#pragma unroll
            for (int ai = 0; ai < 2; ++ai)
#pragma unroll
                for (int m = 0; m < 4; ++m) { const int row = row0 + ai * HALF + m * 16; const float rs = rsv[ai][m];
                    f32x4 v[2][2]; float ss = 0.f;
#pragma unroll
                    for (int bj = 0; bj < 2; ++bj)
#pragma unroll
                        for (int n = 0; n < 2; ++n) { v[bj][n] = acc[ai][bj][m][n] * rs; ss += (v[bj][n][0] * v[bj][n][0] + v[bj][n][1] * v[bj][n][1]) + (v[bj][n][2] * v[bj][n][2] + v[bj][n][3] * v[bj][n][3]); }
                    ss += __shfl_xor(ss, 16); ss += __shfl_xor(ss, 32);
                    const float r2 = __builtin_amdgcn_rsqf(ss * (1.0f / 64.0f) + RMS_EPS) * sc;
#pragma unroll
                    for (int bj = 0; bj < 2; ++bj) st16_wt(base + (size_t)row * DM_ + col0 + 32 * bj, pack8(v[bj][0] * r2 * gv[bj][0], v[bj][1] * r2 * gv[bj][1])); }
        } else {
            const int col0 = (u.pn - 8) * BM + wc * 32 + 8 * fq;
#pragma unroll
            for (int ai = 0; ai < 2; ++ai)
#pragma unroll
                for (int m = 0; m < 4; ++m) { const int row = row0 + ai * HALF + m * 16; const float rs = rsv[ai][m];
#pragma unroll
                    for (int bj = 0; bj < 2; ++bj) st16_wt(V + (size_t)row * DM_ + col0 + bj * HALF, pack8(acc[ai][bj][m][0] * rs, acc[ai][bj][m][1] * rs)); }
        }
    }
};

struct EpiSwiGLU8 {
    static constexpr bool PERM = true, AFTER_DRAIN = false;
    unsigned char* H; int ldh; int ncol;
    __device__ __forceinline__ void operator()(const f32x4 (&acc)[2][2][4][2], const Unit& u, int wr, int wc, int fr, int fq) const {
        const int row0 = u.pm * BM + wr * 64 + fr, col0 = (u.pn % ncol) * 128 + wc * 32 + 8 * fq; constexpr float cs = 1.0f / (F8_SA * F8_SWG);
#pragma unroll
        for (int ai = 0; ai < 2; ++ai)
#pragma unroll
            for (int m = 0; m < 4; ++m) { const int row = row0 + ai * HALF + m * 16; f32x4 h[2];
#pragma unroll
                for (int n = 0; n < 2; ++n) { const f32x4 a = acc[ai][0][m][n], b = acc[ai][1][m][n];
                    const f32x2 h0 = swiglu2((f32x2){a[0], a[1]}, (f32x2){b[0], b[1]}, -cs * LOG2E, 1.0f / (cs * cs * F8_SH)), h1 = swiglu2((f32x2){a[2], a[3]}, (f32x2){b[2], b[3]}, -cs * LOG2E, 1.0f / (cs * cs * F8_SH));
                    h[n] = (f32x4){h0.x, h0.y, h1.x, h1.y}; }
                u32x2 w; w.x = pk4_fp8(h[0][0], h[0][1], h[0][2], h[0][3]); w.y = pk4_fp8(h[1][0], h[1][1], h[1][2], h[1][3]);
                st8_wt(H + (size_t)row * ldh + col0, w.x, w.y); }
    }
};

struct EpiMoeDown {
    static constexpr bool PERM = true, AFTER_DRAIN = false;
    unsigned char* Y; const float* gate; float scale; bf16_t* Pp;
    __device__ __forceinline__ void operator()(const f32x4 (&acc)[2][2][4][2], const Unit& u, int wr, int wc, int fr, int fq) const {
        const int col0 = (u.pn & 3) * BM + wc * 32 + 8 * fq;
        if (u.aux >= 0) {
            bf16_t* base = Pp + ((size_t)u.aux * BM + wr * 64 + fr) * DM_ + col0;
#pragma unroll
            for (int ai = 0; ai < 2; ++ai)
#pragma unroll
                for (int m = 0; m < 4; ++m)
#pragma unroll
                    for (int bj = 0; bj < 2; ++bj) st16_wt(base + (size_t)(ai * HALF + m * 16) * DM_ + bj * HALF, pack8(acc[ai][bj][m][0] * scale, acc[ai][bj][m][1] * scale));
            return; }
        const int row0 = u.pm * BM + wr * 64 + fr;
        float gv[2][4];
#pragma unroll
        for (int ai = 0; ai < 2; ++ai)
#pragma unroll
            for (int m = 0; m < 4; ++m) gv[ai][m] = gate[row0 + ai * HALF + m * 16] * (scale * F8_SY);
#pragma unroll
        for (int ai = 0; ai < 2; ++ai)
#pragma unroll
            for (int m = 0; m < 4; ++m) { const int row = row0 + ai * HALF + m * 16; const float gt = gv[ai][m];
#pragma unroll
                for (int bj = 0; bj < 2; ++bj) { const f32x4 y0 = acc[ai][bj][m][0] * gt, y1 = acc[ai][bj][m][1] * gt; st8_wt(Y + (size_t)row * DM_ + col0 + bj * HALF, pk4_fp8(y0[0], y0[1], y0[2], y0[3]), pk4_fp8(y1[0], y1[1], y1[2], y1[3])); } }
    }
};

struct MoeOrder {
    int nM, nN, nwg, G, c, T, P0, npieces; int t1, t2, t3, t4, t5, t6, t7;
    static constexpr int SPL = 7, PKT = 4;
    __device__ __forceinline__ void init(const int* meta, int nN_, int G_, int c_, bool split) {
        T = meta[8]; nM = split ? meta[9] : T; nN = nN_; nwg = nM * nN; G = G_; c = c_; t1 = meta[1]; t2 = meta[2]; t3 = meta[3]; t4 = meta[4]; t5 = meta[5]; t6 = meta[6]; t7 = meta[7];
        P0 = ((nwg + G - 1) / G) * G; npieces = (T - nM) * nN * SPL; }
    __device__ __forceinline__ int expert_of(int pm) const { return (pm >= t1) + (pm >= t2) + (pm >= t3) + (pm >= t4) + (pm >= t5) + (pm >= t6) + (pm >= t7); }
    __device__ __forceinline__ bool next(int i, Unit& u) const {
        const long L = (long)i * G + c;
        if (L >= nwg) { const long q = L - P0; if (q < 0 || q >= npieces) return false;
            const int rt = (int)q / (nN * SPL), rem = (int)q % (nN * SPL), pnl = rem / SPL, kp = rem % SPL;
            u.pm = nM + rt; u.pn = expert_of(u.pm) * nN + pnl; u.kt0 = kp * PKT; u.nkt = PKT; u.aux = rt * SPL + kp; return true; }
        int wgid = (int)L; { const int q = nwg / NXCD, r = nwg % NXCD, xcd = wgid % NXCD, off = wgid / NXCD; wgid = (xcd < r ? xcd * (q + 1) : r * (q + 1) + (xcd - r) * q) + off; }
        const int nig = WGM * nN, gid = wgid / nig, fm = gid * WGM, gsz = (nM - fm) < WGM ? (nM - fm) : WGM;
        const int pm = fm + ((wgid % nig) % gsz), pnl = (wgid % nig) / gsz;
        u.pm = pm; u.pn = expert_of(pm) * nN + pnl; u.kt0 = 0; u.nkt = 0; u.aux = -1; return true;
    }
    __device__ __forceinline__ void a_ready(const Unit&) const {}
    __device__ __forceinline__ void done(const Unit&) const {}
};
template <class Epi, class Sched, bool ALIGN_EPI = false, bool SP2 = false, bool F8 = false>
__device__ __forceinline__ void gemm_phase(PG8_LAS unsigned char* lds, const Gemm g, const Sched& S, const Epi& E) {
    const int tid = threadIdx.x, wid = __builtin_amdgcn_readfirstlane(tid >> 6), lane = tid & 63, wr = wid >> 2, wc = wid & 3, fr = lane & 15, fq = lane >> 4;
    int K_ = g.K; asm volatile("" : "+s"(K_));
    const int K = K_, nt = K / BK;
    unsigned voffA[2], voffB[2];
#pragma unroll
    for (int i = 0; i < 2; ++i) { int R, C; stage_rc(tid * 16 + i * 8192, R, C); const int Rb = Epi::PERM ? ((R & ~31) + perm32(R & 31)) : R;
        voffA[i] = (unsigned)(R * K + C) * 2u; voffB[i] = (unsigned)(Rb * K + C) * 2u; }
    const size_t kstep = (size_t)(BK * 2);
    const size_t hstep = (size_t)HALF * K * 2;
    const size_t tstep = 2 * hstep;
    const unsigned ldsw = (unsigned)wid * 1024u;
    const int aoff = lds_byte(wr * 64 + fr, fq * 8), boff = lds_byte(wc * 32 + fr, fq * 8);
    constexpr int KSTEP = 1024;
#define PG8_SA(b, h) (((b) * 2 + (h)) * HTB)
#define PG8_SB(b, h) ((4 + (b) * 2 + (h)) * HTB)
#define PG8_STAGE(bufoff, gbase, voff) do { _Pragma("unroll") for (int _i = 0; _i < 2; ++_i) \
        __builtin_amdgcn_global_load_lds((const unsigned*)((const char*)(gbase) + (voff)[_i]), (PG8_LAS unsigned*)(lds + (bufoff) + ldsw + _i * 8192), 16, 0, 0); } while (0)
#define PG8_LDA(dst, b, h) do { _Pragma("unroll") for (int m = 0; m < 4; ++m) _Pragma("unroll") for (int k = 0; k < 2; ++k) dst[m][k] = *(const PG8_LAS bf16x8*)(lds + PG8_SA(b, h) + aoff + m * 2048 + k * KSTEP); } while (0)
#define PG8_LDB(dst, b, h) do { _Pragma("unroll") for (int n = 0; n < 2; ++n) _Pragma("unroll") for (int k = 0; k < 2; ++k) dst[n][k] = *(const PG8_LAS bf16x8*)(lds + PG8_SB(b, h) + boff + n * 2048 + k * KSTEP); } while (0)
#define PG8_CAT8(x) __builtin_shufflevector(__builtin_bit_cast(i32x4, (x)[0]), __builtin_bit_cast(i32x4, (x)[1]), 0, 1, 2, 3, 4, 5, 6, 7)
#define PG8_MMA(ai, bj, At, Bt) do { __builtin_amdgcn_s_setprio(1); _Pragma("unroll") for (int m = 0; m < 4; ++m) _Pragma("unroll") for (int n = 0; n < 2; ++n) { \
        if constexpr (F8) asm volatile("s_nop 1\n\tv_mfma_f32_16x16x128_f8f6f4 %0, %1, %2, %0" : "+v"(acc[ai][bj][m][n]) : "v"(PG8_CAT8(Bt[n])), "v"(PG8_CAT8(At[m]))); \
        else { _Pragma("unroll") for (int k = 0; k < 2; ++k) acc[ai][bj][m][n] = __builtin_amdgcn_mfma_f32_16x16x32_bf16(Bt[n][k], At[m][k], acc[ai][bj][m][n], 0, 0, 0); } } \
        __builtin_amdgcn_s_setprio(0); } while (0)
#define PG8_MMA0(ai, bj, At, Bt) do { __builtin_amdgcn_s_setprio(1); _Pragma("unroll") for (int m = 0; m < 4; ++m) _Pragma("unroll") for (int n = 0; n < 2; ++n) \
        asm volatile("s_nop 1\n\tv_mfma_f32_16x16x128_f8f6f4 %0, %1, %2, 0" : "=&v"(acc[ai][bj][m][n]) : "v"(PG8_CAT8(Bt[n])), "v"(PG8_CAT8(At[m]))); \
        __builtin_amdgcn_s_setprio(0); } while (0)
#define PG8_MMAF(ai, bj, At, Bt) do { if constexpr (F8) { if (t == 0) PG8_MMA0(ai, bj, At, Bt); else PG8_MMA(ai, bj, At, Bt); } else PG8_MMA(ai, bj, At, Bt); } while (0)
#define PG8_WAIT_V(n) asm volatile("s_waitcnt vmcnt(" #n ")" ::: "memory")
#define PG8_WAIT_L(n) asm volatile("s_waitcnt lgkmcnt(" #n ")" ::: "memory")
#define PG8_BAR __builtin_amdgcn_s_barrier()
#define PG8_SCHED __builtin_amdgcn_sched_barrier(0)
    Unit cur, nxt; int ui = 0;
    if (!S.next(0, cur)) return;
    f32x4 acc[2][2][4][2];
    if constexpr (!F8) {
#pragma unroll
    for (int a = 0; a < 2; ++a)
#pragma unroll
        for (int b = 0; b < 2; ++b)
#pragma unroll
            for (int m = 0; m < 4; ++m)
#pragma unroll
                for (int n = 0; n < 2; ++n) acc[a][b][m][n] = (f32x4){0.f, 0.f, 0.f, 0.f};
    }
    bf16x8 At[4][2], B0[2][2], B1[2][2];
    const char* cA = (const char*)g.A + (size_t)cur.pm * tstep + (size_t)cur.kt0 * kstep; const char* cB = (const char*)g.Bt + (size_t)cur.pn * tstep + (size_t)cur.kt0 * kstep;
    S.a_ready(cur);
    if constexpr (SP2) {
        PG8_STAGE(PG8_SB(0, 0), cB, voffB); PG8_STAGE(PG8_SB(0, 1), cB + hstep, voffB); PG8_STAGE(PG8_SA(0, 0), cA, voffA); PG8_STAGE(PG8_SA(0, 1), cA + hstep, voffA);
        if (wr == 1) PG8_BAR;
        PG8_WAIT_V(2); PG8_BAR;
        PG8_STAGE(PG8_SB(1, 0), cB + kstep, voffB); PG8_STAGE(PG8_SA(1, 0), cA + kstep, voffA); PG8_STAGE(PG8_SB(1, 1), cB + hstep + kstep, voffB);
        PG8_WAIT_V(6); PG8_BAR;
    } else {
        PG8_STAGE(PG8_SB(0, 0), cB, voffB); PG8_STAGE(PG8_SA(0, 0), cA, voffA); PG8_STAGE(PG8_SB(0, 1), cB + hstep, voffB); PG8_STAGE(PG8_SA(0, 1), cA + hstep, voffA);
        if (wr == 1) PG8_BAR;
        PG8_WAIT_V(4); PG8_BAR;
        PG8_STAGE(PG8_SB(1, 0), cB + kstep, voffB); PG8_STAGE(PG8_SA(1, 0), cA + kstep, voffA); PG8_STAGE(PG8_SB(1, 1), cB + hstep + kstep, voffB);
        PG8_WAIT_V(6); PG8_BAR;
    }
    for (;;) {
        const bool has_next = S.next(ui + 1, nxt);
        const char* nA = has_next ? (const char*)g.A + (size_t)nxt.pm * tstep + (size_t)nxt.kt0 * kstep : cA; const char* nB = has_next ? (const char*)g.Bt + (size_t)nxt.pn * tstep + (size_t)nxt.kt0 * kstep : cB;
        const int ntu = cur.nkt ? cur.nkt : nt;
        for (int t = 0; t < ntu; t += 2) {
            const bool last = (t == ntu - 2);
            const char* a1 = cA + (size_t)(t + 1) * kstep;
            const char* a2 = last ? nA : cA + (size_t)(t + 2) * kstep; const char* b2 = last ? nB : cB + (size_t)(t + 2) * kstep;
            const char* a3 = a2 + kstep; const char* b3 = b2 + kstep;
            if (last && has_next) S.a_ready(nxt);
            if constexpr (SP2) {
            PG8_LDB(B0, 0, 0); PG8_LDB(B1, 0, 1); PG8_SCHED; PG8_LDA(At, 0, 0); PG8_STAGE(PG8_SA(1, 1), a1 + hstep, voffA);
            PG8_WAIT_V(8); PG8_WAIT_L(0); PG8_BAR; PG8_MMAF(0, 0, At, B0); PG8_MMAF(0, 1, At, B1); PG8_BAR; PG8_SCHED;
            PG8_LDA(At, 0, 1); PG8_STAGE(PG8_SB(0, 0), b2, voffB); PG8_STAGE(PG8_SB(0, 1), b2 + hstep, voffB); PG8_STAGE(PG8_SA(0, 0), a2, voffA);
            PG8_WAIT_V(8); PG8_WAIT_L(0); PG8_BAR; PG8_MMAF(1, 0, At, B0); PG8_MMAF(1, 1, At, B1); PG8_BAR; PG8_SCHED;
            PG8_LDB(B0, 1, 0); PG8_LDB(B1, 1, 1); PG8_SCHED; PG8_LDA(At, 1, 0); PG8_STAGE(PG8_SA(0, 1), a2 + hstep, voffA);
            PG8_WAIT_V(8); PG8_WAIT_L(0); PG8_BAR; PG8_MMA(0, 0, At, B0); PG8_MMA(0, 1, At, B1); PG8_BAR; PG8_SCHED;
            PG8_LDA(At, 1, 1); PG8_STAGE(PG8_SB(1, 0), b3, voffB); PG8_STAGE(PG8_SB(1, 1), b3 + hstep, voffB); PG8_STAGE(PG8_SA(1, 0), a3, voffA);
            PG8_WAIT_V(8); PG8_WAIT_L(0); PG8_BAR; PG8_MMA(1, 0, At, B0); PG8_MMA(1, 1, At, B1); PG8_BAR; PG8_SCHED;
            } else {
            PG8_LDB(B0, 0, 0); PG8_SCHED; PG8_LDA(At, 0, 0); PG8_STAGE(PG8_SA(1, 1), a1 + hstep, voffA);
            PG8_WAIT_L(8); PG8_BAR; PG8_WAIT_L(0); PG8_MMAF(0, 0, At, B0); PG8_BAR; PG8_SCHED;
            PG8_LDB(B1, 0, 1); PG8_STAGE(PG8_SB(0, 0), b2, voffB);
            PG8_BAR; PG8_WAIT_L(0); PG8_MMAF(0, 1, At, B1); PG8_BAR;
            PG8_LDA(At, 0, 1); PG8_STAGE(PG8_SA(0, 0), a2, voffA);
            PG8_BAR; PG8_WAIT_L(0); PG8_MMAF(1, 0, At, B0); PG8_BAR; PG8_SCHED;
            PG8_STAGE(PG8_SB(0, 1), b2 + hstep, voffB);
            PG8_WAIT_V(6); PG8_BAR; PG8_MMAF(1, 1, At, B1); PG8_BAR;
            PG8_LDB(B0, 1, 0); PG8_SCHED; PG8_LDA(At, 1, 0); PG8_STAGE(PG8_SA(0, 1), a2 + hstep, voffA);
            PG8_WAIT_L(8); PG8_BAR; PG8_WAIT_L(0); PG8_MMA(0, 0, At, B0); PG8_BAR; PG8_SCHED;
            PG8_LDB(B1, 1, 1); PG8_STAGE(PG8_SB(1, 0), b3, voffB);
            PG8_BAR; PG8_WAIT_L(0); PG8_MMA(0, 1, At, B1); PG8_BAR;
            PG8_LDA(At, 1, 1); PG8_STAGE(PG8_SA(1, 0), a3, voffA);
            PG8_BAR; PG8_WAIT_L(0); PG8_MMA(1, 0, At, B0); PG8_BAR; PG8_SCHED;
            PG8_STAGE(PG8_SB(1, 1), b3 + hstep, voffB);
            PG8_WAIT_V(6); PG8_BAR; PG8_MMA(1, 1, At, B1); PG8_BAR;
            }
        }
        if constexpr (F8) asm volatile("s_nop 15\n\ts_nop 15" ::: "memory");
        if constexpr (ALIGN_EPI) { if (wr == 0) PG8_BAR; }
        if constexpr (!Epi::AFTER_DRAIN) { E(acc, cur, wr, wc, fr, fq); S.done(cur); }
        if (!has_next) break;
        if constexpr (!F8) {
#pragma unroll
        for (int a = 0; a < 2; ++a)
#pragma unroll
            for (int b = 0; b < 2; ++b)
#pragma unroll
                for (int m = 0; m < 4; ++m)
#pragma unroll
                    for (int n = 0; n < 2; ++n) acc[a][b][m][n] = (f32x4){0.f, 0.f, 0.f, 0.f};
        }
        cur = nxt; cA = nA; cB = nB; ++ui;
        if constexpr (ALIGN_EPI) { if (wr == 1) PG8_BAR; }
    }
    PG8_WAIT_V(0);
    if constexpr (!ALIGN_EPI) { if (wr == 0) PG8_BAR; }
    PG8_BAR;
    if constexpr (Epi::AFTER_DRAIN) { E.fused(acc, cur, wr, wc, fr, fq, lds, wid, lane); S.done(cur); }
#undef PG8_SA
#undef PG8_SB
#undef PG8_STAGE
#undef PG8_LDA
#undef PG8_LDB
#undef PG8_MMA
#undef PG8_MMA0
#undef PG8_MMAF
#undef PG8_CAT8
#undef PG8_WAIT_V
#undef PG8_WAIT_L
#undef PG8_BAR
#undef PG8_SCHED
}
}
#include <hip/hip_bf16.h>
#include <cmath>
namespace attn_body {
using bf16=__hip_bfloat16;
using bf16x8=__attribute__((ext_vector_type(8)))short;
using s16x4=__attribute__((ext_vector_type(4)))short;
using f32x16=__attribute__((ext_vector_type(16)))float;
using u32x4=__attribute__((ext_vector_type(4)))unsigned;
constexpr int BATCH=8,NHEAD=16,SEQ=2048,D=64,DM=NHEAD*D;
constexpr int NW=8,QBLK=32,QB=QBLK*NW,KVBLK=64,NQB=SEQ/QB;
constexpr int ATTN_PITCH=DM, ATTN_UNIT_ROWS=QB;
__device__ __forceinline__ int crow(int r,int hi){return (r&3)+8*(r>>2)+4*hi;}
#define SBAR() __builtin_amdgcn_sched_barrier(0)
__device__ __forceinline__ void cmask(f32x16&p0,f32x16&p1,int jb,int qrel,int hi){
  const float NEG=-INFINITY; int kb=64*jb+4*hi;
  #pragma unroll
  for(int r=0;r<16;++r){int kv=kb+(r&3)+8*(r>>2); if(kv>qrel)p0[r]=NEG; if(kv+32>qrel)p1[r]=NEG;}
}

constexpr int NSLOT=3, SLOTB=8192;
constexpr int LDS_K=0, LDS_V=NSLOT*SLOTB, LDS_WS=3*NSLOT*SLOTB, LDS_QS=LDS_WS+NW*64*4, LDS_OST=LDS_QS+NW*4096, LDS_BYTES=LDS_OST+NW*4096;
constexpr float C2=0.125f*1.4426950408889634f;
__device__ __forceinline__ void glds16(const void*gsrc,unsigned lds_dst){unsigned keep;
  asm volatile("s_mov_b32 %0, m0\n\ts_mov_b32 m0, %2\n\ts_nop 0\n\tglobal_load_lds_dwordx4 %1, off\n\ts_mov_b32 m0, %0":"=&s"(keep):"v"(gsrc),"s"(lds_dst):"memory");}
__device__ __forceinline__ float max3f(float a,float b,float c){float r;asm("v_max3_f32 %0, %1, %2, %3":"=v"(r):"v"(a),"v"(b),"v"(c));return r;}
__device__ __forceinline__ float max2f(float a,float b){float r;asm("v_max_f32_e32 %0, %1, %2":"=v"(r):"v"(a),"v"(b));return r;}
__device__ __forceinline__ float fadd_s(float a,float b){float r;asm("v_add_f32_e32 %0, %1, %2":"=v"(r):"v"(a),"v"(b));return r;}
__device__ __forceinline__ float fsub_s(float a,float b){float r;asm("v_sub_f32_e32 %0, %1, %2":"=v"(r):"v"(a),"v"(b));return r;}
typedef float f32x2_t __attribute__((ext_vector_type(2))); typedef __bf16 bf16x2_t __attribute__((ext_vector_type(2)));
__device__ __forceinline__ unsigned cvtpk_s(float lo,float hi){f32x2_t v={lo,hi};bf16x2_t b=__builtin_convertvector(v,bf16x2_t);return __builtin_bit_cast(unsigned,b);}
#define WAIT_BAR(N) asm volatile("s_waitcnt vmcnt(" #N ") lgkmcnt(0)\n\ts_barrier":::"memory")

__device__ __forceinline__ void qkt(f32x16&p0,f32x16&p1,const char*Kslot,const bf16x8*qr,int r32,int hi){ const f32x16 negm=f32x16{};
  const char*kb=Kslot+hi*1024+r32*16;
  #pragma unroll
  for(int d0=0;d0<4;++d0){
    const bf16x8 b0=*reinterpret_cast<const bf16x8*>(kb+d0*2048);
    const bf16x8 b1=*reinterpret_cast<const bf16x8*>(kb+d0*2048+512);
    if(d0==0){p0=__builtin_amdgcn_mfma_f32_32x32x16_bf16(b0,qr[0],negm,0,0,0);p1=__builtin_amdgcn_mfma_f32_32x32x16_bf16(b1,qr[0],negm,0,0,0);}
    else{p0=__builtin_amdgcn_mfma_f32_32x32x16_bf16(b0,qr[d0],p0,0,0,0);p1=__builtin_amdgcn_mfma_f32_32x32x16_bf16(b1,qr[d0],p1,0,0,0);}}
}
typedef __attribute__((address_space(3))) const char* lds_cptr;
typedef short v4i16_t __attribute__((ext_vector_type(4)));
__device__ __forceinline__ void kload8(bf16x8*kf,lds_cptr kp){
  kf[0]=*(const __attribute__((address_space(3))) bf16x8*)(kp);      kf[1]=*(const __attribute__((address_space(3))) bf16x8*)(kp+512);
  kf[2]=*(const __attribute__((address_space(3))) bf16x8*)(kp+2048); kf[3]=*(const __attribute__((address_space(3))) bf16x8*)(kp+2560);
  kf[4]=*(const __attribute__((address_space(3))) bf16x8*)(kp+4096); kf[5]=*(const __attribute__((address_space(3))) bf16x8*)(kp+4608);
  kf[6]=*(const __attribute__((address_space(3))) bf16x8*)(kp+6144); kf[7]=*(const __attribute__((address_space(3))) bf16x8*)(kp+6656);
}
__device__ __forceinline__ void kload2(bf16x8*kf,lds_cptr kp,int j){ kf[2*j]=*(const __attribute__((address_space(3))) bf16x8*)(kp+j*2048); kf[2*j+1]=*(const __attribute__((address_space(3))) bf16x8*)(kp+j*2048+512); }
__device__ __forceinline__ s16x4 vtr(lds_cptr p){ return __builtin_bit_cast(s16x4,__builtin_amdgcn_ds_read_tr16_b64_v4i16((__attribute__((address_space(3))) v4i16_t*)p)); }
__device__ __forceinline__ float rowmax(const f32x16&p0,const f32x16&p1){
  float a=max3f(p0[0],p0[1],p1[0]),b=max3f(p0[2],p0[3],p1[1]);a=max3f(a,p1[2],p1[3]);
  #pragma unroll
  for(int r=4;r<16;r+=4){a=max3f(a,p0[r],p0[r+1]);b=max3f(b,p0[r+2],p0[r+3]);a=max3f(a,p1[r],p1[r+1]);b=max3f(b,p1[r+2],p1[r+3]);}
  const float m=max2f(a,b);
  auto rr=__builtin_amdgcn_permlane32_swap(__float_as_uint(m),__float_as_uint(m),false,false);
  return max2f(__uint_as_float(rr[0]),__uint_as_float(rr[1]));
}
__device__ __forceinline__ void pv(f32x16*o,int vb,bf16x8 pa0,bf16x8 pa1,bf16x8 pa2,bf16x8 pa3){
  #pragma unroll
  for(int d0=0;d0<4;++d0){s16x4 lo[4],hi[4];
    #pragma unroll
    for(int ks=0;ks<4;++ks){
      asm volatile("ds_read_b64_tr_b16 %0,%1 offset:%c2":"=&v"(lo[ks]):"v"(vb),"i"(d0*4096+ks*1024):"memory");
      asm volatile("ds_read_b64_tr_b16 %0,%1 offset:%c2":"=&v"(hi[ks]):"v"(vb),"i"(d0*4096+ks*1024+512):"memory");}
    asm volatile("s_waitcnt lgkmcnt(0)":::"memory");SBAR();
    #define PK(k) (bf16x8){lo[k][0],lo[k][1],lo[k][2],lo[k][3],hi[k][0],hi[k][1],hi[k][2],hi[k][3]}
    o[d0]=__builtin_amdgcn_mfma_f32_32x32x16_bf16(pa0,PK(0),o[d0],0,0,0);
    o[d0]=__builtin_amdgcn_mfma_f32_32x32x16_bf16(pa1,PK(1),o[d0],0,0,0);
    o[d0]=__builtin_amdgcn_mfma_f32_32x32x16_bf16(pa2,PK(2),o[d0],0,0,0);
    o[d0]=__builtin_amdgcn_mfma_f32_32x32x16_bf16(pa3,PK(3),o[d0],0,0,0);
    #undef PK
  }
}

#ifndef ATTN_STORE16
#define ATTN_STORE16(p,v) pg8::st16_wt((void*)(p),(v))
#endif
template<int THRL,int MODE,bool PRE=false,bool NEXT=false> __device__ __forceinline__ void attn_unit(int b,int qcol,int vcol,int qb,const bf16*Q,const bf16*__restrict__ K,const bf16*__restrict__ V,bf16*O,char*shm,bf16*ON,float lam,const float*subn,int nqcol=0){
  int tid_=threadIdx.x; asm volatile("":"+v"(tid_));
  const int tid=tid_,lane=tid&63,r32=lane&31,hi=lane>>5; const int wid=__builtin_amdgcn_readfirstlane(tid>>6);
  const long rowbase=(long)b*SEQ; const int q0=qb*QB;
  const bf16*Qw=Q+(rowbase+q0+wid*QBLK)*DM+qcol;
  const bf16*Kh=K+rowbase*DM+qcol,*Vh=V+rowbase*DM+vcol;
  const unsigned lds0=(unsigned)(uintptr_t)shm;
  float*wsf=(float*)(shm+LDS_WS)+wid*64;
  const bf16*ksrc=Kh+(long)lane*DM+wid*8;
  const bf16*vsrc=Vh+(long)(16*(wid&3)+(lane>>2))*DM+(wid>>2)*32+(lane&3)*8;
  const unsigned kdst=lds0+LDS_K+wid*1024, vdst=lds0+LDS_V+wid*1024;
  #define DMA_K(t,slot) glds16(ksrc+(long)(t)*KVBLK*DM,(unsigned)__builtin_amdgcn_readfirstlane(kdst+(slot)))
  #define DMA_V(t,slot) do{ glds16(vsrc+(long)(t)*KVBLK*DM,(unsigned)__builtin_amdgcn_readfirstlane(vdst+2*(slot))); glds16(vsrc+(long)(t)*KVBLK*DM+64,(unsigned)__builtin_amdgcn_readfirstlane(vdst+2*(slot)+8192)); }while(0)
  const int vb0=(int)(lds0+LDS_V)+((lane>>4)&1)*32+(lane&3)*8+(4*hi+((lane&15)>>2))*64;
  const char*Kbase=shm+LDS_K; bf16x8 kf[8];
  const lds_cptr shm3=(lds_cptr)shm; const lds_cptr kp0=shm3+LDS_K+hi*1024+r32*16; const lds_cptr vp0=shm3+LDS_V+((lane>>4)&1)*32+(lane&3)*8+(4*hi+((lane&15)>>2))*64;
  const int NT=(q0+QB)/KVBLK;
  if constexpr(!PRE){ DMA_K(0,0);DMA_V(0,0);DMA_K(1,SLOTB); }
  bf16x8 qr[4];
  #pragma unroll
  for(int d0=0;d0<4;++d0)qr[d0]=*reinterpret_cast<const bf16x8*>(&Qw[(long)r32*DM+d0*16+hi*8]);
  float mhat=0.f,l_reg=0.f;f32x16 o[4];o[0]=f32x16{};o[1]=f32x16{};o[2]=f32x16{};o[3]=f32x16{};
  typedef __attribute__((address_space(3))) bf16x8* lds_q8; const lds_cptr qp0=shm3+LDS_QS+wid*4096+lane*16;
  #define QF(j) (*(const __attribute__((address_space(3))) bf16x8*)(qp0+(j)*1024))
  const int qrel=wid*QBLK+r32;
  #define CMASK(P0,P1,t) do{int jb_=(t)-(NT-4); if(jb_>=0)cmask(P0,P1,jb_,qrel,hi);}while(0)
  bool resc=false;
  #define START(P0,P1) do{ resc=false; if constexpr(THRL>=0){ const float rm=rowmax(P0,P1); \
    { const float dl=rm; mhat=fadd_s(mhat,dl); \
      _Pragma("unroll") for(int r=0;r<16;++r){P0[r]=fsub_s(P0[r],dl);P1[r]=fsub_s(P1[r],dl);} } } \
    _Pragma("unroll") for(int r=0;r<16;++r)P0[r]=__builtin_amdgcn_exp2f(P0[r]); }while(0)
  #define RESC() do{ if(resc){ asm volatile("s_waitcnt lgkmcnt(0)":::"memory"); \
      _Pragma("unroll") for(int d_=0;d_<4;++d_) _Pragma("unroll") for(int r=0;r<16;++r)o[d_][r]*=wsf[crow(r,hi)]; } }while(0)
  f32x16 pA0,pA1,pB0,pB1;
  int sl_prev=0,sl_cur=0,sl_next=SLOTB;
  #define ROT() do{sl_prev=sl_cur;sl_cur=sl_next;sl_next=(sl_next==(NSLOT-1)*SLOTB)?0:sl_next+SLOTB;}while(0)
  DMA_K(2,2*SLOTB);
  _Pragma("unroll") for(int d0=0;d0<4;++d0)*(__attribute__((address_space(3))) bf16x8*)(__attribute__((address_space(3))) char*)(qp0+d0*1024)=qr[d0];
  WAIT_BAR(4);
  qkt(pA0,pA1,Kbase,qr,r32,hi);asm volatile("s_nop 15\n\ts_nop 7":"+v"(pA0),"+v"(pA1));CMASK(pA0,pA1,0);
  START(pA0,pA1);
  _Pragma("unroll") for(int r=0;r<16;++r)pA1[r]=__builtin_amdgcn_exp2f(pA1[r]);
  WAIT_BAR(0);
  DMA_K(3,0);DMA_V(1,SLOTB);
  ROT();
  kload8(kf,kp0+sl_cur);
  bf16x8 qa=QF(0),qb_=QF(1);
  WAIT_BAR(3);
  s16x4 vlo[8],vhi[8]; u32x4 pw0,pw1,pw2,pw3;
  #define PKW(P,B) cvtpk_s(P[B],P[B+1])
  #define PAF(k) __builtin_bit_cast(bf16x8,pw##k)
  #define VFR(i) (bf16x8){vlo[i][0],vlo[i][1],vlo[i][2],vlo[i][3],vhi[i][0],vhi[i][1],vhi[i][2],vhi[i][3]}
  #define PIN(x) asm volatile("":"+v"(x))
  #define MX3(a,b,c) __builtin_fmaxf(__builtin_fmaxf((a),(b)),(c))
  #define GAPA(MF,A0,A1,A2,A3,W0,W1,PW) do{ MF; sacc+=A0; sacc2+=A1; sacc+=A2; sacc2+=A3; PIN(sacc); PIN(sacc2); W0; W1; PIN(PW); SBAR(); }while(0)
  #define EX(v) __builtin_amdgcn_exp2f(v)
  #define GAPB(MF,X,B) do{ MF; X[B]=EX(X[B]); X[B+1]=EX(X[B+1]); PIN(X); SBAR(); }while(0)
  #define VRD(i) do{ vlo[i]=vtr(vp_+(((i)>>2)*4096+((i)&3)*1024)); vhi[i]=vtr(vp_+(((i)>>2)*4096+((i)&3)*1024+512)); }while(0)
  #define VRDX(reg,fr) do{ vlo[reg]=vtr(vp_+(((fr)>>2)*4096+((fr)&3)*1024)); vhi[reg]=vtr(vp_+(((fr)>>2)*4096+((fr)&3)*1024+512)); SBAR(); }while(0)
  #define KRD(G,j) do{ if(G){ kload2(kf,kp0+sl_next,j); SBAR(); } }while(0)
  #define ZC f32x16{}
  #define STEP(C0,C1,P0,P1,t,GK,GV,GL) do{ SBAR(); \
    const lds_cptr vp_=vp0+2*sl_prev; \
    VRD(0); SBAR(); float sacc=P0[0],sacc2=P0[1]; \
    GAPA(C0=__builtin_amdgcn_mfma_f32_32x32x16_bf16(kf[0],qa,ZC,0,0,0), P0[2],P0[3],P0[4],P0[5],     pw0[0]=PKW(P0,0), pw0[1]=PKW(P0,2), pw0); \
    VRD(4); SBAR(); GAPA(C1=__builtin_amdgcn_mfma_f32_32x32x16_bf16(kf[1],qa,ZC,0,0,0), P0[6],P0[7],P0[8],P0[9],     pw0[2]=PKW(P0,4), pw0[3]=PKW(P0,6), pw0); \
    qa=QF(2); SBAR(); \
    VRD(1); SBAR(); GAPA(C0=__builtin_amdgcn_mfma_f32_32x32x16_bf16(kf[2],qb_,C0,0,0,0),   P0[10],P0[11],P0[12],P0[13], pw1[0]=PKW(P0,8), pw1[1]=PKW(P0,10), pw1); \
    VRD(5); SBAR(); GAPA(C1=__builtin_amdgcn_mfma_f32_32x32x16_bf16(kf[3],qb_,C1,0,0,0),   P0[14],P0[15],P1[0],P1[1],   pw1[2]=PKW(P0,12),pw1[3]=PKW(P0,14), pw1); \
    qb_=QF(3); SBAR(); \
    VRD(2); SBAR(); GAPA(C0=__builtin_amdgcn_mfma_f32_32x32x16_bf16(kf[4],qa,C0,0,0,0),   P1[2],P1[3],P1[4],P1[5],     pw2[0]=PKW(P1,0), pw2[1]=PKW(P1,2), pw2); \
    VRD(6); SBAR(); GAPA(C1=__builtin_amdgcn_mfma_f32_32x32x16_bf16(kf[5],qa,C1,0,0,0),   P1[6],P1[7],P1[8],P1[9],     pw2[2]=PKW(P1,4), pw2[3]=PKW(P1,6), pw2); \
    VRD(3); SBAR(); GAPA(C0=__builtin_amdgcn_mfma_f32_32x32x16_bf16(kf[6],qb_,C0,0,0,0),   P1[10],P1[11],P1[12],P1[13], pw3[0]=PKW(P1,8), pw3[1]=PKW(P1,10), pw3); \
    VRD(7); SBAR(); GAPA(C1=__builtin_amdgcn_mfma_f32_32x32x16_bf16(kf[7],qb_,C1,0,0,0),   P1[14],P1[15],0.f,0.f,       pw3[2]=PKW(P1,12),pw3[3]=PKW(P1,14), pw3); \
    l_reg+=sacc+sacc2; \
    if(GK){DMA_K((t)+3,sl_cur);} if(GV){DMA_V((t)+1,sl_next);} \
    CMASK(C0,C1,t); \
    if constexpr(THRL>=0){ float a=MX3(C0[0],C0[1],C1[0]),b=MX3(C0[2],C0[3],C1[1]); a=MX3(a,C1[2],C1[3]); \
      _Pragma("unroll") for(int r=4;r<16;r+=4){a=MX3(a,C0[r],C0[r+1]);b=MX3(b,C0[r+2],C0[r+3]);a=MX3(a,C1[r],C1[r+1]);b=MX3(b,C1[r+2],C1[r+3]);} \
      float rm=__builtin_fmaxf(a,b); { auto rr=__builtin_amdgcn_permlane32_swap(__float_as_uint(rm),__float_as_uint(rm),false,false); rm=__builtin_fmaxf(__uint_as_float(rr[0]),__uint_as_float(rr[1])); } \
      rm-=mhat; resc=false;                                      \
      if(__builtin_expect(__any(rm>(float)THRL),0)){ const float dl=__builtin_fmaxf(rm,0.f); mhat+=dl; \
        const float f=__builtin_amdgcn_exp2f(-dl); l_reg*=f; if(hi==0)wsf[r32]=f; resc=true; } \
      _Pragma("unroll") for(int r=0;r<16;++r){C0[r]-=mhat;C1[r]-=mhat;} } \
    SBAR(); \
    GAPB(o[0]=__builtin_amdgcn_mfma_f32_32x32x16_bf16(PAF(0),VFR(0),o[0],0,0,0), C0,0);  VRDX(0,8); \
    GAPB(o[1]=__builtin_amdgcn_mfma_f32_32x32x16_bf16(PAF(0),VFR(4),o[1],0,0,0), C0,2);  VRDX(4,12); \
    GAPB(o[0]=__builtin_amdgcn_mfma_f32_32x32x16_bf16(PAF(1),VFR(1),o[0],0,0,0), C0,4);  VRDX(1,9); \
    GAPB(o[1]=__builtin_amdgcn_mfma_f32_32x32x16_bf16(PAF(1),VFR(5),o[1],0,0,0), C0,6);  VRDX(5,13); \
    GAPB(o[0]=__builtin_amdgcn_mfma_f32_32x32x16_bf16(PAF(2),VFR(2),o[0],0,0,0), C0,8);  VRDX(2,10); \
    GAPB(o[1]=__builtin_amdgcn_mfma_f32_32x32x16_bf16(PAF(2),VFR(6),o[1],0,0,0), C0,10); VRDX(6,14); \
    GAPB(o[0]=__builtin_amdgcn_mfma_f32_32x32x16_bf16(PAF(3),VFR(3),o[0],0,0,0), C0,12); VRDX(3,11); \
    GAPB(o[1]=__builtin_amdgcn_mfma_f32_32x32x16_bf16(PAF(3),VFR(7),o[1],0,0,0), C0,14); VRDX(7,15); \
    KRD(GL,0); GAPB(o[2]=__builtin_amdgcn_mfma_f32_32x32x16_bf16(PAF(0),VFR(0),o[2],0,0,0), C1,0); \
    KRD(GL,1); GAPB(o[3]=__builtin_amdgcn_mfma_f32_32x32x16_bf16(PAF(0),VFR(4),o[3],0,0,0), C1,2); \
    KRD(GL,2); GAPB(o[2]=__builtin_amdgcn_mfma_f32_32x32x16_bf16(PAF(1),VFR(1),o[2],0,0,0), C1,4); \
    KRD(GL,3); GAPB(o[3]=__builtin_amdgcn_mfma_f32_32x32x16_bf16(PAF(1),VFR(5),o[3],0,0,0), C1,6); \
    GAPB(o[2]=__builtin_amdgcn_mfma_f32_32x32x16_bf16(PAF(2),VFR(2),o[2],0,0,0), C1,8); \
    GAPB(o[3]=__builtin_amdgcn_mfma_f32_32x32x16_bf16(PAF(2),VFR(6),o[3],0,0,0), C1,10); \
    qa=QF(0); SBAR(); \
    GAPB(o[2]=__builtin_amdgcn_mfma_f32_32x32x16_bf16(PAF(3),VFR(3),o[2],0,0,0), C1,12); \
    qb_=QF(1); SBAR(); \
    GAPB(o[3]=__builtin_amdgcn_mfma_f32_32x32x16_bf16(PAF(3),VFR(7),o[3],0,0,0), C1,14); \
    }while(0)
  int t=1;
  #undef CMASK
  #define CMASK(P0,P1,t) do{}while(0)
  for(;t+5<NT;t+=2){
    STEP(pB0,pB1,pA0,pA1,t,true,true,true);     WAIT_BAR(3); RESC(); ROT();
    STEP(pA0,pA1,pB0,pB1,t+1,true,true,true);   WAIT_BAR(3); RESC(); ROT();
  }
  #undef CMASK
  #define CMASK(P0,P1,t) do{int jb_=(t)-(NT-4); if(jb_>=0)cmask(P0,P1,jb_,qrel,hi);}while(0)
  #define ENDW(tt) do{ if((tt)+3<NT){WAIT_BAR(3);} else if((tt)+2<NT){WAIT_BAR(2);} else {WAIT_BAR(0);} }while(0)
  for(;t+1<NT;t+=2){
    STEP(pB0,pB1,pA0,pA1,t,(t+3<NT),(t+1<NT),(t+1<NT));       ENDW(t);   RESC(); ROT();
    STEP(pA0,pA1,pB0,pB1,t+1,(t+4<NT),(t+2<NT),(t+2<NT));     ENDW(t+1); RESC(); ROT();
  }
  STEP(pB0,pB1,pA0,pA1,NT-1,false,false,false); RESC();
  { float sacc=pB0[0]+pB0[1]; _Pragma("unroll") for(int r=2;r<16;++r)sacc+=pB0[r]; _Pragma("unroll") for(int r=0;r<16;++r)sacc+=pB1[r]; l_reg+=sacc;
    pw0=(u32x4){PKW(pB0,0),PKW(pB0,2),PKW(pB0,4),PKW(pB0,6)};pw1=(u32x4){PKW(pB0,8),PKW(pB0,10),PKW(pB0,12),PKW(pB0,14)};pw2=(u32x4){PKW(pB1,0),PKW(pB1,2),PKW(pB1,4),PKW(pB1,6)};pw3=(u32x4){PKW(pB1,8),PKW(pB1,10),PKW(pB1,12),PKW(pB1,14)};
    SBAR(); pv(o,vb0+2*sl_cur,PAF(0),PAF(1),PAF(2),PAF(3)); }
  asm volatile("s_waitcnt lgkmcnt(0)\n\ts_barrier":::"memory");
  if constexpr(NEXT){ const bf16*ksrc_n=K+rowbase*DM+nqcol+(long)lane*DM+wid*8;
    glds16(ksrc_n,(unsigned)__builtin_amdgcn_readfirstlane(kdst)); DMA_V(0,0); glds16(ksrc_n+(long)KVBLK*DM,(unsigned)__builtin_amdgcn_readfirstlane(kdst+SLOTB)); }
  #undef PKW
  #undef PAF
  #undef VFR
  #undef PIN
  #undef MX3
  #undef GAPA
  #undef GAPB
  #undef EX
  #undef VRD
  #undef VRDX
  #undef ZC
  #undef QF
  #undef KRD
  #undef STEP
  #undef ENDW
  {auto rr=__builtin_amdgcn_permlane32_swap(__float_as_uint(l_reg),__float_as_uint(l_reg),false,false);l_reg=__uint_as_float(rr[0])+__uint_as_float(rr[1]);}
  if(hi==0)wsf[32+r32]=l_reg;asm volatile("s_waitcnt lgkmcnt(0)":::"memory");
  float rli[16];
  #pragma unroll
  for(int r=0;r<16;++r)rli[r]=__builtin_amdgcn_rcpf(wsf[32+crow(r,hi)]);
  bf16*Ow=O+(rowbase+q0+wid*QBLK)*DM+vcol;
  if constexpr(MODE==0){ bf16*stg=(bf16*)(shm+LDS_OST)+wid*2048;
    #pragma unroll
    for(int hf=0;hf<2;++hf){
      #pragma unroll
      for(int r=0;r<16;++r){const int orow=crow(r,hi);
        #pragma unroll
        for(int d0=0;d0<2;++d0)stg[orow*64+d0*32+r32]=__float2bfloat16(o[2*hf+d0][r]*rli[r]);}
      asm volatile("s_waitcnt lgkmcnt(0)":::"memory");
      #pragma unroll
      for(int i=0;i<4;++i){const int row=i*8+(lane>>3),ch=lane&7; const u32x4 v=*(const u32x4*)(stg+row*64+ch*8); ATTN_STORE16(Ow+(long)row*DM+hf*64+ch*8,v);}
      asm volatile("s_waitcnt lgkmcnt(0)":::"memory"); } }
  else { bf16*stg0=(bf16*)(shm+LDS_OST)+wid*2048,*stg1=(bf16*)(shm+LDS_QS)+wid*2048;
    #pragma unroll
    for(int r=0;r<16;++r){const int orow=crow(r,hi);
      #pragma unroll
      for(int d0=0;d0<2;++d0){stg0[orow*64+d0*32+r32]=__float2bfloat16(o[d0][r]*rli[r]);stg1[orow*64+d0*32+r32]=__float2bfloat16(o[2+d0][r]*rli[r]);}}
    if constexpr(NEXT) asm volatile("s_waitcnt vmcnt(4) lgkmcnt(0)":::"memory");
    else asm volatile("s_waitcnt vmcnt(0) lgkmcnt(0)":::"memory");
    const int ch=lane&7; float g0[8],g1[8];
    #pragma unroll
    for(int j=0;j<8;++j){g0[j]=subn[ch*8+j];g1[j]=subn[64+ch*8+j];}
    bf16*ONw=ON+(rowbase+q0+wid*QBLK)*DM+vcol;
    #pragma unroll
    for(int i=0;i<4;++i){const int row=i*8+(lane>>3);
      const u32x4 a0=*(const u32x4*)(stg0+row*64+ch*8),a1=*(const u32x4*)(stg1+row*64+ch*8);
      const u32x4 b0=*(const u32x4*)(Ow+(long)row*DM+ch*8),b1=*(const u32x4*)(Ow+(long)row*DM+64+ch*8);
      float d[16];
      #pragma unroll
      for(int j=0;j<4;++j){
        d[2*j]  =__uint_as_float(b0[j]<<16)        -lam*__uint_as_float(a0[j]<<16);
        d[2*j+1]=__uint_as_float(b0[j]&0xffff0000u)-lam*__uint_as_float(a0[j]&0xffff0000u);
        d[8+2*j]  =__uint_as_float(b1[j]<<16)        -lam*__uint_as_float(a1[j]<<16);
        d[8+2*j+1]=__uint_as_float(b1[j]&0xffff0000u)-lam*__uint_as_float(a1[j]&0xffff0000u);}
      float ss=0.f;
      #pragma unroll
      for(int j=0;j<16;++j)ss+=d[j]*d[j];
      ss+=__shfl_xor(ss,1);ss+=__shfl_xor(ss,2);ss+=__shfl_xor(ss,4);
      const float rs=__builtin_amdgcn_rsqf(ss*(1.0f/128.0f)+1e-6f);
      u32x4 w0,w1;
      #pragma unroll
      for(int j=0;j<4;++j){w0[j]=cvtpk_s(d[2*j]*rs*g0[2*j],d[2*j+1]*rs*g0[2*j+1]);w1[j]=cvtpk_s(d[8+2*j]*rs*g1[2*j],d[8+2*j+1]*rs*g1[2*j+1]);}
      ATTN_STORE16(ONw+(long)row*DM+ch*8,w0);ATTN_STORE16(ONw+(long)row*DM+64+ch*8,w1);}
    asm volatile("s_waitcnt lgkmcnt(0)":::"memory"); }
  asm volatile("s_waitcnt lgkmcnt(0)":::"memory");
  #undef DMA_K
  #undef DMA_V
  #undef CMASK
  #undef START
  #undef RESC
  #undef ROT
}
constexpr int ATTN_LDS_BYTES=LDS_BYTES;
#undef SBAR
#undef WAIT_BAR
}
constexpr int NWAVES = 8;
constexpr int NPH = 15;
constexpr size_t MiB = 1u << 20;
constexpr size_t WS_CTL = 0, CTL_ZERO_BYTES = 40960;
constexpr size_t WS_W_IN = 1 * MiB;
constexpr size_t WS_W_OUT = WS_W_IN + (size_t)3072 * 1024 * 2;
constexpr size_t WS_W_GU = WS_W_OUT + (size_t)1024 * 1024 * 2;
constexpr size_t WS_W_DN = WS_W_GU + (size_t)5632 * 1024 * 2;
constexpr size_t WS_W_QKV = WS_W_DN + (size_t)1024 * 2816 * 2;
constexpr size_t WS_W_O = WS_W_QKV + (size_t)3072 * 1024 * 2;
constexpr size_t WS_W_MGU = WS_W_O + (size_t)1024 * 1024 * 2;
constexpr size_t WS_W_MDN = WS_W_MGU + (size_t)8 * 7168 * 1024 * 2;
constexpr size_t WS_W_END = WS_W_MDN + (size_t)8 * 1024 * 3584 * 2;
constexpr size_t WS_R = 202 * MiB;
constexpr size_t ACT = (size_t)M * D * 2;
constexpr size_t AR_S = 20 * MiB, AR_BB = 0, AR_UB = 4 * MiB, AR_G = 8 * MiB, AR_X8 = 0, AR_HACT = 2 * MiB, AR_Q = 0, AR_K = 4 * MiB, AR_V = 8 * MiB, AR_O0 = 12 * MiB, AR_ON = 16 * MiB;
#define ARP(off, pitch) (A_WS + WS_R + (size_t)(blockIdx.x & 7) * (AR_S - (size_t)SEQ * (pitch)) + (off))
static_assert(SEQ * 8 == M && AR_HACT + (size_t)SEQ * DFF <= AR_G && AR_ON + (size_t)SEQ * D * 2 <= AR_S, "arena map");
constexpr size_t WS_XG = WS_R, WS_Y = WS_R;
constexpr size_t WS_HM = WS_R + 36 * MiB;
constexpr size_t WS_PP = WS_R + 156 * MiB;
constexpr size_t WS_S = 440 * MiB;
constexpr size_t WS_XB = 632 * MiB;
constexpr size_t WS_SMALL = 792 * MiB;
constexpr size_t WS_SSQ = WS_SMALL;
constexpr size_t WS_SEL = WS_SMALL + 256 * 1024, WS_GATE = WS_SEL + 128 * 1024, WS_TOKSLOT = WS_GATE + 128 * 1024;
constexpr size_t WS_GATES = WS_TOKSLOT + 384 * 1024;
constexpr size_t WS_HIST = WS_GATES + 256 * 1024, WS_META = WS_HIST + 16 * 1024;
constexpr size_t WS_END = 796 * MiB;
static_assert(WS_W_END <= WS_R && WS_XG + (size_t)SLOTS * D <= WS_HM && WS_HM + (size_t)SLOTS * DFE <= WS_PP && WS_PP + (size_t)56 * 256 * D * 2 <= WS_S && 8 * AR_S <= WS_S - WS_R, "d_ws map");
constexpr int CW_TMO = 0, CW_CODE = 1, CW_FQ = 64, CW_FQ4 = 128, CW_MAPBAD = 192, CW_BAR = 4096, CW_XLSUB = 8192, CW_XLGEN = 8704;
constexpr int MISC_OFF = 0, RING_OFF = 1024, RING_BYTES = 131072, LDS_BYTES = 147456;
constexpr int P0_SCR = 16640;

#define GAS __attribute__((address_space(1)))
#define LAS __attribute__((address_space(3)))
typedef unsigned v4u __attribute__((ext_vector_type(4)));
typedef unsigned v2u __attribute__((ext_vector_type(2)));
typedef GAS unsigned gu32;
#define RLX_AGENT __ATOMIC_RELAXED, __HIP_MEMORY_SCOPE_AGENT
#define LDS_WAIT() asm volatile("s_waitcnt lgkmcnt(0)" ::: "memory")
#define VM_WAIT() asm volatile("s_waitcnt vmcnt(0)" ::: "memory")
__device__ __forceinline__ unsigned pk2(float lo, float hi) { return f2bf(lo) | (f2bf(hi) << 16); }
__device__ __forceinline__ float bflo(unsigned w) { return __builtin_bit_cast(float, w << 16); }
__device__ __forceinline__ float bfhi(unsigned w) { return __builtin_bit_cast(float, w & 0xffff0000u); }

#define XB_TMO      128
#define XB_XCNT(j)  (256  + 64 * (j))
#define XB_XSUB(j)  (1280 + 64 * (j))
#define XB_XGEN(j)  (2304 + 64 * (j))
#define XB_TOP      3328
#define XB_TOPGEN   3392
#define XCD_BAR_WORDS 3456
#define XB_SPIN_CAP (1u << 18)

__device__ __forceinline__ unsigned xb_ld(unsigned* p)              { return __hip_atomic_load(p, __ATOMIC_RELAXED, __HIP_MEMORY_SCOPE_AGENT); }
__device__ __forceinline__ unsigned xb_add(unsigned* p, unsigned v) { return __hip_atomic_fetch_add(p, v, __ATOMIC_RELAXED, __HIP_MEMORY_SCOPE_AGENT); }
__device__ __forceinline__ unsigned xb_xcc_id() { return (unsigned)__builtin_amdgcn_s_getreg((3 << 11) | 20) & 0xFu; }
#define XB_SPIN(cond, bar) do { unsigned _sp = 0; while (cond) { __builtin_amdgcn_s_sleep(1); \
    if ((++_sp & 255u) == 0u) { if (xb_ld(&(bar)[XB_TMO])) break; if (_sp > XB_SPIN_CAP) { atomicAdd(&(bar)[XB_TMO], 1u); break; } } } } while (0)

struct XcdBarrier {
    unsigned* bar; unsigned x;
    volatile LAS unsigned* st;
};

__device__ __forceinline__ XcdBarrier xcd_barrier_post(unsigned* bar, volatile LAS unsigned* st) {
    XcdBarrier b; b.bar = bar; b.x = xb_xcc_id(); b.st = st;
    if (threadIdx.x == 0) (void)xb_add(&bar[XB_XCNT(b.x)], 1u);
    return b;
}
__device__ __forceinline__ void xcd_barrier_complete(unsigned* bar, unsigned x, unsigned& nloc, unsigned& nx) {
    const unsigned G = gridDim.x * gridDim.y * gridDim.z;
    unsigned sum, cnt, mine, sp = 0u;
    for (;;) {
        sum = 0u; cnt = 0u; mine = 0u;
#pragma unroll
        for (unsigned j = 0; j < 16; ++j) { const unsigned c = xb_ld(&bar[XB_XCNT(j)]); sum += c; cnt += (c > 0u) ? 1u : 0u; mine = (j == x) ? c : mine; }
        if (sum == G) break;
        __builtin_amdgcn_s_sleep(1);
        if ((++sp & 255u) == 0u) { if (xb_ld(&bar[XB_TMO])) break; if (sp > XB_SPIN_CAP) { atomicAdd(&bar[XB_TMO], 1u); break; } }
    }
    nloc = mine > 0u ? mine : 1u; nx = cnt > 0u ? cnt : 1u;
}

__device__ __forceinline__ void xcd_barrier(const XcdBarrier& b) {
    asm volatile("s_waitcnt vmcnt(0)" ::: "memory");
    __syncthreads();
    if (threadIdx.x == 0) {
        unsigned* bar = b.bar;
        __builtin_amdgcn_s_waitcnt(0);
        unsigned nloc = b.st[0], nx = b.st[1];
        if (nloc == 0u) { xcd_barrier_complete(bar, b.x, nloc, nx); b.st[0] = nloc; b.st[1] = nx; }
        const unsigned old = xb_add(&bar[XB_XSUB(b.x)], 1u);
        const unsigned gen = old / nloc;
        if (old + 1u == (gen + 1u) * nloc) {
            __builtin_amdgcn_fence(__ATOMIC_RELEASE, "agent");
            asm volatile("s_waitcnt vmcnt(0)" ::: "memory");
            const unsigned og = xb_add(&bar[XB_TOP], 1u);
            const unsigned tg = og / nx;
            if (og + 1u == (tg + 1u) * nx) xb_add(&bar[XB_TOPGEN], 1u);
            else XB_SPIN(xb_ld(&bar[XB_TOPGEN]) == tg, bar);
            __builtin_amdgcn_fence(__ATOMIC_ACQUIRE, "agent");
            xb_add(&bar[XB_XGEN(b.x)], 1u);
            asm volatile("s_waitcnt vmcnt(0)" ::: "memory");
        } else {
            XB_SPIN(xb_ld(&bar[XB_XGEN(b.x)]) == gen, bar);
            __builtin_amdgcn_fence(__ATOMIC_ACQUIRE, "agent");
            asm volatile("s_waitcnt vmcnt(0)" ::: "memory");
        }
    }
    __syncthreads();
}


struct Args { const float* in[19]; float* out; unsigned char* wsp; int ph_lo, ph_hi, li, pad; };
struct Frame { LAS unsigned char* lds; int tid, lane, wave, vcu, G; };
#define KA ((const Args*)__builtin_amdgcn_kernarg_segment_ptr())
#define INP(i) (KA->in[i])
#define A_WS (KA->wsp)
#define A_OUT (KA->out)

__device__ __forceinline__ int p0_dstrow(int mode, int aux, int col) {
    if (mode == 1) { if (col < 1024) return col; const int v = col >= 2048, cc = col - (v ? 2048 : 1024); return 1024 + 256 * (cc >> 7) + 128 * v + (cc & 127); }
    if (mode == 2) { const int up = col >= aux, cc = col - (up ? aux : 0); return 256 * (cc >> 7) + 128 * up + (cc & 127); }
    if (mode == 3) { const int g = col >> 6, bj = (col >> 5) & 1; return 256 * (g >> 2) + 32 * (4 * bj + (g & 3)) + (col & 31); }
    return col;
}
struct P0Item { const float* src; const float* gain; unsigned char* dst; int ldw, K, k0, d0, d1, f8; float sc; };
#define P0_JOB(SRC, LDW, KK, C0, NCOLS, GAIN, DSTOFF, DROW0, DSTROWS, MODE, AUX, NMAT, SC, F8) { \
    constexpr int nn_ = (NCOLS) / 64, per_ = ((KK) / 64) * nn_, cnt_ = per_ * (NMAT); \
    if (it < cnt_) { const int mat = it / per_, r = it % per_, kb = r / nn_, col = 64 * (r % nn_); \
        I.src = (SRC) + (size_t)mat * (KK) * (LDW) + (C0) + col; I.gain = (GAIN); I.dst = A_WS + (DSTOFF) + (size_t)mat * (DSTROWS) * (KK) * ((F8) ? 1 : 2); \
        I.ldw = (LDW); I.K = (KK); I.k0 = 64 * kb; I.d0 = (DROW0) + p0_dstrow(MODE, AUX, col); I.d1 = (DROW0) + p0_dstrow(MODE, AUX, col + 32); I.f8 = (F8); I.sc = (SC); return; } \
    it -= cnt_; }
constexpr int P0_NITEMS = 16 * 48 + 16 * 16 + 16 * 88 + 44 * 16 + 3 * 16 * 16 + 16 * 16 + 8 * 16 * 112 + 8 * 56 * 16;
constexpr int P0_FIRST = 16 * 48;
constexpr int P0_E_WOUT = P0_FIRST + 16 * 16, P0_E_WGU = P0_E_WOUT + 16 * 88, P0_E_WDN = P0_E_WGU + 44 * 16, P0_E_QKV = P0_E_WDN + 3 * 16 * 16, P0_E_WO = P0_E_QKV + 16 * 16;
constexpr int P0_DENSE_ITEMS = P0_E_WO;
constexpr int P0_GU_END = P0_DENSE_ITEMS + 8 * 16 * 112;
__device__ __forceinline__ void p0_decode(int it, P0Item& I) {
    P0_JOB(INP(3), 3072, 1024, 0, 3072, INP(1), WS_W_IN, 0, 3072, 1, 0, 1, 1.0f, 0)
    P0_JOB(INP(5), 1024, 1024, 0, 1024, nullptr, WS_W_OUT, 0, 1024, 0, 0, 1, 1.0f, 0)
    P0_JOB(INP(14), 5632, 1024, 0, 5632, INP(2), WS_W_GU, 0, 5632, 2, 2816, 1, pg8::F8_SWGD, 1)
    P0_JOB(INP(15), 1024, 2816, 0, 1024, nullptr, WS_W_DN, 0, 1024, 0, 0, 1, pg8::F8_SWDD, 1)
    P0_JOB(INP(9), 1024, 1024, 0, 1024, INP(1) + 1024, WS_W_QKV, 0, 3072, 3, 0, 1, 1.0f, 0)
    P0_JOB(INP(7), 2048, 1024, 0, 1024, INP(6), WS_W_QKV, 1024, 3072, 3, 0, 1, 1.0f, 0)
    P0_JOB(INP(7), 2048, 1024, 1024, 1024, INP(6), WS_W_QKV, 2048, 3072, 0, 0, 1, 1.0f, 0)
    P0_JOB(INP(13), 1024, 1024, 0, 1024, nullptr, WS_W_O, 0, 1024, 0, 0, 1, 1.0f, 0)
    P0_JOB(INP(17), 7168, 1024, 0, 7168, INP(2) + 1024, WS_W_MGU, 0, 7168, 2, 3584, 8, pg8::F8_SWG, 1)
    P0_JOB(INP(18), 1024, 3584, 0, 1024, nullptr, WS_W_MDN, 0, 1024, 0, 0, 8, pg8::F8_SWD, 1)
}
#undef P0_JOB
struct P0Regs { f32x4 v[16]; float g[16]; };
__device__ __forceinline__ void p0_load(const P0Item& I, P0Regs& R, int lane) {
    const int lr = lane >> 4, lc = lane & 15;
#pragma unroll
    for (int i = 0; i < 16; ++i) R.v[i] = __builtin_nontemporal_load((const GAS f32x4*)(I.src + (size_t)(I.k0 + 4 * i + lr) * I.ldw + 4 * lc));
    if (I.gain) {
#pragma unroll
        for (int i = 0; i < 16; ++i) R.g[i] = I.gain[I.k0 + 4 * i + lr];
    } else {
#pragma unroll
        for (int i = 0; i < 16; ++i) R.g[i] = 1.0f;
    }
}
__device__ __forceinline__ void p0_store(const P0Item& I, const P0Regs& R, LAS float* scr, int lane) {
    const int lr = lane >> 4, lc = lane & 15;
#pragma unroll
    for (int i = 0; i < 16; ++i) { const f32x4 w = R.v[i] * (R.g[i] * I.sc); LAS float* p = scr + (4 * i + lr) * 65 + 4 * lc; p[0] = w[0]; p[1] = w[1]; p[2] = w[2]; p[3] = w[3]; }
    LDS_WAIT(); asm volatile("" ::: "memory");
    const int c = lane & 7;
#pragma unroll
    for (int jj = 0; jj < 8; ++jj) { const int nl = 8 * jj + (lane >> 3); const LAS float* s = scr + (8 * c) * 65 + nl;
        const int drow = (jj < 4 ? I.d0 : I.d1 - 32) + nl;
        if (I.f8) { v2u o; o.x = pg8::pk4_fp8(s[0], s[65], s[130], s[195]); o.y = pg8::pk4_fp8(s[260], s[325], s[390], s[455]);
            pg8::st8_wt(I.dst + (size_t)drow * I.K + I.k0 + 8 * c, o.x, o.y); }
        else { v4u o; o.x = pk2(s[0], s[65]); o.y = pk2(s[130], s[195]); o.z = pk2(s[260], s[325]); o.w = pk2(s[390], s[455]);
            pg8::st16_wt(I.dst + ((size_t)drow * I.K + I.k0 + 8 * c) * 2, o); } }
    LDS_WAIT(); asm volatile("" ::: "memory");
}
__device__ __forceinline__ void rms_row_bf16(const float* xrow, const float* g, bf16_t* orow, int lane) {
    const GAS f32x4* xr = (const GAS f32x4*)xrow + lane; const GAS f32x4* gr = (const GAS f32x4*)g + lane;
    f32x4 v[4]; float s = 0.f;
#pragma unroll
    for (int j = 0; j < 4; ++j) { v[j] = xr[64 * j]; s += (v[j][0] * v[j][0] + v[j][1] * v[j][1]) + (v[j][2] * v[j][2] + v[j][3] * v[j][3]); }
    const float rstd = __builtin_amdgcn_rsqf(wave_sum(s) * (1.f / D) + EPS);
    GAS v2u* o8 = (GAS v2u*)orow + lane;
#pragma unroll
    for (int j = 0; j < 4; ++j) { const f32x4 gg = gr[64 * j]; v2u o; o.x = pk2(v[j][0] * rstd * gg[0], v[j][1] * rstd * gg[1]); o.y = pk2(v[j][2] * rstd * gg[2], v[j][3] * rstd * gg[3]); o8[64 * j] = o; }
}
__device__ __forceinline__ void p0_prologue(Frame& F) {
    const int gw = F.vcu * NWAVES + F.wave, NGW = F.G * NWAVES;
    {
        const float* x = INP(0); bf16_t* XBp = (bf16_t*)(A_WS + WS_XB); float* ssq = (float*)(A_WS + WS_SSQ);
        for (int mb = gw; mb < M; mb += 4 * NGW) { f32x4 v[4][4];
#pragma unroll
            for (int i = 0; i < 4; ++i) { const int m = mb + i * NGW; if (m < M) { const GAS f32x4* xr = (const GAS f32x4*)(x + (size_t)m * D) + F.lane;
#pragma unroll
                for (int j = 0; j < 4; ++j) v[i][j] = __builtin_nontemporal_load(xr + 64 * j); } }
#pragma unroll
            for (int i = 0; i < 4; ++i) { const int m = mb + i * NGW; if (m >= M) break; float s = 0.f;
#pragma unroll
                for (int j = 0; j < 4; ++j) s += (v[i][j][0] * v[i][j][0] + v[i][j][1] * v[i][j][1]) + (v[i][j][2] * v[i][j][2] + v[i][j][3] * v[i][j][3]);
                s = wave_sum(s); GAS v2u* o8 = (GAS v2u*)(XBp + (size_t)m * D) + F.lane;
                if (F.lane == 0) *(GAS f32x4*)(ssq + (size_t)m * 4) = (f32x4){s, 0.f, 0.f, 0.f};
#pragma unroll
                for (int j = 0; j < 4; ++j) { v2u o; o.x = pk2(v[i][j][0], v[i][j][1]); o.y = pk2(v[i][j][2], v[i][j][3]); o8[64 * j] = o; } } }
    }
    LAS float* scr = (LAS float*)(F.lds + RING_OFF + F.wave * P0_SCR);
    int it = gw; if (it >= P0_FIRST) return;
    P0Item cur; P0Regs ra; p0_decode(it, cur); p0_load(cur, ra, F.lane);
    for (;;) { const int nit = it + NGW; const bool has = nit < P0_FIRST; P0Item nx; P0Regs rb;
        if (has) { p0_decode(nit, nx); p0_load(nx, rb, F.lane); }
        p0_store(cur, ra, scr, F.lane);
        if (!has) break;
        cur = nx; ra = rb; it = nit; }
}

#ifndef FILL_CAP
#define FILL_CAP 1
#endif
__device__ __forceinline__ void fill_items(Frame& F, int bound, volatile LAS unsigned* flag) {
    if (F.wave == 0) return;
    volatile LAS unsigned* curp = (volatile LAS unsigned*)(F.lds + MISC_OFF + 64) + F.wave;
    int c = __builtin_amdgcn_readfirstlane((int)*curp);
    const int base = P0_FIRST + F.vcu * (NWAVES - 1) + (F.wave - 1), stride = F.G * (NWAVES - 1);
    if (base + c * stride >= bound) return;
    LAS float* scr = (LAS float*)(F.lds + RING_OFF + F.wave * P0_SCR);
    for (int n = 0;; ++n) { const int it = base + c * stride; if (it >= bound) break; if (flag && (n >= FILL_CAP || *flag != 0u)) break;
        P0Item I; P0Regs R; p0_decode(it, I); p0_load(I, R, F.lane); p0_store(I, R, scr, F.lane); ++c; }
    if (F.lane == 0) *curp = (unsigned)c;
}
struct TouchB { const unsigned char* Bt; int pitch, N; };
__device__ __forceinline__ void touch_next_B(Frame& F, const TouchB& t) {
    if (t.Bt == nullptr || F.wave < 1 || F.wave > 4) return;
    pg8::StaticOrder S; S.init(M, t.N, F.G, (int)blockIdx.x); pg8::Unit u; if (!S.next(0, u)) return;
    LAS unsigned* junk = (LAS unsigned*)(F.lds + RING_OFF + 131072 + 4096) + (F.wave - 1) * 128;
#pragma unroll
    for (int j = 0; j < 2; ++j) { const int idx = ((F.wave - 1) * 64 + F.lane) * 2 + j;
        const unsigned char* p = t.Bt + (size_t)(u.pn * 256 + (idx >> 1)) * t.pitch + (idx & 1) * 128;
        __builtin_amdgcn_global_load_lds((const unsigned*)p, junk + j * 64, 4, 0, 0); }
}
__device__ __forceinline__ void xcd_barrier_fill(const XcdBarrier& b, Frame& F, int bound, const TouchB tb = TouchB{nullptr, 0, 0}) {
    volatile LAS unsigned* flag = (volatile LAS unsigned*)(F.lds + MISC_OFF + 48);
    asm volatile("s_waitcnt vmcnt(0)" ::: "memory");
    if (threadIdx.x == 0) *flag = 0u;
    __syncthreads();
    touch_next_B(F, tb);
    if (threadIdx.x == 0) {
        unsigned* bar = b.bar;
        __builtin_amdgcn_s_waitcnt(0);
        unsigned nloc = b.st[0], nx = b.st[1];
        if (nloc == 0u) { xcd_barrier_complete(bar, b.x, nloc, nx); b.st[0] = nloc; b.st[1] = nx; }
        const unsigned old = xb_add(&bar[XB_XSUB(b.x)], 1u);
        const unsigned gen = old / nloc;
        if (old + 1u == (gen + 1u) * nloc) {
            __builtin_amdgcn_fence(__ATOMIC_RELEASE, "agent");
            asm volatile("s_waitcnt vmcnt(0)" ::: "memory");
            const unsigned og = xb_add(&bar[XB_TOP], 1u);
            const unsigned tg = og / nx;
            if (og + 1u == (tg + 1u) * nx) xb_add(&bar[XB_TOPGEN], 1u);
            else XB_SPIN(xb_ld(&bar[XB_TOPGEN]) == tg, bar);
            __builtin_amdgcn_fence(__ATOMIC_ACQUIRE, "agent");
            xb_add(&bar[XB_XGEN(b.x)], 1u);
            asm volatile("s_waitcnt vmcnt(0)" ::: "memory");
        } else {
            XB_SPIN(xb_ld(&bar[XB_XGEN(b.x)]) == gen, bar);
            __builtin_amdgcn_fence(__ATOMIC_ACQUIRE, "agent");
            asm volatile("s_waitcnt vmcnt(0)" ::: "memory");
        }
        *flag = 1u;
    } else if (threadIdx.x >= 64) fill_items(F, bound, flag);
    asm volatile("s_waitcnt lgkmcnt(0)\n\ts_barrier" ::: "memory");
}

__device__ __forceinline__ void xcd_local_barrier_fill(Frame& F, unsigned* bar, int bound, const TouchB tb = TouchB{nullptr, 0, 0}) {
    unsigned* ctl = (unsigned*)(A_WS + WS_CTL);
    volatile LAS unsigned* flag = (volatile LAS unsigned*)(F.lds + MISC_OFF + 48);
    volatile LAS unsigned* lgen = (volatile LAS unsigned*)(F.lds + MISC_OFF + 56);
    asm volatile("s_waitcnt vmcnt(0)" ::: "memory");
    if (threadIdx.x == 0) *flag = 0u;
    __syncthreads();
    touch_next_B(F, tb);
    if (threadIdx.x == 0) {
        __builtin_amdgcn_s_waitcnt(0);
        const unsigned x = blockIdx.x & 7u, gen = *lgen; *lgen = gen + 1u;
        const unsigned old = xb_add(&ctl[CW_XLSUB + 64 * x], 1u);
        if (old + 1u == (gen + 1u) * (gridDim.x >> 3)) (void)xb_add(&ctl[CW_XLGEN + 64 * x], 1u);
        else XB_SPIN(xb_ld(&ctl[CW_XLGEN + 64 * x]) == gen, bar);
        __builtin_amdgcn_fence(__ATOMIC_ACQUIRE, "agent");
        asm volatile("s_waitcnt vmcnt(0)" ::: "memory");
        *flag = 1u;
    } else if (threadIdx.x >= 64) fill_items(F, bound, flag);
    asm volatile("s_waitcnt lgkmcnt(0)\n\ts_barrier" ::: "memory");
}

#define FILL_TAIL0(F) (P0_FIRST + 11 * (F).G * (NWAVES - 1))
constexpr int FILL_D4_CHUNKS = 384;
__device__ __forceinline__ void fill_tail(Frame& F, int cw, int it0, int it1) {
    unsigned* ctr = (unsigned*)(A_WS + WS_CTL) + cw;
    volatile LAS unsigned* qs = (volatile LAS unsigned*)(F.lds + MISC_OFF + 96);
    const int nchunks = (it1 - it0 + NWAVES - 2) / (NWAVES - 1);
    if (nchunks <= 0) return;
    LAS float* scr = (LAS float*)(F.lds + RING_OFF + F.wave * P0_SCR);
    if (F.tid == 0) *qs = __hip_atomic_fetch_add(ctr, 1u, __ATOMIC_RELAXED, __HIP_MEMORY_SCOPE_AGENT);
    __syncthreads();
    for (;;) {
        const int q = (int)*qs;
        __syncthreads();
        if (q >= nchunks) break;
        if (F.tid == 0) *qs = __hip_atomic_fetch_add(ctr, 1u, __ATOMIC_RELAXED, __HIP_MEMORY_SCOPE_AGENT);
        if (F.wave) { const int it = it0 + q * (NWAVES - 1) + (F.wave - 1);
            if (it < it1) { P0Item I; P0Regs R; p0_decode(it, I); p0_load(I, R, F.lane); p0_store(I, R, scr, F.lane); } }
        __syncthreads();
    }
}
__device__ __forceinline__ int fill_d4_end(Frame& F) { const int e = FILL_TAIL0(F) + FILL_D4_CHUNKS * (NWAVES - 1); return e < P0_NITEMS ? e : P0_NITEMS; }

__device__ __forceinline__ void up8(const v4u w, float (&f)[8]) { f[0] = bflo(w.x); f[1] = bfhi(w.x); f[2] = bflo(w.y); f[3] = bfhi(w.y); f[4] = bflo(w.z); f[5] = bfhi(w.z); f[6] = bflo(w.w); f[7] = bfhi(w.w); }
__device__ __forceinline__ void p2_conv(Frame& F) {
    const bf16_t* Bb = (const bf16_t*)ARP(AR_BB, D * 2); const bf16_t* Ub = (const bf16_t*)ARP(AR_UB, D * 2); bf16_t* G = (bf16_t*)ARP(AR_G, D * 2); const float* cw = INP(4);
    const int gw = F.vcu * NWAVES + F.wave, NGW = F.G * NWAVES;
    for (int strip = gw; strip < 2048; strip += NGW) {
        const int r0 = (strip >> 1) * 16, c0 = (strip & 1) * 512 + F.lane * 8;
        float w0[8], w1[8], w2[8], um2[8], um1[8];
#pragma unroll
        for (int j = 0; j < 8; ++j) { w0[j] = cw[c0 + j]; w1[j] = cw[D + c0 + j]; w2[j] = cw[2 * D + c0 + j]; um2[j] = 0.f; um1[j] = 0.f; }
        if ((r0 & (SEQ - 1)) != 0) { up8(*(const GAS v4u*)(Ub + (size_t)(r0 - 2) * D + c0), um2); up8(*(const GAS v4u*)(Ub + (size_t)(r0 - 1) * D + c0), um1); }
#pragma unroll
        for (int hb = 0; hb < 2; ++hb) { v4u ru[8], rb[8];
#pragma unroll
            for (int i = 0; i < 8; ++i) { ru[i] = *(const GAS v4u*)(Ub + (size_t)(r0 + 8 * hb + i) * D + c0); rb[i] = *(const GAS v4u*)(Bb + (size_t)(r0 + 8 * hb + i) * D + c0); }
#pragma unroll
            for (int ii = 0; ii < 8; ++ii) { const int i = 8 * hb + ii; float u[8], b[8]; up8(ru[ii], u); up8(rb[ii], b);
            float g[8];
#pragma unroll
            for (int j = 0; j < 8; ++j) { g[j] = b[j] * (w0[j] * um2[j] + w1[j] * um1[j] + w2[j] * u[j]); um2[j] = um1[j]; um1[j] = u[j]; }
            v4u o; o.x = pk2(g[0], g[1]); o.y = pk2(g[2], g[3]); o.z = pk2(g[4], g[5]); o.w = pk2(g[6], g[7]);
            pg8::st16_wt(G + (size_t)(r0 + i) * D + c0, o); } }
    }
}

__device__ __forceinline__ void p10a_router(Frame& F) {
    const bf16_t* x3 = (const bf16_t*)(A_WS + WS_XB); const float* g = INP(2) + D; const float* Wr = INP(16); const float* ssq = (const float*)(A_WS + WS_SSQ);
    int* sel = (int*)(A_WS + WS_SEL); float* gate = (float*)(A_WS + WS_GATE); int* hist = (int*)(A_WS + WS_HIST);
    LAS unsigned char* WT = F.lds + RING_OFF;
    LAS float* PT = (LAS float*)(F.lds + RING_OFF + 32768);
    const int lane = F.lane, r16 = lane & 15, quad = lane >> 4;
    for (int blk = F.vcu; blk < M / 64; blk += F.G) {
        const int rb = F.wave >> 1, kh = F.wave & 1;
        const bf16_t* arow = x3 + (size_t)(64 * blk + 16 * rb + r16) * D + 512 * kh + 8 * quad;
        bf16x8 af[16];
#pragma unroll
        for (int s = 0; s < 16; ++s) af[s] = *(const GAS bf16x8*)(arow + 32 * s);
        if (blk == F.vcu) {
            const int kc = F.tid >> 2, c0 = 2 * (F.tid & 3); float w0[8], w1[8];
#pragma unroll
            for (int j = 0; j < 8; ++j) { const int k = 8 * kc + j; const float gk = g[k]; w0[j] = Wr[(size_t)k * 8 + c0] * gk; w1[j] = Wr[(size_t)k * 8 + c0 + 1] * gk; }
            v4u h0, l0, h1, l1;
#pragma unroll
            for (int j = 0; j < 4; ++j) {
                const unsigned a = f2bf(w0[2 * j]), b = f2bf(w0[2 * j + 1]), c = f2bf(w1[2 * j]), d = f2bf(w1[2 * j + 1]);
                h0[j] = a | (b << 16); h1[j] = c | (d << 16);
                l0[j] = f2bf(w0[2 * j] - __builtin_bit_cast(float, a << 16)) | (f2bf(w0[2 * j + 1] - __builtin_bit_cast(float, b << 16)) << 16);
                l1[j] = f2bf(w1[2 * j] - __builtin_bit_cast(float, c << 16)) | (f2bf(w1[2 * j + 1] - __builtin_bit_cast(float, d << 16)) << 16); }
            LAS v4u* wp = (LAS v4u*)(WT + kc * 256);
            wp[c0] = h0; wp[c0 + 1] = h1; wp[8 + c0] = l0; wp[8 + c0 + 1] = l1;
            LDS_WAIT(); __syncthreads(); }
        f32x4 acc = {0.f, 0.f, 0.f, 0.f};
#pragma unroll
        for (int s = 0; s < 16; ++s) { const bf16x8 bfr = *(const LAS bf16x8*)(WT + (64 * kh + 4 * s + quad) * 256 + r16 * 16);
            acc = __builtin_amdgcn_mfma_f32_16x16x32_bf16(af[s], bfr, acc, 0, 0, 0); }
#pragma unroll
        for (int j = 0; j < 4; ++j) PT[F.wave * 256 + (4 * quad + j) * 16 + r16] = acc[j];
        LDS_WAIT(); __syncthreads();
        if (F.wave == 0) {
            const int trb = lane >> 4, tr = lane & 15; const LAS float* p0 = PT + (2 * trb) * 256 + tr * 16; const LAS float* p1 = p0 + 256;
            float lg[8];
#pragma unroll
            for (int e = 0; e < 8; ++e) lg[e] = (p0[e] + p1[e]) + (p0[8 + e] + p1[8 + e]);
            int i0 = 0; float v0 = lg[0];
#pragma unroll
            for (int e = 1; e < 8; ++e) if (lg[e] > v0) { v0 = lg[e]; i0 = e; }
            int i1 = 0; float v1 = -INFINITY;
#pragma unroll
            for (int e = 0; e < 8; ++e) if (e != i0 && lg[e] > v1) { v1 = lg[e]; i1 = e; }
            const int row = 64 * blk + lane; const float rs = pg8::rstd_of(ssq, row);
            const float g1 = 1.f / (1.f + expf((v0 - v1) * rs));
            sel[2 * row] = i0; sel[2 * row + 1] = i1; gate[2 * row] = 1.f - g1; gate[2 * row + 1] = g1;
            int mycnt = 0;
#pragma unroll
            for (int e = 0; e < 8; ++e) { const int c = __popcll(__ballot(i0 == e)) + __popcll(__ballot(i1 == e)); if (lane == e) mycnt = c; }
            if (lane < 8) hist[blk * 8 + lane] = mycnt; }
        __syncthreads();
    }
}
__device__ __forceinline__ void p10b_assign(Frame& F) {
    const int* hist = (const int*)(A_WS + WS_HIST); const int* sel = (const int*)(A_WS + WS_SEL); const float* gate = (const float*)(A_WS + WS_GATE); const float* ssq = (const float*)(A_WS + WS_SSQ);
    int* tok_slot = (int*)(A_WS + WS_TOKSLOT); float* gates = (float*)(A_WS + WS_GATES); int* meta = (int*)(A_WS + WS_META);
    const bf16_t* x3 = (const bf16_t*)(A_WS + WS_XB); unsigned char* XG = A_WS + WS_XG;
    LAS int* pre = (LAS int*)(F.lds + RING_OFF);
    LAS int* tot = pre + 2048;
    LAS int* ebase = tot + 8;
    LAS int* lslot = ebase + 8;
    const int lane = F.lane, e = F.wave;
    { int h[4], run = 0;
#pragma unroll
      for (int i = 0; i < 4; ++i) { h[i] = hist[(4 * lane + i) * 8 + e]; }
      const int mine = h[0] + h[1] + h[2] + h[3]; int inc = mine;
#pragma unroll
      for (int o = 1; o < 64; o <<= 1) { const int t = __shfl_up(inc, o); if (lane >= o) inc += t; }
      run = inc - mine;
#pragma unroll
      for (int i = 0; i < 4; ++i) { pre[(4 * lane + i) * 8 + e] = run; run += h[i]; }
      if (lane == 63) tot[e] = inc; }
    LDS_WAIT(); __syncthreads();
    if (F.tid == 0) { int b = 0; for (int k = 0; k < 8; ++k) { ebase[k] = b; if (blockIdx.x == 0) meta[k] = b >> 8; b += (tot[k] + 255) & ~255; } if (blockIdx.x == 0) { const int T = b >> 8, full = 2 * F.G / 4; meta[8] = T; meta[9] = T < full ? T : full; } }
    LDS_WAIT(); __syncthreads();
    for (int blk = blockIdx.x; blk < M / 64; blk += F.G) {
        if (F.wave == 0) { const int t = 64 * blk + lane; const int s0 = sel[2 * t], s1 = sel[2 * t + 1]; int sl0 = 0, sl1 = 0;
            const unsigned long long below = (1ull << lane) - 1ull;
#pragma unroll
            for (int k = 0; k < 8; ++k) { const unsigned long long m0 = __ballot(s0 == k), m1 = __ballot(s1 == k); const int b0 = ebase[k] + pre[blk * 8 + k];
                if (s0 == k) sl0 = b0 + __popcll(m0 & below); if (s1 == k) sl1 = b0 + __popcll(m0) + __popcll(m1 & below); }
            tok_slot[2 * t] = sl0; tok_slot[2 * t + 1] = sl1; lslot[2 * lane] = sl0; lslot[2 * lane + 1] = sl1;
            gates[sl0] = gate[2 * t]; gates[sl1] = gate[2 * t + 1]; }
        LDS_WAIT(); __syncthreads();
        v4u xw[8][2];
#pragma unroll
        for (int i = 0; i < 8; ++i) { const GAS v4u* xr = (const GAS v4u*)(x3 + (size_t)(64 * blk + 8 * F.wave + i) * D + 16 * lane); xw[i][0] = xr[0]; xw[i][1] = xr[1]; }
#pragma unroll
        for (int i = 0; i < 8; ++i) { const int tl = 8 * F.wave + i; const int t = 64 * blk + tl;
            const float rs = pg8::rstd_of(ssq, t) * pg8::F8_SA; float a[8], b[8]; up8(xw[i][0], a); up8(xw[i][1], b);
            v4u o; o.x = pg8::pk4_fp8(a[0] * rs, a[1] * rs, a[2] * rs, a[3] * rs); o.y = pg8::pk4_fp8(a[4] * rs, a[5] * rs, a[6] * rs, a[7] * rs); o.z = pg8::pk4_fp8(b[0] * rs, b[1] * rs, b[2] * rs, b[3] * rs); o.w = pg8::pk4_fp8(b[4] * rs, b[5] * rs, b[6] * rs, b[7] * rs);
            const int sl0 = lslot[2 * tl], sl1 = lslot[2 * tl + 1];
            pg8::st16_wt(XG + (size_t)sl0 * D + 16 * lane, o); pg8::st16_wt(XG + (size_t)sl1 * D + 16 * lane, o); }
        LDS_WAIT(); __syncthreads();
    }
}
typedef float f32x2_ __attribute__((ext_vector_type(2)));
__device__ __forceinline__ void p13_load_y(const unsigned char* Y, const bf16_t* Pp, const float* gates, int nfull, int slot, int lane, f32x4 (&y)[4]) {
    const int rt = (slot >> 8) - nfull;
    if (rt < 0) { const GAS unsigned* yr = (const GAS unsigned*)(Y + (size_t)slot * D) + lane;
#pragma unroll
        for (int j = 0; j < 4; ++j) { const int w = (int)yr[64 * j]; const f32x2_ lo = __builtin_amdgcn_cvt_pk_f32_fp8(w, false), hi = __builtin_amdgcn_cvt_pk_f32_fp8(w, true);
            y[j] = (f32x4){lo.x, lo.y, hi.x, hi.y} * (1.0f / pg8::F8_SY); }
    } else { const float gt = gates[slot];
#pragma unroll
        for (int j = 0; j < 4; ++j) { f32x4 s = (f32x4){0.f, 0.f, 0.f, 0.f};
#pragma unroll
            for (int kp = 0; kp < pg8::MoeOrder::SPL; ++kp) { const v2u w = *((const GAS v2u*)(Pp + ((size_t)(rt * pg8::MoeOrder::SPL + kp) * 256 + (slot & 255)) * D) + lane + 64 * j);
                s += (f32x4){bflo(w.x), bfhi(w.x), bflo(w.y), bfhi(w.y)}; }
            y[j] = s * gt; } }
}
__device__ __forceinline__ void p13_final(Frame& F) {
    const int* tok_slot = (const int*)(A_WS + WS_TOKSLOT); const unsigned char* Y = A_WS + WS_Y; const bf16_t* X3 = (const bf16_t*)(A_WS + WS_XB); float* out = A_OUT;
    const bf16_t* Pp = (const bf16_t*)(A_WS + WS_PP); const float* gates = (const float*)(A_WS + WS_GATES); const int nfull = ((const int*)(A_WS + WS_META))[9];
    const int gw = F.vcu * NWAVES + F.wave, NGW = F.G * NWAVES, lane = F.lane;
    for (int rowb = gw; rowb < M; rowb += 2 * NGW) {
        v2u xa[2][4]; f32x4 ya[2][4], yb[2][4];
#pragma unroll
        for (int i = 0; i < 2; ++i) { const int row = rowb + i * NGW; if (row < M) { const int s0 = tok_slot[2 * row], s1 = tok_slot[2 * row + 1];
            const GAS v2u* xr = (const GAS v2u*)(X3 + (size_t)row * D) + lane;
#pragma unroll
            for (int j = 0; j < 4; ++j) xa[i][j] = xr[64 * j];
            p13_load_y(Y, Pp, gates, nfull, s0, lane, ya[i]); p13_load_y(Y, Pp, gates, nfull, s1, lane, yb[i]); } }
#pragma unroll
        for (int i = 0; i < 2; ++i) { const int row = rowb + i * NGW; if (row >= M) break; GAS f32x4* orow = (GAS f32x4*)(out + (size_t)row * D) + lane;
#pragma unroll
            for (int j = 0; j < 4; ++j) { const v2u x = xa[i][j];
                orow[64 * j] = (f32x4){bflo(x.x), bfhi(x.x), bflo(x.y), bfhi(x.y)} + (ya[i][j] + yb[i][j]); } }
    }
}

__global__ void __launch_bounds__(NWAVES * 64, 2) mega_fwd(Args args) {
    extern __shared__ __attribute__((aligned(16))) unsigned char lds[];
    Frame F;
    F.lds = (LAS unsigned char*)lds; F.tid = threadIdx.x; F.lane = F.tid & 63; F.wave = __builtin_amdgcn_readfirstlane(F.tid >> 6);
    F.G = gridDim.x; { const int bx = blockIdx.x; F.vcu = (F.G % 8 == 0) ? (bx % 8) * (F.G / 8) + bx / 8 : bx; }
    for (int u = F.tid; u < RING_OFF / 4; u += NWAVES * 64) ((LAS unsigned*)(F.lds + MISC_OFF))[u] = 0u;
    __syncthreads();
    if (F.tid == 0 && xb_xcc_id() != (blockIdx.x & 7u)) (void)__hip_atomic_fetch_or((unsigned*)(A_WS + WS_CTL) + CW_MAPBAD, 1u, __ATOMIC_RELAXED, __HIP_MEMORY_SCOPE_AGENT);
    if (KA->ph_hi - KA->ph_lo > 1) (void)xcd_barrier_post((unsigned*)(A_WS + WS_CTL) + CW_BAR + KA->li * XCD_BAR_WORDS, (volatile LAS unsigned*)(F.lds + MISC_OFF + 32));
#define IN(k) (KA->ph_lo <= (k) && (k) < KA->ph_hi)
#define FILL_BOUND(k) ((k) <= 11 ? FILL_TAIL0(F) : 0)
#define FILL_NEED(k) ((k) == 2 ? P0_E_WO : (k) == 11 ? P0_GU_END : (k) == 12 ? FILL_TAIL0(F) : 0)
#define SEAM(k) do { if (IN(k) && FILL_NEED(k) != 0) fill_items(F, FILL_NEED(k), nullptr); if ((k) == 12 && IN(12)) { if (!IN(4) || (1408 % F.G) == 0) fill_tail(F, CW_FQ4, FILL_TAIL0(F), fill_d4_end(F)); fill_tail(F, CW_FQ, fill_d4_end(F), P0_NITEMS); } \
    if ((k) == 4 && IN(4) && (1408 % F.G) != 0 && (int)blockIdx.x >= 1408 % F.G) fill_tail(F, CW_FQ4, FILL_TAIL0(F), fill_d4_end(F));     \
    if (IN(k) && IN((k) + 1)) { const TouchB SEAM_TB = (k) == 2 ? TouchB{A_WS + WS_W_OUT, 2048, 1024} : (k) == 3 ? TouchB{A_WS + WS_W_GU, 1024, 5632} : (k) == 4 ? TouchB{A_WS + WS_W_DN, 2816, 1024} : (k) == 5 ? TouchB{A_WS + WS_W_QKV, 2048, 3072} : TouchB{nullptr, 0, 0}; if (SEAM_LOCAL(k) && *(volatile LAS unsigned*)(F.lds + MISC_OFF + 52) != 0u) SEAM_NOWL(FILL_BOUND(k)); else SEAM_NOWF(FILL_BOUND(k)); } \
    if ((k) == 0 && IN(0) && IN(1)) { if (F.tid == 0) *(volatile LAS unsigned*)(F.lds + MISC_OFF + 52) = (F.G == 256 && xb_ld((unsigned*)(A_WS + WS_CTL) + CW_MAPBAD) == 0u) ? 1u : 0u; LDS_WAIT(); __syncthreads(); } } while (0)
#define SEAM_LOCAL(k) ((k) == 1 || ((k) >= 3 && (k) <= 7) || (k) == 9)
#define SEAM_NOWL(bound) xcd_local_barrier_fill(F, (unsigned*)(A_WS + WS_CTL) + CW_BAR + KA->li * XCD_BAR_WORDS, (bound), SEAM_TB)
#define SEAM_NOWF(bound) do { { XcdBarrier b_; b_.bar = (unsigned*)(A_WS + WS_CTL) + CW_BAR + KA->li * XCD_BAR_WORDS; b_.x = xb_xcc_id(); b_.st = (volatile LAS unsigned*)(F.lds + MISC_OFF + 32); xcd_barrier_fill(b_, F, (bound), SEAM_TB); } } while (0)
#define SEAM_NOW() do { { XcdBarrier b_; b_.bar = (unsigned*)(A_WS + WS_CTL) + CW_BAR + KA->li * XCD_BAR_WORDS; b_.x = xb_xcc_id(); b_.st = (volatile LAS unsigned*)(F.lds + MISC_OFF + 32); xcd_barrier(b_); } } while (0)
#define ws A_WS
#define XB ((bf16_t*)(A_WS + WS_XB))
#define SSQ ((float*)(A_WS + WS_SSQ))

    if (IN(0)) { p0_prologue(F); } SEAM(0);
    if (IN(1)) { pg8::Gemm g{XB, (const bf16_t*)(ws + WS_W_IN), M, 3072, 1024}; pg8::StaticOrder S; S.init(M, 3072, F.G, (int)blockIdx.x);
        pg8::EpiInProj E{(bf16_t*)ARP(AR_BB, D * 2), (bf16_t*)ARP(AR_UB, D * 2), SSQ};
        pg8::gemm_phase<pg8::EpiInProj, pg8::StaticOrder, true, true>(F.lds + RING_OFF, g, S, E); } SEAM(1);
    if (IN(2)) { p2_conv(F); } SEAM(2);
    if (IN(3)) { pg8::Gemm g{(const bf16_t*)ARP(AR_G, D * 2), (const bf16_t*)(ws + WS_W_OUT), M, 1024, 1024}; pg8::StaticOrder S; S.init(M, 1024, F.G, (int)blockIdx.x);
        pg8::EpiResidSsq<true> E{INP(0), XB, SSQ, 1.0f, ARP(AR_X8, D)};
        pg8::gemm_phase<pg8::EpiResidSsq<true>, pg8::StaticOrder, false, true>(F.lds + RING_OFF, g, S, E); } SEAM(3);
    if (IN(4)) { pg8::Gemm g{(const bf16_t*)ARP(AR_X8, D), (const bf16_t*)(ws + WS_W_GU), M, 5632, 512}; pg8::StaticOrder S; S.init(M, 5632, F.G, (int)blockIdx.x);
        pg8::EpiSwiGLU<true> E{ARP(AR_HACT, DFF), DFF, SSQ, nullptr, 22, 1.0f / (pg8::F8_SX * pg8::F8_SWGD)};
        pg8::gemm_phase<pg8::EpiSwiGLU<true>, pg8::StaticOrder, true, true, true>(F.lds + RING_OFF, g, S, E); } SEAM(4);
    if (IN(5)) { pg8::Gemm g{(const bf16_t*)ARP(AR_HACT, DFF), (const bf16_t*)(ws + WS_W_DN), M, 1024, DFF / 2}; pg8::StaticOrder S; S.init(M, 1024, F.G, (int)blockIdx.x);
        pg8::EpiResidSsq<false> E{nullptr, XB, SSQ, 1.0f / (pg8::F8_SHD * pg8::F8_SWDD), nullptr};
        pg8::gemm_phase<pg8::EpiResidSsq<false>, pg8::StaticOrder, false, true, true>(F.lds + RING_OFF, g, S, E); } SEAM(5);
    if (IN(6)) { pg8::Gemm g{XB, (const bf16_t*)(ws + WS_W_QKV), M, 3072, 1024}; pg8::StaticOrder S; S.init(M, 3072, F.G, (int)blockIdx.x);
        pg8::EpiQKV E{(bf16_t*)ARP(AR_Q, D * 2), (bf16_t*)ARP(AR_K, D * 2), (bf16_t*)ARP(AR_V, D * 2), SSQ, INP(10), INP(8), attn_body::C2};
        pg8::gemm_phase<pg8::EpiQKV, pg8::StaticOrder, true, true>(F.lds + RING_OFF, g, S, E); } SEAM(6);
    if (IN(7)) {
        const float* lp = INP(11); const float* sn = INP(12);
        const float lam = __expf(wave_sum(lp[F.lane] * lp[64 + F.lane])) - __expf(wave_sum(lp[128 + F.lane] * lp[192 + F.lane])) + LAM_INIT;
        LAS float* sng = (LAS float*)(F.lds + MISC_OFF + 256);
        if (F.tid < VD) sng[F.tid] = sn[F.tid] * (1.f - LAM_INIT);
        LDS_WAIT(); __syncthreads();
        for (int it = F.vcu; it < BATCH * 32; it += F.G) { const int b = it >> 5, h = (it >> 2) & 7, p = it & 3;
            attn_body::bf16* O0 = (attn_body::bf16*)ARP(AR_O0, D * 2); attn_body::bf16* ONp = (attn_body::bf16*)ARP(AR_ON, D * 2);
            for (int i = 0; i < 2; ++i) { const int qb = i ? 7 - p : p;
                if (i == 0) attn_body::attn_unit<-1, 0, false, true>(b, (2 * h) * 64, h * 128, qb, (const attn_body::bf16*)ARP(AR_Q, D * 2), (const attn_body::bf16*)ARP(AR_K, D * 2), (const attn_body::bf16*)ARP(AR_V, D * 2), O0, (char*)lds + RING_OFF, nullptr, 0.f, nullptr, (2 * h + 1) * 64);
                else attn_body::attn_unit<-1, 0, true, true>(b, (2 * h) * 64, h * 128, qb, (const attn_body::bf16*)ARP(AR_Q, D * 2), (const attn_body::bf16*)ARP(AR_K, D * 2), (const attn_body::bf16*)ARP(AR_V, D * 2), O0, (char*)lds + RING_OFF, nullptr, 0.f, nullptr, (2 * h + 1) * 64);
                if (i == 0) attn_body::attn_unit<-1, 1, true, true>(b, (2 * h + 1) * 64, h * 128, qb, (const attn_body::bf16*)ARP(AR_Q, D * 2), (const attn_body::bf16*)ARP(AR_K, D * 2), (const attn_body::bf16*)ARP(AR_V, D * 2), O0, (char*)lds + RING_OFF, ONp, lam, (const float*)((char*)lds + MISC_OFF + 256), (2 * h) * 64);
                else attn_body::attn_unit<-1, 1, true, false>(b, (2 * h + 1) * 64, h * 128, qb, (const attn_body::bf16*)ARP(AR_Q, D * 2), (const attn_body::bf16*)ARP(AR_K, D * 2), (const attn_body::bf16*)ARP(AR_V, D * 2), O0, (char*)lds + RING_OFF, ONp, lam, (const float*)((char*)lds + MISC_OFF + 256)); } }
    } if (IN(7) && IN(9)) { const TouchB SEAM_TB = TouchB{A_WS + WS_W_O, 2048, 1024}; if (*(volatile LAS unsigned*)(F.lds + MISC_OFF + 52) != 0u) SEAM_NOWL(FILL_TAIL0(F)); else SEAM_NOWF(FILL_TAIL0(F)); }
    if (IN(9)) { pg8::Gemm g{(const bf16_t*)ARP(AR_ON, D * 2), (const bf16_t*)(ws + WS_W_O), M, 1024, 1024}; pg8::StaticOrder S; S.init(M, 1024, F.G, (int)blockIdx.x);
        pg8::EpiResidSsq<false> E{nullptr, XB, SSQ, 1.0f, nullptr};
        pg8::gemm_phase<pg8::EpiResidSsq<false>, pg8::StaticOrder, false, true>(F.lds + RING_OFF, g, S, E); } SEAM(9);
    if (IN(10)) { p10a_router(F); } SEAM(10);
    if (IN(11)) { p10b_assign(F); } SEAM(11);
    if (IN(12)) { pg8::Gemm g{(const bf16_t*)(ws + WS_XG), (const bf16_t*)(ws + WS_W_MGU), SLOTS, 8 * 7168, 512}; pg8::MoeOrder S; S.init((const int*)(ws + WS_META), 28, F.G, (int)blockIdx.x, false);
        pg8::EpiSwiGLU8 E{ws + WS_HM, DFE, 28};
        pg8::gemm_phase<pg8::EpiSwiGLU8, pg8::MoeOrder, true, true, true>(F.lds + RING_OFF, g, S, E); } SEAM(12);
    if (IN(13)) { pg8::Gemm g{(const bf16_t*)(ws + WS_HM), (const bf16_t*)(ws + WS_W_MDN), SLOTS, 8 * 1024, DFE / 2}; pg8::MoeOrder S; S.init((const int*)(ws + WS_META), 4, F.G, (int)blockIdx.x, true);
        pg8::EpiMoeDown E{ws + WS_Y, (const float*)(ws + WS_GATES), 1.0f / (pg8::F8_SH * pg8::F8_SWD), (bf16_t*)(ws + WS_PP)};
        pg8::gemm_phase<pg8::EpiMoeDown, pg8::MoeOrder, true, true, true>(F.lds + RING_OFF, g, S, E); } SEAM(13);
    if (IN(14)) { p13_final(F); }
#undef IN
#undef SEAM
#undef SEAM_NOW
#undef SEAM_NOWF
#undef SEAM_NOWL
#undef SEAM_LOCAL
#undef ws
#undef XB
#undef SSQ
}
#ifndef MEGA_UPTO
#define MEGA_UPTO 15
#endif
#ifndef MEGA_REPMASK
#define MEGA_REPMASK 0
#endif
#ifndef MEGA_ONE
#define MEGA_ONE 1
#endif
extern "C" void kernel_launch(void* const* d_in, const int* in_sizes, int n_in, void* d_out, int out_size, void* d_ws, size_t ws_size, hipStream_t stream) {
    static int grid = 0;
    if (grid == 0) {
        if (n_in != 19 || in_sizes[0] != M * D || out_size != M * D || ws_size < WS_END) { fprintf(stderr, "kernel_launch: unexpected shapes / workspace (%d inputs, ws %zu, need %zu)\n", n_in, ws_size, (size_t)WS_END); grid = -1; return; }
        int dev = 0, cus = 0, per_cu = 0;
        if (hipGetDevice(&dev) != hipSuccess || hipDeviceGetAttribute(&cus, hipDeviceAttributeMultiprocessorCount, dev) != hipSuccess) { grid = -1; return; }
        if (hipFuncSetAttribute((const void*)mega_fwd, hipFuncAttributeMaxDynamicSharedMemorySize, LDS_BYTES) != hipSuccess) { fprintf(stderr, "kernel_launch: hipFuncSetAttribute failed\n"); grid = -1; return; }
        if (hipOccupancyMaxActiveBlocksPerMultiprocessor(&per_cu, (const void*)mega_fwd, NWAVES * 64, LDS_BYTES) != hipSuccess || per_cu < 1) fprintf(stderr, "kernel_launch: note: occupancy query says %d\n", per_cu);
        (void)hipGetLastError();
        grid = cus < 256 ? cus : 256;
        if (grid != 256) fprintf(stderr, "kernel_launch: %d CUs; this kernel is built for 256\n", cus);
    }
    if (grid < 0) return;
    unsigned char* ws = (unsigned char*)d_ws; float* out = (float*)d_out;
    constexpr int UPTO = MEGA_UPTO;
    static_assert(UPTO == 15, "the plain reference kernels of the transition builds are gone: all 15 phases run in the persistent kernel");
    if (UPTO > 0) {
        if (hipMemsetAsync(ws + WS_CTL, 0, CTL_ZERO_BYTES, stream) != hipSuccess) { fprintf(stderr, "kernel_launch: memset failed\n"); return; }
        Args a{};
        for (int i = 0; i < 19; ++i) a.in[i] = (const float*)d_in[i];
        a.out = out; a.wsp = ws;
        if (MEGA_ONE) { a.ph_lo = 0; a.ph_hi = UPTO; a.li = 0; hipLaunchKernelGGL(mega_fwd, dim3(grid), dim3(NWAVES * 64), LDS_BYTES, stream, a); }
        else for (int p = 0; p < UPTO; ++p) { a.ph_lo = p; a.ph_hi = p + 1; a.li = 0; for (int r = 0; r <= ((MEGA_REPMASK >> p) & 1); ++r) hipLaunchKernelGGL(mega_fwd, dim3(grid), dim3(NWAVES * 64), LDS_BYTES, stream, a); }
        const hipError_t le = hipPeekAtLastError();
        if (le != hipSuccess) fprintf(stderr, "kernel_launch: launch failed: %s\n", hipGetErrorName(le));
    }
}
```
